# Optimizing an MI355X kernel written in HIP

```python
import math
import jax
import jax.numpy as jnp
from jax import lax
import numpy as np

D_MODEL = 2048
BATCH = 8
SEQ = 4096
DEPTH = 4

GRID_W = 64
CTX_LEN = 256
N_MIXERS = 2
N_HYENA_LAYERS = (DEPTH + 1) // 2
N_ATTN_LAYERS = DEPTH // 2
HY_ORDER = 2
HY_EMB = 33
HY_BANDS = (HY_EMB - 1) // 2
HY_FILTER_W = 64
HY_FAST_DECAY_PCT = 0.3
HY_SLOW_DECAY_PCT = 1.5
HY_DECAY_TARGET = 1e-2
HEAD_DIM = 64
N_Q_HEADS = D_MODEL // HEAD_DIM
N_KV_HEADS = 4
Q_PER_KV = N_Q_HEADS // N_KV_HEADS
D_Q = N_Q_HEADS * HEAD_DIM
D_KV = N_KV_HEADS * HEAD_DIM
WINDOW = 128
Q_BLOCK = 128
ROPE_PAIRS = HEAD_DIM // 4
ROPE_BASE = 10000.0
N_GROUPS = 8
EXPERTS_PER_GROUP = 8
N_EXPERTS = N_GROUPS * EXPERTS_PER_GROUP
TOP_K = 2
D_EXPERT = 3 * D_MODEL // 16
MOE_BLOCK = 256
EPS = 1e-6

kernel_name = 'hybrid_hyena_swa_hmoe_dit'


def rms_norm(x, gain=None):
    xf = x.astype(jnp.float32)
    y = xf * lax.rsqrt(jnp.mean(xf * xf, axis=-1, keepdims=True) + EPS)
    if gain is not None:
        y = y * gain.astype(jnp.float32)
    return y.astype(x.dtype)


def modulate(x, shift, scale):
    return rms_norm(x) * (1 + scale) + shift


def ada_modulation(cond, w, b):
    m = jax.nn.silu(cond) @ w + b
    return jnp.split(m, 6, axis=-1)


def short_conv(u, w, b):
    L = u.shape[1]
    up = jnp.pad(u, ((0, 0), (1, 1), (0, 0)))
    return up[:, :L] * w[0] + up[:, 1:L + 1] * w[1] + up[:, 2:L + 2] * w[2] + b


def hyena_filters(L, w1, b1, freq1, w2, b2, freq2, w3):
    f32 = jnp.float32
    t = jnp.linspace(0.0, 1.0, L, dtype=f32)[:, None]
    omega = (2.0 * math.pi / L) * jnp.arange(L, dtype=f32)[:, None]
    bands = jnp.linspace(1e-4, HY_BANDS - 1, HY_BANDS, dtype=f32)[None, :]
    feats = jnp.concatenate([t, jnp.cos(bands * omega), -jnp.sin(bands * omega)], axis=-1)
    h = jnp.sin(freq1.astype(f32) * (feats @ w1.astype(f32) + b1.astype(f32)))
    h = jnp.sin(freq2.astype(f32) * (h @ w2.astype(f32) + b2.astype(f32)))
    h = (h @ w3.astype(f32)).reshape(L, HY_ORDER, 2, D_MODEL)
    max_decay = math.log(HY_DECAY_TARGET) / HY_FAST_DECAY_PCT
    min_decay = math.log(HY_DECAY_TARGET) / HY_SLOW_DECAY_PCT
    deltas = jnp.linspace(min_decay, max_decay, D_MODEL, dtype=f32)
    decay = jnp.exp(-t * jnp.abs(deltas))
    h = h * decay[:, None, None, :]
    h_fwd, h_bwd = h[:, :, 0], h[:, :, 1]
    k = jnp.concatenate([h_fwd, jnp.zeros_like(h_fwd[:1]), h_bwd[:0:-1]], axis=0)
    k = k * lax.rsqrt(jnp.sum(k * k, axis=0, keepdims=True) + EPS)
    return jnp.fft.rfft(k, axis=0)


def long_conv(u, k_f, bias):
    L = u.shape[1]
    uf = u.astype(jnp.float32)
    y = jnp.fft.irfft(jnp.fft.rfft(uf, n=2 * L, axis=1) * k_f, n=2 * L, axis=1)[:, :L]
    return (y + uf * bias.astype(jnp.float32)).astype(u.dtype)


def hyena_mixer(h, w_in, conv_w, conv_b, filt, bias, w_out):
    L = h.shape[1]
    u = short_conv(h @ w_in, conv_w, conv_b)
    v, x1, x2 = jnp.split(u, 3, axis=-1)
    k_f = hyena_filters(L, *filt)
    z = x1 * long_conv(v, k_f[:, 0], bias[0])
    z = x2 * long_conv(z, k_f[:, 1], bias[1])
    return z @ w_out


def axial_rope_tables(L):
    rows = L // GRID_W
    r = jnp.repeat(jnp.arange(rows, dtype=jnp.float32), GRID_W)
    col = jnp.tile(jnp.arange(GRID_W, dtype=jnp.float32), rows)
    inv = ROPE_BASE ** (-(2.0 * jnp.arange(ROPE_PAIRS, dtype=jnp.float32)) / (2 * ROPE_PAIRS))
    ang = jnp.stack([r[:, None] * inv, col[:, None] * inv], axis=1)
    return jnp.cos(ang), jnp.sin(ang)


def apply_axial_rope(x, cos, sin):
    shp = (cos.shape[0],) + (1,) * (x.ndim - 3) + cos.shape[1:]
    cos = cos.reshape(shp)
    sin = sin.reshape(shp)
    xr = x.astype(jnp.float32).reshape(x.shape[:-1] + (2, 2, ROPE_PAIRS))
    x1, x2 = xr[..., 0, :], xr[..., 1, :]
    out = jnp.stack([x1 * cos - x2 * sin, x2 * cos + x1 * sin], axis=-2)
    return out.reshape(x.shape).astype(x.dtype)


def split_qkv(qkv):
    B, L = qkv.shape[:2]
    q, k, v = jnp.split(qkv, [D_Q, D_Q + D_KV], axis=-1)
    return (q.reshape(B, L, N_KV_HEADS, Q_PER_KV, HEAD_DIM),
            k.reshape(B, L, N_KV_HEADS, HEAD_DIM),
            v.reshape(B, L, N_KV_HEADS, HEAD_DIM))


def sink_attention(q, k, v, sink, mask):
    s = jnp.einsum('bqkgd,bskd->bkgqs', q, k).astype(jnp.float32) * (HEAD_DIM ** -0.5)
    s = jnp.where(mask, s, -jnp.inf)
    sink_col = jnp.broadcast_to(sink.astype(jnp.float32)[None, :, :, None, None], s.shape[:-1] + (1,))
    p = jax.nn.softmax(jnp.concatenate([s, sink_col], axis=-1), axis=-1)[..., :-1]
    return jnp.einsum('bkgqs,bskd->bqkgd', p.astype(v.dtype), v)


def attention_mixer(h_lat, h_ctx, w_qkv, sink, w_o, with_ctx_out):
    B, L, _ = h_lat.shape
    sink = sink.reshape(N_KV_HEADS, Q_PER_KV)
    q, k, v = split_qkv(h_lat @ w_qkv)
    q_c, k_c, v_c = split_qkv(h_ctx @ w_qkv)
    ctx_len = k_c.shape[1]
    cos, sin = axial_rope_tables(L)
    q = apply_axial_rope(q, cos, sin)
    k = apply_axial_rope(k, cos, sin)
    kp = jnp.pad(k, ((0, 0), (WINDOW, WINDOW), (0, 0), (0, 0)))
    vp = jnp.pad(v, ((0, 0), (WINDOW, WINDOW), (0, 0), (0, 0)))
    span = Q_BLOCK + 2 * WINDOW
    ctx_mask = jnp.ones((Q_BLOCK, ctx_len), bool)

    def block(bi):
        start = bi * Q_BLOCK
        qb = lax.dynamic_slice_in_dim(q, start, Q_BLOCK, axis=1)
        kb = jnp.concatenate([lax.dynamic_slice_in_dim(kp, start, span, axis=1), k_c], axis=1)
        vb = jnp.concatenate([lax.dynamic_slice_in_dim(vp, start, span, axis=1), v_c], axis=1)
        qpos = start + jnp.arange(Q_BLOCK)
        kpos = start - WINDOW + jnp.arange(span)
        band = (jnp.abs(qpos[:, None] - kpos[None, :]) <= WINDOW) & (kpos >= 0) & (kpos < L)
        return sink_attention(qb, kb, vb, sink, jnp.concatenate([band, ctx_mask], axis=1))

    o = lax.map(block, jnp.arange(L // Q_BLOCK))
    y_lat = jnp.moveaxis(o, 0, 1).reshape(B, L, D_Q) @ w_o
    if not with_ctx_out:
        return y_lat, None
    o_c = sink_attention(q_c, k_c, v_c, sink, jnp.ones((ctx_len, ctx_len), bool))
    return y_lat, o_c.reshape(B, ctx_len, D_Q) @ w_o


def expert_dispatch(h, expert_id, gates, w1, w3, w2):
    n_tok, d = h.shape
    n_assign = n_tok * TOP_K
    flat_e = expert_id.reshape(n_assign).astype(jnp.int32)
    flat_t = jnp.repeat(jnp.arange(n_tok, dtype=jnp.int32), TOP_K)
    flat_g = gates.reshape(n_assign)
    order = jnp.argsort(flat_e)
    se = flat_e[order]
    counts = jnp.bincount(flat_e, length=N_EXPERTS)
    padded = (counts + MOE_BLOCK - 1) // MOE_BLOCK * MOE_BLOCK
    pad_end = jnp.cumsum(padded)
    pad_start = pad_end - padded
    start = jnp.cumsum(counts) - counts
    dest = pad_start[se] + jnp.arange(n_assign, dtype=jnp.int32) - start[se]
    n_blocks = -(-n_assign // MOE_BLOCK) + N_EXPERTS
    slot_tok = jnp.full((n_blocks * MOE_BLOCK,), n_tok, jnp.int32).at[dest].set(flat_t[order])
    slot_gate = jnp.zeros((n_blocks * MOE_BLOCK,), h.dtype).at[dest].set(flat_g[order])
    block_start = jnp.arange(n_blocks, dtype=jnp.int32) * MOE_BLOCK
    block_exp = jnp.clip(jnp.searchsorted(pad_end, block_start, side='right'), 0, N_EXPERTS - 1)
    h_pad = jnp.concatenate([h, jnp.zeros((1, d), h.dtype)], axis=0)

    def run(args):
        tok, e = args
        xb = h_pad[tok]
        return (jax.nn.silu(xb @ w1[e]) * (xb @ w3[e])) @ w2[e]

    y = lax.map(run, (slot_tok.reshape(n_blocks, MOE_BLOCK), block_exp))
    y = y.reshape(n_blocks * MOE_BLOCK, d) * slot_gate[:, None]
    return jax.ops.segment_sum(y, slot_tok, num_segments=n_tok + 1)[:n_tok]


def hier_moe(h, wg, bg, we, be, w1, w3, w2):
    n_tok = h.shape[0]
    f32 = jnp.float32
    hf = h.astype(f32)
    p_group = jax.nn.softmax(hf @ wg.astype(f32) + bg.astype(f32), axis=-1)
    p_g, g_sel = lax.top_k(p_group, 1)
    fine = (hf @ we.astype(f32) + be.astype(f32)).reshape(n_tok, N_GROUPS, EXPERTS_PER_GROUP)
    fine = fine[jnp.arange(n_tok), g_sel[:, 0]]
    p_e = jax.nn.softmax(fine, axis=-1)
    top_p, top_i = lax.top_k(p_e, TOP_K)
    gates = p_g * top_p / jnp.sum(top_p, axis=-1, keepdims=True)
    expert_id = g_sel * EXPERTS_PER_GROUP + top_i
    return expert_dispatch(h, expert_id, gates.astype(h.dtype), w1, w3, w2)


def setup_inputs(seed: int = 0) -> dict:
    key = jax.random.key(seed)
    ks = jax.random.split(key, 32)
    f32 = jnp.float32
    D = D_MODEL

    def nrm(k, shape, std):
        return jax.random.normal(k, shape, f32) * std

    return {
        'x': nrm(ks[0], (BATCH, SEQ, D), 1.0),
        'c': nrm(ks[1], (BATCH, D), 1.0),
        'ctx': nrm(ks[2], (BATCH, CTX_LEN, D), 1.0),
        'c_ctx': nrm(ks[3], (D,), 1.0),
        'mod_w': nrm(ks[4], (DEPTH, D, 6 * D), D ** -0.5),
        'mod_b': nrm(ks[5], (DEPTH, 6 * D), 0.02),
        'hy_w_in': nrm(ks[6], (N_HYENA_LAYERS, D, 3 * D), D ** -0.5),
        'hy_conv_w': nrm(ks[7], (N_HYENA_LAYERS, 3, 3 * D), 3 ** -0.5),
        'hy_conv_b': nrm(ks[8], (N_HYENA_LAYERS, 3 * D), 0.02),
        'hy_f_w1': nrm(ks[9], (N_HYENA_LAYERS, HY_EMB, HY_FILTER_W), HY_EMB ** -0.5),
        'hy_f_b1': nrm(ks[10], (N_HYENA_LAYERS, HY_FILTER_W), 0.02),
        'hy_f_freq1': 1.0 + nrm(ks[11], (N_HYENA_LAYERS, HY_FILTER_W), 0.1),
        'hy_f_w2': nrm(ks[12], (N_HYENA_LAYERS, HY_FILTER_W, HY_FILTER_W), HY_FILTER_W ** -0.5),
        'hy_f_b2': nrm(ks[13], (N_HYENA_LAYERS, HY_FILTER_W), 0.02),
        'hy_f_freq2': 1.0 + nrm(ks[14], (N_HYENA_LAYERS, HY_FILTER_W), 0.1),
        'hy_f_w3': nrm(ks[15], (N_HYENA_LAYERS, HY_FILTER_W, HY_ORDER * 2 * D), HY_FILTER_W ** -0.5),
        'hy_bias': nrm(ks[16], (N_HYENA_LAYERS, HY_ORDER, D), 0.1),
        'hy_w_out': nrm(ks[17], (N_HYENA_LAYERS, D, D), D ** -0.5),
        'at_w_qkv': nrm(ks[18], (N_ATTN_LAYERS, D, D_Q + 2 * D_KV), D ** -0.5),
        'at_sink': nrm(ks[19], (N_ATTN_LAYERS, N_Q_HEADS), 0.5),
        'at_w_o': nrm(ks[20], (N_ATTN_LAYERS, D_Q, D), D_Q ** -0.5),
        'moe_wg': nrm(ks[21], (DEPTH, D, N_GROUPS), D ** -0.5),
        'moe_bg': nrm(ks[22], (DEPTH, N_GROUPS), 0.01),
        'moe_we': nrm(ks[23], (DEPTH, D, N_EXPERTS), D ** -0.5),
        'moe_be': nrm(ks[24], (DEPTH, N_EXPERTS), 0.01),
        'moe_w1': nrm(ks[25], (DEPTH, N_EXPERTS, D, D_EXPERT), D ** -0.5),
        'moe_w3': nrm(ks[26], (DEPTH, N_EXPERTS, D, D_EXPERT), D ** -0.5),
        'moe_w2': nrm(ks[27], (DEPTH, N_EXPERTS, D_EXPERT, D), D_EXPERT ** -0.5),
        'final_gain': 1.0 + nrm(ks[28], (D,), 0.02),
    }


def reference(x, c, ctx, c_ctx, mod_w, mod_b, hy_w_in, hy_conv_w, hy_conv_b, hy_f_w1, hy_f_b1,
              hy_f_freq1, hy_f_w2, hy_f_b2, hy_f_freq2, hy_f_w3, hy_bias, hy_w_out,
              at_w_qkv, at_sink, at_w_o, moe_wg, moe_bg, moe_we, moe_be, moe_w1, moe_w3, moe_w2,
              final_gain):
    B, L, D = x.shape
    xc = ctx
    for i in range(DEPTH):
        last = i == DEPTH - 1
        j = i // N_MIXERS
        sh1, sc1, g1, sh2, sc2, g2 = ada_modulation(c[:, None, :], mod_w[i], mod_b[i])
        sh1c, sc1c, g1c, sh2c, sc2c, g2c = ada_modulation(c_ctx, mod_w[i], mod_b[i])
        h_lat = modulate(x, sh1, sc1)
        y_ctx = None
        if i % N_MIXERS == 0:
            filt = (hy_f_w1[j], hy_f_b1[j], hy_f_freq1[j], hy_f_w2[j], hy_f_b2[j], hy_f_freq2[j], hy_f_w3[j])
            y_lat = hyena_mixer(h_lat, hy_w_in[j], hy_conv_w[j], hy_conv_b[j], filt, hy_bias[j], hy_w_out[j])
            if not last:
                y_ctx = hyena_mixer(modulate(xc, sh1c, sc1c), hy_w_in[j], hy_conv_w[j], hy_conv_b[j],
                                    filt, hy_bias[j], hy_w_out[j])
        else:
            y_lat, y_ctx = attention_mixer(h_lat, modulate(xc, sh1c, sc1c), at_w_qkv[j], at_sink[j],
                                           at_w_o[j], not last)
        x = x + g1 * y_lat
        moe_args = (moe_wg[i], moe_bg[i], moe_we[i], moe_be[i], moe_w1[i], moe_w3[i], moe_w2[i])
        if last:
            y = hier_moe(modulate(x, sh2, sc2).reshape(B * L, D), *moe_args)
            x = x + g2 * y.reshape(B, L, D)
        else:
            xc = xc + g1c * y_ctx
            tokens = jnp.concatenate([modulate(x, sh2, sc2).reshape(B * L, D),
                                      modulate(xc, sh2c, sc2c).reshape(-1, D)], axis=0)
            y = hier_moe(tokens, *moe_args)
            x = x + g2 * y[:B * L].reshape(B, L, D)
            xc = xc + g2c * y[B * L:].reshape(xc.shape)
    return rms_norm(x, final_gain)
```

```cpp
#include <hip/hip_runtime.h>
#include <cstdio>
#include <cstdint>

#define LAS __attribute__((address_space(3)))
typedef _Float16 h16;
typedef _Float16 f16x8 __attribute__((ext_vector_type(8)));
typedef _Float16 f16x4 __attribute__((ext_vector_type(4)));
typedef _Float16 f16x2 __attribute__((ext_vector_type(2)));
typedef float f32x2 __attribute__((ext_vector_type(2)));
typedef float f32x4 __attribute__((ext_vector_type(4)));
typedef float f32x16 __attribute__((ext_vector_type(16)));
typedef unsigned u32x2 __attribute__((ext_vector_type(2)));
typedef unsigned u32x4 __attribute__((ext_vector_type(4)));

constexpr int D = 2048, NB = 8, SEQ = 4096, CTXL = 256, TL = NB * SEQ, TC = NB * CTXL, TT = TL + TC;
constexpr int D3 = 3 * D, D6 = 6 * D, DQK = 2304, DQKV = 2560, NE = 64, DE = 384, DE2 = 768, NLAYER = 4;
constexpr int LCAP = TT;
constexpr int MOE_ROWS = 86016;
constexpr float EPS = 1e-6f;

constexpr size_t WS_CTL = 0;
constexpr size_t CTL_BYTES = 65536;
constexpr size_t WS_TW = WS_CTL + CTL_BYTES;
constexpr size_t WS_ROPE = WS_TW + 65536;
constexpr size_t WS_MODP = WS_ROPE + 8192;
constexpr size_t WS_MODS = WS_MODP + 16ull * 4 * 9 * 12288 * 4;
constexpr size_t WS_RTAB = WS_MODS + 4ull * 9 * 12288 * 4;
constexpr size_t RTAB_L = 64ull * 5 * 2 * 64 * 8 * 2;
constexpr size_t WS_H2P = WS_RTAB + 4 * RTAB_L;
constexpr size_t WS_W3P = WS_H2P + 2ull * 4352 * 256 * 2;
constexpr size_t WS_XRES = WS_W3P + 2ull * 8192 * 256 * 2;
constexpr size_t WS_HBUF = WS_XRES + (size_t)TT * D * 4;
constexpr size_t WS_UT = WS_HBUF + (size_t)TT * D * 2;
constexpr size_t UT_BYTES = (size_t)D3 * TT * 2;
constexpr size_t WS_TAPS = WS_UT;
constexpr size_t WS_TAPSC = WS_TAPS + 2ull * 8192 * 4096 * 4;
constexpr size_t WS_QK = WS_UT;
constexpr size_t WS_VT = WS_QK + (size_t)TT * DQK * 2;
constexpr size_t WS_ZT = WS_UT + UT_BYTES;
constexpr size_t WS_H1 = WS_ZT + (size_t)D * TT * 2;
constexpr size_t WS_YC = WS_H1 + (size_t)MOE_ROWS * DE * 2;
constexpr size_t WS_WIN = WS_YC + 2ull * TT * D * 2;
constexpr size_t WS_WOUT = WS_WIN + 2ull * D3 * D * 2;
constexpr size_t WS_WQKV = WS_WOUT + 2ull * D * D * 2;
constexpr size_t WS_WO = WS_WQKV + 2ull * DQKV * D * 2;
constexpr size_t WS_W13 = WS_WO + 2ull * D * D * 2;
constexpr size_t WS_W2 = WS_W13 + (size_t)NE * DE2 * D * 2;
constexpr size_t WS_KF = WS_W2 + (size_t)NE * D * DE * 2;
constexpr size_t WS_LIST = WS_KF + 2ull * 2 * 2 * 2048 * 65536;
constexpr size_t WS_GATE = WS_LIST + (size_t)NE * LCAP * 4;
constexpr size_t WS_END = WS_GATE + 2ull * TT * 4;
static_assert(WS_TAPSC + 2ull * 8192 * 256 * 4 <= WS_UT + UT_BYTES, "taps alias");
static_assert(WS_VT + 256ull * TT * 2 <= WS_UT + UT_BYTES, "qkv alias");

constexpr int CTL_CNT = 4096;

constexpr int LDS_BYTES = 147456;
constexpr int LDS_MISC = 139264;
constexpr int LDS_XB = LDS_BYTES - 16;

struct Params {
    const float *x, *c, *ctx, *c_ctx, *mod_w, *mod_b, *hy_w_in, *hy_conv_w, *hy_conv_b, *hy_f_w1, *hy_f_b1, *hy_f_freq1, *hy_f_w2, *hy_f_b2, *hy_f_freq2, *hy_f_w3,
        *hy_bias, *hy_w_out, *at_w_qkv, *at_sink, *at_w_o, *moe_wg, *moe_bg, *moe_we, *moe_be, *moe_w1, *moe_w3, *moe_w2, *final_gain;
    float* out; char* ws; int ph0, ph1;
};

#define XB_TMO      128
#define XB_XCNT(j)  (256  + 64 * (j))
#define XB_XSUB(j)  (1280 + 64 * (j))
#define XB_XGEN(j)  (2304 + 64 * (j))
#define XB_TOP      3328
#define XB_TOPGEN   3392
#define XCD_BAR_WORDS 3456
#define XB_SPIN_CAP (1u << 18)

__device__ __forceinline__ unsigned xb_ld(unsigned* p)              { return __hip_atomic_load(p, __ATOMIC_RELAXED, __HIP_MEMORY_SCOPE_AGENT); }
__device__ __forceinline__ unsigned xb_add(unsigned* p, unsigned v) { return __hip_atomic_fetch_add(p, v, __ATOMIC_RELAXED, __HIP_MEMORY_SCOPE_AGENT); }
__device__ __forceinline__ unsigned xb_xcc_id() { return (unsigned)__builtin_amdgcn_s_getreg((3 << 11) | 20) & 0xFu; }
#define XB_SPIN(cond, bar) do { unsigned _sp = 0; while (cond) { __builtin_amdgcn_s_sleep(1); \
    if ((++_sp & 255u) == 0u) { if (xb_ld(&(bar)[XB_TMO])) break; if (_sp > XB_SPIN_CAP) { atomicAdd(&(bar)[XB_TMO], 1u); break; } } } } while (0)

struct XcdBarrier { unsigned* bar; unsigned x; volatile LAS unsigned* st; };

__device__ __forceinline__ XcdBarrier xcd_barrier_post(unsigned* bar, volatile LAS unsigned* st) {
    XcdBarrier b; b.bar = bar; b.x = xb_xcc_id(); b.st = st;
    if (threadIdx.x == 0) (void)xb_add(&bar[XB_XCNT(b.x)], 1u);
    return b;
}
__device__ __forceinline__ void xcd_barrier_complete(unsigned* bar, unsigned x, unsigned& nloc, unsigned& nx) {
    const unsigned G = gridDim.x * gridDim.y * gridDim.z;
    unsigned sum, cnt, mine, sp = 0u;
    for (;;) {
        sum = 0u; cnt = 0u; mine = 0u;
#pragma unroll
        for (unsigned j = 0; j < 16; ++j) { const unsigned c = xb_ld(&bar[XB_XCNT(j)]); sum += c; cnt += (c > 0u) ? 1u : 0u; mine = (j == x) ? c : mine; }
        if (sum == G) break;
        __builtin_amdgcn_s_sleep(1);
        if ((++sp & 255u) == 0u) { if (xb_ld(&bar[XB_TMO])) break; if (sp > XB_SPIN_CAP) { atomicAdd(&bar[XB_TMO], 1u); break; } }
    }
    nloc = mine > 0u ? mine : 1u; nx = cnt > 0u ? cnt : 1u;
}
__device__ __forceinline__ void xcd_barrier(const XcdBarrier& b) {
    asm volatile("s_waitcnt vmcnt(0)" ::: "memory");
    __syncthreads();
    if (threadIdx.x == 0) {
        unsigned* bar = b.bar;
        __builtin_amdgcn_s_waitcnt(0);
        unsigned nloc = b.st[0], nx = b.st[1];
        if (nloc == 0u) { xcd_barrier_complete(bar, b.x, nloc, nx); b.st[0] = nloc; b.st[1] = nx; }
        const unsigned old = xb_add(&bar[XB_XSUB(b.x)], 1u);
        const unsigned gen = old / nloc;
        if (old + 1u == (gen + 1u) * nloc) {
            __builtin_amdgcn_fence(__ATOMIC_RELEASE, "agent");
            asm volatile("s_waitcnt vmcnt(0)" ::: "memory");
            const unsigned og = xb_add(&bar[XB_TOP], 1u);
            const unsigned tg = og / nx;
            if (og + 1u == (tg + 1u) * nx) xb_add(&bar[XB_TOPGEN], 1u);
            else XB_SPIN(xb_ld(&bar[XB_TOPGEN]) == tg, bar);
            __builtin_amdgcn_fence(__ATOMIC_ACQUIRE, "agent");
            xb_add(&bar[XB_XGEN(b.x)], 1u);
            asm volatile("s_waitcnt vmcnt(0)" ::: "memory");
        } else {
            XB_SPIN(xb_ld(&bar[XB_XGEN(b.x)]) == gen, bar);
            __builtin_amdgcn_fence(__ATOMIC_ACQUIRE, "agent");
            asm volatile("s_waitcnt vmcnt(0)" ::: "memory");
        }
    }
    __syncthreads();
}

namespace pg8 {
constexpr int BM = 256, BK = 64, HALF = 128, HTB = HALF * BK * 2, STAGE_BYTES = 8 * HTB;
__device__ __forceinline__ int lds_byte(int r, int c) { const int st = (r >> 4) * 2 + (c >> 5), rr = r & 15, cc = c & 31, ob = rr * 64 + cc * 2; return st * 1024 + (ob ^ (((ob >> 9) & 1) << 5)); }
__device__ __forceinline__ void stage_rc(int b, int& R, int& C) { const int st = b / 1024, sb = b % 1024, swz = sb ^ (((sb >> 9) & 1) << 5); R = (st >> 1) * 16 + swz / 64; C = (st & 1) * 32 + (swz % 64) / 2; }
__device__ __forceinline__ int perm32(int rho) { const int n = rho >> 4, i = rho & 15; return 8 * (i >> 2) + 4 * n + (i & 3); }

struct Unit {
    int pm, pn;
    int e, pos0, cnt;
    int kind;
    const char* A; const char* B;
    const int* rows;
};

template <class Epi, class Sched, bool GATHER>
__device__ __forceinline__ void gemm_phase(LAS unsigned char* lds, const int K, const Sched& S, const Epi& E) {
    const int tid = threadIdx.x, wid = __builtin_amdgcn_readfirstlane(tid >> 6), lane = tid & 63, wr = wid >> 2, wc = wid & 3, fr = lane & 15, fq = lane >> 4;
    const int nt = K / BK;
    unsigned voffA[2], voffB[2]; int RA[2], CA[2];
#pragma unroll
    for (int i = 0; i < 2; ++i) { int R, C; stage_rc(tid * 16 + i * 8192, R, C); const int Rb = Epi::PERM ? ((R & ~31) + perm32(R & 31)) : R;
        voffA[i] = (unsigned)(R * K + C) * 2u; voffB[i] = (unsigned)(Rb * K + C) * 2u; RA[i] = R; CA[i] = C; }
    const size_t kstep = (size_t)(BK * 2);
    const size_t hstep = (size_t)HALF * K * 2;
    const unsigned ldsw = (unsigned)wid * 1024u;
    const int aoff = lds_byte(wr * 64 + fr, fq * 8), boff = lds_byte(wc * 32 + fr, fq * 8);
    unsigned vgC[2][2], vgN[2][2];
#define PG8_ROWS(u, vg) do { if constexpr (GATHER) { _Pragma("unroll") for (int _h = 0; _h < 2; ++_h) _Pragma("unroll") for (int _i = 0; _i < 2; ++_i) { \
        const int _p = (u).pos0 + _h * HALF + RA[_i]; const int _tok = (_p < (u).cnt) ? ((u).rows[_h * HALF + RA[_i]] >> 1) : 0; \
        vg[_h][_i] = ((unsigned)_tok * (unsigned)K + (unsigned)CA[_i]) * 2u; } } } while (0)
#define PG8_SA(b, h) (((b) * 2 + (h)) * HTB)
#define PG8_SB(b, h) ((4 + (b) * 2 + (h)) * HTB)
#define PG8_STAGE_B(bufoff, gbase) do { _Pragma("unroll") for (int _i = 0; _i < 2; ++_i) \
        __builtin_amdgcn_global_load_lds((const unsigned*)((const char*)(gbase) + voffB[_i]), (LAS unsigned*)(lds + (bufoff) + ldsw + _i * 8192), 16, 0, 0); } while (0)
#define PG8_STAGE_A(bufoff, gbase, h, NEXT) do { _Pragma("unroll") for (int _i = 0; _i < 2; ++_i) { \
        const unsigned _vo = GATHER ? ((NEXT) ? vgN[h][_i] : vgC[h][_i]) : voffA[_i]; \
        __builtin_amdgcn_global_load_lds((const unsigned*)((const char*)(gbase) + (GATHER ? (size_t)0 : (size_t)(h) * hstep) + _vo), (LAS unsigned*)(lds + (bufoff) + ldsw + _i * 8192), 16, 0, 0); } } while (0)
#define PG8_LDA(dst, b, h) do { _Pragma("unroll") for (int m = 0; m < 4; ++m) _Pragma("unroll") for (int k = 0; k < 2; ++k) dst[m][k] = *(const LAS f16x8*)(lds + PG8_SA(b, h) + aoff + m * 2048 + k * 1024); } while (0)
#define PG8_LDB(dst, b, h) do { _Pragma("unroll") for (int n = 0; n < 2; ++n) _Pragma("unroll") for (int k = 0; k < 2; ++k) dst[n][k] = *(const LAS f16x8*)(lds + PG8_SB(b, h) + boff + n * 2048 + k * 1024); } while (0)
#define PG8_MMA(ai, bj, At, Bt) do { __builtin_amdgcn_s_setprio(1); _Pragma("unroll") for (int m = 0; m < 4; ++m) _Pragma("unroll") for (int n = 0; n < 2; ++n) _Pragma("unroll") for (int k = 0; k < 2; ++k) \
        acc[ai][bj][m][n] = __builtin_amdgcn_mfma_f32_16x16x32_f16(Bt[n][k], At[m][k], acc[ai][bj][m][n], 0, 0, 0); __builtin_amdgcn_s_setprio(0); } while (0)
#define PG8_WAIT_V(n) asm volatile("s_waitcnt vmcnt(" #n ")" ::: "memory")
#define PG8_WAIT_L(n) asm volatile("s_waitcnt lgkmcnt(" #n ")" ::: "memory")
#define PG8_BAR __builtin_amdgcn_s_barrier()
#define PG8_SCHED __builtin_amdgcn_sched_barrier(0)
    Unit cur, nxt; int ui = 0;
    if (!S.next(0, cur)) return;
    f32x4 acc[2][2][4][2];
#pragma unroll
    for (int a = 0; a < 2; ++a)
#pragma unroll
        for (int b = 0; b < 2; ++b)
#pragma unroll
            for (int m = 0; m < 4; ++m)
#pragma unroll
                for (int n = 0; n < 2; ++n) acc[a][b][m][n] = (f32x4){0.f, 0.f, 0.f, 0.f};
    f16x8 At[4][2], B0[2][2], B1[2][2];
    const char* cA = cur.A; const char* cB = cur.B;
    PG8_ROWS(cur, vgC);
#pragma unroll
    for (int _h = 0; _h < 2; ++_h)
#pragma unroll
        for (int _i = 0; _i < 2; ++_i) vgN[_h][_i] = GATHER ? vgC[_h][_i] : 0u;
    PG8_STAGE_B(PG8_SB(0, 0), cB); PG8_STAGE_B(PG8_SB(0, 1), cB + hstep); PG8_STAGE_A(PG8_SA(0, 0), cA, 0, false); PG8_STAGE_A(PG8_SA(0, 1), cA, 1, false);
    if (wr == 1) PG8_BAR;
    PG8_WAIT_V(2); PG8_BAR;
    PG8_STAGE_B(PG8_SB(1, 0), cB + kstep); PG8_STAGE_A(PG8_SA(1, 0), cA + kstep, 0, false); PG8_STAGE_B(PG8_SB(1, 1), cB + hstep + kstep);
    PG8_WAIT_V(6); PG8_BAR;
    for (;;) {
        const bool has_next = S.next(ui + 1, nxt);
        const char* nA = has_next ? nxt.A : cA; const char* nB = has_next ? nxt.B : cB;
        if (has_next) { PG8_ROWS(nxt, vgN); }
#pragma unroll 1
        for (int t = 0; t < nt; t += 2) {
            const bool last = (t == nt - 2);
            const char* a1 = cA + (size_t)(t + 1) * kstep;
            const char* a2 = last ? nA : cA + (size_t)(t + 2) * kstep; const char* b2 = last ? nB : cB + (size_t)(t + 2) * kstep;
            const char* a3 = a2 + kstep; const char* b3 = b2 + kstep;
            PG8_LDB(B0, 0, 0); PG8_LDB(B1, 0, 1); PG8_SCHED; PG8_LDA(At, 0, 0); PG8_STAGE_A(PG8_SA(1, 1), a1, 1, false);
            PG8_WAIT_V(8); PG8_WAIT_L(0); PG8_BAR; PG8_MMA(0, 0, At, B0); PG8_MMA(0, 1, At, B1); PG8_BAR; PG8_SCHED;
            PG8_LDA(At, 0, 1); PG8_STAGE_B(PG8_SB(0, 0), b2); PG8_STAGE_B(PG8_SB(0, 1), b2 + hstep); PG8_STAGE_A(PG8_SA(0, 0), a2, 0, last);
            PG8_WAIT_V(8); PG8_WAIT_L(0); PG8_BAR; PG8_MMA(1, 0, At, B0); PG8_MMA(1, 1, At, B1); PG8_BAR; PG8_SCHED;
            PG8_LDB(B0, 1, 0); PG8_LDB(B1, 1, 1); PG8_SCHED; PG8_LDA(At, 1, 0); PG8_STAGE_A(PG8_SA(0, 1), a2, 1, last);
            PG8_WAIT_V(8); PG8_WAIT_L(0); PG8_BAR; PG8_MMA(0, 0, At, B0); PG8_MMA(0, 1, At, B1); PG8_BAR; PG8_SCHED;
            PG8_LDA(At, 1, 1); PG8_STAGE_B(PG8_SB(1, 0), b3); PG8_STAGE_B(PG8_SB(1, 1), b3 + hstep); PG8_STAGE_A(PG8_SA(1, 0), a3, 0, last);
            PG8_WAIT_V(8); PG8_WAIT_L(0); PG8_BAR; PG8_MMA(1, 0, At, B0); PG8_MMA(1, 1, At, B1); PG8_BAR; PG8_SCHED;
        }
        if (wr == 0) PG8_BAR;
        E(acc, cur, wr, wc, fr, fq);
        if (!has_next) break;
#pragma unroll
        for (int a = 0; a < 2; ++a)
#pragma unroll
            for (int b = 0; b < 2; ++b)
#pragma unroll
                for (int m = 0; m < 4; ++m)
#pragma unroll
                    for (int n = 0; n < 2; ++n) acc[a][b][m][n] = (f32x4){0.f, 0.f, 0.f, 0.f};
        cur = nxt; cA = nA; cB = nB; ++ui;
#pragma unroll
        for (int _h = 0; _h < 2; ++_h)
#pragma unroll
            for (int _i = 0; _i < 2; ++_i) vgC[_h][_i] = vgN[_h][_i];
        if (wr == 1) PG8_BAR;
    }
    PG8_WAIT_V(0);
    PG8_BAR;
#undef PG8_ROWS
#undef PG8_SA
#undef PG8_SB
#undef PG8_STAGE_A
#undef PG8_STAGE_B
#undef PG8_LDA
#undef PG8_LDB
#undef PG8_MMA
#undef PG8_WAIT_V
#undef PG8_WAIT_L
#undef PG8_BAR
#undef PG8_SCHED
}
}

using pg8::Unit;
__device__ __forceinline__ f16x8 pack8(const f32x4 a, const f32x4 b) {
    f16x8 w; w[0] = (h16)a[0]; w[1] = (h16)a[1]; w[2] = (h16)a[2]; w[3] = (h16)a[3]; w[4] = (h16)b[0]; w[5] = (h16)b[1]; w[6] = (h16)b[2]; w[7] = (h16)b[3]; return w;
}
struct EpiH16 {
    static constexpr bool PERM = true;
    h16* O0; int ld0; h16* O1; int ld1;
    __device__ __forceinline__ void operator()(const f32x4 (&acc)[2][2][4][2], const Unit& u, int wr, int wc, int fr, int fq) const {
        h16* base = u.kind ? O1 : O0; const int ld = u.kind ? ld1 : ld0;
        const int row0 = u.pm * 256 + wr * 64 + fr, col0 = u.pn * 256 + wc * 32 + 8 * fq;
#pragma unroll
        for (int ai = 0; ai < 2; ++ai)
#pragma unroll
            for (int m = 0; m < 4; ++m) { h16* rowp = base + (size_t)(row0 + ai * 128 + m * 16) * ld + col0;
#pragma unroll
                for (int bj = 0; bj < 2; ++bj) *(f16x8*)(rowp + bj * 128) = pack8(acc[ai][bj][m][0], acc[ai][bj][m][1]); }
    }
};
struct EpiTaps {
    static constexpr bool PERM = false;
    float* T0; float* T1;
    __device__ __forceinline__ void operator()(const f32x4 (&acc)[2][2][4][2], const Unit& u, int wr, int wc, int fr, int fq) const {
        const int j = u.kind >> 1, v = u.kind & 1; const int ld = v ? 256 : 4096;
        float* base = v ? (T1 + (size_t)j * 8192 * 256) : (T0 + (size_t)j * 8192 * 4096);
        const int row0 = u.pm * 256 + wr * 64 + fr, col0 = u.pn * 256 + wc * 32 + 4 * fq;
#pragma unroll
        for (int ai = 0; ai < 2; ++ai)
#pragma unroll
            for (int m = 0; m < 4; ++m) { float* rowp = base + (size_t)(row0 + ai * 128 + m * 16) * ld + col0;
#pragma unroll
                for (int bj = 0; bj < 2; ++bj)
#pragma unroll
                    for (int n = 0; n < 2; ++n) *(f32x4*)(rowp + bj * 128 + n * 16) = acc[ai][bj][m][n]; }
    }
};
struct EpiResid {
    static constexpr bool PERM = false;
    float* X; const float* mods; int layer;
    __device__ __forceinline__ void operator()(const f32x4 (&acc)[2][2][4][2], const Unit& u, int wr, int wc, int fr, int fq) const {
        const int r0 = u.pm * 256; const int b = r0 < TL ? (r0 >> 12) : 8;
        const float* g = mods + ((size_t)(layer * 9 + b) * 6 + 2) * D;
        const int row0 = r0 + wr * 64 + fr, col0 = u.pn * 256 + wc * 32 + 4 * fq;
        f32x4 gv[2][2];
#pragma unroll
        for (int bj = 0; bj < 2; ++bj)
#pragma unroll
            for (int n = 0; n < 2; ++n) gv[bj][n] = *(const f32x4*)(g + col0 + bj * 128 + n * 16);
#pragma unroll
        for (int ai = 0; ai < 2; ++ai)
#pragma unroll
            for (int m = 0; m < 4; ++m) { float* rowp = X + (size_t)(row0 + ai * 128 + m * 16) * D + col0;
#pragma unroll
                for (int bj = 0; bj < 2; ++bj)
#pragma unroll
                    for (int n = 0; n < 2; ++n) { f32x4* p = (f32x4*)(rowp + bj * 128 + n * 16); *p = *p + gv[bj][n] * acc[ai][bj][m][n]; } }
    }
};
struct EpiMoe1 {
    static constexpr bool PERM = true;
    h16* H1;
    __device__ __forceinline__ void operator()(const f32x4 (&acc)[2][2][4][2], const Unit& u, int wr, int wc, int fr, int fq) const {
        const int row0 = u.pm * 256 + wr * 64 + fr, col0 = u.pn * 128 + wc * 16 + 4 * fq;
#pragma unroll
        for (int ai = 0; ai < 2; ++ai)
#pragma unroll
            for (int m = 0; m < 4; ++m) { h16* rowp = H1 + (size_t)(row0 + ai * 128 + m * 16) * DE + col0;
#pragma unroll
                for (int bj = 0; bj < 2; ++bj) { const f32x4 a = acc[ai][bj][m][0], b = acc[ai][bj][m][1]; f16x4 w;
#pragma unroll
                    for (int i = 0; i < 4; ++i) { const float s = a[i] / (1.0f + __expf(-a[i])); w[i] = (h16)(s * b[i]); }
                    *(f16x4*)(rowp + bj * 64) = w; } }
    }
};
struct EpiMoe2 {
    static constexpr bool PERM = true;
    h16* YC; const float* gate;
    __device__ __forceinline__ void operator()(const f32x4 (&acc)[2][2][4][2], const Unit& u, int wr, int wc, int fr, int fq) const {
        const int col0 = u.pn * 256 + wc * 32 + 8 * fq;
#pragma unroll
        for (int ai = 0; ai < 2; ++ai)
#pragma unroll
            for (int m = 0; m < 4; ++m) { const int r = ai * 128 + wr * 64 + m * 16 + fr;
                if (u.pos0 + r < u.cnt) { const int a = u.rows[r]; const float g = gate[a]; h16* rowp = YC + (size_t)a * D + col0;
#pragma unroll
                    for (int bj = 0; bj < 2; ++bj) *(f16x8*)(rowp + bj * 128) = pack8(acc[ai][bj][m][0] * g, acc[ai][bj][m][1] * g); }
                asm volatile("" ::: "memory"); }
    }
};

__device__ __forceinline__ void order_tile(int wgid, int nM, int nN, int& pm, int& pn) {
    const int nwg = nM * nN; { const int q = nwg / 8, r = nwg % 8, xcd = wgid % 8, off = wgid / 8; wgid = (xcd < r ? xcd * (q + 1) : r * (q + 1) + (xcd - r) * q) + off; }
    const int nig = 8 * nN, gid = wgid / nig, fm = gid * 8, gsz = (nM - fm) < 8 ? (nM - fm) : 8;
    pm = fm + ((wgid % nig) % gsz); pn = (wgid % nig) / gsz;
}
struct SchedPlain {
    int nM, nN, K; const char* A; const char* B;
    __device__ __forceinline__ bool next(int i, Unit& u) const {
        const long L = (long)i * gridDim.x + blockIdx.x; if (L >= (long)nM * nN) return false;
        order_tile((int)L, nM, nN, u.pm, u.pn); u.kind = 0; u.e = 0; u.pos0 = 0; u.cnt = 0; u.rows = nullptr;
        u.A = A + (size_t)u.pm * 256 * K * 2; u.B = B + (size_t)u.pn * 256 * K * 2; return true;
    }
};
struct SchedQkv {
    const char* H; const char* W;
    __device__ __forceinline__ bool next(int i, Unit& u) const {
        const long L = (long)i * gridDim.x + blockIdx.x; const int nA = 136 * 9; if (L >= nA + 136) return false;
        u.e = 0; u.pos0 = 0; u.cnt = 0; u.rows = nullptr;
        if (L < nA) { order_tile((int)L, 136, 9, u.pm, u.pn); u.kind = 0; u.A = H + (size_t)u.pm * 256 * D * 2; u.B = W + (size_t)u.pn * 256 * D * 2; }
        else { u.pm = 0; u.pn = (int)L - nA; u.kind = 1; u.A = W + (size_t)DQK * D * 2; u.B = H + (size_t)u.pn * 256 * D * 2; }
        return true;
    }
};
struct SchedFilt {
    const char* W3P; const char* H2P;
    __device__ __forceinline__ bool next(int i, Unit& u) const {
        const long L = (long)i * gridDim.x + blockIdx.x; if (L >= 2 * 544) return false;
        const int j = (int)L / 544, r = (int)L % 544; u.e = 0; u.pos0 = 0; u.cnt = 0; u.rows = nullptr;
        int v; if (r < 512) { v = 0; u.pm = r >> 4; u.pn = r & 15; } else { v = 1; u.pm = r - 512; u.pn = 0; }
        u.kind = 2 * j + v;
        u.A = W3P + ((size_t)j * 8192 + (size_t)u.pm * 256) * 256 * 2;
        u.B = H2P + ((size_t)j * 4352 + (v ? 4096 : 0) + (size_t)u.pn * 256) * 256 * 2;
        return true;
    }
};
struct MoeTab { const LAS int* tstart; const LAS int* texp; const LAS int* cnt; };
struct SchedMoe1 {
    MoeTab tb; const char* H; const char* W13; const int* list;
    __device__ __forceinline__ bool next(int i, Unit& u) const {
        const long L = (long)i * gridDim.x + blockIdx.x; const int ntile = __builtin_amdgcn_readfirstlane(tb.tstart[NE]); if (L >= (long)ntile * 3) return false;
        const int rt = (int)L / 3; u.pn = (int)L % 3; u.pm = rt; u.kind = 0;
        const int e = __builtin_amdgcn_readfirstlane(tb.texp[rt]); u.e = e; u.pos0 = (rt - __builtin_amdgcn_readfirstlane(tb.tstart[e])) * 256; u.cnt = __builtin_amdgcn_readfirstlane(tb.cnt[e]);
        u.rows = list + (size_t)e * LCAP + u.pos0; u.A = H; u.B = W13 + ((size_t)e * DE2 + (size_t)u.pn * 256) * D * 2; return true;
    }
};
struct SchedMoe2 {
    MoeTab tb; const char* H1; const char* W2; const int* list;
    __device__ __forceinline__ bool next(int i, Unit& u) const {
        const long L = (long)i * gridDim.x + blockIdx.x; const int ntile = __builtin_amdgcn_readfirstlane(tb.tstart[NE]); if (L >= (long)ntile * 8) return false;
        const int rt = (int)L >> 3; u.pn = (int)L & 7; u.pm = rt; u.kind = 0;
        const int e = __builtin_amdgcn_readfirstlane(tb.texp[rt]); u.e = e; u.pos0 = (rt - __builtin_amdgcn_readfirstlane(tb.tstart[e])) * 256; u.cnt = __builtin_amdgcn_readfirstlane(tb.cnt[e]);
        u.rows = list + (size_t)e * LCAP + u.pos0; u.A = H1 + (size_t)rt * 256 * DE * 2; u.B = W2 + ((size_t)e * D + (size_t)u.pn * 256) * DE * 2; return true;
    }
};
__device__ __forceinline__ void moe_table(LAS int* tstart, LAS int* texp, LAS int* cnt, const int* counters) {
    const int t = threadIdx.x;
    if (t < NE) cnt[t] = counters[t];
    __syncthreads();
    if (t <= NE) { int s = 0; for (int e = 0; e < t; ++e) s += (cnt[e] + 255) >> 8; tstart[t] = s; }
    __syncthreads();
    if (t < NE) { const int s0 = tstart[t], s1 = tstart[t + 1]; for (int q = s0; q < s1; ++q) texp[q] = t; }
    __syncthreads();
}

__device__ __forceinline__ float wave_sum(float v) {
#pragma unroll
    for (int o = 32; o >= 1; o >>= 1) v += __shfl_xor(v, o);
    return v;
}
__device__ __forceinline__ float silu_f(float x) { return x / (1.0f + expf(-x)); }
__device__ __forceinline__ int batch_of_row(int r) { return r < TL ? (r >> 12) : 8; }

__device__ __forceinline__ void modp_unit(const Params& p, int unit, LAS float* sl) {
    const int layer = unit / 96, rem = unit % 96, ks = rem / 6, cc = rem % 6, tid = threadIdx.x;
    for (int i = tid; i < 9 * 128; i += 512) { const int cnd = i >> 7, k = ks * 128 + (i & 127); const float v = cnd < 8 ? p.c[cnd * D + k] : p.c_ctx[k]; sl[i] = silu_f(v); }
    __syncthreads();
    f32x4 acc[9];
#pragma unroll
    for (int q = 0; q < 9; ++q) acc[q] = (f32x4){0.f, 0.f, 0.f, 0.f};
    const float* w = p.mod_w + ((size_t)layer * D + (size_t)ks * 128) * D6 + cc * 2048 + tid * 4;
#pragma unroll 4
    for (int k = 0; k < 128; ++k) { const f32x4 wv = *(const f32x4*)(w + (size_t)k * D6);
#pragma unroll
        for (int q = 0; q < 9; ++q) acc[q] += wv * sl[q * 128 + k]; }
    float* outp = (float*)(p.ws + WS_MODP) + ((size_t)(ks * 4 + layer) * 9) * D6 + cc * 2048 + tid * 4;
#pragma unroll
    for (int q = 0; q < 9; ++q) *(f32x4*)(outp + (size_t)q * D6) = acc[q];
    __syncthreads();
}
__device__ __forceinline__ void modr_unit(const Params& p, int unit) {
    const size_t idx = (size_t)unit * 2048 + threadIdx.x * 4; const int layer = (int)(idx / (9 * D6)), col = (int)(idx % D6);
    f32x4 s = *(const f32x4*)(p.mod_b + (size_t)layer * D6 + col);
    const float* pp = (const float*)(p.ws + WS_MODP) + idx;
#pragma unroll
    for (int ks = 0; ks < 16; ++ks) s += *(const f32x4*)(pp + (size_t)ks * 4 * 9 * D6);
    *(f32x4*)((float*)(p.ws + WS_MODS) + idx) = s;
}
__device__ __forceinline__ void tables_unit(const Params& p) {
    f32x2* tw = (f32x2*)(p.ws + WS_TW);
    for (int m = threadIdx.x; m < 8192; m += 512) { double s, c; sincospi(-(double)m / 4096.0, &s, &c); tw[m] = (f32x2){(float)c, (float)s}; }
    float* rc = (float*)(p.ws + WS_ROPE);
    for (int i = threadIdx.x; i < 1024; i += 512) { const int pos = i >> 4, q = i & 15; const float inv = powf(10000.0f, -(float)q / 16.0f); const float ang = (float)pos * inv;
        rc[i] = cosf(ang); rc[1024 + i] = sinf(ang); }
}
__device__ __forceinline__ void h2_task(const Params& p, int task) {
    const int lane = threadIdx.x & 63; const int j = task / 4352, r = task % 4352; const int v = r >= 4096, t = v ? r - 4096 : r; const int Lv = v ? 256 : 4096;
    const float tl = (float)t / (float)(Lv - 1);
    const float omega = (float)(2.0 * 3.14159265358979323846 / (double)Lv) * (float)t;
    float feat = 0.f;
    if (lane == 0) feat = tl;
    else if (lane <= 32) { const int bi = (lane - 1) & 15; const float band = 1e-4f + (float)bi * ((15.0f - 1e-4f) / 15.0f); const float a = band * omega; feat = lane <= 16 ? cosf(a) : -sinf(a); }
    const float* w1 = p.hy_f_w1 + (size_t)j * 33 * 64; const float* w2 = p.hy_f_w2 + (size_t)j * 64 * 64;
    float s = p.hy_f_b1[j * 64 + lane];
    for (int f = 0; f < 33; ++f) s += __shfl(feat, f) * w1[f * 64 + lane];
    const float h1 = sinf(p.hy_f_freq1[j * 64 + lane] * s);
    float s2 = p.hy_f_b2[j * 64 + lane];
    for (int m = 0; m < 64; ++m) s2 += __shfl(h1, m) * w2[m * 64 + lane];
    const float h2 = sinf(p.hy_f_freq2[j * 64 + lane] * s2);
    const h16 hi = (h16)h2; const h16 lo = (h16)(h2 - (float)hi);
    h16* row = (h16*)(p.ws + WS_H2P) + ((size_t)j * 4352 + r) * 256;
    row[lane] = hi; row[64 + lane] = hi; row[128 + lane] = lo; row[192 + lane] = lo;
}
__device__ __forceinline__ void w3p_unit(const Params& p, int unit) {
    const int j = unit >> 5, c0 = (unit & 31) * 256; const float* w3 = p.hy_f_w3 + (size_t)j * 64 * 8192; h16* dst = (h16*)(p.ws + WS_W3P) + (size_t)j * 8192 * 256;
    for (int i = threadIdx.x; i < 64 * 256; i += 512) { const int m = i >> 8, col = c0 + (i & 255); const float w = w3[(size_t)m * 8192 + col];
        const h16 hi = (h16)w; const h16 lo = (h16)(w - (float)hi); h16* row = dst + (size_t)col * 256; row[m] = hi; row[64 + m] = lo; row[128 + m] = hi; row[192 + m] = lo; }
}
__device__ __forceinline__ void rtab_unit(const Params& p, int unit) {
    const int layer = unit >> 6, c = unit & 63; h16* dst = (h16*)(p.ws + WS_RTAB + (size_t)layer * RTAB_L) + (size_t)c * 5 * 2 * 64 * 8;
    for (int i = threadIdx.x; i < 5 * 2 * 64 * 8; i += 512) { const int jj = i & 7, lane = (i >> 3) & 63, hl = (i >> 9) & 1, ct = i >> 10;
        const int k = 32 * c + 8 * (lane >> 4) + jj, col = 16 * ct + (lane & 15);
        float w = 0.f; if (col < 8) w = p.moe_wg[((size_t)layer * D + k) * 8 + col]; else if (col < 72) w = p.moe_we[((size_t)layer * D + k) * 64 + (col - 8)];
        w *= 256.0f; const h16 hi = (h16)w; const h16 lo = (h16)(w - (float)hi); dst[i] = hl ? lo : hi; }
}
template <int NW>
__device__ __forceinline__ void cvt_tile(const float* src, int ldn, int k0, int n0, h16* dst, int ldk, int mode, LAS float* T) {
    constexpr int P = NW + 1; const int tid = threadIdx.x;
#pragma unroll
    for (int ps = 0; ps < 64 * NW / 4 / 512; ++ps) { const int idx = ps * 512 + tid, k = idx / (NW / 4), n4 = idx % (NW / 4);
        const f32x4 v = *(const f32x4*)(src + (size_t)(k0 + k) * ldn + n0 + 4 * n4); LAS float* q = T + k * P + 4 * n4; q[0] = v[0]; q[1] = v[1]; q[2] = v[2]; q[3] = v[3]; }
    __syncthreads();
#pragma unroll
    for (int ps = 0; ps < NW * 8 / 512; ++ps) { const int item = ps * 512 + tid, kc = item & 7, n = item >> 3; f16x8 w;
#pragma unroll
        for (int i = 0; i < 8; ++i) w[i] = (h16)T[(8 * kc + i) * P + n];
        const int ng = n0 + n; const int row = mode == 0 ? ng : (8 * (ng >> 2) + (ng & 3) + (mode == 2 ? 4 : 0));
        *(f16x8*)(dst + (size_t)row * ldk + k0 + 8 * kc) = w; }
    __syncthreads();
}
__device__ __forceinline__ void cvt_dense_unit(const Params& p, int unit, LAS float* T) {
    const float* src; h16* dst; int nt, N;
    if (unit < 1536) { src = p.hy_w_in; dst = (h16*)(p.ws + WS_WIN); nt = 24; N = D3; }
    else if (unit < 2048) { unit -= 1536; src = p.hy_w_out; dst = (h16*)(p.ws + WS_WOUT); nt = 8; N = D; }
    else if (unit < 2688) { unit -= 2048; src = p.at_w_qkv; dst = (h16*)(p.ws + WS_WQKV); nt = 10; N = DQKV; }
    else { unit -= 2688; src = p.at_w_o; dst = (h16*)(p.ws + WS_WO); nt = 8; N = D; }
    const int j = unit / (32 * nt), r = unit % (32 * nt), kt = r / nt, ntile = r % nt;
    cvt_tile<256>(src + (size_t)j * D * N, N, kt * 64, ntile * 256, dst + (size_t)j * N * D, D, 0, T);
}
constexpr int CVT_DENSE_UNITS = 3200;
__device__ __forceinline__ void cvt_moe_unit(const Params& p, int layer, int unit, LAS float* T) {
    if (unit < 12288) { const int which = unit >= 6144; if (which) unit -= 6144; const int e = unit / 96, r = unit % 96, kt = r / 3, ntile = r % 3;
        const float* src = (which ? p.moe_w3 : p.moe_w1) + ((size_t)layer * NE + e) * D * DE;
        cvt_tile<128>(src, DE, kt * 64, ntile * 128, (h16*)(p.ws + WS_W13) + (size_t)e * DE2 * D, D, which ? 2 : 1, T); }
    else { unit -= 12288; const int e = unit / 48, r = unit % 48, kt = r / 8, ntile = r % 8;
        const float* src = p.moe_w2 + ((size_t)layer * NE + e) * DE * D;
        cvt_tile<256>(src, D, kt * 64, ntile * 256, (h16*)(p.ws + WS_W2) + (size_t)e * D * DE, DE, 0, T); }
}
constexpr int CVT_MOE_UNITS = 15360;

__device__ __forceinline__ void n1_phase(const Params& p, int layer) {
    const int lane = threadIdx.x & 63, gw = blockIdx.x * 8 + (threadIdx.x >> 6), nw = gridDim.x * 8;
    float* xres = (float*)(p.ws + WS_XRES); h16* hb = (h16*)(p.ws + WS_HBUF); const h16* yc = (const h16*)(p.ws + WS_YC); const float* mods = (const float*)(p.ws + WS_MODS);
    for (int r = gw; r < TT; r += nw) {
        const int b = batch_of_row(r);
        const float* src = layer == 0 ? (r < TL ? p.x + (size_t)r * D : p.ctx + (size_t)(r - TL) * D) : xres + (size_t)r * D;
        f32x4 v[8];
#pragma unroll
        for (int c = 0; c < 8; ++c) v[c] = *(const f32x4*)(src + c * 256 + lane * 4);
        if (layer > 0) { const float* g2 = mods + ((size_t)((layer - 1) * 9 + b) * 6 + 5) * D; const h16* y0 = yc + (size_t)(2 * r) * D; const h16* y1 = y0 + D;
#pragma unroll
            for (int c = 0; c < 8; ++c) { const int col = c * 256 + lane * 4; const f16x4 a = *(const f16x4*)(y0 + col), bb = *(const f16x4*)(y1 + col); const f32x4 g = *(const f32x4*)(g2 + col);
#pragma unroll
                for (int i = 0; i < 4; ++i) v[c][i] += g[i] * ((float)a[i] + (float)bb[i]); } }
        float ss = 0.f;
#pragma unroll
        for (int c = 0; c < 8; ++c) { *(f32x4*)(xres + (size_t)r * D + c * 256 + lane * 4) = v[c]; ss += v[c][0] * v[c][0] + v[c][1] * v[c][1] + v[c][2] * v[c][2] + v[c][3] * v[c][3]; }
        ss = wave_sum(ss); const float rs = 1.0f / sqrtf(ss * (1.0f / D) + EPS);
        const float* sh = mods + ((size_t)(layer * 9 + b) * 6 + 0) * D; const float* sc = sh + D;
#pragma unroll
        for (int c = 0; c < 8; ++c) { const int col = c * 256 + lane * 4; const f32x4 s0 = *(const f32x4*)(sh + col), s1 = *(const f32x4*)(sc + col); f16x4 w;
#pragma unroll
            for (int i = 0; i < 4; ++i) w[i] = (h16)(v[c][i] * rs * (1.0f + s1[i]) + s0[i]);
            *(f16x4*)(hb + (size_t)r * D + col) = w; }
    }
}
__device__ __forceinline__ void final_phase(const Params& p) {
    const int lane = threadIdx.x & 63, gw = blockIdx.x * 8 + (threadIdx.x >> 6), nw = gridDim.x * 8;
    const float* xres = (const float*)(p.ws + WS_XRES); const h16* yc = (const h16*)(p.ws + WS_YC); const float* mods = (const float*)(p.ws + WS_MODS);
    for (int r = gw; r < TL; r += nw) {
        const int b = r >> 12; f32x4 v[8];
        const float* g2 = mods + ((size_t)(3 * 9 + b) * 6 + 5) * D; const h16* y0 = yc + (size_t)(2 * r) * D; const h16* y1 = y0 + D;
        float ss = 0.f;
#pragma unroll
        for (int c = 0; c < 8; ++c) { const int col = c * 256 + lane * 4; v[c] = *(const f32x4*)(xres + (size_t)r * D + col);
            const f16x4 a = *(const f16x4*)(y0 + col), bb = *(const f16x4*)(y1 + col); const f32x4 g = *(const f32x4*)(g2 + col);
#pragma unroll
            for (int i = 0; i < 4; ++i) { v[c][i] += g[i] * ((float)a[i] + (float)bb[i]); ss += v[c][i] * v[c][i]; } }
        ss = wave_sum(ss); const float rs = 1.0f / sqrtf(ss * (1.0f / D) + EPS);
#pragma unroll
        for (int c = 0; c < 8; ++c) { const int col = c * 256 + lane * 4; const f32x4 g = *(const f32x4*)(p.final_gain + col); *(f32x4*)(p.out + (size_t)r * D + col) = v[c] * rs * g; }
    }
}
__device__ __forceinline__ void n2_phase(const Params& p, int layer, LAS float* scr_all) {
    const int lane = threadIdx.x & 63, wv = threadIdx.x >> 6, gw = blockIdx.x * 8 + wv, nw = gridDim.x * 8;
    const int r16 = lane & 15, kg = lane >> 4;
    const float* xres = (const float*)(p.ws + WS_XRES); h16* hb = (h16*)(p.ws + WS_HBUF); const float* mods = (const float*)(p.ws + WS_MODS);
    const f16x8* rt = (const f16x8*)(p.ws + WS_RTAB + (size_t)layer * RTAB_L);
    int* counters = (int*)(p.ws + WS_CTL) + CTL_CNT + layer * NE; int* list = (int*)(p.ws + WS_LIST); float* gate = (float*)(p.ws + WS_GATE);
    LAS float* scr = scr_all + wv * (16 * 80);
    for (int task = gw; task < TT / 16; task += nw) {
        const int row = task * 16 + r16; const int b = batch_of_row(task * 16);
        const float* xr = xres + (size_t)row * D + 8 * kg;
        float ss = 0.f;
#pragma unroll 8
        for (int c = 0; c < 64; ++c) { const f32x4 a = *(const f32x4*)(xr + 32 * c), bq = *(const f32x4*)(xr + 32 * c + 4);
            ss += a[0] * a[0] + a[1] * a[1] + a[2] * a[2] + a[3] * a[3] + bq[0] * bq[0] + bq[1] * bq[1] + bq[2] * bq[2] + bq[3] * bq[3]; }
        ss += __shfl_xor(ss, 16); ss += __shfl_xor(ss, 32);
        const float rs = 1.0f / sqrtf(ss * (1.0f / D) + EPS);
        const float* sh = mods + ((size_t)(layer * 9 + b) * 6 + 3) * D + 8 * kg; const float* sc = sh + D;
        f32x4 acc[5];
#pragma unroll
        for (int ct = 0; ct < 5; ++ct) acc[ct] = (f32x4){0.f, 0.f, 0.f, 0.f};
#pragma unroll 2
        for (int c = 0; c < 64; ++c) {
            const f32x4 a = *(const f32x4*)(xr + 32 * c), bq = *(const f32x4*)(xr + 32 * c + 4);
            const f32x4 h0 = *(const f32x4*)(sh + 32 * c), h1 = *(const f32x4*)(sh + 32 * c + 4), c0 = *(const f32x4*)(sc + 32 * c), c1 = *(const f32x4*)(sc + 32 * c + 4);
            f16x8 hi, lo;
#pragma unroll
            for (int i = 0; i < 4; ++i) { const float u0 = a[i] * rs * (1.0f + c0[i]) + h0[i], u1 = bq[i] * rs * (1.0f + c1[i]) + h1[i];
                hi[i] = (h16)u0; lo[i] = (h16)(u0 - (float)hi[i]); hi[4 + i] = (h16)u1; lo[4 + i] = (h16)(u1 - (float)hi[4 + i]); }
            *(f16x8*)(hb + (size_t)row * D + 32 * c + 8 * kg) = hi;
            const f16x8* bt = rt + (size_t)c * (5 * 2 * 64) + lane;
#pragma unroll
            for (int ct = 0; ct < 5; ++ct) { const f16x8 whi = bt[(ct * 2 + 0) * 64], wlo = bt[(ct * 2 + 1) * 64];
                acc[ct] = __builtin_amdgcn_mfma_f32_16x16x32_f16(hi, whi, acc[ct], 0, 0, 0);
                acc[ct] = __builtin_amdgcn_mfma_f32_16x16x32_f16(hi, wlo, acc[ct], 0, 0, 0);
                acc[ct] = __builtin_amdgcn_mfma_f32_16x16x32_f16(lo, whi, acc[ct], 0, 0, 0); }
        }
#pragma unroll
        for (int ct = 0; ct < 5; ++ct)
#pragma unroll
            for (int i = 0; i < 4; ++i) scr[(4 * kg + i) * 80 + 16 * ct + r16] = acc[ct][i] * (1.0f / 256.0f);
        __builtin_amdgcn_wave_barrier(); asm volatile("s_waitcnt lgkmcnt(0)" ::: "memory");
        if (lane < 16) {
            const LAS float* lg = scr + lane * 80; const int tok = task * 16 + lane;
            float gmax = -3.0e38f; int gsel = 0; float gl[8];
#pragma unroll
            for (int g = 0; g < 8; ++g) { gl[g] = lg[g] + p.moe_bg[layer * 8 + g]; if (gl[g] > gmax) { gmax = gl[g]; gsel = g; } }
            float gz = 0.f;
#pragma unroll
            for (int g = 0; g < 8; ++g) gz += expf(gl[g] - gmax);
            const float pg = 1.0f / gz;
            float f1 = -3.0e38f, f2 = -3.0e38f; int i1 = 0, i2 = 0;
            for (int q = 0; q < 8; ++q) { const float f = lg[8 + gsel * 8 + q] + p.moe_be[layer * 64 + gsel * 8 + q];
                if (f > f1) { f2 = f1; i2 = i1; f1 = f; i1 = q; } else if (f > f2) { f2 = f; i2 = q; } }
            const float e2 = expf(f2 - f1); const float g1v = pg / (1.0f + e2), g2v = pg * e2 / (1.0f + e2);
            const int ea = gsel * 8 + i1, eb = gsel * 8 + i2;
            const int pa = atomicAdd(&counters[ea], 1); list[(size_t)ea * LCAP + pa] = 2 * tok; gate[2 * tok] = g1v;
            const int pb = atomicAdd(&counters[eb], 1); list[(size_t)eb * LCAP + pb] = 2 * tok + 1; gate[2 * tok + 1] = g2v;
        }
        __builtin_amdgcn_wave_barrier(); asm volatile("s_waitcnt lgkmcnt(0)" ::: "memory");
    }
}
__device__ __forceinline__ void transpose_phase(const Params& p, LAS h16* T) {
    const h16* zt = (const h16*)(p.ws + WS_ZT); h16* z = (h16*)(p.ws + WS_HBUF); const int tid = threadIdx.x;
    const int ntile = (D / 64) * (TT / 64);
    for (int tile = blockIdx.x; tile < ntile; tile += gridDim.x) {
        const int td = tile % (D / 64), tt = tile / (D / 64); const int d0 = td * 64, t0 = tt * 64;
        { const int dr = tid >> 3, tc = (tid & 7) * 8; const f16x8 v = *(const f16x8*)(zt + (size_t)(d0 + dr) * TT + t0 + tc);
#pragma unroll
            for (int i = 0; i < 8; ++i) T[(tc + i) * 66 + dr] = v[i]; }
        __syncthreads();
        { const int tr = tid >> 3, dc = (tid & 7) * 8; f16x8 v;
#pragma unroll
            for (int i = 0; i < 8; ++i) v[i] = T[tr * 66 + dc + i];
            *(f16x8*)(z + (size_t)(t0 + tr) * D + d0 + dc) = v; }
        __syncthreads();
    }
}

__device__ __forceinline__ f32x2 cmul(const f32x2 a, const f32x2 b) { return (f32x2){a.x * b.x - a.y * b.y, a.x * b.y + a.y * b.x}; }
__device__ __forceinline__ f32x2 cmulc(const f32x2 a, const f32x2 b) { return (f32x2){a.x * b.x + a.y * b.y, a.y * b.x - a.x * b.y}; }
__device__ __forceinline__ f32x2 cconj(const f32x2 a) { return (f32x2){a.x, -a.y}; }
template <bool INV> __device__ __forceinline__ f32x2 mul_mi(const f32x2 a) { return INV ? (f32x2){-a.y, a.x} : (f32x2){a.y, -a.x}; }
template <bool INV> __device__ __forceinline__ void dft4(f32x2& a, f32x2& b, f32x2& c, f32x2& d) {
    const f32x2 s0 = a + c, s1 = a - c, s2 = b + d, s3 = mul_mi<INV>(b - d);
    a = s0 + s2; b = s1 + s3; c = s0 - s2; d = s1 - s3;
}
template <bool INV, int M> __device__ __forceinline__ f32x2 w16mul(const f32x2 a) {
    constexpr float C1 = 0.92387953251128674f, S1 = 0.38268343236508977f, R = 0.70710678118654752f;
    constexpr float cr = (M == 0) ? 1.f : (M == 1) ? C1 : (M == 2) ? R : (M == 3) ? S1 : (M == 4) ? 0.f : (M == 6) ? -R :   -C1;
    constexpr float ci0 = (M == 0) ? 0.f : (M == 1) ? -S1 : (M == 2) ? -R : (M == 3) ? -C1 : (M == 4) ? -1.f : (M == 6) ? -R :   S1;
    constexpr float ci = INV ? -ci0 : ci0;
    return (f32x2){a.x * cr - a.y * ci, a.x * ci + a.y * cr};
}
template <bool INV> __device__ __forceinline__ void dft16(f32x2 (&v)[16]) {
#pragma unroll
    for (int n2 = 0; n2 < 4; ++n2) dft4<INV>(v[n2], v[4 + n2], v[8 + n2], v[12 + n2]);
    v[5] = w16mul<INV, 1>(v[5]); v[6] = w16mul<INV, 2>(v[6]); v[7] = w16mul<INV, 3>(v[7]);
    v[9] = w16mul<INV, 2>(v[9]); v[10] = w16mul<INV, 4>(v[10]); v[11] = w16mul<INV, 6>(v[11]);
    v[13] = w16mul<INV, 3>(v[13]); v[14] = w16mul<INV, 6>(v[14]); v[15] = w16mul<INV, 9>(v[15]);
#pragma unroll
    for (int k1 = 0; k1 < 4; ++k1) dft4<INV>(v[4 * k1], v[4 * k1 + 1], v[4 * k1 + 2], v[4 * k1 + 3]);
    f32x2 t;
    t = v[1]; v[1] = v[4]; v[4] = t; t = v[2]; v[2] = v[8]; v[8] = t; t = v[3]; v[3] = v[12]; v[12] = t;
    t = v[6]; v[6] = v[9]; v[9] = t; t = v[7]; v[7] = v[13]; v[13] = t; t = v[11]; v[11] = v[14]; v[14] = t;
}
__device__ __forceinline__ int fphys(int i) { return i + (i >> 4); }
__device__ __forceinline__ f32x2 w32c(int j) {
    constexpr float c[16] = {1.f, 0.98078528040323043f, 0.92387953251128674f, 0.83146961230254524f, 0.70710678118654752f, 0.55557023301960218f, 0.38268343236508977f, 0.19509032201612825f,
                             0.f, -0.19509032201612825f, -0.38268343236508977f, -0.55557023301960218f, -0.70710678118654752f, -0.83146961230254524f, -0.92387953251128674f, -0.98078528040323043f};
    constexpr float s[16] = {0.f, 0.19509032201612825f, 0.38268343236508977f, 0.55557023301960218f, 0.70710678118654752f, 0.83146961230254524f, 0.92387953251128674f, 0.98078528040323043f,
                             1.f, 0.98078528040323043f, 0.92387953251128674f, 0.83146961230254524f, 0.70710678118654752f, 0.55557023301960218f, 0.38268343236508977f, 0.19509032201612825f};
    return (f32x2){c[j], -s[j]};
}
__device__ __forceinline__ void fft_fwd0(const f32x2 (&xe)[16], const f32x2 (&xo)[16], LAS f32x2* E, LAS f32x2* O, int tau, const f32x2* tw) {
    const f32x2 u = tw[tau]; const f32x2 u2 = cmul(u, u);
    f32x2 y[16];
#pragma unroll
    for (int j = 0; j < 16; ++j) y[j] = xe[j];
    dft16<false>(y);
    f32x2 pw = u2; E[fphys(tau)] = y[0];
#pragma unroll
    for (int q = 1; q < 16; ++q) { E[fphys(tau + 256 * q)] = cmul(y[q], pw); pw = cmul(pw, u2); }
#pragma unroll
    for (int j = 0; j < 16; ++j) y[j] = cmul(xo[j], w32c(j));
    dft16<false>(y);
    pw = u;
#pragma unroll
    for (int q = 0; q < 16; ++q) { O[fphys(tau + 256 * q)] = cmul(y[q], pw); pw = cmul(pw, u2); }
}
template <bool INV> __device__ __forceinline__ void fft_pass1(LAS f32x2* A, int tau, const f32x2* tw) {
    const int i = tau & 15, base = (tau >> 4) << 8; const f32x2 u0 = tw[32 * i]; const f32x2 u = INV ? cconj(u0) : u0;
    f32x2 y[16];
#pragma unroll
    for (int j = 0; j < 16; ++j) y[j] = A[fphys(base + i + 16 * j)];
    if (INV) { f32x2 pw = u;
#pragma unroll
        for (int q = 1; q < 16; ++q) { y[q] = cmul(y[q], pw); pw = cmul(pw, u); } }
    dft16<INV>(y);
    if (!INV) { f32x2 pw = u;
#pragma unroll
        for (int q = 1; q < 16; ++q) { y[q] = cmul(y[q], pw); pw = cmul(pw, u); } }
#pragma unroll
    for (int j = 0; j < 16; ++j) A[fphys(base + i + 16 * j)] = y[j];
}
__device__ __forceinline__ void fft_fwd2(const LAS f32x2* A, int tau, f32x2 (&y)[16]) {
#pragma unroll
    for (int j = 0; j < 16; ++j) y[j] = A[17 * tau + j];
    dft16<false>(y);
}
__device__ __forceinline__ void fft_mid(LAS f32x2* A, int tau, const f32x2* kf) {
    f32x2 y[16]; f32x4 k[8];
#pragma unroll
    for (int j = 0; j < 8; ++j) k[j] = *(const f32x4*)(kf + 2 * j);
    fft_fwd2(A, tau, y);
#pragma unroll
    for (int j = 0; j < 8; ++j) { y[2 * j] = cmul(y[2 * j], (f32x2){k[j][0], k[j][1]}); y[2 * j + 1] = cmul(y[2 * j + 1], (f32x2){k[j][2], k[j][3]}); }
    dft16<true>(y);
#pragma unroll
    for (int j = 0; j < 16; ++j) A[17 * tau + j] = y[j];
}
__device__ __forceinline__ void fft_inv0(const LAS f32x2* E, const LAS f32x2* O, int tau, const f32x2* tw, f32x2 (&out)[16]) {
    const f32x2 u = tw[tau]; const f32x2 u2 = cmul(u, u);
    f32x2 y[16];
    f32x2 pw = u2; y[0] = E[fphys(tau)];
#pragma unroll
    for (int q = 1; q < 16; ++q) { y[q] = cmulc(E[fphys(tau + 256 * q)], pw); pw = cmul(pw, u2); }
    dft16<true>(y);
#pragma unroll
    for (int j = 0; j < 16; ++j) out[j] = y[j];
    pw = u;
#pragma unroll
    for (int q = 0; q < 16; ++q) { y[q] = cmulc(O[fphys(tau + 256 * q)], pw); pw = cmul(pw, u2); }
    dft16<true>(y);
#pragma unroll
    for (int j = 0; j < 16; ++j) out[j] += cmulc(y[j], w32c(j));
}

__device__ __forceinline__ void filt_fft_phase(const Params& p, LAS unsigned char* lds) {
    const int tid = threadIdx.x, grp = tid >> 8, tau = tid & 255;
    LAS f32x2* E = (LAS f32x2*)(lds + grp * 69632); LAS f32x2* O = E + 4352; LAS float* red = (LAS float*)(lds + LDS_MISC) + grp * 8;
    const f32x2* tw = (const f32x2*)(p.ws + WS_TW);
    const int nprob = 2 * 2 * 2 * 2048;
    for (int pb = blockIdx.x * 2 + grp; pb < nprob; pb += gridDim.x * 2) {
        const int d = pb & 2047, n = (pb >> 11) & 1, v = (pb >> 12) & 1, j = pb >> 13;
        const int Lv = v ? 256 : 4096;
        const float* tf = v ? (const float*)(p.ws + WS_TAPSC) + ((size_t)j * 8192 + (size_t)(n * 2 + 0) * D + d) * 256 : (const float*)(p.ws + WS_TAPS) + ((size_t)j * 8192 + (size_t)(n * 2 + 0) * D + d) * 4096;
        const float* tb = tf + (size_t)D * Lv;
        const float adel = fabsf(-3.0701134573253943f + (-15.350567286626973f + 3.0701134573253943f) * ((float)d / 2047.0f));
        const float tscale = 1.0f / (float)(Lv - 1);
        f32x2 xe[16], xo[16]; float ss = 0.f;
#pragma unroll
        for (int jj = 0; jj < 16; ++jj) { const int nn = tau + 256 * jj;
            float klo = 0.f, khi = 0.f;
            if (nn < Lv) klo = tf[nn] * expf(-(float)nn * tscale * adel);
            const int m = 4096 - nn;
            if (m >= 1 && m < Lv) khi = tb[m] * expf(-(float)m * tscale * adel);
            ss += klo * klo + khi * khi; xe[jj] = (f32x2){klo + khi, 0.f}; xo[jj] = (f32x2){klo - khi, 0.f}; }
        ss = wave_sum(ss);
        if ((tid & 63) == 0) red[(tid >> 6) & 3] = ss;
        fft_fwd0(xe, xo, E, O, tau, tw);
        __syncthreads();
        const float tot = red[0] + red[1] + red[2] + red[3];
        const float scale = (1.0f / sqrtf(tot + EPS)) * (1.0f / 8192.0f);
        const float hbs = p.hy_bias[((size_t)j * 2 + n) * D + d] * (1.0f / 8192.0f);
        fft_pass1<false>(E, tau, tw); fft_pass1<false>(O, tau, tw);
        __syncthreads();
        f32x2* kf = (f32x2*)(p.ws + WS_KF) + (size_t)pb * 8192 + (size_t)tau * 16;
        f32x2 y[16];
        fft_fwd2(E, tau, y);
#pragma unroll
        for (int q = 0; q < 8; ++q) *(f32x4*)(kf + 2 * q) = (f32x4){y[2 * q].x * scale + hbs, y[2 * q].y * scale, y[2 * q + 1].x * scale + hbs, y[2 * q + 1].y * scale};
        fft_fwd2(O, tau, y);
#pragma unroll
        for (int q = 0; q < 8; ++q) *(f32x4*)(kf + 4096 + 2 * q) = (f32x4){y[2 * q].x * scale + hbs, y[2 * q].y * scale, y[2 * q + 1].x * scale + hbs, y[2 * q + 1].y * scale};
        __syncthreads();
    }
}

__device__ __forceinline__ float conv3_ld(const h16* row, int n, int Lv, float w0, float w1, float w2, float b) {
    if (n >= Lv) return 0.f;
    const float um = n > 0 ? (float)row[n - 1] : 0.f, u0 = (float)row[n], up = n + 1 < Lv ? (float)row[n + 1] : 0.f;
    return um * w0 + u0 * w1 + up * w2 + b;
}
__device__ __forceinline__ void conv_phase(const Params& p, int jl, LAS unsigned char* lds) {
    const int tid = threadIdx.x, grp = tid >> 8, tau = tid & 255;
    LAS f32x2* E = (LAS f32x2*)(lds + grp * 69632); LAS f32x2* O = E + 4352;
    const f32x2* tw = (const f32x2*)(p.ws + WS_TW);
    const h16* ut = (const h16*)(p.ws + WS_UT); h16* zt = (h16*)(p.ws + WS_ZT);
    const float* cw = p.hy_conv_w + (size_t)jl * 3 * D3; const float* cb = p.hy_conv_b + (size_t)jl * D3;
    for (int unit = blockIdx.x; unit < 2 * 2048 * 2; unit += gridDim.x) {
        const int hq = unit & 1, d = (unit >> 1) & 2047, v = unit >> 12; const int Lv = v ? 256 : 4096;
        const int b0 = 4 * hq + 2 * grp; const size_t col0 = v ? (size_t)TL + (size_t)b0 * 256 : (size_t)b0 * 4096; const size_t col1 = col0 + Lv;
        const int jmax = v ? 1 : 16;
        const f32x2* kfb = (const f32x2*)(p.ws + WS_KF) + ((size_t)((jl * 2 + v) * 2) * 2048 + d) * 8192 + (size_t)tau * 16;
        f32x2 xin[16], y[16];
        { const h16* r0 = ut + (size_t)d * TT + col0; const h16* r1 = ut + (size_t)d * TT + col1; const float w0 = cw[d], w1 = cw[D3 + d], w2 = cw[2 * D3 + d], bb = cb[d];
#pragma unroll
            for (int jj = 0; jj < 16; ++jj) { const int nn = tau + 256 * jj; xin[jj] = (jj < jmax) ? (f32x2){conv3_ld(r0, nn, Lv, w0, w1, w2, bb), conv3_ld(r1, nn, Lv, w0, w1, w2, bb)} : (f32x2){0.f, 0.f}; } }
#pragma unroll 1
        for (int ord = 0; ord < 2; ++ord) {
            fft_fwd0(xin, xin, E, O, tau, tw);
            __syncthreads();
            fft_pass1<false>(E, tau, tw); fft_pass1<false>(O, tau, tw);
            __syncthreads();
            const f32x2* kf = kfb + (size_t)ord * 2048 * 8192;
            fft_mid(E, tau, kf); fft_mid(O, tau, kf + 4096);
            __syncthreads();
            fft_pass1<true>(E, tau, tw); fft_pass1<true>(O, tau, tw);
            __syncthreads();
            fft_inv0(E, O, tau, tw, y);
            const int cg = (ord == 0 ? D : 2 * D) + d; const h16* r0 = ut + (size_t)cg * TT + col0; const h16* r1 = ut + (size_t)cg * TT + col1;
            const float w0 = cw[cg], w1 = cw[D3 + cg], w2 = cw[2 * D3 + cg], bb = cb[cg];
#pragma unroll
            for (int jj = 0; jj < 16; ++jj) { const int nn = tau + 256 * jj;
                if (jj < jmax) { const float g0 = conv3_ld(r0, nn, Lv, w0, w1, w2, bb), g1 = conv3_ld(r1, nn, Lv, w0, w1, w2, bb);
                    xin[jj] = (f32x2){g0 * y[jj].x, g1 * y[jj].y}; } else xin[jj] = (f32x2){0.f, 0.f}; }
        }
        { h16* o0 = zt + (size_t)d * TT + col0; h16* o1 = zt + (size_t)d * TT + col1;
#pragma unroll
            for (int jj = 0; jj < 16; ++jj) { const int nn = tau + 256 * jj; if (jj < jmax && nn < Lv) { o0[nn] = (h16)xin[jj].x; o1[nn] = (h16)xin[jj].y; } } }
    }
}

constexpr int AT_KP = 72, AT_VP = 68;
__device__ __forceinline__ void attn_phase(const Params& p, int jl, bool with_ctx_out, LAS unsigned char* lds) {
    const int tid = threadIdx.x, wv = tid >> 6, lane = tid & 63, r32 = lane & 31, hh = lane >> 5;
    LAS h16* Ks = (LAS h16*)lds; LAS h16* Vs = (LAS h16*)(lds + 64 * AT_KP * 2);
    const h16* qk = (const h16*)(p.ws + WS_QK); const h16* vt = (const h16*)(p.ws + WS_VT); h16* ob = (h16*)(p.ws + WS_HBUF);
    const float* rcos = (const float*)(p.ws + WS_ROPE); const float* rsin = rcos + 1024;
    const int nunit = 2048 + (with_ctx_out ? 128 : 0);
    for (int unit = blockIdx.x; unit < nunit; unit += gridDim.x) {
        int kind, b, g, qb;
        if (unit < 2048) { kind = 0; qb = unit & 63; g = (unit >> 6) & 3; b = unit >> 8; } else { const int u2 = unit - 2048; kind = 1; qb = u2 & 3; g = (u2 >> 2) & 3; b = u2 >> 4; }
        const int head = g * 8 + wv;
        const int qrow0 = kind ? (TL + b * 256 + qb * 64) : (b * 4096 + qb * 64);
        const int ctxrow0 = TL + b * 256;
        f16x8 qf[2][4];
#pragma unroll
        for (int qt = 0; qt < 2; ++qt) {
            f32x4 qv[4][2];
            const h16* qp = qk + (size_t)(qrow0 + 32 * qt + r32) * DQK + head * 64 + 8 * hh;
#pragma unroll
            for (int ks = 0; ks < 4; ++ks) { const f16x8 t = *(const f16x8*)(qp + 16 * ks);
#pragma unroll
                for (int i = 0; i < 4; ++i) { qv[ks][0][i] = (float)t[i]; qv[ks][1][i] = (float)t[4 + i]; } }
            if (kind == 0) {
                const int colpos = 32 * qt + r32;
#pragma unroll
                for (int a = 0; a < 2; ++a) { const int pos = a ? colpos : qb; const float* cp = rcos + pos * 16 + 8 * hh; const float* sp = rsin + pos * 16 + 8 * hh;
#pragma unroll
                    for (int e = 0; e < 2; ++e) { const f32x4 c = *(const f32x4*)(cp + 4 * e), s = *(const f32x4*)(sp + 4 * e);
                        const f32x4 x1 = qv[2 * a][e], x2 = qv[2 * a + 1][e]; qv[2 * a][e] = x1 * c - x2 * s; qv[2 * a + 1][e] = x2 * c + x1 * s; } }
            }
#pragma unroll
            for (int ks = 0; ks < 4; ++ks)
#pragma unroll
                for (int i = 0; i < 4; ++i) { qf[qt][ks][i] = (h16)(qv[ks][0][i] * 0.125f); qf[qt][ks][4 + i] = (h16)(qv[ks][1][i] * 0.125f); }
        }
        const float sink = p.at_sink[jl * 32 + head] * 1.4426950408889634f;
        float mrun[2] = {sink, sink}, lrun[2] = {hh == 0 ? 1.f : 0.f, hh == 0 ? 1.f : 0.f};
        f32x16 oacc[2][2];
#pragma unroll
        for (int a = 0; a < 2; ++a)
#pragma unroll
            for (int c = 0; c < 2; ++c)
#pragma unroll
                for (int i = 0; i < 16; ++i) oacc[a][c][i] = 0.f;
        const int ntile = kind ? 4 : 9;
#pragma unroll 1
        for (int ti = 0; ti < ntile; ++ti) {
            int krow0, mask = 0; bool rope = false;
            if (kind == 0 && ti < 5) { const int k0 = qb * 64 - 128 + 64 * ti; if (k0 < 0 || k0 >= SEQ) continue; krow0 = b * 4096 + k0; rope = true; mask = (ti == 0) ? 1 : (ti == 4) ? 2 : 0; }
            else { const int c = kind ? ti : ti - 5; krow0 = ctxrow0 + 64 * c; }
            __syncthreads();
            if (tid < 256) {
                const int key = tid >> 2, cp = tid & 3, dA = (cp & 1) * 8 + (cp >> 1) * 32;
                const h16* kp = qk + (size_t)(krow0 + key) * DQK + D + g * 64 + dA;
                const f16x8 t1 = *(const f16x8*)kp, t2 = *(const f16x8*)(kp + 16);
                f16x8 o1 = t1, o2 = t2;
                if (rope) { const int kpos = (krow0 - b * 4096) + key; const int pos = (cp >> 1) ? (kpos & 63) : (kpos >> 6);
                    const float* cpp = rcos + pos * 16 + (cp & 1) * 8; const float* spp = rsin + pos * 16 + (cp & 1) * 8;
#pragma unroll
                    for (int i = 0; i < 8; ++i) { const float c = cpp[i], s = spp[i], x1 = (float)t1[i], x2 = (float)t2[i]; o1[i] = (h16)(x1 * c - x2 * s); o2[i] = (h16)(x2 * c + x1 * s); } }
                *(LAS f16x8*)(Ks + key * AT_KP + dA) = o1; *(LAS f16x8*)(Ks + key * AT_KP + dA + 16) = o2;
            } else {
                const int t = tid - 256, dim = t >> 2, kc = t & 3;
                const h16* vp = vt + (size_t)(g * 64 + dim) * TT + krow0 + 16 * kc;
                const f16x8 a = *(const f16x8*)vp, c = *(const f16x8*)(vp + 8);
                LAS h16* dst = Vs + dim * AT_VP + 16 * kc;
                *(LAS f16x4*)(dst) = (f16x4){a[0], a[1], a[2], a[3]}; *(LAS f16x4*)(dst + 4) = (f16x4){a[4], a[5], a[6], a[7]};
                *(LAS f16x4*)(dst + 8) = (f16x4){c[0], c[1], c[2], c[3]}; *(LAS f16x4*)(dst + 12) = (f16x4){c[4], c[5], c[6], c[7]};
            }
            __syncthreads();
            f32x16 sacc[2][2];
#pragma unroll
            for (int kt = 0; kt < 2; ++kt)
#pragma unroll
                for (int qt = 0; qt < 2; ++qt)
#pragma unroll
                    for (int i = 0; i < 16; ++i) sacc[kt][qt][i] = 0.f;
#pragma unroll
            for (int ks = 0; ks < 4; ++ks)
#pragma unroll
                for (int kt = 0; kt < 2; ++kt) { const f16x8 kf = *(const LAS f16x8*)(Ks + (32 * kt + r32) * AT_KP + 16 * ks + 8 * hh);
#pragma unroll
                    for (int qt = 0; qt < 2; ++qt) sacc[kt][qt] = __builtin_amdgcn_mfma_f32_32x32x16_f16(kf, qf[qt][ks], sacc[kt][qt], 0, 0, 0); }
            f16x8 pf[2][2][2];
#pragma unroll
            for (int qt = 0; qt < 2; ++qt) {
                const int qq = 32 * qt + r32; float tmax = -3.0e38f;
#pragma unroll
                for (int kt = 0; kt < 2; ++kt)
#pragma unroll
                    for (int i = 0; i < 16; ++i) { float s = sacc[kt][qt][i] * 1.4426950408889634f; const int kk = 32 * kt + (i & 3) + 8 * (i >> 2) + 4 * hh;
                        if (mask == 1 && kk < qq) s = -1.0e30f; if (mask == 2 && kk > qq) s = -1.0e30f;
                        sacc[kt][qt][i] = s; tmax = fmaxf(tmax, s); }
                tmax = fmaxf(tmax, __shfl_xor(tmax, 32));
                const float mnew = fmaxf(mrun[qt], tmax); const float alpha = exp2f(mrun[qt] - mnew); mrun[qt] = mnew;
                float psum = 0.f;
#pragma unroll
                for (int kt = 0; kt < 2; ++kt)
#pragma unroll
                    for (int s2 = 0; s2 < 2; ++s2)
#pragma unroll
                        for (int jj = 0; jj < 8; ++jj) { const float pv = exp2f(sacc[kt][qt][8 * s2 + jj] - mnew); psum += pv; pf[kt][qt][s2][jj] = (h16)pv; }
                lrun[qt] = lrun[qt] * alpha + psum;
#pragma unroll
                for (int dt = 0; dt < 2; ++dt)
#pragma unroll
                    for (int i = 0; i < 16; ++i) oacc[dt][qt][i] *= alpha;
            }
#pragma unroll
            for (int kt = 0; kt < 2; ++kt)
#pragma unroll
                for (int s2 = 0; s2 < 2; ++s2)
#pragma unroll
                    for (int dt = 0; dt < 2; ++dt) { const LAS h16* vr = Vs + (32 * dt + r32) * AT_VP + 32 * kt + 16 * s2 + 4 * hh;
                        const f16x4 v0 = *(const LAS f16x4*)vr, v1 = *(const LAS f16x4*)(vr + 8);
                        const f16x8 vf = (f16x8){v0[0], v0[1], v0[2], v0[3], v1[0], v1[1], v1[2], v1[3]};
#pragma unroll
                        for (int qt = 0; qt < 2; ++qt) oacc[dt][qt] = __builtin_amdgcn_mfma_f32_32x32x16_f16(vf, pf[kt][qt][s2], oacc[dt][qt], 0, 0, 0); }
        }
#pragma unroll
        for (int qt = 0; qt < 2; ++qt) {
            const float ltot = lrun[qt] + __shfl_xor(lrun[qt], 32); const float inv = 1.0f / ltot;
            h16* op = ob + (size_t)(qrow0 + 32 * qt + r32) * D + head * 64 + 4 * hh;
#pragma unroll
            for (int dt = 0; dt < 2; ++dt)
#pragma unroll
                for (int q4 = 0; q4 < 4; ++q4) { f16x4 w;
#pragma unroll
                    for (int i = 0; i < 4; ++i) w[i] = (h16)(oacc[dt][qt][4 * q4 + i] * inv);
                    *(f16x4*)(op + 32 * dt + 8 * q4) = w; }
        }
    }
}

constexpr int NPHASE = 35;
#ifndef MK_MULTI
#define MK_MULTI 1
#endif

template <int KIND>
__global__ void __launch_bounds__(512, 2) hy_fwd(Params p) {
    extern __shared__ __attribute__((aligned(16))) unsigned char shm[];
    LAS unsigned char* lds = (LAS unsigned char*)shm;
    constexpr bool ALL = KIND < 0;
    if (threadIdx.x == 0) { *(LAS u32x4*)(lds + LDS_XB) = (u32x4){0u, 0u, 0u, 0u}; }
    __syncthreads();
    XcdBarrier bar;
    if constexpr (ALL) bar = xcd_barrier_post((unsigned*)(p.ws + WS_CTL), (volatile LAS unsigned*)(lds + LDS_XB));
#define SITE(k) if constexpr (ALL || KIND == (k))
#define SEAM() do { if constexpr (ALL) xcd_barrier(bar); } while (0)
    const int G = gridDim.x, bid = blockIdx.x;
    SITE(0) {
        for (int u = bid; u < 20353; u += G) {
            if (u < 384) modp_unit(p, u, (LAS float*)lds);
            else if (u == 384) tables_unit(p);
            else if (u < 1473) h2_task(p, (u - 385) * 8 + (threadIdx.x >> 6));
            else if (u < 1537) w3p_unit(p, u - 1473);
            else if (u < 1793) rtab_unit(p, u - 1537);
            else if (u < 4993) cvt_dense_unit(p, u - 1793, (LAS float*)lds);
            else cvt_moe_unit(p, 0, u - 4993, (LAS float*)lds);
        }
        SEAM();
    }
    SITE(1) {
        for (int u = bid; u < 216; u += G) modr_unit(p, u);
        SchedFilt S{p.ws + WS_W3P, p.ws + WS_H2P}; EpiTaps E{(float*)(p.ws + WS_TAPS), (float*)(p.ws + WS_TAPSC)};
        pg8::gemm_phase<EpiTaps, SchedFilt, false>(lds, 256, S, E);
        SEAM();
    }
#pragma unroll 1
    for (int layer = ALL ? 0 : p.ph0; layer < (ALL ? NLAYER : p.ph0 + 1); ++layer) {
        const bool hyena = (layer & 1) == 0; const int jl = layer >> 1;
        SITE(2) {
            n1_phase(p, layer);
            if (layer == 0) filt_fft_phase(p, lds);
            else { for (int u = bid; u < CVT_MOE_UNITS; u += G) cvt_moe_unit(p, layer, u, (LAS float*)lds); }
            SEAM();
        }
        SITE(3) {
            if (hyena) { SchedPlain S{24, 136, D, p.ws + WS_WIN + (size_t)jl * D3 * D * 2, p.ws + WS_HBUF}; EpiH16 E{(h16*)(p.ws + WS_UT), TT, nullptr, 0};
                pg8::gemm_phase<EpiH16, SchedPlain, false>(lds, D, S, E); }
            else { SchedQkv S{p.ws + WS_HBUF, p.ws + WS_WQKV + (size_t)jl * DQKV * D * 2}; EpiH16 E{(h16*)(p.ws + WS_QK), DQK, (h16*)(p.ws + WS_VT), TT};
                pg8::gemm_phase<EpiH16, SchedQkv, false>(lds, D, S, E); }
            SEAM();
        }
        SITE(4) {
            if (hyena) conv_phase(p, jl, lds);
            else attn_phase(p, jl, layer != NLAYER - 1, lds);
            SEAM();
        }
        SITE(5) {
            if (hyena) { transpose_phase(p, (LAS h16*)lds); SEAM(); }
        }
        SITE(6) {
            SchedPlain S{136, 8, D, p.ws + WS_HBUF, hyena ? p.ws + WS_WOUT + (size_t)jl * D * D * 2 : p.ws + WS_WO + (size_t)jl * D * D * 2};
            EpiResid E{(float*)(p.ws + WS_XRES), (const float*)(p.ws + WS_MODS), layer};
            pg8::gemm_phase<EpiResid, SchedPlain, false>(lds, D, S, E);
            SEAM();
        }
        SITE(7) { n2_phase(p, layer, (LAS float*)lds); SEAM(); }
        LAS int* tstart = (LAS int*)(lds + LDS_MISC); LAS int* texp = tstart + 80; LAS int* tcnt = texp + 352;
        const int* counters = (const int*)(p.ws + WS_CTL) + CTL_CNT + layer * NE;
        SITE(8) {
            moe_table(tstart, texp, tcnt, counters);
            SchedMoe1 S{{tstart, texp, tcnt}, p.ws + WS_HBUF, p.ws + WS_W13, (const int*)(p.ws + WS_LIST)}; EpiMoe1 E{(h16*)(p.ws + WS_H1)};
            pg8::gemm_phase<EpiMoe1, SchedMoe1, true>(lds, D, S, E);
            SEAM();
        }
        SITE(9) {
            moe_table(tstart, texp, tcnt, counters);
            SchedMoe2 S{{tstart, texp, tcnt}, p.ws + WS_H1, p.ws + WS_W2, (const int*)(p.ws + WS_LIST)}; EpiMoe2 E{(h16*)(p.ws + WS_YC), (const float*)(p.ws + WS_GATE)};
            pg8::gemm_phase<EpiMoe2, SchedMoe2, false>(lds, DE, S, E);
            SEAM();
        }
    }
    SITE(10) final_phase(p);
#undef SITE
#undef SEAM
}

template <int KIND> static void launch_kind(const Params& p, int grid, hipStream_t stream) {
    static bool attr = false;
    if (!attr) { attr = true; if (hipFuncSetAttribute((const void*)hy_fwd<KIND>, hipFuncAttributeMaxDynamicSharedMemorySize, LDS_BYTES) != hipSuccess) fprintf(stderr, "kernel_launch: hipFuncSetAttribute failed (kind %d)\n", KIND); }
    hipLaunchKernelGGL(hy_fwd<KIND>, dim3(grid), dim3(512), LDS_BYTES, stream, p);
}

extern "C" void kernel_launch(void* const* d_in, const int* in_sizes, int n_in, void* d_out, int out_size, void* d_ws, size_t ws_size, hipStream_t stream) {
    static int grid = 0;
    if (!grid) {
        if (n_in != 29 || out_size != TL * D || ws_size < WS_END) { fprintf(stderr, "kernel_launch: unexpected problem (n_in %d, out %d, ws %zu < %zu)\n", n_in, out_size, ws_size, (size_t)WS_END); grid = -1; return; }
        int dev = 0, cus = 0;
        if (hipGetDevice(&dev) != hipSuccess || hipDeviceGetAttribute(&cus, hipDeviceAttributeMultiprocessorCount, dev) != hipSuccess) { grid = -1; return; }
        grid = cus;
    }
    if (grid <= 0) return;
    (void)hipMemsetAsync((char*)d_ws + WS_CTL, 0, CTL_BYTES, stream);
    Params p{};
    const float** pp = (const float**)&p;
    for (int i = 0; i < 29; ++i) pp[i] = (const float*)d_in[i];
    p.out = (float*)d_out; p.ws = (char*)d_ws;
#if MK_MULTI
    p.ph0 = 0; p.ph1 = 0;
    launch_kind<0>(p, grid, stream); launch_kind<1>(p, grid, stream);
    for (int layer = 0; layer < NLAYER; ++layer) { p.ph0 = layer;
        launch_kind<2>(p, grid, stream); launch_kind<3>(p, grid, stream); launch_kind<4>(p, grid, stream);
        if ((layer & 1) == 0) launch_kind<5>(p, grid, stream);
        launch_kind<6>(p, grid, stream); launch_kind<7>(p, grid, stream); launch_kind<8>(p, grid, stream); launch_kind<9>(p, grid, stream); }
    p.ph0 = 0; launch_kind<10>(p, grid, stream);
#else
    p.ph0 = 0; p.ph1 = NPHASE;
    launch_kind<-1>(p, grid, stream);
#endif
}
```

```cpp
#include <hip/hip_runtime.h>
#include <cstdio>
#include <cstdint>

#define LAS __attribute__((address_space(3)))
typedef _Float16 h16;
typedef _Float16 f16x8 __attribute__((ext_vector_type(8)));
typedef _Float16 f16x4 __attribute__((ext_vector_type(4)));
typedef _Float16 f16x2 __attribute__((ext_vector_type(2)));
typedef float f32x2 __attribute__((ext_vector_type(2)));
typedef float f32x4 __attribute__((ext_vector_type(4)));
typedef float f32x16 __attribute__((ext_vector_type(16)));
typedef unsigned u32x2 __attribute__((ext_vector_type(2)));
typedef unsigned u32x4 __attribute__((ext_vector_type(4)));

constexpr int D = 2048, NB = 8, SEQ = 4096, CTXL = 256, TL = NB * SEQ, TC = NB * CTXL, TT = TL + TC;
constexpr int D3 = 3 * D, D6 = 6 * D, DQK = 2304, DQKV = 2560, NE = 64, DE = 384, DE2 = 768, NLAYER = 4;
constexpr int LCAP = TT;
constexpr int MOE_ROWS = 86016;
constexpr float EPS = 1e-6f;

constexpr size_t WS_CTL = 0;
constexpr size_t CTL_BYTES = 65536;
constexpr size_t WS_TW = WS_CTL + CTL_BYTES;
constexpr size_t WS_ROPE = WS_TW + 65536;
constexpr size_t WS_MODP = WS_ROPE + 8192;
constexpr size_t WS_MODS = WS_MODP + 16ull * 4 * 9 * 12288 * 4;
constexpr size_t WS_RTAB = WS_MODS + 4ull * 9 * 12288 * 4;
constexpr size_t RTAB_L = 64ull * 5 * 2 * 64 * 8 * 2;
constexpr size_t WS_H2P = WS_RTAB + 4 * RTAB_L;
constexpr size_t WS_W3P = WS_H2P + 2ull * 4352 * 256 * 2;
constexpr size_t WS_XRES = WS_W3P + 2ull * 8192 * 256 * 2;
constexpr size_t WS_HBUF = WS_XRES + (size_t)TT * D * 4;
constexpr size_t WS_UT = WS_HBUF + (size_t)TT * D * 2;
constexpr size_t UT_BYTES = (size_t)D3 * TT * 2;
constexpr size_t WS_TAPS = WS_UT;
constexpr size_t WS_TAPSC = WS_TAPS + 2ull * 8192 * 4096 * 4;
constexpr size_t WS_QK = WS_UT;
constexpr size_t WS_VT = WS_QK + (size_t)TT * DQK * 2;
constexpr size_t WS_ZT = WS_UT + UT_BYTES;
constexpr size_t WS_H1 = WS_ZT + (size_t)D * TT * 2;
constexpr size_t WS_YC = WS_H1 + (size_t)MOE_ROWS * DE * 2;
constexpr size_t WS_WIN = WS_YC + 2ull * TT * D * 2;
constexpr size_t WS_WOUT = WS_WIN + 2ull * D3 * D * 2;
constexpr size_t WS_WQKV = WS_WOUT + 2ull * D * D * 2;
constexpr size_t WS_WO = WS_WQKV + 2ull * DQKV * D * 2;
constexpr size_t WS_W13 = WS_WO + 2ull * D * D * 2;
constexpr size_t WS_W2 = WS_W13 + (size_t)NE * DE2 * D * 2;
constexpr size_t WS_KF = WS_W2 + (size_t)NE * D * DE * 2;
constexpr size_t WS_LIST = WS_KF + 2ull * 2 * 2 * 2048 * 65536;
constexpr size_t WS_GATE = WS_LIST + (size_t)NE * LCAP * 4;
constexpr size_t WS_END = WS_GATE + 2ull * TT * 4;
static_assert(WS_TAPSC + 2ull * 8192 * 256 * 4 <= WS_UT + UT_BYTES, "taps alias");
static_assert(WS_VT + 256ull * TT * 2 <= WS_UT + UT_BYTES, "qkv alias");

constexpr int CTL_CNT = 4096;

constexpr int LDS_BYTES = 147456;
constexpr int LDS_MISC = 139264;
constexpr int LDS_XB = LDS_BYTES - 16;

struct Params {
    const float *x, *c, *ctx, *c_ctx, *mod_w, *mod_b, *hy_w_in, *hy_conv_w, *hy_conv_b, *hy_f_w1, *hy_f_b1, *hy_f_freq1, *hy_f_w2, *hy_f_b2, *hy_f_freq2, *hy_f_w3,
        *hy_bias, *hy_w_out, *at_w_qkv, *at_sink, *at_w_o, *moe_wg, *moe_bg, *moe_we, *moe_be, *moe_w1, *moe_w3, *moe_w2, *final_gain;
    float* out; char* ws; int ph0, ph1;
};

__device__ __forceinline__ int tid_fresh() { int t = threadIdx.x; asm volatile("" : "+v"(t)); return t; }
__device__ __forceinline__ float bperm_f(float v, int srclane) { return __int_as_float(__builtin_amdgcn_ds_bpermute(srclane << 2, __float_as_int(v))); }
__device__ __forceinline__ float shx(float v, int mask) { return bperm_f(v, (tid_fresh() & 63) ^ mask); }
__device__ __forceinline__ const Params* params_fresh() { auto q = __builtin_amdgcn_kernarg_segment_ptr(); asm volatile("" : "+s"(q)); return (const Params*)q; }

#define XB_TMO      128
#define XB_XCNT(j)  (256  + 64 * (j))
#define XB_XSUB(j)  (1280 + 64 * (j))
#define XB_XGEN(j)  (2304 + 64 * (j))
#define XB_TOP      3328
#define XB_TOPGEN   3392
#define XCD_BAR_WORDS 3456
#define XB_SPIN_CAP (1u << 18)

__device__ __forceinline__ unsigned xb_ld(unsigned* p)              { return __hip_atomic_load(p, __ATOMIC_RELAXED, __HIP_MEMORY_SCOPE_AGENT); }
__device__ __forceinline__ unsigned xb_add(unsigned* p, unsigned v) { return __hip_atomic_fetch_add(p, v, __ATOMIC_RELAXED, __HIP_MEMORY_SCOPE_AGENT); }
__device__ __forceinline__ unsigned xb_xcc_id() { return (unsigned)__builtin_amdgcn_s_getreg((3 << 11) | 20) & 0xFu; }
#define XB_SPIN(cond, bar) do { unsigned _sp = 0; while (cond) { __builtin_amdgcn_s_sleep(1); \
    if ((++_sp & 255u) == 0u) { if (xb_ld(&(bar)[XB_TMO])) break; if (_sp > XB_SPIN_CAP) { atomicAdd(&(bar)[XB_TMO], 1u); break; } } } } while (0)

struct XcdBarrier { unsigned* bar; volatile LAS unsigned* st; };

__device__ __forceinline__ XcdBarrier xcd_barrier_post(unsigned* bar, volatile LAS unsigned* st) {
    XcdBarrier b; b.bar = bar; b.st = st;
    if (threadIdx.x == 0) (void)xb_add(&bar[XB_XCNT(xb_xcc_id())], 1u);
    return b;
}
__device__ __forceinline__ void xcd_barrier_complete(unsigned* bar, unsigned x, unsigned& nloc, unsigned& nx) {
    const unsigned G = gridDim.x * gridDim.y * gridDim.z;
    unsigned sum, cnt, mine, sp = 0u;
    for (;;) {
        sum = 0u; cnt = 0u; mine = 0u;
#pragma unroll
        for (unsigned j = 0; j < 16; ++j) { const unsigned c = xb_ld(&bar[XB_XCNT(j)]); sum += c; cnt += (c > 0u) ? 1u : 0u; mine = (j == x) ? c : mine; }
        if (sum == G) break;
        __builtin_amdgcn_s_sleep(1);
        if ((++sp & 255u) == 0u) { if (xb_ld(&bar[XB_TMO])) break; if (sp > XB_SPIN_CAP) { atomicAdd(&bar[XB_TMO], 1u); break; } }
    }
    nloc = mine > 0u ? mine : 1u; nx = cnt > 0u ? cnt : 1u;
}
__device__ __forceinline__ void xcd_barrier(const XcdBarrier& b) {
    asm volatile("s_waitcnt vmcnt(0)" ::: "memory");
    __syncthreads();
    if (threadIdx.x == 0) {
        unsigned* bar = b.bar; const unsigned bx = xb_xcc_id();
        __builtin_amdgcn_s_waitcnt(0);
        unsigned nloc = b.st[0], nx = b.st[1];
        if (nloc == 0u) { xcd_barrier_complete(bar, bx, nloc, nx); b.st[0] = nloc; b.st[1] = nx; }
        const unsigned old = xb_add(&bar[XB_XSUB(bx)], 1u);
        const unsigned gen = old / nloc;
        if (old + 1u == (gen + 1u) * nloc) {
            __builtin_amdgcn_fence(__ATOMIC_RELEASE, "agent");
            asm volatile("s_waitcnt vmcnt(0)" ::: "memory");
            const unsigned og = xb_add(&bar[XB_TOP], 1u);
            const unsigned tg = og / nx;
            if (og + 1u == (tg + 1u) * nx) xb_add(&bar[XB_TOPGEN], 1u);
            else XB_SPIN(xb_ld(&bar[XB_TOPGEN]) == tg, bar);
            __builtin_amdgcn_fence(__ATOMIC_ACQUIRE, "agent");
            xb_add(&bar[XB_XGEN(bx)], 1u);
            asm volatile("s_waitcnt vmcnt(0)" ::: "memory");
        } else {
            XB_SPIN(xb_ld(&bar[XB_XGEN(bx)]) == gen, bar);
            __builtin_amdgcn_fence(__ATOMIC_ACQUIRE, "agent");
            asm volatile("s_waitcnt vmcnt(0)" ::: "memory");
        }
    }
    __syncthreads();
}

namespace pg8 {
constexpr int BM = 256, BK = 64, HALF = 128, HTB = HALF * BK * 2, STAGE_BYTES = 8 * HTB;
__device__ __forceinline__ int lds_byte(int r, int c) { const int st = (r >> 4) * 2 + (c >> 5), rr = r & 15, cc = c & 31, ob = rr * 64 + cc * 2; return st * 1024 + (ob ^ (((ob >> 9) & 1) << 5)); }
__device__ __forceinline__ void stage_rc(int b, int& R, int& C) { const int st = b / 1024, sb = b % 1024, swz = sb ^ (((sb >> 9) & 1) << 5); R = (st >> 1) * 16 + swz / 64; C = (st & 1) * 32 + (swz % 64) / 2; }
__device__ __forceinline__ int perm32(int rho) { const int n = rho >> 4, i = rho & 15; return 8 * (i >> 2) + 4 * n + (i & 3); }

struct Unit {
    int pm, pn;
    int e, pos0, cnt;
    int kind;
    const char* A; const char* B;
    const int* rows;
};

template <class Epi, class Sched, bool GATHER>
__device__ __forceinline__ void gemm_phase(LAS unsigned char* lds, const int K, const Sched& S, const Epi& E) {
    const int tid = tid_fresh(), wid = __builtin_amdgcn_readfirstlane(tid >> 6), lane = tid & 63, wr = wid >> 2, wc = wid & 3, fr = lane & 15, fq = lane >> 4;
    const int nt = K / BK;
    unsigned voffA[2], voffB[2]; int RA[2], CA[2];
#pragma unroll
    for (int i = 0; i < 2; ++i) { int R, C; stage_rc(tid * 16 + i * 8192, R, C); const int Rb = Epi::PERM ? ((R & ~31) + perm32(R & 31)) : R;
        voffA[i] = (unsigned)(R * K + C) * 2u; voffB[i] = (unsigned)(Rb * K + C) * 2u; RA[i] = R; CA[i] = C; }
    const size_t kstep = (size_t)(BK * 2);
    const size_t hstep = (size_t)HALF * K * 2;
    const unsigned ldsw = (unsigned)wid * 1024u;
    const int aoff = lds_byte(wr * 64 + fr, fq * 8), boff = lds_byte(wc * 32 + fr, fq * 8);
    unsigned vgC[2][2], vgN[2][2];
#define PG8_ROWS(u, vg) do { if constexpr (GATHER) { _Pragma("unroll") for (int _h = 0; _h < 2; ++_h) _Pragma("unroll") for (int _i = 0; _i < 2; ++_i) { \
        const int _p = (u).pos0 + _h * HALF + RA[_i]; const int _tok = (_p < (u).cnt) ? ((u).rows[_h * HALF + RA[_i]] >> 1) : 0; \
        vg[_h][_i] = ((unsigned)_tok * (unsigned)K + (unsigned)CA[_i]) * 2u; } } } while (0)
#define PG8_SA(b, h) (((b) * 2 + (h)) * HTB)
#define PG8_SB(b, h) ((4 + (b) * 2 + (h)) * HTB)
#define PG8_STAGE_B(bufoff, gbase) do { _Pragma("unroll") for (int _i = 0; _i < 2; ++_i) \
        __builtin_amdgcn_global_load_lds((const unsigned*)((const char*)(gbase) + voffB[_i]), (LAS unsigned*)(lds + (bufoff) + ldsw + _i * 8192), 16, 0, 0); } while (0)
#define PG8_STAGE_A(bufoff, gbase, h, NEXT) do { _Pragma("unroll") for (int _i = 0; _i < 2; ++_i) { \
        const unsigned _vo = GATHER ? ((NEXT) ? vgN[h][_i] : vgC[h][_i]) : voffA[_i]; \
        __builtin_amdgcn_global_load_lds((const unsigned*)((const char*)(gbase) + (GATHER ? (size_t)0 : (size_t)(h) * hstep) + _vo), (LAS unsigned*)(lds + (bufoff) + ldsw + _i * 8192), 16, 0, 0); } } while (0)
#define PG8_LDA(dst, b, h) do { _Pragma("unroll") for (int m = 0; m < 4; ++m) _Pragma("unroll") for (int k = 0; k < 2; ++k) dst[m][k] = *(const LAS f16x8*)(lds + PG8_SA(b, h) + aoff + m * 2048 + k * 1024); } while (0)
#define PG8_LDB(dst, b, h) do { _Pragma("unroll") for (int n = 0; n < 2; ++n) _Pragma("unroll") for (int k = 0; k < 2; ++k) dst[n][k] = *(const LAS f16x8*)(lds + PG8_SB(b, h) + boff + n * 2048 + k * 1024); } while (0)
#define PG8_MMA(ai, bj, At, Bt) do { __builtin_amdgcn_s_setprio(1); _Pragma("unroll") for (int m = 0; m < 4; ++m) _Pragma("unroll") for (int n = 0; n < 2; ++n) _Pragma("unroll") for (int k = 0; k < 2; ++k) \
        acc[ai][bj][m][n] = __builtin_amdgcn_mfma_f32_16x16x32_f16(Bt[n][k], At[m][k], acc[ai][bj][m][n], 0, 0, 0); __builtin_amdgcn_s_setprio(0); } while (0)
#define PG8_WAIT_V(n) asm volatile("s_waitcnt vmcnt(" #n ")" ::: "memory")
#define PG8_WAIT_L(n) asm volatile("s_waitcnt lgkmcnt(" #n ")" ::: "memory")
#define PG8_BAR __builtin_amdgcn_s_barrier()
#define PG8_SCHED __builtin_amdgcn_sched_barrier(0)
    Unit cur, nxt; int ui = 0;
    if (!S.next(0, cur)) return;
    f32x4 acc[2][2][4][2];
#pragma unroll
    for (int a = 0; a < 2; ++a)
#pragma unroll
        for (int b = 0; b < 2; ++b)
#pragma unroll
            for (int m = 0; m < 4; ++m)
#pragma unroll
                for (int n = 0; n < 2; ++n) acc[a][b][m][n] = (f32x4){0.f, 0.f, 0.f, 0.f};
    f16x8 At[4][2], B0[2][2], B1[2][2];
    const char* cA = cur.A; const char* cB = cur.B;
    PG8_ROWS(cur, vgC);
#pragma unroll
    for (int _h = 0; _h < 2; ++_h)
#pragma unroll
        for (int _i = 0; _i < 2; ++_i) vgN[_h][_i] = GATHER ? vgC[_h][_i] : 0u;
    PG8_STAGE_B(PG8_SB(0, 0), cB); PG8_STAGE_B(PG8_SB(0, 1), cB + hstep); PG8_STAGE_A(PG8_SA(0, 0), cA, 0, false); PG8_STAGE_A(PG8_SA(0, 1), cA, 1, false);
    if (wr == 1) PG8_BAR;
    PG8_WAIT_V(2); PG8_BAR;
    PG8_STAGE_B(PG8_SB(1, 0), cB + kstep); PG8_STAGE_A(PG8_SA(1, 0), cA + kstep, 0, false); PG8_STAGE_B(PG8_SB(1, 1), cB + hstep + kstep);
    PG8_WAIT_V(6); PG8_BAR;
    for (;;) {
        const bool has_next = S.next(ui + 1, nxt);
        const char* nA = has_next ? nxt.A : cA; const char* nB = has_next ? nxt.B : cB;
        if (has_next) { PG8_ROWS(nxt, vgN); }
#pragma unroll 1
        for (int t = 0; t < nt; t += 2) {
            const bool last = (t == nt - 2);
            const char* a1 = cA + (size_t)(t + 1) * kstep;
            const char* a2 = last ? nA : cA + (size_t)(t + 2) * kstep; const char* b2 = last ? nB : cB + (size_t)(t + 2) * kstep;
            const char* a3 = a2 + kstep; const char* b3 = b2 + kstep;
            PG8_LDB(B0, 0, 0); PG8_LDB(B1, 0, 1); PG8_SCHED; PG8_LDA(At, 0, 0); PG8_STAGE_A(PG8_SA(1, 1), a1, 1, false);
            PG8_WAIT_V(8); PG8_WAIT_L(0); PG8_BAR; PG8_MMA(0, 0, At, B0); PG8_MMA(0, 1, At, B1); PG8_BAR; PG8_SCHED;
            PG8_LDA(At, 0, 1); PG8_STAGE_B(PG8_SB(0, 0), b2); PG8_STAGE_B(PG8_SB(0, 1), b2 + hstep); PG8_STAGE_A(PG8_SA(0, 0), a2, 0, last);
            PG8_WAIT_V(8); PG8_WAIT_L(0); PG8_BAR; PG8_MMA(1, 0, At, B0); PG8_MMA(1, 1, At, B1); PG8_BAR; PG8_SCHED;
            PG8_LDB(B0, 1, 0); PG8_LDB(B1, 1, 1); PG8_SCHED; PG8_LDA(At, 1, 0); PG8_STAGE_A(PG8_SA(0, 1), a2, 1, last);
            PG8_WAIT_V(8); PG8_WAIT_L(0); PG8_BAR; PG8_MMA(0, 0, At, B0); PG8_MMA(0, 1, At, B1); PG8_BAR; PG8_SCHED;
            PG8_LDA(At, 1, 1); PG8_STAGE_B(PG8_SB(1, 0), b3); PG8_STAGE_B(PG8_SB(1, 1), b3 + hstep); PG8_STAGE_A(PG8_SA(1, 0), a3, 0, last);
            PG8_WAIT_V(8); PG8_WAIT_L(0); PG8_BAR; PG8_MMA(1, 0, At, B0); PG8_MMA(1, 1, At, B1); PG8_BAR; PG8_SCHED;
        }
        if (wr == 0) PG8_BAR;
        E(acc, cur, wr, wc, fr, fq);
        if (!has_next) break;
#pragma unroll
        for (int a = 0; a < 2; ++a)
#pragma unroll
            for (int b = 0; b < 2; ++b)
#pragma unroll
                for (int m = 0; m < 4; ++m)
#pragma unroll
                    for (int n = 0; n < 2; ++n) acc[a][b][m][n] = (f32x4){0.f, 0.f, 0.f, 0.f};
        cur = nxt; cA = nA; cB = nB; ++ui;
#pragma unroll
        for (int _h = 0; _h < 2; ++_h)
#pragma unroll
            for (int _i = 0; _i < 2; ++_i) vgC[_h][_i] = vgN[_h][_i];
        if (wr == 1) PG8_BAR;
    }
    PG8_WAIT_V(0);
    PG8_BAR;
#undef PG8_ROWS
#undef PG8_SA
#undef PG8_SB
#undef PG8_STAGE_A
#undef PG8_STAGE_B
#undef PG8_LDA
#undef PG8_LDB
#undef PG8_MMA
#undef PG8_WAIT_V
#undef PG8_WAIT_L
#undef PG8_BAR
#undef PG8_SCHED
}
}

using pg8::Unit;
__device__ __forceinline__ f16x8 pack8(const f32x4 a, const f32x4 b) {
    f16x8 w; w[0] = (h16)a[0]; w[1] = (h16)a[1]; w[2] = (h16)a[2]; w[3] = (h16)a[3]; w[4] = (h16)b[0]; w[5] = (h16)b[1]; w[6] = (h16)b[2]; w[7] = (h16)b[3]; return w;
}
struct EpiH16 {
    static constexpr bool PERM = true;
    h16* O0; int ld0; h16* O1; int ld1;
    __device__ __forceinline__ void operator()(const f32x4 (&acc)[2][2][4][2], const Unit& u, int wr, int wc, int fr, int fq) const {
        h16* base = u.kind ? O1 : O0; const int ld = u.kind ? ld1 : ld0;
        const int row0 = u.pm * 256 + wr * 64 + fr, col0 = u.pn * 256 + wc * 32 + 8 * fq;
#pragma unroll
        for (int ai = 0; ai < 2; ++ai)
#pragma unroll
            for (int m = 0; m < 4; ++m) { h16* rowp = base + (size_t)(row0 + ai * 128 + m * 16) * ld + col0;
#pragma unroll
                for (int bj = 0; bj < 2; ++bj) *(f16x8*)(rowp + bj * 128) = pack8(acc[ai][bj][m][0], acc[ai][bj][m][1]); }
    }
};
struct EpiTaps {
    static constexpr bool PERM = false;
    float* T0; float* T1;
    __device__ __forceinline__ void operator()(const f32x4 (&acc)[2][2][4][2], const Unit& u, int wr, int wc, int fr, int fq) const {
        const int j = u.kind >> 1, v = u.kind & 1; const int ld = v ? 256 : 4096;
        float* base = v ? (T1 + (size_t)j * 8192 * 256) : (T0 + (size_t)j * 8192 * 4096);
        const int row0 = u.pm * 256 + wr * 64 + fr, col0 = u.pn * 256 + wc * 32 + 4 * fq;
#pragma unroll
        for (int ai = 0; ai < 2; ++ai)
#pragma unroll
            for (int m = 0; m < 4; ++m) { float* rowp = base + (size_t)(row0 + ai * 128 + m * 16) * ld + col0;
#pragma unroll
                for (int bj = 0; bj < 2; ++bj)
#pragma unroll
                    for (int n = 0; n < 2; ++n) *(f32x4*)(rowp + bj * 128 + n * 16) = acc[ai][bj][m][n]; }
    }
};
struct EpiResid {
    static constexpr bool PERM = false;
    float* X; const float* mods; int layer;
    __device__ __forceinline__ void operator()(const f32x4 (&acc)[2][2][4][2], const Unit& u, int wr, int wc, int fr, int fq) const {
        const int r0 = u.pm * 256; const int b = r0 < TL ? (r0 >> 12) : 8;
        const float* g = mods + ((size_t)(layer * 9 + b) * 6 + 2) * D;
        const int row0 = r0 + wr * 64 + fr, col0 = u.pn * 256 + wc * 32 + 4 * fq;
        f32x4 gv[2][2];
#pragma unroll
        for (int bj = 0; bj < 2; ++bj)
#pragma unroll
            for (int n = 0; n < 2; ++n) gv[bj][n] = *(const f32x4*)(g + col0 + bj * 128 + n * 16);
#pragma unroll
        for (int ai = 0; ai < 2; ++ai)
#pragma unroll
            for (int m = 0; m < 4; ++m) { float* rowp = X + (size_t)(row0 + ai * 128 + m * 16) * D + col0;
#pragma unroll
                for (int bj = 0; bj < 2; ++bj)
#pragma unroll
                    for (int n = 0; n < 2; ++n) { f32x4* p = (f32x4*)(rowp + bj * 128 + n * 16); *p = *p + gv[bj][n] * acc[ai][bj][m][n]; } }
    }
};
struct EpiMoe1 {
    static constexpr bool PERM = true;
    h16* H1;
    __device__ __forceinline__ void operator()(const f32x4 (&acc)[2][2][4][2], const Unit& u, int wr, int wc, int fr, int fq) const {
        const int row0 = u.pm * 256 + wr * 64 + fr, col0 = u.pn * 128 + wc * 16 + 4 * fq;
#pragma unroll
        for (int ai = 0; ai < 2; ++ai)
#pragma unroll
            for (int m = 0; m < 4; ++m) { h16* rowp = H1 + (size_t)(row0 + ai * 128 + m * 16) * DE + col0;
#pragma unroll
                for (int bj = 0; bj < 2; ++bj) { const f32x4 a = acc[ai][bj][m][0], b = acc[ai][bj][m][1]; f16x4 w;
#pragma unroll
                    for (int i = 0; i < 4; ++i) { const float s = a[i] / (1.0f + __expf(-a[i])); w[i] = (h16)(s * b[i]); }
                    *(f16x4*)(rowp + bj * 64) = w; } }
    }
};
struct EpiMoe2 {
    static constexpr bool PERM = true;
    h16* YC; const float* gate;
    __device__ __forceinline__ void operator()(const f32x4 (&acc)[2][2][4][2], const Unit& u, int wr, int wc, int fr, int fq) const {
        const int col0 = u.pn * 256 + wc * 32 + 8 * fq;
#pragma unroll
        for (int ai = 0; ai < 2; ++ai)
#pragma unroll
            for (int m = 0; m < 4; ++m) { const int r = ai * 128 + wr * 64 + m * 16 + fr;
                if (u.pos0 + r < u.cnt) { const int a = u.rows[r]; const float g = gate[a]; h16* rowp = YC + (size_t)a * D + col0;
#pragma unroll
                    for (int bj = 0; bj < 2; ++bj) *(f16x8*)(rowp + bj * 128) = pack8(acc[ai][bj][m][0] * g, acc[ai][bj][m][1] * g); }
                asm volatile("" ::: "memory"); }
    }
};

__device__ __forceinline__ void order_tile(int wgid, int nM, int nN, int& pm, int& pn) {
    const int nwg = nM * nN; { const int q = nwg / 8, r = nwg % 8, xcd = wgid % 8, off = wgid / 8; wgid = (xcd < r ? xcd * (q + 1) : r * (q + 1) + (xcd - r) * q) + off; }
    const int nig = 8 * nN, gid = wgid / nig, fm = gid * 8, gsz = (nM - fm) < 8 ? (nM - fm) : 8;
    pm = fm + ((wgid % nig) % gsz); pn = (wgid % nig) / gsz;
}
struct SchedPlain {
    int nM, nN, K; const char* A; const char* B;
    __device__ __forceinline__ bool next(int i, Unit& u) const {
        const long L = (long)i * gridDim.x + blockIdx.x; if (L >= (long)nM * nN) return false;
        order_tile((int)L, nM, nN, u.pm, u.pn); u.kind = 0; u.e = 0; u.pos0 = 0; u.cnt = 0; u.rows = nullptr;
        u.A = A + (size_t)u.pm * 256 * K * 2; u.B = B + (size_t)u.pn * 256 * K * 2; return true;
    }
};
struct SchedQkv {
    const char* H; const char* W;
    __device__ __forceinline__ bool next(int i, Unit& u) const {
        const long L = (long)i * gridDim.x + blockIdx.x; const int nA = 136 * 9; if (L >= nA + 136) return false;
        u.e = 0; u.pos0 = 0; u.cnt = 0; u.rows = nullptr;
        if (L < nA) { order_tile((int)L, 136, 9, u.pm, u.pn); u.kind = 0; u.A = H + (size_t)u.pm * 256 * D * 2; u.B = W + (size_t)u.pn * 256 * D * 2; }
        else { u.pm = 0; u.pn = (int)L - nA; u.kind = 1; u.A = W + (size_t)DQK * D * 2; u.B = H + (size_t)u.pn * 256 * D * 2; }
        return true;
    }
};
struct SchedFilt {
    const char* W3P; const char* H2P;
    __device__ __forceinline__ bool next(int i, Unit& u) const {
        const long L = (long)i * gridDim.x + blockIdx.x; if (L >= 2 * 544) return false;
        const int j = (int)L / 544, r = (int)L % 544; u.e = 0; u.pos0 = 0; u.cnt = 0; u.rows = nullptr;
        int v; if (r < 512) { v = 0; u.pm = r >> 4; u.pn = r & 15; } else { v = 1; u.pm = r - 512; u.pn = 0; }
        u.kind = 2 * j + v;
        u.A = W3P + ((size_t)j * 8192 + (size_t)u.pm * 256) * 256 * 2;
        u.B = H2P + ((size_t)j * 4352 + (v ? 4096 : 0) + (size_t)u.pn * 256) * 256 * 2;
        return true;
    }
};
struct MoeTab { const LAS int* tstart; const LAS int* texp; const LAS int* cnt; };
struct SchedMoe1 {
    MoeTab tb; const char* H; const char* W13; const int* list;
    __device__ __forceinline__ bool next(int i, Unit& u) const {
        const long L = (long)i * gridDim.x + blockIdx.x; const int ntile = __builtin_amdgcn_readfirstlane(tb.tstart[NE]); if (L >= (long)ntile * 3) return false;
        const int rt = (int)L / 3; u.pn = (int)L % 3; u.pm = rt; u.kind = 0;
        const int e = __builtin_amdgcn_readfirstlane(tb.texp[rt]); u.e = e; u.pos0 = (rt - __builtin_amdgcn_readfirstlane(tb.tstart[e])) * 256; u.cnt = __builtin_amdgcn_readfirstlane(tb.cnt[e]);
        u.rows = list + (size_t)e * LCAP + u.pos0; u.A = H; u.B = W13 + ((size_t)e * DE2 + (size_t)u.pn * 256) * D * 2; return true;
    }
};
struct SchedMoe2 {
    MoeTab tb; const char* H1; const char* W2; const int* list;
    __device__ __forceinline__ bool next(int i, Unit& u) const {
        const long L = (long)i * gridDim.x + blockIdx.x; const int ntile = __builtin_amdgcn_readfirstlane(tb.tstart[NE]); if (L >= (long)ntile * 8) return false;
        const int rt = (int)L >> 3; u.pn = (int)L & 7; u.pm = rt; u.kind = 0;
        const int e = __builtin_amdgcn_readfirstlane(tb.texp[rt]); u.e = e; u.pos0 = (rt - __builtin_amdgcn_readfirstlane(tb.tstart[e])) * 256; u.cnt = __builtin_amdgcn_readfirstlane(tb.cnt[e]);
        u.rows = list + (size_t)e * LCAP + u.pos0; u.A = H1 + (size_t)rt * 256 * DE * 2; u.B = W2 + ((size_t)e * D + (size_t)u.pn * 256) * DE * 2; return true;
    }
};
__device__ __forceinline__ void moe_table(LAS int* tstart, LAS int* texp, LAS int* cnt, const int* counters) {
    const int t = tid_fresh();
    if (t < NE) cnt[t] = counters[t];
    __syncthreads();
    if (t <= NE) { int s = 0; for (int e = 0; e < t; ++e) s += (cnt[e] + 255) >> 8; tstart[t] = s; }
    __syncthreads();
    if (t < NE) { const int s0 = tstart[t], s1 = tstart[t + 1]; for (int q = s0; q < s1; ++q) texp[q] = t; }
    __syncthreads();
}

__device__ __forceinline__ float wave_sum(float v) {
#pragma unroll
    for (int o = 32; o >= 1; o >>= 1) v += shx(v, o);
    return v;
}
__device__ __forceinline__ float silu_f(float x) { return x / (1.0f + expf(-x)); }
__device__ __forceinline__ int batch_of_row(int r) { return r < TL ? (r >> 12) : 8; }

__device__ __forceinline__ void modp_unit(const Params& p, int unit, LAS float* sl) {
    const int layer = unit / 96, rem = unit % 96, ks = rem / 6, cc = rem % 6, tid = tid_fresh();
    for (int i = tid; i < 9 * 128; i += 512) { const int cnd = i >> 7, k = ks * 128 + (i & 127); const float v = cnd < 8 ? p.c[cnd * D + k] : p.c_ctx[k]; sl[i] = silu_f(v); }
    __syncthreads();
    f32x4 acc[9];
#pragma unroll
    for (int q = 0; q < 9; ++q) acc[q] = (f32x4){0.f, 0.f, 0.f, 0.f};
    const float* w = p.mod_w + ((size_t)layer * D + (size_t)ks * 128) * D6 + cc * 2048 + tid * 4;
#pragma unroll 4
    for (int k = 0; k < 128; ++k) { const f32x4 wv = *(const f32x4*)(w + (size_t)k * D6);
#pragma unroll
        for (int q = 0; q < 9; ++q) acc[q] += wv * sl[q * 128 + k]; }
    float* outp = (float*)(p.ws + WS_MODP) + ((size_t)(ks * 4 + layer) * 9) * D6 + cc * 2048 + tid * 4;
#pragma unroll
    for (int q = 0; q < 9; ++q) *(f32x4*)(outp + (size_t)q * D6) = acc[q];
    __syncthreads();
}
__device__ __forceinline__ void modr_unit(const Params& p, int unit) {
    const size_t idx = (size_t)unit * 2048 + tid_fresh() * 4; const int layer = (int)(idx / (9 * D6)), col = (int)(idx % D6);
    f32x4 s = *(const f32x4*)(p.mod_b + (size_t)layer * D6 + col);
    const float* pp = (const float*)(p.ws + WS_MODP) + idx;
#pragma unroll
    for (int ks = 0; ks < 16; ++ks) s += *(const f32x4*)(pp + (size_t)ks * 4 * 9 * D6);
    *(f32x4*)((float*)(p.ws + WS_MODS) + idx) = s;
}
__device__ __forceinline__ void tables_unit(const Params& p) {
    f32x2* tw = (f32x2*)(p.ws + WS_TW);
    for (int m = tid_fresh(); m < 8192; m += 512) { double s, c; sincospi(-(double)m / 4096.0, &s, &c); tw[m] = (f32x2){(float)c, (float)s}; }
    float* rc = (float*)(p.ws + WS_ROPE);
    for (int i = tid_fresh(); i < 1024; i += 512) { const int pos = i >> 4, q = i & 15; const float inv = powf(10000.0f, -(float)q / 16.0f); const float ang = (float)pos * inv;
        rc[i] = cosf(ang); rc[1024 + i] = sinf(ang); }
}
__device__ __forceinline__ void h2_task(const Params& p, int task) {
    const int lane = tid_fresh() & 63; const int j = task / 4352, r = task % 4352; const int v = r >= 4096, t = v ? r - 4096 : r; const int Lv = v ? 256 : 4096;
    const float tl = (float)t / (float)(Lv - 1);
    const float omega = (float)(2.0 * 3.14159265358979323846 / (double)Lv) * (float)t;
    float feat = 0.f;
    if (lane == 0) feat = tl;
    else if (lane <= 32) { const int bi = (lane - 1) & 15; const float band = 1e-4f + (float)bi * ((15.0f - 1e-4f) / 15.0f); const float a = band * omega; feat = lane <= 16 ? cosf(a) : -sinf(a); }
    const float* w1 = p.hy_f_w1 + (size_t)j * 33 * 64; const float* w2 = p.hy_f_w2 + (size_t)j * 64 * 64;
    float s = p.hy_f_b1[j * 64 + lane];
    for (int f = 0; f < 33; ++f) s += bperm_f(feat, f) * w1[f * 64 + lane];
    const float h1 = sinf(p.hy_f_freq1[j * 64 + lane] * s);
    float s2 = p.hy_f_b2[j * 64 + lane];
    for (int m = 0; m < 64; ++m) s2 += bperm_f(h1, m) * w2[m * 64 + lane];
    const float h2 = sinf(p.hy_f_freq2[j * 64 + lane] * s2);
    const h16 hi = (h16)h2; const h16 lo = (h16)(h2 - (float)hi);
    h16* row = (h16*)(p.ws + WS_H2P) + ((size_t)j * 4352 + r) * 256;
    row[lane] = hi; row[64 + lane] = hi; row[128 + lane] = lo; row[192 + lane] = lo;
}
__device__ __forceinline__ void w3p_unit(const Params& p, int unit) {
    const int j = unit >> 5, c0 = (unit & 31) * 256; const float* w3 = p.hy_f_w3 + (size_t)j * 64 * 8192; h16* dst = (h16*)(p.ws + WS_W3P) + (size_t)j * 8192 * 256;
    for (int i = tid_fresh(); i < 64 * 256; i += 512) { const int m = i >> 8, col = c0 + (i & 255); const float w = w3[(size_t)m * 8192 + col];
        const h16 hi = (h16)w; const h16 lo = (h16)(w - (float)hi); h16* row = dst + (size_t)col * 256; row[m] = hi; row[64 + m] = lo; row[128 + m] = hi; row[192 + m] = lo; }
}
__device__ __forceinline__ void rtab_unit(const Params& p, int unit) {
    const int layer = unit >> 6, c = unit & 63; h16* dst = (h16*)(p.ws + WS_RTAB + (size_t)layer * RTAB_L) + (size_t)c * 5 * 2 * 64 * 8;
    for (int i = tid_fresh(); i < 5 * 2 * 64 * 8; i += 512) { const int jj = i & 7, lane = (i >> 3) & 63, hl = (i >> 9) & 1, ct = i >> 10;
        const int k = 32 * c + 8 * (lane >> 4) + jj, col = 16 * ct + (lane & 15);
        float w = 0.f; if (col < 8) w = p.moe_wg[((size_t)layer * D + k) * 8 + col]; else if (col < 72) w = p.moe_we[((size_t)layer * D + k) * 64 + (col - 8)];
        w *= 256.0f; const h16 hi = (h16)w; const h16 lo = (h16)(w - (float)hi); dst[i] = hl ? lo : hi; }
}
template <int NW>
__device__ __forceinline__ void cvt_tile(const float* src, int ldn, int k0, int n0, h16* dst, int ldk, int mode, LAS float* T) {
    constexpr int P = NW + 1; const int tid = tid_fresh();
#pragma unroll
    for (int ps = 0; ps < 64 * NW / 4 / 512; ++ps) { const int idx = ps * 512 + tid, k = idx / (NW / 4), n4 = idx % (NW / 4);
        const f32x4 v = *(const f32x4*)(src + (size_t)(k0 + k) * ldn + n0 + 4 * n4); LAS float* q = T + k * P + 4 * n4; q[0] = v[0]; q[1] = v[1]; q[2] = v[2]; q[3] = v[3]; }
    __syncthreads();
#pragma unroll
    for (int ps = 0; ps < NW * 8 / 512; ++ps) { const int item = ps * 512 + tid, kc = item & 7, n = item >> 3; f16x8 w;
#pragma unroll
        for (int i = 0; i < 8; ++i) w[i] = (h16)T[(8 * kc + i) * P + n];
        const int ng = n0 + n; const int row = mode == 0 ? ng : (8 * (ng >> 2) + (ng & 3) + (mode == 2 ? 4 : 0));
        *(f16x8*)(dst + (size_t)row * ldk + k0 + 8 * kc) = w; }
    __syncthreads();
}
__device__ __forceinline__ void cvt_dense_unit(const Params& p, int unit, LAS float* T) {
    const float* src; h16* dst; int nt, N;
    if (unit < 1536) { src = p.hy_w_in; dst = (h16*)(p.ws + WS_WIN); nt = 24; N = D3; }
    else if (unit < 2048) { unit -= 1536; src = p.hy_w_out; dst = (h16*)(p.ws + WS_WOUT); nt = 8; N = D; }
    else if (unit < 2688) { unit -= 2048; src = p.at_w_qkv; dst = (h16*)(p.ws + WS_WQKV); nt = 10; N = DQKV; }
    else { unit -= 2688; src = p.at_w_o; dst = (h16*)(p.ws + WS_WO); nt = 8; N = D; }
    const int j = unit / (32 * nt), r = unit % (32 * nt), kt = r / nt, ntile = r % nt;
    cvt_tile<256>(src + (size_t)j * D * N, N, kt * 64, ntile * 256, dst + (size_t)j * N * D, D, 0, T);
}
constexpr int CVT_DENSE_UNITS = 3200;
__device__ __forceinline__ void cvt_moe_unit(const Params& p, int layer, int unit, LAS float* T) {
    if (unit < 12288) { const int which = unit >= 6144; if (which) unit -= 6144; const int e = unit / 96, r = unit % 96, kt = r / 3, ntile = r % 3;
        const float* src = (which ? p.moe_w3 : p.moe_w1) + ((size_t)layer * NE + e) * D * DE;
        cvt_tile<128>(src, DE, kt * 64, ntile * 128, (h16*)(p.ws + WS_W13) + (size_t)e * DE2 * D, D, which ? 2 : 1, T); }
    else { unit -= 12288; const int e = unit / 48, r = unit % 48, kt = r / 8, ntile = r % 8;
        const float* src = p.moe_w2 + ((size_t)layer * NE + e) * DE * D;
        cvt_tile<256>(src, D, kt * 64, ntile * 256, (h16*)(p.ws + WS_W2) + (size_t)e * D * DE, DE, 0, T); }
}
constexpr int CVT_MOE_UNITS = 15360;

__device__ __forceinline__ void n1_phase(const Params& p, int layer) {
    const int lane = tid_fresh() & 63, gw = blockIdx.x * 8 + (tid_fresh() >> 6), nw = gridDim.x * 8;
    float* xres = (float*)(p.ws + WS_XRES); h16* hb = (h16*)(p.ws + WS_HBUF); const h16* yc = (const h16*)(p.ws + WS_YC); const float* mods = (const float*)(p.ws + WS_MODS);
    for (int r = gw; r < TT; r += nw) {
        const int b = batch_of_row(r);
        const float* src = layer == 0 ? (r < TL ? p.x + (size_t)r * D : p.ctx + (size_t)(r - TL) * D) : xres + (size_t)r * D;
        f32x4 v[8];
#pragma unroll
        for (int c = 0; c < 8; ++c) v[c] = *(const f32x4*)(src + c * 256 + lane * 4);
        if (layer > 0) { const float* g2 = mods + ((size_t)((layer - 1) * 9 + b) * 6 + 5) * D; const h16* y0 = yc + (size_t)(2 * r) * D; const h16* y1 = y0 + D;
#pragma unroll
            for (int c = 0; c < 8; ++c) { const int col = c * 256 + lane * 4; const f16x4 a = *(const f16x4*)(y0 + col), bb = *(const f16x4*)(y1 + col); const f32x4 g = *(const f32x4*)(g2 + col);
#pragma unroll
                for (int i = 0; i < 4; ++i) v[c][i] += g[i] * ((float)a[i] + (float)bb[i]); } }
        float ss = 0.f;
#pragma unroll
        for (int c = 0; c < 8; ++c) { *(f32x4*)(xres + (size_t)r * D + c * 256 + lane * 4) = v[c]; ss += v[c][0] * v[c][0] + v[c][1] * v[c][1] + v[c][2] * v[c][2] + v[c][3] * v[c][3]; }
        ss = wave_sum(ss); const float rs = 1.0f / sqrtf(ss * (1.0f / D) + EPS);
        const float* sh = mods + ((size_t)(layer * 9 + b) * 6 + 0) * D; const float* sc = sh + D;
#pragma unroll
        for (int c = 0; c < 8; ++c) { const int col = c * 256 + lane * 4; const f32x4 s0 = *(const f32x4*)(sh + col), s1 = *(const f32x4*)(sc + col); f16x4 w;
#pragma unroll
            for (int i = 0; i < 4; ++i) w[i] = (h16)(v[c][i] * rs * (1.0f + s1[i]) + s0[i]);
            *(f16x4*)(hb + (size_t)r * D + col) = w; }
    }
}
__device__ __forceinline__ void final_phase(const Params& p) {
    const int lane = tid_fresh() & 63, gw = blockIdx.x * 8 + (tid_fresh() >> 6), nw = gridDim.x * 8;
    const float* xres = (const float*)(p.ws + WS_XRES); const h16* yc = (const h16*)(p.ws + WS_YC); const float* mods = (const float*)(p.ws + WS_MODS);
    for (int r = gw; r < TL; r += nw) {
        const int b = r >> 12; f32x4 v[8];
        const float* g2 = mods + ((size_t)(3 * 9 + b) * 6 + 5) * D; const h16* y0 = yc + (size_t)(2 * r) * D; const h16* y1 = y0 + D;
        float ss = 0.f;
#pragma unroll
        for (int c = 0; c < 8; ++c) { const int col = c * 256 + lane * 4; v[c] = *(const f32x4*)(xres + (size_t)r * D + col);
            const f16x4 a = *(const f16x4*)(y0 + col), bb = *(const f16x4*)(y1 + col); const f32x4 g = *(const f32x4*)(g2 + col);
#pragma unroll
            for (int i = 0; i < 4; ++i) { v[c][i] += g[i] * ((float)a[i] + (float)bb[i]); ss += v[c][i] * v[c][i]; } }
        ss = wave_sum(ss); const float rs = 1.0f / sqrtf(ss * (1.0f / D) + EPS);
#pragma unroll
        for (int c = 0; c < 8; ++c) { const int col = c * 256 + lane * 4; const f32x4 g = *(const f32x4*)(p.final_gain + col); *(f32x4*)(p.out + (size_t)r * D + col) = v[c] * rs * g; }
    }
}
__device__ __forceinline__ void n2_phase(const Params& p, int layer, LAS float* scr_all) {
    const int lane = tid_fresh() & 63, wv = tid_fresh() >> 6, gw = blockIdx.x * 8 + wv, nw = gridDim.x * 8;
    const int r16 = lane & 15, kg = lane >> 4;
    const float* xres = (const float*)(p.ws + WS_XRES); h16* hb = (h16*)(p.ws + WS_HBUF); const float* mods = (const float*)(p.ws + WS_MODS);
    const f16x8* rt = (const f16x8*)(p.ws + WS_RTAB + (size_t)layer * RTAB_L);
    int* counters = (int*)(p.ws + WS_CTL) + CTL_CNT + layer * NE; int* list = (int*)(p.ws + WS_LIST); float* gate = (float*)(p.ws + WS_GATE);
    LAS float* scr = scr_all + wv * (16 * 80);
    for (int task = gw; task < TT / 16; task += nw) {
        const int row = task * 16 + r16; const int b = batch_of_row(task * 16);
        const float* xr = xres + (size_t)row * D + 8 * kg;
        float ss = 0.f;
#pragma unroll 8
        for (int c = 0; c < 64; ++c) { const f32x4 a = *(const f32x4*)(xr + 32 * c), bq = *(const f32x4*)(xr + 32 * c + 4);
            ss += a[0] * a[0] + a[1] * a[1] + a[2] * a[2] + a[3] * a[3] + bq[0] * bq[0] + bq[1] * bq[1] + bq[2] * bq[2] + bq[3] * bq[3]; }
        ss += shx(ss, 16); ss += shx(ss, 32);
        const float rs = 1.0f / sqrtf(ss * (1.0f / D) + EPS);
        const float* sh = mods + ((size_t)(layer * 9 + b) * 6 + 3) * D + 8 * kg; const float* sc = sh + D;
        f32x4 acc[5];
#pragma unroll
        for (int ct = 0; ct < 5; ++ct) acc[ct] = (f32x4){0.f, 0.f, 0.f, 0.f};
#pragma unroll 2
        for (int c = 0; c < 64; ++c) {
            const f32x4 a = *(const f32x4*)(xr + 32 * c), bq = *(const f32x4*)(xr + 32 * c + 4);
            const f32x4 h0 = *(const f32x4*)(sh + 32 * c), h1 = *(const f32x4*)(sh + 32 * c + 4), c0 = *(const f32x4*)(sc + 32 * c), c1 = *(const f32x4*)(sc + 32 * c + 4);
            f16x8 hi, lo;
#pragma unroll
            for (int i = 0; i < 4; ++i) { const float u0 = a[i] * rs * (1.0f + c0[i]) + h0[i], u1 = bq[i] * rs * (1.0f + c1[i]) + h1[i];
                hi[i] = (h16)u0; lo[i] = (h16)(u0 - (float)hi[i]); hi[4 + i] = (h16)u1; lo[4 + i] = (h16)(u1 - (float)hi[4 + i]); }
            *(f16x8*)(hb + (size_t)row * D + 32 * c + 8 * kg) = hi;
            const f16x8* bt = rt + (size_t)c * (5 * 2 * 64) + lane;
#pragma unroll
            for (int ct = 0; ct < 5; ++ct) { const f16x8 whi = bt[(ct * 2 + 0) * 64], wlo = bt[(ct * 2 + 1) * 64];
                acc[ct] = __builtin_amdgcn_mfma_f32_16x16x32_f16(hi, whi, acc[ct], 0, 0, 0);
                acc[ct] = __builtin_amdgcn_mfma_f32_16x16x32_f16(hi, wlo, acc[ct], 0, 0, 0);
                acc[ct] = __builtin_amdgcn_mfma_f32_16x16x32_f16(lo, whi, acc[ct], 0, 0, 0); }
        }
#pragma unroll
        for (int ct = 0; ct < 5; ++ct)
#pragma unroll
            for (int i = 0; i < 4; ++i) scr[(4 * kg + i) * 80 + 16 * ct + r16] = acc[ct][i] * (1.0f / 256.0f);
        __builtin_amdgcn_wave_barrier(); asm volatile("s_waitcnt lgkmcnt(0)" ::: "memory");
        if (lane < 16) {
            const LAS float* lg = scr + lane * 80; const int tok = task * 16 + lane;
            float gmax = -3.0e38f; int gsel = 0; float gl[8];
#pragma unroll
            for (int g = 0; g < 8; ++g) { gl[g] = lg[g] + p.moe_bg[layer * 8 + g]; if (gl[g] > gmax) { gmax = gl[g]; gsel = g; } }
            float gz = 0.f;
#pragma unroll
            for (int g = 0; g < 8; ++g) gz += expf(gl[g] - gmax);
            const float pg = 1.0f / gz;
            float f1 = -3.0e38f, f2 = -3.0e38f; int i1 = 0, i2 = 0;
            for (int q = 0; q < 8; ++q) { const float f = lg[8 + gsel * 8 + q] + p.moe_be[layer * 64 + gsel * 8 + q];
                if (f > f1) { f2 = f1; i2 = i1; f1 = f; i1 = q; } else if (f > f2) { f2 = f; i2 = q; } }
            const float e2 = expf(f2 - f1); const float g1v = pg / (1.0f + e2), g2v = pg * e2 / (1.0f + e2);
            const int ea = gsel * 8 + i1, eb = gsel * 8 + i2;
            const int pa = atomicAdd(&counters[ea], 1); list[(size_t)ea * LCAP + pa] = 2 * tok; gate[2 * tok] = g1v;
            const int pb = atomicAdd(&counters[eb], 1); list[(size_t)eb * LCAP + pb] = 2 * tok + 1; gate[2 * tok + 1] = g2v;
        }
        __builtin_amdgcn_wave_barrier(); asm volatile("s_waitcnt lgkmcnt(0)" ::: "memory");
    }
}
__device__ __forceinline__ void transpose_phase(const Params& p, LAS h16* T) {
    const h16* zt = (const h16*)(p.ws + WS_ZT); h16* z = (h16*)(p.ws + WS_HBUF); const int tid = tid_fresh();
    const int ntile = (D / 64) * (TT / 64);
    for (int tile = blockIdx.x; tile < ntile; tile += gridDim.x) {
        const int td = tile % (D / 64), tt = tile / (D / 64); const int d0 = td * 64, t0 = tt * 64;
        { const int dr = tid >> 3, tc = (tid & 7) * 8; const f16x8 v = *(const f16x8*)(zt + (size_t)(d0 + dr) * TT + t0 + tc);
#pragma unroll
            for (int i = 0; i < 8; ++i) T[(tc + i) * 66 + dr] = v[i]; }
        __syncthreads();
        { const int tr = tid >> 3, dc = (tid & 7) * 8; f16x8 v;
#pragma unroll
            for (int i = 0; i < 8; ++i) v[i] = T[tr * 66 + dc + i];
            *(f16x8*)(z + (size_t)(t0 + tr) * D + d0 + dc) = v; }
        __syncthreads();
    }
}

__device__ __forceinline__ f32x2 cmul(const f32x2 a, const f32x2 b) { return (f32x2){a.x * b.x - a.y * b.y, a.x * b.y + a.y * b.x}; }
__device__ __forceinline__ f32x2 cmulc(const f32x2 a, const f32x2 b) { return (f32x2){a.x * b.x + a.y * b.y, a.y * b.x - a.x * b.y}; }
__device__ __forceinline__ f32x2 cconj(const f32x2 a) { return (f32x2){a.x, -a.y}; }
template <bool INV> __device__ __forceinline__ f32x2 mul_mi(const f32x2 a) { return INV ? (f32x2){-a.y, a.x} : (f32x2){a.y, -a.x}; }
template <bool INV> __device__ __forceinline__ void dft4(f32x2& a, f32x2& b, f32x2& c, f32x2& d) {
    const f32x2 s0 = a + c, s1 = a - c, s2 = b + d, s3 = mul_mi<INV>(b - d);
    a = s0 + s2; b = s1 + s3; c = s0 - s2; d = s1 - s3;
}
template <bool INV, int M> __device__ __forceinline__ f32x2 w16mul(const f32x2 a) {
    constexpr float C1 = 0.92387953251128674f, S1 = 0.38268343236508977f, R = 0.70710678118654752f;
    constexpr float cr = (M == 0) ? 1.f : (M == 1) ? C1 : (M == 2) ? R : (M == 3) ? S1 : (M == 4) ? 0.f : (M == 6) ? -R :   -C1;
    constexpr float ci0 = (M == 0) ? 0.f : (M == 1) ? -S1 : (M == 2) ? -R : (M == 3) ? -C1 : (M == 4) ? -1.f : (M == 6) ? -R :   S1;
    constexpr float ci = INV ? -ci0 : ci0;
    return (f32x2){a.x * cr - a.y * ci, a.x * ci + a.y * cr};
}
template <bool INV> __device__ __forceinline__ void dft16(f32x2 (&v)[16]) {
#pragma unroll
    for (int n2 = 0; n2 < 4; ++n2) dft4<INV>(v[n2], v[4 + n2], v[8 + n2], v[12 + n2]);
    v[5] = w16mul<INV, 1>(v[5]); v[6] = w16mul<INV, 2>(v[6]); v[7] = w16mul<INV, 3>(v[7]);
    v[9] = w16mul<INV, 2>(v[9]); v[10] = w16mul<INV, 4>(v[10]); v[11] = w16mul<INV, 6>(v[11]);
    v[13] = w16mul<INV, 3>(v[13]); v[14] = w16mul<INV, 6>(v[14]); v[15] = w16mul<INV, 9>(v[15]);
#pragma unroll
    for (int k1 = 0; k1 < 4; ++k1) dft4<INV>(v[4 * k1], v[4 * k1 + 1], v[4 * k1 + 2], v[4 * k1 + 3]);
    f32x2 t;
    t = v[1]; v[1] = v[4]; v[4] = t; t = v[2]; v[2] = v[8]; v[8] = t; t = v[3]; v[3] = v[12]; v[12] = t;
    t = v[6]; v[6] = v[9]; v[9] = t; t = v[7]; v[7] = v[13]; v[13] = t; t = v[11]; v[11] = v[14]; v[14] = t;
}
__device__ __forceinline__ int fphys(int i) { return i + (i >> 4); }
__device__ __forceinline__ f32x2 w32c(int j) {
    constexpr float c[16] = {1.f, 0.98078528040323043f, 0.92387953251128674f, 0.83146961230254524f, 0.70710678118654752f, 0.55557023301960218f, 0.38268343236508977f, 0.19509032201612825f,
                             0.f, -0.19509032201612825f, -0.38268343236508977f, -0.55557023301960218f, -0.70710678118654752f, -0.83146961230254524f, -0.92387953251128674f, -0.98078528040323043f};
    constexpr float s[16] = {0.f, 0.19509032201612825f, 0.38268343236508977f, 0.55557023301960218f, 0.70710678118654752f, 0.83146961230254524f, 0.92387953251128674f, 0.98078528040323043f,
                             1.f, 0.98078528040323043f, 0.92387953251128674f, 0.83146961230254524f, 0.70710678118654752f, 0.55557023301960218f, 0.38268343236508977f, 0.19509032201612825f};
    return (f32x2){c[j], -s[j]};
}
__device__ __forceinline__ void fft_fwd0(const f32x2 (&xe)[16], const f32x2 (&xo)[16], LAS f32x2* E, LAS f32x2* O, int tau, const f32x2* tw) {
    const f32x2 u = tw[tau]; const f32x2 u2 = cmul(u, u);
    f32x2 y[16];
#pragma unroll
    for (int j = 0; j < 16; ++j) y[j] = xe[j];
    dft16<false>(y);
    f32x2 pw = u2; E[fphys(tau)] = y[0];
#pragma unroll
    for (int q = 1; q < 16; ++q) { E[fphys(tau + 256 * q)] = cmul(y[q], pw); pw = cmul(pw, u2); }
#pragma unroll
    for (int j = 0; j < 16; ++j) y[j] = cmul(xo[j], w32c(j));
    dft16<false>(y);
    pw = u;
#pragma unroll
    for (int q = 0; q < 16; ++q) { O[fphys(tau + 256 * q)] = cmul(y[q], pw); pw = cmul(pw, u2); }
}
template <bool INV> __device__ __forceinline__ void fft_pass1(LAS f32x2* A, int tau, const f32x2* tw) {
    const int i = tau & 15, base = (tau >> 4) << 8; const f32x2 u0 = tw[32 * i]; const f32x2 u = INV ? cconj(u0) : u0;
    f32x2 y[16];
#pragma unroll
    for (int j = 0; j < 16; ++j) y[j] = A[fphys(base + i + 16 * j)];
    if (INV) { f32x2 pw = u;
#pragma unroll
        for (int q = 1; q < 16; ++q) { y[q] = cmul(y[q], pw); pw = cmul(pw, u); } }
    dft16<INV>(y);
    if (!INV) { f32x2 pw = u;
#pragma unroll
        for (int q = 1; q < 16; ++q) { y[q] = cmul(y[q], pw); pw = cmul(pw, u); } }
#pragma unroll
    for (int j = 0; j < 16; ++j) A[fphys(base + i + 16 * j)] = y[j];
}
__device__ __forceinline__ void fft_fwd2(const LAS f32x2* A, int tau, f32x2 (&y)[16]) {
#pragma unroll
    for (int j = 0; j < 16; ++j) y[j] = A[17 * tau + j];
    dft16<false>(y);
}
__device__ __forceinline__ void fft_mid(LAS f32x2* A, int tau, const f32x2* kf) {
    f32x2 y[16]; f32x4 k[8];
#pragma unroll
    for (int j = 0; j < 8; ++j) k[j] = *(const f32x4*)(kf + 2 * j);
    fft_fwd2(A, tau, y);
#pragma unroll
    for (int j = 0; j < 8; ++j) { y[2 * j] = cmul(y[2 * j], (f32x2){k[j][0], k[j][1]}); y[2 * j + 1] = cmul(y[2 * j + 1], (f32x2){k[j][2], k[j][3]}); }
    dft16<true>(y);
#pragma unroll
    for (int j = 0; j < 16; ++j) A[17 * tau + j] = y[j];
}
__device__ __forceinline__ void fft_inv0(const LAS f32x2* E, const LAS f32x2* O, int tau, const f32x2* tw, f32x2 (&out)[16]) {
    const f32x2 u = tw[tau]; const f32x2 u2 = cmul(u, u);
    f32x2 y[16];
    f32x2 pw = u2; y[0] = E[fphys(tau)];
#pragma unroll
    for (int q = 1; q < 16; ++q) { y[q] = cmulc(E[fphys(tau + 256 * q)], pw); pw = cmul(pw, u2); }
    dft16<true>(y);
#pragma unroll
    for (int j = 0; j < 16; ++j) out[j] = y[j];
    pw = u;
#pragma unroll
    for (int q = 0; q < 16; ++q) { y[q] = cmulc(O[fphys(tau + 256 * q)], pw); pw = cmul(pw, u2); }
    dft16<true>(y);
#pragma unroll
    for (int j = 0; j < 16; ++j) out[j] += cmulc(y[j], w32c(j));
}

__device__ __forceinline__ void filt_fft_phase(const Params& p, LAS unsigned char* lds) {
    const int tid = tid_fresh(), grp = tid >> 8, tau = tid & 255;
    LAS f32x2* E = (LAS f32x2*)(lds + grp * 69632); LAS f32x2* O = E + 4352; LAS float* red = (LAS float*)(lds + LDS_MISC) + grp * 8;
    const f32x2* tw = (const f32x2*)(p.ws + WS_TW);
    const int nprob = 2 * 2 * 2 * 2048;
    for (int pb = blockIdx.x * 2 + grp; pb < nprob; pb += gridDim.x * 2) {
        const int d = pb & 2047, n = (pb >> 11) & 1, v = (pb >> 12) & 1, j = pb >> 13;
        const int Lv = v ? 256 : 4096;
        const float* tf = v ? (const float*)(p.ws + WS_TAPSC) + ((size_t)j * 8192 + (size_t)(n * 2 + 0) * D + d) * 256 : (const float*)(p.ws + WS_TAPS) + ((size_t)j * 8192 + (size_t)(n * 2 + 0) * D + d) * 4096;
        const float* tb = tf + (size_t)D * Lv;
        const float adel = fabsf(-3.0701134573253943f + (-15.350567286626973f + 3.0701134573253943f) * ((float)d / 2047.0f));
        const float tscale = 1.0f / (float)(Lv - 1);
        f32x2 xe[16], xo[16]; float ss = 0.f;
#pragma unroll
        for (int jj = 0; jj < 16; ++jj) { const int nn = tau + 256 * jj;
            float klo = 0.f, khi = 0.f;
            if (nn < Lv) klo = tf[nn] * expf(-(float)nn * tscale * adel);
            const int m = 4096 - nn;
            if (m >= 1 && m < Lv) khi = tb[m] * expf(-(float)m * tscale * adel);
            ss += klo * klo + khi * khi; xe[jj] = (f32x2){klo + khi, 0.f}; xo[jj] = (f32x2){klo - khi, 0.f}; }
        ss = wave_sum(ss);
        if ((tid & 63) == 0) red[(tid >> 6) & 3] = ss;
        fft_fwd0(xe, xo, E, O, tau, tw);
        __syncthreads();
        const float tot = red[0] + red[1] + red[2] + red[3];
        const float scale = (1.0f / sqrtf(tot + EPS)) * (1.0f / 8192.0f);
        const float hbs = p.hy_bias[((size_t)j * 2 + n) * D + d] * (1.0f / 8192.0f);
        fft_pass1<false>(E, tau, tw); fft_pass1<false>(O, tau, tw);
        __syncthreads();
        f32x2* kf = (f32x2*)(p.ws + WS_KF) + (size_t)pb * 8192 + (size_t)tau * 16;
        f32x2 y[16];
        fft_fwd2(E, tau, y);
#pragma unroll
        for (int q = 0; q < 8; ++q) *(f32x4*)(kf + 2 * q) = (f32x4){y[2 * q].x * scale + hbs, y[2 * q].y * scale, y[2 * q + 1].x * scale + hbs, y[2 * q + 1].y * scale};
        fft_fwd2(O, tau, y);
#pragma unroll
        for (int q = 0; q < 8; ++q) *(f32x4*)(kf + 4096 + 2 * q) = (f32x4){y[2 * q].x * scale + hbs, y[2 * q].y * scale, y[2 * q + 1].x * scale + hbs, y[2 * q + 1].y * scale};
        __syncthreads();
    }
}

__device__ __forceinline__ float conv3_ld(const h16* row, int n, int Lv, float w0, float w1, float w2, float b) {
    if (n >= Lv) return 0.f;
    const float um = n > 0 ? (float)row[n - 1] : 0.f, u0 = (float)row[n], up = n + 1 < Lv ? (float)row[n + 1] : 0.f;
    return um * w0 + u0 * w1 + up * w2 + b;
}
__device__ __forceinline__ void conv_phase(const Params& p, int jl, LAS unsigned char* lds) {
    const int tid = tid_fresh(), grp = tid >> 8, tau = tid & 255;
    LAS f32x2* E = (LAS f32x2*)(lds + grp * 69632); LAS f32x2* O = E + 4352;
    const f32x2* tw = (const f32x2*)(p.ws + WS_TW);
    const h16* ut = (const h16*)(p.ws + WS_UT); h16* zt = (h16*)(p.ws + WS_ZT);
    const float* cw = p.hy_conv_w + (size_t)jl * 3 * D3; const float* cb = p.hy_conv_b + (size_t)jl * D3;
    for (int unit = blockIdx.x; unit < 2 * 2048 * 2; unit += gridDim.x) {
        const int hq = unit & 1, d = (unit >> 1) & 2047, v = unit >> 12; const int Lv = v ? 256 : 4096;
        const int b0 = 4 * hq + 2 * grp; const size_t col0 = v ? (size_t)TL + (size_t)b0 * 256 : (size_t)b0 * 4096; const size_t col1 = col0 + Lv;
        const int jmax = v ? 1 : 16;
        const f32x2* kfb = (const f32x2*)(p.ws + WS_KF) + ((size_t)((jl * 2 + v) * 2) * 2048 + d) * 8192 + (size_t)tau * 16;
        f32x2 xin[16], y[16];
        { const h16* r0 = ut + (size_t)d * TT + col0; const h16* r1 = ut + (size_t)d * TT + col1; const float w0 = cw[d], w1 = cw[D3 + d], w2 = cw[2 * D3 + d], bb = cb[d];
#pragma unroll
            for (int jj = 0; jj < 16; ++jj) { const int nn = tau + 256 * jj; xin[jj] = (jj < jmax) ? (f32x2){conv3_ld(r0, nn, Lv, w0, w1, w2, bb), conv3_ld(r1, nn, Lv, w0, w1, w2, bb)} : (f32x2){0.f, 0.f}; } }
#pragma unroll 1
        for (int ord = 0; ord < 2; ++ord) {
            fft_fwd0(xin, xin, E, O, tau, tw);
            __syncthreads();
            fft_pass1<false>(E, tau, tw); fft_pass1<false>(O, tau, tw);
            __syncthreads();
            const f32x2* kf = kfb + (size_t)ord * 2048 * 8192;
            fft_mid(E, tau, kf); fft_mid(O, tau, kf + 4096);
            __syncthreads();
            fft_pass1<true>(E, tau, tw); fft_pass1<true>(O, tau, tw);
            __syncthreads();
            fft_inv0(E, O, tau, tw, y);
            const int cg = (ord == 0 ? D : 2 * D) + d; const h16* r0 = ut + (size_t)cg * TT + col0; const h16* r1 = ut + (size_t)cg * TT + col1;
            const float w0 = cw[cg], w1 = cw[D3 + cg], w2 = cw[2 * D3 + cg], bb = cb[cg];
#pragma unroll
            for (int jj = 0; jj < 16; ++jj) { const int nn = tau + 256 * jj;
                if (jj < jmax) { const float g0 = conv3_ld(r0, nn, Lv, w0, w1, w2, bb), g1 = conv3_ld(r1, nn, Lv, w0, w1, w2, bb);
                    xin[jj] = (f32x2){g0 * y[jj].x, g1 * y[jj].y}; } else xin[jj] = (f32x2){0.f, 0.f}; }
        }
        { h16* o0 = zt + (size_t)d * TT + col0; h16* o1 = zt + (size_t)d * TT + col1;
#pragma unroll
            for (int jj = 0; jj < 16; ++jj) { const int nn = tau + 256 * jj; if (jj < jmax && nn < Lv) { o0[nn] = (h16)xin[jj].x; o1[nn] = (h16)xin[jj].y; } } }
    }
}

constexpr int AT_KP = 72, AT_VP = 68;
__device__ __forceinline__ void attn_phase(const Params& p, int jl, bool with_ctx_out, LAS unsigned char* lds) {
    const int tid = tid_fresh(), wv = tid >> 6, lane = tid & 63, r32 = lane & 31, hh = lane >> 5;
    LAS h16* Ks = (LAS h16*)lds; LAS h16* Vs = (LAS h16*)(lds + 64 * AT_KP * 2);
    const h16* qk = (const h16*)(p.ws + WS_QK); const h16* vt = (const h16*)(p.ws + WS_VT); h16* ob = (h16*)(p.ws + WS_HBUF);
    const float* rcos = (const float*)(p.ws + WS_ROPE); const float* rsin = rcos + 1024;
    const int nunit = 2048 + (with_ctx_out ? 128 : 0);
    for (int unit = blockIdx.x; unit < nunit; unit += gridDim.x) {
        int kind, b, g, qb;
        if (unit < 2048) { kind = 0; qb = unit & 63; g = (unit >> 6) & 3; b = unit >> 8; } else { const int u2 = unit - 2048; kind = 1; qb = u2 & 3; g = (u2 >> 2) & 3; b = u2 >> 4; }
        const int head = g * 8 + wv;
        const int qrow0 = kind ? (TL + b * 256 + qb * 64) : (b * 4096 + qb * 64);
        const int ctxrow0 = TL + b * 256;
        f16x8 qf[2][4];
#pragma unroll
        for (int qt = 0; qt < 2; ++qt) {
            f32x4 qv[4][2];
            const h16* qp = qk + (size_t)(qrow0 + 32 * qt + r32) * DQK + head * 64 + 8 * hh;
#pragma unroll
            for (int ks = 0; ks < 4; ++ks) { const f16x8 t = *(const f16x8*)(qp + 16 * ks);
#pragma unroll
                for (int i = 0; i < 4; ++i) { qv[ks][0][i] = (float)t[i]; qv[ks][1][i] = (float)t[4 + i]; } }
            if (kind == 0) {
                const int colpos = 32 * qt + r32;
#pragma unroll
                for (int a = 0; a < 2; ++a) { const int pos = a ? colpos : qb; const float* cp = rcos + pos * 16 + 8 * hh; const float* sp = rsin + pos * 16 + 8 * hh;
#pragma unroll
                    for (int e = 0; e < 2; ++e) { const f32x4 c = *(const f32x4*)(cp + 4 * e), s = *(const f32x4*)(sp + 4 * e);
                        const f32x4 x1 = qv[2 * a][e], x2 = qv[2 * a + 1][e]; qv[2 * a][e] = x1 * c - x2 * s; qv[2 * a + 1][e] = x2 * c + x1 * s; } }
            }
#pragma unroll
            for (int ks = 0; ks < 4; ++ks)
#pragma unroll
                for (int i = 0; i < 4; ++i) { qf[qt][ks][i] = (h16)(qv[ks][0][i] * 0.125f); qf[qt][ks][4 + i] = (h16)(qv[ks][1][i] * 0.125f); }
        }
        const float sink = p.at_sink[jl * 32 + head] * 1.4426950408889634f;
        float mrun[2] = {sink, sink}, lrun[2] = {hh == 0 ? 1.f : 0.f, hh == 0 ? 1.f : 0.f};
        f32x16 oacc[2][2];
#pragma unroll
        for (int a = 0; a < 2; ++a)
#pragma unroll
            for (int c = 0; c < 2; ++c)
#pragma unroll
                for (int i = 0; i < 16; ++i) oacc[a][c][i] = 0.f;
        const int ntile = kind ? 4 : 9;
#pragma unroll 1
        for (int ti = 0; ti < ntile; ++ti) {
            int krow0, mask = 0; bool rope = false;
            if (kind == 0 && ti < 5) { const int k0 = qb * 64 - 128 + 64 * ti; if (k0 < 0 || k0 >= SEQ) continue; krow0 = b * 4096 + k0; rope = true; mask = (ti == 0) ? 1 : (ti == 4) ? 2 : 0; }
            else { const int c = kind ? ti : ti - 5; krow0 = ctxrow0 + 64 * c; }
            __syncthreads();
            if (tid < 256) {
                const int key = tid >> 2, cp = tid & 3, dA = (cp & 1) * 8 + (cp >> 1) * 32;
                const h16* kp = qk + (size_t)(krow0 + key) * DQK + D + g * 64 + dA;
                const f16x8 t1 = *(const f16x8*)kp, t2 = *(const f16x8*)(kp + 16);
                f16x8 o1 = t1, o2 = t2;
                if (rope) { const int kpos = (krow0 - b * 4096) + key; const int pos = (cp >> 1) ? (kpos & 63) : (kpos >> 6);
                    const float* cpp = rcos + pos * 16 + (cp & 1) * 8; const float* spp = rsin + pos * 16 + (cp & 1) * 8;
#pragma unroll
                    for (int i = 0; i < 8; ++i) { const float c = cpp[i], s = spp[i], x1 = (float)t1[i], x2 = (float)t2[i]; o1[i] = (h16)(x1 * c - x2 * s); o2[i] = (h16)(x2 * c + x1 * s); } }
                *(LAS f16x8*)(Ks + key * AT_KP + dA) = o1; *(LAS f16x8*)(Ks + key * AT_KP + dA + 16) = o2;
            } else {
                const int t = tid - 256, dim = t >> 2, kc = t & 3;
                const h16* vp = vt + (size_t)(g * 64 + dim) * TT + krow0 + 16 * kc;
                const f16x8 a = *(const f16x8*)vp, c = *(const f16x8*)(vp + 8);
                LAS h16* dst = Vs + dim * AT_VP + 16 * kc;
                *(LAS f16x4*)(dst) = (f16x4){a[0], a[1], a[2], a[3]}; *(LAS f16x4*)(dst + 4) = (f16x4){a[4], a[5], a[6], a[7]};
                *(LAS f16x4*)(dst + 8) = (f16x4){c[0], c[1], c[2], c[3]}; *(LAS f16x4*)(dst + 12) = (f16x4){c[4], c[5], c[6], c[7]};
            }
            __syncthreads();
#pragma unroll
            for (int qt = 0; qt < 2; ++qt) {
                f32x16 sacc[2];
#pragma unroll
                for (int kt = 0; kt < 2; ++kt)
#pragma unroll
                    for (int i = 0; i < 16; ++i) sacc[kt][i] = 0.f;
#pragma unroll
                for (int ks = 0; ks < 4; ++ks)
#pragma unroll
                    for (int kt = 0; kt < 2; ++kt) { const f16x8 kf = *(const LAS f16x8*)(Ks + (32 * kt + r32) * AT_KP + 16 * ks + 8 * hh);
                        sacc[kt] = __builtin_amdgcn_mfma_f32_32x32x16_f16(kf, qf[qt][ks], sacc[kt], 0, 0, 0); }
                const int qq = 32 * qt + r32; float tmax = -3.0e38f;
#pragma unroll
                for (int kt = 0; kt < 2; ++kt)
#pragma unroll
                    for (int i = 0; i < 16; ++i) { float s = sacc[kt][i] * 1.4426950408889634f; const int kk = 32 * kt + (i & 3) + 8 * (i >> 2) + 4 * hh;
                        if (mask == 1 && kk < qq) s = -1.0e30f; if (mask == 2 && kk > qq) s = -1.0e30f;
                        sacc[kt][i] = s; tmax = fmaxf(tmax, s); }
                tmax = fmaxf(tmax, shx(tmax, 32));
                const float mnew = fmaxf(mrun[qt], tmax); const float alpha = __builtin_amdgcn_exp2f(mrun[qt] - mnew); mrun[qt] = mnew;
                float psum = 0.f; f16x8 pf[2][2];
#pragma unroll
                for (int kt = 0; kt < 2; ++kt)
#pragma unroll
                    for (int s2 = 0; s2 < 2; ++s2)
#pragma unroll
                        for (int jj = 0; jj < 8; ++jj) { const float pv = __builtin_amdgcn_exp2f(sacc[kt][8 * s2 + jj] - mnew); psum += pv; pf[kt][s2][jj] = (h16)pv; }
                lrun[qt] = lrun[qt] * alpha + psum;
#pragma unroll
                for (int dt = 0; dt < 2; ++dt)
#pragma unroll
                    for (int i = 0; i < 16; ++i) oacc[dt][qt][i] *= alpha;
#pragma unroll
                for (int kt = 0; kt < 2; ++kt)
#pragma unroll
                    for (int s2 = 0; s2 < 2; ++s2)
#pragma unroll
                        for (int dt = 0; dt < 2; ++dt) { const LAS h16* vr = Vs + (32 * dt + r32) * AT_VP + 32 * kt + 16 * s2 + 4 * hh;
                            const f16x4 v0 = *(const LAS f16x4*)vr, v1 = *(const LAS f16x4*)(vr + 8);
                            const f16x8 vf = (f16x8){v0[0], v0[1], v0[2], v0[3], v1[0], v1[1], v1[2], v1[3]};
                            oacc[dt][qt] = __builtin_amdgcn_mfma_f32_32x32x16_f16(vf, pf[kt][s2], oacc[dt][qt], 0, 0, 0); }
            }
        }
#pragma unroll
        for (int qt = 0; qt < 2; ++qt) {
            const float ltot = lrun[qt] + shx(lrun[qt], 32); const float inv = 1.0f / ltot;
            h16* op = ob + (size_t)(qrow0 + 32 * qt + r32) * D + head * 64 + 4 * hh;
#pragma unroll
            for (int dt = 0; dt < 2; ++dt)
#pragma unroll
                for (int q4 = 0; q4 < 4; ++q4) { f16x4 w;
#pragma unroll
                    for (int i = 0; i < 4; ++i) w[i] = (h16)(oacc[dt][qt][4 * q4 + i] * inv);
                    *(f16x4*)(op + 32 * dt + 8 * q4) = w; }
        }
    }
}

constexpr int NPHASE = 35;
#ifndef MK_MULTI
#define MK_MULTI 0
#endif

template <int KIND>
__global__ void __launch_bounds__(512, 2) hy_fwd(Params p_) {
    extern __shared__ __attribute__((aligned(16))) unsigned char shm[];
    LAS unsigned char* lds = (LAS unsigned char*)shm;
    constexpr bool ALL = KIND < 0;
    const int ph0 = p_.ph0;
    if (threadIdx.x == 0) { *(LAS u32x4*)(lds + LDS_XB) = (u32x4){0u, 0u, 0u, 0u}; }
    __syncthreads();
    XcdBarrier bar;
    if constexpr (ALL) bar = xcd_barrier_post((unsigned*)(p_.ws + WS_CTL), (volatile LAS unsigned*)(lds + LDS_XB));
#define SITE(k) if constexpr (ALL || KIND == (k)) if (const Params& p = *params_fresh(); true)
#define SEAM() do { if constexpr (ALL) xcd_barrier(bar); } while (0)
    const int G = gridDim.x, bid = blockIdx.x;
    SITE(0) {
        for (int u = bid; u < 20353; u += G) {
            if (u < 384) modp_unit(p, u, (LAS float*)lds);
            else if (u == 384) tables_unit(p);
            else if (u < 1473) h2_task(p, (u - 385) * 8 + (tid_fresh() >> 6));
            else if (u < 1537) w3p_unit(p, u - 1473);
            else if (u < 1793) rtab_unit(p, u - 1537);
            else if (u < 4993) cvt_dense_unit(p, u - 1793, (LAS float*)lds);
            else cvt_moe_unit(p, 0, u - 4993, (LAS float*)lds);
        }
        SEAM();
    }
    SITE(1) {
        for (int u = bid; u < 216; u += G) modr_unit(p, u);
        SchedFilt S{p.ws + WS_W3P, p.ws + WS_H2P}; EpiTaps E{(float*)(p.ws + WS_TAPS), (float*)(p.ws + WS_TAPSC)};
        pg8::gemm_phase<EpiTaps, SchedFilt, false>(lds, 256, S, E);
        SEAM();
    }
#pragma unroll 1
    for (int layer = ALL ? 0 : ph0; layer < (ALL ? NLAYER : ph0 + 1); ++layer) {
        const bool hyena = (layer & 1) == 0; const int jl = layer >> 1;
        SITE(2) {
            n1_phase(p, layer);
            if (layer == 0) filt_fft_phase(p, lds);
            else { for (int u = bid; u < CVT_MOE_UNITS; u += G) cvt_moe_unit(p, layer, u, (LAS float*)lds); }
            SEAM();
        }
        SITE(3) {
            if (hyena) { SchedPlain S{24, 136, D, p.ws + WS_WIN + (size_t)jl * D3 * D * 2, p.ws + WS_HBUF}; EpiH16 E{(h16*)(p.ws + WS_UT), TT, nullptr, 0};
                pg8::gemm_phase<EpiH16, SchedPlain, false>(lds, D, S, E); }
            else { SchedQkv S{p.ws + WS_HBUF, p.ws + WS_WQKV + (size_t)jl * DQKV * D * 2}; EpiH16 E{(h16*)(p.ws + WS_QK), DQK, (h16*)(p.ws + WS_VT), TT};
                pg8::gemm_phase<EpiH16, SchedQkv, false>(lds, D, S, E); }
            SEAM();
        }
        SITE(4) {
            if (hyena) conv_phase(p, jl, lds);
            else attn_phase(p, jl, layer != NLAYER - 1, lds);
            SEAM();
        }
        SITE(5) {
            if (hyena) { transpose_phase(p, (LAS h16*)lds); SEAM(); }
        }
        SITE(6) {
            SchedPlain S{136, 8, D, p.ws + WS_HBUF, hyena ? p.ws + WS_WOUT + (size_t)jl * D * D * 2 : p.ws + WS_WO + (size_t)jl * D * D * 2};
            EpiResid E{(float*)(p.ws + WS_XRES), (const float*)(p.ws + WS_MODS), layer};
            pg8::gemm_phase<EpiResid, SchedPlain, false>(lds, D, S, E);
            SEAM();
        }
        SITE(7) { n2_phase(p, layer, (LAS float*)lds); SEAM(); }
        LAS int* tstart = (LAS int*)(lds + LDS_MISC); LAS int* texp = tstart + 80; LAS int* tcnt = texp + 352;
        SITE(8) {
            moe_table(tstart, texp, tcnt, (const int*)(p.ws + WS_CTL) + CTL_CNT + layer * NE);
            SchedMoe1 S{{tstart, texp, tcnt}, p.ws + WS_HBUF, p.ws + WS_W13, (const int*)(p.ws + WS_LIST)}; EpiMoe1 E{(h16*)(p.ws + WS_H1)};
            pg8::gemm_phase<EpiMoe1, SchedMoe1, true>(lds, D, S, E);
            SEAM();
        }
        SITE(9) {
            moe_table(tstart, texp, tcnt, (const int*)(p.ws + WS_CTL) + CTL_CNT + layer * NE);
            SchedMoe2 S{{tstart, texp, tcnt}, p.ws + WS_H1, p.ws + WS_W2, (const int*)(p.ws + WS_LIST)}; EpiMoe2 E{(h16*)(p.ws + WS_YC), (const float*)(p.ws + WS_GATE)};
            pg8::gemm_phase<EpiMoe2, SchedMoe2, false>(lds, DE, S, E);
            SEAM();
        }
    }
    SITE(10) final_phase(p);
#undef SITE
#undef SEAM
}

template <int KIND> static void launch_kind(const Params& p, int grid, hipStream_t stream) {
    static bool attr = false;
    if (!attr) { attr = true; if (hipFuncSetAttribute((const void*)hy_fwd<KIND>, hipFuncAttributeMaxDynamicSharedMemorySize, LDS_BYTES) != hipSuccess) fprintf(stderr, "kernel_launch: hipFuncSetAttribute failed (kind %d)\n", KIND); }
    hipLaunchKernelGGL(hy_fwd<KIND>, dim3(grid), dim3(512), LDS_BYTES, stream, p);
}

extern "C" void kernel_launch(void* const* d_in, const int* in_sizes, int n_in, void* d_out, int out_size, void* d_ws, size_t ws_size, hipStream_t stream) {
    static int grid = 0;
    if (!grid) {
        if (n_in != 29 || out_size != TL * D || ws_size < WS_END) { fprintf(stderr, "kernel_launch: unexpected problem (n_in %d, out %d, ws %zu < %zu)\n", n_in, out_size, ws_size, (size_t)WS_END); grid = -1; return; }
        int dev = 0, cus = 0;
        if (hipGetDevice(&dev) != hipSuccess || hipDeviceGetAttribute(&cus, hipDeviceAttributeMultiprocessorCount, dev) != hipSuccess) { grid = -1; return; }
        grid = cus;
    }
    if (grid <= 0) return;
    (void)hipMemsetAsync((char*)d_ws + WS_CTL, 0, CTL_BYTES, stream);
    Params p{};
    const float** pp = (const float**)&p;
    for (int i = 0; i < 29; ++i) pp[i] = (const float*)d_in[i];
    p.out = (float*)d_out; p.ws = (char*)d_ws;
#if MK_MULTI
    p.ph0 = 0; p.ph1 = 0;
    launch_kind<0>(p, grid, stream); launch_kind<1>(p, grid, stream);
    for (int layer = 0; layer < NLAYER; ++layer) { p.ph0 = layer;
        launch_kind<2>(p, grid, stream); launch_kind<3>(p, grid, stream); launch_kind<4>(p, grid, stream);
        if ((layer & 1) == 0) launch_kind<5>(p, grid, stream);
        launch_kind<6>(p, grid, stream); launch_kind<7>(p, grid, stream); launch_kind<8>(p, grid, stream); launch_kind<9>(p, grid, stream); }
    p.ph0 = 0; launch_kind<10>(p, grid, stream);
#else
    p.ph0 = 0; p.ph1 = NPHASE;
    launch_kind<-1>(p, grid, stream);
#endif
}
```

```cpp
#include <hip/hip_runtime.h>
#include <cstdio>
#include <cstdint>

#define LAS __attribute__((address_space(3)))
typedef _Float16 h16;
typedef _Float16 f16x8 __attribute__((ext_vector_type(8)));
typedef _Float16 f16x4 __attribute__((ext_vector_type(4)));
typedef _Float16 f16x2 __attribute__((ext_vector_type(2)));
typedef float f32x2 __attribute__((ext_vector_type(2)));
typedef float f32x4 __attribute__((ext_vector_type(4)));
typedef float f32x16 __attribute__((ext_vector_type(16)));
typedef unsigned u32x2 __attribute__((ext_vector_type(2)));
typedef unsigned u32x4 __attribute__((ext_vector_type(4)));

constexpr int D = 2048, NB = 8, SEQ = 4096, CTXL = 256, TL = NB * SEQ, TC = NB * CTXL, TT = TL + TC;
constexpr int D3 = 3 * D, D6 = 6 * D, DQK = 2304, DQKV = 2560, NE = 64, DE = 384, DE2 = 768, NLAYER = 4;
constexpr int LCAP = TT;
constexpr int MOE_ROWS = 86016;
constexpr float EPS = 1e-6f;

constexpr size_t WS_CTL = 0;
constexpr size_t CTL_BYTES = 65536;
constexpr size_t WS_TW = WS_CTL + CTL_BYTES;
constexpr size_t WS_ROPE = WS_TW + 65536;
constexpr size_t WS_MODP = WS_ROPE + 8192;
constexpr size_t WS_MODS = WS_MODP + 16ull * 4 * 9 * 12288 * 4;
constexpr size_t WS_RTAB = WS_MODS + 4ull * 9 * 12288 * 4;
constexpr size_t RTAB_L = 64ull * 5 * 2 * 64 * 8 * 2;
constexpr size_t WS_RCST = WS_RTAB + 4 * RTAB_L;
constexpr size_t WS_H2P = WS_RCST + 16384;
constexpr size_t WS_W3P = WS_H2P + 2ull * 4352 * 256 * 2;
constexpr size_t WS_XRES = WS_W3P + 2ull * 8192 * 256 * 2;
constexpr size_t WS_HBUF = WS_XRES + (size_t)TT * D * 4;
constexpr size_t WS_UT = WS_HBUF + (size_t)TT * D * 2;
constexpr size_t UT_BYTES = (size_t)D3 * TT * 2;
constexpr size_t WS_TAPS = WS_UT;
constexpr size_t WS_TAPSC = WS_TAPS + 2ull * 8192 * 4096 * 4;
constexpr size_t WS_QK = WS_UT;
constexpr size_t WS_VT = WS_QK + (size_t)TT * DQK * 2;
constexpr size_t WS_ZT = WS_UT + UT_BYTES;
constexpr size_t WS_H1 = WS_ZT + (size_t)D * TT * 2;
constexpr size_t WS_YC = WS_H1 + (size_t)MOE_ROWS * DE * 2;
constexpr size_t WS_WIN = WS_YC + 2ull * TT * D * 2;
constexpr size_t WS_WOUT = WS_WIN + 2ull * D3 * D * 2;
constexpr size_t WS_WQKV = WS_WOUT + 2ull * D * D * 2;
constexpr size_t WS_WO = WS_WQKV + 2ull * DQKV * D * 2;
constexpr size_t WS_W13 = WS_WO + 2ull * D * D * 2;
constexpr size_t WS_W2 = WS_W13 + (size_t)NE * DE2 * D * 2;
constexpr size_t WS_KF = WS_W2 + (size_t)NE * D * DE * 2;
constexpr size_t WS_KFC = WS_KF + 2ull * 2 * 2048 * 65536;
constexpr size_t WS_LIST = WS_KFC + 2ull * 2 * 2048 * 4096;
constexpr size_t WS_GATE = WS_LIST + (size_t)NE * LCAP * 4;
constexpr size_t WS_SSQ = WS_GATE + (size_t)NE * LCAP * 4;
constexpr size_t WS_END = WS_SSQ + (size_t)TT * 32 * 4;
static_assert(WS_TAPSC + 2ull * 8192 * 256 * 4 <= WS_UT + UT_BYTES, "taps alias");
static_assert(WS_VT + 256ull * TT * 2 <= WS_UT + UT_BYTES, "qkv alias");

constexpr int CTL_CNT = 4096;

constexpr int LDS_BYTES = 147456;
constexpr int LDS_MISC = 139264;
constexpr int LDS_XB = LDS_BYTES - 16;

struct Params {
    const float *x, *c, *ctx, *c_ctx, *mod_w, *mod_b, *hy_w_in, *hy_conv_w, *hy_conv_b, *hy_f_w1, *hy_f_b1, *hy_f_freq1, *hy_f_w2, *hy_f_b2, *hy_f_freq2, *hy_f_w3,
        *hy_bias, *hy_w_out, *at_w_qkv, *at_sink, *at_w_o, *moe_wg, *moe_bg, *moe_we, *moe_be, *moe_w1, *moe_w3, *moe_w2, *final_gain;
    float* out; char* ws; int ph0, ph1;
};

__device__ __forceinline__ int tid_fresh() { int t = threadIdx.x; asm volatile("" : "+v"(t)); return t; }
__device__ __forceinline__ float bperm_f(float v, int srclane) { return __int_as_float(__builtin_amdgcn_ds_bpermute(srclane << 2, __float_as_int(v))); }
__device__ __forceinline__ float shx(float v, int mask) { return bperm_f(v, (tid_fresh() & 63) ^ mask); }
__device__ __forceinline__ const Params* params_fresh() { auto q = __builtin_amdgcn_kernarg_segment_ptr(); asm volatile("" : "+s"(q)); return (const Params*)q; }

#define XB_TMO      128
#define XB_XCNT(j)  (256  + 64 * (j))
#define XB_XSUB(j)  (1280 + 64 * (j))
#define XB_XGEN(j)  (2304 + 64 * (j))
#define XB_TOP      3328
#define XB_TOPGEN   3392
#define XCD_BAR_WORDS 3456
#define XB_SPIN_CAP (1u << 18)

__device__ __forceinline__ unsigned xb_ld(unsigned* p)              { return __hip_atomic_load(p, __ATOMIC_RELAXED, __HIP_MEMORY_SCOPE_AGENT); }
__device__ __forceinline__ unsigned xb_add(unsigned* p, unsigned v) { return __hip_atomic_fetch_add(p, v, __ATOMIC_RELAXED, __HIP_MEMORY_SCOPE_AGENT); }
__device__ __forceinline__ unsigned xb_xcc_id() { return (unsigned)__builtin_amdgcn_s_getreg((3 << 11) | 20) & 0xFu; }
#define XB_SPIN(cond, bar) do { unsigned _sp = 0; while (cond) { __builtin_amdgcn_s_sleep(1); \
    if ((++_sp & 255u) == 0u) { if (xb_ld(&(bar)[XB_TMO])) break; if (_sp > XB_SPIN_CAP) { atomicAdd(&(bar)[XB_TMO], 1u); break; } } } } while (0)

struct XcdBarrier { unsigned* bar; volatile LAS unsigned* st; };

__device__ __forceinline__ XcdBarrier xcd_barrier_post(unsigned* bar, volatile LAS unsigned* st) {
    XcdBarrier b; b.bar = bar; b.st = st;
    if (threadIdx.x == 0) (void)xb_add(&bar[XB_XCNT(xb_xcc_id())], 1u);
    return b;
}
__device__ __forceinline__ void xcd_barrier_complete(unsigned* bar, unsigned x, unsigned& nloc, unsigned& nx) {
    const unsigned G = gridDim.x * gridDim.y * gridDim.z;
    unsigned sum, cnt, mine, sp = 0u;
    for (;;) {
        sum = 0u; cnt = 0u; mine = 0u;
#pragma unroll
        for (unsigned j = 0; j < 16; ++j) { const unsigned c = xb_ld(&bar[XB_XCNT(j)]); sum += c; cnt += (c > 0u) ? 1u : 0u; mine = (j == x) ? c : mine; }
        if (sum == G) break;
        __builtin_amdgcn_s_sleep(1);
        if ((++sp & 255u) == 0u) { if (xb_ld(&bar[XB_TMO])) break; if (sp > XB_SPIN_CAP) { atomicAdd(&bar[XB_TMO], 1u); break; } }
    }
    nloc = mine > 0u ? mine : 1u; nx = cnt > 0u ? cnt : 1u;
}
__device__ __forceinline__ void xcd_barrier(const XcdBarrier& b) {
    asm volatile("s_waitcnt vmcnt(0)" ::: "memory");
    __syncthreads();
    if (threadIdx.x == 0) {
        unsigned* bar = b.bar; const unsigned bx = xb_xcc_id();
        __builtin_amdgcn_s_waitcnt(0);
        unsigned nloc = b.st[0], nx = b.st[1];
        if (nloc == 0u) { xcd_barrier_complete(bar, bx, nloc, nx); b.st[0] = nloc; b.st[1] = nx; }
        const unsigned old = xb_add(&bar[XB_XSUB(bx)], 1u);
        const unsigned gen = old / nloc;
        if (old + 1u == (gen + 1u) * nloc) {
            __builtin_amdgcn_fence(__ATOMIC_RELEASE, "agent");
            asm volatile("s_waitcnt vmcnt(0)" ::: "memory");
            const unsigned og = xb_add(&bar[XB_TOP], 1u);
            const unsigned tg = og / nx;
            if (og + 1u == (tg + 1u) * nx) xb_add(&bar[XB_TOPGEN], 1u);
            else XB_SPIN(xb_ld(&bar[XB_TOPGEN]) == tg, bar);
            __builtin_amdgcn_fence(__ATOMIC_ACQUIRE, "agent");
            xb_add(&bar[XB_XGEN(bx)], 1u);
            asm volatile("s_waitcnt vmcnt(0)" ::: "memory");
        } else {
            XB_SPIN(xb_ld(&bar[XB_XGEN(bx)]) == gen, bar);
            __builtin_amdgcn_fence(__ATOMIC_ACQUIRE, "agent");
            asm volatile("s_waitcnt vmcnt(0)" ::: "memory");
        }
    }
    __syncthreads();
}

namespace pg8 {
constexpr int BM = 256, BK = 64, HALF = 128, HTB = HALF * BK * 2, STAGE_BYTES = 8 * HTB;
__device__ __forceinline__ int lds_byte(int r, int c) { const int st = (r >> 4) * 2 + (c >> 5), rr = r & 15, cc = c & 31, ob = rr * 64 + cc * 2; return st * 1024 + (ob ^ (((ob >> 9) & 1) << 5)); }
__device__ __forceinline__ void stage_rc(int b, int& R, int& C) { const int st = b / 1024, sb = b % 1024, swz = sb ^ (((sb >> 9) & 1) << 5); R = (st >> 1) * 16 + swz / 64; C = (st & 1) * 32 + (swz % 64) / 2; }
__device__ __forceinline__ int perm32(int rho) { const int n = rho >> 4, i = rho & 15; return 8 * (i >> 2) + 4 * n + (i & 3); }

struct Unit {
    int pm, pn;
    int e, pos0, cnt;
    int kind;
    const char* A; const char* B;
    const int* rows;
};

template <class Epi, class Sched, bool GATHER>
__device__ __forceinline__ void gemm_phase(LAS unsigned char* lds, const int K, const Sched& S, const Epi& E) {
    const int tid = tid_fresh(), wid = __builtin_amdgcn_readfirstlane(tid >> 6), lane = tid & 63, wr = wid >> 2, wc = wid & 3, fr = lane & 15, fq = lane >> 4;
    const int nt = K / BK;
    unsigned voffA[2], voffB[2]; int RA[2], CA[2];
#pragma unroll
    for (int i = 0; i < 2; ++i) { int R, C; stage_rc(tid * 16 + i * 8192, R, C); const int Rb = Epi::PERM ? ((R & ~31) + perm32(R & 31)) : R;
        voffA[i] = (unsigned)(R * K + C) * 2u; voffB[i] = (unsigned)(Rb * K + C) * 2u; RA[i] = R; CA[i] = C; }
    const size_t kstep = (size_t)(BK * 2);
    const size_t hstep = (size_t)HALF * K * 2;
    const unsigned ldsw = (unsigned)wid * 1024u;
    const int aoff = lds_byte(wr * 64 + fr, fq * 8), boff = lds_byte(wc * 32 + fr, fq * 8);
    unsigned vgC[2][2], vgN[2][2];
#define PG8_ROWS(u, vg) do { if constexpr (GATHER) { _Pragma("unroll") for (int _h = 0; _h < 2; ++_h) _Pragma("unroll") for (int _i = 0; _i < 2; ++_i) { \
        const int _p = (u).pos0 + _h * HALF + RA[_i]; const int _tok = (_p < (u).cnt) ? ((u).rows[_h * HALF + RA[_i]] >> 1) : 0; \
        vg[_h][_i] = ((unsigned)_tok * (unsigned)K + (unsigned)CA[_i]) * 2u; } } } while (0)
#define PG8_SA(b, h) (((b) * 2 + (h)) * HTB)
#define PG8_SB(b, h) ((4 + (b) * 2 + (h)) * HTB)
#define PG8_STAGE_B(bufoff, gbase) do { _Pragma("unroll") for (int _i = 0; _i < 2; ++_i) \
        __builtin_amdgcn_global_load_lds((const unsigned*)((const char*)(gbase) + voffB[_i]), (LAS unsigned*)(lds + (bufoff) + ldsw + _i * 8192), 16, 0, 0); } while (0)
#define PG8_STAGE_A(bufoff, gbase, h, NEXT) do { _Pragma("unroll") for (int _i = 0; _i < 2; ++_i) { \
        const unsigned _vo = GATHER ? ((NEXT) ? vgN[h][_i] : vgC[h][_i]) : voffA[_i]; \
        __builtin_amdgcn_global_load_lds((const unsigned*)((const char*)(gbase) + (GATHER ? (size_t)0 : (size_t)(h) * hstep) + _vo), (LAS unsigned*)(lds + (bufoff) + ldsw + _i * 8192), 16, 0, 0); } } while (0)
#define PG8_LDA(dst, b, h) do { _Pragma("unroll") for (int m = 0; m < 4; ++m) _Pragma("unroll") for (int k = 0; k < 2; ++k) dst[m][k] = *(const LAS f16x8*)(lds + PG8_SA(b, h) + aoff + m * 2048 + k * 1024); } while (0)
#define PG8_LDB(dst, b, h) do { _Pragma("unroll") for (int n = 0; n < 2; ++n) _Pragma("unroll") for (int k = 0; k < 2; ++k) dst[n][k] = *(const LAS f16x8*)(lds + PG8_SB(b, h) + boff + n * 2048 + k * 1024); } while (0)
#define PG8_MMA(ai, bj, At, Bt) do { __builtin_amdgcn_s_setprio(1); _Pragma("unroll") for (int m = 0; m < 4; ++m) _Pragma("unroll") for (int n = 0; n < 2; ++n) _Pragma("unroll") for (int k = 0; k < 2; ++k) \
        acc[ai][bj][m][n] = __builtin_amdgcn_mfma_f32_16x16x32_f16(Bt[n][k], At[m][k], acc[ai][bj][m][n], 0, 0, 0); __builtin_amdgcn_s_setprio(0); } while (0)
#define PG8_WAIT_V(n) asm volatile("s_waitcnt vmcnt(" #n ")" ::: "memory")
#define PG8_WAIT_L(n) asm volatile("s_waitcnt lgkmcnt(" #n ")" ::: "memory")
#define PG8_BAR __builtin_amdgcn_s_barrier()
#define PG8_SCHED __builtin_amdgcn_sched_barrier(0)
    Unit cur, nxt; int ui = 0;
    if (!S.next(0, cur)) return;
    f32x4 acc[2][2][4][2];
#pragma unroll
    for (int a = 0; a < 2; ++a)
#pragma unroll
        for (int b = 0; b < 2; ++b)
#pragma unroll
            for (int m = 0; m < 4; ++m)
#pragma unroll
                for (int n = 0; n < 2; ++n) acc[a][b][m][n] = (f32x4){0.f, 0.f, 0.f, 0.f};
    f16x8 At[4][2], B0[2][2], B1[2][2];
    const char* cA = cur.A; const char* cB = cur.B;
    PG8_ROWS(cur, vgC);
#pragma unroll
    for (int _h = 0; _h < 2; ++_h)
#pragma unroll
        for (int _i = 0; _i < 2; ++_i) vgN[_h][_i] = GATHER ? vgC[_h][_i] : 0u;
    PG8_STAGE_B(PG8_SB(0, 0), cB); PG8_STAGE_B(PG8_SB(0, 1), cB + hstep); PG8_STAGE_A(PG8_SA(0, 0), cA, 0, false); PG8_STAGE_A(PG8_SA(0, 1), cA, 1, false);
    if (wr == 1) PG8_BAR;
    PG8_WAIT_V(2); PG8_BAR;
    PG8_STAGE_B(PG8_SB(1, 0), cB + kstep); PG8_STAGE_A(PG8_SA(1, 0), cA + kstep, 0, false); PG8_STAGE_B(PG8_SB(1, 1), cB + hstep + kstep);
    PG8_WAIT_V(6); PG8_BAR;
    for (;;) {
        const bool has_next = S.next(ui + 1, nxt);
        const char* nA = has_next ? nxt.A : cA; const char* nB = has_next ? nxt.B : cB;
        if (has_next) { PG8_ROWS(nxt, vgN); }
#pragma unroll 1
        for (int t = 0; t < nt; t += 2) {
            const bool last = (t == nt - 2);
            const char* a1 = cA + (size_t)(t + 1) * kstep;
            const char* a2 = last ? nA : cA + (size_t)(t + 2) * kstep; const char* b2 = last ? nB : cB + (size_t)(t + 2) * kstep;
            const char* a3 = a2 + kstep; const char* b3 = b2 + kstep;
            PG8_LDB(B0, 0, 0); PG8_LDB(B1, 0, 1); PG8_SCHED; PG8_LDA(At, 0, 0); PG8_STAGE_A(PG8_SA(1, 1), a1, 1, false);
            PG8_WAIT_V(8); PG8_WAIT_L(0); PG8_BAR; PG8_MMA(0, 0, At, B0); PG8_MMA(0, 1, At, B1); PG8_BAR; PG8_SCHED;
            PG8_LDA(At, 0, 1); PG8_STAGE_B(PG8_SB(0, 0), b2); PG8_STAGE_B(PG8_SB(0, 1), b2 + hstep); PG8_STAGE_A(PG8_SA(0, 0), a2, 0, last);
            PG8_WAIT_V(8); PG8_WAIT_L(0); PG8_BAR; PG8_MMA(1, 0, At, B0); PG8_MMA(1, 1, At, B1); PG8_BAR; PG8_SCHED;
            PG8_LDB(B0, 1, 0); PG8_LDB(B1, 1, 1); PG8_SCHED; PG8_LDA(At, 1, 0); PG8_STAGE_A(PG8_SA(0, 1), a2, 1, last);
            PG8_WAIT_V(8); PG8_WAIT_L(0); PG8_BAR; PG8_MMA(0, 0, At, B0); PG8_MMA(0, 1, At, B1); PG8_BAR; PG8_SCHED;
            PG8_LDA(At, 1, 1); PG8_STAGE_B(PG8_SB(1, 0), b3); PG8_STAGE_B(PG8_SB(1, 1), b3 + hstep); PG8_STAGE_A(PG8_SA(1, 0), a3, 0, last);
            PG8_WAIT_V(8); PG8_WAIT_L(0); PG8_BAR; PG8_MMA(1, 0, At, B0); PG8_MMA(1, 1, At, B1); PG8_BAR; PG8_SCHED;
        }
        if (wr == 0) PG8_BAR;
        E(acc, cur, wr, wc, fr, fq);
        if (!has_next) break;
#pragma unroll
        for (int a = 0; a < 2; ++a)
#pragma unroll
            for (int b = 0; b < 2; ++b)
#pragma unroll
                for (int m = 0; m < 4; ++m)
#pragma unroll
                    for (int n = 0; n < 2; ++n) acc[a][b][m][n] = (f32x4){0.f, 0.f, 0.f, 0.f};
        cur = nxt; cA = nA; cB = nB; ++ui;
#pragma unroll
        for (int _h = 0; _h < 2; ++_h)
#pragma unroll
            for (int _i = 0; _i < 2; ++_i) vgC[_h][_i] = vgN[_h][_i];
        if (wr == 1) PG8_BAR;
    }
    PG8_WAIT_V(0);
    PG8_BAR;
#undef PG8_ROWS
#undef PG8_SA
#undef PG8_SB
#undef PG8_STAGE_A
#undef PG8_STAGE_B
#undef PG8_LDA
#undef PG8_LDB
#undef PG8_MMA
#undef PG8_WAIT_V
#undef PG8_WAIT_L
#undef PG8_BAR
#undef PG8_SCHED
}
}

using pg8::Unit;
__device__ __forceinline__ f16x8 pack8(const f32x4 a, const f32x4 b) {
    f16x8 w; w[0] = (h16)a[0]; w[1] = (h16)a[1]; w[2] = (h16)a[2]; w[3] = (h16)a[3]; w[4] = (h16)b[0]; w[5] = (h16)b[1]; w[6] = (h16)b[2]; w[7] = (h16)b[3]; return w;
}
struct EpiH16 {
    static constexpr bool PERM = true;
    h16* O0; int ld0; h16* O1; int ld1;
    __device__ __forceinline__ void operator()(const f32x4 (&acc)[2][2][4][2], const Unit& u, int wr, int wc, int fr, int fq) const {
        h16* base = u.kind ? O1 : O0; const int ld = u.kind ? ld1 : ld0;
        const int row0 = u.pm * 256 + wr * 64 + fr, col0 = u.pn * 256 + wc * 32 + 8 * fq;
#pragma unroll
        for (int ai = 0; ai < 2; ++ai)
#pragma unroll
            for (int m = 0; m < 4; ++m) { h16* rowp = base + (size_t)(row0 + ai * 128 + m * 16) * ld + col0;
#pragma unroll
                for (int bj = 0; bj < 2; ++bj) *(f16x8*)(rowp + bj * 128) = pack8(acc[ai][bj][m][0], acc[ai][bj][m][1]); }
    }
};
struct EpiTaps {
    static constexpr bool PERM = false;
    float* T0; float* T1;
    __device__ __forceinline__ void operator()(const f32x4 (&acc)[2][2][4][2], const Unit& u, int wr, int wc, int fr, int fq) const {
        const int j = u.kind >> 1, v = u.kind & 1; const int ld = v ? 256 : 4096;
        float* base = v ? (T1 + (size_t)j * 8192 * 256) : (T0 + (size_t)j * 8192 * 4096);
        const int row0 = u.pm * 256 + wr * 64 + fr, col0 = u.pn * 256 + wc * 32 + 4 * fq;
#pragma unroll
        for (int ai = 0; ai < 2; ++ai)
#pragma unroll
            for (int m = 0; m < 4; ++m) { float* rowp = base + (size_t)(row0 + ai * 128 + m * 16) * ld + col0;
#pragma unroll
                for (int bj = 0; bj < 2; ++bj)
#pragma unroll
                    for (int n = 0; n < 2; ++n) *(f32x4*)(rowp + bj * 128 + n * 16) = acc[ai][bj][m][n]; }
    }
};
struct EpiResid {
    static constexpr bool PERM = false;
    float* X; const float* mods; int layer; float* SSQ;
    __device__ __forceinline__ void operator()(const f32x4 (&acc)[2][2][4][2], const Unit& u, int wr, int wc, int fr, int fq) const {
        const int r0 = u.pm * 256; const int b = r0 < TL ? (r0 >> 12) : 8;
        const float* g = mods + ((size_t)(layer * 9 + b) * 6 + 2) * D;
        const int row0 = r0 + wr * 64 + fr, col0 = u.pn * 256 + wc * 32 + 4 * fq;
        f32x4 gv[2][2];
#pragma unroll
        for (int bj = 0; bj < 2; ++bj)
#pragma unroll
            for (int n = 0; n < 2; ++n) gv[bj][n] = *(const f32x4*)(g + col0 + bj * 128 + n * 16);
#pragma unroll
        for (int ai = 0; ai < 2; ++ai)
#pragma unroll
            for (int m = 0; m < 4; ++m) { const int row = row0 + ai * 128 + m * 16; float* rowp = X + (size_t)row * D + col0; float sq = 0.f;
#pragma unroll
                for (int bj = 0; bj < 2; ++bj)
#pragma unroll
                    for (int n = 0; n < 2; ++n) { f32x4* pp = (f32x4*)(rowp + bj * 128 + n * 16); const f32x4 v = *pp + gv[bj][n] * acc[ai][bj][m][n]; *pp = v; sq += v[0] * v[0] + v[1] * v[1] + v[2] * v[2] + v[3] * v[3]; }
                sq += shx(sq, 16); sq += shx(sq, 32);
                if (fq == 0) SSQ[(size_t)row * 32 + u.pn * 4 + wc] = sq; }
    }
};
struct EpiMoe1 {
    static constexpr bool PERM = true;
    h16* H1;
    __device__ __forceinline__ void operator()(const f32x4 (&acc)[2][2][4][2], const Unit& u, int wr, int wc, int fr, int fq) const {
        const int row0 = u.pm * 256 + wr * 64 + fr, col0 = u.pn * 128 + wc * 16 + 4 * fq;
#pragma unroll
        for (int ai = 0; ai < 2; ++ai)
#pragma unroll
            for (int m = 0; m < 4; ++m) { h16* rowp = H1 + (size_t)(row0 + ai * 128 + m * 16) * DE + col0;
#pragma unroll
                for (int bj = 0; bj < 2; ++bj) { const f32x4 a = acc[ai][bj][m][0], b = acc[ai][bj][m][1]; f16x4 w;
#pragma unroll
                    for (int i = 0; i < 4; ++i) { const float s = a[i] / (1.0f + __expf(-a[i])); w[i] = (h16)(s * b[i]); }
                    *(f16x4*)(rowp + bj * 64) = w; } }
    }
};
struct EpiMoe2 {
    static constexpr bool PERM = true;
    h16* YC; const float* gslot;
    __device__ __forceinline__ void operator()(const f32x4 (&acc)[2][2][4][2], const Unit& u, int wr, int wc, int fr, int fq) const {
        const int col0 = u.pn * 256 + wc * 32 + 8 * fq;
        const float* grow = gslot + ((const char*)u.rows - (const char*)listbase) / 4;
        int av[2][4]; float gv[2][4];
#pragma unroll
        for (int ai = 0; ai < 2; ++ai)
#pragma unroll
            for (int m = 0; m < 4; ++m) { const int r = ai * 128 + wr * 64 + m * 16 + fr; const bool ok = u.pos0 + r < u.cnt; av[ai][m] = ok ? u.rows[r] : -1; gv[ai][m] = ok ? grow[r] : 0.f; }
#pragma unroll
        for (int ai = 0; ai < 2; ++ai)
#pragma unroll
            for (int m = 0; m < 4; ++m) { if (av[ai][m] >= 0) { const float g = gv[ai][m]; h16* rowp = YC + (size_t)av[ai][m] * D + col0;
#pragma unroll
                    for (int bj = 0; bj < 2; ++bj) *(f16x8*)(rowp + bj * 128) = pack8(acc[ai][bj][m][0] * g, acc[ai][bj][m][1] * g); } }
    }
    const int* listbase;
};

__device__ __forceinline__ void order_tile(int wgid, int nM, int nN, int& pm, int& pn) {
    const int nwg = nM * nN; { const int q = nwg / 8, r = nwg % 8, xcd = wgid % 8, off = wgid / 8; wgid = (xcd < r ? xcd * (q + 1) : r * (q + 1) + (xcd - r) * q) + off; }
    const int nig = 8 * nN, gid = wgid / nig, fm = gid * 8, gsz = (nM - fm) < 8 ? (nM - fm) : 8;
    pm = fm + ((wgid % nig) % gsz); pn = (wgid % nig) / gsz;
}
struct SchedPlain {
    int nM, nN, K; const char* A; const char* B;
    __device__ __forceinline__ bool next(int i, Unit& u) const {
        const long L = (long)i * gridDim.x + blockIdx.x; if (L >= (long)nM * nN) return false;
        order_tile((int)L, nM, nN, u.pm, u.pn); u.kind = 0; u.e = 0; u.pos0 = 0; u.cnt = 0; u.rows = nullptr;
        u.A = A + (size_t)u.pm * 256 * K * 2; u.B = B + (size_t)u.pn * 256 * K * 2; return true;
    }
};
struct SchedQkv {
    const char* H; const char* W;
    __device__ __forceinline__ bool next(int i, Unit& u) const {
        const long L = (long)i * gridDim.x + blockIdx.x; const int nA = 136 * 9; if (L >= nA + 136) return false;
        u.e = 0; u.pos0 = 0; u.cnt = 0; u.rows = nullptr;
        if (L < nA) { order_tile((int)L, 136, 9, u.pm, u.pn); u.kind = 0; u.A = H + (size_t)u.pm * 256 * D * 2; u.B = W + (size_t)u.pn * 256 * D * 2; }
        else { u.pm = 0; u.pn = (int)L - nA; u.kind = 1; u.A = W + (size_t)DQK * D * 2; u.B = H + (size_t)u.pn * 256 * D * 2; }
        return true;
    }
};
struct SchedFilt {
    const char* W3P; const char* H2P;
    __device__ __forceinline__ bool next(int i, Unit& u) const {
        const long L = (long)i * gridDim.x + blockIdx.x; if (L >= 2 * 544) return false;
        const int j = (int)L / 544, r = (int)L % 544; u.e = 0; u.pos0 = 0; u.cnt = 0; u.rows = nullptr;
        int v; if (r < 512) { v = 0; u.pm = r >> 4; u.pn = r & 15; } else { v = 1; u.pm = r - 512; u.pn = 0; }
        u.kind = 2 * j + v;
        u.A = W3P + ((size_t)j * 8192 + (size_t)u.pm * 256) * 256 * 2;
        u.B = H2P + ((size_t)j * 4352 + (v ? 4096 : 0) + (size_t)u.pn * 256) * 256 * 2;
        return true;
    }
};
struct MoeTab { const LAS int* tstart; const LAS int* texp; const LAS int* cnt; };
struct SchedMoe1 {
    MoeTab tb; const char* H; const char* W13; const int* list;
    __device__ __forceinline__ bool next(int i, Unit& u) const {
        const long L = (long)i * gridDim.x + blockIdx.x; const int ntile = __builtin_amdgcn_readfirstlane(tb.tstart[NE]); if (L >= (long)ntile * 3) return false;
        const int rt = (int)L / 3; u.pn = (int)L % 3; u.pm = rt; u.kind = 0;
        const int e = __builtin_amdgcn_readfirstlane(tb.texp[rt]); u.e = e; u.pos0 = (rt - __builtin_amdgcn_readfirstlane(tb.tstart[e])) * 256; u.cnt = __builtin_amdgcn_readfirstlane(tb.cnt[e]);
        u.rows = list + (size_t)e * LCAP + u.pos0; u.A = H; u.B = W13 + ((size_t)e * DE2 + (size_t)u.pn * 256) * D * 2; return true;
    }
};
struct SchedMoe2 {
    MoeTab tb; const char* H1; const char* W2; const int* list;
    __device__ __forceinline__ bool next(int i, Unit& u) const {
        const long L = (long)i * gridDim.x + blockIdx.x; const int ntile = __builtin_amdgcn_readfirstlane(tb.tstart[NE]); if (L >= (long)ntile * 8) return false;
        const int rt = (int)L >> 3; u.pn = (int)L & 7; u.pm = rt; u.kind = 0;
        const int e = __builtin_amdgcn_readfirstlane(tb.texp[rt]); u.e = e; u.pos0 = (rt - __builtin_amdgcn_readfirstlane(tb.tstart[e])) * 256; u.cnt = __builtin_amdgcn_readfirstlane(tb.cnt[e]);
        u.rows = list + (size_t)e * LCAP + u.pos0; u.A = H1 + (size_t)rt * 256 * DE * 2; u.B = W2 + ((size_t)e * D + (size_t)u.pn * 256) * DE * 2; return true;
    }
};
__device__ __forceinline__ void moe_table(LAS int* tstart, LAS int* texp, LAS int* cnt, const int* counters) {
    const int t = tid_fresh();
    if (t < NE) cnt[t] = counters[t];
    __syncthreads();
    if (t <= NE) { int s = 0; for (int e = 0; e < t; ++e) s += (cnt[e] + 255) >> 8; tstart[t] = s; }
    __syncthreads();
    if (t < NE) { const int s0 = tstart[t], s1 = tstart[t + 1]; for (int q = s0; q < s1; ++q) texp[q] = t; }
    __syncthreads();
}

__device__ __forceinline__ float wave_sum(float v) {
#pragma unroll
    for (int o = 32; o >= 1; o >>= 1) v += shx(v, o);
    return v;
}
__device__ __forceinline__ float silu_f(float x) { return x / (1.0f + expf(-x)); }
__device__ __forceinline__ int batch_of_row(int r) { return r < TL ? (r >> 12) : 8; }

__device__ __forceinline__ void modp_unit(const Params& p, int unit, LAS float* sl) {
    const int layer = unit / 96, rem = unit % 96, ks = rem / 6, cc = rem % 6, tid = tid_fresh();
    for (int i = tid; i < 9 * 128; i += 512) { const int cnd = i >> 7, k = ks * 128 + (i & 127); const float v = cnd < 8 ? p.c[cnd * D + k] : p.c_ctx[k]; sl[i] = silu_f(v); }
    __syncthreads();
    f32x4 acc[9];
#pragma unroll
    for (int q = 0; q < 9; ++q) acc[q] = (f32x4){0.f, 0.f, 0.f, 0.f};
    const float* w = p.mod_w + ((size_t)layer * D + (size_t)ks * 128) * D6 + cc * 2048 + tid * 4;
#pragma unroll 4
    for (int k = 0; k < 128; ++k) { const f32x4 wv = *(const f32x4*)(w + (size_t)k * D6);
#pragma unroll
        for (int q = 0; q < 9; ++q) acc[q] += wv * sl[q * 128 + k]; }
    float* outp = (float*)(p.ws + WS_MODP) + ((size_t)(ks * 4 + layer) * 9) * D6 + cc * 2048 + tid * 4;
#pragma unroll
    for (int q = 0; q < 9; ++q) *(f32x4*)(outp + (size_t)q * D6) = acc[q];
    __syncthreads();
}
__device__ __forceinline__ void modr_unit(const Params& p, int unit) {
    const size_t idx = (size_t)unit * 2048 + tid_fresh() * 4; const int layer = (int)(idx / (9 * D6)), col = (int)(idx % D6);
    f32x4 s = *(const f32x4*)(p.mod_b + (size_t)layer * D6 + col);
    const float* pp = (const float*)(p.ws + WS_MODP) + idx;
#pragma unroll
    for (int ks = 0; ks < 16; ++ks) s += *(const f32x4*)(pp + (size_t)ks * 4 * 9 * D6);
    *(f32x4*)((float*)(p.ws + WS_MODS) + idx) = s;
}
__device__ __forceinline__ void tables_unit(const Params& p) {
    f32x2* tw = (f32x2*)(p.ws + WS_TW);
    for (int m = tid_fresh(); m < 8192; m += 512) { double s, c; sincospi(-(double)m / 4096.0, &s, &c); tw[m] = (f32x2){(float)c, (float)s}; }
    float* rc = (float*)(p.ws + WS_ROPE);
    for (int i = tid_fresh(); i < 1024; i += 512) { const int pos = i >> 4, q = i & 15; const float inv = powf(10000.0f, -(float)q / 16.0f); const float ang = (float)pos * inv;
        rc[i] = cosf(ang); rc[1024 + i] = sinf(ang); }
}
__device__ __forceinline__ void h2_task(const Params& p, int task) {
    const int lane = tid_fresh() & 63; const int j = task / 4352, r = task % 4352; const int v = r >= 4096, t = v ? r - 4096 : r; const int Lv = v ? 256 : 4096;
    const float tl = (float)t / (float)(Lv - 1);
    const float omega = (float)(2.0 * 3.14159265358979323846 / (double)Lv) * (float)t;
    float feat = 0.f;
    if (lane == 0) feat = tl;
    else if (lane <= 32) { const int bi = (lane - 1) & 15; const float band = 1e-4f + (float)bi * ((15.0f - 1e-4f) / 15.0f); const float a = band * omega; feat = lane <= 16 ? cosf(a) : -sinf(a); }
    const float* w1 = p.hy_f_w1 + (size_t)j * 33 * 64; const float* w2 = p.hy_f_w2 + (size_t)j * 64 * 64;
    float s = p.hy_f_b1[j * 64 + lane];
    for (int f = 0; f < 33; ++f) s += bperm_f(feat, f) * w1[f * 64 + lane];
    const float h1 = sinf(p.hy_f_freq1[j * 64 + lane] * s);
    float s2 = p.hy_f_b2[j * 64 + lane];
    for (int m = 0; m < 64; ++m) s2 += bperm_f(h1, m) * w2[m * 64 + lane];
    const float h2 = sinf(p.hy_f_freq2[j * 64 + lane] * s2);
    const h16 hi = (h16)h2; const h16 lo = (h16)(h2 - (float)hi);
    h16* row = (h16*)(p.ws + WS_H2P) + ((size_t)j * 4352 + r) * 256;
    row[lane] = hi; row[64 + lane] = hi; row[128 + lane] = lo; row[192 + lane] = lo;
}
__device__ __forceinline__ void w3p_unit(const Params& p, int unit) {
    const int j = unit >> 5, c0 = (unit & 31) * 256; const float* w3 = p.hy_f_w3 + (size_t)j * 64 * 8192; h16* dst = (h16*)(p.ws + WS_W3P) + (size_t)j * 8192 * 256;
    for (int i = tid_fresh(); i < 64 * 256; i += 512) { const int m = i >> 8, col = c0 + (i & 255); const float w = w3[(size_t)m * 8192 + col];
        const h16 hi = (h16)w; const h16 lo = (h16)(w - (float)hi); h16* row = dst + (size_t)col * 256; row[m] = hi; row[64 + m] = lo; row[128 + m] = hi; row[192 + m] = lo; }
}
__device__ __forceinline__ void rtab_unit(const Params& p, int unit) {
    const int layer = unit >> 6, c = unit & 63; h16* dst = (h16*)(p.ws + WS_RTAB + (size_t)layer * RTAB_L) + (size_t)c * 5 * 2 * 64 * 8;
    for (int i = tid_fresh(); i < 5 * 2 * 64 * 8; i += 512) { const int jj = i & 7, lane = (i >> 3) & 63, hl = (i >> 9) & 1, ct = i >> 10;
        const int k = 32 * c + 8 * (lane >> 4) + jj, col = 16 * ct + (lane & 15);
        float w = 0.f; if (col < 8) w = p.moe_wg[((size_t)layer * D + k) * 8 + col]; else if (col < 72) w = p.moe_we[((size_t)layer * D + k) * 64 + (col - 8)];
        w *= 256.0f; const h16 hi = (h16)w; const h16 lo = (h16)(w - (float)hi); dst[i] = hl ? lo : hi; }
}
template <int NW>
__device__ __forceinline__ void cvt_tile(const float* src, int ldn, int k0, int n0, h16* dst, int ldk, int mode, LAS float* T) {
    constexpr int P = NW + 1; const int tid = tid_fresh();
#pragma unroll
    for (int ps = 0; ps < 64 * NW / 4 / 512; ++ps) { const int idx = ps * 512 + tid, k = idx / (NW / 4), n4 = idx % (NW / 4);
        const f32x4 v = *(const f32x4*)(src + (size_t)(k0 + k) * ldn + n0 + 4 * n4); LAS float* q = T + k * P + 4 * n4; q[0] = v[0]; q[1] = v[1]; q[2] = v[2]; q[3] = v[3]; }
    __syncthreads();
#pragma unroll
    for (int ps = 0; ps < NW * 8 / 512; ++ps) { const int item = ps * 512 + tid, kc = item & 7, n = item >> 3; f16x8 w;
#pragma unroll
        for (int i = 0; i < 8; ++i) w[i] = (h16)T[(8 * kc + i) * P + n];
        const int ng = n0 + n; const int row = mode == 0 ? ng : (8 * (ng >> 2) + (ng & 3) + (mode == 2 ? 4 : 0));
        *(f16x8*)(dst + (size_t)row * ldk + k0 + 8 * kc) = w; }
    __syncthreads();
}
__device__ __forceinline__ void cvt_dense_unit(const Params& p, int unit, LAS float* T) {
    const float* src; h16* dst; int nt, N;
    if (unit < 1536) { src = p.hy_w_in; dst = (h16*)(p.ws + WS_WIN); nt = 24; N = D3; }
    else if (unit < 2048) { unit -= 1536; src = p.hy_w_out; dst = (h16*)(p.ws + WS_WOUT); nt = 8; N = D; }
    else if (unit < 2688) { unit -= 2048; src = p.at_w_qkv; dst = (h16*)(p.ws + WS_WQKV); nt = 10; N = DQKV; }
    else { unit -= 2688; src = p.at_w_o; dst = (h16*)(p.ws + WS_WO); nt = 8; N = D; }
    const int j = unit / (32 * nt), r = unit % (32 * nt), kt = r / nt, ntile = r % nt;
    cvt_tile<256>(src + (size_t)j * D * N, N, kt * 64, ntile * 256, dst + (size_t)j * N * D, D, 0, T);
}
constexpr int CVT_DENSE_UNITS = 3200;
__device__ __forceinline__ void cvt_moe_unit(const Params& p, int layer, int unit, LAS float* T) {
    if (unit < 12288) { const int which = unit >= 6144; if (which) unit -= 6144; const int e = unit / 96, r = unit % 96, kt = r / 3, ntile = r % 3;
        const float* src = (which ? p.moe_w3 : p.moe_w1) + ((size_t)layer * NE + e) * D * DE;
        cvt_tile<128>(src, DE, kt * 64, ntile * 128, (h16*)(p.ws + WS_W13) + (size_t)e * DE2 * D, D, which ? 2 : 1, T); }
    else { unit -= 12288; const int e = unit / 48, r = unit % 48, kt = r / 8, ntile = r % 8;
        const float* src = p.moe_w2 + ((size_t)layer * NE + e) * DE * D;
        cvt_tile<256>(src, D, kt * 64, ntile * 256, (h16*)(p.ws + WS_W2) + (size_t)e * D * DE, DE, 0, T); }
}
constexpr int CVT_MOE_UNITS = 15360;

template <int NR, bool FINAL>
__device__ __forceinline__ void n1_rows(const Params& p, int layer, int r0, int rstride, int lane) {
    float* xres = (float*)(p.ws + WS_XRES); h16* hb = (h16*)(p.ws + WS_HBUF); const h16* yc = (const h16*)(p.ws + WS_YC); const float* mods = (const float*)(p.ws + WS_MODS);
    f32x4 v[NR][8]; f16x4 ya[NR][8], yb[NR][8];
    const bool comb = FINAL || layer > 0; const int lprev = FINAL ? 3 : layer - 1;
#pragma unroll
    for (int q = 0; q < NR; ++q) { const int r = r0 + q * rstride;
        const float* src = (!FINAL && layer == 0) ? (r < TL ? p.x + (size_t)r * D : p.ctx + (size_t)(r - TL) * D) : xres + (size_t)r * D;
#pragma unroll
        for (int c = 0; c < 8; ++c) v[q][c] = *(const f32x4*)(src + c * 256 + lane * 4);
        if (comb) { const h16* y0 = yc + (size_t)(2 * r) * D; const h16* y1 = y0 + D;
#pragma unroll
            for (int c = 0; c < 8; ++c) { ya[q][c] = *(const f16x4*)(y0 + c * 256 + lane * 4); yb[q][c] = *(const f16x4*)(y1 + c * 256 + lane * 4); } } }
#pragma unroll
    for (int q = 0; q < NR; ++q) { const int r = r0 + q * rstride; const int b = batch_of_row(r);
        if (comb) { const float* g2 = mods + ((size_t)(lprev * 9 + b) * 6 + 5) * D;
#pragma unroll
            for (int c = 0; c < 8; ++c) { const f32x4 g = *(const f32x4*)(g2 + c * 256 + lane * 4);
#pragma unroll
                for (int i = 0; i < 4; ++i) v[q][c][i] += g[i] * ((float)ya[q][c][i] + (float)yb[q][c][i]); } }
        float ss = 0.f;
#pragma unroll
        for (int c = 0; c < 8; ++c) { if (!FINAL) *(f32x4*)(xres + (size_t)r * D + c * 256 + lane * 4) = v[q][c]; ss += v[q][c][0] * v[q][c][0] + v[q][c][1] * v[q][c][1] + v[q][c][2] * v[q][c][2] + v[q][c][3] * v[q][c][3]; }
        ss = wave_sum(ss); const float rs = 1.0f / sqrtf(ss * (1.0f / D) + EPS);
        if (FINAL) {
#pragma unroll
            for (int c = 0; c < 8; ++c) { const int col = c * 256 + lane * 4; const f32x4 g = *(const f32x4*)(p.final_gain + col); *(f32x4*)(p.out + (size_t)r * D + col) = v[q][c] * rs * g; }
        } else {
            const float* sh = mods + ((size_t)(layer * 9 + b) * 6 + 0) * D; const float* sc = sh + D;
#pragma unroll
            for (int c = 0; c < 8; ++c) { const int col = c * 256 + lane * 4; const f32x4 s0 = *(const f32x4*)(sh + col), s1 = *(const f32x4*)(sc + col); f16x4 w;
#pragma unroll
                for (int i = 0; i < 4; ++i) w[i] = (h16)(v[q][c][i] * rs * (1.0f + s1[i]) + s0[i]);
                *(f16x4*)(hb + (size_t)r * D + col) = w; }
        } }
}
template <bool FINAL>
__device__ __forceinline__ void n1_any(const Params& p, int layer) {
    const int tid = tid_fresh(), lane = tid & 63, gw = blockIdx.x * 8 + __builtin_amdgcn_readfirstlane(tid >> 6), nw = gridDim.x * 8; const int nrow = FINAL ? TL : TT;
    int r = gw;
    for (; r + nw < nrow; r += 2 * nw) n1_rows<2, FINAL>(p, layer, r, nw, lane);
    if (r < nrow) n1_rows<1, FINAL>(p, layer, r, nw, lane);
}
__device__ __forceinline__ void n1_phase(const Params& p, int layer) { n1_any<false>(p, layer); }
__device__ __forceinline__ void final_phase(const Params& p) { n1_any<true>(p, 0); }
constexpr int N2_CH = 4;
constexpr int N2_SLOT = N2_CH * 10 * 1024;
#ifndef PROBE_N2VAR
#define PROBE_N2VAR 0
#endif
__device__ __forceinline__ void n2_phase(const Params& p, int layer, LAS unsigned char* lds, int ctr_shadow) {
    const bool pv_tail = !(ctr_shadow && (PROBE_N2VAR & 1)), pv_store = !(ctr_shadow && (PROBE_N2VAR & 2)), pv_mma = !(ctr_shadow && (PROBE_N2VAR & 4));
    const int tid = tid_fresh(), lane = tid & 63, wv = __builtin_amdgcn_readfirstlane(tid >> 6), r16 = lane & 15, kg = lane >> 4;
    const float* xres = (const float*)(p.ws + WS_XRES); h16* hb = (h16*)(p.ws + WS_HBUF); const float* mods = (const float*)(p.ws + WS_MODS);
    const char* rtb = p.ws + WS_RTAB + (size_t)layer * RTAB_L; const float* ssq = (const float*)(p.ws + WS_SSQ);
    int* counters = (int*)(p.ws + WS_CTL) + CTL_CNT + (layer + (ctr_shadow ? 4 : 0)) * NE; int* list = (int*)(p.ws + WS_LIST); float* gate = (float*)(p.ws + WS_GATE);
    LAS float* scr = (LAS float*)(lds + 2 * N2_SLOT) + wv * (16 * 80);
    LAS float* scl = (LAS float*)(lds + 2 * N2_SLOT + 8 * 16 * 80 * 4); LAS float* shl = scl + D;
    LAS int* hist = (LAS int*)(lds + LDS_MISC); LAS int* hbase = hist + NE;
    const int ntask = TT / 16, nfull = (int)gridDim.x * 8;
#pragma unroll 1
    for (int round = 0; round < 2; ++round) {
        const int nrem = ntask - nfull;
        if (round == 1 && (int)blockIdx.x >= nrem) break;
        const int task = round == 0 ? (int)blockIdx.x * 8 + wv : nfull + (int)blockIdx.x;
        const bool active = round == 0 ? (task < ntask) : (wv == 0);
        const int trow = active ? task * 16 : 0;
        const int row = trow + r16; const int b = batch_of_row(trow);
        const float* xr = xres + (size_t)row * D + 8 * kg;
        float rs;
        { const float* sp = ssq + (size_t)row * 32; float t = 0.f;
#pragma unroll
            for (int q = 0; q < 8; ++q) { const f32x4 v = *(const f32x4*)(sp + 4 * q); t += (v[0] + v[1]) + (v[2] + v[3]); }
            rs = 1.0f / sqrtf(t * (1.0f / D) + EPS); }
        f32x4 acc[5];
#pragma unroll
        for (int ct = 0; ct < 5; ++ct) acc[ct] = (f32x4){0.f, 0.f, 0.f, 0.f};
        __syncthreads();
        if (tid < NE) hist[tid] = 0;
        { const float* scb = mods + ((size_t)(layer * 9 + b) * 6 + 4) * D; *(LAS f32x4*)(scl + tid * 4) = *(const f32x4*)(scb + tid * 4); *(LAS f32x4*)(shl + tid * 4) = *(const f32x4*)(scb - D + tid * 4); }
        f16x8 bq[5];
#pragma unroll
        for (int q = 0; q < 5; ++q) bq[q] = *(const f16x8*)(rtb + (size_t)(5 * wv + q) * 1024 + lane * 16);
#pragma unroll
        for (int q = 0; q < 5; ++q) *(LAS f16x8*)(lds + (5 * wv + q) * 1024 + lane * 16) = bq[q];
        f32x4 x0[N2_CH][2], x1[N2_CH][2], x2[N2_CH][2];
#pragma unroll
        for (int s2 = 0; s2 < N2_CH; ++s2) { x0[s2][0] = *(const f32x4*)(xr + 32 * s2); x0[s2][1] = *(const f32x4*)(xr + 32 * s2 + 4);
            x1[s2][0] = *(const f32x4*)(xr + 32 * (N2_CH + s2)); x1[s2][1] = *(const f32x4*)(xr + 32 * (N2_CH + s2) + 4); }
#pragma unroll 1
        for (int ch = 0; ch < 64 / N2_CH; ++ch) {
            __syncthreads();
            const int nx = (ch + 1 < 64 / N2_CH) ? ch + 1 : ch;
            const int nx2 = (ch + 2 < 64 / N2_CH) ? ch + 2 : ch;
            {   const char* src = rtb + (size_t)nx * N2_SLOT;
#pragma unroll
                for (int q = 0; q < 5; ++q) bq[q] = *(const f16x8*)(src + (size_t)(5 * wv + q) * 1024 + lane * 16); }
#pragma unroll
            for (int s2 = 0; s2 < N2_CH; ++s2) { const int ko = 32 * (nx2 * N2_CH + s2); x2[s2][0] = *(const f32x4*)(xr + ko); x2[s2][1] = *(const f32x4*)(xr + ko + 4); }
            const LAS unsigned char* bs = lds + (ch & 1) * N2_SLOT + lane * 16;
#pragma unroll
            for (int s2 = 0; s2 < N2_CH; ++s2) {
                const int ko = 32 * (ch * N2_CH + s2) + 8 * kg;
                const f32x4 c0 = *(const LAS f32x4*)(scl + ko), c1 = *(const LAS f32x4*)(scl + ko + 4), h0 = *(const LAS f32x4*)(shl + ko), h1 = *(const LAS f32x4*)(shl + ko + 4);
                f16x8 hi, lo;
#pragma unroll
                for (int i = 0; i < 4; ++i) { const float a0 = x0[s2][0][i] * rs * (1.0f + c0[i]) + h0[i], a1 = x0[s2][1][i] * rs * (1.0f + c1[i]) + h1[i];
                    hi[i] = (h16)a0; lo[i] = (h16)(a0 - (float)hi[i]); hi[4 + i] = (h16)a1; lo[4 + i] = (h16)(a1 - (float)hi[4 + i]); }
                if (active && pv_store) *(f16x8*)(hb + (size_t)row * D + ko) = hi;
                if (pv_mma)
#pragma unroll
                for (int ct = 0; ct < 5; ++ct) { const f16x8 whi = *(const LAS f16x8*)(bs + (s2 * 10 + ct * 2 + 0) * 1024), wlo = *(const LAS f16x8*)(bs + (s2 * 10 + ct * 2 + 1) * 1024);
                    acc[ct] = __builtin_amdgcn_mfma_f32_16x16x32_f16(hi, whi, acc[ct], 0, 0, 0);
                    acc[ct] = __builtin_amdgcn_mfma_f32_16x16x32_f16(hi, wlo, acc[ct], 0, 0, 0);
                    acc[ct] = __builtin_amdgcn_mfma_f32_16x16x32_f16(lo, whi, acc[ct], 0, 0, 0); }
            }
            {   LAS unsigned char* dst = lds + ((ch + 1) & 1) * N2_SLOT;
#pragma unroll
                for (int q = 0; q < 5; ++q) *(LAS f16x8*)(dst + (5 * wv + q) * 1024 + lane * 16) = bq[q]; }
#pragma unroll
            for (int s2 = 0; s2 < N2_CH; ++s2) { x0[s2][0] = x1[s2][0]; x0[s2][1] = x1[s2][1]; x1[s2][0] = x2[s2][0]; x1[s2][1] = x2[s2][1]; }
        }
#pragma unroll
        for (int ct = 0; ct < 5; ++ct)
#pragma unroll
            for (int i = 0; i < 4; ++i) scr[(4 * kg + i) * 80 + 16 * ct + r16] = acc[ct][i] * (1.0f / 256.0f);
        asm volatile("s_waitcnt lgkmcnt(0)" ::: "memory");
        int ea = 0, eb = 0, ra = 0, rb = 0; float g1v = 0.f, g2v = 0.f; const bool tok_lane = active && lane < 16 && pv_tail;
        if (tok_lane) {
            const LAS float* lgr = scr + lane * 80;
            float gmax = -3.0e38f; int gsel = 0; float gl[8];
#pragma unroll
            for (int g = 0; g < 8; ++g) { gl[g] = lgr[g] + p.moe_bg[layer * 8 + g]; if (gl[g] > gmax) { gmax = gl[g]; gsel = g; } }
            float gz = 0.f;
#pragma unroll
            for (int g = 0; g < 8; ++g) gz += expf(gl[g] - gmax);
            const float pg = 1.0f / gz;
            float f1 = -3.0e38f, f2 = -3.0e38f; int i1 = 0, i2 = 0;
            for (int q = 0; q < 8; ++q) { const float f = lgr[8 + gsel * 8 + q] + p.moe_be[layer * 64 + gsel * 8 + q];
                if (f > f1) { f2 = f1; i2 = i1; f1 = f; i1 = q; } else if (f > f2) { f2 = f; i2 = q; } }
            const float e2 = expf(f2 - f1); g1v = pg / (1.0f + e2); g2v = pg * e2 / (1.0f + e2);
            ea = gsel * 8 + i1; eb = gsel * 8 + i2;
            ra = __hip_atomic_fetch_add(hist + ea, 1, __ATOMIC_RELAXED, __HIP_MEMORY_SCOPE_WORKGROUP); rb = __hip_atomic_fetch_add(hist + eb, 1, __ATOMIC_RELAXED, __HIP_MEMORY_SCOPE_WORKGROUP);
        }
        __syncthreads();
        if (tid < NE && pv_tail) { const int n = hist[tid]; hbase[tid] = n ? atomicAdd(&counters[tid], n) : 0; }
        __syncthreads();
        if (tok_lane) { const int tok = task * 16 + lane; const size_t sa = (size_t)ea * LCAP + hbase[ea] + ra, sb = (size_t)eb * LCAP + hbase[eb] + rb;
            list[sa] = 2 * tok; gate[sa] = g1v; list[sb] = 2 * tok + 1; gate[sb] = g2v; }
    }
}
__device__ __forceinline__ void transpose_phase(const Params& p, LAS h16* T) {
    const h16* zt = (const h16*)(p.ws + WS_ZT); h16* z = (h16*)(p.ws + WS_HBUF); const int tid = tid_fresh();
    const int ntile = (D / 64) * (TT / 64);
    for (int tile = blockIdx.x; tile < ntile; tile += gridDim.x) {
        const int td = tile % (D / 64), tt = tile / (D / 64); const int d0 = td * 64, t0 = tt * 64;
        { const int dr = tid >> 3, tc = (tid & 7) * 8; const f16x8 v = *(const f16x8*)(zt + (size_t)(d0 + dr) * TT + t0 + tc);
#pragma unroll
            for (int i = 0; i < 8; ++i) T[(tc + i) * 66 + dr] = v[i]; }
        __syncthreads();
        { const int tr = tid >> 3, dc = (tid & 7) * 8; f16x8 v;
#pragma unroll
            for (int i = 0; i < 8; ++i) v[i] = T[tr * 66 + dc + i];
            *(f16x8*)(z + (size_t)(t0 + tr) * D + d0 + dc) = v; }
        __syncthreads();
    }
}

__device__ __forceinline__ f32x2 cmul(const f32x2 a, const f32x2 b) { return (f32x2){a.x * b.x - a.y * b.y, a.x * b.y + a.y * b.x}; }
__device__ __forceinline__ f32x2 cmulc(const f32x2 a, const f32x2 b) { return (f32x2){a.x * b.x + a.y * b.y, a.y * b.x - a.x * b.y}; }
__device__ __forceinline__ f32x2 cconj(const f32x2 a) { return (f32x2){a.x, -a.y}; }
template <bool INV> __device__ __forceinline__ f32x2 mul_mi(const f32x2 a) { return INV ? (f32x2){-a.y, a.x} : (f32x2){a.y, -a.x}; }
template <bool INV> __device__ __forceinline__ void dft4(f32x2& a, f32x2& b, f32x2& c, f32x2& d) {
    const f32x2 s0 = a + c, s1 = a - c, s2 = b + d, s3 = mul_mi<INV>(b - d);
    a = s0 + s2; b = s1 + s3; c = s0 - s2; d = s1 - s3;
}
template <bool INV, int M> __device__ __forceinline__ f32x2 w16mul(const f32x2 a) {
    constexpr float C1 = 0.92387953251128674f, S1 = 0.38268343236508977f, R = 0.70710678118654752f;
    constexpr float cr = (M == 0) ? 1.f : (M == 1) ? C1 : (M == 2) ? R : (M == 3) ? S1 : (M == 4) ? 0.f : (M == 6) ? -R :   -C1;
    constexpr float ci0 = (M == 0) ? 0.f : (M == 1) ? -S1 : (M == 2) ? -R : (M == 3) ? -C1 : (M == 4) ? -1.f : (M == 6) ? -R :   S1;
    constexpr float ci = INV ? -ci0 : ci0;
    return (f32x2){a.x * cr - a.y * ci, a.x * ci + a.y * cr};
}
template <bool INV> __device__ __forceinline__ void dft16(f32x2 (&v)[16]) {
#pragma unroll
    for (int n2 = 0; n2 < 4; ++n2) dft4<INV>(v[n2], v[4 + n2], v[8 + n2], v[12 + n2]);
    v[5] = w16mul<INV, 1>(v[5]); v[6] = w16mul<INV, 2>(v[6]); v[7] = w16mul<INV, 3>(v[7]);
    v[9] = w16mul<INV, 2>(v[9]); v[10] = w16mul<INV, 4>(v[10]); v[11] = w16mul<INV, 6>(v[11]);
    v[13] = w16mul<INV, 3>(v[13]); v[14] = w16mul<INV, 6>(v[14]); v[15] = w16mul<INV, 9>(v[15]);
#pragma unroll
    for (int k1 = 0; k1 < 4; ++k1) dft4<INV>(v[4 * k1], v[4 * k1 + 1], v[4 * k1 + 2], v[4 * k1 + 3]);
    f32x2 t;
    t = v[1]; v[1] = v[4]; v[4] = t; t = v[2]; v[2] = v[8]; v[8] = t; t = v[3]; v[3] = v[12]; v[12] = t;
    t = v[6]; v[6] = v[9]; v[9] = t; t = v[7]; v[7] = v[13]; v[13] = t; t = v[11]; v[11] = v[14]; v[14] = t;
}
__device__ __forceinline__ int fphys(int i) { return i + (i >> 4); }
__device__ __forceinline__ f32x2 w32c(int j) {
    constexpr float c[16] = {1.f, 0.98078528040323043f, 0.92387953251128674f, 0.83146961230254524f, 0.70710678118654752f, 0.55557023301960218f, 0.38268343236508977f, 0.19509032201612825f,
                             0.f, -0.19509032201612825f, -0.38268343236508977f, -0.55557023301960218f, -0.70710678118654752f, -0.83146961230254524f, -0.92387953251128674f, -0.98078528040323043f};
    constexpr float s[16] = {0.f, 0.19509032201612825f, 0.38268343236508977f, 0.55557023301960218f, 0.70710678118654752f, 0.83146961230254524f, 0.92387953251128674f, 0.98078528040323043f,
                             1.f, 0.98078528040323043f, 0.92387953251128674f, 0.83146961230254524f, 0.70710678118654752f, 0.55557023301960218f, 0.38268343236508977f, 0.19509032201612825f};
    return (f32x2){c[j], -s[j]};
}
template <int S>
__device__ __forceinline__ void fft_fwd0(const f32x2 (&xe)[16], const f32x2 (&xo)[16], LAS f32x2* E, LAS f32x2* O, int t, const f32x2* tw) {
    const f32x2 u = tw[t * (256 / S)]; const f32x2 u2 = cmul(u, u);
    f32x2 y[16];
#pragma unroll
    for (int j = 0; j < 16; ++j) y[j] = xe[j];
    dft16<false>(y);
    constexpr int QS = S + S / 16;
    LAS f32x2* Eb = E + fphys(t); LAS f32x2* Ob = O + fphys(t);
    f32x2 pw = u2; Eb[0] = y[0];
#pragma unroll
    for (int q = 1; q < 16; ++q) { Eb[QS * q] = cmul(y[q], pw); pw = cmul(pw, u2); }
#pragma unroll
    for (int j = 0; j < 16; ++j) y[j] = cmul(xo[j], w32c(j));
    dft16<false>(y);
    pw = u;
#pragma unroll
    for (int q = 0; q < 16; ++q) { Ob[QS * q] = cmul(y[q], pw); pw = cmul(pw, u2); }
}
template <bool INV> __device__ __forceinline__ void fft_pass1(LAS f32x2* A, int tau, const f32x2* tw) {
    const int i = tau & 15, base = (tau >> 4) << 8; const f32x2 u0 = tw[32 * i]; const f32x2 u = INV ? cconj(u0) : u0;
    f32x2 y[16]; LAS f32x2* Ab = A + fphys(base + i);
#pragma unroll
    for (int j = 0; j < 16; ++j) y[j] = Ab[17 * j];
    if (INV) { f32x2 pw = u;
#pragma unroll
        for (int q = 1; q < 16; ++q) { y[q] = cmul(y[q], pw); pw = cmul(pw, u); } }
    dft16<INV>(y);
    if (!INV) { f32x2 pw = u;
#pragma unroll
        for (int q = 1; q < 16; ++q) { y[q] = cmul(y[q], pw); pw = cmul(pw, u); } }
#pragma unroll
    for (int j = 0; j < 16; ++j) Ab[17 * j] = y[j];
}
__device__ __forceinline__ void fft_fwd2(const LAS f32x2* A, int t, f32x2 (&y)[16]) {
#pragma unroll
    for (int j = 0; j < 16; ++j) y[j] = A[17 * t + j];
    dft16<false>(y);
}
__device__ __forceinline__ void fft_mid(LAS f32x2* A, int t, const f32x2* kf) {
    f32x2 y[16]; f32x4 k[8];
#pragma unroll
    for (int j = 0; j < 8; ++j) k[j] = *(const f32x4*)(kf + 2 * j);
    fft_fwd2(A, t, y);
#pragma unroll
    for (int j = 0; j < 8; ++j) { y[2 * j] = cmul(y[2 * j], (f32x2){k[j][0], k[j][1]}); y[2 * j + 1] = cmul(y[2 * j + 1], (f32x2){k[j][2], k[j][3]}); }
    dft16<true>(y);
#pragma unroll
    for (int j = 0; j < 16; ++j) A[17 * t + j] = y[j];
}
template <int S>
__device__ __forceinline__ void fft_inv0(const LAS f32x2* E, const LAS f32x2* O, int t, const f32x2* tw, f32x2 (&out)[16]) {
    const f32x2 u = tw[t * (256 / S)]; const f32x2 u2 = cmul(u, u);
    f32x2 y[16];
    constexpr int QS = S + S / 16;
    const LAS f32x2* Eb = E + fphys(t); const LAS f32x2* Ob = O + fphys(t);
    f32x2 pw = u2; y[0] = Eb[0];
#pragma unroll
    for (int q = 1; q < 16; ++q) { y[q] = cmulc(Eb[QS * q], pw); pw = cmul(pw, u2); }
    dft16<true>(y);
#pragma unroll
    for (int j = 0; j < 16; ++j) out[j] = y[j];
    pw = u;
#pragma unroll
    for (int q = 0; q < 16; ++q) { y[q] = cmulc(Ob[QS * q], pw); pw = cmul(pw, u2); }
    dft16<true>(y);
#pragma unroll
    for (int j = 0; j < 16; ++j) out[j] += cmulc(y[j], w32c(j));
}
__device__ __forceinline__ float hy_absdelta(int d) { return fabsf(-3.0701134573253943f + (-15.350567286626973f + 3.0701134573253943f) * ((float)d / 2047.0f)); }

__device__ __forceinline__ void filt_fft_phase(const Params& p, LAS unsigned char* lds) {
    const int tid = tid_fresh();
    const f32x2* tw = (const f32x2*)(p.ws + WS_TW);
    {
        const int grp = tid >> 8, tau = tid & 255;
        LAS f32x2* E = (LAS f32x2*)(lds + grp * 69632); LAS f32x2* O = E + 4352; LAS float* red = (LAS float*)(lds + LDS_MISC) + grp * 8;
        for (int pb = blockIdx.x * 2 + grp; pb < 2 * 2 * 2048; pb += gridDim.x * 2) {
            const int d = pb & 2047, n = (pb >> 11) & 1, j = pb >> 12;
            const float* tf = (const float*)(p.ws + WS_TAPS) + ((size_t)j * 8192 + (size_t)(n * 2 + 0) * D + d) * 4096;
            const float* tb = tf + (size_t)D * 4096;
            const float adel = hy_absdelta(d); const float tscale = 1.0f / 4095.0f;
            f32x2 xe[16], xo[16]; float ss = 0.f;
#pragma unroll
            for (int jj = 0; jj < 16; ++jj) { const int nn = tau + 256 * jj;
                const float klo = tf[nn] * expf(-(float)nn * tscale * adel);
                const int m = 4096 - nn;
                const float khi = (m < 4096) ? tb[m & 4095] * expf(-(float)m * tscale * adel) : 0.f;
                ss += klo * klo + khi * khi; xe[jj] = (f32x2){klo + khi, 0.f}; xo[jj] = (f32x2){klo - khi, 0.f}; }
            ss = wave_sum(ss);
            if ((tid & 63) == 0) red[(tid >> 6) & 3] = ss;
            fft_fwd0<256>(xe, xo, E, O, tau, tw);
            __syncthreads();
            const float tot = red[0] + red[1] + red[2] + red[3];
            const float scale = (1.0f / sqrtf(tot + EPS)) * (1.0f / 8192.0f);
            const float hbs = p.hy_bias[((size_t)j * 2 + n) * D + d] * (1.0f / 8192.0f);
            fft_pass1<false>(E, tau, tw); fft_pass1<false>(O, tau, tw);
            __syncthreads();
            f32x2* kf = (f32x2*)(p.ws + WS_KF) + (size_t)pb * 8192 + (size_t)tau * 16;
            f32x2 y[16];
            fft_fwd2(E, tau, y);
#pragma unroll
            for (int q = 0; q < 8; ++q) *(f32x4*)(kf + 2 * q) = (f32x4){y[2 * q].x * scale + hbs, y[2 * q].y * scale, y[2 * q + 1].x * scale + hbs, y[2 * q + 1].y * scale};
            fft_fwd2(O, tau, y);
#pragma unroll
            for (int q = 0; q < 8; ++q) *(f32x4*)(kf + 4096 + 2 * q) = (f32x4){y[2 * q].x * scale + hbs, y[2 * q].y * scale, y[2 * q + 1].x * scale + hbs, y[2 * q + 1].y * scale};
            __syncthreads();
        }
    }
    {
        const int pr = tid >> 4, i = tid & 15;
        LAS f32x2* E = (LAS f32x2*)(lds + pr * 4352); LAS f32x2* O = E + 272;
        for (int it = blockIdx.x; it < 256; it += gridDim.x) {
            const int pb = it * 32 + pr; const int d = pb & 2047, n = (pb >> 11) & 1, j = pb >> 12;
            const float* tf = (const float*)(p.ws + WS_TAPSC) + ((size_t)j * 8192 + (size_t)(n * 2 + 0) * D + d) * 256;
            const float* tb = tf + (size_t)D * 256;
            const float adel = hy_absdelta(d); const float tscale = 1.0f / 255.0f;
            f32x2 xe[16], xo[16]; float ss = 0.f;
#pragma unroll
            for (int jj = 0; jj < 16; ++jj) { const int nn = i + 16 * jj;
                const float klo = tf[nn] * expf(-(float)nn * tscale * adel);
                const int m = 256 - nn;
                const float khi = (m < 256) ? tb[m & 255] * expf(-(float)m * tscale * adel) : 0.f;
                ss += klo * klo + khi * khi; xe[jj] = (f32x2){klo + khi, 0.f}; xo[jj] = (f32x2){klo - khi, 0.f}; }
            ss += shx(ss, 8); ss += shx(ss, 4); ss += shx(ss, 2); ss += shx(ss, 1);
            const float scale = (1.0f / sqrtf(ss + EPS)) * (1.0f / 512.0f);
            const float hbs = p.hy_bias[((size_t)j * 2 + n) * D + d] * (1.0f / 512.0f);
            fft_fwd0<16>(xe, xo, E, O, i, tw);
            __syncthreads();
            f32x2* kf = (f32x2*)(p.ws + WS_KFC) + (size_t)pb * 512 + (size_t)i * 16;
            f32x2 y[16];
            fft_fwd2(E, i, y);
#pragma unroll
            for (int q = 0; q < 8; ++q) *(f32x4*)(kf + 2 * q) = (f32x4){y[2 * q].x * scale + hbs, y[2 * q].y * scale, y[2 * q + 1].x * scale + hbs, y[2 * q + 1].y * scale};
            fft_fwd2(O, i, y);
#pragma unroll
            for (int q = 0; q < 8; ++q) *(f32x4*)(kf + 256 + 2 * q) = (f32x4){y[2 * q].x * scale + hbs, y[2 * q].y * scale, y[2 * q + 1].x * scale + hbs, y[2 * q + 1].y * scale};
            __syncthreads();
        }
    }
}

__device__ __forceinline__ float conv3_lds(const LAS h16* row, int n, float w0, float w1, float w2, float b) { return (float)row[n - 1] * w0 + (float)row[n] * w1 + (float)row[n + 1] * w2 + b; }
constexpr int ST_P = 4112, STS_P = 272;

__device__ __forceinline__ void conv_phase(const Params& p, int jl, LAS unsigned char* lds) {
    const int tid = tid_fresh();
    const f32x2* tw = (const f32x2*)(p.ws + WS_TW);
    const h16* ut = (const h16*)(p.ws + WS_UT); h16* zt = (h16*)(p.ws + WS_ZT);
    const float* cw = p.hy_conv_w + (size_t)jl * 3 * D3; const float* cb = p.hy_conv_b + (size_t)jl * D3;
    {
        const int grp = tid >> 8, tau = tid & 255;
        LAS f32x2* E = (LAS f32x2*)(lds + grp * 69632); LAS f32x2* O = E + 4352; LAS h16* ST = (LAS h16*)E;
        for (int unit = blockIdx.x; unit < 4096; unit += gridDim.x) {
            const int hq = unit & 1, d = unit >> 1; const size_t col0 = (size_t)(4 * hq + 2 * grp) * 4096;
            const f32x2* kfb = (const f32x2*)(p.ws + WS_KF) + ((size_t)(jl * 2) * 2048 + d) * 8192 + (size_t)tau * 16;
            f16x8 raw[3][2][2];
#pragma unroll
            for (int sq = 0; sq < 3; ++sq)
#pragma unroll
                for (int bb = 0; bb < 2; ++bb)
#pragma unroll
                    for (int k = 0; k < 2; ++k) raw[sq][bb][k] = *(const f16x8*)(ut + (size_t)(sq * D + d) * TT + col0 + (size_t)bb * 4096 + (size_t)(tau + 256 * k) * 8);
            __syncthreads();
#pragma unroll
            for (int sq = 0; sq < 2; ++sq)
#pragma unroll
                for (int bb = 0; bb < 2; ++bb)
#pragma unroll
                    for (int k = 0; k < 2; ++k) *(LAS f16x8*)(ST + (sq * 2 + bb) * ST_P + 8 + (tau + 256 * k) * 8) = raw[sq][bb][k];
            if (tau < 4) { ST[tau * ST_P + 7] = (h16)0.f; ST[tau * ST_P + 8 + 4096] = (h16)0.f; }
            __syncthreads();
            f32x2 xin[16], gk[16], y[16];
            { const float w0 = cw[d], w1 = cw[D3 + d], w2 = cw[2 * D3 + d], bv = cb[d]; const float g0 = cw[D + d], g1 = cw[D3 + D + d], g2 = cw[2 * D3 + D + d], gb = cb[D + d];
#pragma unroll
                for (int jj = 0; jj < 16; ++jj) { const int nn = tau + 256 * jj;
                    xin[jj] = (f32x2){conv3_lds(ST + 8, nn, w0, w1, w2, bv), conv3_lds(ST + ST_P + 8, nn, w0, w1, w2, bv)};
                    gk[jj] = (f32x2){conv3_lds(ST + 2 * ST_P + 8, nn, g0, g1, g2, gb), conv3_lds(ST + 3 * ST_P + 8, nn, g0, g1, g2, gb)}; } }
            __syncthreads();
#pragma unroll 1
            for (int ord = 0; ord < 2; ++ord) {
                fft_fwd0<256>(xin, xin, E, O, tau, tw);
                __syncthreads();
                fft_pass1<false>(E, tau, tw); fft_pass1<false>(O, tau, tw);
                __syncthreads();
                const f32x2* kf = kfb + (size_t)ord * 2048 * 8192;
                fft_mid(E, tau, kf); fft_mid(O, tau, kf + 4096);
                __syncthreads();
                fft_pass1<true>(E, tau, tw); fft_pass1<true>(O, tau, tw);
                __syncthreads();
                fft_inv0<256>(E, O, tau, tw, y);
#pragma unroll
                for (int jj = 0; jj < 16; ++jj) xin[jj] = gk[jj] * y[jj];
                if (ord == 0) {
                    __syncthreads();
#pragma unroll
                    for (int bb = 0; bb < 2; ++bb)
#pragma unroll
                        for (int k = 0; k < 2; ++k) *(LAS f16x8*)(ST + bb * ST_P + 8 + (tau + 256 * k) * 8) = raw[2][bb][k];
                    if (tau < 2) { ST[tau * ST_P + 7] = (h16)0.f; ST[tau * ST_P + 8 + 4096] = (h16)0.f; }
                    __syncthreads();
                    const float g0 = cw[2 * D + d], g1 = cw[D3 + 2 * D + d], g2 = cw[2 * D3 + 2 * D + d], gb = cb[2 * D + d];
#pragma unroll
                    for (int jj = 0; jj < 16; ++jj) { const int nn = tau + 256 * jj; gk[jj] = (f32x2){conv3_lds(ST + 8, nn, g0, g1, g2, gb), conv3_lds(ST + ST_P + 8, nn, g0, g1, g2, gb)}; }
                    __syncthreads();
                }
            }
            h16* o0 = zt + (size_t)d * TT + col0; h16* o1 = o0 + 4096;
#pragma unroll
            for (int jj = 0; jj < 16; ++jj) { const int nn = tau + 256 * jj; o0[nn] = (h16)xin[jj].x; o1[nn] = (h16)xin[jj].y; }
        }
    }
    {
        const int pr = tid >> 4, i = tid & 15, c8 = pr >> 2, bp = pr & 3;
        LAS f32x2* E = (LAS f32x2*)(lds + pr * 4352); LAS f32x2* O = E + 272; LAS h16* ST = (LAS h16*)lds;
        for (int unit = blockIdx.x; unit < 256; unit += gridDim.x) {
            const int d0 = unit * 8, d = d0 + c8;
            const f32x2* kfb = (const f32x2*)(p.ws + WS_KFC) + ((size_t)(jl * 2) * 2048 + d) * 512 + (size_t)i * 16;
            f16x8 raw[3][4];
#pragma unroll
            for (int sq = 0; sq < 3; ++sq)
#pragma unroll
                for (int k = 0; k < 4; ++k) { const int q = tid + 512 * k, row = q >> 5, ch = q & 31;
                    raw[sq][k] = *(const f16x8*)(ut + (size_t)(sq * D + d0 + (row >> 3)) * TT + TL + (row & 7) * 256 + ch * 8); }
            __syncthreads();
#pragma unroll
            for (int sq = 0; sq < 2; ++sq)
#pragma unroll
                for (int k = 0; k < 4; ++k) { const int q = tid + 512 * k, row = q >> 5, ch = q & 31; *(LAS f16x8*)(ST + (sq * 64 + row) * STS_P + 8 + ch * 8) = raw[sq][k]; }
            if (tid < 128) { ST[tid * STS_P + 7] = (h16)0.f; ST[tid * STS_P + 8 + 256] = (h16)0.f; }
            __syncthreads();
            f32x2 xin[16], gk[16], y[16];
            { const float w0 = cw[d], w1 = cw[D3 + d], w2 = cw[2 * D3 + d], bv = cb[d]; const float g0 = cw[D + d], g1 = cw[D3 + D + d], g2 = cw[2 * D3 + D + d], gb = cb[D + d];
                const LAS h16* r0 = ST + (c8 * 8 + 2 * bp) * STS_P + 8; const LAS h16* r1 = r0 + 64 * STS_P;
#pragma unroll
                for (int jj = 0; jj < 16; ++jj) { const int nn = i + 16 * jj;
                    xin[jj] = (f32x2){conv3_lds(r0, nn, w0, w1, w2, bv), conv3_lds(r0 + STS_P, nn, w0, w1, w2, bv)};
                    gk[jj] = (f32x2){conv3_lds(r1, nn, g0, g1, g2, gb), conv3_lds(r1 + STS_P, nn, g0, g1, g2, gb)}; } }
            __syncthreads();
#pragma unroll 1
            for (int ord = 0; ord < 2; ++ord) {
                fft_fwd0<16>(xin, xin, E, O, i, tw);
                __syncthreads();
                const f32x2* kf = kfb + (size_t)ord * 2048 * 512;
                fft_mid(E, i, kf); fft_mid(O, i, kf + 256);
                __syncthreads();
                fft_inv0<16>(E, O, i, tw, y);
#pragma unroll
                for (int jj = 0; jj < 16; ++jj) xin[jj] = gk[jj] * y[jj];
                if (ord == 0) {
                    __syncthreads();
#pragma unroll
                    for (int k = 0; k < 4; ++k) { const int q = tid + 512 * k, row = q >> 5, ch = q & 31; *(LAS f16x8*)(ST + row * STS_P + 8 + ch * 8) = raw[2][k]; }
                    if (tid < 64) { ST[tid * STS_P + 7] = (h16)0.f; ST[tid * STS_P + 8 + 256] = (h16)0.f; }
                    __syncthreads();
                    const float g0 = cw[2 * D + d], g1 = cw[D3 + 2 * D + d], g2 = cw[2 * D3 + 2 * D + d], gb = cb[2 * D + d];
                    const LAS h16* r0 = ST + (c8 * 8 + 2 * bp) * STS_P + 8;
#pragma unroll
                    for (int jj = 0; jj < 16; ++jj) { const int nn = i + 16 * jj; gk[jj] = (f32x2){conv3_lds(r0, nn, g0, g1, g2, gb), conv3_lds(r0 + STS_P, nn, g0, g1, g2, gb)}; }
                    __syncthreads();
                }
            }
            h16* o0 = zt + (size_t)d * TT + TL + (2 * bp) * 256; h16* o1 = o0 + 256;
#pragma unroll
            for (int jj = 0; jj < 16; ++jj) { const int nn = i + 16 * jj; o0[nn] = (h16)xin[jj].x; o1[nn] = (h16)xin[jj].y; }
        }
    }
}

constexpr int AT_KP = 72, AT_VP = 68;
__device__ __forceinline__ void attn_phase(const Params& p, int jl, bool with_ctx_out, LAS unsigned char* lds) {
    const int tid = tid_fresh(), wv = tid >> 6, lane = tid & 63, r32 = lane & 31, hh = lane >> 5;
    LAS h16* Ks = (LAS h16*)lds; LAS h16* Vs = (LAS h16*)(lds + 64 * AT_KP * 2);
    const h16* qk = (const h16*)(p.ws + WS_QK); const h16* vt = (const h16*)(p.ws + WS_VT); h16* ob = (h16*)(p.ws + WS_HBUF);
    const float* rcos = (const float*)(p.ws + WS_ROPE); const float* rsin = rcos + 1024;
    const int nunit = 2048 + (with_ctx_out ? 128 : 0);
    for (int unit = blockIdx.x; unit < nunit; unit += gridDim.x) {
        int kind, b, g, qb;
        if (unit < 2048) { kind = 0; qb = unit & 63; g = (unit >> 6) & 3; b = unit >> 8; } else { const int u2 = unit - 2048; kind = 1; qb = u2 & 3; g = (u2 >> 2) & 3; b = u2 >> 4; }
        const int head = g * 8 + wv;
        const int qrow0 = kind ? (TL + b * 256 + qb * 64) : (b * 4096 + qb * 64);
        const int ctxrow0 = TL + b * 256;
        f16x8 qf[2][4];
#pragma unroll
        for (int qt = 0; qt < 2; ++qt) {
            f32x4 qv[4][2];
            const h16* qp = qk + (size_t)(qrow0 + 32 * qt + r32) * DQK + head * 64 + 8 * hh;
#pragma unroll
            for (int ks = 0; ks < 4; ++ks) { const f16x8 t = *(const f16x8*)(qp + 16 * ks);
#pragma unroll
                for (int i = 0; i < 4; ++i) { qv[ks][0][i] = (float)t[i]; qv[ks][1][i] = (float)t[4 + i]; } }
            if (kind == 0) {
                const int colpos = 32 * qt + r32;
#pragma unroll
                for (int a = 0; a < 2; ++a) { const int pos = a ? colpos : qb; const float* cp = rcos + pos * 16 + 8 * hh; const float* sp = rsin + pos * 16 + 8 * hh;
#pragma unroll
                    for (int e = 0; e < 2; ++e) { const f32x4 c = *(const f32x4*)(cp + 4 * e), s = *(const f32x4*)(sp + 4 * e);
                        const f32x4 x1 = qv[2 * a][e], x2 = qv[2 * a + 1][e]; qv[2 * a][e] = x1 * c - x2 * s; qv[2 * a + 1][e] = x2 * c + x1 * s; } }
            }
#pragma unroll
            for (int ks = 0; ks < 4; ++ks)
#pragma unroll
                for (int i = 0; i < 4; ++i) { qf[qt][ks][i] = (h16)(qv[ks][0][i] * 0.125f); qf[qt][ks][4 + i] = (h16)(qv[ks][1][i] * 0.125f); }
        }
        const float sink = p.at_sink[jl * 32 + head] * 1.4426950408889634f;
        float mrun[2] = {sink, sink}, lrun[2] = {hh == 0 ? 1.f : 0.f, hh == 0 ? 1.f : 0.f};
        f32x16 oacc[2][2];
#pragma unroll
        for (int a = 0; a < 2; ++a)
#pragma unroll
            for (int c = 0; c < 2; ++c)
#pragma unroll
                for (int i = 0; i < 16; ++i) oacc[a][c][i] = 0.f;
        const int ntile = kind ? 4 : 9;
#pragma unroll 1
        for (int ti = 0; ti < ntile; ++ti) {
            int krow0, mask = 0; bool rope = false;
            if (kind == 0 && ti < 5) { const int k0 = qb * 64 - 128 + 64 * ti; if (k0 < 0 || k0 >= SEQ) continue; krow0 = b * 4096 + k0; rope = true; mask = (ti == 0) ? 1 : (ti == 4) ? 2 : 0; }
            else { const int c = kind ? ti : ti - 5; krow0 = ctxrow0 + 64 * c; }
            __syncthreads();
            if (tid < 256) {
                const int key = tid >> 2, cp = tid & 3, dA = (cp & 1) * 8 + (cp >> 1) * 32;
                const h16* kp = qk + (size_t)(krow0 + key) * DQK + D + g * 64 + dA;
                const f16x8 t1 = *(const f16x8*)kp, t2 = *(const f16x8*)(kp + 16);
                f16x8 o1 = t1, o2 = t2;
                if (rope) { const int kpos = (krow0 - b * 4096) + key; const int pos = (cp >> 1) ? (kpos & 63) : (kpos >> 6);
                    const float* cpp = rcos + pos * 16 + (cp & 1) * 8; const float* spp = rsin + pos * 16 + (cp & 1) * 8;
#pragma unroll
                    for (int i = 0; i < 8; ++i) { const float c = cpp[i], s = spp[i], x1 = (float)t1[i], x2 = (float)t2[i]; o1[i] = (h16)(x1 * c - x2 * s); o2[i] = (h16)(x2 * c + x1 * s); } }
                *(LAS f16x8*)(Ks + key * AT_KP + dA) = o1; *(LAS f16x8*)(Ks + key * AT_KP + dA + 16) = o2;
            } else {
                const int t = tid - 256, dim = t >> 2, kc = t & 3;
                const h16* vp = vt + (size_t)(g * 64 + dim) * TT + krow0 + 16 * kc;
                const f16x8 a = *(const f16x8*)vp, c = *(const f16x8*)(vp + 8);
                LAS h16* dst = Vs + dim * AT_VP + 16 * kc;
                *(LAS f16x4*)(dst) = (f16x4){a[0], a[1], a[2], a[3]}; *(LAS f16x4*)(dst + 4) = (f16x4){a[4], a[5], a[6], a[7]};
                *(LAS f16x4*)(dst + 8) = (f16x4){c[0], c[1], c[2], c[3]}; *(LAS f16x4*)(dst + 12) = (f16x4){c[4], c[5], c[6], c[7]};
            }
            __syncthreads();
#pragma unroll
            for (int qt = 0; qt < 2; ++qt) {
                f32x16 sacc[2];
#pragma unroll
                for (int kt = 0; kt < 2; ++kt)
#pragma unroll
                    for (int i = 0; i < 16; ++i) sacc[kt][i] = 0.f;
#pragma unroll
                for (int ks = 0; ks < 4; ++ks)
#pragma unroll
                    for (int kt = 0; kt < 2; ++kt) { const f16x8 kf = *(const LAS f16x8*)(Ks + (32 * kt + r32) * AT_KP + 16 * ks + 8 * hh);
                        sacc[kt] = __builtin_amdgcn_mfma_f32_32x32x16_f16(kf, qf[qt][ks], sacc[kt], 0, 0, 0); }
                const int qq = 32 * qt + r32; float tmax = -3.0e38f;
#pragma unroll
                for (int kt = 0; kt < 2; ++kt)
#pragma unroll
                    for (int i = 0; i < 16; ++i) { float s = sacc[kt][i] * 1.4426950408889634f; const int kk = 32 * kt + (i & 3) + 8 * (i >> 2) + 4 * hh;
                        if (mask == 1 && kk < qq) s = -1.0e30f; if (mask == 2 && kk > qq) s = -1.0e30f;
                        sacc[kt][i] = s; tmax = fmaxf(tmax, s); }
                tmax = fmaxf(tmax, shx(tmax, 32));
                const float mnew = fmaxf(mrun[qt], tmax); const float alpha = __builtin_amdgcn_exp2f(mrun[qt] - mnew); mrun[qt] = mnew;
                float psum = 0.f; f16x8 pf[2][2];
#pragma unroll
                for (int kt = 0; kt < 2; ++kt)
#pragma unroll
                    for (int s2 = 0; s2 < 2; ++s2)
#pragma unroll
                        for (int jj = 0; jj < 8; ++jj) { const float pv = __builtin_amdgcn_exp2f(sacc[kt][8 * s2 + jj] - mnew); psum += pv; pf[kt][s2][jj] = (h16)pv; }
                lrun[qt] = lrun[qt] * alpha + psum;
#pragma unroll
                for (int dt = 0; dt < 2; ++dt)
#pragma unroll
                    for (int i = 0; i < 16; ++i) oacc[dt][qt][i] *= alpha;
#pragma unroll
                for (int kt = 0; kt < 2; ++kt)
#pragma unroll
                    for (int s2 = 0; s2 < 2; ++s2)
#pragma unroll
                        for (int dt = 0; dt < 2; ++dt) { const LAS h16* vr = Vs + (32 * dt + r32) * AT_VP + 32 * kt + 16 * s2 + 4 * hh;
                            const f16x4 v0 = *(const LAS f16x4*)vr, v1 = *(const LAS f16x4*)(vr + 8);
                            const f16x8 vf = (f16x8){v0[0], v0[1], v0[2], v0[3], v1[0], v1[1], v1[2], v1[3]};
                            oacc[dt][qt] = __builtin_amdgcn_mfma_f32_32x32x16_f16(vf, pf[kt][s2], oacc[dt][qt], 0, 0, 0); }
            }
        }
#pragma unroll
        for (int qt = 0; qt < 2; ++qt) {
            const float ltot = lrun[qt] + shx(lrun[qt], 32); const float inv = 1.0f / ltot;
            h16* op = ob + (size_t)(qrow0 + 32 * qt + r32) * D + head * 64 + 4 * hh;
#pragma unroll
            for (int dt = 0; dt < 2; ++dt)
#pragma unroll
                for (int q4 = 0; q4 < 4; ++q4) { f16x4 w;
#pragma unroll
                    for (int i = 0; i < 4; ++i) w[i] = (h16)(oacc[dt][qt][4 * q4 + i] * inv);
                    *(f16x4*)(op + 32 * dt + 8 * q4) = w; }
        }
    }
}

constexpr int NPHASE = 35;
#ifndef MK_MULTI
#define MK_MULTI 0
#endif

template <int KIND>
__global__ void __launch_bounds__(512, 2) hy_fwd(Params p_) {
    extern __shared__ __attribute__((aligned(16))) unsigned char shm[];
    LAS unsigned char* lds = (LAS unsigned char*)shm;
    constexpr bool ALL = KIND < 0;
    const int ph0 = p_.ph0;
    if (threadIdx.x == 0) { *(LAS u32x4*)(lds + LDS_XB) = (u32x4){0u, 0u, 0u, 0u}; }
    __syncthreads();
    XcdBarrier bar;
    if constexpr (ALL) bar = xcd_barrier_post((unsigned*)(p_.ws + WS_CTL), (volatile LAS unsigned*)(lds + LDS_XB));
#ifndef PROBE_SITE
#define PROBE_SITE -1
#endif
#define SITE(k) if constexpr (ALL || KIND == (k)) for (int rep_ = 0; rep_ < ((k) == PROBE_SITE ? 2 : 1); ++rep_) if (const Params& p = *params_fresh(); true)
#define SEAM() do { if constexpr (ALL) xcd_barrier(bar); } while (0)
    const int G = gridDim.x, bid = blockIdx.x;
    SITE(0) {
        for (int u = bid; u < 20353; u += G) {
            if (u < 384) modp_unit(p, u, (LAS float*)lds);
            else if (u == 384) tables_unit(p);
            else if (u < 1473) h2_task(p, (u - 385) * 8 + (tid_fresh() >> 6));
            else if (u < 1537) w3p_unit(p, u - 1473);
            else if (u < 1793) rtab_unit(p, u - 1537);
            else if (u < 4993) cvt_dense_unit(p, u - 1793, (LAS float*)lds);
            else cvt_moe_unit(p, 0, u - 4993, (LAS float*)lds);
        }
        SEAM();
    }
    SITE(1) {
        for (int u = bid; u < 216; u += G) modr_unit(p, u);
        SchedFilt S{p.ws + WS_W3P, p.ws + WS_H2P}; EpiTaps E{(float*)(p.ws + WS_TAPS), (float*)(p.ws + WS_TAPSC)};
        pg8::gemm_phase<EpiTaps, SchedFilt, false>(lds, 256, S, E);
        SEAM();
    }
#pragma unroll 1
    for (int layer = ALL ? 0 : ph0; layer < (ALL ? NLAYER : ph0 + 1); ++layer) {
        const bool hyena = (layer & 1) == 0; const int jl = layer >> 1;
        SITE(2) {
            n1_phase(p, layer);
            for (int rep2_ = 0; rep2_ < ((PROBE_SITE == 20 && layer > 0) ? 2 : 1); ++rep2_) {
            if (layer == 0) filt_fft_phase(p, lds);
            else { for (int u = bid; u < CVT_MOE_UNITS; u += G) cvt_moe_unit(p, layer, u, (LAS float*)lds); } }
            SEAM();
        }
        SITE(3) {
            if (hyena) { SchedPlain S{24, 136, D, p.ws + WS_WIN + (size_t)jl * D3 * D * 2, p.ws + WS_HBUF}; EpiH16 E{(h16*)(p.ws + WS_UT), TT, nullptr, 0};
                pg8::gemm_phase<EpiH16, SchedPlain, false>(lds, D, S, E); }
            else { SchedQkv S{p.ws + WS_HBUF, p.ws + WS_WQKV + (size_t)jl * DQKV * D * 2}; EpiH16 E{(h16*)(p.ws + WS_QK), DQK, (h16*)(p.ws + WS_VT), TT};
                pg8::gemm_phase<EpiH16, SchedQkv, false>(lds, D, S, E); }
            SEAM();
        }
        SITE(4) {
#ifdef PROBE_PAR
            for (int rep3_ = 0; rep3_ < (((layer & 1) == PROBE_PAR) ? 2 : 1); ++rep3_)
#endif
            { if (hyena) conv_phase(p, jl, lds);
            else attn_phase(p, jl, layer != NLAYER - 1, lds); }
            SEAM();
        }
        SITE(5) {
            if (hyena) { transpose_phase(p, (LAS h16*)lds); SEAM(); }
        }
        SITE(6) {
            SchedPlain S{136, 8, D, p.ws + WS_HBUF, hyena ? p.ws + WS_WOUT + (size_t)jl * D * D * 2 : p.ws + WS_WO + (size_t)jl * D * D * 2};
            EpiResid E{(float*)(p.ws + WS_XRES), (const float*)(p.ws + WS_MODS), layer, (float*)(p.ws + WS_SSQ)};
            pg8::gemm_phase<EpiResid, SchedPlain, false>(lds, D, S, E);
            SEAM();
        }
        SITE(7) { n2_phase(p, layer, lds, ALL ? 0 : p.ph1); SEAM(); }
        LAS int* tstart = (LAS int*)(lds + LDS_MISC); LAS int* texp = tstart + 80; LAS int* tcnt = texp + 352;
        SITE(8) {
            moe_table(tstart, texp, tcnt, (const int*)(p.ws + WS_CTL) + CTL_CNT + layer * NE);
            SchedMoe1 S{{tstart, texp, tcnt}, p.ws + WS_HBUF, p.ws + WS_W13, (const int*)(p.ws + WS_LIST)}; EpiMoe1 E{(h16*)(p.ws + WS_H1)};
            pg8::gemm_phase<EpiMoe1, SchedMoe1, true>(lds, D, S, E);
            SEAM();
        }
        SITE(9) {
            moe_table(tstart, texp, tcnt, (const int*)(p.ws + WS_CTL) + CTL_CNT + layer * NE);
            SchedMoe2 S{{tstart, texp, tcnt}, p.ws + WS_H1, p.ws + WS_W2, (const int*)(p.ws + WS_LIST)}; EpiMoe2 E{(h16*)(p.ws + WS_YC), (const float*)(p.ws + WS_GATE), (const int*)(p.ws + WS_LIST)};
            pg8::gemm_phase<EpiMoe2, SchedMoe2, false>(lds, DE, S, E);
            SEAM();
        }
    }
    SITE(10) final_phase(p);
#undef SITE
#undef SEAM
}

template <int KIND> static void launch_kind(const Params& p, int grid, hipStream_t stream) {
    static bool attr = false;
    if (!attr) { attr = true; if (hipFuncSetAttribute((const void*)hy_fwd<KIND>, hipFuncAttributeMaxDynamicSharedMemorySize, LDS_BYTES) != hipSuccess) fprintf(stderr, "kernel_launch: hipFuncSetAttribute failed (kind %d)\n", KIND); }
    hipLaunchKernelGGL(hy_fwd<KIND>, dim3(grid), dim3(512), LDS_BYTES, stream, p);
}

extern "C" void kernel_launch(void* const* d_in, const int* in_sizes, int n_in, void* d_out, int out_size, void* d_ws, size_t ws_size, hipStream_t stream) {
    static int grid = 0;
    if (!grid) {
        if (n_in != 29 || out_size != TL * D || ws_size < WS_END) { fprintf(stderr, "kernel_launch: unexpected problem (n_in %d, out %d, ws %zu < %zu)\n", n_in, out_size, ws_size, (size_t)WS_END); grid = -1; return; }
        int dev = 0, cus = 0;
        if (hipGetDevice(&dev) != hipSuccess || hipDeviceGetAttribute(&cus, hipDeviceAttributeMultiprocessorCount, dev) != hipSuccess) { grid = -1; return; }
        grid = cus;
    }
    if (grid <= 0) return;
    (void)hipMemsetAsync((char*)d_ws + WS_CTL, 0, CTL_BYTES, stream);
    Params p{};
    const float** pp = (const float**)&p;
    for (int i = 0; i < 29; ++i) pp[i] = (const float*)d_in[i];
    p.out = (float*)d_out; p.ws = (char*)d_ws;
#if MK_MULTI
    p.ph0 = 0; p.ph1 = 0;
    launch_kind<0>(p, grid, stream); launch_kind<1>(p, grid, stream);
#ifndef PROBE_KIND
#define PROBE_KIND -1
#endif
#ifndef PROBE_LAYERS
#define PROBE_LAYERS 15
#endif
#define PREP(k) (((k) == PROBE_KIND && ((PROBE_LAYERS >> layer) & 1)) ? 2 : 1)
    if (PROBE_KIND == 0) launch_kind<0>(p, grid, stream);
    if (PROBE_KIND == 1) launch_kind<1>(p, grid, stream);
    for (int layer = 0; layer < NLAYER; ++layer) { p.ph0 = layer;
        for (int r = 0; r < PREP(2); ++r) launch_kind<2>(p, grid, stream);
        for (int r = 0; r < PREP(3); ++r) launch_kind<3>(p, grid, stream);
        for (int r = 0; r < PREP(4); ++r) launch_kind<4>(p, grid, stream);
        if ((layer & 1) == 0) for (int r = 0; r < PREP(5); ++r) launch_kind<5>(p, grid, stream);
        launch_kind<6>(p, grid, stream); launch_kind<7>(p, grid, stream);
        if (PREP(7) == 2) { p.ph1 = 1; launch_kind<7>(p, grid, stream); p.ph1 = 0; }
        for (int r = 0; r < PREP(8); ++r) launch_kind<8>(p, grid, stream);
        for (int r = 0; r < PREP(9); ++r) launch_kind<9>(p, grid, stream); }
    p.ph0 = 0; launch_kind<10>(p, grid, stream);
    if (PROBE_KIND == 10) launch_kind<10>(p, grid, stream);
#else
    p.ph0 = 0; p.ph1 = NPHASE;
    launch_kind<-1>(p, grid, stream);
#endif
}
```

```cpp
#include <hip/hip_runtime.h>
#include <cstdio>
#include <cstdint>

#define LAS __attribute__((address_space(3)))
typedef _Float16 h16;
typedef _Float16 f16x8 __attribute__((ext_vector_type(8)));
typedef _Float16 f16x4 __attribute__((ext_vector_type(4)));
typedef _Float16 f16x2 __attribute__((ext_vector_type(2)));
typedef float f32x2 __attribute__((ext_vector_type(2)));
typedef float f32x4 __attribute__((ext_vector_type(4)));
typedef float f32x16 __attribute__((ext_vector_type(16)));
typedef unsigned u32x2 __attribute__((ext_vector_type(2)));
typedef unsigned u32x4 __attribute__((ext_vector_type(4)));

constexpr int D = 2048, NB = 8, SEQ = 4096, CTXL = 256, TL = NB * SEQ, TC = NB * CTXL, TT = TL + TC;
constexpr int D3 = 3 * D, D6 = 6 * D, DQK = 2304, DQKV = 2560, NE = 64, DE = 384, DE2 = 768, NLAYER = 4;
constexpr int LCAP = TT;
constexpr int MOE_ROWS = 86016;
constexpr float EPS = 1e-6f;

constexpr size_t WS_CTL = 0;
constexpr size_t CTL_BYTES = 65536;
constexpr size_t WS_TW = WS_CTL + CTL_BYTES;
constexpr size_t WS_ROPE = WS_TW + 65536;
constexpr size_t WS_MODP = WS_ROPE + 8192;
constexpr size_t WS_MODS = WS_MODP + 16ull * 4 * 9 * 12288 * 4;
constexpr size_t WS_RTAB = WS_MODS + 4ull * 9 * 12288 * 4;
constexpr size_t RTAB_L = 64ull * 5 * 2 * 64 * 8 * 2;
constexpr size_t WS_RCST = WS_RTAB + 4 * RTAB_L;
constexpr size_t WS_H2P = WS_RCST + 16384;
constexpr size_t WS_W3P = WS_H2P + 2ull * 4352 * 256 * 2;
constexpr size_t WS_XRES = WS_W3P + 2ull * 8192 * 256 * 2;
constexpr size_t WS_HBUF = WS_XRES + (size_t)TT * D * 4;
constexpr size_t WS_UT = WS_HBUF + (size_t)TT * D * 2;
constexpr size_t UT_BYTES = (size_t)D3 * TT * 2;
constexpr size_t WS_TAPS = WS_UT;
constexpr size_t WS_TAPSC = WS_TAPS + 2ull * 8192 * 4096 * 4;
constexpr size_t WS_QK = WS_UT;
constexpr size_t WS_VT = WS_QK + (size_t)TT * DQK * 2;
constexpr size_t WS_ZT = WS_UT + UT_BYTES;
constexpr size_t WS_H1 = WS_ZT + (size_t)D * TT * 2;
constexpr size_t WS_YC = WS_H1 + (size_t)MOE_ROWS * DE * 2;
constexpr size_t WS_WIN = WS_YC + 2ull * TT * D * 2;
constexpr size_t WS_WOUT = WS_WIN + 2ull * D3 * D * 2;
constexpr size_t WS_WQKV = WS_WOUT + 2ull * D * D * 2;
constexpr size_t WS_WO = WS_WQKV + 2ull * DQKV * D * 2;
constexpr size_t WS_W13 = WS_WO + 2ull * D * D * 2;
constexpr size_t WS_W2 = WS_W13 + (size_t)NE * DE2 * D * 2;
constexpr size_t WS_KF = WS_W2 + (size_t)NE * D * DE * 2;
constexpr size_t WS_KFC = WS_KF + 2ull * 2 * 2048 * 65536;
constexpr size_t WS_LIST = WS_KFC + 2ull * 2 * 2048 * 4096;
constexpr size_t WS_GATE = WS_LIST + (size_t)NE * LCAP * 4;
constexpr size_t WS_SSQ = WS_GATE + (size_t)NE * LCAP * 4;
constexpr size_t WS_END = WS_SSQ + (size_t)TT * 32 * 4;
static_assert(WS_TAPSC + 2ull * 8192 * 256 * 4 <= WS_UT + UT_BYTES, "taps alias");
static_assert(WS_VT + 256ull * TT * 2 <= WS_UT + UT_BYTES, "qkv alias");

constexpr int CTL_CNT = 4096;

constexpr int LDS_BYTES = 147456;
constexpr int LDS_MISC = 139264;
constexpr int LDS_XB = LDS_BYTES - 16;

struct Params {
    const float *x, *c, *ctx, *c_ctx, *mod_w, *mod_b, *hy_w_in, *hy_conv_w, *hy_conv_b, *hy_f_w1, *hy_f_b1, *hy_f_freq1, *hy_f_w2, *hy_f_b2, *hy_f_freq2, *hy_f_w3,
        *hy_bias, *hy_w_out, *at_w_qkv, *at_sink, *at_w_o, *moe_wg, *moe_bg, *moe_we, *moe_be, *moe_w1, *moe_w3, *moe_w2, *final_gain;
    float* out; char* ws; int ph0, ph1;
};

__device__ __forceinline__ int tid_fresh() { int t = threadIdx.x; asm volatile("" : "+v"(t)); return t; }
__device__ __forceinline__ float bperm_f(float v, int srclane) { return __int_as_float(__builtin_amdgcn_ds_bpermute(srclane << 2, __float_as_int(v))); }
__device__ __forceinline__ float shx(float v, int mask) { return bperm_f(v, (tid_fresh() & 63) ^ mask); }
__device__ __forceinline__ const Params* params_fresh() { auto q = __builtin_amdgcn_kernarg_segment_ptr(); asm volatile("" : "+s"(q)); return (const Params*)q; }

#define XB_TMO      128
#define XB_XCNT(j)  (256  + 64 * (j))
#define XB_XSUB(j)  (1280 + 64 * (j))
#define XB_XGEN(j)  (2304 + 64 * (j))
#define XB_TOP      3328
#define XB_TOPGEN   3392
#define XCD_BAR_WORDS 3456
#define XB_SPIN_CAP (1u << 18)

__device__ __forceinline__ unsigned xb_ld(unsigned* p)              { return __hip_atomic_load(p, __ATOMIC_RELAXED, __HIP_MEMORY_SCOPE_AGENT); }
__device__ __forceinline__ unsigned xb_add(unsigned* p, unsigned v) { return __hip_atomic_fetch_add(p, v, __ATOMIC_RELAXED, __HIP_MEMORY_SCOPE_AGENT); }
__device__ __forceinline__ unsigned xb_xcc_id() { return (unsigned)__builtin_amdgcn_s_getreg((3 << 11) | 20) & 0xFu; }
#define XB_SPIN(cond, bar) do { unsigned _sp = 0; while (cond) { __builtin_amdgcn_s_sleep(1); \
    if ((++_sp & 255u) == 0u) { if (xb_ld(&(bar)[XB_TMO])) break; if (_sp > XB_SPIN_CAP) { atomicAdd(&(bar)[XB_TMO], 1u); break; } } } } while (0)

struct XcdBarrier { unsigned* bar; volatile LAS unsigned* st; };

__device__ __forceinline__ XcdBarrier xcd_barrier_post(unsigned* bar, volatile LAS unsigned* st) {
    XcdBarrier b; b.bar = bar; b.st = st;
    if (threadIdx.x == 0) (void)xb_add(&bar[XB_XCNT(xb_xcc_id())], 1u);
    return b;
}
__device__ __forceinline__ void xcd_barrier_complete(unsigned* bar, unsigned x, unsigned& nloc, unsigned& nx) {
    const unsigned G = gridDim.x * gridDim.y * gridDim.z;
    unsigned sum, cnt, mine, sp = 0u;
    for (;;) {
        sum = 0u; cnt = 0u; mine = 0u;
#pragma unroll
        for (unsigned j = 0; j < 16; ++j) { const unsigned c = xb_ld(&bar[XB_XCNT(j)]); sum += c; cnt += (c > 0u) ? 1u : 0u; mine = (j == x) ? c : mine; }
        if (sum == G) break;
        __builtin_amdgcn_s_sleep(1);
        if ((++sp & 255u) == 0u) { if (xb_ld(&bar[XB_TMO])) break; if (sp > XB_SPIN_CAP) { atomicAdd(&bar[XB_TMO], 1u); break; } }
    }
    nloc = mine > 0u ? mine : 1u; nx = cnt > 0u ? cnt : 1u;
}
__device__ __forceinline__ void xcd_barrier(const XcdBarrier& b) {
    asm volatile("s_waitcnt vmcnt(0)" ::: "memory");
    __syncthreads();
    if (threadIdx.x == 0) {
        unsigned* bar = b.bar; const unsigned bx = xb_xcc_id();
        __builtin_amdgcn_s_waitcnt(0);
        unsigned nloc = b.st[0], nx = b.st[1];
        if (nloc == 0u) { xcd_barrier_complete(bar, bx, nloc, nx); b.st[0] = nloc; b.st[1] = nx; }
        const unsigned old = xb_add(&bar[XB_XSUB(bx)], 1u);
        const unsigned gen = old / nloc;
        if (old + 1u == (gen + 1u) * nloc) {
            __builtin_amdgcn_fence(__ATOMIC_RELEASE, "agent");
            asm volatile("s_waitcnt vmcnt(0)" ::: "memory");
            const unsigned og = xb_add(&bar[XB_TOP], 1u);
            const unsigned tg = og / nx;
            if (og + 1u == (tg + 1u) * nx) xb_add(&bar[XB_TOPGEN], 1u);
            else XB_SPIN(xb_ld(&bar[XB_TOPGEN]) == tg, bar);
            __builtin_amdgcn_fence(__ATOMIC_ACQUIRE, "agent");
            xb_add(&bar[XB_XGEN(bx)], 1u);
            asm volatile("s_waitcnt vmcnt(0)" ::: "memory");
        } else {
            XB_SPIN(xb_ld(&bar[XB_XGEN(bx)]) == gen, bar);
            __builtin_amdgcn_fence(__ATOMIC_ACQUIRE, "agent");
            asm volatile("s_waitcnt vmcnt(0)" ::: "memory");
        }
    }
    __syncthreads();
}

namespace pg8 {
constexpr int BM = 256, BK = 64, HALF = 128, HTB = HALF * BK * 2, STAGE_BYTES = 8 * HTB;
__device__ __forceinline__ int lds_byte(int r, int c) { const int st = (r >> 4) * 2 + (c >> 5), rr = r & 15, cc = c & 31, ob = rr * 64 + cc * 2; return st * 1024 + (ob ^ (((ob >> 9) & 1) << 5)); }
__device__ __forceinline__ void stage_rc(int b, int& R, int& C) { const int st = b / 1024, sb = b % 1024, swz = sb ^ (((sb >> 9) & 1) << 5); R = (st >> 1) * 16 + swz / 64; C = (st & 1) * 32 + (swz % 64) / 2; }
__device__ __forceinline__ int perm32(int rho) { const int n = rho >> 4, i = rho & 15; return 8 * (i >> 2) + 4 * n + (i & 3); }

struct Unit {
    int pm, pn;
    int e, pos0, cnt;
    int kind;
    const char* A; const char* B;
    const int* rows;
};

template <class Epi, class Sched, bool GATHER>
__device__ __forceinline__ void gemm_phase(LAS unsigned char* lds, const int K, const Sched& S, const Epi& E) {
    const int tid = tid_fresh(), wid = __builtin_amdgcn_readfirstlane(tid >> 6), lane = tid & 63, wr = wid >> 2, wc = wid & 3, fr = lane & 15, fq = lane >> 4;
    const int nt = K / BK;
    unsigned voffA[2], voffB[2]; int RA[2], CA[2];
#pragma unroll
    for (int i = 0; i < 2; ++i) { int R, C; stage_rc(tid * 16 + i * 8192, R, C); const int Rb = Epi::PERM ? ((R & ~31) + perm32(R & 31)) : R;
        voffA[i] = (unsigned)(R * K + C) * 2u; voffB[i] = (unsigned)(Rb * K + C) * 2u; RA[i] = R; CA[i] = C; }
    const size_t kstep = (size_t)(BK * 2);
    const size_t hstep = (size_t)HALF * K * 2;
    const unsigned ldsw = (unsigned)wid * 1024u;
    const int aoff = lds_byte(wr * 64 + fr, fq * 8), boff = lds_byte(wc * 32 + fr, fq * 8);
    unsigned vgC[2][2], vgN[2][2];
#define PG8_ROWS(u, vg) do { if constexpr (GATHER) { _Pragma("unroll") for (int _h = 0; _h < 2; ++_h) _Pragma("unroll") for (int _i = 0; _i < 2; ++_i) { \
        const int _p = (u).pos0 + _h * HALF + RA[_i]; const int _tok = (_p < (u).cnt) ? ((u).rows[_h * HALF + RA[_i]] >> 1) : 0; \
        vg[_h][_i] = ((unsigned)_tok * (unsigned)K + (unsigned)CA[_i]) * 2u; } } } while (0)
#define PG8_SA(b, h) (((b) * 2 + (h)) * HTB)
#define PG8_SB(b, h) ((4 + (b) * 2 + (h)) * HTB)
#define PG8_STAGE_B(bufoff, gbase) do { _Pragma("unroll") for (int _i = 0; _i < 2; ++_i) \
        __builtin_amdgcn_global_load_lds((const unsigned*)((const char*)(gbase) + voffB[_i]), (LAS unsigned*)(lds + (bufoff) + ldsw + _i * 8192), 16, 0, 0); } while (0)
#define PG8_STAGE_A(bufoff, gbase, h, NEXT) do { _Pragma("unroll") for (int _i = 0; _i < 2; ++_i) { \
        const unsigned _vo = GATHER ? ((NEXT) ? vgN[h][_i] : vgC[h][_i]) : voffA[_i]; \
        __builtin_amdgcn_global_load_lds((const unsigned*)((const char*)(gbase) + (GATHER ? (size_t)0 : (size_t)(h) * hstep) + _vo), (LAS unsigned*)(lds + (bufoff) + ldsw + _i * 8192), 16, 0, 0); } } while (0)
#define PG8_LDA(dst, b, h) do { _Pragma("unroll") for (int m = 0; m < 4; ++m) _Pragma("unroll") for (int k = 0; k < 2; ++k) dst[m][k] = *(const LAS f16x8*)(lds + PG8_SA(b, h) + aoff + m * 2048 + k * 1024); } while (0)
#define PG8_LDB(dst, b, h) do { _Pragma("unroll") for (int n = 0; n < 2; ++n) _Pragma("unroll") for (int k = 0; k < 2; ++k) dst[n][k] = *(const LAS f16x8*)(lds + PG8_SB(b, h) + boff + n * 2048 + k * 1024); } while (0)
#define PG8_MMA(ai, bj, At, Bt) do { __builtin_amdgcn_s_setprio(1); _Pragma("unroll") for (int m = 0; m < 4; ++m) _Pragma("unroll") for (int n = 0; n < 2; ++n) _Pragma("unroll") for (int k = 0; k < 2; ++k) \
        acc[ai][bj][m][n] = __builtin_amdgcn_mfma_f32_16x16x32_f16(Bt[n][k], At[m][k], acc[ai][bj][m][n], 0, 0, 0); __builtin_amdgcn_s_setprio(0); } while (0)
#define PG8_WAIT_V(n) asm volatile("s_waitcnt vmcnt(" #n ")" ::: "memory")
#define PG8_WAIT_L(n) asm volatile("s_waitcnt lgkmcnt(" #n ")" ::: "memory")
#define PG8_BAR __builtin_amdgcn_s_barrier()
#define PG8_SCHED __builtin_amdgcn_sched_barrier(0)
    Unit cur, nxt; int ui = 0;
    if (!S.next(0, cur)) return;
    f32x4 acc[2][2][4][2];
#pragma unroll
    for (int a = 0; a < 2; ++a)
#pragma unroll
        for (int b = 0; b < 2; ++b)
#pragma unroll
            for (int m = 0; m < 4; ++m)
#pragma unroll
                for (int n = 0; n < 2; ++n) acc[a][b][m][n] = (f32x4){0.f, 0.f, 0.f, 0.f};
    f16x8 At[4][2], B0[2][2], B1[2][2];
    const char* cA = cur.A; const char* cB = cur.B;
    PG8_ROWS(cur, vgC);
#pragma unroll
    for (int _h = 0; _h < 2; ++_h)
#pragma unroll
        for (int _i = 0; _i < 2; ++_i) vgN[_h][_i] = GATHER ? vgC[_h][_i] : 0u;
    PG8_STAGE_B(PG8_SB(0, 0), cB); PG8_STAGE_B(PG8_SB(0, 1), cB + hstep); PG8_STAGE_A(PG8_SA(0, 0), cA, 0, false); PG8_STAGE_A(PG8_SA(0, 1), cA, 1, false);
    if (wr == 1) PG8_BAR;
    PG8_WAIT_V(2); PG8_BAR;
    PG8_STAGE_B(PG8_SB(1, 0), cB + kstep); PG8_STAGE_A(PG8_SA(1, 0), cA + kstep, 0, false); PG8_STAGE_B(PG8_SB(1, 1), cB + hstep + kstep);
    PG8_WAIT_V(6); PG8_BAR;
    for (;;) {
        const bool has_next = S.next(ui + 1, nxt);
        const char* nA = has_next ? nxt.A : cA; const char* nB = has_next ? nxt.B : cB;
        if (has_next) { PG8_ROWS(nxt, vgN); }
#pragma unroll 1
        for (int t = 0; t < nt; t += 2) {
            const bool last = (t == nt - 2);
            const char* a1 = cA + (size_t)(t + 1) * kstep;
            const char* a2 = last ? nA : cA + (size_t)(t + 2) * kstep; const char* b2 = last ? nB : cB + (size_t)(t + 2) * kstep;
            const char* a3 = a2 + kstep; const char* b3 = b2 + kstep;
            PG8_LDB(B0, 0, 0); PG8_LDB(B1, 0, 1); PG8_SCHED; PG8_LDA(At, 0, 0); PG8_STAGE_A(PG8_SA(1, 1), a1, 1, false);
            PG8_WAIT_V(8); PG8_WAIT_L(0); PG8_BAR; PG8_MMA(0, 0, At, B0); PG8_MMA(0, 1, At, B1); PG8_BAR; PG8_SCHED;
            PG8_LDA(At, 0, 1); PG8_STAGE_B(PG8_SB(0, 0), b2); PG8_STAGE_B(PG8_SB(0, 1), b2 + hstep); PG8_STAGE_A(PG8_SA(0, 0), a2, 0, last);
            PG8_WAIT_V(8); PG8_WAIT_L(0); PG8_BAR; PG8_MMA(1, 0, At, B0); PG8_MMA(1, 1, At, B1); PG8_BAR; PG8_SCHED;
            PG8_LDB(B0, 1, 0); PG8_LDB(B1, 1, 1); PG8_SCHED; PG8_LDA(At, 1, 0); PG8_STAGE_A(PG8_SA(0, 1), a2, 1, last);
            PG8_WAIT_V(8); PG8_WAIT_L(0); PG8_BAR; PG8_MMA(0, 0, At, B0); PG8_MMA(0, 1, At, B1); PG8_BAR; PG8_SCHED;
            PG8_LDA(At, 1, 1); PG8_STAGE_B(PG8_SB(1, 0), b3); PG8_STAGE_B(PG8_SB(1, 1), b3 + hstep); PG8_STAGE_A(PG8_SA(1, 0), a3, 0, last);
            PG8_WAIT_V(8); PG8_WAIT_L(0); PG8_BAR; PG8_MMA(1, 0, At, B0); PG8_MMA(1, 1, At, B1); PG8_BAR; PG8_SCHED;
        }
        if (wr == 0) PG8_BAR;
        E(acc, cur, wr, wc, fr, fq);
        if (!has_next) break;
#pragma unroll
        for (int a = 0; a < 2; ++a)
#pragma unroll
            for (int b = 0; b < 2; ++b)
#pragma unroll
                for (int m = 0; m < 4; ++m)
#pragma unroll
                    for (int n = 0; n < 2; ++n) acc[a][b][m][n] = (f32x4){0.f, 0.f, 0.f, 0.f};
        cur = nxt; cA = nA; cB = nB; ++ui;
#pragma unroll
        for (int _h = 0; _h < 2; ++_h)
#pragma unroll
            for (int _i = 0; _i < 2; ++_i) vgC[_h][_i] = vgN[_h][_i];
        if (wr == 1) PG8_BAR;
    }
    PG8_WAIT_V(0);
    PG8_BAR;
#undef PG8_ROWS
#undef PG8_SA
#undef PG8_SB
#undef PG8_STAGE_A
#undef PG8_STAGE_B
#undef PG8_LDA
#undef PG8_LDB
#undef PG8_MMA
#undef PG8_WAIT_V
#undef PG8_WAIT_L
#undef PG8_BAR
#undef PG8_SCHED
}
}

using pg8::Unit;
__device__ __forceinline__ f16x8 pack8(const f32x4 a, const f32x4 b) {
    f16x8 w; w[0] = (h16)a[0]; w[1] = (h16)a[1]; w[2] = (h16)a[2]; w[3] = (h16)a[3]; w[4] = (h16)b[0]; w[5] = (h16)b[1]; w[6] = (h16)b[2]; w[7] = (h16)b[3]; return w;
}
struct EpiH16 {
    static constexpr bool PERM = true;
    h16* O0; int ld0; h16* O1; int ld1;
    __device__ __forceinline__ void operator()(const f32x4 (&acc)[2][2][4][2], const Unit& u, int wr, int wc, int fr, int fq) const {
        h16* base = u.kind ? O1 : O0; const int ld = u.kind ? ld1 : ld0;
        const int row0 = u.pm * 256 + wr * 64 + fr, col0 = u.pn * 256 + wc * 32 + 8 * fq;
#pragma unroll
        for (int ai = 0; ai < 2; ++ai)
#pragma unroll
            for (int m = 0; m < 4; ++m) { h16* rowp = base + (size_t)(row0 + ai * 128 + m * 16) * ld + col0;
#pragma unroll
                for (int bj = 0; bj < 2; ++bj) *(f16x8*)(rowp + bj * 128) = pack8(acc[ai][bj][m][0], acc[ai][bj][m][1]); }
    }
};
struct EpiTaps {
    static constexpr bool PERM = false;
    float* T0; float* T1;
    __device__ __forceinline__ void operator()(const f32x4 (&acc)[2][2][4][2], const Unit& u, int wr, int wc, int fr, int fq) const {
        const int j = u.kind >> 1, v = u.kind & 1; const int ld = v ? 256 : 4096;
        float* base = v ? (T1 + (size_t)j * 8192 * 256) : (T0 + (size_t)j * 8192 * 4096);
        const int row0 = u.pm * 256 + wr * 64 + fr, col0 = u.pn * 256 + wc * 32 + 4 * fq;
#pragma unroll
        for (int ai = 0; ai < 2; ++ai)
#pragma unroll
            for (int m = 0; m < 4; ++m) { float* rowp = base + (size_t)(row0 + ai * 128 + m * 16) * ld + col0;
#pragma unroll
                for (int bj = 0; bj < 2; ++bj)
#pragma unroll
                    for (int n = 0; n < 2; ++n) *(f32x4*)(rowp + bj * 128 + n * 16) = acc[ai][bj][m][n]; }
    }
};
struct EpiResid {
    static constexpr bool PERM = false;
    float* X; const float* mods; int layer; float* SSQ;
    __device__ __forceinline__ void operator()(const f32x4 (&acc)[2][2][4][2], const Unit& u, int wr, int wc, int fr, int fq) const {
        const int r0 = u.pm * 256; const int b = r0 < TL ? (r0 >> 12) : 8;
        const float* g = mods + ((size_t)(layer * 9 + b) * 6 + 2) * D;
        const int row0 = r0 + wr * 64 + fr, col0 = u.pn * 256 + wc * 32 + 4 * fq;
        f32x4 gv[2][2];
#pragma unroll
        for (int bj = 0; bj < 2; ++bj)
#pragma unroll
            for (int n = 0; n < 2; ++n) gv[bj][n] = *(const f32x4*)(g + col0 + bj * 128 + n * 16);
#pragma unroll
        for (int ai = 0; ai < 2; ++ai)
#pragma unroll
            for (int m = 0; m < 4; ++m) { const int row = row0 + ai * 128 + m * 16; float* rowp = X + (size_t)row * D + col0; float sq = 0.f;
#pragma unroll
                for (int bj = 0; bj < 2; ++bj)
#pragma unroll
                    for (int n = 0; n < 2; ++n) { f32x4* pp = (f32x4*)(rowp + bj * 128 + n * 16); const f32x4 v = *pp + gv[bj][n] * acc[ai][bj][m][n]; *pp = v; sq += v[0] * v[0] + v[1] * v[1] + v[2] * v[2] + v[3] * v[3]; }
                sq += shx(sq, 16); sq += shx(sq, 32);
                if (fq == 0) SSQ[(size_t)row * 32 + u.pn * 4 + wc] = sq; }
    }
};
struct EpiMoe1 {
    static constexpr bool PERM = true;
    h16* H1;
    __device__ __forceinline__ void operator()(const f32x4 (&acc)[2][2][4][2], const Unit& u, int wr, int wc, int fr, int fq) const {
        const int row0 = u.pm * 256 + wr * 64 + fr, col0 = u.pn * 128 + wc * 16 + 4 * fq;
#pragma unroll
        for (int ai = 0; ai < 2; ++ai)
#pragma unroll
            for (int m = 0; m < 4; ++m) { h16* rowp = H1 + (size_t)(row0 + ai * 128 + m * 16) * DE + col0;
#pragma unroll
                for (int bj = 0; bj < 2; ++bj) { const f32x4 a = acc[ai][bj][m][0], b = acc[ai][bj][m][1]; f16x4 w;
#pragma unroll
                    for (int i = 0; i < 4; ++i) { const float s = a[i] / (1.0f + __expf(-a[i])); w[i] = (h16)(s * b[i]); }
                    *(f16x4*)(rowp + bj * 64) = w; } }
    }
};
struct EpiMoe2 {
    static constexpr bool PERM = true;
    h16* YC; const float* gslot;
    __device__ __forceinline__ void operator()(const f32x4 (&acc)[2][2][4][2], const Unit& u, int wr, int wc, int fr, int fq) const {
        const int col0 = u.pn * 256 + wc * 32 + 8 * fq;
        const float* grow = gslot + ((const char*)u.rows - (const char*)listbase) / 4;
        int av[2][4]; float gv[2][4];
#pragma unroll
        for (int ai = 0; ai < 2; ++ai)
#pragma unroll
            for (int m = 0; m < 4; ++m) { const int r = ai * 128 + wr * 64 + m * 16 + fr; const bool ok = u.pos0 + r < u.cnt; av[ai][m] = ok ? u.rows[r] : -1; gv[ai][m] = ok ? grow[r] : 0.f; }
#pragma unroll
        for (int ai = 0; ai < 2; ++ai)
#pragma unroll
            for (int m = 0; m < 4; ++m) { if (av[ai][m] >= 0) { const float g = gv[ai][m]; h16* rowp = YC + (size_t)av[ai][m] * D + col0;
#pragma unroll
                    for (int bj = 0; bj < 2; ++bj) *(f16x8*)(rowp + bj * 128) = pack8(acc[ai][bj][m][0] * g, acc[ai][bj][m][1] * g); } }
    }
    const int* listbase;
};

__device__ __forceinline__ void order_tile(int wgid, int nM, int nN, int& pm, int& pn) {
    const int nwg = nM * nN; { const int q = nwg / 8, r = nwg % 8, xcd = wgid % 8, off = wgid / 8; wgid = (xcd < r ? xcd * (q + 1) : r * (q + 1) + (xcd - r) * q) + off; }
    const int nig = 8 * nN, gid = wgid / nig, fm = gid * 8, gsz = (nM - fm) < 8 ? (nM - fm) : 8;
    pm = fm + ((wgid % nig) % gsz); pn = (wgid % nig) / gsz;
}
struct SchedPlain {
    int nM, nN, K; const char* A; const char* B;
    __device__ __forceinline__ bool next(int i, Unit& u) const {
        const long L = (long)i * gridDim.x + blockIdx.x; if (L >= (long)nM * nN) return false;
        order_tile((int)L, nM, nN, u.pm, u.pn); u.kind = 0; u.e = 0; u.pos0 = 0; u.cnt = 0; u.rows = nullptr;
        u.A = A + (size_t)u.pm * 256 * K * 2; u.B = B + (size_t)u.pn * 256 * K * 2; return true;
    }
};
struct SchedQkv {
    const char* H; const char* W;
    __device__ __forceinline__ bool next(int i, Unit& u) const {
        const long L = (long)i * gridDim.x + blockIdx.x; const int nA = 136 * 9; if (L >= nA + 136) return false;
        u.e = 0; u.pos0 = 0; u.cnt = 0; u.rows = nullptr;
        if (L < nA) { order_tile((int)L, 136, 9, u.pm, u.pn); u.kind = 0; u.A = H + (size_t)u.pm * 256 * D * 2; u.B = W + (size_t)u.pn * 256 * D * 2; }
        else { u.pm = 0; u.pn = (int)L - nA; u.kind = 1; u.A = W + (size_t)DQK * D * 2; u.B = H + (size_t)u.pn * 256 * D * 2; }
        return true;
    }
};
struct SchedFilt {
    const char* W3P; const char* H2P;
    __device__ __forceinline__ bool next(int i, Unit& u) const {
        const long L = (long)i * gridDim.x + blockIdx.x; if (L >= 2 * 544) return false;
        const int j = (int)L / 544, r = (int)L % 544; u.e = 0; u.pos0 = 0; u.cnt = 0; u.rows = nullptr;
        int v; if (r < 512) { v = 0; u.pm = r >> 4; u.pn = r & 15; } else { v = 1; u.pm = r - 512; u.pn = 0; }
        u.kind = 2 * j + v;
        u.A = W3P + ((size_t)j * 8192 + (size_t)u.pm * 256) * 256 * 2;
        u.B = H2P + ((size_t)j * 4352 + (v ? 4096 : 0) + (size_t)u.pn * 256) * 256 * 2;
        return true;
    }
};
struct MoeTab { const LAS int* tstart; const LAS int* texp; const LAS int* cnt; };
struct SchedMoe1 {
    MoeTab tb; const char* H; const char* W13; const int* list;
    __device__ __forceinline__ bool next(int i, Unit& u) const {
        const long L = (long)i * gridDim.x + blockIdx.x; const int ntile = __builtin_amdgcn_readfirstlane(tb.tstart[NE]); if (L >= (long)ntile * 3) return false;
        int rt; order_tile((int)L, ntile, 3, rt, u.pn); u.pm = rt; u.kind = 0;
        const int e = __builtin_amdgcn_readfirstlane(tb.texp[rt]); u.e = e; u.pos0 = (rt - __builtin_amdgcn_readfirstlane(tb.tstart[e])) * 256; u.cnt = __builtin_amdgcn_readfirstlane(tb.cnt[e]);
        u.rows = list + (size_t)e * LCAP + u.pos0; u.A = H; u.B = W13 + ((size_t)e * DE2 + (size_t)u.pn * 256) * D * 2; return true;
    }
};
struct SchedMoe2 {
    MoeTab tb; const char* H1; const char* W2; const int* list;
    __device__ __forceinline__ bool next(int i, Unit& u) const {
        const long L = (long)i * gridDim.x + blockIdx.x; const int ntile = __builtin_amdgcn_readfirstlane(tb.tstart[NE]); if (L >= (long)ntile * 8) return false;
        int rt; order_tile((int)L, ntile, 8, rt, u.pn); u.pm = rt; u.kind = 0;
        const int e = __builtin_amdgcn_readfirstlane(tb.texp[rt]); u.e = e; u.pos0 = (rt - __builtin_amdgcn_readfirstlane(tb.tstart[e])) * 256; u.cnt = __builtin_amdgcn_readfirstlane(tb.cnt[e]);
        u.rows = list + (size_t)e * LCAP + u.pos0; u.A = H1 + (size_t)rt * 256 * DE * 2; u.B = W2 + ((size_t)e * D + (size_t)u.pn * 256) * DE * 2; return true;
    }
};
__device__ __forceinline__ void moe_table(LAS int* tstart, LAS int* texp, LAS int* cnt, const int* counters) {
    const int t = tid_fresh();
    if (t < NE) cnt[t] = counters[t];
    __syncthreads();
    if (t <= NE) { int s = 0; for (int e = 0; e < t; ++e) s += (cnt[e] + 255) >> 8; tstart[t] = s; }
    __syncthreads();
    if (t < NE) { const int s0 = tstart[t], s1 = tstart[t + 1]; for (int q = s0; q < s1; ++q) texp[q] = t; }
    __syncthreads();
}

__device__ __forceinline__ float wave_sum(float v) {
#pragma unroll
    for (int o = 32; o >= 1; o >>= 1) v += shx(v, o);
    return v;
}
__device__ __forceinline__ float silu_f(float x) { return x / (1.0f + expf(-x)); }
__device__ __forceinline__ int batch_of_row(int r) { return r < TL ? (r >> 12) : 8; }

__device__ __forceinline__ void modp_unit(const Params& p, int unit, LAS float* sl) {
    const int layer = unit / 96, rem = unit % 96, ks = rem / 6, cc = rem % 6, tid = tid_fresh();
    for (int i = tid; i < 9 * 128; i += 512) { const int cnd = i >> 7, k = ks * 128 + (i & 127); const float v = cnd < 8 ? p.c[cnd * D + k] : p.c_ctx[k]; sl[i] = silu_f(v); }
    __syncthreads();
    f32x4 acc[9];
#pragma unroll
    for (int q = 0; q < 9; ++q) acc[q] = (f32x4){0.f, 0.f, 0.f, 0.f};
    const float* w = p.mod_w + ((size_t)layer * D + (size_t)ks * 128) * D6 + cc * 2048 + tid * 4;
#pragma unroll 4
    for (int k = 0; k < 128; ++k) { const f32x4 wv = *(const f32x4*)(w + (size_t)k * D6);
#pragma unroll
        for (int q = 0; q < 9; ++q) acc[q] += wv * sl[q * 128 + k]; }
    float* outp = (float*)(p.ws + WS_MODP) + ((size_t)(ks * 4 + layer) * 9) * D6 + cc * 2048 + tid * 4;
#pragma unroll
    for (int q = 0; q < 9; ++q) *(f32x4*)(outp + (size_t)q * D6) = acc[q];
    __syncthreads();
}
__device__ __forceinline__ void modr_unit(const Params& p, int unit) {
    const size_t idx = (size_t)unit * 2048 + tid_fresh() * 4; const int layer = (int)(idx / (9 * D6)), col = (int)(idx % D6);
    f32x4 s = *(const f32x4*)(p.mod_b + (size_t)layer * D6 + col);
    const float* pp = (const float*)(p.ws + WS_MODP) + idx;
#pragma unroll
    for (int ks = 0; ks < 16; ++ks) s += *(const f32x4*)(pp + (size_t)ks * 4 * 9 * D6);
    *(f32x4*)((float*)(p.ws + WS_MODS) + idx) = s;
}
__device__ __forceinline__ void tables_unit(const Params& p) {
    f32x2* tw = (f32x2*)(p.ws + WS_TW);
    for (int m = tid_fresh(); m < 8192; m += 512) { double s, c; sincospi(-(double)m / 4096.0, &s, &c); tw[m] = (f32x2){(float)c, (float)s}; }
    float* rc = (float*)(p.ws + WS_ROPE);
    for (int i = tid_fresh(); i < 1024; i += 512) { const int pos = i >> 4, q = i & 15; const float inv = powf(10000.0f, -(float)q / 16.0f); const float ang = (float)pos * inv;
        rc[i] = cosf(ang); rc[1024 + i] = sinf(ang); }
}
__device__ __forceinline__ void h2_task(const Params& p, int task) {
    const int lane = tid_fresh() & 63; const int j = task / 4352, r = task % 4352; const int v = r >= 4096, t = v ? r - 4096 : r; const int Lv = v ? 256 : 4096;
    const float tl = (float)t / (float)(Lv - 1);
    const float omega = (float)(2.0 * 3.14159265358979323846 / (double)Lv) * (float)t;
    float feat = 0.f;
    if (lane == 0) feat = tl;
    else if (lane <= 32) { const int bi = (lane - 1) & 15; const float band = 1e-4f + (float)bi * ((15.0f - 1e-4f) / 15.0f); const float a = band * omega; feat = lane <= 16 ? cosf(a) : -sinf(a); }
    const float* w1 = p.hy_f_w1 + (size_t)j * 33 * 64; const float* w2 = p.hy_f_w2 + (size_t)j * 64 * 64;
    float s = p.hy_f_b1[j * 64 + lane];
    for (int f = 0; f < 33; ++f) s += bperm_f(feat, f) * w1[f * 64 + lane];
    const float h1 = sinf(p.hy_f_freq1[j * 64 + lane] * s);
    float s2 = p.hy_f_b2[j * 64 + lane];
    for (int m = 0; m < 64; ++m) s2 += bperm_f(h1, m) * w2[m * 64 + lane];
    const float h2 = sinf(p.hy_f_freq2[j * 64 + lane] * s2);
    const h16 hi = (h16)h2; const h16 lo = (h16)(h2 - (float)hi);
    h16* row = (h16*)(p.ws + WS_H2P) + ((size_t)j * 4352 + r) * 256;
    row[lane] = hi; row[64 + lane] = hi; row[128 + lane] = lo; row[192 + lane] = lo;
}
__device__ __forceinline__ void w3p_unit(const Params& p, int unit) {
    const int j = unit >> 5, c0 = (unit & 31) * 256; const float* w3 = p.hy_f_w3 + (size_t)j * 64 * 8192; h16* dst = (h16*)(p.ws + WS_W3P) + (size_t)j * 8192 * 256;
    for (int i = tid_fresh(); i < 64 * 256; i += 512) { const int m = i >> 8, col = c0 + (i & 255); const float w = w3[(size_t)m * 8192 + col];
        const h16 hi = (h16)w; const h16 lo = (h16)(w - (float)hi); h16* row = dst + (size_t)col * 256; row[m] = hi; row[64 + m] = lo; row[128 + m] = hi; row[192 + m] = lo; }
}
__device__ __forceinline__ void rtab_unit(const Params& p, int unit) {
    const int layer = unit >> 6, c = unit & 63; h16* dst = (h16*)(p.ws + WS_RTAB + (size_t)layer * RTAB_L) + (size_t)c * 5 * 2 * 64 * 8;
    for (int i = tid_fresh(); i < 5 * 2 * 64 * 8; i += 512) { const int jj = i & 7, lane = (i >> 3) & 63, hl = (i >> 9) & 1, ct = i >> 10;
        const int k = 32 * c + 8 * (lane >> 4) + jj, col = 16 * ct + (lane & 15);
        float w = 0.f; if (col < 8) w = p.moe_wg[((size_t)layer * D + k) * 8 + col]; else if (col < 72) w = p.moe_we[((size_t)layer * D + k) * 64 + (col - 8)];
        w *= 256.0f; const h16 hi = (h16)w; const h16 lo = (h16)(w - (float)hi); dst[i] = hl ? lo : hi; }
}
template <int NW>
__device__ __forceinline__ void cvt_tile(const float* src, int ldn, int k0, int n0, h16* dst, int ldk, int mode, LAS float* T) {
    constexpr int P = NW + 1; const int tid = tid_fresh();
#pragma unroll
    for (int ps = 0; ps < 64 * NW / 4 / 512; ++ps) { const int idx = ps * 512 + tid, k = idx / (NW / 4), n4 = idx % (NW / 4);
        const f32x4 v = *(const f32x4*)(src + (size_t)(k0 + k) * ldn + n0 + 4 * n4); LAS float* q = T + k * P + 4 * n4; q[0] = v[0]; q[1] = v[1]; q[2] = v[2]; q[3] = v[3]; }
    __syncthreads();
#pragma unroll
    for (int ps = 0; ps < NW * 8 / 512; ++ps) { const int item = ps * 512 + tid, kc = item & 7, n = item >> 3; f16x8 w;
#pragma unroll
        for (int i = 0; i < 8; ++i) w[i] = (h16)T[(8 * kc + i) * P + n];
        const int ng = n0 + n; const int row = mode == 0 ? ng : (8 * (ng >> 2) + (ng & 3) + (mode == 2 ? 4 : 0));
        *(f16x8*)(dst + (size_t)row * ldk + k0 + 8 * kc) = w; }
    __syncthreads();
}
__device__ __forceinline__ void cvt_dense_unit(const Params& p, int unit, LAS float* T) {
    const float* src; h16* dst; int nt, N;
    if (unit < 1536) { src = p.hy_w_in; dst = (h16*)(p.ws + WS_WIN); nt = 24; N = D3; }
    else if (unit < 2048) { unit -= 1536; src = p.hy_w_out; dst = (h16*)(p.ws + WS_WOUT); nt = 8; N = D; }
    else if (unit < 2688) { unit -= 2048; src = p.at_w_qkv; dst = (h16*)(p.ws + WS_WQKV); nt = 10; N = DQKV; }
    else { unit -= 2688; src = p.at_w_o; dst = (h16*)(p.ws + WS_WO); nt = 8; N = D; }
    const int j = unit / (32 * nt), r = unit % (32 * nt), kt = r / nt, ntile = r % nt;
    cvt_tile<256>(src + (size_t)j * D * N, N, kt * 64, ntile * 256, dst + (size_t)j * N * D, D, 0, T);
}
constexpr int CVT_DENSE_UNITS = 3200;
__device__ __forceinline__ void cvt_moe_unit(const Params& p, int layer, int unit, LAS float* T) {
    if (unit < 12288) { const int which = unit >= 6144; if (which) unit -= 6144; const int e = unit / 96, r = unit % 96, kt = r / 3, ntile = r % 3;
        const float* src = (which ? p.moe_w3 : p.moe_w1) + ((size_t)layer * NE + e) * D * DE;
        cvt_tile<128>(src, DE, kt * 64, ntile * 128, (h16*)(p.ws + WS_W13) + (size_t)e * DE2 * D, D, which ? 2 : 1, T); }
    else { unit -= 12288; const int e = unit / 48, r = unit % 48, kt = r / 8, ntile = r % 8;
        const float* src = p.moe_w2 + ((size_t)layer * NE + e) * DE * D;
        cvt_tile<256>(src, D, kt * 64, ntile * 256, (h16*)(p.ws + WS_W2) + (size_t)e * D * DE, DE, 0, T); }
}
constexpr int CVT_MOE_UNITS = 15360;

template <int NR, bool FINAL>
__device__ __forceinline__ void n1_rows(const Params& p, int layer, int r0, int rstride, int lane) {
    float* xres = (float*)(p.ws + WS_XRES); h16* hb = (h16*)(p.ws + WS_HBUF); const h16* yc = (const h16*)(p.ws + WS_YC); const float* mods = (const float*)(p.ws + WS_MODS);
    f32x4 v[NR][8]; f16x4 ya[NR][8], yb[NR][8];
    const bool comb = FINAL || layer > 0; const int lprev = FINAL ? 3 : layer - 1;
#pragma unroll
    for (int q = 0; q < NR; ++q) { const int r = r0 + q * rstride;
        const float* src = (!FINAL && layer == 0) ? (r < TL ? p.x + (size_t)r * D : p.ctx + (size_t)(r - TL) * D) : xres + (size_t)r * D;
#pragma unroll
        for (int c = 0; c < 8; ++c) v[q][c] = *(const f32x4*)(src + c * 256 + lane * 4);
        if (comb) { const h16* y0 = yc + (size_t)(2 * r) * D; const h16* y1 = y0 + D;
#pragma unroll
            for (int c = 0; c < 8; ++c) { ya[q][c] = *(const f16x4*)(y0 + c * 256 + lane * 4); yb[q][c] = *(const f16x4*)(y1 + c * 256 + lane * 4); } } }
#pragma unroll
    for (int q = 0; q < NR; ++q) { const int r = r0 + q * rstride; const int b = batch_of_row(r);
        if (comb) { const float* g2 = mods + ((size_t)(lprev * 9 + b) * 6 + 5) * D;
#pragma unroll
            for (int c = 0; c < 8; ++c) { const f32x4 g = *(const f32x4*)(g2 + c * 256 + lane * 4);
#pragma unroll
                for (int i = 0; i < 4; ++i) v[q][c][i] += g[i] * ((float)ya[q][c][i] + (float)yb[q][c][i]); } }
        float ss = 0.f;
#pragma unroll
        for (int c = 0; c < 8; ++c) { if (!FINAL) *(f32x4*)(xres + (size_t)r * D + c * 256 + lane * 4) = v[q][c]; ss += v[q][c][0] * v[q][c][0] + v[q][c][1] * v[q][c][1] + v[q][c][2] * v[q][c][2] + v[q][c][3] * v[q][c][3]; }
        ss = wave_sum(ss); const float rs = 1.0f / sqrtf(ss * (1.0f / D) + EPS);
        if (FINAL) {
#pragma unroll
            for (int c = 0; c < 8; ++c) { const int col = c * 256 + lane * 4; const f32x4 g = *(const f32x4*)(p.final_gain + col); *(f32x4*)(p.out + (size_t)r * D + col) = v[q][c] * rs * g; }
        } else {
            const float* sh = mods + ((size_t)(layer * 9 + b) * 6 + 0) * D; const float* sc = sh + D;
#pragma unroll
            for (int c = 0; c < 8; ++c) { const int col = c * 256 + lane * 4; const f32x4 s0 = *(const f32x4*)(sh + col), s1 = *(const f32x4*)(sc + col); f16x4 w;
#pragma unroll
                for (int i = 0; i < 4; ++i) w[i] = (h16)(v[q][c][i] * rs * (1.0f + s1[i]) + s0[i]);
                *(f16x4*)(hb + (size_t)r * D + col) = w; }
        } }
}
template <bool FINAL>
__device__ __forceinline__ void n1_any(const Params& p, int layer) {
    const int tid = tid_fresh(), lane = tid & 63, gw = blockIdx.x * 8 + __builtin_amdgcn_readfirstlane(tid >> 6), nw = gridDim.x * 8; const int nrow = FINAL ? TL : TT;
    int r = gw;
    for (; r + nw < nrow; r += 2 * nw) n1_rows<2, FINAL>(p, layer, r, nw, lane);
    if (r < nrow) n1_rows<1, FINAL>(p, layer, r, nw, lane);
}
__device__ __forceinline__ void n1_phase(const Params& p, int layer) { n1_any<false>(p, layer); }
__device__ __forceinline__ void final_phase(const Params& p) { n1_any<true>(p, 0); }
constexpr int N2_CH = 4;
constexpr int N2_SLOT = N2_CH * 10 * 1024;
constexpr int N2_XT = 2 * N2_SLOT;
constexpr int N2_SC = N2_XT + 8 * 4096;
#ifndef PROBE_N2VAR
#define PROBE_N2VAR 0
#endif
__device__ __forceinline__ void n2_phase(const Params& p, int layer, LAS unsigned char* lds, int ctr_shadow) {
    const bool pv_tail = !(ctr_shadow && (PROBE_N2VAR & 1)), pv_store = !(ctr_shadow && (PROBE_N2VAR & 2)), pv_mma = !(ctr_shadow && (PROBE_N2VAR & 4));
    const int tid = tid_fresh(), lane = tid & 63, wv = __builtin_amdgcn_readfirstlane(tid >> 6), r16 = lane & 15, kg = lane >> 4;
    const int lrow = lane >> 3, lchk = lane & 7;
    const float* xres = (const float*)(p.ws + WS_XRES); h16* hb = (h16*)(p.ws + WS_HBUF); const float* mods = (const float*)(p.ws + WS_MODS);
    const char* rtb = p.ws + WS_RTAB + (size_t)layer * RTAB_L; const float* ssq = (const float*)(p.ws + WS_SSQ);
    int* counters = (int*)(p.ws + WS_CTL) + CTL_CNT + (layer + (ctr_shadow ? 4 : 0)) * NE; int* list = (int*)(p.ws + WS_LIST); float* gate = (float*)(p.ws + WS_GATE);
    LAS float* scr = (LAS float*)lds + wv * (16 * 80);
    LAS float* scl = (LAS float*)(lds + N2_SC); LAS float* shl = scl + D;
    LAS int* hist = (LAS int*)(lds + LDS_MISC); LAS int* hbase = hist + NE;
    LAS unsigned char* xt = lds + N2_XT + wv * 4096;
    const int sxw = ((lrow >> 1) & 1) | (((lrow >> 2) & 1) << 2), sxr = ((r16 >> 1) & 1) | (((r16 >> 2) & 1) << 2);
    const int xw_off = lrow * 128 + 16 * (lchk ^ sxw);
    const int xr_off0 = r16 * 128 + 16 * ((2 * kg) ^ sxr), xr_off1 = r16 * 128 + 16 * ((2 * kg + 1) ^ sxr);
    const int hw_off0 = r16 * 128 + 16 * (kg ^ (r16 & 7)), hw_off1 = r16 * 128 + 16 * ((4 + kg) ^ (r16 & 7));
    const int hr_off = lrow * 128 + 16 * (lchk ^ (lrow & 7));
    const int ntask = (layer == NLAYER - 1 ? TL : TT) / 16, nfull = (int)gridDim.x * 8;
#pragma unroll 1
    for (int round = 0; round < 2; ++round) {
        const int nrem = ntask - nfull;
        if (round == 1 && (int)blockIdx.x >= nrem) break;
        const int task = round == 0 ? (int)blockIdx.x * 8 + wv : nfull + (int)blockIdx.x;
        const bool active = round == 0 ? (task < ntask) : (wv == 0);
        const int trow = active ? task * 16 : 0;
        const int b = batch_of_row(trow);
        const float* xg0 = xres + (size_t)(trow + lrow) * D + lchk * 4; const float* xg1 = xg0 + (size_t)8 * D;
        h16* hg0 = hb + (size_t)(trow + lrow) * D + lchk * 8; h16* hg1 = hg0 + (size_t)8 * D;
        float rs;
        { const float* sp = ssq + (size_t)(trow + r16) * 32; float t = 0.f;
#pragma unroll
            for (int q = 0; q < 8; ++q) { const f32x4 v = *(const f32x4*)(sp + 4 * q); t += (v[0] + v[1]) + (v[2] + v[3]); }
            rs = 1.0f / sqrtf(t * (1.0f / D) + EPS); }
        f32x4 acc[5];
#pragma unroll
        for (int ct = 0; ct < 5; ++ct) acc[ct] = (f32x4){0.f, 0.f, 0.f, 0.f};
        __syncthreads();
        if (tid < NE) hist[tid] = 0;
        { const float* scb = mods + ((size_t)(layer * 9 + b) * 6 + 4) * D; *(LAS f32x4*)(scl + tid * 4) = *(const f32x4*)(scb + tid * 4); *(LAS f32x4*)(shl + tid * 4) = *(const f32x4*)(scb - D + tid * 4); }
        f16x8 bq[5];
#pragma unroll
        for (int q = 0; q < 5; ++q) bq[q] = *(const f16x8*)(rtb + (size_t)(5 * wv + q) * 1024 + lane * 16);
#pragma unroll
        for (int q = 0; q < 5; ++q) *(LAS f16x8*)(lds + (5 * wv + q) * 1024 + lane * 16) = bq[q];
#pragma unroll
        for (int q = 0; q < 5; ++q) bq[q] = *(const f16x8*)(rtb + (size_t)N2_SLOT + (size_t)(5 * wv + q) * 1024 + lane * 16);
        f32x4 x0[N2_CH][2], x1[N2_CH][2], x2[N2_CH][2];
#pragma unroll
        for (int s2 = 0; s2 < N2_CH; ++s2) { x0[s2][0] = *(const f32x4*)(xg0 + 32 * s2); x0[s2][1] = *(const f32x4*)(xg1 + 32 * s2);
            x1[s2][0] = *(const f32x4*)(xg0 + 32 * (N2_CH + s2)); x1[s2][1] = *(const f32x4*)(xg1 + 32 * (N2_CH + s2)); }
#define N2_CHUNK(XC, XL, CH) do { const int ch = (CH); \
            __syncthreads(); \
            const int nx2 = (ch + 2 < 64 / N2_CH) ? ch + 2 : ch; \
            {   LAS unsigned char* dst = lds + ((ch + 1) & 1) * N2_SLOT; \
 _Pragma("unroll") \
                for (int q = 0; q < 5; ++q) *(LAS f16x8*)(dst + (5 * wv + q) * 1024 + lane * 16) = bq[q]; } \
            {   const char* src = rtb + (size_t)nx2 * N2_SLOT; \
 _Pragma("unroll") \
                for (int q = 0; q < 5; ++q) bq[q] = *(const f16x8*)(src + (size_t)(5 * wv + q) * 1024 + lane * 16); } \
 _Pragma("unroll") \
            for (int s2 = 0; s2 < N2_CH; ++s2) { const int ko = 32 * (nx2 * N2_CH + s2); XL[s2][0] = *(const f32x4*)(xg0 + ko); XL[s2][1] = *(const f32x4*)(xg1 + ko); } \
            const LAS unsigned char* bs = lds + (ch & 1) * N2_SLOT + lane * 16; \
 _Pragma("unroll") \
            for (int pp = 0; pp < N2_CH / 2; ++pp) { \
 _Pragma("unroll") \
                for (int sp = 0; sp < 2; ++sp) { *(LAS f32x4*)(xt + sp * 2048 + xw_off) = XC[2 * pp + sp][0]; *(LAS f32x4*)(xt + sp * 2048 + 1024 + xw_off) = XC[2 * pp + sp][1]; } \
                f32x4 xf[2][2]; \
 _Pragma("unroll") \
                for (int sp = 0; sp < 2; ++sp) { xf[sp][0] = *(const LAS f32x4*)(xt + sp * 2048 + xr_off0); xf[sp][1] = *(const LAS f32x4*)(xt + sp * 2048 + xr_off1); } \
                f16x8 hk[2]; \
 _Pragma("unroll") \
                for (int sp = 0; sp < 2; ++sp) { \
                    const int s2 = 2 * pp + sp; const int ko = 32 * (ch * N2_CH + s2) + 8 * kg; \
                    const f32x4 c0 = *(const LAS f32x4*)(scl + ko), c1 = *(const LAS f32x4*)(scl + ko + 4), h0 = *(const LAS f32x4*)(shl + ko), h1 = *(const LAS f32x4*)(shl + ko + 4); \
                    f16x8 hi, lo; \
 _Pragma("unroll") \
                    for (int i = 0; i < 4; ++i) { const float a0 = xf[sp][0][i] * rs * (1.0f + c0[i]) + h0[i], a1 = xf[sp][1][i] * rs * (1.0f + c1[i]) + h1[i]; \
                        hi[i] = (h16)a0; lo[i] = (h16)(a0 - (float)hi[i]); hi[4 + i] = (h16)a1; lo[4 + i] = (h16)(a1 - (float)hi[4 + i]); } \
                    hk[sp] = hi; \
                    if (pv_mma) \
 _Pragma("unroll") \
                    for (int ct = 0; ct < 5; ++ct) { const f16x8 whi = *(const LAS f16x8*)(bs + (s2 * 10 + ct * 2 + 0) * 1024), wlo = *(const LAS f16x8*)(bs + (s2 * 10 + ct * 2 + 1) * 1024); \
                        acc[ct] = __builtin_amdgcn_mfma_f32_16x16x32_f16(hi, whi, acc[ct], 0, 0, 0); \
                        acc[ct] = __builtin_amdgcn_mfma_f32_16x16x32_f16(hi, wlo, acc[ct], 0, 0, 0); \
                        acc[ct] = __builtin_amdgcn_mfma_f32_16x16x32_f16(lo, whi, acc[ct], 0, 0, 0); } \
                } \
                *(LAS f16x8*)(xt + hw_off0) = hk[0]; *(LAS f16x8*)(xt + hw_off1) = hk[1]; \
                const f16x8 o0 = *(const LAS f16x8*)(xt + hr_off), o1 = *(const LAS f16x8*)(xt + 1024 + hr_off); \
                if (active && pv_store) { const int ho = 32 * (ch * N2_CH + 2 * pp); *(f16x8*)(hg0 + ho) = o0; *(f16x8*)(hg1 + ho) = o1; } \
            } \
        } while (0)
#pragma unroll 1
        for (int c3 = 0; c3 < 15; c3 += 3) { N2_CHUNK(x0, x2, c3); N2_CHUNK(x1, x0, c3 + 1); N2_CHUNK(x2, x1, c3 + 2); }
        N2_CHUNK(x0, x2, 15);
#undef N2_CHUNK
        __syncthreads();
#pragma unroll
        for (int ct = 0; ct < 5; ++ct)
#pragma unroll
            for (int i = 0; i < 4; ++i) scr[(4 * kg + i) * 80 + 16 * ct + r16] = acc[ct][i] * (1.0f / 256.0f);
        asm volatile("s_waitcnt lgkmcnt(0)" ::: "memory");
        int ea = 0, eb = 0, ra = 0, rb = 0; float g1v = 0.f, g2v = 0.f; const bool tok_lane = active && lane < 16 && pv_tail;
        if (tok_lane) {
            const LAS float* lgr = scr + lane * 80;
            float gmax = -3.0e38f; int gsel = 0; float gl[8];
#pragma unroll
            for (int g = 0; g < 8; ++g) { gl[g] = lgr[g] + p.moe_bg[layer * 8 + g]; if (gl[g] > gmax) { gmax = gl[g]; gsel = g; } }
            float gz = 0.f;
#pragma unroll
            for (int g = 0; g < 8; ++g) gz += expf(gl[g] - gmax);
            const float pg = 1.0f / gz;
            float f1 = -3.0e38f, f2 = -3.0e38f; int i1 = 0, i2 = 0;
            for (int q = 0; q < 8; ++q) { const float f = lgr[8 + gsel * 8 + q] + p.moe_be[layer * 64 + gsel * 8 + q];
                if (f > f1) { f2 = f1; i2 = i1; f1 = f; i1 = q; } else if (f > f2) { f2 = f; i2 = q; } }
            const float e2 = expf(f2 - f1); g1v = pg / (1.0f + e2); g2v = pg * e2 / (1.0f + e2);
            ea = gsel * 8 + i1; eb = gsel * 8 + i2;
            ra = __hip_atomic_fetch_add(hist + ea, 1, __ATOMIC_RELAXED, __HIP_MEMORY_SCOPE_WORKGROUP); rb = __hip_atomic_fetch_add(hist + eb, 1, __ATOMIC_RELAXED, __HIP_MEMORY_SCOPE_WORKGROUP);
        }
        __syncthreads();
        if (tid < NE && pv_tail) { const int n = hist[tid]; hbase[tid] = n ? atomicAdd(&counters[tid], n) : 0; }
        __syncthreads();
        if (tok_lane) { const int tok = task * 16 + lane; const size_t sa = (size_t)ea * LCAP + hbase[ea] + ra, sb = (size_t)eb * LCAP + hbase[eb] + rb;
            list[sa] = 2 * tok; gate[sa] = g1v; list[sb] = 2 * tok + 1; gate[sb] = g2v; }
    }
}
__device__ __forceinline__ void transpose_phase(const Params& p, LAS h16* T) {
    const h16* zt = (const h16*)(p.ws + WS_ZT); h16* z = (h16*)(p.ws + WS_HBUF); const int tid = tid_fresh();
    const int ntile = (D / 64) * (TT / 64);
    for (int tile = blockIdx.x; tile < ntile; tile += gridDim.x) {
        const int td = tile % (D / 64), tt = tile / (D / 64); const int d0 = td * 64, t0 = tt * 64;
        { const int dr = tid >> 3, tc = (tid & 7) * 8; const f16x8 v = *(const f16x8*)(zt + (size_t)(d0 + dr) * TT + t0 + tc);
#pragma unroll
            for (int i = 0; i < 8; ++i) T[(tc + i) * 66 + dr] = v[i]; }
        __syncthreads();
        { const int tr = tid >> 3, dc = (tid & 7) * 8; f16x8 v;
#pragma unroll
            for (int i = 0; i < 8; ++i) v[i] = T[tr * 66 + dc + i];
            *(f16x8*)(z + (size_t)(t0 + tr) * D + d0 + dc) = v; }
        __syncthreads();
    }
}

__device__ __forceinline__ f32x2 cmul(const f32x2 a, const f32x2 b) { return (f32x2){a.x * b.x - a.y * b.y, a.x * b.y + a.y * b.x}; }
__device__ __forceinline__ f32x2 cmulc(const f32x2 a, const f32x2 b) { return (f32x2){a.x * b.x + a.y * b.y, a.y * b.x - a.x * b.y}; }
__device__ __forceinline__ f32x2 cconj(const f32x2 a) { return (f32x2){a.x, -a.y}; }
template <bool INV> __device__ __forceinline__ f32x2 mul_mi(const f32x2 a) { return INV ? (f32x2){-a.y, a.x} : (f32x2){a.y, -a.x}; }
template <bool INV> __device__ __forceinline__ void dft4(f32x2& a, f32x2& b, f32x2& c, f32x2& d) {
    const f32x2 s0 = a + c, s1 = a - c, s2 = b + d, s3 = mul_mi<INV>(b - d);
    a = s0 + s2; b = s1 + s3; c = s0 - s2; d = s1 - s3;
}
template <bool INV, int M> __device__ __forceinline__ f32x2 w16mul(const f32x2 a) {
    constexpr float C1 = 0.92387953251128674f, S1 = 0.38268343236508977f, R = 0.70710678118654752f;
    constexpr float cr = (M == 0) ? 1.f : (M == 1) ? C1 : (M == 2) ? R : (M == 3) ? S1 : (M == 4) ? 0.f : (M == 6) ? -R :   -C1;
    constexpr float ci0 = (M == 0) ? 0.f : (M == 1) ? -S1 : (M == 2) ? -R : (M == 3) ? -C1 : (M == 4) ? -1.f : (M == 6) ? -R :   S1;
    constexpr float ci = INV ? -ci0 : ci0;
    return (f32x2){a.x * cr - a.y * ci, a.x * ci + a.y * cr};
}
template <bool INV> __device__ __forceinline__ void dft16(f32x2 (&v)[16]) {
#pragma unroll
    for (int n2 = 0; n2 < 4; ++n2) dft4<INV>(v[n2], v[4 + n2], v[8 + n2], v[12 + n2]);
    v[5] = w16mul<INV, 1>(v[5]); v[6] = w16mul<INV, 2>(v[6]); v[7] = w16mul<INV, 3>(v[7]);
    v[9] = w16mul<INV, 2>(v[9]); v[10] = w16mul<INV, 4>(v[10]); v[11] = w16mul<INV, 6>(v[11]);
    v[13] = w16mul<INV, 3>(v[13]); v[14] = w16mul<INV, 6>(v[14]); v[15] = w16mul<INV, 9>(v[15]);
#pragma unroll
    for (int k1 = 0; k1 < 4; ++k1) dft4<INV>(v[4 * k1], v[4 * k1 + 1], v[4 * k1 + 2], v[4 * k1 + 3]);
    f32x2 t;
    t = v[1]; v[1] = v[4]; v[4] = t; t = v[2]; v[2] = v[8]; v[8] = t; t = v[3]; v[3] = v[12]; v[12] = t;
    t = v[6]; v[6] = v[9]; v[9] = t; t = v[7]; v[7] = v[13]; v[13] = t; t = v[11]; v[11] = v[14]; v[14] = t;
}
__device__ __forceinline__ int fphys(int i) { return i + (i >> 4); }
__device__ __forceinline__ f32x2 w32c(int j) {
    constexpr float c[16] = {1.f, 0.98078528040323043f, 0.92387953251128674f, 0.83146961230254524f, 0.70710678118654752f, 0.55557023301960218f, 0.38268343236508977f, 0.19509032201612825f,
                             0.f, -0.19509032201612825f, -0.38268343236508977f, -0.55557023301960218f, -0.70710678118654752f, -0.83146961230254524f, -0.92387953251128674f, -0.98078528040323043f};
    constexpr float s[16] = {0.f, 0.19509032201612825f, 0.38268343236508977f, 0.55557023301960218f, 0.70710678118654752f, 0.83146961230254524f, 0.92387953251128674f, 0.98078528040323043f,
                             1.f, 0.98078528040323043f, 0.92387953251128674f, 0.83146961230254524f, 0.70710678118654752f, 0.55557023301960218f, 0.38268343236508977f, 0.19509032201612825f};
    return (f32x2){c[j], -s[j]};
}
template <int S>
__device__ __forceinline__ void fft_fwd0(const f32x2 (&xe)[16], const f32x2 (&xo)[16], LAS f32x2* E, LAS f32x2* O, int t, const f32x2* tw) {
    const f32x2 u = tw[t * (256 / S)]; const f32x2 u2 = cmul(u, u);
    f32x2 y[16];
#pragma unroll
    for (int j = 0; j < 16; ++j) y[j] = xe[j];
    dft16<false>(y);
    constexpr int QS = S + S / 16;
    LAS f32x2* Eb = E + fphys(t); LAS f32x2* Ob = O + fphys(t);
    f32x2 pw = u2; Eb[0] = y[0];
#pragma unroll
    for (int q = 1; q < 16; ++q) { Eb[QS * q] = cmul(y[q], pw); pw = cmul(pw, u2); }
#pragma unroll
    for (int j = 0; j < 16; ++j) y[j] = cmul(xo[j], w32c(j));
    dft16<false>(y);
    pw = u;
#pragma unroll
    for (int q = 0; q < 16; ++q) { Ob[QS * q] = cmul(y[q], pw); pw = cmul(pw, u2); }
}
template <bool INV> __device__ __forceinline__ void fft_pass1(LAS f32x2* A, int tau, const f32x2* tw) {
    const int i = tau & 15, base = (tau >> 4) << 8; const f32x2 u0 = tw[32 * i]; const f32x2 u = INV ? cconj(u0) : u0;
    f32x2 y[16]; LAS f32x2* Ab = A + fphys(base + i);
#pragma unroll
    for (int j = 0; j < 16; ++j) y[j] = Ab[17 * j];
    if (INV) { f32x2 pw = u;
#pragma unroll
        for (int q = 1; q < 16; ++q) { y[q] = cmul(y[q], pw); pw = cmul(pw, u); } }
    dft16<INV>(y);
    if (!INV) { f32x2 pw = u;
#pragma unroll
        for (int q = 1; q < 16; ++q) { y[q] = cmul(y[q], pw); pw = cmul(pw, u); } }
#pragma unroll
    for (int j = 0; j < 16; ++j) Ab[17 * j] = y[j];
}
__device__ __forceinline__ void fft_fwd2(const LAS f32x2* A, int t, f32x2 (&y)[16]) {
#pragma unroll
    for (int j = 0; j < 16; ++j) y[j] = A[17 * t + j];
    dft16<false>(y);
}
__device__ __forceinline__ void kf_load(const f32x2* kf, f32x4 (&k)[8]) {
#pragma unroll
    for (int j = 0; j < 8; ++j) k[j] = *(const f32x4*)(kf + 2 * j);
}
__device__ __forceinline__ void fft_mid(LAS f32x2* A, int t, const f32x4 (&k)[8]) {
    f32x2 y[16];
    fft_fwd2(A, t, y);
#pragma unroll
    for (int j = 0; j < 8; ++j) { y[2 * j] = cmul(y[2 * j], (f32x2){k[j][0], k[j][1]}); y[2 * j + 1] = cmul(y[2 * j + 1], (f32x2){k[j][2], k[j][3]}); }
    dft16<true>(y);
#pragma unroll
    for (int j = 0; j < 16; ++j) A[17 * t + j] = y[j];
}
template <int S>
__device__ __forceinline__ void fft_inv0(const LAS f32x2* E, const LAS f32x2* O, int t, const f32x2* tw, f32x2 (&out)[16]) {
    const f32x2 u = tw[t * (256 / S)]; const f32x2 u2 = cmul(u, u);
    f32x2 y[16];
    constexpr int QS = S + S / 16;
    const LAS f32x2* Eb = E + fphys(t); const LAS f32x2* Ob = O + fphys(t);
    f32x2 pw = u2; y[0] = Eb[0];
#pragma unroll
    for (int q = 1; q < 16; ++q) { y[q] = cmulc(Eb[QS * q], pw); pw = cmul(pw, u2); }
    dft16<true>(y);
#pragma unroll
    for (int j = 0; j < 16; ++j) out[j] = y[j];
    pw = u;
#pragma unroll
    for (int q = 0; q < 16; ++q) { y[q] = cmulc(Ob[QS * q], pw); pw = cmul(pw, u2); }
    dft16<true>(y);
#pragma unroll
    for (int j = 0; j < 16; ++j) out[j] += cmulc(y[j], w32c(j));
}
__device__ __forceinline__ float hy_absdelta(int d) { return fabsf(-3.0701134573253943f + (-15.350567286626973f + 3.0701134573253943f) * ((float)d / 2047.0f)); }

__device__ __forceinline__ void filt_fft_phase(const Params& p, LAS unsigned char* lds) {
    const int tid = tid_fresh();
    const f32x2* tw = (const f32x2*)(p.ws + WS_TW);
    {
        const int grp = tid >> 8, tau = tid & 255;
        LAS f32x2* E = (LAS f32x2*)(lds + grp * 69632); LAS f32x2* O = E + 4352; LAS float* red = (LAS float*)(lds + LDS_MISC) + grp * 8;
        for (int pb = blockIdx.x * 2 + grp; pb < 2 * 2 * 2048; pb += gridDim.x * 2) {
            const int d = pb & 2047, n = (pb >> 11) & 1, j = pb >> 12;
            const float* tf = (const float*)(p.ws + WS_TAPS) + ((size_t)j * 8192 + (size_t)(n * 2 + 0) * D + d) * 4096;
            const float* tb = tf + (size_t)D * 4096;
            const float adel = hy_absdelta(d); const float tscale = 1.0f / 4095.0f;
            f32x2 xe[16], xo[16]; float ss = 0.f;
#pragma unroll
            for (int jj = 0; jj < 16; ++jj) { const int nn = tau + 256 * jj;
                const float klo = tf[nn] * expf(-(float)nn * tscale * adel);
                const int m = 4096 - nn;
                const float khi = (m < 4096) ? tb[m & 4095] * expf(-(float)m * tscale * adel) : 0.f;
                ss += klo * klo + khi * khi; xe[jj] = (f32x2){klo + khi, 0.f}; xo[jj] = (f32x2){klo - khi, 0.f}; }
            ss = wave_sum(ss);
            if ((tid & 63) == 0) red[(tid >> 6) & 3] = ss;
            fft_fwd0<256>(xe, xo, E, O, tau, tw);
            __syncthreads();
            const float tot = red[0] + red[1] + red[2] + red[3];
            const float scale = (1.0f / sqrtf(tot + EPS)) * (1.0f / 8192.0f);
            const float hbs = p.hy_bias[((size_t)j * 2 + n) * D + d] * (1.0f / 8192.0f);
            fft_pass1<false>(E, tau, tw); fft_pass1<false>(O, tau, tw);
            __syncthreads();
            f32x2* kf = (f32x2*)(p.ws + WS_KF) + (size_t)pb * 8192 + (size_t)tau * 16;
            f32x2 y[16];
            fft_fwd2(E, tau, y);
#pragma unroll
            for (int q = 0; q < 8; ++q) *(f32x4*)(kf + 2 * q) = (f32x4){y[2 * q].x * scale + hbs, y[2 * q].y * scale, y[2 * q + 1].x * scale + hbs, y[2 * q + 1].y * scale};
            fft_fwd2(O, tau, y);
#pragma unroll
            for (int q = 0; q < 8; ++q) *(f32x4*)(kf + 4096 + 2 * q) = (f32x4){y[2 * q].x * scale + hbs, y[2 * q].y * scale, y[2 * q + 1].x * scale + hbs, y[2 * q + 1].y * scale};
            __syncthreads();
        }
    }
    {
        const int pr = tid >> 4, i = tid & 15;
        LAS f32x2* E = (LAS f32x2*)(lds + pr * 4352); LAS f32x2* O = E + 272;
        for (int it = blockIdx.x; it < 256; it += gridDim.x) {
            const int pb = it * 32 + pr; const int d = pb & 2047, n = (pb >> 11) & 1, j = pb >> 12;
            const float* tf = (const float*)(p.ws + WS_TAPSC) + ((size_t)j * 8192 + (size_t)(n * 2 + 0) * D + d) * 256;
            const float* tb = tf + (size_t)D * 256;
            const float adel = hy_absdelta(d); const float tscale = 1.0f / 255.0f;
            f32x2 xe[16], xo[16]; float ss = 0.f;
#pragma unroll
            for (int jj = 0; jj < 16; ++jj) { const int nn = i + 16 * jj;
                const float klo = tf[nn] * expf(-(float)nn * tscale * adel);
                const int m = 256 - nn;
                const float khi = (m < 256) ? tb[m & 255] * expf(-(float)m * tscale * adel) : 0.f;
                ss += klo * klo + khi * khi; xe[jj] = (f32x2){klo + khi, 0.f}; xo[jj] = (f32x2){klo - khi, 0.f}; }
            ss += shx(ss, 8); ss += shx(ss, 4); ss += shx(ss, 2); ss += shx(ss, 1);
            const float scale = (1.0f / sqrtf(ss + EPS)) * (1.0f / 512.0f);
            const float hbs = p.hy_bias[((size_t)j * 2 + n) * D + d] * (1.0f / 512.0f);
            fft_fwd0<16>(xe, xo, E, O, i, tw);
            __syncthreads();
            f32x2* kf = (f32x2*)(p.ws + WS_KFC) + (size_t)pb * 512 + (size_t)i * 16;
            f32x2 y[16];
            fft_fwd2(E, i, y);
#pragma unroll
            for (int q = 0; q < 8; ++q) *(f32x4*)(kf + 2 * q) = (f32x4){y[2 * q].x * scale + hbs, y[2 * q].y * scale, y[2 * q + 1].x * scale + hbs, y[2 * q + 1].y * scale};
            fft_fwd2(O, i, y);
#pragma unroll
            for (int q = 0; q < 8; ++q) *(f32x4*)(kf + 256 + 2 * q) = (f32x4){y[2 * q].x * scale + hbs, y[2 * q].y * scale, y[2 * q + 1].x * scale + hbs, y[2 * q + 1].y * scale};
            __syncthreads();
        }
    }
}

__device__ __forceinline__ float conv3_lds(const LAS h16* row, int n, float w0, float w1, float w2, float b) { return (float)row[n - 1] * w0 + (float)row[n] * w1 + (float)row[n + 1] * w2 + b; }
constexpr int ST_P = 4112, STS_P = 272;

__device__ __forceinline__ void conv_phase(const Params& p, int jl, LAS unsigned char* lds) {
    const int tid = tid_fresh();
    const f32x2* tw = (const f32x2*)(p.ws + WS_TW);
    const h16* ut = (const h16*)(p.ws + WS_UT); h16* zt = (h16*)(p.ws + WS_ZT);
    const float* cw = p.hy_conv_w + (size_t)jl * 3 * D3; const float* cb = p.hy_conv_b + (size_t)jl * D3;
    {
        const int grp = tid >> 8, tau = tid & 255;
        LAS f32x2* E = (LAS f32x2*)(lds + grp * 69632); LAS f32x2* O = E + 4352; LAS h16* ST = (LAS h16*)E;
        for (int unit = blockIdx.x; unit < 4096; unit += gridDim.x) {
            const int hq = unit & 1, d = unit >> 1; const size_t col0 = (size_t)(4 * hq + 2 * grp) * 4096;
            const f32x2* kfb = (const f32x2*)(p.ws + WS_KF) + ((size_t)(jl * 2) * 2048 + d) * 8192 + (size_t)tau * 16;
            f16x8 raw[2][2][2], raw2[2][2];
#pragma unroll
            for (int sq = 0; sq < 2; ++sq)
#pragma unroll
                for (int bb = 0; bb < 2; ++bb)
#pragma unroll
                    for (int k = 0; k < 2; ++k) raw[sq][bb][k] = *(const f16x8*)(ut + (size_t)(sq * D + d) * TT + col0 + (size_t)bb * 4096 + (size_t)(tau + 256 * k) * 8);
            __syncthreads();
#pragma unroll
            for (int sq = 0; sq < 2; ++sq)
#pragma unroll
                for (int bb = 0; bb < 2; ++bb)
#pragma unroll
                    for (int k = 0; k < 2; ++k) *(LAS f16x8*)(ST + (sq * 2 + bb) * ST_P + 8 + (tau + 256 * k) * 8) = raw[sq][bb][k];
            if (tau < 4) { ST[tau * ST_P + 7] = (h16)0.f; ST[tau * ST_P + 8 + 4096] = (h16)0.f; }
            __syncthreads();
            f32x2 xin[16], gk[16], y[16];
            { const float w0 = cw[d], w1 = cw[D3 + d], w2 = cw[2 * D3 + d], bv = cb[d]; const float g0 = cw[D + d], g1 = cw[D3 + D + d], g2 = cw[2 * D3 + D + d], gb = cb[D + d];
#pragma unroll
                for (int jj = 0; jj < 16; ++jj) { const int nn = tau + 256 * jj;
                    xin[jj] = (f32x2){conv3_lds(ST + 8, nn, w0, w1, w2, bv), conv3_lds(ST + ST_P + 8, nn, w0, w1, w2, bv)};
                    gk[jj] = (f32x2){conv3_lds(ST + 2 * ST_P + 8, nn, g0, g1, g2, gb), conv3_lds(ST + 3 * ST_P + 8, nn, g0, g1, g2, gb)}; } }
            __syncthreads();
#pragma unroll 1
            for (int ord = 0; ord < 2; ++ord) {
                fft_fwd0<256>(xin, xin, E, O, tau, tw);
                const f32x2* kf = kfb + (size_t)ord * 2048 * 8192; f32x4 kfe[8], kfo[8];
                kf_load(kf, kfe);
                __syncthreads();
                fft_pass1<false>(E, tau, tw); fft_pass1<false>(O, tau, tw);
                kf_load(kf + 4096, kfo);
                __syncthreads();
                fft_mid(E, tau, kfe); fft_mid(O, tau, kfo);
                if (ord == 0) {
#pragma unroll
                    for (int bb = 0; bb < 2; ++bb)
#pragma unroll
                        for (int k = 0; k < 2; ++k) raw2[bb][k] = *(const f16x8*)(ut + (size_t)(2 * D + d) * TT + col0 + (size_t)bb * 4096 + (size_t)(tau + 256 * k) * 8); }
                __syncthreads();
                fft_pass1<true>(E, tau, tw); fft_pass1<true>(O, tau, tw);
                __syncthreads();
                fft_inv0<256>(E, O, tau, tw, y);
#pragma unroll
                for (int jj = 0; jj < 16; ++jj) xin[jj] = gk[jj] * y[jj];
                if (ord == 0) {
                    __syncthreads();
#pragma unroll
                    for (int bb = 0; bb < 2; ++bb)
#pragma unroll
                        for (int k = 0; k < 2; ++k) *(LAS f16x8*)(ST + bb * ST_P + 8 + (tau + 256 * k) * 8) = raw2[bb][k];
                    if (tau < 2) { ST[tau * ST_P + 7] = (h16)0.f; ST[tau * ST_P + 8 + 4096] = (h16)0.f; }
                    __syncthreads();
                    const float g0 = cw[2 * D + d], g1 = cw[D3 + 2 * D + d], g2 = cw[2 * D3 + 2 * D + d], gb = cb[2 * D + d];
#pragma unroll
                    for (int jj = 0; jj < 16; ++jj) { const int nn = tau + 256 * jj; gk[jj] = (f32x2){conv3_lds(ST + 8, nn, g0, g1, g2, gb), conv3_lds(ST + ST_P + 8, nn, g0, g1, g2, gb)}; }
                    __syncthreads();
                }
            }
            h16* o0 = zt + (size_t)d * TT + col0; h16* o1 = o0 + 4096;
#pragma unroll
            for (int jj = 0; jj < 16; ++jj) { const int nn = tau + 256 * jj; o0[nn] = (h16)xin[jj].x; o1[nn] = (h16)xin[jj].y; }
        }
    }
    {
        const int pr = tid >> 4, i = tid & 15, c8 = pr >> 2, bp = pr & 3;
        LAS f32x2* E = (LAS f32x2*)(lds + pr * 4352); LAS f32x2* O = E + 272; LAS h16* ST = (LAS h16*)lds;
        for (int unit = blockIdx.x; unit < 256; unit += gridDim.x) {
            const int d0 = unit * 8, d = d0 + c8;
            const f32x2* kfb = (const f32x2*)(p.ws + WS_KFC) + ((size_t)(jl * 2) * 2048 + d) * 512 + (size_t)i * 16;
            f16x8 raw[3][4];
#pragma unroll
            for (int sq = 0; sq < 3; ++sq)
#pragma unroll
                for (int k = 0; k < 4; ++k) { const int q = tid + 512 * k, row = q >> 5, ch = q & 31;
                    raw[sq][k] = *(const f16x8*)(ut + (size_t)(sq * D + d0 + (row >> 3)) * TT + TL + (row & 7) * 256 + ch * 8); }
            __syncthreads();
#pragma unroll
            for (int sq = 0; sq < 2; ++sq)
#pragma unroll
                for (int k = 0; k < 4; ++k) { const int q = tid + 512 * k, row = q >> 5, ch = q & 31; *(LAS f16x8*)(ST + (sq * 64 + row) * STS_P + 8 + ch * 8) = raw[sq][k]; }
            if (tid < 128) { ST[tid * STS_P + 7] = (h16)0.f; ST[tid * STS_P + 8 + 256] = (h16)0.f; }
            __syncthreads();
            f32x2 xin[16], gk[16], y[16];
            { const float w0 = cw[d], w1 = cw[D3 + d], w2 = cw[2 * D3 + d], bv = cb[d]; const float g0 = cw[D + d], g1 = cw[D3 + D + d], g2 = cw[2 * D3 + D + d], gb = cb[D + d];
                const LAS h16* r0 = ST + (c8 * 8 + 2 * bp) * STS_P + 8; const LAS h16* r1 = r0 + 64 * STS_P;
#pragma unroll
                for (int jj = 0; jj < 16; ++jj) { const int nn = i + 16 * jj;
                    xin[jj] = (f32x2){conv3_lds(r0, nn, w0, w1, w2, bv), conv3_lds(r0 + STS_P, nn, w0, w1, w2, bv)};
                    gk[jj] = (f32x2){conv3_lds(r1, nn, g0, g1, g2, gb), conv3_lds(r1 + STS_P, nn, g0, g1, g2, gb)}; } }
            __syncthreads();
#pragma unroll 1
            for (int ord = 0; ord < 2; ++ord) {
                const f32x2* kf = kfb + (size_t)ord * 2048 * 512; f32x4 kfe[8], kfo[8];
                fft_fwd0<16>(xin, xin, E, O, i, tw);
                __syncthreads();
                kf_load(kf, kfe); fft_mid(E, i, kfe); kf_load(kf + 256, kfo); fft_mid(O, i, kfo);
                __syncthreads();
                fft_inv0<16>(E, O, i, tw, y);
#pragma unroll
                for (int jj = 0; jj < 16; ++jj) xin[jj] = gk[jj] * y[jj];
                if (ord == 0) {
                    __syncthreads();
#pragma unroll
                    for (int k = 0; k < 4; ++k) { const int q = tid + 512 * k, row = q >> 5, ch = q & 31; *(LAS f16x8*)(ST + row * STS_P + 8 + ch * 8) = raw[2][k]; }
                    if (tid < 64) { ST[tid * STS_P + 7] = (h16)0.f; ST[tid * STS_P + 8 + 256] = (h16)0.f; }
                    __syncthreads();
                    const float g0 = cw[2 * D + d], g1 = cw[D3 + 2 * D + d], g2 = cw[2 * D3 + 2 * D + d], gb = cb[2 * D + d];
                    const LAS h16* r0 = ST + (c8 * 8 + 2 * bp) * STS_P + 8;
#pragma unroll
                    for (int jj = 0; jj < 16; ++jj) { const int nn = i + 16 * jj; gk[jj] = (f32x2){conv3_lds(r0, nn, g0, g1, g2, gb), conv3_lds(r0 + STS_P, nn, g0, g1, g2, gb)}; }
                    __syncthreads();
                }
            }
            h16* o0 = zt + (size_t)d * TT + TL + (2 * bp) * 256; h16* o1 = o0 + 256;
#pragma unroll
            for (int jj = 0; jj < 16; ++jj) { const int nn = i + 16 * jj; o0[nn] = (h16)xin[jj].x; o1[nn] = (h16)xin[jj].y; }
        }
    }
}

constexpr int AT_KP = 72, AT_VP = 68;
__device__ __forceinline__ void attn_phase(const Params& p, int jl, bool with_ctx_out, LAS unsigned char* lds) {
    const int tid = tid_fresh(), wv = tid >> 6, lane = tid & 63, r32 = lane & 31, hh = lane >> 5;
    LAS h16* Ks = (LAS h16*)lds; LAS h16* Vs = (LAS h16*)(lds + 64 * AT_KP * 2);
    const h16* qk = (const h16*)(p.ws + WS_QK); const h16* vt = (const h16*)(p.ws + WS_VT); h16* ob = (h16*)(p.ws + WS_HBUF);
    const float* rcos = (const float*)(p.ws + WS_ROPE); const float* rsin = rcos + 1024;
    const int nunit = 2048 + (with_ctx_out ? 128 : 0);
    for (int unit = blockIdx.x; unit < nunit; unit += gridDim.x) {
        int kind, b, g, qb;
        if (unit < 2048) { kind = 0; qb = unit & 63; g = (unit >> 6) & 3; b = unit >> 8; } else { const int u2 = unit - 2048; kind = 1; qb = u2 & 3; g = (u2 >> 2) & 3; b = u2 >> 4; }
        const int head = g * 8 + wv;
        const int qrow0 = kind ? (TL + b * 256 + qb * 64) : (b * 4096 + qb * 64);
        const int ctxrow0 = TL + b * 256;
        f16x8 qf[2][4];
#pragma unroll
        for (int qt = 0; qt < 2; ++qt) {
            f32x4 qv[4][2];
            const h16* qp = qk + (size_t)(qrow0 + 32 * qt + r32) * DQK + head * 64 + 8 * hh;
#pragma unroll
            for (int ks = 0; ks < 4; ++ks) { const f16x8 t = *(const f16x8*)(qp + 16 * ks);
#pragma unroll
                for (int i = 0; i < 4; ++i) { qv[ks][0][i] = (float)t[i]; qv[ks][1][i] = (float)t[4 + i]; } }
            if (kind == 0) {
                const int colpos = 32 * qt + r32;
#pragma unroll
                for (int a = 0; a < 2; ++a) { const int pos = a ? colpos : qb; const float* cp = rcos + pos * 16 + 8 * hh; const float* sp = rsin + pos * 16 + 8 * hh;
#pragma unroll
                    for (int e = 0; e < 2; ++e) { const f32x4 c = *(const f32x4*)(cp + 4 * e), s = *(const f32x4*)(sp + 4 * e);
                        const f32x4 x1 = qv[2 * a][e], x2 = qv[2 * a + 1][e]; qv[2 * a][e] = x1 * c - x2 * s; qv[2 * a + 1][e] = x2 * c + x1 * s; } }
            }
#pragma unroll
            for (int ks = 0; ks < 4; ++ks)
#pragma unroll
                for (int i = 0; i < 4; ++i) { qf[qt][ks][i] = (h16)(qv[ks][0][i] * 0.125f); qf[qt][ks][4 + i] = (h16)(qv[ks][1][i] * 0.125f); }
        }
        const float sink = p.at_sink[jl * 32 + head] * 1.4426950408889634f;
        float mrun[2] = {sink, sink}, lrun[2] = {hh == 0 ? 1.f : 0.f, hh == 0 ? 1.f : 0.f};
        f32x16 oacc[2][2];
#pragma unroll
        for (int a = 0; a < 2; ++a)
#pragma unroll
            for (int c = 0; c < 2; ++c)
#pragma unroll
                for (int i = 0; i < 16; ++i) oacc[a][c][i] = 0.f;
        const int t_lo = kind ? 0 : (qb < 2 ? 2 - qb : 0), t_hi = kind ? -1 : (65 - qb < 4 ? 65 - qb : 4); const int nwin = t_hi - t_lo + 1, nv = nwin + 4;
        const bool krole = tid < 256; const int kkey = tid >> 2, kcp = tid & 3, kdA = (kcp & 1) * 8 + (kcp >> 1) * 32; const int vdim = (tid - 256) >> 2, vkc = tid & 3;
        f16x8 ld0, ld1;
#define AT_TILE(sidx, KROW0, MASK, ROPE) do { if ((sidx) < nwin) { const int _ti = t_lo + (sidx); KROW0 = b * 4096 + qb * 64 - 128 + 64 * _ti; ROPE = true; MASK = (_ti == 0) ? 1 : (_ti == 4) ? 2 : 0; } \
            else { KROW0 = ctxrow0 + 64 * ((sidx) - nwin); ROPE = false; MASK = 0; } } while (0)
#define AT_LOAD(KROW0) do { if (krole) { const h16* kp = qk + (size_t)((KROW0) + kkey) * DQK + D + g * 64 + kdA; ld0 = *(const f16x8*)kp; ld1 = *(const f16x8*)(kp + 16); } \
            else { const h16* vp = vt + (size_t)(g * 64 + vdim) * TT + (KROW0) + 16 * vkc; ld0 = *(const f16x8*)vp; ld1 = *(const f16x8*)(vp + 8); } } while (0)
        { int kr0, mk; bool rp; AT_TILE(0, kr0, mk, rp); (void)mk; (void)rp; AT_LOAD(kr0); }
#pragma unroll 1
        for (int sx = 0; sx < nv; ++sx) {
            int krow0, mask; bool rope; AT_TILE(sx, krow0, mask, rope);
            __syncthreads();
            if (krole) {
                f16x8 o1 = ld0, o2 = ld1;
                if (rope) { const int kpos = (krow0 - b * 4096) + kkey; const int pos = (kcp >> 1) ? (kpos & 63) : (kpos >> 6);
                    const float* cpp = rcos + pos * 16 + (kcp & 1) * 8; const float* spp = rsin + pos * 16 + (kcp & 1) * 8;
#pragma unroll
                    for (int i = 0; i < 8; ++i) { const float c = cpp[i], s = spp[i], x1 = (float)ld0[i], x2 = (float)ld1[i]; o1[i] = (h16)(x1 * c - x2 * s); o2[i] = (h16)(x2 * c + x1 * s); } }
                *(LAS f16x8*)(Ks + kkey * AT_KP + kdA) = o1; *(LAS f16x8*)(Ks + kkey * AT_KP + kdA + 16) = o2;
            } else {
                LAS h16* dst = Vs + vdim * AT_VP + 16 * vkc;
                *(LAS f16x4*)(dst) = (f16x4){ld0[0], ld0[1], ld0[2], ld0[3]}; *(LAS f16x4*)(dst + 4) = (f16x4){ld0[4], ld0[5], ld0[6], ld0[7]};
                *(LAS f16x4*)(dst + 8) = (f16x4){ld1[0], ld1[1], ld1[2], ld1[3]}; *(LAS f16x4*)(dst + 12) = (f16x4){ld1[4], ld1[5], ld1[6], ld1[7]};
            }
            if (sx + 1 < nv) { int kr1, mk1; bool rp1; AT_TILE(sx + 1, kr1, mk1, rp1); (void)mk1; (void)rp1; AT_LOAD(kr1); }
            __syncthreads();
#pragma unroll
            for (int qt = 0; qt < 2; ++qt) {
                f32x16 sacc[2];
#pragma unroll
                for (int kt = 0; kt < 2; ++kt)
#pragma unroll
                    for (int i = 0; i < 16; ++i) sacc[kt][i] = 0.f;
#pragma unroll
                for (int ks = 0; ks < 4; ++ks)
#pragma unroll
                    for (int kt = 0; kt < 2; ++kt) { const f16x8 kf = *(const LAS f16x8*)(Ks + (32 * kt + r32) * AT_KP + 16 * ks + 8 * hh);
                        sacc[kt] = __builtin_amdgcn_mfma_f32_32x32x16_f16(kf, qf[qt][ks], sacc[kt], 0, 0, 0); }
                const int qq = 32 * qt + r32; float tmax = -3.0e38f;
#pragma unroll
                for (int kt = 0; kt < 2; ++kt)
#pragma unroll
                    for (int i = 0; i < 16; ++i) { float s = sacc[kt][i] * 1.4426950408889634f; const int kk = 32 * kt + (i & 3) + 8 * (i >> 2) + 4 * hh;
                        if (mask == 1 && kk < qq) s = -1.0e30f; if (mask == 2 && kk > qq) s = -1.0e30f;
                        sacc[kt][i] = s; tmax = fmaxf(tmax, s); }
                tmax = fmaxf(tmax, shx(tmax, 32));
                const float mnew = fmaxf(mrun[qt], tmax); const float alpha = __builtin_amdgcn_exp2f(mrun[qt] - mnew); mrun[qt] = mnew;
                float psum = 0.f; f16x8 pf[2][2];
#pragma unroll
                for (int kt = 0; kt < 2; ++kt)
#pragma unroll
                    for (int s2 = 0; s2 < 2; ++s2)
#pragma unroll
                        for (int jj = 0; jj < 8; ++jj) { const float pv = __builtin_amdgcn_exp2f(sacc[kt][8 * s2 + jj] - mnew); psum += pv; pf[kt][s2][jj] = (h16)pv; }
                lrun[qt] = lrun[qt] * alpha + psum;
#pragma unroll
                for (int dt = 0; dt < 2; ++dt)
#pragma unroll
                    for (int i = 0; i < 16; ++i) oacc[dt][qt][i] *= alpha;
#pragma unroll
                for (int kt = 0; kt < 2; ++kt)
#pragma unroll
                    for (int s2 = 0; s2 < 2; ++s2)
#pragma unroll
                        for (int dt = 0; dt < 2; ++dt) { const LAS h16* vr = Vs + (32 * dt + r32) * AT_VP + 32 * kt + 16 * s2 + 4 * hh;
                            const f16x4 v0 = *(const LAS f16x4*)vr, v1 = *(const LAS f16x4*)(vr + 8);
                            const f16x8 vf = (f16x8){v0[0], v0[1], v0[2], v0[3], v1[0], v1[1], v1[2], v1[3]};
                            oacc[dt][qt] = __builtin_amdgcn_mfma_f32_32x32x16_f16(vf, pf[kt][s2], oacc[dt][qt], 0, 0, 0); }
            }
        }
#pragma unroll
        for (int qt = 0; qt < 2; ++qt) {
            const float ltot = lrun[qt] + shx(lrun[qt], 32); const float inv = 1.0f / ltot;
            h16* op = ob + (size_t)(qrow0 + 32 * qt + r32) * D + head * 64 + 4 * hh;
#pragma unroll
            for (int dt = 0; dt < 2; ++dt)
#pragma unroll
                for (int q4 = 0; q4 < 4; ++q4) { f16x4 w;
#pragma unroll
                    for (int i = 0; i < 4; ++i) w[i] = (h16)(oacc[dt][qt][4 * q4 + i] * inv);
                    *(f16x4*)(op + 32 * dt + 8 * q4) = w; }
        }
    }
}
#undef AT_TILE
#undef AT_LOAD

constexpr int NPHASE = 35;
#ifndef MK_MULTI
#define MK_MULTI 0
#endif

template <int KIND>
__attribute__((target("no-packed-fp32-ops"))) __global__ void __launch_bounds__(512, 2) hy_fwd(Params p_) {
    extern __shared__ __attribute__((aligned(16))) unsigned char shm[];
    LAS unsigned char* lds = (LAS unsigned char*)shm;
    constexpr bool ALL = KIND < 0;
    const int ph0 = p_.ph0;
    if (threadIdx.x == 0) { *(LAS u32x4*)(lds + LDS_XB) = (u32x4){0u, 0u, 0u, 0u}; }
    __syncthreads();
    XcdBarrier bar;
    if constexpr (ALL) bar = xcd_barrier_post((unsigned*)(p_.ws + WS_CTL), (volatile LAS unsigned*)(lds + LDS_XB));
#ifndef PROBE_SITE
#define PROBE_SITE -1
#endif
#define SITE(k) if constexpr (ALL || KIND == (k)) for (int rep_ = 0; rep_ < ((k) == PROBE_SITE ? 2 : 1); ++rep_) if (const Params& p = *params_fresh(); true)
#define SEAM() do { if constexpr (ALL) xcd_barrier(bar); } while (0)
    const int G = gridDim.x, bid = blockIdx.x;
    SITE(0) {
        for (int u = bid; u < 20353; u += G) {
            if (u < 384) modp_unit(p, u, (LAS float*)lds);
            else if (u == 384) tables_unit(p);
            else if (u < 1473) h2_task(p, (u - 385) * 8 + (tid_fresh() >> 6));
            else if (u < 1537) w3p_unit(p, u - 1473);
            else if (u < 1793) rtab_unit(p, u - 1537);
            else if (u < 4993) cvt_dense_unit(p, u - 1793, (LAS float*)lds);
            else cvt_moe_unit(p, 0, u - 4993, (LAS float*)lds);
        }
        SEAM();
    }
    SITE(1) {
        for (int u = bid; u < 216; u += G) modr_unit(p, u);
        SchedFilt S{p.ws + WS_W3P, p.ws + WS_H2P}; EpiTaps E{(float*)(p.ws + WS_TAPS), (float*)(p.ws + WS_TAPSC)};
        pg8::gemm_phase<EpiTaps, SchedFilt, false>(lds, 256, S, E);
        SEAM();
    }
#define TAIL_IDLE(nunits) (((nunits) % G) ? G - ((nunits) % G) : 0)
#define CVT_PER_GEMM 10
#pragma unroll 1
    for (int layer = ALL ? 0 : ph0; layer < (ALL ? NLAYER : ph0 + 1); ++layer) {
        const bool hyena = (layer & 1) == 0; const int jl = layer >> 1;
        const int nu1 = hyena ? 24 * 136 : 136 * 10, nu4 = (layer == NLAYER - 1 ? 128 : 136) * 8;
        const int idle1 = TAIL_IDLE(nu1), idle4 = TAIL_IDLE(nu4);
        int cv4 = idle4 * CVT_PER_GEMM, cv1 = idle1 * CVT_PER_GEMM; if (cv4 > CVT_MOE_UNITS / 2) cv4 = CVT_MOE_UNITS / 2; if (cv1 > CVT_MOE_UNITS / 2 - 1) cv1 = CVT_MOE_UNITS / 2 - 1;
        const int cvN0 = CVT_MOE_UNITS - cv1 - cv4, cvN1 = cvN0 + cv1;
        SITE(2) {
            n1_phase(p, layer);
            for (int rep2_ = 0; rep2_ < ((PROBE_SITE == 20 && layer > 0) ? 2 : 1); ++rep2_) {
            if (layer == 0) filt_fft_phase(p, lds);
            else { for (int u = bid; u < cvN0; u += G) cvt_moe_unit(p, layer, u, (LAS float*)lds); } }
            SEAM();
        }
        SITE(3) {
            if (hyena) { SchedPlain S{24, 136, D, p.ws + WS_WIN + (size_t)jl * D3 * D * 2, p.ws + WS_HBUF}; EpiH16 E{(h16*)(p.ws + WS_UT), TT, nullptr, 0};
                pg8::gemm_phase<EpiH16, SchedPlain, false>(lds, D, S, E); }
            else { SchedQkv S{p.ws + WS_HBUF, p.ws + WS_WQKV + (size_t)jl * DQKV * D * 2}; EpiH16 E{(h16*)(p.ws + WS_QK), DQK, (h16*)(p.ws + WS_VT), TT};
                pg8::gemm_phase<EpiH16, SchedQkv, false>(lds, D, S, E); }
            if (layer > 0 && idle1 > 0 && bid >= G - idle1) { for (int u = cvN0 + (bid - (G - idle1)); u < cvN1; u += idle1) cvt_moe_unit(p, layer, u, (LAS float*)lds); }
            SEAM();
        }
        SITE(4) {
#ifdef PROBE_PAR
            for (int rep3_ = 0; rep3_ < (((layer & 1) == PROBE_PAR) ? 2 : 1); ++rep3_)
#endif
            { if (hyena) conv_phase(p, jl, lds);
            else attn_phase(p, jl, layer != NLAYER - 1, lds); }
            SEAM();
        }
        SITE(5) {
            if (hyena) { transpose_phase(p, (LAS h16*)lds); SEAM(); }
        }
        SITE(6) {
            SchedPlain S{layer == NLAYER - 1 ? 128 : 136, 8, D, p.ws + WS_HBUF, hyena ? p.ws + WS_WOUT + (size_t)jl * D * D * 2 : p.ws + WS_WO + (size_t)jl * D * D * 2};
            EpiResid E{(float*)(p.ws + WS_XRES), (const float*)(p.ws + WS_MODS), layer, (float*)(p.ws + WS_SSQ)};
            pg8::gemm_phase<EpiResid, SchedPlain, false>(lds, D, S, E);
            if (layer > 0 && idle4 > 0 && bid >= G - idle4) { for (int u = cvN1 + (bid - (G - idle4)); u < CVT_MOE_UNITS; u += idle4) cvt_moe_unit(p, layer, u, (LAS float*)lds); }
            SEAM();
        }
        SITE(7) { n2_phase(p, layer, lds, ALL ? 0 : p.ph1); SEAM(); }
        LAS int* tstart = (LAS int*)(lds + LDS_MISC); LAS int* texp = tstart + 80; LAS int* tcnt = texp + 352;
        SITE(8) {
            moe_table(tstart, texp, tcnt, (const int*)(p.ws + WS_CTL) + CTL_CNT + layer * NE);
            SchedMoe1 S{{tstart, texp, tcnt}, p.ws + WS_HBUF, p.ws + WS_W13, (const int*)(p.ws + WS_LIST)}; EpiMoe1 E{(h16*)(p.ws + WS_H1)};
            pg8::gemm_phase<EpiMoe1, SchedMoe1, true>(lds, D, S, E);
            SEAM();
        }
        SITE(9) {
            moe_table(tstart, texp, tcnt, (const int*)(p.ws + WS_CTL) + CTL_CNT + layer * NE);
            SchedMoe2 S{{tstart, texp, tcnt}, p.ws + WS_H1, p.ws + WS_W2, (const int*)(p.ws + WS_LIST)}; EpiMoe2 E{(h16*)(p.ws + WS_YC), (const float*)(p.ws + WS_GATE), (const int*)(p.ws + WS_LIST)};
            pg8::gemm_phase<EpiMoe2, SchedMoe2, false>(lds, DE, S, E);
            SEAM();
        }
    }
    SITE(10) final_phase(p);
#undef SITE
#undef SEAM
}

template <int KIND> static void launch_kind(const Params& p, int grid, hipStream_t stream) {
    static bool attr = false;
    if (!attr) { attr = true; if (hipFuncSetAttribute((const void*)hy_fwd<KIND>, hipFuncAttributeMaxDynamicSharedMemorySize, LDS_BYTES) != hipSuccess) fprintf(stderr, "kernel_launch: hipFuncSetAttribute failed (kind %d)\n", KIND); }
    hipLaunchKernelGGL(hy_fwd<KIND>, dim3(grid), dim3(512), LDS_BYTES, stream, p);
}

extern "C" void kernel_launch(void* const* d_in, const int* in_sizes, int n_in, void* d_out, int out_size, void* d_ws, size_t ws_size, hipStream_t stream) {
    static int grid = 0;
    if (!grid) {
        if (n_in != 29 || out_size != TL * D || ws_size < WS_END) { fprintf(stderr, "kernel_launch: unexpected problem (n_in %d, out %d, ws %zu < %zu)\n", n_in, out_size, ws_size, (size_t)WS_END); grid = -1; return; }
        int dev = 0, cus = 0;
        if (hipGetDevice(&dev) != hipSuccess || hipDeviceGetAttribute(&cus, hipDeviceAttributeMultiprocessorCount, dev) != hipSuccess) { grid = -1; return; }
        grid = cus;
    }
    if (grid <= 0) return;
    (void)hipMemsetAsync((char*)d_ws + WS_CTL, 0, CTL_BYTES, stream);
    Params p{};
    const float** pp = (const float**)&p;
    for (int i = 0; i < 29; ++i) pp[i] = (const float*)d_in[i];
    p.out = (float*)d_out; p.ws = (char*)d_ws;
#if MK_MULTI
    p.ph0 = 0; p.ph1 = 0;
    launch_kind<0>(p, grid, stream); launch_kind<1>(p, grid, stream);
#ifndef PROBE_KIND
#define PROBE_KIND -1
#endif
#ifndef PROBE_LAYERS
#define PROBE_LAYERS 15
#endif
#define PREP(k) (((k) == PROBE_KIND && ((PROBE_LAYERS >> layer) & 1)) ? 2 : 1)
    if (PROBE_KIND == 0) launch_kind<0>(p, grid, stream);
    if (PROBE_KIND == 1) launch_kind<1>(p, grid, stream);
    for (int layer = 0; layer < NLAYER; ++layer) { p.ph0 = layer;
        for (int r = 0; r < PREP(2); ++r) launch_kind<2>(p, grid, stream);
        for (int r = 0; r < PREP(3); ++r) launch_kind<3>(p, grid, stream);
        for (int r = 0; r < PREP(4); ++r) launch_kind<4>(p, grid, stream);
        if ((layer & 1) == 0) for (int r = 0; r < PREP(5); ++r) launch_kind<5>(p, grid, stream);
        launch_kind<6>(p, grid, stream); launch_kind<7>(p, grid, stream);
        if (PREP(7) == 2) { p.ph1 = 1; launch_kind<7>(p, grid, stream); p.ph1 = 0; }
        for (int r = 0; r < PREP(8); ++r) launch_kind<8>(p, grid, stream);
        for (int r = 0; r < PREP(9); ++r) launch_kind<9>(p, grid, stream); }
    p.ph0 = 0; launch_kind<10>(p, grid, stream);
    if (PROBE_KIND == 10) launch_kind<10>(p, grid, stream);
#else
    p.ph0 = 0; p.ph1 = NPHASE;
    launch_kind<-1>(p, grid, stream);
#endif
}
```

```cpp
#include <hip/hip_runtime.h>
#include <cstdio>
#include <cstdint>

#define LAS __attribute__((address_space(3)))
typedef _Float16 h16;
typedef _Float16 f16x8 __attribute__((ext_vector_type(8)));
typedef _Float16 f16x4 __attribute__((ext_vector_type(4)));
typedef _Float16 f16x2 __attribute__((ext_vector_type(2)));
typedef float f32x2 __attribute__((ext_vector_type(2)));
typedef float f32x4 __attribute__((ext_vector_type(4)));
typedef float f32x16 __attribute__((ext_vector_type(16)));
typedef unsigned u32x2 __attribute__((ext_vector_type(2)));
typedef unsigned u32x4 __attribute__((ext_vector_type(4)));

constexpr int D = 2048, NB = 8, SEQ = 4096, CTXL = 256, TL = NB * SEQ, TC = NB * CTXL, TT = TL + TC;
constexpr int D3 = 3 * D, D6 = 6 * D, DQK = 2304, DQKV = 2560, NE = 64, DE = 384, DE2 = 768, NLAYER = 4;
constexpr int LCAP = TT;
constexpr int MOE_ROWS = 86016;
constexpr float EPS = 1e-6f;

constexpr size_t WS_CTL = 0;
constexpr size_t CTL_BYTES = 65536;
constexpr size_t WS_TW = WS_CTL + CTL_BYTES;
constexpr size_t WS_ROPE = WS_TW + 65536;
constexpr size_t WS_MODP = WS_ROPE + 8192;
constexpr size_t WS_MODS = WS_MODP + 16ull * 4 * 9 * 12288 * 4;
constexpr size_t WS_RTAB = WS_MODS + 4ull * 9 * 12288 * 4;
constexpr size_t RTAB_L = 64ull * 5 * 2 * 64 * 8 * 2;
constexpr size_t WS_RCST = WS_RTAB + 4 * RTAB_L;
constexpr size_t WS_H2P = WS_RCST + 16384;
constexpr size_t WS_W3P = WS_H2P + 2ull * 4352 * 256 * 2;
constexpr size_t WS_XRES = WS_W3P + 2ull * 8192 * 256 * 2;
constexpr size_t WS_HBUF = WS_XRES + (size_t)TT * D * 4;
constexpr size_t WS_UT = WS_HBUF + (size_t)TT * D * 2;
constexpr size_t UT_BYTES = (size_t)D3 * TT * 2;
constexpr size_t WS_TAPS = WS_UT;
constexpr size_t WS_TAPSC = WS_TAPS + 2ull * 8192 * 4096 * 4;
constexpr size_t WS_QK = WS_UT;
constexpr size_t WS_VT = WS_QK + (size_t)TT * DQK * 2;
constexpr size_t WS_ZT = WS_UT + UT_BYTES;
constexpr size_t WS_H1 = WS_ZT + (size_t)D * TT * 2;
constexpr size_t WS_YC = WS_H1 + (size_t)MOE_ROWS * DE * 2;
constexpr size_t WS_WIN = WS_YC + 2ull * TT * D * 2;
constexpr size_t WS_WOUT = WS_WIN + 2ull * D3 * D * 2;
constexpr size_t WS_WQKV = WS_WOUT + 2ull * D * D * 2;
constexpr size_t WS_WO = WS_WQKV + 2ull * DQKV * D * 2;
constexpr size_t WS_W13 = WS_WO + 2ull * D * D * 2;
constexpr size_t WS_W2 = WS_W13 + (size_t)NE * DE2 * D * 2;
constexpr size_t WS_KF = WS_W2 + (size_t)NE * D * DE * 2;
constexpr size_t WS_KFC = WS_KF + 2ull * 2 * 2048 * 65536;
constexpr size_t WS_LIST = WS_KFC + 2ull * 2 * 2048 * 4096;
constexpr size_t WS_GATE = WS_LIST + (size_t)NE * LCAP * 4;
constexpr size_t WS_SSQ = WS_GATE + (size_t)NE * LCAP * 4;
constexpr size_t WS_END = WS_SSQ + (size_t)TT * 32 * 4;
static_assert(WS_TAPSC + 2ull * 8192 * 256 * 4 <= WS_UT + UT_BYTES, "taps alias");
static_assert(WS_VT + 256ull * TT * 2 <= WS_UT + UT_BYTES, "qkv alias");

constexpr int CTL_CNT = 4096;

constexpr int LDS_BYTES = 147456;
constexpr int LDS_MISC = 139264;
constexpr int LDS_XB = LDS_BYTES - 16;

struct Params {
    const float *x, *c, *ctx, *c_ctx, *mod_w, *mod_b, *hy_w_in, *hy_conv_w, *hy_conv_b, *hy_f_w1, *hy_f_b1, *hy_f_freq1, *hy_f_w2, *hy_f_b2, *hy_f_freq2, *hy_f_w3,
        *hy_bias, *hy_w_out, *at_w_qkv, *at_sink, *at_w_o, *moe_wg, *moe_bg, *moe_we, *moe_be, *moe_w1, *moe_w3, *moe_w2, *final_gain;
    float* out; char* ws; int ph0, ph1;
};

__device__ __forceinline__ int tid_fresh() { int t = threadIdx.x; asm volatile("" : "+v"(t)); return t; }
__device__ __forceinline__ float bperm_f(float v, int srclane) { return __int_as_float(__builtin_amdgcn_ds_bpermute(srclane << 2, __float_as_int(v))); }
__device__ __forceinline__ float shx(float v, int mask) { return bperm_f(v, (tid_fresh() & 63) ^ mask); }
__device__ __forceinline__ const Params* params_fresh() { auto q = __builtin_amdgcn_kernarg_segment_ptr(); asm volatile("" : "+s"(q)); return (const Params*)q; }

#define XB_TMO      128
#define XB_XCNT(j)  (256  + 64 * (j))
#define XB_XSUB(j)  (1280 + 64 * (j))
#define XB_XGEN(j)  (2304 + 64 * (j))
#define XB_TOP      3328
#define XB_TOPGEN   3392
#define XCD_BAR_WORDS 3456
#define XB_SPIN_CAP (1u << 18)

__device__ __forceinline__ unsigned xb_ld(unsigned* p)              { return __hip_atomic_load(p, __ATOMIC_RELAXED, __HIP_MEMORY_SCOPE_AGENT); }
__device__ __forceinline__ unsigned xb_add(unsigned* p, unsigned v) { return __hip_atomic_fetch_add(p, v, __ATOMIC_RELAXED, __HIP_MEMORY_SCOPE_AGENT); }
__device__ __forceinline__ unsigned xb_xcc_id() { return (unsigned)__builtin_amdgcn_s_getreg((3 << 11) | 20) & 0xFu; }
#define XB_SPIN(cond, bar) do { unsigned _sp = 0; while (cond) { __builtin_amdgcn_s_sleep(1); \
    if ((++_sp & 255u) == 0u) { if (xb_ld(&(bar)[XB_TMO])) break; if (_sp > XB_SPIN_CAP) { atomicAdd(&(bar)[XB_TMO], 1u); break; } } } } while (0)

struct XcdBarrier { unsigned* bar; volatile LAS unsigned* st; };

__device__ __forceinline__ XcdBarrier xcd_barrier_post(unsigned* bar, volatile LAS unsigned* st) {
    XcdBarrier b; b.bar = bar; b.st = st;
    if (threadIdx.x == 0) (void)xb_add(&bar[XB_XCNT(xb_xcc_id())], 1u);
    return b;
}
__device__ __forceinline__ void xcd_barrier_complete(unsigned* bar, unsigned x, unsigned& nloc, unsigned& nx) {
    const unsigned G = gridDim.x * gridDim.y * gridDim.z;
    unsigned sum, cnt, mine, sp = 0u;
    for (;;) {
        sum = 0u; cnt = 0u; mine = 0u;
#pragma unroll
        for (unsigned j = 0; j < 16; ++j) { const unsigned c = xb_ld(&bar[XB_XCNT(j)]); sum += c; cnt += (c > 0u) ? 1u : 0u; mine = (j == x) ? c : mine; }
        if (sum == G) break;
        __builtin_amdgcn_s_sleep(1);
        if ((++sp & 255u) == 0u) { if (xb_ld(&bar[XB_TMO])) break; if (sp > XB_SPIN_CAP) { atomicAdd(&bar[XB_TMO], 1u); break; } }
    }
    nloc = mine > 0u ? mine : 1u; nx = cnt > 0u ? cnt : 1u;
}
__device__ __forceinline__ void xcd_barrier(const XcdBarrier& b) {
    asm volatile("s_waitcnt vmcnt(0)" ::: "memory");
    __syncthreads();
    if (threadIdx.x == 0) {
        unsigned* bar = b.bar; const unsigned bx = xb_xcc_id();
        __builtin_amdgcn_s_waitcnt(0);
        unsigned nloc = b.st[0], nx = b.st[1];
        if (nloc == 0u) { xcd_barrier_complete(bar, bx, nloc, nx); b.st[0] = nloc; b.st[1] = nx; }
        const unsigned old = xb_add(&bar[XB_XSUB(bx)], 1u);
        const unsigned gen = old / nloc;
        if (old + 1u == (gen + 1u) * nloc) {
            __builtin_amdgcn_fence(__ATOMIC_RELEASE, "agent");
            asm volatile("s_waitcnt vmcnt(0)" ::: "memory");
            const unsigned og = xb_add(&bar[XB_TOP], 1u);
            const unsigned tg = og / nx;
            if (og + 1u == (tg + 1u) * nx) xb_add(&bar[XB_TOPGEN], 1u);
            else XB_SPIN(xb_ld(&bar[XB_TOPGEN]) == tg, bar);
            __builtin_amdgcn_fence(__ATOMIC_ACQUIRE, "agent");
            xb_add(&bar[XB_XGEN(bx)], 1u);
            asm volatile("s_waitcnt vmcnt(0)" ::: "memory");
        } else {
            XB_SPIN(xb_ld(&bar[XB_XGEN(bx)]) == gen, bar);
            __builtin_amdgcn_fence(__ATOMIC_ACQUIRE, "agent");
            asm volatile("s_waitcnt vmcnt(0)" ::: "memory");
        }
    }
    __syncthreads();
}

namespace pg8 {
constexpr int BM = 256, BK = 64, HALF = 128, HTB = HALF * BK * 2, STAGE_BYTES = 8 * HTB;
__device__ __forceinline__ int lds_byte(int r, int c) { const int st = (r >> 4) * 2 + (c >> 5), rr = r & 15, cc = c & 31, ob = rr * 64 + cc * 2; return st * 1024 + (ob ^ (((ob >> 9) & 1) << 5)); }
__device__ __forceinline__ void stage_rc(int b, int& R, int& C) { const int st = b / 1024, sb = b % 1024, swz = sb ^ (((sb >> 9) & 1) << 5); R = (st >> 1) * 16 + swz / 64; C = (st & 1) * 32 + (swz % 64) / 2; }
__device__ __forceinline__ int perm32(int rho) { const int n = rho >> 4, i = rho & 15; return 8 * (i >> 2) + 4 * n + (i & 3); }

struct Unit {
    int pm, pn;
    int e, pos0, cnt;
    int kind;
    int half;
    const char* A; const char* B;
    const int* rows;
};

typedef short s16x4 __attribute__((ext_vector_type(4)));
template <class Epi, class Sched, int AMODE>
__device__ __forceinline__ void gemm_phase(LAS unsigned char* lds, const int K, const Sched& S, const Epi& E, const int ldat = 0) {
    constexpr bool GATHER = AMODE == 1, ATR = AMODE == 2;
    const int tid = tid_fresh(), wid = __builtin_amdgcn_readfirstlane(tid >> 6), lane = tid & 63, wr = wid >> 2, wc = wid & 3, fr = lane & 15, fq = lane >> 4;
    const int nt = K / BK;
    unsigned voffA[2], voffB[2]; int RA[2], CA[2];
#pragma unroll
    for (int i = 0; i < 2; ++i) { int R, C; stage_rc(tid * 16 + i * 8192, R, C); const int Rb = Epi::PERM ? ((R & ~31) + perm32(R & 31)) : R;
        voffA[i] = (unsigned)(R * K + C) * 2u; voffB[i] = (unsigned)(Rb * K + C) * 2u; RA[i] = R; CA[i] = C;
        if constexpr (ATR) { const int bb = tid * 16 + i * 8192, row = bb >> 8, pc = (bb >> 4) & 15, ch = pc ^ (((row & 3) << 2) | ((row >> 2) & 3)); voffA[i] = (unsigned)(row * ldat + 8 * ch) * 2u; } }
    const size_t kstep = (size_t)(BK * 2);
    const size_t hstep = (size_t)HALF * K * 2;
    const size_t kstepA = ATR ? (size_t)BK * ldat * 2 : kstep, hstepA = ATR ? (size_t)HALF * 2 : hstep;
    const unsigned ldsw = (unsigned)wid * 1024u;
    const int aoff = lds_byte(wr * 64 + fr, fq * 8), boff = lds_byte(wc * 32 + fr, fq * 8);
    int atr[4][2];
#pragma unroll
    for (int m = 0; m < 4; ++m)
#pragma unroll
        for (int bl = 0; bl < 2; ++bl) { const int xr = ((fr >> 2) << 2) | ((2 * fq + bl) & 3); atr[m][bl] = 256 * (8 * fq + (fr >> 2) + 4 * bl) + 16 * ((wr * 8 + 2 * m + ((fr & 3) >> 1)) ^ xr) + 8 * (fr & 1); }
    unsigned vgC[2][2], vgN[2][2];
#define PG8_ROWS(u, vg) do { if constexpr (GATHER) { _Pragma("unroll") for (int _h = 0; _h < 2; ++_h) _Pragma("unroll") for (int _i = 0; _i < 2; ++_i) { \
        const int _p = (u).pos0 + _h * HALF + RA[_i]; const int _tok = (_p < (u).cnt) ? ((u).rows[_h * HALF + RA[_i]] >> 1) : 0; \
        vg[_h][_i] = ((unsigned)_tok * (unsigned)K + (unsigned)CA[_i]) * 2u; } } } while (0)
#define PG8_SA(b, h) (((b) * 2 + (h)) * HTB)
#define PG8_SB(b, h) ((4 + (b) * 2 + (h)) * HTB)
#define PG8_STAGE_B(bufoff, gbase) do { _Pragma("unroll") for (int _i = 0; _i < 2; ++_i) \
        __builtin_amdgcn_global_load_lds((const unsigned*)((const char*)(gbase) + voffB[_i]), (LAS unsigned*)(lds + (bufoff) + ldsw + _i * 8192), 16, 0, 0); } while (0)
#define PG8_STAGE_A(bufoff, gbase, h, NEXT) do { _Pragma("unroll") for (int _i = 0; _i < 2; ++_i) { \
        const unsigned _vo = GATHER ? ((NEXT) ? vgN[h][_i] : vgC[h][_i]) : voffA[_i]; \
        __builtin_amdgcn_global_load_lds((const unsigned*)((const char*)(gbase) + (GATHER ? (size_t)0 : (size_t)(h) * hstepA) + _vo), (LAS unsigned*)(lds + (bufoff) + ldsw + _i * 8192), 16, 0, 0); } } while (0)
#define PG8_LDA(dst, b, h) do { if constexpr (!ATR) { _Pragma("unroll") for (int m = 0; m < 4; ++m) _Pragma("unroll") for (int k = 0; k < 2; ++k) dst[m][k] = *(const LAS f16x8*)(lds + PG8_SA(b, h) + aoff + m * 2048 + k * 1024); } \
        else { _Pragma("unroll") for (int m = 0; m < 4; ++m) _Pragma("unroll") for (int k = 0; k < 2; ++k) { \
            const s16x4 _lo = __builtin_amdgcn_ds_read_tr16_b64_v4i16((LAS s16x4*)(lds + PG8_SA(b, h) + atr[m][0] + k * 8192)), _hi = __builtin_amdgcn_ds_read_tr16_b64_v4i16((LAS s16x4*)(lds + PG8_SA(b, h) + atr[m][1] + k * 8192)); \
            const short __attribute__((ext_vector_type(8))) _v = {_lo[0], _lo[1], _lo[2], _lo[3], _hi[0], _hi[1], _hi[2], _hi[3]}; dst[m][k] = __builtin_bit_cast(f16x8, _v); } } } while (0)
#define PG8_LDB(dst, b, h) do { _Pragma("unroll") for (int n = 0; n < 2; ++n) _Pragma("unroll") for (int k = 0; k < 2; ++k) dst[n][k] = *(const LAS f16x8*)(lds + PG8_SB(b, h) + boff + n * 2048 + k * 1024); } while (0)
#define PG8_MMA(ai, bj, At, Bt) do { __builtin_amdgcn_s_setprio(1); _Pragma("unroll") for (int m = 0; m < 4; ++m) _Pragma("unroll") for (int n = 0; n < 2; ++n) _Pragma("unroll") for (int k = 0; k < 2; ++k) \
        acc[ai][bj][m][n] = __builtin_amdgcn_mfma_f32_16x16x32_f16(Bt[n][k], At[m][k], acc[ai][bj][m][n], 0, 0, 0); __builtin_amdgcn_s_setprio(0); } while (0)
#define PG8_WAIT_V(n) asm volatile("s_waitcnt vmcnt(" #n ")" ::: "memory")
#define PG8_WAIT_L(n) asm volatile("s_waitcnt lgkmcnt(" #n ")" ::: "memory")
#define PG8_BAR __builtin_amdgcn_s_barrier()
#define PG8_SCHED __builtin_amdgcn_sched_barrier(0)
    Unit cur, nxt; int ui = 0;
    if (!S.next(0, cur)) return;
    f32x4 acc[2][2][4][2];
#pragma unroll
    for (int a = 0; a < 2; ++a)
#pragma unroll
        for (int b = 0; b < 2; ++b)
#pragma unroll
            for (int m = 0; m < 4; ++m)
#pragma unroll
                for (int n = 0; n < 2; ++n) acc[a][b][m][n] = (f32x4){0.f, 0.f, 0.f, 0.f};
    f16x8 At[4][2], B0[2][2], B1[2][2];
    const char* cA = cur.A; const char* cB = cur.B;
    PG8_ROWS(cur, vgC);
#pragma unroll
    for (int _h = 0; _h < 2; ++_h)
#pragma unroll
        for (int _i = 0; _i < 2; ++_i) vgN[_h][_i] = GATHER ? vgC[_h][_i] : 0u;
    PG8_STAGE_B(PG8_SB(0, 0), cB); PG8_STAGE_B(PG8_SB(0, 1), cB + hstep); PG8_STAGE_A(PG8_SA(0, 0), cA, 0, false); PG8_STAGE_A(PG8_SA(0, 1), cA, 1, false);
    if (wr == 1) PG8_BAR;
    PG8_WAIT_V(2); PG8_BAR;
    PG8_STAGE_B(PG8_SB(1, 0), cB + kstep); PG8_STAGE_A(PG8_SA(1, 0), cA + kstepA, 0, false); PG8_STAGE_B(PG8_SB(1, 1), cB + hstep + kstep);
    PG8_WAIT_V(6); PG8_BAR;
    for (;;) {
        const bool has_next = S.next(ui + 1, nxt);
        const bool full = cur.half == 0;
        const char* nA = has_next ? nxt.A : cA; const char* nB = has_next ? nxt.B : cB;
        if (has_next) { PG8_ROWS(nxt, vgN); }
#pragma unroll 1
        for (int t = 0; t < nt; t += 2) {
            const bool last = (t == nt - 2);
            const char* a1 = cA + (size_t)(t + 1) * kstepA;
            const char* a2 = last ? nA : cA + (size_t)(t + 2) * kstepA; const char* b2 = last ? nB : cB + (size_t)(t + 2) * kstep;
            const char* a3 = a2 + kstepA; const char* b3 = b2 + kstep;
            PG8_LDB(B0, 0, 0); PG8_LDB(B1, 0, 1); PG8_SCHED; PG8_LDA(At, 0, 0); PG8_STAGE_A(PG8_SA(1, 1), a1, 1, false);
            PG8_WAIT_V(8); PG8_WAIT_L(0); PG8_BAR; PG8_MMA(0, 0, At, B0); PG8_MMA(0, 1, At, B1); PG8_BAR; PG8_SCHED;
            PG8_LDA(At, 0, 1); PG8_STAGE_B(PG8_SB(0, 0), b2); PG8_STAGE_B(PG8_SB(0, 1), b2 + hstep); PG8_STAGE_A(PG8_SA(0, 0), a2, 0, last);
            PG8_WAIT_V(8); PG8_WAIT_L(0); PG8_BAR; if (full) { PG8_MMA(1, 0, At, B0); PG8_MMA(1, 1, At, B1); } PG8_BAR; PG8_SCHED;
            PG8_LDB(B0, 1, 0); PG8_LDB(B1, 1, 1); PG8_SCHED; PG8_LDA(At, 1, 0); PG8_STAGE_A(PG8_SA(0, 1), a2, 1, last);
            PG8_WAIT_V(8); PG8_WAIT_L(0); PG8_BAR; PG8_MMA(0, 0, At, B0); PG8_MMA(0, 1, At, B1); PG8_BAR; PG8_SCHED;
            PG8_LDA(At, 1, 1); PG8_STAGE_B(PG8_SB(1, 0), b3); PG8_STAGE_B(PG8_SB(1, 1), b3 + hstep); PG8_STAGE_A(PG8_SA(1, 0), a3, 0, last);
            PG8_WAIT_V(8); PG8_WAIT_L(0); PG8_BAR; if (full) { PG8_MMA(1, 0, At, B0); PG8_MMA(1, 1, At, B1); } PG8_BAR; PG8_SCHED;
        }
        if (wr == 0) PG8_BAR;
        E(acc, cur, wr, wc, fr, fq);
        if (!has_next) break;
#pragma unroll
        for (int a = 0; a < 2; ++a)
#pragma unroll
            for (int b = 0; b < 2; ++b)
#pragma unroll
                for (int m = 0; m < 4; ++m)
#pragma unroll
                    for (int n = 0; n < 2; ++n) acc[a][b][m][n] = (f32x4){0.f, 0.f, 0.f, 0.f};
        cur = nxt; cA = nA; cB = nB; ++ui;
#pragma unroll
        for (int _h = 0; _h < 2; ++_h)
#pragma unroll
            for (int _i = 0; _i < 2; ++_i) vgC[_h][_i] = vgN[_h][_i];
        if (wr == 1) PG8_BAR;
    }
    PG8_WAIT_V(0);
    PG8_BAR;
#undef PG8_ROWS
#undef PG8_SA
#undef PG8_SB
#undef PG8_STAGE_A
#undef PG8_STAGE_B
#undef PG8_LDA
#undef PG8_LDB
#undef PG8_MMA
#undef PG8_WAIT_V
#undef PG8_WAIT_L
#undef PG8_BAR
#undef PG8_SCHED
}
}

using pg8::Unit;
__device__ __forceinline__ f16x8 pack8(const f32x4 a, const f32x4 b) {
    f16x8 w; w[0] = (h16)a[0]; w[1] = (h16)a[1]; w[2] = (h16)a[2]; w[3] = (h16)a[3]; w[4] = (h16)b[0]; w[5] = (h16)b[1]; w[6] = (h16)b[2]; w[7] = (h16)b[3]; return w;
}
struct EpiH16 {
    static constexpr bool PERM = true;
    h16* O0; int ld0; h16* O1; int ld1;
    __device__ __forceinline__ void operator()(const f32x4 (&acc)[2][2][4][2], const Unit& u, int wr, int wc, int fr, int fq) const {
        h16* base = u.kind ? O1 : O0; const int ld = u.kind ? ld1 : ld0;
        const int row0 = u.pm * 256 + wr * 64 + fr, col0 = u.pn * 256 + wc * 32 + 8 * fq;
#pragma unroll
        for (int ai = 0; ai < 2; ++ai)
#pragma unroll
            for (int m = 0; m < 4; ++m) { h16* rowp = base + (size_t)(row0 + ai * 128 + m * 16) * ld + col0;
#pragma unroll
                for (int bj = 0; bj < 2; ++bj) __builtin_nontemporal_store(pack8(acc[ai][bj][m][0], acc[ai][bj][m][1]), (f16x8*)(rowp + bj * 128)); }
    }
};
struct EpiTaps {
    static constexpr bool PERM = false;
    float* T0; float* T1;
    __device__ __forceinline__ void operator()(const f32x4 (&acc)[2][2][4][2], const Unit& u, int wr, int wc, int fr, int fq) const {
        const int j = u.kind >> 1, v = u.kind & 1; const int ld = v ? 256 : 4096;
        float* base = v ? (T1 + (size_t)j * 8192 * 256) : (T0 + (size_t)j * 8192 * 4096);
        const int row0 = u.pm * 256 + wr * 64 + fr, col0 = u.pn * 256 + wc * 32 + 4 * fq;
#pragma unroll
        for (int ai = 0; ai < 2; ++ai)
#pragma unroll
            for (int m = 0; m < 4; ++m) { float* rowp = base + (size_t)(row0 + ai * 128 + m * 16) * ld + col0;
#pragma unroll
                for (int bj = 0; bj < 2; ++bj)
#pragma unroll
                    for (int n = 0; n < 2; ++n) *(f32x4*)(rowp + bj * 128 + n * 16) = acc[ai][bj][m][n]; }
    }
};
struct EpiResid {
    static constexpr bool PERM = false;
    float* X; const float* mods; int layer; float* SSQ;
    __device__ __forceinline__ void operator()(const f32x4 (&acc)[2][2][4][2], const Unit& u, int wr, int wc, int fr, int fq) const {
        const int r0 = u.pm * 256; const int b = r0 < TL ? (r0 >> 12) : 8;
        const float* g = mods + ((size_t)(layer * 9 + b) * 6 + 2) * D;
        const int row0 = r0 + wr * 64 + fr, col0 = u.pn * 256 + wc * 32 + 4 * fq;
        f32x4 gv[2][2];
#pragma unroll
        for (int bj = 0; bj < 2; ++bj)
#pragma unroll
            for (int n = 0; n < 2; ++n) gv[bj][n] = *(const f32x4*)(g + col0 + bj * 128 + n * 16);
#pragma unroll
        for (int ai = 0; ai < 2; ++ai)
#pragma unroll
            for (int m = 0; m < 4; ++m) { const int row = row0 + ai * 128 + m * 16; float* rowp = X + (size_t)row * D + col0; float sq = 0.f;
#pragma unroll
                for (int bj = 0; bj < 2; ++bj)
#pragma unroll
                    for (int n = 0; n < 2; ++n) { f32x4* pp = (f32x4*)(rowp + bj * 128 + n * 16); const f32x4 v = *pp + gv[bj][n] * acc[ai][bj][m][n]; *pp = v; sq += v[0] * v[0] + v[1] * v[1] + v[2] * v[2] + v[3] * v[3]; }
                sq += shx(sq, 16); sq += shx(sq, 32);
                if (fq == 0) SSQ[(size_t)row * 32 + u.pn * 4 + wc] = sq; }
    }
};
struct EpiMoe1 {
    static constexpr bool PERM = true;
    h16* H1;
    __device__ __forceinline__ void operator()(const f32x4 (&acc)[2][2][4][2], const Unit& u, int wr, int wc, int fr, int fq) const {
        const int row0 = u.pm * 256 + wr * 64 + fr, col0 = u.pn * 128 + wc * 16 + 4 * fq;
#pragma unroll
        for (int ai = 0; ai < 2; ++ai)
#pragma unroll
            for (int m = 0; m < 4; ++m) { if (ai == 1 && u.half) continue; h16* rowp = H1 + (size_t)(row0 + ai * 128 + m * 16) * DE + col0;
#pragma unroll
                for (int bj = 0; bj < 2; ++bj) { const f32x4 a = acc[ai][bj][m][0], b = acc[ai][bj][m][1]; f16x4 w;
#pragma unroll
                    for (int i = 0; i < 4; ++i) { const float s = a[i] / (1.0f + __expf(-a[i])); w[i] = (h16)(s * b[i]); }
                    *(f16x4*)(rowp + bj * 64) = w; } }
    }
};
struct EpiMoe2 {
    static constexpr bool PERM = true;
    h16* YC; const float* gslot;
    __device__ __forceinline__ void operator()(const f32x4 (&acc)[2][2][4][2], const Unit& u, int wr, int wc, int fr, int fq) const {
        const int col0 = u.pn * 256 + wc * 32 + 8 * fq;
        const float* grow = gslot + ((const char*)u.rows - (const char*)listbase) / 4;
        int av[2][4]; float gv[2][4];
#pragma unroll
        for (int ai = 0; ai < 2; ++ai)
#pragma unroll
            for (int m = 0; m < 4; ++m) { const int r = ai * 128 + wr * 64 + m * 16 + fr; const bool ok = u.pos0 + r < u.cnt; av[ai][m] = ok ? u.rows[r] : -1; gv[ai][m] = ok ? grow[r] : 0.f; }
#pragma unroll
        for (int ai = 0; ai < 2; ++ai)
#pragma unroll
            for (int m = 0; m < 4; ++m) { if (av[ai][m] >= 0) { const float g = gv[ai][m]; h16* rowp = YC + (size_t)av[ai][m] * D + col0;
#pragma unroll
                    for (int bj = 0; bj < 2; ++bj) *(f16x8*)(rowp + bj * 128) = pack8(acc[ai][bj][m][0] * g, acc[ai][bj][m][1] * g); } }
    }
    const int* listbase;
};

__device__ __forceinline__ void order_tile(int wgid, int nM, int nN, int& pm, int& pn) {
    const int nwg = nM * nN; { const int q = nwg / 8, r = nwg % 8, xcd = wgid % 8, off = wgid / 8; wgid = (xcd < r ? xcd * (q + 1) : r * (q + 1) + (xcd - r) * q) + off; }
    const int nig = 8 * nN, gid = wgid / nig, fm = gid * 8, gsz = (nM - fm) < 8 ? (nM - fm) : 8;
    pm = fm + ((wgid % nig) % gsz); pn = (wgid % nig) / gsz;
}
struct SchedPlain {
    int nM, nN, K; const char* A; const char* B;
    __device__ __forceinline__ bool next(int i, Unit& u) const {
        const long L = (long)i * gridDim.x + blockIdx.x; if (L >= (long)nM * nN) return false;
        order_tile((int)L, nM, nN, u.pm, u.pn); u.kind = 0; u.half = 0; u.e = 0; u.pos0 = 0; u.cnt = 0; u.rows = nullptr;
        u.A = A + (size_t)u.pm * 256 * K * 2; u.B = B + (size_t)u.pn * 256 * K * 2; return true;
    }
};
struct SchedPlainAT {
    int nM, nN, K; const char* At; const char* B;
    __device__ __forceinline__ bool next(int i, Unit& u) const {
        const long L = (long)i * gridDim.x + blockIdx.x; if (L >= (long)nM * nN) return false;
        order_tile((int)L, nM, nN, u.pm, u.pn); u.kind = 0; u.half = 0; u.e = 0; u.pos0 = 0; u.cnt = 0; u.rows = nullptr;
        u.A = At + (size_t)u.pm * 256 * 2; u.B = B + (size_t)u.pn * 256 * K * 2; return true;
    }
};
struct SchedQkv {
    const char* H; const char* W;
    __device__ __forceinline__ bool next(int i, Unit& u) const {
        const long L = (long)i * gridDim.x + blockIdx.x; const int nA = 136 * 9; if (L >= nA + 136) return false;
        u.e = 0; u.half = 0; u.pos0 = 0; u.cnt = 0; u.rows = nullptr;
        if (L < nA) { order_tile((int)L, 136, 9, u.pm, u.pn); u.kind = 0; u.A = H + (size_t)u.pm * 256 * D * 2; u.B = W + (size_t)u.pn * 256 * D * 2; }
        else { u.pm = 0; u.pn = (int)L - nA; u.kind = 1; u.A = W + (size_t)DQK * D * 2; u.B = H + (size_t)u.pn * 256 * D * 2; }
        return true;
    }
};
struct SchedFilt {
    const char* W3P; const char* H2P;
    __device__ __forceinline__ bool next(int i, Unit& u) const {
        const long L = (long)i * gridDim.x + blockIdx.x; if (L >= 2 * 544) return false;
        const int j = (int)L / 544, r = (int)L % 544; u.e = 0; u.half = 0; u.pos0 = 0; u.cnt = 0; u.rows = nullptr;
        int v; if (r < 512) { v = 0; u.pm = r >> 4; u.pn = r & 15; } else { v = 1; u.pm = r - 512; u.pn = 0; }
        u.kind = 2 * j + v;
        u.A = W3P + ((size_t)j * 8192 + (size_t)u.pm * 256) * 256 * 2;
        u.B = H2P + ((size_t)j * 4352 + (v ? 4096 : 0) + (size_t)u.pn * 256) * 256 * 2;
        return true;
    }
};
struct MoeTab { const LAS int* tstart; const LAS int* texp; const LAS int* cnt; };
struct SchedMoe1 {
    MoeTab tb; const char* H; const char* W13; const int* list;
    __device__ __forceinline__ bool next(int i, Unit& u) const {
        const long L = (long)i * gridDim.x + blockIdx.x; const int ntile = __builtin_amdgcn_readfirstlane(tb.tstart[NE]); if (L >= (long)ntile * 3) return false;
        int rt; order_tile((int)L, ntile, 3, rt, u.pn); u.pm = rt; u.kind = 0;
        const int e = __builtin_amdgcn_readfirstlane(tb.texp[rt]); u.e = e; u.pos0 = (rt - __builtin_amdgcn_readfirstlane(tb.tstart[e])) * 256; u.cnt = __builtin_amdgcn_readfirstlane(tb.cnt[e]); u.half = (u.cnt - u.pos0 <= 128) ? 1 : 0;
        u.rows = list + (size_t)e * LCAP + u.pos0; u.A = H; u.B = W13 + ((size_t)e * DE2 + (size_t)u.pn * 256) * D * 2; return true;
    }
};
struct SchedMoe2 {
    MoeTab tb; const char* H1; const char* W2; const int* list;
    __device__ __forceinline__ bool next(int i, Unit& u) const {
        const long L = (long)i * gridDim.x + blockIdx.x; const int ntile = __builtin_amdgcn_readfirstlane(tb.tstart[NE]); if (L >= (long)ntile * 8) return false;
        int rt; order_tile((int)L, ntile, 8, rt, u.pn); u.pm = rt; u.kind = 0;
        const int e = __builtin_amdgcn_readfirstlane(tb.texp[rt]); u.e = e; u.pos0 = (rt - __builtin_amdgcn_readfirstlane(tb.tstart[e])) * 256; u.cnt = __builtin_amdgcn_readfirstlane(tb.cnt[e]); u.half = (u.cnt - u.pos0 <= 128) ? 1 : 0;
        u.rows = list + (size_t)e * LCAP + u.pos0; u.A = H1 + (size_t)rt * 256 * DE * 2; u.B = W2 + ((size_t)e * D + (size_t)u.pn * 256) * DE * 2; return true;
    }
};
__device__ __forceinline__ void moe_table(LAS int* tstart, LAS int* texp, LAS int* cnt, const int* counters) {
    const int t = tid_fresh();
    if (t < NE) cnt[t] = counters[t];
    __syncthreads();
    if (t <= NE) { int s = 0; for (int e = 0; e < t; ++e) s += (cnt[e] + 255) >> 8; tstart[t] = s; }
    __syncthreads();
    if (t < NE) { const int s0 = tstart[t], s1 = tstart[t + 1]; for (int q = s0; q < s1; ++q) texp[q] = t; }
    __syncthreads();
}

__device__ __forceinline__ float wave_sum(float v) {
#pragma unroll
    for (int o = 32; o >= 1; o >>= 1) v += shx(v, o);
    return v;
}
__device__ __forceinline__ float silu_f(float x) { return x / (1.0f + expf(-x)); }
__device__ __forceinline__ int batch_of_row(int r) { return r < TL ? (r >> 12) : 8; }

__device__ __forceinline__ void modp_unit(const Params& p, int unit, LAS float* sl) {
    const int layer = unit / 96, rem = unit % 96, ks = rem / 6, cc = rem % 6, tid = tid_fresh();
    for (int i = tid; i < 9 * 128; i += 512) { const int cnd = i >> 7, k = ks * 128 + (i & 127); const float v = cnd < 8 ? p.c[cnd * D + k] : p.c_ctx[k]; sl[i] = silu_f(v); }
    __syncthreads();
    f32x4 acc[9];
#pragma unroll
    for (int q = 0; q < 9; ++q) acc[q] = (f32x4){0.f, 0.f, 0.f, 0.f};
    const float* w = p.mod_w + ((size_t)layer * D + (size_t)ks * 128) * D6 + cc * 2048 + tid * 4;
#pragma unroll 4
    for (int k = 0; k < 128; ++k) { const f32x4 wv = *(const f32x4*)(w + (size_t)k * D6);
#pragma unroll
        for (int q = 0; q < 9; ++q) acc[q] += wv * sl[q * 128 + k]; }
    float* outp = (float*)(p.ws + WS_MODP) + ((size_t)(ks * 4 + layer) * 9) * D6 + cc * 2048 + tid * 4;
#pragma unroll
    for (int q = 0; q < 9; ++q) *(f32x4*)(outp + (size_t)q * D6) = acc[q];
    __syncthreads();
}
__device__ __forceinline__ void modr_unit(const Params& p, int unit) {
    const size_t idx = (size_t)unit * 2048 + tid_fresh() * 4; const int layer = (int)(idx / (9 * D6)), col = (int)(idx % D6);
    f32x4 s = *(const f32x4*)(p.mod_b + (size_t)layer * D6 + col);
    const float* pp = (const float*)(p.ws + WS_MODP) + idx;
#pragma unroll
    for (int ks = 0; ks < 16; ++ks) s += *(const f32x4*)(pp + (size_t)ks * 4 * 9 * D6);
    *(f32x4*)((float*)(p.ws + WS_MODS) + idx) = s;
}
__device__ __forceinline__ void tables_unit(const Params& p) {
    f32x2* tw = (f32x2*)(p.ws + WS_TW);
    for (int m = tid_fresh(); m < 8192; m += 512) { double s, c; sincospi(-(double)m / 4096.0, &s, &c); tw[m] = (f32x2){(float)c, (float)s}; }
    float* rc = (float*)(p.ws + WS_ROPE);
    for (int i = tid_fresh(); i < 1024; i += 512) { const int pos = i >> 4, q = i & 15; const float inv = powf(10000.0f, -(float)q / 16.0f); const float ang = (float)pos * inv;
        rc[i] = cosf(ang); rc[1024 + i] = sinf(ang); }
}
__device__ __forceinline__ void h2_task(const Params& p, int task) {
    const int lane = tid_fresh() & 63; const int j = task / 4352, r = task % 4352; const int v = r >= 4096, t = v ? r - 4096 : r; const int Lv = v ? 256 : 4096;
    const float tl = (float)t / (float)(Lv - 1);
    const float omega = (float)(2.0 * 3.14159265358979323846 / (double)Lv) * (float)t;
    float feat = 0.f;
    if (lane == 0) feat = tl;
    else if (lane <= 32) { const int bi = (lane - 1) & 15; const float band = 1e-4f + (float)bi * ((15.0f - 1e-4f) / 15.0f); const float a = band * omega; feat = lane <= 16 ? cosf(a) : -sinf(a); }
    const float* w1 = p.hy_f_w1 + (size_t)j * 33 * 64; const float* w2 = p.hy_f_w2 + (size_t)j * 64 * 64;
    float s = p.hy_f_b1[j * 64 + lane];
    for (int f = 0; f < 33; ++f) s += bperm_f(feat, f) * w1[f * 64 + lane];
    const float h1 = sinf(p.hy_f_freq1[j * 64 + lane] * s);
    float s2 = p.hy_f_b2[j * 64 + lane];
    for (int m = 0; m < 64; ++m) s2 += bperm_f(h1, m) * w2[m * 64 + lane];
    const float h2 = sinf(p.hy_f_freq2[j * 64 + lane] * s2);
    const h16 hi = (h16)h2; const h16 lo = (h16)(h2 - (float)hi);
    h16* row = (h16*)(p.ws + WS_H2P) + ((size_t)j * 4352 + r) * 256;
    row[lane] = hi; row[64 + lane] = hi; row[128 + lane] = lo; row[192 + lane] = lo;
}
__device__ __forceinline__ void w3p_unit(const Params& p, int unit) {
    const int j = unit >> 5, c0 = (unit & 31) * 256; const float* w3 = p.hy_f_w3 + (size_t)j * 64 * 8192; h16* dst = (h16*)(p.ws + WS_W3P) + (size_t)j * 8192 * 256;
    for (int i = tid_fresh(); i < 64 * 256; i += 512) { const int m = i >> 8, col = c0 + (i & 255); const float w = w3[(size_t)m * 8192 + col];
        const h16 hi = (h16)w; const h16 lo = (h16)(w - (float)hi); h16* row = dst + (size_t)col * 256; row[m] = hi; row[64 + m] = lo; row[128 + m] = hi; row[192 + m] = lo; }
}
__device__ __forceinline__ void rtab_unit(const Params& p, int unit) {
    const int layer = unit >> 6, c = unit & 63; h16* dst = (h16*)(p.ws + WS_RTAB + (size_t)layer * RTAB_L) + (size_t)c * 5 * 2 * 64 * 8;
    for (int i = tid_fresh(); i < 5 * 2 * 64 * 8; i += 512) { const int jj = i & 7, lane = (i >> 3) & 63, hl = (i >> 9) & 1, ct = i >> 10;
        const int k = 32 * c + 8 * (lane >> 4) + jj, col = 16 * ct + (lane & 15);
        float w = 0.f; if (col < 8) w = p.moe_wg[((size_t)layer * D + k) * 8 + col]; else if (col < 72) w = p.moe_we[((size_t)layer * D + k) * 64 + (col - 8)];
        w *= 256.0f; const h16 hi = (h16)w; const h16 lo = (h16)(w - (float)hi); dst[i] = hl ? lo : hi; }
}
template <int NW>
__device__ __forceinline__ void cvt_tile(const float* src, int ldn, int k0, int n0, h16* dst, int ldk, int mode, LAS float* T) {
    constexpr int P = NW + 1; const int tid = tid_fresh();
#pragma unroll
    for (int ps = 0; ps < 64 * NW / 4 / 512; ++ps) { const int idx = ps * 512 + tid, k = idx / (NW / 4), n4 = idx % (NW / 4);
        const f32x4 v = *(const f32x4*)(src + (size_t)(k0 + k) * ldn + n0 + 4 * n4); LAS float* q = T + k * P + 4 * n4; q[0] = v[0]; q[1] = v[1]; q[2] = v[2]; q[3] = v[3]; }
    __syncthreads();
#pragma unroll
    for (int ps = 0; ps < NW * 8 / 512; ++ps) { const int item = ps * 512 + tid, kc = item & 7, n = item >> 3; f16x8 w;
#pragma unroll
        for (int i = 0; i < 8; ++i) w[i] = (h16)T[(8 * kc + i) * P + n];
        const int ng = n0 + n; const int row = mode == 0 ? ng : (8 * (ng >> 2) + (ng & 3) + (mode == 2 ? 4 : 0));
        *(f16x8*)(dst + (size_t)row * ldk + k0 + 8 * kc) = w; }
    __syncthreads();
}
__device__ __forceinline__ void cvt_dense_unit(const Params& p, int unit, LAS float* T) {
    const float* src; h16* dst; int nt, N;
    if (unit < 1536) { src = p.hy_w_in; dst = (h16*)(p.ws + WS_WIN); nt = 24; N = D3; }
    else if (unit < 2048) { unit -= 1536; src = p.hy_w_out; dst = (h16*)(p.ws + WS_WOUT); nt = 8; N = D; }
    else if (unit < 2688) { unit -= 2048; src = p.at_w_qkv; dst = (h16*)(p.ws + WS_WQKV); nt = 10; N = DQKV; }
    else { unit -= 2688; src = p.at_w_o; dst = (h16*)(p.ws + WS_WO); nt = 8; N = D; }
    const int j = unit / (32 * nt), r = unit % (32 * nt), kt = r / nt, ntile = r % nt;
    cvt_tile<256>(src + (size_t)j * D * N, N, kt * 64, ntile * 256, dst + (size_t)j * N * D, D, 0, T);
}
constexpr int CVT_DENSE_UNITS = 3200;
__device__ __forceinline__ void cvt_moe_unit(const Params& p, int layer, int unit, LAS float* T) {
    if (unit < 12288) { const int which = unit >= 6144; if (which) unit -= 6144; const int e = unit / 96, r = unit % 96, kt = r / 3, ntile = r % 3;
        const float* src = (which ? p.moe_w3 : p.moe_w1) + ((size_t)layer * NE + e) * D * DE;
        cvt_tile<128>(src, DE, kt * 64, ntile * 128, (h16*)(p.ws + WS_W13) + (size_t)e * DE2 * D, D, which ? 2 : 1, T); }
    else { unit -= 12288; const int e = unit / 48, r = unit % 48, kt = r / 8, ntile = r % 8;
        const float* src = p.moe_w2 + ((size_t)layer * NE + e) * DE * D;
        cvt_tile<256>(src, D, kt * 64, ntile * 256, (h16*)(p.ws + WS_W2) + (size_t)e * D * DE, DE, 0, T); }
}
constexpr int CVT_MOE_UNITS = 15360;

template <int NR, bool FINAL>
__device__ __forceinline__ void n1_rows(const Params& p, int layer, int r0, int rstride, int lane) {
    float* xres = (float*)(p.ws + WS_XRES); h16* hb = (h16*)(p.ws + WS_HBUF); const h16* yc = (const h16*)(p.ws + WS_YC); const float* mods = (const float*)(p.ws + WS_MODS);
    f32x4 v[NR][8]; f16x4 ya[NR][8], yb[NR][8];
    const bool comb = FINAL || layer > 0; const int lprev = FINAL ? 3 : layer - 1;
#pragma unroll
    for (int q = 0; q < NR; ++q) { const int r = r0 + q * rstride;
        const float* src = (!FINAL && layer == 0) ? (r < TL ? p.x + (size_t)r * D : p.ctx + (size_t)(r - TL) * D) : xres + (size_t)r * D;
#pragma unroll
        for (int c = 0; c < 8; ++c) v[q][c] = *(const f32x4*)(src + c * 256 + lane * 4);
        if (comb) { const h16* y0 = yc + (size_t)(2 * r) * D; const h16* y1 = y0 + D;
#pragma unroll
            for (int c = 0; c < 8; ++c) { ya[q][c] = *(const f16x4*)(y0 + c * 256 + lane * 4); yb[q][c] = *(const f16x4*)(y1 + c * 256 + lane * 4); } } }
#pragma unroll
    for (int q = 0; q < NR; ++q) { const int r = r0 + q * rstride; const int b = batch_of_row(r);
        if (comb) { const float* g2 = mods + ((size_t)(lprev * 9 + b) * 6 + 5) * D;
#pragma unroll
            for (int c = 0; c < 8; ++c) { const f32x4 g = *(const f32x4*)(g2 + c * 256 + lane * 4);
#pragma unroll
                for (int i = 0; i < 4; ++i) v[q][c][i] += g[i] * ((float)ya[q][c][i] + (float)yb[q][c][i]); } }
        float ss = 0.f;
#pragma unroll
        for (int c = 0; c < 8; ++c) { if (!FINAL) *(f32x4*)(xres + (size_t)r * D + c * 256 + lane * 4) = v[q][c]; ss += v[q][c][0] * v[q][c][0] + v[q][c][1] * v[q][c][1] + v[q][c][2] * v[q][c][2] + v[q][c][3] * v[q][c][3]; }
        ss = wave_sum(ss); const float rs = 1.0f / sqrtf(ss * (1.0f / D) + EPS);
        if (FINAL) {
#pragma unroll
            for (int c = 0; c < 8; ++c) { const int col = c * 256 + lane * 4; const f32x4 g = *(const f32x4*)(p.final_gain + col); *(f32x4*)(p.out + (size_t)r * D + col) = v[q][c] * rs * g; }
        } else {
            const float* sh = mods + ((size_t)(layer * 9 + b) * 6 + 0) * D; const float* sc = sh + D;
#pragma unroll
            for (int c = 0; c < 8; ++c) { const int col = c * 256 + lane * 4; const f32x4 s0 = *(const f32x4*)(sh + col), s1 = *(const f32x4*)(sc + col); f16x4 w;
#pragma unroll
                for (int i = 0; i < 4; ++i) w[i] = (h16)(v[q][c][i] * rs * (1.0f + s1[i]) + s0[i]);
                *(f16x4*)(hb + (size_t)r * D + col) = w; }
        } }
}
template <bool FINAL>
__device__ __forceinline__ void n1_any(const Params& p, int layer) {
    const int tid = tid_fresh(), lane = tid & 63, gw = blockIdx.x * 8 + __builtin_amdgcn_readfirstlane(tid >> 6), nw = gridDim.x * 8; const int nrow = FINAL ? TL : TT;
    int r = gw;
    for (; r + nw < nrow; r += 2 * nw) n1_rows<2, FINAL>(p, layer, r, nw, lane);
    if (r < nrow) n1_rows<1, FINAL>(p, layer, r, nw, lane);
}
__device__ __forceinline__ void n1_phase(const Params& p, int layer) { n1_any<false>(p, layer); }
__device__ __forceinline__ void final_phase(const Params& p) { n1_any<true>(p, 0); }
constexpr int N2_CH = 4;
constexpr int N2_SLOT = N2_CH * 10 * 1024;
constexpr int N2_XT = 2 * N2_SLOT;
constexpr int N2_SC = N2_XT + 8 * 4096;
#ifndef PROBE_N2VAR
#define PROBE_N2VAR 0
#endif
__device__ __forceinline__ void n2_phase(const Params& p, int layer, LAS unsigned char* lds, int ctr_shadow) {
    const bool pv_tail = !(ctr_shadow && (PROBE_N2VAR & 1)), pv_store = !(ctr_shadow && (PROBE_N2VAR & 2)), pv_mma = !(ctr_shadow && (PROBE_N2VAR & 4));
    const int tid = tid_fresh(), lane = tid & 63, wv = __builtin_amdgcn_readfirstlane(tid >> 6), r16 = lane & 15, kg = lane >> 4;
    const int lrow = lane >> 3, lchk = lane & 7;
    const float* xres = (const float*)(p.ws + WS_XRES); h16* hb = (h16*)(p.ws + WS_HBUF); const float* mods = (const float*)(p.ws + WS_MODS);
    const char* rtb = p.ws + WS_RTAB + (size_t)layer * RTAB_L; const float* ssq = (const float*)(p.ws + WS_SSQ);
    int* counters = (int*)(p.ws + WS_CTL) + CTL_CNT + (layer + (ctr_shadow ? 4 : 0)) * NE; int* list = (int*)(p.ws + WS_LIST); float* gate = (float*)(p.ws + WS_GATE);
    LAS float* scr = (LAS float*)lds + wv * (16 * 80);
    LAS float* scl = (LAS float*)(lds + N2_SC); LAS float* shl = scl + D;
    LAS int* hist = (LAS int*)(lds + LDS_MISC); LAS int* hbase = hist + NE;
    LAS unsigned char* xt = lds + N2_XT + wv * 4096;
    const int sxw = ((lrow >> 1) & 1) | (((lrow >> 2) & 1) << 2), sxr = ((r16 >> 1) & 1) | (((r16 >> 2) & 1) << 2);
    const int xw_off = lrow * 128 + 16 * (lchk ^ sxw);
    const int xr_off0 = r16 * 128 + 16 * ((2 * kg) ^ sxr), xr_off1 = r16 * 128 + 16 * ((2 * kg + 1) ^ sxr);
    const int hw_off0 = r16 * 128 + 16 * (kg ^ (r16 & 7)), hw_off1 = r16 * 128 + 16 * ((4 + kg) ^ (r16 & 7));
    const int hr_off = lrow * 128 + 16 * (lchk ^ (lrow & 7));
    const int ntask = (layer == NLAYER - 1 ? TL : TT) / 16, nfull = (int)gridDim.x * 8;
#pragma unroll 1
    for (int round = 0; round < 2; ++round) {
        const int nrem = ntask - nfull;
        if (round == 1 && (int)blockIdx.x >= nrem) break;
        const int task = round == 0 ? (int)blockIdx.x * 8 + wv : nfull + (int)blockIdx.x;
        const bool active = round == 0 ? (task < ntask) : (wv == 0);
        const int trow = active ? task * 16 : 0;
        const int b = batch_of_row(trow);
        const float* xg0 = xres + (size_t)(trow + lrow) * D + lchk * 4; const float* xg1 = xg0 + (size_t)8 * D;
        h16* hg0 = hb + (size_t)(trow + lrow) * D + lchk * 8; h16* hg1 = hg0 + (size_t)8 * D;
        float rs;
        { const float* sp = ssq + (size_t)(trow + r16) * 32; float t = 0.f;
#pragma unroll
            for (int q = 0; q < 8; ++q) { const f32x4 v = *(const f32x4*)(sp + 4 * q); t += (v[0] + v[1]) + (v[2] + v[3]); }
            rs = 1.0f / sqrtf(t * (1.0f / D) + EPS); }
        f32x4 acc[5];
#pragma unroll
        for (int ct = 0; ct < 5; ++ct) acc[ct] = (f32x4){0.f, 0.f, 0.f, 0.f};
        __syncthreads();
        if (tid < NE) hist[tid] = 0;
        { const float* scb = mods + ((size_t)(layer * 9 + b) * 6 + 4) * D; *(LAS f32x4*)(scl + tid * 4) = *(const f32x4*)(scb + tid * 4); *(LAS f32x4*)(shl + tid * 4) = *(const f32x4*)(scb - D + tid * 4); }
        f16x8 bq[5];
#pragma unroll
        for (int q = 0; q < 5; ++q) bq[q] = *(const f16x8*)(rtb + (size_t)(5 * wv + q) * 1024 + lane * 16);
#pragma unroll
        for (int q = 0; q < 5; ++q) *(LAS f16x8*)(lds + (5 * wv + q) * 1024 + lane * 16) = bq[q];
#pragma unroll
        for (int q = 0; q < 5; ++q) bq[q] = *(const f16x8*)(rtb + (size_t)N2_SLOT + (size_t)(5 * wv + q) * 1024 + lane * 16);
        f32x4 x0[N2_CH][2], x1[N2_CH][2], x2[N2_CH][2];
#pragma unroll
        for (int s2 = 0; s2 < N2_CH; ++s2) { x0[s2][0] = *(const f32x4*)(xg0 + 32 * s2); x0[s2][1] = *(const f32x4*)(xg1 + 32 * s2);
            x1[s2][0] = *(const f32x4*)(xg0 + 32 * (N2_CH + s2)); x1[s2][1] = *(const f32x4*)(xg1 + 32 * (N2_CH + s2)); }
#define N2_CHUNK(XC, XL, CH) do { const int ch = (CH); \
            __syncthreads(); \
            const int nx2 = (ch + 2 < 64 / N2_CH) ? ch + 2 : ch; \
            {   LAS unsigned char* dst = lds + ((ch + 1) & 1) * N2_SLOT; \
 _Pragma("unroll") \
                for (int q = 0; q < 5; ++q) *(LAS f16x8*)(dst + (5 * wv + q) * 1024 + lane * 16) = bq[q]; } \
            {   const char* src = rtb + (size_t)nx2 * N2_SLOT; \
 _Pragma("unroll") \
                for (int q = 0; q < 5; ++q) bq[q] = *(const f16x8*)(src + (size_t)(5 * wv + q) * 1024 + lane * 16); } \
 _Pragma("unroll") \
            for (int s2 = 0; s2 < N2_CH; ++s2) { const int ko = 32 * (nx2 * N2_CH + s2); XL[s2][0] = *(const f32x4*)(xg0 + ko); XL[s2][1] = *(const f32x4*)(xg1 + ko); } \
            const LAS unsigned char* bs = lds + (ch & 1) * N2_SLOT + lane * 16; \
 _Pragma("unroll") \
            for (int pp = 0; pp < N2_CH / 2; ++pp) { \
 _Pragma("unroll") \
                for (int sp = 0; sp < 2; ++sp) { *(LAS f32x4*)(xt + sp * 2048 + xw_off) = XC[2 * pp + sp][0]; *(LAS f32x4*)(xt + sp * 2048 + 1024 + xw_off) = XC[2 * pp + sp][1]; } \
                f32x4 xf[2][2]; \
 _Pragma("unroll") \
                for (int sp = 0; sp < 2; ++sp) { xf[sp][0] = *(const LAS f32x4*)(xt + sp * 2048 + xr_off0); xf[sp][1] = *(const LAS f32x4*)(xt + sp * 2048 + xr_off1); } \
                f16x8 hk[2]; \
 _Pragma("unroll") \
                for (int sp = 0; sp < 2; ++sp) { \
                    const int s2 = 2 * pp + sp; const int ko = 32 * (ch * N2_CH + s2) + 8 * kg; \
                    const f32x4 c0 = *(const LAS f32x4*)(scl + ko), c1 = *(const LAS f32x4*)(scl + ko + 4), h0 = *(const LAS f32x4*)(shl + ko), h1 = *(const LAS f32x4*)(shl + ko + 4); \
                    f16x8 hi, lo; \
 _Pragma("unroll") \
                    for (int i = 0; i < 4; ++i) { const float a0 = xf[sp][0][i] * rs * (1.0f + c0[i]) + h0[i], a1 = xf[sp][1][i] * rs * (1.0f + c1[i]) + h1[i]; \
                        hi[i] = (h16)a0; lo[i] = (h16)(a0 - (float)hi[i]); hi[4 + i] = (h16)a1; lo[4 + i] = (h16)(a1 - (float)hi[4 + i]); } \
                    hk[sp] = hi; \
                    if (pv_mma) \
 _Pragma("unroll") \
                    for (int ct = 0; ct < 5; ++ct) { const f16x8 whi = *(const LAS f16x8*)(bs + (s2 * 10 + ct * 2 + 0) * 1024), wlo = *(const LAS f16x8*)(bs + (s2 * 10 + ct * 2 + 1) * 1024); \
                        acc[ct] = __builtin_amdgcn_mfma_f32_16x16x32_f16(hi, whi, acc[ct], 0, 0, 0); \
                        acc[ct] = __builtin_amdgcn_mfma_f32_16x16x32_f16(hi, wlo, acc[ct], 0, 0, 0); \
                        acc[ct] = __builtin_amdgcn_mfma_f32_16x16x32_f16(lo, whi, acc[ct], 0, 0, 0); } \
                } \
                *(LAS f16x8*)(xt + hw_off0) = hk[0]; *(LAS f16x8*)(xt + hw_off1) = hk[1]; \
                const f16x8 o0 = *(const LAS f16x8*)(xt + hr_off), o1 = *(const LAS f16x8*)(xt + 1024 + hr_off); \
                if (active && pv_store) { const int ho = 32 * (ch * N2_CH + 2 * pp); *(f16x8*)(hg0 + ho) = o0; *(f16x8*)(hg1 + ho) = o1; } \
            } \
        } while (0)
#pragma unroll 1
        for (int c3 = 0; c3 < 15; c3 += 3) { N2_CHUNK(x0, x2, c3); N2_CHUNK(x1, x0, c3 + 1); N2_CHUNK(x2, x1, c3 + 2); }
        N2_CHUNK(x0, x2, 15);
#undef N2_CHUNK
        __syncthreads();
#pragma unroll
        for (int ct = 0; ct < 5; ++ct)
#pragma unroll
            for (int i = 0; i < 4; ++i) scr[(4 * kg + i) * 80 + 16 * ct + r16] = acc[ct][i] * (1.0f / 256.0f);
        asm volatile("s_waitcnt lgkmcnt(0)" ::: "memory");
        int ea = 0, eb = 0, ra = 0, rb = 0; float g1v = 0.f, g2v = 0.f; const bool tok_lane = active && lane < 16 && pv_tail;
        if (tok_lane) {
            const LAS float* lgr = scr + lane * 80;
            float gmax = -3.0e38f; int gsel = 0; float gl[8];
#pragma unroll
            for (int g = 0; g < 8; ++g) { gl[g] = lgr[g] + p.moe_bg[layer * 8 + g]; if (gl[g] > gmax) { gmax = gl[g]; gsel = g; } }
            float gz = 0.f;
#pragma unroll
            for (int g = 0; g < 8; ++g) gz += expf(gl[g] - gmax);
            const float pg = 1.0f / gz;
            float f1 = -3.0e38f, f2 = -3.0e38f; int i1 = 0, i2 = 0;
            for (int q = 0; q < 8; ++q) { const float f = lgr[8 + gsel * 8 + q] + p.moe_be[layer * 64 + gsel * 8 + q];
                if (f > f1) { f2 = f1; i2 = i1; f1 = f; i1 = q; } else if (f > f2) { f2 = f; i2 = q; } }
            const float e2 = expf(f2 - f1); g1v = pg / (1.0f + e2); g2v = pg * e2 / (1.0f + e2);
            ea = gsel * 8 + i1; eb = gsel * 8 + i2;
            ra = __hip_atomic_fetch_add(hist + ea, 1, __ATOMIC_RELAXED, __HIP_MEMORY_SCOPE_WORKGROUP); rb = __hip_atomic_fetch_add(hist + eb, 1, __ATOMIC_RELAXED, __HIP_MEMORY_SCOPE_WORKGROUP);
        }
        __syncthreads();
        if (tid < NE && pv_tail) { const int n = hist[tid]; hbase[tid] = n ? atomicAdd(&counters[tid], n) : 0; }
        __syncthreads();
        if (tok_lane) { const int tok = task * 16 + lane; const size_t sa = (size_t)ea * LCAP + hbase[ea] + ra, sb = (size_t)eb * LCAP + hbase[eb] + rb;
            list[sa] = 2 * tok; gate[sa] = g1v; list[sb] = 2 * tok + 1; gate[sb] = g2v; }
    }
}
__device__ __forceinline__ void transpose_phase(const Params& p, LAS h16* T) {
    const h16* zt = (const h16*)(p.ws + WS_ZT); h16* z = (h16*)(p.ws + WS_HBUF); const int tid = tid_fresh();
    const int ntile = (D / 64) * (TT / 64);
    for (int tile = blockIdx.x; tile < ntile; tile += gridDim.x) {
        const int td = tile % (D / 64), tt = tile / (D / 64); const int d0 = td * 64, t0 = tt * 64;
        { const int dr = tid >> 3, tc = (tid & 7) * 8; const f16x8 v = *(const f16x8*)(zt + (size_t)(d0 + dr) * TT + t0 + tc);
#pragma unroll
            for (int i = 0; i < 8; ++i) T[(tc + i) * 66 + dr] = v[i]; }
        __syncthreads();
        { const int tr = tid >> 3, dc = (tid & 7) * 8; f16x8 v;
#pragma unroll
            for (int i = 0; i < 8; ++i) v[i] = T[tr * 66 + dc + i];
            *(f16x8*)(z + (size_t)(t0 + tr) * D + d0 + dc) = v; }
        __syncthreads();
    }
}

__device__ __forceinline__ f32x2 cmul(const f32x2 a, const f32x2 b) { return (f32x2){a.x * b.x - a.y * b.y, a.x * b.y + a.y * b.x}; }
__device__ __forceinline__ f32x2 cmulc(const f32x2 a, const f32x2 b) { return (f32x2){a.x * b.x + a.y * b.y, a.y * b.x - a.x * b.y}; }
__device__ __forceinline__ f32x2 cconj(const f32x2 a) { return (f32x2){a.x, -a.y}; }
template <bool INV> __device__ __forceinline__ f32x2 mul_mi(const f32x2 a) { return INV ? (f32x2){-a.y, a.x} : (f32x2){a.y, -a.x}; }
template <bool INV> __device__ __forceinline__ void dft4(f32x2& a, f32x2& b, f32x2& c, f32x2& d) {
    const f32x2 s0 = a + c, s1 = a - c, s2 = b + d, s3 = mul_mi<INV>(b - d);
    a = s0 + s2; b = s1 + s3; c = s0 - s2; d = s1 - s3;
}
template <bool INV, int M> __device__ __forceinline__ f32x2 w16mul(const f32x2 a) {
    constexpr float C1 = 0.92387953251128674f, S1 = 0.38268343236508977f, R = 0.70710678118654752f;
    constexpr float cr = (M == 0) ? 1.f : (M == 1) ? C1 : (M == 2) ? R : (M == 3) ? S1 : (M == 4) ? 0.f : (M == 6) ? -R :   -C1;
    constexpr float ci0 = (M == 0) ? 0.f : (M == 1) ? -S1 : (M == 2) ? -R : (M == 3) ? -C1 : (M == 4) ? -1.f : (M == 6) ? -R :   S1;
    constexpr float ci = INV ? -ci0 : ci0;
    return (f32x2){a.x * cr - a.y * ci, a.x * ci + a.y * cr};
}
template <bool INV> __device__ __forceinline__ void dft16(f32x2 (&v)[16]) {
#pragma unroll
    for (int n2 = 0; n2 < 4; ++n2) dft4<INV>(v[n2], v[4 + n2], v[8 + n2], v[12 + n2]);
    v[5] = w16mul<INV, 1>(v[5]); v[6] = w16mul<INV, 2>(v[6]); v[7] = w16mul<INV, 3>(v[7]);
    v[9] = w16mul<INV, 2>(v[9]); v[10] = w16mul<INV, 4>(v[10]); v[11] = w16mul<INV, 6>(v[11]);
    v[13] = w16mul<INV, 3>(v[13]); v[14] = w16mul<INV, 6>(v[14]); v[15] = w16mul<INV, 9>(v[15]);
#pragma unroll
    for (int k1 = 0; k1 < 4; ++k1) dft4<INV>(v[4 * k1], v[4 * k1 + 1], v[4 * k1 + 2], v[4 * k1 + 3]);
    f32x2 t;
    t = v[1]; v[1] = v[4]; v[4] = t; t = v[2]; v[2] = v[8]; v[8] = t; t = v[3]; v[3] = v[12]; v[12] = t;
    t = v[6]; v[6] = v[9]; v[9] = t; t = v[7]; v[7] = v[13]; v[13] = t; t = v[11]; v[11] = v[14]; v[14] = t;
}
__device__ __forceinline__ int fphys(int i) { return i + (i >> 4); }
__device__ __forceinline__ f32x2 w32c(int j) {
    constexpr float c[16] = {1.f, 0.98078528040323043f, 0.92387953251128674f, 0.83146961230254524f, 0.70710678118654752f, 0.55557023301960218f, 0.38268343236508977f, 0.19509032201612825f,
                             0.f, -0.19509032201612825f, -0.38268343236508977f, -0.55557023301960218f, -0.70710678118654752f, -0.83146961230254524f, -0.92387953251128674f, -0.98078528040323043f};
    constexpr float s[16] = {0.f, 0.19509032201612825f, 0.38268343236508977f, 0.55557023301960218f, 0.70710678118654752f, 0.83146961230254524f, 0.92387953251128674f, 0.98078528040323043f,
                             1.f, 0.98078528040323043f, 0.92387953251128674f, 0.83146961230254524f, 0.70710678118654752f, 0.55557023301960218f, 0.38268343236508977f, 0.19509032201612825f};
    return (f32x2){c[j], -s[j]};
}
template <int S>
__device__ __forceinline__ void fft_fwd0(const f32x2 (&xe)[16], const f32x2 (&xo)[16], LAS f32x2* E, LAS f32x2* O, int t, const f32x2* tw) {
    const f32x2 u = tw[t * (256 / S)]; const f32x2 u2 = cmul(u, u);
    f32x2 y[16];
#pragma unroll
    for (int j = 0; j < 16; ++j) y[j] = xe[j];
    dft16<false>(y);
    constexpr int QS = S + S / 16;
    LAS f32x2* Eb = E + fphys(t); LAS f32x2* Ob = O + fphys(t);
    f32x2 pw = u2; Eb[0] = y[0];
#pragma unroll
    for (int q = 1; q < 16; ++q) { Eb[QS * q] = cmul(y[q], pw); pw = cmul(pw, u2); }
#pragma unroll
    for (int j = 0; j < 16; ++j) y[j] = cmul(xo[j], w32c(j));
    dft16<false>(y);
    pw = u;
#pragma unroll
    for (int q = 0; q < 16; ++q) { Ob[QS * q] = cmul(y[q], pw); pw = cmul(pw, u2); }
}
template <bool INV> __device__ __forceinline__ void fft_pass1(LAS f32x2* A, int tau, const f32x2* tw) {
    const int i = tau & 15, base = (tau >> 4) << 8; const f32x2 u0 = tw[32 * i]; const f32x2 u = INV ? cconj(u0) : u0;
    f32x2 y[16]; LAS f32x2* Ab = A + fphys(base + i);
#pragma unroll
    for (int j = 0; j < 16; ++j) y[j] = Ab[17 * j];
    if (INV) { f32x2 pw = u;
#pragma unroll
        for (int q = 1; q < 16; ++q) { y[q] = cmul(y[q], pw); pw = cmul(pw, u); } }
    dft16<INV>(y);
    if (!INV) { f32x2 pw = u;
#pragma unroll
        for (int q = 1; q < 16; ++q) { y[q] = cmul(y[q], pw); pw = cmul(pw, u); } }
#pragma unroll
    for (int j = 0; j < 16; ++j) Ab[17 * j] = y[j];
}
template <bool INV> __device__ __forceinline__ void fft_pass1_pair(LAS f32x2* A, LAS f32x2* B, int tau, const f32x2* tw) {
    const int i = tau & 15, base = (tau >> 4) << 8; const f32x2 u0 = tw[32 * i]; const f32x2 u = INV ? cconj(u0) : u0;
    f32x2 y[16], z[16]; LAS f32x2* Ab = A + fphys(base + i); LAS f32x2* Bb = B + fphys(base + i);
#pragma unroll
    for (int j = 0; j < 16; ++j) y[j] = Ab[17 * j];
#pragma unroll
    for (int j = 0; j < 16; ++j) z[j] = Bb[17 * j];
    f32x2 pwr[16]; pwr[1] = u;
#pragma unroll
    for (int q = 2; q < 16; ++q) pwr[q] = cmul(pwr[q - 1], u);
    if (INV) {
#pragma unroll
        for (int q = 1; q < 16; ++q) y[q] = cmul(y[q], pwr[q]); }
    dft16<INV>(y);
    if (!INV) {
#pragma unroll
        for (int q = 1; q < 16; ++q) y[q] = cmul(y[q], pwr[q]); }
#pragma unroll
    for (int j = 0; j < 16; ++j) Ab[17 * j] = y[j];
    if (INV) {
#pragma unroll
        for (int q = 1; q < 16; ++q) z[q] = cmul(z[q], pwr[q]); }
    dft16<INV>(z);
    if (!INV) {
#pragma unroll
        for (int q = 1; q < 16; ++q) z[q] = cmul(z[q], pwr[q]); }
#pragma unroll
    for (int j = 0; j < 16; ++j) Bb[17 * j] = z[j];
}
__device__ __forceinline__ void fft_fwd2(const LAS f32x2* A, int t, f32x2 (&y)[16]) {
#pragma unroll
    for (int j = 0; j < 16; ++j) y[j] = A[17 * t + j];
    dft16<false>(y);
}
__device__ __forceinline__ void kf_load(const f32x2* kf, f32x4 (&k)[8]) {
#pragma unroll
    for (int j = 0; j < 8; ++j) k[j] = *(const f32x4*)(kf + 2 * j);
}
__device__ __forceinline__ void fft_mid(LAS f32x2* A, int t, const f32x4 (&k)[8]) {
    f32x2 y[16];
    fft_fwd2(A, t, y);
#pragma unroll
    for (int j = 0; j < 8; ++j) { y[2 * j] = cmul(y[2 * j], (f32x2){k[j][0], k[j][1]}); y[2 * j + 1] = cmul(y[2 * j + 1], (f32x2){k[j][2], k[j][3]}); }
    dft16<true>(y);
#pragma unroll
    for (int j = 0; j < 16; ++j) A[17 * t + j] = y[j];
}
template <int S>
__device__ __forceinline__ void fft_inv0(const LAS f32x2* E, const LAS f32x2* O, int t, const f32x2* tw, f32x2 (&out)[16]) {
    const f32x2 u = tw[t * (256 / S)]; const f32x2 u2 = cmul(u, u);
    f32x2 y[16];
    constexpr int QS = S + S / 16;
    const LAS f32x2* Eb = E + fphys(t); const LAS f32x2* Ob = O + fphys(t);
    f32x2 pw = u2; y[0] = Eb[0];
#pragma unroll
    for (int q = 1; q < 16; ++q) { y[q] = cmulc(Eb[QS * q], pw); pw = cmul(pw, u2); }
    dft16<true>(y);
#pragma unroll
    for (int j = 0; j < 16; ++j) out[j] = y[j];
    pw = u;
#pragma unroll
    for (int q = 0; q < 16; ++q) { y[q] = cmulc(Ob[QS * q], pw); pw = cmul(pw, u2); }
    dft16<true>(y);
#pragma unroll
    for (int j = 0; j < 16; ++j) out[j] += cmulc(y[j], w32c(j));
}
__device__ __forceinline__ float hy_absdelta(int d) { return fabsf(-3.0701134573253943f + (-15.350567286626973f + 3.0701134573253943f) * ((float)d / 2047.0f)); }

__device__ __forceinline__ void filt_fft_phase(const Params& p, LAS unsigned char* lds) {
    const int tid = tid_fresh();
    const f32x2* tw = (const f32x2*)(p.ws + WS_TW);
    {
        const int grp = tid >> 8, tau = tid & 255;
        LAS f32x2* E = (LAS f32x2*)(lds + grp * 69632); LAS f32x2* O = E + 4352; LAS float* red = (LAS float*)(lds + LDS_MISC) + grp * 8;
        for (int pb = blockIdx.x * 2 + grp; pb < 2 * 2 * 2048; pb += gridDim.x * 2) {
            const int d = pb & 2047, n = (pb >> 11) & 1, j = pb >> 12;
            const float* tf = (const float*)(p.ws + WS_TAPS) + ((size_t)j * 8192 + (size_t)(n * 2 + 0) * D + d) * 4096;
            const float* tb = tf + (size_t)D * 4096;
            const float adel = hy_absdelta(d); const float tscale = 1.0f / 4095.0f;
            f32x2 xe[16], xo[16]; float ss = 0.f;
#pragma unroll
            for (int jj = 0; jj < 16; ++jj) { const int nn = tau + 256 * jj;
                const float klo = tf[nn] * expf(-(float)nn * tscale * adel);
                const int m = 4096 - nn;
                const float khi = (m < 4096) ? tb[m & 4095] * expf(-(float)m * tscale * adel) : 0.f;
                ss += klo * klo + khi * khi; xe[jj] = (f32x2){klo + khi, 0.f}; xo[jj] = (f32x2){klo - khi, 0.f}; }
            ss = wave_sum(ss);
            if ((tid & 63) == 0) red[(tid >> 6) & 3] = ss;
            fft_fwd0<256>(xe, xo, E, O, tau, tw);
            __syncthreads();
            const float tot = red[0] + red[1] + red[2] + red[3];
            const float scale = (1.0f / sqrtf(tot + EPS)) * (1.0f / 8192.0f);
            const float hbs = p.hy_bias[((size_t)j * 2 + n) * D + d] * (1.0f / 8192.0f);
            fft_pass1<false>(E, tau, tw); fft_pass1<false>(O, tau, tw);
            __syncthreads();
            f32x2* kf = (f32x2*)(p.ws + WS_KF) + (size_t)pb * 8192 + (size_t)tau * 16;
            f32x2 y[16];
            fft_fwd2(E, tau, y);
#pragma unroll
            for (int q = 0; q < 8; ++q) *(f32x4*)(kf + 2 * q) = (f32x4){y[2 * q].x * scale + hbs, y[2 * q].y * scale, y[2 * q + 1].x * scale + hbs, y[2 * q + 1].y * scale};
            fft_fwd2(O, tau, y);
#pragma unroll
            for (int q = 0; q < 8; ++q) *(f32x4*)(kf + 4096 + 2 * q) = (f32x4){y[2 * q].x * scale + hbs, y[2 * q].y * scale, y[2 * q + 1].x * scale + hbs, y[2 * q + 1].y * scale};
            __syncthreads();
        }
    }
    {
        const int pr = tid >> 4, i = tid & 15;
        LAS f32x2* E = (LAS f32x2*)(lds + pr * 4352); LAS f32x2* O = E + 272;
        for (int it = blockIdx.x; it < 256; it += gridDim.x) {
            const int pb = it * 32 + pr; const int d = pb & 2047, n = (pb >> 11) & 1, j = pb >> 12;
            const float* tf = (const float*)(p.ws + WS_TAPSC) + ((size_t)j * 8192 + (size_t)(n * 2 + 0) * D + d) * 256;
            const float* tb = tf + (size_t)D * 256;
            const float adel = hy_absdelta(d); const float tscale = 1.0f / 255.0f;
            f32x2 xe[16], xo[16]; float ss = 0.f;
#pragma unroll
            for (int jj = 0; jj < 16; ++jj) { const int nn = i + 16 * jj;
                const float klo = tf[nn] * expf(-(float)nn * tscale * adel);
                const int m = 256 - nn;
                const float khi = (m < 256) ? tb[m & 255] * expf(-(float)m * tscale * adel) : 0.f;
                ss += klo * klo + khi * khi; xe[jj] = (f32x2){klo + khi, 0.f}; xo[jj] = (f32x2){klo - khi, 0.f}; }
            ss += shx(ss, 8); ss += shx(ss, 4); ss += shx(ss, 2); ss += shx(ss, 1);
            const float scale = (1.0f / sqrtf(ss + EPS)) * (1.0f / 512.0f);
            const float hbs = p.hy_bias[((size_t)j * 2 + n) * D + d] * (1.0f / 512.0f);
            fft_fwd0<16>(xe, xo, E, O, i, tw);
            __syncthreads();
            f32x2* kf = (f32x2*)(p.ws + WS_KFC) + (size_t)pb * 512 + (size_t)i * 16;
            f32x2 y[16];
            fft_fwd2(E, i, y);
#pragma unroll
            for (int q = 0; q < 8; ++q) *(f32x4*)(kf + 2 * q) = (f32x4){y[2 * q].x * scale + hbs, y[2 * q].y * scale, y[2 * q + 1].x * scale + hbs, y[2 * q + 1].y * scale};
            fft_fwd2(O, i, y);
#pragma unroll
            for (int q = 0; q < 8; ++q) *(f32x4*)(kf + 256 + 2 * q) = (f32x4){y[2 * q].x * scale + hbs, y[2 * q].y * scale, y[2 * q + 1].x * scale + hbs, y[2 * q + 1].y * scale};
            __syncthreads();
        }
    }
}

__device__ __forceinline__ float conv3_lds(const LAS h16* row, int n, float w0, float w1, float w2, float b) { return (float)row[n - 1] * w0 + (float)row[n] * w1 + (float)row[n + 1] * w2 + b; }
constexpr int ST_P = 4112, STS_P = 272;

#ifndef PROBE_CVAR
#define PROBE_CVAR 0
#endif
__device__ __forceinline__ void conv_phase(const Params& p, int jl, LAS unsigned char* lds, int pvar = 0, int cvt_layer = -1, int cvt_n = 0) {
    const int tid = tid_fresh(); const bool cv_outer = !(pvar && (PROBE_CVAR & 1)), cv_inner = !(pvar && (PROBE_CVAR & 2));
    const f32x2* tw = (const f32x2*)(p.ws + WS_TW);
    const h16* ut = (const h16*)(p.ws + WS_UT); h16* zt = (h16*)(p.ws + WS_ZT);
    const float* cw = p.hy_conv_w + (size_t)jl * 3 * D3; const float* cb = p.hy_conv_b + (size_t)jl * D3;
    {
        const int grp = tid >> 8, tau = tid & 255;
        LAS f32x2* E = (LAS f32x2*)(lds + grp * 69632); LAS f32x2* O = E + 4352; LAS h16* ST = (LAS h16*)E;
        int uit = 0; const int utrig = 4 * (((int)blockIdx.x >> 3) & 3);
        for (int unit = blockIdx.x; unit < 4096; unit += gridDim.x, ++uit) {
            if (cvt_layer >= 0 && uit == utrig) { __syncthreads(); for (int u = blockIdx.x; u < cvt_n; u += gridDim.x) cvt_moe_unit(p, cvt_layer, u, (LAS float*)lds); }
            const int ux = unit & 7, uj = unit >> 3; const int hq = uj & 1, d = (uj >> 1) * 8 + ux; const size_t col0 = (size_t)(4 * hq + 2 * grp) * 4096;
            const f32x2* kfb = (const f32x2*)(p.ws + WS_KF) + ((size_t)(jl * 2) * 2048 + d) * 8192 + (size_t)tau * 16;
            f16x8 raw[2][2][2], raw2[2][2];
#pragma unroll
            for (int sq = 0; sq < 2; ++sq)
#pragma unroll
                for (int bb = 0; bb < 2; ++bb)
#pragma unroll
                    for (int k = 0; k < 2; ++k) raw[sq][bb][k] = *(const f16x8*)(ut + (size_t)(sq * D + d) * TT + col0 + (size_t)bb * 4096 + (size_t)(tau + 256 * k) * 8);
            __syncthreads();
#pragma unroll
            for (int sq = 0; sq < 2; ++sq)
#pragma unroll
                for (int bb = 0; bb < 2; ++bb)
#pragma unroll
                    for (int k = 0; k < 2; ++k) *(LAS f16x8*)(ST + (sq * 2 + bb) * ST_P + 8 + (tau + 256 * k) * 8) = raw[sq][bb][k];
            if (tau < 4) { ST[tau * ST_P + 7] = (h16)0.f; ST[tau * ST_P + 8 + 4096] = (h16)0.f; }
            __syncthreads();
            f32x2 xin[16], gk[16], y[16];
            { const float w0 = cw[d], w1 = cw[D3 + d], w2 = cw[2 * D3 + d], bv = cb[d]; const float g0 = cw[D + d], g1 = cw[D3 + D + d], g2 = cw[2 * D3 + D + d], gb = cb[D + d];
#pragma unroll
                for (int jj = 0; jj < 16; ++jj) { const int nn = tau + 256 * jj;
                    xin[jj] = (f32x2){conv3_lds(ST + 8, nn, w0, w1, w2, bv), conv3_lds(ST + ST_P + 8, nn, w0, w1, w2, bv)};
                    gk[jj] = (f32x2){conv3_lds(ST + 2 * ST_P + 8, nn, g0, g1, g2, gb), conv3_lds(ST + 3 * ST_P + 8, nn, g0, g1, g2, gb)}; } }
            __syncthreads();
#pragma unroll 1
            for (int ord = 0; ord < 2; ++ord) {
                if (cv_outer) fft_fwd0<256>(xin, xin, E, O, tau, tw);
                const f32x2* kf = kfb + (size_t)ord * 2048 * 8192; f32x4 kfe[8], kfo[8];
                kf_load(kf, kfe);
                __syncthreads();
                if (cv_inner) fft_pass1_pair<false>(E, O, tau, tw);
                kf_load(kf + 4096, kfo);
                __syncthreads();
                if (cv_inner) { fft_mid(E, tau, kfe); fft_mid(O, tau, kfo); }
                if (ord == 0) {
#pragma unroll
                    for (int bb = 0; bb < 2; ++bb)
#pragma unroll
                        for (int k = 0; k < 2; ++k) raw2[bb][k] = *(const f16x8*)(ut + (size_t)(2 * D + d) * TT + col0 + (size_t)bb * 4096 + (size_t)(tau + 256 * k) * 8); }
                __syncthreads();
                if (cv_inner) fft_pass1_pair<true>(E, O, tau, tw);
                __syncthreads();
                if (cv_outer) fft_inv0<256>(E, O, tau, tw, y); else {
#pragma unroll
                    for (int jj = 0; jj < 16; ++jj) y[jj] = xin[jj]; }
#pragma unroll
                for (int jj = 0; jj < 16; ++jj) xin[jj] = gk[jj] * y[jj];
                if (ord == 0) {
                    __syncthreads();
#pragma unroll
                    for (int bb = 0; bb < 2; ++bb)
#pragma unroll
                        for (int k = 0; k < 2; ++k) *(LAS f16x8*)(ST + bb * ST_P + 8 + (tau + 256 * k) * 8) = raw2[bb][k];
                    if (tau < 2) { ST[tau * ST_P + 7] = (h16)0.f; ST[tau * ST_P + 8 + 4096] = (h16)0.f; }
                    __syncthreads();
                    const float g0 = cw[2 * D + d], g1 = cw[D3 + 2 * D + d], g2 = cw[2 * D3 + 2 * D + d], gb = cb[2 * D + d];
#pragma unroll
                    for (int jj = 0; jj < 16; ++jj) { const int nn = tau + 256 * jj; gk[jj] = (f32x2){conv3_lds(ST + 8, nn, g0, g1, g2, gb), conv3_lds(ST + ST_P + 8, nn, g0, g1, g2, gb)}; }
                    __syncthreads();
                }
            }
            h16* o0 = zt + (size_t)d * TT + col0; h16* o1 = o0 + 4096;
#pragma unroll
            for (int jj = 0; jj < 16; ++jj) { const int nn = tau + 256 * jj; o0[nn] = (h16)xin[jj].x; o1[nn] = (h16)xin[jj].y; }
        }
    }
    {
        const int pr = tid >> 4, i = tid & 15, c8 = pr >> 2, bp = pr & 3;
        LAS f32x2* E = (LAS f32x2*)(lds + pr * 4352); LAS f32x2* O = E + 272; LAS h16* ST = (LAS h16*)lds;
        for (int unit = blockIdx.x; unit < 256; unit += gridDim.x) {
            const int d0 = unit * 8, d = d0 + c8;
            const f32x2* kfb = (const f32x2*)(p.ws + WS_KFC) + ((size_t)(jl * 2) * 2048 + d) * 512 + (size_t)i * 16;
            f16x8 raw[3][4];
#pragma unroll
            for (int sq = 0; sq < 3; ++sq)
#pragma unroll
                for (int k = 0; k < 4; ++k) { const int q = tid + 512 * k, row = q >> 5, ch = q & 31;
                    raw[sq][k] = *(const f16x8*)(ut + (size_t)(sq * D + d0 + (row >> 3)) * TT + TL + (row & 7) * 256 + ch * 8); }
            __syncthreads();
#pragma unroll
            for (int sq = 0; sq < 2; ++sq)
#pragma unroll
                for (int k = 0; k < 4; ++k) { const int q = tid + 512 * k, row = q >> 5, ch = q & 31; *(LAS f16x8*)(ST + (sq * 64 + row) * STS_P + 8 + ch * 8) = raw[sq][k]; }
            if (tid < 128) { ST[tid * STS_P + 7] = (h16)0.f; ST[tid * STS_P + 8 + 256] = (h16)0.f; }
            __syncthreads();
            f32x2 xin[16], gk[16], y[16];
            { const float w0 = cw[d], w1 = cw[D3 + d], w2 = cw[2 * D3 + d], bv = cb[d]; const float g0 = cw[D + d], g1 = cw[D3 + D + d], g2 = cw[2 * D3 + D + d], gb = cb[D + d];
                const LAS h16* r0 = ST + (c8 * 8 + 2 * bp) * STS_P + 8; const LAS h16* r1 = r0 + 64 * STS_P;
#pragma unroll
                for (int jj = 0; jj < 16; ++jj) { const int nn = i + 16 * jj;
                    xin[jj] = (f32x2){conv3_lds(r0, nn, w0, w1, w2, bv), conv3_lds(r0 + STS_P, nn, w0, w1, w2, bv)};
                    gk[jj] = (f32x2){conv3_lds(r1, nn, g0, g1, g2, gb), conv3_lds(r1 + STS_P, nn, g0, g1, g2, gb)}; } }
            __syncthreads();
#pragma unroll 1
            for (int ord = 0; ord < 2; ++ord) {
                const f32x2* kf = kfb + (size_t)ord * 2048 * 512; f32x4 kfe[8], kfo[8];
                fft_fwd0<16>(xin, xin, E, O, i, tw);
                __syncthreads();
                kf_load(kf, kfe); fft_mid(E, i, kfe); kf_load(kf + 256, kfo); fft_mid(O, i, kfo);
                __syncthreads();
                fft_inv0<16>(E, O, i, tw, y);
#pragma unroll
                for (int jj = 0; jj < 16; ++jj) xin[jj] = gk[jj] * y[jj];
                if (ord == 0) {
                    __syncthreads();
#pragma unroll
                    for (int k = 0; k < 4; ++k) { const int q = tid + 512 * k, row = q >> 5, ch = q & 31; *(LAS f16x8*)(ST + row * STS_P + 8 + ch * 8) = raw[2][k]; }
                    if (tid < 64) { ST[tid * STS_P + 7] = (h16)0.f; ST[tid * STS_P + 8 + 256] = (h16)0.f; }
                    __syncthreads();
                    const float g0 = cw[2 * D + d], g1 = cw[D3 + 2 * D + d], g2 = cw[2 * D3 + 2 * D + d], gb = cb[2 * D + d];
                    const LAS h16* r0 = ST + (c8 * 8 + 2 * bp) * STS_P + 8;
#pragma unroll
                    for (int jj = 0; jj < 16; ++jj) { const int nn = i + 16 * jj; gk[jj] = (f32x2){conv3_lds(r0, nn, g0, g1, g2, gb), conv3_lds(r0 + STS_P, nn, g0, g1, g2, gb)}; }
                    __syncthreads();
                }
            }
            h16* o0 = zt + (size_t)d * TT + TL + (2 * bp) * 256; h16* o1 = o0 + 256;
#pragma unroll
            for (int jj = 0; jj < 16; ++jj) { const int nn = i + 16 * jj; o0[nn] = (h16)xin[jj].x; o1[nn] = (h16)xin[jj].y; }
        }
    }
}

constexpr int AT_KP = 72, AT_VP = 68;
__device__ __forceinline__ void attn_phase(const Params& p, int jl, bool with_ctx_out, LAS unsigned char* lds, int cvt_layer = -1, int cvt_n = 0) {
    const int tid = tid_fresh(), wv = tid >> 6, lane = tid & 63, r32 = lane & 31, hh = lane >> 5;
    LAS h16* Ks = (LAS h16*)lds; LAS h16* Vs = (LAS h16*)(lds + 64 * AT_KP * 2);
    const h16* qk = (const h16*)(p.ws + WS_QK); const h16* vt = (const h16*)(p.ws + WS_VT); h16* ob = (h16*)(p.ws + WS_HBUF);
    const float* rcos = (const float*)(p.ws + WS_ROPE); const float* rsin = rcos + 1024;
    const int nunit = 2048 + (with_ctx_out ? 128 : 0);
    int uit = 0; const int utrig = 2 * (((int)blockIdx.x >> 3) & 3);
    for (int unit = blockIdx.x; unit < nunit; unit += gridDim.x, ++uit) {
        if (cvt_layer >= 0 && uit == utrig) { __syncthreads(); for (int u = blockIdx.x; u < cvt_n; u += gridDim.x) cvt_moe_unit(p, cvt_layer, u, (LAS float*)lds); }
        int kind, b, g, qb;
        if (unit < 2048) { kind = 0; qb = unit & 63; g = (unit >> 6) & 3; b = unit >> 8; } else { const int u2 = unit - 2048; kind = 1; qb = u2 & 3; g = (u2 >> 2) & 3; b = u2 >> 4; }
        const int head = g * 8 + wv;
        const int qrow0 = kind ? (TL + b * 256 + qb * 64) : (b * 4096 + qb * 64);
        const int ctxrow0 = TL + b * 256;
        f16x8 qf[2][4];
#pragma unroll
        for (int qt = 0; qt < 2; ++qt) {
            f32x4 qv[4][2];
            const h16* qp = qk + (size_t)(qrow0 + 32 * qt + r32) * DQK + head * 64 + 8 * hh;
#pragma unroll
            for (int ks = 0; ks < 4; ++ks) { const f16x8 t = *(const f16x8*)(qp + 16 * ks);
#pragma unroll
                for (int i = 0; i < 4; ++i) { qv[ks][0][i] = (float)t[i]; qv[ks][1][i] = (float)t[4 + i]; } }
            if (kind == 0) {
                const int colpos = 32 * qt + r32;
#pragma unroll
                for (int a = 0; a < 2; ++a) { const int pos = a ? colpos : qb; const float* cp = rcos + pos * 16 + 8 * hh; const float* sp = rsin + pos * 16 + 8 * hh;
#pragma unroll
                    for (int e = 0; e < 2; ++e) { const f32x4 c = *(const f32x4*)(cp + 4 * e), s = *(const f32x4*)(sp + 4 * e);
                        const f32x4 x1 = qv[2 * a][e], x2 = qv[2 * a + 1][e]; qv[2 * a][e] = x1 * c - x2 * s; qv[2 * a + 1][e] = x2 * c + x1 * s; } }
            }
#pragma unroll
            for (int ks = 0; ks < 4; ++ks)
#pragma unroll
                for (int i = 0; i < 4; ++i) { qf[qt][ks][i] = (h16)(qv[ks][0][i] * (0.125f * 1.4426950408889634f)); qf[qt][ks][4 + i] = (h16)(qv[ks][1][i] * (0.125f * 1.4426950408889634f)); }
        }
        const float sink = p.at_sink[jl * 32 + head] * 1.4426950408889634f;
        float mrun[2] = {sink, sink}, lrun[2] = {hh == 0 ? 1.f : 0.f, hh == 0 ? 1.f : 0.f};
        f32x16 oacc[2][2];
#pragma unroll
        for (int a = 0; a < 2; ++a)
#pragma unroll
            for (int c = 0; c < 2; ++c)
#pragma unroll
                for (int i = 0; i < 16; ++i) oacc[a][c][i] = 0.f;
        const int t_lo = kind ? 0 : (qb < 2 ? 2 - qb : 0), t_hi = kind ? -1 : (65 - qb < 4 ? 65 - qb : 4); const int nwin = t_hi - t_lo + 1, nv = nwin + 4;
        const bool krole = tid < 256; const int kkey = tid >> 2, kcp = tid & 3, kdA = (kcp & 1) * 8 + (kcp >> 1) * 32; const int vdim = (tid - 256) >> 2, vkc = tid & 3;
        f16x8 ld0, ld1;
#define AT_TILE(sidx, KROW0, MASK, ROPE) do { if ((sidx) < nwin) { const int _ti = t_lo + (sidx); KROW0 = b * 4096 + qb * 64 - 128 + 64 * _ti; ROPE = true; MASK = (_ti == 0) ? 1 : (_ti == 4) ? 2 : 0; } \
            else { KROW0 = ctxrow0 + 64 * ((sidx) - nwin); ROPE = false; MASK = 0; } } while (0)
#define AT_LOAD(KROW0) do { if (krole) { const h16* kp = qk + (size_t)((KROW0) + kkey) * DQK + D + g * 64 + kdA; ld0 = *(const f16x8*)kp; ld1 = *(const f16x8*)(kp + 16); } \
            else { const h16* vp = vt + (size_t)(g * 64 + vdim) * TT + (KROW0) + 16 * vkc; ld0 = *(const f16x8*)vp; ld1 = *(const f16x8*)(vp + 8); } } while (0)
        { int kr0, mk; bool rp; AT_TILE(0, kr0, mk, rp); (void)mk; (void)rp; AT_LOAD(kr0); }
#pragma unroll 1
        for (int sx = 0; sx < nv; ++sx) {
            int krow0, mask; bool rope; AT_TILE(sx, krow0, mask, rope);
            __syncthreads();
            if (krole) {
                f16x8 o1 = ld0, o2 = ld1;
                if (rope) { const int kpos = (krow0 - b * 4096) + kkey; const int pos = (kcp >> 1) ? (kpos & 63) : (kpos >> 6);
                    const float* cpp = rcos + pos * 16 + (kcp & 1) * 8; const float* spp = rsin + pos * 16 + (kcp & 1) * 8;
#pragma unroll
                    for (int i = 0; i < 8; ++i) { const float c = cpp[i], s = spp[i], x1 = (float)ld0[i], x2 = (float)ld1[i]; o1[i] = (h16)(x1 * c - x2 * s); o2[i] = (h16)(x2 * c + x1 * s); } }
                *(LAS f16x8*)(Ks + kkey * AT_KP + kdA) = o1; *(LAS f16x8*)(Ks + kkey * AT_KP + kdA + 16) = o2;
            } else {
                LAS h16* dst = Vs + vdim * AT_VP + 16 * vkc;
                *(LAS f16x4*)(dst) = (f16x4){ld0[0], ld0[1], ld0[2], ld0[3]}; *(LAS f16x4*)(dst + 4) = (f16x4){ld0[4], ld0[5], ld0[6], ld0[7]};
                *(LAS f16x4*)(dst + 8) = (f16x4){ld1[0], ld1[1], ld1[2], ld1[3]}; *(LAS f16x4*)(dst + 12) = (f16x4){ld1[4], ld1[5], ld1[6], ld1[7]};
            }
            if (sx + 1 < nv) { int kr1, mk1; bool rp1; AT_TILE(sx + 1, kr1, mk1, rp1); (void)mk1; (void)rp1; AT_LOAD(kr1); }
            __syncthreads();
#pragma unroll
            for (int qt = 0; qt < 2; ++qt) {
                f32x16 sacc[2];
#pragma unroll
                for (int kt = 0; kt < 2; ++kt)
#pragma unroll
                    for (int i = 0; i < 16; ++i) sacc[kt][i] = 0.f;
#pragma unroll
                for (int ks = 0; ks < 4; ++ks)
#pragma unroll
                    for (int kt = 0; kt < 2; ++kt) { const f16x8 kf = *(const LAS f16x8*)(Ks + (32 * kt + r32) * AT_KP + 16 * ks + 8 * hh);
                        sacc[kt] = __builtin_amdgcn_mfma_f32_32x32x16_f16(kf, qf[qt][ks], sacc[kt], 0, 0, 0); }
                const int qq = 32 * qt + r32; float tmax = -3.0e38f;
                if (mask != 0) {
#pragma unroll
                for (int kt = 0; kt < 2; ++kt)
#pragma unroll
                    for (int i = 0; i < 16; ++i) { const int kk = 32 * kt + (i & 3) + 8 * (i >> 2) + 4 * hh; const bool dead = (mask == 1) ? (kk < qq) : (kk > qq); if (dead) sacc[kt][i] = -1.0e30f; } }
#pragma unroll
                for (int kt = 0; kt < 2; ++kt)
#pragma unroll
                    for (int i = 0; i < 16; ++i) tmax = fmaxf(tmax, sacc[kt][i]);
                tmax = fmaxf(tmax, shx(tmax, 32));
                const float mnew = fmaxf(mrun[qt], tmax); const float alpha = __builtin_amdgcn_exp2f(mrun[qt] - mnew); mrun[qt] = mnew;
                float psum = 0.f; f16x8 pf[2][2];
#pragma unroll
                for (int kt = 0; kt < 2; ++kt)
#pragma unroll
                    for (int s2 = 0; s2 < 2; ++s2)
#pragma unroll
                        for (int jj = 0; jj < 8; ++jj) { const float pv = __builtin_amdgcn_exp2f(sacc[kt][8 * s2 + jj] - mnew); psum += pv; pf[kt][s2][jj] = (h16)pv; }
                lrun[qt] = lrun[qt] * alpha + psum;
                if (__builtin_amdgcn_ballot_w64(alpha != 1.0f) != 0ull) {
#pragma unroll
                for (int dt = 0; dt < 2; ++dt)
#pragma unroll
                    for (int i = 0; i < 16; ++i) oacc[dt][qt][i] *= alpha; }
#pragma unroll
                for (int kt = 0; kt < 2; ++kt)
#pragma unroll
                    for (int s2 = 0; s2 < 2; ++s2)
#pragma unroll
                        for (int dt = 0; dt < 2; ++dt) { const LAS h16* vr = Vs + (32 * dt + r32) * AT_VP + 32 * kt + 16 * s2 + 4 * hh;
                            const f16x4 v0 = *(const LAS f16x4*)vr, v1 = *(const LAS f16x4*)(vr + 8);
                            const f16x8 vf = (f16x8){v0[0], v0[1], v0[2], v0[3], v1[0], v1[1], v1[2], v1[3]};
                            oacc[dt][qt] = __builtin_amdgcn_mfma_f32_32x32x16_f16(vf, pf[kt][s2], oacc[dt][qt], 0, 0, 0); }
            }
        }
#pragma unroll
        for (int qt = 0; qt < 2; ++qt) {
            const float ltot = lrun[qt] + shx(lrun[qt], 32); const float inv = 1.0f / ltot;
            h16* op = ob + (size_t)(qrow0 + 32 * qt + r32) * D + head * 64 + 4 * hh;
#pragma unroll
            for (int dt = 0; dt < 2; ++dt)
#pragma unroll
                for (int q4 = 0; q4 < 4; ++q4) { f16x4 w;
#pragma unroll
                    for (int i = 0; i < 4; ++i) w[i] = (h16)(oacc[dt][qt][4 * q4 + i] * inv);
                    *(f16x4*)(op + 32 * dt + 8 * q4) = w; }
        }
    }
}
#undef AT_TILE
#undef AT_LOAD

constexpr int NPHASE = 35;
#ifndef MK_MULTI
#define MK_MULTI 0
#endif

template <int KIND>
__attribute__((target("no-packed-fp32-ops"))) __global__ void __launch_bounds__(512, 2) hy_fwd(Params p_) {
    extern __shared__ __attribute__((aligned(16))) unsigned char shm[];
    LAS unsigned char* lds = (LAS unsigned char*)shm;
    constexpr bool ALL = KIND < 0;
    const int ph0 = p_.ph0;
    if (threadIdx.x == 0) { *(LAS u32x4*)(lds + LDS_XB) = (u32x4){0u, 0u, 0u, 0u}; }
    __syncthreads();
    XcdBarrier bar;
    if constexpr (ALL) bar = xcd_barrier_post((unsigned*)(p_.ws + WS_CTL), (volatile LAS unsigned*)(lds + LDS_XB));
#ifndef PROBE_SITE
#define PROBE_SITE -1
#endif
#define SITE(k) if constexpr (ALL || KIND == (k)) for (int rep_ = 0; rep_ < ((k) == PROBE_SITE ? 2 : 1); ++rep_) if (const Params& p = *params_fresh(); true)
#define SEAM() do { if constexpr (ALL) xcd_barrier(bar); } while (0)
    const int G = gridDim.x, bid = blockIdx.x;
    SITE(0) {
        for (int u = bid; u < 20353; u += G) {
            if (u < 384) modp_unit(p, u, (LAS float*)lds);
            else if (u == 384) tables_unit(p);
            else if (u < 1473) h2_task(p, (u - 385) * 8 + (tid_fresh() >> 6));
            else if (u < 1537) w3p_unit(p, u - 1473);
            else if (u < 1793) rtab_unit(p, u - 1537);
            else if (u < 4993) cvt_dense_unit(p, u - 1793, (LAS float*)lds);
            else cvt_moe_unit(p, 0, u - 4993, (LAS float*)lds);
        }
        SEAM();
    }
    SITE(1) {
        for (int u = bid; u < 216; u += G) modr_unit(p, u);
        SchedFilt S{p.ws + WS_W3P, p.ws + WS_H2P}; EpiTaps E{(float*)(p.ws + WS_TAPS), (float*)(p.ws + WS_TAPSC)};
        pg8::gemm_phase<EpiTaps, SchedFilt, 0>(lds, 256, S, E);
        SEAM();
    }
#define TAIL_IDLE(nunits) (((nunits) % G) ? G - ((nunits) % G) : 0)
#define CVT_PER_GEMM 10
#pragma unroll 1
    for (int layer = ALL ? 0 : ph0; layer < (ALL ? NLAYER : ph0 + 1); ++layer) {
        const bool hyena = (layer & 1) == 0; const int jl = layer >> 1;
        const int nu1 = hyena ? 24 * 136 : 136 * 10, nu4 = (layer == NLAYER - 1 ? 128 : 136) * 8;
        const int idle1 = TAIL_IDLE(nu1), idle4 = TAIL_IDLE(nu4);
        int cv4 = idle4 * CVT_PER_GEMM, cv1 = idle1 * CVT_PER_GEMM; if (cv4 > CVT_MOE_UNITS / 2) cv4 = CVT_MOE_UNITS / 2; if (cv1 > CVT_MOE_UNITS / 2 - 1) cv1 = CVT_MOE_UNITS / 2 - 1;
        const int cvN0 = CVT_MOE_UNITS - cv1 - cv4, cvN1 = cvN0 + cv1;
        SITE(2) {
            n1_phase(p, layer);
            for (int rep2_ = 0; rep2_ < ((PROBE_SITE == 20 && layer > 0) ? 2 : 1); ++rep2_) {
            if (layer == 0) filt_fft_phase(p, lds);
            else { (void)0; } }
            SEAM();
        }
        SITE(3) {
            if (hyena) { SchedPlain S{24, 136, D, p.ws + WS_WIN + (size_t)jl * D3 * D * 2, p.ws + WS_HBUF}; EpiH16 E{(h16*)(p.ws + WS_UT), TT, nullptr, 0};
                pg8::gemm_phase<EpiH16, SchedPlain, 0>(lds, D, S, E); }
            else { SchedQkv S{p.ws + WS_HBUF, p.ws + WS_WQKV + (size_t)jl * DQKV * D * 2}; EpiH16 E{(h16*)(p.ws + WS_QK), DQK, (h16*)(p.ws + WS_VT), TT};
                pg8::gemm_phase<EpiH16, SchedQkv, 0>(lds, D, S, E); }
            if (layer > 0 && idle1 > 0 && bid >= G - idle1) { for (int u = cvN0 + (bid - (G - idle1)); u < cvN1; u += idle1) cvt_moe_unit(p, layer, u, (LAS float*)lds); }
            SEAM();
        }
        SITE(4) {
#ifdef PROBE_PAR
            for (int rep3_ = 0; rep3_ < (((layer & 1) == PROBE_PAR) ? 2 : 1); ++rep3_)
#endif
            { if (hyena) conv_phase(p, jl, lds, ALL ? 0 : p.ph1, layer > 0 ? layer : -1, cvN0);
            else attn_phase(p, jl, layer != NLAYER - 1, lds, layer, cvN0); }
            SEAM();
        }
        SITE(5) {
            (void)0;
        }
        SITE(6) {
            EpiResid E{(float*)(p.ws + WS_XRES), (const float*)(p.ws + WS_MODS), layer, (float*)(p.ws + WS_SSQ)};
            if (hyena) {
                SchedPlainAT S{layer == NLAYER - 1 ? 128 : 136, 8, D, p.ws + WS_ZT, p.ws + WS_WOUT + (size_t)jl * D * D * 2};
                pg8::gemm_phase<EpiResid, SchedPlainAT, 2>(lds, D, S, E, TT);
            } else {
                SchedPlain S{layer == NLAYER - 1 ? 128 : 136, 8, D, p.ws + WS_HBUF, p.ws + WS_WO + (size_t)jl * D * D * 2};
                pg8::gemm_phase<EpiResid, SchedPlain, 0>(lds, D, S, E);
            }
            if (layer > 0 && idle4 > 0 && bid >= G - idle4) { for (int u = cvN1 + (bid - (G - idle4)); u < CVT_MOE_UNITS; u += idle4) cvt_moe_unit(p, layer, u, (LAS float*)lds); }
            SEAM();
        }
        SITE(7) { n2_phase(p, layer, lds, ALL ? 0 : p.ph1); SEAM(); }
        LAS int* tstart = (LAS int*)(lds + LDS_MISC); LAS int* texp = tstart + 80; LAS int* tcnt = texp + 352;
        SITE(8) {
            moe_table(tstart, texp, tcnt, (const int*)(p.ws + WS_CTL) + CTL_CNT + layer * NE);
            SchedMoe1 S{{tstart, texp, tcnt}, p.ws + WS_HBUF, p.ws + WS_W13, (const int*)(p.ws + WS_LIST)}; EpiMoe1 E{(h16*)(p.ws + WS_H1)};
            pg8::gemm_phase<EpiMoe1, SchedMoe1, 1>(lds, D, S, E);
            SEAM();
        }
        SITE(9) {
            moe_table(tstart, texp, tcnt, (const int*)(p.ws + WS_CTL) + CTL_CNT + layer * NE);
            SchedMoe2 S{{tstart, texp, tcnt}, p.ws + WS_H1, p.ws + WS_W2, (const int*)(p.ws + WS_LIST)}; EpiMoe2 E{(h16*)(p.ws + WS_YC), (const float*)(p.ws + WS_GATE), (const int*)(p.ws + WS_LIST)};
            pg8::gemm_phase<EpiMoe2, SchedMoe2, 0>(lds, DE, S, E);
            SEAM();
        }
    }
    SITE(10) final_phase(p);
#undef SITE
#undef SEAM
}

template <int KIND> static void launch_kind(const Params& p, int grid, hipStream_t stream) {
    static bool attr = false;
    if (!attr) { attr = true; if (hipFuncSetAttribute((const void*)hy_fwd<KIND>, hipFuncAttributeMaxDynamicSharedMemorySize, LDS_BYTES) != hipSuccess) fprintf(stderr, "kernel_launch: hipFuncSetAttribute failed (kind %d)\n", KIND); }
    hipLaunchKernelGGL(hy_fwd<KIND>, dim3(grid), dim3(512), LDS_BYTES, stream, p);
}

extern "C" void kernel_launch(void* const* d_in, const int* in_sizes, int n_in, void* d_out, int out_size, void* d_ws, size_t ws_size, hipStream_t stream) {
    static int grid = 0;
    if (!grid) {
        if (n_in != 29 || out_size != TL * D || ws_size < WS_END) { fprintf(stderr, "kernel_launch: unexpected problem (n_in %d, out %d, ws %zu < %zu)\n", n_in, out_size, ws_size, (size_t)WS_END); grid = -1; return; }
        int dev = 0, cus = 0;
        if (hipGetDevice(&dev) != hipSuccess || hipDeviceGetAttribute(&cus, hipDeviceAttributeMultiprocessorCount, dev) != hipSuccess) { grid = -1; return; }
        grid = cus;
    }
    if (grid <= 0) return;
    (void)hipMemsetAsync((char*)d_ws + WS_CTL, 0, CTL_BYTES, stream);
    Params p{};
    const float** pp = (const float**)&p;
    for (int i = 0; i < 29; ++i) pp[i] = (const float*)d_in[i];
    p.out = (float*)d_out; p.ws = (char*)d_ws;
#if MK_MULTI
    p.ph0 = 0; p.ph1 = 0;
    launch_kind<0>(p, grid, stream); launch_kind<1>(p, grid, stream);
#ifndef PROBE_KIND
#define PROBE_KIND -1
#endif
#ifndef PROBE_LAYERS
#define PROBE_LAYERS 15
#endif
#define PREP(k) (((k) == PROBE_KIND && ((PROBE_LAYERS >> layer) & 1)) ? 2 : 1)
    if (PROBE_KIND == 0) launch_kind<0>(p, grid, stream);
    if (PROBE_KIND == 1) launch_kind<1>(p, grid, stream);
    for (int layer = 0; layer < NLAYER; ++layer) { p.ph0 = layer;
        for (int r = 0; r < PREP(2); ++r) launch_kind<2>(p, grid, stream);
        for (int r = 0; r < PREP(3); ++r) launch_kind<3>(p, grid, stream);
        for (int r = 0; r < PREP(4); ++r) { p.ph1 = (PREP(4) == 2 && r == 0) ? 1 : 0; launch_kind<4>(p, grid, stream); p.ph1 = 0; }
        launch_kind<6>(p, grid, stream); launch_kind<7>(p, grid, stream);
        if (PREP(7) == 2) { p.ph1 = 1; launch_kind<7>(p, grid, stream); p.ph1 = 0; }
        for (int r = 0; r < PREP(8); ++r) launch_kind<8>(p, grid, stream);
        for (int r = 0; r < PREP(9); ++r) launch_kind<9>(p, grid, stream); }
    p.ph0 = 0; launch_kind<10>(p, grid, stream);
    if (PROBE_KIND == 10) launch_kind<10>(p, grid, stream);
#else
    p.ph0 = 0; p.ph1 = NPHASE;
    launch_kind<-1>(p, grid, stream);
#endif
}
```

```cpp
#include <hip/hip_runtime.h>
#include <cstdio>
#include <cstdint>

#define LAS __attribute__((address_space(3)))
typedef _Float16 h16;
typedef _Float16 f16x8 __attribute__((ext_vector_type(8)));
typedef _Float16 f16x4 __attribute__((ext_vector_type(4)));
typedef _Float16 f16x2 __attribute__((ext_vector_type(2)));
typedef float f32x2 __attribute__((ext_vector_type(2)));
typedef float f32x4 __attribute__((ext_vector_type(4)));
typedef float f32x16 __attribute__((ext_vector_type(16)));
typedef unsigned u32x2 __attribute__((ext_vector_type(2)));
typedef unsigned u32x4 __attribute__((ext_vector_type(4)));

constexpr int D = 2048, NB = 8, SEQ = 4096, CTXL = 256, TL = NB * SEQ, TC = NB * CTXL, TT = TL + TC;
constexpr int D3 = 3 * D, D6 = 6 * D, DQK = 2304, DQKV = 2560, NE = 64, DE = 384, DE2 = 768, NLAYER = 4;
constexpr int LCAP = TT;
constexpr int MOE_ROWS = 86016;
constexpr float EPS = 1e-6f;

constexpr size_t WS_CTL = 0;
constexpr size_t CTL_BYTES = 65536;
constexpr size_t WS_TW = WS_CTL + CTL_BYTES;
constexpr size_t WS_ROPE = WS_TW + 65536;
constexpr size_t WS_MODP = WS_ROPE + 8192;
constexpr size_t WS_MODS = WS_MODP + 16ull * 4 * 9 * 12288 * 4;
constexpr size_t WS_RTAB = WS_MODS + 4ull * 9 * 12288 * 4;
constexpr size_t RTAB_L = 64ull * 5 * 2 * 64 * 8 * 2;
constexpr size_t WS_RCST = WS_RTAB + 4 * RTAB_L;
constexpr size_t WS_H2P = WS_RCST + 16384;
constexpr size_t WS_W3P = WS_H2P + 2ull * 4352 * 256 * 2;
constexpr size_t WS_XRES = WS_W3P + 2ull * 8192 * 256 * 2;
constexpr size_t WS_HBUF = WS_XRES + (size_t)TT * D * 4;
constexpr size_t WS_UT = WS_HBUF + (size_t)TT * D * 2;
constexpr size_t UT_BYTES = (size_t)D3 * TT * 2;
constexpr size_t WS_TAPS = WS_UT;
constexpr size_t WS_TAPSC = WS_TAPS + 2ull * 8192 * 4096 * 4;
constexpr size_t WS_QK = WS_UT;
constexpr size_t WS_VT = WS_QK + (size_t)TT * DQK * 2;
constexpr size_t WS_ZT = WS_UT + UT_BYTES;
constexpr size_t WS_H1 = WS_ZT + (size_t)D * TT * 2;
constexpr size_t WS_YC = WS_H1 + (size_t)MOE_ROWS * DE * 2;
constexpr size_t WS_WIN = WS_YC + 2ull * TT * D * 2;
constexpr size_t WS_WOUT = WS_WIN + 2ull * D3 * D * 2;
constexpr size_t WS_WQKV = WS_WOUT + 2ull * D * D * 2;
constexpr size_t WS_WO = WS_WQKV + 2ull * DQKV * D * 2;
constexpr size_t WS_W13 = WS_WO + 2ull * D * D * 2;
constexpr size_t WS_W2 = WS_W13 + (size_t)NE * DE2 * D * 2;
constexpr size_t WS_KF = WS_W2 + (size_t)NE * D * DE * 2;
constexpr size_t WS_KFC = WS_KF + 2ull * 2 * 2048 * 65536;
constexpr size_t WS_LIST = WS_KFC + 2ull * 2 * 2048 * 4096;
constexpr size_t WS_GATE = WS_LIST + (size_t)NE * LCAP * 4;
constexpr size_t WS_SSQ = WS_GATE + (size_t)NE * LCAP * 4;
constexpr size_t WS_END = WS_SSQ + (size_t)TT * 32 * 4;
static_assert(WS_TAPSC + 2ull * 8192 * 256 * 4 <= WS_UT + UT_BYTES, "taps alias");
static_assert(WS_VT + 256ull * TT * 2 <= WS_UT + UT_BYTES, "qkv alias");

constexpr int CTL_CNT = 4096;

constexpr int LDS_BYTES = 147456;
constexpr int LDS_MISC = 139264;
constexpr int LDS_XB = LDS_BYTES - 16;

struct Params {
    const float *x, *c, *ctx, *c_ctx, *mod_w, *mod_b, *hy_w_in, *hy_conv_w, *hy_conv_b, *hy_f_w1, *hy_f_b1, *hy_f_freq1, *hy_f_w2, *hy_f_b2, *hy_f_freq2, *hy_f_w3,
        *hy_bias, *hy_w_out, *at_w_qkv, *at_sink, *at_w_o, *moe_wg, *moe_bg, *moe_we, *moe_be, *moe_w1, *moe_w3, *moe_w2, *final_gain;
    float* out; char* ws; int ph0, ph1;
};

__device__ __forceinline__ int tid_fresh() { int t = threadIdx.x; asm volatile("" : "+v"(t)); return t; }
__device__ __forceinline__ float bperm_f(float v, int srclane) { return __int_as_float(__builtin_amdgcn_ds_bpermute(srclane << 2, __float_as_int(v))); }
__device__ __forceinline__ float shx(float v, int mask) { return bperm_f(v, (tid_fresh() & 63) ^ mask); }
__device__ __forceinline__ const Params* params_fresh() { auto q = __builtin_amdgcn_kernarg_segment_ptr(); asm volatile("" : "+s"(q)); return (const Params*)q; }

#define XB_TMO      128
#define XB_XCNT(j)  (256  + 64 * (j))
#define XB_XSUB(j)  (1280 + 64 * (j))
#define XB_XGEN(j)  (2304 + 64 * (j))
#define XB_TOP      3328
#define XB_TOPGEN   3392
#define XCD_BAR_WORDS 3456
#define XB_SPIN_CAP (1u << 18)

__device__ __forceinline__ unsigned xb_ld(unsigned* p)              { return __hip_atomic_load(p, __ATOMIC_RELAXED, __HIP_MEMORY_SCOPE_AGENT); }
__device__ __forceinline__ unsigned xb_add(unsigned* p, unsigned v) { return __hip_atomic_fetch_add(p, v, __ATOMIC_RELAXED, __HIP_MEMORY_SCOPE_AGENT); }
__device__ __forceinline__ unsigned xb_xcc_id() { return (unsigned)__builtin_amdgcn_s_getreg((3 << 11) | 20) & 0xFu; }
#define XB_SPIN(cond, bar) do { unsigned _sp = 0; while (cond) { __builtin_amdgcn_s_sleep(1); \
    if ((++_sp & 255u) == 0u) { if (xb_ld(&(bar)[XB_TMO])) break; if (_sp > XB_SPIN_CAP) { atomicAdd(&(bar)[XB_TMO], 1u); break; } } } } while (0)

struct XcdBarrier { unsigned* bar; volatile LAS unsigned* st; };

__device__ __forceinline__ XcdBarrier xcd_barrier_post(unsigned* bar, volatile LAS unsigned* st) {
    XcdBarrier b; b.bar = bar; b.st = st;
    if (threadIdx.x == 0) (void)xb_add(&bar[XB_XCNT(xb_xcc_id())], 1u);
    return b;
}
__device__ __forceinline__ void xcd_barrier_complete(unsigned* bar, unsigned x, unsigned& nloc, unsigned& nx) {
    const unsigned G = gridDim.x * gridDim.y * gridDim.z;
    unsigned sum, cnt, mine, sp = 0u;
    for (;;) {
        sum = 0u; cnt = 0u; mine = 0u;
#pragma unroll
        for (unsigned j = 0; j < 16; ++j) { const unsigned c = xb_ld(&bar[XB_XCNT(j)]); sum += c; cnt += (c > 0u) ? 1u : 0u; mine = (j == x) ? c : mine; }
        if (sum == G) break;
        __builtin_amdgcn_s_sleep(1);
        if ((++sp & 255u) == 0u) { if (xb_ld(&bar[XB_TMO])) break; if (sp > XB_SPIN_CAP) { atomicAdd(&bar[XB_TMO], 1u); break; } }
    }
    nloc = mine > 0u ? mine : 1u; nx = cnt > 0u ? cnt : 1u;
}
__device__ __forceinline__ void xcd_barrier(const XcdBarrier& b) {
    asm volatile("s_waitcnt vmcnt(0)" ::: "memory");
    __syncthreads();
    if (threadIdx.x == 0) {
        unsigned* bar = b.bar; const unsigned bx = xb_xcc_id();
        __builtin_amdgcn_s_waitcnt(0);
        unsigned nloc = b.st[0], nx = b.st[1];
        if (nloc == 0u) { xcd_barrier_complete(bar, bx, nloc, nx); b.st[0] = nloc; b.st[1] = nx; }
        const unsigned old = xb_add(&bar[XB_XSUB(bx)], 1u);
        const unsigned gen = old / nloc;
        if (old + 1u == (gen + 1u) * nloc) {
            __builtin_amdgcn_fence(__ATOMIC_RELEASE, "agent");
            asm volatile("s_waitcnt vmcnt(0)" ::: "memory");
            const unsigned og = xb_add(&bar[XB_TOP], 1u);
            const unsigned tg = og / nx;
            if (og + 1u == (tg + 1u) * nx) xb_add(&bar[XB_TOPGEN], 1u);
            else XB_SPIN(xb_ld(&bar[XB_TOPGEN]) == tg, bar);
            __builtin_amdgcn_fence(__ATOMIC_ACQUIRE, "agent");
            xb_add(&bar[XB_XGEN(bx)], 1u);
            asm volatile("s_waitcnt vmcnt(0)" ::: "memory");
        } else {
            XB_SPIN(xb_ld(&bar[XB_XGEN(bx)]) == gen, bar);
            __builtin_amdgcn_fence(__ATOMIC_ACQUIRE, "agent");
            asm volatile("s_waitcnt vmcnt(0)" ::: "memory");
        }
    }
    __syncthreads();
}

namespace pg8 {
constexpr int BM = 256, BK = 64, HALF = 128, HTB = HALF * BK * 2, STAGE_BYTES = 8 * HTB;
__device__ __forceinline__ int lds_byte(int r, int c) { const int st = (r >> 4) * 2 + (c >> 5), rr = r & 15, cc = c & 31, ob = rr * 64 + cc * 2; return st * 1024 + (ob ^ (((ob >> 9) & 1) << 5)); }
__device__ __forceinline__ void stage_rc(int b, int& R, int& C) { const int st = b / 1024, sb = b % 1024, swz = sb ^ (((sb >> 9) & 1) << 5); R = (st >> 1) * 16 + swz / 64; C = (st & 1) * 32 + (swz % 64) / 2; }
__device__ __forceinline__ int perm32(int rho) { const int n = rho >> 4, i = rho & 15; return 8 * (i >> 2) + 4 * n + (i & 3); }

struct Unit {
    int pm, pn;
    int e, pos0, cnt;
    int kind;
    int half;
    const char* A; const char* B;
    const int* rows;
};

typedef short s16x4 __attribute__((ext_vector_type(4)));
template <class Epi, class Sched, int AMODE>
__device__ __forceinline__ void gemm_phase(LAS unsigned char* lds, const int K, const Sched& S, const Epi& E, const int ldat = 0) {
    constexpr bool GATHER = AMODE == 1, ATR = AMODE == 2;
    const int tid = tid_fresh(), wid = __builtin_amdgcn_readfirstlane(tid >> 6), lane = tid & 63, wr = wid >> 2, wc = wid & 3, fr = lane & 15, fq = lane >> 4;
    const int nt = K / BK;
    unsigned voffA[2], voffB[2]; int RA[2], CA[2];
#pragma unroll
    for (int i = 0; i < 2; ++i) { int R, C; stage_rc(tid * 16 + i * 8192, R, C); const int Rb = Epi::PERM ? ((R & ~31) + perm32(R & 31)) : R;
        voffA[i] = (unsigned)(R * K + C) * 2u; voffB[i] = (unsigned)(Rb * K + C) * 2u; RA[i] = R; CA[i] = C;
        if constexpr (ATR) { const int bb = tid * 16 + i * 8192, row = bb >> 8, pc = (bb >> 4) & 15, ch = pc ^ (((row & 3) << 2) | ((row >> 2) & 3)); voffA[i] = (unsigned)(row * ldat + 8 * ch) * 2u; } }
    const size_t kstep = (size_t)(BK * 2);
    const size_t hstep = (size_t)HALF * K * 2;
    const size_t kstepA = ATR ? (size_t)BK * ldat * 2 : kstep, hstepA = ATR ? (size_t)HALF * 2 : hstep;
    const unsigned ldsw = (unsigned)wid * 1024u;
    const int aoff = lds_byte(wr * 64 + fr, fq * 8), boff = lds_byte(wc * 32 + fr, fq * 8);
    int atr[4][2];
#pragma unroll
    for (int m = 0; m < 4; ++m)
#pragma unroll
        for (int bl = 0; bl < 2; ++bl) { const int xr = ((fr >> 2) << 2) | ((2 * fq + bl) & 3); atr[m][bl] = 256 * (8 * fq + (fr >> 2) + 4 * bl) + 16 * ((wr * 8 + 2 * m + ((fr & 3) >> 1)) ^ xr) + 8 * (fr & 1); }
    unsigned vgC[2][2], vgN[2][2];
#define PG8_ROWS(u, vg) do { if constexpr (GATHER) { _Pragma("unroll") for (int _h = 0; _h < 2; ++_h) _Pragma("unroll") for (int _i = 0; _i < 2; ++_i) { \
        const int _p = (u).pos0 + _h * HALF + RA[_i]; const int _tok = (_p < (u).cnt) ? ((u).rows[_h * HALF + RA[_i]] >> 1) : 0; \
        vg[_h][_i] = ((unsigned)_tok * (unsigned)K + (unsigned)CA[_i]) * 2u; } } } while (0)
#define PG8_SA(b, h) (((b) * 2 + (h)) * HTB)
#define PG8_SB(b, h) ((4 + (b) * 2 + (h)) * HTB)
#define PG8_STAGE_B(bufoff, gbase) do { _Pragma("unroll") for (int _i = 0; _i < 2; ++_i) \
        __builtin_amdgcn_global_load_lds((const unsigned*)((const char*)(gbase) + voffB[_i]), (LAS unsigned*)(lds + (bufoff) + ldsw + _i * 8192), 16, 0, 0); } while (0)
#define PG8_STAGE_A(bufoff, gbase, h, NEXT) do { _Pragma("unroll") for (int _i = 0; _i < 2; ++_i) { \
        const unsigned _vo = GATHER ? ((NEXT) ? vgN[h][_i] : vgC[h][_i]) : voffA[_i]; \
        __builtin_amdgcn_global_load_lds((const unsigned*)((const char*)(gbase) + (GATHER ? (size_t)0 : (size_t)(h) * hstepA) + _vo), (LAS unsigned*)(lds + (bufoff) + ldsw + _i * 8192), 16, 0, 0); } } while (0)
#define PG8_LDA(dst, b, h) do { if constexpr (!ATR) { _Pragma("unroll") for (int m = 0; m < 4; ++m) _Pragma("unroll") for (int k = 0; k < 2; ++k) dst[m][k] = *(const LAS f16x8*)(lds + PG8_SA(b, h) + aoff + m * 2048 + k * 1024); } \
        else { _Pragma("unroll") for (int m = 0; m < 4; ++m) _Pragma("unroll") for (int k = 0; k < 2; ++k) { \
            const s16x4 _lo = __builtin_amdgcn_ds_read_tr16_b64_v4i16((LAS s16x4*)(lds + PG8_SA(b, h) + atr[m][0] + k * 8192)), _hi = __builtin_amdgcn_ds_read_tr16_b64_v4i16((LAS s16x4*)(lds + PG8_SA(b, h) + atr[m][1] + k * 8192)); \
            const short __attribute__((ext_vector_type(8))) _v = {_lo[0], _lo[1], _lo[2], _lo[3], _hi[0], _hi[1], _hi[2], _hi[3]}; dst[m][k] = __builtin_bit_cast(f16x8, _v); } } } while (0)
#define PG8_LDB(dst, b, h) do { _Pragma("unroll") for (int n = 0; n < 2; ++n) _Pragma("unroll") for (int k = 0; k < 2; ++k) dst[n][k] = *(const LAS f16x8*)(lds + PG8_SB(b, h) + boff + n * 2048 + k * 1024); } while (0)
#define PG8_MMA(ai, bj, At, Bt) do { __builtin_amdgcn_s_setprio(1); _Pragma("unroll") for (int m = 0; m < 4; ++m) _Pragma("unroll") for (int n = 0; n < 2; ++n) _Pragma("unroll") for (int k = 0; k < 2; ++k) \
        acc[ai][bj][m][n] = __builtin_amdgcn_mfma_f32_16x16x32_f16(Bt[n][k], At[m][k], acc[ai][bj][m][n], 0, 0, 0); __builtin_amdgcn_s_setprio(0); } while (0)
#define PG8_WAIT_V(n) asm volatile("s_waitcnt vmcnt(" #n ")" ::: "memory")
#define PG8_WAIT_L(n) asm volatile("s_waitcnt lgkmcnt(" #n ")" ::: "memory")
#define PG8_BAR __builtin_amdgcn_s_barrier()
#define PG8_SCHED __builtin_amdgcn_sched_barrier(0)
    Unit cur, nxt; int ui = 0;
    if (!S.next(0, cur)) return;
    f32x4 acc[2][2][4][2];
#pragma unroll
    for (int a = 0; a < 2; ++a)
#pragma unroll
        for (int b = 0; b < 2; ++b)
#pragma unroll
            for (int m = 0; m < 4; ++m)
#pragma unroll
                for (int n = 0; n < 2; ++n) acc[a][b][m][n] = (f32x4){0.f, 0.f, 0.f, 0.f};
    f16x8 At[4][2], B0[2][2], B1[2][2];
    const char* cA = cur.A; const char* cB = cur.B;
    PG8_ROWS(cur, vgC);
#pragma unroll
    for (int _h = 0; _h < 2; ++_h)
#pragma unroll
        for (int _i = 0; _i < 2; ++_i) vgN[_h][_i] = GATHER ? vgC[_h][_i] : 0u;
    PG8_STAGE_B(PG8_SB(0, 0), cB); PG8_STAGE_B(PG8_SB(0, 1), cB + hstep); PG8_STAGE_A(PG8_SA(0, 0), cA, 0, false); PG8_STAGE_A(PG8_SA(0, 1), cA, 1, false);
    if (wr == 1) PG8_BAR;
    PG8_WAIT_V(2); PG8_BAR;
    PG8_STAGE_B(PG8_SB(1, 0), cB + kstep); PG8_STAGE_A(PG8_SA(1, 0), cA + kstepA, 0, false); PG8_STAGE_B(PG8_SB(1, 1), cB + hstep + kstep);
    PG8_WAIT_V(6); PG8_BAR;
    for (;;) {
        const bool has_next = S.next(ui + 1, nxt);
        const bool full = cur.half == 0;
        const char* nA = has_next ? nxt.A : cA; const char* nB = has_next ? nxt.B : cB;
        if (has_next) { PG8_ROWS(nxt, vgN); }
#pragma unroll 1
        for (int t = 0; t < nt; t += 2) {
            const bool last = (t == nt - 2);
            const char* a1 = cA + (size_t)(t + 1) * kstepA;
            const char* a2 = last ? nA : cA + (size_t)(t + 2) * kstepA; const char* b2 = last ? nB : cB + (size_t)(t + 2) * kstep;
            const char* a3 = a2 + kstepA; const char* b3 = b2 + kstep;
            PG8_LDB(B0, 0, 0); PG8_LDB(B1, 0, 1); PG8_SCHED; PG8_LDA(At, 0, 0); PG8_STAGE_A(PG8_SA(1, 1), a1, 1, false);
            PG8_WAIT_V(8); PG8_WAIT_L(0); PG8_BAR; PG8_MMA(0, 0, At, B0); PG8_MMA(0, 1, At, B1); PG8_BAR; PG8_SCHED;
            PG8_LDA(At, 0, 1); PG8_STAGE_B(PG8_SB(0, 0), b2); PG8_STAGE_B(PG8_SB(0, 1), b2 + hstep); PG8_STAGE_A(PG8_SA(0, 0), a2, 0, last);
            PG8_WAIT_V(8); PG8_WAIT_L(0); PG8_BAR; if (full) { PG8_MMA(1, 0, At, B0); PG8_MMA(1, 1, At, B1); } PG8_BAR; PG8_SCHED;
            PG8_LDB(B0, 1, 0); PG8_LDB(B1, 1, 1); PG8_SCHED; PG8_LDA(At, 1, 0); PG8_STAGE_A(PG8_SA(0, 1), a2, 1, last);
            PG8_WAIT_V(8); PG8_WAIT_L(0); PG8_BAR; PG8_MMA(0, 0, At, B0); PG8_MMA(0, 1, At, B1); PG8_BAR; PG8_SCHED;
            PG8_LDA(At, 1, 1); PG8_STAGE_B(PG8_SB(1, 0), b3); PG8_STAGE_B(PG8_SB(1, 1), b3 + hstep); PG8_STAGE_A(PG8_SA(1, 0), a3, 0, last);
            PG8_WAIT_V(8); PG8_WAIT_L(0); PG8_BAR; if (full) { PG8_MMA(1, 0, At, B0); PG8_MMA(1, 1, At, B1); } PG8_BAR; PG8_SCHED;
        }
        if (wr == 0) PG8_BAR;
        E(acc, cur, wr, wc, fr, fq);
        if (!has_next) break;
#pragma unroll
        for (int a = 0; a < 2; ++a)
#pragma unroll
            for (int b = 0; b < 2; ++b)
#pragma unroll
                for (int m = 0; m < 4; ++m)
#pragma unroll
                    for (int n = 0; n < 2; ++n) acc[a][b][m][n] = (f32x4){0.f, 0.f, 0.f, 0.f};
        cur = nxt; cA = nA; cB = nB; ++ui;
#pragma unroll
        for (int _h = 0; _h < 2; ++_h)
#pragma unroll
            for (int _i = 0; _i < 2; ++_i) vgC[_h][_i] = vgN[_h][_i];
        if (wr == 1) PG8_BAR;
    }
    PG8_WAIT_V(0);
    PG8_BAR;
#undef PG8_ROWS
#undef PG8_SA
#undef PG8_SB
#undef PG8_STAGE_A
#undef PG8_STAGE_B
#undef PG8_LDA
#undef PG8_LDB
#undef PG8_MMA
#undef PG8_WAIT_V
#undef PG8_WAIT_L
#undef PG8_BAR
#undef PG8_SCHED
}
}

using pg8::Unit;
__device__ __forceinline__ f16x8 pack8(const f32x4 a, const f32x4 b) {
    f16x8 w; w[0] = (h16)a[0]; w[1] = (h16)a[1]; w[2] = (h16)a[2]; w[3] = (h16)a[3]; w[4] = (h16)b[0]; w[5] = (h16)b[1]; w[6] = (h16)b[2]; w[7] = (h16)b[3]; return w;
}
struct EpiH16 {
    static constexpr bool PERM = true;
    h16* O0; int ld0; h16* O1; int ld1;
    __device__ __forceinline__ void operator()(const f32x4 (&acc)[2][2][4][2], const Unit& u, int wr, int wc, int fr, int fq) const {
        h16* base = u.kind ? O1 : O0; const int ld = u.kind ? ld1 : ld0;
        const int row0 = u.pm * 256 + wr * 64 + fr, col0 = u.pn * 256 + wc * 32 + 8 * fq;
#pragma unroll
        for (int ai = 0; ai < 2; ++ai)
#pragma unroll
            for (int m = 0; m < 4; ++m) { h16* rowp = base + (size_t)(row0 + ai * 128 + m * 16) * ld + col0;
#pragma unroll
                for (int bj = 0; bj < 2; ++bj) __builtin_nontemporal_store(pack8(acc[ai][bj][m][0], acc[ai][bj][m][1]), (f16x8*)(rowp + bj * 128)); }
    }
};
struct EpiTaps {
    static constexpr bool PERM = false;
    float* T0; float* T1;
    __device__ __forceinline__ void operator()(const f32x4 (&acc)[2][2][4][2], const Unit& u, int wr, int wc, int fr, int fq) const {
        const int j = u.kind >> 1, v = u.kind & 1; const int ld = v ? 256 : 4096;
        float* base = v ? (T1 + (size_t)j * 8192 * 256) : (T0 + (size_t)j * 8192 * 4096);
        const int row0 = u.pm * 256 + wr * 64 + fr, col0 = u.pn * 256 + wc * 32 + 4 * fq;
#pragma unroll
        for (int ai = 0; ai < 2; ++ai)
#pragma unroll
            for (int m = 0; m < 4; ++m) { float* rowp = base + (size_t)(row0 + ai * 128 + m * 16) * ld + col0;
#pragma unroll
                for (int bj = 0; bj < 2; ++bj)
#pragma unroll
                    for (int n = 0; n < 2; ++n) *(f32x4*)(rowp + bj * 128 + n * 16) = acc[ai][bj][m][n]; }
    }
};
struct EpiResid {
    static constexpr bool PERM = false;
    float* X; const float* mods; int layer; float* SSQ;
    __device__ __forceinline__ void operator()(const f32x4 (&acc)[2][2][4][2], const Unit& u, int wr, int wc, int fr, int fq) const {
        const int r0 = u.pm * 256; const int b = r0 < TL ? (r0 >> 12) : 8;
        const float* g = mods + ((size_t)(layer * 9 + b) * 6 + 2) * D;
        const int row0 = r0 + wr * 64 + fr, col0 = u.pn * 256 + wc * 32 + 4 * fq;
        f32x4 gv[2][2];
#pragma unroll
        for (int bj = 0; bj < 2; ++bj)
#pragma unroll
            for (int n = 0; n < 2; ++n) gv[bj][n] = *(const f32x4*)(g + col0 + bj * 128 + n * 16);
#pragma unroll
        for (int ai = 0; ai < 2; ++ai)
#pragma unroll
            for (int m = 0; m < 4; ++m) { const int row = row0 + ai * 128 + m * 16; float* rowp = X + (size_t)row * D + col0; float sq = 0.f;
#pragma unroll
                for (int bj = 0; bj < 2; ++bj)
#pragma unroll
                    for (int n = 0; n < 2; ++n) { f32x4* pp = (f32x4*)(rowp + bj * 128 + n * 16); const f32x4 v = *pp + gv[bj][n] * acc[ai][bj][m][n]; *pp = v; sq += v[0] * v[0] + v[1] * v[1] + v[2] * v[2] + v[3] * v[3]; }
                sq += shx(sq, 16); sq += shx(sq, 32);
                if (fq == 0) SSQ[(size_t)row * 32 + u.pn * 4 + wc] = sq; }
    }
};
struct EpiMoe1 {
    static constexpr bool PERM = true;
    h16* H1;
    __device__ __forceinline__ void operator()(const f32x4 (&acc)[2][2][4][2], const Unit& u, int wr, int wc, int fr, int fq) const {
        const int row0 = u.pm * 256 + wr * 64 + fr, col0 = u.pn * 128 + wc * 16 + 4 * fq;
#pragma unroll
        for (int ai = 0; ai < 2; ++ai)
#pragma unroll
            for (int m = 0; m < 4; ++m) { if (ai == 1 && u.half) continue; h16* rowp = H1 + (size_t)(row0 + ai * 128 + m * 16) * DE + col0;
#pragma unroll
                for (int bj = 0; bj < 2; ++bj) { const f32x4 a = acc[ai][bj][m][0], b = acc[ai][bj][m][1]; f16x4 w;
#pragma unroll
                    for (int i = 0; i < 4; ++i) { const float s = a[i] / (1.0f + __expf(-a[i])); w[i] = (h16)(s * b[i]); }
                    *(f16x4*)(rowp + bj * 64) = w; } }
    }
};
struct EpiMoe2 {
    static constexpr bool PERM = true;
    h16* YC; const float* gslot;
    __device__ __forceinline__ void operator()(const f32x4 (&acc)[2][2][4][2], const Unit& u, int wr, int wc, int fr, int fq) const {
        const int col0 = u.pn * 256 + wc * 32 + 8 * fq;
        const float* grow = gslot + ((const char*)u.rows - (const char*)listbase) / 4;
        int av[2][4]; float gv[2][4];
#pragma unroll
        for (int ai = 0; ai < 2; ++ai)
#pragma unroll
            for (int m = 0; m < 4; ++m) { const int r = ai * 128 + wr * 64 + m * 16 + fr; const bool ok = u.pos0 + r < u.cnt; av[ai][m] = ok ? u.rows[r] : -1; gv[ai][m] = ok ? grow[r] : 0.f; }
#pragma unroll
        for (int ai = 0; ai < 2; ++ai)
#pragma unroll
            for (int m = 0; m < 4; ++m) { if (av[ai][m] >= 0) { const float g = gv[ai][m]; h16* rowp = YC + (size_t)av[ai][m] * D + col0;
#pragma unroll
                    for (int bj = 0; bj < 2; ++bj) *(f16x8*)(rowp + bj * 128) = pack8(acc[ai][bj][m][0] * g, acc[ai][bj][m][1] * g); } }
    }
    const int* listbase;
};

__device__ __forceinline__ void order_tile(int wgid, int nM, int nN, int& pm, int& pn) {
    const int nwg = nM * nN; { const int q = nwg / 8, r = nwg % 8, xcd = wgid % 8, off = wgid / 8; wgid = (xcd < r ? xcd * (q + 1) : r * (q + 1) + (xcd - r) * q) + off; }
    const int nig = 8 * nN, gid = wgid / nig, fm = gid * 8, gsz = (nM - fm) < 8 ? (nM - fm) : 8;
    pm = fm + ((wgid % nig) % gsz); pn = (wgid % nig) / gsz;
}
struct SchedPlain {
    int nM, nN, K; const char* A; const char* B;
    __device__ __forceinline__ bool next(int i, Unit& u) const {
        const long L = (long)i * gridDim.x + blockIdx.x; if (L >= (long)nM * nN) return false;
        order_tile((int)L, nM, nN, u.pm, u.pn); u.kind = 0; u.half = 0; u.e = 0; u.pos0 = 0; u.cnt = 0; u.rows = nullptr;
        u.A = A + (size_t)u.pm * 256 * K * 2; u.B = B + (size_t)u.pn * 256 * K * 2; return true;
    }
};
struct SchedPlainAT {
    int nM, nN, K; const char* At; const char* B;
    __device__ __forceinline__ bool next(int i, Unit& u) const {
        const long L = (long)i * gridDim.x + blockIdx.x; if (L >= (long)nM * nN) return false;
        order_tile((int)L, nM, nN, u.pm, u.pn); u.kind = 0; u.half = 0; u.e = 0; u.pos0 = 0; u.cnt = 0; u.rows = nullptr;
        u.A = At + (size_t)u.pm * 256 * 2; u.B = B + (size_t)u.pn * 256 * K * 2; return true;
    }
};
struct SchedQkv {
    const char* H; const char* W;
    __device__ __forceinline__ bool next(int i, Unit& u) const {
        const long L = (long)i * gridDim.x + blockIdx.x; const int nA = 136 * 9; if (L >= nA + 136) return false;
        u.e = 0; u.half = 0; u.pos0 = 0; u.cnt = 0; u.rows = nullptr;
        if (L < nA) { order_tile((int)L, 136, 9, u.pm, u.pn); u.kind = 0; u.A = H + (size_t)u.pm * 256 * D * 2; u.B = W + (size_t)u.pn * 256 * D * 2; }
        else { u.pm = 0; u.pn = (int)L - nA; u.kind = 1; u.A = W + (size_t)DQK * D * 2; u.B = H + (size_t)u.pn * 256 * D * 2; }
        return true;
    }
};
struct SchedFilt {
    const char* W3P; const char* H2P;
    __device__ __forceinline__ bool next(int i, Unit& u) const {
        const long L = (long)i * gridDim.x + blockIdx.x; if (L >= 2 * 544) return false;
        const int j = (int)L / 544, r = (int)L % 544; u.e = 0; u.half = 0; u.pos0 = 0; u.cnt = 0; u.rows = nullptr;
        int v; if (r < 512) { v = 0; u.pm = r >> 4; u.pn = r & 15; } else { v = 1; u.pm = r - 512; u.pn = 0; }
        u.kind = 2 * j + v;
        u.A = W3P + ((size_t)j * 8192 + (size_t)u.pm * 256) * 256 * 2;
        u.B = H2P + ((size_t)j * 4352 + (v ? 4096 : 0) + (size_t)u.pn * 256) * 256 * 2;
        return true;
    }
};
struct MoeTab { const LAS int* tstart; const LAS int* texp; const LAS int* cnt; };
struct SchedMoe1 {
    MoeTab tb; const char* H; const char* W13; const int* list;
    __device__ __forceinline__ bool next(int i, Unit& u) const {
        const long L = (long)i * gridDim.x + blockIdx.x; const int ntile = __builtin_amdgcn_readfirstlane(tb.tstart[NE]); if (L >= (long)ntile * 3) return false;
        int rt; order_tile((int)L, ntile, 3, rt, u.pn); u.pm = rt; u.kind = 0;
        const int e = __builtin_amdgcn_readfirstlane(tb.texp[rt]); u.e = e; u.pos0 = (rt - __builtin_amdgcn_readfirstlane(tb.tstart[e])) * 256; u.cnt = __builtin_amdgcn_readfirstlane(tb.cnt[e]); u.half = (u.cnt - u.pos0 <= 128) ? 1 : 0;
        u.rows = list + (size_t)e * LCAP + u.pos0; u.A = H; u.B = W13 + ((size_t)e * DE2 + (size_t)u.pn * 256) * D * 2; return true;
    }
};
struct SchedMoe2 {
    MoeTab tb; const char* H1; const char* W2; const int* list;
    __device__ __forceinline__ bool next(int i, Unit& u) const {
        const long L = (long)i * gridDim.x + blockIdx.x; const int ntile = __builtin_amdgcn_readfirstlane(tb.tstart[NE]); if (L >= (long)ntile * 8) return false;
        int rt; order_tile((int)L, ntile, 8, rt, u.pn); u.pm = rt; u.kind = 0;
        const int e = __builtin_amdgcn_readfirstlane(tb.texp[rt]); u.e = e; u.pos0 = (rt - __builtin_amdgcn_readfirstlane(tb.tstart[e])) * 256; u.cnt = __builtin_amdgcn_readfirstlane(tb.cnt[e]); u.half = (u.cnt - u.pos0 <= 128) ? 1 : 0;
        u.rows = list + (size_t)e * LCAP + u.pos0; u.A = H1 + (size_t)rt * 256 * DE * 2; u.B = W2 + ((size_t)e * D + (size_t)u.pn * 256) * DE * 2; return true;
    }
};
__device__ __forceinline__ void moe_table(LAS int* tstart, LAS int* texp, LAS int* cnt, const int* counters) {
    const int t = tid_fresh();
    if (t < NE) cnt[t] = counters[t];
    __syncthreads();
    if (t <= NE) { int s = 0; for (int e = 0; e < t; ++e) s += (cnt[e] + 255) >> 8; tstart[t] = s; }
    __syncthreads();
    if (t < NE) { const int s0 = tstart[t], s1 = tstart[t + 1]; for (int q = s0; q < s1; ++q) texp[q] = t; }
    __syncthreads();
}

__device__ __forceinline__ float wave_sum(float v) {
#pragma unroll
    for (int o = 32; o >= 1; o >>= 1) v += shx(v, o);
    return v;
}
__device__ __forceinline__ float silu_f(float x) { return x / (1.0f + expf(-x)); }
__device__ __forceinline__ int batch_of_row(int r) { return r < TL ? (r >> 12) : 8; }

__device__ __forceinline__ void modp_unit(const Params& p, int unit, LAS float* sl) {
    const int layer = unit / 96, rem = unit % 96, ks = rem / 6, cc = rem % 6, tid = tid_fresh();
    for (int i = tid; i < 9 * 128; i += 512) { const int cnd = i >> 7, k = ks * 128 + (i & 127); const float v = cnd < 8 ? p.c[cnd * D + k] : p.c_ctx[k]; sl[i] = silu_f(v); }
    __syncthreads();
    f32x4 acc[9];
#pragma unroll
    for (int q = 0; q < 9; ++q) acc[q] = (f32x4){0.f, 0.f, 0.f, 0.f};
    const float* w = p.mod_w + ((size_t)layer * D + (size_t)ks * 128) * D6 + cc * 2048 + tid * 4;
#pragma unroll 4
    for (int k = 0; k < 128; ++k) { const f32x4 wv = *(const f32x4*)(w + (size_t)k * D6);
#pragma unroll
        for (int q = 0; q < 9; ++q) acc[q] += wv * sl[q * 128 + k]; }
    float* outp = (float*)(p.ws + WS_MODP) + ((size_t)(ks * 4 + layer) * 9) * D6 + cc * 2048 + tid * 4;
#pragma unroll
    for (int q = 0; q < 9; ++q) *(f32x4*)(outp + (size_t)q * D6) = acc[q];
    __syncthreads();
}
__device__ __forceinline__ void modr_unit(const Params& p, int unit) {
    const size_t idx = (size_t)unit * 2048 + tid_fresh() * 4; const int layer = (int)(idx / (9 * D6)), col = (int)(idx % D6);
    f32x4 s = *(const f32x4*)(p.mod_b + (size_t)layer * D6 + col);
    const float* pp = (const float*)(p.ws + WS_MODP) + idx;
#pragma unroll
    for (int ks = 0; ks < 16; ++ks) s += *(const f32x4*)(pp + (size_t)ks * 4 * 9 * D6);
    *(f32x4*)((float*)(p.ws + WS_MODS) + idx) = s;
}
__device__ __forceinline__ void tables_unit(const Params& p) {
    f32x2* tw = (f32x2*)(p.ws + WS_TW);
    for (int m = tid_fresh(); m < 8192; m += 512) { double s, c; sincospi(-(double)m / 4096.0, &s, &c); tw[m] = (f32x2){(float)c, (float)s}; }
    float* rc = (float*)(p.ws + WS_ROPE);
    for (int i = tid_fresh(); i < 1024; i += 512) { const int pos = i >> 4, q = i & 15; const float inv = powf(10000.0f, -(float)q / 16.0f); const float ang = (float)pos * inv;
        rc[i] = cosf(ang); rc[1024 + i] = sinf(ang); }
}
__device__ __forceinline__ void h2_task(const Params& p, int task) {
    const int lane = tid_fresh() & 63; const int j = task / 4352, r = task % 4352; const int v = r >= 4096, t = v ? r - 4096 : r; const int Lv = v ? 256 : 4096;
    const float tl = (float)t / (float)(Lv - 1);
    const float omega = (float)(2.0 * 3.14159265358979323846 / (double)Lv) * (float)t;
    float feat = 0.f;
    if (lane == 0) feat = tl;
    else if (lane <= 32) { const int bi = (lane - 1) & 15; const float band = 1e-4f + (float)bi * ((15.0f - 1e-4f) / 15.0f); const float a = band * omega; feat = lane <= 16 ? cosf(a) : -sinf(a); }
    const float* w1 = p.hy_f_w1 + (size_t)j * 33 * 64; const float* w2 = p.hy_f_w2 + (size_t)j * 64 * 64;
    float s = p.hy_f_b1[j * 64 + lane];
    for (int f = 0; f < 33; ++f) s += bperm_f(feat, f) * w1[f * 64 + lane];
    const float h1 = sinf(p.hy_f_freq1[j * 64 + lane] * s);
    float s2 = p.hy_f_b2[j * 64 + lane];
    for (int m = 0; m < 64; ++m) s2 += bperm_f(h1, m) * w2[m * 64 + lane];
    const float h2 = sinf(p.hy_f_freq2[j * 64 + lane] * s2);
    const h16 hi = (h16)h2; const h16 lo = (h16)(h2 - (float)hi);
    h16* row = (h16*)(p.ws + WS_H2P) + ((size_t)j * 4352 + r) * 256;
    row[lane] = hi; row[64 + lane] = hi; row[128 + lane] = lo; row[192 + lane] = lo;
}
__device__ __forceinline__ void w3p_unit(const Params& p, int unit) {
    const int j = unit >> 5, c0 = (unit & 31) * 256; const float* w3 = p.hy_f_w3 + (size_t)j * 64 * 8192; h16* dst = (h16*)(p.ws + WS_W3P) + (size_t)j * 8192 * 256;
    for (int i = tid_fresh(); i < 64 * 256; i += 512) { const int m = i >> 8, col = c0 + (i & 255); const float w = w3[(size_t)m * 8192 + col];
        const h16 hi = (h16)w; const h16 lo = (h16)(w - (float)hi); h16* row = dst + (size_t)col * 256; row[m] = hi; row[64 + m] = lo; row[128 + m] = hi; row[192 + m] = lo; }
}
__device__ __forceinline__ void rtab_unit(const Params& p, int unit) {
    const int layer = unit >> 6, c = unit & 63; h16* dst = (h16*)(p.ws + WS_RTAB + (size_t)layer * RTAB_L) + (size_t)c * 5 * 2 * 64 * 8;
    for (int i = tid_fresh(); i < 5 * 2 * 64 * 8; i += 512) { const int jj = i & 7, lane = (i >> 3) & 63, hl = (i >> 9) & 1, ct = i >> 10;
        const int k = 32 * c + 8 * (lane >> 4) + jj, col = 16 * ct + (lane & 15);
        float w = 0.f; if (col < 8) w = p.moe_wg[((size_t)layer * D + k) * 8 + col]; else if (col < 72) w = p.moe_we[((size_t)layer * D + k) * 64 + (col - 8)];
        w *= 256.0f; const h16 hi = (h16)w; const h16 lo = (h16)(w - (float)hi); dst[i] = hl ? lo : hi; }
}
template <int NW>
__device__ __forceinline__ void cvt_tile(const float* src, int ldn, int k0, int n0, h16* dst, int ldk, int mode, LAS float* T) {
    constexpr int P = NW + 1; const int tid = tid_fresh();
#pragma unroll
    for (int ps = 0; ps < 64 * NW / 4 / 512; ++ps) { const int idx = ps * 512 + tid, k = idx / (NW / 4), n4 = idx % (NW / 4);
        const f32x4 v = *(const f32x4*)(src + (size_t)(k0 + k) * ldn + n0 + 4 * n4); LAS float* q = T + k * P + 4 * n4; q[0] = v[0]; q[1] = v[1]; q[2] = v[2]; q[3] = v[3]; }
    __syncthreads();
#pragma unroll
    for (int ps = 0; ps < NW * 8 / 512; ++ps) { const int item = ps * 512 + tid, kc = item & 7, n = item >> 3; f16x8 w;
#pragma unroll
        for (int i = 0; i < 8; ++i) w[i] = (h16)T[(8 * kc + i) * P + n];
        const int ng = n0 + n; const int row = mode == 0 ? ng : (8 * (ng >> 2) + (ng & 3) + (mode == 2 ? 4 : 0));
        *(f16x8*)(dst + (size_t)row * ldk + k0 + 8 * kc) = w; }
    __syncthreads();
}
__device__ __forceinline__ void cvt_dense_unit(const Params& p, int unit, LAS float* T) {
    const float* src; h16* dst; int nt, N;
    if (unit < 1536) { src = p.hy_w_in; dst = (h16*)(p.ws + WS_WIN); nt = 24; N = D3; }
    else if (unit < 2048) { unit -= 1536; src = p.hy_w_out; dst = (h16*)(p.ws + WS_WOUT); nt = 8; N = D; }
    else if (unit < 2688) { unit -= 2048; src = p.at_w_qkv; dst = (h16*)(p.ws + WS_WQKV); nt = 10; N = DQKV; }
    else { unit -= 2688; src = p.at_w_o; dst = (h16*)(p.ws + WS_WO); nt = 8; N = D; }
    const int j = unit / (32 * nt), r = unit % (32 * nt), kt = r / nt, ntile = r % nt;
    cvt_tile<256>(src + (size_t)j * D * N, N, kt * 64, ntile * 256, dst + (size_t)j * N * D, D, 0, T);
}
constexpr int CVT_DENSE_UNITS = 3200;
__device__ __forceinline__ void cvt_moe_unit(const Params& p, int layer, int unit, LAS float* T) {
    if (unit < 12288) { const int which = unit >= 6144; if (which) unit -= 6144; const int e = unit / 96, r = unit % 96, kt = r / 3, ntile = r % 3;
        const float* src = (which ? p.moe_w3 : p.moe_w1) + ((size_t)layer * NE + e) * D * DE;
        cvt_tile<128>(src, DE, kt * 64, ntile * 128, (h16*)(p.ws + WS_W13) + (size_t)e * DE2 * D, D, which ? 2 : 1, T); }
    else { unit -= 12288; const int e = unit / 48, r = unit % 48, kt = r / 8, ntile = r % 8;
        const float* src = p.moe_w2 + ((size_t)layer * NE + e) * DE * D;
        cvt_tile<256>(src, D, kt * 64, ntile * 256, (h16*)(p.ws + WS_W2) + (size_t)e * D * DE, DE, 0, T); }
}
constexpr int CVT_MOE_UNITS = 15360;
struct CvtD { const float* src; h16* dst; int mode; };
__device__ __forceinline__ CvtD cvt13_desc(const Params& p, int layer, int unit) {
    const int which = unit >= 6144; if (which) unit -= 6144; const int e = unit / 96, r = unit % 96, kt = r / 3, ntile = r % 3;
    CvtD d; d.src = (which ? p.moe_w3 : p.moe_w1) + ((size_t)layer * NE + e) * D * DE + (size_t)(kt * 64) * DE + ntile * 128;
    d.dst = (h16*)(p.ws + WS_W13) + (size_t)e * DE2 * D + kt * 64; d.mode = (which ? 4 : 0) + 8 * (256 * ntile); return d;
}
__device__ __forceinline__ void cvt13_load(const CvtD& d, f32x4 (&v)[4], int tid) {
#pragma unroll
    for (int ps = 0; ps < 4; ++ps) { const int idx = ps * 512 + tid, k = idx >> 5, n4 = idx & 31; v[ps] = *(const f32x4*)(d.src + (size_t)k * DE + 4 * n4); }
}
__device__ __forceinline__ void cvt13_store(const CvtD& d, const f32x4 (&v)[4], LAS float* T, int tid) {
    constexpr int P = 129;
#pragma unroll
    for (int ps = 0; ps < 4; ++ps) { const int idx = ps * 512 + tid, k = idx >> 5, n4 = idx & 31; LAS float* q = T + k * P + 4 * n4; q[0] = v[ps][0]; q[1] = v[ps][1]; q[2] = v[ps][2]; q[3] = v[ps][3]; }
    __syncthreads();
    const int w3off = d.mode & 7, rg0 = d.mode >> 3;
#pragma unroll
    for (int ps = 0; ps < 2; ++ps) { const int item = ps * 512 + tid, kc = item & 7, n = item >> 3; f16x8 w;
#pragma unroll
        for (int i = 0; i < 8; ++i) w[i] = (h16)T[(8 * kc + i) * P + n];
        const int row = rg0 + 8 * (n >> 2) + (n & 3) + w3off;
        *(f16x8*)(d.dst + (size_t)row * D + 8 * kc) = w; }
    __syncthreads();
}
__device__ __forceinline__ void cvt_moe_share(const Params& p, int layer, int u0, int n, int stride, LAS float* T) {
    const int tid = tid_fresh(); const int n13 = n < 12288 ? n : 12288;
    int u = u0;
    if (u < n13) {
        CvtD dA = cvt13_desc(p, layer, u), dB = dA, dC = dA; f32x4 vA[4], vB[4], vC[4];
        cvt13_load(dA, vA, tid);
        if (u + stride < n13) { dB = cvt13_desc(p, layer, u + stride); cvt13_load(dB, vB, tid); }
        for (;;) {
            if (u + 2 * stride < n13) { dC = cvt13_desc(p, layer, u + 2 * stride); cvt13_load(dC, vC, tid); }
            cvt13_store(dA, vA, T, tid); u += stride; if (u >= n13) break;
            if (u + 2 * stride < n13) { dA = cvt13_desc(p, layer, u + 2 * stride); cvt13_load(dA, vA, tid); }
            cvt13_store(dB, vB, T, tid); u += stride; if (u >= n13) break;
            if (u + 2 * stride < n13) { dB = cvt13_desc(p, layer, u + 2 * stride); cvt13_load(dB, vB, tid); }
            cvt13_store(dC, vC, T, tid); u += stride; if (u >= n13) break;
        }
    }
    for (; u < n; u += stride) cvt_moe_unit(p, layer, u, T);
}

template <int NR, bool FINAL>
__device__ __forceinline__ void n1_rows(const Params& p, int layer, int r0, int rstride, int lane) {
    float* xres = (float*)(p.ws + WS_XRES); h16* hb = (h16*)(p.ws + WS_HBUF); const h16* yc = (const h16*)(p.ws + WS_YC); const float* mods = (const float*)(p.ws + WS_MODS);
    f32x4 v[NR][8]; f16x4 ya[NR][8], yb[NR][8];
    const bool comb = FINAL || layer > 0; const int lprev = FINAL ? 3 : layer - 1;
#pragma unroll
    for (int q = 0; q < NR; ++q) { const int r = r0 + q * rstride;
        const float* src = (!FINAL && layer == 0) ? (r < TL ? p.x + (size_t)r * D : p.ctx + (size_t)(r - TL) * D) : xres + (size_t)r * D;
#pragma unroll
        for (int c = 0; c < 8; ++c) v[q][c] = *(const f32x4*)(src + c * 256 + lane * 4);
        if (comb) { const h16* y0 = yc + (size_t)(2 * r) * D; const h16* y1 = y0 + D;
#pragma unroll
            for (int c = 0; c < 8; ++c) { ya[q][c] = *(const f16x4*)(y0 + c * 256 + lane * 4); yb[q][c] = *(const f16x4*)(y1 + c * 256 + lane * 4); } } }
#pragma unroll
    for (int q = 0; q < NR; ++q) { const int r = r0 + q * rstride; const int b = batch_of_row(r);
        if (comb) { const float* g2 = mods + ((size_t)(lprev * 9 + b) * 6 + 5) * D;
#pragma unroll
            for (int c = 0; c < 8; ++c) { const f32x4 g = *(const f32x4*)(g2 + c * 256 + lane * 4);
#pragma unroll
                for (int i = 0; i < 4; ++i) v[q][c][i] += g[i] * ((float)ya[q][c][i] + (float)yb[q][c][i]); } }
        float ss = 0.f;
#pragma unroll
        for (int c = 0; c < 8; ++c) { if (!FINAL) *(f32x4*)(xres + (size_t)r * D + c * 256 + lane * 4) = v[q][c]; ss += v[q][c][0] * v[q][c][0] + v[q][c][1] * v[q][c][1] + v[q][c][2] * v[q][c][2] + v[q][c][3] * v[q][c][3]; }
        ss = wave_sum(ss); const float rs = 1.0f / sqrtf(ss * (1.0f / D) + EPS);
        if (FINAL) {
#pragma unroll
            for (int c = 0; c < 8; ++c) { const int col = c * 256 + lane * 4; const f32x4 g = *(const f32x4*)(p.final_gain + col); *(f32x4*)(p.out + (size_t)r * D + col) = v[q][c] * rs * g; }
        } else {
            const float* sh = mods + ((size_t)(layer * 9 + b) * 6 + 0) * D; const float* sc = sh + D;
#pragma unroll
            for (int c = 0; c < 8; ++c) { const int col = c * 256 + lane * 4; const f32x4 s0 = *(const f32x4*)(sh + col), s1 = *(const f32x4*)(sc + col); f16x4 w;
#pragma unroll
                for (int i = 0; i < 4; ++i) w[i] = (h16)(v[q][c][i] * rs * (1.0f + s1[i]) + s0[i]);
                *(f16x4*)(hb + (size_t)r * D + col) = w; }
        } }
}
template <bool FINAL>
__device__ __forceinline__ void n1_any(const Params& p, int layer) {
    const int tid = tid_fresh(), lane = tid & 63, gw = blockIdx.x * 8 + __builtin_amdgcn_readfirstlane(tid >> 6), nw = gridDim.x * 8; const int nrow = FINAL ? TL : TT;
    int r = gw;
    for (; r + nw < nrow; r += 2 * nw) n1_rows<2, FINAL>(p, layer, r, nw, lane);
    if (r < nrow) n1_rows<1, FINAL>(p, layer, r, nw, lane);
}
__device__ __forceinline__ void n1_phase(const Params& p, int layer) { n1_any<false>(p, layer); }
__device__ __forceinline__ void final_phase(const Params& p) { n1_any<true>(p, 0); }
constexpr int N2_CH = 4;
constexpr int N2_SLOT = N2_CH * 10 * 1024;
constexpr int N2_XT = 2 * N2_SLOT;
constexpr int N2_SC = N2_XT + 8 * 4096;
#ifndef PROBE_N2VAR
#define PROBE_N2VAR 0
#endif
__device__ __forceinline__ void n2_phase(const Params& p, int layer, LAS unsigned char* lds, int ctr_shadow) {
    const bool pv_tail = !(ctr_shadow && (PROBE_N2VAR & 1)), pv_store = !(ctr_shadow && (PROBE_N2VAR & 2)), pv_mma = !(ctr_shadow && (PROBE_N2VAR & 4));
    const int tid = tid_fresh(), lane = tid & 63, wv = __builtin_amdgcn_readfirstlane(tid >> 6), r16 = lane & 15, kg = lane >> 4;
    const int lrow = lane >> 3, lchk = lane & 7;
    const float* xres = (const float*)(p.ws + WS_XRES); h16* hb = (h16*)(p.ws + WS_HBUF); const float* mods = (const float*)(p.ws + WS_MODS);
    const char* rtb = p.ws + WS_RTAB + (size_t)layer * RTAB_L; const float* ssq = (const float*)(p.ws + WS_SSQ);
    int* counters = (int*)(p.ws + WS_CTL) + CTL_CNT + (layer + (ctr_shadow ? 4 : 0)) * NE; int* list = (int*)(p.ws + WS_LIST); float* gate = (float*)(p.ws + WS_GATE);
    LAS float* scr = (LAS float*)lds + wv * (16 * 80);
    LAS float* scl = (LAS float*)(lds + N2_SC); LAS float* shl = scl + D;
    LAS int* hist = (LAS int*)(lds + LDS_MISC); LAS int* hbase = hist + NE;
    LAS unsigned char* xt = lds + N2_XT + wv * 4096;
    const int sxw = ((lrow >> 1) & 1) | (((lrow >> 2) & 1) << 2), sxr = ((r16 >> 1) & 1) | (((r16 >> 2) & 1) << 2);
    const int xw_off = lrow * 128 + 16 * (lchk ^ sxw);
    const int xr_off0 = r16 * 128 + 16 * ((2 * kg) ^ sxr), xr_off1 = r16 * 128 + 16 * ((2 * kg + 1) ^ sxr);
    const int hw_off0 = r16 * 128 + 16 * (kg ^ (r16 & 7)), hw_off1 = r16 * 128 + 16 * ((4 + kg) ^ (r16 & 7));
    const int hr_off = lrow * 128 + 16 * (lchk ^ (lrow & 7));
    const int ntask = (layer == NLAYER - 1 ? TL : TT) / 16, nfull = (int)gridDim.x * 8;
#pragma unroll 1
    for (int round = 0; round < 2; ++round) {
        const int nrem = ntask - nfull;
        if (round == 1 && (int)blockIdx.x >= nrem) break;
        const int task = round == 0 ? (int)blockIdx.x * 8 + wv : nfull + (int)blockIdx.x;
        const bool active = round == 0 ? (task < ntask) : true;
        const int trow = active ? task * 16 : 0;
        const int b = batch_of_row(trow);
        const float* xg0 = xres + (size_t)(trow + lrow) * D + lchk * 4; const float* xg1 = xg0 + (size_t)8 * D;
        h16* hg0 = hb + (size_t)(trow + lrow) * D + lchk * 8; h16* hg1 = hg0 + (size_t)8 * D;
        float rs;
        { const float* sp = ssq + (size_t)(trow + r16) * 32; float t = 0.f;
#pragma unroll
            for (int q = 0; q < 8; ++q) { const f32x4 v = *(const f32x4*)(sp + 4 * q); t += (v[0] + v[1]) + (v[2] + v[3]); }
            rs = 1.0f / sqrtf(t * (1.0f / D) + EPS); }
        f32x4 acc[5];
#pragma unroll
        for (int ct = 0; ct < 5; ++ct) acc[ct] = (f32x4){0.f, 0.f, 0.f, 0.f};
        __syncthreads();
        if (tid < NE) hist[tid] = 0;
        { const float* scb = mods + ((size_t)(layer * 9 + b) * 6 + 4) * D; *(LAS f32x4*)(scl + tid * 4) = *(const f32x4*)(scb + tid * 4); *(LAS f32x4*)(shl + tid * 4) = *(const f32x4*)(scb - D + tid * 4); }
        if (round == 0) {
        f16x8 bq[5];
#pragma unroll
        for (int q = 0; q < 5; ++q) bq[q] = *(const f16x8*)(rtb + (size_t)(5 * wv + q) * 1024 + lane * 16);
#pragma unroll
        for (int q = 0; q < 5; ++q) *(LAS f16x8*)(lds + (5 * wv + q) * 1024 + lane * 16) = bq[q];
#pragma unroll
        for (int q = 0; q < 5; ++q) bq[q] = *(const f16x8*)(rtb + (size_t)N2_SLOT + (size_t)(5 * wv + q) * 1024 + lane * 16);
        f32x4 x0[N2_CH][2], x1[N2_CH][2], x2[N2_CH][2];
#pragma unroll
        for (int s2 = 0; s2 < N2_CH; ++s2) { x0[s2][0] = *(const f32x4*)(xg0 + 32 * s2); x0[s2][1] = *(const f32x4*)(xg1 + 32 * s2);
            x1[s2][0] = *(const f32x4*)(xg0 + 32 * (N2_CH + s2)); x1[s2][1] = *(const f32x4*)(xg1 + 32 * (N2_CH + s2)); }
#define N2_CHUNK(XC, XL, CH) do { const int ch = (CH); \
            __syncthreads(); \
            const int nx2 = (ch + 2 < 64 / N2_CH) ? ch + 2 : ch; \
            {   LAS unsigned char* dst = lds + ((ch + 1) & 1) * N2_SLOT; \
 _Pragma("unroll") \
                for (int q = 0; q < 5; ++q) *(LAS f16x8*)(dst + (5 * wv + q) * 1024 + lane * 16) = bq[q]; } \
            {   const char* src = rtb + (size_t)nx2 * N2_SLOT; \
 _Pragma("unroll") \
                for (int q = 0; q < 5; ++q) bq[q] = *(const f16x8*)(src + (size_t)(5 * wv + q) * 1024 + lane * 16); } \
 _Pragma("unroll") \
            for (int s2 = 0; s2 < N2_CH; ++s2) { const int ko = 32 * (nx2 * N2_CH + s2); XL[s2][0] = *(const f32x4*)(xg0 + ko); XL[s2][1] = *(const f32x4*)(xg1 + ko); } \
            const LAS unsigned char* bs = lds + (ch & 1) * N2_SLOT + lane * 16; \
 _Pragma("unroll") \
            for (int pp = 0; pp < N2_CH / 2; ++pp) { \
 _Pragma("unroll") \
                for (int sp = 0; sp < 2; ++sp) { *(LAS f32x4*)(xt + sp * 2048 + xw_off) = XC[2 * pp + sp][0]; *(LAS f32x4*)(xt + sp * 2048 + 1024 + xw_off) = XC[2 * pp + sp][1]; } \
                f32x4 xf[2][2]; \
 _Pragma("unroll") \
                for (int sp = 0; sp < 2; ++sp) { xf[sp][0] = *(const LAS f32x4*)(xt + sp * 2048 + xr_off0); xf[sp][1] = *(const LAS f32x4*)(xt + sp * 2048 + xr_off1); } \
                f16x8 hk[2]; \
 _Pragma("unroll") \
                for (int sp = 0; sp < 2; ++sp) { \
                    const int s2 = 2 * pp + sp; const int ko = 32 * (ch * N2_CH + s2) + 8 * kg; \
                    const f32x4 c0 = *(const LAS f32x4*)(scl + ko), c1 = *(const LAS f32x4*)(scl + ko + 4), h0 = *(const LAS f32x4*)(shl + ko), h1 = *(const LAS f32x4*)(shl + ko + 4); \
                    f16x8 hi, lo; \
 _Pragma("unroll") \
                    for (int i = 0; i < 4; ++i) { const float a0 = xf[sp][0][i] * rs * (1.0f + c0[i]) + h0[i], a1 = xf[sp][1][i] * rs * (1.0f + c1[i]) + h1[i]; \
                        hi[i] = (h16)a0; lo[i] = (h16)(a0 - (float)hi[i]); hi[4 + i] = (h16)a1; lo[4 + i] = (h16)(a1 - (float)hi[4 + i]); } \
                    hk[sp] = hi; \
                    if (pv_mma) \
 _Pragma("unroll") \
                    for (int ct = 0; ct < 5; ++ct) { const f16x8 whi = *(const LAS f16x8*)(bs + (s2 * 10 + ct * 2 + 0) * 1024), wlo = *(const LAS f16x8*)(bs + (s2 * 10 + ct * 2 + 1) * 1024); \
                        acc[ct] = __builtin_amdgcn_mfma_f32_16x16x32_f16(hi, whi, acc[ct], 0, 0, 0); \
                        acc[ct] = __builtin_amdgcn_mfma_f32_16x16x32_f16(hi, wlo, acc[ct], 0, 0, 0); \
                        acc[ct] = __builtin_amdgcn_mfma_f32_16x16x32_f16(lo, whi, acc[ct], 0, 0, 0); } \
                } \
                *(LAS f16x8*)(xt + hw_off0) = hk[0]; *(LAS f16x8*)(xt + hw_off1) = hk[1]; \
                const f16x8 o0 = *(const LAS f16x8*)(xt + hr_off), o1 = *(const LAS f16x8*)(xt + 1024 + hr_off); \
                if (active && pv_store) { const int ho = 32 * (ch * N2_CH + 2 * pp); *(f16x8*)(hg0 + ho) = o0; *(f16x8*)(hg1 + ho) = o1; } \
            } \
        } while (0)
#pragma unroll 1
        for (int c3 = 0; c3 < 15; c3 += 3) { N2_CHUNK(x0, x2, c3); N2_CHUNK(x1, x0, c3 + 1); N2_CHUNK(x2, x1, c3 + 2); }
        N2_CHUNK(x0, x2, 15);
#undef N2_CHUNK
        } else {
            const char* rtw = rtb + (size_t)(8 * wv) * 10240; const int kb = 256 * wv;
            unsigned loff = (unsigned)lane * 16u; asm volatile("" : "+v"(loff));
            f16x8 bb[10];
            f32x4 xa[2][2][2];
#pragma unroll
            for (int sp = 0; sp < 2; ++sp) { xa[0][sp][0] = *(const f32x4*)(xg0 + kb + 32 * sp); xa[0][sp][1] = *(const f32x4*)(xg1 + kb + 32 * sp); }
#pragma unroll
            for (int pp = 0; pp < 4; ++pp) {
                if (pp < 3) {
#pragma unroll
                    for (int sp = 0; sp < 2; ++sp) { xa[(pp + 1) & 1][sp][0] = *(const f32x4*)(xg0 + kb + 32 * (2 * pp + 2 + sp)); xa[(pp + 1) & 1][sp][1] = *(const f32x4*)(xg1 + kb + 32 * (2 * pp + 2 + sp)); } }
#pragma unroll
                for (int sp = 0; sp < 2; ++sp) { *(LAS f32x4*)(xt + sp * 2048 + xw_off) = xa[pp & 1][sp][0]; *(LAS f32x4*)(xt + sp * 2048 + 1024 + xw_off) = xa[pp & 1][sp][1]; }
                f32x4 xf[2][2];
#pragma unroll
                for (int sp = 0; sp < 2; ++sp) { xf[sp][0] = *(const LAS f32x4*)(xt + sp * 2048 + xr_off0); xf[sp][1] = *(const LAS f32x4*)(xt + sp * 2048 + xr_off1); }
                f16x8 hk[2];
#pragma unroll
                for (int sp = 0; sp < 2; ++sp) {
                    const int st = 2 * pp + sp; const int ko = kb + 32 * st + 8 * kg;
#pragma unroll
                    for (int q = 0; q < 10; ++q) bb[q] = *(const f16x8*)(rtw + (size_t)(st * 10 + q) * 1024 + loff);
                    asm volatile("" ::: "memory");
                    const f32x4 c0 = *(const LAS f32x4*)(scl + ko), c1 = *(const LAS f32x4*)(scl + ko + 4), h0 = *(const LAS f32x4*)(shl + ko), h1 = *(const LAS f32x4*)(shl + ko + 4);
                    f16x8 hi, lo;
#pragma unroll
                    for (int i = 0; i < 4; ++i) { const float a0 = xf[sp][0][i] * rs * (1.0f + c0[i]) + h0[i], a1 = xf[sp][1][i] * rs * (1.0f + c1[i]) + h1[i];
                        hi[i] = (h16)a0; lo[i] = (h16)(a0 - (float)hi[i]); hi[4 + i] = (h16)a1; lo[4 + i] = (h16)(a1 - (float)hi[4 + i]); }
                    hk[sp] = hi;
#pragma unroll
                    for (int ct = 0; ct < 5; ++ct) {
                        acc[ct] = __builtin_amdgcn_mfma_f32_16x16x32_f16(hi, bb[2 * ct], acc[ct], 0, 0, 0);
                        acc[ct] = __builtin_amdgcn_mfma_f32_16x16x32_f16(hi, bb[2 * ct + 1], acc[ct], 0, 0, 0);
                        acc[ct] = __builtin_amdgcn_mfma_f32_16x16x32_f16(lo, bb[2 * ct], acc[ct], 0, 0, 0); }
                }
                *(LAS f16x8*)(xt + hw_off0) = hk[0]; *(LAS f16x8*)(xt + hw_off1) = hk[1];
                const f16x8 o0 = *(const LAS f16x8*)(xt + hr_off), o1 = *(const LAS f16x8*)(xt + 1024 + hr_off);
                if (pv_store) { const int ho = kb + 64 * pp; *(f16x8*)(hg0 + ho) = o0; *(f16x8*)(hg1 + ho) = o1; }
            }
        }
        __syncthreads();
#pragma unroll
        for (int ct = 0; ct < 5; ++ct)
#pragma unroll
            for (int i = 0; i < 4; ++i) scr[(4 * kg + i) * 80 + 16 * ct + r16] = acc[ct][i] * (1.0f / 256.0f);
        asm volatile("s_waitcnt lgkmcnt(0)" ::: "memory");
        int ea = 0, eb = 0, ra = 0, rb = 0; float g1v = 0.f, g2v = 0.f; const bool tok_lane = (round == 0 ? active : wv == 0) && lane < 16 && pv_tail;
        const int nparts = round == 0 ? 1 : 8;
        if (tok_lane) {
            const LAS float* lgr = scr + lane * 80;
#define N2_LG(c) ({ float _t = lgr[(c)]; for (int _w = 1; _w < nparts; ++_w) _t += lgr[_w * 1280 + (c)]; _t; })
            float gmax = -3.0e38f; int gsel = 0; float gl[8];
#pragma unroll
            for (int g = 0; g < 8; ++g) { gl[g] = N2_LG(g) + p.moe_bg[layer * 8 + g]; if (gl[g] > gmax) { gmax = gl[g]; gsel = g; } }
            float gz = 0.f;
#pragma unroll
            for (int g = 0; g < 8; ++g) gz += expf(gl[g] - gmax);
            const float pg = 1.0f / gz;
            float f1 = -3.0e38f, f2 = -3.0e38f; int i1 = 0, i2 = 0;
            for (int q = 0; q < 8; ++q) { const float f = N2_LG(8 + gsel * 8 + q) + p.moe_be[layer * 64 + gsel * 8 + q];
                if (f > f1) { f2 = f1; i2 = i1; f1 = f; i1 = q; } else if (f > f2) { f2 = f; i2 = q; } }
            const float e2 = expf(f2 - f1); g1v = pg / (1.0f + e2); g2v = pg * e2 / (1.0f + e2);
            ea = gsel * 8 + i1; eb = gsel * 8 + i2;
#undef N2_LG
            ra = __hip_atomic_fetch_add(hist + ea, 1, __ATOMIC_RELAXED, __HIP_MEMORY_SCOPE_WORKGROUP); rb = __hip_atomic_fetch_add(hist + eb, 1, __ATOMIC_RELAXED, __HIP_MEMORY_SCOPE_WORKGROUP);
        }
        __syncthreads();
        { const int t2 = tid_fresh(); if (t2 < NE && pv_tail) { const int n = hist[t2]; hbase[t2] = n ? atomicAdd(&counters[t2], n) : 0; } }
        __syncthreads();
        if (tok_lane) { const int tok = task * 16 + lane; const size_t sa = (size_t)ea * LCAP + hbase[ea] + ra, sb = (size_t)eb * LCAP + hbase[eb] + rb;
            list[sa] = 2 * tok; gate[sa] = g1v; list[sb] = 2 * tok + 1; gate[sb] = g2v; }
    }
}
__device__ __forceinline__ void transpose_phase(const Params& p, LAS h16* T) {
    const h16* zt = (const h16*)(p.ws + WS_ZT); h16* z = (h16*)(p.ws + WS_HBUF); const int tid = tid_fresh();
    const int ntile = (D / 64) * (TT / 64);
    for (int tile = blockIdx.x; tile < ntile; tile += gridDim.x) {
        const int td = tile % (D / 64), tt = tile / (D / 64); const int d0 = td * 64, t0 = tt * 64;
        { const int dr = tid >> 3, tc = (tid & 7) * 8; const f16x8 v = *(const f16x8*)(zt + (size_t)(d0 + dr) * TT + t0 + tc);
#pragma unroll
            for (int i = 0; i < 8; ++i) T[(tc + i) * 66 + dr] = v[i]; }
        __syncthreads();
        { const int tr = tid >> 3, dc = (tid & 7) * 8; f16x8 v;
#pragma unroll
            for (int i = 0; i < 8; ++i) v[i] = T[tr * 66 + dc + i];
            *(f16x8*)(z + (size_t)(t0 + tr) * D + d0 + dc) = v; }
        __syncthreads();
    }
}

__device__ __forceinline__ f32x2 cmul(const f32x2 a, const f32x2 b) { return (f32x2){a.x * b.x - a.y * b.y, a.x * b.y + a.y * b.x}; }
__device__ __forceinline__ f32x2 cmulc(const f32x2 a, const f32x2 b) { return (f32x2){a.x * b.x + a.y * b.y, a.y * b.x - a.x * b.y}; }
__device__ __forceinline__ f32x2 cconj(const f32x2 a) { return (f32x2){a.x, -a.y}; }
template <bool INV> __device__ __forceinline__ f32x2 mul_mi(const f32x2 a) { return INV ? (f32x2){-a.y, a.x} : (f32x2){a.y, -a.x}; }
template <bool INV> __device__ __forceinline__ void dft4(f32x2& a, f32x2& b, f32x2& c, f32x2& d) {
    const f32x2 s0 = a + c, s1 = a - c, s2 = b + d, s3 = mul_mi<INV>(b - d);
    a = s0 + s2; b = s1 + s3; c = s0 - s2; d = s1 - s3;
}
template <bool INV, int M> __device__ __forceinline__ f32x2 w16mul(const f32x2 a) {
    constexpr float C1 = 0.92387953251128674f, S1 = 0.38268343236508977f, R = 0.70710678118654752f;
    constexpr float cr = (M == 0) ? 1.f : (M == 1) ? C1 : (M == 2) ? R : (M == 3) ? S1 : (M == 4) ? 0.f : (M == 6) ? -R :   -C1;
    constexpr float ci0 = (M == 0) ? 0.f : (M == 1) ? -S1 : (M == 2) ? -R : (M == 3) ? -C1 : (M == 4) ? -1.f : (M == 6) ? -R :   S1;
    constexpr float ci = INV ? -ci0 : ci0;
    return (f32x2){a.x * cr - a.y * ci, a.x * ci + a.y * cr};
}
template <bool INV> __device__ __forceinline__ void dft16(f32x2 (&v)[16]) {
#pragma unroll
    for (int n2 = 0; n2 < 4; ++n2) dft4<INV>(v[n2], v[4 + n2], v[8 + n2], v[12 + n2]);
    v[5] = w16mul<INV, 1>(v[5]); v[6] = w16mul<INV, 2>(v[6]); v[7] = w16mul<INV, 3>(v[7]);
    v[9] = w16mul<INV, 2>(v[9]); v[10] = w16mul<INV, 4>(v[10]); v[11] = w16mul<INV, 6>(v[11]);
    v[13] = w16mul<INV, 3>(v[13]); v[14] = w16mul<INV, 6>(v[14]); v[15] = w16mul<INV, 9>(v[15]);
#pragma unroll
    for (int k1 = 0; k1 < 4; ++k1) dft4<INV>(v[4 * k1], v[4 * k1 + 1], v[4 * k1 + 2], v[4 * k1 + 3]);
    f32x2 t;
    t = v[1]; v[1] = v[4]; v[4] = t; t = v[2]; v[2] = v[8]; v[8] = t; t = v[3]; v[3] = v[12]; v[12] = t;
    t = v[6]; v[6] = v[9]; v[9] = t; t = v[7]; v[7] = v[13]; v[13] = t; t = v[11]; v[11] = v[14]; v[14] = t;
}
__device__ __forceinline__ int fphys(int i) { return i + (i >> 4); }
__device__ __forceinline__ f32x2 w32c(int j) {
    constexpr float c[16] = {1.f, 0.98078528040323043f, 0.92387953251128674f, 0.83146961230254524f, 0.70710678118654752f, 0.55557023301960218f, 0.38268343236508977f, 0.19509032201612825f,
                             0.f, -0.19509032201612825f, -0.38268343236508977f, -0.55557023301960218f, -0.70710678118654752f, -0.83146961230254524f, -0.92387953251128674f, -0.98078528040323043f};
    constexpr float s[16] = {0.f, 0.19509032201612825f, 0.38268343236508977f, 0.55557023301960218f, 0.70710678118654752f, 0.83146961230254524f, 0.92387953251128674f, 0.98078528040323043f,
                             1.f, 0.98078528040323043f, 0.92387953251128674f, 0.83146961230254524f, 0.70710678118654752f, 0.55557023301960218f, 0.38268343236508977f, 0.19509032201612825f};
    return (f32x2){c[j], -s[j]};
}
template <int S>
__device__ __forceinline__ void fft_fwd0(const f32x2 (&xe)[16], const f32x2 (&xo)[16], LAS f32x2* E, LAS f32x2* O, int t, const f32x2* tw) {
    const f32x2 u = tw[t * (256 / S)]; const f32x2 u2 = cmul(u, u);
    f32x2 y[16];
#pragma unroll
    for (int j = 0; j < 16; ++j) y[j] = xe[j];
    dft16<false>(y);
    constexpr int QS = S + S / 16;
    LAS f32x2* Eb = E + fphys(t); LAS f32x2* Ob = O + fphys(t);
    f32x2 pw = u2; Eb[0] = y[0];
#pragma unroll
    for (int q = 1; q < 16; ++q) { Eb[QS * q] = cmul(y[q], pw); pw = cmul(pw, u2); }
#pragma unroll
    for (int j = 0; j < 16; ++j) y[j] = cmul(xo[j], w32c(j));
    dft16<false>(y);
    pw = u;
#pragma unroll
    for (int q = 0; q < 16; ++q) { Ob[QS * q] = cmul(y[q], pw); pw = cmul(pw, u2); }
}
template <bool INV> __device__ __forceinline__ void fft_pass1(LAS f32x2* A, int tau, const f32x2* tw) {
    const int i = tau & 15, base = (tau >> 4) << 8; const f32x2 u0 = tw[32 * i]; const f32x2 u = INV ? cconj(u0) : u0;
    f32x2 y[16]; LAS f32x2* Ab = A + fphys(base + i);
#pragma unroll
    for (int j = 0; j < 16; ++j) y[j] = Ab[17 * j];
    if (INV) { f32x2 pw = u;
#pragma unroll
        for (int q = 1; q < 16; ++q) { y[q] = cmul(y[q], pw); pw = cmul(pw, u); } }
    dft16<INV>(y);
    if (!INV) { f32x2 pw = u;
#pragma unroll
        for (int q = 1; q < 16; ++q) { y[q] = cmul(y[q], pw); pw = cmul(pw, u); } }
#pragma unroll
    for (int j = 0; j < 16; ++j) Ab[17 * j] = y[j];
}
template <bool INV> __device__ __forceinline__ void fft_pass1_pair(LAS f32x2* A, LAS f32x2* B, int tau, const f32x2* tw) {
    const int i = tau & 15, base = (tau >> 4) << 8; const f32x2 u0 = tw[32 * i]; const f32x2 u = INV ? cconj(u0) : u0;
    f32x2 y[16], z[16]; LAS f32x2* Ab = A + fphys(base + i); LAS f32x2* Bb = B + fphys(base + i);
#pragma unroll
    for (int j = 0; j < 16; ++j) y[j] = Ab[17 * j];
#pragma unroll
    for (int j = 0; j < 16; ++j) z[j] = Bb[17 * j];
    f32x2 pwr[16]; pwr[1] = u;
#pragma unroll
    for (int q = 2; q < 16; ++q) pwr[q] = cmul(pwr[q - 1], u);
    if (INV) {
#pragma unroll
        for (int q = 1; q < 16; ++q) y[q] = cmul(y[q], pwr[q]); }
    dft16<INV>(y);
    if (!INV) {
#pragma unroll
        for (int q = 1; q < 16; ++q) y[q] = cmul(y[q], pwr[q]); }
#pragma unroll
    for (int j = 0; j < 16; ++j) Ab[17 * j] = y[j];
    if (INV) {
#pragma unroll
        for (int q = 1; q < 16; ++q) z[q] = cmul(z[q], pwr[q]); }
    dft16<INV>(z);
    if (!INV) {
#pragma unroll
        for (int q = 1; q < 16; ++q) z[q] = cmul(z[q], pwr[q]); }
#pragma unroll
    for (int j = 0; j < 16; ++j) Bb[17 * j] = z[j];
}
__device__ __forceinline__ void fft_fwd2(const LAS f32x2* A, int t, f32x2 (&y)[16]) {
#pragma unroll
    for (int j = 0; j < 16; ++j) y[j] = A[17 * t + j];
    dft16<false>(y);
}
__device__ __forceinline__ void kf_load(const f32x2* kf, f32x4 (&k)[8]) {
#pragma unroll
    for (int j = 0; j < 8; ++j) k[j] = *(const f32x4*)(kf + 2 * j);
}
__device__ __forceinline__ void fft_mid(LAS f32x2* A, int t, const f32x4 (&k)[8]) {
    f32x2 y[16];
    fft_fwd2(A, t, y);
#pragma unroll
    for (int j = 0; j < 8; ++j) { y[2 * j] = cmul(y[2 * j], (f32x2){k[j][0], k[j][1]}); y[2 * j + 1] = cmul(y[2 * j + 1], (f32x2){k[j][2], k[j][3]}); }
    dft16<true>(y);
#pragma unroll
    for (int j = 0; j < 16; ++j) A[17 * t + j] = y[j];
}
template <int S>
__device__ __forceinline__ void fft_inv0(const LAS f32x2* E, const LAS f32x2* O, int t, const f32x2* tw, f32x2 (&out)[16]) {
    const f32x2 u = tw[t * (256 / S)]; const f32x2 u2 = cmul(u, u);
    f32x2 y[16];
    constexpr int QS = S + S / 16;
    const LAS f32x2* Eb = E + fphys(t); const LAS f32x2* Ob = O + fphys(t);
    f32x2 pw = u2; y[0] = Eb[0];
#pragma unroll
    for (int q = 1; q < 16; ++q) { y[q] = cmulc(Eb[QS * q], pw); pw = cmul(pw, u2); }
    dft16<true>(y);
#pragma unroll
    for (int j = 0; j < 16; ++j) out[j] = y[j];
    pw = u;
#pragma unroll
    for (int q = 0; q < 16; ++q) { y[q] = cmulc(Ob[QS * q], pw); pw = cmul(pw, u2); }
    dft16<true>(y);
#pragma unroll
    for (int j = 0; j < 16; ++j) out[j] += cmulc(y[j], w32c(j));
}
__device__ __forceinline__ float hy_absdelta(int d) { return fabsf(-3.0701134573253943f + (-15.350567286626973f + 3.0701134573253943f) * ((float)d / 2047.0f)); }

__device__ __forceinline__ void filt_fft_phase(const Params& p, LAS unsigned char* lds) {
    const int tid = tid_fresh();
    const f32x2* tw = (const f32x2*)(p.ws + WS_TW);
    {
        const int grp = tid >> 8, tau = tid & 255;
        LAS f32x2* E = (LAS f32x2*)(lds + grp * 69632); LAS f32x2* O = E + 4352; LAS float* red = (LAS float*)(lds + LDS_MISC) + grp * 8;
        for (int pb = blockIdx.x * 2 + grp; pb < 2 * 2 * 2048; pb += gridDim.x * 2) {
            const int d = pb & 2047, n = (pb >> 11) & 1, j = pb >> 12;
            const float* tf = (const float*)(p.ws + WS_TAPS) + ((size_t)j * 8192 + (size_t)(n * 2 + 0) * D + d) * 4096;
            const float* tb = tf + (size_t)D * 4096;
            const float adel = hy_absdelta(d); const float tscale = 1.0f / 4095.0f;
            f32x2 xe[16], xo[16]; float ss = 0.f;
#pragma unroll
            for (int jj = 0; jj < 16; ++jj) { const int nn = tau + 256 * jj;
                const float klo = tf[nn] * expf(-(float)nn * tscale * adel);
                const int m = 4096 - nn;
                const float khi = (m < 4096) ? tb[m & 4095] * expf(-(float)m * tscale * adel) : 0.f;
                ss += klo * klo + khi * khi; xe[jj] = (f32x2){klo + khi, 0.f}; xo[jj] = (f32x2){klo - khi, 0.f}; }
            ss = wave_sum(ss);
            if ((tid & 63) == 0) red[(tid >> 6) & 3] = ss;
            fft_fwd0<256>(xe, xo, E, O, tau, tw);
            __syncthreads();
            const float tot = red[0] + red[1] + red[2] + red[3];
            const float scale = (1.0f / sqrtf(tot + EPS)) * (1.0f / 8192.0f);
            const float hbs = p.hy_bias[((size_t)j * 2 + n) * D + d] * (1.0f / 8192.0f);
            fft_pass1<false>(E, tau, tw); fft_pass1<false>(O, tau, tw);
            __syncthreads();
            f32x2* kf = (f32x2*)(p.ws + WS_KF) + (size_t)pb * 8192 + (size_t)tau * 16;
            f32x2 y[16];
            fft_fwd2(E, tau, y);
#pragma unroll
            for (int q = 0; q < 8; ++q) *(f32x4*)(kf + 2 * q) = (f32x4){y[2 * q].x * scale + hbs, y[2 * q].y * scale, y[2 * q + 1].x * scale + hbs, y[2 * q + 1].y * scale};
            fft_fwd2(O, tau, y);
#pragma unroll
            for (int q = 0; q < 8; ++q) *(f32x4*)(kf + 4096 + 2 * q) = (f32x4){y[2 * q].x * scale + hbs, y[2 * q].y * scale, y[2 * q + 1].x * scale + hbs, y[2 * q + 1].y * scale};
            __syncthreads();
        }
    }
    {
        const int pr = tid >> 4, i = tid & 15;
        LAS f32x2* E = (LAS f32x2*)(lds + pr * 4352); LAS f32x2* O = E + 272;
        for (int it = blockIdx.x; it < 256; it += gridDim.x) {
            const int pb = it * 32 + pr; const int d = pb & 2047, n = (pb >> 11) & 1, j = pb >> 12;
            const float* tf = (const float*)(p.ws + WS_TAPSC) + ((size_t)j * 8192 + (size_t)(n * 2 + 0) * D + d) * 256;
            const float* tb = tf + (size_t)D * 256;
            const float adel = hy_absdelta(d); const float tscale = 1.0f / 255.0f;
            f32x2 xe[16], xo[16]; float ss = 0.f;
#pragma unroll
            for (int jj = 0; jj < 16; ++jj) { const int nn = i + 16 * jj;
                const float klo = tf[nn] * expf(-(float)nn * tscale * adel);
                const int m = 256 - nn;
                const float khi = (m < 256) ? tb[m & 255] * expf(-(float)m * tscale * adel) : 0.f;
                ss += klo * klo + khi * khi; xe[jj] = (f32x2){klo + khi, 0.f}; xo[jj] = (f32x2){klo - khi, 0.f}; }
            ss += shx(ss, 8); ss += shx(ss, 4); ss += shx(ss, 2); ss += shx(ss, 1);
            const float scale = (1.0f / sqrtf(ss + EPS)) * (1.0f / 512.0f);
            const float hbs = p.hy_bias[((size_t)j * 2 + n) * D + d] * (1.0f / 512.0f);
            fft_fwd0<16>(xe, xo, E, O, i, tw);
            __syncthreads();
            f32x2* kf = (f32x2*)(p.ws + WS_KFC) + (size_t)pb * 512 + (size_t)i * 16;
            f32x2 y[16];
            fft_fwd2(E, i, y);
#pragma unroll
            for (int q = 0; q < 8; ++q) *(f32x4*)(kf + 2 * q) = (f32x4){y[2 * q].x * scale + hbs, y[2 * q].y * scale, y[2 * q + 1].x * scale + hbs, y[2 * q + 1].y * scale};
            fft_fwd2(O, i, y);
#pragma unroll
            for (int q = 0; q < 8; ++q) *(f32x4*)(kf + 256 + 2 * q) = (f32x4){y[2 * q].x * scale + hbs, y[2 * q].y * scale, y[2 * q + 1].x * scale + hbs, y[2 * q + 1].y * scale};
            __syncthreads();
        }
    }
}

__device__ __forceinline__ float conv3_lds(const LAS h16* row, int n, float w0, float w1, float w2, float b) { return (float)row[n - 1] * w0 + (float)row[n] * w1 + (float)row[n + 1] * w2 + b; }
constexpr int ST_P = 4112, STS_P = 272;

#ifndef PROBE_CVAR
#define PROBE_CVAR 0
#endif
__device__ __forceinline__ void conv_phase(const Params& p, int jl, LAS unsigned char* lds, int pvar = 0, int cvt_layer = -1, int cvt_n = 0) {
    const int tid = tid_fresh(); const bool cv_outer = !(pvar && (PROBE_CVAR & 1)), cv_inner = !(pvar && (PROBE_CVAR & 2));
    const f32x2* tw = (const f32x2*)(p.ws + WS_TW);
    const h16* ut = (const h16*)(p.ws + WS_UT); h16* zt = (h16*)(p.ws + WS_ZT);
    const float* cw = p.hy_conv_w + (size_t)jl * 3 * D3; const float* cb = p.hy_conv_b + (size_t)jl * D3;
    {
        const int grp = tid >> 8, tau = tid & 255;
        LAS f32x2* E = (LAS f32x2*)(lds + grp * 69632); LAS f32x2* O = E + 4352; LAS h16* ST = (LAS h16*)E;
        int uit = 0; const int utrig = 4 * (((int)blockIdx.x >> 3) & 3);
        for (int unit = blockIdx.x; unit < 4096; unit += gridDim.x, ++uit) {
            if (cvt_layer >= 0 && uit == utrig) { __syncthreads(); cvt_moe_share(p, cvt_layer, blockIdx.x, cvt_n, gridDim.x, (LAS float*)lds); }
            const int ux = unit & 7, uj = unit >> 3; const int hq = uj & 1, d = (uj >> 1) * 8 + ux; const size_t col0 = (size_t)(4 * hq + 2 * grp) * 4096;
            const f32x2* kfb = (const f32x2*)(p.ws + WS_KF) + ((size_t)(jl * 2) * 2048 + d) * 8192 + (size_t)tau * 16;
            f16x8 raw[2][2][2], raw2[2][2];
#pragma unroll
            for (int sq = 0; sq < 2; ++sq)
#pragma unroll
                for (int bb = 0; bb < 2; ++bb)
#pragma unroll
                    for (int k = 0; k < 2; ++k) raw[sq][bb][k] = *(const f16x8*)(ut + (size_t)(sq * D + d) * TT + col0 + (size_t)bb * 4096 + (size_t)(tau + 256 * k) * 8);
            __syncthreads();
#pragma unroll
            for (int sq = 0; sq < 2; ++sq)
#pragma unroll
                for (int bb = 0; bb < 2; ++bb)
#pragma unroll
                    for (int k = 0; k < 2; ++k) *(LAS f16x8*)(ST + (sq * 2 + bb) * ST_P + 8 + (tau + 256 * k) * 8) = raw[sq][bb][k];
            if (tau < 4) { ST[tau * ST_P + 7] = (h16)0.f; ST[tau * ST_P + 8 + 4096] = (h16)0.f; }
            __syncthreads();
            f32x2 xin[16], gk[16], y[16];
            { const float w0 = cw[d], w1 = cw[D3 + d], w2 = cw[2 * D3 + d], bv = cb[d]; const float g0 = cw[D + d], g1 = cw[D3 + D + d], g2 = cw[2 * D3 + D + d], gb = cb[D + d];
#pragma unroll
                for (int jj = 0; jj < 16; ++jj) { const int nn = tau + 256 * jj;
                    xin[jj] = (f32x2){conv3_lds(ST + 8, nn, w0, w1, w2, bv), conv3_lds(ST + ST_P + 8, nn, w0, w1, w2, bv)};
                    gk[jj] = (f32x2){conv3_lds(ST + 2 * ST_P + 8, nn, g0, g1, g2, gb), conv3_lds(ST + 3 * ST_P + 8, nn, g0, g1, g2, gb)}; } }
            __syncthreads();
#pragma unroll 1
            for (int ord = 0; ord < 2; ++ord) {
                if (cv_outer) fft_fwd0<256>(xin, xin, E, O, tau, tw);
                const f32x2* kf = kfb + (size_t)ord * 2048 * 8192; f32x4 kfe[8], kfo[8];
                kf_load(kf, kfe);
                __syncthreads();
                if (cv_inner) fft_pass1_pair<false>(E, O, tau, tw);
                kf_load(kf + 4096, kfo);
                __syncthreads();
                if (cv_inner) { fft_mid(E, tau, kfe); fft_mid(O, tau, kfo); }
                if (ord == 0) {
#pragma unroll
                    for (int bb = 0; bb < 2; ++bb)
#pragma unroll
                        for (int k = 0; k < 2; ++k) raw2[bb][k] = *(const f16x8*)(ut + (size_t)(2 * D + d) * TT + col0 + (size_t)bb * 4096 + (size_t)(tau + 256 * k) * 8); }
                __syncthreads();
                if (cv_inner) fft_pass1_pair<true>(E, O, tau, tw);
                __syncthreads();
                if (cv_outer) fft_inv0<256>(E, O, tau, tw, y); else {
#pragma unroll
                    for (int jj = 0; jj < 16; ++jj) y[jj] = xin[jj]; }
#pragma unroll
                for (int jj = 0; jj < 16; ++jj) xin[jj] = gk[jj] * y[jj];
                if (ord == 0) {
                    __syncthreads();
#pragma unroll
                    for (int bb = 0; bb < 2; ++bb)
#pragma unroll
                        for (int k = 0; k < 2; ++k) *(LAS f16x8*)(ST + bb * ST_P + 8 + (tau + 256 * k) * 8) = raw2[bb][k];
                    if (tau < 2) { ST[tau * ST_P + 7] = (h16)0.f; ST[tau * ST_P + 8 + 4096] = (h16)0.f; }
                    __syncthreads();
                    const float g0 = cw[2 * D + d], g1 = cw[D3 + 2 * D + d], g2 = cw[2 * D3 + 2 * D + d], gb = cb[2 * D + d];
#pragma unroll
                    for (int jj = 0; jj < 16; ++jj) { const int nn = tau + 256 * jj; gk[jj] = (f32x2){conv3_lds(ST + 8, nn, g0, g1, g2, gb), conv3_lds(ST + ST_P + 8, nn, g0, g1, g2, gb)}; }
                    __syncthreads();
                }
            }
            h16* o0 = zt + (size_t)d * TT + col0; h16* o1 = o0 + 4096;
#pragma unroll
            for (int jj = 0; jj < 16; ++jj) { const int nn = tau + 256 * jj; o0[nn] = (h16)xin[jj].x; o1[nn] = (h16)xin[jj].y; }
        }
    }
    {
        const int pr = tid >> 4, i = tid & 15, c8 = pr >> 2, bp = pr & 3;
        LAS f32x2* E = (LAS f32x2*)(lds + pr * 4352); LAS f32x2* O = E + 272; LAS h16* ST = (LAS h16*)lds;
        for (int unit = blockIdx.x; unit < 256; unit += gridDim.x) {
            const int d0 = unit * 8, d = d0 + c8;
            const f32x2* kfb = (const f32x2*)(p.ws + WS_KFC) + ((size_t)(jl * 2) * 2048 + d) * 512 + (size_t)i * 16;
            f16x8 raw[3][4];
#pragma unroll
            for (int sq = 0; sq < 3; ++sq)
#pragma unroll
                for (int k = 0; k < 4; ++k) { const int q = tid + 512 * k, row = q >> 5, ch = q & 31;
                    raw[sq][k] = *(const f16x8*)(ut + (size_t)(sq * D + d0 + (row >> 3)) * TT + TL + (row & 7) * 256 + ch * 8); }
            __syncthreads();
#pragma unroll
            for (int sq = 0; sq < 2; ++sq)
#pragma unroll
                for (int k = 0; k < 4; ++k) { const int q = tid + 512 * k, row = q >> 5, ch = q & 31; *(LAS f16x8*)(ST + (sq * 64 + row) * STS_P + 8 + ch * 8) = raw[sq][k]; }
            if (tid < 128) { ST[tid * STS_P + 7] = (h16)0.f; ST[tid * STS_P + 8 + 256] = (h16)0.f; }
            __syncthreads();
            f32x2 xin[16], gk[16], y[16];
            { const float w0 = cw[d], w1 = cw[D3 + d], w2 = cw[2 * D3 + d], bv = cb[d]; const float g0 = cw[D + d], g1 = cw[D3 + D + d], g2 = cw[2 * D3 + D + d], gb = cb[D + d];
                const LAS h16* r0 = ST + (c8 * 8 + 2 * bp) * STS_P + 8; const LAS h16* r1 = r0 + 64 * STS_P;
#pragma unroll
                for (int jj = 0; jj < 16; ++jj) { const int nn = i + 16 * jj;
                    xin[jj] = (f32x2){conv3_lds(r0, nn, w0, w1, w2, bv), conv3_lds(r0 + STS_P, nn, w0, w1, w2, bv)};
                    gk[jj] = (f32x2){conv3_lds(r1, nn, g0, g1, g2, gb), conv3_lds(r1 + STS_P, nn, g0, g1, g2, gb)}; } }
            __syncthreads();
#pragma unroll 1
            for (int ord = 0; ord < 2; ++ord) {
                const f32x2* kf = kfb + (size_t)ord * 2048 * 512; f32x4 kfe[8], kfo[8];
                fft_fwd0<16>(xin, xin, E, O, i, tw);
                __syncthreads();
                kf_load(kf, kfe); fft_mid(E, i, kfe); kf_load(kf + 256, kfo); fft_mid(O, i, kfo);
                __syncthreads();
                fft_inv0<16>(E, O, i, tw, y);
#pragma unroll
                for (int jj = 0; jj < 16; ++jj) xin[jj] = gk[jj] * y[jj];
                if (ord == 0) {
                    __syncthreads();
#pragma unroll
                    for (int k = 0; k < 4; ++k) { const int q = tid + 512 * k, row = q >> 5, ch = q & 31; *(LAS f16x8*)(ST + row * STS_P + 8 + ch * 8) = raw[2][k]; }
                    if (tid < 64) { ST[tid * STS_P + 7] = (h16)0.f; ST[tid * STS_P + 8 + 256] = (h16)0.f; }
                    __syncthreads();
                    const float g0 = cw[2 * D + d], g1 = cw[D3 + 2 * D + d], g2 = cw[2 * D3 + 2 * D + d], gb = cb[2 * D + d];
                    const LAS h16* r0 = ST + (c8 * 8 + 2 * bp) * STS_P + 8;
#pragma unroll
                    for (int jj = 0; jj < 16; ++jj) { const int nn = i + 16 * jj; gk[jj] = (f32x2){conv3_lds(r0, nn, g0, g1, g2, gb), conv3_lds(r0 + STS_P, nn, g0, g1, g2, gb)}; }
                    __syncthreads();
                }
            }
            h16* o0 = zt + (size_t)d * TT + TL + (2 * bp) * 256; h16* o1 = o0 + 256;
#pragma unroll
            for (int jj = 0; jj < 16; ++jj) { const int nn = i + 16 * jj; o0[nn] = (h16)xin[jj].x; o1[nn] = (h16)xin[jj].y; }
        }
    }
}

constexpr int AT_KP = 72, AT_VP = 68;
__device__ __forceinline__ void attn_phase(const Params& p, int jl, bool with_ctx_out, LAS unsigned char* lds, int cvt_layer = -1, int cvt_n = 0) {
    const int tid = tid_fresh(), wv = tid >> 6, lane = tid & 63, r32 = lane & 31, hh = lane >> 5;
    LAS h16* Ks = (LAS h16*)lds; LAS h16* Vs = (LAS h16*)(lds + 64 * AT_KP * 2);
    const h16* qk = (const h16*)(p.ws + WS_QK); const h16* vt = (const h16*)(p.ws + WS_VT); h16* ob = (h16*)(p.ws + WS_HBUF);
    const float* rcos = (const float*)(p.ws + WS_ROPE); const float* rsin = rcos + 1024;
    const int nunit = 2048 + (with_ctx_out ? 128 : 0);
    int uit = 0; const int utrig = 2 * (((int)blockIdx.x >> 3) & 3);
    for (int unit = blockIdx.x; unit < nunit; unit += gridDim.x, ++uit) {
        if (cvt_layer >= 0 && uit == utrig) { __syncthreads(); cvt_moe_share(p, cvt_layer, blockIdx.x, cvt_n, gridDim.x, (LAS float*)lds); }
        int kind, b, g, qb;
        if (unit < 2048) { kind = 0; qb = unit & 63; g = (unit >> 6) & 3; b = unit >> 8; } else { const int u2 = unit - 2048; kind = 1; qb = u2 & 3; g = (u2 >> 2) & 3; b = u2 >> 4; }
        const int head = g * 8 + wv;
        const int qrow0 = kind ? (TL + b * 256 + qb * 64) : (b * 4096 + qb * 64);
        const int ctxrow0 = TL + b * 256;
        f16x8 qf[2][4];
#pragma unroll
        for (int qt = 0; qt < 2; ++qt) {
            f32x4 qv[4][2];
            const h16* qp = qk + (size_t)(qrow0 + 32 * qt + r32) * DQK + head * 64 + 8 * hh;
#pragma unroll
            for (int ks = 0; ks < 4; ++ks) { const f16x8 t = *(const f16x8*)(qp + 16 * ks);
#pragma unroll
                for (int i = 0; i < 4; ++i) { qv[ks][0][i] = (float)t[i]; qv[ks][1][i] = (float)t[4 + i]; } }
            if (kind == 0) {
                const int colpos = 32 * qt + r32;
#pragma unroll
                for (int a = 0; a < 2; ++a) { const int pos = a ? colpos : qb; const float* cp = rcos + pos * 16 + 8 * hh; const float* sp = rsin + pos * 16 + 8 * hh;
#pragma unroll
                    for (int e = 0; e < 2; ++e) { const f32x4 c = *(const f32x4*)(cp + 4 * e), s = *(const f32x4*)(sp + 4 * e);
                        const f32x4 x1 = qv[2 * a][e], x2 = qv[2 * a + 1][e]; qv[2 * a][e] = x1 * c - x2 * s; qv[2 * a + 1][e] = x2 * c + x1 * s; } }
            }
#pragma unroll
            for (int ks = 0; ks < 4; ++ks)
#pragma unroll
                for (int i = 0; i < 4; ++i) { qf[qt][ks][i] = (h16)(qv[ks][0][i] * (0.125f * 1.4426950408889634f)); qf[qt][ks][4 + i] = (h16)(qv[ks][1][i] * (0.125f * 1.4426950408889634f)); }
        }
        const float sink = p.at_sink[jl * 32 + head] * 1.4426950408889634f;
        float mrun[2] = {sink, sink}, lrun[2] = {hh == 0 ? 1.f : 0.f, hh == 0 ? 1.f : 0.f};
        f32x16 oacc[2][2];
#pragma unroll
        for (int a = 0; a < 2; ++a)
#pragma unroll
            for (int c = 0; c < 2; ++c)
#pragma unroll
                for (int i = 0; i < 16; ++i) oacc[a][c][i] = 0.f;
        const int t_lo = kind ? 0 : (qb < 2 ? 2 - qb : 0), t_hi = kind ? -1 : (65 - qb < 4 ? 65 - qb : 4); const int nwin = t_hi - t_lo + 1, nv = nwin + 4;
        const bool krole = tid < 256; const int kkey = tid >> 2, kcp = tid & 3, kdA = (kcp & 1) * 8 + (kcp >> 1) * 32; const int vdim = (tid - 256) >> 2, vkc = tid & 3;
        f16x8 ld0, ld1;
#define AT_TILE(sidx, KROW0, MASK, ROPE) do { if ((sidx) < nwin) { const int _ti = t_lo + (sidx); KROW0 = b * 4096 + qb * 64 - 128 + 64 * _ti; ROPE = true; MASK = (_ti == 0) ? 1 : (_ti == 4) ? 2 : 0; } \
            else { KROW0 = ctxrow0 + 64 * ((sidx) - nwin); ROPE = false; MASK = 0; } } while (0)
#define AT_LOAD(KROW0) do { if (krole) { const h16* kp = qk + (size_t)((KROW0) + kkey) * DQK + D + g * 64 + kdA; ld0 = *(const f16x8*)kp; ld1 = *(const f16x8*)(kp + 16); } \
            else { const h16* vp = vt + (size_t)(g * 64 + vdim) * TT + (KROW0) + 16 * vkc; ld0 = *(const f16x8*)vp; ld1 = *(const f16x8*)(vp + 8); } } while (0)
        { int kr0, mk; bool rp; AT_TILE(0, kr0, mk, rp); (void)mk; (void)rp; AT_LOAD(kr0); }
#pragma unroll 1
        for (int sx = 0; sx < nv; ++sx) {
            int krow0, mask; bool rope; AT_TILE(sx, krow0, mask, rope);
            __syncthreads();
            if (krole) {
                f16x8 o1 = ld0, o2 = ld1;
                if (rope) { const int kpos = (krow0 - b * 4096) + kkey; const int pos = (kcp >> 1) ? (kpos & 63) : (kpos >> 6);
                    const float* cpp = rcos + pos * 16 + (kcp & 1) * 8; const float* spp = rsin + pos * 16 + (kcp & 1) * 8;
#pragma unroll
                    for (int i = 0; i < 8; ++i) { const float c = cpp[i], s = spp[i], x1 = (float)ld0[i], x2 = (float)ld1[i]; o1[i] = (h16)(x1 * c - x2 * s); o2[i] = (h16)(x2 * c + x1 * s); } }
                *(LAS f16x8*)(Ks + kkey * AT_KP + kdA) = o1; *(LAS f16x8*)(Ks + kkey * AT_KP + kdA + 16) = o2;
            } else {
                LAS h16* dst = Vs + vdim * AT_VP + 16 * vkc;
                *(LAS f16x4*)(dst) = (f16x4){ld0[0], ld0[1], ld0[2], ld0[3]}; *(LAS f16x4*)(dst + 4) = (f16x4){ld0[4], ld0[5], ld0[6], ld0[7]};
                *(LAS f16x4*)(dst + 8) = (f16x4){ld1[0], ld1[1], ld1[2], ld1[3]}; *(LAS f16x4*)(dst + 12) = (f16x4){ld1[4], ld1[5], ld1[6], ld1[7]};
            }
            if (sx + 1 < nv) { int kr1, mk1; bool rp1; AT_TILE(sx + 1, kr1, mk1, rp1); (void)mk1; (void)rp1; AT_LOAD(kr1); }
            __syncthreads();
#pragma unroll
            for (int qt = 0; qt < 2; ++qt) {
                f32x16 sacc[2];
#pragma unroll
                for (int kt = 0; kt < 2; ++kt)
#pragma unroll
                    for (int i = 0; i < 16; ++i) sacc[kt][i] = 0.f;
#pragma unroll
                for (int ks = 0; ks < 4; ++ks)
#pragma unroll
                    for (int kt = 0; kt < 2; ++kt) { const f16x8 kf = *(const LAS f16x8*)(Ks + (32 * kt + r32) * AT_KP + 16 * ks + 8 * hh);
                        sacc[kt] = __builtin_amdgcn_mfma_f32_32x32x16_f16(kf, qf[qt][ks], sacc[kt], 0, 0, 0); }
                const int qq = 32 * qt + r32; float tmax = -3.0e38f;
                if (mask != 0) {
#pragma unroll
                for (int kt = 0; kt < 2; ++kt)
#pragma unroll
                    for (int i = 0; i < 16; ++i) { const int kk = 32 * kt + (i & 3) + 8 * (i >> 2) + 4 * hh; const bool dead = (mask == 1) ? (kk < qq) : (kk > qq); if (dead) sacc[kt][i] = -1.0e30f; } }
#pragma unroll
                for (int kt = 0; kt < 2; ++kt)
#pragma unroll
                    for (int i = 0; i < 16; ++i) tmax = fmaxf(tmax, sacc[kt][i]);
                tmax = fmaxf(tmax, shx(tmax, 32));
                const float mnew = fmaxf(mrun[qt], tmax); const float alpha = __builtin_amdgcn_exp2f(mrun[qt] - mnew); mrun[qt] = mnew;
                float psum = 0.f; f16x8 pf[2][2];
#pragma unroll
                for (int kt = 0; kt < 2; ++kt)
#pragma unroll
                    for (int s2 = 0; s2 < 2; ++s2)
#pragma unroll
                        for (int jj = 0; jj < 8; ++jj) { const float pv = __builtin_amdgcn_exp2f(sacc[kt][8 * s2 + jj] - mnew); psum += pv; pf[kt][s2][jj] = (h16)pv; }
                lrun[qt] = lrun[qt] * alpha + psum;
                if (__builtin_amdgcn_ballot_w64(alpha != 1.0f) != 0ull) {
#pragma unroll
                for (int dt = 0; dt < 2; ++dt)
#pragma unroll
                    for (int i = 0; i < 16; ++i) oacc[dt][qt][i] *= alpha; }
#pragma unroll
                for (int kt = 0; kt < 2; ++kt)
#pragma unroll
                    for (int s2 = 0; s2 < 2; ++s2)
#pragma unroll
                        for (int dt = 0; dt < 2; ++dt) { const LAS h16* vr = Vs + (32 * dt + r32) * AT_VP + 32 * kt + 16 * s2 + 4 * hh;
                            const f16x4 v0 = *(const LAS f16x4*)vr, v1 = *(const LAS f16x4*)(vr + 8);
                            const f16x8 vf = (f16x8){v0[0], v0[1], v0[2], v0[3], v1[0], v1[1], v1[2], v1[3]};
                            oacc[dt][qt] = __builtin_amdgcn_mfma_f32_32x32x16_f16(vf, pf[kt][s2], oacc[dt][qt], 0, 0, 0); }
            }
        }
#pragma unroll
        for (int qt = 0; qt < 2; ++qt) {
            const float ltot = lrun[qt] + shx(lrun[qt], 32); const float inv = 1.0f / ltot;
            h16* op = ob + (size_t)(qrow0 + 32 * qt + r32) * D + head * 64 + 4 * hh;
#pragma unroll
            for (int dt = 0; dt < 2; ++dt)
#pragma unroll
                for (int q4 = 0; q4 < 4; ++q4) { f16x4 w;
#pragma unroll
                    for (int i = 0; i < 4; ++i) w[i] = (h16)(oacc[dt][qt][4 * q4 + i] * inv);
                    *(f16x4*)(op + 32 * dt + 8 * q4) = w; }
        }
    }
}
#undef AT_TILE
#undef AT_LOAD

constexpr int NPHASE = 35;
#ifndef MK_MULTI
#define MK_MULTI 0
#endif

template <int KIND>
__attribute__((target("no-packed-fp32-ops"))) __global__ void __launch_bounds__(512, 2) hy_fwd(Params p_) {
    extern __shared__ __attribute__((aligned(16))) unsigned char shm[];
    LAS unsigned char* lds = (LAS unsigned char*)shm;
    constexpr bool ALL = KIND < 0;
    const int ph0 = p_.ph0;
    if (threadIdx.x == 0) { *(LAS u32x4*)(lds + LDS_XB) = (u32x4){0u, 0u, 0u, 0u}; }
    __syncthreads();
    XcdBarrier bar;
    if constexpr (ALL) bar = xcd_barrier_post((unsigned*)(p_.ws + WS_CTL), (volatile LAS unsigned*)(lds + LDS_XB));
#ifndef PROBE_SITE
#define PROBE_SITE -1
#endif
#define SITE(k) if constexpr (ALL || KIND == (k)) for (int rep_ = 0; rep_ < ((k) == PROBE_SITE ? 2 : 1); ++rep_) if (const Params& p = *params_fresh(); true)
#define SEAM() do { if constexpr (ALL) xcd_barrier(bar); } while (0)
    const int G = gridDim.x, bid = blockIdx.x;
    SITE(0) {
        for (int u = bid; u < 20353; u += G) {
            if (u < 384) modp_unit(p, u, (LAS float*)lds);
            else if (u == 384) tables_unit(p);
            else if (u < 1473) h2_task(p, (u - 385) * 8 + (tid_fresh() >> 6));
            else if (u < 1537) w3p_unit(p, u - 1473);
            else if (u < 1793) rtab_unit(p, u - 1537);
            else if (u < 4993) cvt_dense_unit(p, u - 1793, (LAS float*)lds);
            else cvt_moe_unit(p, 0, u - 4993, (LAS float*)lds);
        }
        SEAM();
    }
    SITE(1) {
        for (int u = bid; u < 216; u += G) modr_unit(p, u);
        SchedFilt S{p.ws + WS_W3P, p.ws + WS_H2P}; EpiTaps E{(float*)(p.ws + WS_TAPS), (float*)(p.ws + WS_TAPSC)};
        pg8::gemm_phase<EpiTaps, SchedFilt, 0>(lds, 256, S, E);
        SEAM();
    }
#define TAIL_IDLE(nunits) (((nunits) % G) ? G - ((nunits) % G) : 0)
#define CVT_PER_GEMM 20
#pragma unroll 1
    for (int layer = ALL ? 0 : ph0; layer < (ALL ? NLAYER : ph0 + 1); ++layer) {
        const bool hyena = (layer & 1) == 0; const int jl = layer >> 1;
        const int nu1 = hyena ? 24 * 136 : 136 * 10, nu4 = (layer == NLAYER - 1 ? 128 : 136) * 8;
        const int idle1 = TAIL_IDLE(nu1), idle4 = TAIL_IDLE(nu4);
        int cv4 = idle4 * CVT_PER_GEMM, cv1 = idle1 * CVT_PER_GEMM; if (cv4 > CVT_MOE_UNITS / 2) cv4 = CVT_MOE_UNITS / 2; if (cv1 > CVT_MOE_UNITS / 2 - 1) cv1 = CVT_MOE_UNITS / 2 - 1;
        const int cvN0 = CVT_MOE_UNITS - cv1 - cv4, cvN1 = cvN0 + cv1;
        SITE(2) {
            n1_phase(p, layer);
            for (int rep2_ = 0; rep2_ < ((PROBE_SITE == 20 && layer > 0) ? 2 : 1); ++rep2_) {
            if (layer == 0) filt_fft_phase(p, lds);
            else { (void)0; } }
            SEAM();
        }
        SITE(3) {
            if (hyena) { SchedPlain S{24, 136, D, p.ws + WS_WIN + (size_t)jl * D3 * D * 2, p.ws + WS_HBUF}; EpiH16 E{(h16*)(p.ws + WS_UT), TT, nullptr, 0};
                pg8::gemm_phase<EpiH16, SchedPlain, 0>(lds, D, S, E); }
            else { SchedQkv S{p.ws + WS_HBUF, p.ws + WS_WQKV + (size_t)jl * DQKV * D * 2}; EpiH16 E{(h16*)(p.ws + WS_QK), DQK, (h16*)(p.ws + WS_VT), TT};
                pg8::gemm_phase<EpiH16, SchedQkv, 0>(lds, D, S, E); }
            if (layer > 0 && idle1 > 0 && bid >= G - idle1) { cvt_moe_share(p, layer, cvN0 + (bid - (G - idle1)), cvN1, idle1, (LAS float*)lds); }
            SEAM();
        }
        SITE(4) {
#ifdef PROBE_PAR
            for (int rep3_ = 0; rep3_ < (((layer & 1) == PROBE_PAR) ? 2 : 1); ++rep3_)
#endif
            { if (hyena) conv_phase(p, jl, lds, ALL ? 0 : p.ph1, layer > 0 ? layer : -1, cvN0);
            else attn_phase(p, jl, layer != NLAYER - 1, lds, layer, cvN0); }
            SEAM();
        }
        SITE(5) {
            (void)0;
        }
        SITE(6) {
            EpiResid E{(float*)(p.ws + WS_XRES), (const float*)(p.ws + WS_MODS), layer, (float*)(p.ws + WS_SSQ)};
            if (hyena) {
                SchedPlainAT S{layer == NLAYER - 1 ? 128 : 136, 8, D, p.ws + WS_ZT, p.ws + WS_WOUT + (size_t)jl * D * D * 2};
                pg8::gemm_phase<EpiResid, SchedPlainAT, 2>(lds, D, S, E, TT);
            } else {
                SchedPlain S{layer == NLAYER - 1 ? 128 : 136, 8, D, p.ws + WS_HBUF, p.ws + WS_WO + (size_t)jl * D * D * 2};
                pg8::gemm_phase<EpiResid, SchedPlain, 0>(lds, D, S, E);
            }
            if (layer > 0 && idle4 > 0 && bid >= G - idle4) { cvt_moe_share(p, layer, cvN1 + (bid - (G - idle4)), CVT_MOE_UNITS, idle4, (LAS float*)lds); }
            SEAM();
        }
        SITE(7) { n2_phase(p, layer, lds, ALL ? 0 : p.ph1); SEAM(); }
        LAS int* tstart = (LAS int*)(lds + LDS_MISC); LAS int* texp = tstart + 80; LAS int* tcnt = texp + 352;
        SITE(8) {
            moe_table(tstart, texp, tcnt, (const int*)(p.ws + WS_CTL) + CTL_CNT + layer * NE);
            SchedMoe1 S{{tstart, texp, tcnt}, p.ws + WS_HBUF, p.ws + WS_W13, (const int*)(p.ws + WS_LIST)}; EpiMoe1 E{(h16*)(p.ws + WS_H1)};
            pg8::gemm_phase<EpiMoe1, SchedMoe1, 1>(lds, D, S, E);
            SEAM();
        }
        SITE(9) {
            moe_table(tstart, texp, tcnt, (const int*)(p.ws + WS_CTL) + CTL_CNT + layer * NE);
            SchedMoe2 S{{tstart, texp, tcnt}, p.ws + WS_H1, p.ws + WS_W2, (const int*)(p.ws + WS_LIST)}; EpiMoe2 E{(h16*)(p.ws + WS_YC), (const float*)(p.ws + WS_GATE), (const int*)(p.ws + WS_LIST)};
            pg8::gemm_phase<EpiMoe2, SchedMoe2, 0>(lds, DE, S, E);
            SEAM();
        }
    }
    SITE(10) final_phase(p);
#undef SITE
#undef SEAM
}

template <int KIND> static void launch_kind(const Params& p, int grid, hipStream_t stream) {
    static bool attr = false;
    if (!attr) { attr = true; if (hipFuncSetAttribute((const void*)hy_fwd<KIND>, hipFuncAttributeMaxDynamicSharedMemorySize, LDS_BYTES) != hipSuccess) fprintf(stderr, "kernel_launch: hipFuncSetAttribute failed (kind %d)\n", KIND); }
    hipLaunchKernelGGL(hy_fwd<KIND>, dim3(grid), dim3(512), LDS_BYTES, stream, p);
}

extern "C" void kernel_launch(void* const* d_in, const int* in_sizes, int n_in, void* d_out, int out_size, void* d_ws, size_t ws_size, hipStream_t stream) {
    static int grid = 0;
    if (!grid) {
        if (n_in != 29 || out_size != TL * D || ws_size < WS_END) { fprintf(stderr, "kernel_launch: unexpected problem (n_in %d, out %d, ws %zu < %zu)\n", n_in, out_size, ws_size, (size_t)WS_END); grid = -1; return; }
        int dev = 0, cus = 0;
        if (hipGetDevice(&dev) != hipSuccess || hipDeviceGetAttribute(&cus, hipDeviceAttributeMultiprocessorCount, dev) != hipSuccess) { grid = -1; return; }
        grid = cus;
    }
    if (grid <= 0) return;
    (void)hipMemsetAsync((char*)d_ws + WS_CTL, 0, CTL_BYTES, stream);
    Params p{};
    const float** pp = (const float**)&p;
    for (int i = 0; i < 29; ++i) pp[i] = (const float*)d_in[i];
    p.out = (float*)d_out; p.ws = (char*)d_ws;
#if MK_MULTI
    p.ph0 = 0; p.ph1 = 0;
    launch_kind<0>(p, grid, stream); launch_kind<1>(p, grid, stream);
#ifndef PROBE_KIND
#define PROBE_KIND -1
#endif
#ifndef PROBE_LAYERS
#define PROBE_LAYERS 15
#endif
#define PREP(k) (((k) == PROBE_KIND && ((PROBE_LAYERS >> layer) & 1)) ? 2 : 1)
    if (PROBE_KIND == 0) launch_kind<0>(p, grid, stream);
    if (PROBE_KIND == 1) launch_kind<1>(p, grid, stream);
    for (int layer = 0; layer < NLAYER; ++layer) { p.ph0 = layer;
        for (int r = 0; r < PREP(2); ++r) launch_kind<2>(p, grid, stream);
        for (int r = 0; r < PREP(3); ++r) launch_kind<3>(p, grid, stream);
        for (int r = 0; r < PREP(4); ++r) { p.ph1 = (PREP(4) == 2 && r == 0) ? 1 : 0; launch_kind<4>(p, grid, stream); p.ph1 = 0; }
        launch_kind<6>(p, grid, stream); launch_kind<7>(p, grid, stream);
        if (PREP(7) == 2) { p.ph1 = 1; launch_kind<7>(p, grid, stream); p.ph1 = 0; }
        for (int r = 0; r < PREP(8); ++r) launch_kind<8>(p, grid, stream);
        for (int r = 0; r < PREP(9); ++r) launch_kind<9>(p, grid, stream); }
    p.ph0 = 0; launch_kind<10>(p, grid, stream);
    if (PROBE_KIND == 10) launch_kind<10>(p, grid, stream);
#else
    p.ph0 = 0; p.ph1 = NPHASE;
    launch_kind<-1>(p, grid, stream);
#endif
}
```

```cpp
#include <hip/hip_runtime.h>
#include <cstdio>
#include <cstdint>

#define LAS __attribute__((address_space(3)))
typedef _Float16 h16;
typedef _Float16 f16x8 __attribute__((ext_vector_type(8)));
typedef _Float16 f16x4 __attribute__((ext_vector_type(4)));
typedef _Float16 f16x2 __attribute__((ext_vector_type(2)));
typedef float f32x2 __attribute__((ext_vector_type(2)));
typedef float f32x4 __attribute__((ext_vector_type(4)));
typedef float f32x16 __attribute__((ext_vector_type(16)));
typedef unsigned u32x2 __attribute__((ext_vector_type(2)));
typedef unsigned u32x4 __attribute__((ext_vector_type(4)));

constexpr int D = 2048, NB = 8, SEQ = 4096, CTXL = 256, TL = NB * SEQ, TC = NB * CTXL, TT = TL + TC;
constexpr int D3 = 3 * D, D6 = 6 * D, DQK = 2304, DQKV = 2560, NE = 64, DE = 384, DE2 = 768, NLAYER = 4;
constexpr int LCAP = TT;
constexpr int MOE_ROWS = 86016;
constexpr float EPS = 1e-6f;

constexpr size_t WS_CTL = 0;
constexpr size_t CTL_BYTES = 65536;
constexpr size_t WS_TW = WS_CTL + CTL_BYTES;
constexpr size_t WS_ROPE = WS_TW + 65536;
constexpr size_t WS_MODP = WS_ROPE + 8192;
constexpr size_t WS_MODS = WS_MODP + 16ull * 4 * 9 * 12288 * 4;
constexpr size_t WS_RTAB = WS_MODS + 4ull * 9 * 12288 * 4;
constexpr size_t RTAB_L = 64ull * 5 * 2 * 64 * 8 * 2;
constexpr size_t WS_RCST = WS_RTAB + 4 * RTAB_L;
constexpr size_t WS_H2P = WS_RCST + 16384;
constexpr size_t WS_W3P = WS_H2P + 2ull * 4352 * 256 * 2;
constexpr size_t WS_XRES = WS_W3P + 2ull * 8192 * 256 * 2;
constexpr size_t WS_HBUF = WS_XRES + (size_t)TT * D * 4;
constexpr size_t WS_UT = WS_HBUF + (size_t)TT * D * 2;
constexpr size_t UT_BYTES = (size_t)D3 * TT * 2;
constexpr size_t WS_TAPS = WS_UT;
constexpr size_t WS_TAPSC = WS_TAPS + 2ull * 8192 * 4096 * 4;
constexpr size_t WS_QK = WS_UT;
constexpr size_t WS_VT = WS_QK + (size_t)TT * DQK * 2;
constexpr size_t WS_ZT = WS_UT + UT_BYTES;
constexpr size_t WS_H1 = WS_ZT + (size_t)D * TT * 2;
constexpr size_t WS_YC = WS_H1 + (size_t)MOE_ROWS * DE * 2;
constexpr size_t WS_WIN = WS_YC + 2ull * TT * D * 2;
constexpr size_t WS_WOUT = WS_WIN + 2ull * D3 * D * 2;
constexpr size_t WS_WQKV = WS_WOUT + 2ull * D * D * 2;
constexpr size_t WS_WO = WS_WQKV + 2ull * DQKV * D * 2;
constexpr size_t WS_W13 = WS_WO + 2ull * D * D * 2;
constexpr size_t WS_W2 = WS_W13 + (size_t)NE * DE2 * D * 2;
constexpr size_t WS_KF = WS_W2 + (size_t)NE * D * DE * 2;
constexpr size_t WS_KFC = WS_KF + 2ull * 2 * 2048 * 65536;
constexpr size_t WS_LIST = WS_KFC + 2ull * 2 * 2048 * 4096;
constexpr size_t WS_GATE = WS_LIST + (size_t)NE * LCAP * 4;
constexpr size_t WS_SSQ = WS_GATE + (size_t)NE * LCAP * 4;
constexpr size_t WS_END = WS_SSQ + (size_t)TT * 32 * 4;
static_assert(WS_TAPSC + 2ull * 8192 * 256 * 4 <= WS_UT + UT_BYTES, "taps alias");
static_assert(WS_VT + 256ull * TT * 2 <= WS_UT + UT_BYTES, "qkv alias");

constexpr int CTL_CNT = 4096;

constexpr int LDS_BYTES = 147456;
constexpr int LDS_MISC = 139264;
constexpr int LDS_XB = LDS_BYTES - 16;

struct Params {
    const float *x, *c, *ctx, *c_ctx, *mod_w, *mod_b, *hy_w_in, *hy_conv_w, *hy_conv_b, *hy_f_w1, *hy_f_b1, *hy_f_freq1, *hy_f_w2, *hy_f_b2, *hy_f_freq2, *hy_f_w3,
        *hy_bias, *hy_w_out, *at_w_qkv, *at_sink, *at_w_o, *moe_wg, *moe_bg, *moe_we, *moe_be, *moe_w1, *moe_w3, *moe_w2, *final_gain;
    float* out; char* ws; int ph0, ph1;
};

__device__ __forceinline__ int tid_fresh() { int t = threadIdx.x; asm volatile("" : "+v"(t)); return t; }
__device__ __forceinline__ float bperm_f(float v, int srclane) { return __int_as_float(__builtin_amdgcn_ds_bpermute(srclane << 2, __float_as_int(v))); }
__device__ __forceinline__ float shx(float v, int mask) { return bperm_f(v, (tid_fresh() & 63) ^ mask); }
__device__ __forceinline__ const Params* params_fresh() { auto q = __builtin_amdgcn_kernarg_segment_ptr(); asm volatile("" : "+s"(q)); return (const Params*)q; }

#define XB_TMO      128
#define XB_XCNT(j)  (256  + 64 * (j))
#define XB_XSUB(j)  (1280 + 64 * (j))
#define XB_XGEN(j)  (2304 + 64 * (j))
#define XB_TOP      3328
#define XB_TOPGEN   3392
#define XCD_BAR_WORDS 3456
#define XB_SPIN_CAP (1u << 18)

__device__ __forceinline__ unsigned xb_ld(unsigned* p)              { return __hip_atomic_load(p, __ATOMIC_RELAXED, __HIP_MEMORY_SCOPE_AGENT); }
__device__ __forceinline__ unsigned xb_add(unsigned* p, unsigned v) { return __hip_atomic_fetch_add(p, v, __ATOMIC_RELAXED, __HIP_MEMORY_SCOPE_AGENT); }
__device__ __forceinline__ unsigned xb_xcc_id() { return (unsigned)__builtin_amdgcn_s_getreg((3 << 11) | 20) & 0xFu; }
#define XB_SPIN(cond, bar) do { unsigned _sp = 0; while (cond) { __builtin_amdgcn_s_sleep(1); \
    if ((++_sp & 255u) == 0u) { if (xb_ld(&(bar)[XB_TMO])) break; if (_sp > XB_SPIN_CAP) { atomicAdd(&(bar)[XB_TMO], 1u); break; } } } } while (0)

struct XcdBarrier { unsigned* bar; volatile LAS unsigned* st; };

__device__ __forceinline__ XcdBarrier xcd_barrier_post(unsigned* bar, volatile LAS unsigned* st) {
    XcdBarrier b; b.bar = bar; b.st = st;
    if (threadIdx.x == 0) (void)xb_add(&bar[XB_XCNT(xb_xcc_id())], 1u);
    return b;
}
__device__ __forceinline__ void xcd_barrier_complete(unsigned* bar, unsigned x, unsigned& nloc, unsigned& nx) {
    const unsigned G = gridDim.x * gridDim.y * gridDim.z;
    unsigned sum, cnt, mine, sp = 0u;
    for (;;) {
        sum = 0u; cnt = 0u; mine = 0u;
#pragma unroll
        for (unsigned j = 0; j < 16; ++j) { const unsigned c = xb_ld(&bar[XB_XCNT(j)]); sum += c; cnt += (c > 0u) ? 1u : 0u; mine = (j == x) ? c : mine; }
        if (sum == G) break;
        __builtin_amdgcn_s_sleep(1);
        if ((++sp & 255u) == 0u) { if (xb_ld(&bar[XB_TMO])) break; if (sp > XB_SPIN_CAP) { atomicAdd(&bar[XB_TMO], 1u); break; } }
    }
    nloc = mine > 0u ? mine : 1u; nx = cnt > 0u ? cnt : 1u;
}
__device__ __forceinline__ void xcd_barrier(const XcdBarrier& b) {
    asm volatile("s_waitcnt vmcnt(0)" ::: "memory");
    __syncthreads();
    if (threadIdx.x == 0) {
        unsigned* bar = b.bar; const unsigned bx = xb_xcc_id();
        __builtin_amdgcn_s_waitcnt(0);
        unsigned nloc = b.st[0], nx = b.st[1];
        if (nloc == 0u) { xcd_barrier_complete(bar, bx, nloc, nx); b.st[0] = nloc; b.st[1] = nx; }
        const unsigned old = xb_add(&bar[XB_XSUB(bx)], 1u);
        const unsigned gen = old / nloc;
        if (old + 1u == (gen + 1u) * nloc) {
            __builtin_amdgcn_fence(__ATOMIC_RELEASE, "agent");
            asm volatile("s_waitcnt vmcnt(0)" ::: "memory");
            const unsigned og = xb_add(&bar[XB_TOP], 1u);
            const unsigned tg = og / nx;
            if (og + 1u == (tg + 1u) * nx) xb_add(&bar[XB_TOPGEN], 1u);
            else XB_SPIN(xb_ld(&bar[XB_TOPGEN]) == tg, bar);
            __builtin_amdgcn_fence(__ATOMIC_ACQUIRE, "agent");
            xb_add(&bar[XB_XGEN(bx)], 1u);
            asm volatile("s_waitcnt vmcnt(0)" ::: "memory");
        } else {
            XB_SPIN(xb_ld(&bar[XB_XGEN(bx)]) == gen, bar);
            __builtin_amdgcn_fence(__ATOMIC_ACQUIRE, "agent");
            asm volatile("s_waitcnt vmcnt(0)" ::: "memory");
        }
    }
    __syncthreads();
}

namespace pg8 {
constexpr int BM = 256, BK = 64, HALF = 128, HTB = HALF * BK * 2, STAGE_BYTES = 8 * HTB;
__device__ __forceinline__ int lds_byte(int r, int c) { const int st = (r >> 4) * 2 + (c >> 5), rr = r & 15, cc = c & 31, ob = rr * 64 + cc * 2; return st * 1024 + (ob ^ (((ob >> 9) & 1) << 5)); }
__device__ __forceinline__ void stage_rc(int b, int& R, int& C) { const int st = b / 1024, sb = b % 1024, swz = sb ^ (((sb >> 9) & 1) << 5); R = (st >> 1) * 16 + swz / 64; C = (st & 1) * 32 + (swz % 64) / 2; }
__device__ __forceinline__ int perm32(int rho) { const int n = rho >> 4, i = rho & 15; return 8 * (i >> 2) + 4 * n + (i & 3); }

struct Unit {
    int pm, pn;
    int e, pos0, cnt;
    int kind;
    int half;
    const char* A; const char* B;
    const int* rows;
};

typedef short s16x4 __attribute__((ext_vector_type(4)));
template <class Epi, class Sched, int AMODE>
__device__ __forceinline__ void gemm_phase(LAS unsigned char* lds, const int K, const Sched& S, const Epi& E, const int ldat = 0) {
    constexpr bool GATHER = AMODE == 1, ATR = AMODE == 2;
    const int tid = tid_fresh(), wid = __builtin_amdgcn_readfirstlane(tid >> 6), lane = tid & 63, wr = wid >> 2, wc = wid & 3, fr = lane & 15, fq = lane >> 4;
    const int nt = K / BK;
    unsigned voffA[2], voffB[2]; int RA[2], CA[2];
#pragma unroll
    for (int i = 0; i < 2; ++i) { int R, C; stage_rc(tid * 16 + i * 8192, R, C); const int Rb = Epi::PERM ? ((R & ~31) + perm32(R & 31)) : R;
        voffA[i] = (unsigned)(R * K + C) * 2u; voffB[i] = (unsigned)(Rb * K + C) * 2u; RA[i] = R; CA[i] = C;
        if constexpr (ATR) { const int bb = tid * 16 + i * 8192, row = bb >> 8, pc = (bb >> 4) & 15, ch = pc ^ (((row & 3) << 2) | ((row >> 2) & 3)); voffA[i] = (unsigned)(row * ldat + 8 * ch) * 2u; } }
    const size_t kstep = (size_t)(BK * 2);
    const size_t hstep = (size_t)HALF * K * 2;
    const size_t kstepA = ATR ? (size_t)BK * ldat * 2 : kstep, hstepA = ATR ? (size_t)HALF * 2 : hstep;
    const unsigned ldsw = (unsigned)wid * 1024u;
    const int aoff = lds_byte(wr * 64 + fr, fq * 8), boff = lds_byte(wc * 32 + fr, fq * 8);
    int atr[4][2];
#pragma unroll
    for (int m = 0; m < 4; ++m)
#pragma unroll
        for (int bl = 0; bl < 2; ++bl) { const int xr = ((fr >> 2) << 2) | ((2 * fq + bl) & 3); atr[m][bl] = (int)(unsigned)(uintptr_t)lds + 256 * (8 * fq + (fr >> 2) + 4 * bl) + 16 * ((wr * 8 + 2 * m + ((fr & 3) >> 1)) ^ xr) + 8 * (fr & 1); }
    unsigned vgC[2][2], vgN[2][2];
#define PG8_ROWS(u, vg) do { if constexpr (GATHER) { _Pragma("unroll") for (int _h = 0; _h < 2; ++_h) _Pragma("unroll") for (int _i = 0; _i < 2; ++_i) { \
        const int _p = (u).pos0 + _h * HALF + RA[_i]; const int _tok = (_p < (u).cnt) ? ((u).rows[_h * HALF + RA[_i]] >> 1) : 0; \
        vg[_h][_i] = ((unsigned)_tok * (unsigned)K + (unsigned)CA[_i]) * 2u; } } } while (0)
#define PG8_SA(b, h) (((b) * 2 + (h)) * HTB)
#define PG8_SB(b, h) ((4 + (b) * 2 + (h)) * HTB)
#define PG8_STAGE_B(bufoff, gbase) do { _Pragma("unroll") for (int _i = 0; _i < 2; ++_i) \
        __builtin_amdgcn_global_load_lds((const unsigned*)((const char*)(gbase) + voffB[_i]), (LAS unsigned*)(lds + (bufoff) + ldsw + _i * 8192), 16, 0, 0); } while (0)
#define PG8_STAGE_A(bufoff, gbase, h, NEXT) do { _Pragma("unroll") for (int _i = 0; _i < 2; ++_i) { \
        const unsigned _vo = GATHER ? ((NEXT) ? vgN[h][_i] : vgC[h][_i]) : voffA[_i]; \
        __builtin_amdgcn_global_load_lds((const unsigned*)((const char*)(gbase) + (GATHER ? (size_t)0 : (size_t)(h) * hstepA) + _vo), (LAS unsigned*)(lds + (bufoff) + ldsw + _i * 8192), 16, 0, 0); } } while (0)
#define PG8_LDA(dst, b, h) do { if constexpr (!ATR) { _Pragma("unroll") for (int m = 0; m < 4; ++m) _Pragma("unroll") for (int k = 0; k < 2; ++k) dst[m][k] = *(const LAS f16x8*)(lds + PG8_SA(b, h) + aoff + m * 2048 + k * 1024); } \
        else { _Pragma("unroll") for (int m = 0; m < 4; ++m) _Pragma("unroll") for (int k = 0; k < 2; ++k) { s16x4 _lo, _hi; \
            asm volatile("ds_read_b64_tr_b16 %0, %1 offset:%2" : "=v"(_lo) : "v"(atr[m][0]), "i"(PG8_SA(b, h) + k * 8192) : "memory"); \
            asm volatile("ds_read_b64_tr_b16 %0, %1 offset:%2" : "=v"(_hi) : "v"(atr[m][1]), "i"(PG8_SA(b, h) + k * 8192) : "memory"); \
            const short __attribute__((ext_vector_type(8))) _v = {_lo[0], _lo[1], _lo[2], _lo[3], _hi[0], _hi[1], _hi[2], _hi[3]}; dst[m][k] = __builtin_bit_cast(f16x8, _v); } } } while (0)
#define PG8_PIN(At) do { if constexpr (ATR) asm volatile("" : "+v"(At[0][0]), "+v"(At[0][1]), "+v"(At[1][0]), "+v"(At[1][1]), "+v"(At[2][0]), "+v"(At[2][1]), "+v"(At[3][0]), "+v"(At[3][1])); } while (0)
#define PG8_LDB(dst, b, h) do { _Pragma("unroll") for (int n = 0; n < 2; ++n) _Pragma("unroll") for (int k = 0; k < 2; ++k) dst[n][k] = *(const LAS f16x8*)(lds + PG8_SB(b, h) + boff + n * 2048 + k * 1024); } while (0)
#define PG8_MMA(ai, bj, At, Bt) do { __builtin_amdgcn_s_setprio(1); _Pragma("unroll") for (int m = 0; m < 4; ++m) _Pragma("unroll") for (int n = 0; n < 2; ++n) _Pragma("unroll") for (int k = 0; k < 2; ++k) \
        acc[ai][bj][m][n] = __builtin_amdgcn_mfma_f32_16x16x32_f16(Bt[n][k], At[m][k], acc[ai][bj][m][n], 0, 0, 0); __builtin_amdgcn_s_setprio(0); } while (0)
#define PG8_WAIT_V(n) asm volatile("s_waitcnt vmcnt(" #n ")" ::: "memory")
#define PG8_WAIT_L(n) asm volatile("s_waitcnt lgkmcnt(" #n ")" ::: "memory")
#define PG8_BAR __builtin_amdgcn_s_barrier()
#define PG8_SCHED __builtin_amdgcn_sched_barrier(0)
    Unit cur, nxt; int ui = 0;
    if (!S.next(0, cur)) return;
    f32x4 acc[2][2][4][2];
#pragma unroll
    for (int a = 0; a < 2; ++a)
#pragma unroll
        for (int b = 0; b < 2; ++b)
#pragma unroll
            for (int m = 0; m < 4; ++m)
#pragma unroll
                for (int n = 0; n < 2; ++n) acc[a][b][m][n] = (f32x4){0.f, 0.f, 0.f, 0.f};
    f16x8 At[4][2], B0[2][2], B1[2][2];
    const char* cA = cur.A; const char* cB = cur.B;
    PG8_ROWS(cur, vgC);
#pragma unroll
    for (int _h = 0; _h < 2; ++_h)
#pragma unroll
        for (int _i = 0; _i < 2; ++_i) vgN[_h][_i] = GATHER ? vgC[_h][_i] : 0u;
    PG8_STAGE_B(PG8_SB(0, 0), cB); PG8_STAGE_B(PG8_SB(0, 1), cB + hstep); PG8_STAGE_A(PG8_SA(0, 0), cA, 0, false); PG8_STAGE_A(PG8_SA(0, 1), cA, 1, false);
    if (wr == 1) PG8_BAR;
    PG8_WAIT_V(2); PG8_BAR;
    PG8_STAGE_B(PG8_SB(1, 0), cB + kstep); PG8_STAGE_A(PG8_SA(1, 0), cA + kstepA, 0, false); PG8_STAGE_B(PG8_SB(1, 1), cB + hstep + kstep);
    PG8_WAIT_V(6); PG8_BAR;
    for (;;) {
        const bool has_next = S.next(ui + 1, nxt);
        const bool full = cur.half == 0;
        const char* nA = has_next ? nxt.A : cA; const char* nB = has_next ? nxt.B : cB;
        if (has_next) { PG8_ROWS(nxt, vgN); }
#pragma unroll 1
        for (int t = 0; t < nt; t += 2) {
            const bool last = (t == nt - 2);
            const char* a1 = cA + (size_t)(t + 1) * kstepA;
            const char* a2 = last ? nA : cA + (size_t)(t + 2) * kstepA; const char* b2 = last ? nB : cB + (size_t)(t + 2) * kstep;
            const char* a3 = a2 + kstepA; const char* b3 = b2 + kstep;
            PG8_LDB(B0, 0, 0); PG8_LDB(B1, 0, 1); PG8_SCHED; PG8_LDA(At, 0, 0); PG8_STAGE_A(PG8_SA(1, 1), a1, 1, false);
            PG8_WAIT_V(8); PG8_WAIT_L(0); PG8_PIN(At); PG8_BAR; PG8_MMA(0, 0, At, B0); PG8_MMA(0, 1, At, B1); PG8_BAR; PG8_SCHED;
            PG8_LDA(At, 0, 1); PG8_STAGE_B(PG8_SB(0, 0), b2); PG8_STAGE_B(PG8_SB(0, 1), b2 + hstep); PG8_STAGE_A(PG8_SA(0, 0), a2, 0, last);
            PG8_WAIT_V(8); PG8_WAIT_L(0); PG8_PIN(At); PG8_BAR; if (full) { PG8_MMA(1, 0, At, B0); PG8_MMA(1, 1, At, B1); } PG8_BAR; PG8_SCHED;
            PG8_LDB(B0, 1, 0); PG8_LDB(B1, 1, 1); PG8_SCHED; PG8_LDA(At, 1, 0); PG8_STAGE_A(PG8_SA(0, 1), a2, 1, last);
            PG8_WAIT_V(8); PG8_WAIT_L(0); PG8_PIN(At); PG8_BAR; PG8_MMA(0, 0, At, B0); PG8_MMA(0, 1, At, B1); PG8_BAR; PG8_SCHED;
            PG8_LDA(At, 1, 1); PG8_STAGE_B(PG8_SB(1, 0), b3); PG8_STAGE_B(PG8_SB(1, 1), b3 + hstep); PG8_STAGE_A(PG8_SA(1, 0), a3, 0, last);
            PG8_WAIT_V(8); PG8_WAIT_L(0); PG8_PIN(At); PG8_BAR; if (full) { PG8_MMA(1, 0, At, B0); PG8_MMA(1, 1, At, B1); } PG8_BAR; PG8_SCHED;
        }
        if (wr == 0) PG8_BAR;
        E(acc, cur, wr, wc, fr, fq);
        if (!has_next) break;
#pragma unroll
        for (int a = 0; a < 2; ++a)
#pragma unroll
            for (int b = 0; b < 2; ++b)
#pragma unroll
                for (int m = 0; m < 4; ++m)
#pragma unroll
                    for (int n = 0; n < 2; ++n) acc[a][b][m][n] = (f32x4){0.f, 0.f, 0.f, 0.f};
        cur = nxt; cA = nA; cB = nB; ++ui;
#pragma unroll
        for (int _h = 0; _h < 2; ++_h)
#pragma unroll
            for (int _i = 0; _i < 2; ++_i) vgC[_h][_i] = vgN[_h][_i];
        if (wr == 1) PG8_BAR;
    }
    PG8_WAIT_V(0);
    PG8_BAR;
#undef PG8_ROWS
#undef PG8_SA
#undef PG8_SB
#undef PG8_STAGE_A
#undef PG8_STAGE_B
#undef PG8_LDA
#undef PG8_LDB
#undef PG8_PIN
#undef PG8_MMA
#undef PG8_WAIT_V
#undef PG8_WAIT_L
#undef PG8_BAR
#undef PG8_SCHED
}
}

using pg8::Unit;
__device__ __forceinline__ f16x8 pack8(const f32x4 a, const f32x4 b) {
    f16x8 w; w[0] = (h16)a[0]; w[1] = (h16)a[1]; w[2] = (h16)a[2]; w[3] = (h16)a[3]; w[4] = (h16)b[0]; w[5] = (h16)b[1]; w[6] = (h16)b[2]; w[7] = (h16)b[3]; return w;
}
struct EpiH16 {
    static constexpr bool PERM = true;
    h16* O0; int ld0; h16* O1; int ld1;
    __device__ __forceinline__ void operator()(const f32x4 (&acc)[2][2][4][2], const Unit& u, int wr, int wc, int fr, int fq) const {
        h16* base = u.kind ? O1 : O0; const int ld = u.kind ? ld1 : ld0;
        const int row0 = u.pm * 256 + wr * 64 + fr, col0 = u.pn * 256 + wc * 32 + 8 * fq;
#pragma unroll
        for (int ai = 0; ai < 2; ++ai)
#pragma unroll
            for (int m = 0; m < 4; ++m) { h16* rowp = base + (size_t)(row0 + ai * 128 + m * 16) * ld + col0;
#pragma unroll
                for (int bj = 0; bj < 2; ++bj) __builtin_nontemporal_store(pack8(acc[ai][bj][m][0], acc[ai][bj][m][1]), (f16x8*)(rowp + bj * 128)); }
    }
};
struct EpiTaps {
    static constexpr bool PERM = false;
    float* T0; float* T1;
    __device__ __forceinline__ void operator()(const f32x4 (&acc)[2][2][4][2], const Unit& u, int wr, int wc, int fr, int fq) const {
        const int j = u.kind >> 1, v = u.kind & 1; const int ld = v ? 256 : 4096;
        float* base = v ? (T1 + (size_t)j * 8192 * 256) : (T0 + (size_t)j * 8192 * 4096);
        const int row0 = u.pm * 256 + wr * 64 + fr, col0 = u.pn * 256 + wc * 32 + 4 * fq;
#pragma unroll
        for (int ai = 0; ai < 2; ++ai)
#pragma unroll
            for (int m = 0; m < 4; ++m) { float* rowp = base + (size_t)(row0 + ai * 128 + m * 16) * ld + col0;
#pragma unroll
                for (int bj = 0; bj < 2; ++bj)
#pragma unroll
                    for (int n = 0; n < 2; ++n) *(f32x4*)(rowp + bj * 128 + n * 16) = acc[ai][bj][m][n]; }
    }
};
struct EpiResid {
    static constexpr bool PERM = false;
    float* X; const float* mods; int layer; float* SSQ; float* XO;
    __device__ __forceinline__ void operator()(const f32x4 (&acc)[2][2][4][2], const Unit& u, int wr, int wc, int fr, int fq) const {
        const int r0 = u.pm * 256; const int b = r0 < TL ? (r0 >> 12) : 8;
        const float* g = mods + ((size_t)(layer * 9 + b) * 6 + 2) * D;
        const int row0 = r0 + wr * 64 + fr, col0 = u.pn * 256 + wc * 32 + 4 * fq;
        f32x4 gv[2][2];
#pragma unroll
        for (int bj = 0; bj < 2; ++bj)
#pragma unroll
            for (int n = 0; n < 2; ++n) gv[bj][n] = *(const f32x4*)(g + col0 + bj * 128 + n * 16);
#pragma unroll
        for (int ai = 0; ai < 2; ++ai)
#pragma unroll
            for (int m = 0; m < 4; ++m) { const int row = row0 + ai * 128 + m * 16; float* rowp = X + (size_t)row * D + col0; float* rowo = XO + (size_t)row * D + col0; float sq = 0.f;
#pragma unroll
                for (int bj = 0; bj < 2; ++bj)
#pragma unroll
                    for (int n = 0; n < 2; ++n) { const int co = bj * 128 + n * 16; const f32x4 v = *(const f32x4*)(rowp + co) + gv[bj][n] * acc[ai][bj][m][n]; *(f32x4*)(rowo + co) = v; sq += v[0] * v[0] + v[1] * v[1] + v[2] * v[2] + v[3] * v[3]; }
                sq += shx(sq, 16); sq += shx(sq, 32);
                if (fq == 0) SSQ[(size_t)row * 32 + u.pn * 4 + wc] = sq; }
    }
};
struct EpiMoe1 {
    static constexpr bool PERM = true;
    h16* H1;
    __device__ __forceinline__ void operator()(const f32x4 (&acc)[2][2][4][2], const Unit& u, int wr, int wc, int fr, int fq) const {
        const int row0 = u.pm * 256 + wr * 64 + fr, col0 = u.pn * 128 + wc * 16 + 4 * fq;
#pragma unroll
        for (int ai = 0; ai < 2; ++ai)
#pragma unroll
            for (int m = 0; m < 4; ++m) { if (ai == 1 && u.half) continue; h16* rowp = H1 + (size_t)(row0 + ai * 128 + m * 16) * DE + col0;
#pragma unroll
                for (int bj = 0; bj < 2; ++bj) { const f32x4 a = acc[ai][bj][m][0], b = acc[ai][bj][m][1]; f16x4 w;
#pragma unroll
                    for (int i = 0; i < 4; ++i) { const float s = a[i] / (1.0f + __expf(-a[i])); w[i] = (h16)(s * b[i]); }
                    *(f16x4*)(rowp + bj * 64) = w; } }
    }
};
struct EpiMoe2 {
    static constexpr bool PERM = true;
    h16* YC; const float* gslot;
    __device__ __forceinline__ void operator()(const f32x4 (&acc)[2][2][4][2], const Unit& u, int wr, int wc, int fr, int fq) const {
        const int col0 = u.pn * 256 + wc * 32 + 8 * fq;
        const float* grow = gslot + ((const char*)u.rows - (const char*)listbase) / 4;
        int av[2][4]; float gv[2][4];
#pragma unroll
        for (int ai = 0; ai < 2; ++ai)
#pragma unroll
            for (int m = 0; m < 4; ++m) { const int r = ai * 128 + wr * 64 + m * 16 + fr; const bool ok = u.pos0 + r < u.cnt; av[ai][m] = ok ? u.rows[r] : -1; gv[ai][m] = ok ? grow[r] : 0.f; }
#pragma unroll
        for (int ai = 0; ai < 2; ++ai)
#pragma unroll
            for (int m = 0; m < 4; ++m) { if (av[ai][m] >= 0) { const float g = gv[ai][m]; h16* rowp = YC + (size_t)av[ai][m] * D + col0;
#pragma unroll
                    for (int bj = 0; bj < 2; ++bj) *(f16x8*)(rowp + bj * 128) = pack8(acc[ai][bj][m][0] * g, acc[ai][bj][m][1] * g); } }
    }
    const int* listbase;
};

__device__ __forceinline__ void order_tile(int wgid, int nM, int nN, int& pm, int& pn) {
    const int nwg = nM * nN; { const int q = nwg / 8, r = nwg % 8, xcd = wgid % 8, off = wgid / 8; wgid = (xcd < r ? xcd * (q + 1) : r * (q + 1) + (xcd - r) * q) + off; }
    const int nig = 8 * nN, gid = wgid / nig, fm = gid * 8, gsz = (nM - fm) < 8 ? (nM - fm) : 8;
    pm = fm + ((wgid % nig) % gsz); pn = (wgid % nig) / gsz;
}
struct SchedPlain {
    int nM, nN, K; const char* A; const char* B;
    __device__ __forceinline__ bool next(int i, Unit& u) const {
        const long L = (long)i * gridDim.x + blockIdx.x; if (L >= (long)nM * nN) return false;
        order_tile((int)L, nM, nN, u.pm, u.pn); u.kind = 0; u.half = 0; u.e = 0; u.pos0 = 0; u.cnt = 0; u.rows = nullptr;
        u.A = A + (size_t)u.pm * 256 * K * 2; u.B = B + (size_t)u.pn * 256 * K * 2; return true;
    }
};
struct SchedPlainAT {
    int nM, nN, K; const char* At; const char* B;
    __device__ __forceinline__ bool next(int i, Unit& u) const {
        const long L = (long)i * gridDim.x + blockIdx.x; if (L >= (long)nM * nN) return false;
        order_tile((int)L, nM, nN, u.pm, u.pn); u.kind = 0; u.half = 0; u.e = 0; u.pos0 = 0; u.cnt = 0; u.rows = nullptr;
        u.A = At + (size_t)u.pm * 256 * 2; u.B = B + (size_t)u.pn * 256 * K * 2; return true;
    }
};
struct SchedQkv {
    const char* H; const char* W;
    __device__ __forceinline__ bool next(int i, Unit& u) const {
        const long L = (long)i * gridDim.x + blockIdx.x; const int nA = 136 * 9; if (L >= nA + 136) return false;
        u.e = 0; u.half = 0; u.pos0 = 0; u.cnt = 0; u.rows = nullptr;
        if (L < nA) { order_tile((int)L, 136, 9, u.pm, u.pn); u.kind = 0; u.A = H + (size_t)u.pm * 256 * D * 2; u.B = W + (size_t)u.pn * 256 * D * 2; }
        else { u.pm = 0; u.pn = (int)L - nA; u.kind = 1; u.A = W + (size_t)DQK * D * 2; u.B = H + (size_t)u.pn * 256 * D * 2; }
        return true;
    }
};
struct SchedFilt {
    const char* W3P; const char* H2P;
    __device__ __forceinline__ bool next(int i, Unit& u) const {
        const long L = (long)i * gridDim.x + blockIdx.x; if (L >= 2 * 544) return false;
        const int j = (int)L / 544, r = (int)L % 544; u.e = 0; u.half = 0; u.pos0 = 0; u.cnt = 0; u.rows = nullptr;
        int v; if (r < 512) { v = 0; u.pm = r >> 4; u.pn = r & 15; } else { v = 1; u.pm = r - 512; u.pn = 0; }
        u.kind = 2 * j + v;
        u.A = W3P + ((size_t)j * 8192 + (size_t)u.pm * 256) * 256 * 2;
        u.B = H2P + ((size_t)j * 4352 + (v ? 4096 : 0) + (size_t)u.pn * 256) * 256 * 2;
        return true;
    }
};
struct MoeTab { const LAS int* tstart; const LAS int* texp; const LAS int* cnt; };
struct SchedMoe1 {
    MoeTab tb; const char* H; const char* W13; const int* list;
    __device__ __forceinline__ bool next(int i, Unit& u) const {
        const long L = (long)i * gridDim.x + blockIdx.x; const int ntile = __builtin_amdgcn_readfirstlane(tb.tstart[NE]); if (L >= (long)ntile * 3) return false;
        int rt; order_tile((int)L, ntile, 3, rt, u.pn); u.pm = rt; u.kind = 0;
        const int e = __builtin_amdgcn_readfirstlane(tb.texp[rt]); u.e = e; u.pos0 = (rt - __builtin_amdgcn_readfirstlane(tb.tstart[e])) * 256; u.cnt = __builtin_amdgcn_readfirstlane(tb.cnt[e]); u.half = (u.cnt - u.pos0 <= 128) ? 1 : 0;
        u.rows = list + (size_t)e * LCAP + u.pos0; u.A = H; u.B = W13 + ((size_t)e * DE2 + (size_t)u.pn * 256) * D * 2; return true;
    }
};
struct SchedMoe2 {
    MoeTab tb; const char* H1; const char* W2; const int* list;
    __device__ __forceinline__ bool next(int i, Unit& u) const {
        const long L = (long)i * gridDim.x + blockIdx.x; const int ntile = __builtin_amdgcn_readfirstlane(tb.tstart[NE]); if (L >= (long)ntile * 8) return false;
        int rt; order_tile((int)L, ntile, 8, rt, u.pn); u.pm = rt; u.kind = 0;
        const int e = __builtin_amdgcn_readfirstlane(tb.texp[rt]); u.e = e; u.pos0 = (rt - __builtin_amdgcn_readfirstlane(tb.tstart[e])) * 256; u.cnt = __builtin_amdgcn_readfirstlane(tb.cnt[e]); u.half = (u.cnt - u.pos0 <= 128) ? 1 : 0;
        u.rows = list + (size_t)e * LCAP + u.pos0; u.A = H1 + (size_t)rt * 256 * DE * 2; u.B = W2 + ((size_t)e * D + (size_t)u.pn * 256) * DE * 2; return true;
    }
};
__device__ __forceinline__ void moe_table(LAS int* tstart, LAS int* texp, LAS int* cnt, const int* counters) {
    const int t = tid_fresh();
    if (t < NE) cnt[t] = counters[t];
    __syncthreads();
    if (t <= NE) { int s = 0; for (int e = 0; e < t; ++e) s += (cnt[e] + 255) >> 8; tstart[t] = s; }
    __syncthreads();
    if (t < NE) { const int s0 = tstart[t], s1 = tstart[t + 1]; for (int q = s0; q < s1; ++q) texp[q] = t; }
    __syncthreads();
}

__device__ __forceinline__ float wave_sum(float v) {
#pragma unroll
    for (int o = 32; o >= 1; o >>= 1) v += shx(v, o);
    return v;
}
__device__ __forceinline__ float silu_f(float x) { return x / (1.0f + expf(-x)); }
__device__ __forceinline__ int batch_of_row(int r) { return r < TL ? (r >> 12) : 8; }

__device__ __forceinline__ void modp_unit(const Params& p, int unit, LAS float* sl) {
    const int layer = unit / 96, rem = unit % 96, ks = rem / 6, cc = rem % 6, tid = tid_fresh();
    for (int i = tid; i < 9 * 128; i += 512) { const int cnd = i >> 7, k = ks * 128 + (i & 127); const float v = cnd < 8 ? p.c[cnd * D + k] : p.c_ctx[k]; sl[i] = silu_f(v); }
    __syncthreads();
    f32x4 acc[9];
#pragma unroll
    for (int q = 0; q < 9; ++q) acc[q] = (f32x4){0.f, 0.f, 0.f, 0.f};
    const float* w = p.mod_w + ((size_t)layer * D + (size_t)ks * 128) * D6 + cc * 2048 + tid * 4;
#pragma unroll 4
    for (int k = 0; k < 128; ++k) { const f32x4 wv = *(const f32x4*)(w + (size_t)k * D6);
#pragma unroll
        for (int q = 0; q < 9; ++q) acc[q] += wv * sl[q * 128 + k]; }
    float* outp = (float*)(p.ws + WS_MODP) + ((size_t)(ks * 4 + layer) * 9) * D6 + cc * 2048 + tid * 4;
#pragma unroll
    for (int q = 0; q < 9; ++q) *(f32x4*)(outp + (size_t)q * D6) = acc[q];
    __syncthreads();
}
__device__ __forceinline__ void modr_unit(const Params& p, int unit) {
    const size_t idx = (size_t)unit * 2048 + tid_fresh() * 4; const int layer = (int)(idx / (9 * D6)), col = (int)(idx % D6);
    f32x4 s = *(const f32x4*)(p.mod_b + (size_t)layer * D6 + col);
    const float* pp = (const float*)(p.ws + WS_MODP) + idx;
#pragma unroll
    for (int ks = 0; ks < 16; ++ks) s += *(const f32x4*)(pp + (size_t)ks * 4 * 9 * D6);
    *(f32x4*)((float*)(p.ws + WS_MODS) + idx) = s;
}
__device__ __forceinline__ void tables_unit(const Params& p) {
    f32x2* tw = (f32x2*)(p.ws + WS_TW);
    for (int m = tid_fresh(); m < 8192; m += 512) { double s, c; sincospi(-(double)m / 4096.0, &s, &c); tw[m] = (f32x2){(float)c, (float)s}; }
    float* rc = (float*)(p.ws + WS_ROPE);
    for (int i = tid_fresh(); i < 1024; i += 512) { const int pos = i >> 4, q = i & 15; const float inv = powf(10000.0f, -(float)q / 16.0f); const float ang = (float)pos * inv;
        rc[i] = cosf(ang); rc[1024 + i] = sinf(ang); }
}
__device__ __forceinline__ void h2_task(const Params& p, int task) {
    const int lane = tid_fresh() & 63; const int j = task / 4352, r = task % 4352; const int v = r >= 4096, t = v ? r - 4096 : r; const int Lv = v ? 256 : 4096;
    const float tl = (float)t / (float)(Lv - 1);
    const float omega = (float)(2.0 * 3.14159265358979323846 / (double)Lv) * (float)t;
    float feat = 0.f;
    if (lane == 0) feat = tl;
    else if (lane <= 32) { const int bi = (lane - 1) & 15; const float band = 1e-4f + (float)bi * ((15.0f - 1e-4f) / 15.0f); const float a = band * omega; feat = lane <= 16 ? cosf(a) : -sinf(a); }
    const float* w1 = p.hy_f_w1 + (size_t)j * 33 * 64; const float* w2 = p.hy_f_w2 + (size_t)j * 64 * 64;
    float s = p.hy_f_b1[j * 64 + lane];
    for (int f = 0; f < 33; ++f) s += bperm_f(feat, f) * w1[f * 64 + lane];
    const float h1 = sinf(p.hy_f_freq1[j * 64 + lane] * s);
    float s2 = p.hy_f_b2[j * 64 + lane];
    for (int m = 0; m < 64; ++m) s2 += bperm_f(h1, m) * w2[m * 64 + lane];
    const float h2 = sinf(p.hy_f_freq2[j * 64 + lane] * s2);
    const h16 hi = (h16)h2; const h16 lo = (h16)(h2 - (float)hi);
    h16* row = (h16*)(p.ws + WS_H2P) + ((size_t)j * 4352 + r) * 256;
    row[lane] = hi; row[64 + lane] = hi; row[128 + lane] = lo; row[192 + lane] = lo;
}
__device__ __forceinline__ void w3p_unit(const Params& p, int unit) {
    const int j = unit >> 5, c0 = (unit & 31) * 256; const float* w3 = p.hy_f_w3 + (size_t)j * 64 * 8192; h16* dst = (h16*)(p.ws + WS_W3P) + (size_t)j * 8192 * 256;
    for (int i = tid_fresh(); i < 64 * 256; i += 512) { const int m = i >> 8, col = c0 + (i & 255); const float w = w3[(size_t)m * 8192 + col];
        const h16 hi = (h16)w; const h16 lo = (h16)(w - (float)hi); h16* row = dst + (size_t)col * 256; row[m] = hi; row[64 + m] = lo; row[128 + m] = hi; row[192 + m] = lo; }
}
__device__ __forceinline__ void rtab_unit(const Params& p, int unit) {
    const int layer = unit >> 6, c = unit & 63; h16* dst = (h16*)(p.ws + WS_RTAB + (size_t)layer * RTAB_L) + (size_t)c * 5 * 2 * 64 * 8;
    for (int i = tid_fresh(); i < 5 * 2 * 64 * 8; i += 512) { const int jj = i & 7, lane = (i >> 3) & 63, hl = (i >> 9) & 1, ct = i >> 10;
        const int k = 32 * c + 8 * (lane >> 4) + jj, col = 16 * ct + (lane & 15);
        float w = 0.f; if (col < 8) w = p.moe_wg[((size_t)layer * D + k) * 8 + col]; else if (col < 72) w = p.moe_we[((size_t)layer * D + k) * 64 + (col - 8)];
        w *= 256.0f; const h16 hi = (h16)w; const h16 lo = (h16)(w - (float)hi); dst[i] = hl ? lo : hi; }
}
template <int NW>
__device__ __forceinline__ void cvt_tile(const float* src, int ldn, int k0, int n0, h16* dst, int ldk, int mode, LAS float* T) {
    constexpr int P = NW + 1; const int tid = tid_fresh();
#pragma unroll
    for (int ps = 0; ps < 64 * NW / 4 / 512; ++ps) { const int idx = ps * 512 + tid, k = idx / (NW / 4), n4 = idx % (NW / 4);
        const f32x4 v = *(const f32x4*)(src + (size_t)(k0 + k) * ldn + n0 + 4 * n4); LAS float* q = T + k * P + 4 * n4; q[0] = v[0]; q[1] = v[1]; q[2] = v[2]; q[3] = v[3]; }
    __syncthreads();
#pragma unroll
    for (int ps = 0; ps < NW * 8 / 512; ++ps) { const int item = ps * 512 + tid, kc = item & 7, n = item >> 3; f16x8 w;
#pragma unroll
        for (int i = 0; i < 8; ++i) w[i] = (h16)T[(8 * kc + i) * P + n];
        const int ng = n0 + n; const int row = mode == 0 ? ng : (8 * (ng >> 2) + (ng & 3) + (mode == 2 ? 4 : 0));
        *(f16x8*)(dst + (size_t)row * ldk + k0 + 8 * kc) = w; }
    __syncthreads();
}
__device__ __forceinline__ void cvt_dense_unit(const Params& p, int unit, LAS float* T) {
    const float* src; h16* dst; int nt, N;
    if (unit < 1536) { src = p.hy_w_in; dst = (h16*)(p.ws + WS_WIN); nt = 24; N = D3; }
    else if (unit < 2048) { unit -= 1536; src = p.hy_w_out; dst = (h16*)(p.ws + WS_WOUT); nt = 8; N = D; }
    else if (unit < 2688) { unit -= 2048; src = p.at_w_qkv; dst = (h16*)(p.ws + WS_WQKV); nt = 10; N = DQKV; }
    else { unit -= 2688; src = p.at_w_o; dst = (h16*)(p.ws + WS_WO); nt = 8; N = D; }
    const int j = unit / (32 * nt), r = unit % (32 * nt), kt = r / nt, ntile = r % nt;
    cvt_tile<256>(src + (size_t)j * D * N, N, kt * 64, ntile * 256, dst + (size_t)j * N * D, D, 0, T);
}
constexpr int CVT_DENSE_UNITS = 3200;
__device__ __forceinline__ void cvt_moe_unit(const Params& p, int layer, int unit, LAS float* T) {
    if (unit < 12288) { const int which = unit >= 6144; if (which) unit -= 6144; const int e = unit / 96, r = unit % 96, kt = r / 3, ntile = r % 3;
        const float* src = (which ? p.moe_w3 : p.moe_w1) + ((size_t)layer * NE + e) * D * DE;
        cvt_tile<128>(src, DE, kt * 64, ntile * 128, (h16*)(p.ws + WS_W13) + (size_t)e * DE2 * D, D, which ? 2 : 1, T); }
    else { unit -= 12288; const int e = unit / 48, r = unit % 48, kt = r / 8, ntile = r % 8;
        const float* src = p.moe_w2 + ((size_t)layer * NE + e) * DE * D;
        cvt_tile<256>(src, D, kt * 64, ntile * 256, (h16*)(p.ws + WS_W2) + (size_t)e * D * DE, DE, 0, T); }
}
constexpr int CVT_MOE_UNITS = 15360;
struct CvtD { const float* src; h16* dst; int mode; };
__device__ __forceinline__ CvtD cvt13_desc(const Params& p, int layer, int unit) {
    const int which = unit >= 6144; if (which) unit -= 6144; const int e = unit / 96, r = unit % 96, kt = r / 3, ntile = r % 3;
    CvtD d; d.src = (which ? p.moe_w3 : p.moe_w1) + ((size_t)layer * NE + e) * D * DE + (size_t)(kt * 64) * DE + ntile * 128;
    d.dst = (h16*)(p.ws + WS_W13) + (size_t)e * DE2 * D + kt * 64; d.mode = (which ? 4 : 0) + 8 * (256 * ntile); return d;
}
__device__ __forceinline__ void cvt13_load(const CvtD& d, f32x4 (&v)[4], int tid) {
#pragma unroll
    for (int ps = 0; ps < 4; ++ps) { const int idx = ps * 512 + tid, k = idx >> 5, n4 = idx & 31; v[ps] = *(const f32x4*)(d.src + (size_t)k * DE + 4 * n4); }
}
__device__ __forceinline__ void cvt13_store(const CvtD& d, const f32x4 (&v)[4], LAS float* T, int tid) {
    constexpr int P = 129;
#pragma unroll
    for (int ps = 0; ps < 4; ++ps) { const int idx = ps * 512 + tid, k = idx >> 5, n4 = idx & 31; LAS float* q = T + k * P + 4 * n4; q[0] = v[ps][0]; q[1] = v[ps][1]; q[2] = v[ps][2]; q[3] = v[ps][3]; }
    __syncthreads();
    const int w3off = d.mode & 7, rg0 = d.mode >> 3;
#pragma unroll
    for (int ps = 0; ps < 2; ++ps) { const int item = ps * 512 + tid, kc = item & 7, n = item >> 3; f16x8 w;
#pragma unroll
        for (int i = 0; i < 8; ++i) w[i] = (h16)T[(8 * kc + i) * P + n];
        const int row = rg0 + 8 * (n >> 2) + (n & 3) + w3off;
        *(f16x8*)(d.dst + (size_t)row * D + 8 * kc) = w; }
    __syncthreads();
}
__device__ __forceinline__ void cvt_moe_share(const Params& p, int layer, int u0, int n, int stride, LAS float* T) {
    const int tid = tid_fresh(); const int n13 = n < 12288 ? n : 12288;
    int u = u0;
    if (u < n13) {
        CvtD dA = cvt13_desc(p, layer, u), dB = dA, dC = dA; f32x4 vA[4], vB[4], vC[4];
        cvt13_load(dA, vA, tid);
        if (u + stride < n13) { dB = cvt13_desc(p, layer, u + stride); cvt13_load(dB, vB, tid); }
        for (;;) {
            if (u + 2 * stride < n13) { dC = cvt13_desc(p, layer, u + 2 * stride); cvt13_load(dC, vC, tid); }
            cvt13_store(dA, vA, T, tid); u += stride; if (u >= n13) break;
            if (u + 2 * stride < n13) { dA = cvt13_desc(p, layer, u + 2 * stride); cvt13_load(dA, vA, tid); }
            cvt13_store(dB, vB, T, tid); u += stride; if (u >= n13) break;
            if (u + 2 * stride < n13) { dB = cvt13_desc(p, layer, u + 2 * stride); cvt13_load(dB, vB, tid); }
            cvt13_store(dC, vC, T, tid); u += stride; if (u >= n13) break;
        }
    }
    for (; u < n; u += stride) cvt_moe_unit(p, layer, u, T);
}

template <int NR, bool FINAL>
__device__ __forceinline__ void n1_rows(const Params& p, int layer, int r0, int rstride, int lane) {
    float* xres = (float*)(p.ws + WS_XRES); h16* hb = (h16*)(p.ws + WS_HBUF); const h16* yc = (const h16*)(p.ws + WS_YC); const float* mods = (const float*)(p.ws + WS_MODS);
    f32x4 v[NR][8]; f16x4 ya[NR][8], yb[NR][8];
    const bool comb = FINAL || layer > 0; const int lprev = FINAL ? 3 : layer - 1;
#pragma unroll
    for (int q = 0; q < NR; ++q) { const int r = r0 + q * rstride;
        const float* src = (!FINAL && layer == 0) ? (r < TL ? p.x + (size_t)r * D : p.ctx + (size_t)(r - TL) * D) : xres + (size_t)r * D;
#pragma unroll
        for (int c = 0; c < 8; ++c) v[q][c] = *(const f32x4*)(src + c * 256 + lane * 4);
        if (comb) { const h16* y0 = yc + (size_t)(2 * r) * D; const h16* y1 = y0 + D;
#pragma unroll
            for (int c = 0; c < 8; ++c) { ya[q][c] = *(const f16x4*)(y0 + c * 256 + lane * 4); yb[q][c] = *(const f16x4*)(y1 + c * 256 + lane * 4); } } }
#pragma unroll
    for (int q = 0; q < NR; ++q) { const int r = r0 + q * rstride; const int b = batch_of_row(r);
        if (comb) { const float* g2 = mods + ((size_t)(lprev * 9 + b) * 6 + 5) * D;
#pragma unroll
            for (int c = 0; c < 8; ++c) { const f32x4 g = *(const f32x4*)(g2 + c * 256 + lane * 4);
#pragma unroll
                for (int i = 0; i < 4; ++i) v[q][c][i] += g[i] * ((float)ya[q][c][i] + (float)yb[q][c][i]); } }
        float ss = 0.f;
#pragma unroll
        for (int c = 0; c < 8; ++c) { if (!FINAL) *(f32x4*)(xres + (size_t)r * D + c * 256 + lane * 4) = v[q][c]; ss += v[q][c][0] * v[q][c][0] + v[q][c][1] * v[q][c][1] + v[q][c][2] * v[q][c][2] + v[q][c][3] * v[q][c][3]; }
        ss = wave_sum(ss); const float rs = 1.0f / sqrtf(ss * (1.0f / D) + EPS);
        if (FINAL) {
#pragma unroll
            for (int c = 0; c < 8; ++c) { const int col = c * 256 + lane * 4; const f32x4 g = *(const f32x4*)(p.final_gain + col); *(f32x4*)(p.out + (size_t)r * D + col) = v[q][c] * rs * g; }
        } else {
            const float* sh = mods + ((size_t)(layer * 9 + b) * 6 + 0) * D; const float* sc = sh + D;
#pragma unroll
            for (int c = 0; c < 8; ++c) { const int col = c * 256 + lane * 4; const f32x4 s0 = *(const f32x4*)(sh + col), s1 = *(const f32x4*)(sc + col); f16x4 w;
#pragma unroll
                for (int i = 0; i < 4; ++i) w[i] = (h16)(v[q][c][i] * rs * (1.0f + s1[i]) + s0[i]);
                *(f16x4*)(hb + (size_t)r * D + col) = w; }
        } }
}
template <bool FINAL>
__device__ __forceinline__ void n1_any(const Params& p, int layer) {
    const int tid = tid_fresh(), lane = tid & 63, gw = blockIdx.x * 8 + __builtin_amdgcn_readfirstlane(tid >> 6), nw = gridDim.x * 8; const int nrow = FINAL ? TL : TT;
    int r = gw;
    for (; r + nw < nrow; r += 2 * nw) n1_rows<2, FINAL>(p, layer, r, nw, lane);
    if (r < nrow) n1_rows<1, FINAL>(p, layer, r, nw, lane);
}
__device__ __forceinline__ void n1_phase(const Params& p, int layer) { n1_any<false>(p, layer); }
__device__ __forceinline__ void final_phase(const Params& p) { n1_any<true>(p, 0); }
constexpr int N2_CH = 4;
constexpr int N2_SLOT = N2_CH * 10 * 1024;
constexpr int N2_XT = 2 * N2_SLOT;
constexpr int N2_SC = N2_XT + 8 * 4096;
#ifndef PROBE_N2VAR
#define PROBE_N2VAR 0
#endif
__device__ __forceinline__ void n2_phase(const Params& p, int layer, LAS unsigned char* lds, int ctr_shadow) {
    const bool pv_tail = !(ctr_shadow && (PROBE_N2VAR & 1)), pv_store = !(ctr_shadow && (PROBE_N2VAR & 2)), pv_mma = !(ctr_shadow && (PROBE_N2VAR & 4));
    const int tid = tid_fresh(), lane = tid & 63, wv = __builtin_amdgcn_readfirstlane(tid >> 6), r16 = lane & 15, kg = lane >> 4;
    const int lrow = lane >> 3, lchk = lane & 7;
    const float* xres = (const float*)(p.ws + WS_XRES); h16* hb = (h16*)(p.ws + WS_HBUF); const float* mods = (const float*)(p.ws + WS_MODS);
    const char* rtb = p.ws + WS_RTAB + (size_t)layer * RTAB_L; const float* ssq = (const float*)(p.ws + WS_SSQ);
    int* counters = (int*)(p.ws + WS_CTL) + CTL_CNT + (layer + (ctr_shadow ? 4 : 0)) * NE; int* list = (int*)(p.ws + WS_LIST); float* gate = (float*)(p.ws + WS_GATE);
    LAS float* scr = (LAS float*)lds + wv * (16 * 80);
    LAS float* scl = (LAS float*)(lds + N2_SC); LAS float* shl = scl + D;
    LAS int* hist = (LAS int*)(lds + LDS_MISC); LAS int* hbase = hist + NE;
    LAS unsigned char* xt = lds + N2_XT + wv * 4096;
    const int sxw = ((lrow >> 1) & 1) | (((lrow >> 2) & 1) << 2), sxr = ((r16 >> 1) & 1) | (((r16 >> 2) & 1) << 2);
    const int xw_off = lrow * 128 + 16 * (lchk ^ sxw);
    const int xr_off0 = r16 * 128 + 16 * ((2 * kg) ^ sxr), xr_off1 = r16 * 128 + 16 * ((2 * kg + 1) ^ sxr);
    const int hw_off0 = r16 * 128 + 16 * (kg ^ (r16 & 7)), hw_off1 = r16 * 128 + 16 * ((4 + kg) ^ (r16 & 7));
    const int hr_off = lrow * 128 + 16 * (lchk ^ (lrow & 7));
    const int ntask = (layer == NLAYER - 1 ? TL : TT) / 16, nfull = (int)gridDim.x * 8;
#pragma unroll 1
    for (int round = 0; round < 2; ++round) {
        const int nrem = ntask - nfull;
        if (round == 1 && (int)blockIdx.x >= nrem) break;
        const int task = round == 0 ? (int)blockIdx.x * 8 + wv : nfull + (int)blockIdx.x;
        const bool active = round == 0 ? (task < ntask) : true;
        const int trow = active ? task * 16 : 0;
        const int b = batch_of_row(trow);
        const float* xg0 = xres + (size_t)(trow + lrow) * D + lchk * 4; const float* xg1 = xg0 + (size_t)8 * D;
        h16* hg0 = hb + (size_t)(trow + lrow) * D + lchk * 8; h16* hg1 = hg0 + (size_t)8 * D;
        float rs;
        { const float* sp = ssq + (size_t)(trow + r16) * 32; float t = 0.f;
#pragma unroll
            for (int q = 0; q < 8; ++q) { const f32x4 v = *(const f32x4*)(sp + 4 * q); t += (v[0] + v[1]) + (v[2] + v[3]); }
            rs = 1.0f / sqrtf(t * (1.0f / D) + EPS); }
        f32x4 acc[5];
#pragma unroll
        for (int ct = 0; ct < 5; ++ct) acc[ct] = (f32x4){0.f, 0.f, 0.f, 0.f};
        __syncthreads();
        if (tid < NE) hist[tid] = 0;
        { const float* scb = mods + ((size_t)(layer * 9 + b) * 6 + 4) * D; *(LAS f32x4*)(scl + tid * 4) = *(const f32x4*)(scb + tid * 4); *(LAS f32x4*)(shl + tid * 4) = *(const f32x4*)(scb - D + tid * 4); }
        if (round == 0) {
        f16x8 bq[5];
#pragma unroll
        for (int q = 0; q < 5; ++q) bq[q] = *(const f16x8*)(rtb + (size_t)(5 * wv + q) * 1024 + lane * 16);
#pragma unroll
        for (int q = 0; q < 5; ++q) *(LAS f16x8*)(lds + (5 * wv + q) * 1024 + lane * 16) = bq[q];
#pragma unroll
        for (int q = 0; q < 5; ++q) bq[q] = *(const f16x8*)(rtb + (size_t)N2_SLOT + (size_t)(5 * wv + q) * 1024 + lane * 16);
        f32x4 x0[N2_CH][2], x1[N2_CH][2], x2[N2_CH][2];
#pragma unroll
        for (int s2 = 0; s2 < N2_CH; ++s2) { x0[s2][0] = *(const f32x4*)(xg0 + 32 * s2); x0[s2][1] = *(const f32x4*)(xg1 + 32 * s2);
            x1[s2][0] = *(const f32x4*)(xg0 + 32 * (N2_CH + s2)); x1[s2][1] = *(const f32x4*)(xg1 + 32 * (N2_CH + s2)); }
#define N2_CHUNK(XC, XL, CH) do { const int ch = (CH); \
            __syncthreads(); \
            const int nx2 = (ch + 2 < 64 / N2_CH) ? ch + 2 : ch; \
            {   LAS unsigned char* dst = lds + ((ch + 1) & 1) * N2_SLOT; \
 _Pragma("unroll") \
                for (int q = 0; q < 5; ++q) *(LAS f16x8*)(dst + (5 * wv + q) * 1024 + lane * 16) = bq[q]; } \
            {   const char* src = rtb + (size_t)nx2 * N2_SLOT; \
 _Pragma("unroll") \
                for (int q = 0; q < 5; ++q) bq[q] = *(const f16x8*)(src + (size_t)(5 * wv + q) * 1024 + lane * 16); } \
 _Pragma("unroll") \
            for (int s2 = 0; s2 < N2_CH; ++s2) { const int ko = 32 * (nx2 * N2_CH + s2); XL[s2][0] = *(const f32x4*)(xg0 + ko); XL[s2][1] = *(const f32x4*)(xg1 + ko); } \
            const LAS unsigned char* bs = lds + (ch & 1) * N2_SLOT + lane * 16; \
 _Pragma("unroll") \
            for (int pp = 0; pp < N2_CH / 2; ++pp) { \
 _Pragma("unroll") \
                for (int sp = 0; sp < 2; ++sp) { *(LAS f32x4*)(xt + sp * 2048 + xw_off) = XC[2 * pp + sp][0]; *(LAS f32x4*)(xt + sp * 2048 + 1024 + xw_off) = XC[2 * pp + sp][1]; } \
                f32x4 xf[2][2]; \
 _Pragma("unroll") \
                for (int sp = 0; sp < 2; ++sp) { xf[sp][0] = *(const LAS f32x4*)(xt + sp * 2048 + xr_off0); xf[sp][1] = *(const LAS f32x4*)(xt + sp * 2048 + xr_off1); } \
                f16x8 hk[2]; \
 _Pragma("unroll") \
                for (int sp = 0; sp < 2; ++sp) { \
                    const int s2 = 2 * pp + sp; const int ko = 32 * (ch * N2_CH + s2) + 8 * kg; \
                    const f32x4 c0 = *(const LAS f32x4*)(scl + ko), c1 = *(const LAS f32x4*)(scl + ko + 4), h0 = *(const LAS f32x4*)(shl + ko), h1 = *(const LAS f32x4*)(shl + ko + 4); \
                    f16x8 hi, lo; \
 _Pragma("unroll") \
                    for (int i = 0; i < 4; ++i) { const float a0 = xf[sp][0][i] * rs * (1.0f + c0[i]) + h0[i], a1 = xf[sp][1][i] * rs * (1.0f + c1[i]) + h1[i]; \
                        hi[i] = (h16)a0; lo[i] = (h16)(a0 - (float)hi[i]); hi[4 + i] = (h16)a1; lo[4 + i] = (h16)(a1 - (float)hi[4 + i]); } \
                    hk[sp] = hi; \
                    if (pv_mma) \
 _Pragma("unroll") \
                    for (int ct = 0; ct < 5; ++ct) { const f16x8 whi = *(const LAS f16x8*)(bs + (s2 * 10 + ct * 2 + 0) * 1024), wlo = *(const LAS f16x8*)(bs + (s2 * 10 + ct * 2 + 1) * 1024); \
                        acc[ct] = __builtin_amdgcn_mfma_f32_16x16x32_f16(hi, whi, acc[ct], 0, 0, 0); \
                        acc[ct] = __builtin_amdgcn_mfma_f32_16x16x32_f16(hi, wlo, acc[ct], 0, 0, 0); \
                        acc[ct] = __builtin_amdgcn_mfma_f32_16x16x32_f16(lo, whi, acc[ct], 0, 0, 0); } \
                } \
                *(LAS f16x8*)(xt + hw_off0) = hk[0]; *(LAS f16x8*)(xt + hw_off1) = hk[1]; \
                const f16x8 o0 = *(const LAS f16x8*)(xt + hr_off), o1 = *(const LAS f16x8*)(xt + 1024 + hr_off); \
                if (active && pv_store) { const int ho = 32 * (ch * N2_CH + 2 * pp); *(f16x8*)(hg0 + ho) = o0; *(f16x8*)(hg1 + ho) = o1; } \
            } \
        } while (0)
#pragma unroll 1
        for (int c3 = 0; c3 < 15; c3 += 3) { N2_CHUNK(x0, x2, c3); N2_CHUNK(x1, x0, c3 + 1); N2_CHUNK(x2, x1, c3 + 2); }
        N2_CHUNK(x0, x2, 15);
#undef N2_CHUNK
        } else {
            const char* rtw = rtb + (size_t)(8 * wv) * 10240; const int kb = 256 * wv;
            unsigned loff = (unsigned)lane * 16u; asm volatile("" : "+v"(loff));
            f16x8 bb[10];
            f32x4 xa[2][2][2];
#pragma unroll
            for (int sp = 0; sp < 2; ++sp) { xa[0][sp][0] = *(const f32x4*)(xg0 + kb + 32 * sp); xa[0][sp][1] = *(const f32x4*)(xg1 + kb + 32 * sp); }
#pragma unroll
            for (int pp = 0; pp < 4; ++pp) {
                if (pp < 3) {
#pragma unroll
                    for (int sp = 0; sp < 2; ++sp) { xa[(pp + 1) & 1][sp][0] = *(const f32x4*)(xg0 + kb + 32 * (2 * pp + 2 + sp)); xa[(pp + 1) & 1][sp][1] = *(const f32x4*)(xg1 + kb + 32 * (2 * pp + 2 + sp)); } }
#pragma unroll
                for (int sp = 0; sp < 2; ++sp) { *(LAS f32x4*)(xt + sp * 2048 + xw_off) = xa[pp & 1][sp][0]; *(LAS f32x4*)(xt + sp * 2048 + 1024 + xw_off) = xa[pp & 1][sp][1]; }
                f32x4 xf[2][2];
#pragma unroll
                for (int sp = 0; sp < 2; ++sp) { xf[sp][0] = *(const LAS f32x4*)(xt + sp * 2048 + xr_off0); xf[sp][1] = *(const LAS f32x4*)(xt + sp * 2048 + xr_off1); }
                f16x8 hk[2];
#pragma unroll
                for (int sp = 0; sp < 2; ++sp) {
                    const int st = 2 * pp + sp; const int ko = kb + 32 * st + 8 * kg;
#pragma unroll
                    for (int q = 0; q < 10; ++q) bb[q] = *(const f16x8*)(rtw + (size_t)(st * 10 + q) * 1024 + loff);
                    asm volatile("" ::: "memory");
                    const f32x4 c0 = *(const LAS f32x4*)(scl + ko), c1 = *(const LAS f32x4*)(scl + ko + 4), h0 = *(const LAS f32x4*)(shl + ko), h1 = *(const LAS f32x4*)(shl + ko + 4);
                    f16x8 hi, lo;
#pragma unroll
                    for (int i = 0; i < 4; ++i) { const float a0 = xf[sp][0][i] * rs * (1.0f + c0[i]) + h0[i], a1 = xf[sp][1][i] * rs * (1.0f + c1[i]) + h1[i];
                        hi[i] = (h16)a0; lo[i] = (h16)(a0 - (float)hi[i]); hi[4 + i] = (h16)a1; lo[4 + i] = (h16)(a1 - (float)hi[4 + i]); }
                    hk[sp] = hi;
#pragma unroll
                    for (int ct = 0; ct < 5; ++ct) {
                        acc[ct] = __builtin_amdgcn_mfma_f32_16x16x32_f16(hi, bb[2 * ct], acc[ct], 0, 0, 0);
                        acc[ct] = __builtin_amdgcn_mfma_f32_16x16x32_f16(hi, bb[2 * ct + 1], acc[ct], 0, 0, 0);
                        acc[ct] = __builtin_amdgcn_mfma_f32_16x16x32_f16(lo, bb[2 * ct], acc[ct], 0, 0, 0); }
                }
                *(LAS f16x8*)(xt + hw_off0) = hk[0]; *(LAS f16x8*)(xt + hw_off1) = hk[1];
                const f16x8 o0 = *(const LAS f16x8*)(xt + hr_off), o1 = *(const LAS f16x8*)(xt + 1024 + hr_off);
                if (pv_store) { const int ho = kb + 64 * pp; *(f16x8*)(hg0 + ho) = o0; *(f16x8*)(hg1 + ho) = o1; }
            }
        }
        __syncthreads();
#pragma unroll
        for (int ct = 0; ct < 5; ++ct)
#pragma unroll
            for (int i = 0; i < 4; ++i) scr[(4 * kg + i) * 80 + 16 * ct + r16] = acc[ct][i] * (1.0f / 256.0f);
        asm volatile("s_waitcnt lgkmcnt(0)" ::: "memory");
        int ea = 0, eb = 0, ra = 0, rb = 0; float g1v = 0.f, g2v = 0.f; const bool tok_lane = (round == 0 ? active : wv == 0) && lane < 16 && pv_tail;
        const int nparts = round == 0 ? 1 : 8;
        if (tok_lane) {
            const LAS float* lgr = scr + lane * 80;
#define N2_LG(c) ({ float _t = lgr[(c)]; for (int _w = 1; _w < nparts; ++_w) _t += lgr[_w * 1280 + (c)]; _t; })
            float gmax = -3.0e38f; int gsel = 0; float gl[8];
#pragma unroll
            for (int g = 0; g < 8; ++g) { gl[g] = N2_LG(g) + p.moe_bg[layer * 8 + g]; if (gl[g] > gmax) { gmax = gl[g]; gsel = g; } }
            float gz = 0.f;
#pragma unroll
            for (int g = 0; g < 8; ++g) gz += expf(gl[g] - gmax);
            const float pg = 1.0f / gz;
            float f1 = -3.0e38f, f2 = -3.0e38f; int i1 = 0, i2 = 0;
            for (int q = 0; q < 8; ++q) { const float f = N2_LG(8 + gsel * 8 + q) + p.moe_be[layer * 64 + gsel * 8 + q];
                if (f > f1) { f2 = f1; i2 = i1; f1 = f; i1 = q; } else if (f > f2) { f2 = f; i2 = q; } }
            const float e2 = expf(f2 - f1); g1v = pg / (1.0f + e2); g2v = pg * e2 / (1.0f + e2);
            ea = gsel * 8 + i1; eb = gsel * 8 + i2;
#undef N2_LG
            ra = __hip_atomic_fetch_add(hist + ea, 1, __ATOMIC_RELAXED, __HIP_MEMORY_SCOPE_WORKGROUP); rb = __hip_atomic_fetch_add(hist + eb, 1, __ATOMIC_RELAXED, __HIP_MEMORY_SCOPE_WORKGROUP);
        }
        __syncthreads();
        { const int t2 = tid_fresh(); if (t2 < NE && pv_tail) { const int n = hist[t2]; hbase[t2] = n ? atomicAdd(&counters[t2], n) : 0; } }
        __syncthreads();
        if (tok_lane) { const int tok = task * 16 + lane; const size_t sa = (size_t)ea * LCAP + hbase[ea] + ra, sb = (size_t)eb * LCAP + hbase[eb] + rb;
            list[sa] = 2 * tok; gate[sa] = g1v; list[sb] = 2 * tok + 1; gate[sb] = g2v; }
    }
}
__device__ __forceinline__ void transpose_phase(const Params& p, LAS h16* T) {
    const h16* zt = (const h16*)(p.ws + WS_ZT); h16* z = (h16*)(p.ws + WS_HBUF); const int tid = tid_fresh();
    const int ntile = (D / 64) * (TT / 64);
    for (int tile = blockIdx.x; tile < ntile; tile += gridDim.x) {
        const int td = tile % (D / 64), tt = tile / (D / 64); const int d0 = td * 64, t0 = tt * 64;
        { const int dr = tid >> 3, tc = (tid & 7) * 8; const f16x8 v = *(const f16x8*)(zt + (size_t)(d0 + dr) * TT + t0 + tc);
#pragma unroll
            for (int i = 0; i < 8; ++i) T[(tc + i) * 66 + dr] = v[i]; }
        __syncthreads();
        { const int tr = tid >> 3, dc = (tid & 7) * 8; f16x8 v;
#pragma unroll
            for (int i = 0; i < 8; ++i) v[i] = T[tr * 66 + dc + i];
            *(f16x8*)(z + (size_t)(t0 + tr) * D + d0 + dc) = v; }
        __syncthreads();
    }
}

__device__ __forceinline__ f32x2 cmul(const f32x2 a, const f32x2 b) { return (f32x2){a.x * b.x - a.y * b.y, a.x * b.y + a.y * b.x}; }
__device__ __forceinline__ f32x2 cmulc(const f32x2 a, const f32x2 b) { return (f32x2){a.x * b.x + a.y * b.y, a.y * b.x - a.x * b.y}; }
__device__ __forceinline__ f32x2 cconj(const f32x2 a) { return (f32x2){a.x, -a.y}; }
template <bool INV> __device__ __forceinline__ f32x2 mul_mi(const f32x2 a) { return INV ? (f32x2){-a.y, a.x} : (f32x2){a.y, -a.x}; }
template <bool INV> __device__ __forceinline__ void dft4(f32x2& a, f32x2& b, f32x2& c, f32x2& d) {
    const f32x2 s0 = a + c, s1 = a - c, s2 = b + d, s3 = mul_mi<INV>(b - d);
    a = s0 + s2; b = s1 + s3; c = s0 - s2; d = s1 - s3;
}
template <bool INV, int M> __device__ __forceinline__ f32x2 w16mul(const f32x2 a) {
    constexpr float C1 = 0.92387953251128674f, S1 = 0.38268343236508977f, R = 0.70710678118654752f;
    constexpr float cr = (M == 0) ? 1.f : (M == 1) ? C1 : (M == 2) ? R : (M == 3) ? S1 : (M == 4) ? 0.f : (M == 6) ? -R :   -C1;
    constexpr float ci0 = (M == 0) ? 0.f : (M == 1) ? -S1 : (M == 2) ? -R : (M == 3) ? -C1 : (M == 4) ? -1.f : (M == 6) ? -R :   S1;
    constexpr float ci = INV ? -ci0 : ci0;
    return (f32x2){a.x * cr - a.y * ci, a.x * ci + a.y * cr};
}
template <bool INV> __device__ __forceinline__ void dft16(f32x2 (&v)[16]) {
#pragma unroll
    for (int n2 = 0; n2 < 4; ++n2) dft4<INV>(v[n2], v[4 + n2], v[8 + n2], v[12 + n2]);
    v[5] = w16mul<INV, 1>(v[5]); v[6] = w16mul<INV, 2>(v[6]); v[7] = w16mul<INV, 3>(v[7]);
    v[9] = w16mul<INV, 2>(v[9]); v[10] = w16mul<INV, 4>(v[10]); v[11] = w16mul<INV, 6>(v[11]);
    v[13] = w16mul<INV, 3>(v[13]); v[14] = w16mul<INV, 6>(v[14]); v[15] = w16mul<INV, 9>(v[15]);
#pragma unroll
    for (int k1 = 0; k1 < 4; ++k1) dft4<INV>(v[4 * k1], v[4 * k1 + 1], v[4 * k1 + 2], v[4 * k1 + 3]);
    f32x2 t;
    t = v[1]; v[1] = v[4]; v[4] = t; t = v[2]; v[2] = v[8]; v[8] = t; t = v[3]; v[3] = v[12]; v[12] = t;
    t = v[6]; v[6] = v[9]; v[9] = t; t = v[7]; v[7] = v[13]; v[13] = t; t = v[11]; v[11] = v[14]; v[14] = t;
}
__device__ __forceinline__ int fphys(int i) { return i + (i >> 4); }
__device__ __forceinline__ f32x2 w32c(int j) {
    constexpr float c[16] = {1.f, 0.98078528040323043f, 0.92387953251128674f, 0.83146961230254524f, 0.70710678118654752f, 0.55557023301960218f, 0.38268343236508977f, 0.19509032201612825f,
                             0.f, -0.19509032201612825f, -0.38268343236508977f, -0.55557023301960218f, -0.70710678118654752f, -0.83146961230254524f, -0.92387953251128674f, -0.98078528040323043f};
    constexpr float s[16] = {0.f, 0.19509032201612825f, 0.38268343236508977f, 0.55557023301960218f, 0.70710678118654752f, 0.83146961230254524f, 0.92387953251128674f, 0.98078528040323043f,
                             1.f, 0.98078528040323043f, 0.92387953251128674f, 0.83146961230254524f, 0.70710678118654752f, 0.55557023301960218f, 0.38268343236508977f, 0.19509032201612825f};
    return (f32x2){c[j], -s[j]};
}
template <int S>
__device__ __forceinline__ void fft_fwd0(const f32x2 (&xe)[16], const f32x2 (&xo)[16], LAS f32x2* E, LAS f32x2* O, int t, const f32x2* tw) {
    const f32x2 u = tw[t * (256 / S)]; const f32x2 u2 = cmul(u, u);
    f32x2 y[16];
#pragma unroll
    for (int j = 0; j < 16; ++j) y[j] = xe[j];
    dft16<false>(y);
    constexpr int QS = S + S / 16;
    LAS f32x2* Eb = E + fphys(t); LAS f32x2* Ob = O + fphys(t);
    f32x2 pw = u2; Eb[0] = y[0];
#pragma unroll
    for (int q = 1; q < 16; ++q) { Eb[QS * q] = cmul(y[q], pw); pw = cmul(pw, u2); }
#pragma unroll
    for (int j = 0; j < 16; ++j) y[j] = cmul(xo[j], w32c(j));
    dft16<false>(y);
    pw = u;
#pragma unroll
    for (int q = 0; q < 16; ++q) { Ob[QS * q] = cmul(y[q], pw); pw = cmul(pw, u2); }
}
template <bool INV> __device__ __forceinline__ void fft_pass1(LAS f32x2* A, int tau, const f32x2* tw) {
    const int i = tau & 15, base = (tau >> 4) << 8; const f32x2 u0 = tw[32 * i]; const f32x2 u = INV ? cconj(u0) : u0;
    f32x2 y[16]; LAS f32x2* Ab = A + fphys(base + i);
#pragma unroll
    for (int j = 0; j < 16; ++j) y[j] = Ab[17 * j];
    if (INV) { f32x2 pw = u;
#pragma unroll
        for (int q = 1; q < 16; ++q) { y[q] = cmul(y[q], pw); pw = cmul(pw, u); } }
    dft16<INV>(y);
    if (!INV) { f32x2 pw = u;
#pragma unroll
        for (int q = 1; q < 16; ++q) { y[q] = cmul(y[q], pw); pw = cmul(pw, u); } }
#pragma unroll
    for (int j = 0; j < 16; ++j) Ab[17 * j] = y[j];
}
template <bool INV> __device__ __forceinline__ void fft_pass1_pair(LAS f32x2* A, LAS f32x2* B, int tau, const f32x2* tw) {
    const int i = tau & 15, base = (tau >> 4) << 8; const f32x2 u0 = tw[32 * i]; const f32x2 u = INV ? cconj(u0) : u0;
    f32x2 y[16], z[16]; LAS f32x2* Ab = A + fphys(base + i); LAS f32x2* Bb = B + fphys(base + i);
#pragma unroll
    for (int j = 0; j < 16; ++j) y[j] = Ab[17 * j];
#pragma unroll
    for (int j = 0; j < 16; ++j) z[j] = Bb[17 * j];
    f32x2 pwr[16]; pwr[1] = u;
#pragma unroll
    for (int q = 2; q < 16; ++q) pwr[q] = cmul(pwr[q - 1], u);
    if (INV) {
#pragma unroll
        for (int q = 1; q < 16; ++q) y[q] = cmul(y[q], pwr[q]); }
    dft16<INV>(y);
    if (!INV) {
#pragma unroll
        for (int q = 1; q < 16; ++q) y[q] = cmul(y[q], pwr[q]); }
#pragma unroll
    for (int j = 0; j < 16; ++j) Ab[17 * j] = y[j];
    if (INV) {
#pragma unroll
        for (int q = 1; q < 16; ++q) z[q] = cmul(z[q], pwr[q]); }
    dft16<INV>(z);
    if (!INV) {
#pragma unroll
        for (int q = 1; q < 16; ++q) z[q] = cmul(z[q], pwr[q]); }
#pragma unroll
    for (int j = 0; j < 16; ++j) Bb[17 * j] = z[j];
}
__device__ __forceinline__ void fft_fwd2(const LAS f32x2* A, int t, f32x2 (&y)[16]) {
#pragma unroll
    for (int j = 0; j < 16; ++j) y[j] = A[17 * t + j];
    dft16<false>(y);
}
__device__ __forceinline__ void kf_load(const f32x2* kf, f32x4 (&k)[8]) {
#pragma unroll
    for (int j = 0; j < 8; ++j) k[j] = *(const f32x4*)(kf + 2 * j);
}
__device__ __forceinline__ void fft_mid(LAS f32x2* A, int t, const f32x4 (&k)[8]) {
    f32x2 y[16];
    fft_fwd2(A, t, y);
#pragma unroll
    for (int j = 0; j < 8; ++j) { y[2 * j] = cmul(y[2 * j], (f32x2){k[j][0], k[j][1]}); y[2 * j + 1] = cmul(y[2 * j + 1], (f32x2){k[j][2], k[j][3]}); }
    dft16<true>(y);
#pragma unroll
    for (int j = 0; j < 16; ++j) A[17 * t + j] = y[j];
}
template <int S>
__device__ __forceinline__ void fft_inv0(const LAS f32x2* E, const LAS f32x2* O, int t, const f32x2* tw, f32x2 (&out)[16]) {
    const f32x2 u = tw[t * (256 / S)]; const f32x2 u2 = cmul(u, u);
    f32x2 y[16];
    constexpr int QS = S + S / 16;
    const LAS f32x2* Eb = E + fphys(t); const LAS f32x2* Ob = O + fphys(t);
    f32x2 pw = u2; y[0] = Eb[0];
#pragma unroll
    for (int q = 1; q < 16; ++q) { y[q] = cmulc(Eb[QS * q], pw); pw = cmul(pw, u2); }
    dft16<true>(y);
#pragma unroll
    for (int j = 0; j < 16; ++j) out[j] = y[j];
    pw = u;
#pragma unroll
    for (int q = 0; q < 16; ++q) { y[q] = cmulc(Ob[QS * q], pw); pw = cmul(pw, u2); }
    dft16<true>(y);
#pragma unroll
    for (int j = 0; j < 16; ++j) out[j] += cmulc(y[j], w32c(j));
}
__device__ __forceinline__ float hy_absdelta(int d) { return fabsf(-3.0701134573253943f + (-15.350567286626973f + 3.0701134573253943f) * ((float)d / 2047.0f)); }

__device__ __forceinline__ void filt_fft_phase(const Params& p, LAS unsigned char* lds) {
    const int tid = tid_fresh();
    const f32x2* tw = (const f32x2*)(p.ws + WS_TW);
    {
        const int grp = tid >> 8, tau = tid & 255;
        LAS f32x2* E = (LAS f32x2*)(lds + grp * 69632); LAS f32x2* O = E + 4352; LAS float* red = (LAS float*)(lds + LDS_MISC) + grp * 8;
        for (int pb = blockIdx.x * 2 + grp; pb < 2 * 2 * 2048; pb += gridDim.x * 2) {
            const int d = pb & 2047, n = (pb >> 11) & 1, j = pb >> 12;
            const float* tf = (const float*)(p.ws + WS_TAPS) + ((size_t)j * 8192 + (size_t)(n * 2 + 0) * D + d) * 4096;
            const float* tb = tf + (size_t)D * 4096;
            const float adel = hy_absdelta(d); const float tscale = 1.0f / 4095.0f;
            f32x2 xe[16], xo[16]; float ss = 0.f;
#pragma unroll
            for (int jj = 0; jj < 16; ++jj) { const int nn = tau + 256 * jj;
                const float klo = tf[nn] * expf(-(float)nn * tscale * adel);
                const int m = 4096 - nn;
                const float khi = (m < 4096) ? tb[m & 4095] * expf(-(float)m * tscale * adel) : 0.f;
                ss += klo * klo + khi * khi; xe[jj] = (f32x2){klo + khi, 0.f}; xo[jj] = (f32x2){klo - khi, 0.f}; }
            ss = wave_sum(ss);
            if ((tid & 63) == 0) red[(tid >> 6) & 3] = ss;
            fft_fwd0<256>(xe, xo, E, O, tau, tw);
            __syncthreads();
            const float tot = red[0] + red[1] + red[2] + red[3];
            const float scale = (1.0f / sqrtf(tot + EPS)) * (1.0f / 8192.0f);
            const float hbs = p.hy_bias[((size_t)j * 2 + n) * D + d] * (1.0f / 8192.0f);
            fft_pass1<false>(E, tau, tw); fft_pass1<false>(O, tau, tw);
            __syncthreads();
            f32x2* kf = (f32x2*)(p.ws + WS_KF) + (size_t)pb * 8192 + (size_t)tau * 16;
            f32x2 y[16];
            fft_fwd2(E, tau, y);
#pragma unroll
            for (int q = 0; q < 8; ++q) *(f32x4*)(kf + 2 * q) = (f32x4){y[2 * q].x * scale + hbs, y[2 * q].y * scale, y[2 * q + 1].x * scale + hbs, y[2 * q + 1].y * scale};
            fft_fwd2(O, tau, y);
#pragma unroll
            for (int q = 0; q < 8; ++q) *(f32x4*)(kf + 4096 + 2 * q) = (f32x4){y[2 * q].x * scale + hbs, y[2 * q].y * scale, y[2 * q + 1].x * scale + hbs, y[2 * q + 1].y * scale};
            __syncthreads();
        }
    }
    {
        const int pr = tid >> 4, i = tid & 15;
        LAS f32x2* E = (LAS f32x2*)(lds + pr * 4352); LAS f32x2* O = E + 272;
        for (int it = blockIdx.x; it < 256; it += gridDim.x) {
            const int pb = it * 32 + pr; const int d = pb & 2047, n = (pb >> 11) & 1, j = pb >> 12;
            const float* tf = (const float*)(p.ws + WS_TAPSC) + ((size_t)j * 8192 + (size_t)(n * 2 + 0) * D + d) * 256;
            const float* tb = tf + (size_t)D * 256;
            const float adel = hy_absdelta(d); const float tscale = 1.0f / 255.0f;
            f32x2 xe[16], xo[16]; float ss = 0.f;
#pragma unroll
            for (int jj = 0; jj < 16; ++jj) { const int nn = i + 16 * jj;
                const float klo = tf[nn] * expf(-(float)nn * tscale * adel);
                const int m = 256 - nn;
                const float khi = (m < 256) ? tb[m & 255] * expf(-(float)m * tscale * adel) : 0.f;
                ss += klo * klo + khi * khi; xe[jj] = (f32x2){klo + khi, 0.f}; xo[jj] = (f32x2){klo - khi, 0.f}; }
            ss += shx(ss, 8); ss += shx(ss, 4); ss += shx(ss, 2); ss += shx(ss, 1);
            const float scale = (1.0f / sqrtf(ss + EPS)) * (1.0f / 512.0f);
            const float hbs = p.hy_bias[((size_t)j * 2 + n) * D + d] * (1.0f / 512.0f);
            fft_fwd0<16>(xe, xo, E, O, i, tw);
            __syncthreads();
            f32x2* kf = (f32x2*)(p.ws + WS_KFC) + (size_t)pb * 512 + (size_t)i * 16;
            f32x2 y[16];
            fft_fwd2(E, i, y);
#pragma unroll
            for (int q = 0; q < 8; ++q) *(f32x4*)(kf + 2 * q) = (f32x4){y[2 * q].x * scale + hbs, y[2 * q].y * scale, y[2 * q + 1].x * scale + hbs, y[2 * q + 1].y * scale};
            fft_fwd2(O, i, y);
#pragma unroll
            for (int q = 0; q < 8; ++q) *(f32x4*)(kf + 256 + 2 * q) = (f32x4){y[2 * q].x * scale + hbs, y[2 * q].y * scale, y[2 * q + 1].x * scale + hbs, y[2 * q + 1].y * scale};
            __syncthreads();
        }
    }
}

__device__ __forceinline__ float conv3_lds(const LAS h16* row, int n, float w0, float w1, float w2, float b) { return (float)row[n - 1] * w0 + (float)row[n] * w1 + (float)row[n + 1] * w2 + b; }
constexpr int ST_P = 4112, STS_P = 272;

#ifndef PROBE_CVAR
#define PROBE_CVAR 0
#endif
__device__ __forceinline__ void conv_phase(const Params& p, int jl, LAS unsigned char* lds, int pvar = 0, int cvt_layer = -1, int cvt_n = 0) {
    const int tid = tid_fresh(); const bool cv_outer = !(pvar && (PROBE_CVAR & 1)), cv_inner = !(pvar && (PROBE_CVAR & 2));
    const f32x2* tw = (const f32x2*)(p.ws + WS_TW);
    const h16* ut = (const h16*)(p.ws + WS_UT); h16* zt = (h16*)(p.ws + WS_ZT);
    const float* cw = p.hy_conv_w + (size_t)jl * 3 * D3; const float* cb = p.hy_conv_b + (size_t)jl * D3;
    {
        const int grp = tid >> 8, tau = tid & 255;
        LAS f32x2* E = (LAS f32x2*)(lds + grp * 69632); LAS f32x2* O = E + 4352; LAS h16* ST = (LAS h16*)E;
        int uit = 0; const int utrig = 4 * (((int)blockIdx.x >> 3) & 3);
        for (int unit = blockIdx.x; unit < 4096; unit += gridDim.x, ++uit) {
            if (cvt_layer >= 0 && uit == utrig) { __syncthreads(); cvt_moe_share(p, cvt_layer, blockIdx.x, cvt_n, gridDim.x, (LAS float*)lds); }
            const int ux = unit & 7, uj = unit >> 3; const int hq = uj & 1, d = (uj >> 1) * 8 + ux; const size_t col0 = (size_t)(4 * hq + 2 * grp) * 4096;
            const f32x2* kfb = (const f32x2*)(p.ws + WS_KF) + ((size_t)(jl * 2) * 2048 + d) * 8192 + (size_t)tau * 16;
            f16x8 raw[2][2][2], raw2[2][2];
#pragma unroll
            for (int sq = 0; sq < 2; ++sq)
#pragma unroll
                for (int bb = 0; bb < 2; ++bb)
#pragma unroll
                    for (int k = 0; k < 2; ++k) raw[sq][bb][k] = *(const f16x8*)(ut + (size_t)(sq * D + d) * TT + col0 + (size_t)bb * 4096 + (size_t)(tau + 256 * k) * 8);
            __syncthreads();
#pragma unroll
            for (int sq = 0; sq < 2; ++sq)
#pragma unroll
                for (int bb = 0; bb < 2; ++bb)
#pragma unroll
                    for (int k = 0; k < 2; ++k) *(LAS f16x8*)(ST + (sq * 2 + bb) * ST_P + 8 + (tau + 256 * k) * 8) = raw[sq][bb][k];
            if (tau < 4) { ST[tau * ST_P + 7] = (h16)0.f; ST[tau * ST_P + 8 + 4096] = (h16)0.f; }
            __syncthreads();
            f32x2 xin[16], gk[16], y[16];
            { const float w0 = cw[d], w1 = cw[D3 + d], w2 = cw[2 * D3 + d], bv = cb[d]; const float g0 = cw[D + d], g1 = cw[D3 + D + d], g2 = cw[2 * D3 + D + d], gb = cb[D + d];
#pragma unroll
                for (int jj = 0; jj < 16; ++jj) { const int nn = tau + 256 * jj;
                    xin[jj] = (f32x2){conv3_lds(ST + 8, nn, w0, w1, w2, bv), conv3_lds(ST + ST_P + 8, nn, w0, w1, w2, bv)};
                    gk[jj] = (f32x2){conv3_lds(ST + 2 * ST_P + 8, nn, g0, g1, g2, gb), conv3_lds(ST + 3 * ST_P + 8, nn, g0, g1, g2, gb)}; } }
            __syncthreads();
#pragma unroll 1
            for (int ord = 0; ord < 2; ++ord) {
                if (cv_outer) fft_fwd0<256>(xin, xin, E, O, tau, tw);
                const f32x2* kf = kfb + (size_t)ord * 2048 * 8192; f32x4 kfe[8], kfo[8];
                kf_load(kf, kfe);
                __syncthreads();
                if (cv_inner) fft_pass1_pair<false>(E, O, tau, tw);
                kf_load(kf + 4096, kfo);
                __syncthreads();
                if (cv_inner) { fft_mid(E, tau, kfe); fft_mid(O, tau, kfo); }
                if (ord == 0) {
#pragma unroll
                    for (int bb = 0; bb < 2; ++bb)
#pragma unroll
                        for (int k = 0; k < 2; ++k) raw2[bb][k] = *(const f16x8*)(ut + (size_t)(2 * D + d) * TT + col0 + (size_t)bb * 4096 + (size_t)(tau + 256 * k) * 8); }
                __syncthreads();
                if (cv_inner) fft_pass1_pair<true>(E, O, tau, tw);
                __syncthreads();
                if (cv_outer) fft_inv0<256>(E, O, tau, tw, y); else {
#pragma unroll
                    for (int jj = 0; jj < 16; ++jj) y[jj] = xin[jj]; }
#pragma unroll
                for (int jj = 0; jj < 16; ++jj) xin[jj] = gk[jj] * y[jj];
                if (ord == 0) {
                    __syncthreads();
#pragma unroll
                    for (int bb = 0; bb < 2; ++bb)
#pragma unroll
                        for (int k = 0; k < 2; ++k) *(LAS f16x8*)(ST + bb * ST_P + 8 + (tau + 256 * k) * 8) = raw2[bb][k];
                    if (tau < 2) { ST[tau * ST_P + 7] = (h16)0.f; ST[tau * ST_P + 8 + 4096] = (h16)0.f; }
                    __syncthreads();
                    const float g0 = cw[2 * D + d], g1 = cw[D3 + 2 * D + d], g2 = cw[2 * D3 + 2 * D + d], gb = cb[2 * D + d];
#pragma unroll
                    for (int jj = 0; jj < 16; ++jj) { const int nn = tau + 256 * jj; gk[jj] = (f32x2){conv3_lds(ST + 8, nn, g0, g1, g2, gb), conv3_lds(ST + ST_P + 8, nn, g0, g1, g2, gb)}; }
                    __syncthreads();
                }
            }
            h16* o0 = zt + (size_t)d * TT + col0; h16* o1 = o0 + 4096;
#pragma unroll
            for (int jj = 0; jj < 16; ++jj) { const int nn = tau + 256 * jj; o0[nn] = (h16)xin[jj].x; o1[nn] = (h16)xin[jj].y; }
        }
    }
    {
        const int pr = tid >> 4, i = tid & 15, c8 = pr >> 2, bp = pr & 3;
        LAS f32x2* E = (LAS f32x2*)(lds + pr * 4352); LAS f32x2* O = E + 272; LAS h16* ST = (LAS h16*)lds;
        for (int unit = blockIdx.x; unit < 256; unit += gridDim.x) {
            const int d0 = unit * 8, d = d0 + c8;
            const f32x2* kfb = (const f32x2*)(p.ws + WS_KFC) + ((size_t)(jl * 2) * 2048 + d) * 512 + (size_t)i * 16;
            f16x8 raw[3][4];
#pragma unroll
            for (int sq = 0; sq < 3; ++sq)
#pragma unroll
                for (int k = 0; k < 4; ++k) { const int q = tid + 512 * k, row = q >> 5, ch = q & 31;
                    raw[sq][k] = *(const f16x8*)(ut + (size_t)(sq * D + d0 + (row >> 3)) * TT + TL + (row & 7) * 256 + ch * 8); }
            __syncthreads();
#pragma unroll
            for (int sq = 0; sq < 2; ++sq)
#pragma unroll
                for (int k = 0; k < 4; ++k) { const int q = tid + 512 * k, row = q >> 5, ch = q & 31; *(LAS f16x8*)(ST + (sq * 64 + row) * STS_P + 8 + ch * 8) = raw[sq][k]; }
            if (tid < 128) { ST[tid * STS_P + 7] = (h16)0.f; ST[tid * STS_P + 8 + 256] = (h16)0.f; }
            __syncthreads();
            f32x2 xin[16], gk[16], y[16];
            { const float w0 = cw[d], w1 = cw[D3 + d], w2 = cw[2 * D3 + d], bv = cb[d]; const float g0 = cw[D + d], g1 = cw[D3 + D + d], g2 = cw[2 * D3 + D + d], gb = cb[D + d];
                const LAS h16* r0 = ST + (c8 * 8 + 2 * bp) * STS_P + 8; const LAS h16* r1 = r0 + 64 * STS_P;
#pragma unroll
                for (int jj = 0; jj < 16; ++jj) { const int nn = i + 16 * jj;
                    xin[jj] = (f32x2){conv3_lds(r0, nn, w0, w1, w2, bv), conv3_lds(r0 + STS_P, nn, w0, w1, w2, bv)};
                    gk[jj] = (f32x2){conv3_lds(r1, nn, g0, g1, g2, gb), conv3_lds(r1 + STS_P, nn, g0, g1, g2, gb)}; } }
            __syncthreads();
#pragma unroll 1
            for (int ord = 0; ord < 2; ++ord) {
                const f32x2* kf = kfb + (size_t)ord * 2048 * 512; f32x4 kfe[8], kfo[8];
                fft_fwd0<16>(xin, xin, E, O, i, tw);
                __syncthreads();
                kf_load(kf, kfe); fft_mid(E, i, kfe); kf_load(kf + 256, kfo); fft_mid(O, i, kfo);
                __syncthreads();
                fft_inv0<16>(E, O, i, tw, y);
#pragma unroll
                for (int jj = 0; jj < 16; ++jj) xin[jj] = gk[jj] * y[jj];
                if (ord == 0) {
                    __syncthreads();
#pragma unroll
                    for (int k = 0; k < 4; ++k) { const int q = tid + 512 * k, row = q >> 5, ch = q & 31; *(LAS f16x8*)(ST + row * STS_P + 8 + ch * 8) = raw[2][k]; }
                    if (tid < 64) { ST[tid * STS_P + 7] = (h16)0.f; ST[tid * STS_P + 8 + 256] = (h16)0.f; }
                    __syncthreads();
                    const float g0 = cw[2 * D + d], g1 = cw[D3 + 2 * D + d], g2 = cw[2 * D3 + 2 * D + d], gb = cb[2 * D + d];
                    const LAS h16* r0 = ST + (c8 * 8 + 2 * bp) * STS_P + 8;
#pragma unroll
                    for (int jj = 0; jj < 16; ++jj) { const int nn = i + 16 * jj; gk[jj] = (f32x2){conv3_lds(r0, nn, g0, g1, g2, gb), conv3_lds(r0 + STS_P, nn, g0, g1, g2, gb)}; }
                    __syncthreads();
                }
            }
            h16* o0 = zt + (size_t)d * TT + TL + (2 * bp) * 256; h16* o1 = o0 + 256;
#pragma unroll
            for (int jj = 0; jj < 16; ++jj) { const int nn = i + 16 * jj; o0[nn] = (h16)xin[jj].x; o1[nn] = (h16)xin[jj].y; }
        }
    }
}

constexpr int AT_KP = 72, AT_VP = 68;
__device__ __forceinline__ void attn_phase(const Params& p, int jl, bool with_ctx_out, LAS unsigned char* lds, int cvt_layer = -1, int cvt_n = 0) {
    const int tid = tid_fresh(), wv = tid >> 6, lane = tid & 63, r32 = lane & 31, hh = lane >> 5;
    LAS h16* Ks = (LAS h16*)lds; LAS h16* Vs = (LAS h16*)(lds + 64 * AT_KP * 2);
    const h16* qk = (const h16*)(p.ws + WS_QK); const h16* vt = (const h16*)(p.ws + WS_VT); h16* ob = (h16*)(p.ws + WS_HBUF);
    const float* rcos = (const float*)(p.ws + WS_ROPE); const float* rsin = rcos + 1024;
    const int nunit = 2048 + (with_ctx_out ? 128 : 0);
    int uit = 0; const int utrig = 2 * (((int)blockIdx.x >> 3) & 3);
    for (int unit = blockIdx.x; unit < nunit; unit += gridDim.x, ++uit) {
        if (cvt_layer >= 0 && uit == utrig) { __syncthreads(); cvt_moe_share(p, cvt_layer, blockIdx.x, cvt_n, gridDim.x, (LAS float*)lds); }
        int kind, b, g, qb;
        if (unit < 2048) { kind = 0; qb = unit & 63; g = (unit >> 6) & 3; b = unit >> 8; } else { const int u2 = unit - 2048; kind = 1; qb = u2 & 3; g = (u2 >> 2) & 3; b = u2 >> 4; }
        const int head = g * 8 + wv;
        const int qrow0 = kind ? (TL + b * 256 + qb * 64) : (b * 4096 + qb * 64);
        const int ctxrow0 = TL + b * 256;
        f16x8 qf[2][4];
#pragma unroll
        for (int qt = 0; qt < 2; ++qt) {
            f32x4 qv[4][2];
            const h16* qp = qk + (size_t)(qrow0 + 32 * qt + r32) * DQK + head * 64 + 8 * hh;
#pragma unroll
            for (int ks = 0; ks < 4; ++ks) { const f16x8 t = *(const f16x8*)(qp + 16 * ks);
#pragma unroll
                for (int i = 0; i < 4; ++i) { qv[ks][0][i] = (float)t[i]; qv[ks][1][i] = (float)t[4 + i]; } }
            if (kind == 0) {
                const int colpos = 32 * qt + r32;
#pragma unroll
                for (int a = 0; a < 2; ++a) { const int pos = a ? colpos : qb; const float* cp = rcos + pos * 16 + 8 * hh; const float* sp = rsin + pos * 16 + 8 * hh;
#pragma unroll
                    for (int e = 0; e < 2; ++e) { const f32x4 c = *(const f32x4*)(cp + 4 * e), s = *(const f32x4*)(sp + 4 * e);
                        const f32x4 x1 = qv[2 * a][e], x2 = qv[2 * a + 1][e]; qv[2 * a][e] = x1 * c - x2 * s; qv[2 * a + 1][e] = x2 * c + x1 * s; } }
            }
#pragma unroll
            for (int ks = 0; ks < 4; ++ks)
#pragma unroll
                for (int i = 0; i < 4; ++i) { qf[qt][ks][i] = (h16)(qv[ks][0][i] * (0.125f * 1.4426950408889634f)); qf[qt][ks][4 + i] = (h16)(qv[ks][1][i] * (0.125f * 1.4426950408889634f)); }
        }
        const float sink = p.at_sink[jl * 32 + head] * 1.4426950408889634f;
        float mrun[2] = {sink, sink}, lrun[2] = {hh == 0 ? 1.f : 0.f, hh == 0 ? 1.f : 0.f};
        f32x16 oacc[2][2];
#pragma unroll
        for (int a = 0; a < 2; ++a)
#pragma unroll
            for (int c = 0; c < 2; ++c)
#pragma unroll
                for (int i = 0; i < 16; ++i) oacc[a][c][i] = 0.f;
        const int t_lo = kind ? 0 : (qb < 2 ? 2 - qb : 0), t_hi = kind ? -1 : (65 - qb < 4 ? 65 - qb : 4); const int nwin = t_hi - t_lo + 1, nv = nwin + 4;
        const bool krole = tid < 256; const int kkey = tid >> 2, kcp = tid & 3, kdA = (kcp & 1) * 8 + (kcp >> 1) * 32; const int vdim = (tid - 256) >> 2, vkc = tid & 3;
        f16x8 ld0, ld1;
#define AT_TILE(sidx, KROW0, MASK, ROPE) do { if ((sidx) < nwin) { const int _ti = t_lo + (sidx); KROW0 = b * 4096 + qb * 64 - 128 + 64 * _ti; ROPE = true; MASK = (_ti == 0) ? 1 : (_ti == 4) ? 2 : 0; } \
            else { KROW0 = ctxrow0 + 64 * ((sidx) - nwin); ROPE = false; MASK = 0; } } while (0)
#define AT_LOAD(KROW0) do { if (krole) { const h16* kp = qk + (size_t)((KROW0) + kkey) * DQK + D + g * 64 + kdA; ld0 = *(const f16x8*)kp; ld1 = *(const f16x8*)(kp + 16); } \
            else { const h16* vp = vt + (size_t)(g * 64 + vdim) * TT + (KROW0) + 16 * vkc; ld0 = *(const f16x8*)vp; ld1 = *(const f16x8*)(vp + 8); } } while (0)
        { int kr0, mk; bool rp; AT_TILE(0, kr0, mk, rp); (void)mk; (void)rp; AT_LOAD(kr0); }
#pragma unroll 1
        for (int sx = 0; sx < nv; ++sx) {
            int krow0, mask; bool rope; AT_TILE(sx, krow0, mask, rope);
            __syncthreads();
            if (krole) {
                f16x8 o1 = ld0, o2 = ld1;
                if (rope) { const int kpos = (krow0 - b * 4096) + kkey; const int pos = (kcp >> 1) ? (kpos & 63) : (kpos >> 6);
                    const float* cpp = rcos + pos * 16 + (kcp & 1) * 8; const float* spp = rsin + pos * 16 + (kcp & 1) * 8;
#pragma unroll
                    for (int i = 0; i < 8; ++i) { const float c = cpp[i], s = spp[i], x1 = (float)ld0[i], x2 = (float)ld1[i]; o1[i] = (h16)(x1 * c - x2 * s); o2[i] = (h16)(x2 * c + x1 * s); } }
                *(LAS f16x8*)(Ks + kkey * AT_KP + kdA) = o1; *(LAS f16x8*)(Ks + kkey * AT_KP + kdA + 16) = o2;
            } else {
                LAS h16* dst = Vs + vdim * AT_VP + 16 * vkc;
                *(LAS f16x4*)(dst) = (f16x4){ld0[0], ld0[1], ld0[2], ld0[3]}; *(LAS f16x4*)(dst + 4) = (f16x4){ld0[4], ld0[5], ld0[6], ld0[7]};
                *(LAS f16x4*)(dst + 8) = (f16x4){ld1[0], ld1[1], ld1[2], ld1[3]}; *(LAS f16x4*)(dst + 12) = (f16x4){ld1[4], ld1[5], ld1[6], ld1[7]};
            }
            if (sx + 1 < nv) { int kr1, mk1; bool rp1; AT_TILE(sx + 1, kr1, mk1, rp1); (void)mk1; (void)rp1; AT_LOAD(kr1); }
            __syncthreads();
#pragma unroll
            for (int qt = 0; qt < 2; ++qt) {
                f32x16 sacc[2];
#pragma unroll
                for (int kt = 0; kt < 2; ++kt)
#pragma unroll
                    for (int i = 0; i < 16; ++i) sacc[kt][i] = 0.f;
#pragma unroll
                for (int ks = 0; ks < 4; ++ks)
#pragma unroll
                    for (int kt = 0; kt < 2; ++kt) { const f16x8 kf = *(const LAS f16x8*)(Ks + (32 * kt + r32) * AT_KP + 16 * ks + 8 * hh);
                        sacc[kt] = __builtin_amdgcn_mfma_f32_32x32x16_f16(kf, qf[qt][ks], sacc[kt], 0, 0, 0); }
                const int qq = 32 * qt + r32; float tmax = -3.0e38f;
                if (mask != 0) {
#pragma unroll
                for (int kt = 0; kt < 2; ++kt)
#pragma unroll
                    for (int i = 0; i < 16; ++i) { const int kk = 32 * kt + (i & 3) + 8 * (i >> 2) + 4 * hh; const bool dead = (mask == 1) ? (kk < qq) : (kk > qq); if (dead) sacc[kt][i] = -1.0e30f; } }
#pragma unroll
                for (int kt = 0; kt < 2; ++kt)
#pragma unroll
                    for (int i = 0; i < 16; ++i) tmax = fmaxf(tmax, sacc[kt][i]);
                tmax = fmaxf(tmax, shx(tmax, 32));
                const float mnew = fmaxf(mrun[qt], tmax); const float alpha = __builtin_amdgcn_exp2f(mrun[qt] - mnew); mrun[qt] = mnew;
                float psum = 0.f; f16x8 pf[2][2];
#pragma unroll
                for (int kt = 0; kt < 2; ++kt)
#pragma unroll
                    for (int s2 = 0; s2 < 2; ++s2)
#pragma unroll
                        for (int jj = 0; jj < 8; ++jj) { const float pv = __builtin_amdgcn_exp2f(sacc[kt][8 * s2 + jj] - mnew); psum += pv; pf[kt][s2][jj] = (h16)pv; }
                lrun[qt] = lrun[qt] * alpha + psum;
                if (__builtin_amdgcn_ballot_w64(alpha != 1.0f) != 0ull) {
#pragma unroll
                for (int dt = 0; dt < 2; ++dt)
#pragma unroll
                    for (int i = 0; i < 16; ++i) oacc[dt][qt][i] *= alpha; }
#pragma unroll
                for (int kt = 0; kt < 2; ++kt)
#pragma unroll
                    for (int s2 = 0; s2 < 2; ++s2)
#pragma unroll
                        for (int dt = 0; dt < 2; ++dt) { const LAS h16* vr = Vs + (32 * dt + r32) * AT_VP + 32 * kt + 16 * s2 + 4 * hh;
                            const f16x4 v0 = *(const LAS f16x4*)vr, v1 = *(const LAS f16x4*)(vr + 8);
                            const f16x8 vf = (f16x8){v0[0], v0[1], v0[2], v0[3], v1[0], v1[1], v1[2], v1[3]};
                            oacc[dt][qt] = __builtin_amdgcn_mfma_f32_32x32x16_f16(vf, pf[kt][s2], oacc[dt][qt], 0, 0, 0); }
            }
        }
#pragma unroll
        for (int qt = 0; qt < 2; ++qt) {
            const float ltot = lrun[qt] + shx(lrun[qt], 32); const float inv = 1.0f / ltot;
            h16* op = ob + (size_t)(qrow0 + 32 * qt + r32) * D + head * 64 + 4 * hh;
#pragma unroll
            for (int dt = 0; dt < 2; ++dt)
#pragma unroll
                for (int q4 = 0; q4 < 4; ++q4) { f16x4 w;
#pragma unroll
                    for (int i = 0; i < 4; ++i) w[i] = (h16)(oacc[dt][qt][4 * q4 + i] * inv);
                    *(f16x4*)(op + 32 * dt + 8 * q4) = w; }
        }
    }
}
#undef AT_TILE
#undef AT_LOAD

constexpr int NPHASE = 35;
#ifndef MK_MULTI
#define MK_MULTI 0
#endif

template <int KIND>
__attribute__((target("no-packed-fp32-ops"))) __global__ void __launch_bounds__(512, 2) hy_fwd(Params p_) {
    extern __shared__ __attribute__((aligned(16))) unsigned char shm[];
    LAS unsigned char* lds = (LAS unsigned char*)shm;
    constexpr bool ALL = KIND < 0;
    const int ph0 = p_.ph0;
    if (threadIdx.x == 0) { *(LAS u32x4*)(lds + LDS_XB) = (u32x4){0u, 0u, 0u, 0u}; }
    __syncthreads();
    XcdBarrier bar;
    if constexpr (ALL) bar = xcd_barrier_post((unsigned*)(p_.ws + WS_CTL), (volatile LAS unsigned*)(lds + LDS_XB));
#ifndef PROBE_SITE
#define PROBE_SITE -1
#endif
#define SITE(k) if constexpr (ALL || KIND == (k)) for (int rep_ = 0; rep_ < ((k) == PROBE_SITE ? 2 : 1); ++rep_) if (const Params& p = *params_fresh(); true)
#define SEAM() do { if constexpr (ALL) xcd_barrier(bar); } while (0)
    const int G = gridDim.x, bid = blockIdx.x;
    SITE(0) {
        for (int u = bid; u < 20353; u += G) {
            if (u < 384) modp_unit(p, u, (LAS float*)lds);
            else if (u == 384) tables_unit(p);
            else if (u < 1473) h2_task(p, (u - 385) * 8 + (tid_fresh() >> 6));
            else if (u < 1537) w3p_unit(p, u - 1473);
            else if (u < 1793) rtab_unit(p, u - 1537);
            else if (u < 4993) cvt_dense_unit(p, u - 1793, (LAS float*)lds);
            else cvt_moe_unit(p, 0, u - 4993, (LAS float*)lds);
        }
        SEAM();
    }
    SITE(1) {
        for (int u = bid; u < 216; u += G) modr_unit(p, u);
        SchedFilt S{p.ws + WS_W3P, p.ws + WS_H2P}; EpiTaps E{(float*)(p.ws + WS_TAPS), (float*)(p.ws + WS_TAPSC)};
        pg8::gemm_phase<EpiTaps, SchedFilt, 0>(lds, 256, S, E);
        SEAM();
    }
#define TAIL_IDLE(nunits) (((nunits) % G) ? G - ((nunits) % G) : 0)
#define CVT_PER_GEMM 20
#pragma unroll 1
    for (int layer = ALL ? 0 : ph0; layer < (ALL ? NLAYER : ph0 + 1); ++layer) {
        const bool hyena = (layer & 1) == 0; const int jl = layer >> 1;
        const int nu1 = hyena ? 24 * 136 : 136 * 10, nu4 = (layer == NLAYER - 1 ? 128 : 136) * 8;
        const int idle1 = TAIL_IDLE(nu1), idle4 = TAIL_IDLE(nu4);
        int cv4 = idle4 * CVT_PER_GEMM, cv1 = idle1 * CVT_PER_GEMM; if (cv4 > CVT_MOE_UNITS / 2) cv4 = CVT_MOE_UNITS / 2; if (cv1 > CVT_MOE_UNITS / 2 - 1) cv1 = CVT_MOE_UNITS / 2 - 1;
        const int cvN0 = CVT_MOE_UNITS - cv1 - cv4, cvN1 = cvN0 + cv1;
        SITE(2) {
            n1_phase(p, layer);
            for (int rep2_ = 0; rep2_ < ((PROBE_SITE == 20 && layer > 0) ? 2 : 1); ++rep2_) {
            if (layer == 0) filt_fft_phase(p, lds);
            else { (void)0; } }
            SEAM();
        }
        SITE(3) {
            if (hyena) { SchedPlain S{24, 136, D, p.ws + WS_WIN + (size_t)jl * D3 * D * 2, p.ws + WS_HBUF}; EpiH16 E{(h16*)(p.ws + WS_UT), TT, nullptr, 0};
                pg8::gemm_phase<EpiH16, SchedPlain, 0>(lds, D, S, E); }
            else { SchedQkv S{p.ws + WS_HBUF, p.ws + WS_WQKV + (size_t)jl * DQKV * D * 2}; EpiH16 E{(h16*)(p.ws + WS_QK), DQK, (h16*)(p.ws + WS_VT), TT};
                pg8::gemm_phase<EpiH16, SchedQkv, 0>(lds, D, S, E); }
            if (layer > 0 && idle1 > 0 && bid >= G - idle1) { cvt_moe_share(p, layer, cvN0 + (bid - (G - idle1)), cvN1, idle1, (LAS float*)lds); }
            SEAM();
        }
        SITE(4) {
#ifdef PROBE_PAR
            for (int rep3_ = 0; rep3_ < (((layer & 1) == PROBE_PAR) ? 2 : 1); ++rep3_)
#endif
            { if (hyena) conv_phase(p, jl, lds, ALL ? 0 : p.ph1, layer > 0 ? layer : -1, cvN0);
            else attn_phase(p, jl, layer != NLAYER - 1, lds, layer, cvN0); }
            SEAM();
        }
        SITE(5) {
            (void)0;
        }
        SITE(6) {
            EpiResid E{(float*)(p.ws + WS_XRES), (const float*)(p.ws + WS_MODS), layer, (float*)(p.ws + WS_SSQ), (!ALL && p.ph1) ? (float*)(p.ws + WS_YC) : (float*)(p.ws + WS_XRES)};
            if (hyena) {
                SchedPlainAT S{layer == NLAYER - 1 ? 128 : 136, 8, D, p.ws + WS_ZT, p.ws + WS_WOUT + (size_t)jl * D * D * 2};
                pg8::gemm_phase<EpiResid, SchedPlainAT, 2>(lds, D, S, E, TT);
            } else {
                SchedPlain S{layer == NLAYER - 1 ? 128 : 136, 8, D, p.ws + WS_HBUF, p.ws + WS_WO + (size_t)jl * D * D * 2};
                pg8::gemm_phase<EpiResid, SchedPlain, 0>(lds, D, S, E);
            }
            if (layer > 0 && idle4 > 0 && bid >= G - idle4) { cvt_moe_share(p, layer, cvN1 + (bid - (G - idle4)), CVT_MOE_UNITS, idle4, (LAS float*)lds); }
            SEAM();
        }
        SITE(7) { n2_phase(p, layer, lds, ALL ? 0 : p.ph1); SEAM(); }
        LAS int* tstart = (LAS int*)(lds + LDS_MISC); LAS int* texp = tstart + 80; LAS int* tcnt = texp + 352;
        SITE(8) {
            moe_table(tstart, texp, tcnt, (const int*)(p.ws + WS_CTL) + CTL_CNT + layer * NE);
            SchedMoe1 S{{tstart, texp, tcnt}, p.ws + WS_HBUF, p.ws + WS_W13, (const int*)(p.ws + WS_LIST)}; EpiMoe1 E{(h16*)(p.ws + WS_H1)};
            pg8::gemm_phase<EpiMoe1, SchedMoe1, 1>(lds, D, S, E);
            SEAM();
        }
        SITE(9) {
            moe_table(tstart, texp, tcnt, (const int*)(p.ws + WS_CTL) + CTL_CNT + layer * NE);
            SchedMoe2 S{{tstart, texp, tcnt}, p.ws + WS_H1, p.ws + WS_W2, (const int*)(p.ws + WS_LIST)}; EpiMoe2 E{(h16*)(p.ws + WS_YC), (const float*)(p.ws + WS_GATE), (const int*)(p.ws + WS_LIST)};
            pg8::gemm_phase<EpiMoe2, SchedMoe2, 0>(lds, DE, S, E);
            SEAM();
        }
    }
    SITE(10) final_phase(p);
#undef SITE
#undef SEAM
}

template <int KIND> static void launch_kind(const Params& p, int grid, hipStream_t stream) {
    static bool attr = false;
    if (!attr) { attr = true; if (hipFuncSetAttribute((const void*)hy_fwd<KIND>, hipFuncAttributeMaxDynamicSharedMemorySize, LDS_BYTES) != hipSuccess) fprintf(stderr, "kernel_launch: hipFuncSetAttribute failed (kind %d)\n", KIND); }
    hipLaunchKernelGGL(hy_fwd<KIND>, dim3(grid), dim3(512), LDS_BYTES, stream, p);
}

extern "C" void kernel_launch(void* const* d_in, const int* in_sizes, int n_in, void* d_out, int out_size, void* d_ws, size_t ws_size, hipStream_t stream) {
    static int grid = 0;
    if (!grid) {
        if (n_in != 29 || out_size != TL * D || ws_size < WS_END) { fprintf(stderr, "kernel_launch: unexpected problem (n_in %d, out %d, ws %zu < %zu)\n", n_in, out_size, ws_size, (size_t)WS_END); grid = -1; return; }
        int dev = 0, cus = 0;
        if (hipGetDevice(&dev) != hipSuccess || hipDeviceGetAttribute(&cus, hipDeviceAttributeMultiprocessorCount, dev) != hipSuccess) { grid = -1; return; }
        grid = cus;
    }
    if (grid <= 0) return;
    (void)hipMemsetAsync((char*)d_ws + WS_CTL, 0, CTL_BYTES, stream);
    Params p{};
    const float** pp = (const float**)&p;
    for (int i = 0; i < 29; ++i) pp[i] = (const float*)d_in[i];
    p.out = (float*)d_out; p.ws = (char*)d_ws;
#if MK_MULTI
    p.ph0 = 0; p.ph1 = 0;
    launch_kind<0>(p, grid, stream); launch_kind<1>(p, grid, stream);
#ifndef PROBE_KINDS
#define PROBE_KINDS 0
#endif
#ifndef PROBE_LAYERS
#define PROBE_LAYERS 15
#endif
#define PKIND(k) ((PROBE_KINDS >> (k)) & 1)
#define PREP(k) ((PKIND(k) && ((PROBE_LAYERS >> layer) & 1)) ? 2 : 1)
    if (PKIND(0)) launch_kind<0>(p, grid, stream);
    if (PKIND(1)) launch_kind<1>(p, grid, stream);
    for (int layer = 0; layer < NLAYER; ++layer) { p.ph0 = layer;
        for (int r = 0; r < PREP(2); ++r) launch_kind<2>(p, grid, stream);
        for (int r = 0; r < PREP(3); ++r) launch_kind<3>(p, grid, stream);
        for (int r = 0; r < PREP(4); ++r) { p.ph1 = (PREP(4) == 2 && r == 0) ? 1 : 0; launch_kind<4>(p, grid, stream); p.ph1 = 0; }
        if (PREP(6) == 2) { p.ph1 = 1; launch_kind<6>(p, grid, stream); p.ph1 = 0; }
        launch_kind<6>(p, grid, stream); launch_kind<7>(p, grid, stream);
        if (PREP(7) == 2) { p.ph1 = 1; launch_kind<7>(p, grid, stream); p.ph1 = 0; }
        for (int r = 0; r < PREP(8); ++r) launch_kind<8>(p, grid, stream);
        for (int r = 0; r < PREP(9); ++r) launch_kind<9>(p, grid, stream); }
    p.ph0 = 0; launch_kind<10>(p, grid, stream);
    if (PKIND(10)) launch_kind<10>(p, grid, stream);
#else
    p.ph0 = 0; p.ph1 = NPHASE;
    launch_kind<-1>(p, grid, stream);
#endif
}
```

```cpp
#include <hip/hip_runtime.h>
#include <cstdio>
#include <cstdint>

#define LAS __attribute__((address_space(3)))
typedef _Float16 h16;
typedef _Float16 f16x8 __attribute__((ext_vector_type(8)));
typedef _Float16 f16x4 __attribute__((ext_vector_type(4)));
typedef _Float16 f16x2 __attribute__((ext_vector_type(2)));
typedef float f32x2 __attribute__((ext_vector_type(2)));
typedef float f32x4 __attribute__((ext_vector_type(4)));
typedef float f32x16 __attribute__((ext_vector_type(16)));
typedef unsigned u32x2 __attribute__((ext_vector_type(2)));
typedef unsigned u32x4 __attribute__((ext_vector_type(4)));

constexpr int D = 2048, NB = 8, SEQ = 4096, CTXL = 256, TL = NB * SEQ, TC = NB * CTXL, TT = TL + TC;
constexpr int D3 = 3 * D, D6 = 6 * D, DQK = 2304, DQKV = 2560, NE = 64, DE = 384, DE2 = 768, NLAYER = 4;
constexpr int LCAP = TT;
constexpr int MOE_ROWS = 86016;
constexpr float EPS = 1e-6f;

constexpr size_t WS_CTL = 0;
constexpr size_t CTL_BYTES = 65536;
constexpr size_t WS_TW = WS_CTL + CTL_BYTES;
constexpr size_t WS_ROPE = WS_TW + 65536;
constexpr size_t WS_MODP = WS_ROPE + 8192;
constexpr size_t WS_MODS = WS_MODP + 16ull * 4 * 9 * 12288 * 4;
constexpr size_t WS_RTAB = WS_MODS + 4ull * 9 * 12288 * 4;
constexpr size_t RTAB_L = 64ull * 5 * 2 * 64 * 8 * 2;
constexpr size_t WS_RCST = WS_RTAB + 4 * RTAB_L;
constexpr size_t WS_H2P = WS_RCST + 16384;
constexpr size_t WS_W3P = WS_H2P + 2ull * 4352 * 256 * 2;
constexpr size_t WS_XRES = WS_W3P + 2ull * 8192 * 256 * 2;
constexpr size_t WS_HBUF = WS_XRES + (size_t)TT * D * 4;
constexpr size_t WS_UT = WS_HBUF + (size_t)TT * D * 2;
constexpr size_t UT_BYTES = (size_t)D3 * TT * 2;
constexpr size_t WS_TAPS = WS_UT;
constexpr size_t WS_TAPSC = WS_TAPS + 2ull * 8192 * 4096 * 4;
constexpr size_t WS_QK = WS_UT;
constexpr size_t WS_VT = WS_QK + (size_t)TT * DQK * 2;
constexpr size_t WS_ZT = WS_UT + UT_BYTES;
constexpr size_t WS_H1 = WS_ZT + (size_t)D * TT * 2;
constexpr size_t WS_YC = WS_H1 + (size_t)MOE_ROWS * DE * 2;
constexpr size_t WS_WIN = WS_YC + 2ull * TT * D * 2;
constexpr size_t WS_WOUT = WS_WIN + 2ull * D3 * D * 2;
constexpr size_t WS_WQKV = WS_WOUT + 2ull * D * D * 2;
constexpr size_t WS_WO = WS_WQKV + 2ull * DQKV * D * 2;
constexpr size_t WS_W13 = WS_WO + 2ull * D * D * 2;
constexpr size_t WS_W2 = WS_W13 + (size_t)NE * DE2 * D * 2;
constexpr size_t WS_KF = WS_W2 + (size_t)NE * D * DE * 2;
constexpr size_t WS_KFC = WS_KF + 2ull * 2 * 2048 * 65536;
constexpr size_t WS_LIST = WS_KFC + 2ull * 2 * 2048 * 4096;
constexpr size_t WS_GATE = WS_LIST + (size_t)NE * LCAP * 4;
constexpr size_t WS_SSQ = WS_GATE + (size_t)NE * LCAP * 4;
constexpr size_t WS_END = WS_SSQ + (size_t)TT * 32 * 4;
static_assert(WS_TAPSC + 2ull * 8192 * 256 * 4 <= WS_UT + UT_BYTES, "taps alias");
static_assert(WS_VT + 256ull * TT * 2 <= WS_UT + UT_BYTES, "qkv alias");

constexpr int CTL_CNT = 4096;

constexpr int LDS_BYTES = 147456;
constexpr int LDS_MISC = 139264;
constexpr int LDS_XB = LDS_BYTES - 16;

struct Params {
    const float *x, *c, *ctx, *c_ctx, *mod_w, *mod_b, *hy_w_in, *hy_conv_w, *hy_conv_b, *hy_f_w1, *hy_f_b1, *hy_f_freq1, *hy_f_w2, *hy_f_b2, *hy_f_freq2, *hy_f_w3,
        *hy_bias, *hy_w_out, *at_w_qkv, *at_sink, *at_w_o, *moe_wg, *moe_bg, *moe_we, *moe_be, *moe_w1, *moe_w3, *moe_w2, *final_gain;
    float* out; char* ws; int ph0, ph1;
};

__device__ __forceinline__ int tid_fresh() { int t = threadIdx.x; asm volatile("" : "+v"(t)); return t; }
__device__ __forceinline__ float bperm_f(float v, int srclane) { return __int_as_float(__builtin_amdgcn_ds_bpermute(srclane << 2, __float_as_int(v))); }
__device__ __forceinline__ float shx(float v, int mask) { return bperm_f(v, (tid_fresh() & 63) ^ mask); }
__device__ __forceinline__ const Params* params_fresh() { auto q = __builtin_amdgcn_kernarg_segment_ptr(); asm volatile("" : "+s"(q)); return (const Params*)q; }

#define XB_TMO      128
#define XB_XCNT(j)  (256  + 64 * (j))
#define XB_XSUB(j)  (1280 + 64 * (j))
#define XB_XGEN(j)  (2304 + 64 * (j))
#define XB_TOP      3328
#define XB_TOPGEN   3392
#define XCD_BAR_WORDS 3456
#define XB_SPIN_CAP (1u << 18)

__device__ __forceinline__ unsigned xb_ld(unsigned* p)              { return __hip_atomic_load(p, __ATOMIC_RELAXED, __HIP_MEMORY_SCOPE_AGENT); }
__device__ __forceinline__ unsigned xb_add(unsigned* p, unsigned v) { return __hip_atomic_fetch_add(p, v, __ATOMIC_RELAXED, __HIP_MEMORY_SCOPE_AGENT); }
__device__ __forceinline__ unsigned xb_xcc_id() { return (unsigned)__builtin_amdgcn_s_getreg((3 << 11) | 20) & 0xFu; }
#define XB_SPIN(cond, bar) do { unsigned _sp = 0; while (cond) { __builtin_amdgcn_s_sleep(1); \
    if ((++_sp & 255u) == 0u) { if (xb_ld(&(bar)[XB_TMO])) break; if (_sp > XB_SPIN_CAP) { atomicAdd(&(bar)[XB_TMO], 1u); break; } } } } while (0)

struct XcdBarrier { unsigned* bar; volatile LAS unsigned* st; };

__device__ __forceinline__ XcdBarrier xcd_barrier_post(unsigned* bar, volatile LAS unsigned* st) {
    XcdBarrier b; b.bar = bar; b.st = st;
    if (threadIdx.x == 0) (void)xb_add(&bar[XB_XCNT(xb_xcc_id())], 1u);
    return b;
}
__device__ __forceinline__ void xcd_barrier_complete(unsigned* bar, unsigned x, unsigned& nloc, unsigned& nx) {
    const unsigned G = gridDim.x * gridDim.y * gridDim.z;
    unsigned sum, cnt, mine, sp = 0u;
    for (;;) {
        sum = 0u; cnt = 0u; mine = 0u;
#pragma unroll
        for (unsigned j = 0; j < 16; ++j) { const unsigned c = xb_ld(&bar[XB_XCNT(j)]); sum += c; cnt += (c > 0u) ? 1u : 0u; mine = (j == x) ? c : mine; }
        if (sum == G) break;
        __builtin_amdgcn_s_sleep(1);
        if ((++sp & 255u) == 0u) { if (xb_ld(&bar[XB_TMO])) break; if (sp > XB_SPIN_CAP) { atomicAdd(&bar[XB_TMO], 1u); break; } }
    }
    nloc = mine > 0u ? mine : 1u; nx = cnt > 0u ? cnt : 1u;
}
__device__ __forceinline__ void xcd_barrier(const XcdBarrier& b) {
    asm volatile("s_waitcnt vmcnt(0)" ::: "memory");
    __syncthreads();
    if (threadIdx.x == 0) {
        unsigned* bar = b.bar; const unsigned bx = xb_xcc_id();
        __builtin_amdgcn_s_waitcnt(0);
        unsigned nloc = b.st[0], nx = b.st[1];
        if (nloc == 0u) { xcd_barrier_complete(bar, bx, nloc, nx); b.st[0] = nloc; b.st[1] = nx; }
        const unsigned old = xb_add(&bar[XB_XSUB(bx)], 1u);
        const unsigned gen = old / nloc;
        if (old + 1u == (gen + 1u) * nloc) {
            __builtin_amdgcn_fence(__ATOMIC_RELEASE, "agent");
            asm volatile("s_waitcnt vmcnt(0)" ::: "memory");
            const unsigned og = xb_add(&bar[XB_TOP], 1u);
            const unsigned tg = og / nx;
            if (og + 1u == (tg + 1u) * nx) xb_add(&bar[XB_TOPGEN], 1u);
            else XB_SPIN(xb_ld(&bar[XB_TOPGEN]) == tg, bar);
            __builtin_amdgcn_fence(__ATOMIC_ACQUIRE, "agent");
            xb_add(&bar[XB_XGEN(bx)], 1u);
            asm volatile("s_waitcnt vmcnt(0)" ::: "memory");
        } else {
            XB_SPIN(xb_ld(&bar[XB_XGEN(bx)]) == gen, bar);
            __builtin_amdgcn_fence(__ATOMIC_ACQUIRE, "agent");
            asm volatile("s_waitcnt vmcnt(0)" ::: "memory");
        }
    }
    __syncthreads();
}

namespace pg8 {
constexpr int BM = 256, BK = 64, HALF = 128, HTB = HALF * BK * 2, STAGE_BYTES = 8 * HTB;
__device__ __forceinline__ int lds_byte(int r, int c) { const int st = (r >> 4) * 2 + (c >> 5), rr = r & 15, cc = c & 31, ob = rr * 64 + cc * 2; return st * 1024 + (ob ^ (((ob >> 9) & 1) << 5)); }
__device__ __forceinline__ void stage_rc(int b, int& R, int& C) { const int st = b / 1024, sb = b % 1024, swz = sb ^ (((sb >> 9) & 1) << 5); R = (st >> 1) * 16 + swz / 64; C = (st & 1) * 32 + (swz % 64) / 2; }
__device__ __forceinline__ int perm32(int rho) { const int n = rho >> 4, i = rho & 15; return 8 * (i >> 2) + 4 * n + (i & 3); }

struct Unit {
    int pm, pn;
    int e, pos0, cnt;
    int kind;
    int half;
    const char* A; const char* B;
    const int* rows;
};

typedef short s16x4 __attribute__((ext_vector_type(4)));
template <class Epi, class Sched, int AMODE>
__device__ __forceinline__ void gemm_phase(LAS unsigned char* lds, const int K, const Sched& S, const Epi& E, const int ldat = 0) {
    constexpr bool GATHER = AMODE == 1, ATR = AMODE == 2;
    const int tid = tid_fresh(), wid = __builtin_amdgcn_readfirstlane(tid >> 6), lane = tid & 63, wr = wid >> 2, wc = wid & 3, fr = lane & 15, fq = lane >> 4;
    const int nt = K / BK;
    unsigned voffA[2], voffB[2]; int RA[2], CA[2];
#pragma unroll
    for (int i = 0; i < 2; ++i) { int R, C; stage_rc(tid * 16 + i * 8192, R, C); const int Rb = Epi::PERM ? ((R & ~31) + perm32(R & 31)) : R;
        voffA[i] = (unsigned)(R * K + C) * 2u; voffB[i] = (unsigned)(Rb * K + C) * 2u; RA[i] = R; CA[i] = C;
        if constexpr (ATR) { const int bb = tid * 16 + i * 8192, row = bb >> 8, pc = (bb >> 4) & 15, ch = pc ^ (((row & 3) << 2) | ((row >> 2) & 3)); voffA[i] = (unsigned)(row * ldat + 8 * ch) * 2u; } }
    const size_t kstep = (size_t)(BK * 2);
    const size_t hstep = (size_t)HALF * K * 2;
    const size_t kstepA = ATR ? (size_t)BK * ldat * 2 : kstep, hstepA = ATR ? (size_t)HALF * 2 : hstep;
    const unsigned ldsw = (unsigned)wid * 1024u;
    const int aoff = lds_byte(wr * 64 + fr, fq * 8), boff = lds_byte(wc * 32 + fr, fq * 8);
    int atr[4][2];
#pragma unroll
    for (int m = 0; m < 4; ++m)
#pragma unroll
        for (int bl = 0; bl < 2; ++bl) { const int xr = ((fr >> 2) << 2) | ((2 * fq + bl) & 3); atr[m][bl] = (int)(unsigned)(uintptr_t)lds + 256 * (8 * fq + (fr >> 2) + 4 * bl) + 16 * ((wr * 8 + 2 * m + ((fr & 3) >> 1)) ^ xr) + 8 * (fr & 1); }
    unsigned vgC[2][2], vgN[2][2];
#define PG8_ROWS(u, vg) do { if constexpr (GATHER) { _Pragma("unroll") for (int _h = 0; _h < 2; ++_h) _Pragma("unroll") for (int _i = 0; _i < 2; ++_i) { \
        const int _p = (u).pos0 + _h * HALF + RA[_i]; const int _tok = (_p < (u).cnt) ? ((u).rows[_h * HALF + RA[_i]] >> 1) : 0; \
        vg[_h][_i] = ((unsigned)_tok * (unsigned)K + (unsigned)CA[_i]) * 2u; } } } while (0)
#define PG8_SA(b, h) (((b) * 2 + (h)) * HTB)
#define PG8_SB(b, h) ((4 + (b) * 2 + (h)) * HTB)
#define PG8_STAGE_B(bufoff, gbase) do { _Pragma("unroll") for (int _i = 0; _i < 2; ++_i) \
        __builtin_amdgcn_global_load_lds((const unsigned*)((const char*)(gbase) + voffB[_i]), (LAS unsigned*)(lds + (bufoff) + ldsw + _i * 8192), 16, 0, 0); } while (0)
#define PG8_STAGE_A(bufoff, gbase, h, NEXT) do { _Pragma("unroll") for (int _i = 0; _i < 2; ++_i) { \
        const unsigned _vo = GATHER ? ((NEXT) ? vgN[h][_i] : vgC[h][_i]) : voffA[_i]; \
        __builtin_amdgcn_global_load_lds((const unsigned*)((const char*)(gbase) + (GATHER ? (size_t)0 : (size_t)(h) * hstepA) + _vo), (LAS unsigned*)(lds + (bufoff) + ldsw + _i * 8192), 16, 0, 0); } } while (0)
#define PG8_LDA(dst, b, h) do { if constexpr (!ATR) { _Pragma("unroll") for (int m = 0; m < 4; ++m) _Pragma("unroll") for (int k = 0; k < 2; ++k) dst[m][k] = *(const LAS f16x8*)(lds + PG8_SA(b, h) + aoff + m * 2048 + k * 1024); } \
        else { _Pragma("unroll") for (int m = 0; m < 4; ++m) _Pragma("unroll") for (int k = 0; k < 2; ++k) { s16x4 _lo, _hi; \
            asm volatile("ds_read_b64_tr_b16 %0, %1 offset:%2" : "=v"(_lo) : "v"(atr[m][0]), "i"(PG8_SA(b, h) + k * 8192) : "memory"); \
            asm volatile("ds_read_b64_tr_b16 %0, %1 offset:%2" : "=v"(_hi) : "v"(atr[m][1]), "i"(PG8_SA(b, h) + k * 8192) : "memory"); \
            const short __attribute__((ext_vector_type(8))) _v = {_lo[0], _lo[1], _lo[2], _lo[3], _hi[0], _hi[1], _hi[2], _hi[3]}; dst[m][k] = __builtin_bit_cast(f16x8, _v); } } } while (0)
#define PG8_PIN(At) do { if constexpr (ATR) asm volatile("" : "+v"(At[0][0]), "+v"(At[0][1]), "+v"(At[1][0]), "+v"(At[1][1]), "+v"(At[2][0]), "+v"(At[2][1]), "+v"(At[3][0]), "+v"(At[3][1])); } while (0)
#define PG8_LDB(dst, b, h) do { _Pragma("unroll") for (int n = 0; n < 2; ++n) _Pragma("unroll") for (int k = 0; k < 2; ++k) dst[n][k] = *(const LAS f16x8*)(lds + PG8_SB(b, h) + boff + n * 2048 + k * 1024); } while (0)
#define PG8_MMA(ai, bj, At, Bt) do { __builtin_amdgcn_s_setprio(1); _Pragma("unroll") for (int m = 0; m < 4; ++m) _Pragma("unroll") for (int n = 0; n < 2; ++n) _Pragma("unroll") for (int k = 0; k < 2; ++k) \
        acc[ai][bj][m][n] = __builtin_amdgcn_mfma_f32_16x16x32_f16(Bt[n][k], At[m][k], acc[ai][bj][m][n], 0, 0, 0); __builtin_amdgcn_s_setprio(0); } while (0)
#define PG8_WAIT_V(n) asm volatile("s_waitcnt vmcnt(" #n ")" ::: "memory")
#define PG8_WAIT_L(n) asm volatile("s_waitcnt lgkmcnt(" #n ")" ::: "memory")
#define PG8_BAR __builtin_amdgcn_s_barrier()
#define PG8_SCHED __builtin_amdgcn_sched_barrier(0)
    Unit cur, nxt; int ui = 0;
    if (!S.next(0, cur)) return;
    f32x4 acc[2][2][4][2];
#pragma unroll
    for (int a = 0; a < 2; ++a)
#pragma unroll
        for (int b = 0; b < 2; ++b)
#pragma unroll
            for (int m = 0; m < 4; ++m)
#pragma unroll
                for (int n = 0; n < 2; ++n) acc[a][b][m][n] = (f32x4){0.f, 0.f, 0.f, 0.f};
    f16x8 At[4][2], B0[2][2], B1[2][2];
    const char* cA = cur.A; const char* cB = cur.B;
    PG8_ROWS(cur, vgC);
#pragma unroll
    for (int _h = 0; _h < 2; ++_h)
#pragma unroll
        for (int _i = 0; _i < 2; ++_i) vgN[_h][_i] = GATHER ? vgC[_h][_i] : 0u;
    PG8_STAGE_B(PG8_SB(0, 0), cB); PG8_STAGE_B(PG8_SB(0, 1), cB + hstep); PG8_STAGE_A(PG8_SA(0, 0), cA, 0, false); PG8_STAGE_A(PG8_SA(0, 1), cA, 1, false);
    if (wr == 1) PG8_BAR;
    PG8_WAIT_V(2); PG8_BAR;
    PG8_STAGE_B(PG8_SB(1, 0), cB + kstep); PG8_STAGE_A(PG8_SA(1, 0), cA + kstepA, 0, false); PG8_STAGE_B(PG8_SB(1, 1), cB + hstep + kstep);
    PG8_WAIT_V(6); PG8_BAR;
    for (;;) {
        const bool has_next = S.next(ui + 1, nxt);
        const bool full = cur.half == 0;
        const char* nA = has_next ? nxt.A : cA; const char* nB = has_next ? nxt.B : cB;
        if (has_next) { PG8_ROWS(nxt, vgN); }
#pragma unroll 1
        for (int t = 0; t < nt; t += 2) {
            const bool last = (t == nt - 2);
            const char* a1 = cA + (size_t)(t + 1) * kstepA;
            const char* a2 = last ? nA : cA + (size_t)(t + 2) * kstepA; const char* b2 = last ? nB : cB + (size_t)(t + 2) * kstep;
            const char* a3 = a2 + kstepA; const char* b3 = b2 + kstep;
            PG8_LDB(B0, 0, 0); PG8_LDB(B1, 0, 1); PG8_SCHED; PG8_LDA(At, 0, 0); PG8_STAGE_A(PG8_SA(1, 1), a1, 1, false);
            PG8_WAIT_V(8); PG8_WAIT_L(0); PG8_PIN(At); PG8_BAR; PG8_MMA(0, 0, At, B0); PG8_MMA(0, 1, At, B1); PG8_BAR; PG8_SCHED;
            PG8_LDA(At, 0, 1); PG8_STAGE_B(PG8_SB(0, 0), b2); PG8_STAGE_B(PG8_SB(0, 1), b2 + hstep); PG8_STAGE_A(PG8_SA(0, 0), a2, 0, last);
            PG8_WAIT_V(8); PG8_WAIT_L(0); PG8_PIN(At); PG8_BAR; if (full) { PG8_MMA(1, 0, At, B0); PG8_MMA(1, 1, At, B1); } PG8_BAR; PG8_SCHED;
            PG8_LDB(B0, 1, 0); PG8_LDB(B1, 1, 1); PG8_SCHED; PG8_LDA(At, 1, 0); PG8_STAGE_A(PG8_SA(0, 1), a2, 1, last);
            PG8_WAIT_V(8); PG8_WAIT_L(0); PG8_PIN(At); PG8_BAR; PG8_MMA(0, 0, At, B0); PG8_MMA(0, 1, At, B1); PG8_BAR; PG8_SCHED;
            PG8_LDA(At, 1, 1); PG8_STAGE_B(PG8_SB(1, 0), b3); PG8_STAGE_B(PG8_SB(1, 1), b3 + hstep); PG8_STAGE_A(PG8_SA(1, 0), a3, 0, last);
            PG8_WAIT_V(8); PG8_WAIT_L(0); PG8_PIN(At); PG8_BAR; if (full) { PG8_MMA(1, 0, At, B0); PG8_MMA(1, 1, At, B1); } PG8_BAR; PG8_SCHED;
        }
        if (wr == 0) PG8_BAR;
        E(acc, cur, wr, wc, fr, fq);
        if (!has_next) break;
#pragma unroll
        for (int a = 0; a < 2; ++a)
#pragma unroll
            for (int b = 0; b < 2; ++b)
#pragma unroll
                for (int m = 0; m < 4; ++m)
#pragma unroll
                    for (int n = 0; n < 2; ++n) acc[a][b][m][n] = (f32x4){0.f, 0.f, 0.f, 0.f};
        cur = nxt; cA = nA; cB = nB; ++ui;
#pragma unroll
        for (int _h = 0; _h < 2; ++_h)
#pragma unroll
            for (int _i = 0; _i < 2; ++_i) vgC[_h][_i] = vgN[_h][_i];
        if (wr == 1) PG8_BAR;
    }
    PG8_WAIT_V(0);
    PG8_BAR;
#undef PG8_ROWS
#undef PG8_SA
#undef PG8_SB
#undef PG8_STAGE_A
#undef PG8_STAGE_B
#undef PG8_LDA
#undef PG8_LDB
#undef PG8_PIN
#undef PG8_MMA
#undef PG8_WAIT_V
#undef PG8_WAIT_L
#undef PG8_BAR
#undef PG8_SCHED
}
}

using pg8::Unit;
__device__ __forceinline__ f16x8 pack8(const f32x4 a, const f32x4 b) {
    f16x8 w; w[0] = (h16)a[0]; w[1] = (h16)a[1]; w[2] = (h16)a[2]; w[3] = (h16)a[3]; w[4] = (h16)b[0]; w[5] = (h16)b[1]; w[6] = (h16)b[2]; w[7] = (h16)b[3]; return w;
}
struct EpiH16 {
    static constexpr bool PERM = true;
    h16* O0; int ld0; h16* O1; int ld1;
    __device__ __forceinline__ void operator()(const f32x4 (&acc)[2][2][4][2], const Unit& u, int wr, int wc, int fr, int fq) const {
        h16* base = u.kind ? O1 : O0; const int ld = u.kind ? ld1 : ld0;
        const int row0 = u.pm * 256 + wr * 64 + fr, col0 = u.pn * 256 + wc * 32 + 8 * fq;
#pragma unroll
        for (int ai = 0; ai < 2; ++ai)
#pragma unroll
            for (int m = 0; m < 4; ++m) { h16* rowp = base + (size_t)(row0 + ai * 128 + m * 16) * ld + col0;
#pragma unroll
                for (int bj = 0; bj < 2; ++bj) __builtin_nontemporal_store(pack8(acc[ai][bj][m][0], acc[ai][bj][m][1]), (f16x8*)(rowp + bj * 128)); }
    }
};
struct EpiTaps {
    static constexpr bool PERM = false;
    float* T0; float* T1;
    __device__ __forceinline__ void operator()(const f32x4 (&acc)[2][2][4][2], const Unit& u, int wr, int wc, int fr, int fq) const {
        const int j = u.kind >> 1, v = u.kind & 1; const int ld = v ? 256 : 4096;
        float* base = v ? (T1 + (size_t)j * 8192 * 256) : (T0 + (size_t)j * 8192 * 4096);
        const int row0 = u.pm * 256 + wr * 64 + fr, col0 = u.pn * 256 + wc * 32 + 4 * fq;
#pragma unroll
        for (int ai = 0; ai < 2; ++ai)
#pragma unroll
            for (int m = 0; m < 4; ++m) { float* rowp = base + (size_t)(row0 + ai * 128 + m * 16) * ld + col0;
#pragma unroll
                for (int bj = 0; bj < 2; ++bj)
#pragma unroll
                    for (int n = 0; n < 2; ++n) *(f32x4*)(rowp + bj * 128 + n * 16) = acc[ai][bj][m][n]; }
    }
};
struct EpiResid {
    static constexpr bool PERM = true;
    h16* X; const float* mods; int layer; float* SSQ; h16* XO;
    __device__ __forceinline__ void operator()(const f32x4 (&acc)[2][2][4][2], const Unit& u, int wr, int wc, int fr, int fq) const {
        const int r0 = u.pm * 256; const int b = r0 < TL ? (r0 >> 12) : 8;
        const float* g = mods + ((size_t)(layer * 9 + b) * 6 + 2) * D;
        const int row0 = r0 + wr * 64 + fr, col0 = u.pn * 256 + wc * 32 + 8 * fq;
        f32x4 gv[2][2];
#pragma unroll
        for (int bj = 0; bj < 2; ++bj)
#pragma unroll
            for (int n = 0; n < 2; ++n) gv[bj][n] = *(const f32x4*)(g + col0 + bj * 128 + n * 4);
#pragma unroll
        for (int ai = 0; ai < 2; ++ai)
#pragma unroll
            for (int m = 0; m < 4; ++m) { const int row = row0 + ai * 128 + m * 16; const h16* rowp = X + (size_t)row * D + col0; h16* rowo = XO + (size_t)row * D + col0; float sq = 0.f;
#pragma unroll
                for (int bj = 0; bj < 2; ++bj) { const f16x8 xv = *(const f16x8*)(rowp + bj * 128); f32x4 v0, v1;
#pragma unroll
                    for (int i = 0; i < 4; ++i) { v0[i] = (float)xv[i] + gv[bj][0][i] * acc[ai][bj][m][0][i]; v1[i] = (float)xv[4 + i] + gv[bj][1][i] * acc[ai][bj][m][1][i]; }
                    const f16x8 w = pack8(v0, v1); *(f16x8*)(rowo + bj * 128) = w;
#pragma unroll
                    for (int i = 0; i < 8; ++i) { const float t = (float)w[i]; sq += t * t; } }
                sq += shx(sq, 16); sq += shx(sq, 32);
                if (fq == 0) SSQ[(size_t)row * 32 + u.pn * 4 + wc] = sq; }
    }
};
struct EpiMoe1 {
    static constexpr bool PERM = true;
    h16* H1;
    __device__ __forceinline__ void operator()(const f32x4 (&acc)[2][2][4][2], const Unit& u, int wr, int wc, int fr, int fq) const {
        const int row0 = u.pm * 256 + wr * 64 + fr, col0 = u.pn * 128 + wc * 16 + 4 * fq;
#pragma unroll
        for (int ai = 0; ai < 2; ++ai)
#pragma unroll
            for (int m = 0; m < 4; ++m) { if (ai == 1 && u.half) continue; h16* rowp = H1 + (size_t)(row0 + ai * 128 + m * 16) * DE + col0;
#pragma unroll
                for (int bj = 0; bj < 2; ++bj) { const f32x4 a = acc[ai][bj][m][0], b = acc[ai][bj][m][1]; f16x4 w;
#pragma unroll
                    for (int i = 0; i < 4; ++i) { const float s = a[i] / (1.0f + __expf(-a[i])); w[i] = (h16)(s * b[i]); }
                    *(f16x4*)(rowp + bj * 64) = w; } }
    }
};
struct EpiMoe2 {
    static constexpr bool PERM = true;
    h16* YC; const float* gslot;
    __device__ __forceinline__ void operator()(const f32x4 (&acc)[2][2][4][2], const Unit& u, int wr, int wc, int fr, int fq) const {
        const int col0 = u.pn * 256 + wc * 32 + 8 * fq;
        const float* grow = gslot + ((const char*)u.rows - (const char*)listbase) / 4;
        int av[2][4]; float gv[2][4];
#pragma unroll
        for (int ai = 0; ai < 2; ++ai)
#pragma unroll
            for (int m = 0; m < 4; ++m) { const int r = ai * 128 + wr * 64 + m * 16 + fr; const bool ok = u.pos0 + r < u.cnt; av[ai][m] = ok ? u.rows[r] : -1; gv[ai][m] = ok ? grow[r] : 0.f; }
#pragma unroll
        for (int ai = 0; ai < 2; ++ai)
#pragma unroll
            for (int m = 0; m < 4; ++m) { if (av[ai][m] >= 0) { const float g = gv[ai][m]; h16* rowp = YC + (size_t)av[ai][m] * D + col0;
#pragma unroll
                    for (int bj = 0; bj < 2; ++bj) *(f16x8*)(rowp + bj * 128) = pack8(acc[ai][bj][m][0] * g, acc[ai][bj][m][1] * g); } }
    }
    const int* listbase;
};

__device__ __forceinline__ void order_tile(int wgid, int nM, int nN, int& pm, int& pn) {
    const int nwg = nM * nN; { const int q = nwg / 8, r = nwg % 8, xcd = wgid % 8, off = wgid / 8; wgid = (xcd < r ? xcd * (q + 1) : r * (q + 1) + (xcd - r) * q) + off; }
    const int nig = 8 * nN, gid = wgid / nig, fm = gid * 8, gsz = (nM - fm) < 8 ? (nM - fm) : 8;
    pm = fm + ((wgid % nig) % gsz); pn = (wgid % nig) / gsz;
}
struct SchedPlain {
    int nM, nN, K; const char* A; const char* B;
    __device__ __forceinline__ bool next(int i, Unit& u) const {
        const long L = (long)i * gridDim.x + blockIdx.x; if (L >= (long)nM * nN) return false;
        order_tile((int)L, nM, nN, u.pm, u.pn); u.kind = 0; u.half = 0; u.e = 0; u.pos0 = 0; u.cnt = 0; u.rows = nullptr;
        u.A = A + (size_t)u.pm * 256 * K * 2; u.B = B + (size_t)u.pn * 256 * K * 2; return true;
    }
};
struct SchedPlainAT {
    int nM, nN, K; const char* At; const char* B;
    __device__ __forceinline__ bool next(int i, Unit& u) const {
        const long L = (long)i * gridDim.x + blockIdx.x; if (L >= (long)nM * nN) return false;
        order_tile((int)L, nM, nN, u.pm, u.pn); u.kind = 0; u.half = 0; u.e = 0; u.pos0 = 0; u.cnt = 0; u.rows = nullptr;
        u.A = At + (size_t)u.pm * 256 * 2; u.B = B + (size_t)u.pn * 256 * K * 2; return true;
    }
};
struct SchedQkv {
    const char* H; const char* W;
    __device__ __forceinline__ bool next(int i, Unit& u) const {
        const long L = (long)i * gridDim.x + blockIdx.x; const int nA = 136 * 9; if (L >= nA + 136) return false;
        u.e = 0; u.half = 0; u.pos0 = 0; u.cnt = 0; u.rows = nullptr;
        if (L < nA) { order_tile((int)L, 136, 9, u.pm, u.pn); u.kind = 0; u.A = H + (size_t)u.pm * 256 * D * 2; u.B = W + (size_t)u.pn * 256 * D * 2; }
        else { u.pm = 0; u.pn = (int)L - nA; u.kind = 1; u.A = W + (size_t)DQK * D * 2; u.B = H + (size_t)u.pn * 256 * D * 2; }
        return true;
    }
};
struct SchedFilt {
    const char* W3P; const char* H2P;
    __device__ __forceinline__ bool next(int i, Unit& u) const {
        const long L = (long)i * gridDim.x + blockIdx.x; if (L >= 2 * 544) return false;
        const int j = (int)L / 544, r = (int)L % 544; u.e = 0; u.half = 0; u.pos0 = 0; u.cnt = 0; u.rows = nullptr;
        int v; if (r < 512) { v = 0; u.pm = r >> 4; u.pn = r & 15; } else { v = 1; u.pm = r - 512; u.pn = 0; }
        u.kind = 2 * j + v;
        u.A = W3P + ((size_t)j * 8192 + (size_t)u.pm * 256) * 256 * 2;
        u.B = H2P + ((size_t)j * 4352 + (v ? 4096 : 0) + (size_t)u.pn * 256) * 256 * 2;
        return true;
    }
};
struct MoeTab { const LAS int* tstart; const LAS int* texp; const LAS int* cnt; };
struct SchedMoe1 {
    MoeTab tb; const char* H; const char* W13; const int* list;
    __device__ __forceinline__ bool next(int i, Unit& u) const {
        const long L = (long)i * gridDim.x + blockIdx.x; const int ntile = __builtin_amdgcn_readfirstlane(tb.tstart[NE]); if (L >= (long)ntile * 3) return false;
        int rt; order_tile((int)L, ntile, 3, rt, u.pn); u.pm = rt; u.kind = 0;
        const int e = __builtin_amdgcn_readfirstlane(tb.texp[rt]); u.e = e; u.pos0 = (rt - __builtin_amdgcn_readfirstlane(tb.tstart[e])) * 256; u.cnt = __builtin_amdgcn_readfirstlane(tb.cnt[e]); u.half = (u.cnt - u.pos0 <= 128) ? 1 : 0;
        u.rows = list + (size_t)e * LCAP + u.pos0; u.A = H; u.B = W13 + ((size_t)e * DE2 + (size_t)u.pn * 256) * D * 2; return true;
    }
};
struct SchedMoe2 {
    MoeTab tb; const char* H1; const char* W2; const int* list;
    __device__ __forceinline__ bool next(int i, Unit& u) const {
        const long L = (long)i * gridDim.x + blockIdx.x; const int ntile = __builtin_amdgcn_readfirstlane(tb.tstart[NE]); if (L >= (long)ntile * 8) return false;
        int rt; order_tile((int)L, ntile, 8, rt, u.pn); u.pm = rt; u.kind = 0;
        const int e = __builtin_amdgcn_readfirstlane(tb.texp[rt]); u.e = e; u.pos0 = (rt - __builtin_amdgcn_readfirstlane(tb.tstart[e])) * 256; u.cnt = __builtin_amdgcn_readfirstlane(tb.cnt[e]); u.half = (u.cnt - u.pos0 <= 128) ? 1 : 0;
        u.rows = list + (size_t)e * LCAP + u.pos0; u.A = H1 + (size_t)rt * 256 * DE * 2; u.B = W2 + ((size_t)e * D + (size_t)u.pn * 256) * DE * 2; return true;
    }
};
__device__ __forceinline__ void moe_table(LAS int* tstart, LAS int* texp, LAS int* cnt, const int* counters) {
    const int t = tid_fresh();
    if (t < NE) cnt[t] = counters[t];
    __syncthreads();
    if (t <= NE) { int s = 0; for (int e = 0; e < t; ++e) s += (cnt[e] + 255) >> 8; tstart[t] = s; }
    __syncthreads();
    if (t < NE) { const int s0 = tstart[t], s1 = tstart[t + 1]; for (int q = s0; q < s1; ++q) texp[q] = t; }
    __syncthreads();
}

__device__ __forceinline__ float wave_sum(float v) {
#pragma unroll
    for (int o = 32; o >= 1; o >>= 1) v += shx(v, o);
    return v;
}
__device__ __forceinline__ float silu_f(float x) { return x / (1.0f + expf(-x)); }
__device__ __forceinline__ int batch_of_row(int r) { return r < TL ? (r >> 12) : 8; }

__device__ __forceinline__ void modp_unit(const Params& p, int unit, LAS float* sl) {
    const int layer = unit / 96, rem = unit % 96, ks = rem / 6, cc = rem % 6, tid = tid_fresh();
    for (int i = tid; i < 9 * 128; i += 512) { const int cnd = i >> 7, k = ks * 128 + (i & 127); const float v = cnd < 8 ? p.c[cnd * D + k] : p.c_ctx[k]; sl[i] = silu_f(v); }
    __syncthreads();
    f32x4 acc[9];
#pragma unroll
    for (int q = 0; q < 9; ++q) acc[q] = (f32x4){0.f, 0.f, 0.f, 0.f};
    const float* w = p.mod_w + ((size_t)layer * D + (size_t)ks * 128) * D6 + cc * 2048 + tid * 4;
#pragma unroll 4
    for (int k = 0; k < 128; ++k) { const f32x4 wv = *(const f32x4*)(w + (size_t)k * D6);
#pragma unroll
        for (int q = 0; q < 9; ++q) acc[q] += wv * sl[q * 128 + k]; }
    float* outp = (float*)(p.ws + WS_MODP) + ((size_t)(ks * 4 + layer) * 9) * D6 + cc * 2048 + tid * 4;
#pragma unroll
    for (int q = 0; q < 9; ++q) *(f32x4*)(outp + (size_t)q * D6) = acc[q];
    __syncthreads();
}
__device__ __forceinline__ void modr_unit(const Params& p, int unit) {
    const size_t idx = (size_t)unit * 2048 + tid_fresh() * 4; const int layer = (int)(idx / (9 * D6)), col = (int)(idx % D6);
    f32x4 s = *(const f32x4*)(p.mod_b + (size_t)layer * D6 + col);
    const float* pp = (const float*)(p.ws + WS_MODP) + idx;
#pragma unroll
    for (int ks = 0; ks < 16; ++ks) s += *(const f32x4*)(pp + (size_t)ks * 4 * 9 * D6);
    *(f32x4*)((float*)(p.ws + WS_MODS) + idx) = s;
}
__device__ __forceinline__ void tables_unit(const Params& p) {
    f32x2* tw = (f32x2*)(p.ws + WS_TW);
    for (int m = tid_fresh(); m < 8192; m += 512) { double s, c; sincospi(-(double)m / 4096.0, &s, &c); tw[m] = (f32x2){(float)c, (float)s}; }
    float* rc = (float*)(p.ws + WS_ROPE);
    for (int i = tid_fresh(); i < 1024; i += 512) { const int pos = i >> 4, q = i & 15; const float inv = powf(10000.0f, -(float)q / 16.0f); const float ang = (float)pos * inv;
        rc[i] = cosf(ang); rc[1024 + i] = sinf(ang); }
}
__device__ __forceinline__ void h2_task(const Params& p, int task) {
    const int lane = tid_fresh() & 63; const int j = task / 4352, r = task % 4352; const int v = r >= 4096, t = v ? r - 4096 : r; const int Lv = v ? 256 : 4096;
    const float tl = (float)t / (float)(Lv - 1);
    const float omega = (float)(2.0 * 3.14159265358979323846 / (double)Lv) * (float)t;
    float feat = 0.f;
    if (lane == 0) feat = tl;
    else if (lane <= 32) { const int bi = (lane - 1) & 15; const float band = 1e-4f + (float)bi * ((15.0f - 1e-4f) / 15.0f); const float a = band * omega; feat = lane <= 16 ? cosf(a) : -sinf(a); }
    const float* w1 = p.hy_f_w1 + (size_t)j * 33 * 64; const float* w2 = p.hy_f_w2 + (size_t)j * 64 * 64;
    float s = p.hy_f_b1[j * 64 + lane];
    for (int f = 0; f < 33; ++f) s += bperm_f(feat, f) * w1[f * 64 + lane];
    const float h1 = sinf(p.hy_f_freq1[j * 64 + lane] * s);
    float s2 = p.hy_f_b2[j * 64 + lane];
    for (int m = 0; m < 64; ++m) s2 += bperm_f(h1, m) * w2[m * 64 + lane];
    const float h2 = sinf(p.hy_f_freq2[j * 64 + lane] * s2);
    const h16 hi = (h16)h2; const h16 lo = (h16)(h2 - (float)hi);
    h16* row = (h16*)(p.ws + WS_H2P) + ((size_t)j * 4352 + r) * 256;
    row[lane] = hi; row[64 + lane] = hi; row[128 + lane] = lo; row[192 + lane] = lo;
}
__device__ __forceinline__ void w3p_unit(const Params& p, int unit) {
    const int j = unit >> 5, c0 = (unit & 31) * 256; const float* w3 = p.hy_f_w3 + (size_t)j * 64 * 8192; h16* dst = (h16*)(p.ws + WS_W3P) + (size_t)j * 8192 * 256;
    for (int i = tid_fresh(); i < 64 * 256; i += 512) { const int m = i >> 8, col = c0 + (i & 255); const float w = w3[(size_t)m * 8192 + col];
        const h16 hi = (h16)w; const h16 lo = (h16)(w - (float)hi); h16* row = dst + (size_t)col * 256; row[m] = hi; row[64 + m] = lo; row[128 + m] = hi; row[192 + m] = lo; }
}
__device__ __forceinline__ void rtab_unit(const Params& p, int unit) {
    const int layer = unit >> 6, c = unit & 63; h16* dst = (h16*)(p.ws + WS_RTAB + (size_t)layer * RTAB_L) + (size_t)c * 5 * 2 * 64 * 8;
    for (int i = tid_fresh(); i < 5 * 2 * 64 * 8; i += 512) { const int jj = i & 7, lane = (i >> 3) & 63, hl = (i >> 9) & 1, ct = i >> 10;
        const int k = 32 * c + 8 * (lane >> 4) + jj, col = 16 * ct + (lane & 15);
        float w = 0.f; if (col < 8) w = p.moe_wg[((size_t)layer * D + k) * 8 + col]; else if (col < 72) w = p.moe_we[((size_t)layer * D + k) * 64 + (col - 8)];
        w *= 256.0f; const h16 hi = (h16)w; const h16 lo = (h16)(w - (float)hi); dst[i] = hl ? lo : hi; }
}
template <int NW>
__device__ __forceinline__ void cvt_tile(const float* src, int ldn, int k0, int n0, h16* dst, int ldk, int mode, LAS float* T) {
    constexpr int P = NW + 1; const int tid = tid_fresh();
#pragma unroll
    for (int ps = 0; ps < 64 * NW / 4 / 512; ++ps) { const int idx = ps * 512 + tid, k = idx / (NW / 4), n4 = idx % (NW / 4);
        const f32x4 v = *(const f32x4*)(src + (size_t)(k0 + k) * ldn + n0 + 4 * n4); LAS float* q = T + k * P + 4 * n4; q[0] = v[0]; q[1] = v[1]; q[2] = v[2]; q[3] = v[3]; }
    __syncthreads();
#pragma unroll
    for (int ps = 0; ps < NW * 8 / 512; ++ps) { const int item = ps * 512 + tid, kc = item & 7, n = item >> 3; f16x8 w;
#pragma unroll
        for (int i = 0; i < 8; ++i) w[i] = (h16)T[(8 * kc + i) * P + n];
        const int ng = n0 + n; const int row = mode == 0 ? ng : (8 * (ng >> 2) + (ng & 3) + (mode == 2 ? 4 : 0));
        *(f16x8*)(dst + (size_t)row * ldk + k0 + 8 * kc) = w; }
    __syncthreads();
}
__device__ __forceinline__ void cvt_dense_unit(const Params& p, int unit, LAS float* T) {
    const float* src; h16* dst; int nt, N;
    if (unit < 1536) { src = p.hy_w_in; dst = (h16*)(p.ws + WS_WIN); nt = 24; N = D3; }
    else if (unit < 2048) { unit -= 1536; src = p.hy_w_out; dst = (h16*)(p.ws + WS_WOUT); nt = 8; N = D; }
    else if (unit < 2688) { unit -= 2048; src = p.at_w_qkv; dst = (h16*)(p.ws + WS_WQKV); nt = 10; N = DQKV; }
    else { unit -= 2688; src = p.at_w_o; dst = (h16*)(p.ws + WS_WO); nt = 8; N = D; }
    const int j = unit / (32 * nt), r = unit % (32 * nt), kt = r / nt, ntile = r % nt;
    cvt_tile<256>(src + (size_t)j * D * N, N, kt * 64, ntile * 256, dst + (size_t)j * N * D, D, 0, T);
}
constexpr int CVT_DENSE_UNITS = 3200;
__device__ __forceinline__ void cvt_moe_unit(const Params& p, int layer, int unit, LAS float* T) {
    if (unit < 12288) { const int which = unit >= 6144; if (which) unit -= 6144; const int e = unit / 96, r = unit % 96, kt = r / 3, ntile = r % 3;
        const float* src = (which ? p.moe_w3 : p.moe_w1) + ((size_t)layer * NE + e) * D * DE;
        cvt_tile<128>(src, DE, kt * 64, ntile * 128, (h16*)(p.ws + WS_W13) + (size_t)e * DE2 * D, D, which ? 2 : 1, T); }
    else { unit -= 12288; const int e = unit / 48, r = unit % 48, kt = r / 8, ntile = r % 8;
        const float* src = p.moe_w2 + ((size_t)layer * NE + e) * DE * D;
        cvt_tile<256>(src, D, kt * 64, ntile * 256, (h16*)(p.ws + WS_W2) + (size_t)e * D * DE, DE, 0, T); }
}
constexpr int CVT_MOE_UNITS = 15360;
struct CvtD { const float* src; h16* dst; int mode; };
__device__ __forceinline__ CvtD cvt13_desc(const Params& p, int layer, int unit) {
    const int which = unit >= 6144; if (which) unit -= 6144; const int e = unit / 96, r = unit % 96, kt = r / 3, ntile = r % 3;
    CvtD d; d.src = (which ? p.moe_w3 : p.moe_w1) + ((size_t)layer * NE + e) * D * DE + (size_t)(kt * 64) * DE + ntile * 128;
    d.dst = (h16*)(p.ws + WS_W13) + (size_t)e * DE2 * D + kt * 64; d.mode = (which ? 4 : 0) + 8 * (256 * ntile); return d;
}
__device__ __forceinline__ void cvt13_load(const CvtD& d, f32x4 (&v)[4], int tid) {
#pragma unroll
    for (int ps = 0; ps < 4; ++ps) { const int idx = ps * 512 + tid, k = idx >> 5, n4 = idx & 31; v[ps] = *(const f32x4*)(d.src + (size_t)k * DE + 4 * n4); }
}
__device__ __forceinline__ void cvt13_store(const CvtD& d, const f32x4 (&v)[4], LAS float* T, int tid) {
    constexpr int P = 129;
#pragma unroll
    for (int ps = 0; ps < 4; ++ps) { const int idx = ps * 512 + tid, k = idx >> 5, n4 = idx & 31; LAS float* q = T + k * P + 4 * n4; q[0] = v[ps][0]; q[1] = v[ps][1]; q[2] = v[ps][2]; q[3] = v[ps][3]; }
    __syncthreads();
    const int w3off = d.mode & 7, rg0 = d.mode >> 3;
#pragma unroll
    for (int ps = 0; ps < 2; ++ps) { const int item = ps * 512 + tid, kc = item & 7, n = item >> 3; f16x8 w;
#pragma unroll
        for (int i = 0; i < 8; ++i) w[i] = (h16)T[(8 * kc + i) * P + n];
        const int row = rg0 + 8 * (n >> 2) + (n & 3) + w3off;
        *(f16x8*)(d.dst + (size_t)row * D + 8 * kc) = w; }
    __syncthreads();
}
__device__ __forceinline__ void cvt_moe_share(const Params& p, int layer, int u0, int n, int stride, LAS float* T) {
    const int tid = tid_fresh(); const int n13 = n < 12288 ? n : 12288;
    int u = u0;
    if (u < n13) {
        CvtD dA = cvt13_desc(p, layer, u), dB = dA, dC = dA; f32x4 vA[4], vB[4], vC[4];
        cvt13_load(dA, vA, tid);
        if (u + stride < n13) { dB = cvt13_desc(p, layer, u + stride); cvt13_load(dB, vB, tid); }
        for (;;) {
            if (u + 2 * stride < n13) { dC = cvt13_desc(p, layer, u + 2 * stride); cvt13_load(dC, vC, tid); }
            cvt13_store(dA, vA, T, tid); u += stride; if (u >= n13) break;
            if (u + 2 * stride < n13) { dA = cvt13_desc(p, layer, u + 2 * stride); cvt13_load(dA, vA, tid); }
            cvt13_store(dB, vB, T, tid); u += stride; if (u >= n13) break;
            if (u + 2 * stride < n13) { dB = cvt13_desc(p, layer, u + 2 * stride); cvt13_load(dB, vB, tid); }
            cvt13_store(dC, vC, T, tid); u += stride; if (u >= n13) break;
        }
    }
    for (; u < n; u += stride) cvt_moe_unit(p, layer, u, T);
}

template <int NR, bool FINAL>
__device__ __forceinline__ void n1_rows(const Params& p, int layer, int r0, int rstride, int lane, h16* xout) {
    const h16* xres = (const h16*)(p.ws + WS_XRES); h16* hb = (h16*)(p.ws + WS_HBUF); const h16* yc = (const h16*)(p.ws + WS_YC); const float* mods = (const float*)(p.ws + WS_MODS);
    f32x4 v[NR][8]; f16x4 xh[NR][8], ya[NR][8], yb[NR][8];
    const bool comb = FINAL || layer > 0; const int lprev = FINAL ? 3 : layer - 1;
#pragma unroll
    for (int q = 0; q < NR; ++q) { const int r = r0 + q * rstride;
        if (!comb) { const float* src = r < TL ? p.x + (size_t)r * D : p.ctx + (size_t)(r - TL) * D;
#pragma unroll
            for (int c = 0; c < 8; ++c) v[q][c] = *(const f32x4*)(src + c * 256 + lane * 4); }
        else { const h16* src = xres + (size_t)r * D; const h16* y0 = yc + (size_t)(2 * r) * D; const h16* y1 = y0 + D;
#pragma unroll
            for (int c = 0; c < 8; ++c) { xh[q][c] = *(const f16x4*)(src + c * 256 + lane * 4); ya[q][c] = *(const f16x4*)(y0 + c * 256 + lane * 4); yb[q][c] = *(const f16x4*)(y1 + c * 256 + lane * 4); } } }
#pragma unroll
    for (int q = 0; q < NR; ++q) { const int r = r0 + q * rstride; const int b = batch_of_row(r);
        if (comb) { const float* g2 = mods + ((size_t)(lprev * 9 + b) * 6 + 5) * D;
#pragma unroll
            for (int c = 0; c < 8; ++c) { const f32x4 g = *(const f32x4*)(g2 + c * 256 + lane * 4);
#pragma unroll
                for (int i = 0; i < 4; ++i) v[q][c][i] = (float)xh[q][c][i] + g[i] * ((float)ya[q][c][i] + (float)yb[q][c][i]); } }
        float ss = 0.f;
#pragma unroll
        for (int c = 0; c < 8; ++c) { if (!FINAL) { f16x4 w; w[0] = (h16)v[q][c][0]; w[1] = (h16)v[q][c][1]; w[2] = (h16)v[q][c][2]; w[3] = (h16)v[q][c][3]; *(f16x4*)(xout + (size_t)r * D + c * 256 + lane * 4) = w; } ss += v[q][c][0] * v[q][c][0] + v[q][c][1] * v[q][c][1] + v[q][c][2] * v[q][c][2] + v[q][c][3] * v[q][c][3]; }
        ss = wave_sum(ss); const float rs = 1.0f / sqrtf(ss * (1.0f / D) + EPS);
        if (FINAL) {
#pragma unroll
            for (int c = 0; c < 8; ++c) { const int col = c * 256 + lane * 4; const f32x4 g = *(const f32x4*)(p.final_gain + col); *(f32x4*)(p.out + (size_t)r * D + col) = v[q][c] * rs * g; }
        } else {
            const float* sh = mods + ((size_t)(layer * 9 + b) * 6 + 0) * D; const float* sc = sh + D;
#pragma unroll
            for (int c = 0; c < 8; ++c) { const int col = c * 256 + lane * 4; const f32x4 s0 = *(const f32x4*)(sh + col), s1 = *(const f32x4*)(sc + col); f16x4 w;
#pragma unroll
                for (int i = 0; i < 4; ++i) w[i] = (h16)(v[q][c][i] * rs * (1.0f + s1[i]) + s0[i]);
                *(f16x4*)(hb + (size_t)r * D + col) = w; }
        } }
}
template <bool FINAL>
__device__ __forceinline__ void n1_any(const Params& p, int layer, h16* xout) {
    const int tid = tid_fresh(), lane = tid & 63, gw = blockIdx.x * 8 + __builtin_amdgcn_readfirstlane(tid >> 6), nw = gridDim.x * 8; const int nrow = FINAL ? TL : TT;
    int r = gw;
    for (; r + nw < nrow; r += 2 * nw) n1_rows<2, FINAL>(p, layer, r, nw, lane, xout);
    if (r < nrow) n1_rows<1, FINAL>(p, layer, r, nw, lane, xout);
}
__device__ __forceinline__ void n1_phase(const Params& p, int layer, h16* xout) { n1_any<false>(p, layer, xout); }
__device__ __forceinline__ void final_phase(const Params& p) { n1_any<true>(p, 0, nullptr); }
constexpr int N2_CH = 4;
constexpr int N2_SLOT = N2_CH * 10 * 1024;
constexpr int N2_XT = 2 * N2_SLOT;
constexpr int N2_SC = N2_XT + 8 * 4096;
#ifndef PROBE_N2VAR
#define PROBE_N2VAR 0
#endif
__device__ __forceinline__ void n2_phase(const Params& p, int layer, LAS unsigned char* lds, int ctr_shadow) {
    const bool pv_tail = !(ctr_shadow && (PROBE_N2VAR & 1)), pv_store = !(ctr_shadow && (PROBE_N2VAR & 2)), pv_mma = !(ctr_shadow && (PROBE_N2VAR & 4));
    const int tid = tid_fresh(), lane = tid & 63, wv = __builtin_amdgcn_readfirstlane(tid >> 6), r16 = lane & 15, kg = lane >> 4;
    const int lrow = lane >> 3, lchk = lane & 7;
    const h16* xres = (const h16*)(p.ws + WS_XRES); h16* hb = (h16*)(p.ws + WS_HBUF); const float* mods = (const float*)(p.ws + WS_MODS);
    const char* rtb = p.ws + WS_RTAB + (size_t)layer * RTAB_L; const float* ssq = (const float*)(p.ws + WS_SSQ);
    int* counters = (int*)(p.ws + WS_CTL) + CTL_CNT + (layer + (ctr_shadow ? 4 : 0)) * NE; int* list = (int*)(p.ws + WS_LIST); float* gate = (float*)(p.ws + WS_GATE);
    LAS float* scr = (LAS float*)lds + wv * (16 * 80);
    LAS float* scl = (LAS float*)(lds + N2_SC); LAS float* shl = scl + D;
    LAS int* hist = (LAS int*)(lds + LDS_MISC); LAS int* hbase = hist + NE;
    LAS unsigned char* xt = lds + N2_XT + wv * 4096;
    const int hw_off0 = r16 * 128 + 16 * (kg ^ (r16 & 7)), hw_off1 = r16 * 128 + 16 * ((4 + kg) ^ (r16 & 7));
    const int hr_off = lrow * 128 + 16 * (lchk ^ (lrow & 7));
    const int ntask = (layer == NLAYER - 1 ? TL : TT) / 16, nfull = (int)gridDim.x * 8;
#pragma unroll 1
    for (int round = 0; round < 2; ++round) {
        const int nrem = ntask - nfull;
        if (round == 1 && (int)blockIdx.x >= nrem) break;
        const int task = round == 0 ? (int)blockIdx.x * 8 + wv : nfull + (int)blockIdx.x;
        const bool active = round == 0 ? (task < ntask) : true;
        const int trow = active ? task * 16 : 0;
        const int b = batch_of_row(trow);
        const h16* xg = xres + (size_t)(trow + r16) * D + 8 * kg;
        h16* hg0 = hb + (size_t)(trow + lrow) * D + lchk * 8; h16* hg1 = hg0 + (size_t)8 * D;
        float rs;
        { const float* sp = ssq + (size_t)(trow + r16) * 32; float t = 0.f;
#pragma unroll
            for (int q = 0; q < 8; ++q) { const f32x4 v = *(const f32x4*)(sp + 4 * q); t += (v[0] + v[1]) + (v[2] + v[3]); }
            rs = 1.0f / sqrtf(t * (1.0f / D) + EPS); }
        f32x4 acc[5];
#pragma unroll
        for (int ct = 0; ct < 5; ++ct) acc[ct] = (f32x4){0.f, 0.f, 0.f, 0.f};
        __syncthreads();
        if (tid < NE) hist[tid] = 0;
        { const float* scb = mods + ((size_t)(layer * 9 + b) * 6 + 4) * D; *(LAS f32x4*)(scl + tid * 4) = *(const f32x4*)(scb + tid * 4); *(LAS f32x4*)(shl + tid * 4) = *(const f32x4*)(scb - D + tid * 4); }
        if (round == 0) {
        f16x8 bq[5];
#pragma unroll
        for (int q = 0; q < 5; ++q) bq[q] = *(const f16x8*)(rtb + (size_t)(5 * wv + q) * 1024 + lane * 16);
#pragma unroll
        for (int q = 0; q < 5; ++q) *(LAS f16x8*)(lds + (5 * wv + q) * 1024 + lane * 16) = bq[q];
#pragma unroll
        for (int q = 0; q < 5; ++q) bq[q] = *(const f16x8*)(rtb + (size_t)N2_SLOT + (size_t)(5 * wv + q) * 1024 + lane * 16);
        f16x8 x0[N2_CH], x1[N2_CH], x2[N2_CH];
#pragma unroll
        for (int s2 = 0; s2 < N2_CH; ++s2) { x0[s2] = *(const f16x8*)(xg + 32 * s2); x1[s2] = *(const f16x8*)(xg + 32 * (N2_CH + s2)); }
#define N2_CHUNK(XC, XL, CH) do { const int ch = (CH); \
            __syncthreads(); \
            const int nx2 = (ch + 2 < 64 / N2_CH) ? ch + 2 : ch; \
            {   LAS unsigned char* dst = lds + ((ch + 1) & 1) * N2_SLOT; \
 _Pragma("unroll") \
                for (int q = 0; q < 5; ++q) *(LAS f16x8*)(dst + (5 * wv + q) * 1024 + lane * 16) = bq[q]; } \
            {   const char* src = rtb + (size_t)nx2 * N2_SLOT; \
 _Pragma("unroll") \
                for (int q = 0; q < 5; ++q) bq[q] = *(const f16x8*)(src + (size_t)(5 * wv + q) * 1024 + lane * 16); } \
 _Pragma("unroll") \
            for (int s2 = 0; s2 < N2_CH; ++s2) { const int ko = 32 * (nx2 * N2_CH + s2); XL[s2] = *(const f16x8*)(xg + ko); } \
            const LAS unsigned char* bs = lds + (ch & 1) * N2_SLOT + lane * 16; \
 _Pragma("unroll") \
            for (int pp = 0; pp < N2_CH / 2; ++pp) { \
                f16x8 hk[2]; \
 _Pragma("unroll") \
                for (int sp = 0; sp < 2; ++sp) { \
                    const int s2 = 2 * pp + sp; const int ko = 32 * (ch * N2_CH + s2) + 8 * kg; \
                    const f32x4 c0 = *(const LAS f32x4*)(scl + ko), c1 = *(const LAS f32x4*)(scl + ko + 4), h0 = *(const LAS f32x4*)(shl + ko), h1 = *(const LAS f32x4*)(shl + ko + 4); \
                    f16x8 hi, lo; \
 _Pragma("unroll") \
                    for (int i = 0; i < 4; ++i) { const float a0 = (float)XC[s2][i] * rs * (1.0f + c0[i]) + h0[i], a1 = (float)XC[s2][4 + i] * rs * (1.0f + c1[i]) + h1[i]; \
                        hi[i] = (h16)a0; lo[i] = (h16)(a0 - (float)hi[i]); hi[4 + i] = (h16)a1; lo[4 + i] = (h16)(a1 - (float)hi[4 + i]); } \
                    hk[sp] = hi; \
                    if (pv_mma) \
 _Pragma("unroll") \
                    for (int ct = 0; ct < 5; ++ct) { const f16x8 whi = *(const LAS f16x8*)(bs + (s2 * 10 + ct * 2 + 0) * 1024), wlo = *(const LAS f16x8*)(bs + (s2 * 10 + ct * 2 + 1) * 1024); \
                        acc[ct] = __builtin_amdgcn_mfma_f32_16x16x32_f16(hi, whi, acc[ct], 0, 0, 0); \
                        acc[ct] = __builtin_amdgcn_mfma_f32_16x16x32_f16(hi, wlo, acc[ct], 0, 0, 0); \
                        acc[ct] = __builtin_amdgcn_mfma_f32_16x16x32_f16(lo, whi, acc[ct], 0, 0, 0); } \
                } \
                *(LAS f16x8*)(xt + hw_off0) = hk[0]; *(LAS f16x8*)(xt + hw_off1) = hk[1]; \
                const f16x8 o0 = *(const LAS f16x8*)(xt + hr_off), o1 = *(const LAS f16x8*)(xt + 1024 + hr_off); \
                if (active && pv_store) { const int ho = 32 * (ch * N2_CH + 2 * pp); *(f16x8*)(hg0 + ho) = o0; *(f16x8*)(hg1 + ho) = o1; } \
            } \
        } while (0)
#pragma unroll 1
        for (int c3 = 0; c3 < 15; c3 += 3) { N2_CHUNK(x0, x2, c3); N2_CHUNK(x1, x0, c3 + 1); N2_CHUNK(x2, x1, c3 + 2); }
        N2_CHUNK(x0, x2, 15);
#undef N2_CHUNK
        } else {
            const char* rtw = rtb + (size_t)(8 * wv) * 10240; const int kb = 256 * wv;
            unsigned loff = (unsigned)lane * 16u; asm volatile("" : "+v"(loff));
            f16x8 bb[10];
            f16x8 xa[2][2];
#pragma unroll
            for (int sp = 0; sp < 2; ++sp) xa[0][sp] = *(const f16x8*)(xg + kb + 32 * sp);
#pragma unroll
            for (int pp = 0; pp < 4; ++pp) {
                if (pp < 3) {
#pragma unroll
                    for (int sp = 0; sp < 2; ++sp) xa[(pp + 1) & 1][sp] = *(const f16x8*)(xg + kb + 32 * (2 * pp + 2 + sp)); }
                f16x8 hk[2];
#pragma unroll
                for (int sp = 0; sp < 2; ++sp) {
                    const int st = 2 * pp + sp; const int ko = kb + 32 * st + 8 * kg;
#pragma unroll
                    for (int q = 0; q < 10; ++q) bb[q] = *(const f16x8*)(rtw + (size_t)(st * 10 + q) * 1024 + loff);
                    asm volatile("" ::: "memory");
                    const f32x4 c0 = *(const LAS f32x4*)(scl + ko), c1 = *(const LAS f32x4*)(scl + ko + 4), h0 = *(const LAS f32x4*)(shl + ko), h1 = *(const LAS f32x4*)(shl + ko + 4);
                    f16x8 hi, lo;
#pragma unroll
                    for (int i = 0; i < 4; ++i) { const float a0 = (float)xa[pp & 1][sp][i] * rs * (1.0f + c0[i]) + h0[i], a1 = (float)xa[pp & 1][sp][4 + i] * rs * (1.0f + c1[i]) + h1[i];
                        hi[i] = (h16)a0; lo[i] = (h16)(a0 - (float)hi[i]); hi[4 + i] = (h16)a1; lo[4 + i] = (h16)(a1 - (float)hi[4 + i]); }
                    hk[sp] = hi;
#pragma unroll
                    for (int ct = 0; ct < 5; ++ct) {
                        acc[ct] = __builtin_amdgcn_mfma_f32_16x16x32_f16(hi, bb[2 * ct], acc[ct], 0, 0, 0);
                        acc[ct] = __builtin_amdgcn_mfma_f32_16x16x32_f16(hi, bb[2 * ct + 1], acc[ct], 0, 0, 0);
                        acc[ct] = __builtin_amdgcn_mfma_f32_16x16x32_f16(lo, bb[2 * ct], acc[ct], 0, 0, 0); }
                }
                *(LAS f16x8*)(xt + hw_off0) = hk[0]; *(LAS f16x8*)(xt + hw_off1) = hk[1];
                const f16x8 o0 = *(const LAS f16x8*)(xt + hr_off), o1 = *(const LAS f16x8*)(xt + 1024 + hr_off);
                if (pv_store) { const int ho = kb + 64 * pp; *(f16x8*)(hg0 + ho) = o0; *(f16x8*)(hg1 + ho) = o1; }
            }
        }
        __syncthreads();
#pragma unroll
        for (int ct = 0; ct < 5; ++ct)
#pragma unroll
            for (int i = 0; i < 4; ++i) scr[(4 * kg + i) * 80 + 16 * ct + r16] = acc[ct][i] * (1.0f / 256.0f);
        asm volatile("s_waitcnt lgkmcnt(0)" ::: "memory");
        int ea = 0, eb = 0, ra = 0, rb = 0; float g1v = 0.f, g2v = 0.f; const bool tok_lane = (round == 0 ? active : wv == 0) && lane < 16 && pv_tail;
        const int nparts = round == 0 ? 1 : 8;
        if (tok_lane) {
            const LAS float* lgr = scr + lane * 80;
#define N2_LG(c) ({ float _t = lgr[(c)]; for (int _w = 1; _w < nparts; ++_w) _t += lgr[_w * 1280 + (c)]; _t; })
            float gmax = -3.0e38f; int gsel = 0; float gl[8];
#pragma unroll
            for (int g = 0; g < 8; ++g) { gl[g] = N2_LG(g) + p.moe_bg[layer * 8 + g]; if (gl[g] > gmax) { gmax = gl[g]; gsel = g; } }
            float gz = 0.f;
#pragma unroll
            for (int g = 0; g < 8; ++g) gz += expf(gl[g] - gmax);
            const float pg = 1.0f / gz;
            float f1 = -3.0e38f, f2 = -3.0e38f; int i1 = 0, i2 = 0;
            for (int q = 0; q < 8; ++q) { const float f = N2_LG(8 + gsel * 8 + q) + p.moe_be[layer * 64 + gsel * 8 + q];
                if (f > f1) { f2 = f1; i2 = i1; f1 = f; i1 = q; } else if (f > f2) { f2 = f; i2 = q; } }
            const float e2 = expf(f2 - f1); g1v = pg / (1.0f + e2); g2v = pg * e2 / (1.0f + e2);
            ea = gsel * 8 + i1; eb = gsel * 8 + i2;
#undef N2_LG
            ra = __hip_atomic_fetch_add(hist + ea, 1, __ATOMIC_RELAXED, __HIP_MEMORY_SCOPE_WORKGROUP); rb = __hip_atomic_fetch_add(hist + eb, 1, __ATOMIC_RELAXED, __HIP_MEMORY_SCOPE_WORKGROUP);
        }
        __syncthreads();
        { const int t2 = tid_fresh(); if (t2 < NE && pv_tail) { const int n = hist[t2]; hbase[t2] = n ? atomicAdd(&counters[t2], n) : 0; } }
        __syncthreads();
        if (tok_lane) { const int tok = task * 16 + lane; const size_t sa = (size_t)ea * LCAP + hbase[ea] + ra, sb = (size_t)eb * LCAP + hbase[eb] + rb;
            list[sa] = 2 * tok; gate[sa] = g1v; list[sb] = 2 * tok + 1; gate[sb] = g2v; }
    }
}
__device__ __forceinline__ void transpose_phase(const Params& p, LAS h16* T) {
    const h16* zt = (const h16*)(p.ws + WS_ZT); h16* z = (h16*)(p.ws + WS_HBUF); const int tid = tid_fresh();
    const int ntile = (D / 64) * (TT / 64);
    for (int tile = blockIdx.x; tile < ntile; tile += gridDim.x) {
        const int td = tile % (D / 64), tt = tile / (D / 64); const int d0 = td * 64, t0 = tt * 64;
        { const int dr = tid >> 3, tc = (tid & 7) * 8; const f16x8 v = *(const f16x8*)(zt + (size_t)(d0 + dr) * TT + t0 + tc);
#pragma unroll
            for (int i = 0; i < 8; ++i) T[(tc + i) * 66 + dr] = v[i]; }
        __syncthreads();
        { const int tr = tid >> 3, dc = (tid & 7) * 8; f16x8 v;
#pragma unroll
            for (int i = 0; i < 8; ++i) v[i] = T[tr * 66 + dc + i];
            *(f16x8*)(z + (size_t)(t0 + tr) * D + d0 + dc) = v; }
        __syncthreads();
    }
}

__device__ __forceinline__ f32x2 cmul(const f32x2 a, const f32x2 b) { return (f32x2){a.x * b.x - a.y * b.y, a.x * b.y + a.y * b.x}; }
__device__ __forceinline__ f32x2 cmulc(const f32x2 a, const f32x2 b) { return (f32x2){a.x * b.x + a.y * b.y, a.y * b.x - a.x * b.y}; }
__device__ __forceinline__ f32x2 cconj(const f32x2 a) { return (f32x2){a.x, -a.y}; }
template <bool INV> __device__ __forceinline__ f32x2 mul_mi(const f32x2 a) { return INV ? (f32x2){-a.y, a.x} : (f32x2){a.y, -a.x}; }
template <bool INV> __device__ __forceinline__ void dft4(f32x2& a, f32x2& b, f32x2& c, f32x2& d) {
    const f32x2 s0 = a + c, s1 = a - c, s2 = b + d, s3 = mul_mi<INV>(b - d);
    a = s0 + s2; b = s1 + s3; c = s0 - s2; d = s1 - s3;
}
template <bool INV, int M> __device__ __forceinline__ f32x2 w16mul(const f32x2 a) {
    constexpr float C1 = 0.92387953251128674f, S1 = 0.38268343236508977f, R = 0.70710678118654752f;
    constexpr float cr = (M == 0) ? 1.f : (M == 1) ? C1 : (M == 2) ? R : (M == 3) ? S1 : (M == 4) ? 0.f : (M == 6) ? -R :   -C1;
    constexpr float ci0 = (M == 0) ? 0.f : (M == 1) ? -S1 : (M == 2) ? -R : (M == 3) ? -C1 : (M == 4) ? -1.f : (M == 6) ? -R :   S1;
    constexpr float ci = INV ? -ci0 : ci0;
    return (f32x2){a.x * cr - a.y * ci, a.x * ci + a.y * cr};
}
template <bool INV> __device__ __forceinline__ void dft16(f32x2 (&v)[16]) {
#pragma unroll
    for (int n2 = 0; n2 < 4; ++n2) dft4<INV>(v[n2], v[4 + n2], v[8 + n2], v[12 + n2]);
    v[5] = w16mul<INV, 1>(v[5]); v[6] = w16mul<INV, 2>(v[6]); v[7] = w16mul<INV, 3>(v[7]);
    v[9] = w16mul<INV, 2>(v[9]); v[10] = w16mul<INV, 4>(v[10]); v[11] = w16mul<INV, 6>(v[11]);
    v[13] = w16mul<INV, 3>(v[13]); v[14] = w16mul<INV, 6>(v[14]); v[15] = w16mul<INV, 9>(v[15]);
#pragma unroll
    for (int k1 = 0; k1 < 4; ++k1) dft4<INV>(v[4 * k1], v[4 * k1 + 1], v[4 * k1 + 2], v[4 * k1 + 3]);
    f32x2 t;
    t = v[1]; v[1] = v[4]; v[4] = t; t = v[2]; v[2] = v[8]; v[8] = t; t = v[3]; v[3] = v[12]; v[12] = t;
    t = v[6]; v[6] = v[9]; v[9] = t; t = v[7]; v[7] = v[13]; v[13] = t; t = v[11]; v[11] = v[14]; v[14] = t;
}
__device__ __forceinline__ int fphys(int i) { return i + (i >> 4); }
__device__ __forceinline__ f32x2 w32c(int j) {
    constexpr float c[16] = {1.f, 0.98078528040323043f, 0.92387953251128674f, 0.83146961230254524f, 0.70710678118654752f, 0.55557023301960218f, 0.38268343236508977f, 0.19509032201612825f,
                             0.f, -0.19509032201612825f, -0.38268343236508977f, -0.55557023301960218f, -0.70710678118654752f, -0.83146961230254524f, -0.92387953251128674f, -0.98078528040323043f};
    constexpr float s[16] = {0.f, 0.19509032201612825f, 0.38268343236508977f, 0.55557023301960218f, 0.70710678118654752f, 0.83146961230254524f, 0.92387953251128674f, 0.98078528040323043f,
                             1.f, 0.98078528040323043f, 0.92387953251128674f, 0.83146961230254524f, 0.70710678118654752f, 0.55557023301960218f, 0.38268343236508977f, 0.19509032201612825f};
    return (f32x2){c[j], -s[j]};
}
template <int S>
__device__ __forceinline__ void fft_fwd0(const f32x2 (&xe)[16], const f32x2 (&xo)[16], LAS f32x2* E, LAS f32x2* O, int t, const f32x2* tw) {
    const f32x2 u = tw[t * (256 / S)]; const f32x2 u2 = cmul(u, u);
    f32x2 y[16];
#pragma unroll
    for (int j = 0; j < 16; ++j) y[j] = xe[j];
    dft16<false>(y);
    constexpr int QS = S + S / 16;
    LAS f32x2* Eb = E + fphys(t); LAS f32x2* Ob = O + fphys(t);
    f32x2 pw = u2; Eb[0] = y[0];
#pragma unroll
    for (int q = 1; q < 16; ++q) { Eb[QS * q] = cmul(y[q], pw); pw = cmul(pw, u2); }
#pragma unroll
    for (int j = 0; j < 16; ++j) y[j] = cmul(xo[j], w32c(j));
    dft16<false>(y);
    pw = u;
#pragma unroll
    for (int q = 0; q < 16; ++q) { Ob[QS * q] = cmul(y[q], pw); pw = cmul(pw, u2); }
}
template <bool INV> __device__ __forceinline__ void fft_pass1(LAS f32x2* A, int tau, const f32x2* tw) {
    const int i = tau & 15, base = (tau >> 4) << 8; const f32x2 u0 = tw[32 * i]; const f32x2 u = INV ? cconj(u0) : u0;
    f32x2 y[16]; LAS f32x2* Ab = A + fphys(base + i);
#pragma unroll
    for (int j = 0; j < 16; ++j) y[j] = Ab[17 * j];
    if (INV) { f32x2 pw = u;
#pragma unroll
        for (int q = 1; q < 16; ++q) { y[q] = cmul(y[q], pw); pw = cmul(pw, u); } }
    dft16<INV>(y);
    if (!INV) { f32x2 pw = u;
#pragma unroll
        for (int q = 1; q < 16; ++q) { y[q] = cmul(y[q], pw); pw = cmul(pw, u); } }
#pragma unroll
    for (int j = 0; j < 16; ++j) Ab[17 * j] = y[j];
}
template <bool INV> __device__ __forceinline__ void fft_pass1_pair(LAS f32x2* A, LAS f32x2* B, int tau, const f32x2* tw) {
    const int i = tau & 15, base = (tau >> 4) << 8; const f32x2 u0 = tw[32 * i]; const f32x2 u = INV ? cconj(u0) : u0;
    f32x2 y[16], z[16]; LAS f32x2* Ab = A + fphys(base + i); LAS f32x2* Bb = B + fphys(base + i);
#pragma unroll
    for (int j = 0; j < 16; ++j) y[j] = Ab[17 * j];
#pragma unroll
    for (int j = 0; j < 16; ++j) z[j] = Bb[17 * j];
    f32x2 pwr[16]; pwr[1] = u;
#pragma unroll
    for (int q = 2; q < 16; ++q) pwr[q] = cmul(pwr[q - 1], u);
    if (INV) {
#pragma unroll
        for (int q = 1; q < 16; ++q) y[q] = cmul(y[q], pwr[q]); }
    dft16<INV>(y);
    if (!INV) {
#pragma unroll
        for (int q = 1; q < 16; ++q) y[q] = cmul(y[q], pwr[q]); }
#pragma unroll
    for (int j = 0; j < 16; ++j) Ab[17 * j] = y[j];
    if (INV) {
#pragma unroll
        for (int q = 1; q < 16; ++q) z[q] = cmul(z[q], pwr[q]); }
    dft16<INV>(z);
    if (!INV) {
#pragma unroll
        for (int q = 1; q < 16; ++q) z[q] = cmul(z[q], pwr[q]); }
#pragma unroll
    for (int j = 0; j < 16; ++j) Bb[17 * j] = z[j];
}
__device__ __forceinline__ void fft_fwd2(const LAS f32x2* A, int t, f32x2 (&y)[16]) {
#pragma unroll
    for (int j = 0; j < 16; ++j) y[j] = A[17 * t + j];
    dft16<false>(y);
}
__device__ __forceinline__ void kf_load(const f32x2* kf, f32x4 (&k)[8]) {
#pragma unroll
    for (int j = 0; j < 8; ++j) k[j] = *(const f32x4*)(kf + 2 * j);
}
__device__ __forceinline__ void fft_mid(LAS f32x2* A, int t, const f32x4 (&k)[8]) {
    f32x2 y[16];
    fft_fwd2(A, t, y);
#pragma unroll
    for (int j = 0; j < 8; ++j) { y[2 * j] = cmul(y[2 * j], (f32x2){k[j][0], k[j][1]}); y[2 * j + 1] = cmul(y[2 * j + 1], (f32x2){k[j][2], k[j][3]}); }
    dft16<true>(y);
#pragma unroll
    for (int j = 0; j < 16; ++j) A[17 * t + j] = y[j];
}
template <int S>
__device__ __forceinline__ void fft_inv0(const LAS f32x2* E, const LAS f32x2* O, int t, const f32x2* tw, f32x2 (&out)[16]) {
    const f32x2 u = tw[t * (256 / S)]; const f32x2 u2 = cmul(u, u);
    f32x2 y[16];
    constexpr int QS = S + S / 16;
    const LAS f32x2* Eb = E + fphys(t); const LAS f32x2* Ob = O + fphys(t);
    f32x2 pw = u2; y[0] = Eb[0];
#pragma unroll
    for (int q = 1; q < 16; ++q) { y[q] = cmulc(Eb[QS * q], pw); pw = cmul(pw, u2); }
    dft16<true>(y);
#pragma unroll
    for (int j = 0; j < 16; ++j) out[j] = y[j];
    pw = u;
#pragma unroll
    for (int q = 0; q < 16; ++q) { y[q] = cmulc(Ob[QS * q], pw); pw = cmul(pw, u2); }
    dft16<true>(y);
#pragma unroll
    for (int j = 0; j < 16; ++j) out[j] += cmulc(y[j], w32c(j));
}
__device__ __forceinline__ float hy_absdelta(int d) { return fabsf(-3.0701134573253943f + (-15.350567286626973f + 3.0701134573253943f) * ((float)d / 2047.0f)); }

__device__ __forceinline__ void filt_fft_phase(const Params& p, LAS unsigned char* lds) {
    const int tid = tid_fresh();
    const f32x2* tw = (const f32x2*)(p.ws + WS_TW);
    {
        const int grp = tid >> 8, tau = tid & 255;
        LAS f32x2* E = (LAS f32x2*)(lds + grp * 69632); LAS f32x2* O = E + 4352; LAS float* red = (LAS float*)(lds + LDS_MISC) + grp * 8;
        for (int pb = blockIdx.x * 2 + grp; pb < 2 * 2 * 2048; pb += gridDim.x * 2) {
            const int d = pb & 2047, n = (pb >> 11) & 1, j = pb >> 12;
            const float* tf = (const float*)(p.ws + WS_TAPS) + ((size_t)j * 8192 + (size_t)(n * 2 + 0) * D + d) * 4096;
            const float* tb = tf + (size_t)D * 4096;
            const float adel = hy_absdelta(d); const float tscale = 1.0f / 4095.0f;
            f32x2 xe[16], xo[16]; float ss = 0.f;
#pragma unroll
            for (int jj = 0; jj < 16; ++jj) { const int nn = tau + 256 * jj;
                const float klo = tf[nn] * expf(-(float)nn * tscale * adel);
                const int m = 4096 - nn;
                const float khi = (m < 4096) ? tb[m & 4095] * expf(-(float)m * tscale * adel) : 0.f;
                ss += klo * klo + khi * khi; xe[jj] = (f32x2){klo + khi, 0.f}; xo[jj] = (f32x2){klo - khi, 0.f}; }
            ss = wave_sum(ss);
            if ((tid & 63) == 0) red[(tid >> 6) & 3] = ss;
            fft_fwd0<256>(xe, xo, E, O, tau, tw);
            __syncthreads();
            const float tot = red[0] + red[1] + red[2] + red[3];
            const float scale = (1.0f / sqrtf(tot + EPS)) * (1.0f / 8192.0f);
            const float hbs = p.hy_bias[((size_t)j * 2 + n) * D + d] * (1.0f / 8192.0f);
            fft_pass1<false>(E, tau, tw); fft_pass1<false>(O, tau, tw);
            __syncthreads();
            f32x2* kf = (f32x2*)(p.ws + WS_KF) + (size_t)pb * 8192 + (size_t)tau * 16;
            f32x2 y[16];
            fft_fwd2(E, tau, y);
#pragma unroll
            for (int q = 0; q < 8; ++q) *(f32x4*)(kf + 2 * q) = (f32x4){y[2 * q].x * scale + hbs, y[2 * q].y * scale, y[2 * q + 1].x * scale + hbs, y[2 * q + 1].y * scale};
            fft_fwd2(O, tau, y);
#pragma unroll
            for (int q = 0; q < 8; ++q) *(f32x4*)(kf + 4096 + 2 * q) = (f32x4){y[2 * q].x * scale + hbs, y[2 * q].y * scale, y[2 * q + 1].x * scale + hbs, y[2 * q + 1].y * scale};
            __syncthreads();
        }
    }
    {
        const int pr = tid >> 4, i = tid & 15;
        LAS f32x2* E = (LAS f32x2*)(lds + pr * 4352); LAS f32x2* O = E + 272;
        for (int it = blockIdx.x; it < 256; it += gridDim.x) {
            const int pb = it * 32 + pr; const int d = pb & 2047, n = (pb >> 11) & 1, j = pb >> 12;
            const float* tf = (const float*)(p.ws + WS_TAPSC) + ((size_t)j * 8192 + (size_t)(n * 2 + 0) * D + d) * 256;
            const float* tb = tf + (size_t)D * 256;
            const float adel = hy_absdelta(d); const float tscale = 1.0f / 255.0f;
            f32x2 xe[16], xo[16]; float ss = 0.f;
#pragma unroll
            for (int jj = 0; jj < 16; ++jj) { const int nn = i + 16 * jj;
                const float klo = tf[nn] * expf(-(float)nn * tscale * adel);
                const int m = 256 - nn;
                const float khi = (m < 256) ? tb[m & 255] * expf(-(float)m * tscale * adel) : 0.f;
                ss += klo * klo + khi * khi; xe[jj] = (f32x2){klo + khi, 0.f}; xo[jj] = (f32x2){klo - khi, 0.f}; }
            ss += shx(ss, 8); ss += shx(ss, 4); ss += shx(ss, 2); ss += shx(ss, 1);
            const float scale = (1.0f / sqrtf(ss + EPS)) * (1.0f / 512.0f);
            const float hbs = p.hy_bias[((size_t)j * 2 + n) * D + d] * (1.0f / 512.0f);
            fft_fwd0<16>(xe, xo, E, O, i, tw);
            __syncthreads();
            f32x2* kf = (f32x2*)(p.ws + WS_KFC) + (size_t)pb * 512 + (size_t)i * 16;
            f32x2 y[16];
            fft_fwd2(E, i, y);
#pragma unroll
            for (int q = 0; q < 8; ++q) *(f32x4*)(kf + 2 * q) = (f32x4){y[2 * q].x * scale + hbs, y[2 * q].y * scale, y[2 * q + 1].x * scale + hbs, y[2 * q + 1].y * scale};
            fft_fwd2(O, i, y);
#pragma unroll
            for (int q = 0; q < 8; ++q) *(f32x4*)(kf + 256 + 2 * q) = (f32x4){y[2 * q].x * scale + hbs, y[2 * q].y * scale, y[2 * q + 1].x * scale + hbs, y[2 * q + 1].y * scale};
            __syncthreads();
        }
    }
}

__device__ __forceinline__ float conv3_lds(const LAS h16* row, int n, float w0, float w1, float w2, float b) { return (float)row[n - 1] * w0 + (float)row[n] * w1 + (float)row[n + 1] * w2 + b; }
constexpr int ST_P = 4112, STS_P = 272;

#ifndef PROBE_CVAR
#define PROBE_CVAR 0
#endif
__device__ __forceinline__ void conv_phase(const Params& p, int jl, LAS unsigned char* lds, int pvar = 0, int cvt_layer = -1, int cvt_n = 0) {
    const int tid = tid_fresh(); const bool cv_outer = !(pvar && (PROBE_CVAR & 1)), cv_inner = !(pvar && (PROBE_CVAR & 2));
    const f32x2* tw = (const f32x2*)(p.ws + WS_TW);
    const h16* ut = (const h16*)(p.ws + WS_UT); h16* zt = (h16*)(p.ws + WS_ZT);
    const float* cw = p.hy_conv_w + (size_t)jl * 3 * D3; const float* cb = p.hy_conv_b + (size_t)jl * D3;
    {
        const int grp = tid >> 8, tau = tid & 255;
        LAS f32x2* E = (LAS f32x2*)(lds + grp * 69632); LAS f32x2* O = E + 4352; LAS h16* ST = (LAS h16*)E;
        int uit = 0; const int utrig = 4 * (((int)blockIdx.x >> 3) & 3);
        for (int unit = blockIdx.x; unit < 4096; unit += gridDim.x, ++uit) {
            if (cvt_layer >= 0 && uit == utrig) { __syncthreads(); cvt_moe_share(p, cvt_layer, blockIdx.x, cvt_n, gridDim.x, (LAS float*)lds); }
            const int ux = unit & 7, uj = unit >> 3; const int hq = uj & 1, d = (uj >> 1) * 8 + ux; const size_t col0 = (size_t)(4 * hq + 2 * grp) * 4096;
            const f32x2* kfb = (const f32x2*)(p.ws + WS_KF) + ((size_t)(jl * 2) * 2048 + d) * 8192 + (size_t)tau * 16;
            f16x8 raw[2][2][2], raw2[2][2];
#pragma unroll
            for (int sq = 0; sq < 2; ++sq)
#pragma unroll
                for (int bb = 0; bb < 2; ++bb)
#pragma unroll
                    for (int k = 0; k < 2; ++k) raw[sq][bb][k] = *(const f16x8*)(ut + (size_t)(sq * D + d) * TT + col0 + (size_t)bb * 4096 + (size_t)(tau + 256 * k) * 8);
            __syncthreads();
#pragma unroll
            for (int sq = 0; sq < 2; ++sq)
#pragma unroll
                for (int bb = 0; bb < 2; ++bb)
#pragma unroll
                    for (int k = 0; k < 2; ++k) *(LAS f16x8*)(ST + (sq * 2 + bb) * ST_P + 8 + (tau + 256 * k) * 8) = raw[sq][bb][k];
            if (tau < 4) { ST[tau * ST_P + 7] = (h16)0.f; ST[tau * ST_P + 8 + 4096] = (h16)0.f; }
            __syncthreads();
            f32x2 xin[16], gk[16], y[16];
            { const float w0 = cw[d], w1 = cw[D3 + d], w2 = cw[2 * D3 + d], bv = cb[d]; const float g0 = cw[D + d], g1 = cw[D3 + D + d], g2 = cw[2 * D3 + D + d], gb = cb[D + d];
#pragma unroll
                for (int jj = 0; jj < 16; ++jj) { const int nn = tau + 256 * jj;
                    xin[jj] = (f32x2){conv3_lds(ST + 8, nn, w0, w1, w2, bv), conv3_lds(ST + ST_P + 8, nn, w0, w1, w2, bv)};
                    gk[jj] = (f32x2){conv3_lds(ST + 2 * ST_P + 8, nn, g0, g1, g2, gb), conv3_lds(ST + 3 * ST_P + 8, nn, g0, g1, g2, gb)}; } }
            __syncthreads();
#pragma unroll 1
            for (int ord = 0; ord < 2; ++ord) {
                if (cv_outer) fft_fwd0<256>(xin, xin, E, O, tau, tw);
                const f32x2* kf = kfb + (size_t)ord * 2048 * 8192; f32x4 kfe[8], kfo[8];
                kf_load(kf, kfe);
                __syncthreads();
                if (cv_inner) fft_pass1_pair<false>(E, O, tau, tw);
                kf_load(kf + 4096, kfo);
                __syncthreads();
                if (cv_inner) { fft_mid(E, tau, kfe); fft_mid(O, tau, kfo); }
                if (ord == 0) {
#pragma unroll
                    for (int bb = 0; bb < 2; ++bb)
#pragma unroll
                        for (int k = 0; k < 2; ++k) raw2[bb][k] = *(const f16x8*)(ut + (size_t)(2 * D + d) * TT + col0 + (size_t)bb * 4096 + (size_t)(tau + 256 * k) * 8); }
                __syncthreads();
                if (cv_inner) fft_pass1_pair<true>(E, O, tau, tw);
                __syncthreads();
                if (cv_outer) fft_inv0<256>(E, O, tau, tw, y); else {
#pragma unroll
                    for (int jj = 0; jj < 16; ++jj) y[jj] = xin[jj]; }
#pragma unroll
                for (int jj = 0; jj < 16; ++jj) xin[jj] = gk[jj] * y[jj];
                if (ord == 0) {
                    __syncthreads();
#pragma unroll
                    for (int bb = 0; bb < 2; ++bb)
#pragma unroll
                        for (int k = 0; k < 2; ++k) *(LAS f16x8*)(ST + bb * ST_P + 8 + (tau + 256 * k) * 8) = raw2[bb][k];
                    if (tau < 2) { ST[tau * ST_P + 7] = (h16)0.f; ST[tau * ST_P + 8 + 4096] = (h16)0.f; }
                    __syncthreads();
                    const float g0 = cw[2 * D + d], g1 = cw[D3 + 2 * D + d], g2 = cw[2 * D3 + 2 * D + d], gb = cb[2 * D + d];
#pragma unroll
                    for (int jj = 0; jj < 16; ++jj) { const int nn = tau + 256 * jj; gk[jj] = (f32x2){conv3_lds(ST + 8, nn, g0, g1, g2, gb), conv3_lds(ST + ST_P + 8, nn, g0, g1, g2, gb)}; }
                    __syncthreads();
                }
            }
            h16* o0 = zt + (size_t)d * TT + col0; h16* o1 = o0 + 4096;
#pragma unroll
            for (int jj = 0; jj < 16; ++jj) { const int nn = tau + 256 * jj; o0[nn] = (h16)xin[jj].x; o1[nn] = (h16)xin[jj].y; }
        }
    }
    {
        const int pr = tid >> 4, i = tid & 15, c8 = pr >> 2, bp = pr & 3;
        LAS f32x2* E = (LAS f32x2*)(lds + pr * 4352); LAS f32x2* O = E + 272; LAS h16* ST = (LAS h16*)lds;
        for (int unit = blockIdx.x; unit < 256; unit += gridDim.x) {
            const int d0 = unit * 8, d = d0 + c8;
            const f32x2* kfb = (const f32x2*)(p.ws + WS_KFC) + ((size_t)(jl * 2) * 2048 + d) * 512 + (size_t)i * 16;
            f16x8 raw[3][4];
#pragma unroll
            for (int sq = 0; sq < 3; ++sq)
#pragma unroll
                for (int k = 0; k < 4; ++k) { const int q = tid + 512 * k, row = q >> 5, ch = q & 31;
                    raw[sq][k] = *(const f16x8*)(ut + (size_t)(sq * D + d0 + (row >> 3)) * TT + TL + (row & 7) * 256 + ch * 8); }
            __syncthreads();
#pragma unroll
            for (int sq = 0; sq < 2; ++sq)
#pragma unroll
                for (int k = 0; k < 4; ++k) { const int q = tid + 512 * k, row = q >> 5, ch = q & 31; *(LAS f16x8*)(ST + (sq * 64 + row) * STS_P + 8 + ch * 8) = raw[sq][k]; }
            if (tid < 128) { ST[tid * STS_P + 7] = (h16)0.f; ST[tid * STS_P + 8 + 256] = (h16)0.f; }
            __syncthreads();
            f32x2 xin[16], gk[16], y[16];
            { const float w0 = cw[d], w1 = cw[D3 + d], w2 = cw[2 * D3 + d], bv = cb[d]; const float g0 = cw[D + d], g1 = cw[D3 + D + d], g2 = cw[2 * D3 + D + d], gb = cb[D + d];
                const LAS h16* r0 = ST + (c8 * 8 + 2 * bp) * STS_P + 8; const LAS h16* r1 = r0 + 64 * STS_P;
#pragma unroll
                for (int jj = 0; jj < 16; ++jj) { const int nn = i + 16 * jj;
                    xin[jj] = (f32x2){conv3_lds(r0, nn, w0, w1, w2, bv), conv3_lds(r0 + STS_P, nn, w0, w1, w2, bv)};
                    gk[jj] = (f32x2){conv3_lds(r1, nn, g0, g1, g2, gb), conv3_lds(r1 + STS_P, nn, g0, g1, g2, gb)}; } }
            __syncthreads();
#pragma unroll 1
            for (int ord = 0; ord < 2; ++ord) {
                const f32x2* kf = kfb + (size_t)ord * 2048 * 512; f32x4 kfe[8], kfo[8];
                fft_fwd0<16>(xin, xin, E, O, i, tw);
                __syncthreads();
                kf_load(kf, kfe); fft_mid(E, i, kfe); kf_load(kf + 256, kfo); fft_mid(O, i, kfo);
                __syncthreads();
                fft_inv0<16>(E, O, i, tw, y);
#pragma unroll
                for (int jj = 0; jj < 16; ++jj) xin[jj] = gk[jj] * y[jj];
                if (ord == 0) {
                    __syncthreads();
#pragma unroll
                    for (int k = 0; k < 4; ++k) { const int q = tid + 512 * k, row = q >> 5, ch = q & 31; *(LAS f16x8*)(ST + row * STS_P + 8 + ch * 8) = raw[2][k]; }
                    if (tid < 64) { ST[tid * STS_P + 7] = (h16)0.f; ST[tid * STS_P + 8 + 256] = (h16)0.f; }
                    __syncthreads();
                    const float g0 = cw[2 * D + d], g1 = cw[D3 + 2 * D + d], g2 = cw[2 * D3 + 2 * D + d], gb = cb[2 * D + d];
                    const LAS h16* r0 = ST + (c8 * 8 + 2 * bp) * STS_P + 8;
#pragma unroll
                    for (int jj = 0; jj < 16; ++jj) { const int nn = i + 16 * jj; gk[jj] = (f32x2){conv3_lds(r0, nn, g0, g1, g2, gb), conv3_lds(r0 + STS_P, nn, g0, g1, g2, gb)}; }
                    __syncthreads();
                }
            }
            h16* o0 = zt + (size_t)d * TT + TL + (2 * bp) * 256; h16* o1 = o0 + 256;
#pragma unroll
            for (int jj = 0; jj < 16; ++jj) { const int nn = i + 16 * jj; o0[nn] = (h16)xin[jj].x; o1[nn] = (h16)xin[jj].y; }
        }
    }
}

constexpr int AT_KP = 72, AT_VP = 68;
__device__ __forceinline__ void attn_phase(const Params& p, int jl, bool with_ctx_out, LAS unsigned char* lds, int cvt_layer = -1, int cvt_n = 0) {
    const int tid = tid_fresh(), wv = tid >> 6, lane = tid & 63, r32 = lane & 31, hh = lane >> 5;
    LAS h16* Ks = (LAS h16*)lds; LAS h16* Vs = (LAS h16*)(lds + 64 * AT_KP * 2);
    const h16* qk = (const h16*)(p.ws + WS_QK); const h16* vt = (const h16*)(p.ws + WS_VT); h16* ob = (h16*)(p.ws + WS_HBUF);
    const float* rcos = (const float*)(p.ws + WS_ROPE); const float* rsin = rcos + 1024;
    const int nunit = 2048 + (with_ctx_out ? 128 : 0);
    int uit = 0; const int utrig = 2 * (((int)blockIdx.x >> 3) & 3);
    for (int unit = blockIdx.x; unit < nunit; unit += gridDim.x, ++uit) {
        if (cvt_layer >= 0 && uit == utrig) { __syncthreads(); cvt_moe_share(p, cvt_layer, blockIdx.x, cvt_n, gridDim.x, (LAS float*)lds); }
        int kind, b, g, qb;
        if (unit < 2048) { kind = 0; qb = unit & 63; g = (unit >> 6) & 3; b = unit >> 8; } else { const int u2 = unit - 2048; kind = 1; qb = u2 & 3; g = (u2 >> 2) & 3; b = u2 >> 4; }
        const int head = g * 8 + wv;
        const int qrow0 = kind ? (TL + b * 256 + qb * 64) : (b * 4096 + qb * 64);
        const int ctxrow0 = TL + b * 256;
        f16x8 qf[2][4];
#pragma unroll
        for (int qt = 0; qt < 2; ++qt) {
            f32x4 qv[4][2];
            const h16* qp = qk + (size_t)(qrow0 + 32 * qt + r32) * DQK + head * 64 + 8 * hh;
#pragma unroll
            for (int ks = 0; ks < 4; ++ks) { const f16x8 t = *(const f16x8*)(qp + 16 * ks);
#pragma unroll
                for (int i = 0; i < 4; ++i) { qv[ks][0][i] = (float)t[i]; qv[ks][1][i] = (float)t[4 + i]; } }
            if (kind == 0) {
                const int colpos = 32 * qt + r32;
#pragma unroll
                for (int a = 0; a < 2; ++a) { const int pos = a ? colpos : qb; const float* cp = rcos + pos * 16 + 8 * hh; const float* sp = rsin + pos * 16 + 8 * hh;
#pragma unroll
                    for (int e = 0; e < 2; ++e) { const f32x4 c = *(const f32x4*)(cp + 4 * e), s = *(const f32x4*)(sp + 4 * e);
                        const f32x4 x1 = qv[2 * a][e], x2 = qv[2 * a + 1][e]; qv[2 * a][e] = x1 * c - x2 * s; qv[2 * a + 1][e] = x2 * c + x1 * s; } }
            }
#pragma unroll
            for (int ks = 0; ks < 4; ++ks)
#pragma unroll
                for (int i = 0; i < 4; ++i) { qf[qt][ks][i] = (h16)(qv[ks][0][i] * (0.125f * 1.4426950408889634f)); qf[qt][ks][4 + i] = (h16)(qv[ks][1][i] * (0.125f * 1.4426950408889634f)); }
        }
        const float sink = p.at_sink[jl * 32 + head] * 1.4426950408889634f;
        float mrun[2] = {sink, sink}, lrun[2] = {hh == 0 ? 1.f : 0.f, hh == 0 ? 1.f : 0.f};
        f32x16 oacc[2][2];
#pragma unroll
        for (int a = 0; a < 2; ++a)
#pragma unroll
            for (int c = 0; c < 2; ++c)
#pragma unroll
                for (int i = 0; i < 16; ++i) oacc[a][c][i] = 0.f;
        const int t_lo = kind ? 0 : (qb < 2 ? 2 - qb : 0), t_hi = kind ? -1 : (65 - qb < 4 ? 65 - qb : 4); const int nwin = t_hi - t_lo + 1, nv = nwin + 4;
        const bool krole = tid < 256; const int kkey = tid >> 2, kcp = tid & 3, kdA = (kcp & 1) * 8 + (kcp >> 1) * 32; const int vdim = (tid - 256) >> 2, vkc = tid & 3;
        f16x8 ld0, ld1;
#define AT_TILE(sidx, KROW0, MASK, ROPE) do { if ((sidx) < nwin) { const int _ti = t_lo + (sidx); KROW0 = b * 4096 + qb * 64 - 128 + 64 * _ti; ROPE = true; MASK = (_ti == 0) ? 1 : (_ti == 4) ? 2 : 0; } \
            else { KROW0 = ctxrow0 + 64 * ((sidx) - nwin); ROPE = false; MASK = 0; } } while (0)
#define AT_LOAD(KROW0) do { if (krole) { const h16* kp = qk + (size_t)((KROW0) + kkey) * DQK + D + g * 64 + kdA; ld0 = *(const f16x8*)kp; ld1 = *(const f16x8*)(kp + 16); } \
            else { const h16* vp = vt + (size_t)(g * 64 + vdim) * TT + (KROW0) + 16 * vkc; ld0 = *(const f16x8*)vp; ld1 = *(const f16x8*)(vp + 8); } } while (0)
        { int kr0, mk; bool rp; AT_TILE(0, kr0, mk, rp); (void)mk; (void)rp; AT_LOAD(kr0); }
#pragma unroll 1
        for (int sx = 0; sx < nv; ++sx) {
            int krow0, mask; bool rope; AT_TILE(sx, krow0, mask, rope);
            __syncthreads();
            if (krole) {
                f16x8 o1 = ld0, o2 = ld1;
                if (rope) { const int kpos = (krow0 - b * 4096) + kkey; const int pos = (kcp >> 1) ? (kpos & 63) : (kpos >> 6);
                    const float* cpp = rcos + pos * 16 + (kcp & 1) * 8; const float* spp = rsin + pos * 16 + (kcp & 1) * 8;
#pragma unroll
                    for (int i = 0; i < 8; ++i) { const float c = cpp[i], s = spp[i], x1 = (float)ld0[i], x2 = (float)ld1[i]; o1[i] = (h16)(x1 * c - x2 * s); o2[i] = (h16)(x2 * c + x1 * s); } }
                *(LAS f16x8*)(Ks + kkey * AT_KP + kdA) = o1; *(LAS f16x8*)(Ks + kkey * AT_KP + kdA + 16) = o2;
            } else {
                LAS h16* dst = Vs + vdim * AT_VP + 16 * vkc;
                *(LAS f16x4*)(dst) = (f16x4){ld0[0], ld0[1], ld0[2], ld0[3]}; *(LAS f16x4*)(dst + 4) = (f16x4){ld0[4], ld0[5], ld0[6], ld0[7]};
                *(LAS f16x4*)(dst + 8) = (f16x4){ld1[0], ld1[1], ld1[2], ld1[3]}; *(LAS f16x4*)(dst + 12) = (f16x4){ld1[4], ld1[5], ld1[6], ld1[7]};
            }
            if (sx + 1 < nv) { int kr1, mk1; bool rp1; AT_TILE(sx + 1, kr1, mk1, rp1); (void)mk1; (void)rp1; AT_LOAD(kr1); }
            __syncthreads();
#pragma unroll
            for (int qt = 0; qt < 2; ++qt) {
                f32x16 sacc[2];
#pragma unroll
                for (int kt = 0; kt < 2; ++kt)
#pragma unroll
                    for (int i = 0; i < 16; ++i) sacc[kt][i] = 0.f;
#pragma unroll
                for (int ks = 0; ks < 4; ++ks)
#pragma unroll
                    for (int kt = 0; kt < 2; ++kt) { const f16x8 kf = *(const LAS f16x8*)(Ks + (32 * kt + r32) * AT_KP + 16 * ks + 8 * hh);
                        sacc[kt] = __builtin_amdgcn_mfma_f32_32x32x16_f16(kf, qf[qt][ks], sacc[kt], 0, 0, 0); }
                float tmax = -3.0e38f;
                if (mask != 0) {
                    int lim = r32 - 4 * hh; asm volatile("" : "+v"(lim));
                    if (mask == 1) {
#pragma unroll
                        for (int kt = 0; kt < 2; ++kt) {
                            if (kt < qt) {
#pragma unroll
                                for (int i = 0; i < 16; ++i) sacc[kt][i] = -1.0e30f; }
                            else if (kt == qt) {
#pragma unroll
                                for (int i = 0; i < 16; ++i) { const int kc = (i & 3) + 8 * (i >> 2); if (kc < lim) sacc[kt][i] = -1.0e30f; } } }
                    } else {
#pragma unroll
                        for (int kt = 0; kt < 2; ++kt) {
                            if (kt > qt) {
#pragma unroll
                                for (int i = 0; i < 16; ++i) sacc[kt][i] = -1.0e30f; }
                            else if (kt == qt) {
#pragma unroll
                                for (int i = 0; i < 16; ++i) { const int kc = (i & 3) + 8 * (i >> 2); if (kc > lim) sacc[kt][i] = -1.0e30f; } } }
                    } }
#pragma unroll
                for (int kt = 0; kt < 2; ++kt)
#pragma unroll
                    for (int i = 0; i < 16; ++i) tmax = fmaxf(tmax, sacc[kt][i]);
                tmax = fmaxf(tmax, shx(tmax, 32));
                const float mnew = fmaxf(mrun[qt], tmax); const float alpha = __builtin_amdgcn_exp2f(mrun[qt] - mnew); mrun[qt] = mnew;
                float psum = 0.f; f16x8 pf[2][2];
#pragma unroll
                for (int kt = 0; kt < 2; ++kt)
#pragma unroll
                    for (int s2 = 0; s2 < 2; ++s2)
#pragma unroll
                        for (int jj = 0; jj < 8; jj += 2) { const float p0 = __builtin_amdgcn_exp2f(sacc[kt][8 * s2 + jj] - mnew), p1 = __builtin_amdgcn_exp2f(sacc[kt][8 * s2 + jj + 1] - mnew);
                            const f16x2 pk = {(h16)p0, (h16)p1}; pf[kt][s2][jj] = pk[0]; pf[kt][s2][jj + 1] = pk[1];
                            psum = __builtin_amdgcn_fdot2(pk, (f16x2){(h16)1.0f, (h16)1.0f}, psum, false); }
                lrun[qt] = lrun[qt] * alpha + psum;
                if (__builtin_amdgcn_ballot_w64(alpha != 1.0f) != 0ull) {
#pragma unroll
                for (int dt = 0; dt < 2; ++dt)
#pragma unroll
                    for (int i = 0; i < 16; ++i) oacc[dt][qt][i] *= alpha; }
#pragma unroll
                for (int kt = 0; kt < 2; ++kt)
#pragma unroll
                    for (int s2 = 0; s2 < 2; ++s2)
#pragma unroll
                        for (int dt = 0; dt < 2; ++dt) { const LAS h16* vr = Vs + (32 * dt + r32) * AT_VP + 32 * kt + 16 * s2 + 4 * hh;
                            const f16x4 v0 = *(const LAS f16x4*)vr, v1 = *(const LAS f16x4*)(vr + 8);
                            const f16x8 vf = (f16x8){v0[0], v0[1], v0[2], v0[3], v1[0], v1[1], v1[2], v1[3]};
                            oacc[dt][qt] = __builtin_amdgcn_mfma_f32_32x32x16_f16(vf, pf[kt][s2], oacc[dt][qt], 0, 0, 0); }
            }
        }
#pragma unroll
        for (int qt = 0; qt < 2; ++qt) {
            const float ltot = lrun[qt] + shx(lrun[qt], 32); const float inv = 1.0f / ltot;
            h16* op = ob + (size_t)(qrow0 + 32 * qt + r32) * D + head * 64 + 4 * hh;
#pragma unroll
            for (int dt = 0; dt < 2; ++dt)
#pragma unroll
                for (int q4 = 0; q4 < 4; ++q4) { f16x4 w;
#pragma unroll
                    for (int i = 0; i < 4; ++i) w[i] = (h16)(oacc[dt][qt][4 * q4 + i] * inv);
                    *(f16x4*)(op + 32 * dt + 8 * q4) = w; }
        }
    }
}
#undef AT_TILE
#undef AT_LOAD

constexpr int NPHASE = 35;
#ifndef MK_MULTI
#define MK_MULTI 0
#endif

template <int KIND>
__attribute__((target("no-packed-fp32-ops"))) __global__ void __launch_bounds__(512, 2) hy_fwd(Params p_) {
    extern __shared__ __attribute__((aligned(16))) unsigned char shm[];
    LAS unsigned char* lds = (LAS unsigned char*)shm;
    constexpr bool ALL = KIND < 0;
    const int ph0 = p_.ph0;
    if (threadIdx.x == 0) { *(LAS u32x4*)(lds + LDS_XB) = (u32x4){0u, 0u, 0u, 0u}; }
    __syncthreads();
    XcdBarrier bar;
    if constexpr (ALL) bar = xcd_barrier_post((unsigned*)(p_.ws + WS_CTL), (volatile LAS unsigned*)(lds + LDS_XB));
#ifndef PROBE_SITE
#define PROBE_SITE -1
#endif
#define SITE(k) if constexpr (ALL || KIND == (k)) for (int rep_ = 0; rep_ < ((k) == PROBE_SITE ? 2 : 1); ++rep_) if (const Params& p = *params_fresh(); true)
#ifndef PROBE_XBAR
#define PROBE_XBAR 1
#endif
#define SEAM() do { if constexpr (ALL) { xcd_barrier(bar); if (PROBE_XBAR > 1) xcd_barrier(bar); if (PROBE_XBAR > 2) xcd_barrier(bar); } } while (0)
    const int G = gridDim.x, bid = blockIdx.x;
    SITE(0) {
        for (int u = bid; u < 4993; u += G) {
            if (u < 384) modp_unit(p, u, (LAS float*)lds);
            else if (u == 384) tables_unit(p);
            else if (u < 1473) h2_task(p, (u - 385) * 8 + (tid_fresh() >> 6));
            else if (u < 1537) w3p_unit(p, u - 1473);
            else if (u < 1793) rtab_unit(p, u - 1537);
            else cvt_dense_unit(p, u - 1793, (LAS float*)lds);
        }
        SEAM();
    }
    SITE(1) {
        for (int u = bid; u < 216; u += G) modr_unit(p, u);
        SchedFilt S{p.ws + WS_W3P, p.ws + WS_H2P}; EpiTaps E{(float*)(p.ws + WS_TAPS), (float*)(p.ws + WS_TAPSC)};
        pg8::gemm_phase<EpiTaps, SchedFilt, 0>(lds, 256, S, E);
        SEAM();
    }
#define TAIL_IDLE(nunits) (((nunits) % G) ? G - ((nunits) % G) : 0)
#define CVT_PER_GEMM 20
#pragma unroll 1
    for (int layer = ALL ? 0 : ph0; layer < (ALL ? NLAYER : ph0 + 1); ++layer) {
        const bool hyena = (layer & 1) == 0; const int jl = layer >> 1;
        const int nu1 = hyena ? 24 * 136 : 136 * 10, nu4 = (layer == NLAYER - 1 ? 128 : 136) * 8;
        const int idle1 = TAIL_IDLE(nu1), idle4 = TAIL_IDLE(nu4);
        int cv4 = idle4 * CVT_PER_GEMM, cv1 = idle1 * CVT_PER_GEMM; if (cv4 > CVT_MOE_UNITS / 2) cv4 = CVT_MOE_UNITS / 2; if (cv1 > CVT_MOE_UNITS / 2 - 1) cv1 = CVT_MOE_UNITS / 2 - 1;
        const int cvN0 = CVT_MOE_UNITS - cv1 - cv4, cvN1 = cvN0 + cv1;
        SITE(2) {
            n1_phase(p, layer, (h16*)(p.ws + ((!ALL && p.ph1) ? WS_UT : WS_XRES)));
            for (int rep2_ = 0; rep2_ < ((PROBE_SITE == 20 && layer > 0) ? 2 : 1); ++rep2_) {
            if (layer == 0) filt_fft_phase(p, lds);
            else { (void)0; } }
            SEAM();
        }
        SITE(3) {
#ifdef PROBE_CLK
            unsigned long long pc0_ = __builtin_readcyclecounter(), pr0_ = wall_clock64();
#endif
            if (hyena) { SchedPlain S{24, 136, D, p.ws + WS_WIN + (size_t)jl * D3 * D * 2, p.ws + WS_HBUF}; EpiH16 E{(h16*)(p.ws + WS_UT), TT, nullptr, 0};
                pg8::gemm_phase<EpiH16, SchedPlain, 0>(lds, D, S, E); }
            else { SchedQkv S{p.ws + WS_HBUF, p.ws + WS_WQKV + (size_t)jl * DQKV * D * 2}; EpiH16 E{(h16*)(p.ws + WS_QK), DQK, (h16*)(p.ws + WS_VT), TT};
                pg8::gemm_phase<EpiH16, SchedQkv, 0>(lds, D, S, E); }
#ifdef PROBE_CLK
            if (bid == 0 && threadIdx.x == 0) { const unsigned long long dc = __builtin_readcyclecounter() - pc0_, dr = wall_clock64() - pr0_; const unsigned long long spin = dc * 2500ull / (dr ? dr : 1ull);
                const unsigned long long t0 = wall_clock64(); while (wall_clock64() - t0 < spin) __builtin_amdgcn_s_sleep(8); }
#endif
            if (idle1 > 0 && bid >= G - idle1) { cvt_moe_share(p, layer, cvN0 + (bid - (G - idle1)), cvN1, idle1, (LAS float*)lds); }
            SEAM();
        }
        SITE(4) {
#ifdef PROBE_PAR
            for (int rep3_ = 0; rep3_ < (((layer & 1) == PROBE_PAR) ? 2 : 1); ++rep3_)
#endif
            { if (hyena) conv_phase(p, jl, lds, ALL ? 0 : p.ph1, layer, cvN0);
            else attn_phase(p, jl, layer != NLAYER - 1, lds, layer, cvN0); }
            SEAM();
        }
        SITE(5) {
            (void)0;
        }
        SITE(6) {
            EpiResid E{(h16*)(p.ws + WS_XRES), (const float*)(p.ws + WS_MODS), layer, (float*)(p.ws + WS_SSQ), (!ALL && p.ph1) ? (h16*)(p.ws + WS_YC) : (h16*)(p.ws + WS_XRES)};
            if (hyena) {
                SchedPlainAT S{layer == NLAYER - 1 ? 128 : 136, 8, D, p.ws + WS_ZT, p.ws + WS_WOUT + (size_t)jl * D * D * 2};
                pg8::gemm_phase<EpiResid, SchedPlainAT, 2>(lds, D, S, E, TT);
            } else {
                SchedPlain S{layer == NLAYER - 1 ? 128 : 136, 8, D, p.ws + WS_HBUF, p.ws + WS_WO + (size_t)jl * D * D * 2};
                pg8::gemm_phase<EpiResid, SchedPlain, 0>(lds, D, S, E);
            }
            if (idle4 > 0 && bid >= G - idle4) { cvt_moe_share(p, layer, cvN1 + (bid - (G - idle4)), CVT_MOE_UNITS, idle4, (LAS float*)lds); }
            SEAM();
        }
        SITE(7) { n2_phase(p, layer, lds, ALL ? 0 : p.ph1); SEAM(); }
        LAS int* tstart = (LAS int*)(lds + LDS_MISC); LAS int* texp = tstart + 80; LAS int* tcnt = texp + 352;
        SITE(8) {
            moe_table(tstart, texp, tcnt, (const int*)(p.ws + WS_CTL) + CTL_CNT + layer * NE);
            SchedMoe1 S{{tstart, texp, tcnt}, p.ws + WS_HBUF, p.ws + WS_W13, (const int*)(p.ws + WS_LIST)}; EpiMoe1 E{(h16*)(p.ws + WS_H1)};
            pg8::gemm_phase<EpiMoe1, SchedMoe1, 1>(lds, D, S, E);
            SEAM();
        }
        SITE(9) {
            moe_table(tstart, texp, tcnt, (const int*)(p.ws + WS_CTL) + CTL_CNT + layer * NE);
            SchedMoe2 S{{tstart, texp, tcnt}, p.ws + WS_H1, p.ws + WS_W2, (const int*)(p.ws + WS_LIST)}; EpiMoe2 E{(h16*)(p.ws + WS_YC), (const float*)(p.ws + WS_GATE), (const int*)(p.ws + WS_LIST)};
            pg8::gemm_phase<EpiMoe2, SchedMoe2, 0>(lds, DE, S, E);
            SEAM();
        }
    }
    SITE(10) final_phase(p);
#undef SITE
#undef SEAM
}

template <int KIND> static void launch_kind(const Params& p, int grid, hipStream_t stream) {
    static bool attr = false;
    if (!attr) { attr = true; if (hipFuncSetAttribute((const void*)hy_fwd<KIND>, hipFuncAttributeMaxDynamicSharedMemorySize, LDS_BYTES) != hipSuccess) fprintf(stderr, "kernel_launch: hipFuncSetAttribute failed (kind %d)\n", KIND); }
    hipLaunchKernelGGL(hy_fwd<KIND>, dim3(grid), dim3(512), LDS_BYTES, stream, p);
}

extern "C" void kernel_launch(void* const* d_in, const int* in_sizes, int n_in, void* d_out, int out_size, void* d_ws, size_t ws_size, hipStream_t stream) {
    static int grid = 0;
    if (!grid) {
        if (n_in != 29 || out_size != TL * D || ws_size < WS_END) { fprintf(stderr, "kernel_launch: unexpected problem (n_in %d, out %d, ws %zu < %zu)\n", n_in, out_size, ws_size, (size_t)WS_END); grid = -1; return; }
        int dev = 0, cus = 0;
        if (hipGetDevice(&dev) != hipSuccess || hipDeviceGetAttribute(&cus, hipDeviceAttributeMultiprocessorCount, dev) != hipSuccess) { grid = -1; return; }
        grid = cus;
    }
    if (grid <= 0) return;
    (void)hipMemsetAsync((char*)d_ws + WS_CTL, 0, CTL_BYTES, stream);
    Params p{};
    const float** pp = (const float**)&p;
    for (int i = 0; i < 29; ++i) pp[i] = (const float*)d_in[i];
    p.out = (float*)d_out; p.ws = (char*)d_ws;
#if MK_MULTI
    p.ph0 = 0; p.ph1 = 0;
    launch_kind<0>(p, grid, stream); launch_kind<1>(p, grid, stream);
#ifndef PROBE_KINDS
#define PROBE_KINDS 0
#endif
#ifndef PROBE_VAR
#define PROBE_VAR 0
#endif
#ifndef PROBE_LAYERS
#define PROBE_LAYERS 15
#endif
#define PKIND(k) ((PROBE_KINDS >> (k)) & 1)
#define PREP(k) ((PKIND(k) && ((PROBE_LAYERS >> layer) & 1)) ? 2 : 1)
    if (PKIND(0)) launch_kind<0>(p, grid, stream);
    if (PKIND(1)) launch_kind<1>(p, grid, stream);
    for (int layer = 0; layer < NLAYER; ++layer) { p.ph0 = layer;
        for (int r = 0; r < PREP(2); ++r) { p.ph1 = (PREP(2) == 2 && r == 0) ? 1 : 0; launch_kind<2>(p, grid, stream); p.ph1 = 0; }
        for (int r = 0; r < PREP(3); ++r) { p.ph1 = (PREP(3) == 2 && r == 0) ? PROBE_VAR : 0; launch_kind<3>(p, grid, stream); p.ph1 = 0; }
        for (int r = 0; r < PREP(4); ++r) { p.ph1 = (PREP(4) == 2 && r == 0) ? 1 : 0; launch_kind<4>(p, grid, stream); p.ph1 = 0; }
        if (PREP(6) == 2) { p.ph1 = 1; launch_kind<6>(p, grid, stream); p.ph1 = 0; }
        launch_kind<6>(p, grid, stream); launch_kind<7>(p, grid, stream);
        if (PREP(7) == 2) { p.ph1 = 1; launch_kind<7>(p, grid, stream); p.ph1 = 0; }
        for (int r = 0; r < PREP(8); ++r) launch_kind<8>(p, grid, stream);
        for (int r = 0; r < PREP(9); ++r) launch_kind<9>(p, grid, stream); }
    p.ph0 = 0; launch_kind<10>(p, grid, stream);
    if (PKIND(10)) launch_kind<10>(p, grid, stream);
#else
    p.ph0 = 0; p.ph1 = NPHASE;
    launch_kind<-1>(p, grid, stream);
#endif
}
```

```cpp
#include <hip/hip_runtime.h>
#include <cstdio>
#include <cstdint>

#define LAS __attribute__((address_space(3)))
typedef _Float16 h16;
typedef _Float16 f16x8 __attribute__((ext_vector_type(8)));
typedef _Float16 f16x4 __attribute__((ext_vector_type(4)));
typedef _Float16 f16x2 __attribute__((ext_vector_type(2)));
typedef float f32x2 __attribute__((ext_vector_type(2)));
typedef float f32x4 __attribute__((ext_vector_type(4)));
typedef float f32x16 __attribute__((ext_vector_type(16)));
typedef unsigned u32x2 __attribute__((ext_vector_type(2)));
typedef unsigned u32x4 __attribute__((ext_vector_type(4)));

constexpr int D = 2048, NB = 8, SEQ = 4096, CTXL = 256, TL = NB * SEQ, TC = NB * CTXL, TT = TL + TC;
constexpr int D3 = 3 * D, D6 = 6 * D, DQK = 2304, DQKV = 2560, NE = 64, DE = 384, DE2 = 768, NLAYER = 4;
constexpr int LCAP = TT;
constexpr int MOE_ROWS = 86016;
constexpr float EPS = 1e-6f;

constexpr size_t WS_CTL = 0;
constexpr size_t CTL_BYTES = 65536;
constexpr size_t WS_TW = WS_CTL + CTL_BYTES;
constexpr size_t WS_ROPE = WS_TW + 65536;
constexpr size_t WS_MODP = WS_ROPE + 8192;
constexpr size_t WS_MODS = WS_MODP + 16ull * 4 * 9 * 12288 * 4;
constexpr size_t WS_RTAB = WS_MODS + 4ull * 9 * 12288 * 4;
constexpr size_t RTAB_L = 64ull * 5 * 2 * 64 * 8 * 2;
constexpr size_t WS_RCST = WS_RTAB + 4 * RTAB_L;
constexpr size_t WS_H2P = WS_RCST + 16384;
constexpr size_t WS_W3P = WS_H2P + 2ull * 4352 * 256 * 2;
constexpr size_t WS_XRES = WS_W3P + 2ull * 8192 * 256 * 2;
constexpr size_t WS_HBUF = WS_XRES + (size_t)TT * D * 4;
constexpr size_t WS_UT = WS_HBUF + (size_t)TT * D * 2;
constexpr size_t UT_BYTES = (size_t)D3 * TT * 2;
constexpr size_t WS_TAPS = WS_UT;
constexpr size_t WS_TAPSC = WS_TAPS + 2ull * 8192 * 4096 * 4;
constexpr size_t WS_QK = WS_UT;
constexpr size_t WS_VT = WS_QK + (size_t)TT * DQK * 2;
constexpr size_t WS_ZT = WS_UT + UT_BYTES;
constexpr size_t WS_H1 = WS_ZT + (size_t)D * TT * 2;
constexpr size_t WS_YC = WS_H1 + (size_t)MOE_ROWS * DE * 2;
constexpr size_t WS_WIN = WS_YC + 2ull * TT * D * 2;
constexpr size_t WS_WOUT = WS_WIN + 2ull * D3 * D * 2;
constexpr size_t WS_WQKV = WS_WOUT + 2ull * D * D * 2;
constexpr size_t WS_WO = WS_WQKV + 2ull * DQKV * D * 2;
constexpr size_t WS_W13 = WS_WO + 2ull * D * D * 2;
constexpr size_t WS_W2 = WS_W13 + (size_t)NE * DE2 * D * 2;
constexpr size_t WS_KF = WS_W2 + (size_t)NE * D * DE * 2;
constexpr size_t WS_KFC = WS_KF + 2ull * 2 * 2048 * 65536;
constexpr size_t WS_LIST = WS_KFC + 2ull * 2 * 2048 * 4096;
constexpr size_t WS_GATE = WS_LIST + (size_t)NE * LCAP * 4;
constexpr size_t WS_SSQ = WS_GATE + (size_t)NE * LCAP * 4;
constexpr size_t WS_END = WS_SSQ + (size_t)TT * 32 * 4;
static_assert(WS_TAPSC + 2ull * 8192 * 256 * 4 <= WS_UT + UT_BYTES, "taps alias");
static_assert(WS_VT + 256ull * TT * 2 <= WS_UT + UT_BYTES, "qkv alias");

constexpr int CTL_CNT = 4096;

constexpr int LDS_BYTES = 147456;
constexpr int LDS_MISC = 139264;
constexpr int LDS_XB = LDS_BYTES - 16;

struct Params {
    const float *x, *c, *ctx, *c_ctx, *mod_w, *mod_b, *hy_w_in, *hy_conv_w, *hy_conv_b, *hy_f_w1, *hy_f_b1, *hy_f_freq1, *hy_f_w2, *hy_f_b2, *hy_f_freq2, *hy_f_w3,
        *hy_bias, *hy_w_out, *at_w_qkv, *at_sink, *at_w_o, *moe_wg, *moe_bg, *moe_we, *moe_be, *moe_w1, *moe_w3, *moe_w2, *final_gain;
    float* out; char* ws; int ph0, ph1;
};

__device__ __forceinline__ int tid_fresh() { int t = threadIdx.x; asm volatile("" : "+v"(t)); return t; }
__device__ __forceinline__ float bperm_f(float v, int srclane) { return __int_as_float(__builtin_amdgcn_ds_bpermute(srclane << 2, __float_as_int(v))); }
__device__ __forceinline__ float shx(float v, int mask) { return bperm_f(v, (tid_fresh() & 63) ^ mask); }
__device__ __forceinline__ const Params* params_fresh() { auto q = __builtin_amdgcn_kernarg_segment_ptr(); asm volatile("" : "+s"(q)); return (const Params*)q; }

#define XB_TMO      128
#define XB_XCNT(j)  (256  + 64 * (j))
#define XB_XSUB(j)  (1280 + 64 * (j))
#define XB_XGEN(j)  (2304 + 64 * (j))
#define XB_TOP      3328
#define XB_TOPGEN   3392
#define XCD_BAR_WORDS 3456
#define XB_SPIN_CAP (1u << 18)

__device__ __forceinline__ unsigned xb_ld(unsigned* p)              { return __hip_atomic_load(p, __ATOMIC_RELAXED, __HIP_MEMORY_SCOPE_AGENT); }
__device__ __forceinline__ unsigned xb_add(unsigned* p, unsigned v) { return __hip_atomic_fetch_add(p, v, __ATOMIC_RELAXED, __HIP_MEMORY_SCOPE_AGENT); }
__device__ __forceinline__ unsigned xb_xcc_id() { return (unsigned)__builtin_amdgcn_s_getreg((3 << 11) | 20) & 0xFu; }
#define XB_SPIN(cond, bar) do { unsigned _sp = 0; while (cond) { __builtin_amdgcn_s_sleep(1); \
    if ((++_sp & 255u) == 0u) { if (xb_ld(&(bar)[XB_TMO])) break; if (_sp > XB_SPIN_CAP) { atomicAdd(&(bar)[XB_TMO], 1u); break; } } } } while (0)

struct XcdBarrier { unsigned* bar; volatile LAS unsigned* st; };

__device__ __forceinline__ XcdBarrier xcd_barrier_post(unsigned* bar, volatile LAS unsigned* st) {
    XcdBarrier b; b.bar = bar; b.st = st;
    if (threadIdx.x == 0) (void)xb_add(&bar[XB_XCNT(xb_xcc_id())], 1u);
    return b;
}
__device__ __forceinline__ void xcd_barrier_complete(unsigned* bar, unsigned x, unsigned& nloc, unsigned& nx) {
    const unsigned G = gridDim.x * gridDim.y * gridDim.z;
    unsigned sum, cnt, mine, sp = 0u;
    for (;;) {
        sum = 0u; cnt = 0u; mine = 0u;
#pragma unroll
        for (unsigned j = 0; j < 16; ++j) { const unsigned c = xb_ld(&bar[XB_XCNT(j)]); sum += c; cnt += (c > 0u) ? 1u : 0u; mine = (j == x) ? c : mine; }
        if (sum == G) break;
        __builtin_amdgcn_s_sleep(1);
        if ((++sp & 255u) == 0u) { if (xb_ld(&bar[XB_TMO])) break; if (sp > XB_SPIN_CAP) { atomicAdd(&bar[XB_TMO], 1u); break; } }
    }
    nloc = mine > 0u ? mine : 1u; nx = cnt > 0u ? cnt : 1u;
}
__device__ __forceinline__ void xcd_barrier(const XcdBarrier& b) {
    asm volatile("s_waitcnt vmcnt(0)" ::: "memory");
    __syncthreads();
    if (threadIdx.x == 0) {
        unsigned* bar = b.bar; const unsigned bx = xb_xcc_id();
        __builtin_amdgcn_s_waitcnt(0);
        unsigned nloc = b.st[0], nx = b.st[1];
        if (nloc == 0u) { xcd_barrier_complete(bar, bx, nloc, nx); b.st[0] = nloc; b.st[1] = nx; }
        const unsigned old = xb_add(&bar[XB_XSUB(bx)], 1u);
        const unsigned gen = old / nloc;
        if (old + 1u == (gen + 1u) * nloc) {
            __builtin_amdgcn_fence(__ATOMIC_RELEASE, "agent");
            asm volatile("s_waitcnt vmcnt(0)" ::: "memory");
            const unsigned og = xb_add(&bar[XB_TOP], 1u);
            const unsigned tg = og / nx;
            if (og + 1u == (tg + 1u) * nx) xb_add(&bar[XB_TOPGEN], 1u);
            else XB_SPIN(xb_ld(&bar[XB_TOPGEN]) == tg, bar);
            __builtin_amdgcn_fence(__ATOMIC_ACQUIRE, "agent");
            xb_add(&bar[XB_XGEN(bx)], 1u);
            asm volatile("s_waitcnt vmcnt(0)" ::: "memory");
        } else {
            XB_SPIN(xb_ld(&bar[XB_XGEN(bx)]) == gen, bar);
            __builtin_amdgcn_fence(__ATOMIC_ACQUIRE, "agent");
            asm volatile("s_waitcnt vmcnt(0)" ::: "memory");
        }
    }
    __syncthreads();
}

namespace pg8 {
constexpr int BM = 256, BK = 64, HALF = 128, HTB = HALF * BK * 2, STAGE_BYTES = 8 * HTB;
__device__ __forceinline__ int lds_byte(int r, int c) { const int st = (r >> 4) * 2 + (c >> 5), rr = r & 15, cc = c & 31, ob = rr * 64 + cc * 2; return st * 1024 + (ob ^ (((ob >> 9) & 1) << 5)); }
__device__ __forceinline__ void stage_rc(int b, int& R, int& C) { const int st = b / 1024, sb = b % 1024, swz = sb ^ (((sb >> 9) & 1) << 5); R = (st >> 1) * 16 + swz / 64; C = (st & 1) * 32 + (swz % 64) / 2; }
__device__ __forceinline__ int perm32(int rho) { const int n = rho >> 4, i = rho & 15; return 8 * (i >> 2) + 4 * n + (i & 3); }

struct Unit {
    int pm, pn;
    int e, pos0, cnt;
    int kind;
    int half;
    const char* A; const char* B;
    const int* rows;
};

typedef short s16x4 __attribute__((ext_vector_type(4)));
template <class Epi, class Sched, int AMODE>
__device__ __forceinline__ void gemm_phase(LAS unsigned char* lds, const int K, const Sched& S, const Epi& E, const int ldat = 0) {
    constexpr bool GATHER = AMODE == 1, ATR = AMODE == 2;
    const int tid = tid_fresh(), wid = __builtin_amdgcn_readfirstlane(tid >> 6), lane = tid & 63, wr = wid >> 2, wc = wid & 3, fr = lane & 15, fq = lane >> 4;
    const int nt = K / BK;
    unsigned voffA[2], voffB[2]; int RA[2], CA[2];
#pragma unroll
    for (int i = 0; i < 2; ++i) { int R, C; stage_rc(tid * 16 + i * 8192, R, C); const int Rb = Epi::PERM ? ((R & ~31) + perm32(R & 31)) : R;
        voffA[i] = (unsigned)(R * K + C) * 2u; voffB[i] = (unsigned)(Rb * K + C) * 2u; RA[i] = R; CA[i] = C;
        if constexpr (ATR) { const int bb = tid * 16 + i * 8192, row = bb >> 8, pc = (bb >> 4) & 15, ch = pc ^ (((row & 3) << 2) | ((row >> 2) & 3)); voffA[i] = (unsigned)(row * ldat + 8 * ch) * 2u; } }
    const size_t kstep = (size_t)(BK * 2);
    const size_t hstep = (size_t)HALF * K * 2;
    const size_t kstepA = ATR ? (size_t)BK * ldat * 2 : kstep, hstepA = ATR ? (size_t)HALF * 2 : hstep;
    const unsigned ldsw = (unsigned)wid * 1024u;
    const int aoff = lds_byte(wr * 64 + fr, fq * 8), boff = lds_byte(wc * 32 + fr, fq * 8);
    int atr[4][2];
#pragma unroll
    for (int m = 0; m < 4; ++m)
#pragma unroll
        for (int bl = 0; bl < 2; ++bl) { const int xr = ((fr >> 2) << 2) | ((2 * fq + bl) & 3); atr[m][bl] = (int)(unsigned)(uintptr_t)lds + 256 * (8 * fq + (fr >> 2) + 4 * bl) + 16 * ((wr * 8 + 2 * m + ((fr & 3) >> 1)) ^ xr) + 8 * (fr & 1); }
    unsigned vgC[2][2], vgN[2][2];
#define PG8_ROWS(u, vg) do { if constexpr (GATHER) { _Pragma("unroll") for (int _h = 0; _h < 2; ++_h) _Pragma("unroll") for (int _i = 0; _i < 2; ++_i) { \
        const int _p = (u).pos0 + _h * HALF + RA[_i]; const int _tok = (_p < (u).cnt) ? ((u).rows[_h * HALF + RA[_i]] >> 1) : 0; \
        vg[_h][_i] = ((unsigned)_tok * (unsigned)K + (unsigned)CA[_i]) * 2u; } } } while (0)
#define PG8_SA(b, h) (((b) * 2 + (h)) * HTB)
#define PG8_SB(b, h) ((4 + (b) * 2 + (h)) * HTB)
#define PG8_STAGE_B(bufoff, gbase) do { _Pragma("unroll") for (int _i = 0; _i < 2; ++_i) \
        __builtin_amdgcn_global_load_lds((const unsigned*)((const char*)(gbase) + voffB[_i]), (LAS unsigned*)(lds + (bufoff) + ldsw + _i * 8192), 16, 0, 0); } while (0)
#define PG8_STAGE_A(bufoff, gbase, h, NEXT) do { _Pragma("unroll") for (int _i = 0; _i < 2; ++_i) { \
        const unsigned _vo = GATHER ? ((NEXT) ? vgN[h][_i] : vgC[h][_i]) : voffA[_i]; \
        __builtin_amdgcn_global_load_lds((const unsigned*)((const char*)(gbase) + (GATHER ? (size_t)0 : (size_t)(h) * hstepA) + _vo), (LAS unsigned*)(lds + (bufoff) + ldsw + _i * 8192), 16, 0, 0); } } while (0)
#define PG8_LDA(dst, b, h) do { if constexpr (!ATR) { _Pragma("unroll") for (int m = 0; m < 4; ++m) _Pragma("unroll") for (int k = 0; k < 2; ++k) dst[m][k] = *(const LAS f16x8*)(lds + PG8_SA(b, h) + aoff + m * 2048 + k * 1024); } \
        else { _Pragma("unroll") for (int m = 0; m < 4; ++m) _Pragma("unroll") for (int k = 0; k < 2; ++k) { s16x4 _lo, _hi; \
            asm volatile("ds_read_b64_tr_b16 %0, %1 offset:%2" : "=v"(_lo) : "v"(atr[m][0]), "i"(PG8_SA(b, h) + k * 8192) : "memory"); \
            asm volatile("ds_read_b64_tr_b16 %0, %1 offset:%2" : "=v"(_hi) : "v"(atr[m][1]), "i"(PG8_SA(b, h) + k * 8192) : "memory"); \
            const short __attribute__((ext_vector_type(8))) _v = {_lo[0], _lo[1], _lo[2], _lo[3], _hi[0], _hi[1], _hi[2], _hi[3]}; dst[m][k] = __builtin_bit_cast(f16x8, _v); } } } while (0)
#define PG8_PIN(At) do { if constexpr (ATR) asm volatile("" : "+v"(At[0][0]), "+v"(At[0][1]), "+v"(At[1][0]), "+v"(At[1][1]), "+v"(At[2][0]), "+v"(At[2][1]), "+v"(At[3][0]), "+v"(At[3][1])); } while (0)
#define PG8_LDB(dst, b, h) do { _Pragma("unroll") for (int n = 0; n < 2; ++n) _Pragma("unroll") for (int k = 0; k < 2; ++k) dst[n][k] = *(const LAS f16x8*)(lds + PG8_SB(b, h) + boff + n * 2048 + k * 1024); } while (0)
#define PG8_MMA(ai, bj, At, Bt) do { __builtin_amdgcn_s_setprio(1); _Pragma("unroll") for (int m = 0; m < 4; ++m) _Pragma("unroll") for (int n = 0; n < 2; ++n) _Pragma("unroll") for (int k = 0; k < 2; ++k) \
        acc[ai][bj][m][n] = __builtin_amdgcn_mfma_f32_16x16x32_f16(Bt[n][k], At[m][k], acc[ai][bj][m][n], 0, 0, 0); __builtin_amdgcn_s_setprio(0); } while (0)
#define PG8_WAIT_V(n) asm volatile("s_waitcnt vmcnt(" #n ")" ::: "memory")
#define PG8_WAIT_L(n) asm volatile("s_waitcnt lgkmcnt(" #n ")" ::: "memory")
#define PG8_BAR __builtin_amdgcn_s_barrier()
#define PG8_SCHED __builtin_amdgcn_sched_barrier(0)
    Unit cur, nxt; int ui = 0;
    if (!S.next(0, cur)) return;
    f32x4 acc[2][2][4][2];
#pragma unroll
    for (int a = 0; a < 2; ++a)
#pragma unroll
        for (int b = 0; b < 2; ++b)
#pragma unroll
            for (int m = 0; m < 4; ++m)
#pragma unroll
                for (int n = 0; n < 2; ++n) acc[a][b][m][n] = (f32x4){0.f, 0.f, 0.f, 0.f};
    f16x8 At[4][2], B0[2][2], B1[2][2];
    const char* cA = cur.A; const char* cB = cur.B;
    PG8_ROWS(cur, vgC);
#pragma unroll
    for (int _h = 0; _h < 2; ++_h)
#pragma unroll
        for (int _i = 0; _i < 2; ++_i) vgN[_h][_i] = GATHER ? vgC[_h][_i] : 0u;
    PG8_STAGE_B(PG8_SB(0, 0), cB); PG8_STAGE_B(PG8_SB(0, 1), cB + hstep); PG8_STAGE_A(PG8_SA(0, 0), cA, 0, false); PG8_STAGE_A(PG8_SA(0, 1), cA, 1, false);
    if (wr == 1) PG8_BAR;
    PG8_WAIT_V(2); PG8_BAR;
    PG8_STAGE_B(PG8_SB(1, 0), cB + kstep); PG8_STAGE_A(PG8_SA(1, 0), cA + kstepA, 0, false); PG8_STAGE_B(PG8_SB(1, 1), cB + hstep + kstep);
    PG8_WAIT_V(6); PG8_BAR;
    for (;;) {
        const bool has_next = S.next(ui + 1, nxt);
        const bool full = cur.half == 0;
        const char* nA = has_next ? nxt.A : cA; const char* nB = has_next ? nxt.B : cB;
        if (has_next) { PG8_ROWS(nxt, vgN); }
#pragma unroll 1
        for (int t = 0; t < nt; t += 2) {
            const bool last = (t == nt - 2);
            const char* a1 = cA + (size_t)(t + 1) * kstepA;
            const char* a2 = last ? nA : cA + (size_t)(t + 2) * kstepA; const char* b2 = last ? nB : cB + (size_t)(t + 2) * kstep;
            const char* a3 = a2 + kstepA; const char* b3 = b2 + kstep;
            PG8_LDB(B0, 0, 0); PG8_LDB(B1, 0, 1); PG8_SCHED; PG8_LDA(At, 0, 0); PG8_STAGE_A(PG8_SA(1, 1), a1, 1, false);
            PG8_WAIT_V(8); PG8_WAIT_L(0); PG8_PIN(At); PG8_BAR; PG8_MMA(0, 0, At, B0); PG8_MMA(0, 1, At, B1); PG8_BAR; PG8_SCHED;
            PG8_LDA(At, 0, 1); PG8_STAGE_B(PG8_SB(0, 0), b2); PG8_STAGE_B(PG8_SB(0, 1), b2 + hstep); PG8_STAGE_A(PG8_SA(0, 0), a2, 0, last);
            PG8_WAIT_V(8); PG8_WAIT_L(0); PG8_PIN(At); PG8_BAR; if (full) { PG8_MMA(1, 0, At, B0); PG8_MMA(1, 1, At, B1); } PG8_BAR; PG8_SCHED;
            PG8_LDB(B0, 1, 0); PG8_LDB(B1, 1, 1); PG8_SCHED; PG8_LDA(At, 1, 0); PG8_STAGE_A(PG8_SA(0, 1), a2, 1, last);
            PG8_WAIT_V(8); PG8_WAIT_L(0); PG8_PIN(At); PG8_BAR; PG8_MMA(0, 0, At, B0); PG8_MMA(0, 1, At, B1); PG8_BAR; PG8_SCHED;
            PG8_LDA(At, 1, 1); PG8_STAGE_B(PG8_SB(1, 0), b3); PG8_STAGE_B(PG8_SB(1, 1), b3 + hstep); PG8_STAGE_A(PG8_SA(1, 0), a3, 0, last);
            PG8_WAIT_V(8); PG8_WAIT_L(0); PG8_PIN(At); PG8_BAR; if (full) { PG8_MMA(1, 0, At, B0); PG8_MMA(1, 1, At, B1); } PG8_BAR; PG8_SCHED;
        }
        if (wr == 0) PG8_BAR;
        E(acc, cur, wr, wc, fr, fq);
        if (!has_next) break;
#pragma unroll
        for (int a = 0; a < 2; ++a)
#pragma unroll
            for (int b = 0; b < 2; ++b)
#pragma unroll
                for (int m = 0; m < 4; ++m)
#pragma unroll
                    for (int n = 0; n < 2; ++n) acc[a][b][m][n] = (f32x4){0.f, 0.f, 0.f, 0.f};
        cur = nxt; cA = nA; cB = nB; ++ui;
#pragma unroll
        for (int _h = 0; _h < 2; ++_h)
#pragma unroll
            for (int _i = 0; _i < 2; ++_i) vgC[_h][_i] = vgN[_h][_i];
        if (wr == 1) PG8_BAR;
    }
    PG8_WAIT_V(0);
    PG8_BAR;
#undef PG8_ROWS
#undef PG8_SA
#undef PG8_SB
#undef PG8_STAGE_A
#undef PG8_STAGE_B
#undef PG8_LDA
#undef PG8_LDB
#undef PG8_PIN
#undef PG8_MMA
#undef PG8_WAIT_V
#undef PG8_WAIT_L
#undef PG8_BAR
#undef PG8_SCHED
}
}

using pg8::Unit;
__device__ __forceinline__ f16x8 pack8(const f32x4 a, const f32x4 b) {
    f16x8 w; w[0] = (h16)a[0]; w[1] = (h16)a[1]; w[2] = (h16)a[2]; w[3] = (h16)a[3]; w[4] = (h16)b[0]; w[5] = (h16)b[1]; w[6] = (h16)b[2]; w[7] = (h16)b[3]; return w;
}
struct EpiH16 {
    static constexpr bool PERM = true;
    h16* O0; int ld0; h16* O1; int ld1;
    __device__ __forceinline__ void operator()(const f32x4 (&acc)[2][2][4][2], const Unit& u, int wr, int wc, int fr, int fq) const {
        h16* base = u.kind ? O1 : O0; const int ld = u.kind ? ld1 : ld0;
        const int row0 = u.pm * 256 + wr * 64 + fr, col0 = u.pn * 256 + wc * 32 + 8 * fq;
#pragma unroll
        for (int ai = 0; ai < 2; ++ai)
#pragma unroll
            for (int m = 0; m < 4; ++m) { h16* rowp = base + (size_t)(row0 + ai * 128 + m * 16) * ld + col0;
#pragma unroll
                for (int bj = 0; bj < 2; ++bj) __builtin_nontemporal_store(pack8(acc[ai][bj][m][0], acc[ai][bj][m][1]), (f16x8*)(rowp + bj * 128)); }
    }
};
struct EpiTaps {
    static constexpr bool PERM = false;
    float* T0; float* T1;
    __device__ __forceinline__ void operator()(const f32x4 (&acc)[2][2][4][2], const Unit& u, int wr, int wc, int fr, int fq) const {
        const int j = u.kind >> 1, v = u.kind & 1; const int ld = v ? 256 : 4096;
        float* base = v ? (T1 + (size_t)j * 8192 * 256) : (T0 + (size_t)j * 8192 * 4096);
        const int row0 = u.pm * 256 + wr * 64 + fr, col0 = u.pn * 256 + wc * 32 + 4 * fq;
#pragma unroll
        for (int ai = 0; ai < 2; ++ai)
#pragma unroll
            for (int m = 0; m < 4; ++m) { float* rowp = base + (size_t)(row0 + ai * 128 + m * 16) * ld + col0;
#pragma unroll
                for (int bj = 0; bj < 2; ++bj)
#pragma unroll
                    for (int n = 0; n < 2; ++n) *(f32x4*)(rowp + bj * 128 + n * 16) = acc[ai][bj][m][n]; }
    }
};
struct EpiResid {
    static constexpr bool PERM = true;
    h16* X; const float* mods; int layer; float* SSQ; h16* XO;
    __device__ __forceinline__ void operator()(const f32x4 (&acc)[2][2][4][2], const Unit& u, int wr, int wc, int fr, int fq) const {
        const int r0 = u.pm * 256; const int b = r0 < TL ? (r0 >> 12) : 8;
        const float* g = mods + ((size_t)(layer * 9 + b) * 6 + 2) * D;
        const int row0 = r0 + wr * 64 + fr, col0 = u.pn * 256 + wc * 32 + 8 * fq;
        f32x4 gv[2][2];
#pragma unroll
        for (int bj = 0; bj < 2; ++bj)
#pragma unroll
            for (int n = 0; n < 2; ++n) gv[bj][n] = *(const f32x4*)(g + col0 + bj * 128 + n * 4);
#pragma unroll
        for (int ai = 0; ai < 2; ++ai)
#pragma unroll
            for (int m = 0; m < 4; ++m) { const int row = row0 + ai * 128 + m * 16; const h16* rowp = X + (size_t)row * D + col0; h16* rowo = XO + (size_t)row * D + col0; float sq = 0.f;
#pragma unroll
                for (int bj = 0; bj < 2; ++bj) { const f16x8 xv = *(const f16x8*)(rowp + bj * 128); f32x4 v0, v1;
#pragma unroll
                    for (int i = 0; i < 4; ++i) { v0[i] = (float)xv[i] + gv[bj][0][i] * acc[ai][bj][m][0][i]; v1[i] = (float)xv[4 + i] + gv[bj][1][i] * acc[ai][bj][m][1][i]; }
                    const f16x8 w = pack8(v0, v1); *(f16x8*)(rowo + bj * 128) = w;
#pragma unroll
                    for (int i = 0; i < 8; ++i) { const float t = (float)w[i]; sq += t * t; } }
                sq += shx(sq, 16); sq += shx(sq, 32);
                if (fq == 0) SSQ[(size_t)row * 32 + u.pn * 4 + wc] = sq; }
    }
};
struct EpiMoe1 {
    static constexpr bool PERM = true;
    h16* H1;
    __device__ __forceinline__ void operator()(const f32x4 (&acc)[2][2][4][2], const Unit& u, int wr, int wc, int fr, int fq) const {
        const int row0 = u.pm * 256 + wr * 64 + fr, col0 = u.pn * 128 + wc * 16 + 4 * fq;
#pragma unroll
        for (int ai = 0; ai < 2; ++ai)
#pragma unroll
            for (int m = 0; m < 4; ++m) { if (ai == 1 && u.half) continue; h16* rowp = H1 + (size_t)(row0 + ai * 128 + m * 16) * DE + col0;
#pragma unroll
                for (int bj = 0; bj < 2; ++bj) { const f32x4 a = acc[ai][bj][m][0], b = acc[ai][bj][m][1]; f16x4 w;
#pragma unroll
                    for (int i = 0; i < 4; ++i) { const float s = a[i] / (1.0f + __expf(-a[i])); w[i] = (h16)(s * b[i]); }
                    *(f16x4*)(rowp + bj * 64) = w; } }
    }
};
struct EpiMoe2 {
    static constexpr bool PERM = true;
    h16* YC; const float* gslot;
    __device__ __forceinline__ void operator()(const f32x4 (&acc)[2][2][4][2], const Unit& u, int wr, int wc, int fr, int fq) const {
        const int col0 = u.pn * 256 + wc * 32 + 8 * fq;
        const float* grow = gslot + ((const char*)u.rows - (const char*)listbase) / 4;
        int av[2][4]; float gv[2][4];
#pragma unroll
        for (int ai = 0; ai < 2; ++ai)
#pragma unroll
            for (int m = 0; m < 4; ++m) { const int r = ai * 128 + wr * 64 + m * 16 + fr; const bool ok = u.pos0 + r < u.cnt; av[ai][m] = ok ? u.rows[r] : -1; gv[ai][m] = ok ? grow[r] : 0.f; }
#pragma unroll
        for (int ai = 0; ai < 2; ++ai)
#pragma unroll
            for (int m = 0; m < 4; ++m) { if (av[ai][m] >= 0) { const float g = gv[ai][m]; h16* rowp = YC + (size_t)av[ai][m] * D + col0;
#pragma unroll
                    for (int bj = 0; bj < 2; ++bj) *(f16x8*)(rowp + bj * 128) = pack8(acc[ai][bj][m][0] * g, acc[ai][bj][m][1] * g); } }
    }
    const int* listbase;
};

__device__ __forceinline__ void order_tile(int wgid, int nM, int nN, int& pm, int& pn) {
    const int nwg = nM * nN; { const int q = nwg / 8, r = nwg % 8, xcd = wgid % 8, off = wgid / 8; wgid = (xcd < r ? xcd * (q + 1) : r * (q + 1) + (xcd - r) * q) + off; }
    const int nig = 8 * nN, gid = wgid / nig, fm = gid * 8, gsz = (nM - fm) < 8 ? (nM - fm) : 8;
    pm = fm + ((wgid % nig) % gsz); pn = (wgid % nig) / gsz;
}
struct SchedPlain {
    int nM, nN, K; const char* A; const char* B;
    __device__ __forceinline__ bool next(int i, Unit& u) const {
        const long L = (long)i * gridDim.x + blockIdx.x; if (L >= (long)nM * nN) return false;
        order_tile((int)L, nM, nN, u.pm, u.pn); u.kind = 0; u.half = 0; u.e = 0; u.pos0 = 0; u.cnt = 0; u.rows = nullptr;
        u.A = A + (size_t)u.pm * 256 * K * 2; u.B = B + (size_t)u.pn * 256 * K * 2; return true;
    }
};
struct SchedPlainAT {
    int nM, nN, K; const char* At; const char* B;
    __device__ __forceinline__ bool next(int i, Unit& u) const {
        const long L = (long)i * gridDim.x + blockIdx.x; if (L >= (long)nM * nN) return false;
        order_tile((int)L, nM, nN, u.pm, u.pn); u.kind = 0; u.half = 0; u.e = 0; u.pos0 = 0; u.cnt = 0; u.rows = nullptr;
        u.A = At + (size_t)u.pm * 256 * 2; u.B = B + (size_t)u.pn * 256 * K * 2; return true;
    }
};
struct SchedQkv {
    const char* H; const char* W;
    __device__ __forceinline__ bool next(int i, Unit& u) const {
        const long L = (long)i * gridDim.x + blockIdx.x; const int nA = 136 * 9; if (L >= nA + 136) return false;
        u.e = 0; u.half = 0; u.pos0 = 0; u.cnt = 0; u.rows = nullptr;
        if (L < nA) { order_tile((int)L, 136, 9, u.pm, u.pn); u.kind = 0; u.A = H + (size_t)u.pm * 256 * D * 2; u.B = W + (size_t)u.pn * 256 * D * 2; }
        else { u.pm = 0; u.pn = (int)L - nA; u.kind = 1; u.A = W + (size_t)DQK * D * 2; u.B = H + (size_t)u.pn * 256 * D * 2; }
        return true;
    }
};
struct SchedFilt {
    const char* W3P; const char* H2P;
    __device__ __forceinline__ bool next(int i, Unit& u) const {
        const long L = (long)i * gridDim.x + blockIdx.x; if (L >= 2 * 544) return false;
        const int j = (int)L / 544, r = (int)L % 544; u.e = 0; u.half = 0; u.pos0 = 0; u.cnt = 0; u.rows = nullptr;
        int v; if (r < 512) { v = 0; u.pm = r >> 4; u.pn = r & 15; } else { v = 1; u.pm = r - 512; u.pn = 0; }
        u.kind = 2 * j + v;
        u.A = W3P + ((size_t)j * 8192 + (size_t)u.pm * 256) * 256 * 2;
        u.B = H2P + ((size_t)j * 4352 + (v ? 4096 : 0) + (size_t)u.pn * 256) * 256 * 2;
        return true;
    }
};
struct MoeTab { const LAS int* tstart; const LAS int* texp; const LAS int* cnt; };
struct SchedMoe1 {
    MoeTab tb; const char* H; const char* W13; const int* list;
    __device__ __forceinline__ bool next(int i, Unit& u) const {
        const long L = (long)i * gridDim.x + blockIdx.x; const int ntile = __builtin_amdgcn_readfirstlane(tb.tstart[NE]); if (L >= (long)ntile * 3) return false;
        int rt; order_tile((int)L, ntile, 3, rt, u.pn); u.pm = rt; u.kind = 0;
        const int e = __builtin_amdgcn_readfirstlane(tb.texp[rt]); u.e = e; u.pos0 = (rt - __builtin_amdgcn_readfirstlane(tb.tstart[e])) * 256; u.cnt = __builtin_amdgcn_readfirstlane(tb.cnt[e]); u.half = (u.cnt - u.pos0 <= 128) ? 1 : 0;
        u.rows = list + (size_t)e * LCAP + u.pos0; u.A = H; u.B = W13 + ((size_t)e * DE2 + (size_t)u.pn * 256) * D * 2; return true;
    }
};
struct SchedMoe2 {
    MoeTab tb; const char* H1; const char* W2; const int* list;
    __device__ __forceinline__ bool next(int i, Unit& u) const {
        const long L = (long)i * gridDim.x + blockIdx.x; const int ntile = __builtin_amdgcn_readfirstlane(tb.tstart[NE]); if (L >= (long)ntile * 8) return false;
        int rt; order_tile((int)L, ntile, 8, rt, u.pn); u.pm = rt; u.kind = 0;
        const int e = __builtin_amdgcn_readfirstlane(tb.texp[rt]); u.e = e; u.pos0 = (rt - __builtin_amdgcn_readfirstlane(tb.tstart[e])) * 256; u.cnt = __builtin_amdgcn_readfirstlane(tb.cnt[e]); u.half = (u.cnt - u.pos0 <= 128) ? 1 : 0;
        u.rows = list + (size_t)e * LCAP + u.pos0; u.A = H1 + (size_t)rt * 256 * DE * 2; u.B = W2 + ((size_t)e * D + (size_t)u.pn * 256) * DE * 2; return true;
    }
};
__device__ __forceinline__ void moe_table(LAS int* tstart, LAS int* texp, LAS int* cnt, const int* counters) {
    const int t = tid_fresh();
    if (t < NE) cnt[t] = counters[t];
    __syncthreads();
    if (t <= NE) { int s = 0; for (int e = 0; e < t; ++e) s += (cnt[e] + 255) >> 8; tstart[t] = s; }
    __syncthreads();
    if (t < NE) { const int s0 = tstart[t], s1 = tstart[t + 1]; for (int q = s0; q < s1; ++q) texp[q] = t; }
    __syncthreads();
}

__device__ __forceinline__ float wave_sum(float v) {
#pragma unroll
    for (int o = 32; o >= 1; o >>= 1) v += shx(v, o);
    return v;
}
__device__ __forceinline__ float silu_f(float x) { return x / (1.0f + expf(-x)); }
__device__ __forceinline__ int batch_of_row(int r) { return r < TL ? (r >> 12) : 8; }

__device__ __forceinline__ void modp_unit(const Params& p, int unit, LAS float* sl) {
    const int layer = unit / 96, rem = unit % 96, ks = rem / 6, cc = rem % 6, tid = tid_fresh();
    for (int i = tid; i < 9 * 128; i += 512) { const int cnd = i >> 7, k = ks * 128 + (i & 127); const float v = cnd < 8 ? p.c[cnd * D + k] : p.c_ctx[k]; sl[i] = silu_f(v); }
    __syncthreads();
    f32x4 acc[9];
#pragma unroll
    for (int q = 0; q < 9; ++q) acc[q] = (f32x4){0.f, 0.f, 0.f, 0.f};
    const float* w = p.mod_w + ((size_t)layer * D + (size_t)ks * 128) * D6 + cc * 2048 + tid * 4;
#pragma unroll 4
    for (int k = 0; k < 128; ++k) { const f32x4 wv = *(const f32x4*)(w + (size_t)k * D6);
#pragma unroll
        for (int q = 0; q < 9; ++q) acc[q] += wv * sl[q * 128 + k]; }
    float* outp = (float*)(p.ws + WS_MODP) + ((size_t)(ks * 4 + layer) * 9) * D6 + cc * 2048 + tid * 4;
#pragma unroll
    for (int q = 0; q < 9; ++q) *(f32x4*)(outp + (size_t)q * D6) = acc[q];
    __syncthreads();
}
__device__ __forceinline__ void modr_unit(const Params& p, int unit) {
    const size_t idx = (size_t)unit * 2048 + tid_fresh() * 4; const int layer = (int)(idx / (9 * D6)), col = (int)(idx % D6);
    f32x4 s = *(const f32x4*)(p.mod_b + (size_t)layer * D6 + col);
    const float* pp = (const float*)(p.ws + WS_MODP) + idx;
#pragma unroll
    for (int ks = 0; ks < 16; ++ks) s += *(const f32x4*)(pp + (size_t)ks * 4 * 9 * D6);
    *(f32x4*)((float*)(p.ws + WS_MODS) + idx) = s;
}
__device__ __forceinline__ void tables_unit(const Params& p) {
    f32x2* tw = (f32x2*)(p.ws + WS_TW);
    for (int m = tid_fresh(); m < 8192; m += 512) { double s, c; sincospi(-(double)m / 4096.0, &s, &c); tw[m] = (f32x2){(float)c, (float)s}; }
    float* rc = (float*)(p.ws + WS_ROPE);
    for (int i = tid_fresh(); i < 1024; i += 512) { const int pos = i >> 4, q = i & 15; const float inv = powf(10000.0f, -(float)q / 16.0f); const float ang = (float)pos * inv;
        rc[i] = cosf(ang); rc[1024 + i] = sinf(ang); }
}
__device__ __forceinline__ void h2_task(const Params& p, int task) {
    const int lane = tid_fresh() & 63; const int j = task / 4352, r = task % 4352; const int v = r >= 4096, t = v ? r - 4096 : r; const int Lv = v ? 256 : 4096;
    const float tl = (float)t / (float)(Lv - 1);
    const float omega = (float)(2.0 * 3.14159265358979323846 / (double)Lv) * (float)t;
    float feat = 0.f;
    if (lane == 0) feat = tl;
    else if (lane <= 32) { const int bi = (lane - 1) & 15; const float band = 1e-4f + (float)bi * ((15.0f - 1e-4f) / 15.0f); const float a = band * omega; feat = lane <= 16 ? cosf(a) : -sinf(a); }
    const float* w1 = p.hy_f_w1 + (size_t)j * 33 * 64; const float* w2 = p.hy_f_w2 + (size_t)j * 64 * 64;
    float s = p.hy_f_b1[j * 64 + lane];
    for (int f = 0; f < 33; ++f) s += bperm_f(feat, f) * w1[f * 64 + lane];
    const float h1 = sinf(p.hy_f_freq1[j * 64 + lane] * s);
    float s2 = p.hy_f_b2[j * 64 + lane];
    for (int m = 0; m < 64; ++m) s2 += bperm_f(h1, m) * w2[m * 64 + lane];
    const float h2 = sinf(p.hy_f_freq2[j * 64 + lane] * s2);
    const h16 hi = (h16)h2; const h16 lo = (h16)(h2 - (float)hi);
    h16* row = (h16*)(p.ws + WS_H2P) + ((size_t)j * 4352 + r) * 256;
    row[lane] = hi; row[64 + lane] = hi; row[128 + lane] = lo; row[192 + lane] = lo;
}
__device__ __forceinline__ void w3p_unit(const Params& p, int unit) {
    const int j = unit >> 5, c0 = (unit & 31) * 256; const float* w3 = p.hy_f_w3 + (size_t)j * 64 * 8192; h16* dst = (h16*)(p.ws + WS_W3P) + (size_t)j * 8192 * 256;
    for (int i = tid_fresh(); i < 64 * 256; i += 512) { const int m = i >> 8, col = c0 + (i & 255); const float w = w3[(size_t)m * 8192 + col];
        const h16 hi = (h16)w; const h16 lo = (h16)(w - (float)hi); h16* row = dst + (size_t)col * 256; row[m] = hi; row[64 + m] = lo; row[128 + m] = hi; row[192 + m] = lo; }
}
__device__ __forceinline__ void rtab_unit(const Params& p, int unit) {
    const int layer = unit >> 6, c = unit & 63; h16* dst = (h16*)(p.ws + WS_RTAB + (size_t)layer * RTAB_L) + (size_t)c * 5 * 2 * 64 * 8;
    for (int i = tid_fresh(); i < 5 * 2 * 64 * 8; i += 512) { const int jj = i & 7, lane = (i >> 3) & 63, hl = (i >> 9) & 1, ct = i >> 10;
        const int k = 32 * c + 8 * (lane >> 4) + jj, col = 16 * ct + (lane & 15);
        float w = 0.f; if (col < 8) w = p.moe_wg[((size_t)layer * D + k) * 8 + col]; else if (col < 72) w = p.moe_we[((size_t)layer * D + k) * 64 + (col - 8)];
        w *= 256.0f; const h16 hi = (h16)w; const h16 lo = (h16)(w - (float)hi); dst[i] = hl ? lo : hi; }
}
template <int NW>
__device__ __forceinline__ void cvt_tile(const float* src, int ldn, int k0, int n0, h16* dst, int ldk, int mode, LAS float* T) {
    constexpr int P = NW + 1; const int tid = tid_fresh();
#pragma unroll
    for (int ps = 0; ps < 64 * NW / 4 / 512; ++ps) { const int idx = ps * 512 + tid, k = idx / (NW / 4), n4 = idx % (NW / 4);
        const f32x4 v = *(const f32x4*)(src + (size_t)(k0 + k) * ldn + n0 + 4 * n4); LAS float* q = T + k * P + 4 * n4; q[0] = v[0]; q[1] = v[1]; q[2] = v[2]; q[3] = v[3]; }
    __syncthreads();
#pragma unroll
    for (int ps = 0; ps < NW * 8 / 512; ++ps) { const int item = ps * 512 + tid, kc = item & 7, n = item >> 3; f16x8 w;
#pragma unroll
        for (int i = 0; i < 8; ++i) w[i] = (h16)T[(8 * kc + i) * P + n];
        const int ng = n0 + n; const int row = mode == 0 ? ng : (8 * (ng >> 2) + (ng & 3) + (mode == 2 ? 4 : 0));
        *(f16x8*)(dst + (size_t)row * ldk + k0 + 8 * kc) = w; }
    __syncthreads();
}
__device__ __forceinline__ void cvt_dense_unit(const Params& p, int unit, LAS float* T) {
    const float* src; h16* dst; int nt, N;
    if (unit < 1536) { src = p.hy_w_in; dst = (h16*)(p.ws + WS_WIN); nt = 24; N = D3; }
    else if (unit < 2048) { unit -= 1536; src = p.hy_w_out; dst = (h16*)(p.ws + WS_WOUT); nt = 8; N = D; }
    else if (unit < 2688) { unit -= 2048; src = p.at_w_qkv; dst = (h16*)(p.ws + WS_WQKV); nt = 10; N = DQKV; }
    else { unit -= 2688; src = p.at_w_o; dst = (h16*)(p.ws + WS_WO); nt = 8; N = D; }
    const int j = unit / (32 * nt), r = unit % (32 * nt), kt = r / nt, ntile = r % nt;
    cvt_tile<256>(src + (size_t)j * D * N, N, kt * 64, ntile * 256, dst + (size_t)j * N * D, D, 0, T);
}
constexpr int CVT_DENSE_UNITS = 3200;
__device__ __forceinline__ void cvt_moe_unit(const Params& p, int layer, int unit, LAS float* T) {
    if (unit < 12288) { const int which = unit >= 6144; if (which) unit -= 6144; const int e = unit / 96, r = unit % 96, kt = r / 3, ntile = r % 3;
        const float* src = (which ? p.moe_w3 : p.moe_w1) + ((size_t)layer * NE + e) * D * DE;
        cvt_tile<128>(src, DE, kt * 64, ntile * 128, (h16*)(p.ws + WS_W13) + (size_t)e * DE2 * D, D, which ? 2 : 1, T); }
    else { unit -= 12288; const int e = unit / 48, r = unit % 48, kt = r / 8, ntile = r % 8;
        const float* src = p.moe_w2 + ((size_t)layer * NE + e) * DE * D;
        cvt_tile<256>(src, D, kt * 64, ntile * 256, (h16*)(p.ws + WS_W2) + (size_t)e * D * DE, DE, 0, T); }
}
constexpr int CVT_MOE_UNITS = 15360;
struct CvtD { const float* src; h16* dst; int mode; };
__device__ __forceinline__ CvtD cvt13_desc(const Params& p, int layer, int unit) {
    const int which = unit >= 6144; if (which) unit -= 6144; const int e = unit / 96, r = unit % 96, kt = r / 3, ntile = r % 3;
    CvtD d; d.src = (which ? p.moe_w3 : p.moe_w1) + ((size_t)layer * NE + e) * D * DE + (size_t)(kt * 64) * DE + ntile * 128;
    d.dst = (h16*)(p.ws + WS_W13) + (size_t)e * DE2 * D + kt * 64; d.mode = (which ? 4 : 0) + 8 * (256 * ntile); return d;
}
__device__ __forceinline__ void cvt13_load(const CvtD& d, f32x4 (&v)[4], int tid) {
#pragma unroll
    for (int ps = 0; ps < 4; ++ps) { const int idx = ps * 512 + tid, k = idx >> 5, n4 = idx & 31; v[ps] = *(const f32x4*)(d.src + (size_t)k * DE + 4 * n4); }
}
__device__ __forceinline__ void cvt13_store(const CvtD& d, const f32x4 (&v)[4], LAS float* T, int tid) {
    constexpr int P = 129;
#pragma unroll
    for (int ps = 0; ps < 4; ++ps) { const int idx = ps * 512 + tid, k = idx >> 5, n4 = idx & 31; LAS float* q = T + k * P + 4 * n4; q[0] = v[ps][0]; q[1] = v[ps][1]; q[2] = v[ps][2]; q[3] = v[ps][3]; }
    __syncthreads();
    const int w3off = d.mode & 7, rg0 = d.mode >> 3;
#pragma unroll
    for (int ps = 0; ps < 2; ++ps) { const int item = ps * 512 + tid, kc = item & 7, n = item >> 3; f16x8 w;
#pragma unroll
        for (int i = 0; i < 8; ++i) w[i] = (h16)T[(8 * kc + i) * P + n];
        const int row = rg0 + 8 * (n >> 2) + (n & 3) + w3off;
        *(f16x8*)(d.dst + (size_t)row * D + 8 * kc) = w; }
    __syncthreads();
}
__device__ __forceinline__ void cvt_moe_share(const Params& p, int layer, int u0, int n, int stride, LAS float* T) {
    const int tid = tid_fresh(); const int n13 = n < 12288 ? n : 12288;
    int u = u0;
    if (u < n13) {
        CvtD dA = cvt13_desc(p, layer, u), dB = dA, dC = dA; f32x4 vA[4], vB[4], vC[4];
        cvt13_load(dA, vA, tid);
        if (u + stride < n13) { dB = cvt13_desc(p, layer, u + stride); cvt13_load(dB, vB, tid); }
        for (;;) {
            if (u + 2 * stride < n13) { dC = cvt13_desc(p, layer, u + 2 * stride); cvt13_load(dC, vC, tid); }
            cvt13_store(dA, vA, T, tid); u += stride; if (u >= n13) break;
            if (u + 2 * stride < n13) { dA = cvt13_desc(p, layer, u + 2 * stride); cvt13_load(dA, vA, tid); }
            cvt13_store(dB, vB, T, tid); u += stride; if (u >= n13) break;
            if (u + 2 * stride < n13) { dB = cvt13_desc(p, layer, u + 2 * stride); cvt13_load(dB, vB, tid); }
            cvt13_store(dC, vC, T, tid); u += stride; if (u >= n13) break;
        }
    }
    for (; u < n; u += stride) cvt_moe_unit(p, layer, u, T);
}

template <int NR, bool FINAL>
__device__ __forceinline__ void n1_rows(const Params& p, int layer, int r0, int rstride, int lane, h16* xout) {
    const h16* xres = (const h16*)(p.ws + WS_XRES); h16* hb = (h16*)(p.ws + WS_HBUF); const h16* yc = (const h16*)(p.ws + WS_YC); const float* mods = (const float*)(p.ws + WS_MODS);
    f32x4 v[NR][8]; f16x4 xh[NR][8], ya[NR][8], yb[NR][8];
    const bool comb = FINAL || layer > 0; const int lprev = FINAL ? 3 : layer - 1;
#pragma unroll
    for (int q = 0; q < NR; ++q) { const int r = r0 + q * rstride;
        if (!comb) { const float* src = r < TL ? p.x + (size_t)r * D : p.ctx + (size_t)(r - TL) * D;
#pragma unroll
            for (int c = 0; c < 8; ++c) v[q][c] = *(const f32x4*)(src + c * 256 + lane * 4); }
        else { const h16* src = xres + (size_t)r * D; const h16* y0 = yc + (size_t)(2 * r) * D; const h16* y1 = y0 + D;
#pragma unroll
            for (int c = 0; c < 8; ++c) { xh[q][c] = *(const f16x4*)(src + c * 256 + lane * 4); ya[q][c] = *(const f16x4*)(y0 + c * 256 + lane * 4); yb[q][c] = *(const f16x4*)(y1 + c * 256 + lane * 4); } } }
#pragma unroll
    for (int q = 0; q < NR; ++q) { const int r = r0 + q * rstride; const int b = batch_of_row(r);
        if (comb) { const float* g2 = mods + ((size_t)(lprev * 9 + b) * 6 + 5) * D;
#pragma unroll
            for (int c = 0; c < 8; ++c) { const f32x4 g = *(const f32x4*)(g2 + c * 256 + lane * 4);
#pragma unroll
                for (int i = 0; i < 4; ++i) v[q][c][i] = (float)xh[q][c][i] + g[i] * ((float)ya[q][c][i] + (float)yb[q][c][i]); } }
        float ss = 0.f;
#pragma unroll
        for (int c = 0; c < 8; ++c) { if (!FINAL) { f16x4 w; w[0] = (h16)v[q][c][0]; w[1] = (h16)v[q][c][1]; w[2] = (h16)v[q][c][2]; w[3] = (h16)v[q][c][3]; *(f16x4*)(xout + (size_t)r * D + c * 256 + lane * 4) = w; } ss += v[q][c][0] * v[q][c][0] + v[q][c][1] * v[q][c][1] + v[q][c][2] * v[q][c][2] + v[q][c][3] * v[q][c][3]; }
        ss = wave_sum(ss); const float rs = 1.0f / sqrtf(ss * (1.0f / D) + EPS);
        if (FINAL) {
#pragma unroll
            for (int c = 0; c < 8; ++c) { const int col = c * 256 + lane * 4; const f32x4 g = *(const f32x4*)(p.final_gain + col); *(f32x4*)(p.out + (size_t)r * D + col) = v[q][c] * rs * g; }
        } else {
            const float* sh = mods + ((size_t)(layer * 9 + b) * 6 + 0) * D; const float* sc = sh + D;
#pragma unroll
            for (int c = 0; c < 8; ++c) { const int col = c * 256 + lane * 4; const f32x4 s0 = *(const f32x4*)(sh + col), s1 = *(const f32x4*)(sc + col); f16x4 w;
#pragma unroll
                for (int i = 0; i < 4; ++i) w[i] = (h16)(v[q][c][i] * rs * (1.0f + s1[i]) + s0[i]);
                *(f16x4*)(hb + (size_t)r * D + col) = w; }
        } }
}
template <bool FINAL>
__device__ __forceinline__ void n1_any(const Params& p, int layer, h16* xout) {
    const int tid = tid_fresh(), lane = tid & 63, gw = blockIdx.x * 8 + __builtin_amdgcn_readfirstlane(tid >> 6), nw = gridDim.x * 8; const int nrow = FINAL ? TL : TT;
    int r = gw;
    for (; r + nw < nrow; r += 2 * nw) n1_rows<2, FINAL>(p, layer, r, nw, lane, xout);
    if (r < nrow) n1_rows<1, FINAL>(p, layer, r, nw, lane, xout);
}
__device__ __forceinline__ void n1_phase(const Params& p, int layer, h16* xout) { n1_any<false>(p, layer, xout); }
__device__ __forceinline__ void final_phase(const Params& p) { n1_any<true>(p, 0, nullptr); }
constexpr int N2_CH = 4;
constexpr int N2_SLOT = N2_CH * 10 * 1024;
constexpr int N2_XT = 2 * N2_SLOT;
constexpr int N2_SC = N2_XT + 8 * 4096;
#ifndef PROBE_N2VAR
#define PROBE_N2VAR 0
#endif
__device__ __forceinline__ void n2_phase(const Params& p, int layer, LAS unsigned char* lds, int ctr_shadow) {
    const bool pv_tail = !(ctr_shadow && (PROBE_N2VAR & 1)), pv_store = !(ctr_shadow && (PROBE_N2VAR & 2)), pv_mma = !(ctr_shadow && (PROBE_N2VAR & 4));
    const int tid = tid_fresh(), lane = tid & 63, wv = __builtin_amdgcn_readfirstlane(tid >> 6), r16 = lane & 15, kg = lane >> 4;
    const int lrow = lane >> 3, lchk = lane & 7;
    const h16* xres = (const h16*)(p.ws + WS_XRES); h16* hb = (h16*)(p.ws + WS_HBUF); const float* mods = (const float*)(p.ws + WS_MODS);
    const char* rtb = p.ws + WS_RTAB + (size_t)layer * RTAB_L; const float* ssq = (const float*)(p.ws + WS_SSQ);
    int* counters = (int*)(p.ws + WS_CTL) + CTL_CNT + (layer + (ctr_shadow ? 4 : 0)) * NE; int* list = (int*)(p.ws + WS_LIST); float* gate = (float*)(p.ws + WS_GATE);
    LAS float* scr = (LAS float*)lds + wv * (16 * 80);
    LAS float* scl = (LAS float*)(lds + N2_SC); LAS float* shl = scl + D;
    LAS int* hist = (LAS int*)(lds + LDS_MISC); LAS int* hbase = hist + NE;
    LAS unsigned char* xt = lds + N2_XT + wv * 4096;
    const int hw_off0 = r16 * 128 + 16 * (kg ^ (r16 & 7)), hw_off1 = r16 * 128 + 16 * ((4 + kg) ^ (r16 & 7));
    const int hr_off = lrow * 128 + 16 * (lchk ^ (lrow & 7));
    const int ntask = (layer == NLAYER - 1 ? TL : TT) / 16, nfull = (int)gridDim.x * 8;
#pragma unroll 1
    for (int round = 0; round < 2; ++round) {
        const int nrem = ntask - nfull;
        if (round == 1 && (int)blockIdx.x >= nrem) break;
        const int task = round == 0 ? (int)blockIdx.x * 8 + wv : nfull + (int)blockIdx.x;
        const bool active = round == 0 ? (task < ntask) : true;
        const int trow = active ? task * 16 : 0;
        const int b = batch_of_row(trow);
        const h16* xg = xres + (size_t)(trow + r16) * D + 8 * kg;
        h16* hg0 = hb + (size_t)(trow + lrow) * D + lchk * 8; h16* hg1 = hg0 + (size_t)8 * D;
        float rs;
        { const float* sp = ssq + (size_t)(trow + r16) * 32; float t = 0.f;
#pragma unroll
            for (int q = 0; q < 8; ++q) { const f32x4 v = *(const f32x4*)(sp + 4 * q); t += (v[0] + v[1]) + (v[2] + v[3]); }
            rs = 1.0f / sqrtf(t * (1.0f / D) + EPS); }
        f32x4 acc[5];
#pragma unroll
        for (int ct = 0; ct < 5; ++ct) acc[ct] = (f32x4){0.f, 0.f, 0.f, 0.f};
        __syncthreads();
        if (tid < NE) hist[tid] = 0;
        { const float* scb = mods + ((size_t)(layer * 9 + b) * 6 + 4) * D; *(LAS f32x4*)(scl + tid * 4) = *(const f32x4*)(scb + tid * 4); *(LAS f32x4*)(shl + tid * 4) = *(const f32x4*)(scb - D + tid * 4); }
        if (round == 0) {
        f16x8 bq[5];
#pragma unroll
        for (int q = 0; q < 5; ++q) bq[q] = *(const f16x8*)(rtb + (size_t)(5 * wv + q) * 1024 + lane * 16);
#pragma unroll
        for (int q = 0; q < 5; ++q) *(LAS f16x8*)(lds + (5 * wv + q) * 1024 + lane * 16) = bq[q];
#pragma unroll
        for (int q = 0; q < 5; ++q) bq[q] = *(const f16x8*)(rtb + (size_t)N2_SLOT + (size_t)(5 * wv + q) * 1024 + lane * 16);
        f16x8 x0[N2_CH], x1[N2_CH], x2[N2_CH];
#pragma unroll
        for (int s2 = 0; s2 < N2_CH; ++s2) { x0[s2] = *(const f16x8*)(xg + 32 * s2); x1[s2] = *(const f16x8*)(xg + 32 * (N2_CH + s2)); }
#define N2_CHUNK(XC, XL, CH) do { const int ch = (CH); \
            __syncthreads(); \
            const int nx2 = (ch + 2 < 64 / N2_CH) ? ch + 2 : ch; \
            {   LAS unsigned char* dst = lds + ((ch + 1) & 1) * N2_SLOT; \
 _Pragma("unroll") \
                for (int q = 0; q < 5; ++q) *(LAS f16x8*)(dst + (5 * wv + q) * 1024 + lane * 16) = bq[q]; } \
            {   const char* src = rtb + (size_t)nx2 * N2_SLOT; \
 _Pragma("unroll") \
                for (int q = 0; q < 5; ++q) bq[q] = *(const f16x8*)(src + (size_t)(5 * wv + q) * 1024 + lane * 16); } \
 _Pragma("unroll") \
            for (int s2 = 0; s2 < N2_CH; ++s2) { const int ko = 32 * (nx2 * N2_CH + s2); XL[s2] = *(const f16x8*)(xg + ko); } \
            const LAS unsigned char* bs = lds + (ch & 1) * N2_SLOT + lane * 16; \
 _Pragma("unroll") \
            for (int pp = 0; pp < N2_CH / 2; ++pp) { \
                f16x8 hk[2]; \
 _Pragma("unroll") \
                for (int sp = 0; sp < 2; ++sp) { \
                    const int s2 = 2 * pp + sp; const int ko = 32 * (ch * N2_CH + s2) + 8 * kg; \
                    const f32x4 c0 = *(const LAS f32x4*)(scl + ko), c1 = *(const LAS f32x4*)(scl + ko + 4), h0 = *(const LAS f32x4*)(shl + ko), h1 = *(const LAS f32x4*)(shl + ko + 4); \
                    f16x8 hi, lo; \
 _Pragma("unroll") \
                    for (int i = 0; i < 4; ++i) { const float a0 = (float)XC[s2][i] * rs * (1.0f + c0[i]) + h0[i], a1 = (float)XC[s2][4 + i] * rs * (1.0f + c1[i]) + h1[i]; \
                        hi[i] = (h16)a0; lo[i] = (h16)(a0 - (float)hi[i]); hi[4 + i] = (h16)a1; lo[4 + i] = (h16)(a1 - (float)hi[4 + i]); } \
                    hk[sp] = hi; \
                    if (pv_mma) \
 _Pragma("unroll") \
                    for (int ct = 0; ct < 5; ++ct) { const f16x8 whi = *(const LAS f16x8*)(bs + (s2 * 10 + ct * 2 + 0) * 1024), wlo = *(const LAS f16x8*)(bs + (s2 * 10 + ct * 2 + 1) * 1024); \
                        acc[ct] = __builtin_amdgcn_mfma_f32_16x16x32_f16(hi, whi, acc[ct], 0, 0, 0); \
                        acc[ct] = __builtin_amdgcn_mfma_f32_16x16x32_f16(hi, wlo, acc[ct], 0, 0, 0); \
                        acc[ct] = __builtin_amdgcn_mfma_f32_16x16x32_f16(lo, whi, acc[ct], 0, 0, 0); } \
                } \
                *(LAS f16x8*)(xt + hw_off0) = hk[0]; *(LAS f16x8*)(xt + hw_off1) = hk[1]; \
                const f16x8 o0 = *(const LAS f16x8*)(xt + hr_off), o1 = *(const LAS f16x8*)(xt + 1024 + hr_off); \
                if (active && pv_store) { const int ho = 32 * (ch * N2_CH + 2 * pp); *(f16x8*)(hg0 + ho) = o0; *(f16x8*)(hg1 + ho) = o1; } \
            } \
        } while (0)
#pragma unroll 1
        for (int c3 = 0; c3 < 15; c3 += 3) { N2_CHUNK(x0, x2, c3); N2_CHUNK(x1, x0, c3 + 1); N2_CHUNK(x2, x1, c3 + 2); }
        N2_CHUNK(x0, x2, 15);
#undef N2_CHUNK
        } else {
            const char* rtw = rtb + (size_t)(8 * wv) * 10240; const int kb = 256 * wv;
            unsigned loff = (unsigned)lane * 16u; asm volatile("" : "+v"(loff));
            f16x8 bb[10];
            f16x8 xa[2][2];
#pragma unroll
            for (int sp = 0; sp < 2; ++sp) xa[0][sp] = *(const f16x8*)(xg + kb + 32 * sp);
#pragma unroll
            for (int pp = 0; pp < 4; ++pp) {
                if (pp < 3) {
#pragma unroll
                    for (int sp = 0; sp < 2; ++sp) xa[(pp + 1) & 1][sp] = *(const f16x8*)(xg + kb + 32 * (2 * pp + 2 + sp)); }
                f16x8 hk[2];
#pragma unroll
                for (int sp = 0; sp < 2; ++sp) {
                    const int st = 2 * pp + sp; const int ko = kb + 32 * st + 8 * kg;
#pragma unroll
                    for (int q = 0; q < 10; ++q) bb[q] = *(const f16x8*)(rtw + (size_t)(st * 10 + q) * 1024 + loff);
                    asm volatile("" ::: "memory");
                    const f32x4 c0 = *(const LAS f32x4*)(scl + ko), c1 = *(const LAS f32x4*)(scl + ko + 4), h0 = *(const LAS f32x4*)(shl + ko), h1 = *(const LAS f32x4*)(shl + ko + 4);
                    f16x8 hi, lo;
#pragma unroll
                    for (int i = 0; i < 4; ++i) { const float a0 = (float)xa[pp & 1][sp][i] * rs * (1.0f + c0[i]) + h0[i], a1 = (float)xa[pp & 1][sp][4 + i] * rs * (1.0f + c1[i]) + h1[i];
                        hi[i] = (h16)a0; lo[i] = (h16)(a0 - (float)hi[i]); hi[4 + i] = (h16)a1; lo[4 + i] = (h16)(a1 - (float)hi[4 + i]); }
                    hk[sp] = hi;
#pragma unroll
                    for (int ct = 0; ct < 5; ++ct) {
                        acc[ct] = __builtin_amdgcn_mfma_f32_16x16x32_f16(hi, bb[2 * ct], acc[ct], 0, 0, 0);
                        acc[ct] = __builtin_amdgcn_mfma_f32_16x16x32_f16(hi, bb[2 * ct + 1], acc[ct], 0, 0, 0);
                        acc[ct] = __builtin_amdgcn_mfma_f32_16x16x32_f16(lo, bb[2 * ct], acc[ct], 0, 0, 0); }
                }
                *(LAS f16x8*)(xt + hw_off0) = hk[0]; *(LAS f16x8*)(xt + hw_off1) = hk[1];
                const f16x8 o0 = *(const LAS f16x8*)(xt + hr_off), o1 = *(const LAS f16x8*)(xt + 1024 + hr_off);
                if (pv_store) { const int ho = kb + 64 * pp; *(f16x8*)(hg0 + ho) = o0; *(f16x8*)(hg1 + ho) = o1; }
            }
        }
        __syncthreads();
#pragma unroll
        for (int ct = 0; ct < 5; ++ct)
#pragma unroll
            for (int i = 0; i < 4; ++i) scr[(4 * kg + i) * 80 + 16 * ct + r16] = acc[ct][i] * (1.0f / 256.0f);
        asm volatile("s_waitcnt lgkmcnt(0)" ::: "memory");
        int ea = 0, eb = 0, ra = 0, rb = 0; float g1v = 0.f, g2v = 0.f; const bool tok_lane = (round == 0 ? active : wv == 0) && lane < 16 && pv_tail;
        const int nparts = round == 0 ? 1 : 8;
        if (tok_lane) {
            const LAS float* lgr = scr + lane * 80;
#define N2_LG(c) ({ float _t = lgr[(c)]; for (int _w = 1; _w < nparts; ++_w) _t += lgr[_w * 1280 + (c)]; _t; })
            float gmax = -3.0e38f; int gsel = 0; float gl[8];
#pragma unroll
            for (int g = 0; g < 8; ++g) { gl[g] = N2_LG(g) + p.moe_bg[layer * 8 + g]; if (gl[g] > gmax) { gmax = gl[g]; gsel = g; } }
            float gz = 0.f;
#pragma unroll
            for (int g = 0; g < 8; ++g) gz += expf(gl[g] - gmax);
            const float pg = 1.0f / gz;
            float f1 = -3.0e38f, f2 = -3.0e38f; int i1 = 0, i2 = 0;
            for (int q = 0; q < 8; ++q) { const float f = N2_LG(8 + gsel * 8 + q) + p.moe_be[layer * 64 + gsel * 8 + q];
                if (f > f1) { f2 = f1; i2 = i1; f1 = f; i1 = q; } else if (f > f2) { f2 = f; i2 = q; } }
            const float e2 = expf(f2 - f1); g1v = pg / (1.0f + e2); g2v = pg * e2 / (1.0f + e2);
            ea = gsel * 8 + i1; eb = gsel * 8 + i2;
#undef N2_LG
            ra = __hip_atomic_fetch_add(hist + ea, 1, __ATOMIC_RELAXED, __HIP_MEMORY_SCOPE_WORKGROUP); rb = __hip_atomic_fetch_add(hist + eb, 1, __ATOMIC_RELAXED, __HIP_MEMORY_SCOPE_WORKGROUP);
        }
        __syncthreads();
        { const int t2 = tid_fresh(); if (t2 < NE && pv_tail) { const int n = hist[t2]; hbase[t2] = n ? atomicAdd(&counters[t2], n) : 0; } }
        __syncthreads();
        if (tok_lane) { const int tok = task * 16 + lane; const size_t sa = (size_t)ea * LCAP + hbase[ea] + ra, sb = (size_t)eb * LCAP + hbase[eb] + rb;
            list[sa] = 2 * tok; gate[sa] = g1v; list[sb] = 2 * tok + 1; gate[sb] = g2v; }
    }
}
__device__ __forceinline__ void transpose_phase(const Params& p, LAS h16* T) {
    const h16* zt = (const h16*)(p.ws + WS_ZT); h16* z = (h16*)(p.ws + WS_HBUF); const int tid = tid_fresh();
    const int ntile = (D / 64) * (TT / 64);
    for (int tile = blockIdx.x; tile < ntile; tile += gridDim.x) {
        const int td = tile % (D / 64), tt = tile / (D / 64); const int d0 = td * 64, t0 = tt * 64;
        { const int dr = tid >> 3, tc = (tid & 7) * 8; const f16x8 v = *(const f16x8*)(zt + (size_t)(d0 + dr) * TT + t0 + tc);
#pragma unroll
            for (int i = 0; i < 8; ++i) T[(tc + i) * 66 + dr] = v[i]; }
        __syncthreads();
        { const int tr = tid >> 3, dc = (tid & 7) * 8; f16x8 v;
#pragma unroll
            for (int i = 0; i < 8; ++i) v[i] = T[tr * 66 + dc + i];
            *(f16x8*)(z + (size_t)(t0 + tr) * D + d0 + dc) = v; }
        __syncthreads();
    }
}

__device__ __forceinline__ f32x2 cmul(const f32x2 a, const f32x2 b) { return (f32x2){a.x * b.x - a.y * b.y, a.x * b.y + a.y * b.x}; }
__device__ __forceinline__ f32x2 cmulc(const f32x2 a, const f32x2 b) { return (f32x2){a.x * b.x + a.y * b.y, a.y * b.x - a.x * b.y}; }
__device__ __forceinline__ f32x2 cconj(const f32x2 a) { return (f32x2){a.x, -a.y}; }
template <bool INV> __device__ __forceinline__ f32x2 mul_mi(const f32x2 a) { return INV ? (f32x2){-a.y, a.x} : (f32x2){a.y, -a.x}; }
template <bool INV> __device__ __forceinline__ void dft4(f32x2& a, f32x2& b, f32x2& c, f32x2& d) {
    const f32x2 s0 = a + c, s1 = a - c, s2 = b + d, s3 = mul_mi<INV>(b - d);
    a = s0 + s2; b = s1 + s3; c = s0 - s2; d = s1 - s3;
}
template <bool INV, int M> __device__ __forceinline__ f32x2 w16mul(const f32x2 a) {
    constexpr float C1 = 0.92387953251128674f, S1 = 0.38268343236508977f, R = 0.70710678118654752f;
    constexpr float cr = (M == 0) ? 1.f : (M == 1) ? C1 : (M == 2) ? R : (M == 3) ? S1 : (M == 4) ? 0.f : (M == 6) ? -R :   -C1;
    constexpr float ci0 = (M == 0) ? 0.f : (M == 1) ? -S1 : (M == 2) ? -R : (M == 3) ? -C1 : (M == 4) ? -1.f : (M == 6) ? -R :   S1;
    constexpr float ci = INV ? -ci0 : ci0;
    return (f32x2){a.x * cr - a.y * ci, a.x * ci + a.y * cr};
}
template <bool INV> __device__ __forceinline__ void dft16(f32x2 (&v)[16]) {
#pragma unroll
    for (int n2 = 0; n2 < 4; ++n2) dft4<INV>(v[n2], v[4 + n2], v[8 + n2], v[12 + n2]);
    v[5] = w16mul<INV, 1>(v[5]); v[6] = w16mul<INV, 2>(v[6]); v[7] = w16mul<INV, 3>(v[7]);
    v[9] = w16mul<INV, 2>(v[9]); v[10] = w16mul<INV, 4>(v[10]); v[11] = w16mul<INV, 6>(v[11]);
    v[13] = w16mul<INV, 3>(v[13]); v[14] = w16mul<INV, 6>(v[14]); v[15] = w16mul<INV, 9>(v[15]);
#pragma unroll
    for (int k1 = 0; k1 < 4; ++k1) dft4<INV>(v[4 * k1], v[4 * k1 + 1], v[4 * k1 + 2], v[4 * k1 + 3]);
    f32x2 t;
    t = v[1]; v[1] = v[4]; v[4] = t; t = v[2]; v[2] = v[8]; v[8] = t; t = v[3]; v[3] = v[12]; v[12] = t;
    t = v[6]; v[6] = v[9]; v[9] = t; t = v[7]; v[7] = v[13]; v[13] = t; t = v[11]; v[11] = v[14]; v[14] = t;
}
__device__ __forceinline__ int fphys(int i) { return i + (i >> 4); }
__device__ __forceinline__ f32x2 w32c(int j) {
    constexpr float c[16] = {1.f, 0.98078528040323043f, 0.92387953251128674f, 0.83146961230254524f, 0.70710678118654752f, 0.55557023301960218f, 0.38268343236508977f, 0.19509032201612825f,
                             0.f, -0.19509032201612825f, -0.38268343236508977f, -0.55557023301960218f, -0.70710678118654752f, -0.83146961230254524f, -0.92387953251128674f, -0.98078528040323043f};
    constexpr float s[16] = {0.f, 0.19509032201612825f, 0.38268343236508977f, 0.55557023301960218f, 0.70710678118654752f, 0.83146961230254524f, 0.92387953251128674f, 0.98078528040323043f,
                             1.f, 0.98078528040323043f, 0.92387953251128674f, 0.83146961230254524f, 0.70710678118654752f, 0.55557023301960218f, 0.38268343236508977f, 0.19509032201612825f};
    return (f32x2){c[j], -s[j]};
}
template <int S>
__device__ __forceinline__ void fft_fwd0(const f32x2 (&xe)[16], const f32x2 (&xo)[16], LAS f32x2* E, LAS f32x2* O, int t, const f32x2* tw) {
    const f32x2 u = tw[t * (256 / S)]; const f32x2 u2 = cmul(u, u);
    f32x2 y[16];
#pragma unroll
    for (int j = 0; j < 16; ++j) y[j] = xe[j];
    dft16<false>(y);
    constexpr int QS = S + S / 16;
    LAS f32x2* Eb = E + fphys(t); LAS f32x2* Ob = O + fphys(t);
    f32x2 pw = u2; Eb[0] = y[0];
#pragma unroll
    for (int q = 1; q < 16; ++q) { Eb[QS * q] = cmul(y[q], pw); pw = cmul(pw, u2); }
#pragma unroll
    for (int j = 0; j < 16; ++j) y[j] = cmul(xo[j], w32c(j));
    dft16<false>(y);
    pw = u;
#pragma unroll
    for (int q = 0; q < 16; ++q) { Ob[QS * q] = cmul(y[q], pw); pw = cmul(pw, u2); }
}
template <bool INV> __device__ __forceinline__ void fft_pass1(LAS f32x2* A, int tau, const f32x2* tw) {
    const int i = tau & 15, base = (tau >> 4) << 8; const f32x2 u0 = tw[32 * i]; const f32x2 u = INV ? cconj(u0) : u0;
    f32x2 y[16]; LAS f32x2* Ab = A + fphys(base + i);
#pragma unroll
    for (int j = 0; j < 16; ++j) y[j] = Ab[17 * j];
    if (INV) { f32x2 pw = u;
#pragma unroll
        for (int q = 1; q < 16; ++q) { y[q] = cmul(y[q], pw); pw = cmul(pw, u); } }
    dft16<INV>(y);
    if (!INV) { f32x2 pw = u;
#pragma unroll
        for (int q = 1; q < 16; ++q) { y[q] = cmul(y[q], pw); pw = cmul(pw, u); } }
#pragma unroll
    for (int j = 0; j < 16; ++j) Ab[17 * j] = y[j];
}
template <bool INV> __device__ __forceinline__ void fft_pass1_pair(LAS f32x2* A, LAS f32x2* B, int tau, const f32x2* tw) {
    const int i = tau & 15, base = (tau >> 4) << 8; const f32x2 u0 = tw[32 * i]; const f32x2 u = INV ? cconj(u0) : u0;
    f32x2 y[16], z[16]; LAS f32x2* Ab = A + fphys(base + i); LAS f32x2* Bb = B + fphys(base + i);
#pragma unroll
    for (int j = 0; j < 16; ++j) y[j] = Ab[17 * j];
#pragma unroll
    for (int j = 0; j < 16; ++j) z[j] = Bb[17 * j];
    f32x2 pwr[16]; pwr[1] = u;
#pragma unroll
    for (int q = 2; q < 16; ++q) pwr[q] = cmul(pwr[q - 1], u);
    if (INV) {
#pragma unroll
        for (int q = 1; q < 16; ++q) y[q] = cmul(y[q], pwr[q]); }
    dft16<INV>(y);
    if (!INV) {
#pragma unroll
        for (int q = 1; q < 16; ++q) y[q] = cmul(y[q], pwr[q]); }
#pragma unroll
    for (int j = 0; j < 16; ++j) Ab[17 * j] = y[j];
    if (INV) {
#pragma unroll
        for (int q = 1; q < 16; ++q) z[q] = cmul(z[q], pwr[q]); }
    dft16<INV>(z);
    if (!INV) {
#pragma unroll
        for (int q = 1; q < 16; ++q) z[q] = cmul(z[q], pwr[q]); }
#pragma unroll
    for (int j = 0; j < 16; ++j) Bb[17 * j] = z[j];
}
__device__ __forceinline__ void fft_fwd2(const LAS f32x2* A, int t, f32x2 (&y)[16]) {
#pragma unroll
    for (int j = 0; j < 16; ++j) y[j] = A[17 * t + j];
    dft16<false>(y);
}
__device__ __forceinline__ void kf_load(const f32x2* kf, f32x4 (&k)[8]) {
#pragma unroll
    for (int j = 0; j < 8; ++j) k[j] = *(const f32x4*)(kf + 2 * j);
}
__device__ __forceinline__ void fft_mid(LAS f32x2* A, int t, const f32x4 (&k)[8]) {
    f32x2 y[16];
    fft_fwd2(A, t, y);
#pragma unroll
    for (int j = 0; j < 8; ++j) { y[2 * j] = cmul(y[2 * j], (f32x2){k[j][0], k[j][1]}); y[2 * j + 1] = cmul(y[2 * j + 1], (f32x2){k[j][2], k[j][3]}); }
    dft16<true>(y);
#pragma unroll
    for (int j = 0; j < 16; ++j) A[17 * t + j] = y[j];
}
template <int S>
__device__ __forceinline__ void fft_inv0(const LAS f32x2* E, const LAS f32x2* O, int t, const f32x2* tw, f32x2 (&out)[16]) {
    const f32x2 u = tw[t * (256 / S)]; const f32x2 u2 = cmul(u, u);
    f32x2 y[16];
    constexpr int QS = S + S / 16;
    const LAS f32x2* Eb = E + fphys(t); const LAS f32x2* Ob = O + fphys(t);
    f32x2 pw = u2; y[0] = Eb[0];
#pragma unroll
    for (int q = 1; q < 16; ++q) { y[q] = cmulc(Eb[QS * q], pw); pw = cmul(pw, u2); }
    dft16<true>(y);
#pragma unroll
    for (int j = 0; j < 16; ++j) out[j] = y[j];
    pw = u;
#pragma unroll
    for (int q = 0; q < 16; ++q) { y[q] = cmulc(Ob[QS * q], pw); pw = cmul(pw, u2); }
    dft16<true>(y);
#pragma unroll
    for (int j = 0; j < 16; ++j) out[j] += cmulc(y[j], w32c(j));
}
__device__ __forceinline__ float hy_absdelta(int d) { return fabsf(-3.0701134573253943f + (-15.350567286626973f + 3.0701134573253943f) * ((float)d / 2047.0f)); }

__device__ __forceinline__ void filt_fft_phase(const Params& p, LAS unsigned char* lds) {
    const int tid = tid_fresh();
    const f32x2* tw = (const f32x2*)(p.ws + WS_TW);
    {
        const int grp = tid >> 8, tau = tid & 255;
        LAS f32x2* E = (LAS f32x2*)(lds + grp * 69632); LAS f32x2* O = E + 4352; LAS float* red = (LAS float*)(lds + LDS_MISC) + grp * 8;
        for (int pb = blockIdx.x * 2 + grp; pb < 2 * 2 * 2048; pb += gridDim.x * 2) {
            const int d = pb & 2047, n = (pb >> 11) & 1, j = pb >> 12;
            const float* tf = (const float*)(p.ws + WS_TAPS) + ((size_t)j * 8192 + (size_t)(n * 2 + 0) * D + d) * 4096;
            const float* tb = tf + (size_t)D * 4096;
            const float adel = hy_absdelta(d); const float tscale = 1.0f / 4095.0f;
            f32x2 xe[16], xo[16]; float ss = 0.f;
#pragma unroll
            for (int jj = 0; jj < 16; ++jj) { const int nn = tau + 256 * jj;
                const float klo = tf[nn] * expf(-(float)nn * tscale * adel);
                const int m = 4096 - nn;
                const float khi = (m < 4096) ? tb[m & 4095] * expf(-(float)m * tscale * adel) : 0.f;
                ss += klo * klo + khi * khi; xe[jj] = (f32x2){klo + khi, 0.f}; xo[jj] = (f32x2){klo - khi, 0.f}; }
            ss = wave_sum(ss);
            if ((tid & 63) == 0) red[(tid >> 6) & 3] = ss;
            fft_fwd0<256>(xe, xo, E, O, tau, tw);
            __syncthreads();
            const float tot = red[0] + red[1] + red[2] + red[3];
            const float scale = (1.0f / sqrtf(tot + EPS)) * (1.0f / 8192.0f);
            const float hbs = p.hy_bias[((size_t)j * 2 + n) * D + d] * (1.0f / 8192.0f);
            fft_pass1<false>(E, tau, tw); fft_pass1<false>(O, tau, tw);
            __syncthreads();
            f32x2* kf = (f32x2*)(p.ws + WS_KF) + (size_t)pb * 8192 + (size_t)tau * 16;
            f32x2 y[16];
            fft_fwd2(E, tau, y);
#pragma unroll
            for (int q = 0; q < 8; ++q) *(f32x4*)(kf + 2 * q) = (f32x4){y[2 * q].x * scale + hbs, y[2 * q].y * scale, y[2 * q + 1].x * scale + hbs, y[2 * q + 1].y * scale};
            fft_fwd2(O, tau, y);
#pragma unroll
            for (int q = 0; q < 8; ++q) *(f32x4*)(kf + 4096 + 2 * q) = (f32x4){y[2 * q].x * scale + hbs, y[2 * q].y * scale, y[2 * q + 1].x * scale + hbs, y[2 * q + 1].y * scale};
            __syncthreads();
        }
    }
    {
        const int pr = tid >> 4, i = tid & 15;
        LAS f32x2* E = (LAS f32x2*)(lds + pr * 4352); LAS f32x2* O = E + 272;
        for (int it = blockIdx.x; it < 256; it += gridDim.x) {
            const int pb = it * 32 + pr; const int d = pb & 2047, n = (pb >> 11) & 1, j = pb >> 12;
            const float* tf = (const float*)(p.ws + WS_TAPSC) + ((size_t)j * 8192 + (size_t)(n * 2 + 0) * D + d) * 256;
            const float* tb = tf + (size_t)D * 256;
            const float adel = hy_absdelta(d); const float tscale = 1.0f / 255.0f;
            f32x2 xe[16], xo[16]; float ss = 0.f;
#pragma unroll
            for (int jj = 0; jj < 16; ++jj) { const int nn = i + 16 * jj;
                const float klo = tf[nn] * expf(-(float)nn * tscale * adel);
                const int m = 256 - nn;
                const float khi = (m < 256) ? tb[m & 255] * expf(-(float)m * tscale * adel) : 0.f;
                ss += klo * klo + khi * khi; xe[jj] = (f32x2){klo + khi, 0.f}; xo[jj] = (f32x2){klo - khi, 0.f}; }
            ss += shx(ss, 8); ss += shx(ss, 4); ss += shx(ss, 2); ss += shx(ss, 1);
            const float scale = (1.0f / sqrtf(ss + EPS)) * (1.0f / 512.0f);
            const float hbs = p.hy_bias[((size_t)j * 2 + n) * D + d] * (1.0f / 512.0f);
            fft_fwd0<16>(xe, xo, E, O, i, tw);
            __syncthreads();
            f32x2* kf = (f32x2*)(p.ws + WS_KFC) + (size_t)pb * 512 + (size_t)i * 16;
            f32x2 y[16];
            fft_fwd2(E, i, y);
#pragma unroll
            for (int q = 0; q < 8; ++q) *(f32x4*)(kf + 2 * q) = (f32x4){y[2 * q].x * scale + hbs, y[2 * q].y * scale, y[2 * q + 1].x * scale + hbs, y[2 * q + 1].y * scale};
            fft_fwd2(O, i, y);
#pragma unroll
            for (int q = 0; q < 8; ++q) *(f32x4*)(kf + 256 + 2 * q) = (f32x4){y[2 * q].x * scale + hbs, y[2 * q].y * scale, y[2 * q + 1].x * scale + hbs, y[2 * q + 1].y * scale};
            __syncthreads();
        }
    }
}

__device__ __forceinline__ float conv3_lds(const LAS h16* row, int n, float w0, float w1, float w2, float b) { return (float)row[n - 1] * w0 + (float)row[n] * w1 + (float)row[n + 1] * w2 + b; }
constexpr int ST_P = 4112, STS_P = 272;

#ifndef PROBE_CVAR
#define PROBE_CVAR 0
#endif
__device__ __forceinline__ void conv_phase(const Params& p, int jl, LAS unsigned char* lds, int pvar = 0, int cvt_layer = -1, int cvt_n = 0) {
    const int tid = tid_fresh(); const bool cv_outer = !(pvar && (PROBE_CVAR & 1)), cv_inner = !(pvar && (PROBE_CVAR & 2));
    const f32x2* tw = (const f32x2*)(p.ws + WS_TW);
    const h16* ut = (const h16*)(p.ws + WS_UT); h16* zt = (h16*)(p.ws + WS_ZT);
    const float* cw = p.hy_conv_w + (size_t)jl * 3 * D3; const float* cb = p.hy_conv_b + (size_t)jl * D3;
    {
        const int grp = tid >> 8, tau = tid & 255;
        LAS f32x2* E = (LAS f32x2*)(lds + grp * 69632); LAS f32x2* O = E + 4352; LAS h16* ST = (LAS h16*)E;
        int uit = 0; const int utrig = 4 * (((int)blockIdx.x >> 3) & 3);
        for (int unit = blockIdx.x; unit < 4096; unit += gridDim.x, ++uit) {
            if (cvt_layer >= 0 && uit == utrig) { __syncthreads(); cvt_moe_share(p, cvt_layer, blockIdx.x, cvt_n, gridDim.x, (LAS float*)lds); }
            const int ux = unit & 7, uj = unit >> 3; const int hq = uj & 1, d = (uj >> 1) * 8 + ux; const size_t col0 = (size_t)(4 * hq + 2 * grp) * 4096;
            const f32x2* kfb = (const f32x2*)(p.ws + WS_KF) + ((size_t)(jl * 2) * 2048 + d) * 8192 + (size_t)tau * 16;
            f16x8 raw[2][2][2], raw2[2][2];
#pragma unroll
            for (int sq = 0; sq < 2; ++sq)
#pragma unroll
                for (int bb = 0; bb < 2; ++bb)
#pragma unroll
                    for (int k = 0; k < 2; ++k) raw[sq][bb][k] = *(const f16x8*)(ut + (size_t)(sq * D + d) * TT + col0 + (size_t)bb * 4096 + (size_t)(tau + 256 * k) * 8);
            __syncthreads();
#pragma unroll
            for (int sq = 0; sq < 2; ++sq)
#pragma unroll
                for (int bb = 0; bb < 2; ++bb)
#pragma unroll
                    for (int k = 0; k < 2; ++k) *(LAS f16x8*)(ST + (sq * 2 + bb) * ST_P + 8 + (tau + 256 * k) * 8) = raw[sq][bb][k];
            if (tau < 4) { ST[tau * ST_P + 7] = (h16)0.f; ST[tau * ST_P + 8 + 4096] = (h16)0.f; }
            __syncthreads();
            f32x2 xin[16], gk[16], y[16];
            { const float w0 = cw[d], w1 = cw[D3 + d], w2 = cw[2 * D3 + d], bv = cb[d]; const float g0 = cw[D + d], g1 = cw[D3 + D + d], g2 = cw[2 * D3 + D + d], gb = cb[D + d];
#pragma unroll
                for (int jj = 0; jj < 16; ++jj) { const int nn = tau + 256 * jj;
                    xin[jj] = (f32x2){conv3_lds(ST + 8, nn, w0, w1, w2, bv), conv3_lds(ST + ST_P + 8, nn, w0, w1, w2, bv)};
                    gk[jj] = (f32x2){conv3_lds(ST + 2 * ST_P + 8, nn, g0, g1, g2, gb), conv3_lds(ST + 3 * ST_P + 8, nn, g0, g1, g2, gb)}; } }
            __syncthreads();
#pragma unroll 1
            for (int ord = 0; ord < 2; ++ord) {
                if (cv_outer) fft_fwd0<256>(xin, xin, E, O, tau, tw);
                const f32x2* kf = kfb + (size_t)ord * 2048 * 8192; f32x4 kfe[8], kfo[8];
                kf_load(kf, kfe);
                __syncthreads();
                if (cv_inner) fft_pass1_pair<false>(E, O, tau, tw);
                kf_load(kf + 4096, kfo);
                __syncthreads();
                if (cv_inner) { fft_mid(E, tau, kfe); fft_mid(O, tau, kfo); }
                if (ord == 0) {
#pragma unroll
                    for (int bb = 0; bb < 2; ++bb)
#pragma unroll
                        for (int k = 0; k < 2; ++k) raw2[bb][k] = *(const f16x8*)(ut + (size_t)(2 * D + d) * TT + col0 + (size_t)bb * 4096 + (size_t)(tau + 256 * k) * 8); }
                __syncthreads();
                if (cv_inner) fft_pass1_pair<true>(E, O, tau, tw);
                __syncthreads();
                if (cv_outer) fft_inv0<256>(E, O, tau, tw, y); else {
#pragma unroll
                    for (int jj = 0; jj < 16; ++jj) y[jj] = xin[jj]; }
#pragma unroll
                for (int jj = 0; jj < 16; ++jj) xin[jj] = gk[jj] * y[jj];
                if (ord == 0) {
                    __syncthreads();
#pragma unroll
                    for (int bb = 0; bb < 2; ++bb)
#pragma unroll
                        for (int k = 0; k < 2; ++k) *(LAS f16x8*)(ST + bb * ST_P + 8 + (tau + 256 * k) * 8) = raw2[bb][k];
                    if (tau < 2) { ST[tau * ST_P + 7] = (h16)0.f; ST[tau * ST_P + 8 + 4096] = (h16)0.f; }
                    __syncthreads();
                    const float g0 = cw[2 * D + d], g1 = cw[D3 + 2 * D + d], g2 = cw[2 * D3 + 2 * D + d], gb = cb[2 * D + d];
#pragma unroll
                    for (int jj = 0; jj < 16; ++jj) { const int nn = tau + 256 * jj; gk[jj] = (f32x2){conv3_lds(ST + 8, nn, g0, g1, g2, gb), conv3_lds(ST + ST_P + 8, nn, g0, g1, g2, gb)}; }
                    __syncthreads();
                }
            }
            h16* o0 = zt + (size_t)d * TT + col0; h16* o1 = o0 + 4096;
#pragma unroll
            for (int jj = 0; jj < 16; ++jj) { const int nn = tau + 256 * jj; o0[nn] = (h16)xin[jj].x; o1[nn] = (h16)xin[jj].y; }
        }
    }
    {
        const int pr = tid >> 4, i = tid & 15, c8 = pr >> 2, bp = pr & 3;
        LAS f32x2* E = (LAS f32x2*)(lds + pr * 4352); LAS f32x2* O = E + 272; LAS h16* ST = (LAS h16*)lds;
        for (int unit = blockIdx.x; unit < 256; unit += gridDim.x) {
            const int d0 = unit * 8, d = d0 + c8;
            const f32x2* kfb = (const f32x2*)(p.ws + WS_KFC) + ((size_t)(jl * 2) * 2048 + d) * 512 + (size_t)i * 16;
            f16x8 raw[3][4];
#pragma unroll
            for (int sq = 0; sq < 3; ++sq)
#pragma unroll
                for (int k = 0; k < 4; ++k) { const int q = tid + 512 * k, row = q >> 5, ch = q & 31;
                    raw[sq][k] = *(const f16x8*)(ut + (size_t)(sq * D + d0 + (row >> 3)) * TT + TL + (row & 7) * 256 + ch * 8); }
            __syncthreads();
#pragma unroll
            for (int sq = 0; sq < 2; ++sq)
#pragma unroll
                for (int k = 0; k < 4; ++k) { const int q = tid + 512 * k, row = q >> 5, ch = q & 31; *(LAS f16x8*)(ST + (sq * 64 + row) * STS_P + 8 + ch * 8) = raw[sq][k]; }
            if (tid < 128) { ST[tid * STS_P + 7] = (h16)0.f; ST[tid * STS_P + 8 + 256] = (h16)0.f; }
            __syncthreads();
            f32x2 xin[16], gk[16], y[16];
            { const float w0 = cw[d], w1 = cw[D3 + d], w2 = cw[2 * D3 + d], bv = cb[d]; const float g0 = cw[D + d], g1 = cw[D3 + D + d], g2 = cw[2 * D3 + D + d], gb = cb[D + d];
                const LAS h16* r0 = ST + (c8 * 8 + 2 * bp) * STS_P + 8; const LAS h16* r1 = r0 + 64 * STS_P;
#pragma unroll
                for (int jj = 0; jj < 16; ++jj) { const int nn = i + 16 * jj;
                    xin[jj] = (f32x2){conv3_lds(r0, nn, w0, w1, w2, bv), conv3_lds(r0 + STS_P, nn, w0, w1, w2, bv)};
                    gk[jj] = (f32x2){conv3_lds(r1, nn, g0, g1, g2, gb), conv3_lds(r1 + STS_P, nn, g0, g1, g2, gb)}; } }
            __syncthreads();
#pragma unroll 1
            for (int ord = 0; ord < 2; ++ord) {
                const f32x2* kf = kfb + (size_t)ord * 2048 * 512; f32x4 kfe[8], kfo[8];
                fft_fwd0<16>(xin, xin, E, O, i, tw);
                __syncthreads();
                kf_load(kf, kfe); fft_mid(E, i, kfe); kf_load(kf + 256, kfo); fft_mid(O, i, kfo);
                __syncthreads();
                fft_inv0<16>(E, O, i, tw, y);
#pragma unroll
                for (int jj = 0; jj < 16; ++jj) xin[jj] = gk[jj] * y[jj];
                if (ord == 0) {
                    __syncthreads();
#pragma unroll
                    for (int k = 0; k < 4; ++k) { const int q = tid + 512 * k, row = q >> 5, ch = q & 31; *(LAS f16x8*)(ST + row * STS_P + 8 + ch * 8) = raw[2][k]; }
                    if (tid < 64) { ST[tid * STS_P + 7] = (h16)0.f; ST[tid * STS_P + 8 + 256] = (h16)0.f; }
                    __syncthreads();
                    const float g0 = cw[2 * D + d], g1 = cw[D3 + 2 * D + d], g2 = cw[2 * D3 + 2 * D + d], gb = cb[2 * D + d];
                    const LAS h16* r0 = ST + (c8 * 8 + 2 * bp) * STS_P + 8;
#pragma unroll
                    for (int jj = 0; jj < 16; ++jj) { const int nn = i + 16 * jj; gk[jj] = (f32x2){conv3_lds(r0, nn, g0, g1, g2, gb), conv3_lds(r0 + STS_P, nn, g0, g1, g2, gb)}; }
                    __syncthreads();
                }
            }
            h16* o0 = zt + (size_t)d * TT + TL + (2 * bp) * 256; h16* o1 = o0 + 256;
#pragma unroll
            for (int jj = 0; jj < 16; ++jj) { const int nn = i + 16 * jj; o0[nn] = (h16)xin[jj].x; o1[nn] = (h16)xin[jj].y; }
        }
    }
}

constexpr int AT_KP = 72, AT_VP = 68;
__device__ __forceinline__ void attn_phase(const Params& p, int jl, bool with_ctx_out, LAS unsigned char* lds, int cvt_layer = -1, int cvt_n = 0) {
    const int tid = tid_fresh(), wv = tid >> 6, lane = tid & 63, r32 = lane & 31, hh = lane >> 5;
    LAS h16* Ks = (LAS h16*)lds; LAS h16* Vs = (LAS h16*)(lds + 64 * AT_KP * 2);
    const h16* qk = (const h16*)(p.ws + WS_QK); const h16* vt = (const h16*)(p.ws + WS_VT); h16* ob = (h16*)(p.ws + WS_HBUF);
    LAS float* rcos = (LAS float*)(lds + 65536); LAS float* rsin = rcos + 1024;
    { const float* rg = (const float*)(p.ws + WS_ROPE); for (int i = tid; i < 2048; i += 512) rcos[i] = rg[i]; }
    __syncthreads();
    const int nunit = 2048 + (with_ctx_out ? 128 : 0);
    int uit = 0; const int utrig = 2 * (((int)blockIdx.x >> 3) & 3);
    for (int unit = blockIdx.x; unit < nunit; unit += gridDim.x, ++uit) {
        if (cvt_layer >= 0 && uit == utrig) { __syncthreads(); cvt_moe_share(p, cvt_layer, blockIdx.x, cvt_n, gridDim.x, (LAS float*)lds); }
        int kind, b, g, qb;
        if (unit < 2048) { kind = 0; qb = unit & 63; g = (unit >> 6) & 3; b = unit >> 8; } else { const int u2 = unit - 2048; kind = 1; qb = u2 & 3; g = (u2 >> 2) & 3; b = u2 >> 4; }
        const int head = g * 8 + wv;
        const int qrow0 = kind ? (TL + b * 256 + qb * 64) : (b * 4096 + qb * 64);
        const int ctxrow0 = TL + b * 256;
        f16x8 qf[2][4];
#pragma unroll
        for (int qt = 0; qt < 2; ++qt) {
            f32x4 qv[4][2];
            const h16* qp = qk + (size_t)(qrow0 + 32 * qt + r32) * DQK + head * 64 + 8 * hh;
#pragma unroll
            for (int ks = 0; ks < 4; ++ks) { const f16x8 t = *(const f16x8*)(qp + 16 * ks);
#pragma unroll
                for (int i = 0; i < 4; ++i) { qv[ks][0][i] = (float)t[i]; qv[ks][1][i] = (float)t[4 + i]; } }
            if (kind == 0) {
                const int colpos = 32 * qt + r32;
#pragma unroll
                for (int a = 0; a < 2; ++a) { const int pos = a ? colpos : qb; const LAS float* cp = rcos + pos * 16 + 8 * hh; const LAS float* sp = rsin + pos * 16 + 8 * hh;
#pragma unroll
                    for (int e = 0; e < 2; ++e) { const f32x4 c = *(const LAS f32x4*)(cp + 4 * e), s = *(const LAS f32x4*)(sp + 4 * e);
                        const f32x4 x1 = qv[2 * a][e], x2 = qv[2 * a + 1][e]; qv[2 * a][e] = x1 * c - x2 * s; qv[2 * a + 1][e] = x2 * c + x1 * s; } }
            }
#pragma unroll
            for (int ks = 0; ks < 4; ++ks)
#pragma unroll
                for (int i = 0; i < 4; ++i) { qf[qt][ks][i] = (h16)(qv[ks][0][i] * (0.125f * 1.4426950408889634f)); qf[qt][ks][4 + i] = (h16)(qv[ks][1][i] * (0.125f * 1.4426950408889634f)); }
        }
        const float sink = p.at_sink[jl * 32 + head] * 1.4426950408889634f;
        float mrun[2] = {sink, sink}, lrun[2] = {hh == 0 ? 1.f : 0.f, hh == 0 ? 1.f : 0.f};
        f32x16 oacc[2][2];
#pragma unroll
        for (int a = 0; a < 2; ++a)
#pragma unroll
            for (int c = 0; c < 2; ++c)
#pragma unroll
                for (int i = 0; i < 16; ++i) oacc[a][c][i] = 0.f;
        const int t_lo = kind ? 0 : (qb < 2 ? 2 - qb : 0), t_hi = kind ? -1 : (65 - qb < 4 ? 65 - qb : 4); const int nwin = t_hi - t_lo + 1, nv = nwin + 4;
        const bool krole = tid < 256; const int kkey = tid >> 2, kcp = tid & 3, kdA = (kcp & 1) * 8 + (kcp >> 1) * 32; const int vdim = (tid - 256) >> 2, vkc = tid & 3;
        f16x8 ld0, ld1;
#define AT_TILE(sidx, KROW0, MASK, ROPE) do { if ((sidx) < nwin) { const int _ti = t_lo + (sidx); KROW0 = b * 4096 + qb * 64 - 128 + 64 * _ti; ROPE = true; MASK = (_ti == 0) ? 1 : (_ti == 4) ? 2 : 0; } \
            else { KROW0 = ctxrow0 + 64 * ((sidx) - nwin); ROPE = false; MASK = 0; } } while (0)
#define AT_LOAD(KROW0) do { if (krole) { const h16* kp = qk + (size_t)((KROW0) + kkey) * DQK + D + g * 64 + kdA; ld0 = *(const f16x8*)kp; ld1 = *(const f16x8*)(kp + 16); } \
            else { const h16* vp = vt + (size_t)(g * 64 + vdim) * TT + (KROW0) + 16 * vkc; ld0 = *(const f16x8*)vp; ld1 = *(const f16x8*)(vp + 8); } } while (0)
        { int kr0, mk; bool rp; AT_TILE(0, kr0, mk, rp); (void)mk; (void)rp; AT_LOAD(kr0); }
#pragma unroll 1
        for (int sx = 0; sx < nv; ++sx) {
            int krow0, mask; bool rope; AT_TILE(sx, krow0, mask, rope);
            __syncthreads();
            if (krole) {
                f16x8 o1 = ld0, o2 = ld1;
                if (rope) { const int kpos = (krow0 - b * 4096) + kkey; const int pos = (kcp >> 1) ? (kpos & 63) : (kpos >> 6);
                    const LAS float* cpp = rcos + pos * 16 + (kcp & 1) * 8; const LAS float* spp = rsin + pos * 16 + (kcp & 1) * 8;
#pragma unroll
                    for (int i = 0; i < 8; ++i) { const float c = cpp[i], s = spp[i], x1 = (float)ld0[i], x2 = (float)ld1[i]; o1[i] = (h16)(x1 * c - x2 * s); o2[i] = (h16)(x2 * c + x1 * s); } }
                *(LAS f16x8*)(Ks + kkey * AT_KP + kdA) = o1; *(LAS f16x8*)(Ks + kkey * AT_KP + kdA + 16) = o2;
            } else {
                LAS h16* dst = Vs + vdim * AT_VP + 16 * vkc;
                *(LAS f16x4*)(dst) = (f16x4){ld0[0], ld0[1], ld0[2], ld0[3]}; *(LAS f16x4*)(dst + 4) = (f16x4){ld0[4], ld0[5], ld0[6], ld0[7]};
                *(LAS f16x4*)(dst + 8) = (f16x4){ld1[0], ld1[1], ld1[2], ld1[3]}; *(LAS f16x4*)(dst + 12) = (f16x4){ld1[4], ld1[5], ld1[6], ld1[7]};
            }
            if (sx + 1 < nv) { int kr1, mk1; bool rp1; AT_TILE(sx + 1, kr1, mk1, rp1); (void)mk1; (void)rp1; AT_LOAD(kr1); }
            __syncthreads();
#pragma unroll
            for (int qt = 0; qt < 2; ++qt) {
                f32x16 sacc[2];
#pragma unroll
                for (int kt = 0; kt < 2; ++kt)
#pragma unroll
                    for (int i = 0; i < 16; ++i) sacc[kt][i] = 0.f;
#pragma unroll
                for (int ks = 0; ks < 4; ++ks)
#pragma unroll
                    for (int kt = 0; kt < 2; ++kt) { const f16x8 kf = *(const LAS f16x8*)(Ks + (32 * kt + r32) * AT_KP + 16 * ks + 8 * hh);
                        sacc[kt] = __builtin_amdgcn_mfma_f32_32x32x16_f16(kf, qf[qt][ks], sacc[kt], 0, 0, 0); }
                float tmax = -3.0e38f;
                if (mask != 0) {
                    int lim = r32 - 4 * hh; asm volatile("" : "+v"(lim));
                    if (mask == 1) {
#pragma unroll
                        for (int kt = 0; kt < 2; ++kt) {
                            if (kt < qt) {
#pragma unroll
                                for (int i = 0; i < 16; ++i) sacc[kt][i] = -1.0e30f; }
                            else if (kt == qt) {
#pragma unroll
                                for (int i = 0; i < 16; ++i) { const int kc = (i & 3) + 8 * (i >> 2); if (kc < lim) sacc[kt][i] = -1.0e30f; } } }
                    } else {
#pragma unroll
                        for (int kt = 0; kt < 2; ++kt) {
                            if (kt > qt) {
#pragma unroll
                                for (int i = 0; i < 16; ++i) sacc[kt][i] = -1.0e30f; }
                            else if (kt == qt) {
#pragma unroll
                                for (int i = 0; i < 16; ++i) { const int kc = (i & 3) + 8 * (i >> 2); if (kc > lim) sacc[kt][i] = -1.0e30f; } } }
                    } }
#pragma unroll
                for (int kt = 0; kt < 2; ++kt)
#pragma unroll
                    for (int i = 0; i < 16; ++i) tmax = fmaxf(tmax, sacc[kt][i]);
                tmax = fmaxf(tmax, shx(tmax, 32));
                const float mnew = fmaxf(mrun[qt], tmax); const float alpha = __builtin_amdgcn_exp2f(mrun[qt] - mnew); mrun[qt] = mnew;
                float psum = 0.f; f16x8 pf[2][2];
#pragma unroll
                for (int kt = 0; kt < 2; ++kt)
#pragma unroll
                    for (int s2 = 0; s2 < 2; ++s2)
#pragma unroll
                        for (int jj = 0; jj < 8; jj += 2) { const float p0 = __builtin_amdgcn_exp2f(sacc[kt][8 * s2 + jj] - mnew), p1 = __builtin_amdgcn_exp2f(sacc[kt][8 * s2 + jj + 1] - mnew);
                            const f16x2 pk = {(h16)p0, (h16)p1}; pf[kt][s2][jj] = pk[0]; pf[kt][s2][jj + 1] = pk[1];
                            psum = __builtin_amdgcn_fdot2(pk, (f16x2){(h16)1.0f, (h16)1.0f}, psum, false); }
                lrun[qt] = lrun[qt] * alpha + psum;
                if (__builtin_amdgcn_ballot_w64(alpha != 1.0f) != 0ull) {
#pragma unroll
                for (int dt = 0; dt < 2; ++dt)
#pragma unroll
                    for (int i = 0; i < 16; ++i) oacc[dt][qt][i] *= alpha; }
#pragma unroll
                for (int kt = 0; kt < 2; ++kt)
#pragma unroll
                    for (int s2 = 0; s2 < 2; ++s2)
#pragma unroll
                        for (int dt = 0; dt < 2; ++dt) { const LAS h16* vr = Vs + (32 * dt + r32) * AT_VP + 32 * kt + 16 * s2 + 4 * hh;
                            const f16x4 v0 = *(const LAS f16x4*)vr, v1 = *(const LAS f16x4*)(vr + 8);
                            const f16x8 vf = (f16x8){v0[0], v0[1], v0[2], v0[3], v1[0], v1[1], v1[2], v1[3]};
                            oacc[dt][qt] = __builtin_amdgcn_mfma_f32_32x32x16_f16(vf, pf[kt][s2], oacc[dt][qt], 0, 0, 0); }
            }
        }
#pragma unroll
        for (int qt = 0; qt < 2; ++qt) {
            const float ltot = lrun[qt] + shx(lrun[qt], 32); const float inv = 1.0f / ltot;
            h16* op = ob + (size_t)(qrow0 + 32 * qt + r32) * D + head * 64 + 4 * hh;
#pragma unroll
            for (int dt = 0; dt < 2; ++dt)
#pragma unroll
                for (int q4 = 0; q4 < 4; ++q4) { f16x4 w;
#pragma unroll
                    for (int i = 0; i < 4; ++i) w[i] = (h16)(oacc[dt][qt][4 * q4 + i] * inv);
                    *(f16x4*)(op + 32 * dt + 8 * q4) = w; }
        }
    }
}
#undef AT_TILE
#undef AT_LOAD

constexpr int NPHASE = 35;
#ifndef MK_MULTI
#define MK_MULTI 0
#endif

template <int KIND>
__attribute__((target("no-packed-fp32-ops"))) __global__ void __launch_bounds__(512, 2) hy_fwd(Params p_) {
    extern __shared__ __attribute__((aligned(16))) unsigned char shm[];
    LAS unsigned char* lds = (LAS unsigned char*)shm;
    constexpr bool ALL = KIND < 0;
    const int ph0 = p_.ph0;
    if (threadIdx.x == 0) { *(LAS u32x4*)(lds + LDS_XB) = (u32x4){0u, 0u, 0u, 0u}; }
    __syncthreads();
    XcdBarrier bar;
    if constexpr (ALL) bar = xcd_barrier_post((unsigned*)(p_.ws + WS_CTL), (volatile LAS unsigned*)(lds + LDS_XB));
#ifndef PROBE_SITE
#define PROBE_SITE -1
#endif
#define SITE(k) if constexpr (ALL || KIND == (k)) for (int rep_ = 0; rep_ < ((k) == PROBE_SITE ? 2 : 1); ++rep_) if (const Params& p = *params_fresh(); true)
#ifndef PROBE_XBAR
#define PROBE_XBAR 1
#endif
#define SEAM() do { if constexpr (ALL) { xcd_barrier(bar); if (PROBE_XBAR > 1) xcd_barrier(bar); if (PROBE_XBAR > 2) xcd_barrier(bar); } } while (0)
    const int G = gridDim.x, bid = blockIdx.x;
    SITE(0) {
        for (int u = bid; u < 4993; u += G) {
            if (u < 384) modp_unit(p, u, (LAS float*)lds);
            else if (u == 384) tables_unit(p);
            else if (u < 1473) h2_task(p, (u - 385) * 8 + (tid_fresh() >> 6));
            else if (u < 1537) w3p_unit(p, u - 1473);
            else if (u < 1793) rtab_unit(p, u - 1537);
            else cvt_dense_unit(p, u - 1793, (LAS float*)lds);
        }
        SEAM();
    }
    SITE(1) {
        for (int u = bid; u < 216; u += G) modr_unit(p, u);
        SchedFilt S{p.ws + WS_W3P, p.ws + WS_H2P}; EpiTaps E{(float*)(p.ws + WS_TAPS), (float*)(p.ws + WS_TAPSC)};
        pg8::gemm_phase<EpiTaps, SchedFilt, 0>(lds, 256, S, E);
        SEAM();
    }
#define TAIL_IDLE(nunits) (((nunits) % G) ? G - ((nunits) % G) : 0)
#define CVT_PER_GEMM 20
#pragma unroll 1
    for (int layer = ALL ? 0 : ph0; layer < (ALL ? NLAYER : ph0 + 1); ++layer) {
        const bool hyena = (layer & 1) == 0; const int jl = layer >> 1;
        const int nu1 = hyena ? 24 * 136 : 136 * 10, nu4 = (layer == NLAYER - 1 ? 128 : 136) * 8;
        const int idle1 = TAIL_IDLE(nu1), idle4 = TAIL_IDLE(nu4);
        int cv4 = idle4 * CVT_PER_GEMM, cv1 = idle1 * CVT_PER_GEMM; if (cv4 > CVT_MOE_UNITS / 2) cv4 = CVT_MOE_UNITS / 2; if (cv1 > CVT_MOE_UNITS / 2 - 1) cv1 = CVT_MOE_UNITS / 2 - 1;
        const int cvN0 = CVT_MOE_UNITS - cv1 - cv4, cvN1 = cvN0 + cv1;
        SITE(2) {
            n1_phase(p, layer, (h16*)(p.ws + ((!ALL && p.ph1) ? WS_UT : WS_XRES)));
            for (int rep2_ = 0; rep2_ < ((PROBE_SITE == 20 && layer > 0) ? 2 : 1); ++rep2_) {
            if (layer == 0) filt_fft_phase(p, lds);
            else { (void)0; } }
            SEAM();
        }
        SITE(3) {
#ifdef PROBE_CLK
            unsigned long long pc0_ = __builtin_readcyclecounter(), pr0_ = wall_clock64();
#endif
            if (hyena) { SchedPlain S{24, 136, D, p.ws + WS_WIN + (size_t)jl * D3 * D * 2, p.ws + WS_HBUF}; EpiH16 E{(h16*)(p.ws + WS_UT), TT, nullptr, 0};
                pg8::gemm_phase<EpiH16, SchedPlain, 0>(lds, D, S, E); }
            else { SchedQkv S{p.ws + WS_HBUF, p.ws + WS_WQKV + (size_t)jl * DQKV * D * 2}; EpiH16 E{(h16*)(p.ws + WS_QK), DQK, (h16*)(p.ws + WS_VT), TT};
                pg8::gemm_phase<EpiH16, SchedQkv, 0>(lds, D, S, E); }
#ifdef PROBE_CLK
            if (bid == 0 && threadIdx.x == 0) { const unsigned long long dc = __builtin_readcyclecounter() - pc0_, dr = wall_clock64() - pr0_; const unsigned long long spin = dc * 2500ull / (dr ? dr : 1ull);
                const unsigned long long t0 = wall_clock64(); while (wall_clock64() - t0 < spin) __builtin_amdgcn_s_sleep(8); }
#endif
            if (idle1 > 0 && bid >= G - idle1) { cvt_moe_share(p, layer, cvN0 + (bid - (G - idle1)), cvN1, idle1, (LAS float*)lds); }
            SEAM();
        }
        SITE(4) {
#ifdef PROBE_PAR
            for (int rep3_ = 0; rep3_ < (((layer & 1) == PROBE_PAR) ? 2 : 1); ++rep3_)
#endif
            { if (hyena) conv_phase(p, jl, lds, ALL ? 0 : p.ph1, layer, cvN0);
            else attn_phase(p, jl, layer != NLAYER - 1, lds, layer, cvN0); }
            SEAM();
        }
        SITE(5) {
            (void)0;
        }
        SITE(6) {
            EpiResid E{(h16*)(p.ws + WS_XRES), (const float*)(p.ws + WS_MODS), layer, (float*)(p.ws + WS_SSQ), (!ALL && p.ph1) ? (h16*)(p.ws + WS_YC) : (h16*)(p.ws + WS_XRES)};
            if (hyena) {
                SchedPlainAT S{layer == NLAYER - 1 ? 128 : 136, 8, D, p.ws + WS_ZT, p.ws + WS_WOUT + (size_t)jl * D * D * 2};
                pg8::gemm_phase<EpiResid, SchedPlainAT, 2>(lds, D, S, E, TT);
            } else {
                SchedPlain S{layer == NLAYER - 1 ? 128 : 136, 8, D, p.ws + WS_HBUF, p.ws + WS_WO + (size_t)jl * D * D * 2};
                pg8::gemm_phase<EpiResid, SchedPlain, 0>(lds, D, S, E);
            }
            if (idle4 > 0 && bid >= G - idle4) { cvt_moe_share(p, layer, cvN1 + (bid - (G - idle4)), CVT_MOE_UNITS, idle4, (LAS float*)lds); }
            SEAM();
        }
        SITE(7) { n2_phase(p, layer, lds, ALL ? 0 : p.ph1); SEAM(); }
        LAS int* tstart = (LAS int*)(lds + LDS_MISC); LAS int* texp = tstart + 80; LAS int* tcnt = texp + 352;
        SITE(8) {
            moe_table(tstart, texp, tcnt, (const int*)(p.ws + WS_CTL) + CTL_CNT + layer * NE);
            SchedMoe1 S{{tstart, texp, tcnt}, p.ws + WS_HBUF, p.ws + WS_W13, (const int*)(p.ws + WS_LIST)}; EpiMoe1 E{(h16*)(p.ws + WS_H1)};
            pg8::gemm_phase<EpiMoe1, SchedMoe1, 1>(lds, D, S, E);
            SEAM();
        }
        SITE(9) {
            moe_table(tstart, texp, tcnt, (const int*)(p.ws + WS_CTL) + CTL_CNT + layer * NE);
            SchedMoe2 S{{tstart, texp, tcnt}, p.ws + WS_H1, p.ws + WS_W2, (const int*)(p.ws + WS_LIST)}; EpiMoe2 E{(h16*)(p.ws + WS_YC), (const float*)(p.ws + WS_GATE), (const int*)(p.ws + WS_LIST)};
            pg8::gemm_phase<EpiMoe2, SchedMoe2, 0>(lds, DE, S, E);
            SEAM();
        }
    }
    SITE(10) final_phase(p);
#undef SITE
#undef SEAM
}

template <int KIND> static void launch_kind(const Params& p, int grid, hipStream_t stream) {
    static bool attr = false;
    if (!attr) { attr = true; if (hipFuncSetAttribute((const void*)hy_fwd<KIND>, hipFuncAttributeMaxDynamicSharedMemorySize, LDS_BYTES) != hipSuccess) fprintf(stderr, "kernel_launch: hipFuncSetAttribute failed (kind %d)\n", KIND); }
    hipLaunchKernelGGL(hy_fwd<KIND>, dim3(grid), dim3(512), LDS_BYTES, stream, p);
}

extern "C" void kernel_launch(void* const* d_in, const int* in_sizes, int n_in, void* d_out, int out_size, void* d_ws, size_t ws_size, hipStream_t stream) {
    static int grid = 0;
    if (!grid) {
        if (n_in != 29 || out_size != TL * D || ws_size < WS_END) { fprintf(stderr, "kernel_launch: unexpected problem (n_in %d, out %d, ws %zu < %zu)\n", n_in, out_size, ws_size, (size_t)WS_END); grid = -1; return; }
        int dev = 0, cus = 0;
        if (hipGetDevice(&dev) != hipSuccess || hipDeviceGetAttribute(&cus, hipDeviceAttributeMultiprocessorCount, dev) != hipSuccess) { grid = -1; return; }
        grid = cus;
    }
    if (grid <= 0) return;
    (void)hipMemsetAsync((char*)d_ws + WS_CTL, 0, CTL_BYTES, stream);
    Params p{};
    const float** pp = (const float**)&p;
    for (int i = 0; i < 29; ++i) pp[i] = (const float*)d_in[i];
    p.out = (float*)d_out; p.ws = (char*)d_ws;
#if MK_MULTI
    p.ph0 = 0; p.ph1 = 0;
    launch_kind<0>(p, grid, stream); launch_kind<1>(p, grid, stream);
#ifndef PROBE_KINDS
#define PROBE_KINDS 0
#endif
#ifndef PROBE_VAR
#define PROBE_VAR 0
#endif
#ifndef PROBE_LAYERS
#define PROBE_LAYERS 15
#endif
#define PKIND(k) ((PROBE_KINDS >> (k)) & 1)
#define PREP(k) ((PKIND(k) && ((PROBE_LAYERS >> layer) & 1)) ? 2 : 1)
    if (PKIND(0)) launch_kind<0>(p, grid, stream);
    if (PKIND(1)) launch_kind<1>(p, grid, stream);
    for (int layer = 0; layer < NLAYER; ++layer) { p.ph0 = layer;
        for (int r = 0; r < PREP(2); ++r) { p.ph1 = (PREP(2) == 2 && r == 0) ? 1 : 0; launch_kind<2>(p, grid, stream); p.ph1 = 0; }
        for (int r = 0; r < PREP(3); ++r) { p.ph1 = (PREP(3) == 2 && r == 0) ? PROBE_VAR : 0; launch_kind<3>(p, grid, stream); p.ph1 = 0; }
        for (int r = 0; r < PREP(4); ++r) { p.ph1 = (PREP(4) == 2 && r == 0) ? 1 : 0; launch_kind<4>(p, grid, stream); p.ph1 = 0; }
        if (PREP(6) == 2) { p.ph1 = 1; launch_kind<6>(p, grid, stream); p.ph1 = 0; }
        launch_kind<6>(p, grid, stream); launch_kind<7>(p, grid, stream);
        if (PREP(7) == 2) { p.ph1 = 1; launch_kind<7>(p, grid, stream); p.ph1 = 0; }
        for (int r = 0; r < PREP(8); ++r) launch_kind<8>(p, grid, stream);
        for (int r = 0; r < PREP(9); ++r) launch_kind<9>(p, grid, stream); }
    p.ph0 = 0; launch_kind<10>(p, grid, stream);
    if (PKIND(10)) launch_kind<10>(p, grid, stream);
#else
    p.ph0 = 0; p.ph1 = NPHASE;
    launch_kind<-1>(p, grid, stream);
#endif
}
```

```cpp
#include <hip/hip_runtime.h>
#include <cstdio>
#include <cstdint>

#define LAS __attribute__((address_space(3)))
typedef _Float16 h16;
typedef _Float16 f16x8 __attribute__((ext_vector_type(8)));
typedef _Float16 f16x4 __attribute__((ext_vector_type(4)));
typedef _Float16 f16x2 __attribute__((ext_vector_type(2)));
typedef float f32x2 __attribute__((ext_vector_type(2)));
typedef float f32x4 __attribute__((ext_vector_type(4)));
typedef float f32x16 __attribute__((ext_vector_type(16)));
typedef unsigned u32x2 __attribute__((ext_vector_type(2)));
typedef unsigned u32x4 __attribute__((ext_vector_type(4)));

constexpr int D = 2048, NB = 8, SEQ = 4096, CTXL = 256, TL = NB * SEQ, TC = NB * CTXL, TT = TL + TC;
constexpr int D3 = 3 * D, D6 = 6 * D, DQK = 2304, DQKV = 2560, NE = 64, DE = 384, DE2 = 768, NLAYER = 4;
constexpr int LCAP = TT;
constexpr int MOE_ROWS = 86016;
constexpr float EPS = 1e-6f;

constexpr size_t WS_CTL = 0;
constexpr size_t CTL_BYTES = 65536;
constexpr size_t WS_TW = WS_CTL + CTL_BYTES;
constexpr size_t WS_ROPE = WS_TW + 65536;
constexpr size_t WS_MODP = WS_ROPE + 8192;
constexpr size_t WS_MODS = WS_MODP + 16ull * 4 * 9 * 12288 * 4;
constexpr size_t WS_RTAB = WS_MODS + 4ull * 9 * 12288 * 4;
constexpr size_t RTAB_L = 64ull * 5 * 2 * 64 * 8 * 2;
constexpr size_t WS_RCST = WS_RTAB + 4 * RTAB_L;
constexpr size_t WS_H2P = WS_RCST + 16384;
constexpr size_t WS_W3P = WS_H2P + 2ull * 4352 * 256 * 2;
constexpr size_t WS_XRES = WS_W3P + 2ull * 8192 * 256 * 2;
constexpr size_t WS_HBUF = WS_XRES + (size_t)TT * D * 4;
constexpr size_t WS_UT = WS_HBUF + (size_t)TT * D * 2;
constexpr size_t UT_BYTES = (size_t)D3 * TT * 2;
constexpr size_t WS_TAPS = WS_UT;
constexpr size_t WS_TAPSC = WS_TAPS + 2ull * 8192 * 4096 * 4;
constexpr size_t WS_QK = WS_UT;
constexpr size_t WS_VT = WS_QK + (size_t)TT * DQK * 2;
constexpr size_t WS_ZT = WS_UT + UT_BYTES;
constexpr size_t WS_H1 = WS_ZT + (size_t)D * TT * 2;
constexpr size_t WS_YC = WS_H1 + (size_t)MOE_ROWS * DE * 2;
constexpr size_t WS_WIN = WS_YC + 2ull * TT * D * 2;
constexpr size_t WS_WOUT = WS_WIN + 2ull * D3 * D * 2;
constexpr size_t WS_WQKV = WS_WOUT + 2ull * D * D * 2;
constexpr size_t WS_WO = WS_WQKV + 2ull * DQKV * D * 2;
constexpr size_t WS_W13 = WS_WO + 2ull * D * D * 2;
constexpr size_t WS_W2 = WS_W13 + (size_t)NE * DE2 * D * 2;
constexpr size_t WS_KF = WS_W2 + (size_t)NE * D * DE * 2;
constexpr size_t WS_KFC = WS_KF + 2ull * 2 * 2048 * 65536;
constexpr size_t WS_LIST = WS_KFC + 2ull * 2 * 2048 * 4096;
constexpr size_t WS_GATE = WS_LIST + (size_t)NE * LCAP * 4;
constexpr size_t WS_SSQ = WS_GATE + (size_t)NE * LCAP * 4;
constexpr size_t WS_END = WS_SSQ + (size_t)TT * 32 * 4;
static_assert(WS_TAPSC + 2ull * 8192 * 256 * 4 <= WS_UT + UT_BYTES, "taps alias");
static_assert(WS_VT + 256ull * TT * 2 <= WS_UT + UT_BYTES, "qkv alias");

constexpr int CTL_CNT = 4096;

constexpr int LDS_BYTES = 147456;
constexpr int LDS_MISC = 139264;
constexpr int LDS_XB = LDS_BYTES - 16;

struct Params {
    const float *x, *c, *ctx, *c_ctx, *mod_w, *mod_b, *hy_w_in, *hy_conv_w, *hy_conv_b, *hy_f_w1, *hy_f_b1, *hy_f_freq1, *hy_f_w2, *hy_f_b2, *hy_f_freq2, *hy_f_w3,
        *hy_bias, *hy_w_out, *at_w_qkv, *at_sink, *at_w_o, *moe_wg, *moe_bg, *moe_we, *moe_be, *moe_w1, *moe_w3, *moe_w2, *final_gain;
    float* out; char* ws; int ph0, ph1;
};

__device__ __forceinline__ int tid_fresh() { int t = threadIdx.x; asm volatile("" : "+v"(t)); return t; }
__device__ __forceinline__ float bperm_f(float v, int srclane) { return __int_as_float(__builtin_amdgcn_ds_bpermute(srclane << 2, __float_as_int(v))); }
__device__ __forceinline__ float shx(float v, int mask) { return bperm_f(v, (tid_fresh() & 63) ^ mask); }
__device__ __forceinline__ const Params* params_fresh() { auto q = __builtin_amdgcn_kernarg_segment_ptr(); asm volatile("" : "+s"(q)); return (const Params*)q; }

#define XB_TMO      128
#define XB_XCNT(j)  (256  + 64 * (j))
#define XB_XSUB(j)  (1280 + 64 * (j))
#define XB_XGEN(j)  (2304 + 64 * (j))
#define XB_TOP      3328
#define XB_TOPGEN   3392
#define XCD_BAR_WORDS 3456
#define XB_SPIN_CAP (1u << 18)

__device__ __forceinline__ unsigned xb_ld(unsigned* p)              { return __hip_atomic_load(p, __ATOMIC_RELAXED, __HIP_MEMORY_SCOPE_AGENT); }
__device__ __forceinline__ unsigned xb_add(unsigned* p, unsigned v) { return __hip_atomic_fetch_add(p, v, __ATOMIC_RELAXED, __HIP_MEMORY_SCOPE_AGENT); }
__device__ __forceinline__ unsigned xb_xcc_id() { return (unsigned)__builtin_amdgcn_s_getreg((3 << 11) | 20) & 0xFu; }
#define XB_SPIN(cond, bar) do { unsigned _sp = 0; while (cond) { __builtin_amdgcn_s_sleep(1); \
    if ((++_sp & 255u) == 0u) { if (xb_ld(&(bar)[XB_TMO])) break; if (_sp > XB_SPIN_CAP) { atomicAdd(&(bar)[XB_TMO], 1u); break; } } } } while (0)

struct XcdBarrier { unsigned* bar; volatile LAS unsigned* st; };

__device__ __forceinline__ XcdBarrier xcd_barrier_post(unsigned* bar, volatile LAS unsigned* st) {
    XcdBarrier b; b.bar = bar; b.st = st;
    if (threadIdx.x == 0) (void)xb_add(&bar[XB_XCNT(xb_xcc_id())], 1u);
    return b;
}
__device__ __forceinline__ void xcd_barrier_complete(unsigned* bar, unsigned x, unsigned& nloc, unsigned& nx) {
    const unsigned G = gridDim.x * gridDim.y * gridDim.z;
    unsigned sum, cnt, mine, sp = 0u;
    for (;;) {
        sum = 0u; cnt = 0u; mine = 0u;
#pragma unroll
        for (unsigned j = 0; j < 16; ++j) { const unsigned c = xb_ld(&bar[XB_XCNT(j)]); sum += c; cnt += (c > 0u) ? 1u : 0u; mine = (j == x) ? c : mine; }
        if (sum == G) break;
        __builtin_amdgcn_s_sleep(1);
        if ((++sp & 255u) == 0u) { if (xb_ld(&bar[XB_TMO])) break; if (sp > XB_SPIN_CAP) { atomicAdd(&bar[XB_TMO], 1u); break; } }
    }
    nloc = mine > 0u ? mine : 1u; nx = cnt > 0u ? cnt : 1u;
}
__device__ __forceinline__ void xcd_barrier(const XcdBarrier& b) {
    asm volatile("s_waitcnt vmcnt(0)" ::: "memory");
    __syncthreads();
    if (threadIdx.x == 0) {
        unsigned* bar = b.bar; const unsigned bx = xb_xcc_id();
        __builtin_amdgcn_s_waitcnt(0);
        unsigned nloc = b.st[0], nx = b.st[1];
        if (nloc == 0u) { xcd_barrier_complete(bar, bx, nloc, nx); b.st[0] = nloc; b.st[1] = nx; }
        const unsigned old = xb_add(&bar[XB_XSUB(bx)], 1u);
        const unsigned gen = old / nloc;
        if (old + 1u == (gen + 1u) * nloc) {
            __builtin_amdgcn_fence(__ATOMIC_RELEASE, "agent");
            asm volatile("s_waitcnt vmcnt(0)" ::: "memory");
            const unsigned og = xb_add(&bar[XB_TOP], 1u);
            const unsigned tg = og / nx;
            if (og + 1u == (tg + 1u) * nx) xb_add(&bar[XB_TOPGEN], 1u);
            else XB_SPIN(xb_ld(&bar[XB_TOPGEN]) == tg, bar);
            __builtin_amdgcn_fence(__ATOMIC_ACQUIRE, "agent");
            xb_add(&bar[XB_XGEN(bx)], 1u);
            asm volatile("s_waitcnt vmcnt(0)" ::: "memory");
        } else {
            XB_SPIN(xb_ld(&bar[XB_XGEN(bx)]) == gen, bar);
            __builtin_amdgcn_fence(__ATOMIC_ACQUIRE, "agent");
            asm volatile("s_waitcnt vmcnt(0)" ::: "memory");
        }
    }
    __syncthreads();
}

namespace pg8 {
constexpr int BM = 256, BK = 64, HALF = 128, HTB = HALF * BK * 2, STAGE_BYTES = 8 * HTB;
__device__ __forceinline__ int lds_byte(int r, int c) { const int st = (r >> 4) * 2 + (c >> 5), rr = r & 15, cc = c & 31, ob = rr * 64 + cc * 2; return st * 1024 + (ob ^ (((ob >> 9) & 1) << 5)); }
__device__ __forceinline__ void stage_rc(int b, int& R, int& C) { const int st = b / 1024, sb = b % 1024, swz = sb ^ (((sb >> 9) & 1) << 5); R = (st >> 1) * 16 + swz / 64; C = (st & 1) * 32 + (swz % 64) / 2; }
__device__ __forceinline__ int perm32(int rho) { const int n = rho >> 4, i = rho & 15; return 8 * (i >> 2) + 4 * n + (i & 3); }

struct Unit {
    int pm, pn;
    int e, pos0, cnt;
    int kind;
    int half;
    const char* A; const char* B;
    const int* rows;
};

typedef short s16x4 __attribute__((ext_vector_type(4)));
template <class Epi, class Sched, int AMODE>
__device__ __forceinline__ void gemm_phase(LAS unsigned char* lds, const int K, const Sched& S, const Epi& E, const int ldat = 0) {
    constexpr bool GATHER = AMODE == 1, ATR = AMODE == 2;
    const int tid = tid_fresh(), wid = __builtin_amdgcn_readfirstlane(tid >> 6), lane = tid & 63, wr = wid >> 2, wc = wid & 3, fr = lane & 15, fq = lane >> 4;
    const int nt = K / BK;
    unsigned voffA[2], voffB[2]; int RA[2], CA[2];
#pragma unroll
    for (int i = 0; i < 2; ++i) { int R, C; stage_rc(tid * 16 + i * 8192, R, C); const int Rb = Epi::PERM ? ((R & ~31) + perm32(R & 31)) : R;
        voffA[i] = (unsigned)(R * K + C) * 2u; voffB[i] = (unsigned)(Rb * K + C) * 2u; RA[i] = R; CA[i] = C;
        if constexpr (ATR) { const int bb = tid * 16 + i * 8192, row = bb >> 8, pc = (bb >> 4) & 15, ch = pc ^ (((row & 3) << 2) | ((row >> 2) & 3)); voffA[i] = (unsigned)(row * ldat + 8 * ch) * 2u; } }
    const size_t kstep = (size_t)(BK * 2);
    const size_t hstep = (size_t)HALF * K * 2;
    const size_t kstepA = ATR ? (size_t)BK * ldat * 2 : kstep, hstepA = ATR ? (size_t)HALF * 2 : hstep;
    const unsigned ldsw = (unsigned)wid * 1024u;
    const int aoff = lds_byte(wr * 64 + fr, fq * 8), boff = lds_byte(wc * 32 + fr, fq * 8);
    int atr[4][2];
#pragma unroll
    for (int m = 0; m < 4; ++m)
#pragma unroll
        for (int bl = 0; bl < 2; ++bl) { const int xr = ((fr >> 2) << 2) | ((2 * fq + bl) & 3); atr[m][bl] = (int)(unsigned)(uintptr_t)lds + 256 * (8 * fq + (fr >> 2) + 4 * bl) + 16 * ((wr * 8 + 2 * m + ((fr & 3) >> 1)) ^ xr) + 8 * (fr & 1); }
    unsigned vgC[2][2], vgN[2][2];
#define PG8_ROWS(u, vg) do { if constexpr (GATHER) { _Pragma("unroll") for (int _h = 0; _h < 2; ++_h) _Pragma("unroll") for (int _i = 0; _i < 2; ++_i) { \
        const int _p = (u).pos0 + _h * HALF + RA[_i]; const int _tok = (_p < (u).cnt) ? ((u).rows[_h * HALF + RA[_i]] >> 1) : 0; \
        vg[_h][_i] = ((unsigned)_tok * (unsigned)K + (unsigned)CA[_i]) * 2u; } } } while (0)
#define PG8_SA(b, h) (((b) * 2 + (h)) * HTB)
#define PG8_SB(b, h) ((4 + (b) * 2 + (h)) * HTB)
#define PG8_STAGE_B(bufoff, gbase) do { _Pragma("unroll") for (int _i = 0; _i < 2; ++_i) \
        __builtin_amdgcn_global_load_lds((const unsigned*)((const char*)(gbase) + voffB[_i]), (LAS unsigned*)(lds + (bufoff) + ldsw + _i * 8192), 16, 0, 0); } while (0)
#define PG8_STAGE_A(bufoff, gbase, h, NEXT) do { _Pragma("unroll") for (int _i = 0; _i < 2; ++_i) { \
        const unsigned _vo = GATHER ? ((NEXT) ? vgN[h][_i] : vgC[h][_i]) : voffA[_i]; \
        __builtin_amdgcn_global_load_lds((const unsigned*)((const char*)(gbase) + (GATHER ? (size_t)0 : (size_t)(h) * hstepA) + _vo), (LAS unsigned*)(lds + (bufoff) + ldsw + _i * 8192), 16, 0, 0); } } while (0)
#define PG8_LDA(dst, b, h) do { if constexpr (!ATR) { _Pragma("unroll") for (int m = 0; m < 4; ++m) _Pragma("unroll") for (int k = 0; k < 2; ++k) dst[m][k] = *(const LAS f16x8*)(lds + PG8_SA(b, h) + aoff + m * 2048 + k * 1024); } \
        else { _Pragma("unroll") for (int m = 0; m < 4; ++m) _Pragma("unroll") for (int k = 0; k < 2; ++k) { s16x4 _lo, _hi; \
            asm volatile("ds_read_b64_tr_b16 %0, %1 offset:%2" : "=v"(_lo) : "v"(atr[m][0]), "i"(PG8_SA(b, h) + k * 8192) : "memory"); \
            asm volatile("ds_read_b64_tr_b16 %0, %1 offset:%2" : "=v"(_hi) : "v"(atr[m][1]), "i"(PG8_SA(b, h) + k * 8192) : "memory"); \
            const short __attribute__((ext_vector_type(8))) _v = {_lo[0], _lo[1], _lo[2], _lo[3], _hi[0], _hi[1], _hi[2], _hi[3]}; dst[m][k] = __builtin_bit_cast(f16x8, _v); } } } while (0)
#define PG8_PIN(At) do { if constexpr (ATR) asm volatile("" : "+v"(At[0][0]), "+v"(At[0][1]), "+v"(At[1][0]), "+v"(At[1][1]), "+v"(At[2][0]), "+v"(At[2][1]), "+v"(At[3][0]), "+v"(At[3][1])); } while (0)
#define PG8_LDB(dst, b, h) do { _Pragma("unroll") for (int n = 0; n < 2; ++n) _Pragma("unroll") for (int k = 0; k < 2; ++k) dst[n][k] = *(const LAS f16x8*)(lds + PG8_SB(b, h) + boff + n * 2048 + k * 1024); } while (0)
#define PG8_MMA(ai, bj, At, Bt) do { __builtin_amdgcn_s_setprio(1); _Pragma("unroll") for (int m = 0; m < 4; ++m) _Pragma("unroll") for (int n = 0; n < 2; ++n) _Pragma("unroll") for (int k = 0; k < 2; ++k) \
        acc[ai][bj][m][n] = __builtin_amdgcn_mfma_f32_16x16x32_f16(Bt[n][k], At[m][k], acc[ai][bj][m][n], 0, 0, 0); __builtin_amdgcn_s_setprio(0); } while (0)
#define PG8_WAIT_V(n) asm volatile("s_waitcnt vmcnt(" #n ")" ::: "memory")
#define PG8_WAIT_L(n) asm volatile("s_waitcnt lgkmcnt(" #n ")" ::: "memory")
#define PG8_BAR __builtin_amdgcn_s_barrier()
#define PG8_SCHED __builtin_amdgcn_sched_barrier(0)
    Unit cur, nxt; int ui = 0;
    if (!S.next(0, cur)) return;
    f32x4 acc[2][2][4][2];
#pragma unroll
    for (int a = 0; a < 2; ++a)
#pragma unroll
        for (int b = 0; b < 2; ++b)
#pragma unroll
            for (int m = 0; m < 4; ++m)
#pragma unroll
                for (int n = 0; n < 2; ++n) acc[a][b][m][n] = (f32x4){0.f, 0.f, 0.f, 0.f};
    f16x8 At[4][2], B0[2][2], B1[2][2];
    const char* cA = cur.A; const char* cB = cur.B;
    PG8_ROWS(cur, vgC);
#pragma unroll
    for (int _h = 0; _h < 2; ++_h)
#pragma unroll
        for (int _i = 0; _i < 2; ++_i) vgN[_h][_i] = GATHER ? vgC[_h][_i] : 0u;
    PG8_STAGE_B(PG8_SB(0, 0), cB); PG8_STAGE_B(PG8_SB(0, 1), cB + hstep); PG8_STAGE_A(PG8_SA(0, 0), cA, 0, false); PG8_STAGE_A(PG8_SA(0, 1), cA, 1, false);
    if (wr == 1) PG8_BAR;
    PG8_WAIT_V(2); PG8_BAR;
    PG8_STAGE_B(PG8_SB(1, 0), cB + kstep); PG8_STAGE_A(PG8_SA(1, 0), cA + kstepA, 0, false); PG8_STAGE_B(PG8_SB(1, 1), cB + hstep + kstep);
    PG8_WAIT_V(6); PG8_BAR;
    for (;;) {
        const bool has_next = S.next(ui + 1, nxt);
        const bool full = cur.half == 0;
        const char* nA = has_next ? nxt.A : cA; const char* nB = has_next ? nxt.B : cB;
        if (has_next) { PG8_ROWS(nxt, vgN); }
        typename Epi::Pre pre; E.prefetch(cur, wr, fr, pre);
#pragma unroll 1
        for (int t = 0; t < nt; t += 2) {
            const bool last = (t == nt - 2);
            const char* a1 = cA + (size_t)(t + 1) * kstepA;
            const char* a2 = last ? nA : cA + (size_t)(t + 2) * kstepA; const char* b2 = last ? nB : cB + (size_t)(t + 2) * kstep;
            const char* a3 = a2 + kstepA; const char* b3 = b2 + kstep;
            PG8_LDB(B0, 0, 0); PG8_LDB(B1, 0, 1); PG8_SCHED; PG8_LDA(At, 0, 0); PG8_STAGE_A(PG8_SA(1, 1), a1, 1, false);
            PG8_WAIT_V(8); PG8_WAIT_L(0); PG8_PIN(At); PG8_BAR; PG8_MMA(0, 0, At, B0); PG8_MMA(0, 1, At, B1); PG8_BAR; PG8_SCHED;
            PG8_LDA(At, 0, 1); PG8_STAGE_B(PG8_SB(0, 0), b2); PG8_STAGE_B(PG8_SB(0, 1), b2 + hstep); PG8_STAGE_A(PG8_SA(0, 0), a2, 0, last);
            PG8_WAIT_V(8); PG8_WAIT_L(0); PG8_PIN(At); PG8_BAR; if (full) { PG8_MMA(1, 0, At, B0); PG8_MMA(1, 1, At, B1); } PG8_BAR; PG8_SCHED;
            PG8_LDB(B0, 1, 0); PG8_LDB(B1, 1, 1); PG8_SCHED; PG8_LDA(At, 1, 0); PG8_STAGE_A(PG8_SA(0, 1), a2, 1, last);
            PG8_WAIT_V(8); PG8_WAIT_L(0); PG8_PIN(At); PG8_BAR; PG8_MMA(0, 0, At, B0); PG8_MMA(0, 1, At, B1); PG8_BAR; PG8_SCHED;
            PG8_LDA(At, 1, 1); PG8_STAGE_B(PG8_SB(1, 0), b3); PG8_STAGE_B(PG8_SB(1, 1), b3 + hstep); PG8_STAGE_A(PG8_SA(1, 0), a3, 0, last);
            PG8_WAIT_V(8); PG8_WAIT_L(0); PG8_PIN(At); PG8_BAR; if (full) { PG8_MMA(1, 0, At, B0); PG8_MMA(1, 1, At, B1); } PG8_BAR; PG8_SCHED;
        }
        if (wr == 0) PG8_BAR;
        E(acc, cur, wr, wc, fr, fq, pre);
        if (!has_next) break;
#pragma unroll
        for (int a = 0; a < 2; ++a)
#pragma unroll
            for (int b = 0; b < 2; ++b)
#pragma unroll
                for (int m = 0; m < 4; ++m)
#pragma unroll
                    for (int n = 0; n < 2; ++n) acc[a][b][m][n] = (f32x4){0.f, 0.f, 0.f, 0.f};
        cur = nxt; cA = nA; cB = nB; ++ui;
#pragma unroll
        for (int _h = 0; _h < 2; ++_h)
#pragma unroll
            for (int _i = 0; _i < 2; ++_i) vgC[_h][_i] = vgN[_h][_i];
        if (wr == 1) PG8_BAR;
    }
    PG8_WAIT_V(0);
    PG8_BAR;
#undef PG8_ROWS
#undef PG8_SA
#undef PG8_SB
#undef PG8_STAGE_A
#undef PG8_STAGE_B
#undef PG8_LDA
#undef PG8_LDB
#undef PG8_PIN
#undef PG8_MMA
#undef PG8_WAIT_V
#undef PG8_WAIT_L
#undef PG8_BAR
#undef PG8_SCHED
}
}

using pg8::Unit;
__device__ __forceinline__ f16x8 pack8(const f32x4 a, const f32x4 b) {
    f16x8 w; w[0] = (h16)a[0]; w[1] = (h16)a[1]; w[2] = (h16)a[2]; w[3] = (h16)a[3]; w[4] = (h16)b[0]; w[5] = (h16)b[1]; w[6] = (h16)b[2]; w[7] = (h16)b[3]; return w;
}
struct EpiH16 {
    static constexpr bool PERM = true;
    h16* O0; int ld0; h16* O1; int ld1;
    struct Pre {}; __device__ __forceinline__ void prefetch(const Unit&, int, int, Pre&) const {}
    __device__ __forceinline__ void operator()(const f32x4 (&acc)[2][2][4][2], const Unit& u, int wr, int wc, int fr, int fq, const Pre&) const {
        h16* base = u.kind ? O1 : O0; const int ld = u.kind ? ld1 : ld0;
        const int row0 = u.pm * 256 + wr * 64 + fr, col0 = u.pn * 256 + wc * 32 + 8 * fq;
#pragma unroll
        for (int ai = 0; ai < 2; ++ai)
#pragma unroll
            for (int m = 0; m < 4; ++m) { h16* rowp = base + (size_t)(row0 + ai * 128 + m * 16) * ld + col0;
#pragma unroll
                for (int bj = 0; bj < 2; ++bj) __builtin_nontemporal_store(pack8(acc[ai][bj][m][0], acc[ai][bj][m][1]), (f16x8*)(rowp + bj * 128)); }
    }
};
struct EpiTaps {
    static constexpr bool PERM = false;
    float* T0; float* T1;
    struct Pre {}; __device__ __forceinline__ void prefetch(const Unit&, int, int, Pre&) const {}
    __device__ __forceinline__ void operator()(const f32x4 (&acc)[2][2][4][2], const Unit& u, int wr, int wc, int fr, int fq, const Pre&) const {
        const int j = u.kind >> 1, v = u.kind & 1; const int ld = v ? 256 : 4096;
        float* base = v ? (T1 + (size_t)j * 8192 * 256) : (T0 + (size_t)j * 8192 * 4096);
        const int row0 = u.pm * 256 + wr * 64 + fr, col0 = u.pn * 256 + wc * 32 + 4 * fq;
#pragma unroll
        for (int ai = 0; ai < 2; ++ai)
#pragma unroll
            for (int m = 0; m < 4; ++m) { float* rowp = base + (size_t)(row0 + ai * 128 + m * 16) * ld + col0;
#pragma unroll
                for (int bj = 0; bj < 2; ++bj)
#pragma unroll
                    for (int n = 0; n < 2; ++n) *(f32x4*)(rowp + bj * 128 + n * 16) = acc[ai][bj][m][n]; }
    }
};
struct EpiResid {
    static constexpr bool PERM = true;
    h16* X; const float* mods; int layer; float* SSQ; h16* XO;
    struct Pre {}; __device__ __forceinline__ void prefetch(const Unit&, int, int, Pre&) const {}
    __device__ __forceinline__ void operator()(const f32x4 (&acc)[2][2][4][2], const Unit& u, int wr, int wc, int fr, int fq, const Pre&) const {
        const int r0 = u.pm * 256; const int b = r0 < TL ? (r0 >> 12) : 8;
        const float* g = mods + ((size_t)(layer * 9 + b) * 6 + 2) * D;
        const int row0 = r0 + wr * 64 + fr, col0 = u.pn * 256 + wc * 32 + 8 * fq;
        f32x4 gv[2][2];
#pragma unroll
        for (int bj = 0; bj < 2; ++bj)
#pragma unroll
            for (int n = 0; n < 2; ++n) gv[bj][n] = *(const f32x4*)(g + col0 + bj * 128 + n * 4);
#pragma unroll
        for (int ai = 0; ai < 2; ++ai)
#pragma unroll
            for (int m = 0; m < 4; ++m) { const int row = row0 + ai * 128 + m * 16; const h16* rowp = X + (size_t)row * D + col0; h16* rowo = XO + (size_t)row * D + col0; float sq = 0.f;
#pragma unroll
                for (int bj = 0; bj < 2; ++bj) { const f16x8 xv = *(const f16x8*)(rowp + bj * 128); f32x4 v0, v1;
#pragma unroll
                    for (int i = 0; i < 4; ++i) { v0[i] = (float)xv[i] + gv[bj][0][i] * acc[ai][bj][m][0][i]; v1[i] = (float)xv[4 + i] + gv[bj][1][i] * acc[ai][bj][m][1][i]; }
                    const f16x8 w = pack8(v0, v1); *(f16x8*)(rowo + bj * 128) = w;
#pragma unroll
                    for (int i = 0; i < 8; ++i) { const float t = (float)w[i]; sq += t * t; } }
                sq += shx(sq, 16); sq += shx(sq, 32);
                if (fq == 0) SSQ[(size_t)row * 32 + u.pn * 4 + wc] = sq; }
    }
};
struct EpiMoe1 {
    static constexpr bool PERM = true;
    h16* H1;
    struct Pre {}; __device__ __forceinline__ void prefetch(const Unit&, int, int, Pre&) const {}
    __device__ __forceinline__ void operator()(const f32x4 (&acc)[2][2][4][2], const Unit& u, int wr, int wc, int fr, int fq, const Pre&) const {
        const int row0 = u.pm * 256 + wr * 64 + fr, col0 = u.pn * 128 + wc * 16 + 4 * fq;
#pragma unroll
        for (int ai = 0; ai < 2; ++ai)
#pragma unroll
            for (int m = 0; m < 4; ++m) { if (ai == 1 && u.half) continue; h16* rowp = H1 + (size_t)(row0 + ai * 128 + m * 16) * DE + col0;
#pragma unroll
                for (int bj = 0; bj < 2; ++bj) { const f32x4 a = acc[ai][bj][m][0], b = acc[ai][bj][m][1]; f16x4 w;
#pragma unroll
                    for (int i = 0; i < 4; ++i) { const float s = a[i] / (1.0f + __expf(-a[i])); w[i] = (h16)(s * b[i]); }
                    *(f16x4*)(rowp + bj * 64) = w; } }
    }
};
struct EpiMoe2 {
    static constexpr bool PERM = true;
    h16* YC; const float* gslot;
    struct Pre { int av[2][4]; float gv[2][4]; };
    __device__ __forceinline__ void prefetch(const Unit& u, int wr, int fr, Pre& q) const {
        const float* grow = gslot + ((const char*)u.rows - (const char*)listbase) / 4;
#pragma unroll
        for (int ai = 0; ai < 2; ++ai)
#pragma unroll
            for (int m = 0; m < 4; ++m) { const int r = ai * 128 + wr * 64 + m * 16 + fr; const bool ok = u.pos0 + r < u.cnt; q.av[ai][m] = ok ? u.rows[r] : -1; q.gv[ai][m] = ok ? grow[r] : 0.f; }
    }
    __device__ __forceinline__ void operator()(const f32x4 (&acc)[2][2][4][2], const Unit& u, int wr, int wc, int fr, int fq, const Pre& q) const {
        const int col0 = u.pn * 256 + wc * 32 + 8 * fq;
#pragma unroll
        for (int ai = 0; ai < 2; ++ai)
#pragma unroll
            for (int m = 0; m < 4; ++m) { if (q.av[ai][m] >= 0) { const float g = q.gv[ai][m]; h16* rowp = YC + (size_t)q.av[ai][m] * D + col0;
#pragma unroll
                    for (int bj = 0; bj < 2; ++bj) *(f16x8*)(rowp + bj * 128) = pack8(acc[ai][bj][m][0] * g, acc[ai][bj][m][1] * g); } }
    }
    const int* listbase;
};

__device__ __forceinline__ void order_tile(int wgid, int nM, int nN, int& pm, int& pn) {
    const int nwg = nM * nN; { const int q = nwg / 8, r = nwg % 8, xcd = wgid % 8, off = wgid / 8; wgid = (xcd < r ? xcd * (q + 1) : r * (q + 1) + (xcd - r) * q) + off; }
    const int nig = 8 * nN, gid = wgid / nig, fm = gid * 8, gsz = (nM - fm) < 8 ? (nM - fm) : 8;
    pm = fm + ((wgid % nig) % gsz); pn = (wgid % nig) / gsz;
}
struct SchedPlain {
    int nM, nN, K; const char* A; const char* B;
    __device__ __forceinline__ bool next(int i, Unit& u) const {
        const long L = (long)i * gridDim.x + blockIdx.x; if (L >= (long)nM * nN) return false;
        order_tile((int)L, nM, nN, u.pm, u.pn); u.kind = 0; u.half = 0; u.e = 0; u.pos0 = 0; u.cnt = 0; u.rows = nullptr;
        u.A = A + (size_t)u.pm * 256 * K * 2; u.B = B + (size_t)u.pn * 256 * K * 2; return true;
    }
};
struct SchedPlainAT {
    int nM, nN, K; const char* At; const char* B;
    __device__ __forceinline__ bool next(int i, Unit& u) const {
        const long L = (long)i * gridDim.x + blockIdx.x; if (L >= (long)nM * nN) return false;
        order_tile((int)L, nM, nN, u.pm, u.pn); u.kind = 0; u.half = 0; u.e = 0; u.pos0 = 0; u.cnt = 0; u.rows = nullptr;
        u.A = At + (size_t)u.pm * 256 * 2; u.B = B + (size_t)u.pn * 256 * K * 2; return true;
    }
};
struct SchedQkv {
    const char* H; const char* W;
    __device__ __forceinline__ bool next(int i, Unit& u) const {
        const long L = (long)i * gridDim.x + blockIdx.x; const int nA = 136 * 9; if (L >= nA + 136) return false;
        u.e = 0; u.half = 0; u.pos0 = 0; u.cnt = 0; u.rows = nullptr;
        if (L < nA) { order_tile((int)L, 136, 9, u.pm, u.pn); u.kind = 0; u.A = H + (size_t)u.pm * 256 * D * 2; u.B = W + (size_t)u.pn * 256 * D * 2; }
        else { u.pm = 0; u.pn = (int)L - nA; u.kind = 1; u.A = W + (size_t)DQK * D * 2; u.B = H + (size_t)u.pn * 256 * D * 2; }
        return true;
    }
};
struct SchedFilt {
    const char* W3P; const char* H2P;
    __device__ __forceinline__ bool next(int i, Unit& u) const {
        const long L = (long)i * gridDim.x + blockIdx.x; if (L >= 2 * 544) return false;
        const int j = (int)L / 544, r = (int)L % 544; u.e = 0; u.half = 0; u.pos0 = 0; u.cnt = 0; u.rows = nullptr;
        int v; if (r < 512) { v = 0; u.pm = r >> 4; u.pn = r & 15; } else { v = 1; u.pm = r - 512; u.pn = 0; }
        u.kind = 2 * j + v;
        u.A = W3P + ((size_t)j * 8192 + (size_t)u.pm * 256) * 256 * 2;
        u.B = H2P + ((size_t)j * 4352 + (v ? 4096 : 0) + (size_t)u.pn * 256) * 256 * 2;
        return true;
    }
};
struct MoeTab { const LAS int* tstart; const LAS int* texp; const LAS int* cnt; };
struct SchedMoe1 {
    MoeTab tb; const char* H; const char* W13; const int* list;
    __device__ __forceinline__ bool next(int i, Unit& u) const {
        const long L = (long)i * gridDim.x + blockIdx.x; const int ntile = __builtin_amdgcn_readfirstlane(tb.tstart[NE]); if (L >= (long)ntile * 3) return false;
        int rt; order_tile((int)L, ntile, 3, rt, u.pn); u.pm = rt; u.kind = 0;
        const int e = __builtin_amdgcn_readfirstlane(tb.texp[rt]); u.e = e; u.pos0 = (rt - __builtin_amdgcn_readfirstlane(tb.tstart[e])) * 256; u.cnt = __builtin_amdgcn_readfirstlane(tb.cnt[e]); u.half = (u.cnt - u.pos0 <= 128) ? 1 : 0;
        u.rows = list + (size_t)e * LCAP + u.pos0; u.A = H; u.B = W13 + ((size_t)e * DE2 + (size_t)u.pn * 256) * D * 2; return true;
    }
};
struct SchedMoe2 {
    MoeTab tb; const char* H1; const char* W2; const int* list;
    __device__ __forceinline__ bool next(int i, Unit& u) const {
        const long L = (long)i * gridDim.x + blockIdx.x; const int ntile = __builtin_amdgcn_readfirstlane(tb.tstart[NE]); if (L >= (long)ntile * 8) return false;
        int rt; order_tile((int)L, ntile, 8, rt, u.pn); u.pm = rt; u.kind = 0;
        const int e = __builtin_amdgcn_readfirstlane(tb.texp[rt]); u.e = e; u.pos0 = (rt - __builtin_amdgcn_readfirstlane(tb.tstart[e])) * 256; u.cnt = __builtin_amdgcn_readfirstlane(tb.cnt[e]); u.half = (u.cnt - u.pos0 <= 128) ? 1 : 0;
        u.rows = list + (size_t)e * LCAP + u.pos0; u.A = H1 + (size_t)rt * 256 * DE * 2; u.B = W2 + ((size_t)e * D + (size_t)u.pn * 256) * DE * 2; return true;
    }
};
__device__ __forceinline__ void moe_table(LAS int* tstart, LAS int* texp, LAS int* cnt, const int* counters) {
    const int t = tid_fresh();
    if (t < NE) cnt[t] = counters[t];
    __syncthreads();
    if (t <= NE) { int s = 0; for (int e = 0; e < t; ++e) s += (cnt[e] + 255) >> 8; tstart[t] = s; }
    __syncthreads();
    if (t < NE) { const int s0 = tstart[t], s1 = tstart[t + 1]; for (int q = s0; q < s1; ++q) texp[q] = t; }
    __syncthreads();
}

__device__ __forceinline__ float wave_sum(float v) {
#pragma unroll
    for (int o = 32; o >= 1; o >>= 1) v += shx(v, o);
    return v;
}
__device__ __forceinline__ float silu_f(float x) { return x / (1.0f + expf(-x)); }
__device__ __forceinline__ int batch_of_row(int r) { return r < TL ? (r >> 12) : 8; }

__device__ __forceinline__ void modp_unit(const Params& p, int unit, LAS float* sl) {
    const int layer = unit / 96, rem = unit % 96, ks = rem / 6, cc = rem % 6, tid = tid_fresh();
    for (int i = tid; i < 9 * 128; i += 512) { const int cnd = i >> 7, k = ks * 128 + (i & 127); const float v = cnd < 8 ? p.c[cnd * D + k] : p.c_ctx[k]; sl[i] = silu_f(v); }
    __syncthreads();
    f32x4 acc[9];
#pragma unroll
    for (int q = 0; q < 9; ++q) acc[q] = (f32x4){0.f, 0.f, 0.f, 0.f};
    const float* w = p.mod_w + ((size_t)layer * D + (size_t)ks * 128) * D6 + cc * 2048 + tid * 4;
#pragma unroll 4
    for (int k = 0; k < 128; ++k) { const f32x4 wv = *(const f32x4*)(w + (size_t)k * D6);
#pragma unroll
        for (int q = 0; q < 9; ++q) acc[q] += wv * sl[q * 128 + k]; }
    float* outp = (float*)(p.ws + WS_MODP) + ((size_t)(ks * 4 + layer) * 9) * D6 + cc * 2048 + tid * 4;
#pragma unroll
    for (int q = 0; q < 9; ++q) *(f32x4*)(outp + (size_t)q * D6) = acc[q];
    __syncthreads();
}
__device__ __forceinline__ void modr_unit(const Params& p, int unit) {
    const size_t idx = (size_t)unit * 2048 + tid_fresh() * 4; const int layer = (int)(idx / (9 * D6)), col = (int)(idx % D6);
    f32x4 s = *(const f32x4*)(p.mod_b + (size_t)layer * D6 + col);
    const float* pp = (const float*)(p.ws + WS_MODP) + idx;
#pragma unroll
    for (int ks = 0; ks < 16; ++ks) s += *(const f32x4*)(pp + (size_t)ks * 4 * 9 * D6);
    *(f32x4*)((float*)(p.ws + WS_MODS) + idx) = s;
}
__device__ __forceinline__ void tables_unit(const Params& p) {
    f32x2* tw = (f32x2*)(p.ws + WS_TW);
    for (int m = tid_fresh(); m < 8192; m += 512) { double s, c; sincospi(-(double)m / 4096.0, &s, &c); tw[m] = (f32x2){(float)c, (float)s}; }
    float* rc = (float*)(p.ws + WS_ROPE);
    for (int i = tid_fresh(); i < 1024; i += 512) { const int pos = i >> 4, q = i & 15; const float inv = powf(10000.0f, -(float)q / 16.0f); const float ang = (float)pos * inv;
        rc[i] = cosf(ang); rc[1024 + i] = sinf(ang); }
}
__device__ __forceinline__ void h2_task(const Params& p, int task) {
    const int lane = tid_fresh() & 63; const int j = task / 4352, r = task % 4352; const int v = r >= 4096, t = v ? r - 4096 : r; const int Lv = v ? 256 : 4096;
    const float tl = (float)t / (float)(Lv - 1);
    const float omega = (float)(2.0 * 3.14159265358979323846 / (double)Lv) * (float)t;
    float feat = 0.f;
    if (lane == 0) feat = tl;
    else if (lane <= 32) { const int bi = (lane - 1) & 15; const float band = 1e-4f + (float)bi * ((15.0f - 1e-4f) / 15.0f); const float a = band * omega; feat = lane <= 16 ? cosf(a) : -sinf(a); }
    const float* w1 = p.hy_f_w1 + (size_t)j * 33 * 64; const float* w2 = p.hy_f_w2 + (size_t)j * 64 * 64;
    float s = p.hy_f_b1[j * 64 + lane];
    for (int f = 0; f < 33; ++f) s += bperm_f(feat, f) * w1[f * 64 + lane];
    const float h1 = sinf(p.hy_f_freq1[j * 64 + lane] * s);
    float s2 = p.hy_f_b2[j * 64 + lane];
    for (int m = 0; m < 64; ++m) s2 += bperm_f(h1, m) * w2[m * 64 + lane];
    const float h2 = sinf(p.hy_f_freq2[j * 64 + lane] * s2);
    const h16 hi = (h16)h2; const h16 lo = (h16)(h2 - (float)hi);
    h16* row = (h16*)(p.ws + WS_H2P) + ((size_t)j * 4352 + r) * 256;
    row[lane] = hi; row[64 + lane] = hi; row[128 + lane] = lo; row[192 + lane] = lo;
}
__device__ __forceinline__ void w3p_unit(const Params& p, int unit) {
    const int j = unit >> 5, c0 = (unit & 31) * 256; const float* w3 = p.hy_f_w3 + (size_t)j * 64 * 8192; h16* dst = (h16*)(p.ws + WS_W3P) + (size_t)j * 8192 * 256;
    for (int i = tid_fresh(); i < 64 * 256; i += 512) { const int m = i >> 8, col = c0 + (i & 255); const float w = w3[(size_t)m * 8192 + col];
        const h16 hi = (h16)w; const h16 lo = (h16)(w - (float)hi); h16* row = dst + (size_t)col * 256; row[m] = hi; row[64 + m] = lo; row[128 + m] = hi; row[192 + m] = lo; }
}
__device__ __forceinline__ void rtab_unit(const Params& p, int unit) {
    const int layer = unit >> 6, c = unit & 63; h16* dst = (h16*)(p.ws + WS_RTAB + (size_t)layer * RTAB_L) + (size_t)c * 5 * 2 * 64 * 8;
    for (int i = tid_fresh(); i < 5 * 2 * 64 * 8; i += 512) { const int jj = i & 7, lane = (i >> 3) & 63, hl = (i >> 9) & 1, ct = i >> 10;
        const int k = 32 * c + 8 * (lane >> 4) + jj, col = 16 * ct + (lane & 15);
        float w = 0.f; if (col < 8) w = p.moe_wg[((size_t)layer * D + k) * 8 + col]; else if (col < 72) w = p.moe_we[((size_t)layer * D + k) * 64 + (col - 8)];
        w *= 256.0f; const h16 hi = (h16)w; const h16 lo = (h16)(w - (float)hi); dst[i] = hl ? lo : hi; }
}
template <int NW>
__device__ __forceinline__ void cvt_tile(const float* src, int ldn, int k0, int n0, h16* dst, int ldk, int mode, LAS float* T) {
    constexpr int P = NW + 1; const int tid = tid_fresh();
#pragma unroll
    for (int ps = 0; ps < 64 * NW / 4 / 512; ++ps) { const int idx = ps * 512 + tid, k = idx / (NW / 4), n4 = idx % (NW / 4);
        const f32x4 v = *(const f32x4*)(src + (size_t)(k0 + k) * ldn + n0 + 4 * n4); LAS float* q = T + k * P + 4 * n4; q[0] = v[0]; q[1] = v[1]; q[2] = v[2]; q[3] = v[3]; }
    __syncthreads();
#pragma unroll
    for (int ps = 0; ps < NW * 8 / 512; ++ps) { const int item = ps * 512 + tid, kc = item & 7, n = item >> 3; f16x8 w;
#pragma unroll
        for (int i = 0; i < 8; ++i) w[i] = (h16)T[(8 * kc + i) * P + n];
        const int ng = n0 + n; const int row = mode == 0 ? ng : (8 * (ng >> 2) + (ng & 3) + (mode == 2 ? 4 : 0));
        *(f16x8*)(dst + (size_t)row * ldk + k0 + 8 * kc) = w; }
    __syncthreads();
}
__device__ __forceinline__ void cvt_dense_unit(const Params& p, int unit, LAS float* T) {
    const float* src; h16* dst; int nt, N;
    if (unit < 1536) { src = p.hy_w_in; dst = (h16*)(p.ws + WS_WIN); nt = 24; N = D3; }
    else if (unit < 2048) { unit -= 1536; src = p.hy_w_out; dst = (h16*)(p.ws + WS_WOUT); nt = 8; N = D; }
    else if (unit < 2688) { unit -= 2048; src = p.at_w_qkv; dst = (h16*)(p.ws + WS_WQKV); nt = 10; N = DQKV; }
    else { unit -= 2688; src = p.at_w_o; dst = (h16*)(p.ws + WS_WO); nt = 8; N = D; }
    const int j = unit / (32 * nt), r = unit % (32 * nt), kt = r / nt, ntile = r % nt;
    cvt_tile<256>(src + (size_t)j * D * N, N, kt * 64, ntile * 256, dst + (size_t)j * N * D, D, 0, T);
}
constexpr int CVT_DENSE_UNITS = 3200;
__device__ __forceinline__ void cvt_moe_unit(const Params& p, int layer, int unit, LAS float* T) {
    if (unit < 12288) { const int which = unit >= 6144; if (which) unit -= 6144; const int e = unit / 96, r = unit % 96, kt = r / 3, ntile = r % 3;
        const float* src = (which ? p.moe_w3 : p.moe_w1) + ((size_t)layer * NE + e) * D * DE;
        cvt_tile<128>(src, DE, kt * 64, ntile * 128, (h16*)(p.ws + WS_W13) + (size_t)e * DE2 * D, D, which ? 2 : 1, T); }
    else { unit -= 12288; const int e = unit / 48, r = unit % 48, kt = r / 8, ntile = r % 8;
        const float* src = p.moe_w2 + ((size_t)layer * NE + e) * DE * D;
        cvt_tile<256>(src, D, kt * 64, ntile * 256, (h16*)(p.ws + WS_W2) + (size_t)e * D * DE, DE, 0, T); }
}
constexpr int CVT_MOE_UNITS = 15360;
struct CvtD { const float* src; h16* dst; int mode; };
__device__ __forceinline__ CvtD cvt13_desc(const Params& p, int layer, int unit) {
    const int which = unit >= 6144; if (which) unit -= 6144; const int e = unit / 96, r = unit % 96, kt = r / 3, ntile = r % 3;
    CvtD d; d.src = (which ? p.moe_w3 : p.moe_w1) + ((size_t)layer * NE + e) * D * DE + (size_t)(kt * 64) * DE + ntile * 128;
    d.dst = (h16*)(p.ws + WS_W13) + (size_t)e * DE2 * D + kt * 64; d.mode = (which ? 4 : 0) + 8 * (256 * ntile); return d;
}
__device__ __forceinline__ void cvt13_load(const CvtD& d, f32x4 (&v)[4], int tid) {
#pragma unroll
    for (int ps = 0; ps < 4; ++ps) { const int idx = ps * 512 + tid, k = idx >> 5, n4 = idx & 31; v[ps] = *(const f32x4*)(d.src + (size_t)k * DE + 4 * n4); }
}
__device__ __forceinline__ void cvt13_store(const CvtD& d, const f32x4 (&v)[4], LAS float* T, int tid) {
    constexpr int P = 129;
#pragma unroll
    for (int ps = 0; ps < 4; ++ps) { const int idx = ps * 512 + tid, k = idx >> 5, n4 = idx & 31; LAS float* q = T + k * P + 4 * n4; q[0] = v[ps][0]; q[1] = v[ps][1]; q[2] = v[ps][2]; q[3] = v[ps][3]; }
    __syncthreads();
    const int w3off = d.mode & 7, rg0 = d.mode >> 3;
#pragma unroll
    for (int ps = 0; ps < 2; ++ps) { const int item = ps * 512 + tid, kc = item & 7, n = item >> 3; f16x8 w;
#pragma unroll
        for (int i = 0; i < 8; ++i) w[i] = (h16)T[(8 * kc + i) * P + n];
        const int row = rg0 + 8 * (n >> 2) + (n & 3) + w3off;
        *(f16x8*)(d.dst + (size_t)row * D + 8 * kc) = w; }
    __syncthreads();
}
__device__ __forceinline__ void cvt_moe_share(const Params& p, int layer, int u0, int n, int stride, LAS float* T) {
    const int tid = tid_fresh(); const int n13 = n < 12288 ? n : 12288;
    int u = u0;
    if (u < n13) {
        CvtD dA = cvt13_desc(p, layer, u), dB = dA, dC = dA; f32x4 vA[4], vB[4], vC[4];
        cvt13_load(dA, vA, tid);
        if (u + stride < n13) { dB = cvt13_desc(p, layer, u + stride); cvt13_load(dB, vB, tid); }
        for (;;) {
            if (u + 2 * stride < n13) { dC = cvt13_desc(p, layer, u + 2 * stride); cvt13_load(dC, vC, tid); }
            cvt13_store(dA, vA, T, tid); u += stride; if (u >= n13) break;
            if (u + 2 * stride < n13) { dA = cvt13_desc(p, layer, u + 2 * stride); cvt13_load(dA, vA, tid); }
            cvt13_store(dB, vB, T, tid); u += stride; if (u >= n13) break;
            if (u + 2 * stride < n13) { dB = cvt13_desc(p, layer, u + 2 * stride); cvt13_load(dB, vB, tid); }
            cvt13_store(dC, vC, T, tid); u += stride; if (u >= n13) break;
        }
    }
    for (; u < n; u += stride) cvt_moe_unit(p, layer, u, T);
}

template <int NR, bool FINAL>
__device__ __forceinline__ void n1_rows(const Params& p, int layer, int r0, int rstride, int lane, h16* xout) {
    const h16* xres = (const h16*)(p.ws + WS_XRES); h16* hb = (h16*)(p.ws + WS_HBUF); const h16* yc = (const h16*)(p.ws + WS_YC); const float* mods = (const float*)(p.ws + WS_MODS);
    f32x4 v[NR][8]; f16x4 xh[NR][8], ya[NR][8], yb[NR][8];
    const bool comb = FINAL || layer > 0; const int lprev = FINAL ? 3 : layer - 1;
#pragma unroll
    for (int q = 0; q < NR; ++q) { const int r = r0 + q * rstride;
        if (!comb) { const float* src = r < TL ? p.x + (size_t)r * D : p.ctx + (size_t)(r - TL) * D;
#pragma unroll
            for (int c = 0; c < 8; ++c) v[q][c] = *(const f32x4*)(src + c * 256 + lane * 4); }
        else { const h16* src = xres + (size_t)r * D; const h16* y0 = yc + (size_t)(2 * r) * D; const h16* y1 = y0 + D;
#pragma unroll
            for (int c = 0; c < 8; ++c) { xh[q][c] = *(const f16x4*)(src + c * 256 + lane * 4); ya[q][c] = *(const f16x4*)(y0 + c * 256 + lane * 4); yb[q][c] = *(const f16x4*)(y1 + c * 256 + lane * 4); } } }
#pragma unroll
    for (int q = 0; q < NR; ++q) { const int r = r0 + q * rstride; const int b = batch_of_row(r);
        if (comb) { const float* g2 = mods + ((size_t)(lprev * 9 + b) * 6 + 5) * D;
#pragma unroll
            for (int c = 0; c < 8; ++c) { const f32x4 g = *(const f32x4*)(g2 + c * 256 + lane * 4);
#pragma unroll
                for (int i = 0; i < 4; ++i) v[q][c][i] = (float)xh[q][c][i] + g[i] * ((float)ya[q][c][i] + (float)yb[q][c][i]); } }
        float ss = 0.f;
#pragma unroll
        for (int c = 0; c < 8; ++c) { if (!FINAL) { f16x4 w; w[0] = (h16)v[q][c][0]; w[1] = (h16)v[q][c][1]; w[2] = (h16)v[q][c][2]; w[3] = (h16)v[q][c][3]; *(f16x4*)(xout + (size_t)r * D + c * 256 + lane * 4) = w; } ss += v[q][c][0] * v[q][c][0] + v[q][c][1] * v[q][c][1] + v[q][c][2] * v[q][c][2] + v[q][c][3] * v[q][c][3]; }
        ss = wave_sum(ss); const float rs = 1.0f / sqrtf(ss * (1.0f / D) + EPS);
        if (FINAL) {
#pragma unroll
            for (int c = 0; c < 8; ++c) { const int col = c * 256 + lane * 4; const f32x4 g = *(const f32x4*)(p.final_gain + col); *(f32x4*)(p.out + (size_t)r * D + col) = v[q][c] * rs * g; }
        } else {
            const float* sh = mods + ((size_t)(layer * 9 + b) * 6 + 0) * D; const float* sc = sh + D;
#pragma unroll
            for (int c = 0; c < 8; ++c) { const int col = c * 256 + lane * 4; const f32x4 s0 = *(const f32x4*)(sh + col), s1 = *(const f32x4*)(sc + col); f16x4 w;
#pragma unroll
                for (int i = 0; i < 4; ++i) w[i] = (h16)(v[q][c][i] * rs * (1.0f + s1[i]) + s0[i]);
                *(f16x4*)(hb + (size_t)r * D + col) = w; }
        } }
}
template <bool FINAL>
__device__ __forceinline__ void n1_any(const Params& p, int layer, h16* xout) {
    const int tid = tid_fresh(), lane = tid & 63, gw = blockIdx.x * 8 + __builtin_amdgcn_readfirstlane(tid >> 6), nw = gridDim.x * 8; const int nrow = FINAL ? TL : TT;
    int r = gw;
    for (; r + nw < nrow; r += 2 * nw) n1_rows<2, FINAL>(p, layer, r, nw, lane, xout);
    if (r < nrow) n1_rows<1, FINAL>(p, layer, r, nw, lane, xout);
}
__device__ __forceinline__ void n1_phase(const Params& p, int layer, h16* xout) { n1_any<false>(p, layer, xout); }
__device__ __forceinline__ void final_phase(const Params& p) { n1_any<true>(p, 0, nullptr); }
constexpr int N2_CH = 4;
constexpr int N2_SLOT = N2_CH * 10 * 1024;
constexpr int N2_XT = 2 * N2_SLOT;
constexpr int N2_SC = N2_XT + 8 * 4096;
#ifndef PROBE_N2VAR
#define PROBE_N2VAR 0
#endif
__device__ __forceinline__ void n2_phase(const Params& p, int layer, LAS unsigned char* lds, int ctr_shadow) {
    const bool pv_tail = !(ctr_shadow && (PROBE_N2VAR & 1)), pv_store = !(ctr_shadow && (PROBE_N2VAR & 2)), pv_mma = !(ctr_shadow && (PROBE_N2VAR & 4));
    const int tid = tid_fresh(), lane = tid & 63, wv = __builtin_amdgcn_readfirstlane(tid >> 6), r16 = lane & 15, kg = lane >> 4;
    const int lrow = lane >> 3, lchk = lane & 7;
    const h16* xres = (const h16*)(p.ws + WS_XRES); h16* hb = (h16*)(p.ws + WS_HBUF); const float* mods = (const float*)(p.ws + WS_MODS);
    const char* rtb = p.ws + WS_RTAB + (size_t)layer * RTAB_L; const float* ssq = (const float*)(p.ws + WS_SSQ);
    int* counters = (int*)(p.ws + WS_CTL) + CTL_CNT + (layer + (ctr_shadow ? 4 : 0)) * NE; int* list = (int*)(p.ws + WS_LIST); float* gate = (float*)(p.ws + WS_GATE);
    LAS float* scr = (LAS float*)lds + wv * (16 * 80);
    LAS float* scl = (LAS float*)(lds + N2_SC); LAS float* shl = scl + D;
    LAS int* hist = (LAS int*)(lds + LDS_MISC); LAS int* hbase = hist + NE;
    LAS unsigned char* xt = lds + N2_XT + wv * 4096;
    const int hw_off0 = r16 * 128 + 16 * (kg ^ (r16 & 7)), hw_off1 = r16 * 128 + 16 * ((4 + kg) ^ (r16 & 7));
    const int hr_off = lrow * 128 + 16 * (lchk ^ (lrow & 7));
    const int ntask = (layer == NLAYER - 1 ? TL : TT) / 16, nfull = (int)gridDim.x * 8;
#pragma unroll 1
    for (int round = 0; round < 2; ++round) {
        const int nrem = ntask - nfull;
        if (round == 1 && (int)blockIdx.x >= nrem) break;
        const int task = round == 0 ? (int)blockIdx.x * 8 + wv : nfull + (int)blockIdx.x;
        const bool active = round == 0 ? (task < ntask) : true;
        const int trow = active ? task * 16 : 0;
        const int b = batch_of_row(trow);
        const h16* xg = xres + (size_t)(trow + r16) * D + 8 * kg;
        h16* hg0 = hb + (size_t)(trow + lrow) * D + lchk * 8; h16* hg1 = hg0 + (size_t)8 * D;
        float rs;
        { const float* sp = ssq + (size_t)(trow + r16) * 32; float t = 0.f;
#pragma unroll
            for (int q = 0; q < 8; ++q) { const f32x4 v = *(const f32x4*)(sp + 4 * q); t += (v[0] + v[1]) + (v[2] + v[3]); }
            rs = 1.0f / sqrtf(t * (1.0f / D) + EPS); }
        f32x4 acc[5];
#pragma unroll
        for (int ct = 0; ct < 5; ++ct) acc[ct] = (f32x4){0.f, 0.f, 0.f, 0.f};
        __syncthreads();
        if (tid < NE) hist[tid] = 0;
        { const float* scb = mods + ((size_t)(layer * 9 + b) * 6 + 4) * D; *(LAS f32x4*)(scl + tid * 4) = *(const f32x4*)(scb + tid * 4); *(LAS f32x4*)(shl + tid * 4) = *(const f32x4*)(scb - D + tid * 4); }
        if (round == 0) {
        f16x8 bq[5];
#pragma unroll
        for (int q = 0; q < 5; ++q) bq[q] = *(const f16x8*)(rtb + (size_t)(5 * wv + q) * 1024 + lane * 16);
#pragma unroll
        for (int q = 0; q < 5; ++q) *(LAS f16x8*)(lds + (5 * wv + q) * 1024 + lane * 16) = bq[q];
#pragma unroll
        for (int q = 0; q < 5; ++q) bq[q] = *(const f16x8*)(rtb + (size_t)N2_SLOT + (size_t)(5 * wv + q) * 1024 + lane * 16);
        f16x8 x0[N2_CH], x1[N2_CH], x2[N2_CH];
#pragma unroll
        for (int s2 = 0; s2 < N2_CH; ++s2) { x0[s2] = *(const f16x8*)(xg + 32 * s2); x1[s2] = *(const f16x8*)(xg + 32 * (N2_CH + s2)); }
#define N2_CHUNK(XC, XL, CH) do { const int ch = (CH); \
            __syncthreads(); \
            const int nx2 = (ch + 2 < 64 / N2_CH) ? ch + 2 : ch; \
            {   LAS unsigned char* dst = lds + ((ch + 1) & 1) * N2_SLOT; \
 _Pragma("unroll") \
                for (int q = 0; q < 5; ++q) *(LAS f16x8*)(dst + (5 * wv + q) * 1024 + lane * 16) = bq[q]; } \
            {   const char* src = rtb + (size_t)nx2 * N2_SLOT; \
 _Pragma("unroll") \
                for (int q = 0; q < 5; ++q) bq[q] = *(const f16x8*)(src + (size_t)(5 * wv + q) * 1024 + lane * 16); } \
 _Pragma("unroll") \
            for (int s2 = 0; s2 < N2_CH; ++s2) { const int ko = 32 * (nx2 * N2_CH + s2); XL[s2] = *(const f16x8*)(xg + ko); } \
            const LAS unsigned char* bs = lds + (ch & 1) * N2_SLOT + lane * 16; \
 _Pragma("unroll") \
            for (int pp = 0; pp < N2_CH / 2; ++pp) { \
                f16x8 hk[2]; \
 _Pragma("unroll") \
                for (int sp = 0; sp < 2; ++sp) { \
                    const int s2 = 2 * pp + sp; const int ko = 32 * (ch * N2_CH + s2) + 8 * kg; \
                    const f32x4 c0 = *(const LAS f32x4*)(scl + ko), c1 = *(const LAS f32x4*)(scl + ko + 4), h0 = *(const LAS f32x4*)(shl + ko), h1 = *(const LAS f32x4*)(shl + ko + 4); \
                    f16x8 hi, lo; \
 _Pragma("unroll") \
                    for (int i = 0; i < 4; ++i) { const float a0 = (float)XC[s2][i] * rs * (1.0f + c0[i]) + h0[i], a1 = (float)XC[s2][4 + i] * rs * (1.0f + c1[i]) + h1[i]; \
                        hi[i] = (h16)a0; lo[i] = (h16)(a0 - (float)hi[i]); hi[4 + i] = (h16)a1; lo[4 + i] = (h16)(a1 - (float)hi[4 + i]); } \
                    hk[sp] = hi; \
                    if (pv_mma) \
 _Pragma("unroll") \
                    for (int ct = 0; ct < 5; ++ct) { const f16x8 whi = *(const LAS f16x8*)(bs + (s2 * 10 + ct * 2 + 0) * 1024), wlo = *(const LAS f16x8*)(bs + (s2 * 10 + ct * 2 + 1) * 1024); \
                        acc[ct] = __builtin_amdgcn_mfma_f32_16x16x32_f16(hi, whi, acc[ct], 0, 0, 0); \
                        acc[ct] = __builtin_amdgcn_mfma_f32_16x16x32_f16(hi, wlo, acc[ct], 0, 0, 0); \
                        acc[ct] = __builtin_amdgcn_mfma_f32_16x16x32_f16(lo, whi, acc[ct], 0, 0, 0); } \
                } \
                *(LAS f16x8*)(xt + hw_off0) = hk[0]; *(LAS f16x8*)(xt + hw_off1) = hk[1]; \
                const f16x8 o0 = *(const LAS f16x8*)(xt + hr_off), o1 = *(const LAS f16x8*)(xt + 1024 + hr_off); \
                if (active && pv_store) { const int ho = 32 * (ch * N2_CH + 2 * pp); *(f16x8*)(hg0 + ho) = o0; *(f16x8*)(hg1 + ho) = o1; } \
            } \
        } while (0)
#pragma unroll 1
        for (int c3 = 0; c3 < 15; c3 += 3) { N2_CHUNK(x0, x2, c3); N2_CHUNK(x1, x0, c3 + 1); N2_CHUNK(x2, x1, c3 + 2); }
        N2_CHUNK(x0, x2, 15);
#undef N2_CHUNK
        } else {
            const char* rtw = rtb + (size_t)(8 * wv) * 10240; const int kb = 256 * wv;
            unsigned loff = (unsigned)lane * 16u; asm volatile("" : "+v"(loff));
            f16x8 bb[10];
            f16x8 xa[2][2];
#pragma unroll
            for (int sp = 0; sp < 2; ++sp) xa[0][sp] = *(const f16x8*)(xg + kb + 32 * sp);
#pragma unroll
            for (int pp = 0; pp < 4; ++pp) {
                if (pp < 3) {
#pragma unroll
                    for (int sp = 0; sp < 2; ++sp) xa[(pp + 1) & 1][sp] = *(const f16x8*)(xg + kb + 32 * (2 * pp + 2 + sp)); }
                f16x8 hk[2];
#pragma unroll
                for (int sp = 0; sp < 2; ++sp) {
                    const int st = 2 * pp + sp; const int ko = kb + 32 * st + 8 * kg;
#pragma unroll
                    for (int q = 0; q < 10; ++q) bb[q] = *(const f16x8*)(rtw + (size_t)(st * 10 + q) * 1024 + loff);
                    asm volatile("" ::: "memory");
                    const f32x4 c0 = *(const LAS f32x4*)(scl + ko), c1 = *(const LAS f32x4*)(scl + ko + 4), h0 = *(const LAS f32x4*)(shl + ko), h1 = *(const LAS f32x4*)(shl + ko + 4);
                    f16x8 hi, lo;
#pragma unroll
                    for (int i = 0; i < 4; ++i) { const float a0 = (float)xa[pp & 1][sp][i] * rs * (1.0f + c0[i]) + h0[i], a1 = (float)xa[pp & 1][sp][4 + i] * rs * (1.0f + c1[i]) + h1[i];
                        hi[i] = (h16)a0; lo[i] = (h16)(a0 - (float)hi[i]); hi[4 + i] = (h16)a1; lo[4 + i] = (h16)(a1 - (float)hi[4 + i]); }
                    hk[sp] = hi;
#pragma unroll
                    for (int ct = 0; ct < 5; ++ct) {
                        acc[ct] = __builtin_amdgcn_mfma_f32_16x16x32_f16(hi, bb[2 * ct], acc[ct], 0, 0, 0);
                        acc[ct] = __builtin_amdgcn_mfma_f32_16x16x32_f16(hi, bb[2 * ct + 1], acc[ct], 0, 0, 0);
                        acc[ct] = __builtin_amdgcn_mfma_f32_16x16x32_f16(lo, bb[2 * ct], acc[ct], 0, 0, 0); }
                }
                *(LAS f16x8*)(xt + hw_off0) = hk[0]; *(LAS f16x8*)(xt + hw_off1) = hk[1];
                const f16x8 o0 = *(const LAS f16x8*)(xt + hr_off), o1 = *(const LAS f16x8*)(xt + 1024 + hr_off);
                if (pv_store) { const int ho = kb + 64 * pp; *(f16x8*)(hg0 + ho) = o0; *(f16x8*)(hg1 + ho) = o1; }
            }
        }
        __syncthreads();
#pragma unroll
        for (int ct = 0; ct < 5; ++ct)
#pragma unroll
            for (int i = 0; i < 4; ++i) scr[(4 * kg + i) * 80 + 16 * ct + r16] = acc[ct][i] * (1.0f / 256.0f);
        asm volatile("s_waitcnt lgkmcnt(0)" ::: "memory");
        int ea = 0, eb = 0, ra = 0, rb = 0; float g1v = 0.f, g2v = 0.f; const bool tok_lane = (round == 0 ? active : wv == 0) && lane < 16 && pv_tail;
        const int nparts = round == 0 ? 1 : 8;
        if (tok_lane) {
            const LAS float* lgr = scr + lane * 80;
#define N2_LG(c) ({ float _t = lgr[(c)]; for (int _w = 1; _w < nparts; ++_w) _t += lgr[_w * 1280 + (c)]; _t; })
            float gmax = -3.0e38f; int gsel = 0; float gl[8];
#pragma unroll
            for (int g = 0; g < 8; ++g) { gl[g] = N2_LG(g) + p.moe_bg[layer * 8 + g]; if (gl[g] > gmax) { gmax = gl[g]; gsel = g; } }
            float gz = 0.f;
#pragma unroll
            for (int g = 0; g < 8; ++g) gz += expf(gl[g] - gmax);
            const float pg = 1.0f / gz;
            float f1 = -3.0e38f, f2 = -3.0e38f; int i1 = 0, i2 = 0;
            for (int q = 0; q < 8; ++q) { const float f = N2_LG(8 + gsel * 8 + q) + p.moe_be[layer * 64 + gsel * 8 + q];
                if (f > f1) { f2 = f1; i2 = i1; f1 = f; i1 = q; } else if (f > f2) { f2 = f; i2 = q; } }
            const float e2 = expf(f2 - f1); g1v = pg / (1.0f + e2); g2v = pg * e2 / (1.0f + e2);
            ea = gsel * 8 + i1; eb = gsel * 8 + i2;
#undef N2_LG
            ra = __hip_atomic_fetch_add(hist + ea, 1, __ATOMIC_RELAXED, __HIP_MEMORY_SCOPE_WORKGROUP); rb = __hip_atomic_fetch_add(hist + eb, 1, __ATOMIC_RELAXED, __HIP_MEMORY_SCOPE_WORKGROUP);
        }
        __syncthreads();
        { const int t2 = tid_fresh(); if (t2 < NE && pv_tail) { const int n = hist[t2]; hbase[t2] = n ? atomicAdd(&counters[t2], n) : 0; } }
        __syncthreads();
        if (tok_lane) { const int tok = task * 16 + lane; const size_t sa = (size_t)ea * LCAP + hbase[ea] + ra, sb = (size_t)eb * LCAP + hbase[eb] + rb;
            list[sa] = 2 * tok; gate[sa] = g1v; list[sb] = 2 * tok + 1; gate[sb] = g2v; }
    }
}
__device__ __forceinline__ void transpose_phase(const Params& p, LAS h16* T) {
    const h16* zt = (const h16*)(p.ws + WS_ZT); h16* z = (h16*)(p.ws + WS_HBUF); const int tid = tid_fresh();
    const int ntile = (D / 64) * (TT / 64);
    for (int tile = blockIdx.x; tile < ntile; tile += gridDim.x) {
        const int td = tile % (D / 64), tt = tile / (D / 64); const int d0 = td * 64, t0 = tt * 64;
        { const int dr = tid >> 3, tc = (tid & 7) * 8; const f16x8 v = *(const f16x8*)(zt + (size_t)(d0 + dr) * TT + t0 + tc);
#pragma unroll
            for (int i = 0; i < 8; ++i) T[(tc + i) * 66 + dr] = v[i]; }
        __syncthreads();
        { const int tr = tid >> 3, dc = (tid & 7) * 8; f16x8 v;
#pragma unroll
            for (int i = 0; i < 8; ++i) v[i] = T[tr * 66 + dc + i];
            *(f16x8*)(z + (size_t)(t0 + tr) * D + d0 + dc) = v; }
        __syncthreads();
    }
}

__device__ __forceinline__ f32x2 cmul(const f32x2 a, const f32x2 b) { return (f32x2){a.x * b.x - a.y * b.y, a.x * b.y + a.y * b.x}; }
__device__ __forceinline__ f32x2 cmulc(const f32x2 a, const f32x2 b) { return (f32x2){a.x * b.x + a.y * b.y, a.y * b.x - a.x * b.y}; }
__device__ __forceinline__ f32x2 cconj(const f32x2 a) { return (f32x2){a.x, -a.y}; }
template <bool INV> __device__ __forceinline__ f32x2 mul_mi(const f32x2 a) { return INV ? (f32x2){-a.y, a.x} : (f32x2){a.y, -a.x}; }
template <bool INV> __device__ __forceinline__ void dft4(f32x2& a, f32x2& b, f32x2& c, f32x2& d) {
    const f32x2 s0 = a + c, s1 = a - c, s2 = b + d, s3 = mul_mi<INV>(b - d);
    a = s0 + s2; b = s1 + s3; c = s0 - s2; d = s1 - s3;
}
template <bool INV, int M> __device__ __forceinline__ f32x2 w16mul(const f32x2 a) {
    constexpr float C1 = 0.92387953251128674f, S1 = 0.38268343236508977f, R = 0.70710678118654752f;
    constexpr float cr = (M == 0) ? 1.f : (M == 1) ? C1 : (M == 2) ? R : (M == 3) ? S1 : (M == 4) ? 0.f : (M == 6) ? -R :   -C1;
    constexpr float ci0 = (M == 0) ? 0.f : (M == 1) ? -S1 : (M == 2) ? -R : (M == 3) ? -C1 : (M == 4) ? -1.f : (M == 6) ? -R :   S1;
    constexpr float ci = INV ? -ci0 : ci0;
    return (f32x2){a.x * cr - a.y * ci, a.x * ci + a.y * cr};
}
template <bool INV> __device__ __forceinline__ void dft16(f32x2 (&v)[16]) {
#pragma unroll
    for (int n2 = 0; n2 < 4; ++n2) dft4<INV>(v[n2], v[4 + n2], v[8 + n2], v[12 + n2]);
    v[5] = w16mul<INV, 1>(v[5]); v[6] = w16mul<INV, 2>(v[6]); v[7] = w16mul<INV, 3>(v[7]);
    v[9] = w16mul<INV, 2>(v[9]); v[10] = w16mul<INV, 4>(v[10]); v[11] = w16mul<INV, 6>(v[11]);
    v[13] = w16mul<INV, 3>(v[13]); v[14] = w16mul<INV, 6>(v[14]); v[15] = w16mul<INV, 9>(v[15]);
#pragma unroll
    for (int k1 = 0; k1 < 4; ++k1) dft4<INV>(v[4 * k1], v[4 * k1 + 1], v[4 * k1 + 2], v[4 * k1 + 3]);
    f32x2 t;
    t = v[1]; v[1] = v[4]; v[4] = t; t = v[2]; v[2] = v[8]; v[8] = t; t = v[3]; v[3] = v[12]; v[12] = t;
    t = v[6]; v[6] = v[9]; v[9] = t; t = v[7]; v[7] = v[13]; v[13] = t; t = v[11]; v[11] = v[14]; v[14] = t;
}
__device__ __forceinline__ int fphys(int i) { return i + (i >> 4); }
__device__ __forceinline__ f32x2 w32c(int j) {
    constexpr float c[16] = {1.f, 0.98078528040323043f, 0.92387953251128674f, 0.83146961230254524f, 0.70710678118654752f, 0.55557023301960218f, 0.38268343236508977f, 0.19509032201612825f,
                             0.f, -0.19509032201612825f, -0.38268343236508977f, -0.55557023301960218f, -0.70710678118654752f, -0.83146961230254524f, -0.92387953251128674f, -0.98078528040323043f};
    constexpr float s[16] = {0.f, 0.19509032201612825f, 0.38268343236508977f, 0.55557023301960218f, 0.70710678118654752f, 0.83146961230254524f, 0.92387953251128674f, 0.98078528040323043f,
                             1.f, 0.98078528040323043f, 0.92387953251128674f, 0.83146961230254524f, 0.70710678118654752f, 0.55557023301960218f, 0.38268343236508977f, 0.19509032201612825f};
    return (f32x2){c[j], -s[j]};
}
template <int S>
__device__ __forceinline__ void fft_fwd0(const f32x2 (&xe)[16], const f32x2 (&xo)[16], LAS f32x2* E, LAS f32x2* O, int t, const f32x2* tw) {
    const f32x2 u = tw[t * (256 / S)]; const f32x2 u2 = cmul(u, u);
    f32x2 y[16];
#pragma unroll
    for (int j = 0; j < 16; ++j) y[j] = xe[j];
    dft16<false>(y);
    constexpr int QS = S + S / 16;
    LAS f32x2* Eb = E + fphys(t); LAS f32x2* Ob = O + fphys(t);
    f32x2 pw = u2; Eb[0] = y[0];
#pragma unroll
    for (int q = 1; q < 16; ++q) { Eb[QS * q] = cmul(y[q], pw); pw = cmul(pw, u2); }
#pragma unroll
    for (int j = 0; j < 16; ++j) y[j] = cmul(xo[j], w32c(j));
    dft16<false>(y);
    pw = u;
#pragma unroll
    for (int q = 0; q < 16; ++q) { Ob[QS * q] = cmul(y[q], pw); pw = cmul(pw, u2); }
}
template <bool INV> __device__ __forceinline__ void fft_pass1(LAS f32x2* A, int tau, const f32x2* tw) {
    const int i = tau & 15, base = (tau >> 4) << 8; const f32x2 u0 = tw[32 * i]; const f32x2 u = INV ? cconj(u0) : u0;
    f32x2 y[16]; LAS f32x2* Ab = A + fphys(base + i);
#pragma unroll
    for (int j = 0; j < 16; ++j) y[j] = Ab[17 * j];
    if (INV) { f32x2 pw = u;
#pragma unroll
        for (int q = 1; q < 16; ++q) { y[q] = cmul(y[q], pw); pw = cmul(pw, u); } }
    dft16<INV>(y);
    if (!INV) { f32x2 pw = u;
#pragma unroll
        for (int q = 1; q < 16; ++q) { y[q] = cmul(y[q], pw); pw = cmul(pw, u); } }
#pragma unroll
    for (int j = 0; j < 16; ++j) Ab[17 * j] = y[j];
}
template <bool INV> __device__ __forceinline__ void fft_pass1_pair(LAS f32x2* A, LAS f32x2* B, int tau, const f32x2* tw) {
    const int i = tau & 15, base = (tau >> 4) << 8; const f32x2 u0 = tw[32 * i]; const f32x2 u = INV ? cconj(u0) : u0;
    f32x2 y[16], z[16]; LAS f32x2* Ab = A + fphys(base + i); LAS f32x2* Bb = B + fphys(base + i);
#pragma unroll
    for (int j = 0; j < 16; ++j) y[j] = Ab[17 * j];
#pragma unroll
    for (int j = 0; j < 16; ++j) z[j] = Bb[17 * j];
    f32x2 pwr[16]; pwr[1] = u;
#pragma unroll
    for (int q = 2; q < 16; ++q) pwr[q] = cmul(pwr[q - 1], u);
    if (INV) {
#pragma unroll
        for (int q = 1; q < 16; ++q) y[q] = cmul(y[q], pwr[q]); }
    dft16<INV>(y);
    if (!INV) {
#pragma unroll
        for (int q = 1; q < 16; ++q) y[q] = cmul(y[q], pwr[q]); }
#pragma unroll
    for (int j = 0; j < 16; ++j) Ab[17 * j] = y[j];
    if (INV) {
#pragma unroll
        for (int q = 1; q < 16; ++q) z[q] = cmul(z[q], pwr[q]); }
    dft16<INV>(z);
    if (!INV) {
#pragma unroll
        for (int q = 1; q < 16; ++q) z[q] = cmul(z[q], pwr[q]); }
#pragma unroll
    for (int j = 0; j < 16; ++j) Bb[17 * j] = z[j];
}
__device__ __forceinline__ void fft_fwd2(const LAS f32x2* A, int t, f32x2 (&y)[16]) {
#pragma unroll
    for (int j = 0; j < 16; ++j) y[j] = A[17 * t + j];
    dft16<false>(y);
}
__device__ __forceinline__ void kf_load(const f32x2* kf, f32x4 (&k)[8]) {
#pragma unroll
    for (int j = 0; j < 8; ++j) k[j] = *(const f32x4*)(kf + 2 * j);
}
__device__ __forceinline__ void fft_mid(LAS f32x2* A, int t, const f32x4 (&k)[8]) {
    f32x2 y[16];
    fft_fwd2(A, t, y);
#pragma unroll
    for (int j = 0; j < 8; ++j) { y[2 * j] = cmul(y[2 * j], (f32x2){k[j][0], k[j][1]}); y[2 * j + 1] = cmul(y[2 * j + 1], (f32x2){k[j][2], k[j][3]}); }
    dft16<true>(y);
#pragma unroll
    for (int j = 0; j < 16; ++j) A[17 * t + j] = y[j];
}
template <int S>
__device__ __forceinline__ void fft_inv0(const LAS f32x2* E, const LAS f32x2* O, int t, const f32x2* tw, f32x2 (&out)[16]) {
    const f32x2 u = tw[t * (256 / S)]; const f32x2 u2 = cmul(u, u);
    f32x2 y[16];
    constexpr int QS = S + S / 16;
    const LAS f32x2* Eb = E + fphys(t); const LAS f32x2* Ob = O + fphys(t);
    f32x2 pw = u2; y[0] = Eb[0];
#pragma unroll
    for (int q = 1; q < 16; ++q) { y[q] = cmulc(Eb[QS * q], pw); pw = cmul(pw, u2); }
    dft16<true>(y);
#pragma unroll
    for (int j = 0; j < 16; ++j) out[j] = y[j];
    pw = u;
#pragma unroll
    for (int q = 0; q < 16; ++q) { y[q] = cmulc(Ob[QS * q], pw); pw = cmul(pw, u2); }
    dft16<true>(y);
#pragma unroll
    for (int j = 0; j < 16; ++j) out[j] += cmulc(y[j], w32c(j));
}
__device__ __forceinline__ float hy_absdelta(int d) { return fabsf(-3.0701134573253943f + (-15.350567286626973f + 3.0701134573253943f) * ((float)d / 2047.0f)); }

__device__ __forceinline__ void filt_fft_phase(const Params& p, LAS unsigned char* lds) {
    const int tid = tid_fresh();
    const f32x2* tw = (const f32x2*)(p.ws + WS_TW);
    {
        const int grp = tid >> 8, tau = tid & 255;
        LAS f32x2* E = (LAS f32x2*)(lds + grp * 69632); LAS f32x2* O = E + 4352; LAS float* red = (LAS float*)(lds + LDS_MISC) + grp * 8;
        for (int pb = blockIdx.x * 2 + grp; pb < 2 * 2 * 2048; pb += gridDim.x * 2) {
            const int d = pb & 2047, n = (pb >> 11) & 1, j = pb >> 12;
            const float* tf = (const float*)(p.ws + WS_TAPS) + ((size_t)j * 8192 + (size_t)(n * 2 + 0) * D + d) * 4096;
            const float* tb = tf + (size_t)D * 4096;
            const float adel = hy_absdelta(d); const float tscale = 1.0f / 4095.0f;
            f32x2 xe[16], xo[16]; float ss = 0.f;
#pragma unroll
            for (int jj = 0; jj < 16; ++jj) { const int nn = tau + 256 * jj;
                const float klo = tf[nn] * expf(-(float)nn * tscale * adel);
                const int m = 4096 - nn;
                const float khi = (m < 4096) ? tb[m & 4095] * expf(-(float)m * tscale * adel) : 0.f;
                ss += klo * klo + khi * khi; xe[jj] = (f32x2){klo + khi, 0.f}; xo[jj] = (f32x2){klo - khi, 0.f}; }
            ss = wave_sum(ss);
            if ((tid & 63) == 0) red[(tid >> 6) & 3] = ss;
            fft_fwd0<256>(xe, xo, E, O, tau, tw);
            __syncthreads();
            const float tot = red[0] + red[1] + red[2] + red[3];
            const float scale = (1.0f / sqrtf(tot + EPS)) * (1.0f / 8192.0f);
            const float hbs = p.hy_bias[((size_t)j * 2 + n) * D + d] * (1.0f / 8192.0f);
            fft_pass1<false>(E, tau, tw); fft_pass1<false>(O, tau, tw);
            __syncthreads();
            f32x2* kf = (f32x2*)(p.ws + WS_KF) + (size_t)pb * 8192 + (size_t)tau * 16;
            f32x2 y[16];
            fft_fwd2(E, tau, y);
#pragma unroll
            for (int q = 0; q < 8; ++q) *(f32x4*)(kf + 2 * q) = (f32x4){y[2 * q].x * scale + hbs, y[2 * q].y * scale, y[2 * q + 1].x * scale + hbs, y[2 * q + 1].y * scale};
            fft_fwd2(O, tau, y);
#pragma unroll
            for (int q = 0; q < 8; ++q) *(f32x4*)(kf + 4096 + 2 * q) = (f32x4){y[2 * q].x * scale + hbs, y[2 * q].y * scale, y[2 * q + 1].x * scale + hbs, y[2 * q + 1].y * scale};
            __syncthreads();
        }
    }
    {
        const int pr = tid >> 4, i = tid & 15;
        LAS f32x2* E = (LAS f32x2*)(lds + pr * 4352); LAS f32x2* O = E + 272;
        for (int it = blockIdx.x; it < 256; it += gridDim.x) {
            const int pb = it * 32 + pr; const int d = pb & 2047, n = (pb >> 11) & 1, j = pb >> 12;
            const float* tf = (const float*)(p.ws + WS_TAPSC) + ((size_t)j * 8192 + (size_t)(n * 2 + 0) * D + d) * 256;
            const float* tb = tf + (size_t)D * 256;
            const float adel = hy_absdelta(d); const float tscale = 1.0f / 255.0f;
            f32x2 xe[16], xo[16]; float ss = 0.f;
#pragma unroll
            for (int jj = 0; jj < 16; ++jj) { const int nn = i + 16 * jj;
                const float klo = tf[nn] * expf(-(float)nn * tscale * adel);
                const int m = 256 - nn;
                const float khi = (m < 256) ? tb[m & 255] * expf(-(float)m * tscale * adel) : 0.f;
                ss += klo * klo + khi * khi; xe[jj] = (f32x2){klo + khi, 0.f}; xo[jj] = (f32x2){klo - khi, 0.f}; }
            ss += shx(ss, 8); ss += shx(ss, 4); ss += shx(ss, 2); ss += shx(ss, 1);
            const float scale = (1.0f / sqrtf(ss + EPS)) * (1.0f / 512.0f);
            const float hbs = p.hy_bias[((size_t)j * 2 + n) * D + d] * (1.0f / 512.0f);
            fft_fwd0<16>(xe, xo, E, O, i, tw);
            __syncthreads();
            f32x2* kf = (f32x2*)(p.ws + WS_KFC) + (size_t)pb * 512 + (size_t)i * 16;
            f32x2 y[16];
            fft_fwd2(E, i, y);
#pragma unroll
            for (int q = 0; q < 8; ++q) *(f32x4*)(kf + 2 * q) = (f32x4){y[2 * q].x * scale + hbs, y[2 * q].y * scale, y[2 * q + 1].x * scale + hbs, y[2 * q + 1].y * scale};
            fft_fwd2(O, i, y);
#pragma unroll
            for (int q = 0; q < 8; ++q) *(f32x4*)(kf + 256 + 2 * q) = (f32x4){y[2 * q].x * scale + hbs, y[2 * q].y * scale, y[2 * q + 1].x * scale + hbs, y[2 * q + 1].y * scale};
            __syncthreads();
        }
    }
}

__device__ __forceinline__ float conv3_lds(const LAS h16* row, int n, float w0, float w1, float w2, float b) { return (float)row[n - 1] * w0 + (float)row[n] * w1 + (float)row[n + 1] * w2 + b; }
constexpr int ST_P = 4112, STS_P = 272;

#ifndef PROBE_CVAR
#define PROBE_CVAR 0
#endif
__device__ __forceinline__ void conv_phase(const Params& p, int jl, LAS unsigned char* lds, int pvar = 0, int cvt_layer = -1, int cvt_n = 0) {
    const int tid = tid_fresh(); const bool cv_outer = !(pvar && (PROBE_CVAR & 1)), cv_inner = !(pvar && (PROBE_CVAR & 2));
    const f32x2* tw = (const f32x2*)(p.ws + WS_TW);
    const h16* ut = (const h16*)(p.ws + WS_UT); h16* zt = (h16*)(p.ws + WS_ZT);
    const float* cw = p.hy_conv_w + (size_t)jl * 3 * D3; const float* cb = p.hy_conv_b + (size_t)jl * D3;
    {
        const int grp = tid >> 8, tau = tid & 255;
        LAS f32x2* E = (LAS f32x2*)(lds + grp * 69632); LAS f32x2* O = E + 4352; LAS h16* ST = (LAS h16*)E;
        int uit = 0; const int utrig = 4 * (((int)blockIdx.x >> 3) & 3);
        for (int unit = blockIdx.x; unit < 4096; unit += gridDim.x, ++uit) {
            if (cvt_layer >= 0 && uit == utrig) { __syncthreads(); cvt_moe_share(p, cvt_layer, blockIdx.x, cvt_n, gridDim.x, (LAS float*)lds); }
            const int ux = unit & 7, uj = unit >> 3; const int hq = uj & 1, d = (uj >> 1) * 8 + ux; const size_t col0 = (size_t)(4 * hq + 2 * grp) * 4096;
            const f32x2* kfb = (const f32x2*)(p.ws + WS_KF) + ((size_t)(jl * 2) * 2048 + d) * 8192 + (size_t)tau * 16;
            f16x8 raw[2][2][2], raw2[2][2];
#pragma unroll
            for (int sq = 0; sq < 2; ++sq)
#pragma unroll
                for (int bb = 0; bb < 2; ++bb)
#pragma unroll
                    for (int k = 0; k < 2; ++k) raw[sq][bb][k] = *(const f16x8*)(ut + (size_t)(sq * D + d) * TT + col0 + (size_t)bb * 4096 + (size_t)(tau + 256 * k) * 8);
            __syncthreads();
#pragma unroll
            for (int sq = 0; sq < 2; ++sq)
#pragma unroll
                for (int bb = 0; bb < 2; ++bb)
#pragma unroll
                    for (int k = 0; k < 2; ++k) *(LAS f16x8*)(ST + (sq * 2 + bb) * ST_P + 8 + (tau + 256 * k) * 8) = raw[sq][bb][k];
            if (tau < 4) { ST[tau * ST_P + 7] = (h16)0.f; ST[tau * ST_P + 8 + 4096] = (h16)0.f; }
            __syncthreads();
            f32x2 xin[16], gk[16], y[16];
            { const float w0 = cw[d], w1 = cw[D3 + d], w2 = cw[2 * D3 + d], bv = cb[d]; const float g0 = cw[D + d], g1 = cw[D3 + D + d], g2 = cw[2 * D3 + D + d], gb = cb[D + d];
#pragma unroll
                for (int jj = 0; jj < 16; ++jj) { const int nn = tau + 256 * jj;
                    xin[jj] = (f32x2){conv3_lds(ST + 8, nn, w0, w1, w2, bv), conv3_lds(ST + ST_P + 8, nn, w0, w1, w2, bv)};
                    gk[jj] = (f32x2){conv3_lds(ST + 2 * ST_P + 8, nn, g0, g1, g2, gb), conv3_lds(ST + 3 * ST_P + 8, nn, g0, g1, g2, gb)}; } }
            __syncthreads();
#pragma unroll 1
            for (int ord = 0; ord < 2; ++ord) {
                if (cv_outer) fft_fwd0<256>(xin, xin, E, O, tau, tw);
                const f32x2* kf = kfb + (size_t)ord * 2048 * 8192; f32x4 kfe[8], kfo[8];
                kf_load(kf, kfe);
                __syncthreads();
                if (cv_inner) fft_pass1_pair<false>(E, O, tau, tw);
                kf_load(kf + 4096, kfo);
                __syncthreads();
                if (cv_inner) { fft_mid(E, tau, kfe); fft_mid(O, tau, kfo); }
                if (ord == 0) {
#pragma unroll
                    for (int bb = 0; bb < 2; ++bb)
#pragma unroll
                        for (int k = 0; k < 2; ++k) raw2[bb][k] = *(const f16x8*)(ut + (size_t)(2 * D + d) * TT + col0 + (size_t)bb * 4096 + (size_t)(tau + 256 * k) * 8); }
                __syncthreads();
                if (cv_inner) fft_pass1_pair<true>(E, O, tau, tw);
                __syncthreads();
                if (cv_outer) fft_inv0<256>(E, O, tau, tw, y); else {
#pragma unroll
                    for (int jj = 0; jj < 16; ++jj) y[jj] = xin[jj]; }
#pragma unroll
                for (int jj = 0; jj < 16; ++jj) xin[jj] = gk[jj] * y[jj];
                if (ord == 0) {
                    __syncthreads();
#pragma unroll
                    for (int bb = 0; bb < 2; ++bb)
#pragma unroll
                        for (int k = 0; k < 2; ++k) *(LAS f16x8*)(ST + bb * ST_P + 8 + (tau + 256 * k) * 8) = raw2[bb][k];
                    if (tau < 2) { ST[tau * ST_P + 7] = (h16)0.f; ST[tau * ST_P + 8 + 4096] = (h16)0.f; }
                    __syncthreads();
                    const float g0 = cw[2 * D + d], g1 = cw[D3 + 2 * D + d], g2 = cw[2 * D3 + 2 * D + d], gb = cb[2 * D + d];
#pragma unroll
                    for (int jj = 0; jj < 16; ++jj) { const int nn = tau + 256 * jj; gk[jj] = (f32x2){conv3_lds(ST + 8, nn, g0, g1, g2, gb), conv3_lds(ST + ST_P + 8, nn, g0, g1, g2, gb)}; }
                    __syncthreads();
                }
            }
            h16* o0 = zt + (size_t)d * TT + col0; h16* o1 = o0 + 4096;
#pragma unroll
            for (int jj = 0; jj < 16; ++jj) { const int nn = tau + 256 * jj; o0[nn] = (h16)xin[jj].x; o1[nn] = (h16)xin[jj].y; }
        }
    }
    {
        const int pr = tid >> 4, i = tid & 15, c8 = pr >> 2, bp = pr & 3;
        LAS f32x2* E = (LAS f32x2*)(lds + pr * 4352); LAS f32x2* O = E + 272; LAS h16* ST = (LAS h16*)lds;
        for (int unit = blockIdx.x; unit < 256; unit += gridDim.x) {
            const int d0 = unit * 8, d = d0 + c8;
            const f32x2* kfb = (const f32x2*)(p.ws + WS_KFC) + ((size_t)(jl * 2) * 2048 + d) * 512 + (size_t)i * 16;
            f16x8 raw[3][4];
#pragma unroll
            for (int sq = 0; sq < 3; ++sq)
#pragma unroll
                for (int k = 0; k < 4; ++k) { const int q = tid + 512 * k, row = q >> 5, ch = q & 31;
                    raw[sq][k] = *(const f16x8*)(ut + (size_t)(sq * D + d0 + (row >> 3)) * TT + TL + (row & 7) * 256 + ch * 8); }
            __syncthreads();
#pragma unroll
            for (int sq = 0; sq < 2; ++sq)
#pragma unroll
                for (int k = 0; k < 4; ++k) { const int q = tid + 512 * k, row = q >> 5, ch = q & 31; *(LAS f16x8*)(ST + (sq * 64 + row) * STS_P + 8 + ch * 8) = raw[sq][k]; }
            if (tid < 128) { ST[tid * STS_P + 7] = (h16)0.f; ST[tid * STS_P + 8 + 256] = (h16)0.f; }
            __syncthreads();
            f32x2 xin[16], gk[16], y[16];
            { const float w0 = cw[d], w1 = cw[D3 + d], w2 = cw[2 * D3 + d], bv = cb[d]; const float g0 = cw[D + d], g1 = cw[D3 + D + d], g2 = cw[2 * D3 + D + d], gb = cb[D + d];
                const LAS h16* r0 = ST + (c8 * 8 + 2 * bp) * STS_P + 8; const LAS h16* r1 = r0 + 64 * STS_P;
#pragma unroll
                for (int jj = 0; jj < 16; ++jj) { const int nn = i + 16 * jj;
                    xin[jj] = (f32x2){conv3_lds(r0, nn, w0, w1, w2, bv), conv3_lds(r0 + STS_P, nn, w0, w1, w2, bv)};
                    gk[jj] = (f32x2){conv3_lds(r1, nn, g0, g1, g2, gb), conv3_lds(r1 + STS_P, nn, g0, g1, g2, gb)}; } }
            __syncthreads();
#pragma unroll 1
            for (int ord = 0; ord < 2; ++ord) {
                const f32x2* kf = kfb + (size_t)ord * 2048 * 512; f32x4 kfe[8], kfo[8];
                fft_fwd0<16>(xin, xin, E, O, i, tw);
                __syncthreads();
                kf_load(kf, kfe); fft_mid(E, i, kfe); kf_load(kf + 256, kfo); fft_mid(O, i, kfo);
                __syncthreads();
                fft_inv0<16>(E, O, i, tw, y);
#pragma unroll
                for (int jj = 0; jj < 16; ++jj) xin[jj] = gk[jj] * y[jj];
                if (ord == 0) {
                    __syncthreads();
#pragma unroll
                    for (int k = 0; k < 4; ++k) { const int q = tid + 512 * k, row = q >> 5, ch = q & 31; *(LAS f16x8*)(ST + row * STS_P + 8 + ch * 8) = raw[2][k]; }
                    if (tid < 64) { ST[tid * STS_P + 7] = (h16)0.f; ST[tid * STS_P + 8 + 256] = (h16)0.f; }
                    __syncthreads();
                    const float g0 = cw[2 * D + d], g1 = cw[D3 + 2 * D + d], g2 = cw[2 * D3 + 2 * D + d], gb = cb[2 * D + d];
                    const LAS h16* r0 = ST + (c8 * 8 + 2 * bp) * STS_P + 8;
#pragma unroll
                    for (int jj = 0; jj < 16; ++jj) { const int nn = i + 16 * jj; gk[jj] = (f32x2){conv3_lds(r0, nn, g0, g1, g2, gb), conv3_lds(r0 + STS_P, nn, g0, g1, g2, gb)}; }
                    __syncthreads();
                }
            }
            h16* o0 = zt + (size_t)d * TT + TL + (2 * bp) * 256; h16* o1 = o0 + 256;
#pragma unroll
            for (int jj = 0; jj < 16; ++jj) { const int nn = i + 16 * jj; o0[nn] = (h16)xin[jj].x; o1[nn] = (h16)xin[jj].y; }
        }
    }
}

constexpr int AT_KP = 72, AT_VP = 68;
__device__ __forceinline__ void attn_phase(const Params& p, int jl, bool with_ctx_out, LAS unsigned char* lds, int cvt_layer = -1, int cvt_n = 0) {
    const int tid = tid_fresh(), wv = tid >> 6, lane = tid & 63, r32 = lane & 31, hh = lane >> 5;
    LAS h16* Ks = (LAS h16*)lds; LAS h16* Vs = (LAS h16*)(lds + 64 * AT_KP * 2);
    const h16* qk = (const h16*)(p.ws + WS_QK); const h16* vt = (const h16*)(p.ws + WS_VT); h16* ob = (h16*)(p.ws + WS_HBUF);
    LAS float* rcos = (LAS float*)(lds + 65536); LAS float* rsin = rcos + 1024;
    { const float* rg = (const float*)(p.ws + WS_ROPE); for (int i = tid; i < 2048; i += 512) rcos[i] = rg[i]; }
    __syncthreads();
    const int nunit = 2048 + (with_ctx_out ? 128 : 0);
    int uit = 0; const int utrig = 2 * (((int)blockIdx.x >> 3) & 3);
    for (int unit = blockIdx.x; unit < nunit; unit += gridDim.x, ++uit) {
        if (cvt_layer >= 0 && uit == utrig) { __syncthreads(); cvt_moe_share(p, cvt_layer, blockIdx.x, cvt_n, gridDim.x, (LAS float*)lds); }
        int kind, b, g, qb;
        if (unit < 2048) { kind = 0; qb = unit & 63; g = (unit >> 6) & 3; b = unit >> 8; } else { const int u2 = unit - 2048; kind = 1; qb = u2 & 3; g = (u2 >> 2) & 3; b = u2 >> 4; }
        const int head = g * 8 + wv;
        const int qrow0 = kind ? (TL + b * 256 + qb * 64) : (b * 4096 + qb * 64);
        const int ctxrow0 = TL + b * 256;
        f16x8 qf[2][4];
#pragma unroll
        for (int qt = 0; qt < 2; ++qt) {
            f32x4 qv[4][2];
            const h16* qp = qk + (size_t)(qrow0 + 32 * qt + r32) * DQK + head * 64 + 8 * hh;
#pragma unroll
            for (int ks = 0; ks < 4; ++ks) { const f16x8 t = *(const f16x8*)(qp + 16 * ks);
#pragma unroll
                for (int i = 0; i < 4; ++i) { qv[ks][0][i] = (float)t[i]; qv[ks][1][i] = (float)t[4 + i]; } }
            if (kind == 0) {
                const int colpos = 32 * qt + r32;
#pragma unroll
                for (int a = 0; a < 2; ++a) { const int pos = a ? colpos : qb; const LAS float* cp = rcos + pos * 16 + 8 * hh; const LAS float* sp = rsin + pos * 16 + 8 * hh;
#pragma unroll
                    for (int e = 0; e < 2; ++e) { const f32x4 c = *(const LAS f32x4*)(cp + 4 * e), s = *(const LAS f32x4*)(sp + 4 * e);
                        const f32x4 x1 = qv[2 * a][e], x2 = qv[2 * a + 1][e]; qv[2 * a][e] = x1 * c - x2 * s; qv[2 * a + 1][e] = x2 * c + x1 * s; } }
            }
#pragma unroll
            for (int ks = 0; ks < 4; ++ks)
#pragma unroll
                for (int i = 0; i < 4; ++i) { qf[qt][ks][i] = (h16)(qv[ks][0][i] * (0.125f * 1.4426950408889634f)); qf[qt][ks][4 + i] = (h16)(qv[ks][1][i] * (0.125f * 1.4426950408889634f)); }
        }
        const float sink = p.at_sink[jl * 32 + head] * 1.4426950408889634f;
        float mrun[2] = {sink, sink}, lrun[2] = {hh == 0 ? 1.f : 0.f, hh == 0 ? 1.f : 0.f};
        f32x16 oacc[2][2];
#pragma unroll
        for (int a = 0; a < 2; ++a)
#pragma unroll
            for (int c = 0; c < 2; ++c)
#pragma unroll
                for (int i = 0; i < 16; ++i) oacc[a][c][i] = 0.f;
        const int t_lo = kind ? 0 : (qb < 2 ? 2 - qb : 0), t_hi = kind ? -1 : (65 - qb < 4 ? 65 - qb : 4); const int nwin = t_hi - t_lo + 1, nv = nwin + 4;
        const bool krole = tid < 256; const int kkey = tid >> 2, kcp = tid & 3, kdA = (kcp & 1) * 8 + (kcp >> 1) * 32; const int vdim = (tid - 256) >> 2, vkc = tid & 3;
        f16x8 ld0, ld1;
#define AT_TILE(sidx, KROW0, MASK, ROPE) do { if ((sidx) < nwin) { const int _ti = t_lo + (sidx); KROW0 = b * 4096 + qb * 64 - 128 + 64 * _ti; ROPE = true; MASK = (_ti == 0) ? 1 : (_ti == 4) ? 2 : 0; } \
            else { KROW0 = ctxrow0 + 64 * ((sidx) - nwin); ROPE = false; MASK = 0; } } while (0)
#define AT_LOAD(KROW0) do { if (krole) { const h16* kp = qk + (size_t)((KROW0) + kkey) * DQK + D + g * 64 + kdA; ld0 = *(const f16x8*)kp; ld1 = *(const f16x8*)(kp + 16); } \
            else { const h16* vp = vt + (size_t)(g * 64 + vdim) * TT + (KROW0) + 16 * vkc; ld0 = *(const f16x8*)vp; ld1 = *(const f16x8*)(vp + 8); } } while (0)
        { int kr0, mk; bool rp; AT_TILE(0, kr0, mk, rp); (void)mk; (void)rp; AT_LOAD(kr0); }
#pragma unroll 1
        for (int sx = 0; sx < nv; ++sx) {
            int krow0, mask; bool rope; AT_TILE(sx, krow0, mask, rope);
            __syncthreads();
            if (krole) {
                f16x8 o1 = ld0, o2 = ld1;
                if (rope) { const int kpos = (krow0 - b * 4096) + kkey; const int pos = (kcp >> 1) ? (kpos & 63) : (kpos >> 6);
                    const LAS float* cpp = rcos + pos * 16 + (kcp & 1) * 8; const LAS float* spp = rsin + pos * 16 + (kcp & 1) * 8;
#pragma unroll
                    for (int i = 0; i < 8; ++i) { const float c = cpp[i], s = spp[i], x1 = (float)ld0[i], x2 = (float)ld1[i]; o1[i] = (h16)(x1 * c - x2 * s); o2[i] = (h16)(x2 * c + x1 * s); } }
                *(LAS f16x8*)(Ks + kkey * AT_KP + kdA) = o1; *(LAS f16x8*)(Ks + kkey * AT_KP + kdA + 16) = o2;
            } else {
                LAS h16* dst = Vs + vdim * AT_VP + 16 * vkc;
                *(LAS f16x4*)(dst) = (f16x4){ld0[0], ld0[1], ld0[2], ld0[3]}; *(LAS f16x4*)(dst + 4) = (f16x4){ld0[4], ld0[5], ld0[6], ld0[7]};
                *(LAS f16x4*)(dst + 8) = (f16x4){ld1[0], ld1[1], ld1[2], ld1[3]}; *(LAS f16x4*)(dst + 12) = (f16x4){ld1[4], ld1[5], ld1[6], ld1[7]};
            }
            if (sx + 1 < nv) { int kr1, mk1; bool rp1; AT_TILE(sx + 1, kr1, mk1, rp1); (void)mk1; (void)rp1; AT_LOAD(kr1); }
            __syncthreads();
#pragma unroll
            for (int qt = 0; qt < 2; ++qt) {
                f32x16 sacc[2];
#pragma unroll
                for (int kt = 0; kt < 2; ++kt)
#pragma unroll
                    for (int i = 0; i < 16; ++i) sacc[kt][i] = 0.f;
#pragma unroll
                for (int ks = 0; ks < 4; ++ks)
#pragma unroll
                    for (int kt = 0; kt < 2; ++kt) { const f16x8 kf = *(const LAS f16x8*)(Ks + (32 * kt + r32) * AT_KP + 16 * ks + 8 * hh);
                        sacc[kt] = __builtin_amdgcn_mfma_f32_32x32x16_f16(kf, qf[qt][ks], sacc[kt], 0, 0, 0); }
                float tmax = -3.0e38f;
                if (mask != 0) {
                    int lim = r32 - 4 * hh; asm volatile("" : "+v"(lim));
                    if (mask == 1) {
#pragma unroll
                        for (int kt = 0; kt < 2; ++kt) {
                            if (kt < qt) {
#pragma unroll
                                for (int i = 0; i < 16; ++i) sacc[kt][i] = -1.0e30f; }
                            else if (kt == qt) {
#pragma unroll
                                for (int i = 0; i < 16; ++i) { const int kc = (i & 3) + 8 * (i >> 2); if (kc < lim) sacc[kt][i] = -1.0e30f; } } }
                    } else {
#pragma unroll
                        for (int kt = 0; kt < 2; ++kt) {
                            if (kt > qt) {
#pragma unroll
                                for (int i = 0; i < 16; ++i) sacc[kt][i] = -1.0e30f; }
                            else if (kt == qt) {
#pragma unroll
                                for (int i = 0; i < 16; ++i) { const int kc = (i & 3) + 8 * (i >> 2); if (kc > lim) sacc[kt][i] = -1.0e30f; } } }
                    } }
#pragma unroll
                for (int kt = 0; kt < 2; ++kt)
#pragma unroll
                    for (int i = 0; i < 16; ++i) tmax = fmaxf(tmax, sacc[kt][i]);
                tmax = fmaxf(tmax, shx(tmax, 32));
                const float mnew = fmaxf(mrun[qt], tmax); const float alpha = __builtin_amdgcn_exp2f(mrun[qt] - mnew); mrun[qt] = mnew;
                float psum = 0.f; f16x8 pf[2][2];
#pragma unroll
                for (int kt = 0; kt < 2; ++kt)
#pragma unroll
                    for (int s2 = 0; s2 < 2; ++s2)
#pragma unroll
                        for (int jj = 0; jj < 8; jj += 2) { const float p0 = __builtin_amdgcn_exp2f(sacc[kt][8 * s2 + jj] - mnew), p1 = __builtin_amdgcn_exp2f(sacc[kt][8 * s2 + jj + 1] - mnew);
                            const f16x2 pk = {(h16)p0, (h16)p1}; pf[kt][s2][jj] = pk[0]; pf[kt][s2][jj + 1] = pk[1];
                            psum = __builtin_amdgcn_fdot2(pk, (f16x2){(h16)1.0f, (h16)1.0f}, psum, false); }
                lrun[qt] = lrun[qt] * alpha + psum;
                if (__builtin_amdgcn_ballot_w64(alpha != 1.0f) != 0ull) {
#pragma unroll
                for (int dt = 0; dt < 2; ++dt)
#pragma unroll
                    for (int i = 0; i < 16; ++i) oacc[dt][qt][i] *= alpha; }
#pragma unroll
                for (int kt = 0; kt < 2; ++kt)
#pragma unroll
                    for (int s2 = 0; s2 < 2; ++s2)
#pragma unroll
                        for (int dt = 0; dt < 2; ++dt) { const LAS h16* vr = Vs + (32 * dt + r32) * AT_VP + 32 * kt + 16 * s2 + 4 * hh;
                            const f16x4 v0 = *(const LAS f16x4*)vr, v1 = *(const LAS f16x4*)(vr + 8);
                            const f16x8 vf = (f16x8){v0[0], v0[1], v0[2], v0[3], v1[0], v1[1], v1[2], v1[3]};
                            oacc[dt][qt] = __builtin_amdgcn_mfma_f32_32x32x16_f16(vf, pf[kt][s2], oacc[dt][qt], 0, 0, 0); }
            }
        }
#pragma unroll
        for (int qt = 0; qt < 2; ++qt) {
            const float ltot = lrun[qt] + shx(lrun[qt], 32); const float inv = 1.0f / ltot;
            h16* op = ob + (size_t)(qrow0 + 32 * qt + r32) * D + head * 64 + 4 * hh;
#pragma unroll
            for (int dt = 0; dt < 2; ++dt)
#pragma unroll
                for (int q4 = 0; q4 < 4; ++q4) { f16x4 w;
#pragma unroll
                    for (int i = 0; i < 4; ++i) w[i] = (h16)(oacc[dt][qt][4 * q4 + i] * inv);
                    *(f16x4*)(op + 32 * dt + 8 * q4) = w; }
        }
    }
}
#undef AT_TILE
#undef AT_LOAD

constexpr int NPHASE = 35;
#ifndef MK_MULTI
#define MK_MULTI 0
#endif

template <int KIND>
__attribute__((target("no-packed-fp32-ops"))) __global__ void __launch_bounds__(512, 2) hy_fwd(Params p_) {
    extern __shared__ __attribute__((aligned(16))) unsigned char shm[];
    LAS unsigned char* lds = (LAS unsigned char*)shm;
    constexpr bool ALL = KIND < 0;
    const int ph0 = p_.ph0;
    if (threadIdx.x == 0) { *(LAS u32x4*)(lds + LDS_XB) = (u32x4){0u, 0u, 0u, 0u}; }
    __syncthreads();
    XcdBarrier bar;
    if constexpr (ALL) bar = xcd_barrier_post((unsigned*)(p_.ws + WS_CTL), (volatile LAS unsigned*)(lds + LDS_XB));
#ifndef PROBE_SITE
#define PROBE_SITE -1
#endif
#define SITE(k) if constexpr (ALL || KIND == (k)) for (int rep_ = 0; rep_ < ((k) == PROBE_SITE ? 2 : 1); ++rep_) if (const Params& p = *params_fresh(); true)
#ifndef PROBE_XBAR
#define PROBE_XBAR 1
#endif
#define SEAM() do { if constexpr (ALL) { xcd_barrier(bar); if (PROBE_XBAR > 1) xcd_barrier(bar); if (PROBE_XBAR > 2) xcd_barrier(bar); } } while (0)
    const int G = gridDim.x, bid = blockIdx.x;
    SITE(0) {
        for (int u = bid; u < 4993; u += G) {
            if (u < 384) modp_unit(p, u, (LAS float*)lds);
            else if (u == 384) tables_unit(p);
            else if (u < 1473) h2_task(p, (u - 385) * 8 + (tid_fresh() >> 6));
            else if (u < 1537) w3p_unit(p, u - 1473);
            else if (u < 1793) rtab_unit(p, u - 1537);
            else cvt_dense_unit(p, u - 1793, (LAS float*)lds);
        }
        SEAM();
    }
    SITE(1) {
        for (int u = bid; u < 216; u += G) modr_unit(p, u);
        SchedFilt S{p.ws + WS_W3P, p.ws + WS_H2P}; EpiTaps E{(float*)(p.ws + WS_TAPS), (float*)(p.ws + WS_TAPSC)};
        pg8::gemm_phase<EpiTaps, SchedFilt, 0>(lds, 256, S, E);
        SEAM();
    }
#define TAIL_IDLE(nunits) (((nunits) % G) ? G - ((nunits) % G) : 0)
#define CVT_PER_GEMM 20
#pragma unroll 1
    for (int layer = ALL ? 0 : ph0; layer < (ALL ? NLAYER : ph0 + 1); ++layer) {
        const bool hyena = (layer & 1) == 0; const int jl = layer >> 1;
        const int nu1 = hyena ? 24 * 136 : 136 * 10, nu4 = (layer == NLAYER - 1 ? 128 : 136) * 8;
        const int idle1 = TAIL_IDLE(nu1), idle4 = TAIL_IDLE(nu4);
        int cv4 = idle4 * CVT_PER_GEMM, cv1 = idle1 * CVT_PER_GEMM; if (cv4 > CVT_MOE_UNITS / 2) cv4 = CVT_MOE_UNITS / 2; if (cv1 > CVT_MOE_UNITS / 2 - 1) cv1 = CVT_MOE_UNITS / 2 - 1;
        const int cvN0 = CVT_MOE_UNITS - cv1 - cv4, cvN1 = cvN0 + cv1;
        SITE(2) {
            n1_phase(p, layer, (h16*)(p.ws + ((!ALL && p.ph1) ? WS_UT : WS_XRES)));
            for (int rep2_ = 0; rep2_ < ((PROBE_SITE == 20 && layer > 0) ? 2 : 1); ++rep2_) {
            if (layer == 0) filt_fft_phase(p, lds);
            else { (void)0; } }
            SEAM();
        }
        SITE(3) {
#ifdef PROBE_CLK
            unsigned long long pc0_ = __builtin_readcyclecounter(), pr0_ = wall_clock64();
#endif
            if (hyena) { SchedPlain S{24, 136, D, p.ws + WS_WIN + (size_t)jl * D3 * D * 2, p.ws + WS_HBUF}; EpiH16 E{(h16*)(p.ws + WS_UT), TT, nullptr, 0};
                pg8::gemm_phase<EpiH16, SchedPlain, 0>(lds, D, S, E); }
            else { SchedQkv S{p.ws + WS_HBUF, p.ws + WS_WQKV + (size_t)jl * DQKV * D * 2}; EpiH16 E{(h16*)(p.ws + WS_QK), DQK, (h16*)(p.ws + WS_VT), TT};
                pg8::gemm_phase<EpiH16, SchedQkv, 0>(lds, D, S, E); }
#ifdef PROBE_CLK
            if (bid == 0 && threadIdx.x == 0) { const unsigned long long dc = __builtin_readcyclecounter() - pc0_, dr = wall_clock64() - pr0_; const unsigned long long spin = dc * 2500ull / (dr ? dr : 1ull);
                const unsigned long long t0 = wall_clock64(); while (wall_clock64() - t0 < spin) __builtin_amdgcn_s_sleep(8); }
#endif
            if (idle1 > 0 && bid >= G - idle1) { cvt_moe_share(p, layer, cvN0 + (bid - (G - idle1)), cvN1, idle1, (LAS float*)lds); }
            SEAM();
        }
        SITE(4) {
#ifdef PROBE_PAR
            for (int rep3_ = 0; rep3_ < (((layer & 1) == PROBE_PAR) ? 2 : 1); ++rep3_)
#endif
            { if (hyena) conv_phase(p, jl, lds, ALL ? 0 : p.ph1, layer, cvN0);
            else attn_phase(p, jl, layer != NLAYER - 1, lds, layer, cvN0); }
            SEAM();
        }
        SITE(5) {
            (void)0;
        }
        SITE(6) {
            EpiResid E{(h16*)(p.ws + WS_XRES), (const float*)(p.ws + WS_MODS), layer, (float*)(p.ws + WS_SSQ), (!ALL && p.ph1) ? (h16*)(p.ws + WS_YC) : (h16*)(p.ws + WS_XRES)};
            if (hyena) {
                SchedPlainAT S{layer == NLAYER - 1 ? 128 : 136, 8, D, p.ws + WS_ZT, p.ws + WS_WOUT + (size_t)jl * D * D * 2};
                pg8::gemm_phase<EpiResid, SchedPlainAT, 2>(lds, D, S, E, TT);
            } else {
                SchedPlain S{layer == NLAYER - 1 ? 128 : 136, 8, D, p.ws + WS_HBUF, p.ws + WS_WO + (size_t)jl * D * D * 2};
                pg8::gemm_phase<EpiResid, SchedPlain, 0>(lds, D, S, E);
            }
            if (idle4 > 0 && bid >= G - idle4) { cvt_moe_share(p, layer, cvN1 + (bid - (G - idle4)), CVT_MOE_UNITS, idle4, (LAS float*)lds); }
            SEAM();
        }
        SITE(7) { n2_phase(p, layer, lds, ALL ? 0 : p.ph1); SEAM(); }
        LAS int* tstart = (LAS int*)(lds + LDS_MISC); LAS int* texp = tstart + 80; LAS int* tcnt = texp + 352;
        SITE(8) {
            moe_table(tstart, texp, tcnt, (const int*)(p.ws + WS_CTL) + CTL_CNT + layer * NE);
            SchedMoe1 S{{tstart, texp, tcnt}, p.ws + WS_HBUF, p.ws + WS_W13, (const int*)(p.ws + WS_LIST)}; EpiMoe1 E{(h16*)(p.ws + WS_H1)};
            pg8::gemm_phase<EpiMoe1, SchedMoe1, 1>(lds, D, S, E);
            SEAM();
        }
        SITE(9) {
            moe_table(tstart, texp, tcnt, (const int*)(p.ws + WS_CTL) + CTL_CNT + layer * NE);
            SchedMoe2 S{{tstart, texp, tcnt}, p.ws + WS_H1, p.ws + WS_W2, (const int*)(p.ws + WS_LIST)}; EpiMoe2 E{(h16*)(p.ws + WS_YC), (const float*)(p.ws + WS_GATE), (const int*)(p.ws + WS_LIST)};
            pg8::gemm_phase<EpiMoe2, SchedMoe2, 0>(lds, DE, S, E);
            SEAM();
        }
    }
    SITE(10) final_phase(p);
#undef SITE
#undef SEAM
}

template <int KIND> static void launch_kind(const Params& p, int grid, hipStream_t stream) {
    static bool attr = false;
    if (!attr) { attr = true; if (hipFuncSetAttribute((const void*)hy_fwd<KIND>, hipFuncAttributeMaxDynamicSharedMemorySize, LDS_BYTES) != hipSuccess) fprintf(stderr, "kernel_launch: hipFuncSetAttribute failed (kind %d)\n", KIND); }
    hipLaunchKernelGGL(hy_fwd<KIND>, dim3(grid), dim3(512), LDS_BYTES, stream, p);
}

extern "C" void kernel_launch(void* const* d_in, const int* in_sizes, int n_in, void* d_out, int out_size, void* d_ws, size_t ws_size, hipStream_t stream) {
    static int grid = 0;
    if (!grid) {
        if (n_in != 29 || out_size != TL * D || ws_size < WS_END) { fprintf(stderr, "kernel_launch: unexpected problem (n_in %d, out %d, ws %zu < %zu)\n", n_in, out_size, ws_size, (size_t)WS_END); grid = -1; return; }
        int dev = 0, cus = 0;
        if (hipGetDevice(&dev) != hipSuccess || hipDeviceGetAttribute(&cus, hipDeviceAttributeMultiprocessorCount, dev) != hipSuccess) { grid = -1; return; }
        grid = cus;
    }
    if (grid <= 0) return;
    (void)hipMemsetAsync((char*)d_ws + WS_CTL, 0, CTL_BYTES, stream);
    Params p{};
    const float** pp = (const float**)&p;
    for (int i = 0; i < 29; ++i) pp[i] = (const float*)d_in[i];
    p.out = (float*)d_out; p.ws = (char*)d_ws;
#if MK_MULTI
    p.ph0 = 0; p.ph1 = 0;
    launch_kind<0>(p, grid, stream); launch_kind<1>(p, grid, stream);
#ifndef PROBE_KINDS
#define PROBE_KINDS 0
#endif
#ifndef PROBE_VAR
#define PROBE_VAR 0
#endif
#ifndef PROBE_LAYERS
#define PROBE_LAYERS 15
#endif
#define PKIND(k) ((PROBE_KINDS >> (k)) & 1)
#define PREP(k) ((PKIND(k) && ((PROBE_LAYERS >> layer) & 1)) ? 2 : 1)
    if (PKIND(0)) launch_kind<0>(p, grid, stream);
    if (PKIND(1)) launch_kind<1>(p, grid, stream);
    for (int layer = 0; layer < NLAYER; ++layer) { p.ph0 = layer;
        for (int r = 0; r < PREP(2); ++r) { p.ph1 = (PREP(2) == 2 && r == 0) ? 1 : 0; launch_kind<2>(p, grid, stream); p.ph1 = 0; }
        for (int r = 0; r < PREP(3); ++r) { p.ph1 = (PREP(3) == 2 && r == 0) ? PROBE_VAR : 0; launch_kind<3>(p, grid, stream); p.ph1 = 0; }
        for (int r = 0; r < PREP(4); ++r) { p.ph1 = (PREP(4) == 2 && r == 0) ? 1 : 0; launch_kind<4>(p, grid, stream); p.ph1 = 0; }
        if (PREP(6) == 2) { p.ph1 = 1; launch_kind<6>(p, grid, stream); p.ph1 = 0; }
        launch_kind<6>(p, grid, stream); launch_kind<7>(p, grid, stream);
        if (PREP(7) == 2) { p.ph1 = 1; launch_kind<7>(p, grid, stream); p.ph1 = 0; }
        for (int r = 0; r < PREP(8); ++r) launch_kind<8>(p, grid, stream);
        for (int r = 0; r < PREP(9); ++r) launch_kind<9>(p, grid, stream); }
    p.ph0 = 0; launch_kind<10>(p, grid, stream);
    if (PKIND(10)) launch_kind<10>(p, grid, stream);
#else
    p.ph0 = 0; p.ph1 = NPHASE;
    launch_kind<-1>(p, grid, stream);
#endif
}
```

```cpp
#include <hip/hip_runtime.h>
#include <cstdio>
#include <cstdint>

#define LAS __attribute__((address_space(3)))
typedef _Float16 h16;
typedef _Float16 f16x8 __attribute__((ext_vector_type(8)));
typedef _Float16 f16x4 __attribute__((ext_vector_type(4)));
typedef _Float16 f16x2 __attribute__((ext_vector_type(2)));
typedef float f32x2 __attribute__((ext_vector_type(2)));
typedef float f32x4 __attribute__((ext_vector_type(4)));
typedef float f32x16 __attribute__((ext_vector_type(16)));
typedef unsigned u32x2 __attribute__((ext_vector_type(2)));
typedef unsigned u32x4 __attribute__((ext_vector_type(4)));

constexpr int D = 2048, NB = 8, SEQ = 4096, CTXL = 256, TL = NB * SEQ, TC = NB * CTXL, TT = TL + TC;
constexpr int D3 = 3 * D, D6 = 6 * D, DQK = 2304, DQKV = 2560, NE = 64, DE = 384, DE2 = 768, NLAYER = 4;
constexpr int LCAP = TT;
constexpr int MOE_ROWS = 86016;
constexpr float EPS = 1e-6f;

constexpr size_t WS_CTL = 0;
constexpr size_t CTL_BYTES = 65536;
constexpr size_t WS_TW = WS_CTL + CTL_BYTES;
constexpr size_t WS_ROPE = WS_TW + 65536;
constexpr size_t WS_MODP = WS_ROPE + 8192;
constexpr size_t WS_MODS = WS_MODP + 16ull * 4 * 9 * 12288 * 4;
constexpr size_t WS_RTAB = WS_MODS + 4ull * 9 * 12288 * 4;
constexpr size_t RTAB_L = 64ull * 5 * 2 * 64 * 8 * 2;
constexpr size_t WS_RCST = WS_RTAB + 4 * RTAB_L;
constexpr size_t WS_H2P = WS_RCST + 16384;
constexpr size_t WS_W3P = WS_H2P + 2ull * 4352 * 256 * 2;
constexpr size_t WS_XRES = WS_W3P + 2ull * 8192 * 256 * 2;
constexpr size_t WS_HBUF = WS_XRES + (size_t)TT * D * 4;
constexpr size_t WS_UT = WS_HBUF + (size_t)TT * D * 2;
constexpr size_t UT_BYTES = (size_t)D3 * TT * 2;
constexpr size_t WS_TAPS = WS_UT;
constexpr size_t WS_TAPSC = WS_TAPS + 2ull * 8192 * 4096 * 4;
constexpr size_t WS_QK = WS_UT;
constexpr size_t WS_VT = WS_QK + (size_t)TT * DQK * 2;
constexpr size_t WS_ZT = WS_UT + UT_BYTES;
constexpr size_t WS_H1 = WS_ZT + (size_t)D * TT * 2;
constexpr size_t WS_YC = WS_H1 + (size_t)MOE_ROWS * DE * 2;
constexpr size_t WS_WIN = WS_YC + 2ull * TT * D * 2;
constexpr size_t WS_WOUT = WS_WIN + 2ull * D3 * D * 2;
constexpr size_t WS_WQKV = WS_WOUT + 2ull * D * D * 2;
constexpr size_t WS_WO = WS_WQKV + 2ull * DQKV * D * 2;
constexpr size_t WS_W13 = WS_WO + 2ull * D * D * 2;
constexpr size_t WS_W2 = WS_W13 + (size_t)NE * DE2 * D * 2;
constexpr size_t WS_KF = WS_W2 + (size_t)NE * D * DE * 2;
constexpr size_t WS_KFC = WS_KF + 2ull * 2 * 2048 * 65536;
constexpr size_t WS_LIST = WS_KFC + 2ull * 2 * 2048 * 4096;
constexpr size_t WS_GATE = WS_LIST + (size_t)NE * LCAP * 4;
constexpr size_t WS_SSQ = WS_GATE + (size_t)NE * LCAP * 4;
constexpr size_t WS_END = WS_SSQ + (size_t)TT * 32 * 4;
static_assert(WS_TAPSC + 2ull * 8192 * 256 * 4 <= WS_UT + UT_BYTES, "taps alias");
static_assert(WS_VT + 256ull * TT * 2 <= WS_UT + UT_BYTES, "qkv alias");

constexpr int CTL_CNT = 4096;

constexpr int LDS_BYTES = 147456;
constexpr int LDS_MISC = 139264;
constexpr int LDS_XB = LDS_BYTES - 16;

struct Params {
    const float *x, *c, *ctx, *c_ctx, *mod_w, *mod_b, *hy_w_in, *hy_conv_w, *hy_conv_b, *hy_f_w1, *hy_f_b1, *hy_f_freq1, *hy_f_w2, *hy_f_b2, *hy_f_freq2, *hy_f_w3,
        *hy_bias, *hy_w_out, *at_w_qkv, *at_sink, *at_w_o, *moe_wg, *moe_bg, *moe_we, *moe_be, *moe_w1, *moe_w3, *moe_w2, *final_gain;
    float* out; char* ws; int ph0, ph1;
};

__device__ __forceinline__ int tid_fresh() { int t = threadIdx.x; asm volatile("" : "+v"(t)); return t; }
__device__ __forceinline__ float bperm_f(float v, int srclane) { return __int_as_float(__builtin_amdgcn_ds_bpermute(srclane << 2, __float_as_int(v))); }
__device__ __forceinline__ float shx(float v, int mask) { return bperm_f(v, (tid_fresh() & 63) ^ mask); }
__device__ __forceinline__ const Params* params_fresh() { auto q = __builtin_amdgcn_kernarg_segment_ptr(); asm volatile("" : "+s"(q)); return (const Params*)q; }

#define XB_TMO      128
#define XB_XCNT(j)  (256  + 64 * (j))
#define XB_XSUB(j)  (1280 + 64 * (j))
#define XB_XGEN(j)  (2304 + 64 * (j))
#define XB_TOP      3328
#define XB_TOPGEN   3392
#define XCD_BAR_WORDS 3456
#define XB_SPIN_CAP (1u << 18)

__device__ __forceinline__ unsigned xb_ld(unsigned* p)              { return __hip_atomic_load(p, __ATOMIC_RELAXED, __HIP_MEMORY_SCOPE_AGENT); }
__device__ __forceinline__ unsigned xb_add(unsigned* p, unsigned v) { return __hip_atomic_fetch_add(p, v, __ATOMIC_RELAXED, __HIP_MEMORY_SCOPE_AGENT); }
__device__ __forceinline__ unsigned xb_xcc_id() { return (unsigned)__builtin_amdgcn_s_getreg((3 << 11) | 20) & 0xFu; }
#define XB_SPIN(cond, bar) do { unsigned _sp = 0; while (cond) { __builtin_amdgcn_s_sleep(1); \
    if ((++_sp & 255u) == 0u) { if (xb_ld(&(bar)[XB_TMO])) break; if (_sp > XB_SPIN_CAP) { atomicAdd(&(bar)[XB_TMO], 1u); break; } } } } while (0)

struct XcdBarrier { unsigned* bar; volatile LAS unsigned* st; };

__device__ __forceinline__ XcdBarrier xcd_barrier_post(unsigned* bar, volatile LAS unsigned* st) {
    XcdBarrier b; b.bar = bar; b.st = st;
    if (threadIdx.x == 0) (void)xb_add(&bar[XB_XCNT(xb_xcc_id())], 1u);
    return b;
}
__device__ __forceinline__ void xcd_barrier_complete(unsigned* bar, unsigned x, unsigned& nloc, unsigned& nx) {
    const unsigned G = gridDim.x * gridDim.y * gridDim.z;
    unsigned sum, cnt, mine, sp = 0u;
    for (;;) {
        sum = 0u; cnt = 0u; mine = 0u;
#pragma unroll
        for (unsigned j = 0; j < 16; ++j) { const unsigned c = xb_ld(&bar[XB_XCNT(j)]); sum += c; cnt += (c > 0u) ? 1u : 0u; mine = (j == x) ? c : mine; }
        if (sum == G) break;
        __builtin_amdgcn_s_sleep(1);
        if ((++sp & 255u) == 0u) { if (xb_ld(&bar[XB_TMO])) break; if (sp > XB_SPIN_CAP) { atomicAdd(&bar[XB_TMO], 1u); break; } }
    }
    nloc = mine > 0u ? mine : 1u; nx = cnt > 0u ? cnt : 1u;
}
__device__ __forceinline__ void xcd_barrier(const XcdBarrier& b) {
    asm volatile("s_waitcnt vmcnt(0)" ::: "memory");
    __syncthreads();
    if (threadIdx.x == 0) {
        unsigned* bar = b.bar; const unsigned bx = xb_xcc_id();
        __builtin_amdgcn_s_waitcnt(0);
        unsigned nloc = b.st[0], nx = b.st[1];
        if (nloc == 0u) { xcd_barrier_complete(bar, bx, nloc, nx); b.st[0] = nloc; b.st[1] = nx; }
        const unsigned old = xb_add(&bar[XB_XSUB(bx)], 1u);
        const unsigned gen = old / nloc;
        if (old + 1u == (gen + 1u) * nloc) {
            __builtin_amdgcn_fence(__ATOMIC_RELEASE, "agent");
            asm volatile("s_waitcnt vmcnt(0)" ::: "memory");
            const unsigned og = xb_add(&bar[XB_TOP], 1u);
            const unsigned tg = og / nx;
            if (og + 1u == (tg + 1u) * nx) xb_add(&bar[XB_TOPGEN], 1u);
            else XB_SPIN(xb_ld(&bar[XB_TOPGEN]) == tg, bar);
            __builtin_amdgcn_fence(__ATOMIC_ACQUIRE, "agent");
            xb_add(&bar[XB_XGEN(bx)], 1u);
            asm volatile("s_waitcnt vmcnt(0)" ::: "memory");
        } else {
            XB_SPIN(xb_ld(&bar[XB_XGEN(bx)]) == gen, bar);
            __builtin_amdgcn_fence(__ATOMIC_ACQUIRE, "agent");
            asm volatile("s_waitcnt vmcnt(0)" ::: "memory");
        }
    }
    __syncthreads();
}

namespace pg8 {
constexpr int BM = 256, BK = 64, HALF = 128, HTB = HALF * BK * 2, STAGE_BYTES = 8 * HTB;
__device__ __forceinline__ int lds_byte(int r, int c) { const int st = (r >> 4) * 2 + (c >> 5), rr = r & 15, cc = c & 31, ob = rr * 64 + cc * 2; return st * 1024 + (ob ^ (((ob >> 9) & 1) << 5)); }
__device__ __forceinline__ void stage_rc(int b, int& R, int& C) { const int st = b / 1024, sb = b % 1024, swz = sb ^ (((sb >> 9) & 1) << 5); R = (st >> 1) * 16 + swz / 64; C = (st & 1) * 32 + (swz % 64) / 2; }
__device__ __forceinline__ int perm32(int rho) { const int n = rho >> 4, i = rho & 15; return 8 * (i >> 2) + 4 * n + (i & 3); }

struct Unit {
    int pm, pn;
    int e, pos0, cnt;
    int kind;
    int half;
    const char* A; const char* B;
    const int* rows;
};

typedef short s16x4 __attribute__((ext_vector_type(4)));
template <class Epi, class Sched, int AMODE>
__device__ __forceinline__ void gemm_phase(LAS unsigned char* lds, const int K, const Sched& S, const Epi& E, const int ldat = 0) {
    constexpr bool GATHER = AMODE == 1, ATR = AMODE == 2;
    const int tid = tid_fresh(), wid = __builtin_amdgcn_readfirstlane(tid >> 6), lane = tid & 63, wr = wid >> 2, wc = wid & 3, fr = lane & 15, fq = lane >> 4;
    const int nt = K / BK;
    unsigned voffA[2], voffB[2]; int RA[2], CA[2];
#pragma unroll
    for (int i = 0; i < 2; ++i) { int R, C; stage_rc(tid * 16 + i * 8192, R, C); const int Rb = Epi::PERM ? ((R & ~31) + perm32(R & 31)) : R;
        voffA[i] = (unsigned)(R * K + C) * 2u; voffB[i] = (unsigned)(Rb * K + C) * 2u; RA[i] = R; CA[i] = C;
        if constexpr (ATR) { const int bb = tid * 16 + i * 8192, row = bb >> 8, pc = (bb >> 4) & 15, ch = pc ^ (((row & 3) << 2) | ((row >> 2) & 3)); voffA[i] = (unsigned)(row * ldat + 8 * ch) * 2u; } }
    const size_t kstep = (size_t)(BK * 2);
    const size_t hstep = (size_t)HALF * K * 2;
    const size_t kstepA = ATR ? (size_t)BK * ldat * 2 : kstep, hstepA = ATR ? (size_t)HALF * 2 : hstep;
    const unsigned ldsw = (unsigned)wid * 1024u;
    const int aoff = lds_byte(wr * 64 + fr, fq * 8), boff = lds_byte(wc * 32 + fr, fq * 8);
    int atr[4][2];
#pragma unroll
    for (int m = 0; m < 4; ++m)
#pragma unroll
        for (int bl = 0; bl < 2; ++bl) { const int xr = ((fr >> 2) << 2) | ((2 * fq + bl) & 3); atr[m][bl] = (int)(unsigned)(uintptr_t)lds + 256 * (8 * fq + (fr >> 2) + 4 * bl) + 16 * ((wr * 8 + 2 * m + ((fr & 3) >> 1)) ^ xr) + 8 * (fr & 1); }
    unsigned vgC[2][2], vgN[2][2];
#define PG8_ROWS(u, vg) do { if constexpr (GATHER) { _Pragma("unroll") for (int _h = 0; _h < 2; ++_h) _Pragma("unroll") for (int _i = 0; _i < 2; ++_i) { \
        const int _p = (u).pos0 + _h * HALF + RA[_i]; const int _tok = (_p < (u).cnt) ? ((u).rows[_h * HALF + RA[_i]] >> 1) : 0; \
        vg[_h][_i] = ((unsigned)_tok * (unsigned)K + (unsigned)CA[_i]) * 2u; } } } while (0)
#define PG8_SA(b, h) (((b) * 2 + (h)) * HTB)
#define PG8_SB(b, h) ((4 + (b) * 2 + (h)) * HTB)
#define PG8_STAGE_B(bufoff, gbase) do { _Pragma("unroll") for (int _i = 0; _i < 2; ++_i) \
        __builtin_amdgcn_global_load_lds((const unsigned*)((const char*)(gbase) + voffB[_i]), (LAS unsigned*)(lds + (bufoff) + ldsw + _i * 8192), 16, 0, 0); } while (0)
#define PG8_STAGE_A(bufoff, gbase, h, NEXT) do { _Pragma("unroll") for (int _i = 0; _i < 2; ++_i) { \
        const unsigned _vo = GATHER ? ((NEXT) ? vgN[h][_i] : vgC[h][_i]) : voffA[_i]; \
        __builtin_amdgcn_global_load_lds((const unsigned*)((const char*)(gbase) + (GATHER ? (size_t)0 : (size_t)(h) * hstepA) + _vo), (LAS unsigned*)(lds + (bufoff) + ldsw + _i * 8192), 16, 0, 0); } } while (0)
#define PG8_LDA(dst, b, h) do { if constexpr (!ATR) { _Pragma("unroll") for (int m = 0; m < 4; ++m) _Pragma("unroll") for (int k = 0; k < 2; ++k) dst[m][k] = *(const LAS f16x8*)(lds + PG8_SA(b, h) + aoff + m * 2048 + k * 1024); } \
        else { _Pragma("unroll") for (int m = 0; m < 4; ++m) _Pragma("unroll") for (int k = 0; k < 2; ++k) { s16x4 _lo, _hi; \
            asm volatile("ds_read_b64_tr_b16 %0, %1 offset:%2" : "=v"(_lo) : "v"(atr[m][0]), "i"(PG8_SA(b, h) + k * 8192) : "memory"); \
            asm volatile("ds_read_b64_tr_b16 %0, %1 offset:%2" : "=v"(_hi) : "v"(atr[m][1]), "i"(PG8_SA(b, h) + k * 8192) : "memory"); \
            const short __attribute__((ext_vector_type(8))) _v = {_lo[0], _lo[1], _lo[2], _lo[3], _hi[0], _hi[1], _hi[2], _hi[3]}; dst[m][k] = __builtin_bit_cast(f16x8, _v); } } } while (0)
#define PG8_PIN(At) do { if constexpr (ATR) asm volatile("" : "+v"(At[0][0]), "+v"(At[0][1]), "+v"(At[1][0]), "+v"(At[1][1]), "+v"(At[2][0]), "+v"(At[2][1]), "+v"(At[3][0]), "+v"(At[3][1])); } while (0)
#define PG8_LDB(dst, b, h) do { _Pragma("unroll") for (int n = 0; n < 2; ++n) _Pragma("unroll") for (int k = 0; k < 2; ++k) dst[n][k] = *(const LAS f16x8*)(lds + PG8_SB(b, h) + boff + n * 2048 + k * 1024); } while (0)
#define PG8_MMA(ai, bj, At, Bt) do { __builtin_amdgcn_s_setprio(1); _Pragma("unroll") for (int m = 0; m < 4; ++m) _Pragma("unroll") for (int n = 0; n < 2; ++n) _Pragma("unroll") for (int k = 0; k < 2; ++k) \
        acc[ai][bj][m][n] = __builtin_amdgcn_mfma_f32_16x16x32_f16(Bt[n][k], At[m][k], acc[ai][bj][m][n], 0, 0, 0); __builtin_amdgcn_s_setprio(0); } while (0)
#define PG8_WAIT_V(n) asm volatile("s_waitcnt vmcnt(" #n ")" ::: "memory")
#define PG8_WAIT_L(n) asm volatile("s_waitcnt lgkmcnt(" #n ")" ::: "memory")
#define PG8_BAR __builtin_amdgcn_s_barrier()
#define PG8_SCHED __builtin_amdgcn_sched_barrier(0)
    Unit cur, nxt; int ui = 0;
    if (!S.next(0, cur)) return;
    f32x4 acc[2][2][4][2];
#pragma unroll
    for (int a = 0; a < 2; ++a)
#pragma unroll
        for (int b = 0; b < 2; ++b)
#pragma unroll
            for (int m = 0; m < 4; ++m)
#pragma unroll
                for (int n = 0; n < 2; ++n) acc[a][b][m][n] = (f32x4){0.f, 0.f, 0.f, 0.f};
    f16x8 At[4][2], B0[2][2], B1[2][2];
    const char* cA = cur.A; const char* cB = cur.B;
    PG8_ROWS(cur, vgC);
#pragma unroll
    for (int _h = 0; _h < 2; ++_h)
#pragma unroll
        for (int _i = 0; _i < 2; ++_i) vgN[_h][_i] = GATHER ? vgC[_h][_i] : 0u;
    PG8_STAGE_B(PG8_SB(0, 0), cB); PG8_STAGE_B(PG8_SB(0, 1), cB + hstep); PG8_STAGE_A(PG8_SA(0, 0), cA, 0, false); PG8_STAGE_A(PG8_SA(0, 1), cA, 1, false);
    if (wr == 1) PG8_BAR;
    PG8_WAIT_V(2); PG8_BAR;
    PG8_STAGE_B(PG8_SB(1, 0), cB + kstep); PG8_STAGE_A(PG8_SA(1, 0), cA + kstepA, 0, false); PG8_STAGE_B(PG8_SB(1, 1), cB + hstep + kstep);
    PG8_WAIT_V(6); PG8_BAR;
    for (;;) {
        const bool has_next = S.next(ui + 1, nxt);
        const bool full = cur.half == 0;
        const char* nA = has_next ? nxt.A : cA; const char* nB = has_next ? nxt.B : cB;
        if (has_next) { PG8_ROWS(nxt, vgN); }
        typename Epi::Pre pre; E.prefetch(cur, wr, fr, pre);
#pragma unroll 1
        for (int t = 0; t < nt; t += 2) {
            const bool last = (t == nt - 2);
            const char* a1 = cA + (size_t)(t + 1) * kstepA;
            const char* a2 = last ? nA : cA + (size_t)(t + 2) * kstepA; const char* b2 = last ? nB : cB + (size_t)(t + 2) * kstep;
            const char* a3 = a2 + kstepA; const char* b3 = b2 + kstep;
            PG8_LDB(B0, 0, 0); PG8_LDB(B1, 0, 1); PG8_SCHED; PG8_LDA(At, 0, 0); PG8_STAGE_A(PG8_SA(1, 1), a1, 1, false);
            PG8_WAIT_V(8); PG8_WAIT_L(0); PG8_PIN(At); PG8_BAR; PG8_MMA(0, 0, At, B0); PG8_MMA(0, 1, At, B1); PG8_BAR; PG8_SCHED;
            PG8_LDA(At, 0, 1); PG8_STAGE_B(PG8_SB(0, 0), b2); PG8_STAGE_B(PG8_SB(0, 1), b2 + hstep); PG8_STAGE_A(PG8_SA(0, 0), a2, 0, last);
            PG8_WAIT_V(8); PG8_WAIT_L(0); PG8_PIN(At); PG8_BAR; if (full) { PG8_MMA(1, 0, At, B0); PG8_MMA(1, 1, At, B1); } PG8_BAR; PG8_SCHED;
            PG8_LDB(B0, 1, 0); PG8_LDB(B1, 1, 1); PG8_SCHED; PG8_LDA(At, 1, 0); PG8_STAGE_A(PG8_SA(0, 1), a2, 1, last);
            PG8_WAIT_V(8); PG8_WAIT_L(0); PG8_PIN(At); PG8_BAR; PG8_MMA(0, 0, At, B0); PG8_MMA(0, 1, At, B1); PG8_BAR; PG8_SCHED;
            PG8_LDA(At, 1, 1); PG8_STAGE_B(PG8_SB(1, 0), b3); PG8_STAGE_B(PG8_SB(1, 1), b3 + hstep); PG8_STAGE_A(PG8_SA(1, 0), a3, 0, last);
            PG8_WAIT_V(8); PG8_WAIT_L(0); PG8_PIN(At); PG8_BAR; if (full) { PG8_MMA(1, 0, At, B0); PG8_MMA(1, 1, At, B1); } PG8_BAR; PG8_SCHED;
        }
        if (wr == 0) PG8_BAR;
        E(acc, cur, wr, wc, fr, fq, pre);
        if (!has_next) break;
#pragma unroll
        for (int a = 0; a < 2; ++a)
#pragma unroll
            for (int b = 0; b < 2; ++b)
#pragma unroll
                for (int m = 0; m < 4; ++m)
#pragma unroll
                    for (int n = 0; n < 2; ++n) acc[a][b][m][n] = (f32x4){0.f, 0.f, 0.f, 0.f};
        cur = nxt; cA = nA; cB = nB; ++ui;
#pragma unroll
        for (int _h = 0; _h < 2; ++_h)
#pragma unroll
            for (int _i = 0; _i < 2; ++_i) vgC[_h][_i] = vgN[_h][_i];
        if (wr == 1) PG8_BAR;
    }
    PG8_WAIT_V(0);
    PG8_BAR;
#undef PG8_ROWS
#undef PG8_SA
#undef PG8_SB
#undef PG8_STAGE_A
#undef PG8_STAGE_B
#undef PG8_LDA
#undef PG8_LDB
#undef PG8_PIN
#undef PG8_MMA
#undef PG8_WAIT_V
#undef PG8_WAIT_L
#undef PG8_BAR
#undef PG8_SCHED
}
}

using pg8::Unit;
__device__ __forceinline__ f16x8 pack8(const f32x4 a, const f32x4 b) {
    f16x8 w; w[0] = (h16)a[0]; w[1] = (h16)a[1]; w[2] = (h16)a[2]; w[3] = (h16)a[3]; w[4] = (h16)b[0]; w[5] = (h16)b[1]; w[6] = (h16)b[2]; w[7] = (h16)b[3]; return w;
}
struct EpiH16 {
    static constexpr bool PERM = true;
    h16* O0; int ld0; h16* O1; int ld1;
    struct Pre {}; __device__ __forceinline__ void prefetch(const Unit&, int, int, Pre&) const {}
    __device__ __forceinline__ void operator()(const f32x4 (&acc)[2][2][4][2], const Unit& u, int wr, int wc, int fr, int fq, const Pre&) const {
        h16* base = u.kind ? O1 : O0; const int ld = u.kind ? ld1 : ld0;
        const int row0 = u.pm * 256 + wr * 64 + fr, col0 = u.pn * 256 + wc * 32 + 8 * fq;
#pragma unroll
        for (int ai = 0; ai < 2; ++ai)
#pragma unroll
            for (int m = 0; m < 4; ++m) { h16* rowp = base + (size_t)(row0 + ai * 128 + m * 16) * ld + col0;
#pragma unroll
                for (int bj = 0; bj < 2; ++bj) __builtin_nontemporal_store(pack8(acc[ai][bj][m][0], acc[ai][bj][m][1]), (f16x8*)(rowp + bj * 128)); }
    }
};
struct EpiTaps {
    static constexpr bool PERM = false;
    float* T0; float* T1;
    struct Pre {}; __device__ __forceinline__ void prefetch(const Unit&, int, int, Pre&) const {}
    __device__ __forceinline__ void operator()(const f32x4 (&acc)[2][2][4][2], const Unit& u, int wr, int wc, int fr, int fq, const Pre&) const {
        const int j = u.kind >> 1, v = u.kind & 1; const int ld = v ? 256 : 4096;
        float* base = v ? (T1 + (size_t)j * 8192 * 256) : (T0 + (size_t)j * 8192 * 4096);
        const int row0 = u.pm * 256 + wr * 64 + fr, col0 = u.pn * 256 + wc * 32 + 4 * fq;
#pragma unroll
        for (int ai = 0; ai < 2; ++ai)
#pragma unroll
            for (int m = 0; m < 4; ++m) { float* rowp = base + (size_t)(row0 + ai * 128 + m * 16) * ld + col0;
#pragma unroll
                for (int bj = 0; bj < 2; ++bj)
#pragma unroll
                    for (int n = 0; n < 2; ++n) *(f32x4*)(rowp + bj * 128 + n * 16) = acc[ai][bj][m][n]; }
    }
};
struct EpiResid {
    static constexpr bool PERM = true;
    h16* X; const float* mods; int layer; float* SSQ; h16* XO;
    struct Pre {}; __device__ __forceinline__ void prefetch(const Unit&, int, int, Pre&) const {}
    __device__ __forceinline__ void operator()(const f32x4 (&acc)[2][2][4][2], const Unit& u, int wr, int wc, int fr, int fq, const Pre&) const {
        const int r0 = u.pm * 256; const int b = r0 < TL ? (r0 >> 12) : 8;
        const float* g = mods + ((size_t)(layer * 9 + b) * 6 + 2) * D;
        const int row0 = r0 + wr * 64 + fr, col0 = u.pn * 256 + wc * 32 + 8 * fq;
        f32x4 gv[2][2];
#pragma unroll
        for (int bj = 0; bj < 2; ++bj)
#pragma unroll
            for (int n = 0; n < 2; ++n) gv[bj][n] = *(const f32x4*)(g + col0 + bj * 128 + n * 4);
#pragma unroll
        for (int ai = 0; ai < 2; ++ai)
#pragma unroll
            for (int m = 0; m < 4; ++m) { const int row = row0 + ai * 128 + m * 16; const h16* rowp = X + (size_t)row * D + col0; h16* rowo = XO + (size_t)row * D + col0; float sq = 0.f;
#pragma unroll
                for (int bj = 0; bj < 2; ++bj) { const f16x8 xv = *(const f16x8*)(rowp + bj * 128); f32x4 v0, v1;
#pragma unroll
                    for (int i = 0; i < 4; ++i) { v0[i] = (float)xv[i] + gv[bj][0][i] * acc[ai][bj][m][0][i]; v1[i] = (float)xv[4 + i] + gv[bj][1][i] * acc[ai][bj][m][1][i]; }
                    const f16x8 w = pack8(v0, v1); *(f16x8*)(rowo + bj * 128) = w;
#pragma unroll
                    for (int i = 0; i < 8; ++i) { const float t = (float)w[i]; sq += t * t; } }
                sq += shx(sq, 16); sq += shx(sq, 32);
                if (fq == 0) SSQ[(size_t)row * 32 + u.pn * 4 + wc] = sq; }
    }
};
struct EpiMoe1 {
    static constexpr bool PERM = true;
    h16* H1;
    struct Pre {}; __device__ __forceinline__ void prefetch(const Unit&, int, int, Pre&) const {}
    __device__ __forceinline__ void operator()(const f32x4 (&acc)[2][2][4][2], const Unit& u, int wr, int wc, int fr, int fq, const Pre&) const {
        const int row0 = u.pm * 256 + wr * 64 + fr, col0 = u.pn * 128 + wc * 16 + 4 * fq;
#pragma unroll
        for (int ai = 0; ai < 2; ++ai)
#pragma unroll
            for (int m = 0; m < 4; ++m) { if (ai == 1 && u.half) continue; h16* rowp = H1 + (size_t)(row0 + ai * 128 + m * 16) * DE + col0;
#pragma unroll
                for (int bj = 0; bj < 2; ++bj) { const f32x4 a = acc[ai][bj][m][0], b = acc[ai][bj][m][1]; f16x4 w;
#pragma unroll
                    for (int i = 0; i < 4; ++i) { const float s = a[i] / (1.0f + __expf(-a[i])); w[i] = (h16)(s * b[i]); }
                    *(f16x4*)(rowp + bj * 64) = w; } }
    }
};
struct EpiMoe2 {
    static constexpr bool PERM = true;
    h16* YC; const float* gslot;
    struct Pre { int av[2][4]; float gv[2][4]; };
    __device__ __forceinline__ void prefetch(const Unit& u, int wr, int fr, Pre& q) const {
        const float* grow = gslot + ((const char*)u.rows - (const char*)listbase) / 4;
#pragma unroll
        for (int ai = 0; ai < 2; ++ai)
#pragma unroll
            for (int m = 0; m < 4; ++m) { const int r = ai * 128 + wr * 64 + m * 16 + fr; const bool ok = u.pos0 + r < u.cnt; q.av[ai][m] = ok ? u.rows[r] : -1; q.gv[ai][m] = ok ? grow[r] : 0.f; }
    }
    __device__ __forceinline__ void operator()(const f32x4 (&acc)[2][2][4][2], const Unit& u, int wr, int wc, int fr, int fq, const Pre& q) const {
        const int col0 = u.pn * 256 + wc * 32 + 8 * fq;
#pragma unroll
        for (int ai = 0; ai < 2; ++ai)
#pragma unroll
            for (int m = 0; m < 4; ++m) { if (q.av[ai][m] >= 0) { const float g = q.gv[ai][m]; h16* rowp = YC + (size_t)q.av[ai][m] * D + col0;
#pragma unroll
                    for (int bj = 0; bj < 2; ++bj) *(f16x8*)(rowp + bj * 128) = pack8(acc[ai][bj][m][0] * g, acc[ai][bj][m][1] * g); } }
    }
    const int* listbase;
};

__device__ __forceinline__ void order_tile(int wgid, int nM, int nN, int& pm, int& pn) {
    const int nwg = nM * nN; { const int q = nwg / 8, r = nwg % 8, xcd = wgid % 8, off = wgid / 8; wgid = (xcd < r ? xcd * (q + 1) : r * (q + 1) + (xcd - r) * q) + off; }
    const int nig = 8 * nN, gid = wgid / nig, fm = gid * 8, gsz = (nM - fm) < 8 ? (nM - fm) : 8;
    pm = fm + ((wgid % nig) % gsz); pn = (wgid % nig) / gsz;
}
struct SchedPlain {
    int nM, nN, K; const char* A; const char* B;
    __device__ __forceinline__ bool next(int i, Unit& u) const {
        const long L = (long)i * gridDim.x + blockIdx.x; if (L >= (long)nM * nN) return false;
        order_tile((int)L, nM, nN, u.pm, u.pn); u.kind = 0; u.half = 0; u.e = 0; u.pos0 = 0; u.cnt = 0; u.rows = nullptr;
        u.A = A + (size_t)u.pm * 256 * K * 2; u.B = B + (size_t)u.pn * 256 * K * 2; return true;
    }
};
struct SchedPlainAT {
    int nM, nN, K; const char* At; const char* B;
    __device__ __forceinline__ bool next(int i, Unit& u) const {
        const long L = (long)i * gridDim.x + blockIdx.x; if (L >= (long)nM * nN) return false;
        order_tile((int)L, nM, nN, u.pm, u.pn); u.kind = 0; u.half = 0; u.e = 0; u.pos0 = 0; u.cnt = 0; u.rows = nullptr;
        u.A = At + (size_t)u.pm * 256 * 2; u.B = B + (size_t)u.pn * 256 * K * 2; return true;
    }
};
struct SchedQkv {
    const char* H; const char* W;
    __device__ __forceinline__ bool next(int i, Unit& u) const {
        const long L = (long)i * gridDim.x + blockIdx.x; const int nA = 136 * 9; if (L >= nA + 136) return false;
        u.e = 0; u.half = 0; u.pos0 = 0; u.cnt = 0; u.rows = nullptr;
        if (L < nA) { order_tile((int)L, 136, 9, u.pm, u.pn); u.kind = 0; u.A = H + (size_t)u.pm * 256 * D * 2; u.B = W + (size_t)u.pn * 256 * D * 2; }
        else { u.pm = 0; u.pn = (int)L - nA; u.kind = 1; u.A = W + (size_t)DQK * D * 2; u.B = H + (size_t)u.pn * 256 * D * 2; }
        return true;
    }
};
struct SchedFilt {
    const char* W3P; const char* H2P;
    __device__ __forceinline__ bool next(int i, Unit& u) const {
        const long L = (long)i * gridDim.x + blockIdx.x; if (L >= 2 * 544) return false;
        const int j = (int)L / 544, r = (int)L % 544; u.e = 0; u.half = 0; u.pos0 = 0; u.cnt = 0; u.rows = nullptr;
        int v; if (r < 512) { v = 0; u.pm = r >> 4; u.pn = r & 15; } else { v = 1; u.pm = r - 512; u.pn = 0; }
        u.kind = 2 * j + v;
        u.A = W3P + ((size_t)j * 8192 + (size_t)u.pm * 256) * 256 * 2;
        u.B = H2P + ((size_t)j * 4352 + (v ? 4096 : 0) + (size_t)u.pn * 256) * 256 * 2;
        return true;
    }
};
struct MoeTab { const LAS int* tstart; const LAS int* texp; const LAS int* cnt; };
struct SchedMoe1 {
    MoeTab tb; const char* H; const char* W13; const int* list;
    __device__ __forceinline__ bool next(int i, Unit& u) const {
        const long L = (long)i * gridDim.x + blockIdx.x; const int ntile = __builtin_amdgcn_readfirstlane(tb.tstart[NE]); if (L >= (long)ntile * 3) return false;
        int rt; order_tile((int)L, ntile, 3, rt, u.pn); u.pm = rt; u.kind = 0;
        const int e = __builtin_amdgcn_readfirstlane(tb.texp[rt]); u.e = e; u.pos0 = (rt - __builtin_amdgcn_readfirstlane(tb.tstart[e])) * 256; u.cnt = __builtin_amdgcn_readfirstlane(tb.cnt[e]); u.half = (u.cnt - u.pos0 <= 128) ? 1 : 0;
        u.rows = list + (size_t)e * LCAP + u.pos0; u.A = H; u.B = W13 + ((size_t)e * DE2 + (size_t)u.pn * 256) * D * 2; return true;
    }
};
struct SchedMoe2 {
    MoeTab tb; const char* H1; const char* W2; const int* list;
    __device__ __forceinline__ bool next(int i, Unit& u) const {
        const long L = (long)i * gridDim.x + blockIdx.x; const int ntile = __builtin_amdgcn_readfirstlane(tb.tstart[NE]); if (L >= (long)ntile * 8) return false;
        int rt; order_tile((int)L, ntile, 8, rt, u.pn); u.pm = rt; u.kind = 0;
        const int e = __builtin_amdgcn_readfirstlane(tb.texp[rt]); u.e = e; u.pos0 = (rt - __builtin_amdgcn_readfirstlane(tb.tstart[e])) * 256; u.cnt = __builtin_amdgcn_readfirstlane(tb.cnt[e]); u.half = (u.cnt - u.pos0 <= 128) ? 1 : 0;
        u.rows = list + (size_t)e * LCAP + u.pos0; u.A = H1 + (size_t)rt * 256 * DE * 2; u.B = W2 + ((size_t)e * D + (size_t)u.pn * 256) * DE * 2; return true;
    }
};
__device__ __forceinline__ void moe_table(LAS int* tstart, LAS int* texp, LAS int* cnt, const int* counters) {
    const int t = tid_fresh();
    if (t < NE) cnt[t] = counters[t];
    __syncthreads();
    if (t <= NE) { int s = 0; for (int e = 0; e < t; ++e) s += (cnt[e] + 255) >> 8; tstart[t] = s; }
    __syncthreads();
    if (t < NE) { const int s0 = tstart[t], s1 = tstart[t + 1]; for (int q = s0; q < s1; ++q) texp[q] = t; }
    __syncthreads();
}

__device__ __forceinline__ float wave_sum(float v) {
#pragma unroll
    for (int o = 32; o >= 1; o >>= 1) v += shx(v, o);
    return v;
}
__device__ __forceinline__ float silu_f(float x) { return x / (1.0f + expf(-x)); }
__device__ __forceinline__ int batch_of_row(int r) { return r < TL ? (r >> 12) : 8; }

__device__ __forceinline__ void modp_unit(const Params& p, int unit, LAS float* sl) {
    const int layer = unit / 96, rem = unit % 96, ks = rem / 6, cc = rem % 6, tid = tid_fresh();
    for (int i = tid; i < 9 * 128; i += 512) { const int cnd = i >> 7, k = ks * 128 + (i & 127); const float v = cnd < 8 ? p.c[cnd * D + k] : p.c_ctx[k]; sl[i] = silu_f(v); }
    __syncthreads();
    f32x4 acc[9];
#pragma unroll
    for (int q = 0; q < 9; ++q) acc[q] = (f32x4){0.f, 0.f, 0.f, 0.f};
    const float* w = p.mod_w + ((size_t)layer * D + (size_t)ks * 128) * D6 + cc * 2048 + tid * 4;
#pragma unroll 4
    for (int k = 0; k < 128; ++k) { const f32x4 wv = *(const f32x4*)(w + (size_t)k * D6);
#pragma unroll
        for (int q = 0; q < 9; ++q) acc[q] += wv * sl[q * 128 + k]; }
    float* outp = (float*)(p.ws + WS_MODP) + ((size_t)(ks * 4 + layer) * 9) * D6 + cc * 2048 + tid * 4;
#pragma unroll
    for (int q = 0; q < 9; ++q) *(f32x4*)(outp + (size_t)q * D6) = acc[q];
    __syncthreads();
}
__device__ __forceinline__ void modr_unit(const Params& p, int unit) {
    const size_t idx = (size_t)unit * 2048 + tid_fresh() * 4; const int layer = (int)(idx / (9 * D6)), col = (int)(idx % D6);
    f32x4 s = *(const f32x4*)(p.mod_b + (size_t)layer * D6 + col);
    const float* pp = (const float*)(p.ws + WS_MODP) + idx;
#pragma unroll
    for (int ks = 0; ks < 16; ++ks) s += *(const f32x4*)(pp + (size_t)ks * 4 * 9 * D6);
    *(f32x4*)((float*)(p.ws + WS_MODS) + idx) = s;
}
__device__ __forceinline__ void tables_unit(const Params& p) {
    f32x2* tw = (f32x2*)(p.ws + WS_TW);
    for (int m = tid_fresh(); m < 8192; m += 512) { double s, c; sincospi(-(double)m / 4096.0, &s, &c); tw[m] = (f32x2){(float)c, (float)s}; }
    float* rc = (float*)(p.ws + WS_ROPE);
    for (int i = tid_fresh(); i < 1024; i += 512) { const int pos = i >> 4, q = i & 15; const float inv = powf(10000.0f, -(float)q / 16.0f); const float ang = (float)pos * inv;
        rc[i] = cosf(ang); rc[1024 + i] = sinf(ang); }
}
__device__ __forceinline__ void h2_task(const Params& p, int task) {
    const int lane = tid_fresh() & 63; const int j = task / 4352, r = task % 4352; const int v = r >= 4096, t = v ? r - 4096 : r; const int Lv = v ? 256 : 4096;
    const float tl = (float)t / (float)(Lv - 1);
    const float omega = (float)(2.0 * 3.14159265358979323846 / (double)Lv) * (float)t;
    float feat = 0.f;
    if (lane == 0) feat = tl;
    else if (lane <= 32) { const int bi = (lane - 1) & 15; const float band = 1e-4f + (float)bi * ((15.0f - 1e-4f) / 15.0f); const float a = band * omega; feat = lane <= 16 ? cosf(a) : -sinf(a); }
    const float* w1 = p.hy_f_w1 + (size_t)j * 33 * 64; const float* w2 = p.hy_f_w2 + (size_t)j * 64 * 64;
    float s = p.hy_f_b1[j * 64 + lane];
    for (int f = 0; f < 33; ++f) s += bperm_f(feat, f) * w1[f * 64 + lane];
    const float h1 = sinf(p.hy_f_freq1[j * 64 + lane] * s);
    float s2 = p.hy_f_b2[j * 64 + lane];
    for (int m = 0; m < 64; ++m) s2 += bperm_f(h1, m) * w2[m * 64 + lane];
    const float h2 = sinf(p.hy_f_freq2[j * 64 + lane] * s2);
    const h16 hi = (h16)h2; const h16 lo = (h16)(h2 - (float)hi);
    h16* row = (h16*)(p.ws + WS_H2P) + ((size_t)j * 4352 + r) * 256;
    row[lane] = hi; row[64 + lane] = hi; row[128 + lane] = lo; row[192 + lane] = lo;
}
__device__ __forceinline__ void w3p_unit(const Params& p, int unit) {
    const int j = unit >> 5, c0 = (unit & 31) * 256; const float* w3 = p.hy_f_w3 + (size_t)j * 64 * 8192; h16* dst = (h16*)(p.ws + WS_W3P) + (size_t)j * 8192 * 256;
    for (int i = tid_fresh(); i < 64 * 256; i += 512) { const int m = i >> 8, col = c0 + (i & 255); const float w = w3[(size_t)m * 8192 + col];
        const h16 hi = (h16)w; const h16 lo = (h16)(w - (float)hi); h16* row = dst + (size_t)col * 256; row[m] = hi; row[64 + m] = lo; row[128 + m] = hi; row[192 + m] = lo; }
}
__device__ __forceinline__ void rtab_unit(const Params& p, int unit) {
    const int layer = unit >> 6, c = unit & 63; h16* dst = (h16*)(p.ws + WS_RTAB + (size_t)layer * RTAB_L) + (size_t)c * 5 * 2 * 64 * 8;
    for (int i = tid_fresh(); i < 5 * 2 * 64 * 8; i += 512) { const int jj = i & 7, lane = (i >> 3) & 63, hl = (i >> 9) & 1, ct = i >> 10;
        const int k = 32 * c + 8 * (lane >> 4) + jj, col = 16 * ct + (lane & 15);
        float w = 0.f; if (col < 8) w = p.moe_wg[((size_t)layer * D + k) * 8 + col]; else if (col < 72) w = p.moe_we[((size_t)layer * D + k) * 64 + (col - 8)];
        w *= 256.0f; const h16 hi = (h16)w; const h16 lo = (h16)(w - (float)hi); dst[i] = hl ? lo : hi; }
}
template <int NW>
__device__ __forceinline__ void cvt_tile(const float* src, int ldn, int k0, int n0, h16* dst, int ldk, int mode, LAS float* T) {
    constexpr int P = NW + 1; const int tid = tid_fresh();
#pragma unroll
    for (int ps = 0; ps < 64 * NW / 4 / 512; ++ps) { const int idx = ps * 512 + tid, k = idx / (NW / 4), n4 = idx % (NW / 4);
        const f32x4 v = *(const f32x4*)(src + (size_t)(k0 + k) * ldn + n0 + 4 * n4); LAS float* q = T + k * P + 4 * n4; q[0] = v[0]; q[1] = v[1]; q[2] = v[2]; q[3] = v[3]; }
    __syncthreads();
#pragma unroll
    for (int ps = 0; ps < NW * 8 / 512; ++ps) { const int item = ps * 512 + tid, kc = item & 7, n = item >> 3; f16x8 w;
#pragma unroll
        for (int i = 0; i < 8; ++i) w[i] = (h16)T[(8 * kc + i) * P + n];
        const int ng = n0 + n; const int row = mode == 0 ? ng : (8 * (ng >> 2) + (ng & 3) + (mode == 2 ? 4 : 0));
        *(f16x8*)(dst + (size_t)row * ldk + k0 + 8 * kc) = w; }
    __syncthreads();
}
__device__ __forceinline__ void cvt_dense_unit(const Params& p, int unit, LAS float* T) {
    const float* src; h16* dst; int nt, N;
    if (unit < 1536) { src = p.hy_w_in; dst = (h16*)(p.ws + WS_WIN); nt = 24; N = D3; }
    else if (unit < 2048) { unit -= 1536; src = p.hy_w_out; dst = (h16*)(p.ws + WS_WOUT); nt = 8; N = D; }
    else if (unit < 2688) { unit -= 2048; src = p.at_w_qkv; dst = (h16*)(p.ws + WS_WQKV); nt = 10; N = DQKV; }
    else { unit -= 2688; src = p.at_w_o; dst = (h16*)(p.ws + WS_WO); nt = 8; N = D; }
    const int j = unit / (32 * nt), r = unit % (32 * nt), kt = r / nt, ntile = r % nt;
    cvt_tile<256>(src + (size_t)j * D * N, N, kt * 64, ntile * 256, dst + (size_t)j * N * D, D, 0, T);
}
constexpr int CVT_DENSE_UNITS = 3200;
__device__ __forceinline__ void cvt_moe_unit(const Params& p, int layer, int unit, LAS float* T) {
    if (unit < 12288) { const int which = unit >= 6144; if (which) unit -= 6144; const int e = unit / 96, r = unit % 96, kt = r / 3, ntile = r % 3;
        const float* src = (which ? p.moe_w3 : p.moe_w1) + ((size_t)layer * NE + e) * D * DE;
        cvt_tile<128>(src, DE, kt * 64, ntile * 128, (h16*)(p.ws + WS_W13) + (size_t)e * DE2 * D, D, which ? 2 : 1, T); }
    else { unit -= 12288; const int e = unit / 48, r = unit % 48, kt = r / 8, ntile = r % 8;
        const float* src = p.moe_w2 + ((size_t)layer * NE + e) * DE * D;
        cvt_tile<256>(src, D, kt * 64, ntile * 256, (h16*)(p.ws + WS_W2) + (size_t)e * D * DE, DE, 0, T); }
}
constexpr int CVT_MOE_UNITS = 15360;
struct CvtD { const float* src; h16* dst; int mode; };
__device__ __forceinline__ CvtD cvt13_desc(const Params& p, int layer, int unit) {
    const int which = unit >= 6144; if (which) unit -= 6144; const int e = unit / 96, r = unit % 96, kt = r / 3, ntile = r % 3;
    CvtD d; d.src = (which ? p.moe_w3 : p.moe_w1) + ((size_t)layer * NE + e) * D * DE + (size_t)(kt * 64) * DE + ntile * 128;
    d.dst = (h16*)(p.ws + WS_W13) + (size_t)e * DE2 * D + kt * 64; d.mode = (which ? 4 : 0) + 8 * (256 * ntile); return d;
}
__device__ __forceinline__ void cvt13_load(const CvtD& d, f32x4 (&v)[4], int tid) {
#pragma unroll
    for (int ps = 0; ps < 4; ++ps) { const int idx = ps * 512 + tid, k = idx >> 5, n4 = idx & 31; v[ps] = *(const f32x4*)(d.src + (size_t)k * DE + 4 * n4); }
}
__device__ __forceinline__ void cvt13_store(const CvtD& d, const f32x4 (&v)[4], LAS float* T, int tid) {
    constexpr int P = 129;
#pragma unroll
    for (int ps = 0; ps < 4; ++ps) { const int idx = ps * 512 + tid, k = idx >> 5, n4 = idx & 31; LAS float* q = T + k * P + 4 * n4; q[0] = v[ps][0]; q[1] = v[ps][1]; q[2] = v[ps][2]; q[3] = v[ps][3]; }
    __syncthreads();
    const int w3off = d.mode & 7, rg0 = d.mode >> 3;
#pragma unroll
    for (int ps = 0; ps < 2; ++ps) { const int item = ps * 512 + tid, kc = item & 7, n = item >> 3; f16x8 w;
#pragma unroll
        for (int i = 0; i < 8; ++i) w[i] = (h16)T[(8 * kc + i) * P + n];
        const int row = rg0 + 8 * (n >> 2) + (n & 3) + w3off;
        *(f16x8*)(d.dst + (size_t)row * D + 8 * kc) = w; }
    __syncthreads();
}
__device__ __forceinline__ void cvt_moe_share(const Params& p, int layer, int u0, int n, int stride, LAS float* T) {
    const int tid = tid_fresh(); const int n13 = n < 12288 ? n : 12288;
    int u = u0;
    if (u < n13) {
        CvtD dA = cvt13_desc(p, layer, u), dB = dA, dC = dA; f32x4 vA[4], vB[4], vC[4];
        cvt13_load(dA, vA, tid);
        if (u + stride < n13) { dB = cvt13_desc(p, layer, u + stride); cvt13_load(dB, vB, tid); }
        for (;;) {
            if (u + 2 * stride < n13) { dC = cvt13_desc(p, layer, u + 2 * stride); cvt13_load(dC, vC, tid); }
            cvt13_store(dA, vA, T, tid); u += stride; if (u >= n13) break;
            if (u + 2 * stride < n13) { dA = cvt13_desc(p, layer, u + 2 * stride); cvt13_load(dA, vA, tid); }
            cvt13_store(dB, vB, T, tid); u += stride; if (u >= n13) break;
            if (u + 2 * stride < n13) { dB = cvt13_desc(p, layer, u + 2 * stride); cvt13_load(dB, vB, tid); }
            cvt13_store(dC, vC, T, tid); u += stride; if (u >= n13) break;
        }
    }
    for (; u < n; u += stride) cvt_moe_unit(p, layer, u, T);
}

template <int NR, bool FINAL>
__device__ __forceinline__ void n1_rows(const Params& p, int layer, int r0, int rstride, int lane, h16* xout) {
    const h16* xres = (const h16*)(p.ws + WS_XRES); h16* hb = (h16*)(p.ws + WS_HBUF); const h16* yc = (const h16*)(p.ws + WS_YC); const float* mods = (const float*)(p.ws + WS_MODS);
    f32x4 v[NR][8]; f16x4 xh[NR][8], ya[NR][8], yb[NR][8];
    const bool comb = FINAL || layer > 0; const int lprev = FINAL ? 3 : layer - 1;
#pragma unroll
    for (int q = 0; q < NR; ++q) { const int r = r0 + q * rstride;
        if (!comb) { const float* src = r < TL ? p.x + (size_t)r * D : p.ctx + (size_t)(r - TL) * D;
#pragma unroll
            for (int c = 0; c < 8; ++c) v[q][c] = *(const f32x4*)(src + c * 256 + lane * 4); }
        else { const h16* src = xres + (size_t)r * D; const h16* y0 = yc + (size_t)(2 * r) * D; const h16* y1 = y0 + D;
#pragma unroll
            for (int c = 0; c < 8; ++c) { xh[q][c] = *(const f16x4*)(src + c * 256 + lane * 4); ya[q][c] = *(const f16x4*)(y0 + c * 256 + lane * 4); yb[q][c] = *(const f16x4*)(y1 + c * 256 + lane * 4); } } }
#pragma unroll
    for (int q = 0; q < NR; ++q) { const int r = r0 + q * rstride; const int b = batch_of_row(r);
        if (comb) { const float* g2 = mods + ((size_t)(lprev * 9 + b) * 6 + 5) * D;
#pragma unroll
            for (int c = 0; c < 8; ++c) { const f32x4 g = *(const f32x4*)(g2 + c * 256 + lane * 4);
#pragma unroll
                for (int i = 0; i < 4; ++i) v[q][c][i] = (float)xh[q][c][i] + g[i] * ((float)ya[q][c][i] + (float)yb[q][c][i]); } }
        float ss = 0.f;
#pragma unroll
        for (int c = 0; c < 8; ++c) { if (!FINAL) { f16x4 w; w[0] = (h16)v[q][c][0]; w[1] = (h16)v[q][c][1]; w[2] = (h16)v[q][c][2]; w[3] = (h16)v[q][c][3]; *(f16x4*)(xout + (size_t)r * D + c * 256 + lane * 4) = w; } ss += v[q][c][0] * v[q][c][0] + v[q][c][1] * v[q][c][1] + v[q][c][2] * v[q][c][2] + v[q][c][3] * v[q][c][3]; }
        ss = wave_sum(ss); const float rs = 1.0f / sqrtf(ss * (1.0f / D) + EPS);
        if (FINAL) {
#pragma unroll
            for (int c = 0; c < 8; ++c) { const int col = c * 256 + lane * 4; const f32x4 g = *(const f32x4*)(p.final_gain + col); *(f32x4*)(p.out + (size_t)r * D + col) = v[q][c] * rs * g; }
        } else {
            const float* sh = mods + ((size_t)(layer * 9 + b) * 6 + 0) * D; const float* sc = sh + D;
#pragma unroll
            for (int c = 0; c < 8; ++c) { const int col = c * 256 + lane * 4; const f32x4 s0 = *(const f32x4*)(sh + col), s1 = *(const f32x4*)(sc + col); f16x4 w;
#pragma unroll
                for (int i = 0; i < 4; ++i) w[i] = (h16)(v[q][c][i] * rs * (1.0f + s1[i]) + s0[i]);
                *(f16x4*)(hb + (size_t)r * D + col) = w; }
        } }
}
template <bool FINAL>
__device__ __forceinline__ void n1_any(const Params& p, int layer, h16* xout) {
    const int tid = tid_fresh(), lane = tid & 63, gw = blockIdx.x * 8 + __builtin_amdgcn_readfirstlane(tid >> 6), nw = gridDim.x * 8; const int nrow = FINAL ? TL : TT;
    int r = gw;
    for (; r + nw < nrow; r += 2 * nw) n1_rows<2, FINAL>(p, layer, r, nw, lane, xout);
    if (r < nrow) n1_rows<1, FINAL>(p, layer, r, nw, lane, xout);
}
__device__ __forceinline__ void n1_phase(const Params& p, int layer, h16* xout) { n1_any<false>(p, layer, xout); }
__device__ __forceinline__ void final_phase(const Params& p) { n1_any<true>(p, 0, nullptr); }
constexpr int N2_CH = 4;
constexpr int N2_SLOT = N2_CH * 10 * 1024;
constexpr int N2_XT = 2 * N2_SLOT;
constexpr int N2_SC = N2_XT + 8 * 4096;
#ifndef PROBE_N2VAR
#define PROBE_N2VAR 0
#endif
__device__ __forceinline__ void n2_phase(const Params& p, int layer, LAS unsigned char* lds, int ctr_shadow) {
    const bool pv_tail = !(ctr_shadow && (PROBE_N2VAR & 1)), pv_store = !(ctr_shadow && (PROBE_N2VAR & 2)), pv_mma = !(ctr_shadow && (PROBE_N2VAR & 4));
    const int tid = tid_fresh(), lane = tid & 63, wv = __builtin_amdgcn_readfirstlane(tid >> 6), r16 = lane & 15, kg = lane >> 4;
    const int lrow = lane >> 3, lchk = lane & 7;
    const h16* xres = (const h16*)(p.ws + WS_XRES); h16* hb = (h16*)(p.ws + WS_HBUF); const float* mods = (const float*)(p.ws + WS_MODS);
    const char* rtb = p.ws + WS_RTAB + (size_t)layer * RTAB_L; const float* ssq = (const float*)(p.ws + WS_SSQ);
    int* counters = (int*)(p.ws + WS_CTL) + CTL_CNT + (layer + (ctr_shadow ? 4 : 0)) * NE; int* list = (int*)(p.ws + WS_LIST); float* gate = (float*)(p.ws + WS_GATE);
    LAS float* scr = (LAS float*)lds + wv * (16 * 80);
    LAS float* scl = (LAS float*)(lds + N2_SC); LAS float* shl = scl + D;
    LAS int* hist = (LAS int*)(lds + LDS_MISC); LAS int* hbase = hist + NE;
    LAS unsigned char* xt = lds + N2_XT + wv * 4096;
    const int hw_off0 = r16 * 128 + 16 * (kg ^ (r16 & 7)), hw_off1 = r16 * 128 + 16 * ((4 + kg) ^ (r16 & 7));
    const int hr_off = lrow * 128 + 16 * (lchk ^ (lrow & 7));
    const int ntask = (layer == NLAYER - 1 ? TL : TT) / 16, nfull = (int)gridDim.x * 8;
#pragma unroll 1
    for (int round = 0; round < 2; ++round) {
        const int nrem = ntask - nfull;
        if (round == 1 && (int)blockIdx.x >= nrem) break;
        const int task = round == 0 ? (int)blockIdx.x * 8 + wv : nfull + (int)blockIdx.x;
        const bool active = round == 0 ? (task < ntask) : true;
        const int trow = active ? task * 16 : 0;
        const int b = batch_of_row(trow);
        const h16* xg = xres + (size_t)(trow + r16) * D + 8 * kg;
        h16* hg0 = hb + (size_t)(trow + lrow) * D + lchk * 8; h16* hg1 = hg0 + (size_t)8 * D;
        float rs;
        { const float* sp = ssq + (size_t)(trow + r16) * 32; float t = 0.f;
#pragma unroll
            for (int q = 0; q < 8; ++q) { const f32x4 v = *(const f32x4*)(sp + 4 * q); t += (v[0] + v[1]) + (v[2] + v[3]); }
            rs = 1.0f / sqrtf(t * (1.0f / D) + EPS); }
        f32x4 acc[5];
#pragma unroll
        for (int ct = 0; ct < 5; ++ct) acc[ct] = (f32x4){0.f, 0.f, 0.f, 0.f};
        __syncthreads();
        if (tid < NE) hist[tid] = 0;
        { const float* scb = mods + ((size_t)(layer * 9 + b) * 6 + 4) * D; *(LAS f32x4*)(scl + tid * 4) = *(const f32x4*)(scb + tid * 4); *(LAS f32x4*)(shl + tid * 4) = *(const f32x4*)(scb - D + tid * 4); }
        if (round == 0) {
        f16x8 bq[5];
#pragma unroll
        for (int q = 0; q < 5; ++q) bq[q] = *(const f16x8*)(rtb + (size_t)(5 * wv + q) * 1024 + lane * 16);
#pragma unroll
        for (int q = 0; q < 5; ++q) *(LAS f16x8*)(lds + (5 * wv + q) * 1024 + lane * 16) = bq[q];
#pragma unroll
        for (int q = 0; q < 5; ++q) bq[q] = *(const f16x8*)(rtb + (size_t)N2_SLOT + (size_t)(5 * wv + q) * 1024 + lane * 16);
        f16x8 x0[N2_CH], x1[N2_CH], x2[N2_CH];
#pragma unroll
        for (int s2 = 0; s2 < N2_CH; ++s2) { x0[s2] = *(const f16x8*)(xg + 32 * s2); x1[s2] = *(const f16x8*)(xg + 32 * (N2_CH + s2)); }
#define N2_CHUNK(XC, XL, CH) do { const int ch = (CH); \
            __syncthreads(); \
            const int nx2 = (ch + 2 < 64 / N2_CH) ? ch + 2 : ch; \
            {   LAS unsigned char* dst = lds + ((ch + 1) & 1) * N2_SLOT; \
 _Pragma("unroll") \
                for (int q = 0; q < 5; ++q) *(LAS f16x8*)(dst + (5 * wv + q) * 1024 + lane * 16) = bq[q]; } \
            {   const char* src = rtb + (size_t)nx2 * N2_SLOT; \
 _Pragma("unroll") \
                for (int q = 0; q < 5; ++q) bq[q] = *(const f16x8*)(src + (size_t)(5 * wv + q) * 1024 + lane * 16); } \
 _Pragma("unroll") \
            for (int s2 = 0; s2 < N2_CH; ++s2) { const int ko = 32 * (nx2 * N2_CH + s2); XL[s2] = *(const f16x8*)(xg + ko); } \
            const LAS unsigned char* bs = lds + (ch & 1) * N2_SLOT + lane * 16; \
 _Pragma("unroll") \
            for (int pp = 0; pp < N2_CH / 2; ++pp) { \
                f16x8 hk[2]; \
 _Pragma("unroll") \
                for (int sp = 0; sp < 2; ++sp) { \
                    const int s2 = 2 * pp + sp; const int ko = 32 * (ch * N2_CH + s2) + 8 * kg; \
                    const f32x4 c0 = *(const LAS f32x4*)(scl + ko), c1 = *(const LAS f32x4*)(scl + ko + 4), h0 = *(const LAS f32x4*)(shl + ko), h1 = *(const LAS f32x4*)(shl + ko + 4); \
                    f16x8 hi, lo; \
 _Pragma("unroll") \
                    for (int i = 0; i < 4; ++i) { const float a0 = (float)XC[s2][i] * rs * (1.0f + c0[i]) + h0[i], a1 = (float)XC[s2][4 + i] * rs * (1.0f + c1[i]) + h1[i]; \
                        hi[i] = (h16)a0; lo[i] = (h16)(a0 - (float)hi[i]); hi[4 + i] = (h16)a1; lo[4 + i] = (h16)(a1 - (float)hi[4 + i]); } \
                    hk[sp] = hi; \
                    if (pv_mma) \
 _Pragma("unroll") \
                    for (int ct = 0; ct < 5; ++ct) { const f16x8 whi = *(const LAS f16x8*)(bs + (s2 * 10 + ct * 2 + 0) * 1024), wlo = *(const LAS f16x8*)(bs + (s2 * 10 + ct * 2 + 1) * 1024); \
                        acc[ct] = __builtin_amdgcn_mfma_f32_16x16x32_f16(hi, whi, acc[ct], 0, 0, 0); \
                        acc[ct] = __builtin_amdgcn_mfma_f32_16x16x32_f16(hi, wlo, acc[ct], 0, 0, 0); \
                        acc[ct] = __builtin_amdgcn_mfma_f32_16x16x32_f16(lo, whi, acc[ct], 0, 0, 0); } \
                } \
                *(LAS f16x8*)(xt + hw_off0) = hk[0]; *(LAS f16x8*)(xt + hw_off1) = hk[1]; \
                const f16x8 o0 = *(const LAS f16x8*)(xt + hr_off), o1 = *(const LAS f16x8*)(xt + 1024 + hr_off); \
                if (active && pv_store) { const int ho = 32 * (ch * N2_CH + 2 * pp); *(f16x8*)(hg0 + ho) = o0; *(f16x8*)(hg1 + ho) = o1; } \
            } \
        } while (0)
#pragma unroll 1
        for (int c3 = 0; c3 < 15; c3 += 3) { N2_CHUNK(x0, x2, c3); N2_CHUNK(x1, x0, c3 + 1); N2_CHUNK(x2, x1, c3 + 2); }
        N2_CHUNK(x0, x2, 15);
#undef N2_CHUNK
        } else {
            const char* rtw = rtb + (size_t)(8 * wv) * 10240; const int kb = 256 * wv;
            unsigned loff = (unsigned)lane * 16u; asm volatile("" : "+v"(loff));
            f16x8 bb[10];
            f16x8 xa[2][2];
#pragma unroll
            for (int sp = 0; sp < 2; ++sp) xa[0][sp] = *(const f16x8*)(xg + kb + 32 * sp);
#pragma unroll
            for (int pp = 0; pp < 4; ++pp) {
                if (pp < 3) {
#pragma unroll
                    for (int sp = 0; sp < 2; ++sp) xa[(pp + 1) & 1][sp] = *(const f16x8*)(xg + kb + 32 * (2 * pp + 2 + sp)); }
                f16x8 hk[2];
#pragma unroll
                for (int sp = 0; sp < 2; ++sp) {
                    const int st = 2 * pp + sp; const int ko = kb + 32 * st + 8 * kg;
#pragma unroll
                    for (int q = 0; q < 10; ++q) bb[q] = *(const f16x8*)(rtw + (size_t)(st * 10 + q) * 1024 + loff);
                    asm volatile("" ::: "memory");
                    const f32x4 c0 = *(const LAS f32x4*)(scl + ko), c1 = *(const LAS f32x4*)(scl + ko + 4), h0 = *(const LAS f32x4*)(shl + ko), h1 = *(const LAS f32x4*)(shl + ko + 4);
                    f16x8 hi, lo;
#pragma unroll
                    for (int i = 0; i < 4; ++i) { const float a0 = (float)xa[pp & 1][sp][i] * rs * (1.0f + c0[i]) + h0[i], a1 = (float)xa[pp & 1][sp][4 + i] * rs * (1.0f + c1[i]) + h1[i];
                        hi[i] = (h16)a0; lo[i] = (h16)(a0 - (float)hi[i]); hi[4 + i] = (h16)a1; lo[4 + i] = (h16)(a1 - (float)hi[4 + i]); }
                    hk[sp] = hi;
#pragma unroll
                    for (int ct = 0; ct < 5; ++ct) {
                        acc[ct] = __builtin_amdgcn_mfma_f32_16x16x32_f16(hi, bb[2 * ct], acc[ct], 0, 0, 0);
                        acc[ct] = __builtin_amdgcn_mfma_f32_16x16x32_f16(hi, bb[2 * ct + 1], acc[ct], 0, 0, 0);
                        acc[ct] = __builtin_amdgcn_mfma_f32_16x16x32_f16(lo, bb[2 * ct], acc[ct], 0, 0, 0); }
                }
                *(LAS f16x8*)(xt + hw_off0) = hk[0]; *(LAS f16x8*)(xt + hw_off1) = hk[1];
                const f16x8 o0 = *(const LAS f16x8*)(xt + hr_off), o1 = *(const LAS f16x8*)(xt + 1024 + hr_off);
                if (pv_store) { const int ho = kb + 64 * pp; *(f16x8*)(hg0 + ho) = o0; *(f16x8*)(hg1 + ho) = o1; }
            }
        }
        __syncthreads();
#pragma unroll
        for (int ct = 0; ct < 5; ++ct)
#pragma unroll
            for (int i = 0; i < 4; ++i) scr[(4 * kg + i) * 80 + 16 * ct + r16] = acc[ct][i] * (1.0f / 256.0f);
        asm volatile("s_waitcnt lgkmcnt(0)" ::: "memory");
        int ea = 0, eb = 0, ra = 0, rb = 0; float g1v = 0.f, g2v = 0.f; const bool tok_lane = (round == 0 ? active : wv == 0) && lane < 16 && pv_tail;
        const int nparts = round == 0 ? 1 : 8;
        if (tok_lane) {
            const LAS float* lgr = scr + lane * 80;
#define N2_LG(c) ({ float _t = lgr[(c)]; for (int _w = 1; _w < nparts; ++_w) _t += lgr[_w * 1280 + (c)]; _t; })
            float gmax = -3.0e38f; int gsel = 0; float gl[8];
#pragma unroll
            for (int g = 0; g < 8; ++g) { gl[g] = N2_LG(g) + p.moe_bg[layer * 8 + g]; if (gl[g] > gmax) { gmax = gl[g]; gsel = g; } }
            float gz = 0.f;
#pragma unroll
            for (int g = 0; g < 8; ++g) gz += expf(gl[g] - gmax);
            const float pg = 1.0f / gz;
            float f1 = -3.0e38f, f2 = -3.0e38f; int i1 = 0, i2 = 0;
            for (int q = 0; q < 8; ++q) { const float f = N2_LG(8 + gsel * 8 + q) + p.moe_be[layer * 64 + gsel * 8 + q];
                if (f > f1) { f2 = f1; i2 = i1; f1 = f; i1 = q; } else if (f > f2) { f2 = f; i2 = q; } }
            const float e2 = expf(f2 - f1); g1v = pg / (1.0f + e2); g2v = pg * e2 / (1.0f + e2);
            ea = gsel * 8 + i1; eb = gsel * 8 + i2;
#undef N2_LG
            ra = __hip_atomic_fetch_add(hist + ea, 1, __ATOMIC_RELAXED, __HIP_MEMORY_SCOPE_WORKGROUP); rb = __hip_atomic_fetch_add(hist + eb, 1, __ATOMIC_RELAXED, __HIP_MEMORY_SCOPE_WORKGROUP);
        }
        __syncthreads();
        { const int t2 = tid_fresh(); if (t2 < NE && pv_tail) { const int n = hist[t2]; hbase[t2] = n ? atomicAdd(&counters[t2], n) : 0; } }
        __syncthreads();
        if (tok_lane) { const int tok = task * 16 + lane; const size_t sa = (size_t)ea * LCAP + hbase[ea] + ra, sb = (size_t)eb * LCAP + hbase[eb] + rb;
            list[sa] = 2 * tok; gate[sa] = g1v; list[sb] = 2 * tok + 1; gate[sb] = g2v; }
    }
}
__device__ __forceinline__ void transpose_phase(const Params& p, LAS h16* T) {
    const h16* zt = (const h16*)(p.ws + WS_ZT); h16* z = (h16*)(p.ws + WS_HBUF); const int tid = tid_fresh();
    const int ntile = (D / 64) * (TT / 64);
    for (int tile = blockIdx.x; tile < ntile; tile += gridDim.x) {
        const int td = tile % (D / 64), tt = tile / (D / 64); const int d0 = td * 64, t0 = tt * 64;
        { const int dr = tid >> 3, tc = (tid & 7) * 8; const f16x8 v = *(const f16x8*)(zt + (size_t)(d0 + dr) * TT + t0 + tc);
#pragma unroll
            for (int i = 0; i < 8; ++i) T[(tc + i) * 66 + dr] = v[i]; }
        __syncthreads();
        { const int tr = tid >> 3, dc = (tid & 7) * 8; f16x8 v;
#pragma unroll
            for (int i = 0; i < 8; ++i) v[i] = T[tr * 66 + dc + i];
            *(f16x8*)(z + (size_t)(t0 + tr) * D + d0 + dc) = v; }
        __syncthreads();
    }
}

__device__ __forceinline__ f32x2 cmul(const f32x2 a, const f32x2 b) { return (f32x2){a.x * b.x - a.y * b.y, a.x * b.y + a.y * b.x}; }
__device__ __forceinline__ f32x2 cmulc(const f32x2 a, const f32x2 b) { return (f32x2){a.x * b.x + a.y * b.y, a.y * b.x - a.x * b.y}; }
__device__ __forceinline__ f32x2 cconj(const f32x2 a) { return (f32x2){a.x, -a.y}; }
template <bool INV> __device__ __forceinline__ f32x2 mul_mi(const f32x2 a) { return INV ? (f32x2){-a.y, a.x} : (f32x2){a.y, -a.x}; }
template <bool INV> __device__ __forceinline__ void dft4(f32x2& a, f32x2& b, f32x2& c, f32x2& d) {
    const f32x2 s0 = a + c, s1 = a - c, s2 = b + d, s3 = mul_mi<INV>(b - d);
    a = s0 + s2; b = s1 + s3; c = s0 - s2; d = s1 - s3;
}
template <bool INV, int M> __device__ __forceinline__ f32x2 w16mul(const f32x2 a) {
    constexpr float C1 = 0.92387953251128674f, S1 = 0.38268343236508977f, R = 0.70710678118654752f;
    constexpr float cr = (M == 0) ? 1.f : (M == 1) ? C1 : (M == 2) ? R : (M == 3) ? S1 : (M == 4) ? 0.f : (M == 6) ? -R :   -C1;
    constexpr float ci0 = (M == 0) ? 0.f : (M == 1) ? -S1 : (M == 2) ? -R : (M == 3) ? -C1 : (M == 4) ? -1.f : (M == 6) ? -R :   S1;
    constexpr float ci = INV ? -ci0 : ci0;
    return (f32x2){a.x * cr - a.y * ci, a.x * ci + a.y * cr};
}
template <bool INV> __device__ __forceinline__ void dft16(f32x2 (&v)[16]) {
#pragma unroll
    for (int n2 = 0; n2 < 4; ++n2) dft4<INV>(v[n2], v[4 + n2], v[8 + n2], v[12 + n2]);
    v[5] = w16mul<INV, 1>(v[5]); v[6] = w16mul<INV, 2>(v[6]); v[7] = w16mul<INV, 3>(v[7]);
    v[9] = w16mul<INV, 2>(v[9]); v[10] = w16mul<INV, 4>(v[10]); v[11] = w16mul<INV, 6>(v[11]);
    v[13] = w16mul<INV, 3>(v[13]); v[14] = w16mul<INV, 6>(v[14]); v[15] = w16mul<INV, 9>(v[15]);
#pragma unroll
    for (int k1 = 0; k1 < 4; ++k1) dft4<INV>(v[4 * k1], v[4 * k1 + 1], v[4 * k1 + 2], v[4 * k1 + 3]);
    f32x2 t;
    t = v[1]; v[1] = v[4]; v[4] = t; t = v[2]; v[2] = v[8]; v[8] = t; t = v[3]; v[3] = v[12]; v[12] = t;
    t = v[6]; v[6] = v[9]; v[9] = t; t = v[7]; v[7] = v[13]; v[13] = t; t = v[11]; v[11] = v[14]; v[14] = t;
}
__device__ __forceinline__ int fphys(int i) { return i + (i >> 4); }
__device__ __forceinline__ f32x2 w32c(int j) {
    constexpr float c[16] = {1.f, 0.98078528040323043f, 0.92387953251128674f, 0.83146961230254524f, 0.70710678118654752f, 0.55557023301960218f, 0.38268343236508977f, 0.19509032201612825f,
                             0.f, -0.19509032201612825f, -0.38268343236508977f, -0.55557023301960218f, -0.70710678118654752f, -0.83146961230254524f, -0.92387953251128674f, -0.98078528040323043f};
    constexpr float s[16] = {0.f, 0.19509032201612825f, 0.38268343236508977f, 0.55557023301960218f, 0.70710678118654752f, 0.83146961230254524f, 0.92387953251128674f, 0.98078528040323043f,
                             1.f, 0.98078528040323043f, 0.92387953251128674f, 0.83146961230254524f, 0.70710678118654752f, 0.55557023301960218f, 0.38268343236508977f, 0.19509032201612825f};
    return (f32x2){c[j], -s[j]};
}
template <int S>
__device__ __forceinline__ void fft_fwd0(const f32x2 (&xe)[16], const f32x2 (&xo)[16], LAS f32x2* E, LAS f32x2* O, int t, const LAS f32x2* tw) {
    const f32x2 u = tw[t * (256 / S)]; const f32x2 u2 = cmul(u, u);
    f32x2 y[16];
#pragma unroll
    for (int j = 0; j < 16; ++j) y[j] = xe[j];
    dft16<false>(y);
    constexpr int QS = S + S / 16;
    LAS f32x2* Eb = E + fphys(t); LAS f32x2* Ob = O + fphys(t);
    f32x2 pw = u2; Eb[0] = y[0];
#pragma unroll
    for (int q = 1; q < 16; ++q) { Eb[QS * q] = cmul(y[q], pw); pw = cmul(pw, u2); }
#pragma unroll
    for (int j = 0; j < 16; ++j) y[j] = cmul(xo[j], w32c(j));
    dft16<false>(y);
    pw = u;
#pragma unroll
    for (int q = 0; q < 16; ++q) { Ob[QS * q] = cmul(y[q], pw); pw = cmul(pw, u2); }
}
template <bool INV> __device__ __forceinline__ void fft_pass1(LAS f32x2* A, int tau, const LAS f32x2* tw) {
    const int i = tau & 15, base = (tau >> 4) << 8; const f32x2 u0 = tw[32 * i]; const f32x2 u = INV ? cconj(u0) : u0;
    f32x2 y[16]; LAS f32x2* Ab = A + fphys(base + i);
#pragma unroll
    for (int j = 0; j < 16; ++j) y[j] = Ab[17 * j];
    if (INV) { f32x2 pw = u;
#pragma unroll
        for (int q = 1; q < 16; ++q) { y[q] = cmul(y[q], pw); pw = cmul(pw, u); } }
    dft16<INV>(y);
    if (!INV) { f32x2 pw = u;
#pragma unroll
        for (int q = 1; q < 16; ++q) { y[q] = cmul(y[q], pw); pw = cmul(pw, u); } }
#pragma unroll
    for (int j = 0; j < 16; ++j) Ab[17 * j] = y[j];
}
template <bool INV> __device__ __forceinline__ void fft_pass1_pair(LAS f32x2* A, LAS f32x2* B, int tau, const LAS f32x2* tw) {
    const int i = tau & 15, base = (tau >> 4) << 8; const f32x2 u0 = tw[32 * i]; const f32x2 u = INV ? cconj(u0) : u0;
    f32x2 y[16], z[16]; LAS f32x2* Ab = A + fphys(base + i); LAS f32x2* Bb = B + fphys(base + i);
#pragma unroll
    for (int j = 0; j < 16; ++j) y[j] = Ab[17 * j];
#pragma unroll
    for (int j = 0; j < 16; ++j) z[j] = Bb[17 * j];
    f32x2 pwr[16]; pwr[1] = u;
#pragma unroll
    for (int q = 2; q < 16; ++q) pwr[q] = cmul(pwr[q - 1], u);
    if (INV) {
#pragma unroll
        for (int q = 1; q < 16; ++q) y[q] = cmul(y[q], pwr[q]); }
    dft16<INV>(y);
    if (!INV) {
#pragma unroll
        for (int q = 1; q < 16; ++q) y[q] = cmul(y[q], pwr[q]); }
#pragma unroll
    for (int j = 0; j < 16; ++j) Ab[17 * j] = y[j];
    if (INV) {
#pragma unroll
        for (int q = 1; q < 16; ++q) z[q] = cmul(z[q], pwr[q]); }
    dft16<INV>(z);
    if (!INV) {
#pragma unroll
        for (int q = 1; q < 16; ++q) z[q] = cmul(z[q], pwr[q]); }
#pragma unroll
    for (int j = 0; j < 16; ++j) Bb[17 * j] = z[j];
}
__device__ __forceinline__ void fft_fwd2(const LAS f32x2* A, int t, f32x2 (&y)[16]) {
#pragma unroll
    for (int j = 0; j < 16; ++j) y[j] = A[17 * t + j];
    dft16<false>(y);
}
__device__ __forceinline__ void kf_load(const f32x2* kf, f32x4 (&k)[8]) {
#pragma unroll
    for (int j = 0; j < 8; ++j) k[j] = *(const f32x4*)(kf + 2 * j);
}
__device__ __forceinline__ void fft_mid(LAS f32x2* A, int t, const f32x4 (&k)[8]) {
    f32x2 y[16];
    fft_fwd2(A, t, y);
#pragma unroll
    for (int j = 0; j < 8; ++j) { y[2 * j] = cmul(y[2 * j], (f32x2){k[j][0], k[j][1]}); y[2 * j + 1] = cmul(y[2 * j + 1], (f32x2){k[j][2], k[j][3]}); }
    dft16<true>(y);
#pragma unroll
    for (int j = 0; j < 16; ++j) A[17 * t + j] = y[j];
}
template <int S>
__device__ __forceinline__ void fft_inv0(const LAS f32x2* E, const LAS f32x2* O, int t, const LAS f32x2* tw, f32x2 (&out)[16]) {
    const f32x2 u = tw[t * (256 / S)]; const f32x2 u2 = cmul(u, u);
    f32x2 y[16];
    constexpr int QS = S + S / 16;
    const LAS f32x2* Eb = E + fphys(t); const LAS f32x2* Ob = O + fphys(t);
    f32x2 pw = u2; y[0] = Eb[0];
#pragma unroll
    for (int q = 1; q < 16; ++q) { y[q] = cmulc(Eb[QS * q], pw); pw = cmul(pw, u2); }
    dft16<true>(y);
#pragma unroll
    for (int j = 0; j < 16; ++j) out[j] = y[j];
    pw = u;
#pragma unroll
    for (int q = 0; q < 16; ++q) { y[q] = cmulc(Ob[QS * q], pw); pw = cmul(pw, u2); }
    dft16<true>(y);
#pragma unroll
    for (int j = 0; j < 16; ++j) out[j] += cmulc(y[j], w32c(j));
}
__device__ __forceinline__ float hy_absdelta(int d) { return fabsf(-3.0701134573253943f + (-15.350567286626973f + 3.0701134573253943f) * ((float)d / 2047.0f)); }

__device__ __forceinline__ void filt_fft_phase(const Params& p, LAS unsigned char* lds) {
    const int tid = tid_fresh();
    LAS f32x2* tw = (LAS f32x2*)(lds + LDS_MISC + 1024);
    tw[tid] = ((const f32x2*)(p.ws + WS_TW))[tid];
    __syncthreads();
    {
        const int grp = tid >> 8, tau = tid & 255;
        LAS f32x2* E = (LAS f32x2*)(lds + grp * 69632); LAS f32x2* O = E + 4352; LAS float* red = (LAS float*)(lds + LDS_MISC) + grp * 8;
        for (int pb = blockIdx.x * 2 + grp; pb < 2 * 2 * 2048; pb += gridDim.x * 2) {
            const int d = pb & 2047, n = (pb >> 11) & 1, j = pb >> 12;
            const float* tf = (const float*)(p.ws + WS_TAPS) + ((size_t)j * 8192 + (size_t)(n * 2 + 0) * D + d) * 4096;
            const float* tb = tf + (size_t)D * 4096;
            const float adel = hy_absdelta(d); const float tscale = 1.0f / 4095.0f;
            f32x2 xe[16], xo[16]; float ss = 0.f;
#pragma unroll
            for (int jj = 0; jj < 16; ++jj) { const int nn = tau + 256 * jj;
                const float klo = tf[nn] * expf(-(float)nn * tscale * adel);
                const int m = 4096 - nn;
                const float khi = (m < 4096) ? tb[m & 4095] * expf(-(float)m * tscale * adel) : 0.f;
                ss += klo * klo + khi * khi; xe[jj] = (f32x2){klo + khi, 0.f}; xo[jj] = (f32x2){klo - khi, 0.f}; }
            ss = wave_sum(ss);
            if ((tid & 63) == 0) red[(tid >> 6) & 3] = ss;
            fft_fwd0<256>(xe, xo, E, O, tau, tw);
            __syncthreads();
            const float tot = red[0] + red[1] + red[2] + red[3];
            const float scale = (1.0f / sqrtf(tot + EPS)) * (1.0f / 8192.0f);
            const float hbs = p.hy_bias[((size_t)j * 2 + n) * D + d] * (1.0f / 8192.0f);
            fft_pass1<false>(E, tau, tw); fft_pass1<false>(O, tau, tw);
            __syncthreads();
            f32x2* kf = (f32x2*)(p.ws + WS_KF) + (size_t)pb * 8192 + (size_t)tau * 16;
            f32x2 y[16];
            fft_fwd2(E, tau, y);
#pragma unroll
            for (int q = 0; q < 8; ++q) *(f32x4*)(kf + 2 * q) = (f32x4){y[2 * q].x * scale + hbs, y[2 * q].y * scale, y[2 * q + 1].x * scale + hbs, y[2 * q + 1].y * scale};
            fft_fwd2(O, tau, y);
#pragma unroll
            for (int q = 0; q < 8; ++q) *(f32x4*)(kf + 4096 + 2 * q) = (f32x4){y[2 * q].x * scale + hbs, y[2 * q].y * scale, y[2 * q + 1].x * scale + hbs, y[2 * q + 1].y * scale};
            __syncthreads();
        }
    }
    {
        const int pr = tid >> 4, i = tid & 15;
        LAS f32x2* E = (LAS f32x2*)(lds + pr * 4352); LAS f32x2* O = E + 272;
        for (int it = blockIdx.x; it < 256; it += gridDim.x) {
            const int pb = it * 32 + pr; const int d = pb & 2047, n = (pb >> 11) & 1, j = pb >> 12;
            const float* tf = (const float*)(p.ws + WS_TAPSC) + ((size_t)j * 8192 + (size_t)(n * 2 + 0) * D + d) * 256;
            const float* tb = tf + (size_t)D * 256;
            const float adel = hy_absdelta(d); const float tscale = 1.0f / 255.0f;
            f32x2 xe[16], xo[16]; float ss = 0.f;
#pragma unroll
            for (int jj = 0; jj < 16; ++jj) { const int nn = i + 16 * jj;
                const float klo = tf[nn] * expf(-(float)nn * tscale * adel);
                const int m = 256 - nn;
                const float khi = (m < 256) ? tb[m & 255] * expf(-(float)m * tscale * adel) : 0.f;
                ss += klo * klo + khi * khi; xe[jj] = (f32x2){klo + khi, 0.f}; xo[jj] = (f32x2){klo - khi, 0.f}; }
            ss += shx(ss, 8); ss += shx(ss, 4); ss += shx(ss, 2); ss += shx(ss, 1);
            const float scale = (1.0f / sqrtf(ss + EPS)) * (1.0f / 512.0f);
            const float hbs = p.hy_bias[((size_t)j * 2 + n) * D + d] * (1.0f / 512.0f);
            fft_fwd0<16>(xe, xo, E, O, i, tw);
            __syncthreads();
            f32x2* kf = (f32x2*)(p.ws + WS_KFC) + (size_t)pb * 512 + (size_t)i * 16;
            f32x2 y[16];
            fft_fwd2(E, i, y);
#pragma unroll
            for (int q = 0; q < 8; ++q) *(f32x4*)(kf + 2 * q) = (f32x4){y[2 * q].x * scale + hbs, y[2 * q].y * scale, y[2 * q + 1].x * scale + hbs, y[2 * q + 1].y * scale};
            fft_fwd2(O, i, y);
#pragma unroll
            for (int q = 0; q < 8; ++q) *(f32x4*)(kf + 256 + 2 * q) = (f32x4){y[2 * q].x * scale + hbs, y[2 * q].y * scale, y[2 * q + 1].x * scale + hbs, y[2 * q + 1].y * scale};
            __syncthreads();
        }
    }
}

__device__ __forceinline__ float conv3_lds(const LAS h16* row, int n, float w0, float w1, float w2, float b) { return (float)row[n - 1] * w0 + (float)row[n] * w1 + (float)row[n + 1] * w2 + b; }
constexpr int ST_P = 4112, STS_P = 272;

#ifndef PROBE_CVAR
#define PROBE_CVAR 0
#endif
__device__ __forceinline__ void conv_phase(const Params& p, int jl, LAS unsigned char* lds, int pvar = 0, int cvt_layer = -1, int cvt_n = 0) {
    const int tid = tid_fresh(); const bool cv_outer = !(pvar && (PROBE_CVAR & 1)), cv_inner = !(pvar && (PROBE_CVAR & 2));
    LAS f32x2* tw = (LAS f32x2*)(lds + LDS_MISC + 1024);
    tw[tid] = ((const f32x2*)(p.ws + WS_TW))[tid];
    __syncthreads();
    const h16* ut = (const h16*)(p.ws + WS_UT); h16* zt = (h16*)(p.ws + WS_ZT);
    const float* cw = p.hy_conv_w + (size_t)jl * 3 * D3; const float* cb = p.hy_conv_b + (size_t)jl * D3;
    {
        const int grp = tid >> 8, tau = tid & 255;
        LAS f32x2* E = (LAS f32x2*)(lds + grp * 69632); LAS f32x2* O = E + 4352; LAS h16* ST = (LAS h16*)E;
        int uit = 0; const int utrig = 4 * (((int)blockIdx.x >> 3) & 3);
        for (int unit = blockIdx.x; unit < 4096; unit += gridDim.x, ++uit) {
            if (cvt_layer >= 0 && uit == utrig) { __syncthreads(); cvt_moe_share(p, cvt_layer, blockIdx.x, cvt_n, gridDim.x, (LAS float*)lds); }
            const int ux = unit & 7, uj = unit >> 3; const int hq = uj & 1, d = (uj >> 1) * 8 + ux; const size_t col0 = (size_t)(4 * hq + 2 * grp) * 4096;
            const f32x2* kfb = (const f32x2*)(p.ws + WS_KF) + ((size_t)(jl * 2) * 2048 + d) * 8192 + (size_t)tau * 16;
            f16x8 raw[2][2][2], raw2[2][2];
#pragma unroll
            for (int sq = 0; sq < 2; ++sq)
#pragma unroll
                for (int bb = 0; bb < 2; ++bb)
#pragma unroll
                    for (int k = 0; k < 2; ++k) raw[sq][bb][k] = *(const f16x8*)(ut + (size_t)(sq * D + d) * TT + col0 + (size_t)bb * 4096 + (size_t)(tau + 256 * k) * 8);
            __syncthreads();
#pragma unroll
            for (int sq = 0; sq < 2; ++sq)
#pragma unroll
                for (int bb = 0; bb < 2; ++bb)
#pragma unroll
                    for (int k = 0; k < 2; ++k) *(LAS f16x8*)(ST + (sq * 2 + bb) * ST_P + 8 + (tau + 256 * k) * 8) = raw[sq][bb][k];
            if (tau < 4) { ST[tau * ST_P + 7] = (h16)0.f; ST[tau * ST_P + 8 + 4096] = (h16)0.f; }
            __syncthreads();
            f32x2 xin[16], gk[16], y[16];
            { const float w0 = cw[d], w1 = cw[D3 + d], w2 = cw[2 * D3 + d], bv = cb[d]; const float g0 = cw[D + d], g1 = cw[D3 + D + d], g2 = cw[2 * D3 + D + d], gb = cb[D + d];
#pragma unroll
                for (int jj = 0; jj < 16; ++jj) { const int nn = tau + 256 * jj;
                    xin[jj] = (f32x2){conv3_lds(ST + 8, nn, w0, w1, w2, bv), conv3_lds(ST + ST_P + 8, nn, w0, w1, w2, bv)};
                    gk[jj] = (f32x2){conv3_lds(ST + 2 * ST_P + 8, nn, g0, g1, g2, gb), conv3_lds(ST + 3 * ST_P + 8, nn, g0, g1, g2, gb)}; } }
            __syncthreads();
#pragma unroll 1
            for (int ord = 0; ord < 2; ++ord) {
                if (cv_outer) fft_fwd0<256>(xin, xin, E, O, tau, tw);
                const f32x2* kf = kfb + (size_t)ord * 2048 * 8192; f32x4 kfe[8], kfo[8];
                kf_load(kf, kfe);
                __syncthreads();
                if (cv_inner) fft_pass1_pair<false>(E, O, tau, tw);
                kf_load(kf + 4096, kfo);
                __syncthreads();
                if (cv_inner) { fft_mid(E, tau, kfe); fft_mid(O, tau, kfo); }
                if (ord == 0) {
#pragma unroll
                    for (int bb = 0; bb < 2; ++bb)
#pragma unroll
                        for (int k = 0; k < 2; ++k) raw2[bb][k] = *(const f16x8*)(ut + (size_t)(2 * D + d) * TT + col0 + (size_t)bb * 4096 + (size_t)(tau + 256 * k) * 8); }
                __syncthreads();
                if (cv_inner) fft_pass1_pair<true>(E, O, tau, tw);
                __syncthreads();
                if (cv_outer) fft_inv0<256>(E, O, tau, tw, y); else {
#pragma unroll
                    for (int jj = 0; jj < 16; ++jj) y[jj] = xin[jj]; }
#pragma unroll
                for (int jj = 0; jj < 16; ++jj) xin[jj] = gk[jj] * y[jj];
                if (ord == 0) {
                    __syncthreads();
#pragma unroll
                    for (int bb = 0; bb < 2; ++bb)
#pragma unroll
                        for (int k = 0; k < 2; ++k) *(LAS f16x8*)(ST + bb * ST_P + 8 + (tau + 256 * k) * 8) = raw2[bb][k];
                    if (tau < 2) { ST[tau * ST_P + 7] = (h16)0.f; ST[tau * ST_P + 8 + 4096] = (h16)0.f; }
                    __syncthreads();
                    const float g0 = cw[2 * D + d], g1 = cw[D3 + 2 * D + d], g2 = cw[2 * D3 + 2 * D + d], gb = cb[2 * D + d];
#pragma unroll
                    for (int jj = 0; jj < 16; ++jj) { const int nn = tau + 256 * jj; gk[jj] = (f32x2){conv3_lds(ST + 8, nn, g0, g1, g2, gb), conv3_lds(ST + ST_P + 8, nn, g0, g1, g2, gb)}; }
                    __syncthreads();
                }
            }
            h16* o0 = zt + (size_t)d * TT + col0; h16* o1 = o0 + 4096;
#pragma unroll
            for (int jj = 0; jj < 16; ++jj) { const int nn = tau + 256 * jj; o0[nn] = (h16)xin[jj].x; o1[nn] = (h16)xin[jj].y; }
        }
    }
    {
        const int pr = tid >> 4, i = tid & 15, c8 = pr >> 2, bp = pr & 3;
        LAS f32x2* E = (LAS f32x2*)(lds + pr * 4352); LAS f32x2* O = E + 272; LAS h16* ST = (LAS h16*)lds;
        for (int unit = blockIdx.x; unit < 256; unit += gridDim.x) {
            const int d0 = unit * 8, d = d0 + c8;
            const f32x2* kfb = (const f32x2*)(p.ws + WS_KFC) + ((size_t)(jl * 2) * 2048 + d) * 512 + (size_t)i * 16;
            f16x8 raw[3][4];
#pragma unroll
            for (int sq = 0; sq < 3; ++sq)
#pragma unroll
                for (int k = 0; k < 4; ++k) { const int q = tid + 512 * k, row = q >> 5, ch = q & 31;
                    raw[sq][k] = *(const f16x8*)(ut + (size_t)(sq * D + d0 + (row >> 3)) * TT + TL + (row & 7) * 256 + ch * 8); }
            __syncthreads();
#pragma unroll
            for (int sq = 0; sq < 2; ++sq)
#pragma unroll
                for (int k = 0; k < 4; ++k) { const int q = tid + 512 * k, row = q >> 5, ch = q & 31; *(LAS f16x8*)(ST + (sq * 64 + row) * STS_P + 8 + ch * 8) = raw[sq][k]; }
            if (tid < 128) { ST[tid * STS_P + 7] = (h16)0.f; ST[tid * STS_P + 8 + 256] = (h16)0.f; }
            __syncthreads();
            f32x2 xin[16], gk[16], y[16];
            { const float w0 = cw[d], w1 = cw[D3 + d], w2 = cw[2 * D3 + d], bv = cb[d]; const float g0 = cw[D + d], g1 = cw[D3 + D + d], g2 = cw[2 * D3 + D + d], gb = cb[D + d];
                const LAS h16* r0 = ST + (c8 * 8 + 2 * bp) * STS_P + 8; const LAS h16* r1 = r0 + 64 * STS_P;
#pragma unroll
                for (int jj = 0; jj < 16; ++jj) { const int nn = i + 16 * jj;
                    xin[jj] = (f32x2){conv3_lds(r0, nn, w0, w1, w2, bv), conv3_lds(r0 + STS_P, nn, w0, w1, w2, bv)};
                    gk[jj] = (f32x2){conv3_lds(r1, nn, g0, g1, g2, gb), conv3_lds(r1 + STS_P, nn, g0, g1, g2, gb)}; } }
            __syncthreads();
#pragma unroll 1
            for (int ord = 0; ord < 2; ++ord) {
                const f32x2* kf = kfb + (size_t)ord * 2048 * 512; f32x4 kfe[8], kfo[8];
                fft_fwd0<16>(xin, xin, E, O, i, tw);
                __syncthreads();
                kf_load(kf, kfe); fft_mid(E, i, kfe); kf_load(kf + 256, kfo); fft_mid(O, i, kfo);
                __syncthreads();
                fft_inv0<16>(E, O, i, tw, y);
#pragma unroll
                for (int jj = 0; jj < 16; ++jj) xin[jj] = gk[jj] * y[jj];
                if (ord == 0) {
                    __syncthreads();
#pragma unroll
                    for (int k = 0; k < 4; ++k) { const int q = tid + 512 * k, row = q >> 5, ch = q & 31; *(LAS f16x8*)(ST + row * STS_P + 8 + ch * 8) = raw[2][k]; }
                    if (tid < 64) { ST[tid * STS_P + 7] = (h16)0.f; ST[tid * STS_P + 8 + 256] = (h16)0.f; }
                    __syncthreads();
                    const float g0 = cw[2 * D + d], g1 = cw[D3 + 2 * D + d], g2 = cw[2 * D3 + 2 * D + d], gb = cb[2 * D + d];
                    const LAS h16* r0 = ST + (c8 * 8 + 2 * bp) * STS_P + 8;
#pragma unroll
                    for (int jj = 0; jj < 16; ++jj) { const int nn = i + 16 * jj; gk[jj] = (f32x2){conv3_lds(r0, nn, g0, g1, g2, gb), conv3_lds(r0 + STS_P, nn, g0, g1, g2, gb)}; }
                    __syncthreads();
                }
            }
            h16* o0 = zt + (size_t)d * TT + TL + (2 * bp) * 256; h16* o1 = o0 + 256;
#pragma unroll
            for (int jj = 0; jj < 16; ++jj) { const int nn = i + 16 * jj; o0[nn] = (h16)xin[jj].x; o1[nn] = (h16)xin[jj].y; }
        }
    }
}

constexpr int AT_KP = 72, AT_VP = 68;
__device__ __forceinline__ void attn_phase(const Params& p, int jl, bool with_ctx_out, LAS unsigned char* lds, int cvt_layer = -1, int cvt_n = 0) {
    const int tid = tid_fresh(), wv = tid >> 6, lane = tid & 63, r32 = lane & 31, hh = lane >> 5;
    LAS h16* Ks = (LAS h16*)lds; LAS h16* Vs = (LAS h16*)(lds + 64 * AT_KP * 2);
    const h16* qk = (const h16*)(p.ws + WS_QK); const h16* vt = (const h16*)(p.ws + WS_VT); h16* ob = (h16*)(p.ws + WS_HBUF);
    LAS float* rcos = (LAS float*)(lds + 65536); LAS float* rsin = rcos + 1024;
    { const float* rg = (const float*)(p.ws + WS_ROPE); for (int i = tid; i < 2048; i += 512) rcos[i] = rg[i]; }
    __syncthreads();
    const int nunit = 2048 + (with_ctx_out ? 128 : 0);
    int uit = 0; const int utrig = 2 * (((int)blockIdx.x >> 3) & 3);
    for (int unit = blockIdx.x; unit < nunit; unit += gridDim.x, ++uit) {
        if (cvt_layer >= 0 && uit == utrig) { __syncthreads(); cvt_moe_share(p, cvt_layer, blockIdx.x, cvt_n, gridDim.x, (LAS float*)lds); }
        int kind, b, g, qb;
        if (unit < 2048) { kind = 0; qb = unit & 63; g = (unit >> 6) & 3; b = unit >> 8; } else { const int u2 = unit - 2048; kind = 1; qb = u2 & 3; g = (u2 >> 2) & 3; b = u2 >> 4; }
        const int head = g * 8 + wv;
        const int qrow0 = kind ? (TL + b * 256 + qb * 64) : (b * 4096 + qb * 64);
        const int ctxrow0 = TL + b * 256;
        const int t_lo = kind ? 0 : (qb < 2 ? 2 - qb : 0), t_hi = kind ? -1 : (65 - qb < 4 ? 65 - qb : 4); const int nwin = t_hi - t_lo + 1, nv = nwin + 4;
        const bool krole = tid < 256; const int kkey = tid >> 2, kcp = tid & 3, kdA = (kcp & 1) * 8 + (kcp >> 1) * 32; const int vdim = (tid - 256) >> 2, vkc = tid & 3;
        f16x8 ld0, ld1;
#define AT_TILE(sidx, KROW0, MASK, ROPE) do { if ((sidx) < nwin) { const int _ti = t_lo + (sidx); KROW0 = b * 4096 + qb * 64 - 128 + 64 * _ti; ROPE = true; MASK = (_ti == 0) ? 1 : (_ti == 4) ? 2 : 0; } \
            else { KROW0 = ctxrow0 + 64 * ((sidx) - nwin); ROPE = false; MASK = 0; } } while (0)
#define AT_LOAD(KROW0) do { if (krole) { const h16* kp = qk + (size_t)((KROW0) + kkey) * DQK + D + g * 64 + kdA; ld0 = *(const f16x8*)kp; ld1 = *(const f16x8*)(kp + 16); } \
            else { const h16* vp = vt + (size_t)(g * 64 + vdim) * TT + (KROW0) + 16 * vkc; ld0 = *(const f16x8*)vp; ld1 = *(const f16x8*)(vp + 8); } } while (0)
        { int kr0, mk; bool rp; AT_TILE(0, kr0, mk, rp); (void)mk; (void)rp; AT_LOAD(kr0); }
        f16x8 qf[2][4];
#pragma unroll
        for (int qt = 0; qt < 2; ++qt) {
            f32x4 qv[4][2];
            const h16* qp = qk + (size_t)(qrow0 + 32 * qt + r32) * DQK + head * 64 + 8 * hh;
#pragma unroll
            for (int ks = 0; ks < 4; ++ks) { const f16x8 t = *(const f16x8*)(qp + 16 * ks);
#pragma unroll
                for (int i = 0; i < 4; ++i) { qv[ks][0][i] = (float)t[i]; qv[ks][1][i] = (float)t[4 + i]; } }
            if (kind == 0) {
                const int colpos = 32 * qt + r32;
#pragma unroll
                for (int a = 0; a < 2; ++a) { const int pos = a ? colpos : qb; const LAS float* cp = rcos + pos * 16 + 8 * hh; const LAS float* sp = rsin + pos * 16 + 8 * hh;
#pragma unroll
                    for (int e = 0; e < 2; ++e) { const f32x4 c = *(const LAS f32x4*)(cp + 4 * e), s = *(const LAS f32x4*)(sp + 4 * e);
                        const f32x4 x1 = qv[2 * a][e], x2 = qv[2 * a + 1][e]; qv[2 * a][e] = x1 * c - x2 * s; qv[2 * a + 1][e] = x2 * c + x1 * s; } }
            }
#pragma unroll
            for (int ks = 0; ks < 4; ++ks)
#pragma unroll
                for (int i = 0; i < 4; ++i) { qf[qt][ks][i] = (h16)(qv[ks][0][i] * (0.125f * 1.4426950408889634f)); qf[qt][ks][4 + i] = (h16)(qv[ks][1][i] * (0.125f * 1.4426950408889634f)); }
        }
        const float sink = p.at_sink[jl * 32 + head] * 1.4426950408889634f;
        float mrun[2] = {sink, sink}, lrun[2] = {hh == 0 ? 1.f : 0.f, hh == 0 ? 1.f : 0.f};
        f32x16 oacc[2][2];
#pragma unroll
        for (int a = 0; a < 2; ++a)
#pragma unroll
            for (int c = 0; c < 2; ++c)
#pragma unroll
                for (int i = 0; i < 16; ++i) oacc[a][c][i] = 0.f;
#pragma unroll 1
        for (int sx = 0; sx < nv; ++sx) {
            int krow0, mask; bool rope; AT_TILE(sx, krow0, mask, rope);
            __syncthreads();
            if (krole) {
                f16x8 o1 = ld0, o2 = ld1;
                if (rope) { const int kpos = (krow0 - b * 4096) + kkey; const int pos = (kcp >> 1) ? (kpos & 63) : (kpos >> 6);
                    const LAS float* cpp = rcos + pos * 16 + (kcp & 1) * 8; const LAS float* spp = rsin + pos * 16 + (kcp & 1) * 8;
#pragma unroll
                    for (int i = 0; i < 8; ++i) { const float c = cpp[i], s = spp[i], x1 = (float)ld0[i], x2 = (float)ld1[i]; o1[i] = (h16)(x1 * c - x2 * s); o2[i] = (h16)(x2 * c + x1 * s); } }
                *(LAS f16x8*)(Ks + kkey * AT_KP + kdA) = o1; *(LAS f16x8*)(Ks + kkey * AT_KP + kdA + 16) = o2;
            } else {
                LAS h16* dst = Vs + vdim * AT_VP + 16 * vkc;
                *(LAS f16x4*)(dst) = (f16x4){ld0[0], ld0[1], ld0[2], ld0[3]}; *(LAS f16x4*)(dst + 4) = (f16x4){ld0[4], ld0[5], ld0[6], ld0[7]};
                *(LAS f16x4*)(dst + 8) = (f16x4){ld1[0], ld1[1], ld1[2], ld1[3]}; *(LAS f16x4*)(dst + 12) = (f16x4){ld1[4], ld1[5], ld1[6], ld1[7]};
            }
            if (sx + 1 < nv) { int kr1, mk1; bool rp1; AT_TILE(sx + 1, kr1, mk1, rp1); (void)mk1; (void)rp1; AT_LOAD(kr1); }
            __syncthreads();
#pragma unroll
            for (int qt = 0; qt < 2; ++qt) {
                f32x16 sacc[2];
#pragma unroll
                for (int kt = 0; kt < 2; ++kt)
#pragma unroll
                    for (int i = 0; i < 16; ++i) sacc[kt][i] = 0.f;
#pragma unroll
                for (int ks = 0; ks < 4; ++ks)
#pragma unroll
                    for (int kt = 0; kt < 2; ++kt) { const f16x8 kf = *(const LAS f16x8*)(Ks + (32 * kt + r32) * AT_KP + 16 * ks + 8 * hh);
                        sacc[kt] = __builtin_amdgcn_mfma_f32_32x32x16_f16(kf, qf[qt][ks], sacc[kt], 0, 0, 0); }
                float tmax = -3.0e38f;
                if (mask != 0) {
                    int lim = r32 - 4 * hh; asm volatile("" : "+v"(lim));
                    if (mask == 1) {
#pragma unroll
                        for (int kt = 0; kt < 2; ++kt) {
                            if (kt < qt) {
#pragma unroll
                                for (int i = 0; i < 16; ++i) sacc[kt][i] = -1.0e30f; }
                            else if (kt == qt) {
#pragma unroll
                                for (int i = 0; i < 16; ++i) { const int kc = (i & 3) + 8 * (i >> 2); if (kc < lim) sacc[kt][i] = -1.0e30f; } } }
                    } else {
#pragma unroll
                        for (int kt = 0; kt < 2; ++kt) {
                            if (kt > qt) {
#pragma unroll
                                for (int i = 0; i < 16; ++i) sacc[kt][i] = -1.0e30f; }
                            else if (kt == qt) {
#pragma unroll
                                for (int i = 0; i < 16; ++i) { const int kc = (i & 3) + 8 * (i >> 2); if (kc > lim) sacc[kt][i] = -1.0e30f; } } }
                    } }
#pragma unroll
                for (int kt = 0; kt < 2; ++kt)
#pragma unroll
                    for (int i = 0; i < 16; ++i) tmax = fmaxf(tmax, sacc[kt][i]);
                tmax = fmaxf(tmax, shx(tmax, 32));
                const float mnew = fmaxf(mrun[qt], tmax); const float alpha = __builtin_amdgcn_exp2f(mrun[qt] - mnew); mrun[qt] = mnew;
                float psum = 0.f; f16x8 pf[2][2];
#pragma unroll
                for (int kt = 0; kt < 2; ++kt)
#pragma unroll
                    for (int s2 = 0; s2 < 2; ++s2)
#pragma unroll
                        for (int jj = 0; jj < 8; jj += 2) { const float p0 = __builtin_amdgcn_exp2f(sacc[kt][8 * s2 + jj] - mnew), p1 = __builtin_amdgcn_exp2f(sacc[kt][8 * s2 + jj + 1] - mnew);
                            const f16x2 pk = {(h16)p0, (h16)p1}; pf[kt][s2][jj] = pk[0]; pf[kt][s2][jj + 1] = pk[1];
                            psum = __builtin_amdgcn_fdot2(pk, (f16x2){(h16)1.0f, (h16)1.0f}, psum, false); }
                lrun[qt] = lrun[qt] * alpha + psum;
                if (__builtin_amdgcn_ballot_w64(alpha != 1.0f) != 0ull) {
#pragma unroll
                for (int dt = 0; dt < 2; ++dt)
#pragma unroll
                    for (int i = 0; i < 16; ++i) oacc[dt][qt][i] *= alpha; }
#pragma unroll
                for (int kt = 0; kt < 2; ++kt)
#pragma unroll
                    for (int s2 = 0; s2 < 2; ++s2)
#pragma unroll
                        for (int dt = 0; dt < 2; ++dt) { const LAS h16* vr = Vs + (32 * dt + r32) * AT_VP + 32 * kt + 16 * s2 + 4 * hh;
                            const f16x4 v0 = *(const LAS f16x4*)vr, v1 = *(const LAS f16x4*)(vr + 8);
                            const f16x8 vf = (f16x8){v0[0], v0[1], v0[2], v0[3], v1[0], v1[1], v1[2], v1[3]};
                            oacc[dt][qt] = __builtin_amdgcn_mfma_f32_32x32x16_f16(vf, pf[kt][s2], oacc[dt][qt], 0, 0, 0); }
            }
        }
#pragma unroll
        for (int qt = 0; qt < 2; ++qt) {
            const float ltot = lrun[qt] + shx(lrun[qt], 32); const float inv = 1.0f / ltot;
            h16* op = ob + (size_t)(qrow0 + 32 * qt + r32) * D + head * 64 + 4 * hh;
#pragma unroll
            for (int dt = 0; dt < 2; ++dt)
#pragma unroll
                for (int q4 = 0; q4 < 4; ++q4) { f16x4 w;
#pragma unroll
                    for (int i = 0; i < 4; ++i) w[i] = (h16)(oacc[dt][qt][4 * q4 + i] * inv);
                    *(f16x4*)(op + 32 * dt + 8 * q4) = w; }
        }
    }
}
#undef AT_TILE
#undef AT_LOAD

constexpr int NPHASE = 35;
#ifndef MK_MULTI
#define MK_MULTI 0
#endif

template <int KIND>
__attribute__((target("no-packed-fp32-ops"))) __global__ void __launch_bounds__(512, 2) hy_fwd(Params p_) {
    extern __shared__ __attribute__((aligned(16))) unsigned char shm[];
    LAS unsigned char* lds = (LAS unsigned char*)shm;
    constexpr bool ALL = KIND < 0;
    const int ph0 = p_.ph0;
    if (threadIdx.x == 0) { *(LAS u32x4*)(lds + LDS_XB) = (u32x4){0u, 0u, 0u, 0u}; }
    __syncthreads();
    XcdBarrier bar;
    if constexpr (ALL) bar = xcd_barrier_post((unsigned*)(p_.ws + WS_CTL), (volatile LAS unsigned*)(lds + LDS_XB));
#ifndef PROBE_SITE
#define PROBE_SITE -1
#endif
#define SITE(k) if constexpr (ALL || KIND == (k)) for (int rep_ = 0; rep_ < ((k) == PROBE_SITE ? 2 : 1); ++rep_) if (const Params& p = *params_fresh(); true)
#ifndef PROBE_XBAR
#define PROBE_XBAR 1
#endif
#define SEAM() do { if constexpr (ALL) { xcd_barrier(bar); if (PROBE_XBAR > 1) xcd_barrier(bar); if (PROBE_XBAR > 2) xcd_barrier(bar); } } while (0)
    const int G = gridDim.x, bid = blockIdx.x;
    SITE(0) {
        for (int u = bid; u < 4993; u += G) {
            if (u < 384) modp_unit(p, u, (LAS float*)lds);
            else if (u == 384) tables_unit(p);
            else if (u < 1473) h2_task(p, (u - 385) * 8 + (tid_fresh() >> 6));
            else if (u < 1537) w3p_unit(p, u - 1473);
            else if (u < 1793) rtab_unit(p, u - 1537);
            else cvt_dense_unit(p, u - 1793, (LAS float*)lds);
        }
        SEAM();
    }
    SITE(1) {
        for (int u = bid; u < 216; u += G) modr_unit(p, u);
        SchedFilt S{p.ws + WS_W3P, p.ws + WS_H2P}; EpiTaps E{(float*)(p.ws + WS_TAPS), (float*)(p.ws + WS_TAPSC)};
        pg8::gemm_phase<EpiTaps, SchedFilt, 0>(lds, 256, S, E);
        SEAM();
    }
#define TAIL_IDLE(nunits) (((nunits) % G) ? G - ((nunits) % G) : 0)
#define CVT_PER_GEMM 20
#pragma unroll 1
    for (int layer = ALL ? 0 : ph0; layer < (ALL ? NLAYER : ph0 + 1); ++layer) {
        const bool hyena = (layer & 1) == 0; const int jl = layer >> 1;
        const int nu1 = hyena ? 24 * 136 : 136 * 10, nu4 = (layer == NLAYER - 1 ? 128 : 136) * 8;
        const int idle1 = TAIL_IDLE(nu1), idle4 = TAIL_IDLE(nu4);
        int cv4 = idle4 * CVT_PER_GEMM, cv1 = idle1 * CVT_PER_GEMM; if (cv4 > CVT_MOE_UNITS / 2) cv4 = CVT_MOE_UNITS / 2; if (cv1 > CVT_MOE_UNITS / 2 - 1) cv1 = CVT_MOE_UNITS / 2 - 1;
        const int cvN0 = CVT_MOE_UNITS - cv1 - cv4, cvN1 = cvN0 + cv1;
        SITE(2) {
            n1_phase(p, layer, (h16*)(p.ws + ((!ALL && p.ph1) ? WS_UT : WS_XRES)));
            for (int rep2_ = 0; rep2_ < ((PROBE_SITE == 20 && layer > 0) ? 2 : 1); ++rep2_) {
            if (layer == 0) filt_fft_phase(p, lds);
            else { (void)0; } }
            SEAM();
        }
        SITE(3) {
#ifdef PROBE_CLK
            unsigned long long pc0_ = __builtin_readcyclecounter(), pr0_ = wall_clock64();
#endif
            if (hyena) { SchedPlain S{24, 136, D, p.ws + WS_WIN + (size_t)jl * D3 * D * 2, p.ws + WS_HBUF}; EpiH16 E{(h16*)(p.ws + WS_UT), TT, nullptr, 0};
                pg8::gemm_phase<EpiH16, SchedPlain, 0>(lds, D, S, E); }
            else { SchedQkv S{p.ws + WS_HBUF, p.ws + WS_WQKV + (size_t)jl * DQKV * D * 2}; EpiH16 E{(h16*)(p.ws + WS_QK), DQK, (h16*)(p.ws + WS_VT), TT};
                pg8::gemm_phase<EpiH16, SchedQkv, 0>(lds, D, S, E); }
#ifdef PROBE_CLK
            if (bid == 0 && threadIdx.x == 0) { const unsigned long long dc = __builtin_readcyclecounter() - pc0_, dr = wall_clock64() - pr0_; const unsigned long long spin = dc * 2500ull / (dr ? dr : 1ull);
                const unsigned long long t0 = wall_clock64(); while (wall_clock64() - t0 < spin) __builtin_amdgcn_s_sleep(8); }
#endif
            if (idle1 > 0 && bid >= G - idle1) { cvt_moe_share(p, layer, cvN0 + (bid - (G - idle1)), cvN1, idle1, (LAS float*)lds); }
            SEAM();
        }
        SITE(4) {
#ifdef PROBE_PAR
            for (int rep3_ = 0; rep3_ < (((layer & 1) == PROBE_PAR) ? 2 : 1); ++rep3_)
#endif
            { if (hyena) conv_phase(p, jl, lds, ALL ? 0 : p.ph1, layer, cvN0);
            else attn_phase(p, jl, layer != NLAYER - 1, lds, layer, cvN0); }
            SEAM();
        }
        SITE(5) {
            (void)0;
        }
        SITE(6) {
            EpiResid E{(h16*)(p.ws + WS_XRES), (const float*)(p.ws + WS_MODS), layer, (float*)(p.ws + WS_SSQ), (!ALL && p.ph1) ? (h16*)(p.ws + WS_YC) : (h16*)(p.ws + WS_XRES)};
            if (hyena) {
                SchedPlainAT S{layer == NLAYER - 1 ? 128 : 136, 8, D, p.ws + WS_ZT, p.ws + WS_WOUT + (size_t)jl * D * D * 2};
                pg8::gemm_phase<EpiResid, SchedPlainAT, 2>(lds, D, S, E, TT);
            } else {
                SchedPlain S{layer == NLAYER - 1 ? 128 : 136, 8, D, p.ws + WS_HBUF, p.ws + WS_WO + (size_t)jl * D * D * 2};
                pg8::gemm_phase<EpiResid, SchedPlain, 0>(lds, D, S, E);
            }
            if (idle4 > 0 && bid >= G - idle4) { cvt_moe_share(p, layer, cvN1 + (bid - (G - idle4)), CVT_MOE_UNITS, idle4, (LAS float*)lds); }
            SEAM();
        }
        SITE(7) { n2_phase(p, layer, lds, ALL ? 0 : p.ph1); SEAM(); }
        LAS int* tstart = (LAS int*)(lds + LDS_MISC); LAS int* texp = tstart + 80; LAS int* tcnt = texp + 352;
        SITE(8) {
            moe_table(tstart, texp, tcnt, (const int*)(p.ws + WS_CTL) + CTL_CNT + layer * NE);
            SchedMoe1 S{{tstart, texp, tcnt}, p.ws + WS_HBUF, p.ws + WS_W13, (const int*)(p.ws + WS_LIST)}; EpiMoe1 E{(h16*)(p.ws + WS_H1)};
            pg8::gemm_phase<EpiMoe1, SchedMoe1, 1>(lds, D, S, E);
            SEAM();
        }
        SITE(9) {
            moe_table(tstart, texp, tcnt, (const int*)(p.ws + WS_CTL) + CTL_CNT + layer * NE);
            SchedMoe2 S{{tstart, texp, tcnt}, p.ws + WS_H1, p.ws + WS_W2, (const int*)(p.ws + WS_LIST)}; EpiMoe2 E{(h16*)(p.ws + WS_YC), (const float*)(p.ws + WS_GATE), (const int*)(p.ws + WS_LIST)};
            pg8::gemm_phase<EpiMoe2, SchedMoe2, 0>(lds, DE, S, E);
            SEAM();
        }
    }
    SITE(10) final_phase(p);
#undef SITE
#undef SEAM
}

template <int KIND> static void launch_kind(const Params& p, int grid, hipStream_t stream) {
    static bool attr = false;
    if (!attr) { attr = true; if (hipFuncSetAttribute((const void*)hy_fwd<KIND>, hipFuncAttributeMaxDynamicSharedMemorySize, LDS_BYTES) != hipSuccess) fprintf(stderr, "kernel_launch: hipFuncSetAttribute failed (kind %d)\n", KIND); }
    hipLaunchKernelGGL(hy_fwd<KIND>, dim3(grid), dim3(512), LDS_BYTES, stream, p);
}

extern "C" void kernel_launch(void* const* d_in, const int* in_sizes, int n_in, void* d_out, int out_size, void* d_ws, size_t ws_size, hipStream_t stream) {
    static int grid = 0;
    if (!grid) {
        if (n_in != 29 || out_size != TL * D || ws_size < WS_END) { fprintf(stderr, "kernel_launch: unexpected problem (n_in %d, out %d, ws %zu < %zu)\n", n_in, out_size, ws_size, (size_t)WS_END); grid = -1; return; }
        int dev = 0, cus = 0;
        if (hipGetDevice(&dev) != hipSuccess || hipDeviceGetAttribute(&cus, hipDeviceAttributeMultiprocessorCount, dev) != hipSuccess) { grid = -1; return; }
        grid = cus;
    }
    if (grid <= 0) return;
    (void)hipMemsetAsync((char*)d_ws + WS_CTL, 0, CTL_BYTES, stream);
    Params p{};
    const float** pp = (const float**)&p;
    for (int i = 0; i < 29; ++i) pp[i] = (const float*)d_in[i];
    p.out = (float*)d_out; p.ws = (char*)d_ws;
#if MK_MULTI
    p.ph0 = 0; p.ph1 = 0;
    launch_kind<0>(p, grid, stream); launch_kind<1>(p, grid, stream);
#ifndef PROBE_KINDS
#define PROBE_KINDS 0
#endif
#ifndef PROBE_VAR
#define PROBE_VAR 0
#endif
#ifndef PROBE_LAYERS
#define PROBE_LAYERS 15
#endif
#define PKIND(k) ((PROBE_KINDS >> (k)) & 1)
#define PREP(k) ((PKIND(k) && ((PROBE_LAYERS >> layer) & 1)) ? 2 : 1)
    if (PKIND(0)) launch_kind<0>(p, grid, stream);
    if (PKIND(1)) launch_kind<1>(p, grid, stream);
    for (int layer = 0; layer < NLAYER; ++layer) { p.ph0 = layer;
        for (int r = 0; r < PREP(2); ++r) { p.ph1 = (PREP(2) == 2 && r == 0) ? 1 : 0; launch_kind<2>(p, grid, stream); p.ph1 = 0; }
        for (int r = 0; r < PREP(3); ++r) { p.ph1 = (PREP(3) == 2 && r == 0) ? PROBE_VAR : 0; launch_kind<3>(p, grid, stream); p.ph1 = 0; }
        for (int r = 0; r < PREP(4); ++r) { p.ph1 = (PREP(4) == 2 && r == 0) ? 1 : 0; launch_kind<4>(p, grid, stream); p.ph1 = 0; }
        if (PREP(6) == 2) { p.ph1 = 1; launch_kind<6>(p, grid, stream); p.ph1 = 0; }
        launch_kind<6>(p, grid, stream); launch_kind<7>(p, grid, stream);
        if (PREP(7) == 2) { p.ph1 = 1; launch_kind<7>(p, grid, stream); p.ph1 = 0; }
        for (int r = 0; r < PREP(8); ++r) launch_kind<8>(p, grid, stream);
        for (int r = 0; r < PREP(9); ++r) launch_kind<9>(p, grid, stream); }
    p.ph0 = 0; launch_kind<10>(p, grid, stream);
    if (PKIND(10)) launch_kind<10>(p, grid, stream);
#else
    p.ph0 = 0; p.ph1 = NPHASE;
    launch_kind<-1>(p, grid, stream);
#endif
}
```

```cpp
#include <hip/hip_runtime.h>
#include <cstdio>
#include <cstdint>

#define LAS __attribute__((address_space(3)))
typedef _Float16 h16;
typedef _Float16 f16x8 __attribute__((ext_vector_type(8)));
typedef _Float16 f16x4 __attribute__((ext_vector_type(4)));
typedef _Float16 f16x2 __attribute__((ext_vector_type(2)));
typedef float f32x2 __attribute__((ext_vector_type(2)));
typedef float f32x4 __attribute__((ext_vector_type(4)));
typedef float f32x16 __attribute__((ext_vector_type(16)));
typedef unsigned u32x2 __attribute__((ext_vector_type(2)));
typedef unsigned u32x4 __attribute__((ext_vector_type(4)));

constexpr int D = 2048, NB = 8, SEQ = 4096, CTXL = 256, TL = NB * SEQ, TC = NB * CTXL, TT = TL + TC;
constexpr int D3 = 3 * D, D6 = 6 * D, DQK = 2304, DQKV = 2560, NE = 64, DE = 384, DE2 = 768, NLAYER = 4;
constexpr int LCAP = TT;
constexpr int MOE_ROWS = 86016;
constexpr float EPS = 1e-6f;

constexpr size_t WS_CTL = 0;
constexpr size_t CTL_BYTES = 65536;
constexpr size_t WS_TW = WS_CTL + CTL_BYTES;
constexpr size_t WS_ROPE = WS_TW + 65536;
constexpr size_t WS_MODP = WS_ROPE + 8192;
constexpr size_t WS_MODS = WS_MODP + 16ull * 4 * 9 * 12288 * 4;
constexpr size_t WS_RTAB = WS_MODS + 4ull * 9 * 12288 * 4;
constexpr size_t RTAB_L = 64ull * 5 * 2 * 64 * 8 * 2;
constexpr size_t WS_RCST = WS_RTAB + 4 * RTAB_L;
constexpr size_t WS_H2P = WS_RCST + 16384;
constexpr size_t WS_W3P = WS_H2P + 2ull * 4352 * 256 * 2;
constexpr size_t WS_XRES = WS_W3P + 2ull * 8192 * 256 * 2;
constexpr size_t WS_HBUF = WS_XRES + (size_t)TT * D * 4;
constexpr size_t WS_UT = WS_HBUF + (size_t)TT * D * 2;
constexpr size_t UT_BYTES = (size_t)D3 * TT * 2;
constexpr size_t WS_TAPS = WS_UT;
constexpr size_t WS_TAPSC = WS_TAPS + 2ull * 8192 * 4096 * 4;
constexpr size_t WS_QK = WS_UT;
constexpr size_t WS_VT = WS_QK + (size_t)TT * DQK * 2;
constexpr size_t WS_ZT = WS_UT + UT_BYTES;
constexpr size_t WS_H1 = WS_ZT + (size_t)D * TT * 2;
constexpr size_t WS_YC = WS_H1 + (size_t)MOE_ROWS * DE * 2;
constexpr size_t WS_WIN = WS_YC + 2ull * TT * D * 2;
constexpr size_t WS_WOUT = WS_WIN + 2ull * D3 * D * 2;
constexpr size_t WS_WQKV = WS_WOUT + 2ull * D * D * 2;
constexpr size_t WS_WO = WS_WQKV + 2ull * DQKV * D * 2;
constexpr size_t WS_W13 = WS_WO + 2ull * D * D * 2;
constexpr size_t WS_W2 = WS_W13 + (size_t)NE * DE2 * D * 2;
constexpr size_t WS_KF = WS_W2 + (size_t)NE * D * DE * 2;
constexpr size_t WS_KFC = WS_KF + 2ull * 2 * 2048 * 65536;
constexpr size_t WS_LIST = WS_KFC + 2ull * 2 * 2048 * 4096;
constexpr size_t WS_GATE = WS_LIST + (size_t)NE * LCAP * 4;
constexpr size_t WS_SSQ = WS_GATE + (size_t)NE * LCAP * 4;
constexpr size_t WS_END = WS_SSQ + (size_t)TT * 32 * 4;
static_assert(WS_TAPSC + 2ull * 8192 * 256 * 4 <= WS_UT + UT_BYTES, "taps alias");
static_assert(WS_VT + 256ull * TT * 2 <= WS_UT + UT_BYTES, "qkv alias");

constexpr int CTL_CNT = 4096;

constexpr int LDS_BYTES = 147456;
constexpr int LDS_MISC = 139264;
constexpr int LDS_XB = LDS_BYTES - 16;

struct Params {
    const float *x, *c, *ctx, *c_ctx, *mod_w, *mod_b, *hy_w_in, *hy_conv_w, *hy_conv_b, *hy_f_w1, *hy_f_b1, *hy_f_freq1, *hy_f_w2, *hy_f_b2, *hy_f_freq2, *hy_f_w3,
        *hy_bias, *hy_w_out, *at_w_qkv, *at_sink, *at_w_o, *moe_wg, *moe_bg, *moe_we, *moe_be, *moe_w1, *moe_w3, *moe_w2, *final_gain;
    float* out; char* ws; int ph0, ph1;
};

__device__ __forceinline__ int tid_fresh() { int t = threadIdx.x; asm volatile("" : "+v"(t)); return t; }
__device__ __forceinline__ float bperm_f(float v, int srclane) { return __int_as_float(__builtin_amdgcn_ds_bpermute(srclane << 2, __float_as_int(v))); }
__device__ __forceinline__ float shx(float v, int mask) { return bperm_f(v, (tid_fresh() & 63) ^ mask); }
__device__ __forceinline__ const Params* params_fresh() { auto q = __builtin_amdgcn_kernarg_segment_ptr(); asm volatile("" : "+s"(q)); return (const Params*)q; }

#define XB_TMO      128
#define XB_XCNT(j)  (256  + 64 * (j))
#define XB_XSUB(j)  (1280 + 64 * (j))
#define XB_XGEN(j)  (2304 + 64 * (j))
#define XB_TOP      3328
#define XB_TOPGEN   3392
#define XCD_BAR_WORDS 3456
#define XB_SPIN_CAP (1u << 18)

__device__ __forceinline__ unsigned xb_ld(unsigned* p)              { return __hip_atomic_load(p, __ATOMIC_RELAXED, __HIP_MEMORY_SCOPE_AGENT); }
__device__ __forceinline__ unsigned xb_add(unsigned* p, unsigned v) { return __hip_atomic_fetch_add(p, v, __ATOMIC_RELAXED, __HIP_MEMORY_SCOPE_AGENT); }
__device__ __forceinline__ unsigned xb_xcc_id() { return (unsigned)__builtin_amdgcn_s_getreg((3 << 11) | 20) & 0xFu; }
#define XB_SPIN(cond, bar) do { unsigned _sp = 0; while (cond) { __builtin_amdgcn_s_sleep(1); \
    if ((++_sp & 255u) == 0u) { if (xb_ld(&(bar)[XB_TMO])) break; if (_sp > XB_SPIN_CAP) { atomicAdd(&(bar)[XB_TMO], 1u); break; } } } } while (0)

struct XcdBarrier { unsigned* bar; volatile LAS unsigned* st; };

__device__ __forceinline__ XcdBarrier xcd_barrier_post(unsigned* bar, volatile LAS unsigned* st) {
    XcdBarrier b; b.bar = bar; b.st = st;
    if (threadIdx.x == 0) (void)xb_add(&bar[XB_XCNT(xb_xcc_id())], 1u);
    return b;
}
__device__ __forceinline__ void xcd_barrier_complete(unsigned* bar, unsigned x, unsigned& nloc, unsigned& nx) {
    const unsigned G = gridDim.x * gridDim.y * gridDim.z;
    unsigned sum, cnt, mine, sp = 0u;
    for (;;) {
        sum = 0u; cnt = 0u; mine = 0u;
#pragma unroll
        for (unsigned j = 0; j < 16; ++j) { const unsigned c = xb_ld(&bar[XB_XCNT(j)]); sum += c; cnt += (c > 0u) ? 1u : 0u; mine = (j == x) ? c : mine; }
        if (sum == G) break;
        __builtin_amdgcn_s_sleep(1);
        if ((++sp & 255u) == 0u) { if (xb_ld(&bar[XB_TMO])) break; if (sp > XB_SPIN_CAP) { atomicAdd(&bar[XB_TMO], 1u); break; } }
    }
    nloc = mine > 0u ? mine : 1u; nx = cnt > 0u ? cnt : 1u;
}
__device__ __forceinline__ void xcd_barrier(const XcdBarrier& b) {
    asm volatile("s_waitcnt vmcnt(0)" ::: "memory");
    __syncthreads();
    if (threadIdx.x == 0) {
        unsigned* bar = b.bar; const unsigned bx = xb_xcc_id();
        __builtin_amdgcn_s_waitcnt(0);
        unsigned nloc = b.st[0], nx = b.st[1];
        if (nloc == 0u) { xcd_barrier_complete(bar, bx, nloc, nx); b.st[0] = nloc; b.st[1] = nx; }
        const unsigned old = xb_add(&bar[XB_XSUB(bx)], 1u);
        const unsigned gen = old / nloc;
        if (old + 1u == (gen + 1u) * nloc) {
            __builtin_amdgcn_fence(__ATOMIC_RELEASE, "agent");
            asm volatile("s_waitcnt vmcnt(0)" ::: "memory");
            const unsigned og = xb_add(&bar[XB_TOP], 1u);
            const unsigned tg = og / nx;
            if (og + 1u == (tg + 1u) * nx) xb_add(&bar[XB_TOPGEN], 1u);
            else XB_SPIN(xb_ld(&bar[XB_TOPGEN]) == tg, bar);
            __builtin_amdgcn_fence(__ATOMIC_ACQUIRE, "agent");
            xb_add(&bar[XB_XGEN(bx)], 1u);
            asm volatile("s_waitcnt vmcnt(0)" ::: "memory");
        } else {
            XB_SPIN(xb_ld(&bar[XB_XGEN(bx)]) == gen, bar);
            __builtin_amdgcn_fence(__ATOMIC_ACQUIRE, "agent");
            asm volatile("s_waitcnt vmcnt(0)" ::: "memory");
        }
    }
    __syncthreads();
}

namespace pg8 {
constexpr int BM = 256, BK = 64, HALF = 128, HTB = HALF * BK * 2, STAGE_BYTES = 8 * HTB;
__device__ __forceinline__ int lds_byte(int r, int c) { const int st = (r >> 4) * 2 + (c >> 5), rr = r & 15, cc = c & 31, ob = rr * 64 + cc * 2; return st * 1024 + (ob ^ (((ob >> 9) & 1) << 5)); }
__device__ __forceinline__ void stage_rc(int b, int& R, int& C) { const int st = b / 1024, sb = b % 1024, swz = sb ^ (((sb >> 9) & 1) << 5); R = (st >> 1) * 16 + swz / 64; C = (st & 1) * 32 + (swz % 64) / 2; }
__device__ __forceinline__ int perm32(int rho) { const int n = rho >> 4, i = rho & 15; return 8 * (i >> 2) + 4 * n + (i & 3); }

struct Unit {
    int pm, pn;
    int e, pos0, cnt;
    int kind;
    int half;
    const char* A; const char* B;
    const int* rows;
};

typedef short s16x4 __attribute__((ext_vector_type(4)));
template <class Epi, class Sched, int AMODE>
__device__ __forceinline__ void gemm_phase(LAS unsigned char* lds, const int K, const Sched& S, const Epi& E, const int ldat = 0) {
    constexpr bool GATHER = AMODE == 1, ATR = AMODE == 2;
    const int tid = tid_fresh(), wid = __builtin_amdgcn_readfirstlane(tid >> 6), lane = tid & 63, wr = wid >> 2, wc = wid & 3, fr = lane & 15, fq = lane >> 4;
    const int nt = K / BK;
    unsigned voffA[2], voffB[2]; int RA[2], CA[2];
#pragma unroll
    for (int i = 0; i < 2; ++i) { int R, C; stage_rc(tid * 16 + i * 8192, R, C); const int Rb = Epi::PERM ? ((R & ~31) + perm32(R & 31)) : R;
        voffA[i] = (unsigned)(R * K + C) * 2u; voffB[i] = (unsigned)(Rb * K + C) * 2u; RA[i] = R; CA[i] = C;
        if constexpr (ATR) { const int bb = tid * 16 + i * 8192, row = bb >> 8, pc = (bb >> 4) & 15, ch = pc ^ (((row & 3) << 2) | ((row >> 2) & 3)); voffA[i] = (unsigned)(row * ldat + 8 * ch) * 2u; } }
    const size_t kstep = (size_t)(BK * 2);
    const size_t hstep = (size_t)HALF * K * 2;
    const size_t kstepA = ATR ? (size_t)BK * ldat * 2 : kstep, hstepA = ATR ? (size_t)HALF * 2 : hstep;
    const unsigned ldsw = (unsigned)wid * 1024u;
    const int aoff = lds_byte(wr * 64 + fr, fq * 8), boff = lds_byte(wc * 32 + fr, fq * 8);
    int atr[4][2];
#pragma unroll
    for (int m = 0; m < 4; ++m)
#pragma unroll
        for (int bl = 0; bl < 2; ++bl) { const int xr = ((fr >> 2) << 2) | ((2 * fq + bl) & 3); atr[m][bl] = (int)(unsigned)(uintptr_t)lds + 256 * (8 * fq + (fr >> 2) + 4 * bl) + 16 * ((wr * 8 + 2 * m + ((fr & 3) >> 1)) ^ xr) + 8 * (fr & 1); }
    unsigned vgC[2][2], vgN[2][2];
#define PG8_ROWS(u, vg) do { if constexpr (GATHER) { _Pragma("unroll") for (int _h = 0; _h < 2; ++_h) _Pragma("unroll") for (int _i = 0; _i < 2; ++_i) { \
        const int _p = (u).pos0 + _h * HALF + RA[_i]; const int _tok = (_p < (u).cnt) ? ((u).rows[_h * HALF + RA[_i]] >> 1) : 0; \
        vg[_h][_i] = ((unsigned)_tok * (unsigned)K + (unsigned)CA[_i]) * 2u; } } } while (0)
#define PG8_SA(b, h) (((b) * 2 + (h)) * HTB)
#define PG8_SB(b, h) ((4 + (b) * 2 + (h)) * HTB)
#define PG8_STAGE_B(bufoff, gbase) do { _Pragma("unroll") for (int _i = 0; _i < 2; ++_i) \
        __builtin_amdgcn_global_load_lds((const unsigned*)((const char*)(gbase) + voffB[_i]), (LAS unsigned*)(lds + (bufoff) + ldsw + _i * 8192), 16, 0, 0); } while (0)
#define PG8_STAGE_A(bufoff, gbase, h, NEXT) do { _Pragma("unroll") for (int _i = 0; _i < 2; ++_i) { \
        const unsigned _vo = GATHER ? ((NEXT) ? vgN[h][_i] : vgC[h][_i]) : voffA[_i]; \
        __builtin_amdgcn_global_load_lds((const unsigned*)((const char*)(gbase) + (GATHER ? (size_t)0 : (size_t)(h) * hstepA) + _vo), (LAS unsigned*)(lds + (bufoff) + ldsw + _i * 8192), 16, 0, 0); } } while (0)
#define PG8_LDA(dst, b, h) do { if constexpr (!ATR) { _Pragma("unroll") for (int m = 0; m < 4; ++m) _Pragma("unroll") for (int k = 0; k < 2; ++k) dst[m][k] = *(const LAS f16x8*)(lds + PG8_SA(b, h) + aoff + m * 2048 + k * 1024); } \
        else { _Pragma("unroll") for (int m = 0; m < 4; ++m) _Pragma("unroll") for (int k = 0; k < 2; ++k) { s16x4 _lo, _hi; \
            asm volatile("ds_read_b64_tr_b16 %0, %1 offset:%2" : "=v"(_lo) : "v"(atr[m][0]), "i"(PG8_SA(b, h) + k * 8192) : "memory"); \
            asm volatile("ds_read_b64_tr_b16 %0, %1 offset:%2" : "=v"(_hi) : "v"(atr[m][1]), "i"(PG8_SA(b, h) + k * 8192) : "memory"); \
            const short __attribute__((ext_vector_type(8))) _v = {_lo[0], _lo[1], _lo[2], _lo[3], _hi[0], _hi[1], _hi[2], _hi[3]}; dst[m][k] = __builtin_bit_cast(f16x8, _v); } } } while (0)
#define PG8_PIN(At) do { if constexpr (ATR) asm volatile("" : "+v"(At[0][0]), "+v"(At[0][1]), "+v"(At[1][0]), "+v"(At[1][1]), "+v"(At[2][0]), "+v"(At[2][1]), "+v"(At[3][0]), "+v"(At[3][1])); } while (0)
#define PG8_LDB(dst, b, h) do { _Pragma("unroll") for (int n = 0; n < 2; ++n) _Pragma("unroll") for (int k = 0; k < 2; ++k) dst[n][k] = *(const LAS f16x8*)(lds + PG8_SB(b, h) + boff + n * 2048 + k * 1024); } while (0)
#define PG8_MMA(ai, bj, At, Bt) do { __builtin_amdgcn_s_setprio(1); _Pragma("unroll") for (int m = 0; m < 4; ++m) _Pragma("unroll") for (int n = 0; n < 2; ++n) _Pragma("unroll") for (int k = 0; k < 2; ++k) \
        acc[ai][bj][m][n] = __builtin_amdgcn_mfma_f32_16x16x32_f16(Bt[n][k], At[m][k], acc[ai][bj][m][n], 0, 0, 0); __builtin_amdgcn_s_setprio(0); } while (0)
#define PG8_WAIT_V(n) asm volatile("s_waitcnt vmcnt(" #n ")" ::: "memory")
#define PG8_WAIT_L(n) asm volatile("s_waitcnt lgkmcnt(" #n ")" ::: "memory")
#define PG8_BAR __builtin_amdgcn_s_barrier()
#define PG8_SCHED __builtin_amdgcn_sched_barrier(0)
    Unit cur, nxt; int ui = 0;
    if (!S.next(0, cur)) return;
    f32x4 acc[2][2][4][2];
#pragma unroll
    for (int a = 0; a < 2; ++a)
#pragma unroll
        for (int b = 0; b < 2; ++b)
#pragma unroll
            for (int m = 0; m < 4; ++m)
#pragma unroll
                for (int n = 0; n < 2; ++n) acc[a][b][m][n] = (f32x4){0.f, 0.f, 0.f, 0.f};
    f16x8 At[4][2], B0[2][2], B1[2][2];
    const char* cA = cur.A; const char* cB = cur.B;
    PG8_ROWS(cur, vgC);
#pragma unroll
    for (int _h = 0; _h < 2; ++_h)
#pragma unroll
        for (int _i = 0; _i < 2; ++_i) vgN[_h][_i] = GATHER ? vgC[_h][_i] : 0u;
    PG8_STAGE_B(PG8_SB(0, 0), cB); PG8_STAGE_B(PG8_SB(0, 1), cB + hstep); PG8_STAGE_A(PG8_SA(0, 0), cA, 0, false); PG8_STAGE_A(PG8_SA(0, 1), cA, 1, false);
    if (wr == 1) PG8_BAR;
    PG8_WAIT_V(2); PG8_BAR;
    PG8_STAGE_B(PG8_SB(1, 0), cB + kstep); PG8_STAGE_A(PG8_SA(1, 0), cA + kstepA, 0, false); PG8_STAGE_B(PG8_SB(1, 1), cB + hstep + kstep);
    PG8_WAIT_V(6); PG8_BAR;
    for (;;) {
        const bool has_next = S.next(ui + 1, nxt);
        const bool full = cur.half == 0;
        const char* nA = has_next ? nxt.A : cA; const char* nB = has_next ? nxt.B : cB;
        if (has_next) { PG8_ROWS(nxt, vgN); }
        typename Epi::Pre pre; E.prefetch(cur, wr, fr, pre);
#pragma unroll 1
        for (int t = 0; t < nt; t += 2) {
            const bool last = (t == nt - 2);
            const char* a1 = cA + (size_t)(t + 1) * kstepA;
            const char* a2 = last ? nA : cA + (size_t)(t + 2) * kstepA; const char* b2 = last ? nB : cB + (size_t)(t + 2) * kstep;
            const char* a3 = a2 + kstepA; const char* b3 = b2 + kstep;
            PG8_LDB(B0, 0, 0); PG8_LDB(B1, 0, 1); PG8_SCHED; PG8_LDA(At, 0, 0); PG8_STAGE_A(PG8_SA(1, 1), a1, 1, false);
            PG8_WAIT_V(8); PG8_WAIT_L(0); PG8_PIN(At); PG8_BAR; PG8_MMA(0, 0, At, B0); PG8_MMA(0, 1, At, B1); PG8_BAR; PG8_SCHED;
            PG8_LDA(At, 0, 1); PG8_STAGE_B(PG8_SB(0, 0), b2); PG8_STAGE_B(PG8_SB(0, 1), b2 + hstep); PG8_STAGE_A(PG8_SA(0, 0), a2, 0, last);
            PG8_WAIT_V(8); PG8_WAIT_L(0); PG8_PIN(At); PG8_BAR; if (full) { PG8_MMA(1, 0, At, B0); PG8_MMA(1, 1, At, B1); } PG8_BAR; PG8_SCHED;
            PG8_LDB(B0, 1, 0); PG8_LDB(B1, 1, 1); PG8_SCHED; PG8_LDA(At, 1, 0); PG8_STAGE_A(PG8_SA(0, 1), a2, 1, last);
            PG8_WAIT_V(8); PG8_WAIT_L(0); PG8_PIN(At); PG8_BAR; PG8_MMA(0, 0, At, B0); PG8_MMA(0, 1, At, B1); PG8_BAR; PG8_SCHED;
            PG8_LDA(At, 1, 1); PG8_STAGE_B(PG8_SB(1, 0), b3); PG8_STAGE_B(PG8_SB(1, 1), b3 + hstep); PG8_STAGE_A(PG8_SA(1, 0), a3, 0, last);
            PG8_WAIT_V(8); PG8_WAIT_L(0); PG8_PIN(At); PG8_BAR; if (full) { PG8_MMA(1, 0, At, B0); PG8_MMA(1, 1, At, B1); } PG8_BAR; PG8_SCHED;
        }
        if (wr == 0) PG8_BAR;
        E(acc, cur, wr, wc, fr, fq, pre);
        if (!has_next) break;
#pragma unroll
        for (int a = 0; a < 2; ++a)
#pragma unroll
            for (int b = 0; b < 2; ++b)
#pragma unroll
                for (int m = 0; m < 4; ++m)
#pragma unroll
                    for (int n = 0; n < 2; ++n) acc[a][b][m][n] = (f32x4){0.f, 0.f, 0.f, 0.f};
        cur = nxt; cA = nA; cB = nB; ++ui;
#pragma unroll
        for (int _h = 0; _h < 2; ++_h)
#pragma unroll
            for (int _i = 0; _i < 2; ++_i) vgC[_h][_i] = vgN[_h][_i];
        if (wr == 1) PG8_BAR;
    }
    PG8_WAIT_V(0);
    PG8_BAR;
#undef PG8_ROWS
#undef PG8_SA
#undef PG8_SB
#undef PG8_STAGE_A
#undef PG8_STAGE_B
#undef PG8_LDA
#undef PG8_LDB
#undef PG8_PIN
#undef PG8_MMA
#undef PG8_WAIT_V
#undef PG8_WAIT_L
#undef PG8_BAR
#undef PG8_SCHED
}
}

using pg8::Unit;
__device__ __forceinline__ f16x8 pack8(const f32x4 a, const f32x4 b) {
    f16x8 w; w[0] = (h16)a[0]; w[1] = (h16)a[1]; w[2] = (h16)a[2]; w[3] = (h16)a[3]; w[4] = (h16)b[0]; w[5] = (h16)b[1]; w[6] = (h16)b[2]; w[7] = (h16)b[3]; return w;
}
struct EpiH16 {
    static constexpr bool PERM = true;
    h16* O0; int ld0; h16* O1; int ld1;
    struct Pre {}; __device__ __forceinline__ void prefetch(const Unit&, int, int, Pre&) const {}
    __device__ __forceinline__ void operator()(const f32x4 (&acc)[2][2][4][2], const Unit& u, int wr, int wc, int fr, int fq, const Pre&) const {
        h16* base = u.kind ? O1 : O0; const int ld = u.kind ? ld1 : ld0;
        const int row0 = u.pm * 256 + wr * 64 + fr, col0 = u.pn * 256 + wc * 32 + 8 * fq;
#pragma unroll
        for (int ai = 0; ai < 2; ++ai)
#pragma unroll
            for (int m = 0; m < 4; ++m) { h16* rowp = base + (size_t)(row0 + ai * 128 + m * 16) * ld + col0;
#pragma unroll
                for (int bj = 0; bj < 2; ++bj) __builtin_nontemporal_store(pack8(acc[ai][bj][m][0], acc[ai][bj][m][1]), (f16x8*)(rowp + bj * 128)); }
    }
};
struct EpiTaps {
    static constexpr bool PERM = false;
    float* T0; float* T1;
    struct Pre {}; __device__ __forceinline__ void prefetch(const Unit&, int, int, Pre&) const {}
    __device__ __forceinline__ void operator()(const f32x4 (&acc)[2][2][4][2], const Unit& u, int wr, int wc, int fr, int fq, const Pre&) const {
        const int j = u.kind >> 1, v = u.kind & 1; const int ld = v ? 256 : 4096;
        float* base = v ? (T1 + (size_t)j * 8192 * 256) : (T0 + (size_t)j * 8192 * 4096);
        const int row0 = u.pm * 256 + wr * 64 + fr, col0 = u.pn * 256 + wc * 32 + 4 * fq;
#pragma unroll
        for (int ai = 0; ai < 2; ++ai)
#pragma unroll
            for (int m = 0; m < 4; ++m) { float* rowp = base + (size_t)(row0 + ai * 128 + m * 16) * ld + col0;
#pragma unroll
                for (int bj = 0; bj < 2; ++bj)
#pragma unroll
                    for (int n = 0; n < 2; ++n) *(f32x4*)(rowp + bj * 128 + n * 16) = acc[ai][bj][m][n]; }
    }
};
struct EpiResid {
    static constexpr bool PERM = true;
    h16* X; const float* mods; int layer; float* SSQ; h16* XO;
    struct Pre {}; __device__ __forceinline__ void prefetch(const Unit&, int, int, Pre&) const {}
    __device__ __forceinline__ void operator()(const f32x4 (&acc)[2][2][4][2], const Unit& u, int wr, int wc, int fr, int fq, const Pre&) const {
        const int r0 = u.pm * 256; const int b = r0 < TL ? (r0 >> 12) : 8;
        const float* g = mods + ((size_t)(layer * 9 + b) * 6 + 2) * D;
        const int row0 = r0 + wr * 64 + fr, col0 = u.pn * 256 + wc * 32 + 8 * fq;
        f32x4 gv[2][2];
#pragma unroll
        for (int bj = 0; bj < 2; ++bj)
#pragma unroll
            for (int n = 0; n < 2; ++n) gv[bj][n] = *(const f32x4*)(g + col0 + bj * 128 + n * 4);
#pragma unroll
        for (int ai = 0; ai < 2; ++ai)
#pragma unroll
            for (int m = 0; m < 4; ++m) { const int row = row0 + ai * 128 + m * 16; const h16* rowp = X + (size_t)row * D + col0; h16* rowo = XO + (size_t)row * D + col0; float sq = 0.f;
#pragma unroll
                for (int bj = 0; bj < 2; ++bj) { const f16x8 xv = *(const f16x8*)(rowp + bj * 128); f32x4 v0, v1;
#pragma unroll
                    for (int i = 0; i < 4; ++i) { v0[i] = (float)xv[i] + gv[bj][0][i] * acc[ai][bj][m][0][i]; v1[i] = (float)xv[4 + i] + gv[bj][1][i] * acc[ai][bj][m][1][i]; }
                    const f16x8 w = pack8(v0, v1); *(f16x8*)(rowo + bj * 128) = w;
#pragma unroll
                    for (int i = 0; i < 8; ++i) { const float t = (float)w[i]; sq += t * t; } }
                sq += shx(sq, 16); sq += shx(sq, 32);
                if (fq == 0) SSQ[(size_t)row * 32 + u.pn * 4 + wc] = sq; }
    }
};
struct EpiMoe1 {
    static constexpr bool PERM = true;
    h16* H1;
    struct Pre {}; __device__ __forceinline__ void prefetch(const Unit&, int, int, Pre&) const {}
    __device__ __forceinline__ void operator()(const f32x4 (&acc)[2][2][4][2], const Unit& u, int wr, int wc, int fr, int fq, const Pre&) const {
        const int row0 = u.pm * 256 + wr * 64 + fr, col0 = u.pn * 128 + wc * 16 + 4 * fq;
#pragma unroll
        for (int ai = 0; ai < 2; ++ai)
#pragma unroll
            for (int m = 0; m < 4; ++m) { if (ai == 1 && u.half) continue; h16* rowp = H1 + (size_t)(row0 + ai * 128 + m * 16) * DE + col0;
#pragma unroll
                for (int bj = 0; bj < 2; ++bj) { const f32x4 a = acc[ai][bj][m][0], b = acc[ai][bj][m][1]; f16x4 w;
#pragma unroll
                    for (int i = 0; i < 4; ++i) { const float s = a[i] / (1.0f + __expf(-a[i])); w[i] = (h16)(s * b[i]); }
                    *(f16x4*)(rowp + bj * 64) = w; } }
    }
};
struct EpiMoe2 {
    static constexpr bool PERM = true;
    h16* YC; const float* gslot;
    struct Pre { int av[2][4]; float gv[2][4]; };
    __device__ __forceinline__ void prefetch(const Unit& u, int wr, int fr, Pre& q) const {
        const float* grow = gslot + ((const char*)u.rows - (const char*)listbase) / 4;
#pragma unroll
        for (int ai = 0; ai < 2; ++ai)
#pragma unroll
            for (int m = 0; m < 4; ++m) { const int r = ai * 128 + wr * 64 + m * 16 + fr; const bool ok = u.pos0 + r < u.cnt; q.av[ai][m] = ok ? u.rows[r] : -1; q.gv[ai][m] = ok ? grow[r] : 0.f; }
    }
    __device__ __forceinline__ void operator()(const f32x4 (&acc)[2][2][4][2], const Unit& u, int wr, int wc, int fr, int fq, const Pre& q) const {
        const int col0 = u.pn * 256 + wc * 32 + 8 * fq;
#pragma unroll
        for (int ai = 0; ai < 2; ++ai)
#pragma unroll
            for (int m = 0; m < 4; ++m) { if (q.av[ai][m] >= 0) { const float g = q.gv[ai][m]; h16* rowp = YC + (size_t)q.av[ai][m] * D + col0;
#pragma unroll
                    for (int bj = 0; bj < 2; ++bj) *(f16x8*)(rowp + bj * 128) = pack8(acc[ai][bj][m][0] * g, acc[ai][bj][m][1] * g); } }
    }
    const int* listbase;
};

__device__ __forceinline__ void order_tile(int wgid, int nM, int nN, int& pm, int& pn) {
    const int nwg = nM * nN; { const int q = nwg / 8, r = nwg % 8, xcd = wgid % 8, off = wgid / 8; wgid = (xcd < r ? xcd * (q + 1) : r * (q + 1) + (xcd - r) * q) + off; }
    const int nig = 8 * nN, gid = wgid / nig, fm = gid * 8, gsz = (nM - fm) < 8 ? (nM - fm) : 8;
    pm = fm + ((wgid % nig) % gsz); pn = (wgid % nig) / gsz;
}
struct SchedPlain {
    int nM, nN, K; const char* A; const char* B;
    __device__ __forceinline__ bool next(int i, Unit& u) const {
        const long L = (long)i * gridDim.x + blockIdx.x; if (L >= (long)nM * nN) return false;
        order_tile((int)L, nM, nN, u.pm, u.pn); u.kind = 0; u.half = 0; u.e = 0; u.pos0 = 0; u.cnt = 0; u.rows = nullptr;
        u.A = A + (size_t)u.pm * 256 * K * 2; u.B = B + (size_t)u.pn * 256 * K * 2; return true;
    }
};
struct SchedPlainAT {
    int nM, nN, K; const char* At; const char* B;
    __device__ __forceinline__ bool next(int i, Unit& u) const {
        const long L = (long)i * gridDim.x + blockIdx.x; if (L >= (long)nM * nN) return false;
        order_tile((int)L, nM, nN, u.pm, u.pn); u.kind = 0; u.half = 0; u.e = 0; u.pos0 = 0; u.cnt = 0; u.rows = nullptr;
        u.A = At + (size_t)u.pm * 256 * 2; u.B = B + (size_t)u.pn * 256 * K * 2; return true;
    }
};
struct SchedQkv {
    const char* H; const char* W;
    __device__ __forceinline__ bool next(int i, Unit& u) const {
        const long L = (long)i * gridDim.x + blockIdx.x; const int nA = 136 * 9; if (L >= nA + 136) return false;
        u.e = 0; u.half = 0; u.pos0 = 0; u.cnt = 0; u.rows = nullptr;
        if (L < nA) { order_tile((int)L, 136, 9, u.pm, u.pn); u.kind = 0; u.A = H + (size_t)u.pm * 256 * D * 2; u.B = W + (size_t)u.pn * 256 * D * 2; }
        else { u.pm = 0; u.pn = (int)L - nA; u.kind = 1; u.A = W + (size_t)DQK * D * 2; u.B = H + (size_t)u.pn * 256 * D * 2; }
        return true;
    }
};
struct SchedFilt {
    const char* W3P; const char* H2P;
    __device__ __forceinline__ bool next(int i, Unit& u) const {
        const long L = (long)i * gridDim.x + blockIdx.x; if (L >= 2 * 544) return false;
        const int j = (int)L / 544, r = (int)L % 544; u.e = 0; u.half = 0; u.pos0 = 0; u.cnt = 0; u.rows = nullptr;
        int v; if (r < 512) { v = 0; u.pm = r >> 4; u.pn = r & 15; } else { v = 1; u.pm = r - 512; u.pn = 0; }
        u.kind = 2 * j + v;
        u.A = W3P + ((size_t)j * 8192 + (size_t)u.pm * 256) * 256 * 2;
        u.B = H2P + ((size_t)j * 4352 + (v ? 4096 : 0) + (size_t)u.pn * 256) * 256 * 2;
        return true;
    }
};
struct MoeTab { const LAS int* tstart; const LAS int* texp; const LAS int* cnt; };
struct SchedMoe1 {
    MoeTab tb; const char* H; const char* W13; const int* list;
    __device__ __forceinline__ bool next(int i, Unit& u) const {
        const long L = (long)i * gridDim.x + blockIdx.x; const int ntile = __builtin_amdgcn_readfirstlane(tb.tstart[NE]); if (L >= (long)ntile * 3) return false;
        int rt; order_tile((int)L, ntile, 3, rt, u.pn); u.pm = rt; u.kind = 0;
        const int e = __builtin_amdgcn_readfirstlane(tb.texp[rt]); u.e = e; u.pos0 = (rt - __builtin_amdgcn_readfirstlane(tb.tstart[e])) * 256; u.cnt = __builtin_amdgcn_readfirstlane(tb.cnt[e]); u.half = (u.cnt - u.pos0 <= 128) ? 1 : 0;
        u.rows = list + (size_t)e * LCAP + u.pos0; u.A = H; u.B = W13 + ((size_t)e * DE2 + (size_t)u.pn * 256) * D * 2; return true;
    }
};
struct SchedMoe2 {
    MoeTab tb; const char* H1; const char* W2; const int* list;
    __device__ __forceinline__ bool next(int i, Unit& u) const {
        const long L = (long)i * gridDim.x + blockIdx.x; const int ntile = __builtin_amdgcn_readfirstlane(tb.tstart[NE]); if (L >= (long)ntile * 8) return false;
        int rt; order_tile((int)L, ntile, 8, rt, u.pn); u.pm = rt; u.kind = 0;
        const int e = __builtin_amdgcn_readfirstlane(tb.texp[rt]); u.e = e; u.pos0 = (rt - __builtin_amdgcn_readfirstlane(tb.tstart[e])) * 256; u.cnt = __builtin_amdgcn_readfirstlane(tb.cnt[e]); u.half = (u.cnt - u.pos0 <= 128) ? 1 : 0;
        u.rows = list + (size_t)e * LCAP + u.pos0; u.A = H1 + (size_t)rt * 256 * DE * 2; u.B = W2 + ((size_t)e * D + (size_t)u.pn * 256) * DE * 2; return true;
    }
};
__device__ __forceinline__ void moe_table(LAS int* tstart, LAS int* texp, LAS int* cnt, const int* counters) {
    const int t = tid_fresh();
    if (t < NE) cnt[t] = counters[t];
    __syncthreads();
    if (t <= NE) { int s = 0; for (int e = 0; e < t; ++e) s += (cnt[e] + 255) >> 8; tstart[t] = s; }
    __syncthreads();
    if (t < NE) { const int s0 = tstart[t], s1 = tstart[t + 1]; for (int q = s0; q < s1; ++q) texp[q] = t; }
    __syncthreads();
}

__device__ __forceinline__ float wave_sum(float v) {
#pragma unroll
    for (int o = 32; o >= 1; o >>= 1) v += shx(v, o);
    return v;
}
__device__ __forceinline__ float silu_f(float x) { return x / (1.0f + expf(-x)); }
__device__ __forceinline__ int batch_of_row(int r) { return r < TL ? (r >> 12) : 8; }

__device__ __forceinline__ void modp_unit(const Params& p, int unit, LAS float* sl) {
    const int layer = unit / 96, rem = unit % 96, ks = rem / 6, cc = rem % 6, tid = tid_fresh();
    for (int i = tid; i < 9 * 128; i += 512) { const int cnd = i >> 7, k = ks * 128 + (i & 127); const float v = cnd < 8 ? p.c[cnd * D + k] : p.c_ctx[k]; sl[i] = silu_f(v); }
    __syncthreads();
    f32x4 acc[9];
#pragma unroll
    for (int q = 0; q < 9; ++q) acc[q] = (f32x4){0.f, 0.f, 0.f, 0.f};
    const float* w = p.mod_w + ((size_t)layer * D + (size_t)ks * 128) * D6 + cc * 2048 + tid * 4;
#pragma unroll 4
    for (int k = 0; k < 128; ++k) { const f32x4 wv = *(const f32x4*)(w + (size_t)k * D6);
#pragma unroll
        for (int q = 0; q < 9; ++q) acc[q] += wv * sl[q * 128 + k]; }
    float* outp = (float*)(p.ws + WS_MODP) + ((size_t)(ks * 4 + layer) * 9) * D6 + cc * 2048 + tid * 4;
#pragma unroll
    for (int q = 0; q < 9; ++q) *(f32x4*)(outp + (size_t)q * D6) = acc[q];
    __syncthreads();
}
__device__ __forceinline__ void modr_unit(const Params& p, int unit) {
    const size_t idx = (size_t)unit * 2048 + tid_fresh() * 4; const int layer = (int)(idx / (9 * D6)), col = (int)(idx % D6);
    f32x4 s = *(const f32x4*)(p.mod_b + (size_t)layer * D6 + col);
    const float* pp = (const float*)(p.ws + WS_MODP) + idx;
#pragma unroll
    for (int ks = 0; ks < 16; ++ks) s += *(const f32x4*)(pp + (size_t)ks * 4 * 9 * D6);
    *(f32x4*)((float*)(p.ws + WS_MODS) + idx) = s;
}
__device__ __forceinline__ void tables_unit(const Params& p) {
    f32x2* tw = (f32x2*)(p.ws + WS_TW);
    for (int m = tid_fresh(); m < 8192; m += 512) { double s, c; sincospi(-(double)m / 4096.0, &s, &c); tw[m] = (f32x2){(float)c, (float)s}; }
    float* rc = (float*)(p.ws + WS_ROPE);
    for (int i = tid_fresh(); i < 1024; i += 512) { const int pos = i >> 4, q = i & 15; const float inv = powf(10000.0f, -(float)q / 16.0f); const float ang = (float)pos * inv;
        rc[i] = cosf(ang); rc[1024 + i] = sinf(ang); }
}
__device__ __forceinline__ void h2_task(const Params& p, int task) {
    const int lane = tid_fresh() & 63; const int j = task / 4352, r = task % 4352; const int v = r >= 4096, t = v ? r - 4096 : r; const int Lv = v ? 256 : 4096;
    const float tl = (float)t / (float)(Lv - 1);
    const float omega = (float)(2.0 * 3.14159265358979323846 / (double)Lv) * (float)t;
    float feat = 0.f;
    if (lane == 0) feat = tl;
    else if (lane <= 32) { const int bi = (lane - 1) & 15; const float band = 1e-4f + (float)bi * ((15.0f - 1e-4f) / 15.0f); const float a = band * omega; feat = lane <= 16 ? cosf(a) : -sinf(a); }
    const float* w1 = p.hy_f_w1 + (size_t)j * 33 * 64; const float* w2 = p.hy_f_w2 + (size_t)j * 64 * 64;
    float s = p.hy_f_b1[j * 64 + lane];
    for (int f = 0; f < 33; ++f) s += bperm_f(feat, f) * w1[f * 64 + lane];
    const float h1 = sinf(p.hy_f_freq1[j * 64 + lane] * s);
    float s2 = p.hy_f_b2[j * 64 + lane];
    for (int m = 0; m < 64; ++m) s2 += bperm_f(h1, m) * w2[m * 64 + lane];
    const float h2 = sinf(p.hy_f_freq2[j * 64 + lane] * s2);
    const h16 hi = (h16)h2; const h16 lo = (h16)(h2 - (float)hi);
    h16* row = (h16*)(p.ws + WS_H2P) + ((size_t)j * 4352 + r) * 256;
    row[lane] = hi; row[64 + lane] = hi; row[128 + lane] = lo; row[192 + lane] = lo;
}
__device__ __forceinline__ void w3p_unit(const Params& p, int unit) {
    const int j = unit >> 5, c0 = (unit & 31) * 256; const float* w3 = p.hy_f_w3 + (size_t)j * 64 * 8192; h16* dst = (h16*)(p.ws + WS_W3P) + (size_t)j * 8192 * 256;
    for (int i = tid_fresh(); i < 64 * 256; i += 512) { const int m = i >> 8, col = c0 + (i & 255); const float w = w3[(size_t)m * 8192 + col];
        const h16 hi = (h16)w; const h16 lo = (h16)(w - (float)hi); h16* row = dst + (size_t)col * 256; row[m] = hi; row[64 + m] = lo; row[128 + m] = hi; row[192 + m] = lo; }
}
__device__ __forceinline__ void rtab_unit(const Params& p, int unit) {
    const int layer = unit >> 6, c = unit & 63; h16* dst = (h16*)(p.ws + WS_RTAB + (size_t)layer * RTAB_L) + (size_t)c * 5 * 2 * 64 * 8;
    for (int i = tid_fresh(); i < 5 * 2 * 64 * 8; i += 512) { const int jj = i & 7, lane = (i >> 3) & 63, hl = (i >> 9) & 1, ct = i >> 10;
        const int k = 32 * c + 8 * (lane >> 4) + jj, col = 16 * ct + (lane & 15);
        float w = 0.f; if (col < 8) w = p.moe_wg[((size_t)layer * D + k) * 8 + col]; else if (col < 72) w = p.moe_we[((size_t)layer * D + k) * 64 + (col - 8)];
        w *= 256.0f; const h16 hi = (h16)w; const h16 lo = (h16)(w - (float)hi); dst[i] = hl ? lo : hi; }
}
template <int NW>
__device__ __forceinline__ void cvt_tile(const float* src, int ldn, int k0, int n0, h16* dst, int ldk, int mode, LAS float* T) {
    constexpr int P = NW + 1; const int tid = tid_fresh();
#pragma unroll
    for (int ps = 0; ps < 64 * NW / 4 / 512; ++ps) { const int idx = ps * 512 + tid, k = idx / (NW / 4), n4 = idx % (NW / 4);
        const f32x4 v = *(const f32x4*)(src + (size_t)(k0 + k) * ldn + n0 + 4 * n4); LAS float* q = T + k * P + 4 * n4; q[0] = v[0]; q[1] = v[1]; q[2] = v[2]; q[3] = v[3]; }
    __syncthreads();
#pragma unroll
    for (int ps = 0; ps < NW * 8 / 512; ++ps) { const int item = ps * 512 + tid, kc = item & 7, n = item >> 3; f16x8 w;
#pragma unroll
        for (int i = 0; i < 8; ++i) w[i] = (h16)T[(8 * kc + i) * P + n];
        const int ng = n0 + n; const int row = mode == 0 ? ng : (8 * (ng >> 2) + (ng & 3) + (mode == 2 ? 4 : 0));
        *(f16x8*)(dst + (size_t)row * ldk + k0 + 8 * kc) = w; }
    __syncthreads();
}
__device__ __forceinline__ void cvt_dense_unit(const Params& p, int unit, LAS float* T) {
    const float* src; h16* dst; int nt, N;
    if (unit < 1536) { src = p.hy_w_in; dst = (h16*)(p.ws + WS_WIN); nt = 24; N = D3; }
    else if (unit < 2048) { unit -= 1536; src = p.hy_w_out; dst = (h16*)(p.ws + WS_WOUT); nt = 8; N = D; }
    else if (unit < 2688) { unit -= 2048; src = p.at_w_qkv; dst = (h16*)(p.ws + WS_WQKV); nt = 10; N = DQKV; }
    else { unit -= 2688; src = p.at_w_o; dst = (h16*)(p.ws + WS_WO); nt = 8; N = D; }
    const int j = unit / (32 * nt), r = unit % (32 * nt), kt = r / nt, ntile = r % nt;
    cvt_tile<256>(src + (size_t)j * D * N, N, kt * 64, ntile * 256, dst + (size_t)j * N * D, D, 0, T);
}
constexpr int CVT_DENSE_UNITS = 3200;
__device__ __forceinline__ void cvt_moe_unit(const Params& p, int layer, int unit, LAS float* T) {
    if (unit < 12288) { const int which = unit >= 6144; if (which) unit -= 6144; const int e = unit / 96, r = unit % 96, kt = r / 3, ntile = r % 3;
        const float* src = (which ? p.moe_w3 : p.moe_w1) + ((size_t)layer * NE + e) * D * DE;
        cvt_tile<128>(src, DE, kt * 64, ntile * 128, (h16*)(p.ws + WS_W13) + (size_t)e * DE2 * D, D, which ? 2 : 1, T); }
    else { unit -= 12288; const int e = unit / 48, r = unit % 48, kt = r / 8, ntile = r % 8;
        const float* src = p.moe_w2 + ((size_t)layer * NE + e) * DE * D;
        cvt_tile<256>(src, D, kt * 64, ntile * 256, (h16*)(p.ws + WS_W2) + (size_t)e * D * DE, DE, 0, T); }
}
constexpr int CVT_MOE_UNITS = 15360;
struct CvtD { const float* src; h16* dst; int mode; };
__device__ __forceinline__ CvtD cvt13_desc(const Params& p, int layer, int unit) {
    const int which = unit >= 6144; if (which) unit -= 6144; const int e = unit / 96, r = unit % 96, kt = r / 3, ntile = r % 3;
    CvtD d; d.src = (which ? p.moe_w3 : p.moe_w1) + ((size_t)layer * NE + e) * D * DE + (size_t)(kt * 64) * DE + ntile * 128;
    d.dst = (h16*)(p.ws + WS_W13) + (size_t)e * DE2 * D + kt * 64; d.mode = (which ? 4 : 0) + 8 * (256 * ntile); return d;
}
__device__ __forceinline__ void cvt13_load(const CvtD& d, f32x4 (&v)[4], int tid) {
#pragma unroll
    for (int ps = 0; ps < 4; ++ps) { const int idx = ps * 512 + tid, k = idx >> 5, n4 = idx & 31; v[ps] = *(const f32x4*)(d.src + (size_t)k * DE + 4 * n4); }
}
__device__ __forceinline__ void cvt13_store(const CvtD& d, const f32x4 (&v)[4], LAS float* T, int tid) {
    constexpr int P = 129;
#pragma unroll
    for (int ps = 0; ps < 4; ++ps) { const int idx = ps * 512 + tid, k = idx >> 5, n4 = idx & 31; LAS float* q = T + k * P + 4 * n4; q[0] = v[ps][0]; q[1] = v[ps][1]; q[2] = v[ps][2]; q[3] = v[ps][3]; }
    __syncthreads();
    const int w3off = d.mode & 7, rg0 = d.mode >> 3;
#pragma unroll
    for (int ps = 0; ps < 2; ++ps) { const int item = ps * 512 + tid, kc = item & 7, n = item >> 3; f16x8 w;
#pragma unroll
        for (int i = 0; i < 8; ++i) w[i] = (h16)T[(8 * kc + i) * P + n];
        const int row = rg0 + 8 * (n >> 2) + (n & 3) + w3off;
        *(f16x8*)(d.dst + (size_t)row * D + 8 * kc) = w; }
    __syncthreads();
}
__device__ __forceinline__ void cvt_moe_share(const Params& p, int layer, int u0, int n, int stride, LAS float* T) {
    const int tid = tid_fresh(); const int n13 = n < 12288 ? n : 12288;
    int u = u0;
    if (u < n13) {
        CvtD dA = cvt13_desc(p, layer, u), dB = dA, dC = dA; f32x4 vA[4], vB[4], vC[4];
        cvt13_load(dA, vA, tid);
        if (u + stride < n13) { dB = cvt13_desc(p, layer, u + stride); cvt13_load(dB, vB, tid); }
        for (;;) {
            if (u + 2 * stride < n13) { dC = cvt13_desc(p, layer, u + 2 * stride); cvt13_load(dC, vC, tid); }
            cvt13_store(dA, vA, T, tid); u += stride; if (u >= n13) break;
            if (u + 2 * stride < n13) { dA = cvt13_desc(p, layer, u + 2 * stride); cvt13_load(dA, vA, tid); }
            cvt13_store(dB, vB, T, tid); u += stride; if (u >= n13) break;
            if (u + 2 * stride < n13) { dB = cvt13_desc(p, layer, u + 2 * stride); cvt13_load(dB, vB, tid); }
            cvt13_store(dC, vC, T, tid); u += stride; if (u >= n13) break;
        }
    }
    for (; u < n; u += stride) cvt_moe_unit(p, layer, u, T);
}

template <int NR, bool FINAL>
__device__ __forceinline__ void n1_rows(const Params& p, int layer, int r0, int rstride, int lane, h16* xout) {
    const h16* xres = (const h16*)(p.ws + WS_XRES); h16* hb = (h16*)(p.ws + WS_HBUF); const h16* yc = (const h16*)(p.ws + WS_YC); const float* mods = (const float*)(p.ws + WS_MODS);
    f32x4 v[NR][8]; f16x4 xh[NR][8], ya[NR][8], yb[NR][8];
    const bool comb = FINAL || layer > 0; const int lprev = FINAL ? 3 : layer - 1;
#pragma unroll
    for (int q = 0; q < NR; ++q) { const int r = r0 + q * rstride;
        if (!comb) { const float* src = r < TL ? p.x + (size_t)r * D : p.ctx + (size_t)(r - TL) * D;
#pragma unroll
            for (int c = 0; c < 8; ++c) v[q][c] = *(const f32x4*)(src + c * 256 + lane * 4); }
        else { const h16* src = xres + (size_t)r * D; const h16* y0 = yc + (size_t)(2 * r) * D; const h16* y1 = y0 + D;
#pragma unroll
            for (int c = 0; c < 8; ++c) { xh[q][c] = *(const f16x4*)(src + c * 256 + lane * 4); ya[q][c] = *(const f16x4*)(y0 + c * 256 + lane * 4); yb[q][c] = *(const f16x4*)(y1 + c * 256 + lane * 4); } } }
#pragma unroll
    for (int q = 0; q < NR; ++q) { const int r = r0 + q * rstride; const int b = batch_of_row(r);
        if (comb) { const float* g2 = mods + ((size_t)(lprev * 9 + b) * 6 + 5) * D;
#pragma unroll
            for (int c = 0; c < 8; ++c) { const f32x4 g = *(const f32x4*)(g2 + c * 256 + lane * 4);
#pragma unroll
                for (int i = 0; i < 4; ++i) v[q][c][i] = (float)xh[q][c][i] + g[i] * ((float)ya[q][c][i] + (float)yb[q][c][i]); } }
        float ss = 0.f;
#pragma unroll
        for (int c = 0; c < 8; ++c) { if (!FINAL) { f16x4 w; w[0] = (h16)v[q][c][0]; w[1] = (h16)v[q][c][1]; w[2] = (h16)v[q][c][2]; w[3] = (h16)v[q][c][3]; *(f16x4*)(xout + (size_t)r * D + c * 256 + lane * 4) = w; } ss += v[q][c][0] * v[q][c][0] + v[q][c][1] * v[q][c][1] + v[q][c][2] * v[q][c][2] + v[q][c][3] * v[q][c][3]; }
        ss = wave_sum(ss); const float rs = 1.0f / sqrtf(ss * (1.0f / D) + EPS);
        if (FINAL) {
#pragma unroll
            for (int c = 0; c < 8; ++c) { const int col = c * 256 + lane * 4; const f32x4 g = *(const f32x4*)(p.final_gain + col); *(f32x4*)(p.out + (size_t)r * D + col) = v[q][c] * rs * g; }
        } else {
            const float* sh = mods + ((size_t)(layer * 9 + b) * 6 + 0) * D; const float* sc = sh + D;
#pragma unroll
            for (int c = 0; c < 8; ++c) { const int col = c * 256 + lane * 4; const f32x4 s0 = *(const f32x4*)(sh + col), s1 = *(const f32x4*)(sc + col); f16x4 w;
#pragma unroll
                for (int i = 0; i < 4; ++i) w[i] = (h16)(v[q][c][i] * rs * (1.0f + s1[i]) + s0[i]);
                *(f16x4*)(hb + (size_t)r * D + col) = w; }
        } }
}
template <bool FINAL>
__device__ __forceinline__ void n1_any(const Params& p, int layer, h16* xout) {
    const int tid = tid_fresh(), lane = tid & 63, gw = blockIdx.x * 8 + __builtin_amdgcn_readfirstlane(tid >> 6), nw = gridDim.x * 8; const int nrow = FINAL ? TL : TT;
    int r = gw;
    for (; r + nw < nrow; r += 2 * nw) n1_rows<2, FINAL>(p, layer, r, nw, lane, xout);
    if (r < nrow) n1_rows<1, FINAL>(p, layer, r, nw, lane, xout);
}
__device__ __forceinline__ void n1_phase(const Params& p, int layer, h16* xout) { n1_any<false>(p, layer, xout); }
__device__ __forceinline__ void final_phase(const Params& p) { n1_any<true>(p, 0, nullptr); }
constexpr int N2_CH = 4;
constexpr int N2_SLOT = N2_CH * 10 * 1024;
constexpr int N2_XT = 2 * N2_SLOT;
constexpr int N2_SC = N2_XT + 8 * 4096;
#ifndef PROBE_N2VAR
#define PROBE_N2VAR 0
#endif
__device__ __forceinline__ void n2_phase(const Params& p, int layer, LAS unsigned char* lds, int ctr_shadow) {
    const bool pv_tail = !(ctr_shadow && (PROBE_N2VAR & 1)), pv_store = !(ctr_shadow && (PROBE_N2VAR & 2)), pv_mma = !(ctr_shadow && (PROBE_N2VAR & 4));
    const int tid = tid_fresh(), lane = tid & 63, wv = __builtin_amdgcn_readfirstlane(tid >> 6), r16 = lane & 15, kg = lane >> 4;
    const int lrow = lane >> 3, lchk = lane & 7;
    const h16* xres = (const h16*)(p.ws + WS_XRES); h16* hb = (h16*)(p.ws + WS_HBUF); const float* mods = (const float*)(p.ws + WS_MODS);
    const char* rtb = p.ws + WS_RTAB + (size_t)layer * RTAB_L; const float* ssq = (const float*)(p.ws + WS_SSQ);
    int* counters = (int*)(p.ws + WS_CTL) + CTL_CNT + (layer + (ctr_shadow ? 4 : 0)) * NE; int* list = (int*)(p.ws + WS_LIST); float* gate = (float*)(p.ws + WS_GATE);
    LAS float* scr = (LAS float*)lds + wv * (16 * 80);
    LAS float* scl = (LAS float*)(lds + N2_SC); LAS float* shl = scl + D;
    LAS int* hist = (LAS int*)(lds + LDS_MISC); LAS int* hbase = hist + NE;
    LAS unsigned char* xt = lds + N2_XT + wv * 4096;
    const int hw_off0 = r16 * 128 + 16 * (kg ^ (r16 & 7)), hw_off1 = r16 * 128 + 16 * ((4 + kg) ^ (r16 & 7));
    const int hr_off = lrow * 128 + 16 * (lchk ^ (lrow & 7));
    const int ntask = (layer == NLAYER - 1 ? TL : TT) / 16, nfull = (int)gridDim.x * 8;
#pragma unroll 1
    for (int round = 0; round < 2; ++round) {
        const int nrem = ntask - nfull;
        if (round == 1 && (int)blockIdx.x >= nrem) break;
        const int task = round == 0 ? (int)blockIdx.x * 8 + wv : nfull + (int)blockIdx.x;
        const bool active = round == 0 ? (task < ntask) : true;
        const int trow = active ? task * 16 : 0;
        const int b = batch_of_row(trow);
        const h16* xg = xres + (size_t)(trow + r16) * D + 8 * kg;
        h16* hg0 = hb + (size_t)(trow + lrow) * D + lchk * 8; h16* hg1 = hg0 + (size_t)8 * D;
        float rs;
        { const float* sp = ssq + (size_t)(trow + r16) * 32; float t = 0.f;
#pragma unroll
            for (int q = 0; q < 8; ++q) { const f32x4 v = *(const f32x4*)(sp + 4 * q); t += (v[0] + v[1]) + (v[2] + v[3]); }
            rs = 1.0f / sqrtf(t * (1.0f / D) + EPS); }
        f32x4 acc[5];
#pragma unroll
        for (int ct = 0; ct < 5; ++ct) acc[ct] = (f32x4){0.f, 0.f, 0.f, 0.f};
        __syncthreads();
        if (tid < NE) hist[tid] = 0;
        { const float* scb = mods + ((size_t)(layer * 9 + b) * 6 + 4) * D; *(LAS f32x4*)(scl + tid * 4) = *(const f32x4*)(scb + tid * 4); *(LAS f32x4*)(shl + tid * 4) = *(const f32x4*)(scb - D + tid * 4); }
        if (round == 0) {
        f16x8 bq[5];
#pragma unroll
        for (int q = 0; q < 5; ++q) bq[q] = *(const f16x8*)(rtb + (size_t)(5 * wv + q) * 1024 + lane * 16);
#pragma unroll
        for (int q = 0; q < 5; ++q) *(LAS f16x8*)(lds + (5 * wv + q) * 1024 + lane * 16) = bq[q];
#pragma unroll
        for (int q = 0; q < 5; ++q) bq[q] = *(const f16x8*)(rtb + (size_t)N2_SLOT + (size_t)(5 * wv + q) * 1024 + lane * 16);
        f16x8 x0[N2_CH], x1[N2_CH], x2[N2_CH];
#pragma unroll
        for (int s2 = 0; s2 < N2_CH; ++s2) { x0[s2] = *(const f16x8*)(xg + 32 * s2); x1[s2] = *(const f16x8*)(xg + 32 * (N2_CH + s2)); }
#define N2_CHUNK(XC, XL, CH) do { const int ch = (CH); \
            __syncthreads(); \
            const int nx2 = (ch + 2 < 64 / N2_CH) ? ch + 2 : ch; \
            {   LAS unsigned char* dst = lds + ((ch + 1) & 1) * N2_SLOT; \
 _Pragma("unroll") \
                for (int q = 0; q < 5; ++q) *(LAS f16x8*)(dst + (5 * wv + q) * 1024 + lane * 16) = bq[q]; } \
            {   const char* src = rtb + (size_t)nx2 * N2_SLOT; \
 _Pragma("unroll") \
                for (int q = 0; q < 5; ++q) bq[q] = *(const f16x8*)(src + (size_t)(5 * wv + q) * 1024 + lane * 16); } \
 _Pragma("unroll") \
            for (int s2 = 0; s2 < N2_CH; ++s2) { const int ko = 32 * (nx2 * N2_CH + s2); XL[s2] = *(const f16x8*)(xg + ko); } \
            const LAS unsigned char* bs = lds + (ch & 1) * N2_SLOT + lane * 16; \
 _Pragma("unroll") \
            for (int pp = 0; pp < N2_CH / 2; ++pp) { \
                f16x8 hk[2]; \
 _Pragma("unroll") \
                for (int sp = 0; sp < 2; ++sp) { \
                    const int s2 = 2 * pp + sp; const int ko = 32 * (ch * N2_CH + s2) + 8 * kg; \
                    const f32x4 c0 = *(const LAS f32x4*)(scl + ko), c1 = *(const LAS f32x4*)(scl + ko + 4), h0 = *(const LAS f32x4*)(shl + ko), h1 = *(const LAS f32x4*)(shl + ko + 4); \
                    f16x8 hi, lo; \
 _Pragma("unroll") \
                    for (int i = 0; i < 4; ++i) { const float a0 = (float)XC[s2][i] * rs * (1.0f + c0[i]) + h0[i], a1 = (float)XC[s2][4 + i] * rs * (1.0f + c1[i]) + h1[i]; \
                        hi[i] = (h16)a0; lo[i] = (h16)(a0 - (float)hi[i]); hi[4 + i] = (h16)a1; lo[4 + i] = (h16)(a1 - (float)hi[4 + i]); } \
                    hk[sp] = hi; \
                    if (pv_mma) \
 _Pragma("unroll") \
                    for (int ct = 0; ct < 5; ++ct) { const f16x8 whi = *(const LAS f16x8*)(bs + (s2 * 10 + ct * 2 + 0) * 1024), wlo = *(const LAS f16x8*)(bs + (s2 * 10 + ct * 2 + 1) * 1024); \
                        acc[ct] = __builtin_amdgcn_mfma_f32_16x16x32_f16(hi, whi, acc[ct], 0, 0, 0); \
                        acc[ct] = __builtin_amdgcn_mfma_f32_16x16x32_f16(hi, wlo, acc[ct], 0, 0, 0); \
                        acc[ct] = __builtin_amdgcn_mfma_f32_16x16x32_f16(lo, whi, acc[ct], 0, 0, 0); } \
                } \
                *(LAS f16x8*)(xt + hw_off0) = hk[0]; *(LAS f16x8*)(xt + hw_off1) = hk[1]; \
                const f16x8 o0 = *(const LAS f16x8*)(xt + hr_off), o1 = *(const LAS f16x8*)(xt + 1024 + hr_off); \
                if (active && pv_store) { const int ho = 32 * (ch * N2_CH + 2 * pp); *(f16x8*)(hg0 + ho) = o0; *(f16x8*)(hg1 + ho) = o1; } \
            } \
        } while (0)
#pragma unroll 1
        for (int c3 = 0; c3 < 15; c3 += 3) { N2_CHUNK(x0, x2, c3); N2_CHUNK(x1, x0, c3 + 1); N2_CHUNK(x2, x1, c3 + 2); }
        N2_CHUNK(x0, x2, 15);
#undef N2_CHUNK
        } else {
            const char* rtw = rtb + (size_t)(8 * wv) * 10240; const int kb = 256 * wv;
            unsigned loff = (unsigned)lane * 16u; asm volatile("" : "+v"(loff));
            f16x8 bb[10];
            f16x8 xa[2][2];
#pragma unroll
            for (int sp = 0; sp < 2; ++sp) xa[0][sp] = *(const f16x8*)(xg + kb + 32 * sp);
#pragma unroll
            for (int pp = 0; pp < 4; ++pp) {
                if (pp < 3) {
#pragma unroll
                    for (int sp = 0; sp < 2; ++sp) xa[(pp + 1) & 1][sp] = *(const f16x8*)(xg + kb + 32 * (2 * pp + 2 + sp)); }
                f16x8 hk[2];
#pragma unroll
                for (int sp = 0; sp < 2; ++sp) {
                    const int st = 2 * pp + sp; const int ko = kb + 32 * st + 8 * kg;
#pragma unroll
                    for (int q = 0; q < 10; ++q) bb[q] = *(const f16x8*)(rtw + (size_t)(st * 10 + q) * 1024 + loff);
                    asm volatile("" ::: "memory");
                    const f32x4 c0 = *(const LAS f32x4*)(scl + ko), c1 = *(const LAS f32x4*)(scl + ko + 4), h0 = *(const LAS f32x4*)(shl + ko), h1 = *(const LAS f32x4*)(shl + ko + 4);
                    f16x8 hi, lo;
#pragma unroll
                    for (int i = 0; i < 4; ++i) { const float a0 = (float)xa[pp & 1][sp][i] * rs * (1.0f + c0[i]) + h0[i], a1 = (float)xa[pp & 1][sp][4 + i] * rs * (1.0f + c1[i]) + h1[i];
                        hi[i] = (h16)a0; lo[i] = (h16)(a0 - (float)hi[i]); hi[4 + i] = (h16)a1; lo[4 + i] = (h16)(a1 - (float)hi[4 + i]); }
                    hk[sp] = hi;
#pragma unroll
                    for (int ct = 0; ct < 5; ++ct) {
                        acc[ct] = __builtin_amdgcn_mfma_f32_16x16x32_f16(hi, bb[2 * ct], acc[ct], 0, 0, 0);
                        acc[ct] = __builtin_amdgcn_mfma_f32_16x16x32_f16(hi, bb[2 * ct + 1], acc[ct], 0, 0, 0);
                        acc[ct] = __builtin_amdgcn_mfma_f32_16x16x32_f16(lo, bb[2 * ct], acc[ct], 0, 0, 0); }
                }
                *(LAS f16x8*)(xt + hw_off0) = hk[0]; *(LAS f16x8*)(xt + hw_off1) = hk[1];
                const f16x8 o0 = *(const LAS f16x8*)(xt + hr_off), o1 = *(const LAS f16x8*)(xt + 1024 + hr_off);
                if (pv_store) { const int ho = kb + 64 * pp; *(f16x8*)(hg0 + ho) = o0; *(f16x8*)(hg1 + ho) = o1; }
            }
        }
        __syncthreads();
#pragma unroll
        for (int ct = 0; ct < 5; ++ct)
#pragma unroll
            for (int i = 0; i < 4; ++i) scr[(4 * kg + i) * 80 + 16 * ct + r16] = acc[ct][i] * (1.0f / 256.0f);
        asm volatile("s_waitcnt lgkmcnt(0)" ::: "memory");
        int ea = 0, eb = 0, ra = 0, rb = 0; float g1v = 0.f, g2v = 0.f; const bool tok_lane = (round == 0 ? active : wv == 0) && lane < 16 && pv_tail;
        const int nparts = round == 0 ? 1 : 8;
        if (tok_lane) {
            const LAS float* lgr = scr + lane * 80;
#define N2_LG(c) ({ float _t = lgr[(c)]; for (int _w = 1; _w < nparts; ++_w) _t += lgr[_w * 1280 + (c)]; _t; })
            float gmax = -3.0e38f; int gsel = 0; float gl[8];
#pragma unroll
            for (int g = 0; g < 8; ++g) { gl[g] = N2_LG(g) + p.moe_bg[layer * 8 + g]; if (gl[g] > gmax) { gmax = gl[g]; gsel = g; } }
            float gz = 0.f;
#pragma unroll
            for (int g = 0; g < 8; ++g) gz += expf(gl[g] - gmax);
            const float pg = 1.0f / gz;
            float f1 = -3.0e38f, f2 = -3.0e38f; int i1 = 0, i2 = 0;
            for (int q = 0; q < 8; ++q) { const float f = N2_LG(8 + gsel * 8 + q) + p.moe_be[layer * 64 + gsel * 8 + q];
                if (f > f1) { f2 = f1; i2 = i1; f1 = f; i1 = q; } else if (f > f2) { f2 = f; i2 = q; } }
            const float e2 = expf(f2 - f1); g1v = pg / (1.0f + e2); g2v = pg * e2 / (1.0f + e2);
            ea = gsel * 8 + i1; eb = gsel * 8 + i2;
#undef N2_LG
            ra = __hip_atomic_fetch_add(hist + ea, 1, __ATOMIC_RELAXED, __HIP_MEMORY_SCOPE_WORKGROUP); rb = __hip_atomic_fetch_add(hist + eb, 1, __ATOMIC_RELAXED, __HIP_MEMORY_SCOPE_WORKGROUP);
        }
        __syncthreads();
        { const int t2 = tid_fresh(); if (t2 < NE && pv_tail) { const int n = hist[t2]; hbase[t2] = n ? atomicAdd(&counters[t2], n) : 0; } }
        __syncthreads();
        if (tok_lane) { const int tok = task * 16 + lane; const size_t sa = (size_t)ea * LCAP + hbase[ea] + ra, sb = (size_t)eb * LCAP + hbase[eb] + rb;
            list[sa] = 2 * tok; gate[sa] = g1v; list[sb] = 2 * tok + 1; gate[sb] = g2v; }
    }
}
__device__ __forceinline__ void transpose_phase(const Params& p, LAS h16* T) {
    const h16* zt = (const h16*)(p.ws + WS_ZT); h16* z = (h16*)(p.ws + WS_HBUF); const int tid = tid_fresh();
    const int ntile = (D / 64) * (TT / 64);
    for (int tile = blockIdx.x; tile < ntile; tile += gridDim.x) {
        const int td = tile % (D / 64), tt = tile / (D / 64); const int d0 = td * 64, t0 = tt * 64;
        { const int dr = tid >> 3, tc = (tid & 7) * 8; const f16x8 v = *(const f16x8*)(zt + (size_t)(d0 + dr) * TT + t0 + tc);
#pragma unroll
            for (int i = 0; i < 8; ++i) T[(tc + i) * 66 + dr] = v[i]; }
        __syncthreads();
        { const int tr = tid >> 3, dc = (tid & 7) * 8; f16x8 v;
#pragma unroll
            for (int i = 0; i < 8; ++i) v[i] = T[tr * 66 + dc + i];
            *(f16x8*)(z + (size_t)(t0 + tr) * D + d0 + dc) = v; }
        __syncthreads();
    }
}

__device__ __forceinline__ f32x2 cmul(const f32x2 a, const f32x2 b) { return (f32x2){a.x * b.x - a.y * b.y, a.x * b.y + a.y * b.x}; }
__device__ __forceinline__ f32x2 cmulc(const f32x2 a, const f32x2 b) { return (f32x2){a.x * b.x + a.y * b.y, a.y * b.x - a.x * b.y}; }
__device__ __forceinline__ f32x2 cconj(const f32x2 a) { return (f32x2){a.x, -a.y}; }
template <bool INV> __device__ __forceinline__ f32x2 mul_mi(const f32x2 a) { return INV ? (f32x2){-a.y, a.x} : (f32x2){a.y, -a.x}; }
template <bool INV> __device__ __forceinline__ void dft4(f32x2& a, f32x2& b, f32x2& c, f32x2& d) {
    const f32x2 s0 = a + c, s1 = a - c, s2 = b + d, s3 = mul_mi<INV>(b - d);
    a = s0 + s2; b = s1 + s3; c = s0 - s2; d = s1 - s3;
}
template <bool INV, int M> __device__ __forceinline__ f32x2 w16mul(const f32x2 a) {
    constexpr float C1 = 0.92387953251128674f, S1 = 0.38268343236508977f, R = 0.70710678118654752f;
    constexpr float cr = (M == 0) ? 1.f : (M == 1) ? C1 : (M == 2) ? R : (M == 3) ? S1 : (M == 4) ? 0.f : (M == 6) ? -R :   -C1;
    constexpr float ci0 = (M == 0) ? 0.f : (M == 1) ? -S1 : (M == 2) ? -R : (M == 3) ? -C1 : (M == 4) ? -1.f : (M == 6) ? -R :   S1;
    constexpr float ci = INV ? -ci0 : ci0;
    return (f32x2){a.x * cr - a.y * ci, a.x * ci + a.y * cr};
}
template <bool INV> __device__ __forceinline__ void dft16(f32x2 (&v)[16]) {
#pragma unroll
    for (int n2 = 0; n2 < 4; ++n2) dft4<INV>(v[n2], v[4 + n2], v[8 + n2], v[12 + n2]);
    v[5] = w16mul<INV, 1>(v[5]); v[6] = w16mul<INV, 2>(v[6]); v[7] = w16mul<INV, 3>(v[7]);
    v[9] = w16mul<INV, 2>(v[9]); v[10] = w16mul<INV, 4>(v[10]); v[11] = w16mul<INV, 6>(v[11]);
    v[13] = w16mul<INV, 3>(v[13]); v[14] = w16mul<INV, 6>(v[14]); v[15] = w16mul<INV, 9>(v[15]);
#pragma unroll
    for (int k1 = 0; k1 < 4; ++k1) dft4<INV>(v[4 * k1], v[4 * k1 + 1], v[4 * k1 + 2], v[4 * k1 + 3]);
    f32x2 t;
    t = v[1]; v[1] = v[4]; v[4] = t; t = v[2]; v[2] = v[8]; v[8] = t; t = v[3]; v[3] = v[12]; v[12] = t;
    t = v[6]; v[6] = v[9]; v[9] = t; t = v[7]; v[7] = v[13]; v[13] = t; t = v[11]; v[11] = v[14]; v[14] = t;
}
__device__ __forceinline__ int fphys(int i) { return i + (i >> 4); }
__device__ __forceinline__ f32x2 w32c(int j) {
    constexpr float c[16] = {1.f, 0.98078528040323043f, 0.92387953251128674f, 0.83146961230254524f, 0.70710678118654752f, 0.55557023301960218f, 0.38268343236508977f, 0.19509032201612825f,
                             0.f, -0.19509032201612825f, -0.38268343236508977f, -0.55557023301960218f, -0.70710678118654752f, -0.83146961230254524f, -0.92387953251128674f, -0.98078528040323043f};
    constexpr float s[16] = {0.f, 0.19509032201612825f, 0.38268343236508977f, 0.55557023301960218f, 0.70710678118654752f, 0.83146961230254524f, 0.92387953251128674f, 0.98078528040323043f,
                             1.f, 0.98078528040323043f, 0.92387953251128674f, 0.83146961230254524f, 0.70710678118654752f, 0.55557023301960218f, 0.38268343236508977f, 0.19509032201612825f};
    return (f32x2){c[j], -s[j]};
}
template <int S>
__device__ __forceinline__ void fft_fwd0(const f32x2 (&xe)[16], const f32x2 (&xo)[16], LAS f32x2* E, LAS f32x2* O, int t, const LAS f32x2* tw) {
    const f32x2 u = tw[t * (256 / S)]; const f32x2 u2 = cmul(u, u);
    f32x2 y[16];
#pragma unroll
    for (int j = 0; j < 16; ++j) y[j] = xe[j];
    dft16<false>(y);
    constexpr int QS = S + S / 16;
    LAS f32x2* Eb = E + fphys(t); LAS f32x2* Ob = O + fphys(t);
    f32x2 pw = u2; Eb[0] = y[0];
#pragma unroll
    for (int q = 1; q < 16; ++q) { Eb[QS * q] = cmul(y[q], pw); pw = cmul(pw, u2); }
#pragma unroll
    for (int j = 0; j < 16; ++j) y[j] = cmul(xo[j], w32c(j));
    dft16<false>(y);
    pw = u;
#pragma unroll
    for (int q = 0; q < 16; ++q) { Ob[QS * q] = cmul(y[q], pw); pw = cmul(pw, u2); }
}
template <bool INV> __device__ __forceinline__ void fft_pass1(LAS f32x2* A, int tau, const LAS f32x2* tw) {
    const int i = tau & 15, base = (tau >> 4) << 8; const f32x2 u0 = tw[32 * i]; const f32x2 u = INV ? cconj(u0) : u0;
    f32x2 y[16]; LAS f32x2* Ab = A + fphys(base + i);
#pragma unroll
    for (int j = 0; j < 16; ++j) y[j] = Ab[17 * j];
    if (INV) { f32x2 pw = u;
#pragma unroll
        for (int q = 1; q < 16; ++q) { y[q] = cmul(y[q], pw); pw = cmul(pw, u); } }
    dft16<INV>(y);
    if (!INV) { f32x2 pw = u;
#pragma unroll
        for (int q = 1; q < 16; ++q) { y[q] = cmul(y[q], pw); pw = cmul(pw, u); } }
#pragma unroll
    for (int j = 0; j < 16; ++j) Ab[17 * j] = y[j];
}
template <bool INV> __device__ __forceinline__ void fft_pass1_pair(LAS f32x2* A, LAS f32x2* B, int tau, const LAS f32x2* tw) {
    const int i = tau & 15, base = (tau >> 4) << 8; const f32x2 u0 = tw[32 * i]; const f32x2 u = INV ? cconj(u0) : u0;
    f32x2 y[16], z[16]; LAS f32x2* Ab = A + fphys(base + i); LAS f32x2* Bb = B + fphys(base + i);
#pragma unroll
    for (int j = 0; j < 16; ++j) y[j] = Ab[17 * j];
#pragma unroll
    for (int j = 0; j < 16; ++j) z[j] = Bb[17 * j];
    f32x2 pwr[16]; pwr[1] = u;
#pragma unroll
    for (int q = 2; q < 16; ++q) pwr[q] = cmul(pwr[q - 1], u);
    if (INV) {
#pragma unroll
        for (int q = 1; q < 16; ++q) y[q] = cmul(y[q], pwr[q]); }
    dft16<INV>(y);
    if (!INV) {
#pragma unroll
        for (int q = 1; q < 16; ++q) y[q] = cmul(y[q], pwr[q]); }
#pragma unroll
    for (int j = 0; j < 16; ++j) Ab[17 * j] = y[j];
    if (INV) {
#pragma unroll
        for (int q = 1; q < 16; ++q) z[q] = cmul(z[q], pwr[q]); }
    dft16<INV>(z);
    if (!INV) {
#pragma unroll
        for (int q = 1; q < 16; ++q) z[q] = cmul(z[q], pwr[q]); }
#pragma unroll
    for (int j = 0; j < 16; ++j) Bb[17 * j] = z[j];
}
__device__ __forceinline__ void fft_fwd2(const LAS f32x2* A, int t, f32x2 (&y)[16]) {
#pragma unroll
    for (int j = 0; j < 16; ++j) y[j] = A[17 * t + j];
    dft16<false>(y);
}
template <int NT> __device__ __forceinline__ void kf_load(const f32x2* kf, f32x4 (&k)[8]) {
#pragma unroll
    for (int j = 0; j < 8; ++j) k[j] = *(const f32x4*)(kf + j * (2 * NT));
}
__device__ __forceinline__ void fft_mid(LAS f32x2* A, int t, const f32x4 (&k)[8]) {
    f32x2 y[16];
    fft_fwd2(A, t, y);
#pragma unroll
    for (int j = 0; j < 8; ++j) { y[2 * j] = cmul(y[2 * j], (f32x2){k[j][0], k[j][1]}); y[2 * j + 1] = cmul(y[2 * j + 1], (f32x2){k[j][2], k[j][3]}); }
    dft16<true>(y);
#pragma unroll
    for (int j = 0; j < 16; ++j) A[17 * t + j] = y[j];
}
template <int S>
__device__ __forceinline__ void fft_inv0(const LAS f32x2* E, const LAS f32x2* O, int t, const LAS f32x2* tw, f32x2 (&out)[16]) {
    const f32x2 u = tw[t * (256 / S)]; const f32x2 u2 = cmul(u, u);
    f32x2 y[16];
    constexpr int QS = S + S / 16;
    const LAS f32x2* Eb = E + fphys(t); const LAS f32x2* Ob = O + fphys(t);
    f32x2 pw = u2; y[0] = Eb[0];
#pragma unroll
    for (int q = 1; q < 16; ++q) { y[q] = cmulc(Eb[QS * q], pw); pw = cmul(pw, u2); }
    dft16<true>(y);
#pragma unroll
    for (int j = 0; j < 16; ++j) out[j] = y[j];
    pw = u;
#pragma unroll
    for (int q = 0; q < 16; ++q) { y[q] = cmulc(Ob[QS * q], pw); pw = cmul(pw, u2); }
    dft16<true>(y);
#pragma unroll
    for (int j = 0; j < 16; ++j) out[j] += cmulc(y[j], w32c(j));
}
__device__ __forceinline__ float hy_absdelta(int d) { return fabsf(-3.0701134573253943f + (-15.350567286626973f + 3.0701134573253943f) * ((float)d / 2047.0f)); }

__device__ __forceinline__ void filt_fft_phase(const Params& p, LAS unsigned char* lds) {
    const int tid = tid_fresh();
    LAS f32x2* tw = (LAS f32x2*)(lds + LDS_MISC + 1024);
    tw[tid] = ((const f32x2*)(p.ws + WS_TW))[tid];
    __syncthreads();
    {
        const int grp = tid >> 8, tau = tid & 255; constexpr int KFQ = 512;
        LAS f32x2* E = (LAS f32x2*)(lds + grp * 69632); LAS f32x2* O = E + 4352; LAS float* red = (LAS float*)(lds + LDS_MISC) + grp * 8;
        for (int pb = blockIdx.x * 2 + grp; pb < 2 * 2 * 2048; pb += gridDim.x * 2) {
            const int d = pb & 2047, n = (pb >> 11) & 1, j = pb >> 12;
            const float* tf = (const float*)(p.ws + WS_TAPS) + ((size_t)j * 8192 + (size_t)(n * 2 + 0) * D + d) * 4096;
            const float* tb = tf + (size_t)D * 4096;
            const float adel = hy_absdelta(d); const float tscale = 1.0f / 4095.0f;
            f32x2 xe[16], xo[16]; float ss = 0.f;
#pragma unroll
            for (int jj = 0; jj < 16; ++jj) { const int nn = tau + 256 * jj;
                const float klo = tf[nn] * expf(-(float)nn * tscale * adel);
                const int m = 4096 - nn;
                const float khi = (m < 4096) ? tb[m & 4095] * expf(-(float)m * tscale * adel) : 0.f;
                ss += klo * klo + khi * khi; xe[jj] = (f32x2){klo + khi, 0.f}; xo[jj] = (f32x2){klo - khi, 0.f}; }
            ss = wave_sum(ss);
            if ((tid & 63) == 0) red[(tid >> 6) & 3] = ss;
            fft_fwd0<256>(xe, xo, E, O, tau, tw);
            __syncthreads();
            const float tot = red[0] + red[1] + red[2] + red[3];
            const float scale = (1.0f / sqrtf(tot + EPS)) * (1.0f / 8192.0f);
            const float hbs = p.hy_bias[((size_t)j * 2 + n) * D + d] * (1.0f / 8192.0f);
            fft_pass1<false>(E, tau, tw); fft_pass1<false>(O, tau, tw);
            __syncthreads();
            f32x2* kf = (f32x2*)(p.ws + WS_KF) + (size_t)pb * 8192 + (size_t)tau * 2;
            f32x2 y[16];
            fft_fwd2(E, tau, y);
#pragma unroll
            for (int q = 0; q < 8; ++q) *(f32x4*)(kf + KFQ * q) = (f32x4){y[2 * q].x * scale + hbs, y[2 * q].y * scale, y[2 * q + 1].x * scale + hbs, y[2 * q + 1].y * scale};
            fft_fwd2(O, tau, y);
#pragma unroll
            for (int q = 0; q < 8; ++q) *(f32x4*)(kf + 4096 + KFQ * q) = (f32x4){y[2 * q].x * scale + hbs, y[2 * q].y * scale, y[2 * q + 1].x * scale + hbs, y[2 * q + 1].y * scale};
            __syncthreads();
        }
    }
    {
        const int pr = tid >> 4, i = tid & 15; constexpr int KFQ = 32;
        LAS f32x2* E = (LAS f32x2*)(lds + pr * 4352); LAS f32x2* O = E + 272;
        for (int it = blockIdx.x; it < 256; it += gridDim.x) {
            const int pb = it * 32 + pr; const int d = pb & 2047, n = (pb >> 11) & 1, j = pb >> 12;
            const float* tf = (const float*)(p.ws + WS_TAPSC) + ((size_t)j * 8192 + (size_t)(n * 2 + 0) * D + d) * 256;
            const float* tb = tf + (size_t)D * 256;
            const float adel = hy_absdelta(d); const float tscale = 1.0f / 255.0f;
            f32x2 xe[16], xo[16]; float ss = 0.f;
#pragma unroll
            for (int jj = 0; jj < 16; ++jj) { const int nn = i + 16 * jj;
                const float klo = tf[nn] * expf(-(float)nn * tscale * adel);
                const int m = 256 - nn;
                const float khi = (m < 256) ? tb[m & 255] * expf(-(float)m * tscale * adel) : 0.f;
                ss += klo * klo + khi * khi; xe[jj] = (f32x2){klo + khi, 0.f}; xo[jj] = (f32x2){klo - khi, 0.f}; }
            ss += shx(ss, 8); ss += shx(ss, 4); ss += shx(ss, 2); ss += shx(ss, 1);
            const float scale = (1.0f / sqrtf(ss + EPS)) * (1.0f / 512.0f);
            const float hbs = p.hy_bias[((size_t)j * 2 + n) * D + d] * (1.0f / 512.0f);
            fft_fwd0<16>(xe, xo, E, O, i, tw);
            __syncthreads();
            f32x2* kf = (f32x2*)(p.ws + WS_KFC) + (size_t)pb * 512 + (size_t)i * 2;
            f32x2 y[16];
            fft_fwd2(E, i, y);
#pragma unroll
            for (int q = 0; q < 8; ++q) *(f32x4*)(kf + KFQ * q) = (f32x4){y[2 * q].x * scale + hbs, y[2 * q].y * scale, y[2 * q + 1].x * scale + hbs, y[2 * q + 1].y * scale};
            fft_fwd2(O, i, y);
#pragma unroll
            for (int q = 0; q < 8; ++q) *(f32x4*)(kf + 256 + KFQ * q) = (f32x4){y[2 * q].x * scale + hbs, y[2 * q].y * scale, y[2 * q + 1].x * scale + hbs, y[2 * q + 1].y * scale};
            __syncthreads();
        }
    }
}

__device__ __forceinline__ float conv3_lds(const LAS h16* row, int n, float w0, float w1, float w2, float b) { return (float)row[n - 1] * w0 + (float)row[n] * w1 + (float)row[n + 1] * w2 + b; }
constexpr int ST_P = 4112, STS_P = 272;

#ifndef PROBE_CVAR
#define PROBE_CVAR 0
#endif
__device__ __forceinline__ void conv_phase(const Params& p, int jl, LAS unsigned char* lds, int pvar = 0, int cvt_layer = -1, int cvt_n = 0) {
    const int tid = tid_fresh(); const bool cv_outer = !(pvar && (PROBE_CVAR & 1)), cv_inner = !(pvar && (PROBE_CVAR & 2));
    LAS f32x2* tw = (LAS f32x2*)(lds + LDS_MISC + 1024);
    tw[tid] = ((const f32x2*)(p.ws + WS_TW))[tid];
    __syncthreads();
    const h16* ut = (const h16*)(p.ws + WS_UT); h16* zt = (h16*)(p.ws + WS_ZT);
    const float* cw = p.hy_conv_w + (size_t)jl * 3 * D3; const float* cb = p.hy_conv_b + (size_t)jl * D3;
    {
        const int grp = tid >> 8, tau = tid & 255;
        LAS f32x2* E = (LAS f32x2*)(lds + grp * 69632); LAS f32x2* O = E + 4352; LAS h16* ST = (LAS h16*)E;
        int uit = 0; const int utrig = 4 * (((int)blockIdx.x >> 3) & 3);
        for (int unit = blockIdx.x; unit < 4096; unit += gridDim.x, ++uit) {
            if (cvt_layer >= 0 && uit == utrig) { __syncthreads(); cvt_moe_share(p, cvt_layer, blockIdx.x, cvt_n, gridDim.x, (LAS float*)lds); }
            const int ux = unit & 7, uj = unit >> 3; const int hq = uj & 1, d = (uj >> 1) * 8 + ux; const size_t col0 = (size_t)(4 * hq + 2 * grp) * 4096;
            const f32x2* kfb = (const f32x2*)(p.ws + WS_KF) + ((size_t)(jl * 2) * 2048 + d) * 8192 + (size_t)tau * 2;
            f16x8 raw[2][2][2], raw2[2][2];
#pragma unroll
            for (int sq = 0; sq < 2; ++sq)
#pragma unroll
                for (int bb = 0; bb < 2; ++bb)
#pragma unroll
                    for (int k = 0; k < 2; ++k) raw[sq][bb][k] = *(const f16x8*)(ut + (size_t)(sq * D + d) * TT + col0 + (size_t)bb * 4096 + (size_t)(tau + 256 * k) * 8);
            __syncthreads();
#pragma unroll
            for (int sq = 0; sq < 2; ++sq)
#pragma unroll
                for (int bb = 0; bb < 2; ++bb)
#pragma unroll
                    for (int k = 0; k < 2; ++k) *(LAS f16x8*)(ST + (sq * 2 + bb) * ST_P + 8 + (tau + 256 * k) * 8) = raw[sq][bb][k];
            if (tau < 4) { ST[tau * ST_P + 7] = (h16)0.f; ST[tau * ST_P + 8 + 4096] = (h16)0.f; }
            __syncthreads();
            f32x2 xin[16], gk[16], y[16];
            { const float w0 = cw[d], w1 = cw[D3 + d], w2 = cw[2 * D3 + d], bv = cb[d]; const float g0 = cw[D + d], g1 = cw[D3 + D + d], g2 = cw[2 * D3 + D + d], gb = cb[D + d];
#pragma unroll
                for (int jj = 0; jj < 16; ++jj) { const int nn = tau + 256 * jj;
                    xin[jj] = (f32x2){conv3_lds(ST + 8, nn, w0, w1, w2, bv), conv3_lds(ST + ST_P + 8, nn, w0, w1, w2, bv)};
                    gk[jj] = (f32x2){conv3_lds(ST + 2 * ST_P + 8, nn, g0, g1, g2, gb), conv3_lds(ST + 3 * ST_P + 8, nn, g0, g1, g2, gb)}; } }
            __syncthreads();
#pragma unroll 1
            for (int ord = 0; ord < 2; ++ord) {
                if (cv_outer) fft_fwd0<256>(xin, xin, E, O, tau, tw);
                const f32x2* kf = kfb + (size_t)ord * 2048 * 8192; f32x4 kfe[8], kfo[8];
                kf_load<256>(kf, kfe);
                __syncthreads();
                if (cv_inner) fft_pass1_pair<false>(E, O, tau, tw);
                kf_load<256>(kf + 4096, kfo);
                __syncthreads();
                if (cv_inner) { fft_mid(E, tau, kfe); fft_mid(O, tau, kfo); }
                if (ord == 0) {
#pragma unroll
                    for (int bb = 0; bb < 2; ++bb)
#pragma unroll
                        for (int k = 0; k < 2; ++k) raw2[bb][k] = *(const f16x8*)(ut + (size_t)(2 * D + d) * TT + col0 + (size_t)bb * 4096 + (size_t)(tau + 256 * k) * 8); }
                __syncthreads();
                if (cv_inner) fft_pass1_pair<true>(E, O, tau, tw);
                __syncthreads();
                if (cv_outer) fft_inv0<256>(E, O, tau, tw, y); else {
#pragma unroll
                    for (int jj = 0; jj < 16; ++jj) y[jj] = xin[jj]; }
#pragma unroll
                for (int jj = 0; jj < 16; ++jj) xin[jj] = gk[jj] * y[jj];
                if (ord == 0) {
                    __syncthreads();
#pragma unroll
                    for (int bb = 0; bb < 2; ++bb)
#pragma unroll
                        for (int k = 0; k < 2; ++k) *(LAS f16x8*)(ST + bb * ST_P + 8 + (tau + 256 * k) * 8) = raw2[bb][k];
                    if (tau < 2) { ST[tau * ST_P + 7] = (h16)0.f; ST[tau * ST_P + 8 + 4096] = (h16)0.f; }
                    __syncthreads();
                    const float g0 = cw[2 * D + d], g1 = cw[D3 + 2 * D + d], g2 = cw[2 * D3 + 2 * D + d], gb = cb[2 * D + d];
#pragma unroll
                    for (int jj = 0; jj < 16; ++jj) { const int nn = tau + 256 * jj; gk[jj] = (f32x2){conv3_lds(ST + 8, nn, g0, g1, g2, gb), conv3_lds(ST + ST_P + 8, nn, g0, g1, g2, gb)}; }
                    __syncthreads();
                }
            }
            h16* o0 = zt + (size_t)d * TT + col0; h16* o1 = o0 + 4096;
#pragma unroll
            for (int jj = 0; jj < 16; ++jj) { const int nn = tau + 256 * jj; o0[nn] = (h16)xin[jj].x; o1[nn] = (h16)xin[jj].y; }
        }
    }
    {
        const int pr = tid >> 4, i = tid & 15, c8 = pr >> 2, bp = pr & 3;
        LAS f32x2* E = (LAS f32x2*)(lds + pr * 4352); LAS f32x2* O = E + 272; LAS h16* ST = (LAS h16*)lds;
        for (int unit = blockIdx.x; unit < 256; unit += gridDim.x) {
            const int d0 = unit * 8, d = d0 + c8;
            const f32x2* kfb = (const f32x2*)(p.ws + WS_KFC) + ((size_t)(jl * 2) * 2048 + d) * 512 + (size_t)i * 2;
            f16x8 raw[3][4];
#pragma unroll
            for (int sq = 0; sq < 3; ++sq)
#pragma unroll
                for (int k = 0; k < 4; ++k) { const int q = tid + 512 * k, row = q >> 5, ch = q & 31;
                    raw[sq][k] = *(const f16x8*)(ut + (size_t)(sq * D + d0 + (row >> 3)) * TT + TL + (row & 7) * 256 + ch * 8); }
            __syncthreads();
#pragma unroll
            for (int sq = 0; sq < 2; ++sq)
#pragma unroll
                for (int k = 0; k < 4; ++k) { const int q = tid + 512 * k, row = q >> 5, ch = q & 31; *(LAS f16x8*)(ST + (sq * 64 + row) * STS_P + 8 + ch * 8) = raw[sq][k]; }
            if (tid < 128) { ST[tid * STS_P + 7] = (h16)0.f; ST[tid * STS_P + 8 + 256] = (h16)0.f; }
            __syncthreads();
            f32x2 xin[16], gk[16], y[16];
            { const float w0 = cw[d], w1 = cw[D3 + d], w2 = cw[2 * D3 + d], bv = cb[d]; const float g0 = cw[D + d], g1 = cw[D3 + D + d], g2 = cw[2 * D3 + D + d], gb = cb[D + d];
                const LAS h16* r0 = ST + (c8 * 8 + 2 * bp) * STS_P + 8; const LAS h16* r1 = r0 + 64 * STS_P;
#pragma unroll
                for (int jj = 0; jj < 16; ++jj) { const int nn = i + 16 * jj;
                    xin[jj] = (f32x2){conv3_lds(r0, nn, w0, w1, w2, bv), conv3_lds(r0 + STS_P, nn, w0, w1, w2, bv)};
                    gk[jj] = (f32x2){conv3_lds(r1, nn, g0, g1, g2, gb), conv3_lds(r1 + STS_P, nn, g0, g1, g2, gb)}; } }
            __syncthreads();
#pragma unroll 1
            for (int ord = 0; ord < 2; ++ord) {
                const f32x2* kf = kfb + (size_t)ord * 2048 * 512; f32x4 kfe[8], kfo[8];
                fft_fwd0<16>(xin, xin, E, O, i, tw);
                __syncthreads();
                kf_load<16>(kf, kfe); fft_mid(E, i, kfe); kf_load<16>(kf + 256, kfo); fft_mid(O, i, kfo);
                __syncthreads();
                fft_inv0<16>(E, O, i, tw, y);
#pragma unroll
                for (int jj = 0; jj < 16; ++jj) xin[jj] = gk[jj] * y[jj];
                if (ord == 0) {
                    __syncthreads();
#pragma unroll
                    for (int k = 0; k < 4; ++k) { const int q = tid + 512 * k, row = q >> 5, ch = q & 31; *(LAS f16x8*)(ST + row * STS_P + 8 + ch * 8) = raw[2][k]; }
                    if (tid < 64) { ST[tid * STS_P + 7] = (h16)0.f; ST[tid * STS_P + 8 + 256] = (h16)0.f; }
                    __syncthreads();
                    const float g0 = cw[2 * D + d], g1 = cw[D3 + 2 * D + d], g2 = cw[2 * D3 + 2 * D + d], gb = cb[2 * D + d];
                    const LAS h16* r0 = ST + (c8 * 8 + 2 * bp) * STS_P + 8;
#pragma unroll
                    for (int jj = 0; jj < 16; ++jj) { const int nn = i + 16 * jj; gk[jj] = (f32x2){conv3_lds(r0, nn, g0, g1, g2, gb), conv3_lds(r0 + STS_P, nn, g0, g1, g2, gb)}; }
                    __syncthreads();
                }
            }
            h16* o0 = zt + (size_t)d * TT + TL + (2 * bp) * 256; h16* o1 = o0 + 256;
#pragma unroll
            for (int jj = 0; jj < 16; ++jj) { const int nn = i + 16 * jj; o0[nn] = (h16)xin[jj].x; o1[nn] = (h16)xin[jj].y; }
        }
    }
}

constexpr int AT_KP = 72, AT_VP = 68;
__device__ __forceinline__ void attn_phase(const Params& p, int jl, bool with_ctx_out, LAS unsigned char* lds, int cvt_layer = -1, int cvt_n = 0) {
    const int tid = tid_fresh(), wv = tid >> 6, lane = tid & 63, r32 = lane & 31, hh = lane >> 5;
    LAS h16* Ks = (LAS h16*)lds; LAS h16* Vs = (LAS h16*)(lds + 64 * AT_KP * 2);
    const h16* qk = (const h16*)(p.ws + WS_QK); const h16* vt = (const h16*)(p.ws + WS_VT); h16* ob = (h16*)(p.ws + WS_HBUF);
    LAS float* rcos = (LAS float*)(lds + 65536); LAS float* rsin = rcos + 1024;
    { const float* rg = (const float*)(p.ws + WS_ROPE); for (int i = tid; i < 2048; i += 512) rcos[i] = rg[i]; }
    __syncthreads();
    const int nunit = 2048 + (with_ctx_out ? 128 : 0);
    int uit = 0; const int utrig = 2 * (((int)blockIdx.x >> 3) & 3);
    for (int unit = blockIdx.x; unit < nunit; unit += gridDim.x, ++uit) {
        if (cvt_layer >= 0 && uit == utrig) { __syncthreads(); cvt_moe_share(p, cvt_layer, blockIdx.x, cvt_n, gridDim.x, (LAS float*)lds); }
        int kind, b, g, qb;
        if (unit < 2048) { kind = 0; qb = unit & 63; g = (unit >> 6) & 3; b = unit >> 8; } else { const int u2 = unit - 2048; kind = 1; qb = u2 & 3; g = (u2 >> 2) & 3; b = u2 >> 4; }
        const int head = g * 8 + wv;
        const int qrow0 = kind ? (TL + b * 256 + qb * 64) : (b * 4096 + qb * 64);
        const int ctxrow0 = TL + b * 256;
        const int t_lo = kind ? 0 : (qb < 2 ? 2 - qb : 0), t_hi = kind ? -1 : (65 - qb < 4 ? 65 - qb : 4); const int nwin = t_hi - t_lo + 1, nv = nwin + 4;
        const bool krole = tid < 256; const int kkey = tid >> 2, kcp = tid & 3, kdA = (kcp & 1) * 8 + (kcp >> 1) * 32; const int vdim = (tid - 256) >> 2, vkc = tid & 3;
        f16x8 ld0, ld1;
#define AT_TILE(sidx, KROW0, MASK, ROPE) do { if ((sidx) < nwin) { const int _ti = t_lo + (sidx); KROW0 = b * 4096 + qb * 64 - 128 + 64 * _ti; ROPE = true; MASK = (_ti == 0) ? 1 : (_ti == 4) ? 2 : 0; } \
            else { KROW0 = ctxrow0 + 64 * ((sidx) - nwin); ROPE = false; MASK = 0; } } while (0)
#define AT_LOAD(KROW0) do { if (krole) { const h16* kp = qk + (size_t)((KROW0) + kkey) * DQK + D + g * 64 + kdA; ld0 = *(const f16x8*)kp; ld1 = *(const f16x8*)(kp + 16); } \
            else { const h16* vp = vt + (size_t)(g * 64 + vdim) * TT + (KROW0) + 16 * vkc; ld0 = *(const f16x8*)vp; ld1 = *(const f16x8*)(vp + 8); } } while (0)
        { int kr0, mk; bool rp; AT_TILE(0, kr0, mk, rp); (void)mk; (void)rp; AT_LOAD(kr0); }
        f16x8 qf[2][4];
#pragma unroll
        for (int qt = 0; qt < 2; ++qt) {
            f32x4 qv[4][2];
            const h16* qp = qk + (size_t)(qrow0 + 32 * qt + r32) * DQK + head * 64 + 8 * hh;
#pragma unroll
            for (int ks = 0; ks < 4; ++ks) { const f16x8 t = *(const f16x8*)(qp + 16 * ks);
#pragma unroll
                for (int i = 0; i < 4; ++i) { qv[ks][0][i] = (float)t[i]; qv[ks][1][i] = (float)t[4 + i]; } }
            if (kind == 0) {
                const int colpos = 32 * qt + r32;
#pragma unroll
                for (int a = 0; a < 2; ++a) { const int pos = a ? colpos : qb; const LAS float* cp = rcos + pos * 16 + 8 * hh; const LAS float* sp = rsin + pos * 16 + 8 * hh;
#pragma unroll
                    for (int e = 0; e < 2; ++e) { const f32x4 c = *(const LAS f32x4*)(cp + 4 * e), s = *(const LAS f32x4*)(sp + 4 * e);
                        const f32x4 x1 = qv[2 * a][e], x2 = qv[2 * a + 1][e]; qv[2 * a][e] = x1 * c - x2 * s; qv[2 * a + 1][e] = x2 * c + x1 * s; } }
            }
#pragma unroll
            for (int ks = 0; ks < 4; ++ks)
#pragma unroll
                for (int i = 0; i < 4; ++i) { qf[qt][ks][i] = (h16)(qv[ks][0][i] * (0.125f * 1.4426950408889634f)); qf[qt][ks][4 + i] = (h16)(qv[ks][1][i] * (0.125f * 1.4426950408889634f)); }
        }
        const float sink = p.at_sink[jl * 32 + head] * 1.4426950408889634f;
        float mrun[2] = {sink, sink}, lrun[2] = {hh == 0 ? 1.f : 0.f, hh == 0 ? 1.f : 0.f};
        f32x16 oacc[2][2];
#pragma unroll
        for (int a = 0; a < 2; ++a)
#pragma unroll
            for (int c = 0; c < 2; ++c)
#pragma unroll
                for (int i = 0; i < 16; ++i) oacc[a][c][i] = 0.f;
#pragma unroll 1
        for (int sx = 0; sx < nv; ++sx) {
            int krow0, mask; bool rope; AT_TILE(sx, krow0, mask, rope);
            __syncthreads();
            if (krole) {
                f16x8 o1 = ld0, o2 = ld1;
                if (rope) { const int kpos = (krow0 - b * 4096) + kkey; const int pos = (kcp >> 1) ? (kpos & 63) : (kpos >> 6);
                    const LAS float* cpp = rcos + pos * 16 + (kcp & 1) * 8; const LAS float* spp = rsin + pos * 16 + (kcp & 1) * 8;
#pragma unroll
                    for (int i = 0; i < 8; ++i) { const float c = cpp[i], s = spp[i], x1 = (float)ld0[i], x2 = (float)ld1[i]; o1[i] = (h16)(x1 * c - x2 * s); o2[i] = (h16)(x2 * c + x1 * s); } }
                *(LAS f16x8*)(Ks + kkey * AT_KP + kdA) = o1; *(LAS f16x8*)(Ks + kkey * AT_KP + kdA + 16) = o2;
            } else {
                LAS h16* dst = Vs + vdim * AT_VP + 16 * vkc;
                *(LAS f16x4*)(dst) = (f16x4){ld0[0], ld0[1], ld0[2], ld0[3]}; *(LAS f16x4*)(dst + 4) = (f16x4){ld0[4], ld0[5], ld0[6], ld0[7]};
                *(LAS f16x4*)(dst + 8) = (f16x4){ld1[0], ld1[1], ld1[2], ld1[3]}; *(LAS f16x4*)(dst + 12) = (f16x4){ld1[4], ld1[5], ld1[6], ld1[7]};
            }
            if (sx + 1 < nv) { int kr1, mk1; bool rp1; AT_TILE(sx + 1, kr1, mk1, rp1); (void)mk1; (void)rp1; AT_LOAD(kr1); }
            __syncthreads();
#pragma unroll
            for (int qt = 0; qt < 2; ++qt) {
                f32x16 sacc[2];
#pragma unroll
                for (int kt = 0; kt < 2; ++kt)
#pragma unroll
                    for (int i = 0; i < 16; ++i) sacc[kt][i] = 0.f;
#pragma unroll
                for (int ks = 0; ks < 4; ++ks)
#pragma unroll
                    for (int kt = 0; kt < 2; ++kt) { const f16x8 kf = *(const LAS f16x8*)(Ks + (32 * kt + r32) * AT_KP + 16 * ks + 8 * hh);
                        sacc[kt] = __builtin_amdgcn_mfma_f32_32x32x16_f16(kf, qf[qt][ks], sacc[kt], 0, 0, 0); }
                float tmax = -3.0e38f;
                if (mask != 0) {
                    int lim = r32 - 4 * hh; asm volatile("" : "+v"(lim));
                    if (mask == 1) {
#pragma unroll
                        for (int kt = 0; kt < 2; ++kt) {
                            if (kt < qt) {
#pragma unroll
                                for (int i = 0; i < 16; ++i) sacc[kt][i] = -1.0e30f; }
                            else if (kt == qt) {
#pragma unroll
                                for (int i = 0; i < 16; ++i) { const int kc = (i & 3) + 8 * (i >> 2); if (kc < lim) sacc[kt][i] = -1.0e30f; } } }
                    } else {
#pragma unroll
                        for (int kt = 0; kt < 2; ++kt) {
                            if (kt > qt) {
#pragma unroll
                                for (int i = 0; i < 16; ++i) sacc[kt][i] = -1.0e30f; }
                            else if (kt == qt) {
#pragma unroll
                                for (int i = 0; i < 16; ++i) { const int kc = (i & 3) + 8 * (i >> 2); if (kc > lim) sacc[kt][i] = -1.0e30f; } } }
                    } }
#pragma unroll
                for (int kt = 0; kt < 2; ++kt)
#pragma unroll
                    for (int i = 0; i < 16; ++i) tmax = fmaxf(tmax, sacc[kt][i]);
                tmax = fmaxf(tmax, shx(tmax, 32));
                const float mnew = fmaxf(mrun[qt], tmax); const float alpha = __builtin_amdgcn_exp2f(mrun[qt] - mnew); mrun[qt] = mnew;
                float psum = 0.f; f16x8 pf[2][2];
#pragma unroll
                for (int kt = 0; kt < 2; ++kt)
#pragma unroll
                    for (int s2 = 0; s2 < 2; ++s2)
#pragma unroll
                        for (int jj = 0; jj < 8; jj += 2) { const float p0 = __builtin_amdgcn_exp2f(sacc[kt][8 * s2 + jj] - mnew), p1 = __builtin_amdgcn_exp2f(sacc[kt][8 * s2 + jj + 1] - mnew);
                            const f16x2 pk = {(h16)p0, (h16)p1}; pf[kt][s2][jj] = pk[0]; pf[kt][s2][jj + 1] = pk[1];
                            psum = __builtin_amdgcn_fdot2(pk, (f16x2){(h16)1.0f, (h16)1.0f}, psum, false); }
                lrun[qt] = lrun[qt] * alpha + psum;
                if (__builtin_amdgcn_ballot_w64(alpha != 1.0f) != 0ull) {
#pragma unroll
                for (int dt = 0; dt < 2; ++dt)
#pragma unroll
                    for (int i = 0; i < 16; ++i) oacc[dt][qt][i] *= alpha; }
#pragma unroll
                for (int kt = 0; kt < 2; ++kt)
#pragma unroll
                    for (int s2 = 0; s2 < 2; ++s2)
#pragma unroll
                        for (int dt = 0; dt < 2; ++dt) { const LAS h16* vr = Vs + (32 * dt + r32) * AT_VP + 32 * kt + 16 * s2 + 4 * hh;
                            const f16x4 v0 = *(const LAS f16x4*)vr, v1 = *(const LAS f16x4*)(vr + 8);
                            const f16x8 vf = (f16x8){v0[0], v0[1], v0[2], v0[3], v1[0], v1[1], v1[2], v1[3]};
                            oacc[dt][qt] = __builtin_amdgcn_mfma_f32_32x32x16_f16(vf, pf[kt][s2], oacc[dt][qt], 0, 0, 0); }
            }
        }
#pragma unroll
        for (int qt = 0; qt < 2; ++qt) {
            const float ltot = lrun[qt] + shx(lrun[qt], 32); const float inv = 1.0f / ltot;
            h16* op = ob + (size_t)(qrow0 + 32 * qt + r32) * D + head * 64 + 4 * hh;
#pragma unroll
            for (int dt = 0; dt < 2; ++dt)
#pragma unroll
                for (int q4 = 0; q4 < 4; ++q4) { f16x4 w;
#pragma unroll
                    for (int i = 0; i < 4; ++i) w[i] = (h16)(oacc[dt][qt][4 * q4 + i] * inv);
                    *(f16x4*)(op + 32 * dt + 8 * q4) = w; }
        }
    }
}
#undef AT_TILE
#undef AT_LOAD

constexpr int NPHASE = 35;
#ifndef MK_MULTI
#define MK_MULTI 0
#endif

template <int KIND>
__attribute__((target("no-packed-fp32-ops"))) __global__ void __launch_bounds__(512, 2) hy_fwd(Params p_) {
    extern __shared__ __attribute__((aligned(16))) unsigned char shm[];
    LAS unsigned char* lds = (LAS unsigned char*)shm;
    constexpr bool ALL = KIND < 0;
    const int ph0 = p_.ph0;
    if (threadIdx.x == 0) { *(LAS u32x4*)(lds + LDS_XB) = (u32x4){0u, 0u, 0u, 0u}; }
    __syncthreads();
    XcdBarrier bar;
    if constexpr (ALL) bar = xcd_barrier_post((unsigned*)(p_.ws + WS_CTL), (volatile LAS unsigned*)(lds + LDS_XB));
#ifndef PROBE_SITE
#define PROBE_SITE -1
#endif
#define SITE(k) if constexpr (ALL || KIND == (k)) for (int rep_ = 0; rep_ < ((k) == PROBE_SITE ? 2 : 1); ++rep_) if (const Params& p = *params_fresh(); true)
#ifndef PROBE_XBAR
#define PROBE_XBAR 1
#endif
#define SEAM() do { if constexpr (ALL) { xcd_barrier(bar); if (PROBE_XBAR > 1) xcd_barrier(bar); if (PROBE_XBAR > 2) xcd_barrier(bar); } } while (0)
    const int G = gridDim.x, bid = blockIdx.x;
    SITE(0) {
        for (int u = bid; u < 4993; u += G) {
            if (u < 384) modp_unit(p, u, (LAS float*)lds);
            else if (u == 384) tables_unit(p);
            else if (u < 1473) h2_task(p, (u - 385) * 8 + (tid_fresh() >> 6));
            else if (u < 1537) w3p_unit(p, u - 1473);
            else if (u < 1793) rtab_unit(p, u - 1537);
            else cvt_dense_unit(p, u - 1793, (LAS float*)lds);
        }
        SEAM();
    }
    SITE(1) {
        for (int u = bid; u < 216; u += G) modr_unit(p, u);
        SchedFilt S{p.ws + WS_W3P, p.ws + WS_H2P}; EpiTaps E{(float*)(p.ws + WS_TAPS), (float*)(p.ws + WS_TAPSC)};
        pg8::gemm_phase<EpiTaps, SchedFilt, 0>(lds, 256, S, E);
        SEAM();
    }
#define TAIL_IDLE(nunits) (((nunits) % G) ? G - ((nunits) % G) : 0)
#define CVT_PER_GEMM 20
#pragma unroll 1
    for (int layer = ALL ? 0 : ph0; layer < (ALL ? NLAYER : ph0 + 1); ++layer) {
        const bool hyena = (layer & 1) == 0; const int jl = layer >> 1;
        const int nu1 = hyena ? 24 * 136 : 136 * 10, nu4 = (layer == NLAYER - 1 ? 128 : 136) * 8;
        const int idle1 = TAIL_IDLE(nu1), idle4 = TAIL_IDLE(nu4);
        int cv4 = idle4 * CVT_PER_GEMM, cv1 = idle1 * CVT_PER_GEMM; if (cv4 > CVT_MOE_UNITS / 2) cv4 = CVT_MOE_UNITS / 2; if (cv1 > CVT_MOE_UNITS / 2 - 1) cv1 = CVT_MOE_UNITS / 2 - 1;
        const int cvN0 = CVT_MOE_UNITS - cv1 - cv4, cvN1 = cvN0 + cv1;
        SITE(2) {
            n1_phase(p, layer, (h16*)(p.ws + ((!ALL && p.ph1) ? WS_UT : WS_XRES)));
            for (int rep2_ = 0; rep2_ < ((PROBE_SITE == 20 && layer > 0) ? 2 : 1); ++rep2_) {
            if (layer == 0) filt_fft_phase(p, lds);
            else { (void)0; } }
            SEAM();
        }
        SITE(3) {
#ifdef PROBE_CLK
            unsigned long long pc0_ = __builtin_readcyclecounter(), pr0_ = wall_clock64();
#endif
            if (hyena) { SchedPlain S{24, 136, D, p.ws + WS_WIN + (size_t)jl * D3 * D * 2, p.ws + WS_HBUF}; EpiH16 E{(h16*)(p.ws + WS_UT), TT, nullptr, 0};
                pg8::gemm_phase<EpiH16, SchedPlain, 0>(lds, D, S, E); }
            else { SchedQkv S{p.ws + WS_HBUF, p.ws + WS_WQKV + (size_t)jl * DQKV * D * 2}; EpiH16 E{(h16*)(p.ws + WS_QK), DQK, (h16*)(p.ws + WS_VT), TT};
                pg8::gemm_phase<EpiH16, SchedQkv, 0>(lds, D, S, E); }
#ifdef PROBE_CLK
            if (bid == 0 && threadIdx.x == 0) { const unsigned long long dc = __builtin_readcyclecounter() - pc0_, dr = wall_clock64() - pr0_; const unsigned long long spin = dc * 2500ull / (dr ? dr : 1ull);
                const unsigned long long t0 = wall_clock64(); while (wall_clock64() - t0 < spin) __builtin_amdgcn_s_sleep(8); }
#endif
            if (idle1 > 0 && bid >= G - idle1) { cvt_moe_share(p, layer, cvN0 + (bid - (G - idle1)), cvN1, idle1, (LAS float*)lds); }
            SEAM();
        }
        SITE(4) {
#ifdef PROBE_PAR
            for (int rep3_ = 0; rep3_ < (((layer & 1) == PROBE_PAR) ? 2 : 1); ++rep3_)
#endif
            { if (hyena) conv_phase(p, jl, lds, ALL ? 0 : p.ph1, layer, cvN0);
            else attn_phase(p, jl, layer != NLAYER - 1, lds, layer, cvN0); }
            SEAM();
        }
        SITE(5) {
            (void)0;
        }
        SITE(6) {
            EpiResid E{(h16*)(p.ws + WS_XRES), (const float*)(p.ws + WS_MODS), layer, (float*)(p.ws + WS_SSQ), (!ALL && p.ph1) ? (h16*)(p.ws + WS_YC) : (h16*)(p.ws + WS_XRES)};
            if (hyena) {
                SchedPlainAT S{layer == NLAYER - 1 ? 128 : 136, 8, D, p.ws + WS_ZT, p.ws + WS_WOUT + (size_t)jl * D * D * 2};
                pg8::gemm_phase<EpiResid, SchedPlainAT, 2>(lds, D, S, E, TT);
            } else {
                SchedPlain S{layer == NLAYER - 1 ? 128 : 136, 8, D, p.ws + WS_HBUF, p.ws + WS_WO + (size_t)jl * D * D * 2};
                pg8::gemm_phase<EpiResid, SchedPlain, 0>(lds, D, S, E);
            }
            if (idle4 > 0 && bid >= G - idle4) { cvt_moe_share(p, layer, cvN1 + (bid - (G - idle4)), CVT_MOE_UNITS, idle4, (LAS float*)lds); }
            SEAM();
        }
        SITE(7) { n2_phase(p, layer, lds, ALL ? 0 : p.ph1); SEAM(); }
        LAS int* tstart = (LAS int*)(lds + LDS_MISC); LAS int* texp = tstart + 80; LAS int* tcnt = texp + 352;
        SITE(8) {
            moe_table(tstart, texp, tcnt, (const int*)(p.ws + WS_CTL) + CTL_CNT + layer * NE);
            SchedMoe1 S{{tstart, texp, tcnt}, p.ws + WS_HBUF, p.ws + WS_W13, (const int*)(p.ws + WS_LIST)}; EpiMoe1 E{(h16*)(p.ws + WS_H1)};
            pg8::gemm_phase<EpiMoe1, SchedMoe1, 1>(lds, D, S, E);
            SEAM();
        }
        SITE(9) {
            moe_table(tstart, texp, tcnt, (const int*)(p.ws + WS_CTL) + CTL_CNT + layer * NE);
            SchedMoe2 S{{tstart, texp, tcnt}, p.ws + WS_H1, p.ws + WS_W2, (const int*)(p.ws + WS_LIST)}; EpiMoe2 E{(h16*)(p.ws + WS_YC), (const float*)(p.ws + WS_GATE), (const int*)(p.ws + WS_LIST)};
            pg8::gemm_phase<EpiMoe2, SchedMoe2, 0>(lds, DE, S, E);
            SEAM();
        }
    }
    SITE(10) final_phase(p);
#undef SITE
#undef SEAM
}

template <int KIND> static void launch_kind(const Params& p, int grid, hipStream_t stream) {
    static bool attr = false;
    if (!attr) { attr = true; if (hipFuncSetAttribute((const void*)hy_fwd<KIND>, hipFuncAttributeMaxDynamicSharedMemorySize, LDS_BYTES) != hipSuccess) fprintf(stderr, "kernel_launch: hipFuncSetAttribute failed (kind %d)\n", KIND); }
    hipLaunchKernelGGL(hy_fwd<KIND>, dim3(grid), dim3(512), LDS_BYTES, stream, p);
}

extern "C" void kernel_launch(void* const* d_in, const int* in_sizes, int n_in, void* d_out, int out_size, void* d_ws, size_t ws_size, hipStream_t stream) {
    static int grid = 0;
    if (!grid) {
        if (n_in != 29 || out_size != TL * D || ws_size < WS_END) { fprintf(stderr, "kernel_launch: unexpected problem (n_in %d, out %d, ws %zu < %zu)\n", n_in, out_size, ws_size, (size_t)WS_END); grid = -1; return; }
        int dev = 0, cus = 0;
        if (hipGetDevice(&dev) != hipSuccess || hipDeviceGetAttribute(&cus, hipDeviceAttributeMultiprocessorCount, dev) != hipSuccess) { grid = -1; return; }
        grid = cus;
    }
    if (grid <= 0) return;
    (void)hipMemsetAsync((char*)d_ws + WS_CTL, 0, CTL_BYTES, stream);
    Params p{};
    const float** pp = (const float**)&p;
    for (int i = 0; i < 29; ++i) pp[i] = (const float*)d_in[i];
    p.out = (float*)d_out; p.ws = (char*)d_ws;
#if MK_MULTI
    p.ph0 = 0; p.ph1 = 0;
    launch_kind<0>(p, grid, stream); launch_kind<1>(p, grid, stream);
#ifndef PROBE_KINDS
#define PROBE_KINDS 0
#endif
#ifndef PROBE_VAR
#define PROBE_VAR 0
#endif
#ifndef PROBE_LAYERS
#define PROBE_LAYERS 15
#endif
#define PKIND(k) ((PROBE_KINDS >> (k)) & 1)
#define PREP(k) ((PKIND(k) && ((PROBE_LAYERS >> layer) & 1)) ? 2 : 1)
    if (PKIND(0)) launch_kind<0>(p, grid, stream);
    if (PKIND(1)) launch_kind<1>(p, grid, stream);
    for (int layer = 0; layer < NLAYER; ++layer) { p.ph0 = layer;
        for (int r = 0; r < PREP(2); ++r) { p.ph1 = (PREP(2) == 2 && r == 0) ? 1 : 0; launch_kind<2>(p, grid, stream); p.ph1 = 0; }
        for (int r = 0; r < PREP(3); ++r) { p.ph1 = (PREP(3) == 2 && r == 0) ? PROBE_VAR : 0; launch_kind<3>(p, grid, stream); p.ph1 = 0; }
        for (int r = 0; r < PREP(4); ++r) { p.ph1 = (PREP(4) == 2 && r == 0) ? 1 : 0; launch_kind<4>(p, grid, stream); p.ph1 = 0; }
        if (PREP(6) == 2) { p.ph1 = 1; launch_kind<6>(p, grid, stream); p.ph1 = 0; }
        launch_kind<6>(p, grid, stream); launch_kind<7>(p, grid, stream);
        if (PREP(7) == 2) { p.ph1 = 1; launch_kind<7>(p, grid, stream); p.ph1 = 0; }
        for (int r = 0; r < PREP(8); ++r) launch_kind<8>(p, grid, stream);
        for (int r = 0; r < PREP(9); ++r) launch_kind<9>(p, grid, stream); }
    p.ph0 = 0; launch_kind<10>(p, grid, stream);
    if (PKIND(10)) launch_kind<10>(p, grid, stream);
#else
    p.ph0 = 0; p.ph1 = NPHASE;
    launch_kind<-1>(p, grid, stream);
#endif
}
```

```cpp
#include <hip/hip_runtime.h>
#include <cstdio>
#include <cstdint>

#define LAS __attribute__((address_space(3)))
typedef _Float16 h16;
typedef _Float16 f16x8 __attribute__((ext_vector_type(8)));
typedef _Float16 f16x4 __attribute__((ext_vector_type(4)));
typedef _Float16 f16x2 __attribute__((ext_vector_type(2)));
typedef float f32x2 __attribute__((ext_vector_type(2)));
typedef float f32x4 __attribute__((ext_vector_type(4)));
typedef float f32x16 __attribute__((ext_vector_type(16)));
typedef unsigned u32x2 __attribute__((ext_vector_type(2)));
typedef unsigned u32x4 __attribute__((ext_vector_type(4)));

constexpr int D = 2048, NB = 8, SEQ = 4096, CTXL = 256, TL = NB * SEQ, TC = NB * CTXL, TT = TL + TC;
constexpr int D3 = 3 * D, D6 = 6 * D, DQK = 2304, DQKV = 2560, NE = 64, DE = 384, DE2 = 768, NLAYER = 4;
constexpr int LCAP = TT;
constexpr int MOE_ROWS = 86016;
constexpr float EPS = 1e-6f;

constexpr size_t WS_CTL = 0;
constexpr size_t CTL_BYTES = 65536;
constexpr size_t WS_TW = WS_CTL + CTL_BYTES;
constexpr size_t WS_ROPE = WS_TW + 65536;
constexpr size_t WS_MODP = WS_ROPE + 8192;
constexpr size_t WS_MODS = WS_MODP + 16ull * 4 * 9 * 12288 * 4;
constexpr size_t WS_RTAB = WS_MODS + 4ull * 9 * 12288 * 4;
constexpr size_t RTAB_L = 64ull * 5 * 2 * 64 * 8 * 2;
constexpr size_t WS_RCST = WS_RTAB + 4 * RTAB_L;
constexpr size_t WS_H2P = WS_RCST + 16384;
constexpr size_t WS_W3P = WS_H2P + 2ull * 4352 * 256 * 2;
constexpr size_t WS_XRES = WS_W3P + 2ull * 8192 * 256 * 2;
constexpr size_t WS_HBUF = WS_XRES + (size_t)TT * D * 4;
constexpr size_t WS_UT = WS_HBUF + (size_t)TT * D * 2;
constexpr size_t UT_BYTES = (size_t)D3 * TT * 2;
constexpr size_t WS_TAPS = WS_UT;
constexpr size_t WS_TAPSC = WS_TAPS + 2ull * 8192 * 4096 * 4;
constexpr size_t WS_QK = WS_UT;
constexpr size_t WS_VT = WS_QK + (size_t)TT * DQK * 2;
constexpr size_t WS_ZT = WS_UT + UT_BYTES;
constexpr size_t WS_H1 = WS_ZT + (size_t)D * TT * 2;
constexpr size_t WS_YC = WS_H1 + (size_t)MOE_ROWS * DE * 2;
constexpr size_t WS_WIN = WS_YC + 2ull * TT * D * 2;
constexpr size_t WS_WOUT = WS_WIN + 2ull * D3 * D * 2;
constexpr size_t WS_WQKV = WS_WOUT + 2ull * D * D * 2;
constexpr size_t WS_WO = WS_WQKV + 2ull * DQKV * D * 2;
constexpr size_t WS_W13 = WS_WO + 2ull * D * D * 2;
constexpr size_t WS_W2 = WS_W13 + (size_t)NE * DE2 * D * 2;
constexpr size_t WS_KF = WS_W2 + (size_t)NE * D * DE * 2;
constexpr size_t WS_KFC = WS_KF + 2ull * 2 * 2048 * 65536;
constexpr size_t WS_LIST = WS_KFC + 2ull * 2 * 2048 * 4096;
constexpr size_t WS_GATE = WS_LIST + (size_t)NE * LCAP * 4;
constexpr size_t WS_SSQ = WS_GATE + (size_t)NE * LCAP * 4;
constexpr size_t WS_END = WS_SSQ + (size_t)TT * 32 * 4;
static_assert(WS_TAPSC + 2ull * 8192 * 256 * 4 <= WS_UT + UT_BYTES, "taps alias");
static_assert(WS_VT + 256ull * TT * 2 <= WS_UT + UT_BYTES, "qkv alias");

constexpr int CTL_CNT = 4096;

constexpr int LDS_BYTES = 147456;
constexpr int LDS_MISC = 139264;
constexpr int LDS_XB = LDS_BYTES - 16;

struct Params {
    const float *x, *c, *ctx, *c_ctx, *mod_w, *mod_b, *hy_w_in, *hy_conv_w, *hy_conv_b, *hy_f_w1, *hy_f_b1, *hy_f_freq1, *hy_f_w2, *hy_f_b2, *hy_f_freq2, *hy_f_w3,
        *hy_bias, *hy_w_out, *at_w_qkv, *at_sink, *at_w_o, *moe_wg, *moe_bg, *moe_we, *moe_be, *moe_w1, *moe_w3, *moe_w2, *final_gain;
    float* out; char* ws; int ph0, ph1;
};

__device__ __forceinline__ int tid_fresh() { int t = threadIdx.x; asm volatile("" : "+v"(t)); return t; }
__device__ __forceinline__ float bperm_f(float v, int srclane) { return __int_as_float(__builtin_amdgcn_ds_bpermute(srclane << 2, __float_as_int(v))); }
__device__ __forceinline__ float shx(float v, int mask) { return bperm_f(v, (tid_fresh() & 63) ^ mask); }
__device__ __forceinline__ const Params* params_fresh() { auto q = __builtin_amdgcn_kernarg_segment_ptr(); asm volatile("" : "+s"(q)); return (const Params*)q; }

#define XB_TMO      128
#define XB_XCNT(j)  (256  + 64 * (j))
#define XB_XSUB(j)  (1280 + 64 * (j))
#define XB_XGEN(j)  (2304 + 64 * (j))
#define XB_TOP      3328
#define XB_TOPGEN   3392
#define XCD_BAR_WORDS 3456
#define XB_SPIN_CAP (1u << 18)

__device__ __forceinline__ unsigned xb_ld(unsigned* p)              { return __hip_atomic_load(p, __ATOMIC_RELAXED, __HIP_MEMORY_SCOPE_AGENT); }
__device__ __forceinline__ unsigned xb_add(unsigned* p, unsigned v) { return __hip_atomic_fetch_add(p, v, __ATOMIC_RELAXED, __HIP_MEMORY_SCOPE_AGENT); }
__device__ __forceinline__ unsigned xb_xcc_id() { return (unsigned)__builtin_amdgcn_s_getreg((3 << 11) | 20) & 0xFu; }
#define XB_SPIN(cond, bar) do { unsigned _sp = 0; while (cond) { __builtin_amdgcn_s_sleep(1); \
    if ((++_sp & 255u) == 0u) { if (xb_ld(&(bar)[XB_TMO])) break; if (_sp > XB_SPIN_CAP) { atomicAdd(&(bar)[XB_TMO], 1u); break; } } } } while (0)

struct XcdBarrier { unsigned* bar; volatile LAS unsigned* st; };

__device__ __forceinline__ XcdBarrier xcd_barrier_post(unsigned* bar, volatile LAS unsigned* st) {
    XcdBarrier b; b.bar = bar; b.st = st;
    if (threadIdx.x == 0) (void)xb_add(&bar[XB_XCNT(xb_xcc_id())], 1u);
    return b;
}
__device__ __forceinline__ void xcd_barrier_complete(unsigned* bar, unsigned x, unsigned& nloc, unsigned& nx) {
    const unsigned G = gridDim.x * gridDim.y * gridDim.z;
    unsigned sum, cnt, mine, sp = 0u;
    for (;;) {
        sum = 0u; cnt = 0u; mine = 0u;
#pragma unroll
        for (unsigned j = 0; j < 16; ++j) { const unsigned c = xb_ld(&bar[XB_XCNT(j)]); sum += c; cnt += (c > 0u) ? 1u : 0u; mine = (j == x) ? c : mine; }
        if (sum == G) break;
        __builtin_amdgcn_s_sleep(1);
        if ((++sp & 255u) == 0u) { if (xb_ld(&bar[XB_TMO])) break; if (sp > XB_SPIN_CAP) { atomicAdd(&bar[XB_TMO], 1u); break; } }
    }
    nloc = mine > 0u ? mine : 1u; nx = cnt > 0u ? cnt : 1u;
}
__device__ __forceinline__ void xcd_barrier(const XcdBarrier& b) {
    asm volatile("s_waitcnt vmcnt(0)" ::: "memory");
    __syncthreads();
    if (threadIdx.x == 0) {
        unsigned* bar = b.bar; const unsigned bx = xb_xcc_id();
        __builtin_amdgcn_s_waitcnt(0);
        unsigned nloc = b.st[0], nx = b.st[1];
        if (nloc == 0u) { xcd_barrier_complete(bar, bx, nloc, nx); b.st[0] = nloc; b.st[1] = nx; }
        const unsigned old = xb_add(&bar[XB_XSUB(bx)], 1u);
        const unsigned gen = old / nloc;
        if (old + 1u == (gen + 1u) * nloc) {
            __builtin_amdgcn_fence(__ATOMIC_RELEASE, "agent");
            asm volatile("s_waitcnt vmcnt(0)" ::: "memory");
            const unsigned og = xb_add(&bar[XB_TOP], 1u);
            const unsigned tg = og / nx;
            if (og + 1u == (tg + 1u) * nx) xb_add(&bar[XB_TOPGEN], 1u);
            else XB_SPIN(xb_ld(&bar[XB_TOPGEN]) == tg, bar);
            __builtin_amdgcn_fence(__ATOMIC_ACQUIRE, "agent");
            xb_add(&bar[XB_XGEN(bx)], 1u);
            asm volatile("s_waitcnt vmcnt(0)" ::: "memory");
        } else {
            XB_SPIN(xb_ld(&bar[XB_XGEN(bx)]) == gen, bar);
            __builtin_amdgcn_fence(__ATOMIC_ACQUIRE, "agent");
            asm volatile("s_waitcnt vmcnt(0)" ::: "memory");
        }
    }
    __syncthreads();
}

namespace pg8 {
constexpr int BM = 256, BK = 64, HALF = 128, HTB = HALF * BK * 2, STAGE_BYTES = 8 * HTB;
__device__ __forceinline__ int lds_byte(int r, int c) { const int st = (r >> 4) * 2 + (c >> 5), rr = r & 15, cc = c & 31, ob = rr * 64 + cc * 2; return st * 1024 + (ob ^ (((ob >> 9) & 1) << 5)); }
__device__ __forceinline__ void stage_rc(int b, int& R, int& C) { const int st = b / 1024, sb = b % 1024, swz = sb ^ (((sb >> 9) & 1) << 5); R = (st >> 1) * 16 + swz / 64; C = (st & 1) * 32 + (swz % 64) / 2; }
__device__ __forceinline__ int perm32(int rho) { const int n = rho >> 4, i = rho & 15; return 8 * (i >> 2) + 4 * n + (i & 3); }

struct Unit {
    int pm, pn;
    int e, pos0, cnt;
    int kind;
    int half;
    const char* A; const char* B;
    const int* rows;
};

typedef short s16x4 __attribute__((ext_vector_type(4)));
template <class Epi, class Sched, int AMODE>
__device__ __forceinline__ void gemm_phase(LAS unsigned char* lds, const int K, const Sched& S, const Epi& E, const int ldat = 0) {
    constexpr bool GATHER = AMODE == 1, ATR = AMODE == 2;
    const int tid = tid_fresh(), wid = __builtin_amdgcn_readfirstlane(tid >> 6), lane = tid & 63, wr = wid >> 2, wc = wid & 3, fr = lane & 15, fq = lane >> 4;
    const int nt = K / BK;
    unsigned voffA[2], voffB[2]; int RA[2], CA[2];
#pragma unroll
    for (int i = 0; i < 2; ++i) { int R, C; stage_rc(tid * 16 + i * 8192, R, C); const int Rb = Epi::PERM ? ((R & ~31) + perm32(R & 31)) : R;
        voffA[i] = (unsigned)(R * K + C) * 2u; voffB[i] = (unsigned)(Rb * K + C) * 2u; RA[i] = R; CA[i] = C;
        if constexpr (ATR) { const int bb = tid * 16 + i * 8192, row = bb >> 8, pc = (bb >> 4) & 15, ch = pc ^ (((row & 3) << 2) | ((row >> 2) & 3)); voffA[i] = (unsigned)(row * ldat + 8 * ch) * 2u; } }
    const size_t kstep = (size_t)(BK * 2);
    const size_t hstep = (size_t)HALF * K * 2;
    const size_t kstepA = ATR ? (size_t)BK * ldat * 2 : kstep, hstepA = ATR ? (size_t)HALF * 2 : hstep;
    const unsigned ldsw = (unsigned)wid * 1024u;
    const int aoff = lds_byte(wr * 64 + fr, fq * 8), boff = lds_byte(wc * 32 + fr, fq * 8);
    int atr[4][2];
#pragma unroll
    for (int m = 0; m < 4; ++m)
#pragma unroll
        for (int bl = 0; bl < 2; ++bl) { const int xr = ((fr >> 2) << 2) | ((2 * fq + bl) & 3); atr[m][bl] = (int)(unsigned)(uintptr_t)lds + 256 * (8 * fq + (fr >> 2) + 4 * bl) + 16 * ((wr * 8 + 2 * m + ((fr & 3) >> 1)) ^ xr) + 8 * (fr & 1); }
    unsigned vgC[2][2], vgN[2][2];
#define PG8_ROWS(u, vg) do { if constexpr (GATHER) { _Pragma("unroll") for (int _h = 0; _h < 2; ++_h) _Pragma("unroll") for (int _i = 0; _i < 2; ++_i) { \
        const int _p = (u).pos0 + _h * HALF + RA[_i]; const int _tok = (_p < (u).cnt) ? ((u).rows[_h * HALF + RA[_i]] >> 1) : 0; \
        vg[_h][_i] = ((unsigned)_tok * (unsigned)K + (unsigned)CA[_i]) * 2u; } } } while (0)
#define PG8_SA(b, h) (((b) * 2 + (h)) * HTB)
#define PG8_SB(b, h) ((4 + (b) * 2 + (h)) * HTB)
#define PG8_STAGE_B(bufoff, gbase) do { _Pragma("unroll") for (int _i = 0; _i < 2; ++_i) \
        __builtin_amdgcn_global_load_lds((const unsigned*)((const char*)(gbase) + voffB[_i]), (LAS unsigned*)(lds + (bufoff) + ldsw + _i * 8192), 16, 0, 0); } while (0)
#define PG8_STAGE_A(bufoff, gbase, h, NEXT) do { _Pragma("unroll") for (int _i = 0; _i < 2; ++_i) { \
        const unsigned _vo = GATHER ? ((NEXT) ? vgN[h][_i] : vgC[h][_i]) : voffA[_i]; \
        __builtin_amdgcn_global_load_lds((const unsigned*)((const char*)(gbase) + (GATHER ? (size_t)0 : (size_t)(h) * hstepA) + _vo), (LAS unsigned*)(lds + (bufoff) + ldsw + _i * 8192), 16, 0, 0); } } while (0)
#define PG8_LDA(dst, b, h) do { if constexpr (!ATR) { _Pragma("unroll") for (int m = 0; m < 4; ++m) _Pragma("unroll") for (int k = 0; k < 2; ++k) dst[m][k] = *(const LAS f16x8*)(lds + PG8_SA(b, h) + aoff + m * 2048 + k * 1024); } \
        else { _Pragma("unroll") for (int m = 0; m < 4; ++m) _Pragma("unroll") for (int k = 0; k < 2; ++k) { s16x4 _lo, _hi; \
            asm volatile("ds_read_b64_tr_b16 %0, %1 offset:%2" : "=v"(_lo) : "v"(atr[m][0]), "i"(PG8_SA(b, h) + k * 8192) : "memory"); \
            asm volatile("ds_read_b64_tr_b16 %0, %1 offset:%2" : "=v"(_hi) : "v"(atr[m][1]), "i"(PG8_SA(b, h) + k * 8192) : "memory"); \
            const short __attribute__((ext_vector_type(8))) _v = {_lo[0], _lo[1], _lo[2], _lo[3], _hi[0], _hi[1], _hi[2], _hi[3]}; dst[m][k] = __builtin_bit_cast(f16x8, _v); } } } while (0)
#define PG8_PIN(At) do { if constexpr (ATR) asm volatile("" : "+v"(At[0][0]), "+v"(At[0][1]), "+v"(At[1][0]), "+v"(At[1][1]), "+v"(At[2][0]), "+v"(At[2][1]), "+v"(At[3][0]), "+v"(At[3][1])); } while (0)
#define PG8_LDB(dst, b, h) do { _Pragma("unroll") for (int n = 0; n < 2; ++n) _Pragma("unroll") for (int k = 0; k < 2; ++k) dst[n][k] = *(const LAS f16x8*)(lds + PG8_SB(b, h) + boff + n * 2048 + k * 1024); } while (0)
#define PG8_MMA(ai, bj, At, Bt) do { __builtin_amdgcn_s_setprio(1); _Pragma("unroll") for (int m = 0; m < 4; ++m) _Pragma("unroll") for (int n = 0; n < 2; ++n) _Pragma("unroll") for (int k = 0; k < 2; ++k) \
        acc[ai][bj][m][n] = __builtin_amdgcn_mfma_f32_16x16x32_f16(Bt[n][k], At[m][k], acc[ai][bj][m][n], 0, 0, 0); __builtin_amdgcn_s_setprio(0); } while (0)
#define PG8_WAIT_V(n) asm volatile("s_waitcnt vmcnt(" #n ")" ::: "memory")
#define PG8_WAIT_L(n) asm volatile("s_waitcnt lgkmcnt(" #n ")" ::: "memory")
#define PG8_BAR __builtin_amdgcn_s_barrier()
#define PG8_SCHED __builtin_amdgcn_sched_barrier(0)
    Unit cur, nxt; int ui = 0;
    if (!S.next(0, cur)) return;
    f32x4 acc[2][2][4][2];
#pragma unroll
    for (int a = 0; a < 2; ++a)
#pragma unroll
        for (int b = 0; b < 2; ++b)
#pragma unroll
            for (int m = 0; m < 4; ++m)
#pragma unroll
                for (int n = 0; n < 2; ++n) acc[a][b][m][n] = (f32x4){0.f, 0.f, 0.f, 0.f};
    f16x8 At[4][2], B0[2][2], B1[2][2];
    const char* cA = cur.A; const char* cB = cur.B;
    PG8_ROWS(cur, vgC);
#pragma unroll
    for (int _h = 0; _h < 2; ++_h)
#pragma unroll
        for (int _i = 0; _i < 2; ++_i) vgN[_h][_i] = GATHER ? vgC[_h][_i] : 0u;
    PG8_STAGE_B(PG8_SB(0, 0), cB); PG8_STAGE_B(PG8_SB(0, 1), cB + hstep); PG8_STAGE_A(PG8_SA(0, 0), cA, 0, false); PG8_STAGE_A(PG8_SA(0, 1), cA, 1, false);
    if (wr == 1) PG8_BAR;
    PG8_WAIT_V(2); PG8_BAR;
    PG8_STAGE_B(PG8_SB(1, 0), cB + kstep); PG8_STAGE_A(PG8_SA(1, 0), cA + kstepA, 0, false); PG8_STAGE_B(PG8_SB(1, 1), cB + hstep + kstep);
    PG8_WAIT_V(6); PG8_BAR;
    for (;;) {
        const bool has_next = S.next(ui + 1, nxt);
        const bool full = cur.half == 0;
        const char* nA = has_next ? nxt.A : cA; const char* nB = has_next ? nxt.B : cB;
        if (has_next) { PG8_ROWS(nxt, vgN); }
        typename Epi::Pre pre; E.prefetch(cur, wr, fr, pre);
#pragma unroll 1
        for (int t = 0; t < nt; t += 2) {
            const bool last = (t == nt - 2);
            const char* a1 = cA + (size_t)(t + 1) * kstepA;
            const char* a2 = last ? nA : cA + (size_t)(t + 2) * kstepA; const char* b2 = last ? nB : cB + (size_t)(t + 2) * kstep;
            const char* a3 = a2 + kstepA; const char* b3 = b2 + kstep;
            PG8_LDB(B0, 0, 0); PG8_LDB(B1, 0, 1); PG8_SCHED; PG8_LDA(At, 0, 0); PG8_STAGE_A(PG8_SA(1, 1), a1, 1, false);
            PG8_WAIT_V(8); PG8_WAIT_L(0); PG8_PIN(At); PG8_BAR; PG8_MMA(0, 0, At, B0); PG8_MMA(0, 1, At, B1); PG8_BAR; PG8_SCHED;
            PG8_LDA(At, 0, 1); PG8_STAGE_B(PG8_SB(0, 0), b2); PG8_STAGE_B(PG8_SB(0, 1), b2 + hstep); PG8_STAGE_A(PG8_SA(0, 0), a2, 0, last);
            PG8_WAIT_V(8); PG8_WAIT_L(0); PG8_PIN(At); PG8_BAR; if (full) { PG8_MMA(1, 0, At, B0); PG8_MMA(1, 1, At, B1); } PG8_BAR; PG8_SCHED;
            PG8_LDB(B0, 1, 0); PG8_LDB(B1, 1, 1); PG8_SCHED; PG8_LDA(At, 1, 0); PG8_STAGE_A(PG8_SA(0, 1), a2, 1, last);
            PG8_WAIT_V(8); PG8_WAIT_L(0); PG8_PIN(At); PG8_BAR; PG8_MMA(0, 0, At, B0); PG8_MMA(0, 1, At, B1); PG8_BAR; PG8_SCHED;
            PG8_LDA(At, 1, 1); PG8_STAGE_B(PG8_SB(1, 0), b3); PG8_STAGE_B(PG8_SB(1, 1), b3 + hstep); PG8_STAGE_A(PG8_SA(1, 0), a3, 0, last);
            PG8_WAIT_V(8); PG8_WAIT_L(0); PG8_PIN(At); PG8_BAR; if (full) { PG8_MMA(1, 0, At, B0); PG8_MMA(1, 1, At, B1); } PG8_BAR; PG8_SCHED;
        }
        if (wr == 0) PG8_BAR;
        E(acc, cur, wr, wc, fr, fq, pre);
        if (!has_next) break;
#pragma unroll
        for (int a = 0; a < 2; ++a)
#pragma unroll
            for (int b = 0; b < 2; ++b)
#pragma unroll
                for (int m = 0; m < 4; ++m)
#pragma unroll
                    for (int n = 0; n < 2; ++n) acc[a][b][m][n] = (f32x4){0.f, 0.f, 0.f, 0.f};
        cur = nxt; cA = nA; cB = nB; ++ui;
#pragma unroll
        for (int _h = 0; _h < 2; ++_h)
#pragma unroll
            for (int _i = 0; _i < 2; ++_i) vgC[_h][_i] = vgN[_h][_i];
        if (wr == 1) PG8_BAR;
    }
    PG8_WAIT_V(0);
    PG8_BAR;
#undef PG8_ROWS
#undef PG8_SA
#undef PG8_SB
#undef PG8_STAGE_A
#undef PG8_STAGE_B
#undef PG8_LDA
#undef PG8_LDB
#undef PG8_PIN
#undef PG8_MMA
#undef PG8_WAIT_V
#undef PG8_WAIT_L
#undef PG8_BAR
#undef PG8_SCHED
}
}

using pg8::Unit;
__device__ __forceinline__ f16x8 pack8(const f32x4 a, const f32x4 b) {
    f16x8 w; w[0] = (h16)a[0]; w[1] = (h16)a[1]; w[2] = (h16)a[2]; w[3] = (h16)a[3]; w[4] = (h16)b[0]; w[5] = (h16)b[1]; w[6] = (h16)b[2]; w[7] = (h16)b[3]; return w;
}
struct EpiH16 {
    static constexpr bool PERM = true;
    h16* O0; int ld0; h16* O1; int ld1;
    struct Pre {}; __device__ __forceinline__ void prefetch(const Unit&, int, int, Pre&) const {}
    __device__ __forceinline__ void operator()(const f32x4 (&acc)[2][2][4][2], const Unit& u, int wr, int wc, int fr, int fq, const Pre&) const {
        h16* base = u.kind ? O1 : O0; const int ld = u.kind ? ld1 : ld0;
        const int row0 = u.pm * 256 + wr * 64 + fr, col0 = u.pn * 256 + wc * 32 + 8 * fq;
#pragma unroll
        for (int ai = 0; ai < 2; ++ai)
#pragma unroll
            for (int m = 0; m < 4; ++m) { h16* rowp = base + (size_t)(row0 + ai * 128 + m * 16) * ld + col0;
#pragma unroll
                for (int bj = 0; bj < 2; ++bj) __builtin_nontemporal_store(pack8(acc[ai][bj][m][0], acc[ai][bj][m][1]), (f16x8*)(rowp + bj * 128)); }
    }
};
struct EpiTaps {
    static constexpr bool PERM = false;
    float* T0; float* T1;
    struct Pre {}; __device__ __forceinline__ void prefetch(const Unit&, int, int, Pre&) const {}
    __device__ __forceinline__ void operator()(const f32x4 (&acc)[2][2][4][2], const Unit& u, int wr, int wc, int fr, int fq, const Pre&) const {
        const int j = u.kind >> 1, v = u.kind & 1; const int ld = v ? 256 : 4096;
        float* base = v ? (T1 + (size_t)j * 8192 * 256) : (T0 + (size_t)j * 8192 * 4096);
        const int row0 = u.pm * 256 + wr * 64 + fr, col0 = u.pn * 256 + wc * 32 + 4 * fq;
#pragma unroll
        for (int ai = 0; ai < 2; ++ai)
#pragma unroll
            for (int m = 0; m < 4; ++m) { float* rowp = base + (size_t)(row0 + ai * 128 + m * 16) * ld + col0;
#pragma unroll
                for (int bj = 0; bj < 2; ++bj)
#pragma unroll
                    for (int n = 0; n < 2; ++n) *(f32x4*)(rowp + bj * 128 + n * 16) = acc[ai][bj][m][n]; }
    }
};
struct EpiResid {
    static constexpr bool PERM = true;
    h16* X; const float* mods; int layer; float* SSQ; h16* XO;
    struct Pre {}; __device__ __forceinline__ void prefetch(const Unit&, int, int, Pre&) const {}
    __device__ __forceinline__ void operator()(const f32x4 (&acc)[2][2][4][2], const Unit& u, int wr, int wc, int fr, int fq, const Pre&) const {
        const int r0 = u.pm * 256; const int b = r0 < TL ? (r0 >> 12) : 8;
        const float* g = mods + ((size_t)(layer * 9 + b) * 6 + 2) * D;
        const int row0 = r0 + wr * 64 + fr, col0 = u.pn * 256 + wc * 32 + 8 * fq;
        f32x4 gv[2][2];
#pragma unroll
        for (int bj = 0; bj < 2; ++bj)
#pragma unroll
            for (int n = 0; n < 2; ++n) gv[bj][n] = *(const f32x4*)(g + col0 + bj * 128 + n * 4);
#pragma unroll
        for (int ai = 0; ai < 2; ++ai)
#pragma unroll
            for (int m = 0; m < 4; ++m) { const int row = row0 + ai * 128 + m * 16; const h16* rowp = X + (size_t)row * D + col0; h16* rowo = XO + (size_t)row * D + col0; float sq = 0.f;
#pragma unroll
                for (int bj = 0; bj < 2; ++bj) { const f16x8 xv = *(const f16x8*)(rowp + bj * 128); f32x4 v0, v1;
#pragma unroll
                    for (int i = 0; i < 4; ++i) { v0[i] = (float)xv[i] + gv[bj][0][i] * acc[ai][bj][m][0][i]; v1[i] = (float)xv[4 + i] + gv[bj][1][i] * acc[ai][bj][m][1][i]; }
                    const f16x8 w = pack8(v0, v1); *(f16x8*)(rowo + bj * 128) = w;
#pragma unroll
                    for (int i = 0; i < 8; ++i) { const float t = (float)w[i]; sq += t * t; } }
                sq += shx(sq, 16); sq += shx(sq, 32);
                if (fq == 0) SSQ[(size_t)row * 32 + u.pn * 4 + wc] = sq; }
    }
};
struct EpiMoe1 {
    static constexpr bool PERM = true;
    h16* H1;
    struct Pre {}; __device__ __forceinline__ void prefetch(const Unit&, int, int, Pre&) const {}
    __device__ __forceinline__ void operator()(const f32x4 (&acc)[2][2][4][2], const Unit& u, int wr, int wc, int fr, int fq, const Pre&) const {
        const int row0 = u.pm * 256 + wr * 64 + fr, col0 = u.pn * 128 + wc * 16 + 4 * fq;
#pragma unroll
        for (int ai = 0; ai < 2; ++ai)
#pragma unroll
            for (int m = 0; m < 4; ++m) { if (ai == 1 && u.half) continue; h16* rowp = H1 + (size_t)(row0 + ai * 128 + m * 16) * DE + col0;
#pragma unroll
                for (int bj = 0; bj < 2; ++bj) { const f32x4 a = acc[ai][bj][m][0], b = acc[ai][bj][m][1]; f16x4 w;
#pragma unroll
                    for (int i = 0; i < 4; ++i) { const float s = a[i] / (1.0f + __expf(-a[i])); w[i] = (h16)(s * b[i]); }
                    *(f16x4*)(rowp + bj * 64) = w; } }
    }
};
struct EpiMoe2 {
    static constexpr bool PERM = true;
    h16* YC; const float* gslot;
    struct Pre { int av[2][4]; float gv[2][4]; };
    __device__ __forceinline__ void prefetch(const Unit& u, int wr, int fr, Pre& q) const {
        const float* grow = gslot + ((const char*)u.rows - (const char*)listbase) / 4;
#pragma unroll
        for (int ai = 0; ai < 2; ++ai)
#pragma unroll
            for (int m = 0; m < 4; ++m) { const int r = ai * 128 + wr * 64 + m * 16 + fr; const bool ok = u.pos0 + r < u.cnt; q.av[ai][m] = ok ? u.rows[r] : -1; q.gv[ai][m] = ok ? grow[r] : 0.f; }
    }
    __device__ __forceinline__ void operator()(const f32x4 (&acc)[2][2][4][2], const Unit& u, int wr, int wc, int fr, int fq, const Pre& q) const {
        const int col0 = u.pn * 256 + wc * 32 + 8 * fq;
#pragma unroll
        for (int ai = 0; ai < 2; ++ai)
#pragma unroll
            for (int m = 0; m < 4; ++m) { if (q.av[ai][m] >= 0) { const float g = q.gv[ai][m]; h16* rowp = YC + (size_t)q.av[ai][m] * D + col0;
#pragma unroll
                    for (int bj = 0; bj < 2; ++bj) *(f16x8*)(rowp + bj * 128) = pack8(acc[ai][bj][m][0] * g, acc[ai][bj][m][1] * g); } }
    }
    const int* listbase;
};

__device__ __forceinline__ void order_tile(int wgid, int nM, int nN, int& pm, int& pn) {
    const int nwg = nM * nN; { const int q = nwg / 8, r = nwg % 8, xcd = wgid % 8, off = wgid / 8; wgid = (xcd < r ? xcd * (q + 1) : r * (q + 1) + (xcd - r) * q) + off; }
    const int nig = 8 * nN, gid = wgid / nig, fm = gid * 8, gsz = (nM - fm) < 8 ? (nM - fm) : 8;
    pm = fm + ((wgid % nig) % gsz); pn = (wgid % nig) / gsz;
}
struct SchedPlain {
    int nM, nN, K; const char* A; const char* B;
    __device__ __forceinline__ bool next(int i, Unit& u) const {
        const long L = (long)i * gridDim.x + blockIdx.x; if (L >= (long)nM * nN) return false;
        order_tile((int)L, nM, nN, u.pm, u.pn); u.kind = 0; u.half = 0; u.e = 0; u.pos0 = 0; u.cnt = 0; u.rows = nullptr;
        u.A = A + (size_t)u.pm * 256 * K * 2; u.B = B + (size_t)u.pn * 256 * K * 2; return true;
    }
};
struct SchedPlainAT {
    int nM, nN, K; const char* At; const char* B;
    __device__ __forceinline__ bool next(int i, Unit& u) const {
        const long L = (long)i * gridDim.x + blockIdx.x; if (L >= (long)nM * nN) return false;
        order_tile((int)L, nM, nN, u.pm, u.pn); u.kind = 0; u.half = 0; u.e = 0; u.pos0 = 0; u.cnt = 0; u.rows = nullptr;
        u.A = At + (size_t)u.pm * 256 * 2; u.B = B + (size_t)u.pn * 256 * K * 2; return true;
    }
};
struct SchedQkv {
    const char* H; const char* W;
    __device__ __forceinline__ bool next(int i, Unit& u) const {
        const long L = (long)i * gridDim.x + blockIdx.x; const int nA = 136 * 9; if (L >= nA + 136) return false;
        u.e = 0; u.half = 0; u.pos0 = 0; u.cnt = 0; u.rows = nullptr;
        if (L < nA) { order_tile((int)L, 136, 9, u.pm, u.pn); u.kind = 0; u.A = H + (size_t)u.pm * 256 * D * 2; u.B = W + (size_t)u.pn * 256 * D * 2; }
        else { u.pm = 0; u.pn = (int)L - nA; u.kind = 1; u.A = W + (size_t)DQK * D * 2; u.B = H + (size_t)u.pn * 256 * D * 2; }
        return true;
    }
};
struct SchedFilt {
    const char* W3P; const char* H2P;
    __device__ __forceinline__ bool next(int i, Unit& u) const {
        const long L = (long)i * gridDim.x + blockIdx.x; if (L >= 2 * 544) return false;
        const int j = (int)L / 544, r = (int)L % 544; u.e = 0; u.half = 0; u.pos0 = 0; u.cnt = 0; u.rows = nullptr;
        int v; if (r < 512) { v = 0; u.pm = r >> 4; u.pn = r & 15; } else { v = 1; u.pm = r - 512; u.pn = 0; }
        u.kind = 2 * j + v;
        u.A = W3P + ((size_t)j * 8192 + (size_t)u.pm * 256) * 256 * 2;
        u.B = H2P + ((size_t)j * 4352 + (v ? 4096 : 0) + (size_t)u.pn * 256) * 256 * 2;
        return true;
    }
};
struct MoeTab { const LAS int* tstart; const LAS int* texp; const LAS int* cnt; };
struct SchedMoe1 {
    MoeTab tb; const char* H; const char* W13; const int* list;
    __device__ __forceinline__ bool next(int i, Unit& u) const {
        const long L = (long)i * gridDim.x + blockIdx.x; const int ntile = __builtin_amdgcn_readfirstlane(tb.tstart[NE]); if (L >= (long)ntile * 3) return false;
        int rt; order_tile((int)L, ntile, 3, rt, u.pn); u.pm = rt; u.kind = 0;
        const int e = __builtin_amdgcn_readfirstlane(tb.texp[rt]); u.e = e; u.pos0 = (rt - __builtin_amdgcn_readfirstlane(tb.tstart[e])) * 256; u.cnt = __builtin_amdgcn_readfirstlane(tb.cnt[e]); u.half = (u.cnt - u.pos0 <= 128) ? 1 : 0;
        u.rows = list + (size_t)e * LCAP + u.pos0; u.A = H; u.B = W13 + ((size_t)e * DE2 + (size_t)u.pn * 256) * D * 2; return true;
    }
};
struct SchedMoe2 {
    MoeTab tb; const char* H1; const char* W2; const int* list;
    __device__ __forceinline__ bool next(int i, Unit& u) const {
        const long L = (long)i * gridDim.x + blockIdx.x; const int ntile = __builtin_amdgcn_readfirstlane(tb.tstart[NE]); if (L >= (long)ntile * 8) return false;
        int rt; order_tile((int)L, ntile, 8, rt, u.pn); u.pm = rt; u.kind = 0;
        const int e = __builtin_amdgcn_readfirstlane(tb.texp[rt]); u.e = e; u.pos0 = (rt - __builtin_amdgcn_readfirstlane(tb.tstart[e])) * 256; u.cnt = __builtin_amdgcn_readfirstlane(tb.cnt[e]); u.half = (u.cnt - u.pos0 <= 128) ? 1 : 0;
        u.rows = list + (size_t)e * LCAP + u.pos0; u.A = H1 + (size_t)rt * 256 * DE * 2; u.B = W2 + ((size_t)e * D + (size_t)u.pn * 256) * DE * 2; return true;
    }
};
__device__ __forceinline__ void moe_table(LAS int* tstart, LAS int* texp, LAS int* cnt, const int* counters) {
    const int t = tid_fresh();
    if (t < NE) cnt[t] = counters[t];
    __syncthreads();
    if (t <= NE) { int s = 0; for (int e = 0; e < t; ++e) s += (cnt[e] + 255) >> 8; tstart[t] = s; }
    __syncthreads();
    if (t < NE) { const int s0 = tstart[t], s1 = tstart[t + 1]; for (int q = s0; q < s1; ++q) texp[q] = t; }
    __syncthreads();
}

__device__ __forceinline__ float wave_sum(float v) {
#pragma unroll
    for (int o = 32; o >= 1; o >>= 1) v += shx(v, o);
    return v;
}
__device__ __forceinline__ float silu_f(float x) { return x / (1.0f + expf(-x)); }
__device__ __forceinline__ int batch_of_row(int r) { return r < TL ? (r >> 12) : 8; }

__device__ __forceinline__ void modp_unit(const Params& p, int unit, LAS float* sl) {
    const int layer = unit / 96, rem = unit % 96, ks = rem / 6, cc = rem % 6, tid = tid_fresh();
    for (int i = tid; i < 9 * 128; i += 512) { const int cnd = i >> 7, k = ks * 128 + (i & 127); const float v = cnd < 8 ? p.c[cnd * D + k] : p.c_ctx[k]; sl[i] = silu_f(v); }
    __syncthreads();
    f32x4 acc[9];
#pragma unroll
    for (int q = 0; q < 9; ++q) acc[q] = (f32x4){0.f, 0.f, 0.f, 0.f};
    const float* w = p.mod_w + ((size_t)layer * D + (size_t)ks * 128) * D6 + cc * 2048 + tid * 4;
#pragma unroll 4
    for (int k = 0; k < 128; ++k) { const f32x4 wv = *(const f32x4*)(w + (size_t)k * D6);
#pragma unroll
        for (int q = 0; q < 9; ++q) acc[q] += wv * sl[q * 128 + k]; }
    float* outp = (float*)(p.ws + WS_MODP) + ((size_t)(ks * 4 + layer) * 9) * D6 + cc * 2048 + tid * 4;
#pragma unroll
    for (int q = 0; q < 9; ++q) *(f32x4*)(outp + (size_t)q * D6) = acc[q];
    __syncthreads();
}
__device__ __forceinline__ void modr_unit(const Params& p, int unit) {
    const size_t idx = (size_t)unit * 2048 + tid_fresh() * 4; const int layer = (int)(idx / (9 * D6)), col = (int)(idx % D6);
    f32x4 s = *(const f32x4*)(p.mod_b + (size_t)layer * D6 + col);
    const float* pp = (const float*)(p.ws + WS_MODP) + idx;
#pragma unroll
    for (int ks = 0; ks < 16; ++ks) s += *(const f32x4*)(pp + (size_t)ks * 4 * 9 * D6);
    *(f32x4*)((float*)(p.ws + WS_MODS) + idx) = s;
}
__device__ __forceinline__ void tables_unit(const Params& p) {
    f32x2* tw = (f32x2*)(p.ws + WS_TW);
    for (int m = tid_fresh(); m < 8192; m += 512) { double s, c; sincospi(-(double)m / 4096.0, &s, &c); tw[m] = (f32x2){(float)c, (float)s}; }
    float* rc = (float*)(p.ws + WS_ROPE);
    for (int i = tid_fresh(); i < 1024; i += 512) { const int pos = i >> 4, q = i & 15; const float inv = powf(10000.0f, -(float)q / 16.0f); const float ang = (float)pos * inv;
        rc[i] = cosf(ang); rc[1024 + i] = sinf(ang); }
}
__device__ __forceinline__ void h2_task(const Params& p, int task) {
    const int lane = tid_fresh() & 63; const int j = task / 4352, r = task % 4352; const int v = r >= 4096, t = v ? r - 4096 : r; const int Lv = v ? 256 : 4096;
    const float tl = (float)t / (float)(Lv - 1);
    const float omega = (float)(2.0 * 3.14159265358979323846 / (double)Lv) * (float)t;
    float feat = 0.f;
    if (lane == 0) feat = tl;
    else if (lane <= 32) { const int bi = (lane - 1) & 15; const float band = 1e-4f + (float)bi * ((15.0f - 1e-4f) / 15.0f); const float a = band * omega; feat = lane <= 16 ? cosf(a) : -sinf(a); }
    const float* w1 = p.hy_f_w1 + (size_t)j * 33 * 64; const float* w2 = p.hy_f_w2 + (size_t)j * 64 * 64;
    float s = p.hy_f_b1[j * 64 + lane];
    for (int f = 0; f < 33; ++f) s += bperm_f(feat, f) * w1[f * 64 + lane];
    const float h1 = sinf(p.hy_f_freq1[j * 64 + lane] * s);
    float s2 = p.hy_f_b2[j * 64 + lane];
    for (int m = 0; m < 64; ++m) s2 += bperm_f(h1, m) * w2[m * 64 + lane];
    const float h2 = sinf(p.hy_f_freq2[j * 64 + lane] * s2);
    const h16 hi = (h16)h2; const h16 lo = (h16)(h2 - (float)hi);
    h16* row = (h16*)(p.ws + WS_H2P) + ((size_t)j * 4352 + r) * 256;
    row[lane] = hi; row[64 + lane] = hi; row[128 + lane] = lo; row[192 + lane] = lo;
}
__device__ __forceinline__ void w3p_unit(const Params& p, int unit) {
    const int j = unit >> 5, c0 = (unit & 31) * 256; const float* w3 = p.hy_f_w3 + (size_t)j * 64 * 8192; h16* dst = (h16*)(p.ws + WS_W3P) + (size_t)j * 8192 * 256;
    for (int i = tid_fresh(); i < 64 * 256; i += 512) { const int m = i >> 8, col = c0 + (i & 255); const float w = w3[(size_t)m * 8192 + col];
        const h16 hi = (h16)w; const h16 lo = (h16)(w - (float)hi); h16* row = dst + (size_t)col * 256; row[m] = hi; row[64 + m] = lo; row[128 + m] = hi; row[192 + m] = lo; }
}
__device__ __forceinline__ void rtab_unit(const Params& p, int unit) {
    const int layer = unit >> 6, c = unit & 63; h16* dst = (h16*)(p.ws + WS_RTAB + (size_t)layer * RTAB_L) + (size_t)c * 5 * 2 * 64 * 8;
    for (int i = tid_fresh(); i < 5 * 2 * 64 * 8; i += 512) { const int jj = i & 7, lane = (i >> 3) & 63, hl = (i >> 9) & 1, ct = i >> 10;
        const int k = 32 * c + 8 * (lane >> 4) + jj, col = 16 * ct + (lane & 15);
        float w = 0.f; if (col < 8) w = p.moe_wg[((size_t)layer * D + k) * 8 + col]; else if (col < 72) w = p.moe_we[((size_t)layer * D + k) * 64 + (col - 8)];
        w *= 256.0f; const h16 hi = (h16)w; const h16 lo = (h16)(w - (float)hi); dst[i] = hl ? lo : hi; }
}
template <int NW>
__device__ __forceinline__ void cvt_tile(const float* src, int ldn, int k0, int n0, h16* dst, int ldk, int mode, LAS float* T) {
    constexpr int P = NW + 1; const int tid = tid_fresh();
#pragma unroll
    for (int ps = 0; ps < 64 * NW / 4 / 512; ++ps) { const int idx = ps * 512 + tid, k = idx / (NW / 4), n4 = idx % (NW / 4);
        const f32x4 v = *(const f32x4*)(src + (size_t)(k0 + k) * ldn + n0 + 4 * n4); LAS float* q = T + k * P + 4 * n4; q[0] = v[0]; q[1] = v[1]; q[2] = v[2]; q[3] = v[3]; }
    __syncthreads();
#pragma unroll
    for (int ps = 0; ps < NW * 8 / 512; ++ps) { const int item = ps * 512 + tid, kc = item & 7, n = item >> 3; f16x8 w;
#pragma unroll
        for (int i = 0; i < 8; ++i) w[i] = (h16)T[(8 * kc + i) * P + n];
        const int ng = n0 + n; const int row = mode == 0 ? ng : (8 * (ng >> 2) + (ng & 3) + (mode == 2 ? 4 : 0));
        *(f16x8*)(dst + (size_t)row * ldk + k0 + 8 * kc) = w; }
    __syncthreads();
}
__device__ __forceinline__ void cvt_dense_unit(const Params& p, int unit, LAS float* T) {
    const float* src; h16* dst; int nt, N;
    if (unit < 1536) { src = p.hy_w_in; dst = (h16*)(p.ws + WS_WIN); nt = 24; N = D3; }
    else if (unit < 2048) { unit -= 1536; src = p.hy_w_out; dst = (h16*)(p.ws + WS_WOUT); nt = 8; N = D; }
    else if (unit < 2688) { unit -= 2048; src = p.at_w_qkv; dst = (h16*)(p.ws + WS_WQKV); nt = 10; N = DQKV; }
    else { unit -= 2688; src = p.at_w_o; dst = (h16*)(p.ws + WS_WO); nt = 8; N = D; }
    const int j = unit / (32 * nt), r = unit % (32 * nt), kt = r / nt, ntile = r % nt;
    cvt_tile<256>(src + (size_t)j * D * N, N, kt * 64, ntile * 256, dst + (size_t)j * N * D, D, 0, T);
}
constexpr int CVT_DENSE_UNITS = 3200;
__device__ __forceinline__ void cvt_moe_unit(const Params& p, int layer, int unit, LAS float* T) {
    if (unit < 12288) { const int which = unit >= 6144; if (which) unit -= 6144; const int e = unit / 96, r = unit % 96, kt = r / 3, ntile = r % 3;
        const float* src = (which ? p.moe_w3 : p.moe_w1) + ((size_t)layer * NE + e) * D * DE;
        cvt_tile<128>(src, DE, kt * 64, ntile * 128, (h16*)(p.ws + WS_W13) + (size_t)e * DE2 * D, D, which ? 2 : 1, T); }
    else { unit -= 12288; const int e = unit / 48, r = unit % 48, kt = r / 8, ntile = r % 8;
        const float* src = p.moe_w2 + ((size_t)layer * NE + e) * DE * D;
        cvt_tile<256>(src, D, kt * 64, ntile * 256, (h16*)(p.ws + WS_W2) + (size_t)e * D * DE, DE, 0, T); }
}
constexpr int CVT_MOE_UNITS = 15360;
struct CvtD { const float* src; h16* dst; int mode; };
__device__ __forceinline__ CvtD cvt13_desc(const Params& p, int layer, int unit) {
    const int which = unit >= 6144; if (which) unit -= 6144; const int e = unit / 96, r = unit % 96, kt = r / 3, ntile = r % 3;
    CvtD d; d.src = (which ? p.moe_w3 : p.moe_w1) + ((size_t)layer * NE + e) * D * DE + (size_t)(kt * 64) * DE + ntile * 128;
    d.dst = (h16*)(p.ws + WS_W13) + (size_t)e * DE2 * D + kt * 64; d.mode = (which ? 4 : 0) + 8 * (256 * ntile); return d;
}
__device__ __forceinline__ void cvt13_load(const CvtD& d, f32x4 (&v)[4], int tid) {
#pragma unroll
    for (int ps = 0; ps < 4; ++ps) { const int idx = ps * 512 + tid, k = idx >> 5, n4 = idx & 31; v[ps] = *(const f32x4*)(d.src + (size_t)k * DE + 4 * n4); }
}
__device__ __forceinline__ void cvt13_store(const CvtD& d, const f32x4 (&v)[4], LAS float* T, int tid) {
    constexpr int P = 129;
#pragma unroll
    for (int ps = 0; ps < 4; ++ps) { const int idx = ps * 512 + tid, k = idx >> 5, n4 = idx & 31; LAS float* q = T + k * P + 4 * n4; q[0] = v[ps][0]; q[1] = v[ps][1]; q[2] = v[ps][2]; q[3] = v[ps][3]; }
    __syncthreads();
    const int w3off = d.mode & 7, rg0 = d.mode >> 3;
#pragma unroll
    for (int ps = 0; ps < 2; ++ps) { const int item = ps * 512 + tid, kc = item & 7, n = item >> 3; f16x8 w;
#pragma unroll
        for (int i = 0; i < 8; ++i) w[i] = (h16)T[(8 * kc + i) * P + n];
        const int row = rg0 + 8 * (n >> 2) + (n & 3) + w3off;
        *(f16x8*)(d.dst + (size_t)row * D + 8 * kc) = w; }
    __syncthreads();
}
__device__ __forceinline__ void cvt_moe_share(const Params& p, int layer, int u0, int n, int stride, LAS float* T) {
    const int tid = tid_fresh(); const int n13 = n < 12288 ? n : 12288;
    int u = u0;
    if (u < n13) {
        CvtD dA = cvt13_desc(p, layer, u), dB = dA, dC = dA; f32x4 vA[4], vB[4], vC[4];
        cvt13_load(dA, vA, tid);
        if (u + stride < n13) { dB = cvt13_desc(p, layer, u + stride); cvt13_load(dB, vB, tid); }
        for (;;) {
            if (u + 2 * stride < n13) { dC = cvt13_desc(p, layer, u + 2 * stride); cvt13_load(dC, vC, tid); }
            cvt13_store(dA, vA, T, tid); u += stride; if (u >= n13) break;
            if (u + 2 * stride < n13) { dA = cvt13_desc(p, layer, u + 2 * stride); cvt13_load(dA, vA, tid); }
            cvt13_store(dB, vB, T, tid); u += stride; if (u >= n13) break;
            if (u + 2 * stride < n13) { dB = cvt13_desc(p, layer, u + 2 * stride); cvt13_load(dB, vB, tid); }
            cvt13_store(dC, vC, T, tid); u += stride; if (u >= n13) break;
        }
    }
    for (; u < n; u += stride) cvt_moe_unit(p, layer, u, T);
}

template <int NR, bool FINAL>
__device__ __forceinline__ void n1_rows(const Params& p, int layer, int r0, int rstride, int lane, h16* xout) {
    const h16* xres = (const h16*)(p.ws + WS_XRES); h16* hb = (h16*)(p.ws + WS_HBUF); const h16* yc = (const h16*)(p.ws + WS_YC); const float* mods = (const float*)(p.ws + WS_MODS);
    f32x4 v[NR][8]; f16x4 xh[NR][8], ya[NR][8], yb[NR][8];
    const bool comb = FINAL || layer > 0; const int lprev = FINAL ? 3 : layer - 1;
#pragma unroll
    for (int q = 0; q < NR; ++q) { const int r = r0 + q * rstride;
        if (!comb) { const float* src = r < TL ? p.x + (size_t)r * D : p.ctx + (size_t)(r - TL) * D;
#pragma unroll
            for (int c = 0; c < 8; ++c) v[q][c] = *(const f32x4*)(src + c * 256 + lane * 4); }
        else { const h16* src = xres + (size_t)r * D; const h16* y0 = yc + (size_t)(2 * r) * D; const h16* y1 = y0 + D;
#pragma unroll
            for (int c = 0; c < 8; ++c) { xh[q][c] = *(const f16x4*)(src + c * 256 + lane * 4); ya[q][c] = *(const f16x4*)(y0 + c * 256 + lane * 4); yb[q][c] = *(const f16x4*)(y1 + c * 256 + lane * 4); } } }
#pragma unroll
    for (int q = 0; q < NR; ++q) { const int r = r0 + q * rstride; const int b = batch_of_row(r);
        if (comb) { const float* g2 = mods + ((size_t)(lprev * 9 + b) * 6 + 5) * D;
#pragma unroll
            for (int c = 0; c < 8; ++c) { const f32x4 g = *(const f32x4*)(g2 + c * 256 + lane * 4);
#pragma unroll
                for (int i = 0; i < 4; ++i) v[q][c][i] = (float)xh[q][c][i] + g[i] * ((float)ya[q][c][i] + (float)yb[q][c][i]); } }
        float ss = 0.f;
#pragma unroll
        for (int c = 0; c < 8; ++c) { if (!FINAL) { f16x4 w; w[0] = (h16)v[q][c][0]; w[1] = (h16)v[q][c][1]; w[2] = (h16)v[q][c][2]; w[3] = (h16)v[q][c][3]; *(f16x4*)(xout + (size_t)r * D + c * 256 + lane * 4) = w; } ss += v[q][c][0] * v[q][c][0] + v[q][c][1] * v[q][c][1] + v[q][c][2] * v[q][c][2] + v[q][c][3] * v[q][c][3]; }
        ss = wave_sum(ss); const float rs = 1.0f / sqrtf(ss * (1.0f / D) + EPS);
        if (FINAL) {
#pragma unroll
            for (int c = 0; c < 8; ++c) { const int col = c * 256 + lane * 4; const f32x4 g = *(const f32x4*)(p.final_gain + col); *(f32x4*)(p.out + (size_t)r * D + col) = v[q][c] * rs * g; }
        } else {
            const float* sh = mods + ((size_t)(layer * 9 + b) * 6 + 0) * D; const float* sc = sh + D;
#pragma unroll
            for (int c = 0; c < 8; ++c) { const int col = c * 256 + lane * 4; const f32x4 s0 = *(const f32x4*)(sh + col), s1 = *(const f32x4*)(sc + col); f16x4 w;
#pragma unroll
                for (int i = 0; i < 4; ++i) w[i] = (h16)(v[q][c][i] * rs * (1.0f + s1[i]) + s0[i]);
                *(f16x4*)(hb + (size_t)r * D + col) = w; }
        } }
}
template <bool FINAL>
__device__ __forceinline__ void n1_any(const Params& p, int layer, h16* xout) {
    const int tid = tid_fresh(), lane = tid & 63, gw = blockIdx.x * 8 + __builtin_amdgcn_readfirstlane(tid >> 6), nw = gridDim.x * 8; const int nrow = FINAL ? TL : TT;
    int r = gw;
    for (; r + nw < nrow; r += 2 * nw) n1_rows<2, FINAL>(p, layer, r, nw, lane, xout);
    if (r < nrow) n1_rows<1, FINAL>(p, layer, r, nw, lane, xout);
}
__device__ __forceinline__ void n1_phase(const Params& p, int layer, h16* xout) { n1_any<false>(p, layer, xout); }
__device__ __forceinline__ void final_phase(const Params& p) { n1_any<true>(p, 0, nullptr); }
constexpr int N2_CH = 4;
constexpr int N2_SLOT = N2_CH * 10 * 1024;
constexpr int N2_XT = 2 * N2_SLOT;
constexpr int N2_SC = N2_XT + 8 * 4096;
#ifndef PROBE_N2VAR
#define PROBE_N2VAR 0
#endif
__device__ __forceinline__ void n2_phase(const Params& p, int layer, LAS unsigned char* lds, int ctr_shadow) {
    const bool pv_tail = !(ctr_shadow && (PROBE_N2VAR & 1)), pv_store = !(ctr_shadow && (PROBE_N2VAR & 2)), pv_mma = !(ctr_shadow && (PROBE_N2VAR & 4));
    const int tid = tid_fresh(), lane = tid & 63, wv = __builtin_amdgcn_readfirstlane(tid >> 6), r16 = lane & 15, kg = lane >> 4;
    const int lrow = lane >> 3, lchk = lane & 7;
    const h16* xres = (const h16*)(p.ws + WS_XRES); h16* hb = (h16*)(p.ws + WS_HBUF); const float* mods = (const float*)(p.ws + WS_MODS);
    const char* rtb = p.ws + WS_RTAB + (size_t)layer * RTAB_L; const float* ssq = (const float*)(p.ws + WS_SSQ);
    int* counters = (int*)(p.ws + WS_CTL) + CTL_CNT + (layer + (ctr_shadow ? 4 : 0)) * NE; int* list = (int*)(p.ws + WS_LIST); float* gate = (float*)(p.ws + WS_GATE);
    LAS float* scr = (LAS float*)lds + wv * (16 * 80);
    LAS float* scl = (LAS float*)(lds + N2_SC); LAS float* shl = scl + D;
    LAS int* hist = (LAS int*)(lds + LDS_MISC); LAS int* hbase = hist + NE;
    LAS unsigned char* xt = lds + N2_XT + wv * 4096;
    const int hw_off0 = r16 * 128 + 16 * (kg ^ (r16 & 7)), hw_off1 = r16 * 128 + 16 * ((4 + kg) ^ (r16 & 7));
    const int hr_off = lrow * 128 + 16 * (lchk ^ (lrow & 7));
    const int ntask = (layer == NLAYER - 1 ? TL : TT) / 16, nfull = (int)gridDim.x * 8;
#pragma unroll 1
    for (int round = 0; round < 2; ++round) {
        const int nrem = ntask - nfull;
        if (round == 1 && (int)blockIdx.x >= nrem) break;
        const int task = round == 0 ? (int)blockIdx.x * 8 + wv : nfull + (int)blockIdx.x;
        const bool active = round == 0 ? (task < ntask) : true;
        const int trow = active ? task * 16 : 0;
        const int b = batch_of_row(trow);
        const h16* xg = xres + (size_t)(trow + r16) * D + 8 * kg;
        h16* hg0 = hb + (size_t)(trow + lrow) * D + lchk * 8; h16* hg1 = hg0 + (size_t)8 * D;
        float rs;
        { const float* sp = ssq + (size_t)(trow + r16) * 32; float t = 0.f;
#pragma unroll
            for (int q = 0; q < 8; ++q) { const f32x4 v = *(const f32x4*)(sp + 4 * q); t += (v[0] + v[1]) + (v[2] + v[3]); }
            rs = 1.0f / sqrtf(t * (1.0f / D) + EPS); }
        f32x4 acc[5];
#pragma unroll
        for (int ct = 0; ct < 5; ++ct) acc[ct] = (f32x4){0.f, 0.f, 0.f, 0.f};
        __syncthreads();
        if (tid < NE) hist[tid] = 0;
        { const float* scb = mods + ((size_t)(layer * 9 + b) * 6 + 4) * D; *(LAS f32x4*)(scl + tid * 4) = *(const f32x4*)(scb + tid * 4); *(LAS f32x4*)(shl + tid * 4) = *(const f32x4*)(scb - D + tid * 4); }
        if (round == 0) {
        f16x8 bq[5];
#pragma unroll
        for (int q = 0; q < 5; ++q) bq[q] = *(const f16x8*)(rtb + (size_t)(5 * wv + q) * 1024 + lane * 16);
#pragma unroll
        for (int q = 0; q < 5; ++q) *(LAS f16x8*)(lds + (5 * wv + q) * 1024 + lane * 16) = bq[q];
#pragma unroll
        for (int q = 0; q < 5; ++q) bq[q] = *(const f16x8*)(rtb + (size_t)N2_SLOT + (size_t)(5 * wv + q) * 1024 + lane * 16);
        f16x8 x0[N2_CH], x1[N2_CH], x2[N2_CH];
#pragma unroll
        for (int s2 = 0; s2 < N2_CH; ++s2) { x0[s2] = *(const f16x8*)(xg + 32 * s2); x1[s2] = *(const f16x8*)(xg + 32 * (N2_CH + s2)); }
#define N2_CHUNK(XC, XL, CH) do { const int ch = (CH); \
            __syncthreads(); \
            const int nx2 = (ch + 2 < 64 / N2_CH) ? ch + 2 : ch; \
            {   LAS unsigned char* dst = lds + ((ch + 1) & 1) * N2_SLOT; \
 _Pragma("unroll") \
                for (int q = 0; q < 5; ++q) *(LAS f16x8*)(dst + (5 * wv + q) * 1024 + lane * 16) = bq[q]; } \
            {   const char* src = rtb + (size_t)nx2 * N2_SLOT; \
 _Pragma("unroll") \
                for (int q = 0; q < 5; ++q) bq[q] = *(const f16x8*)(src + (size_t)(5 * wv + q) * 1024 + lane * 16); } \
 _Pragma("unroll") \
            for (int s2 = 0; s2 < N2_CH; ++s2) { const int ko = 32 * (nx2 * N2_CH + s2); XL[s2] = *(const f16x8*)(xg + ko); } \
            const LAS unsigned char* bs = lds + (ch & 1) * N2_SLOT + lane * 16; \
 _Pragma("unroll") \
            for (int pp = 0; pp < N2_CH / 2; ++pp) { \
                f16x8 hk[2]; \
 _Pragma("unroll") \
                for (int sp = 0; sp < 2; ++sp) { \
                    const int s2 = 2 * pp + sp; const int ko = 32 * (ch * N2_CH + s2) + 8 * kg; \
                    const f32x4 c0 = *(const LAS f32x4*)(scl + ko), c1 = *(const LAS f32x4*)(scl + ko + 4), h0 = *(const LAS f32x4*)(shl + ko), h1 = *(const LAS f32x4*)(shl + ko + 4); \
                    f16x8 hi, lo; \
 _Pragma("unroll") \
                    for (int i = 0; i < 4; ++i) { const float a0 = (float)XC[s2][i] * rs * (1.0f + c0[i]) + h0[i], a1 = (float)XC[s2][4 + i] * rs * (1.0f + c1[i]) + h1[i]; \
                        hi[i] = (h16)a0; lo[i] = (h16)(a0 - (float)hi[i]); hi[4 + i] = (h16)a1; lo[4 + i] = (h16)(a1 - (float)hi[4 + i]); } \
                    hk[sp] = hi; \
                    if (pv_mma) \
 _Pragma("unroll") \
                    for (int ct = 0; ct < 5; ++ct) { const f16x8 whi = *(const LAS f16x8*)(bs + (s2 * 10 + ct * 2 + 0) * 1024), wlo = *(const LAS f16x8*)(bs + (s2 * 10 + ct * 2 + 1) * 1024); \
                        acc[ct] = __builtin_amdgcn_mfma_f32_16x16x32_f16(hi, whi, acc[ct], 0, 0, 0); \
                        acc[ct] = __builtin_amdgcn_mfma_f32_16x16x32_f16(hi, wlo, acc[ct], 0, 0, 0); \
                        acc[ct] = __builtin_amdgcn_mfma_f32_16x16x32_f16(lo, whi, acc[ct], 0, 0, 0); } \
                } \
                *(LAS f16x8*)(xt + hw_off0) = hk[0]; *(LAS f16x8*)(xt + hw_off1) = hk[1]; \
                const f16x8 o0 = *(const LAS f16x8*)(xt + hr_off), o1 = *(const LAS f16x8*)(xt + 1024 + hr_off); \
                if (active && pv_store) { const int ho = 32 * (ch * N2_CH + 2 * pp); *(f16x8*)(hg0 + ho) = o0; *(f16x8*)(hg1 + ho) = o1; } \
            } \
        } while (0)
#pragma unroll 1
        for (int c3 = 0; c3 < 15; c3 += 3) { N2_CHUNK(x0, x2, c3); N2_CHUNK(x1, x0, c3 + 1); N2_CHUNK(x2, x1, c3 + 2); }
        N2_CHUNK(x0, x2, 15);
#undef N2_CHUNK
        } else {
            const char* rtw = rtb + (size_t)(8 * wv) * 10240; const int kb = 256 * wv;
            unsigned loff = (unsigned)lane * 16u; asm volatile("" : "+v"(loff));
            f16x8 bb[10];
            f16x8 xa[2][2];
#pragma unroll
            for (int sp = 0; sp < 2; ++sp) xa[0][sp] = *(const f16x8*)(xg + kb + 32 * sp);
#pragma unroll
            for (int pp = 0; pp < 4; ++pp) {
                if (pp < 3) {
#pragma unroll
                    for (int sp = 0; sp < 2; ++sp) xa[(pp + 1) & 1][sp] = *(const f16x8*)(xg + kb + 32 * (2 * pp + 2 + sp)); }
                f16x8 hk[2];
#pragma unroll
                for (int sp = 0; sp < 2; ++sp) {
                    const int st = 2 * pp + sp; const int ko = kb + 32 * st + 8 * kg;
#pragma unroll
                    for (int q = 0; q < 10; ++q) bb[q] = *(const f16x8*)(rtw + (size_t)(st * 10 + q) * 1024 + loff);
                    asm volatile("" ::: "memory");
                    const f32x4 c0 = *(const LAS f32x4*)(scl + ko), c1 = *(const LAS f32x4*)(scl + ko + 4), h0 = *(const LAS f32x4*)(shl + ko), h1 = *(const LAS f32x4*)(shl + ko + 4);
                    f16x8 hi, lo;
#pragma unroll
                    for (int i = 0; i < 4; ++i) { const float a0 = (float)xa[pp & 1][sp][i] * rs * (1.0f + c0[i]) + h0[i], a1 = (float)xa[pp & 1][sp][4 + i] * rs * (1.0f + c1[i]) + h1[i];
                        hi[i] = (h16)a0; lo[i] = (h16)(a0 - (float)hi[i]); hi[4 + i] = (h16)a1; lo[4 + i] = (h16)(a1 - (float)hi[4 + i]); }
                    hk[sp] = hi;
#pragma unroll
                    for (int ct = 0; ct < 5; ++ct) {
                        acc[ct] = __builtin_amdgcn_mfma_f32_16x16x32_f16(hi, bb[2 * ct], acc[ct], 0, 0, 0);
                        acc[ct] = __builtin_amdgcn_mfma_f32_16x16x32_f16(hi, bb[2 * ct + 1], acc[ct], 0, 0, 0);
                        acc[ct] = __builtin_amdgcn_mfma_f32_16x16x32_f16(lo, bb[2 * ct], acc[ct], 0, 0, 0); }
                }
                *(LAS f16x8*)(xt + hw_off0) = hk[0]; *(LAS f16x8*)(xt + hw_off1) = hk[1];
                const f16x8 o0 = *(const LAS f16x8*)(xt + hr_off), o1 = *(const LAS f16x8*)(xt + 1024 + hr_off);
                if (pv_store) { const int ho = kb + 64 * pp; *(f16x8*)(hg0 + ho) = o0; *(f16x8*)(hg1 + ho) = o1; }
            }
        }
        __syncthreads();
#pragma unroll
        for (int ct = 0; ct < 5; ++ct)
#pragma unroll
            for (int i = 0; i < 4; ++i) scr[(4 * kg + i) * 80 + 16 * ct + r16] = acc[ct][i] * (1.0f / 256.0f);
        asm volatile("s_waitcnt lgkmcnt(0)" ::: "memory");
        int ea = 0, eb = 0, ra = 0, rb = 0; float g1v = 0.f, g2v = 0.f; const bool tok_lane = (round == 0 ? active : wv == 0) && lane < 16 && pv_tail;
        const int nparts = round == 0 ? 1 : 8;
        if (tok_lane) {
            const LAS float* lgr = scr + lane * 80;
#define N2_LG(c) ({ float _t = lgr[(c)]; for (int _w = 1; _w < nparts; ++_w) _t += lgr[_w * 1280 + (c)]; _t; })
            float gmax = -3.0e38f; int gsel = 0; float gl[8];
#pragma unroll
            for (int g = 0; g < 8; ++g) { gl[g] = N2_LG(g) + p.moe_bg[layer * 8 + g]; if (gl[g] > gmax) { gmax = gl[g]; gsel = g; } }
            float gz = 0.f;
#pragma unroll
            for (int g = 0; g < 8; ++g) gz += expf(gl[g] - gmax);
            const float pg = 1.0f / gz;
            float f1 = -3.0e38f, f2 = -3.0e38f; int i1 = 0, i2 = 0;
            for (int q = 0; q < 8; ++q) { const float f = N2_LG(8 + gsel * 8 + q) + p.moe_be[layer * 64 + gsel * 8 + q];
                if (f > f1) { f2 = f1; i2 = i1; f1 = f; i1 = q; } else if (f > f2) { f2 = f; i2 = q; } }
            const float e2 = expf(f2 - f1); g1v = pg / (1.0f + e2); g2v = pg * e2 / (1.0f + e2);
            ea = gsel * 8 + i1; eb = gsel * 8 + i2;
#undef N2_LG
            ra = __hip_atomic_fetch_add(hist + ea, 1, __ATOMIC_RELAXED, __HIP_MEMORY_SCOPE_WORKGROUP); rb = __hip_atomic_fetch_add(hist + eb, 1, __ATOMIC_RELAXED, __HIP_MEMORY_SCOPE_WORKGROUP);
        }
        __syncthreads();
        { const int t2 = tid_fresh(); if (t2 < NE && pv_tail) { const int n = hist[t2]; hbase[t2] = n ? atomicAdd(&counters[t2], n) : 0; } }
        __syncthreads();
        if (tok_lane) { const int tok = task * 16 + lane; const size_t sa = (size_t)ea * LCAP + hbase[ea] + ra, sb = (size_t)eb * LCAP + hbase[eb] + rb;
            list[sa] = 2 * tok; gate[sa] = g1v; list[sb] = 2 * tok + 1; gate[sb] = g2v; }
    }
}
__device__ __forceinline__ void transpose_phase(const Params& p, LAS h16* T) {
    const h16* zt = (const h16*)(p.ws + WS_ZT); h16* z = (h16*)(p.ws + WS_HBUF); const int tid = tid_fresh();
    const int ntile = (D / 64) * (TT / 64);
    for (int tile = blockIdx.x; tile < ntile; tile += gridDim.x) {
        const int td = tile % (D / 64), tt = tile / (D / 64); const int d0 = td * 64, t0 = tt * 64;
        { const int dr = tid >> 3, tc = (tid & 7) * 8; const f16x8 v = *(const f16x8*)(zt + (size_t)(d0 + dr) * TT + t0 + tc);
#pragma unroll
            for (int i = 0; i < 8; ++i) T[(tc + i) * 66 + dr] = v[i]; }
        __syncthreads();
        { const int tr = tid >> 3, dc = (tid & 7) * 8; f16x8 v;
#pragma unroll
            for (int i = 0; i < 8; ++i) v[i] = T[tr * 66 + dc + i];
            *(f16x8*)(z + (size_t)(t0 + tr) * D + d0 + dc) = v; }
        __syncthreads();
    }
}

__device__ __forceinline__ f32x2 cmul(const f32x2 a, const f32x2 b) { return (f32x2){a.x * b.x - a.y * b.y, a.x * b.y + a.y * b.x}; }
__device__ __forceinline__ f32x2 cmulc(const f32x2 a, const f32x2 b) { return (f32x2){a.x * b.x + a.y * b.y, a.y * b.x - a.x * b.y}; }
__device__ __forceinline__ f32x2 cconj(const f32x2 a) { return (f32x2){a.x, -a.y}; }
template <bool INV> __device__ __forceinline__ f32x2 mul_mi(const f32x2 a) { return INV ? (f32x2){-a.y, a.x} : (f32x2){a.y, -a.x}; }
template <bool INV> __device__ __forceinline__ void dft4(f32x2& a, f32x2& b, f32x2& c, f32x2& d) {
    const f32x2 s0 = a + c, s1 = a - c, s2 = b + d, s3 = mul_mi<INV>(b - d);
    a = s0 + s2; b = s1 + s3; c = s0 - s2; d = s1 - s3;
}
template <bool INV, int M> __device__ __forceinline__ f32x2 w16mul(const f32x2 a) {
    constexpr float C1 = 0.92387953251128674f, S1 = 0.38268343236508977f, R = 0.70710678118654752f;
    constexpr float cr = (M == 0) ? 1.f : (M == 1) ? C1 : (M == 2) ? R : (M == 3) ? S1 : (M == 4) ? 0.f : (M == 6) ? -R :   -C1;
    constexpr float ci0 = (M == 0) ? 0.f : (M == 1) ? -S1 : (M == 2) ? -R : (M == 3) ? -C1 : (M == 4) ? -1.f : (M == 6) ? -R :   S1;
    constexpr float ci = INV ? -ci0 : ci0;
    return (f32x2){a.x * cr - a.y * ci, a.x * ci + a.y * cr};
}
template <bool INV> __device__ __forceinline__ void dft16(f32x2 (&v)[16]) {
#pragma unroll
    for (int n2 = 0; n2 < 4; ++n2) dft4<INV>(v[n2], v[4 + n2], v[8 + n2], v[12 + n2]);
    v[5] = w16mul<INV, 1>(v[5]); v[6] = w16mul<INV, 2>(v[6]); v[7] = w16mul<INV, 3>(v[7]);
    v[9] = w16mul<INV, 2>(v[9]); v[10] = w16mul<INV, 4>(v[10]); v[11] = w16mul<INV, 6>(v[11]);
    v[13] = w16mul<INV, 3>(v[13]); v[14] = w16mul<INV, 6>(v[14]); v[15] = w16mul<INV, 9>(v[15]);
#pragma unroll
    for (int k1 = 0; k1 < 4; ++k1) dft4<INV>(v[4 * k1], v[4 * k1 + 1], v[4 * k1 + 2], v[4 * k1 + 3]);
    f32x2 t;
    t = v[1]; v[1] = v[4]; v[4] = t; t = v[2]; v[2] = v[8]; v[8] = t; t = v[3]; v[3] = v[12]; v[12] = t;
    t = v[6]; v[6] = v[9]; v[9] = t; t = v[7]; v[7] = v[13]; v[13] = t; t = v[11]; v[11] = v[14]; v[14] = t;
}
__device__ __forceinline__ int fphys(int i) { return i + (i >> 4); }
__device__ __forceinline__ f32x2 w32c(int j) {
    constexpr float c[16] = {1.f, 0.98078528040323043f, 0.92387953251128674f, 0.83146961230254524f, 0.70710678118654752f, 0.55557023301960218f, 0.38268343236508977f, 0.19509032201612825f,
                             0.f, -0.19509032201612825f, -0.38268343236508977f, -0.55557023301960218f, -0.70710678118654752f, -0.83146961230254524f, -0.92387953251128674f, -0.98078528040323043f};
    constexpr float s[16] = {0.f, 0.19509032201612825f, 0.38268343236508977f, 0.55557023301960218f, 0.70710678118654752f, 0.83146961230254524f, 0.92387953251128674f, 0.98078528040323043f,
                             1.f, 0.98078528040323043f, 0.92387953251128674f, 0.83146961230254524f, 0.70710678118654752f, 0.55557023301960218f, 0.38268343236508977f, 0.19509032201612825f};
    return (f32x2){c[j], -s[j]};
}
template <int S>
__device__ __forceinline__ void fft_fwd0(const f32x2 (&xe)[16], const f32x2 (&xo)[16], LAS f32x2* E, LAS f32x2* O, int t, const LAS f32x2* tw) {
    const f32x2 u = tw[t * (256 / S)]; const f32x2 u2 = cmul(u, u);
    f32x2 y[16];
#pragma unroll
    for (int j = 0; j < 16; ++j) y[j] = xe[j];
    dft16<false>(y);
    constexpr int QS = S + S / 16;
    LAS f32x2* Eb = E + fphys(t); LAS f32x2* Ob = O + fphys(t);
    f32x2 pw = u2; Eb[0] = y[0];
#pragma unroll
    for (int q = 1; q < 16; ++q) { Eb[QS * q] = cmul(y[q], pw); pw = cmul(pw, u2); }
#pragma unroll
    for (int j = 0; j < 16; ++j) y[j] = cmul(xo[j], w32c(j));
    dft16<false>(y);
    pw = u;
#pragma unroll
    for (int q = 0; q < 16; ++q) { Ob[QS * q] = cmul(y[q], pw); pw = cmul(pw, u2); }
}
template <bool INV> __device__ __forceinline__ void fft_pass1(LAS f32x2* A, int tau, const LAS f32x2* tw) {
    const int i = tau & 15, base = (tau >> 4) << 8; const f32x2 u0 = tw[32 * i]; const f32x2 u = INV ? cconj(u0) : u0;
    f32x2 y[16]; LAS f32x2* Ab = A + fphys(base + i);
#pragma unroll
    for (int j = 0; j < 16; ++j) y[j] = Ab[17 * j];
    if (INV) { f32x2 pw = u;
#pragma unroll
        for (int q = 1; q < 16; ++q) { y[q] = cmul(y[q], pw); pw = cmul(pw, u); } }
    dft16<INV>(y);
    if (!INV) { f32x2 pw = u;
#pragma unroll
        for (int q = 1; q < 16; ++q) { y[q] = cmul(y[q], pw); pw = cmul(pw, u); } }
#pragma unroll
    for (int j = 0; j < 16; ++j) Ab[17 * j] = y[j];
}
template <bool INV> __device__ __forceinline__ void fft_pass1_pair(LAS f32x2* A, LAS f32x2* B, int tau, const LAS f32x2* tw) {
    const int i = tau & 15, base = (tau >> 4) << 8; const f32x2 u0 = tw[32 * i]; const f32x2 u = INV ? cconj(u0) : u0;
    f32x2 y[16], z[16]; LAS f32x2* Ab = A + fphys(base + i); LAS f32x2* Bb = B + fphys(base + i);
#pragma unroll
    for (int j = 0; j < 16; ++j) y[j] = Ab[17 * j];
#pragma unroll
    for (int j = 0; j < 16; ++j) z[j] = Bb[17 * j];
    f32x2 pwr[16]; pwr[1] = u;
#pragma unroll
    for (int q = 2; q < 16; ++q) pwr[q] = cmul(pwr[q - 1], u);
    if (INV) {
#pragma unroll
        for (int q = 1; q < 16; ++q) y[q] = cmul(y[q], pwr[q]); }
    dft16<INV>(y);
    if (!INV) {
#pragma unroll
        for (int q = 1; q < 16; ++q) y[q] = cmul(y[q], pwr[q]); }
#pragma unroll
    for (int j = 0; j < 16; ++j) Ab[17 * j] = y[j];
    if (INV) {
#pragma unroll
        for (int q = 1; q < 16; ++q) z[q] = cmul(z[q], pwr[q]); }
    dft16<INV>(z);
    if (!INV) {
#pragma unroll
        for (int q = 1; q < 16; ++q) z[q] = cmul(z[q], pwr[q]); }
#pragma unroll
    for (int j = 0; j < 16; ++j) Bb[17 * j] = z[j];
}
__device__ __forceinline__ void fft_fwd2(const LAS f32x2* A, int t, f32x2 (&y)[16]) {
#pragma unroll
    for (int j = 0; j < 16; ++j) y[j] = A[17 * t + j];
    dft16<false>(y);
}
template <int NT> __device__ __forceinline__ void kf_load(const f32x2* kf, f32x4 (&k)[8]) {
#pragma unroll
    for (int j = 0; j < 8; ++j) k[j] = *(const f32x4*)(kf + j * (2 * NT));
}
__device__ __forceinline__ void fft_mid(LAS f32x2* A, int t, const f32x4 (&k)[8]) {
    f32x2 y[16];
    fft_fwd2(A, t, y);
#pragma unroll
    for (int j = 0; j < 8; ++j) { y[2 * j] = cmul(y[2 * j], (f32x2){k[j][0], k[j][1]}); y[2 * j + 1] = cmul(y[2 * j + 1], (f32x2){k[j][2], k[j][3]}); }
    dft16<true>(y);
#pragma unroll
    for (int j = 0; j < 16; ++j) A[17 * t + j] = y[j];
}
template <int S>
__device__ __forceinline__ void fft_inv0(const LAS f32x2* E, const LAS f32x2* O, int t, const LAS f32x2* tw, f32x2 (&out)[16]) {
    const f32x2 u = tw[t * (256 / S)]; const f32x2 u2 = cmul(u, u);
    f32x2 y[16];
    constexpr int QS = S + S / 16;
    const LAS f32x2* Eb = E + fphys(t); const LAS f32x2* Ob = O + fphys(t);
    f32x2 pw = u2; y[0] = Eb[0];
#pragma unroll
    for (int q = 1; q < 16; ++q) { y[q] = cmulc(Eb[QS * q], pw); pw = cmul(pw, u2); }
    dft16<true>(y);
#pragma unroll
    for (int j = 0; j < 16; ++j) out[j] = y[j];
    pw = u;
#pragma unroll
    for (int q = 0; q < 16; ++q) { y[q] = cmulc(Ob[QS * q], pw); pw = cmul(pw, u2); }
    dft16<true>(y);
#pragma unroll
    for (int j = 0; j < 16; ++j) out[j] += cmulc(y[j], w32c(j));
}
__device__ __forceinline__ float hy_absdelta(int d) { return fabsf(-3.0701134573253943f + (-15.350567286626973f + 3.0701134573253943f) * ((float)d / 2047.0f)); }

__device__ __forceinline__ void filt_fft_phase(const Params& p, LAS unsigned char* lds) {
    const int tid = tid_fresh();
    LAS f32x2* tw = (LAS f32x2*)(lds + LDS_MISC + 1024);
    tw[tid] = ((const f32x2*)(p.ws + WS_TW))[tid];
    __syncthreads();
    {
        const int grp = tid >> 8, tau = tid & 255; constexpr int KFQ = 512;
        LAS f32x2* E = (LAS f32x2*)(lds + grp * 69632); LAS f32x2* O = E + 4352; LAS float* red = (LAS float*)(lds + LDS_MISC) + grp * 8;
        for (int pb = blockIdx.x * 2 + grp; pb < 2 * 2 * 2048; pb += gridDim.x * 2) {
            const int d = pb & 2047, n = (pb >> 11) & 1, j = pb >> 12;
            const float* tf = (const float*)(p.ws + WS_TAPS) + ((size_t)j * 8192 + (size_t)(n * 2 + 0) * D + d) * 4096;
            const float* tb = tf + (size_t)D * 4096;
            const float adel = hy_absdelta(d); const float tscale = 1.0f / 4095.0f;
            f32x2 xe[16], xo[16]; float ss = 0.f;
#pragma unroll
            for (int jj = 0; jj < 16; ++jj) { const int nn = tau + 256 * jj;
                const float klo = tf[nn] * expf(-(float)nn * tscale * adel);
                const int m = 4096 - nn;
                const float khi = (m < 4096) ? tb[m & 4095] * expf(-(float)m * tscale * adel) : 0.f;
                ss += klo * klo + khi * khi; xe[jj] = (f32x2){klo + khi, 0.f}; xo[jj] = (f32x2){klo - khi, 0.f}; }
            ss = wave_sum(ss);
            if ((tid & 63) == 0) red[(tid >> 6) & 3] = ss;
            fft_fwd0<256>(xe, xo, E, O, tau, tw);
            __syncthreads();
            const float tot = red[0] + red[1] + red[2] + red[3];
            const float scale = (1.0f / sqrtf(tot + EPS)) * (1.0f / 8192.0f);
            const float hbs = p.hy_bias[((size_t)j * 2 + n) * D + d] * (1.0f / 8192.0f);
            fft_pass1<false>(E, tau, tw); fft_pass1<false>(O, tau, tw);
            __syncthreads();
            f32x2* kf = (f32x2*)(p.ws + WS_KF) + (size_t)pb * 8192 + (size_t)tau * 2;
            f32x2 y[16];
            fft_fwd2(E, tau, y);
#pragma unroll
            for (int q = 0; q < 8; ++q) *(f32x4*)(kf + KFQ * q) = (f32x4){y[2 * q].x * scale + hbs, y[2 * q].y * scale, y[2 * q + 1].x * scale + hbs, y[2 * q + 1].y * scale};
            fft_fwd2(O, tau, y);
#pragma unroll
            for (int q = 0; q < 8; ++q) *(f32x4*)(kf + 4096 + KFQ * q) = (f32x4){y[2 * q].x * scale + hbs, y[2 * q].y * scale, y[2 * q + 1].x * scale + hbs, y[2 * q + 1].y * scale};
            __syncthreads();
        }
    }
    {
        const int pr = tid >> 4, i = tid & 15; constexpr int KFQ = 32;
        LAS f32x2* E = (LAS f32x2*)(lds + pr * 4352); LAS f32x2* O = E + 272;
        for (int it = blockIdx.x; it < 256; it += gridDim.x) {
            const int pb = it * 32 + pr; const int d = pb & 2047, n = (pb >> 11) & 1, j = pb >> 12;
            const float* tf = (const float*)(p.ws + WS_TAPSC) + ((size_t)j * 8192 + (size_t)(n * 2 + 0) * D + d) * 256;
            const float* tb = tf + (size_t)D * 256;
            const float adel = hy_absdelta(d); const float tscale = 1.0f / 255.0f;
            f32x2 xe[16], xo[16]; float ss = 0.f;
#pragma unroll
            for (int jj = 0; jj < 16; ++jj) { const int nn = i + 16 * jj;
                const float klo = tf[nn] * expf(-(float)nn * tscale * adel);
                const int m = 256 - nn;
                const float khi = (m < 256) ? tb[m & 255] * expf(-(float)m * tscale * adel) : 0.f;
                ss += klo * klo + khi * khi; xe[jj] = (f32x2){klo + khi, 0.f}; xo[jj] = (f32x2){klo - khi, 0.f}; }
            ss += shx(ss, 8); ss += shx(ss, 4); ss += shx(ss, 2); ss += shx(ss, 1);
            const float scale = (1.0f / sqrtf(ss + EPS)) * (1.0f / 512.0f);
            const float hbs = p.hy_bias[((size_t)j * 2 + n) * D + d] * (1.0f / 512.0f);
            fft_fwd0<16>(xe, xo, E, O, i, tw);
            __syncthreads();
            f32x2* kf = (f32x2*)(p.ws + WS_KFC) + (size_t)pb * 512 + (size_t)i * 2;
            f32x2 y[16];
            fft_fwd2(E, i, y);
#pragma unroll
            for (int q = 0; q < 8; ++q) *(f32x4*)(kf + KFQ * q) = (f32x4){y[2 * q].x * scale + hbs, y[2 * q].y * scale, y[2 * q + 1].x * scale + hbs, y[2 * q + 1].y * scale};
            fft_fwd2(O, i, y);
#pragma unroll
            for (int q = 0; q < 8; ++q) *(f32x4*)(kf + 256 + KFQ * q) = (f32x4){y[2 * q].x * scale + hbs, y[2 * q].y * scale, y[2 * q + 1].x * scale + hbs, y[2 * q + 1].y * scale};
            __syncthreads();
        }
    }
}

__device__ __forceinline__ float conv3_lds(const LAS h16* row, int n, float w0, float w1, float w2, float b) { return (float)row[n - 1] * w0 + (float)row[n] * w1 + (float)row[n + 1] * w2 + b; }
constexpr int ST_P = 4112, STS_P = 272;

#ifndef PROBE_CVAR
#define PROBE_CVAR 0
#endif
__device__ __forceinline__ void conv_phase(const Params& p, int jl, LAS unsigned char* lds, int pvar = 0, int cvt_layer = -1, int cvt_n = 0) {
    const int tid = tid_fresh(); const bool cv_outer = !(pvar && (PROBE_CVAR & 1)), cv_inner = !(pvar && (PROBE_CVAR & 2));
    LAS f32x2* tw = (LAS f32x2*)(lds + LDS_MISC + 1024);
    tw[tid] = ((const f32x2*)(p.ws + WS_TW))[tid];
    __syncthreads();
    const h16* ut = (const h16*)(p.ws + WS_UT); h16* zt = (h16*)(p.ws + WS_ZT);
    const float* cw = p.hy_conv_w + (size_t)jl * 3 * D3; const float* cb = p.hy_conv_b + (size_t)jl * D3;
    {
        const int grp = tid >> 8, tau = tid & 255;
        LAS f32x2* E = (LAS f32x2*)(lds + grp * 69632); LAS f32x2* O = E + 4352; LAS h16* ST = (LAS h16*)E;
        int uit = 0; const int utrig = 4 * (((int)blockIdx.x >> 3) & 3);
        for (int unit = blockIdx.x; unit < 4096; unit += gridDim.x, ++uit) {
            if (cvt_layer >= 0 && uit == utrig) { __syncthreads(); cvt_moe_share(p, cvt_layer, blockIdx.x, cvt_n, gridDim.x, (LAS float*)lds); }
            const int ux = unit & 7, uj = unit >> 3; const int hq = uj & 1, d = (uj >> 1) * 8 + ux; const size_t col0 = (size_t)(4 * hq + 2 * grp) * 4096;
            const f32x2* kfb = (const f32x2*)(p.ws + WS_KF) + ((size_t)(jl * 2) * 2048 + d) * 8192 + (size_t)tau * 2;
            f16x8 raw[2][2][2], raw2[2][2];
#pragma unroll
            for (int sq = 0; sq < 2; ++sq)
#pragma unroll
                for (int bb = 0; bb < 2; ++bb)
#pragma unroll
                    for (int k = 0; k < 2; ++k) raw[sq][bb][k] = *(const f16x8*)(ut + (size_t)(sq * D + d) * TT + col0 + (size_t)bb * 4096 + (size_t)(tau + 256 * k) * 8);
            __syncthreads();
#pragma unroll
            for (int sq = 0; sq < 2; ++sq)
#pragma unroll
                for (int bb = 0; bb < 2; ++bb)
#pragma unroll
                    for (int k = 0; k < 2; ++k) *(LAS f16x8*)(ST + (sq * 2 + bb) * ST_P + 8 + (tau + 256 * k) * 8) = raw[sq][bb][k];
            if (tau < 4) { ST[tau * ST_P + 7] = (h16)0.f; ST[tau * ST_P + 8 + 4096] = (h16)0.f; }
            __syncthreads();
            f32x2 xin[16], gk[16], y[16];
            { const float w0 = cw[d], w1 = cw[D3 + d], w2 = cw[2 * D3 + d], bv = cb[d]; const float g0 = cw[D + d], g1 = cw[D3 + D + d], g2 = cw[2 * D3 + D + d], gb = cb[D + d];
#pragma unroll
                for (int jj = 0; jj < 16; ++jj) { const int nn = tau + 256 * jj;
                    xin[jj] = (f32x2){conv3_lds(ST + 8, nn, w0, w1, w2, bv), conv3_lds(ST + ST_P + 8, nn, w0, w1, w2, bv)};
                    gk[jj] = (f32x2){conv3_lds(ST + 2 * ST_P + 8, nn, g0, g1, g2, gb), conv3_lds(ST + 3 * ST_P + 8, nn, g0, g1, g2, gb)}; } }
            __syncthreads();
#pragma unroll 1
            for (int ord = 0; ord < 2; ++ord) {
                if (cv_outer) fft_fwd0<256>(xin, xin, E, O, tau, tw);
                const f32x2* kf = kfb + (size_t)ord * 2048 * 8192; f32x4 kfe[8], kfo[8];
                kf_load<256>(kf, kfe);
                __syncthreads();
                if (cv_inner) fft_pass1_pair<false>(E, O, tau, tw);
                kf_load<256>(kf + 4096, kfo);
                __syncthreads();
                if (cv_inner) { fft_mid(E, tau, kfe); fft_mid(O, tau, kfo); }
                if (ord == 0) {
#pragma unroll
                    for (int bb = 0; bb < 2; ++bb)
#pragma unroll
                        for (int k = 0; k < 2; ++k) raw2[bb][k] = *(const f16x8*)(ut + (size_t)(2 * D + d) * TT + col0 + (size_t)bb * 4096 + (size_t)(tau + 256 * k) * 8); }
                __syncthreads();
                if (cv_inner) fft_pass1_pair<true>(E, O, tau, tw);
                __syncthreads();
                if (cv_outer) fft_inv0<256>(E, O, tau, tw, y); else {
#pragma unroll
                    for (int jj = 0; jj < 16; ++jj) y[jj] = xin[jj]; }
#pragma unroll
                for (int jj = 0; jj < 16; ++jj) xin[jj] = gk[jj] * y[jj];
                if (ord == 0) {
                    __syncthreads();
#pragma unroll
                    for (int bb = 0; bb < 2; ++bb)
#pragma unroll
                        for (int k = 0; k < 2; ++k) *(LAS f16x8*)(ST + bb * ST_P + 8 + (tau + 256 * k) * 8) = raw2[bb][k];
                    if (tau < 2) { ST[tau * ST_P + 7] = (h16)0.f; ST[tau * ST_P + 8 + 4096] = (h16)0.f; }
                    __syncthreads();
                    const float g0 = cw[2 * D + d], g1 = cw[D3 + 2 * D + d], g2 = cw[2 * D3 + 2 * D + d], gb = cb[2 * D + d];
#pragma unroll
                    for (int jj = 0; jj < 16; ++jj) { const int nn = tau + 256 * jj; gk[jj] = (f32x2){conv3_lds(ST + 8, nn, g0, g1, g2, gb), conv3_lds(ST + ST_P + 8, nn, g0, g1, g2, gb)}; }
                    __syncthreads();
                }
            }
            h16* o0 = zt + (size_t)d * TT + col0; h16* o1 = o0 + 4096;
#pragma unroll
            for (int jj = 0; jj < 16; ++jj) { const int nn = tau + 256 * jj; o0[nn] = (h16)xin[jj].x; o1[nn] = (h16)xin[jj].y; }
        }
    }
    {
        const int pr = tid >> 4, i = tid & 15, c8 = pr >> 2, bp = pr & 3;
        LAS f32x2* E = (LAS f32x2*)(lds + pr * 4352); LAS f32x2* O = E + 272; LAS h16* ST = (LAS h16*)lds;
        for (int unit = blockIdx.x; unit < 256; unit += gridDim.x) {
            const int d0 = unit * 8, d = d0 + c8;
            const f32x2* kfb = (const f32x2*)(p.ws + WS_KFC) + ((size_t)(jl * 2) * 2048 + d) * 512 + (size_t)i * 2;
            f16x8 raw[3][4];
#pragma unroll
            for (int sq = 0; sq < 3; ++sq)
#pragma unroll
                for (int k = 0; k < 4; ++k) { const int q = tid + 512 * k, row = q >> 5, ch = q & 31;
                    raw[sq][k] = *(const f16x8*)(ut + (size_t)(sq * D + d0 + (row >> 3)) * TT + TL + (row & 7) * 256 + ch * 8); }
            __syncthreads();
#pragma unroll
            for (int sq = 0; sq < 2; ++sq)
#pragma unroll
                for (int k = 0; k < 4; ++k) { const int q = tid + 512 * k, row = q >> 5, ch = q & 31; *(LAS f16x8*)(ST + (sq * 64 + row) * STS_P + 8 + ch * 8) = raw[sq][k]; }
            if (tid < 128) { ST[tid * STS_P + 7] = (h16)0.f; ST[tid * STS_P + 8 + 256] = (h16)0.f; }
            __syncthreads();
            f32x2 xin[16], gk[16], y[16];
            { const float w0 = cw[d], w1 = cw[D3 + d], w2 = cw[2 * D3 + d], bv = cb[d]; const float g0 = cw[D + d], g1 = cw[D3 + D + d], g2 = cw[2 * D3 + D + d], gb = cb[D + d];
                const LAS h16* r0 = ST + (c8 * 8 + 2 * bp) * STS_P + 8; const LAS h16* r1 = r0 + 64 * STS_P;
#pragma unroll
                for (int jj = 0; jj < 16; ++jj) { const int nn = i + 16 * jj;
                    xin[jj] = (f32x2){conv3_lds(r0, nn, w0, w1, w2, bv), conv3_lds(r0 + STS_P, nn, w0, w1, w2, bv)};
                    gk[jj] = (f32x2){conv3_lds(r1, nn, g0, g1, g2, gb), conv3_lds(r1 + STS_P, nn, g0, g1, g2, gb)}; } }
            __syncthreads();
#pragma unroll 1
            for (int ord = 0; ord < 2; ++ord) {
                const f32x2* kf = kfb + (size_t)ord * 2048 * 512; f32x4 kfe[8], kfo[8];
                fft_fwd0<16>(xin, xin, E, O, i, tw);
                __syncthreads();
                kf_load<16>(kf, kfe); fft_mid(E, i, kfe); kf_load<16>(kf + 256, kfo); fft_mid(O, i, kfo);
                __syncthreads();
                fft_inv0<16>(E, O, i, tw, y);
#pragma unroll
                for (int jj = 0; jj < 16; ++jj) xin[jj] = gk[jj] * y[jj];
                if (ord == 0) {
                    __syncthreads();
#pragma unroll
                    for (int k = 0; k < 4; ++k) { const int q = tid + 512 * k, row = q >> 5, ch = q & 31; *(LAS f16x8*)(ST + row * STS_P + 8 + ch * 8) = raw[2][k]; }
                    if (tid < 64) { ST[tid * STS_P + 7] = (h16)0.f; ST[tid * STS_P + 8 + 256] = (h16)0.f; }
                    __syncthreads();
                    const float g0 = cw[2 * D + d], g1 = cw[D3 + 2 * D + d], g2 = cw[2 * D3 + 2 * D + d], gb = cb[2 * D + d];
                    const LAS h16* r0 = ST + (c8 * 8 + 2 * bp) * STS_P + 8;
#pragma unroll
                    for (int jj = 0; jj < 16; ++jj) { const int nn = i + 16 * jj; gk[jj] = (f32x2){conv3_lds(r0, nn, g0, g1, g2, gb), conv3_lds(r0 + STS_P, nn, g0, g1, g2, gb)}; }
                    __syncthreads();
                }
            }
            h16* o0 = zt + (size_t)d * TT + TL + (2 * bp) * 256; h16* o1 = o0 + 256;
#pragma unroll
            for (int jj = 0; jj < 16; ++jj) { const int nn = i + 16 * jj; o0[nn] = (h16)xin[jj].x; o1[nn] = (h16)xin[jj].y; }
        }
    }
}

constexpr int AT_KP = 72, AT_VP = 68;
__device__ __forceinline__ void attn_phase(const Params& p, int jl, bool with_ctx_out, LAS unsigned char* lds, int cvt_layer = -1, int cvt_n = 0) {
    const int tid = tid_fresh(), wv = tid >> 6, lane = tid & 63, r32 = lane & 31, hh = lane >> 5;
    LAS h16* Ks = (LAS h16*)lds; LAS h16* Vs = (LAS h16*)(lds + 64 * AT_KP * 2);
    const h16* qk = (const h16*)(p.ws + WS_QK); const h16* vt = (const h16*)(p.ws + WS_VT); h16* ob = (h16*)(p.ws + WS_HBUF);
    LAS float* rcos = (LAS float*)(lds + 65536); LAS float* rsin = rcos + 1024;
    { const float* rg = (const float*)(p.ws + WS_ROPE); for (int i = tid; i < 2048; i += 512) rcos[i] = rg[i]; }
    __syncthreads();
    const int nunit = 2048 + (with_ctx_out ? 128 : 0);
    int uit = 0; const int utrig = 2 * (((int)blockIdx.x >> 3) & 3);
    for (int unit = blockIdx.x; unit < nunit; unit += gridDim.x, ++uit) {
        if (cvt_layer >= 0 && uit == utrig) { __syncthreads(); cvt_moe_share(p, cvt_layer, blockIdx.x, cvt_n, gridDim.x, (LAS float*)lds); }
        int kind, b, g, qb;
        if (unit < 2048) { kind = 0; qb = unit & 63; g = (unit >> 6) & 3; b = unit >> 8; } else { const int u2 = unit - 2048; kind = 1; qb = u2 & 3; g = (u2 >> 2) & 3; b = u2 >> 4; }
        const int head = g * 8 + wv;
        const int qrow0 = kind ? (TL + b * 256 + qb * 64) : (b * 4096 + qb * 64);
        const int ctxrow0 = TL + b * 256;
        const int t_lo = kind ? 0 : (qb < 2 ? 2 - qb : 0), t_hi = kind ? -1 : (65 - qb < 4 ? 65 - qb : 4); const int nwin = t_hi - t_lo + 1, nv = nwin + 4;
        const bool krole = tid < 256; const int kkey = tid >> 2, kcp = tid & 3, kdA = (kcp & 1) * 8 + (kcp >> 1) * 32; const int vdim = (tid - 256) >> 2, vkc = tid & 3;
        f16x8 ld0, ld1;
#define AT_TILE(sidx, KROW0, MASK, ROPE) do { if ((sidx) < nwin) { const int _ti = t_lo + (sidx); KROW0 = b * 4096 + qb * 64 - 128 + 64 * _ti; ROPE = true; MASK = (_ti == 0) ? 1 : (_ti == 4) ? 2 : 0; } \
            else { KROW0 = ctxrow0 + 64 * ((sidx) - nwin); ROPE = false; MASK = 0; } } while (0)
#define AT_LOAD(KROW0) do { if (krole) { const h16* kp = qk + (size_t)((KROW0) + kkey) * DQK + D + g * 64 + kdA; ld0 = *(const f16x8*)kp; ld1 = *(const f16x8*)(kp + 16); } \
            else { const h16* vp = vt + (size_t)(g * 64 + vdim) * TT + (KROW0) + 16 * vkc; ld0 = *(const f16x8*)vp; ld1 = *(const f16x8*)(vp + 8); } } while (0)
        { int kr0, mk; bool rp; AT_TILE(0, kr0, mk, rp); (void)mk; (void)rp; AT_LOAD(kr0); }
        f16x8 qf[2][4];
#pragma unroll
        for (int qt = 0; qt < 2; ++qt) {
            f32x4 qv[4][2];
            const h16* qp = qk + (size_t)(qrow0 + 32 * qt + r32) * DQK + head * 64 + 8 * hh;
#pragma unroll
            for (int ks = 0; ks < 4; ++ks) { const f16x8 t = *(const f16x8*)(qp + 16 * ks);
#pragma unroll
                for (int i = 0; i < 4; ++i) { qv[ks][0][i] = (float)t[i]; qv[ks][1][i] = (float)t[4 + i]; } }
            if (kind == 0) {
                const int colpos = 32 * qt + r32;
#pragma unroll
                for (int a = 0; a < 2; ++a) { const int pos = a ? colpos : qb; const LAS float* cp = rcos + pos * 16 + 8 * hh; const LAS float* sp = rsin + pos * 16 + 8 * hh;
#pragma unroll
                    for (int e = 0; e < 2; ++e) { const f32x4 c = *(const LAS f32x4*)(cp + 4 * e), s = *(const LAS f32x4*)(sp + 4 * e);
                        const f32x4 x1 = qv[2 * a][e], x2 = qv[2 * a + 1][e]; qv[2 * a][e] = x1 * c - x2 * s; qv[2 * a + 1][e] = x2 * c + x1 * s; } }
            }
#pragma unroll
            for (int ks = 0; ks < 4; ++ks)
#pragma unroll
                for (int i = 0; i < 4; ++i) { qf[qt][ks][i] = (h16)(qv[ks][0][i] * (0.125f * 1.4426950408889634f)); qf[qt][ks][4 + i] = (h16)(qv[ks][1][i] * (0.125f * 1.4426950408889634f)); }
        }
        const float sink = p.at_sink[jl * 32 + head] * 1.4426950408889634f;
        float mrun[2] = {sink, sink}, lrun[2] = {hh == 0 ? 1.f : 0.f, hh == 0 ? 1.f : 0.f};
        f32x16 oacc[2][2];
#pragma unroll
        for (int a = 0; a < 2; ++a)
#pragma unroll
            for (int c = 0; c < 2; ++c)
#pragma unroll
                for (int i = 0; i < 16; ++i) oacc[a][c][i] = 0.f;
#pragma unroll 1
        for (int sx = 0; sx < nv; ++sx) {
            int krow0, mask; bool rope; AT_TILE(sx, krow0, mask, rope);
            __syncthreads();
            if (krole) {
                f16x8 o1 = ld0, o2 = ld1;
                if (rope) { const int kpos = (krow0 - b * 4096) + kkey; const int pos = (kcp >> 1) ? (kpos & 63) : (kpos >> 6);
                    const LAS float* cpp = rcos + pos * 16 + (kcp & 1) * 8; const LAS float* spp = rsin + pos * 16 + (kcp & 1) * 8;
#pragma unroll
                    for (int i = 0; i < 8; ++i) { const float c = cpp[i], s = spp[i], x1 = (float)ld0[i], x2 = (float)ld1[i]; o1[i] = (h16)(x1 * c - x2 * s); o2[i] = (h16)(x2 * c + x1 * s); } }
                *(LAS f16x8*)(Ks + kkey * AT_KP + kdA) = o1; *(LAS f16x8*)(Ks + kkey * AT_KP + kdA + 16) = o2;
            } else {
                LAS h16* dst = Vs + vdim * AT_VP + 16 * vkc;
                *(LAS f16x4*)(dst) = (f16x4){ld0[0], ld0[1], ld0[2], ld0[3]}; *(LAS f16x4*)(dst + 4) = (f16x4){ld0[4], ld0[5], ld0[6], ld0[7]};
                *(LAS f16x4*)(dst + 8) = (f16x4){ld1[0], ld1[1], ld1[2], ld1[3]}; *(LAS f16x4*)(dst + 12) = (f16x4){ld1[4], ld1[5], ld1[6], ld1[7]};
            }
            if (sx + 1 < nv) { int kr1, mk1; bool rp1; AT_TILE(sx + 1, kr1, mk1, rp1); (void)mk1; (void)rp1; AT_LOAD(kr1); }
            __syncthreads();
#pragma unroll
            for (int qt = 0; qt < 2; ++qt) {
                f32x16 sacc[2];
#pragma unroll
                for (int kt = 0; kt < 2; ++kt)
#pragma unroll
                    for (int i = 0; i < 16; ++i) sacc[kt][i] = 0.f;
#pragma unroll
                for (int ks = 0; ks < 4; ++ks)
#pragma unroll
                    for (int kt = 0; kt < 2; ++kt) { const f16x8 kf = *(const LAS f16x8*)(Ks + (32 * kt + r32) * AT_KP + 16 * ks + 8 * hh);
                        sacc[kt] = __builtin_amdgcn_mfma_f32_32x32x16_f16(kf, qf[qt][ks], sacc[kt], 0, 0, 0); }
                float tmax = -3.0e38f;
                if (mask != 0) {
                    int lim = r32 - 4 * hh; asm volatile("" : "+v"(lim));
                    if (mask == 1) {
#pragma unroll
                        for (int kt = 0; kt < 2; ++kt) {
                            if (kt < qt) {
#pragma unroll
                                for (int i = 0; i < 16; ++i) sacc[kt][i] = -1.0e30f; }
                            else if (kt == qt) {
#pragma unroll
                                for (int i = 0; i < 16; ++i) { const int kc = (i & 3) + 8 * (i >> 2); if (kc < lim) sacc[kt][i] = -1.0e30f; } } }
                    } else {
#pragma unroll
                        for (int kt = 0; kt < 2; ++kt) {
                            if (kt > qt) {
#pragma unroll
                                for (int i = 0; i < 16; ++i) sacc[kt][i] = -1.0e30f; }
                            else if (kt == qt) {
#pragma unroll
                                for (int i = 0; i < 16; ++i) { const int kc = (i & 3) + 8 * (i >> 2); if (kc > lim) sacc[kt][i] = -1.0e30f; } } }
                    } }
#pragma unroll
                for (int kt = 0; kt < 2; ++kt)
#pragma unroll
                    for (int i = 0; i < 16; ++i) tmax = fmaxf(tmax, sacc[kt][i]);
                tmax = fmaxf(tmax, shx(tmax, 32));
                const float mnew = fmaxf(mrun[qt], tmax); const float alpha = __builtin_amdgcn_exp2f(mrun[qt] - mnew); mrun[qt] = mnew;
                float psum = 0.f; f16x8 pf[2][2];
#pragma unroll
                for (int kt = 0; kt < 2; ++kt)
#pragma unroll
                    for (int s2 = 0; s2 < 2; ++s2)
#pragma unroll
                        for (int jj = 0; jj < 8; jj += 2) { const float p0 = __builtin_amdgcn_exp2f(sacc[kt][8 * s2 + jj] - mnew), p1 = __builtin_amdgcn_exp2f(sacc[kt][8 * s2 + jj + 1] - mnew);
                            const f16x2 pk = {(h16)p0, (h16)p1}; pf[kt][s2][jj] = pk[0]; pf[kt][s2][jj + 1] = pk[1];
                            psum = __builtin_amdgcn_fdot2(pk, (f16x2){(h16)1.0f, (h16)1.0f}, psum, false); }
                lrun[qt] = lrun[qt] * alpha + psum;
                if (__builtin_amdgcn_ballot_w64(alpha != 1.0f) != 0ull) {
#pragma unroll
                for (int dt = 0; dt < 2; ++dt)
#pragma unroll
                    for (int i = 0; i < 16; ++i) oacc[dt][qt][i] *= alpha; }
#pragma unroll
                for (int kt = 0; kt < 2; ++kt)
#pragma unroll
                    for (int s2 = 0; s2 < 2; ++s2)
#pragma unroll
                        for (int dt = 0; dt < 2; ++dt) { const LAS h16* vr = Vs + (32 * dt + r32) * AT_VP + 32 * kt + 16 * s2 + 4 * hh;
                            const f16x4 v0 = *(const LAS f16x4*)vr, v1 = *(const LAS f16x4*)(vr + 8);
                            const f16x8 vf = (f16x8){v0[0], v0[1], v0[2], v0[3], v1[0], v1[1], v1[2], v1[3]};
                            oacc[dt][qt] = __builtin_amdgcn_mfma_f32_32x32x16_f16(vf, pf[kt][s2], oacc[dt][qt], 0, 0, 0); }
            }
        }
        {   LAS h16* Ow = (LAS h16*)(lds + (wv < 4 ? 18432 + wv * 9216 : 73728 + (wv - 4) * 9216));
#pragma unroll
            for (int qt = 0; qt < 2; ++qt) {
                const float ltot = lrun[qt] + shx(lrun[qt], 32); const float inv = 1.0f / ltot;
                LAS h16* orow = Ow + (32 * qt + r32) * 72 + 4 * hh;
#pragma unroll
                for (int dt = 0; dt < 2; ++dt)
#pragma unroll
                    for (int q4 = 0; q4 < 4; ++q4) { f16x4 w;
#pragma unroll
                        for (int i = 0; i < 4; ++i) w[i] = (h16)(oacc[dt][qt][4 * q4 + i] * inv);
                        *(LAS f16x4*)(orow + 32 * dt + 8 * q4) = w; }
            }
            asm volatile("s_waitcnt lgkmcnt(0)" ::: "memory");
            const int orw = lane >> 3, och = lane & 7;
#pragma unroll
            for (int ps = 0; ps < 8; ++ps) { const int q = 8 * ps + orw; const f16x8 w = *(const LAS f16x8*)(Ow + q * 72 + 8 * och);
                *(f16x8*)(ob + (size_t)(qrow0 + q) * D + head * 64 + 8 * och) = w; }
        }
    }
}
#undef AT_TILE
#undef AT_LOAD

constexpr int NPHASE = 35;
#ifndef MK_MULTI
#define MK_MULTI 0
#endif

template <int KIND>
__attribute__((target("no-packed-fp32-ops"))) __global__ void __launch_bounds__(512, 2) hy_fwd(Params p_) {
    extern __shared__ __attribute__((aligned(16))) unsigned char shm[];
    LAS unsigned char* lds = (LAS unsigned char*)shm;
    constexpr bool ALL = KIND < 0;
    const int ph0 = p_.ph0;
    if (threadIdx.x == 0) { *(LAS u32x4*)(lds + LDS_XB) = (u32x4){0u, 0u, 0u, 0u}; }
    __syncthreads();
    XcdBarrier bar;
    if constexpr (ALL) bar = xcd_barrier_post((unsigned*)(p_.ws + WS_CTL), (volatile LAS unsigned*)(lds + LDS_XB));
#ifndef PROBE_SITE
#define PROBE_SITE -1
#endif
#define SITE(k) if constexpr (ALL || KIND == (k)) for (int rep_ = 0; rep_ < ((k) == PROBE_SITE ? 2 : 1); ++rep_) if (const Params& p = *params_fresh(); true)
#ifndef PROBE_XBAR
#define PROBE_XBAR 1
#endif
#define SEAM() do { if constexpr (ALL) { xcd_barrier(bar); if (PROBE_XBAR > 1) xcd_barrier(bar); if (PROBE_XBAR > 2) xcd_barrier(bar); } } while (0)
    const int G = gridDim.x, bid = blockIdx.x;
    SITE(0) {
        for (int u = bid; u < 4993; u += G) {
            if (u < 384) modp_unit(p, u, (LAS float*)lds);
            else if (u == 384) tables_unit(p);
            else if (u < 1473) h2_task(p, (u - 385) * 8 + (tid_fresh() >> 6));
            else if (u < 1537) w3p_unit(p, u - 1473);
            else if (u < 1793) rtab_unit(p, u - 1537);
            else cvt_dense_unit(p, u - 1793, (LAS float*)lds);
        }
        SEAM();
    }
    SITE(1) {
        for (int u = bid; u < 216; u += G) modr_unit(p, u);
        SchedFilt S{p.ws + WS_W3P, p.ws + WS_H2P}; EpiTaps E{(float*)(p.ws + WS_TAPS), (float*)(p.ws + WS_TAPSC)};
        pg8::gemm_phase<EpiTaps, SchedFilt, 0>(lds, 256, S, E);
        SEAM();
    }
#define TAIL_IDLE(nunits) (((nunits) % G) ? G - ((nunits) % G) : 0)
#define CVT_PER_GEMM 20
#pragma unroll 1
    for (int layer = ALL ? 0 : ph0; layer < (ALL ? NLAYER : ph0 + 1); ++layer) {
        const bool hyena = (layer & 1) == 0; const int jl = layer >> 1;
        const int nu1 = hyena ? 24 * 136 : 136 * 10, nu4 = (layer == NLAYER - 1 ? 128 : 136) * 8;
        const int idle1 = TAIL_IDLE(nu1), idle4 = TAIL_IDLE(nu4);
        int cv4 = idle4 * CVT_PER_GEMM, cv1 = idle1 * CVT_PER_GEMM; if (cv4 > CVT_MOE_UNITS / 2) cv4 = CVT_MOE_UNITS / 2; if (cv1 > CVT_MOE_UNITS / 2 - 1) cv1 = CVT_MOE_UNITS / 2 - 1;
        const int cvN0 = CVT_MOE_UNITS - cv1 - cv4, cvN1 = cvN0 + cv1;
        SITE(2) {
            n1_phase(p, layer, (h16*)(p.ws + ((!ALL && p.ph1) ? WS_UT : WS_XRES)));
            for (int rep2_ = 0; rep2_ < ((PROBE_SITE == 20 && layer > 0) ? 2 : 1); ++rep2_) {
            if (layer == 0) filt_fft_phase(p, lds);
            else { (void)0; } }
            SEAM();
        }
        SITE(3) {
#ifdef PROBE_CLK
            unsigned long long pc0_ = __builtin_readcyclecounter(), pr0_ = wall_clock64();
#endif
            if (hyena) { SchedPlain S{24, 136, D, p.ws + WS_WIN + (size_t)jl * D3 * D * 2, p.ws + WS_HBUF}; EpiH16 E{(h16*)(p.ws + WS_UT), TT, nullptr, 0};
                pg8::gemm_phase<EpiH16, SchedPlain, 0>(lds, D, S, E); }
            else { SchedQkv S{p.ws + WS_HBUF, p.ws + WS_WQKV + (size_t)jl * DQKV * D * 2}; EpiH16 E{(h16*)(p.ws + WS_QK), DQK, (h16*)(p.ws + WS_VT), TT};
                pg8::gemm_phase<EpiH16, SchedQkv, 0>(lds, D, S, E); }
#ifdef PROBE_CLK
            if (bid == 0 && threadIdx.x == 0) { const unsigned long long dc = __builtin_readcyclecounter() - pc0_, dr = wall_clock64() - pr0_; const unsigned long long spin = dc * 2500ull / (dr ? dr : 1ull);
                const unsigned long long t0 = wall_clock64(); while (wall_clock64() - t0 < spin) __builtin_amdgcn_s_sleep(8); }
#endif
            if (idle1 > 0 && bid >= G - idle1) { cvt_moe_share(p, layer, cvN0 + (bid - (G - idle1)), cvN1, idle1, (LAS float*)lds); }
            SEAM();
        }
        SITE(4) {
#ifdef PROBE_PAR
            for (int rep3_ = 0; rep3_ < (((layer & 1) == PROBE_PAR) ? 2 : 1); ++rep3_)
#endif
            { if (hyena) conv_phase(p, jl, lds, ALL ? 0 : p.ph1, layer, cvN0);
            else attn_phase(p, jl, layer != NLAYER - 1, lds, layer, cvN0); }
            SEAM();
        }
        SITE(5) {
            (void)0;
        }
        SITE(6) {
            EpiResid E{(h16*)(p.ws + WS_XRES), (const float*)(p.ws + WS_MODS), layer, (float*)(p.ws + WS_SSQ), (!ALL && p.ph1) ? (h16*)(p.ws + WS_YC) : (h16*)(p.ws + WS_XRES)};
            if (hyena) {
                SchedPlainAT S{layer == NLAYER - 1 ? 128 : 136, 8, D, p.ws + WS_ZT, p.ws + WS_WOUT + (size_t)jl * D * D * 2};
                pg8::gemm_phase<EpiResid, SchedPlainAT, 2>(lds, D, S, E, TT);
            } else {
                SchedPlain S{layer == NLAYER - 1 ? 128 : 136, 8, D, p.ws + WS_HBUF, p.ws + WS_WO + (size_t)jl * D * D * 2};
                pg8::gemm_phase<EpiResid, SchedPlain, 0>(lds, D, S, E);
            }
            if (idle4 > 0 && bid >= G - idle4) { cvt_moe_share(p, layer, cvN1 + (bid - (G - idle4)), CVT_MOE_UNITS, idle4, (LAS float*)lds); }
            SEAM();
        }
        SITE(7) { n2_phase(p, layer, lds, ALL ? 0 : p.ph1); SEAM(); }
        LAS int* tstart = (LAS int*)(lds + LDS_MISC); LAS int* texp = tstart + 80; LAS int* tcnt = texp + 352;
        SITE(8) {
            moe_table(tstart, texp, tcnt, (const int*)(p.ws + WS_CTL) + CTL_CNT + layer * NE);
            SchedMoe1 S{{tstart, texp, tcnt}, p.ws + WS_HBUF, p.ws + WS_W13, (const int*)(p.ws + WS_LIST)}; EpiMoe1 E{(h16*)(p.ws + WS_H1)};
            pg8::gemm_phase<EpiMoe1, SchedMoe1, 1>(lds, D, S, E);
            SEAM();
        }
        SITE(9) {
            moe_table(tstart, texp, tcnt, (const int*)(p.ws + WS_CTL) + CTL_CNT + layer * NE);
            SchedMoe2 S{{tstart, texp, tcnt}, p.ws + WS_H1, p.ws + WS_W2, (const int*)(p.ws + WS_LIST)}; EpiMoe2 E{(h16*)(p.ws + WS_YC), (const float*)(p.ws + WS_GATE), (const int*)(p.ws + WS_LIST)};
            pg8::gemm_phase<EpiMoe2, SchedMoe2, 0>(lds, DE, S, E);
            SEAM();
        }
    }
    SITE(10) final_phase(p);
#undef SITE
#undef SEAM
}

template <int KIND> static void launch_kind(const Params& p, int grid, hipStream_t stream) {
    static bool attr = false;
    if (!attr) { attr = true; if (hipFuncSetAttribute((const void*)hy_fwd<KIND>, hipFuncAttributeMaxDynamicSharedMemorySize, LDS_BYTES) != hipSuccess) fprintf(stderr, "kernel_launch: hipFuncSetAttribute failed (kind %d)\n", KIND); }
    hipLaunchKernelGGL(hy_fwd<KIND>, dim3(grid), dim3(512), LDS_BYTES, stream, p);
}

extern "C" void kernel_launch(void* const* d_in, const int* in_sizes, int n_in, void* d_out, int out_size, void* d_ws, size_t ws_size, hipStream_t stream) {
    static int grid = 0;
    if (!grid) {
        if (n_in != 29 || out_size != TL * D || ws_size < WS_END) { fprintf(stderr, "kernel_launch: unexpected problem (n_in %d, out %d, ws %zu < %zu)\n", n_in, out_size, ws_size, (size_t)WS_END); grid = -1; return; }
        int dev = 0, cus = 0;
        if (hipGetDevice(&dev) != hipSuccess || hipDeviceGetAttribute(&cus, hipDeviceAttributeMultiprocessorCount, dev) != hipSuccess) { grid = -1; return; }
        grid = cus;
    }
    if (grid <= 0) return;
    (void)hipMemsetAsync((char*)d_ws + WS_CTL, 0, CTL_BYTES, stream);
    Params p{};
    const float** pp = (const float**)&p;
    for (int i = 0; i < 29; ++i) pp[i] = (const float*)d_in[i];
    p.out = (float*)d_out; p.ws = (char*)d_ws;
#if MK_MULTI
    p.ph0 = 0; p.ph1 = 0;
    launch_kind<0>(p, grid, stream); launch_kind<1>(p, grid, stream);
#ifndef PROBE_KINDS
#define PROBE_KINDS 0
#endif
#ifndef PROBE_VAR
#define PROBE_VAR 0
#endif
#ifndef PROBE_LAYERS
#define PROBE_LAYERS 15
#endif
#define PKIND(k) ((PROBE_KINDS >> (k)) & 1)
#define PREP(k) ((PKIND(k) && ((PROBE_LAYERS >> layer) & 1)) ? 2 : 1)
    if (PKIND(0)) launch_kind<0>(p, grid, stream);
    if (PKIND(1)) launch_kind<1>(p, grid, stream);
    for (int layer = 0; layer < NLAYER; ++layer) { p.ph0 = layer;
        for (int r = 0; r < PREP(2); ++r) { p.ph1 = (PREP(2) == 2 && r == 0) ? 1 : 0; launch_kind<2>(p, grid, stream); p.ph1 = 0; }
        for (int r = 0; r < PREP(3); ++r) { p.ph1 = (PREP(3) == 2 && r == 0) ? PROBE_VAR : 0; launch_kind<3>(p, grid, stream); p.ph1 = 0; }
        for (int r = 0; r < PREP(4); ++r) { p.ph1 = (PREP(4) == 2 && r == 0) ? 1 : 0; launch_kind<4>(p, grid, stream); p.ph1 = 0; }
        if (PREP(6) == 2) { p.ph1 = 1; launch_kind<6>(p, grid, stream); p.ph1 = 0; }
        launch_kind<6>(p, grid, stream); launch_kind<7>(p, grid, stream);
        if (PREP(7) == 2) { p.ph1 = 1; launch_kind<7>(p, grid, stream); p.ph1 = 0; }
        for (int r = 0; r < PREP(8); ++r) launch_kind<8>(p, grid, stream);
        for (int r = 0; r < PREP(9); ++r) launch_kind<9>(p, grid, stream); }
    p.ph0 = 0; launch_kind<10>(p, grid, stream);
    if (PKIND(10)) launch_kind<10>(p, grid, stream);
#else
    p.ph0 = 0; p.ph1 = NPHASE;
    launch_kind<-1>(p, grid, stream);
#endif
}
```

```cpp
#include <hip/hip_runtime.h>
#include <cstdio>
#include <cstdint>

#define LAS __attribute__((address_space(3)))
typedef _Float16 h16;
typedef _Float16 f16x8 __attribute__((ext_vector_type(8)));
typedef _Float16 f16x4 __attribute__((ext_vector_type(4)));
typedef _Float16 f16x2 __attribute__((ext_vector_type(2)));
typedef float f32x2 __attribute__((ext_vector_type(2)));
typedef float f32x4 __attribute__((ext_vector_type(4)));
typedef float f32x16 __attribute__((ext_vector_type(16)));
typedef unsigned u32x2 __attribute__((ext_vector_type(2)));
typedef unsigned u32x4 __attribute__((ext_vector_type(4)));

constexpr int D = 2048, NB = 8, SEQ = 4096, CTXL = 256, TL = NB * SEQ, TC = NB * CTXL, TT = TL + TC;
constexpr int D3 = 3 * D, D6 = 6 * D, DQK = 2304, DQKV = 2560, NE = 64, DE = 384, DE2 = 768, NLAYER = 4;
constexpr int LCAP = TT;
constexpr int MOE_ROWS = 86016;
constexpr float EPS = 1e-6f;

constexpr size_t WS_CTL = 0;
constexpr size_t CTL_BYTES = 65536;
constexpr size_t WS_TW = WS_CTL + CTL_BYTES;
constexpr size_t WS_ROPE = WS_TW + 65536;
constexpr size_t WS_MODP = WS_ROPE + 8192;
constexpr size_t WS_MODS = WS_MODP + 16ull * 4 * 9 * 12288 * 4;
constexpr size_t WS_RTAB = WS_MODS + 4ull * 9 * 12288 * 4;
constexpr size_t RTAB_L = 64ull * 5 * 2 * 64 * 8 * 2;
constexpr size_t WS_RCST = WS_RTAB + 4 * RTAB_L;
constexpr size_t WS_H2P = WS_RCST + 16384;
constexpr size_t WS_W3P = WS_H2P + 2ull * 4352 * 256 * 2;
constexpr size_t WS_XRES = WS_W3P + 2ull * 8192 * 256 * 2;
constexpr size_t WS_HBUF = WS_XRES + (size_t)TT * D * 4;
constexpr size_t WS_UT = WS_HBUF + (size_t)TT * D * 2;
constexpr size_t UT_BYTES = (size_t)D3 * TT * 2;
constexpr size_t WS_TAPS = WS_UT;
constexpr size_t WS_TAPSC = WS_TAPS + 2ull * 8192 * 4096 * 4;
constexpr size_t WS_QK = WS_UT;
constexpr size_t WS_VT = WS_QK + (size_t)TT * DQK * 2;
constexpr size_t WS_ZT = WS_UT + UT_BYTES;
constexpr size_t WS_H1 = WS_ZT + (size_t)D * TT * 2;
constexpr size_t WS_YC = WS_H1 + (size_t)MOE_ROWS * DE * 2;
constexpr size_t WS_WIN = WS_YC + 2ull * TT * D * 2;
constexpr size_t WS_WOUT = WS_WIN + 2ull * D3 * D * 2;
constexpr size_t WS_WQKV = WS_WOUT + 2ull * D * D * 2;
constexpr size_t WS_WO = WS_WQKV + 2ull * DQKV * D * 2;
constexpr size_t WS_W13 = WS_WO + 2ull * D * D * 2;
constexpr size_t WS_W2 = WS_W13 + (size_t)NE * DE2 * D * 2;
constexpr size_t WS_KF = WS_W2 + (size_t)NE * D * DE * 2;
constexpr size_t WS_KFC = WS_KF + 2ull * 2 * 2048 * 65536;
constexpr size_t WS_LIST = WS_KFC + 2ull * 2 * 2048 * 4096;
constexpr size_t WS_GATE = WS_LIST + (size_t)NE * LCAP * 4;
constexpr size_t WS_SSQ = WS_GATE + (size_t)NE * LCAP * 4;
constexpr size_t WS_END = WS_SSQ + (size_t)TT * 32 * 4;
static_assert(WS_TAPSC + 2ull * 8192 * 256 * 4 <= WS_UT + UT_BYTES, "taps alias");
static_assert(WS_VT + 256ull * TT * 2 <= WS_UT + UT_BYTES, "qkv alias");

constexpr int CTL_CNT = 4096;

constexpr int LDS_BYTES = 147456;
constexpr int LDS_MISC = 139264;
constexpr int LDS_XB = LDS_BYTES - 16;

struct Params {
    const float *x, *c, *ctx, *c_ctx, *mod_w, *mod_b, *hy_w_in, *hy_conv_w, *hy_conv_b, *hy_f_w1, *hy_f_b1, *hy_f_freq1, *hy_f_w2, *hy_f_b2, *hy_f_freq2, *hy_f_w3,
        *hy_bias, *hy_w_out, *at_w_qkv, *at_sink, *at_w_o, *moe_wg, *moe_bg, *moe_we, *moe_be, *moe_w1, *moe_w3, *moe_w2, *final_gain;
    float* out; char* ws; int ph0, ph1;
};

__device__ __forceinline__ int tid_fresh() { int t = threadIdx.x; asm volatile("" : "+v"(t)); return t; }
__device__ __forceinline__ float bperm_f(float v, int srclane) { return __int_as_float(__builtin_amdgcn_ds_bpermute(srclane << 2, __float_as_int(v))); }
__device__ __forceinline__ float shx(float v, int mask) { return bperm_f(v, (tid_fresh() & 63) ^ mask); }
__device__ __forceinline__ const Params* params_fresh() { auto q = __builtin_amdgcn_kernarg_segment_ptr(); asm volatile("" : "+s"(q)); return (const Params*)q; }

#define XB_TMO      128
#define XB_XCNT(j)  (256  + 64 * (j))
#define XB_XSUB(j)  (1280 + 64 * (j))
#define XB_XGEN(j)  (2304 + 64 * (j))
#define XB_TOP      3328
#define XB_TOPGEN   3392
#define XCD_BAR_WORDS 3456
#define XB_SPIN_CAP (1u << 18)

__device__ __forceinline__ unsigned xb_ld(unsigned* p)              { return __hip_atomic_load(p, __ATOMIC_RELAXED, __HIP_MEMORY_SCOPE_AGENT); }
__device__ __forceinline__ unsigned xb_add(unsigned* p, unsigned v) { return __hip_atomic_fetch_add(p, v, __ATOMIC_RELAXED, __HIP_MEMORY_SCOPE_AGENT); }
__device__ __forceinline__ unsigned xb_xcc_id() { return (unsigned)__builtin_amdgcn_s_getreg((3 << 11) | 20) & 0xFu; }
#define XB_SPIN(cond, bar) do { unsigned _sp = 0; while (cond) { __builtin_amdgcn_s_sleep(1); \
    if ((++_sp & 255u) == 0u) { if (xb_ld(&(bar)[XB_TMO])) break; if (_sp > XB_SPIN_CAP) { atomicAdd(&(bar)[XB_TMO], 1u); break; } } } } while (0)

struct XcdBarrier { unsigned* bar; volatile LAS unsigned* st; };

__device__ __forceinline__ XcdBarrier xcd_barrier_post(unsigned* bar, volatile LAS unsigned* st) {
    XcdBarrier b; b.bar = bar; b.st = st;
    if (threadIdx.x == 0) (void)xb_add(&bar[XB_XCNT(xb_xcc_id())], 1u);
    return b;
}
__device__ __forceinline__ void xcd_barrier_complete(unsigned* bar, unsigned x, unsigned& nloc, unsigned& nx) {
    const unsigned G = gridDim.x * gridDim.y * gridDim.z;
    unsigned sum, cnt, mine, sp = 0u;
    for (;;) {
        sum = 0u; cnt = 0u; mine = 0u;
#pragma unroll
        for (unsigned j = 0; j < 16; ++j) { const unsigned c = xb_ld(&bar[XB_XCNT(j)]); sum += c; cnt += (c > 0u) ? 1u : 0u; mine = (j == x) ? c : mine; }
        if (sum == G) break;
        __builtin_amdgcn_s_sleep(1);
        if ((++sp & 255u) == 0u) { if (xb_ld(&bar[XB_TMO])) break; if (sp > XB_SPIN_CAP) { atomicAdd(&bar[XB_TMO], 1u); break; } }
    }
    nloc = mine > 0u ? mine : 1u; nx = cnt > 0u ? cnt : 1u;
}
__device__ __forceinline__ void xcd_barrier(const XcdBarrier& b) {
    asm volatile("s_waitcnt vmcnt(0)" ::: "memory");
    __syncthreads();
    if (threadIdx.x == 0) {
        unsigned* bar = b.bar; const unsigned bx = xb_xcc_id();
        __builtin_amdgcn_s_waitcnt(0);
        unsigned nloc = b.st[0], nx = b.st[1];
        if (nloc == 0u) { xcd_barrier_complete(bar, bx, nloc, nx); b.st[0] = nloc; b.st[1] = nx; }
        const unsigned old = xb_add(&bar[XB_XSUB(bx)], 1u);
        const unsigned gen = old / nloc;
        if (old + 1u == (gen + 1u) * nloc) {
            __builtin_amdgcn_fence(__ATOMIC_RELEASE, "agent");
            asm volatile("s_waitcnt vmcnt(0)" ::: "memory");
            const unsigned og = xb_add(&bar[XB_TOP], 1u);
            const unsigned tg = og / nx;
            if (og + 1u == (tg + 1u) * nx) xb_add(&bar[XB_TOPGEN], 1u);
            else XB_SPIN(xb_ld(&bar[XB_TOPGEN]) == tg, bar);
            __builtin_amdgcn_fence(__ATOMIC_ACQUIRE, "agent");
            xb_add(&bar[XB_XGEN(bx)], 1u);
            asm volatile("s_waitcnt vmcnt(0)" ::: "memory");
        } else {
            XB_SPIN(xb_ld(&bar[XB_XGEN(bx)]) == gen, bar);
            __builtin_amdgcn_fence(__ATOMIC_ACQUIRE, "agent");
            asm volatile("s_waitcnt vmcnt(0)" ::: "memory");
        }
    }
    __syncthreads();
}

namespace pg8 {
constexpr int BM = 256, BK = 64, HALF = 128, HTB = HALF * BK * 2, STAGE_BYTES = 8 * HTB;
__device__ __forceinline__ int lds_byte(int r, int c) { const int st = (r >> 4) * 2 + (c >> 5), rr = r & 15, cc = c & 31, ob = rr * 64 + cc * 2; return st * 1024 + (ob ^ (((ob >> 9) & 1) << 5)); }
__device__ __forceinline__ void stage_rc(int b, int& R, int& C) { const int st = b / 1024, sb = b % 1024, swz = sb ^ (((sb >> 9) & 1) << 5); R = (st >> 1) * 16 + swz / 64; C = (st & 1) * 32 + (swz % 64) / 2; }
__device__ __forceinline__ int perm32(int rho) { const int n = rho >> 4, i = rho & 15; return 8 * (i >> 2) + 4 * n + (i & 3); }

struct Unit {
    int pm, pn;
    int e, pos0, cnt;
    int kind;
    int half;
    const char* A; const char* B;
    const int* rows;
};

typedef short s16x4 __attribute__((ext_vector_type(4)));
template <class Epi, class Sched, int AMODE>
__device__ __forceinline__ void gemm_phase(LAS unsigned char* lds, const int K, const Sched& S, const Epi& E, const int ldat = 0) {
    constexpr bool GATHER = AMODE == 1, ATR = AMODE == 2;
    const int tid = tid_fresh(), wid = __builtin_amdgcn_readfirstlane(tid >> 6), lane = tid & 63, wr = wid >> 2, wc = wid & 3, fr = lane & 15, fq = lane >> 4;
    const int nt = K / BK;
    unsigned voffA[2], voffB[2]; int RA[2], CA[2];
#pragma unroll
    for (int i = 0; i < 2; ++i) { int R, C; stage_rc(tid * 16 + i * 8192, R, C); const int Rb = Epi::PERM ? ((R & ~31) + perm32(R & 31)) : R;
        voffA[i] = (unsigned)(R * K + C) * 2u; voffB[i] = (unsigned)(Rb * K + C) * 2u; RA[i] = R; CA[i] = C;
        if constexpr (ATR) { const int bb = tid * 16 + i * 8192, row = bb >> 8, pc = (bb >> 4) & 15, ch = pc ^ (((row & 3) << 2) | ((row >> 2) & 3)); voffA[i] = (unsigned)(row * ldat + 8 * ch) * 2u; } }
    const size_t kstep = (size_t)(BK * 2);
    const size_t hstep = (size_t)HALF * K * 2;
    const size_t kstepA = ATR ? (size_t)BK * ldat * 2 : kstep, hstepA = ATR ? (size_t)HALF * 2 : hstep;
    const unsigned ldsw = (unsigned)wid * 1024u;
    const int aoff = lds_byte(wr * 64 + fr, fq * 8), boff = lds_byte(wc * 32 + fr, fq * 8);
    int atr[4][2];
#pragma unroll
    for (int m = 0; m < 4; ++m)
#pragma unroll
        for (int bl = 0; bl < 2; ++bl) { const int xr = ((fr >> 2) << 2) | ((2 * fq + bl) & 3); atr[m][bl] = (int)(unsigned)(uintptr_t)lds + 256 * (8 * fq + (fr >> 2) + 4 * bl) + 16 * ((wr * 8 + 2 * m + ((fr & 3) >> 1)) ^ xr) + 8 * (fr & 1); }
    unsigned vgC[2][2], vgN[2][2];
#define PG8_ROWS(u, vg) do { if constexpr (GATHER) { _Pragma("unroll") for (int _h = 0; _h < 2; ++_h) _Pragma("unroll") for (int _i = 0; _i < 2; ++_i) { \
        const int _p = (u).pos0 + _h * HALF + RA[_i]; const int _tok = (_p < (u).cnt) ? ((u).rows[_h * HALF + RA[_i]] >> 1) : 0; \
        vg[_h][_i] = ((unsigned)_tok * (unsigned)K + (unsigned)CA[_i]) * 2u; } } } while (0)
#define PG8_SA(b, h) (((b) * 2 + (h)) * HTB)
#define PG8_SB(b, h) ((4 + (b) * 2 + (h)) * HTB)
#define PG8_STAGE_B(bufoff, gbase) do { _Pragma("unroll") for (int _i = 0; _i < 2; ++_i) \
        __builtin_amdgcn_global_load_lds((const unsigned*)((const char*)(gbase) + voffB[_i]), (LAS unsigned*)(lds + (bufoff) + ldsw + _i * 8192), 16, 0, 0); } while (0)
#define PG8_STAGE_A(bufoff, gbase, h, NEXT) do { _Pragma("unroll") for (int _i = 0; _i < 2; ++_i) { \
        const unsigned _vo = GATHER ? ((NEXT) ? vgN[h][_i] : vgC[h][_i]) : voffA[_i]; \
        __builtin_amdgcn_global_load_lds((const unsigned*)((const char*)(gbase) + (GATHER ? (size_t)0 : (size_t)(h) * hstepA) + _vo), (LAS unsigned*)(lds + (bufoff) + ldsw + _i * 8192), 16, 0, 0); } } while (0)
#define PG8_LDA(dst, b, h) do { if constexpr (!ATR) { _Pragma("unroll") for (int m = 0; m < 4; ++m) _Pragma("unroll") for (int k = 0; k < 2; ++k) dst[m][k] = *(const LAS f16x8*)(lds + PG8_SA(b, h) + aoff + m * 2048 + k * 1024); } \
        else { _Pragma("unroll") for (int m = 0; m < 4; ++m) _Pragma("unroll") for (int k = 0; k < 2; ++k) { s16x4 _lo, _hi; \
            asm volatile("ds_read_b64_tr_b16 %0, %1 offset:%2" : "=v"(_lo) : "v"(atr[m][0]), "i"(PG8_SA(b, h) + k * 8192) : "memory"); \
            asm volatile("ds_read_b64_tr_b16 %0, %1 offset:%2" : "=v"(_hi) : "v"(atr[m][1]), "i"(PG8_SA(b, h) + k * 8192) : "memory"); \
            const short __attribute__((ext_vector_type(8))) _v = {_lo[0], _lo[1], _lo[2], _lo[3], _hi[0], _hi[1], _hi[2], _hi[3]}; dst[m][k] = __builtin_bit_cast(f16x8, _v); } } } while (0)
#define PG8_PIN(At) do { if constexpr (ATR) asm volatile("" : "+v"(At[0][0]), "+v"(At[0][1]), "+v"(At[1][0]), "+v"(At[1][1]), "+v"(At[2][0]), "+v"(At[2][1]), "+v"(At[3][0]), "+v"(At[3][1])); } while (0)
#define PG8_LDB(dst, b, h) do { _Pragma("unroll") for (int n = 0; n < 2; ++n) _Pragma("unroll") for (int k = 0; k < 2; ++k) dst[n][k] = *(const LAS f16x8*)(lds + PG8_SB(b, h) + boff + n * 2048 + k * 1024); } while (0)
#define PG8_MMA(ai, bj, At, Bt) do { __builtin_amdgcn_s_setprio(1); _Pragma("unroll") for (int m = 0; m < 4; ++m) _Pragma("unroll") for (int n = 0; n < 2; ++n) _Pragma("unroll") for (int k = 0; k < 2; ++k) \
        acc[ai][bj][m][n] = __builtin_amdgcn_mfma_f32_16x16x32_f16(Bt[n][k], At[m][k], acc[ai][bj][m][n], 0, 0, 0); __builtin_amdgcn_s_setprio(0); } while (0)
#define PG8_WAIT_V(n) asm volatile("s_waitcnt vmcnt(" #n ")" ::: "memory")
#define PG8_WAIT_L(n) asm volatile("s_waitcnt lgkmcnt(" #n ")" ::: "memory")
#define PG8_BAR __builtin_amdgcn_s_barrier()
#define PG8_SCHED __builtin_amdgcn_sched_barrier(0)
    Unit cur, nxt; int ui = 0;
    if (!S.next(0, cur)) return;
    f32x4 acc[2][2][4][2];
#pragma unroll
    for (int a = 0; a < 2; ++a)
#pragma unroll
        for (int b = 0; b < 2; ++b)
#pragma unroll
            for (int m = 0; m < 4; ++m)
#pragma unroll
                for (int n = 0; n < 2; ++n) acc[a][b][m][n] = (f32x4){0.f, 0.f, 0.f, 0.f};
    f16x8 At[4][2], B0[2][2], B1[2][2];
    const char* cA = cur.A; const char* cB = cur.B;
    PG8_ROWS(cur, vgC);
#pragma unroll
    for (int _h = 0; _h < 2; ++_h)
#pragma unroll
        for (int _i = 0; _i < 2; ++_i) vgN[_h][_i] = GATHER ? vgC[_h][_i] : 0u;
    PG8_STAGE_B(PG8_SB(0, 0), cB); PG8_STAGE_B(PG8_SB(0, 1), cB + hstep); PG8_STAGE_A(PG8_SA(0, 0), cA, 0, false); PG8_STAGE_A(PG8_SA(0, 1), cA, 1, false);
    if (wr == 1) PG8_BAR;
    PG8_WAIT_V(2); PG8_BAR;
    PG8_STAGE_B(PG8_SB(1, 0), cB + kstep); PG8_STAGE_A(PG8_SA(1, 0), cA + kstepA, 0, false); PG8_STAGE_B(PG8_SB(1, 1), cB + hstep + kstep);
    PG8_WAIT_V(6); PG8_BAR;
    for (;;) {
        const bool has_next = S.next(ui + 1, nxt);
        const bool full = cur.half == 0;
        const char* nA = has_next ? nxt.A : cA; const char* nB = has_next ? nxt.B : cB;
        if (has_next) { PG8_ROWS(nxt, vgN); }
        typename Epi::Pre pre; E.prefetch(cur, wr, fr, pre);
#pragma unroll 1
        for (int t = 0; t < nt; t += 2) {
            const bool last = (t == nt - 2);
            const char* a1 = cA + (size_t)(t + 1) * kstepA;
            const char* a2 = last ? nA : cA + (size_t)(t + 2) * kstepA; const char* b2 = last ? nB : cB + (size_t)(t + 2) * kstep;
            const char* a3 = a2 + kstepA; const char* b3 = b2 + kstep;
            PG8_LDB(B0, 0, 0); PG8_LDB(B1, 0, 1); PG8_SCHED; PG8_LDA(At, 0, 0); PG8_STAGE_A(PG8_SA(1, 1), a1, 1, false);
            PG8_WAIT_V(8); PG8_WAIT_L(0); PG8_PIN(At); PG8_BAR; PG8_MMA(0, 0, At, B0); PG8_MMA(0, 1, At, B1); PG8_BAR; PG8_SCHED;
            PG8_LDA(At, 0, 1); PG8_STAGE_B(PG8_SB(0, 0), b2); PG8_STAGE_B(PG8_SB(0, 1), b2 + hstep); PG8_STAGE_A(PG8_SA(0, 0), a2, 0, last);
            PG8_WAIT_V(8); PG8_WAIT_L(0); PG8_PIN(At); PG8_BAR; if (full) { PG8_MMA(1, 0, At, B0); PG8_MMA(1, 1, At, B1); } PG8_BAR; PG8_SCHED;
            PG8_LDB(B0, 1, 0); PG8_LDB(B1, 1, 1); PG8_SCHED; PG8_LDA(At, 1, 0); PG8_STAGE_A(PG8_SA(0, 1), a2, 1, last);
            PG8_WAIT_V(8); PG8_WAIT_L(0); PG8_PIN(At); PG8_BAR; PG8_MMA(0, 0, At, B0); PG8_MMA(0, 1, At, B1); PG8_BAR; PG8_SCHED;
            PG8_LDA(At, 1, 1); PG8_STAGE_B(PG8_SB(1, 0), b3); PG8_STAGE_B(PG8_SB(1, 1), b3 + hstep); PG8_STAGE_A(PG8_SA(1, 0), a3, 0, last);
            PG8_WAIT_V(8); PG8_WAIT_L(0); PG8_PIN(At); PG8_BAR; if (full) { PG8_MMA(1, 0, At, B0); PG8_MMA(1, 1, At, B1); } PG8_BAR; PG8_SCHED;
        }
        if (wr == 0) PG8_BAR;
        E(acc, cur, wr, wc, fr, fq, pre);
        if (!has_next) break;
#pragma unroll
        for (int a = 0; a < 2; ++a)
#pragma unroll
            for (int b = 0; b < 2; ++b)
#pragma unroll
                for (int m = 0; m < 4; ++m)
#pragma unroll
                    for (int n = 0; n < 2; ++n) acc[a][b][m][n] = (f32x4){0.f, 0.f, 0.f, 0.f};
        cur = nxt; cA = nA; cB = nB; ++ui;
#pragma unroll
        for (int _h = 0; _h < 2; ++_h)
#pragma unroll
            for (int _i = 0; _i < 2; ++_i) vgC[_h][_i] = vgN[_h][_i];
        if (wr == 1) PG8_BAR;
    }
    PG8_WAIT_V(0);
    PG8_BAR;
#undef PG8_ROWS
#undef PG8_SA
#undef PG8_SB
#undef PG8_STAGE_A
#undef PG8_STAGE_B
#undef PG8_LDA
#undef PG8_LDB
#undef PG8_PIN
#undef PG8_MMA
#undef PG8_WAIT_V
#undef PG8_WAIT_L
#undef PG8_BAR
#undef PG8_SCHED
}
}

using pg8::Unit;
__device__ __forceinline__ f16x8 pack8(const f32x4 a, const f32x4 b) {
    f16x8 w; w[0] = (h16)a[0]; w[1] = (h16)a[1]; w[2] = (h16)a[2]; w[3] = (h16)a[3]; w[4] = (h16)b[0]; w[5] = (h16)b[1]; w[6] = (h16)b[2]; w[7] = (h16)b[3]; return w;
}
struct EpiH16 {
    static constexpr bool PERM = true;
    h16* O0; int ld0; h16* O1; int ld1;
    struct Pre {}; __device__ __forceinline__ void prefetch(const Unit&, int, int, Pre&) const {}
    __device__ __forceinline__ void operator()(const f32x4 (&acc)[2][2][4][2], const Unit& u, int wr, int wc, int fr, int fq, const Pre&) const {
        h16* base = u.kind ? O1 : O0; const int ld = u.kind ? ld1 : ld0;
        const int row0 = u.pm * 256 + wr * 64 + fr, col0 = u.pn * 256 + wc * 32 + 8 * fq;
#pragma unroll
        for (int ai = 0; ai < 2; ++ai)
#pragma unroll
            for (int m = 0; m < 4; ++m) { h16* rowp = base + (size_t)(row0 + ai * 128 + m * 16) * ld + col0;
#pragma unroll
                for (int bj = 0; bj < 2; ++bj) __builtin_nontemporal_store(pack8(acc[ai][bj][m][0], acc[ai][bj][m][1]), (f16x8*)(rowp + bj * 128)); }
    }
};
struct EpiTaps {
    static constexpr bool PERM = false;
    float* T0; float* T1;
    struct Pre {}; __device__ __forceinline__ void prefetch(const Unit&, int, int, Pre&) const {}
    __device__ __forceinline__ void operator()(const f32x4 (&acc)[2][2][4][2], const Unit& u, int wr, int wc, int fr, int fq, const Pre&) const {
        const int j = u.kind >> 1, v = u.kind & 1; const int ld = v ? 256 : 4096;
        float* base = v ? (T1 + (size_t)j * 8192 * 256) : (T0 + (size_t)j * 8192 * 4096);
        const int row0 = u.pm * 256 + wr * 64 + fr, col0 = u.pn * 256 + wc * 32 + 4 * fq;
#pragma unroll
        for (int ai = 0; ai < 2; ++ai)
#pragma unroll
            for (int m = 0; m < 4; ++m) { float* rowp = base + (size_t)(row0 + ai * 128 + m * 16) * ld + col0;
#pragma unroll
                for (int bj = 0; bj < 2; ++bj)
#pragma unroll
                    for (int n = 0; n < 2; ++n) *(f32x4*)(rowp + bj * 128 + n * 16) = acc[ai][bj][m][n]; }
    }
};
struct EpiResid {
    static constexpr bool PERM = true;
    h16* X; const float* mods; int layer; float* SSQ; h16* XO;
    struct Pre {}; __device__ __forceinline__ void prefetch(const Unit&, int, int, Pre&) const {}
    __device__ __forceinline__ void operator()(const f32x4 (&acc)[2][2][4][2], const Unit& u, int wr, int wc, int fr, int fq, const Pre&) const {
        const int r0 = u.pm * 256; const int b = r0 < TL ? (r0 >> 12) : 8;
        const float* g = mods + ((size_t)(layer * 9 + b) * 6 + 2) * D;
        const int row0 = r0 + wr * 64 + fr, col0 = u.pn * 256 + wc * 32 + 8 * fq;
        f32x4 gv[2][2];
#pragma unroll
        for (int bj = 0; bj < 2; ++bj)
#pragma unroll
            for (int n = 0; n < 2; ++n) gv[bj][n] = *(const f32x4*)(g + col0 + bj * 128 + n * 4);
#pragma unroll
        for (int ai = 0; ai < 2; ++ai)
#pragma unroll
            for (int m = 0; m < 4; ++m) { const int row = row0 + ai * 128 + m * 16; const h16* rowp = X + (size_t)row * D + col0; h16* rowo = XO + (size_t)row * D + col0; float sq = 0.f;
#pragma unroll
                for (int bj = 0; bj < 2; ++bj) { const f16x8 xv = *(const f16x8*)(rowp + bj * 128); f32x4 v0, v1;
#pragma unroll
                    for (int i = 0; i < 4; ++i) { v0[i] = (float)xv[i] + gv[bj][0][i] * acc[ai][bj][m][0][i]; v1[i] = (float)xv[4 + i] + gv[bj][1][i] * acc[ai][bj][m][1][i]; }
                    const f16x8 w = pack8(v0, v1); *(f16x8*)(rowo + bj * 128) = w;
#pragma unroll
                    for (int i = 0; i < 8; ++i) { const float t = (float)w[i]; sq += t * t; } }
                sq += shx(sq, 16); sq += shx(sq, 32);
                if (fq == 0) SSQ[(size_t)row * 32 + u.pn * 4 + wc] = sq; }
    }
};
struct EpiMoe1 {
    static constexpr bool PERM = true;
    h16* H1;
    struct Pre {}; __device__ __forceinline__ void prefetch(const Unit&, int, int, Pre&) const {}
    __device__ __forceinline__ void operator()(const f32x4 (&acc)[2][2][4][2], const Unit& u, int wr, int wc, int fr, int fq, const Pre&) const {
        const int row0 = u.pm * 256 + wr * 64 + fr, col0 = u.pn * 128 + wc * 16 + 4 * fq;
#pragma unroll
        for (int ai = 0; ai < 2; ++ai)
#pragma unroll
            for (int m = 0; m < 4; ++m) { if (ai == 1 && u.half) continue; h16* rowp = H1 + (size_t)(row0 + ai * 128 + m * 16) * DE + col0;
#pragma unroll
                for (int bj = 0; bj < 2; ++bj) { const f32x4 a = acc[ai][bj][m][0], b = acc[ai][bj][m][1]; f16x4 w;
#pragma unroll
                    for (int i = 0; i < 4; ++i) { const float s = a[i] / (1.0f + __expf(-a[i])); w[i] = (h16)(s * b[i]); }
                    *(f16x4*)(rowp + bj * 64) = w; } }
    }
};
struct EpiMoe2 {
    static constexpr bool PERM = true;
    h16* YC; const float* gslot;
    struct Pre { int av[2][4]; float gv[2][4]; };
    __device__ __forceinline__ void prefetch(const Unit& u, int wr, int fr, Pre& q) const {
        const float* grow = gslot + ((const char*)u.rows - (const char*)listbase) / 4;
#pragma unroll
        for (int ai = 0; ai < 2; ++ai)
#pragma unroll
            for (int m = 0; m < 4; ++m) { const int r = ai * 128 + wr * 64 + m * 16 + fr; const bool ok = u.pos0 + r < u.cnt; q.av[ai][m] = ok ? u.rows[r] : -1; q.gv[ai][m] = ok ? grow[r] : 0.f; }
    }
    __device__ __forceinline__ void operator()(const f32x4 (&acc)[2][2][4][2], const Unit& u, int wr, int wc, int fr, int fq, const Pre& q) const {
        const int col0 = u.pn * 256 + wc * 32 + 8 * fq;
#pragma unroll
        for (int ai = 0; ai < 2; ++ai)
#pragma unroll
            for (int m = 0; m < 4; ++m) { if (q.av[ai][m] >= 0) { const float g = q.gv[ai][m]; h16* rowp = YC + (size_t)q.av[ai][m] * D + col0;
#pragma unroll
                    for (int bj = 0; bj < 2; ++bj) *(f16x8*)(rowp + bj * 128) = pack8(acc[ai][bj][m][0] * g, acc[ai][bj][m][1] * g); } }
    }
    const int* listbase;
};

__device__ __forceinline__ void order_tile(int wgid, int nM, int nN, int& pm, int& pn) {
    const int nwg = nM * nN; { const int q = nwg / 8, r = nwg % 8, xcd = wgid % 8, off = wgid / 8; wgid = (xcd < r ? xcd * (q + 1) : r * (q + 1) + (xcd - r) * q) + off; }
    const int nig = 8 * nN, gid = wgid / nig, fm = gid * 8, gsz = (nM - fm) < 8 ? (nM - fm) : 8;
    pm = fm + ((wgid % nig) % gsz); pn = (wgid % nig) / gsz;
}
struct SchedPlain {
    int nM, nN, K; const char* A; const char* B;
    __device__ __forceinline__ bool next(int i, Unit& u) const {
        const long L = (long)i * gridDim.x + blockIdx.x; if (L >= (long)nM * nN) return false;
        order_tile((int)L, nM, nN, u.pm, u.pn); u.kind = 0; u.half = 0; u.e = 0; u.pos0 = 0; u.cnt = 0; u.rows = nullptr;
        u.A = A + (size_t)u.pm * 256 * K * 2; u.B = B + (size_t)u.pn * 256 * K * 2; return true;
    }
};
struct SchedPlainAT {
    int nM, nN, K; const char* At; const char* B;
    __device__ __forceinline__ bool next(int i, Unit& u) const {
        const long L = (long)i * gridDim.x + blockIdx.x; if (L >= (long)nM * nN) return false;
        order_tile((int)L, nM, nN, u.pm, u.pn); u.kind = 0; u.half = 0; u.e = 0; u.pos0 = 0; u.cnt = 0; u.rows = nullptr;
        u.A = At + (size_t)u.pm * 256 * 2; u.B = B + (size_t)u.pn * 256 * K * 2; return true;
    }
};
struct SchedQkv {
    const char* H; const char* W;
    __device__ __forceinline__ bool next(int i, Unit& u) const {
        const long L = (long)i * gridDim.x + blockIdx.x; const int nA = 136 * 9; if (L >= nA + 136) return false;
        u.e = 0; u.half = 0; u.pos0 = 0; u.cnt = 0; u.rows = nullptr;
        if (L < nA) { order_tile((int)L, 136, 9, u.pm, u.pn); u.kind = 0; u.A = H + (size_t)u.pm * 256 * D * 2; u.B = W + (size_t)u.pn * 256 * D * 2; }
        else { u.pm = 0; u.pn = (int)L - nA; u.kind = 1; u.A = W + (size_t)DQK * D * 2; u.B = H + (size_t)u.pn * 256 * D * 2; }
        return true;
    }
};
struct SchedFilt {
    const char* W3P; const char* H2P;
    __device__ __forceinline__ bool next(int i, Unit& u) const {
        const long L = (long)i * gridDim.x + blockIdx.x; if (L >= 2 * 544) return false;
        const int j = (int)L / 544, r = (int)L % 544; u.e = 0; u.half = 0; u.pos0 = 0; u.cnt = 0; u.rows = nullptr;
        int v; if (r < 512) { v = 0; u.pm = r >> 4; u.pn = r & 15; } else { v = 1; u.pm = r - 512; u.pn = 0; }
        u.kind = 2 * j + v;
        u.A = W3P + ((size_t)j * 8192 + (size_t)u.pm * 256) * 256 * 2;
        u.B = H2P + ((size_t)j * 4352 + (v ? 4096 : 0) + (size_t)u.pn * 256) * 256 * 2;
        return true;
    }
};
struct MoeTab { const LAS int* tstart; const LAS int* texp; const LAS int* cnt; };
struct SchedMoe1 {
    MoeTab tb; const char* H; const char* W13; const int* list;
    __device__ __forceinline__ bool next(int i, Unit& u) const {
        const long L = (long)i * gridDim.x + blockIdx.x; const int ntile = __builtin_amdgcn_readfirstlane(tb.tstart[NE]); if (L >= (long)ntile * 3) return false;
        int rt; order_tile((int)L, ntile, 3, rt, u.pn); u.pm = rt; u.kind = 0;
        const int e = __builtin_amdgcn_readfirstlane(tb.texp[rt]); u.e = e; u.pos0 = (rt - __builtin_amdgcn_readfirstlane(tb.tstart[e])) * 256; u.cnt = __builtin_amdgcn_readfirstlane(tb.cnt[e]); u.half = (u.cnt - u.pos0 <= 128) ? 1 : 0;
        u.rows = list + (size_t)e * LCAP + u.pos0; u.A = H; u.B = W13 + ((size_t)e * DE2 + (size_t)u.pn * 256) * D * 2; return true;
    }
};
struct SchedMoe2 {
    MoeTab tb; const char* H1; const char* W2; const int* list;
    __device__ __forceinline__ bool next(int i, Unit& u) const {
        const long L = (long)i * gridDim.x + blockIdx.x; const int ntile = __builtin_amdgcn_readfirstlane(tb.tstart[NE]); if (L >= (long)ntile * 8) return false;
        int rt; order_tile((int)L, ntile, 8, rt, u.pn); u.pm = rt; u.kind = 0;
        const int e = __builtin_amdgcn_readfirstlane(tb.texp[rt]); u.e = e; u.pos0 = (rt - __builtin_amdgcn_readfirstlane(tb.tstart[e])) * 256; u.cnt = __builtin_amdgcn_readfirstlane(tb.cnt[e]); u.half = (u.cnt - u.pos0 <= 128) ? 1 : 0;
        u.rows = list + (size_t)e * LCAP + u.pos0; u.A = H1 + (size_t)rt * 256 * DE * 2; u.B = W2 + ((size_t)e * D + (size_t)u.pn * 256) * DE * 2; return true;
    }
};
__device__ __forceinline__ void moe_table(LAS int* tstart, LAS int* texp, LAS int* cnt, const int* counters) {
    const int t = tid_fresh();
    if (t < NE) cnt[t] = counters[t];
    __syncthreads();
    if (t <= NE) { int s = 0; for (int e = 0; e < t; ++e) s += (cnt[e] + 255) >> 8; tstart[t] = s; }
    __syncthreads();
    if (t < NE) { const int s0 = tstart[t], s1 = tstart[t + 1]; for (int q = s0; q < s1; ++q) texp[q] = t; }
    __syncthreads();
}

__device__ __forceinline__ float wave_sum(float v) {
#pragma unroll
    for (int o = 32; o >= 1; o >>= 1) v += shx(v, o);
    return v;
}
__device__ __forceinline__ float silu_f(float x) { return x / (1.0f + expf(-x)); }
__device__ __forceinline__ int batch_of_row(int r) { return r < TL ? (r >> 12) : 8; }

__device__ __forceinline__ void modp_unit(const Params& p, int unit, LAS float* sl) {
    const int layer = unit / 96, rem = unit % 96, ks = rem / 6, cc = rem % 6, tid = tid_fresh();
    for (int i = tid; i < 9 * 128; i += 512) { const int cnd = i >> 7, k = ks * 128 + (i & 127); const float v = cnd < 8 ? p.c[cnd * D + k] : p.c_ctx[k]; sl[i] = silu_f(v); }
    __syncthreads();
    f32x4 acc[9];
#pragma unroll
    for (int q = 0; q < 9; ++q) acc[q] = (f32x4){0.f, 0.f, 0.f, 0.f};
    const float* w = p.mod_w + ((size_t)layer * D + (size_t)ks * 128) * D6 + cc * 2048 + tid * 4;
#pragma unroll 4
    for (int k = 0; k < 128; ++k) { const f32x4 wv = *(const f32x4*)(w + (size_t)k * D6);
#pragma unroll
        for (int q = 0; q < 9; ++q) acc[q] += wv * sl[q * 128 + k]; }
    float* outp = (float*)(p.ws + WS_MODP) + ((size_t)(ks * 4 + layer) * 9) * D6 + cc * 2048 + tid * 4;
#pragma unroll
    for (int q = 0; q < 9; ++q) *(f32x4*)(outp + (size_t)q * D6) = acc[q];
    __syncthreads();
}
__device__ __forceinline__ void modr_unit(const Params& p, int unit) {
    const size_t idx = (size_t)unit * 2048 + tid_fresh() * 4; const int layer = (int)(idx / (9 * D6)), col = (int)(idx % D6);
    f32x4 s = *(const f32x4*)(p.mod_b + (size_t)layer * D6 + col);
    const float* pp = (const float*)(p.ws + WS_MODP) + idx;
#pragma unroll
    for (int ks = 0; ks < 16; ++ks) s += *(const f32x4*)(pp + (size_t)ks * 4 * 9 * D6);
    *(f32x4*)((float*)(p.ws + WS_MODS) + idx) = s;
}
__device__ __forceinline__ void tables_unit(const Params& p) {
    f32x2* tw = (f32x2*)(p.ws + WS_TW);
    for (int m = tid_fresh(); m < 8192; m += 512) { double s, c; sincospi(-(double)m / 4096.0, &s, &c); tw[m] = (f32x2){(float)c, (float)s}; }
    float* rc = (float*)(p.ws + WS_ROPE);
    for (int i = tid_fresh(); i < 1024; i += 512) { const int pos = i >> 4, q = i & 15; const float inv = powf(10000.0f, -(float)q / 16.0f); const float ang = (float)pos * inv;
        rc[i] = cosf(ang); rc[1024 + i] = sinf(ang); }
}
__device__ __forceinline__ void h2_task(const Params& p, int task) {
    const int lane = tid_fresh() & 63; const int j = task / 4352, r = task % 4352; const int v = r >= 4096, t = v ? r - 4096 : r; const int Lv = v ? 256 : 4096;
    const float tl = (float)t / (float)(Lv - 1);
    const float omega = (float)(2.0 * 3.14159265358979323846 / (double)Lv) * (float)t;
    float feat = 0.f;
    if (lane == 0) feat = tl;
    else if (lane <= 32) { const int bi = (lane - 1) & 15; const float band = 1e-4f + (float)bi * ((15.0f - 1e-4f) / 15.0f); const float a = band * omega; feat = lane <= 16 ? cosf(a) : -sinf(a); }
    const float* w1 = p.hy_f_w1 + (size_t)j * 33 * 64; const float* w2 = p.hy_f_w2 + (size_t)j * 64 * 64;
    float s = p.hy_f_b1[j * 64 + lane];
    for (int f = 0; f < 33; ++f) s += bperm_f(feat, f) * w1[f * 64 + lane];
    const float h1 = sinf(p.hy_f_freq1[j * 64 + lane] * s);
    float s2 = p.hy_f_b2[j * 64 + lane];
    for (int m = 0; m < 64; ++m) s2 += bperm_f(h1, m) * w2[m * 64 + lane];
    const float h2 = sinf(p.hy_f_freq2[j * 64 + lane] * s2);
    const h16 hi = (h16)h2; const h16 lo = (h16)(h2 - (float)hi);
    h16* row = (h16*)(p.ws + WS_H2P) + ((size_t)j * 4352 + r) * 256;
    row[lane] = hi; row[64 + lane] = hi; row[128 + lane] = lo; row[192 + lane] = lo;
}
__device__ __forceinline__ void w3p_unit(const Params& p, int unit) {
    const int j = unit >> 5, c0 = (unit & 31) * 256; const float* w3 = p.hy_f_w3 + (size_t)j * 64 * 8192; h16* dst = (h16*)(p.ws + WS_W3P) + (size_t)j * 8192 * 256;
    for (int i = tid_fresh(); i < 64 * 256; i += 512) { const int m = i >> 8, col = c0 + (i & 255); const float w = w3[(size_t)m * 8192 + col];
        const h16 hi = (h16)w; const h16 lo = (h16)(w - (float)hi); h16* row = dst + (size_t)col * 256; row[m] = hi; row[64 + m] = lo; row[128 + m] = hi; row[192 + m] = lo; }
}
__device__ __forceinline__ void rtab_unit(const Params& p, int unit) {
    const int layer = unit >> 6, c = unit & 63; h16* dst = (h16*)(p.ws + WS_RTAB + (size_t)layer * RTAB_L) + (size_t)c * 5 * 2 * 64 * 8;
    for (int i = tid_fresh(); i < 5 * 2 * 64 * 8; i += 512) { const int jj = i & 7, lane = (i >> 3) & 63, hl = (i >> 9) & 1, ct = i >> 10;
        const int k = 32 * c + 8 * (lane >> 4) + jj, col = 16 * ct + (lane & 15);
        float w = 0.f; if (col < 8) w = p.moe_wg[((size_t)layer * D + k) * 8 + col]; else if (col < 72) w = p.moe_we[((size_t)layer * D + k) * 64 + (col - 8)];
        w *= 256.0f; const h16 hi = (h16)w; const h16 lo = (h16)(w - (float)hi); dst[i] = hl ? lo : hi; }
}
template <int NW>
__device__ __forceinline__ void cvt_tile(const float* src, int ldn, int k0, int n0, h16* dst, int ldk, int mode, LAS float* T) {
    constexpr int P = NW + 1; const int tid = tid_fresh();
#pragma unroll
    for (int ps = 0; ps < 64 * NW / 4 / 512; ++ps) { const int idx = ps * 512 + tid, k = idx / (NW / 4), n4 = idx % (NW / 4);
        const f32x4 v = *(const f32x4*)(src + (size_t)(k0 + k) * ldn + n0 + 4 * n4); LAS float* q = T + k * P + 4 * n4; q[0] = v[0]; q[1] = v[1]; q[2] = v[2]; q[3] = v[3]; }
    __syncthreads();
#pragma unroll
    for (int ps = 0; ps < NW * 8 / 512; ++ps) { const int item = ps * 512 + tid, kc = item & 7, n = item >> 3; f16x8 w;
#pragma unroll
        for (int i = 0; i < 8; ++i) w[i] = (h16)T[(8 * kc + i) * P + n];
        const int ng = n0 + n; const int row = mode == 0 ? ng : (8 * (ng >> 2) + (ng & 3) + (mode == 2 ? 4 : 0));
        *(f16x8*)(dst + (size_t)row * ldk + k0 + 8 * kc) = w; }
    __syncthreads();
}
__device__ __forceinline__ void cvt_dense_unit(const Params& p, int unit, LAS float* T) {
    const float* src; h16* dst; int nt, N;
    if (unit < 1536) { src = p.hy_w_in; dst = (h16*)(p.ws + WS_WIN); nt = 24; N = D3; }
    else if (unit < 2048) { unit -= 1536; src = p.hy_w_out; dst = (h16*)(p.ws + WS_WOUT); nt = 8; N = D; }
    else if (unit < 2688) { unit -= 2048; src = p.at_w_qkv; dst = (h16*)(p.ws + WS_WQKV); nt = 10; N = DQKV; }
    else { unit -= 2688; src = p.at_w_o; dst = (h16*)(p.ws + WS_WO); nt = 8; N = D; }
    const int j = unit / (32 * nt), r = unit % (32 * nt), kt = r / nt, ntile = r % nt;
    cvt_tile<256>(src + (size_t)j * D * N, N, kt * 64, ntile * 256, dst + (size_t)j * N * D, D, 0, T);
}
constexpr int CVT_DENSE_UNITS = 3200;
__device__ __forceinline__ void cvt_moe_unit(const Params& p, int layer, int unit, LAS float* T) {
    if (unit < 12288) { const int which = unit >= 6144; if (which) unit -= 6144; const int e = unit / 96, r = unit % 96, kt = r / 3, ntile = r % 3;
        const float* src = (which ? p.moe_w3 : p.moe_w1) + ((size_t)layer * NE + e) * D * DE;
        cvt_tile<128>(src, DE, kt * 64, ntile * 128, (h16*)(p.ws + WS_W13) + (size_t)e * DE2 * D, D, which ? 2 : 1, T); }
    else { unit -= 12288; const int e = unit / 48, r = unit % 48, kt = r / 8, ntile = r % 8;
        const float* src = p.moe_w2 + ((size_t)layer * NE + e) * DE * D;
        cvt_tile<256>(src, D, kt * 64, ntile * 256, (h16*)(p.ws + WS_W2) + (size_t)e * D * DE, DE, 0, T); }
}
constexpr int CVT_MOE_UNITS = 15360;
struct CvtD { const float* src; h16* dst; int mode; };
__device__ __forceinline__ CvtD cvt13_desc(const Params& p, int layer, int unit) {
    const int which = unit >= 6144; if (which) unit -= 6144; const int e = unit / 96, r = unit % 96, kt = r / 3, ntile = r % 3;
    CvtD d; d.src = (which ? p.moe_w3 : p.moe_w1) + ((size_t)layer * NE + e) * D * DE + (size_t)(kt * 64) * DE + ntile * 128;
    d.dst = (h16*)(p.ws + WS_W13) + (size_t)e * DE2 * D + kt * 64; d.mode = (which ? 4 : 0) + 8 * (256 * ntile); return d;
}
__device__ __forceinline__ void cvt13_load(const CvtD& d, f32x4 (&v)[4], int tid) {
#pragma unroll
    for (int ps = 0; ps < 4; ++ps) { const int idx = ps * 512 + tid, k = idx >> 5, n4 = idx & 31; v[ps] = *(const f32x4*)(d.src + (size_t)k * DE + 4 * n4); }
}
__device__ __forceinline__ void cvt13_store(const CvtD& d, const f32x4 (&v)[4], LAS float* T, int tid) {
    constexpr int P = 129;
#pragma unroll
    for (int ps = 0; ps < 4; ++ps) { const int idx = ps * 512 + tid, k = idx >> 5, n4 = idx & 31; LAS float* q = T + k * P + 4 * n4; q[0] = v[ps][0]; q[1] = v[ps][1]; q[2] = v[ps][2]; q[3] = v[ps][3]; }
    __syncthreads();
    const int w3off = d.mode & 7, rg0 = d.mode >> 3;
#pragma unroll
    for (int ps = 0; ps < 2; ++ps) { const int item = ps * 512 + tid, kc = item & 7, n = item >> 3; f16x8 w;
#pragma unroll
        for (int i = 0; i < 8; ++i) w[i] = (h16)T[(8 * kc + i) * P + n];
        const int row = rg0 + 8 * (n >> 2) + (n & 3) + w3off;
        *(f16x8*)(d.dst + (size_t)row * D + 8 * kc) = w; }
    __syncthreads();
}
__device__ __forceinline__ void cvt_moe_share(const Params& p, int layer, int u0, int n, int stride, LAS float* T) {
    const int tid = tid_fresh(); const int n13 = n < 12288 ? n : 12288;
    int u = u0;
    if (u < n13) {
        CvtD dA = cvt13_desc(p, layer, u), dB = dA, dC = dA; f32x4 vA[4], vB[4], vC[4];
        cvt13_load(dA, vA, tid);
        if (u + stride < n13) { dB = cvt13_desc(p, layer, u + stride); cvt13_load(dB, vB, tid); }
        for (;;) {
            if (u + 2 * stride < n13) { dC = cvt13_desc(p, layer, u + 2 * stride); cvt13_load(dC, vC, tid); }
            cvt13_store(dA, vA, T, tid); u += stride; if (u >= n13) break;
            if (u + 2 * stride < n13) { dA = cvt13_desc(p, layer, u + 2 * stride); cvt13_load(dA, vA, tid); }
            cvt13_store(dB, vB, T, tid); u += stride; if (u >= n13) break;
            if (u + 2 * stride < n13) { dB = cvt13_desc(p, layer, u + 2 * stride); cvt13_load(dB, vB, tid); }
            cvt13_store(dC, vC, T, tid); u += stride; if (u >= n13) break;
        }
    }
    for (; u < n; u += stride) cvt_moe_unit(p, layer, u, T);
}

template <int NR, bool FINAL>
__device__ __forceinline__ void n1_rows(const Params& p, int layer, int r0, int rstride, int lane, h16* xout) {
    const h16* xres = (const h16*)(p.ws + WS_XRES); h16* hb = (h16*)(p.ws + WS_HBUF); const h16* yc = (const h16*)(p.ws + WS_YC); const float* mods = (const float*)(p.ws + WS_MODS);
    f32x4 v[NR][8]; f16x4 xh[NR][8], ya[NR][8], yb[NR][8];
    const bool comb = FINAL || layer > 0; const int lprev = FINAL ? 3 : layer - 1;
#pragma unroll
    for (int q = 0; q < NR; ++q) { const int r = r0 + q * rstride;
        if (!comb) { const float* src = r < TL ? p.x + (size_t)r * D : p.ctx + (size_t)(r - TL) * D;
#pragma unroll
            for (int c = 0; c < 8; ++c) v[q][c] = *(const f32x4*)(src + c * 256 + lane * 4); }
        else { const h16* src = xres + (size_t)r * D; const h16* y0 = yc + (size_t)(2 * r) * D; const h16* y1 = y0 + D;
#pragma unroll
            for (int c = 0; c < 8; ++c) { xh[q][c] = *(const f16x4*)(src + c * 256 + lane * 4); ya[q][c] = *(const f16x4*)(y0 + c * 256 + lane * 4); yb[q][c] = *(const f16x4*)(y1 + c * 256 + lane * 4); } } }
#pragma unroll
    for (int q = 0; q < NR; ++q) { const int r = r0 + q * rstride; const int b = batch_of_row(r);
        if (comb) { const float* g2 = mods + ((size_t)(lprev * 9 + b) * 6 + 5) * D;
#pragma unroll
            for (int c = 0; c < 8; ++c) { const f32x4 g = *(const f32x4*)(g2 + c * 256 + lane * 4);
#pragma unroll
                for (int i = 0; i < 4; ++i) v[q][c][i] = (float)xh[q][c][i] + g[i] * ((float)ya[q][c][i] + (float)yb[q][c][i]); } }
        float ss = 0.f;
#pragma unroll
        for (int c = 0; c < 8; ++c) { if (!FINAL) { f16x4 w; w[0] = (h16)v[q][c][0]; w[1] = (h16)v[q][c][1]; w[2] = (h16)v[q][c][2]; w[3] = (h16)v[q][c][3]; *(f16x4*)(xout + (size_t)r * D + c * 256 + lane * 4) = w; } ss += v[q][c][0] * v[q][c][0] + v[q][c][1] * v[q][c][1] + v[q][c][2] * v[q][c][2] + v[q][c][3] * v[q][c][3]; }
        ss = wave_sum(ss); const float rs = 1.0f / sqrtf(ss * (1.0f / D) + EPS);
        if (FINAL) {
#pragma unroll
            for (int c = 0; c < 8; ++c) { const int col = c * 256 + lane * 4; const f32x4 g = *(const f32x4*)(p.final_gain + col); *(f32x4*)(p.out + (size_t)r * D + col) = v[q][c] * rs * g; }
        } else {
            const float* sh = mods + ((size_t)(layer * 9 + b) * 6 + 0) * D; const float* sc = sh + D;
#pragma unroll
            for (int c = 0; c < 8; ++c) { const int col = c * 256 + lane * 4; const f32x4 s0 = *(const f32x4*)(sh + col), s1 = *(const f32x4*)(sc + col); f16x4 w;
#pragma unroll
                for (int i = 0; i < 4; ++i) w[i] = (h16)(v[q][c][i] * rs * (1.0f + s1[i]) + s0[i]);
                *(f16x4*)(hb + (size_t)r * D + col) = w; }
        } }
}
template <bool FINAL>
__device__ __forceinline__ void n1_any(const Params& p, int layer, h16* xout) {
    const int tid = tid_fresh(), lane = tid & 63, gw = blockIdx.x * 8 + __builtin_amdgcn_readfirstlane(tid >> 6), nw = gridDim.x * 8; const int nrow = FINAL ? TL : TT;
    int r = gw;
    for (; r + nw < nrow; r += 2 * nw) n1_rows<2, FINAL>(p, layer, r, nw, lane, xout);
    if (r < nrow) n1_rows<1, FINAL>(p, layer, r, nw, lane, xout);
}
__device__ __forceinline__ void n1_phase(const Params& p, int layer, h16* xout) { n1_any<false>(p, layer, xout); }
__device__ __forceinline__ void final_phase(const Params& p) { n1_any<true>(p, 0, nullptr); }
constexpr int N2_CH = 4;
constexpr int N2_SLOT = N2_CH * 10 * 1024;
constexpr int N2_XT = 2 * N2_SLOT;
constexpr int N2_SC = N2_XT + 8 * 4096;
#ifndef PROBE_N2VAR
#define PROBE_N2VAR 0
#endif
__device__ __forceinline__ void n2_phase(const Params& p, int layer, LAS unsigned char* lds, int ctr_shadow) {
    const bool pv_tail = !(ctr_shadow && (PROBE_N2VAR & 1)), pv_store = !(ctr_shadow && (PROBE_N2VAR & 2)), pv_mma = !(ctr_shadow && (PROBE_N2VAR & 4));
    const int tid = tid_fresh(), lane = tid & 63, wv = __builtin_amdgcn_readfirstlane(tid >> 6), r16 = lane & 15, kg = lane >> 4;
    const int lrow = lane >> 3, lchk = lane & 7;
    const h16* xres = (const h16*)(p.ws + WS_XRES); h16* hb = (h16*)(p.ws + WS_HBUF); const float* mods = (const float*)(p.ws + WS_MODS);
    const char* rtb = p.ws + WS_RTAB + (size_t)layer * RTAB_L; const float* ssq = (const float*)(p.ws + WS_SSQ);
    int* counters = (int*)(p.ws + WS_CTL) + CTL_CNT + (layer + (ctr_shadow ? 4 : 0)) * NE; int* list = (int*)(p.ws + WS_LIST); float* gate = (float*)(p.ws + WS_GATE);
    LAS float* scr = (LAS float*)lds + wv * (16 * 80);
    LAS float* scl = (LAS float*)(lds + N2_SC); LAS float* shl = scl + D;
    LAS int* hist = (LAS int*)(lds + LDS_MISC); LAS int* hbase = hist + NE;
    LAS unsigned char* xt = lds + N2_XT + wv * 4096;
    const int hw_off0 = r16 * 128 + 16 * (kg ^ (r16 & 7)), hw_off1 = r16 * 128 + 16 * ((4 + kg) ^ (r16 & 7));
    const int hr_off = lrow * 128 + 16 * (lchk ^ (lrow & 7));
    const int ntask = (layer == NLAYER - 1 ? TL : TT) / 16, nfull = (int)gridDim.x * 8;
#pragma unroll 1
    for (int round = 0; round < 2; ++round) {
        const int nrem = ntask - nfull;
        if (round == 1 && (int)blockIdx.x >= nrem) break;
        const int task = round == 0 ? (int)blockIdx.x * 8 + wv : nfull + (int)blockIdx.x;
        const bool active = round == 0 ? (task < ntask) : true;
        const int trow = active ? task * 16 : 0;
        const int b = batch_of_row(trow);
        const h16* xg = xres + (size_t)(trow + r16) * D + 8 * kg;
        h16* hg0 = hb + (size_t)(trow + lrow) * D + lchk * 8; h16* hg1 = hg0 + (size_t)8 * D;
        float rs;
        { const float* sp = ssq + (size_t)(trow + r16) * 32; float t = 0.f;
#pragma unroll
            for (int q = 0; q < 8; ++q) { const f32x4 v = *(const f32x4*)(sp + 4 * q); t += (v[0] + v[1]) + (v[2] + v[3]); }
            rs = 1.0f / sqrtf(t * (1.0f / D) + EPS); }
        f32x4 acc[5];
#pragma unroll
        for (int ct = 0; ct < 5; ++ct) acc[ct] = (f32x4){0.f, 0.f, 0.f, 0.f};
        __syncthreads();
        if (tid < NE) hist[tid] = 0;
        { const float* scb = mods + ((size_t)(layer * 9 + b) * 6 + 4) * D; *(LAS f32x4*)(scl + tid * 4) = *(const f32x4*)(scb + tid * 4); *(LAS f32x4*)(shl + tid * 4) = *(const f32x4*)(scb - D + tid * 4); }
        if (round == 0) {
        f16x8 bq[5];
#pragma unroll
        for (int q = 0; q < 5; ++q) bq[q] = *(const f16x8*)(rtb + (size_t)(5 * wv + q) * 1024 + lane * 16);
#pragma unroll
        for (int q = 0; q < 5; ++q) *(LAS f16x8*)(lds + (5 * wv + q) * 1024 + lane * 16) = bq[q];
#pragma unroll
        for (int q = 0; q < 5; ++q) bq[q] = *(const f16x8*)(rtb + (size_t)N2_SLOT + (size_t)(5 * wv + q) * 1024 + lane * 16);
        f16x8 x0[N2_CH], x1[N2_CH], x2[N2_CH];
#pragma unroll
        for (int s2 = 0; s2 < N2_CH; ++s2) { x0[s2] = *(const f16x8*)(xg + 32 * s2); x1[s2] = *(const f16x8*)(xg + 32 * (N2_CH + s2)); }
#define N2_CHUNK(XC, XL, CH) do { const int ch = (CH); \
            __syncthreads(); \
            const int nx2 = (ch + 2 < 64 / N2_CH) ? ch + 2 : ch; \
            {   LAS unsigned char* dst = lds + ((ch + 1) & 1) * N2_SLOT; \
 _Pragma("unroll") \
                for (int q = 0; q < 5; ++q) *(LAS f16x8*)(dst + (5 * wv + q) * 1024 + lane * 16) = bq[q]; } \
            {   const char* src = rtb + (size_t)nx2 * N2_SLOT; \
 _Pragma("unroll") \
                for (int q = 0; q < 5; ++q) bq[q] = *(const f16x8*)(src + (size_t)(5 * wv + q) * 1024 + lane * 16); } \
 _Pragma("unroll") \
            for (int s2 = 0; s2 < N2_CH; ++s2) { const int ko = 32 * (nx2 * N2_CH + s2); XL[s2] = *(const f16x8*)(xg + ko); } \
            const LAS unsigned char* bs = lds + (ch & 1) * N2_SLOT + lane * 16; \
 _Pragma("unroll") \
            for (int pp = 0; pp < N2_CH / 2; ++pp) { \
                f16x8 hk[2]; \
 _Pragma("unroll") \
                for (int sp = 0; sp < 2; ++sp) { \
                    const int s2 = 2 * pp + sp; const int ko = 32 * (ch * N2_CH + s2) + 8 * kg; \
                    const f32x4 c0 = *(const LAS f32x4*)(scl + ko), c1 = *(const LAS f32x4*)(scl + ko + 4), h0 = *(const LAS f32x4*)(shl + ko), h1 = *(const LAS f32x4*)(shl + ko + 4); \
                    f16x8 hi, lo; \
 _Pragma("unroll") \
                    for (int i = 0; i < 4; ++i) { const float a0 = (float)XC[s2][i] * rs * (1.0f + c0[i]) + h0[i], a1 = (float)XC[s2][4 + i] * rs * (1.0f + c1[i]) + h1[i]; \
                        hi[i] = (h16)a0; lo[i] = (h16)(a0 - (float)hi[i]); hi[4 + i] = (h16)a1; lo[4 + i] = (h16)(a1 - (float)hi[4 + i]); } \
                    hk[sp] = hi; \
                    if (pv_mma) \
 _Pragma("unroll") \
                    for (int ct = 0; ct < 5; ++ct) { const f16x8 whi = *(const LAS f16x8*)(bs + (s2 * 10 + ct * 2 + 0) * 1024), wlo = *(const LAS f16x8*)(bs + (s2 * 10 + ct * 2 + 1) * 1024); \
                        acc[ct] = __builtin_amdgcn_mfma_f32_16x16x32_f16(hi, whi, acc[ct], 0, 0, 0); \
                        acc[ct] = __builtin_amdgcn_mfma_f32_16x16x32_f16(hi, wlo, acc[ct], 0, 0, 0); \
                        acc[ct] = __builtin_amdgcn_mfma_f32_16x16x32_f16(lo, whi, acc[ct], 0, 0, 0); } \
                } \
                *(LAS f16x8*)(xt + hw_off0) = hk[0]; *(LAS f16x8*)(xt + hw_off1) = hk[1]; \
                const f16x8 o0 = *(const LAS f16x8*)(xt + hr_off), o1 = *(const LAS f16x8*)(xt + 1024 + hr_off); \
                if (active && pv_store) { const int ho = 32 * (ch * N2_CH + 2 * pp); *(f16x8*)(hg0 + ho) = o0; *(f16x8*)(hg1 + ho) = o1; } \
            } \
        } while (0)
#pragma unroll 1
        for (int c3 = 0; c3 < 15; c3 += 3) { N2_CHUNK(x0, x2, c3); N2_CHUNK(x1, x0, c3 + 1); N2_CHUNK(x2, x1, c3 + 2); }
        N2_CHUNK(x0, x2, 15);
#undef N2_CHUNK
        } else {
            const char* rtw = rtb + (size_t)(8 * wv) * 10240; const int kb = 256 * wv;
            unsigned loff = (unsigned)lane * 16u; asm volatile("" : "+v"(loff));
            f16x8 bb[10];
            f16x8 xa[2][2];
#pragma unroll
            for (int sp = 0; sp < 2; ++sp) xa[0][sp] = *(const f16x8*)(xg + kb + 32 * sp);
#pragma unroll
            for (int pp = 0; pp < 4; ++pp) {
                if (pp < 3) {
#pragma unroll
                    for (int sp = 0; sp < 2; ++sp) xa[(pp + 1) & 1][sp] = *(const f16x8*)(xg + kb + 32 * (2 * pp + 2 + sp)); }
                f16x8 hk[2];
#pragma unroll
                for (int sp = 0; sp < 2; ++sp) {
                    const int st = 2 * pp + sp; const int ko = kb + 32 * st + 8 * kg;
#pragma unroll
                    for (int q = 0; q < 10; ++q) bb[q] = *(const f16x8*)(rtw + (size_t)(st * 10 + q) * 1024 + loff);
                    asm volatile("" ::: "memory");
                    const f32x4 c0 = *(const LAS f32x4*)(scl + ko), c1 = *(const LAS f32x4*)(scl + ko + 4), h0 = *(const LAS f32x4*)(shl + ko), h1 = *(const LAS f32x4*)(shl + ko + 4);
                    f16x8 hi, lo;
#pragma unroll
                    for (int i = 0; i < 4; ++i) { const float a0 = (float)xa[pp & 1][sp][i] * rs * (1.0f + c0[i]) + h0[i], a1 = (float)xa[pp & 1][sp][4 + i] * rs * (1.0f + c1[i]) + h1[i];
                        hi[i] = (h16)a0; lo[i] = (h16)(a0 - (float)hi[i]); hi[4 + i] = (h16)a1; lo[4 + i] = (h16)(a1 - (float)hi[4 + i]); }
                    hk[sp] = hi;
#pragma unroll
                    for (int ct = 0; ct < 5; ++ct) {
                        acc[ct] = __builtin_amdgcn_mfma_f32_16x16x32_f16(hi, bb[2 * ct], acc[ct], 0, 0, 0);
                        acc[ct] = __builtin_amdgcn_mfma_f32_16x16x32_f16(hi, bb[2 * ct + 1], acc[ct], 0, 0, 0);
                        acc[ct] = __builtin_amdgcn_mfma_f32_16x16x32_f16(lo, bb[2 * ct], acc[ct], 0, 0, 0); }
                }
                *(LAS f16x8*)(xt + hw_off0) = hk[0]; *(LAS f16x8*)(xt + hw_off1) = hk[1];
                const f16x8 o0 = *(const LAS f16x8*)(xt + hr_off), o1 = *(const LAS f16x8*)(xt + 1024 + hr_off);
                if (pv_store) { const int ho = kb + 64 * pp; *(f16x8*)(hg0 + ho) = o0; *(f16x8*)(hg1 + ho) = o1; }
            }
        }
        __syncthreads();
#pragma unroll
        for (int ct = 0; ct < 5; ++ct)
#pragma unroll
            for (int i = 0; i < 4; ++i) scr[(4 * kg + i) * 80 + 16 * ct + r16] = acc[ct][i] * (1.0f / 256.0f);
        asm volatile("s_waitcnt lgkmcnt(0)" ::: "memory");
        int ea = 0, eb = 0, ra = 0, rb = 0; float g1v = 0.f, g2v = 0.f; const bool tok_lane = (round == 0 ? active : wv == 0) && lane < 16 && pv_tail;
        const int nparts = round == 0 ? 1 : 8;
        if (tok_lane) {
            const LAS float* lgr = scr + lane * 80;
#define N2_LG(c) ({ float _t = lgr[(c)]; for (int _w = 1; _w < nparts; ++_w) _t += lgr[_w * 1280 + (c)]; _t; })
            float gmax = -3.0e38f; int gsel = 0; float gl[8];
#pragma unroll
            for (int g = 0; g < 8; ++g) { gl[g] = N2_LG(g) + p.moe_bg[layer * 8 + g]; if (gl[g] > gmax) { gmax = gl[g]; gsel = g; } }
            float gz = 0.f;
#pragma unroll
            for (int g = 0; g < 8; ++g) gz += expf(gl[g] - gmax);
            const float pg = 1.0f / gz;
            float f1 = -3.0e38f, f2 = -3.0e38f; int i1 = 0, i2 = 0;
            for (int q = 0; q < 8; ++q) { const float f = N2_LG(8 + gsel * 8 + q) + p.moe_be[layer * 64 + gsel * 8 + q];
                if (f > f1) { f2 = f1; i2 = i1; f1 = f; i1 = q; } else if (f > f2) { f2 = f; i2 = q; } }
            const float e2 = expf(f2 - f1); g1v = pg / (1.0f + e2); g2v = pg * e2 / (1.0f + e2);
            ea = gsel * 8 + i1; eb = gsel * 8 + i2;
#undef N2_LG
            ra = __hip_atomic_fetch_add(hist + ea, 1, __ATOMIC_RELAXED, __HIP_MEMORY_SCOPE_WORKGROUP); rb = __hip_atomic_fetch_add(hist + eb, 1, __ATOMIC_RELAXED, __HIP_MEMORY_SCOPE_WORKGROUP);
        }
        __syncthreads();
        { const int t2 = tid_fresh(); if (t2 < NE && pv_tail) { const int n = hist[t2]; hbase[t2] = n ? atomicAdd(&counters[t2], n) : 0; } }
        __syncthreads();
        if (tok_lane) { const int tok = task * 16 + lane; const size_t sa = (size_t)ea * LCAP + hbase[ea] + ra, sb = (size_t)eb * LCAP + hbase[eb] + rb;
            list[sa] = 2 * tok; gate[sa] = g1v; list[sb] = 2 * tok + 1; gate[sb] = g2v; }
    }
}
__device__ __forceinline__ void transpose_phase(const Params& p, LAS h16* T) {
    const h16* zt = (const h16*)(p.ws + WS_ZT); h16* z = (h16*)(p.ws + WS_HBUF); const int tid = tid_fresh();
    const int ntile = (D / 64) * (TT / 64);
    for (int tile = blockIdx.x; tile < ntile; tile += gridDim.x) {
        const int td = tile % (D / 64), tt = tile / (D / 64); const int d0 = td * 64, t0 = tt * 64;
        { const int dr = tid >> 3, tc = (tid & 7) * 8; const f16x8 v = *(const f16x8*)(zt + (size_t)(d0 + dr) * TT + t0 + tc);
#pragma unroll
            for (int i = 0; i < 8; ++i) T[(tc + i) * 66 + dr] = v[i]; }
        __syncthreads();
        { const int tr = tid >> 3, dc = (tid & 7) * 8; f16x8 v;
#pragma unroll
            for (int i = 0; i < 8; ++i) v[i] = T[tr * 66 + dc + i];
            *(f16x8*)(z + (size_t)(t0 + tr) * D + d0 + dc) = v; }
        __syncthreads();
    }
}

__device__ __forceinline__ f32x2 cmul(const f32x2 a, const f32x2 b) { return (f32x2){a.x * b.x - a.y * b.y, a.x * b.y + a.y * b.x}; }
__device__ __forceinline__ f32x2 cmulc(const f32x2 a, const f32x2 b) { return (f32x2){a.x * b.x + a.y * b.y, a.y * b.x - a.x * b.y}; }
__device__ __forceinline__ f32x2 cconj(const f32x2 a) { return (f32x2){a.x, -a.y}; }
template <bool INV> __device__ __forceinline__ f32x2 mul_mi(const f32x2 a) { return INV ? (f32x2){-a.y, a.x} : (f32x2){a.y, -a.x}; }
template <bool INV> __device__ __forceinline__ void dft4(f32x2& a, f32x2& b, f32x2& c, f32x2& d) {
    const f32x2 s0 = a + c, s1 = a - c, s2 = b + d, s3 = mul_mi<INV>(b - d);
    a = s0 + s2; b = s1 + s3; c = s0 - s2; d = s1 - s3;
}
template <bool INV, int M> __device__ __forceinline__ f32x2 w16mul(const f32x2 a) {
    constexpr float C1 = 0.92387953251128674f, S1 = 0.38268343236508977f, R = 0.70710678118654752f;
    constexpr float cr = (M == 0) ? 1.f : (M == 1) ? C1 : (M == 2) ? R : (M == 3) ? S1 : (M == 4) ? 0.f : (M == 6) ? -R :   -C1;
    constexpr float ci0 = (M == 0) ? 0.f : (M == 1) ? -S1 : (M == 2) ? -R : (M == 3) ? -C1 : (M == 4) ? -1.f : (M == 6) ? -R :   S1;
    constexpr float ci = INV ? -ci0 : ci0;
    return (f32x2){a.x * cr - a.y * ci, a.x * ci + a.y * cr};
}
template <bool INV> __device__ __forceinline__ void dft16(f32x2 (&v)[16]) {
#pragma unroll
    for (int n2 = 0; n2 < 4; ++n2) dft4<INV>(v[n2], v[4 + n2], v[8 + n2], v[12 + n2]);
    v[5] = w16mul<INV, 1>(v[5]); v[6] = w16mul<INV, 2>(v[6]); v[7] = w16mul<INV, 3>(v[7]);
    v[9] = w16mul<INV, 2>(v[9]); v[10] = w16mul<INV, 4>(v[10]); v[11] = w16mul<INV, 6>(v[11]);
    v[13] = w16mul<INV, 3>(v[13]); v[14] = w16mul<INV, 6>(v[14]); v[15] = w16mul<INV, 9>(v[15]);
#pragma unroll
    for (int k1 = 0; k1 < 4; ++k1) dft4<INV>(v[4 * k1], v[4 * k1 + 1], v[4 * k1 + 2], v[4 * k1 + 3]);
    f32x2 t;
    t = v[1]; v[1] = v[4]; v[4] = t; t = v[2]; v[2] = v[8]; v[8] = t; t = v[3]; v[3] = v[12]; v[12] = t;
    t = v[6]; v[6] = v[9]; v[9] = t; t = v[7]; v[7] = v[13]; v[13] = t; t = v[11]; v[11] = v[14]; v[14] = t;
}
__device__ __forceinline__ int fphys(int i) { return i + (i >> 4); }
__device__ __forceinline__ f32x2 w32c(int j) {
    constexpr float c[16] = {1.f, 0.98078528040323043f, 0.92387953251128674f, 0.83146961230254524f, 0.70710678118654752f, 0.55557023301960218f, 0.38268343236508977f, 0.19509032201612825f,
                             0.f, -0.19509032201612825f, -0.38268343236508977f, -0.55557023301960218f, -0.70710678118654752f, -0.83146961230254524f, -0.92387953251128674f, -0.98078528040323043f};
    constexpr float s[16] = {0.f, 0.19509032201612825f, 0.38268343236508977f, 0.55557023301960218f, 0.70710678118654752f, 0.83146961230254524f, 0.92387953251128674f, 0.98078528040323043f,
                             1.f, 0.98078528040323043f, 0.92387953251128674f, 0.83146961230254524f, 0.70710678118654752f, 0.55557023301960218f, 0.38268343236508977f, 0.19509032201612825f};
    return (f32x2){c[j], -s[j]};
}
template <int S>
__device__ __forceinline__ void fft_fwd0(const f32x2 (&xe)[16], const f32x2 (&xo)[16], LAS f32x2* E, LAS f32x2* O, int t, const LAS f32x2* tw) {
    const f32x2 u = tw[t * (256 / S)]; const f32x2 u2 = cmul(u, u);
    f32x2 y[16];
#pragma unroll
    for (int j = 0; j < 16; ++j) y[j] = xe[j];
    dft16<false>(y);
    constexpr int QS = S + S / 16;
    LAS f32x2* Eb = E + fphys(t); LAS f32x2* Ob = O + fphys(t);
    f32x2 pw = u2; Eb[0] = y[0];
#pragma unroll
    for (int q = 1; q < 16; ++q) { Eb[QS * q] = cmul(y[q], pw); pw = cmul(pw, u2); }
#pragma unroll
    for (int j = 0; j < 16; ++j) y[j] = cmul(xo[j], w32c(j));
    dft16<false>(y);
    pw = u;
#pragma unroll
    for (int q = 0; q < 16; ++q) { Ob[QS * q] = cmul(y[q], pw); pw = cmul(pw, u2); }
}
template <bool INV> __device__ __forceinline__ void fft_pass1(LAS f32x2* A, int tau, const LAS f32x2* tw) {
    const int i = tau & 15, base = (tau >> 4) << 8; const f32x2 u0 = tw[32 * i]; const f32x2 u = INV ? cconj(u0) : u0;
    f32x2 y[16]; LAS f32x2* Ab = A + fphys(base + i);
#pragma unroll
    for (int j = 0; j < 16; ++j) y[j] = Ab[17 * j];
    if (INV) { f32x2 pw = u;
#pragma unroll
        for (int q = 1; q < 16; ++q) { y[q] = cmul(y[q], pw); pw = cmul(pw, u); } }
    dft16<INV>(y);
    if (!INV) { f32x2 pw = u;
#pragma unroll
        for (int q = 1; q < 16; ++q) { y[q] = cmul(y[q], pw); pw = cmul(pw, u); } }
#pragma unroll
    for (int j = 0; j < 16; ++j) Ab[17 * j] = y[j];
}
template <bool INV> __device__ __forceinline__ void fft_pass1_pair(LAS f32x2* A, LAS f32x2* B, int tau, const LAS f32x2* tw) {
    const int i = tau & 15, base = (tau >> 4) << 8; const f32x2 u0 = tw[32 * i]; const f32x2 u = INV ? cconj(u0) : u0;
    f32x2 y[16], z[16]; LAS f32x2* Ab = A + fphys(base + i); LAS f32x2* Bb = B + fphys(base + i);
#pragma unroll
    for (int j = 0; j < 16; ++j) y[j] = Ab[17 * j];
#pragma unroll
    for (int j = 0; j < 16; ++j) z[j] = Bb[17 * j];
    f32x2 pwr[16]; pwr[1] = u;
#pragma unroll
    for (int q = 2; q < 16; ++q) pwr[q] = cmul(pwr[q - 1], u);
    if (INV) {
#pragma unroll
        for (int q = 1; q < 16; ++q) y[q] = cmul(y[q], pwr[q]); }
    dft16<INV>(y);
    if (!INV) {
#pragma unroll
        for (int q = 1; q < 16; ++q) y[q] = cmul(y[q], pwr[q]); }
#pragma unroll
    for (int j = 0; j < 16; ++j) Ab[17 * j] = y[j];
    if (INV) {
#pragma unroll
        for (int q = 1; q < 16; ++q) z[q] = cmul(z[q], pwr[q]); }
    dft16<INV>(z);
    if (!INV) {
#pragma unroll
        for (int q = 1; q < 16; ++q) z[q] = cmul(z[q], pwr[q]); }
#pragma unroll
    for (int j = 0; j < 16; ++j) Bb[17 * j] = z[j];
}
__device__ __forceinline__ void fft_fwd2(const LAS f32x2* A, int t, f32x2 (&y)[16]) {
#pragma unroll
    for (int j = 0; j < 16; ++j) y[j] = A[17 * t + j];
    dft16<false>(y);
}
template <int NT> __device__ __forceinline__ void kf_load(const f32x2* kf, f32x4 (&k)[8]) {
#pragma unroll
    for (int j = 0; j < 8; ++j) k[j] = *(const f32x4*)(kf + j * (2 * NT));
}
__device__ __forceinline__ void fft_mid(LAS f32x2* A, int t, const f32x4 (&k)[8]) {
    f32x2 y[16];
    fft_fwd2(A, t, y);
#pragma unroll
    for (int j = 0; j < 8; ++j) { y[2 * j] = cmul(y[2 * j], (f32x2){k[j][0], k[j][1]}); y[2 * j + 1] = cmul(y[2 * j + 1], (f32x2){k[j][2], k[j][3]}); }
    dft16<true>(y);
#pragma unroll
    for (int j = 0; j < 16; ++j) A[17 * t + j] = y[j];
}
template <int S>
__device__ __forceinline__ void fft_inv0(const LAS f32x2* E, const LAS f32x2* O, int t, const LAS f32x2* tw, f32x2 (&out)[16]) {
    const f32x2 u = tw[t * (256 / S)]; const f32x2 u2 = cmul(u, u);
    f32x2 y[16];
    constexpr int QS = S + S / 16;
    const LAS f32x2* Eb = E + fphys(t); const LAS f32x2* Ob = O + fphys(t);
    f32x2 pw = u2; y[0] = Eb[0];
#pragma unroll
    for (int q = 1; q < 16; ++q) { y[q] = cmulc(Eb[QS * q], pw); pw = cmul(pw, u2); }
    dft16<true>(y);
#pragma unroll
    for (int j = 0; j < 16; ++j) out[j] = y[j];
    pw = u;
#pragma unroll
    for (int q = 0; q < 16; ++q) { y[q] = cmulc(Ob[QS * q], pw); pw = cmul(pw, u2); }
    dft16<true>(y);
#pragma unroll
    for (int j = 0; j < 16; ++j) out[j] += cmulc(y[j], w32c(j));
}
__device__ __forceinline__ float hy_absdelta(int d) { return fabsf(-3.0701134573253943f + (-15.350567286626973f + 3.0701134573253943f) * ((float)d / 2047.0f)); }

__device__ __forceinline__ void filt_fft_phase(const Params& p, LAS unsigned char* lds) {
    const int tid = tid_fresh();
    LAS f32x2* tw = (LAS f32x2*)(lds + LDS_MISC + 1024);
    tw[tid] = ((const f32x2*)(p.ws + WS_TW))[tid];
    __syncthreads();
    {
        const int grp = tid >> 8, tau = tid & 255; constexpr int KFQ = 512;
        LAS f32x2* E = (LAS f32x2*)(lds + grp * 69632); LAS f32x2* O = E + 4352; LAS float* red = (LAS float*)(lds + LDS_MISC) + grp * 8;
        float tlo[16], thi[16];
#define FILT_TAPS(pbx) do { const int d_ = (pbx) & 2047, n_ = ((pbx) >> 11) & 1, j_ = (pbx) >> 12; const float* tf_ = (const float*)(p.ws + WS_TAPS) + ((size_t)j_ * 8192 + (size_t)(n_ * 2 + 0) * D + d_) * 4096; \
            const float* tb_ = tf_ + (size_t)D * 4096; _Pragma("unroll") for (int jj = 0; jj < 16; ++jj) { const int nn = tau + 256 * jj; tlo[jj] = tf_[nn]; thi[jj] = tb_[(4096 - nn) & 4095]; } } while (0)
        if (blockIdx.x * 2 + grp < 2 * 2 * 2048) FILT_TAPS(blockIdx.x * 2 + grp);
        for (int pb = blockIdx.x * 2 + grp; pb < 2 * 2 * 2048; pb += gridDim.x * 2) {
            const int d = pb & 2047, n = (pb >> 11) & 1, j = pb >> 12;
            const float adel = hy_absdelta(d); const float cdec = adel * (1.0f / 4095.0f);
            float dl = expf(-(float)tau * cdec), dh = expf(-(float)(4096 - tau) * cdec); const float rl = expf(-256.0f * cdec), rh = expf(256.0f * cdec);
            f32x2 xe[16], xo[16]; float ss = 0.f;
#pragma unroll
            for (int jj = 0; jj < 16; ++jj) { const int nn = tau + 256 * jj;
                const float klo = tlo[jj] * dl;
                const float khi = (nn != 0) ? thi[jj] * dh : 0.f;
                dl *= rl; dh *= rh;
                ss += klo * klo + khi * khi; xe[jj] = (f32x2){klo + khi, 0.f}; xo[jj] = (f32x2){klo - khi, 0.f}; }
            if (pb + (int)gridDim.x * 2 < 2 * 2 * 2048) FILT_TAPS(pb + (int)gridDim.x * 2);
            ss = wave_sum(ss);
            if ((tid & 63) == 0) red[(tid >> 6) & 3] = ss;
            fft_fwd0<256>(xe, xo, E, O, tau, tw);
            __syncthreads();
            const float tot = red[0] + red[1] + red[2] + red[3];
            const float scale = (1.0f / sqrtf(tot + EPS)) * (1.0f / 8192.0f);
            const float hbs = p.hy_bias[((size_t)j * 2 + n) * D + d] * (1.0f / 8192.0f);
            fft_pass1<false>(E, tau, tw); fft_pass1<false>(O, tau, tw);
            __syncthreads();
            f32x2* kf = (f32x2*)(p.ws + WS_KF) + (size_t)pb * 8192 + (size_t)tau * 2;
            f32x2 y[16];
            fft_fwd2(E, tau, y);
#pragma unroll
            for (int q = 0; q < 8; ++q) *(f32x4*)(kf + KFQ * q) = (f32x4){y[2 * q].x * scale + hbs, y[2 * q].y * scale, y[2 * q + 1].x * scale + hbs, y[2 * q + 1].y * scale};
            fft_fwd2(O, tau, y);
#pragma unroll
            for (int q = 0; q < 8; ++q) *(f32x4*)(kf + 4096 + KFQ * q) = (f32x4){y[2 * q].x * scale + hbs, y[2 * q].y * scale, y[2 * q + 1].x * scale + hbs, y[2 * q + 1].y * scale};
            __syncthreads();
        }
    }
#undef FILT_TAPS
    {
        const int pr = tid >> 4, i = tid & 15; constexpr int KFQ = 32;
        LAS f32x2* E = (LAS f32x2*)(lds + pr * 4352); LAS f32x2* O = E + 272;
        for (int it = blockIdx.x; it < 256; it += gridDim.x) {
            const int pb = it * 32 + pr; const int d = pb & 2047, n = (pb >> 11) & 1, j = pb >> 12;
            const float* tf = (const float*)(p.ws + WS_TAPSC) + ((size_t)j * 8192 + (size_t)(n * 2 + 0) * D + d) * 256;
            const float* tb = tf + (size_t)D * 256;
            const float adel = hy_absdelta(d); const float tscale = 1.0f / 255.0f;
            f32x2 xe[16], xo[16]; float ss = 0.f;
#pragma unroll
            for (int jj = 0; jj < 16; ++jj) { const int nn = i + 16 * jj;
                const float klo = tf[nn] * expf(-(float)nn * tscale * adel);
                const int m = 256 - nn;
                const float khi = (m < 256) ? tb[m & 255] * expf(-(float)m * tscale * adel) : 0.f;
                ss += klo * klo + khi * khi; xe[jj] = (f32x2){klo + khi, 0.f}; xo[jj] = (f32x2){klo - khi, 0.f}; }
            ss += shx(ss, 8); ss += shx(ss, 4); ss += shx(ss, 2); ss += shx(ss, 1);
            const float scale = (1.0f / sqrtf(ss + EPS)) * (1.0f / 512.0f);
            const float hbs = p.hy_bias[((size_t)j * 2 + n) * D + d] * (1.0f / 512.0f);
            fft_fwd0<16>(xe, xo, E, O, i, tw);
            __syncthreads();
            f32x2* kf = (f32x2*)(p.ws + WS_KFC) + (size_t)pb * 512 + (size_t)i * 2;
            f32x2 y[16];
            fft_fwd2(E, i, y);
#pragma unroll
            for (int q = 0; q < 8; ++q) *(f32x4*)(kf + KFQ * q) = (f32x4){y[2 * q].x * scale + hbs, y[2 * q].y * scale, y[2 * q + 1].x * scale + hbs, y[2 * q + 1].y * scale};
            fft_fwd2(O, i, y);
#pragma unroll
            for (int q = 0; q < 8; ++q) *(f32x4*)(kf + 256 + KFQ * q) = (f32x4){y[2 * q].x * scale + hbs, y[2 * q].y * scale, y[2 * q + 1].x * scale + hbs, y[2 * q + 1].y * scale};
            __syncthreads();
        }
    }
}

__device__ __forceinline__ float conv3_lds(const LAS h16* row, int n, float w0, float w1, float w2, float b) { return (float)row[n - 1] * w0 + (float)row[n] * w1 + (float)row[n + 1] * w2 + b; }
constexpr int ST_P = 4112, STS_P = 272;

#ifndef PROBE_CVAR
#define PROBE_CVAR 0
#endif
__device__ __forceinline__ void conv_phase(const Params& p, int jl, LAS unsigned char* lds, int pvar = 0, int cvt_layer = -1, int cvt_n = 0) {
    const int tid = tid_fresh(); const bool cv_outer = !(pvar && (PROBE_CVAR & 1)), cv_inner = !(pvar && (PROBE_CVAR & 2));
    LAS f32x2* tw = (LAS f32x2*)(lds + LDS_MISC + 1024);
    tw[tid] = ((const f32x2*)(p.ws + WS_TW))[tid];
    __syncthreads();
    const h16* ut = (const h16*)(p.ws + WS_UT); h16* zt = (h16*)(p.ws + WS_ZT);
    const float* cw = p.hy_conv_w + (size_t)jl * 3 * D3; const float* cb = p.hy_conv_b + (size_t)jl * D3;
    {
        const int grp = tid >> 8, tau = tid & 255;
        LAS f32x2* E = (LAS f32x2*)(lds + grp * 69632); LAS f32x2* O = E + 4352; LAS h16* ST = (LAS h16*)E;
        int uit = 0; const int utrig = 4 * (((int)blockIdx.x >> 3) & 3);
        for (int unit = blockIdx.x; unit < 4096; unit += gridDim.x, ++uit) {
            if (cvt_layer >= 0 && uit == utrig) { __syncthreads(); cvt_moe_share(p, cvt_layer, blockIdx.x, cvt_n, gridDim.x, (LAS float*)lds); }
            const int ux = unit & 7, uj = unit >> 3; const int hq = uj & 1, d = (uj >> 1) * 8 + ux; const size_t col0 = (size_t)(4 * hq + 2 * grp) * 4096;
            const f32x2* kfb = (const f32x2*)(p.ws + WS_KF) + ((size_t)(jl * 2) * 2048 + d) * 8192 + (size_t)tau * 2;
            f16x8 raw[2][2][2], raw2[2][2];
#pragma unroll
            for (int sq = 0; sq < 2; ++sq)
#pragma unroll
                for (int bb = 0; bb < 2; ++bb)
#pragma unroll
                    for (int k = 0; k < 2; ++k) raw[sq][bb][k] = *(const f16x8*)(ut + (size_t)(sq * D + d) * TT + col0 + (size_t)bb * 4096 + (size_t)(tau + 256 * k) * 8);
            __syncthreads();
#pragma unroll
            for (int sq = 0; sq < 2; ++sq)
#pragma unroll
                for (int bb = 0; bb < 2; ++bb)
#pragma unroll
                    for (int k = 0; k < 2; ++k) *(LAS f16x8*)(ST + (sq * 2 + bb) * ST_P + 8 + (tau + 256 * k) * 8) = raw[sq][bb][k];
            if (tau < 4) { ST[tau * ST_P + 7] = (h16)0.f; ST[tau * ST_P + 8 + 4096] = (h16)0.f; }
            __syncthreads();
            f32x2 xin[16], gk[16], y[16];
            { const float w0 = cw[d], w1 = cw[D3 + d], w2 = cw[2 * D3 + d], bv = cb[d]; const float g0 = cw[D + d], g1 = cw[D3 + D + d], g2 = cw[2 * D3 + D + d], gb = cb[D + d];
#pragma unroll
                for (int jj = 0; jj < 16; ++jj) { const int nn = tau + 256 * jj;
                    xin[jj] = (f32x2){conv3_lds(ST + 8, nn, w0, w1, w2, bv), conv3_lds(ST + ST_P + 8, nn, w0, w1, w2, bv)};
                    gk[jj] = (f32x2){conv3_lds(ST + 2 * ST_P + 8, nn, g0, g1, g2, gb), conv3_lds(ST + 3 * ST_P + 8, nn, g0, g1, g2, gb)}; } }
            __syncthreads();
#pragma unroll 1
            for (int ord = 0; ord < 2; ++ord) {
                if (cv_outer) fft_fwd0<256>(xin, xin, E, O, tau, tw);
                const f32x2* kf = kfb + (size_t)ord * 2048 * 8192; f32x4 kfe[8], kfo[8];
                kf_load<256>(kf, kfe);
                __syncthreads();
                if (cv_inner) fft_pass1_pair<false>(E, O, tau, tw);
                kf_load<256>(kf + 4096, kfo);
                __syncthreads();
                if (cv_inner) { fft_mid(E, tau, kfe); fft_mid(O, tau, kfo); }
                if (ord == 0) {
#pragma unroll
                    for (int bb = 0; bb < 2; ++bb)
#pragma unroll
                        for (int k = 0; k < 2; ++k) raw2[bb][k] = *(const f16x8*)(ut + (size_t)(2 * D + d) * TT + col0 + (size_t)bb * 4096 + (size_t)(tau + 256 * k) * 8); }
                __syncthreads();
                if (cv_inner) fft_pass1_pair<true>(E, O, tau, tw);
                __syncthreads();
                if (cv_outer) fft_inv0<256>(E, O, tau, tw, y); else {
#pragma unroll
                    for (int jj = 0; jj < 16; ++jj) y[jj] = xin[jj]; }
#pragma unroll
                for (int jj = 0; jj < 16; ++jj) xin[jj] = gk[jj] * y[jj];
                if (ord == 0) {
                    __syncthreads();
#pragma unroll
                    for (int bb = 0; bb < 2; ++bb)
#pragma unroll
                        for (int k = 0; k < 2; ++k) *(LAS f16x8*)(ST + bb * ST_P + 8 + (tau + 256 * k) * 8) = raw2[bb][k];
                    if (tau < 2) { ST[tau * ST_P + 7] = (h16)0.f; ST[tau * ST_P + 8 + 4096] = (h16)0.f; }
                    __syncthreads();
                    const float g0 = cw[2 * D + d], g1 = cw[D3 + 2 * D + d], g2 = cw[2 * D3 + 2 * D + d], gb = cb[2 * D + d];
#pragma unroll
                    for (int jj = 0; jj < 16; ++jj) { const int nn = tau + 256 * jj; gk[jj] = (f32x2){conv3_lds(ST + 8, nn, g0, g1, g2, gb), conv3_lds(ST + ST_P + 8, nn, g0, g1, g2, gb)}; }
                    __syncthreads();
                }
            }
            h16* o0 = zt + (size_t)d * TT + col0; h16* o1 = o0 + 4096;
#pragma unroll
            for (int jj = 0; jj < 16; ++jj) { const int nn = tau + 256 * jj; o0[nn] = (h16)xin[jj].x; o1[nn] = (h16)xin[jj].y; }
        }
    }
    {
        const int pr = tid >> 4, i = tid & 15, c8 = pr >> 2, bp = pr & 3;
        LAS f32x2* E = (LAS f32x2*)(lds + pr * 4352); LAS f32x2* O = E + 272; LAS h16* ST = (LAS h16*)lds;
        for (int unit = blockIdx.x; unit < 256; unit += gridDim.x) {
            const int d0 = unit * 8, d = d0 + c8;
            const f32x2* kfb = (const f32x2*)(p.ws + WS_KFC) + ((size_t)(jl * 2) * 2048 + d) * 512 + (size_t)i * 2;
            f16x8 raw[3][4];
#pragma unroll
            for (int sq = 0; sq < 3; ++sq)
#pragma unroll
                for (int k = 0; k < 4; ++k) { const int q = tid + 512 * k, row = q >> 5, ch = q & 31;
                    raw[sq][k] = *(const f16x8*)(ut + (size_t)(sq * D + d0 + (row >> 3)) * TT + TL + (row & 7) * 256 + ch * 8); }
            __syncthreads();
#pragma unroll
            for (int sq = 0; sq < 2; ++sq)
#pragma unroll
                for (int k = 0; k < 4; ++k) { const int q = tid + 512 * k, row = q >> 5, ch = q & 31; *(LAS f16x8*)(ST + (sq * 64 + row) * STS_P + 8 + ch * 8) = raw[sq][k]; }
            if (tid < 128) { ST[tid * STS_P + 7] = (h16)0.f; ST[tid * STS_P + 8 + 256] = (h16)0.f; }
            __syncthreads();
            f32x2 xin[16], gk[16], y[16];
            { const float w0 = cw[d], w1 = cw[D3 + d], w2 = cw[2 * D3 + d], bv = cb[d]; const float g0 = cw[D + d], g1 = cw[D3 + D + d], g2 = cw[2 * D3 + D + d], gb = cb[D + d];
                const LAS h16* r0 = ST + (c8 * 8 + 2 * bp) * STS_P + 8; const LAS h16* r1 = r0 + 64 * STS_P;
#pragma unroll
                for (int jj = 0; jj < 16; ++jj) { const int nn = i + 16 * jj;
                    xin[jj] = (f32x2){conv3_lds(r0, nn, w0, w1, w2, bv), conv3_lds(r0 + STS_P, nn, w0, w1, w2, bv)};
                    gk[jj] = (f32x2){conv3_lds(r1, nn, g0, g1, g2, gb), conv3_lds(r1 + STS_P, nn, g0, g1, g2, gb)}; } }
            __syncthreads();
#pragma unroll 1
            for (int ord = 0; ord < 2; ++ord) {
                const f32x2* kf = kfb + (size_t)ord * 2048 * 512; f32x4 kfe[8], kfo[8];
                fft_fwd0<16>(xin, xin, E, O, i, tw);
                __syncthreads();
                kf_load<16>(kf, kfe); fft_mid(E, i, kfe); kf_load<16>(kf + 256, kfo); fft_mid(O, i, kfo);
                __syncthreads();
                fft_inv0<16>(E, O, i, tw, y);
#pragma unroll
                for (int jj = 0; jj < 16; ++jj) xin[jj] = gk[jj] * y[jj];
                if (ord == 0) {
                    __syncthreads();
#pragma unroll
                    for (int k = 0; k < 4; ++k) { const int q = tid + 512 * k, row = q >> 5, ch = q & 31; *(LAS f16x8*)(ST + row * STS_P + 8 + ch * 8) = raw[2][k]; }
                    if (tid < 64) { ST[tid * STS_P + 7] = (h16)0.f; ST[tid * STS_P + 8 + 256] = (h16)0.f; }
                    __syncthreads();
                    const float g0 = cw[2 * D + d], g1 = cw[D3 + 2 * D + d], g2 = cw[2 * D3 + 2 * D + d], gb = cb[2 * D + d];
                    const LAS h16* r0 = ST + (c8 * 8 + 2 * bp) * STS_P + 8;
#pragma unroll
                    for (int jj = 0; jj < 16; ++jj) { const int nn = i + 16 * jj; gk[jj] = (f32x2){conv3_lds(r0, nn, g0, g1, g2, gb), conv3_lds(r0 + STS_P, nn, g0, g1, g2, gb)}; }
                    __syncthreads();
                }
            }
            h16* o0 = zt + (size_t)d * TT + TL + (2 * bp) * 256; h16* o1 = o0 + 256;
#pragma unroll
            for (int jj = 0; jj < 16; ++jj) { const int nn = i + 16 * jj; o0[nn] = (h16)xin[jj].x; o1[nn] = (h16)xin[jj].y; }
        }
    }
}

constexpr int AT_KP = 72, AT_VP = 68;
__device__ __forceinline__ void attn_phase(const Params& p, int jl, bool with_ctx_out, LAS unsigned char* lds, int cvt_layer = -1, int cvt_n = 0) {
    const int tid = tid_fresh(), wv = tid >> 6, lane = tid & 63, r32 = lane & 31, hh = lane >> 5;
    LAS h16* Ks = (LAS h16*)lds; LAS h16* Vs = (LAS h16*)(lds + 64 * AT_KP * 2);
    const h16* qk = (const h16*)(p.ws + WS_QK); const h16* vt = (const h16*)(p.ws + WS_VT); h16* ob = (h16*)(p.ws + WS_HBUF);
    LAS float* rcos = (LAS float*)(lds + 65536); LAS float* rsin = rcos + 1024;
    { const float* rg = (const float*)(p.ws + WS_ROPE); for (int i = tid; i < 2048; i += 512) rcos[i] = rg[i]; }
    __syncthreads();
    const int nunit = 2048 + (with_ctx_out ? 128 : 0);
    int uit = 0; const int utrig = 2 * (((int)blockIdx.x >> 3) & 3);
    for (int unit = blockIdx.x; unit < nunit; unit += gridDim.x, ++uit) {
        if (cvt_layer >= 0 && uit == utrig) { __syncthreads(); cvt_moe_share(p, cvt_layer, blockIdx.x, cvt_n, gridDim.x, (LAS float*)lds); }
        int kind, b, g, qb;
        if (unit < 2048) { kind = 0; qb = unit & 63; g = (unit >> 6) & 3; b = unit >> 8; } else { const int u2 = unit - 2048; kind = 1; qb = u2 & 3; g = (u2 >> 2) & 3; b = u2 >> 4; }
        const int head = g * 8 + wv;
        const int qrow0 = kind ? (TL + b * 256 + qb * 64) : (b * 4096 + qb * 64);
        const int ctxrow0 = TL + b * 256;
        const int t_lo = kind ? 0 : (qb < 2 ? 2 - qb : 0), t_hi = kind ? -1 : (65 - qb < 4 ? 65 - qb : 4); const int nwin = t_hi - t_lo + 1, nv = nwin + 4;
        const bool krole = tid < 256; const int kkey = tid >> 2, kcp = tid & 3, kdA = (kcp & 1) * 8 + (kcp >> 1) * 32; const int vdim = (tid - 256) >> 2, vkc = tid & 3;
        f16x8 ld0, ld1;
#define AT_TILE(sidx, KROW0, MASK, ROPE) do { if ((sidx) < nwin) { const int _ti = t_lo + (sidx); KROW0 = b * 4096 + qb * 64 - 128 + 64 * _ti; ROPE = true; MASK = (_ti == 0) ? 1 : (_ti == 4) ? 2 : 0; } \
            else { KROW0 = ctxrow0 + 64 * ((sidx) - nwin); ROPE = false; MASK = 0; } } while (0)
#define AT_LOAD(KROW0) do { if (krole) { const h16* kp = qk + (size_t)((KROW0) + kkey) * DQK + D + g * 64 + kdA; ld0 = *(const f16x8*)kp; ld1 = *(const f16x8*)(kp + 16); } \
            else { const h16* vp = vt + (size_t)(g * 64 + vdim) * TT + (KROW0) + 16 * vkc; ld0 = *(const f16x8*)vp; ld1 = *(const f16x8*)(vp + 8); } } while (0)
        { int kr0, mk; bool rp; AT_TILE(0, kr0, mk, rp); (void)mk; (void)rp; AT_LOAD(kr0); }
        f16x8 qf[2][4];
#pragma unroll
        for (int qt = 0; qt < 2; ++qt) {
            f32x4 qv[4][2];
            const h16* qp = qk + (size_t)(qrow0 + 32 * qt + r32) * DQK + head * 64 + 8 * hh;
#pragma unroll
            for (int ks = 0; ks < 4; ++ks) { const f16x8 t = *(const f16x8*)(qp + 16 * ks);
#pragma unroll
                for (int i = 0; i < 4; ++i) { qv[ks][0][i] = (float)t[i]; qv[ks][1][i] = (float)t[4 + i]; } }
            if (kind == 0) {
                const int colpos = 32 * qt + r32;
#pragma unroll
                for (int a = 0; a < 2; ++a) { const int pos = a ? colpos : qb; const LAS float* cp = rcos + pos * 16 + 8 * hh; const LAS float* sp = rsin + pos * 16 + 8 * hh;
#pragma unroll
                    for (int e = 0; e < 2; ++e) { const f32x4 c = *(const LAS f32x4*)(cp + 4 * e), s = *(const LAS f32x4*)(sp + 4 * e);
                        const f32x4 x1 = qv[2 * a][e], x2 = qv[2 * a + 1][e]; qv[2 * a][e] = x1 * c - x2 * s; qv[2 * a + 1][e] = x2 * c + x1 * s; } }
            }
#pragma unroll
            for (int ks = 0; ks < 4; ++ks)
#pragma unroll
                for (int i = 0; i < 4; ++i) { qf[qt][ks][i] = (h16)(qv[ks][0][i] * (0.125f * 1.4426950408889634f)); qf[qt][ks][4 + i] = (h16)(qv[ks][1][i] * (0.125f * 1.4426950408889634f)); }
        }
        const float sink = p.at_sink[jl * 32 + head] * 1.4426950408889634f;
        float mrun[2] = {sink, sink}, lrun[2] = {hh == 0 ? 1.f : 0.f, hh == 0 ? 1.f : 0.f};
        f32x16 oacc[2][2];
#pragma unroll
        for (int a = 0; a < 2; ++a)
#pragma unroll
            for (int c = 0; c < 2; ++c)
#pragma unroll
                for (int i = 0; i < 16; ++i) oacc[a][c][i] = 0.f;
#pragma unroll 1
        for (int sx = 0; sx < nv; ++sx) {
            int krow0, mask; bool rope; AT_TILE(sx, krow0, mask, rope);
            __syncthreads();
            if (krole) {
                f16x8 o1 = ld0, o2 = ld1;
                if (rope) { const int kpos = (krow0 - b * 4096) + kkey; const int pos = (kcp >> 1) ? (kpos & 63) : (kpos >> 6);
                    const LAS float* cpp = rcos + pos * 16 + (kcp & 1) * 8; const LAS float* spp = rsin + pos * 16 + (kcp & 1) * 8;
#pragma unroll
                    for (int i = 0; i < 8; ++i) { const float c = cpp[i], s = spp[i], x1 = (float)ld0[i], x2 = (float)ld1[i]; o1[i] = (h16)(x1 * c - x2 * s); o2[i] = (h16)(x2 * c + x1 * s); } }
                *(LAS f16x8*)(Ks + kkey * AT_KP + kdA) = o1; *(LAS f16x8*)(Ks + kkey * AT_KP + kdA + 16) = o2;
            } else {
                LAS h16* dst = Vs + vdim * AT_VP + 16 * vkc;
                *(LAS f16x4*)(dst) = (f16x4){ld0[0], ld0[1], ld0[2], ld0[3]}; *(LAS f16x4*)(dst + 4) = (f16x4){ld0[4], ld0[5], ld0[6], ld0[7]};
                *(LAS f16x4*)(dst + 8) = (f16x4){ld1[0], ld1[1], ld1[2], ld1[3]}; *(LAS f16x4*)(dst + 12) = (f16x4){ld1[4], ld1[5], ld1[6], ld1[7]};
            }
            if (sx + 1 < nv) { int kr1, mk1; bool rp1; AT_TILE(sx + 1, kr1, mk1, rp1); (void)mk1; (void)rp1; AT_LOAD(kr1); }
            __syncthreads();
#pragma unroll
            for (int qt = 0; qt < 2; ++qt) {
                f32x16 sacc[2];
#pragma unroll
                for (int kt = 0; kt < 2; ++kt)
#pragma unroll
                    for (int i = 0; i < 16; ++i) sacc[kt][i] = 0.f;
#pragma unroll
                for (int ks = 0; ks < 4; ++ks)
#pragma unroll
                    for (int kt = 0; kt < 2; ++kt) { const f16x8 kf = *(const LAS f16x8*)(Ks + (32 * kt + r32) * AT_KP + 16 * ks + 8 * hh);
                        sacc[kt] = __builtin_amdgcn_mfma_f32_32x32x16_f16(kf, qf[qt][ks], sacc[kt], 0, 0, 0); }
                float tmax = -3.0e38f;
                if (mask != 0) {
                    int lim = r32 - 4 * hh; asm volatile("" : "+v"(lim));
                    if (mask == 1) {
#pragma unroll
                        for (int kt = 0; kt < 2; ++kt) {
                            if (kt < qt) {
#pragma unroll
                                for (int i = 0; i < 16; ++i) sacc[kt][i] = -1.0e30f; }
                            else if (kt == qt) {
#pragma unroll
                                for (int i = 0; i < 16; ++i) { const int kc = (i & 3) + 8 * (i >> 2); if (kc < lim) sacc[kt][i] = -1.0e30f; } } }
                    } else {
#pragma unroll
                        for (int kt = 0; kt < 2; ++kt) {
                            if (kt > qt) {
#pragma unroll
                                for (int i = 0; i < 16; ++i) sacc[kt][i] = -1.0e30f; }
                            else if (kt == qt) {
#pragma unroll
                                for (int i = 0; i < 16; ++i) { const int kc = (i & 3) + 8 * (i >> 2); if (kc > lim) sacc[kt][i] = -1.0e30f; } } }
                    } }
#pragma unroll
                for (int kt = 0; kt < 2; ++kt)
#pragma unroll
                    for (int i = 0; i < 16; ++i) tmax = fmaxf(tmax, sacc[kt][i]);
                tmax = fmaxf(tmax, shx(tmax, 32));
                const float mnew = fmaxf(mrun[qt], tmax); const float alpha = __builtin_amdgcn_exp2f(mrun[qt] - mnew); mrun[qt] = mnew;
                float psum = 0.f; f16x8 pf[2][2];
#pragma unroll
                for (int kt = 0; kt < 2; ++kt)
#pragma unroll
                    for (int s2 = 0; s2 < 2; ++s2)
#pragma unroll
                        for (int jj = 0; jj < 8; jj += 2) { const float p0 = __builtin_amdgcn_exp2f(sacc[kt][8 * s2 + jj] - mnew), p1 = __builtin_amdgcn_exp2f(sacc[kt][8 * s2 + jj + 1] - mnew);
                            const f16x2 pk = {(h16)p0, (h16)p1}; pf[kt][s2][jj] = pk[0]; pf[kt][s2][jj + 1] = pk[1];
                            psum = __builtin_amdgcn_fdot2(pk, (f16x2){(h16)1.0f, (h16)1.0f}, psum, false); }
                lrun[qt] = lrun[qt] * alpha + psum;
                if (__builtin_amdgcn_ballot_w64(alpha != 1.0f) != 0ull) {
#pragma unroll
                for (int dt = 0; dt < 2; ++dt)
#pragma unroll
                    for (int i = 0; i < 16; ++i) oacc[dt][qt][i] *= alpha; }
#pragma unroll
                for (int kt = 0; kt < 2; ++kt)
#pragma unroll
                    for (int s2 = 0; s2 < 2; ++s2)
#pragma unroll
                        for (int dt = 0; dt < 2; ++dt) { const LAS h16* vr = Vs + (32 * dt + r32) * AT_VP + 32 * kt + 16 * s2 + 4 * hh;
                            const f16x4 v0 = *(const LAS f16x4*)vr, v1 = *(const LAS f16x4*)(vr + 8);
                            const f16x8 vf = (f16x8){v0[0], v0[1], v0[2], v0[3], v1[0], v1[1], v1[2], v1[3]};
                            oacc[dt][qt] = __builtin_amdgcn_mfma_f32_32x32x16_f16(vf, pf[kt][s2], oacc[dt][qt], 0, 0, 0); }
            }
        }
        {   LAS h16* Ow = (LAS h16*)(lds + (wv < 4 ? 18432 + wv * 9216 : 73728 + (wv - 4) * 9216));
#pragma unroll
            for (int qt = 0; qt < 2; ++qt) {
                const float ltot = lrun[qt] + shx(lrun[qt], 32); const float inv = 1.0f / ltot;
                LAS h16* orow = Ow + (32 * qt + r32) * 72 + 4 * hh;
#pragma unroll
                for (int dt = 0; dt < 2; ++dt)
#pragma unroll
                    for (int q4 = 0; q4 < 4; ++q4) { f16x4 w;
#pragma unroll
                        for (int i = 0; i < 4; ++i) w[i] = (h16)(oacc[dt][qt][4 * q4 + i] * inv);
                        *(LAS f16x4*)(orow + 32 * dt + 8 * q4) = w; }
            }
            asm volatile("s_waitcnt lgkmcnt(0)" ::: "memory");
            const int orw = lane >> 3, och = lane & 7;
#pragma unroll
            for (int ps = 0; ps < 8; ++ps) { const int q = 8 * ps + orw; const f16x8 w = *(const LAS f16x8*)(Ow + q * 72 + 8 * och);
                *(f16x8*)(ob + (size_t)(qrow0 + q) * D + head * 64 + 8 * och) = w; }
        }
    }
}
#undef AT_TILE
#undef AT_LOAD

constexpr int NPHASE = 35;
#ifndef MK_MULTI
#define MK_MULTI 0
#endif

template <int KIND>
__attribute__((target("no-packed-fp32-ops"))) __global__ void __launch_bounds__(512, 2) hy_fwd(Params p_) {
    extern __shared__ __attribute__((aligned(16))) unsigned char shm[];
    LAS unsigned char* lds = (LAS unsigned char*)shm;
    constexpr bool ALL = KIND < 0;
    const int ph0 = p_.ph0;
    if (threadIdx.x == 0) { *(LAS u32x4*)(lds + LDS_XB) = (u32x4){0u, 0u, 0u, 0u}; }
    __syncthreads();
    XcdBarrier bar;
    if constexpr (ALL) bar = xcd_barrier_post((unsigned*)(p_.ws + WS_CTL), (volatile LAS unsigned*)(lds + LDS_XB));
#ifndef PROBE_SITE
#define PROBE_SITE -1
#endif
#define SITE(k) if constexpr (ALL || KIND == (k)) for (int rep_ = 0; rep_ < ((k) == PROBE_SITE ? 2 : 1); ++rep_) if (const Params& p = *params_fresh(); true)
#ifndef PROBE_XBAR
#define PROBE_XBAR 1
#endif
#define SEAM() do { if constexpr (ALL) { xcd_barrier(bar); if (PROBE_XBAR > 1) xcd_barrier(bar); if (PROBE_XBAR > 2) xcd_barrier(bar); } } while (0)
    const int G = gridDim.x, bid = blockIdx.x;
    SITE(0) {
        for (int u = bid; u < 4993; u += G) {
            if (u < 384) modp_unit(p, u, (LAS float*)lds);
            else if (u == 384) tables_unit(p);
            else if (u < 1473) h2_task(p, (u - 385) * 8 + (tid_fresh() >> 6));
            else if (u < 1537) w3p_unit(p, u - 1473);
            else if (u < 1793) rtab_unit(p, u - 1537);
            else cvt_dense_unit(p, u - 1793, (LAS float*)lds);
        }
        SEAM();
    }
    SITE(1) {
        for (int u = bid; u < 216; u += G) modr_unit(p, u);
        SchedFilt S{p.ws + WS_W3P, p.ws + WS_H2P}; EpiTaps E{(float*)(p.ws + WS_TAPS), (float*)(p.ws + WS_TAPSC)};
        pg8::gemm_phase<EpiTaps, SchedFilt, 0>(lds, 256, S, E);
        SEAM();
    }
#define TAIL_IDLE(nunits) (((nunits) % G) ? G - ((nunits) % G) : 0)
#define CVT_PER_GEMM 20
#pragma unroll 1
    for (int layer = ALL ? 0 : ph0; layer < (ALL ? NLAYER : ph0 + 1); ++layer) {
        const bool hyena = (layer & 1) == 0; const int jl = layer >> 1;
        const int nu1 = hyena ? 24 * 136 : 136 * 10, nu4 = (layer == NLAYER - 1 ? 128 : 136) * 8;
        const int idle1 = TAIL_IDLE(nu1), idle4 = TAIL_IDLE(nu4);
        int cv4 = idle4 * CVT_PER_GEMM, cv1 = idle1 * CVT_PER_GEMM; if (cv4 > CVT_MOE_UNITS / 2) cv4 = CVT_MOE_UNITS / 2; if (cv1 > CVT_MOE_UNITS / 2 - 1) cv1 = CVT_MOE_UNITS / 2 - 1;
        const int cvN0 = CVT_MOE_UNITS - cv1 - cv4, cvN1 = cvN0 + cv1;
        SITE(2) {
            n1_phase(p, layer, (h16*)(p.ws + ((!ALL && p.ph1) ? WS_UT : WS_XRES)));
            for (int rep2_ = 0; rep2_ < ((PROBE_SITE == 20 && layer > 0) ? 2 : 1); ++rep2_) {
            if (layer == 0) filt_fft_phase(p, lds);
            else { (void)0; } }
            SEAM();
        }
        SITE(3) {
#ifdef PROBE_CLK
            unsigned long long pc0_ = __builtin_readcyclecounter(), pr0_ = wall_clock64();
#endif
            if (hyena) { SchedPlain S{24, 136, D, p.ws + WS_WIN + (size_t)jl * D3 * D * 2, p.ws + WS_HBUF}; EpiH16 E{(h16*)(p.ws + WS_UT), TT, nullptr, 0};
                pg8::gemm_phase<EpiH16, SchedPlain, 0>(lds, D, S, E); }
            else { SchedQkv S{p.ws + WS_HBUF, p.ws + WS_WQKV + (size_t)jl * DQKV * D * 2}; EpiH16 E{(h16*)(p.ws + WS_QK), DQK, (h16*)(p.ws + WS_VT), TT};
                pg8::gemm_phase<EpiH16, SchedQkv, 0>(lds, D, S, E); }
#ifdef PROBE_CLK
            if (bid == 0 && threadIdx.x == 0) { const unsigned long long dc = __builtin_readcyclecounter() - pc0_, dr = wall_clock64() - pr0_; const unsigned long long spin = dc * 2500ull / (dr ? dr : 1ull);
                const unsigned long long t0 = wall_clock64(); while (wall_clock64() - t0 < spin) __builtin_amdgcn_s_sleep(8); }
#endif
            if (idle1 > 0 && bid >= G - idle1) { cvt_moe_share(p, layer, cvN0 + (bid - (G - idle1)), cvN1, idle1, (LAS float*)lds); }
            SEAM();
        }
        SITE(4) {
#ifdef PROBE_PAR
            for (int rep3_ = 0; rep3_ < (((layer & 1) == PROBE_PAR) ? 2 : 1); ++rep3_)
#endif
            { if (hyena) conv_phase(p, jl, lds, ALL ? 0 : p.ph1, layer, cvN0);
            else attn_phase(p, jl, layer != NLAYER - 1, lds, layer, cvN0); }
            SEAM();
        }
        SITE(5) {
            (void)0;
        }
        SITE(6) {
            EpiResid E{(h16*)(p.ws + WS_XRES), (const float*)(p.ws + WS_MODS), layer, (float*)(p.ws + WS_SSQ), (!ALL && p.ph1) ? (h16*)(p.ws + WS_YC) : (h16*)(p.ws + WS_XRES)};
            if (hyena) {
                SchedPlainAT S{layer == NLAYER - 1 ? 128 : 136, 8, D, p.ws + WS_ZT, p.ws + WS_WOUT + (size_t)jl * D * D * 2};
                pg8::gemm_phase<EpiResid, SchedPlainAT, 2>(lds, D, S, E, TT);
            } else {
                SchedPlain S{layer == NLAYER - 1 ? 128 : 136, 8, D, p.ws + WS_HBUF, p.ws + WS_WO + (size_t)jl * D * D * 2};
                pg8::gemm_phase<EpiResid, SchedPlain, 0>(lds, D, S, E);
            }
            if (idle4 > 0 && bid >= G - idle4) { cvt_moe_share(p, layer, cvN1 + (bid - (G - idle4)), CVT_MOE_UNITS, idle4, (LAS float*)lds); }
            SEAM();
        }
        SITE(7) { n2_phase(p, layer, lds, ALL ? 0 : p.ph1); SEAM(); }
        LAS int* tstart = (LAS int*)(lds + LDS_MISC); LAS int* texp = tstart + 80; LAS int* tcnt = texp + 352;
        SITE(8) {
            moe_table(tstart, texp, tcnt, (const int*)(p.ws + WS_CTL) + CTL_CNT + layer * NE);
            SchedMoe1 S{{tstart, texp, tcnt}, p.ws + WS_HBUF, p.ws + WS_W13, (const int*)(p.ws + WS_LIST)}; EpiMoe1 E{(h16*)(p.ws + WS_H1)};
            pg8::gemm_phase<EpiMoe1, SchedMoe1, 1>(lds, D, S, E);
            SEAM();
        }
        SITE(9) {
            moe_table(tstart, texp, tcnt, (const int*)(p.ws + WS_CTL) + CTL_CNT + layer * NE);
            SchedMoe2 S{{tstart, texp, tcnt}, p.ws + WS_H1, p.ws + WS_W2, (const int*)(p.ws + WS_LIST)}; EpiMoe2 E{(h16*)(p.ws + WS_YC), (const float*)(p.ws + WS_GATE), (const int*)(p.ws + WS_LIST)};
            pg8::gemm_phase<EpiMoe2, SchedMoe2, 0>(lds, DE, S, E);
            SEAM();
        }
    }
    SITE(10) final_phase(p);
#undef SITE
#undef SEAM
}

template <int KIND> static void launch_kind(const Params& p, int grid, hipStream_t stream) {
    static bool attr = false;
    if (!attr) { attr = true; if (hipFuncSetAttribute((const void*)hy_fwd<KIND>, hipFuncAttributeMaxDynamicSharedMemorySize, LDS_BYTES) != hipSuccess) fprintf(stderr, "kernel_launch: hipFuncSetAttribute failed (kind %d)\n", KIND); }
    hipLaunchKernelGGL(hy_fwd<KIND>, dim3(grid), dim3(512), LDS_BYTES, stream, p);
}

extern "C" void kernel_launch(void* const* d_in, const int* in_sizes, int n_in, void* d_out, int out_size, void* d_ws, size_t ws_size, hipStream_t stream) {
    static int grid = 0;
    if (!grid) {
        if (n_in != 29 || out_size != TL * D || ws_size < WS_END) { fprintf(stderr, "kernel_launch: unexpected problem (n_in %d, out %d, ws %zu < %zu)\n", n_in, out_size, ws_size, (size_t)WS_END); grid = -1; return; }
        int dev = 0, cus = 0;
        if (hipGetDevice(&dev) != hipSuccess || hipDeviceGetAttribute(&cus, hipDeviceAttributeMultiprocessorCount, dev) != hipSuccess) { grid = -1; return; }
        grid = cus;
    }
    if (grid <= 0) return;
    (void)hipMemsetAsync((char*)d_ws + WS_CTL, 0, CTL_BYTES, stream);
    Params p{};
    const float** pp = (const float**)&p;
    for (int i = 0; i < 29; ++i) pp[i] = (const float*)d_in[i];
    p.out = (float*)d_out; p.ws = (char*)d_ws;
#if MK_MULTI
    p.ph0 = 0; p.ph1 = 0;
    launch_kind<0>(p, grid, stream); launch_kind<1>(p, grid, stream);
#ifndef PROBE_KINDS
#define PROBE_KINDS 0
#endif
#ifndef PROBE_VAR
#define PROBE_VAR 0
#endif
#ifndef PROBE_LAYERS
#define PROBE_LAYERS 15
#endif
#define PKIND(k) ((PROBE_KINDS >> (k)) & 1)
#define PREP(k) ((PKIND(k) && ((PROBE_LAYERS >> layer) & 1)) ? 2 : 1)
    if (PKIND(0)) launch_kind<0>(p, grid, stream);
    if (PKIND(1)) launch_kind<1>(p, grid, stream);
    for (int layer = 0; layer < NLAYER; ++layer) { p.ph0 = layer;
        for (int r = 0; r < PREP(2); ++r) { p.ph1 = (PREP(2) == 2 && r == 0) ? 1 : 0; launch_kind<2>(p, grid, stream); p.ph1 = 0; }
        for (int r = 0; r < PREP(3); ++r) { p.ph1 = (PREP(3) == 2 && r == 0) ? PROBE_VAR : 0; launch_kind<3>(p, grid, stream); p.ph1 = 0; }
        for (int r = 0; r < PREP(4); ++r) { p.ph1 = (PREP(4) == 2 && r == 0) ? 1 : 0; launch_kind<4>(p, grid, stream); p.ph1 = 0; }
        if (PREP(6) == 2) { p.ph1 = 1; launch_kind<6>(p, grid, stream); p.ph1 = 0; }
        launch_kind<6>(p, grid, stream); launch_kind<7>(p, grid, stream);
        if (PREP(7) == 2) { p.ph1 = 1; launch_kind<7>(p, grid, stream); p.ph1 = 0; }
        for (int r = 0; r < PREP(8); ++r) launch_kind<8>(p, grid, stream);
        for (int r = 0; r < PREP(9); ++r) launch_kind<9>(p, grid, stream); }
    p.ph0 = 0; launch_kind<10>(p, grid, stream);
    if (PKIND(10)) launch_kind<10>(p, grid, stream);
#else
    p.ph0 = 0; p.ph1 = NPHASE;
    launch_kind<-1>(p, grid, stream);
#endif
}
```

```cpp
#include <hip/hip_runtime.h>
#include <cstdio>
#include <cstdint>

#define LAS __attribute__((address_space(3)))
typedef _Float16 h16;
typedef _Float16 f16x8 __attribute__((ext_vector_type(8)));
typedef _Float16 f16x4 __attribute__((ext_vector_type(4)));
typedef _Float16 f16x2 __attribute__((ext_vector_type(2)));
typedef float f32x2 __attribute__((ext_vector_type(2)));
typedef float f32x4 __attribute__((ext_vector_type(4)));
typedef float f32x16 __attribute__((ext_vector_type(16)));
typedef unsigned u32x2 __attribute__((ext_vector_type(2)));
typedef unsigned u32x4 __attribute__((ext_vector_type(4)));

constexpr int D = 2048, NB = 8, SEQ = 4096, CTXL = 256, TL = NB * SEQ, TC = NB * CTXL, TT = TL + TC;
constexpr int D3 = 3 * D, D6 = 6 * D, DQK = 2304, DQKV = 2560, NE = 64, DE = 384, DE2 = 768, NLAYER = 4;
constexpr int LCAP = TT;
constexpr int MOE_ROWS = 86016;
constexpr float EPS = 1e-6f;

constexpr size_t WS_CTL = 0;
constexpr size_t CTL_BYTES = 65536;
constexpr size_t WS_TW = WS_CTL + CTL_BYTES;
constexpr size_t WS_ROPE = WS_TW + 65536;
constexpr size_t WS_MODP = WS_ROPE + 8192;
constexpr size_t WS_MODS = WS_MODP + 16ull * 4 * 9 * 12288 * 4;
constexpr size_t WS_RTAB = WS_MODS + 4ull * 9 * 12288 * 4;
constexpr size_t RTAB_L = 64ull * 5 * 2 * 64 * 8 * 2;
constexpr size_t WS_RCST = WS_RTAB + 4 * RTAB_L;
constexpr size_t WS_H2P = WS_RCST + 16384;
constexpr size_t WS_W3P = WS_H2P + 2ull * 4352 * 256 * 2;
constexpr size_t WS_XRES = WS_W3P + 2ull * 8192 * 256 * 2;
constexpr size_t WS_HBUF = WS_XRES + (size_t)TT * D * 4;
constexpr size_t WS_UT = WS_HBUF + (size_t)TT * D * 2;
constexpr size_t UT_BYTES = (size_t)D3 * TT * 2;
constexpr size_t WS_TAPS = WS_UT;
constexpr size_t WS_TAPSC = WS_TAPS + 2ull * 8192 * 4096 * 4;
constexpr size_t WS_QK = WS_UT;
constexpr size_t WS_VT = WS_QK + (size_t)TT * DQK * 2;
constexpr size_t WS_ZT = WS_UT + UT_BYTES;
constexpr size_t WS_H1 = WS_ZT + (size_t)D * TT * 2;
constexpr size_t WS_YC = WS_H1 + (size_t)MOE_ROWS * DE * 2;
constexpr size_t WS_WIN = WS_YC + 2ull * TT * D * 2;
constexpr size_t WS_WOUT = WS_WIN + 2ull * D3 * D * 2;
constexpr size_t WS_WQKV = WS_WOUT + 2ull * D * D * 2;
constexpr size_t WS_WO = WS_WQKV + 2ull * DQKV * D * 2;
constexpr size_t WS_W13 = WS_WO + 2ull * D * D * 2;
constexpr size_t WS_W2 = WS_W13 + (size_t)NE * DE2 * D * 2;
constexpr size_t WS_KF = WS_W2 + (size_t)NE * D * DE * 2;
constexpr size_t WS_KFC = WS_KF + 2ull * 2 * 2048 * 65536;
constexpr size_t WS_LIST = WS_KFC + 2ull * 2 * 2048 * 4096;
constexpr size_t WS_GATE = WS_LIST + (size_t)NE * LCAP * 4;
constexpr size_t WS_SSQ = WS_GATE + (size_t)NE * LCAP * 4;
constexpr size_t WS_END = WS_SSQ + (size_t)TT * 32 * 4;
static_assert(WS_TAPSC + 2ull * 8192 * 256 * 4 <= WS_UT + UT_BYTES, "taps alias");
static_assert(WS_VT + 256ull * TT * 2 <= WS_UT + UT_BYTES, "qkv alias");

constexpr int CTL_CNT = 4096;

constexpr int LDS_BYTES = 147456;
constexpr int LDS_MISC = 139264;
constexpr int LDS_XB = LDS_BYTES - 16;

struct Params {
    const float *x, *c, *ctx, *c_ctx, *mod_w, *mod_b, *hy_w_in, *hy_conv_w, *hy_conv_b, *hy_f_w1, *hy_f_b1, *hy_f_freq1, *hy_f_w2, *hy_f_b2, *hy_f_freq2, *hy_f_w3,
        *hy_bias, *hy_w_out, *at_w_qkv, *at_sink, *at_w_o, *moe_wg, *moe_bg, *moe_we, *moe_be, *moe_w1, *moe_w3, *moe_w2, *final_gain;
    float* out; char* ws; int ph0, ph1;
};

__device__ __forceinline__ int tid_fresh() { int t = threadIdx.x; asm volatile("" : "+v"(t)); return t; }
__device__ __forceinline__ float bperm_f(float v, int srclane) { return __int_as_float(__builtin_amdgcn_ds_bpermute(srclane << 2, __float_as_int(v))); }
__device__ __forceinline__ float shx(float v, int mask) { return bperm_f(v, (tid_fresh() & 63) ^ mask); }
__device__ __forceinline__ const Params* params_fresh() { auto q = __builtin_amdgcn_kernarg_segment_ptr(); asm volatile("" : "+s"(q)); return (const Params*)q; }

#define XB_TMO      128
#define XB_XCNT(j)  (256  + 64 * (j))
#define XB_XSUB(j)  (1280 + 64 * (j))
#define XB_XGEN(j)  (2304 + 64 * (j))
#define XB_TOP      3328
#define XB_TOPGEN   3392
#define XCD_BAR_WORDS 3456
#define XB_SPIN_CAP (1u << 18)

__device__ __forceinline__ unsigned xb_ld(unsigned* p)              { return __hip_atomic_load(p, __ATOMIC_RELAXED, __HIP_MEMORY_SCOPE_AGENT); }
__device__ __forceinline__ unsigned xb_add(unsigned* p, unsigned v) { return __hip_atomic_fetch_add(p, v, __ATOMIC_RELAXED, __HIP_MEMORY_SCOPE_AGENT); }
__device__ __forceinline__ unsigned xb_xcc_id() { return (unsigned)__builtin_amdgcn_s_getreg((3 << 11) | 20) & 0xFu; }
#define XB_SPIN(cond, bar) do { unsigned _sp = 0; while (cond) { __builtin_amdgcn_s_sleep(1); \
    if ((++_sp & 255u) == 0u) { if (xb_ld(&(bar)[XB_TMO])) break; if (_sp > XB_SPIN_CAP) { atomicAdd(&(bar)[XB_TMO], 1u); break; } } } } while (0)

struct XcdBarrier { unsigned* bar; volatile LAS unsigned* st; };

__device__ __forceinline__ XcdBarrier xcd_barrier_post(unsigned* bar, volatile LAS unsigned* st) {
    XcdBarrier b; b.bar = bar; b.st = st;
    if (threadIdx.x == 0) (void)xb_add(&bar[XB_XCNT(xb_xcc_id())], 1u);
    return b;
}
__device__ __forceinline__ void xcd_barrier_complete(unsigned* bar, unsigned x, unsigned& nloc, unsigned& nx) {
    const unsigned G = gridDim.x * gridDim.y * gridDim.z;
    unsigned sum, cnt, mine, sp = 0u;
    for (;;) {
        sum = 0u; cnt = 0u; mine = 0u;
#pragma unroll
        for (unsigned j = 0; j < 16; ++j) { const unsigned c = xb_ld(&bar[XB_XCNT(j)]); sum += c; cnt += (c > 0u) ? 1u : 0u; mine = (j == x) ? c : mine; }
        if (sum == G) break;
        __builtin_amdgcn_s_sleep(1);
        if ((++sp & 255u) == 0u) { if (xb_ld(&bar[XB_TMO])) break; if (sp > XB_SPIN_CAP) { atomicAdd(&bar[XB_TMO], 1u); break; } }
    }
    nloc = mine > 0u ? mine : 1u; nx = cnt > 0u ? cnt : 1u;
}
__device__ __forceinline__ void xcd_barrier(const XcdBarrier& b) {
    asm volatile("s_waitcnt vmcnt(0)" ::: "memory");
    __syncthreads();
    if (threadIdx.x == 0) {
        unsigned* bar = b.bar; const unsigned bx = xb_xcc_id();
        __builtin_amdgcn_s_waitcnt(0);
        unsigned nloc = b.st[0], nx = b.st[1];
        if (nloc == 0u) { xcd_barrier_complete(bar, bx, nloc, nx); b.st[0] = nloc; b.st[1] = nx; }
        const unsigned old = xb_add(&bar[XB_XSUB(bx)], 1u);
        const unsigned gen = old / nloc;
        if (old + 1u == (gen + 1u) * nloc) {
            __builtin_amdgcn_fence(__ATOMIC_RELEASE, "agent");
            asm volatile("s_waitcnt vmcnt(0)" ::: "memory");
            const unsigned og = xb_add(&bar[XB_TOP], 1u);
            const unsigned tg = og / nx;
            if (og + 1u == (tg + 1u) * nx) xb_add(&bar[XB_TOPGEN], 1u);
            else XB_SPIN(xb_ld(&bar[XB_TOPGEN]) == tg, bar);
            __builtin_amdgcn_fence(__ATOMIC_ACQUIRE, "agent");
            xb_add(&bar[XB_XGEN(bx)], 1u);
            asm volatile("s_waitcnt vmcnt(0)" ::: "memory");
        } else {
            XB_SPIN(xb_ld(&bar[XB_XGEN(bx)]) == gen, bar);
            __builtin_amdgcn_fence(__ATOMIC_ACQUIRE, "agent");
            asm volatile("s_waitcnt vmcnt(0)" ::: "memory");
        }
    }
    __syncthreads();
}

namespace pg8 {
constexpr int BM = 256, BK = 64, HALF = 128, HTB = HALF * BK * 2, STAGE_BYTES = 8 * HTB;
__device__ __forceinline__ int lds_byte(int r, int c) { const int st = (r >> 4) * 2 + (c >> 5), rr = r & 15, cc = c & 31, ob = rr * 64 + cc * 2; return st * 1024 + (ob ^ (((ob >> 9) & 1) << 5)); }
__device__ __forceinline__ void stage_rc(int b, int& R, int& C) { const int st = b / 1024, sb = b % 1024, swz = sb ^ (((sb >> 9) & 1) << 5); R = (st >> 1) * 16 + swz / 64; C = (st & 1) * 32 + (swz % 64) / 2; }
__device__ __forceinline__ int perm32(int rho) { const int n = rho >> 4, i = rho & 15; return 8 * (i >> 2) + 4 * n + (i & 3); }

struct Unit {
    int pm, pn;
    int e, pos0, cnt;
    int kind;
    int half;
    const char* A; const char* B;
    const int* rows;
};

typedef short s16x4 __attribute__((ext_vector_type(4)));
template <class Epi, class Sched, int AMODE>
__device__ __forceinline__ void gemm_phase(LAS unsigned char* lds, const int K, const Sched& S, const Epi& E, const int ldat = 0) {
    constexpr bool GATHER = AMODE == 1, ATR = AMODE == 2;
    const int tid = tid_fresh(), wid = __builtin_amdgcn_readfirstlane(tid >> 6), lane = tid & 63, wr = wid >> 2, wc = wid & 3, fr = lane & 15, fq = lane >> 4;
    const int nt = K / BK;
    unsigned voffA[2], voffB[2]; int RA[2], CA[2];
#pragma unroll
    for (int i = 0; i < 2; ++i) { int R, C; stage_rc(tid * 16 + i * 8192, R, C); const int Rb = Epi::PERM ? ((R & ~31) + perm32(R & 31)) : R;
        voffA[i] = (unsigned)(R * K + C) * 2u; voffB[i] = (unsigned)(Rb * K + C) * 2u; RA[i] = R; CA[i] = C;
        if constexpr (ATR) { const int bb = tid * 16 + i * 8192, row = bb >> 8, pc = (bb >> 4) & 15, ch = pc ^ (((row & 3) << 2) | ((row >> 2) & 3)); voffA[i] = (unsigned)(row * ldat + 8 * ch) * 2u; } }
    const size_t kstep = (size_t)(BK * 2);
    const size_t hstep = (size_t)HALF * K * 2;
    const size_t kstepA = ATR ? (size_t)BK * ldat * 2 : kstep, hstepA = ATR ? (size_t)HALF * 2 : hstep;
    const unsigned ldsw = (unsigned)wid * 1024u;
    const int aoff = lds_byte(wr * 64 + fr, fq * 8), boff = lds_byte(wc * 32 + fr, fq * 8);
    int atr[4][2];
#pragma unroll
    for (int m = 0; m < 4; ++m)
#pragma unroll
        for (int bl = 0; bl < 2; ++bl) { const int xr = ((fr >> 2) << 2) | ((2 * fq + bl) & 3); atr[m][bl] = (int)(unsigned)(uintptr_t)lds + 256 * (8 * fq + (fr >> 2) + 4 * bl) + 16 * ((wr * 8 + 2 * m + ((fr & 3) >> 1)) ^ xr) + 8 * (fr & 1); }
    unsigned vgC[2][2], vgN[2][2];
#define PG8_ROWS(u, vg) do { if constexpr (GATHER) { _Pragma("unroll") for (int _h = 0; _h < 2; ++_h) _Pragma("unroll") for (int _i = 0; _i < 2; ++_i) { \
        const int _p = (u).pos0 + _h * HALF + RA[_i]; const int _tok = (_p < (u).cnt) ? ((u).rows[_h * HALF + RA[_i]] >> 1) : 0; \
        vg[_h][_i] = ((unsigned)_tok * (unsigned)K + (unsigned)CA[_i]) * 2u; } } } while (0)
#define PG8_SA(b, h) (((b) * 2 + (h)) * HTB)
#define PG8_SB(b, h) ((4 + (b) * 2 + (h)) * HTB)
#define PG8_STAGE_B(bufoff, gbase) do { _Pragma("unroll") for (int _i = 0; _i < 2; ++_i) \
        __builtin_amdgcn_global_load_lds((const unsigned*)((const char*)(gbase) + voffB[_i]), (LAS unsigned*)(lds + (bufoff) + ldsw + _i * 8192), 16, 0, 0); } while (0)
#define PG8_STAGE_A(bufoff, gbase, h, NEXT) do { _Pragma("unroll") for (int _i = 0; _i < 2; ++_i) { \
        const unsigned _vo = GATHER ? ((NEXT) ? vgN[h][_i] : vgC[h][_i]) : voffA[_i]; \
        __builtin_amdgcn_global_load_lds((const unsigned*)((const char*)(gbase) + (GATHER ? (size_t)0 : (size_t)(h) * hstepA) + _vo), (LAS unsigned*)(lds + (bufoff) + ldsw + _i * 8192), 16, 0, 0); } } while (0)
#define PG8_LDA(dst, b, h) do { if constexpr (!ATR) { _Pragma("unroll") for (int m = 0; m < 4; ++m) _Pragma("unroll") for (int k = 0; k < 2; ++k) dst[m][k] = *(const LAS f16x8*)(lds + PG8_SA(b, h) + aoff + m * 2048 + k * 1024); } \
        else { _Pragma("unroll") for (int m = 0; m < 4; ++m) _Pragma("unroll") for (int k = 0; k < 2; ++k) { s16x4 _lo, _hi; \
            asm volatile("ds_read_b64_tr_b16 %0, %1 offset:%2" : "=v"(_lo) : "v"(atr[m][0]), "i"(PG8_SA(b, h) + k * 8192) : "memory"); \
            asm volatile("ds_read_b64_tr_b16 %0, %1 offset:%2" : "=v"(_hi) : "v"(atr[m][1]), "i"(PG8_SA(b, h) + k * 8192) : "memory"); \
            const short __attribute__((ext_vector_type(8))) _v = {_lo[0], _lo[1], _lo[2], _lo[3], _hi[0], _hi[1], _hi[2], _hi[3]}; dst[m][k] = __builtin_bit_cast(f16x8, _v); } } } while (0)
#define PG8_PIN(At) do { if constexpr (ATR) asm volatile("" : "+v"(At[0][0]), "+v"(At[0][1]), "+v"(At[1][0]), "+v"(At[1][1]), "+v"(At[2][0]), "+v"(At[2][1]), "+v"(At[3][0]), "+v"(At[3][1])); } while (0)
#define PG8_LDB(dst, b, h) do { _Pragma("unroll") for (int n = 0; n < 2; ++n) _Pragma("unroll") for (int k = 0; k < 2; ++k) dst[n][k] = *(const LAS f16x8*)(lds + PG8_SB(b, h) + boff + n * 2048 + k * 1024); } while (0)
#define PG8_MMA(ai, bj, At, Bt) do { __builtin_amdgcn_s_setprio(1); _Pragma("unroll") for (int m = 0; m < 4; ++m) _Pragma("unroll") for (int n = 0; n < 2; ++n) _Pragma("unroll") for (int k = 0; k < 2; ++k) \
        acc[ai][bj][m][n] = __builtin_amdgcn_mfma_f32_16x16x32_f16(Bt[n][k], At[m][k], acc[ai][bj][m][n], 0, 0, 0); __builtin_amdgcn_s_setprio(0); } while (0)
#define PG8_WAIT_V(n) asm volatile("s_waitcnt vmcnt(" #n ")" ::: "memory")
#define PG8_WAIT_L(n) asm volatile("s_waitcnt lgkmcnt(" #n ")" ::: "memory")
#define PG8_BAR __builtin_amdgcn_s_barrier()
#define PG8_SCHED __builtin_amdgcn_sched_barrier(0)
    Unit cur, nxt; int ui = 0;
    if (!S.next(0, cur)) return;
    f32x4 acc[2][2][4][2];
#pragma unroll
    for (int a = 0; a < 2; ++a)
#pragma unroll
        for (int b = 0; b < 2; ++b)
#pragma unroll
            for (int m = 0; m < 4; ++m)
#pragma unroll
                for (int n = 0; n < 2; ++n) acc[a][b][m][n] = (f32x4){0.f, 0.f, 0.f, 0.f};
    f16x8 At[4][2], B0[2][2], B1[2][2];
    const char* cA = cur.A; const char* cB = cur.B;
    PG8_ROWS(cur, vgC);
#pragma unroll
    for (int _h = 0; _h < 2; ++_h)
#pragma unroll
        for (int _i = 0; _i < 2; ++_i) vgN[_h][_i] = GATHER ? vgC[_h][_i] : 0u;
    PG8_STAGE_B(PG8_SB(0, 0), cB); PG8_STAGE_B(PG8_SB(0, 1), cB + hstep); PG8_STAGE_A(PG8_SA(0, 0), cA, 0, false); PG8_STAGE_A(PG8_SA(0, 1), cA, 1, false);
    if (wr == 1) PG8_BAR;
    PG8_WAIT_V(2); PG8_BAR;
    PG8_STAGE_B(PG8_SB(1, 0), cB + kstep); PG8_STAGE_A(PG8_SA(1, 0), cA + kstepA, 0, false); PG8_STAGE_B(PG8_SB(1, 1), cB + hstep + kstep);
    PG8_WAIT_V(6); PG8_BAR;
    for (;;) {
        const bool has_next = S.next(ui + 1, nxt);
        const bool full = cur.half == 0;
        const char* nA = has_next ? nxt.A : cA; const char* nB = has_next ? nxt.B : cB;
        if (has_next) { PG8_ROWS(nxt, vgN); }
        typename Epi::Pre pre; E.prefetch(cur, wr, fr, pre);
#pragma unroll 1
        for (int t = 0; t < nt; t += 2) {
            const bool last = (t == nt - 2);
            const char* a1 = cA + (size_t)(t + 1) * kstepA;
            const char* a2 = last ? nA : cA + (size_t)(t + 2) * kstepA; const char* b2 = last ? nB : cB + (size_t)(t + 2) * kstep;
            const char* a3 = a2 + kstepA; const char* b3 = b2 + kstep;
            PG8_LDB(B0, 0, 0); PG8_LDB(B1, 0, 1); PG8_SCHED; PG8_LDA(At, 0, 0); PG8_STAGE_A(PG8_SA(1, 1), a1, 1, false);
            PG8_WAIT_V(8); PG8_WAIT_L(0); PG8_PIN(At); PG8_BAR; PG8_MMA(0, 0, At, B0); PG8_MMA(0, 1, At, B1); PG8_BAR; PG8_SCHED;
            PG8_LDA(At, 0, 1); PG8_STAGE_B(PG8_SB(0, 0), b2); PG8_STAGE_B(PG8_SB(0, 1), b2 + hstep); PG8_STAGE_A(PG8_SA(0, 0), a2, 0, last);
            PG8_WAIT_V(8); PG8_WAIT_L(0); PG8_PIN(At); PG8_BAR; if (full) { PG8_MMA(1, 0, At, B0); PG8_MMA(1, 1, At, B1); } PG8_BAR; PG8_SCHED;
            PG8_LDB(B0, 1, 0); PG8_LDB(B1, 1, 1); PG8_SCHED; PG8_LDA(At, 1, 0); PG8_STAGE_A(PG8_SA(0, 1), a2, 1, last);
            PG8_WAIT_V(8); PG8_WAIT_L(0); PG8_PIN(At); PG8_BAR; PG8_MMA(0, 0, At, B0); PG8_MMA(0, 1, At, B1); PG8_BAR; PG8_SCHED;
            PG8_LDA(At, 1, 1); PG8_STAGE_B(PG8_SB(1, 0), b3); PG8_STAGE_B(PG8_SB(1, 1), b3 + hstep); PG8_STAGE_A(PG8_SA(1, 0), a3, 0, last);
            PG8_WAIT_V(8); PG8_WAIT_L(0); PG8_PIN(At); PG8_BAR; if (full) { PG8_MMA(1, 0, At, B0); PG8_MMA(1, 1, At, B1); } PG8_BAR; PG8_SCHED;
        }
        if (wr == 0) PG8_BAR;
        E(acc, cur, wr, wc, fr, fq, pre);
        if (!has_next) break;
#pragma unroll
        for (int a = 0; a < 2; ++a)
#pragma unroll
            for (int b = 0; b < 2; ++b)
#pragma unroll
                for (int m = 0; m < 4; ++m)
#pragma unroll
                    for (int n = 0; n < 2; ++n) acc[a][b][m][n] = (f32x4){0.f, 0.f, 0.f, 0.f};
        cur = nxt; cA = nA; cB = nB; ++ui;
#pragma unroll
        for (int _h = 0; _h < 2; ++_h)
#pragma unroll
            for (int _i = 0; _i < 2; ++_i) vgC[_h][_i] = vgN[_h][_i];
        if (wr == 1) PG8_BAR;
    }
    PG8_WAIT_V(0);
    PG8_BAR;
#undef PG8_ROWS
#undef PG8_SA
#undef PG8_SB
#undef PG8_STAGE_A
#undef PG8_STAGE_B
#undef PG8_LDA
#undef PG8_LDB
#undef PG8_PIN
#undef PG8_MMA
#undef PG8_WAIT_V
#undef PG8_WAIT_L
#undef PG8_BAR
#undef PG8_SCHED
}
}

using pg8::Unit;
__device__ __forceinline__ f16x8 pack8(const f32x4 a, const f32x4 b) {
    f16x8 w; w[0] = (h16)a[0]; w[1] = (h16)a[1]; w[2] = (h16)a[2]; w[3] = (h16)a[3]; w[4] = (h16)b[0]; w[5] = (h16)b[1]; w[6] = (h16)b[2]; w[7] = (h16)b[3]; return w;
}
struct EpiH16 {
    static constexpr bool PERM = true;
    h16* O0; int ld0; h16* O1; int ld1;
    struct Pre {}; __device__ __forceinline__ void prefetch(const Unit&, int, int, Pre&) const {}
    __device__ __forceinline__ void operator()(const f32x4 (&acc)[2][2][4][2], const Unit& u, int wr, int wc, int fr, int fq, const Pre&) const {
        h16* base = u.kind ? O1 : O0; const int ld = u.kind ? ld1 : ld0;
        const int row0 = u.pm * 256 + wr * 64 + fr, col0 = u.pn * 256 + wc * 32 + 8 * fq;
#pragma unroll
        for (int ai = 0; ai < 2; ++ai)
#pragma unroll
            for (int m = 0; m < 4; ++m) { h16* rowp = base + (size_t)(row0 + ai * 128 + m * 16) * ld + col0;
#pragma unroll
                for (int bj = 0; bj < 2; ++bj) __builtin_nontemporal_store(pack8(acc[ai][bj][m][0], acc[ai][bj][m][1]), (f16x8*)(rowp + bj * 128)); }
    }
};
struct EpiTaps {
    static constexpr bool PERM = false;
    float* T0; float* T1;
    struct Pre {}; __device__ __forceinline__ void prefetch(const Unit&, int, int, Pre&) const {}
    __device__ __forceinline__ void operator()(const f32x4 (&acc)[2][2][4][2], const Unit& u, int wr, int wc, int fr, int fq, const Pre&) const {
        const int j = u.kind >> 1, v = u.kind & 1; const int ld = v ? 256 : 4096;
        float* base = v ? (T1 + (size_t)j * 8192 * 256) : (T0 + (size_t)j * 8192 * 4096);
        const int row0 = u.pm * 256 + wr * 64 + fr, col0 = u.pn * 256 + wc * 32 + 4 * fq;
#pragma unroll
        for (int ai = 0; ai < 2; ++ai)
#pragma unroll
            for (int m = 0; m < 4; ++m) { float* rowp = base + (size_t)(row0 + ai * 128 + m * 16) * ld + col0;
#pragma unroll
                for (int bj = 0; bj < 2; ++bj)
#pragma unroll
                    for (int n = 0; n < 2; ++n) *(f32x4*)(rowp + bj * 128 + n * 16) = acc[ai][bj][m][n]; }
    }
};
struct EpiResid {
    static constexpr bool PERM = true;
    h16* X; const float* mods; int layer; float* SSQ; h16* XO;
    struct Pre {}; __device__ __forceinline__ void prefetch(const Unit&, int, int, Pre&) const {}
    __device__ __forceinline__ void operator()(const f32x4 (&acc)[2][2][4][2], const Unit& u, int wr, int wc, int fr, int fq, const Pre&) const {
        const int r0 = u.pm * 256; const int b = r0 < TL ? (r0 >> 12) : 8;
        const float* g = mods + ((size_t)(layer * 9 + b) * 6 + 2) * D;
        const int row0 = r0 + wr * 64 + fr, col0 = u.pn * 256 + wc * 32 + 8 * fq;
        f32x4 gv[2][2];
#pragma unroll
        for (int bj = 0; bj < 2; ++bj)
#pragma unroll
            for (int n = 0; n < 2; ++n) gv[bj][n] = *(const f32x4*)(g + col0 + bj * 128 + n * 4);
#pragma unroll
        for (int ai = 0; ai < 2; ++ai)
#pragma unroll
            for (int m = 0; m < 4; ++m) { const int row = row0 + ai * 128 + m * 16; const h16* rowp = X + (size_t)row * D + col0; h16* rowo = XO + (size_t)row * D + col0; float sq = 0.f;
#pragma unroll
                for (int bj = 0; bj < 2; ++bj) { const f16x8 xv = *(const f16x8*)(rowp + bj * 128); f32x4 v0, v1;
#pragma unroll
                    for (int i = 0; i < 4; ++i) { v0[i] = (float)xv[i] + gv[bj][0][i] * acc[ai][bj][m][0][i]; v1[i] = (float)xv[4 + i] + gv[bj][1][i] * acc[ai][bj][m][1][i]; }
                    const f16x8 w = pack8(v0, v1); *(f16x8*)(rowo + bj * 128) = w;
#pragma unroll
                    for (int i = 0; i < 8; ++i) { const float t = (float)w[i]; sq += t * t; } }
                sq += shx(sq, 16); sq += shx(sq, 32);
                if (fq == 0) SSQ[(size_t)row * 32 + u.pn * 4 + wc] = sq; }
    }
};
struct EpiMoe1 {
    static constexpr bool PERM = true;
    h16* H1;
    struct Pre {}; __device__ __forceinline__ void prefetch(const Unit&, int, int, Pre&) const {}
    __device__ __forceinline__ void operator()(const f32x4 (&acc)[2][2][4][2], const Unit& u, int wr, int wc, int fr, int fq, const Pre&) const {
        const int row0 = u.pm * 256 + wr * 64 + fr, col0 = u.pn * 128 + wc * 16 + 4 * fq;
#pragma unroll
        for (int ai = 0; ai < 2; ++ai)
#pragma unroll
            for (int m = 0; m < 4; ++m) { if (ai == 1 && u.half) continue; h16* rowp = H1 + (size_t)(row0 + ai * 128 + m * 16) * DE + col0;
#pragma unroll
                for (int bj = 0; bj < 2; ++bj) { const f32x4 a = acc[ai][bj][m][0], b = acc[ai][bj][m][1]; f16x4 w;
#pragma unroll
                    for (int i = 0; i < 4; ++i) { const float s = a[i] * __builtin_amdgcn_rcpf(1.0f + __expf(-a[i])); w[i] = (h16)(s * b[i]); }
                    *(f16x4*)(rowp + bj * 64) = w; } }
    }
};
struct EpiMoe2 {
    static constexpr bool PERM = true;
    h16* YC; const float* gslot;
    struct Pre { int av[2][4]; float gv[2][4]; };
    __device__ __forceinline__ void prefetch(const Unit& u, int wr, int fr, Pre& q) const {
        const float* grow = gslot + ((const char*)u.rows - (const char*)listbase) / 4;
#pragma unroll
        for (int ai = 0; ai < 2; ++ai)
#pragma unroll
            for (int m = 0; m < 4; ++m) { const int r = ai * 128 + wr * 64 + m * 16 + fr; const bool ok = u.pos0 + r < u.cnt; q.av[ai][m] = ok ? u.rows[r] : -1; q.gv[ai][m] = ok ? grow[r] : 0.f; }
    }
    __device__ __forceinline__ void operator()(const f32x4 (&acc)[2][2][4][2], const Unit& u, int wr, int wc, int fr, int fq, const Pre& q) const {
        const int col0 = u.pn * 256 + wc * 32 + 8 * fq;
#pragma unroll
        for (int ai = 0; ai < 2; ++ai)
#pragma unroll
            for (int m = 0; m < 4; ++m) { if (q.av[ai][m] >= 0) { const float g = q.gv[ai][m]; h16* rowp = YC + (size_t)q.av[ai][m] * D + col0;
#pragma unroll
                    for (int bj = 0; bj < 2; ++bj) *(f16x8*)(rowp + bj * 128) = pack8(acc[ai][bj][m][0] * g, acc[ai][bj][m][1] * g); } }
    }
    const int* listbase;
};

__device__ __forceinline__ void order_tile(int wgid, int nM, int nN, int& pm, int& pn) {
    const int nwg = nM * nN; { const int q = nwg / 8, r = nwg % 8, xcd = wgid % 8, off = wgid / 8; wgid = (xcd < r ? xcd * (q + 1) : r * (q + 1) + (xcd - r) * q) + off; }
    const int nig = 8 * nN, gid = wgid / nig, fm = gid * 8, gsz = (nM - fm) < 8 ? (nM - fm) : 8;
    pm = fm + ((wgid % nig) % gsz); pn = (wgid % nig) / gsz;
}
struct SchedPlain {
    int nM, nN, K; const char* A; const char* B;
    __device__ __forceinline__ bool next(int i, Unit& u) const {
        const long L = (long)i * gridDim.x + blockIdx.x; if (L >= (long)nM * nN) return false;
        order_tile((int)L, nM, nN, u.pm, u.pn); u.kind = 0; u.half = 0; u.e = 0; u.pos0 = 0; u.cnt = 0; u.rows = nullptr;
        u.A = A + (size_t)u.pm * 256 * K * 2; u.B = B + (size_t)u.pn * 256 * K * 2; return true;
    }
};
struct SchedPlainAT {
    int nM, nN, K; const char* At; const char* B;
    __device__ __forceinline__ bool next(int i, Unit& u) const {
        const long L = (long)i * gridDim.x + blockIdx.x; if (L >= (long)nM * nN) return false;
        order_tile((int)L, nM, nN, u.pm, u.pn); u.kind = 0; u.half = 0; u.e = 0; u.pos0 = 0; u.cnt = 0; u.rows = nullptr;
        u.A = At + (size_t)u.pm * 256 * 2; u.B = B + (size_t)u.pn * 256 * K * 2; return true;
    }
};
struct SchedQkv {
    const char* H; const char* W;
    __device__ __forceinline__ bool next(int i, Unit& u) const {
        const long L = (long)i * gridDim.x + blockIdx.x; const int nA = 136 * 9; if (L >= nA + 136) return false;
        u.e = 0; u.half = 0; u.pos0 = 0; u.cnt = 0; u.rows = nullptr;
        if (L < nA) { order_tile((int)L, 136, 9, u.pm, u.pn); u.kind = 0; u.A = H + (size_t)u.pm * 256 * D * 2; u.B = W + (size_t)u.pn * 256 * D * 2; }
        else { u.pm = 0; u.pn = (int)L - nA; u.kind = 1; u.A = W + (size_t)DQK * D * 2; u.B = H + (size_t)u.pn * 256 * D * 2; }
        return true;
    }
};
struct SchedFilt {
    const char* W3P; const char* H2P;
    __device__ __forceinline__ bool next(int i, Unit& u) const {
        const long L = (long)i * gridDim.x + blockIdx.x; if (L >= 2 * 544) return false;
        const int j = (int)L / 544, r = (int)L % 544; u.e = 0; u.half = 0; u.pos0 = 0; u.cnt = 0; u.rows = nullptr;
        int v; if (r < 512) { v = 0; u.pm = r >> 4; u.pn = r & 15; } else { v = 1; u.pm = r - 512; u.pn = 0; }
        u.kind = 2 * j + v;
        u.A = W3P + ((size_t)j * 8192 + (size_t)u.pm * 256) * 256 * 2;
        u.B = H2P + ((size_t)j * 4352 + (v ? 4096 : 0) + (size_t)u.pn * 256) * 256 * 2;
        return true;
    }
};
struct MoeTab { const LAS int* tstart; const LAS int* texp; const LAS int* cnt; };
struct SchedMoe1 {
    MoeTab tb; const char* H; const char* W13; const int* list;
    __device__ __forceinline__ bool next(int i, Unit& u) const {
        const long L = (long)i * gridDim.x + blockIdx.x; const int ntile = __builtin_amdgcn_readfirstlane(tb.tstart[NE]); if (L >= (long)ntile * 3) return false;
        int rt; order_tile((int)L, ntile, 3, rt, u.pn); u.pm = rt; u.kind = 0;
        const int e = __builtin_amdgcn_readfirstlane(tb.texp[rt]); u.e = e; u.pos0 = (rt - __builtin_amdgcn_readfirstlane(tb.tstart[e])) * 256; u.cnt = __builtin_amdgcn_readfirstlane(tb.cnt[e]); u.half = (u.cnt - u.pos0 <= 128) ? 1 : 0;
        u.rows = list + (size_t)e * LCAP + u.pos0; u.A = H; u.B = W13 + ((size_t)e * DE2 + (size_t)u.pn * 256) * D * 2; return true;
    }
};
struct SchedMoe2 {
    MoeTab tb; const char* H1; const char* W2; const int* list;
    __device__ __forceinline__ bool next(int i, Unit& u) const {
        const long L = (long)i * gridDim.x + blockIdx.x; const int ntile = __builtin_amdgcn_readfirstlane(tb.tstart[NE]); if (L >= (long)ntile * 8) return false;
        int rt; order_tile((int)L, ntile, 8, rt, u.pn); u.pm = rt; u.kind = 0;
        const int e = __builtin_amdgcn_readfirstlane(tb.texp[rt]); u.e = e; u.pos0 = (rt - __builtin_amdgcn_readfirstlane(tb.tstart[e])) * 256; u.cnt = __builtin_amdgcn_readfirstlane(tb.cnt[e]); u.half = (u.cnt - u.pos0 <= 128) ? 1 : 0;
        u.rows = list + (size_t)e * LCAP + u.pos0; u.A = H1 + (size_t)rt * 256 * DE * 2; u.B = W2 + ((size_t)e * D + (size_t)u.pn * 256) * DE * 2; return true;
    }
};
__device__ __forceinline__ void moe_table(LAS int* tstart, LAS int* texp, LAS int* cnt, const int* counters) {
    const int t = tid_fresh();
    if (t < NE) cnt[t] = counters[t];
    __syncthreads();
    if (t <= NE) { int s = 0; for (int e = 0; e < t; ++e) s += (cnt[e] + 255) >> 8; tstart[t] = s; }
    __syncthreads();
    if (t < NE) { const int s0 = tstart[t], s1 = tstart[t + 1]; for (int q = s0; q < s1; ++q) texp[q] = t; }
    __syncthreads();
}

__device__ __forceinline__ float wave_sum(float v) {
#pragma unroll
    for (int o = 32; o >= 1; o >>= 1) v += shx(v, o);
    return v;
}
__device__ __forceinline__ float silu_f(float x) { return x / (1.0f + expf(-x)); }
__device__ __forceinline__ int batch_of_row(int r) { return r < TL ? (r >> 12) : 8; }

__device__ __forceinline__ void modp_unit(const Params& p, int unit, LAS float* sl) {
    const int layer = unit / 96, rem = unit % 96, ks = rem / 6, cc = rem % 6, tid = tid_fresh();
    for (int i = tid; i < 9 * 128; i += 512) { const int cnd = i >> 7, k = ks * 128 + (i & 127); const float v = cnd < 8 ? p.c[cnd * D + k] : p.c_ctx[k]; sl[i] = silu_f(v); }
    __syncthreads();
    f32x4 acc[9];
#pragma unroll
    for (int q = 0; q < 9; ++q) acc[q] = (f32x4){0.f, 0.f, 0.f, 0.f};
    const float* w = p.mod_w + ((size_t)layer * D + (size_t)ks * 128) * D6 + cc * 2048 + tid * 4;
#pragma unroll 4
    for (int k = 0; k < 128; ++k) { const f32x4 wv = *(const f32x4*)(w + (size_t)k * D6);
#pragma unroll
        for (int q = 0; q < 9; ++q) acc[q] += wv * sl[q * 128 + k]; }
    float* outp = (float*)(p.ws + WS_MODP) + ((size_t)(ks * 4 + layer) * 9) * D6 + cc * 2048 + tid * 4;
#pragma unroll
    for (int q = 0; q < 9; ++q) *(f32x4*)(outp + (size_t)q * D6) = acc[q];
    __syncthreads();
}
__device__ __forceinline__ void modr_unit(const Params& p, int unit) {
    const size_t idx = (size_t)unit * 2048 + tid_fresh() * 4; const int layer = (int)(idx / (9 * D6)), col = (int)(idx % D6);
    f32x4 s = *(const f32x4*)(p.mod_b + (size_t)layer * D6 + col);
    const float* pp = (const float*)(p.ws + WS_MODP) + idx;
#pragma unroll
    for (int ks = 0; ks < 16; ++ks) s += *(const f32x4*)(pp + (size_t)ks * 4 * 9 * D6);
    *(f32x4*)((float*)(p.ws + WS_MODS) + idx) = s;
}
__device__ __forceinline__ void tables_unit(const Params& p) {
    f32x2* tw = (f32x2*)(p.ws + WS_TW);
    for (int m = tid_fresh(); m < 8192; m += 512) { double s, c; sincospi(-(double)m / 4096.0, &s, &c); tw[m] = (f32x2){(float)c, (float)s}; }
    float* rc = (float*)(p.ws + WS_ROPE);
    for (int i = tid_fresh(); i < 1024; i += 512) { const int pos = i >> 4, q = i & 15; const float inv = powf(10000.0f, -(float)q / 16.0f); const float ang = (float)pos * inv;
        rc[i] = cosf(ang); rc[1024 + i] = sinf(ang); }
}
__device__ __forceinline__ void h2_task(const Params& p, int task) {
    const int lane = tid_fresh() & 63; const int j = task / 4352, r = task % 4352; const int v = r >= 4096, t = v ? r - 4096 : r; const int Lv = v ? 256 : 4096;
    const float tl = (float)t / (float)(Lv - 1);
    const float omega = (float)(2.0 * 3.14159265358979323846 / (double)Lv) * (float)t;
    float feat = 0.f;
    if (lane == 0) feat = tl;
    else if (lane <= 32) { const int bi = (lane - 1) & 15; const float band = 1e-4f + (float)bi * ((15.0f - 1e-4f) / 15.0f); const float a = band * omega; feat = lane <= 16 ? cosf(a) : -sinf(a); }
    const float* w1 = p.hy_f_w1 + (size_t)j * 33 * 64; const float* w2 = p.hy_f_w2 + (size_t)j * 64 * 64;
    float s = p.hy_f_b1[j * 64 + lane];
    for (int f = 0; f < 33; ++f) s += bperm_f(feat, f) * w1[f * 64 + lane];
    const float h1 = sinf(p.hy_f_freq1[j * 64 + lane] * s);
    float s2 = p.hy_f_b2[j * 64 + lane];
    for (int m = 0; m < 64; ++m) s2 += bperm_f(h1, m) * w2[m * 64 + lane];
    const float h2 = sinf(p.hy_f_freq2[j * 64 + lane] * s2);
    const h16 hi = (h16)h2; const h16 lo = (h16)(h2 - (float)hi);
    h16* row = (h16*)(p.ws + WS_H2P) + ((size_t)j * 4352 + r) * 256;
    row[lane] = hi; row[64 + lane] = hi; row[128 + lane] = lo; row[192 + lane] = lo;
}
__device__ __forceinline__ void w3p_unit(const Params& p, int unit) {
    const int j = unit >> 5, c0 = (unit & 31) * 256; const float* w3 = p.hy_f_w3 + (size_t)j * 64 * 8192; h16* dst = (h16*)(p.ws + WS_W3P) + (size_t)j * 8192 * 256;
    for (int i = tid_fresh(); i < 64 * 256; i += 512) { const int m = i >> 8, col = c0 + (i & 255); const float w = w3[(size_t)m * 8192 + col];
        const h16 hi = (h16)w; const h16 lo = (h16)(w - (float)hi); h16* row = dst + (size_t)col * 256; row[m] = hi; row[64 + m] = lo; row[128 + m] = hi; row[192 + m] = lo; }
}
__device__ __forceinline__ void rtab_unit(const Params& p, int unit) {
    const int layer = unit >> 6, c = unit & 63; h16* dst = (h16*)(p.ws + WS_RTAB + (size_t)layer * RTAB_L) + (size_t)c * 5 * 2 * 64 * 8;
    for (int i = tid_fresh(); i < 5 * 2 * 64 * 8; i += 512) { const int jj = i & 7, lane = (i >> 3) & 63, hl = (i >> 9) & 1, ct = i >> 10;
        const int k = 32 * c + 8 * (lane >> 4) + jj, col = 16 * ct + (lane & 15);
        float w = 0.f; if (col < 8) w = p.moe_wg[((size_t)layer * D + k) * 8 + col]; else if (col < 72) w = p.moe_we[((size_t)layer * D + k) * 64 + (col - 8)];
        w *= 256.0f; const h16 hi = (h16)w; const h16 lo = (h16)(w - (float)hi); dst[i] = hl ? lo : hi; }
}
template <int NW>
__device__ __forceinline__ void cvt_tile(const float* src, int ldn, int k0, int n0, h16* dst, int ldk, int mode, LAS float* T) {
    constexpr int P = NW + 1; const int tid = tid_fresh();
#pragma unroll
    for (int ps = 0; ps < 64 * NW / 4 / 512; ++ps) { const int idx = ps * 512 + tid, k = idx / (NW / 4), n4 = idx % (NW / 4);
        const f32x4 v = *(const f32x4*)(src + (size_t)(k0 + k) * ldn + n0 + 4 * n4); LAS float* q = T + k * P + 4 * n4; q[0] = v[0]; q[1] = v[1]; q[2] = v[2]; q[3] = v[3]; }
    __syncthreads();
#pragma unroll
    for (int ps = 0; ps < NW * 8 / 512; ++ps) { const int item = ps * 512 + tid, kc = item & 7, n = item >> 3; f16x8 w;
#pragma unroll
        for (int i = 0; i < 8; ++i) w[i] = (h16)T[(8 * kc + i) * P + n];
        const int ng = n0 + n; const int row = mode == 0 ? ng : (8 * (ng >> 2) + (ng & 3) + (mode == 2 ? 4 : 0));
        *(f16x8*)(dst + (size_t)row * ldk + k0 + 8 * kc) = w; }
    __syncthreads();
}
__device__ __forceinline__ void cvt_dense_unit(const Params& p, int unit, LAS float* T) {
    const float* src; h16* dst; int nt, N;
    if (unit < 1536) { src = p.hy_w_in; dst = (h16*)(p.ws + WS_WIN); nt = 24; N = D3; }
    else if (unit < 2048) { unit -= 1536; src = p.hy_w_out; dst = (h16*)(p.ws + WS_WOUT); nt = 8; N = D; }
    else if (unit < 2688) { unit -= 2048; src = p.at_w_qkv; dst = (h16*)(p.ws + WS_WQKV); nt = 10; N = DQKV; }
    else { unit -= 2688; src = p.at_w_o; dst = (h16*)(p.ws + WS_WO); nt = 8; N = D; }
    const int j = unit / (32 * nt), r = unit % (32 * nt), kt = r / nt, ntile = r % nt;
    cvt_tile<256>(src + (size_t)j * D * N, N, kt * 64, ntile * 256, dst + (size_t)j * N * D, D, 0, T);
}
constexpr int CVT_DENSE_UNITS = 3200;
__device__ __forceinline__ void cvt_moe_unit(const Params& p, int layer, int unit, LAS float* T) {
    if (unit < 12288) { const int which = unit >= 6144; if (which) unit -= 6144; const int e = unit / 96, r = unit % 96, kt = r / 3, ntile = r % 3;
        const float* src = (which ? p.moe_w3 : p.moe_w1) + ((size_t)layer * NE + e) * D * DE;
        cvt_tile<128>(src, DE, kt * 64, ntile * 128, (h16*)(p.ws + WS_W13) + (size_t)e * DE2 * D, D, which ? 2 : 1, T); }
    else { unit -= 12288; const int e = unit / 48, r = unit % 48, kt = r / 8, ntile = r % 8;
        const float* src = p.moe_w2 + ((size_t)layer * NE + e) * DE * D;
        cvt_tile<256>(src, D, kt * 64, ntile * 256, (h16*)(p.ws + WS_W2) + (size_t)e * D * DE, DE, 0, T); }
}
constexpr int CVT_MOE_UNITS = 15360;
struct CvtD { const float* src; h16* dst; int mode; };
__device__ __forceinline__ CvtD cvt13_desc(const Params& p, int layer, int unit) {
    const int which = unit >= 6144; if (which) unit -= 6144; const int e = unit / 96, r = unit % 96, kt = r / 3, ntile = r % 3;
    CvtD d; d.src = (which ? p.moe_w3 : p.moe_w1) + ((size_t)layer * NE + e) * D * DE + (size_t)(kt * 64) * DE + ntile * 128;
    d.dst = (h16*)(p.ws + WS_W13) + (size_t)e * DE2 * D + kt * 64; d.mode = (which ? 4 : 0) + 8 * (256 * ntile); return d;
}
__device__ __forceinline__ void cvt13_load(const CvtD& d, f32x4 (&v)[4], int tid) {
#pragma unroll
    for (int ps = 0; ps < 4; ++ps) { const int idx = ps * 512 + tid, k = idx >> 5, n4 = idx & 31; v[ps] = *(const f32x4*)(d.src + (size_t)k * DE + 4 * n4); }
}
__device__ __forceinline__ void cvt13_store(const CvtD& d, const f32x4 (&v)[4], LAS float* T, int tid) {
    constexpr int P = 129;
#pragma unroll
    for (int ps = 0; ps < 4; ++ps) { const int idx = ps * 512 + tid, k = idx >> 5, n4 = idx & 31; LAS float* q = T + k * P + 4 * n4; q[0] = v[ps][0]; q[1] = v[ps][1]; q[2] = v[ps][2]; q[3] = v[ps][3]; }
    __syncthreads();
    const int w3off = d.mode & 7, rg0 = d.mode >> 3;
#pragma unroll
    for (int ps = 0; ps < 2; ++ps) { const int item = ps * 512 + tid, kc = item & 7, n = item >> 3; f16x8 w;
#pragma unroll
        for (int i = 0; i < 8; ++i) w[i] = (h16)T[(8 * kc + i) * P + n];
        const int row = rg0 + 8 * (n >> 2) + (n & 3) + w3off;
        *(f16x8*)(d.dst + (size_t)row * D + 8 * kc) = w; }
    __syncthreads();
}
__device__ __forceinline__ void cvt_moe_share(const Params& p, int layer, int u0, int n, int stride, LAS float* T) {
    const int tid = tid_fresh(); const int n13 = n < 12288 ? n : 12288;
    int u = u0;
    if (u < n13) {
        CvtD dA = cvt13_desc(p, layer, u), dB = dA, dC = dA; f32x4 vA[4], vB[4], vC[4];
        cvt13_load(dA, vA, tid);
        if (u + stride < n13) { dB = cvt13_desc(p, layer, u + stride); cvt13_load(dB, vB, tid); }
        for (;;) {
            if (u + 2 * stride < n13) { dC = cvt13_desc(p, layer, u + 2 * stride); cvt13_load(dC, vC, tid); }
            cvt13_store(dA, vA, T, tid); u += stride; if (u >= n13) break;
            if (u + 2 * stride < n13) { dA = cvt13_desc(p, layer, u + 2 * stride); cvt13_load(dA, vA, tid); }
            cvt13_store(dB, vB, T, tid); u += stride; if (u >= n13) break;
            if (u + 2 * stride < n13) { dB = cvt13_desc(p, layer, u + 2 * stride); cvt13_load(dB, vB, tid); }
            cvt13_store(dC, vC, T, tid); u += stride; if (u >= n13) break;
        }
    }
    for (; u < n; u += stride) cvt_moe_unit(p, layer, u, T);
}

template <int NR, bool FINAL>
__device__ __forceinline__ void n1_rows(const Params& p, int layer, int r0, int rstride, int lane, h16* xout) {
    const h16* xres = (const h16*)(p.ws + WS_XRES); h16* hb = (h16*)(p.ws + WS_HBUF); const h16* yc = (const h16*)(p.ws + WS_YC); const float* mods = (const float*)(p.ws + WS_MODS);
    f32x4 v[NR][8]; f16x4 xh[NR][8], ya[NR][8], yb[NR][8];
    const bool comb = FINAL || layer > 0; const int lprev = FINAL ? 3 : layer - 1;
#pragma unroll
    for (int q = 0; q < NR; ++q) { const int r = r0 + q * rstride;
        if (!comb) { const float* src = r < TL ? p.x + (size_t)r * D : p.ctx + (size_t)(r - TL) * D;
#pragma unroll
            for (int c = 0; c < 8; ++c) v[q][c] = *(const f32x4*)(src + c * 256 + lane * 4); }
        else { const h16* src = xres + (size_t)r * D; const h16* y0 = yc + (size_t)(2 * r) * D; const h16* y1 = y0 + D;
#pragma unroll
            for (int c = 0; c < 8; ++c) { xh[q][c] = *(const f16x4*)(src + c * 256 + lane * 4); ya[q][c] = *(const f16x4*)(y0 + c * 256 + lane * 4); yb[q][c] = *(const f16x4*)(y1 + c * 256 + lane * 4); } } }
#pragma unroll
    for (int q = 0; q < NR; ++q) { const int r = r0 + q * rstride; const int b = batch_of_row(r);
        if (comb) { const float* g2 = mods + ((size_t)(lprev * 9 + b) * 6 + 5) * D;
#pragma unroll
            for (int c = 0; c < 8; ++c) { const f32x4 g = *(const f32x4*)(g2 + c * 256 + lane * 4);
#pragma unroll
                for (int i = 0; i < 4; ++i) v[q][c][i] = (float)xh[q][c][i] + g[i] * ((float)ya[q][c][i] + (float)yb[q][c][i]); } }
        float ss = 0.f;
#pragma unroll
        for (int c = 0; c < 8; ++c) { if (!FINAL) { f16x4 w; w[0] = (h16)v[q][c][0]; w[1] = (h16)v[q][c][1]; w[2] = (h16)v[q][c][2]; w[3] = (h16)v[q][c][3]; *(f16x4*)(xout + (size_t)r * D + c * 256 + lane * 4) = w; } ss += v[q][c][0] * v[q][c][0] + v[q][c][1] * v[q][c][1] + v[q][c][2] * v[q][c][2] + v[q][c][3] * v[q][c][3]; }
        ss = wave_sum(ss); const float rs = 1.0f / sqrtf(ss * (1.0f / D) + EPS);
        if (FINAL) {
#pragma unroll
            for (int c = 0; c < 8; ++c) { const int col = c * 256 + lane * 4; const f32x4 g = *(const f32x4*)(p.final_gain + col); *(f32x4*)(p.out + (size_t)r * D + col) = v[q][c] * rs * g; }
        } else {
            const float* sh = mods + ((size_t)(layer * 9 + b) * 6 + 0) * D; const float* sc = sh + D;
#pragma unroll
            for (int c = 0; c < 8; ++c) { const int col = c * 256 + lane * 4; const f32x4 s0 = *(const f32x4*)(sh + col), s1 = *(const f32x4*)(sc + col); f16x4 w;
#pragma unroll
                for (int i = 0; i < 4; ++i) w[i] = (h16)(v[q][c][i] * rs * (1.0f + s1[i]) + s0[i]);
                *(f16x4*)(hb + (size_t)r * D + col) = w; }
        } }
}
template <bool FINAL>
__device__ __forceinline__ void n1_any(const Params& p, int layer, h16* xout) {
    const int tid = tid_fresh(), lane = tid & 63, gw = blockIdx.x * 8 + __builtin_amdgcn_readfirstlane(tid >> 6), nw = gridDim.x * 8; const int nrow = FINAL ? TL : TT;
    int r = gw;
    for (; r + nw < nrow; r += 2 * nw) n1_rows<2, FINAL>(p, layer, r, nw, lane, xout);
    if (r < nrow) n1_rows<1, FINAL>(p, layer, r, nw, lane, xout);
}
__device__ __forceinline__ void n1_phase(const Params& p, int layer, h16* xout) { n1_any<false>(p, layer, xout); }
__device__ __forceinline__ void final_phase(const Params& p) { n1_any<true>(p, 0, nullptr); }
constexpr int N2_CH = 4;
constexpr int N2_SLOT = N2_CH * 10 * 1024;
constexpr int N2_XT = 2 * N2_SLOT;
constexpr int N2_SC = N2_XT + 8 * 4096;
#ifndef PROBE_N2VAR
#define PROBE_N2VAR 0
#endif
__device__ __forceinline__ void n2_phase(const Params& p, int layer, LAS unsigned char* lds, int ctr_shadow) {
    const bool pv_tail = !(ctr_shadow && (PROBE_N2VAR & 1)), pv_store = !(ctr_shadow && (PROBE_N2VAR & 2)), pv_mma = !(ctr_shadow && (PROBE_N2VAR & 4));
    const int tid = tid_fresh(), lane = tid & 63, wv = __builtin_amdgcn_readfirstlane(tid >> 6), r16 = lane & 15, kg = lane >> 4;
    const int lrow = lane >> 3, lchk = lane & 7;
    const h16* xres = (const h16*)(p.ws + WS_XRES); h16* hb = (h16*)(p.ws + WS_HBUF); const float* mods = (const float*)(p.ws + WS_MODS);
    const char* rtb = p.ws + WS_RTAB + (size_t)layer * RTAB_L; const float* ssq = (const float*)(p.ws + WS_SSQ);
    int* counters = (int*)(p.ws + WS_CTL) + CTL_CNT + (layer + (ctr_shadow ? 4 : 0)) * NE; int* list = (int*)(p.ws + WS_LIST); float* gate = (float*)(p.ws + WS_GATE);
    LAS float* scr = (LAS float*)lds + wv * (16 * 80);
    LAS float* scl = (LAS float*)(lds + N2_SC); LAS float* shl = scl + D;
    LAS int* hist = (LAS int*)(lds + LDS_MISC); LAS int* hbase = hist + NE;
    LAS unsigned char* xt = lds + N2_XT + wv * 4096;
    const int hw_off0 = r16 * 128 + 16 * (kg ^ (r16 & 7)), hw_off1 = r16 * 128 + 16 * ((4 + kg) ^ (r16 & 7));
    const int hr_off = lrow * 128 + 16 * (lchk ^ (lrow & 7));
    const int ntask = (layer == NLAYER - 1 ? TL : TT) / 16, nfull = (int)gridDim.x * 8;
#pragma unroll 1
    for (int round = 0; round < 2; ++round) {
        const int nrem = ntask - nfull;
        if (round == 1 && (int)blockIdx.x >= nrem) break;
        const int task = round == 0 ? (int)blockIdx.x * 8 + wv : nfull + (int)blockIdx.x;
        const bool active = round == 0 ? (task < ntask) : true;
        const int trow = active ? task * 16 : 0;
        const int b = batch_of_row(trow);
        const h16* xg = xres + (size_t)(trow + r16) * D + 8 * kg;
        h16* hg0 = hb + (size_t)(trow + lrow) * D + lchk * 8; h16* hg1 = hg0 + (size_t)8 * D;
        float rs;
        { const float* sp = ssq + (size_t)(trow + r16) * 32; float t = 0.f;
#pragma unroll
            for (int q = 0; q < 8; ++q) { const f32x4 v = *(const f32x4*)(sp + 4 * q); t += (v[0] + v[1]) + (v[2] + v[3]); }
            rs = 1.0f / sqrtf(t * (1.0f / D) + EPS); }
        f32x4 acc[5];
#pragma unroll
        for (int ct = 0; ct < 5; ++ct) acc[ct] = (f32x4){0.f, 0.f, 0.f, 0.f};
        __syncthreads();
        if (tid < NE) hist[tid] = 0;
        { const float* scb = mods + ((size_t)(layer * 9 + b) * 6 + 4) * D; *(LAS f32x4*)(scl + tid * 4) = *(const f32x4*)(scb + tid * 4); *(LAS f32x4*)(shl + tid * 4) = *(const f32x4*)(scb - D + tid * 4); }
        if (round == 0) {
        f16x8 bq[5];
#pragma unroll
        for (int q = 0; q < 5; ++q) bq[q] = *(const f16x8*)(rtb + (size_t)(5 * wv + q) * 1024 + lane * 16);
#pragma unroll
        for (int q = 0; q < 5; ++q) *(LAS f16x8*)(lds + (5 * wv + q) * 1024 + lane * 16) = bq[q];
#pragma unroll
        for (int q = 0; q < 5; ++q) bq[q] = *(const f16x8*)(rtb + (size_t)N2_SLOT + (size_t)(5 * wv + q) * 1024 + lane * 16);
        f16x8 x0[N2_CH], x1[N2_CH], x2[N2_CH];
#pragma unroll
        for (int s2 = 0; s2 < N2_CH; ++s2) { x0[s2] = *(const f16x8*)(xg + 32 * s2); x1[s2] = *(const f16x8*)(xg + 32 * (N2_CH + s2)); }
#define N2_CHUNK(XC, XL, CH) do { const int ch = (CH); \
            __syncthreads(); \
            const int nx2 = (ch + 2 < 64 / N2_CH) ? ch + 2 : ch; \
            {   LAS unsigned char* dst = lds + ((ch + 1) & 1) * N2_SLOT; \
 _Pragma("unroll") \
                for (int q = 0; q < 5; ++q) *(LAS f16x8*)(dst + (5 * wv + q) * 1024 + lane * 16) = bq[q]; } \
            {   const char* src = rtb + (size_t)nx2 * N2_SLOT; \
 _Pragma("unroll") \
                for (int q = 0; q < 5; ++q) bq[q] = *(const f16x8*)(src + (size_t)(5 * wv + q) * 1024 + lane * 16); } \
 _Pragma("unroll") \
            for (int s2 = 0; s2 < N2_CH; ++s2) { const int ko = 32 * (nx2 * N2_CH + s2); XL[s2] = *(const f16x8*)(xg + ko); } \
            const LAS unsigned char* bs = lds + (ch & 1) * N2_SLOT + lane * 16; \
 _Pragma("unroll") \
            for (int pp = 0; pp < N2_CH / 2; ++pp) { \
                f16x8 hk[2]; \
 _Pragma("unroll") \
                for (int sp = 0; sp < 2; ++sp) { \
                    const int s2 = 2 * pp + sp; const int ko = 32 * (ch * N2_CH + s2) + 8 * kg; \
                    const f32x4 c0 = *(const LAS f32x4*)(scl + ko), c1 = *(const LAS f32x4*)(scl + ko + 4), h0 = *(const LAS f32x4*)(shl + ko), h1 = *(const LAS f32x4*)(shl + ko + 4); \
                    f16x8 hi, lo; \
 _Pragma("unroll") \
                    for (int i = 0; i < 4; ++i) { const float a0 = (float)XC[s2][i] * rs * (1.0f + c0[i]) + h0[i], a1 = (float)XC[s2][4 + i] * rs * (1.0f + c1[i]) + h1[i]; \
                        hi[i] = (h16)a0; lo[i] = (h16)(a0 - (float)hi[i]); hi[4 + i] = (h16)a1; lo[4 + i] = (h16)(a1 - (float)hi[4 + i]); } \
                    hk[sp] = hi; \
                    if (pv_mma) \
 _Pragma("unroll") \
                    for (int ct = 0; ct < 5; ++ct) { const f16x8 whi = *(const LAS f16x8*)(bs + (s2 * 10 + ct * 2 + 0) * 1024), wlo = *(const LAS f16x8*)(bs + (s2 * 10 + ct * 2 + 1) * 1024); \
                        acc[ct] = __builtin_amdgcn_mfma_f32_16x16x32_f16(hi, whi, acc[ct], 0, 0, 0); \
                        acc[ct] = __builtin_amdgcn_mfma_f32_16x16x32_f16(hi, wlo, acc[ct], 0, 0, 0); \
                        acc[ct] = __builtin_amdgcn_mfma_f32_16x16x32_f16(lo, whi, acc[ct], 0, 0, 0); } \
                } \
                *(LAS f16x8*)(xt + hw_off0) = hk[0]; *(LAS f16x8*)(xt + hw_off1) = hk[1]; \
                const f16x8 o0 = *(const LAS f16x8*)(xt + hr_off), o1 = *(const LAS f16x8*)(xt + 1024 + hr_off); \
                if (active && pv_store) { const int ho = 32 * (ch * N2_CH + 2 * pp); *(f16x8*)(hg0 + ho) = o0; *(f16x8*)(hg1 + ho) = o1; } \
            } \
        } while (0)
#pragma unroll 1
        for (int c3 = 0; c3 < 15; c3 += 3) { N2_CHUNK(x0, x2, c3); N2_CHUNK(x1, x0, c3 + 1); N2_CHUNK(x2, x1, c3 + 2); }
        N2_CHUNK(x0, x2, 15);
#undef N2_CHUNK
        } else {
            const char* rtw = rtb + (size_t)(8 * wv) * 10240; const int kb = 256 * wv;
            unsigned loff = (unsigned)lane * 16u; asm volatile("" : "+v"(loff));
            f16x8 bb[10];
            f16x8 xa[2][2];
#pragma unroll
            for (int sp = 0; sp < 2; ++sp) xa[0][sp] = *(const f16x8*)(xg + kb + 32 * sp);
#pragma unroll
            for (int pp = 0; pp < 4; ++pp) {
                if (pp < 3) {
#pragma unroll
                    for (int sp = 0; sp < 2; ++sp) xa[(pp + 1) & 1][sp] = *(const f16x8*)(xg + kb + 32 * (2 * pp + 2 + sp)); }
                f16x8 hk[2];
#pragma unroll
                for (int sp = 0; sp < 2; ++sp) {
                    const int st = 2 * pp + sp; const int ko = kb + 32 * st + 8 * kg;
#pragma unroll
                    for (int q = 0; q < 10; ++q) bb[q] = *(const f16x8*)(rtw + (size_t)(st * 10 + q) * 1024 + loff);
                    asm volatile("" ::: "memory");
                    const f32x4 c0 = *(const LAS f32x4*)(scl + ko), c1 = *(const LAS f32x4*)(scl + ko + 4), h0 = *(const LAS f32x4*)(shl + ko), h1 = *(const LAS f32x4*)(shl + ko + 4);
                    f16x8 hi, lo;
#pragma unroll
                    for (int i = 0; i < 4; ++i) { const float a0 = (float)xa[pp & 1][sp][i] * rs * (1.0f + c0[i]) + h0[i], a1 = (float)xa[pp & 1][sp][4 + i] * rs * (1.0f + c1[i]) + h1[i];
                        hi[i] = (h16)a0; lo[i] = (h16)(a0 - (float)hi[i]); hi[4 + i] = (h16)a1; lo[4 + i] = (h16)(a1 - (float)hi[4 + i]); }
                    hk[sp] = hi;
#pragma unroll
                    for (int ct = 0; ct < 5; ++ct) {
                        acc[ct] = __builtin_amdgcn_mfma_f32_16x16x32_f16(hi, bb[2 * ct], acc[ct], 0, 0, 0);
                        acc[ct] = __builtin_amdgcn_mfma_f32_16x16x32_f16(hi, bb[2 * ct + 1], acc[ct], 0, 0, 0);
                        acc[ct] = __builtin_amdgcn_mfma_f32_16x16x32_f16(lo, bb[2 * ct], acc[ct], 0, 0, 0); }
                }
                *(LAS f16x8*)(xt + hw_off0) = hk[0]; *(LAS f16x8*)(xt + hw_off1) = hk[1];
                const f16x8 o0 = *(const LAS f16x8*)(xt + hr_off), o1 = *(const LAS f16x8*)(xt + 1024 + hr_off);
                if (pv_store) { const int ho = kb + 64 * pp; *(f16x8*)(hg0 + ho) = o0; *(f16x8*)(hg1 + ho) = o1; }
            }
        }
        __syncthreads();
#pragma unroll
        for (int ct = 0; ct < 5; ++ct)
#pragma unroll
            for (int i = 0; i < 4; ++i) scr[(4 * kg + i) * 80 + 16 * ct + r16] = acc[ct][i] * (1.0f / 256.0f);
        asm volatile("s_waitcnt lgkmcnt(0)" ::: "memory");
        int ea = 0, eb = 0, ra = 0, rb = 0; float g1v = 0.f, g2v = 0.f; const bool tok_lane = (round == 0 ? active : wv == 0) && lane < 16 && pv_tail;
        const int nparts = round == 0 ? 1 : 8;
        if (tok_lane) {
            const LAS float* lgr = scr + lane * 80;
#define N2_LG(c) ({ float _t = lgr[(c)]; for (int _w = 1; _w < nparts; ++_w) _t += lgr[_w * 1280 + (c)]; _t; })
            float gmax = -3.0e38f; int gsel = 0; float gl[8];
#pragma unroll
            for (int g = 0; g < 8; ++g) { gl[g] = N2_LG(g) + p.moe_bg[layer * 8 + g]; if (gl[g] > gmax) { gmax = gl[g]; gsel = g; } }
            float gz = 0.f;
#pragma unroll
            for (int g = 0; g < 8; ++g) gz += expf(gl[g] - gmax);
            const float pg = 1.0f / gz;
            float f1 = -3.0e38f, f2 = -3.0e38f; int i1 = 0, i2 = 0;
            for (int q = 0; q < 8; ++q) { const float f = N2_LG(8 + gsel * 8 + q) + p.moe_be[layer * 64 + gsel * 8 + q];
                if (f > f1) { f2 = f1; i2 = i1; f1 = f; i1 = q; } else if (f > f2) { f2 = f; i2 = q; } }
            const float e2 = expf(f2 - f1); g1v = pg / (1.0f + e2); g2v = pg * e2 / (1.0f + e2);
            ea = gsel * 8 + i1; eb = gsel * 8 + i2;
#undef N2_LG
            ra = __hip_atomic_fetch_add(hist + ea, 1, __ATOMIC_RELAXED, __HIP_MEMORY_SCOPE_WORKGROUP); rb = __hip_atomic_fetch_add(hist + eb, 1, __ATOMIC_RELAXED, __HIP_MEMORY_SCOPE_WORKGROUP);
        }
        __syncthreads();
        { const int t2 = tid_fresh(); if (t2 < NE && pv_tail) { const int n = hist[t2]; hbase[t2] = n ? atomicAdd(&counters[t2], n) : 0; } }
        __syncthreads();
        if (tok_lane) { const int tok = task * 16 + lane; const size_t sa = (size_t)ea * LCAP + hbase[ea] + ra, sb = (size_t)eb * LCAP + hbase[eb] + rb;
            list[sa] = 2 * tok; gate[sa] = g1v; list[sb] = 2 * tok + 1; gate[sb] = g2v; }
    }
}
__device__ __forceinline__ void transpose_phase(const Params& p, LAS h16* T) {
    const h16* zt = (const h16*)(p.ws + WS_ZT); h16* z = (h16*)(p.ws + WS_HBUF); const int tid = tid_fresh();
    const int ntile = (D / 64) * (TT / 64);
    for (int tile = blockIdx.x; tile < ntile; tile += gridDim.x) {
        const int td = tile % (D / 64), tt = tile / (D / 64); const int d0 = td * 64, t0 = tt * 64;
        { const int dr = tid >> 3, tc = (tid & 7) * 8; const f16x8 v = *(const f16x8*)(zt + (size_t)(d0 + dr) * TT + t0 + tc);
#pragma unroll
            for (int i = 0; i < 8; ++i) T[(tc + i) * 66 + dr] = v[i]; }
        __syncthreads();
        { const int tr = tid >> 3, dc = (tid & 7) * 8; f16x8 v;
#pragma unroll
            for (int i = 0; i < 8; ++i) v[i] = T[tr * 66 + dc + i];
            *(f16x8*)(z + (size_t)(t0 + tr) * D + d0 + dc) = v; }
        __syncthreads();
    }
}

__device__ __forceinline__ f32x2 cmul(const f32x2 a, const f32x2 b) { return (f32x2){a.x * b.x - a.y * b.y, a.x * b.y + a.y * b.x}; }
__device__ __forceinline__ f32x2 cmulc(const f32x2 a, const f32x2 b) { return (f32x2){a.x * b.x + a.y * b.y, a.y * b.x - a.x * b.y}; }
__device__ __forceinline__ f32x2 cconj(const f32x2 a) { return (f32x2){a.x, -a.y}; }
template <bool INV> __device__ __forceinline__ f32x2 mul_mi(const f32x2 a) { return INV ? (f32x2){-a.y, a.x} : (f32x2){a.y, -a.x}; }
template <bool INV> __device__ __forceinline__ void dft4(f32x2& a, f32x2& b, f32x2& c, f32x2& d) {
    const f32x2 s0 = a + c, s1 = a - c, s2 = b + d, s3 = mul_mi<INV>(b - d);
    a = s0 + s2; b = s1 + s3; c = s0 - s2; d = s1 - s3;
}
template <bool INV, int M> __device__ __forceinline__ f32x2 w16mul(const f32x2 a) {
    constexpr float C1 = 0.92387953251128674f, S1 = 0.38268343236508977f, R = 0.70710678118654752f;
    constexpr float cr = (M == 0) ? 1.f : (M == 1) ? C1 : (M == 2) ? R : (M == 3) ? S1 : (M == 4) ? 0.f : (M == 6) ? -R :   -C1;
    constexpr float ci0 = (M == 0) ? 0.f : (M == 1) ? -S1 : (M == 2) ? -R : (M == 3) ? -C1 : (M == 4) ? -1.f : (M == 6) ? -R :   S1;
    constexpr float ci = INV ? -ci0 : ci0;
    return (f32x2){a.x * cr - a.y * ci, a.x * ci + a.y * cr};
}
template <bool INV> __device__ __forceinline__ void dft16(f32x2 (&v)[16]) {
#pragma unroll
    for (int n2 = 0; n2 < 4; ++n2) dft4<INV>(v[n2], v[4 + n2], v[8 + n2], v[12 + n2]);
    v[5] = w16mul<INV, 1>(v[5]); v[6] = w16mul<INV, 2>(v[6]); v[7] = w16mul<INV, 3>(v[7]);
    v[9] = w16mul<INV, 2>(v[9]); v[10] = w16mul<INV, 4>(v[10]); v[11] = w16mul<INV, 6>(v[11]);
    v[13] = w16mul<INV, 3>(v[13]); v[14] = w16mul<INV, 6>(v[14]); v[15] = w16mul<INV, 9>(v[15]);
#pragma unroll
    for (int k1 = 0; k1 < 4; ++k1) dft4<INV>(v[4 * k1], v[4 * k1 + 1], v[4 * k1 + 2], v[4 * k1 + 3]);
    f32x2 t;
    t = v[1]; v[1] = v[4]; v[4] = t; t = v[2]; v[2] = v[8]; v[8] = t; t = v[3]; v[3] = v[12]; v[12] = t;
    t = v[6]; v[6] = v[9]; v[9] = t; t = v[7]; v[7] = v[13]; v[13] = t; t = v[11]; v[11] = v[14]; v[14] = t;
}
__device__ __forceinline__ int fphys(int i) { return i + (i >> 4); }
__device__ __forceinline__ f32x2 w32c(int j) {
    constexpr float c[16] = {1.f, 0.98078528040323043f, 0.92387953251128674f, 0.83146961230254524f, 0.70710678118654752f, 0.55557023301960218f, 0.38268343236508977f, 0.19509032201612825f,
                             0.f, -0.19509032201612825f, -0.38268343236508977f, -0.55557023301960218f, -0.70710678118654752f, -0.83146961230254524f, -0.92387953251128674f, -0.98078528040323043f};
    constexpr float s[16] = {0.f, 0.19509032201612825f, 0.38268343236508977f, 0.55557023301960218f, 0.70710678118654752f, 0.83146961230254524f, 0.92387953251128674f, 0.98078528040323043f,
                             1.f, 0.98078528040323043f, 0.92387953251128674f, 0.83146961230254524f, 0.70710678118654752f, 0.55557023301960218f, 0.38268343236508977f, 0.19509032201612825f};
    return (f32x2){c[j], -s[j]};
}
template <int S>
__device__ __forceinline__ void fft_fwd0(const f32x2 (&xe)[16], const f32x2 (&xo)[16], LAS f32x2* E, LAS f32x2* O, int t, const LAS f32x2* tw) {
    const f32x2 u = tw[t * (256 / S)]; const f32x2 u2 = cmul(u, u);
    f32x2 y[16];
#pragma unroll
    for (int j = 0; j < 16; ++j) y[j] = xe[j];
    dft16<false>(y);
    constexpr int QS = S + S / 16;
    LAS f32x2* Eb = E + fphys(t); LAS f32x2* Ob = O + fphys(t);
    f32x2 pw = u2; Eb[0] = y[0];
#pragma unroll
    for (int q = 1; q < 16; ++q) { Eb[QS * q] = cmul(y[q], pw); pw = cmul(pw, u2); }
#pragma unroll
    for (int j = 0; j < 16; ++j) y[j] = cmul(xo[j], w32c(j));
    dft16<false>(y);
    pw = u;
#pragma unroll
    for (int q = 0; q < 16; ++q) { Ob[QS * q] = cmul(y[q], pw); pw = cmul(pw, u2); }
}
template <bool INV> __device__ __forceinline__ void fft_pass1(LAS f32x2* A, int tau, const LAS f32x2* tw) {
    const int i = tau & 15, base = (tau >> 4) << 8; const f32x2 u0 = tw[32 * i]; const f32x2 u = INV ? cconj(u0) : u0;
    f32x2 y[16]; LAS f32x2* Ab = A + fphys(base + i);
#pragma unroll
    for (int j = 0; j < 16; ++j) y[j] = Ab[17 * j];
    if (INV) { f32x2 pw = u;
#pragma unroll
        for (int q = 1; q < 16; ++q) { y[q] = cmul(y[q], pw); pw = cmul(pw, u); } }
    dft16<INV>(y);
    if (!INV) { f32x2 pw = u;
#pragma unroll
        for (int q = 1; q < 16; ++q) { y[q] = cmul(y[q], pw); pw = cmul(pw, u); } }
#pragma unroll
    for (int j = 0; j < 16; ++j) Ab[17 * j] = y[j];
}
template <bool INV> __device__ __forceinline__ void fft_pass1_pair(LAS f32x2* A, LAS f32x2* B, int tau, const LAS f32x2* tw) {
    const int i = tau & 15, base = (tau >> 4) << 8; const f32x2 u0 = tw[32 * i]; const f32x2 u = INV ? cconj(u0) : u0;
    f32x2 y[16], z[16]; LAS f32x2* Ab = A + fphys(base + i); LAS f32x2* Bb = B + fphys(base + i);
#pragma unroll
    for (int j = 0; j < 16; ++j) y[j] = Ab[17 * j];
#pragma unroll
    for (int j = 0; j < 16; ++j) z[j] = Bb[17 * j];
    f32x2 pwr[16]; pwr[1] = u;
#pragma unroll
    for (int q = 2; q < 16; ++q) pwr[q] = cmul(pwr[q - 1], u);
    if (INV) {
#pragma unroll
        for (int q = 1; q < 16; ++q) y[q] = cmul(y[q], pwr[q]); }
    dft16<INV>(y);
    if (!INV) {
#pragma unroll
        for (int q = 1; q < 16; ++q) y[q] = cmul(y[q], pwr[q]); }
#pragma unroll
    for (int j = 0; j < 16; ++j) Ab[17 * j] = y[j];
    if (INV) {
#pragma unroll
        for (int q = 1; q < 16; ++q) z[q] = cmul(z[q], pwr[q]); }
    dft16<INV>(z);
    if (!INV) {
#pragma unroll
        for (int q = 1; q < 16; ++q) z[q] = cmul(z[q], pwr[q]); }
#pragma unroll
    for (int j = 0; j < 16; ++j) Bb[17 * j] = z[j];
}
__device__ __forceinline__ void fft_fwd2(const LAS f32x2* A, int t, f32x2 (&y)[16]) {
#pragma unroll
    for (int j = 0; j < 16; ++j) y[j] = A[17 * t + j];
    dft16<false>(y);
}
template <int NT> __device__ __forceinline__ void kf_load(const f32x2* kf, f32x4 (&k)[8]) {
#pragma unroll
    for (int j = 0; j < 8; ++j) k[j] = *(const f32x4*)(kf + j * (2 * NT));
}
__device__ __forceinline__ void fft_mid(LAS f32x2* A, int t, const f32x4 (&k)[8]) {
    f32x2 y[16];
    fft_fwd2(A, t, y);
#pragma unroll
    for (int j = 0; j < 8; ++j) { y[2 * j] = cmul(y[2 * j], (f32x2){k[j][0], k[j][1]}); y[2 * j + 1] = cmul(y[2 * j + 1], (f32x2){k[j][2], k[j][3]}); }
    dft16<true>(y);
#pragma unroll
    for (int j = 0; j < 16; ++j) A[17 * t + j] = y[j];
}
template <int S>
__device__ __forceinline__ void fft_inv0(const LAS f32x2* E, const LAS f32x2* O, int t, const LAS f32x2* tw, f32x2 (&out)[16]) {
    const f32x2 u = tw[t * (256 / S)]; const f32x2 u2 = cmul(u, u);
    f32x2 y[16];
    constexpr int QS = S + S / 16;
    const LAS f32x2* Eb = E + fphys(t); const LAS f32x2* Ob = O + fphys(t);
    f32x2 pw = u2; y[0] = Eb[0];
#pragma unroll
    for (int q = 1; q < 16; ++q) { y[q] = cmulc(Eb[QS * q], pw); pw = cmul(pw, u2); }
    dft16<true>(y);
#pragma unroll
    for (int j = 0; j < 16; ++j) out[j] = y[j];
    pw = u;
#pragma unroll
    for (int q = 0; q < 16; ++q) { y[q] = cmulc(Ob[QS * q], pw); pw = cmul(pw, u2); }
    dft16<true>(y);
#pragma unroll
    for (int j = 0; j < 16; ++j) out[j] += cmulc(y[j], w32c(j));
}
__device__ __forceinline__ float hy_absdelta(int d) { return fabsf(-3.0701134573253943f + (-15.350567286626973f + 3.0701134573253943f) * ((float)d / 2047.0f)); }

__device__ __forceinline__ void filt_fft_phase(const Params& p, LAS unsigned char* lds) {
    const int tid = tid_fresh();
    LAS f32x2* tw = (LAS f32x2*)(lds + LDS_MISC + 1024);
    tw[tid] = ((const f32x2*)(p.ws + WS_TW))[tid];
    __syncthreads();
    {
        const int grp = tid >> 8, tau = tid & 255; constexpr int KFQ = 512;
        LAS f32x2* E = (LAS f32x2*)(lds + grp * 69632); LAS f32x2* O = E + 4352; LAS float* red = (LAS float*)(lds + LDS_MISC) + grp * 8;
        float tlo[16], thi[16];
#define FILT_TAPS(pbx) do { const int d_ = (pbx) & 2047, n_ = ((pbx) >> 11) & 1, j_ = (pbx) >> 12; const float* tf_ = (const float*)(p.ws + WS_TAPS) + ((size_t)j_ * 8192 + (size_t)(n_ * 2 + 0) * D + d_) * 4096; \
            const float* tb_ = tf_ + (size_t)D * 4096; _Pragma("unroll") for (int jj = 0; jj < 16; ++jj) { const int nn = tau + 256 * jj; tlo[jj] = tf_[nn]; thi[jj] = tb_[(4096 - nn) & 4095]; } } while (0)
        if (blockIdx.x * 2 + grp < 2 * 2 * 2048) FILT_TAPS(blockIdx.x * 2 + grp);
        for (int pb = blockIdx.x * 2 + grp; pb < 2 * 2 * 2048; pb += gridDim.x * 2) {
            const int d = pb & 2047, n = (pb >> 11) & 1, j = pb >> 12;
            const float adel = hy_absdelta(d); const float cdec = adel * (1.0f / 4095.0f);
            float dl = expf(-(float)tau * cdec), dh = expf(-(float)(4096 - tau) * cdec); const float rl = expf(-256.0f * cdec), rh = expf(256.0f * cdec);
            f32x2 xe[16], xo[16]; float ss = 0.f;
#pragma unroll
            for (int jj = 0; jj < 16; ++jj) { const int nn = tau + 256 * jj;
                const float klo = tlo[jj] * dl;
                const float khi = (nn != 0) ? thi[jj] * dh : 0.f;
                dl *= rl; dh *= rh;
                ss += klo * klo + khi * khi; xe[jj] = (f32x2){klo + khi, 0.f}; xo[jj] = (f32x2){klo - khi, 0.f}; }
            if (pb + (int)gridDim.x * 2 < 2 * 2 * 2048) FILT_TAPS(pb + (int)gridDim.x * 2);
            ss = wave_sum(ss);
            if ((tid & 63) == 0) red[(tid >> 6) & 3] = ss;
            fft_fwd0<256>(xe, xo, E, O, tau, tw);
            __syncthreads();
            const float tot = red[0] + red[1] + red[2] + red[3];
            const float scale = (1.0f / sqrtf(tot + EPS)) * (1.0f / 8192.0f);
            const float hbs = p.hy_bias[((size_t)j * 2 + n) * D + d] * (1.0f / 8192.0f);
            fft_pass1<false>(E, tau, tw); fft_pass1<false>(O, tau, tw);
            __syncthreads();
            f32x2* kf = (f32x2*)(p.ws + WS_KF) + (size_t)pb * 8192 + (size_t)tau * 2;
            f32x2 y[16];
            fft_fwd2(E, tau, y);
#pragma unroll
            for (int q = 0; q < 8; ++q) *(f32x4*)(kf + KFQ * q) = (f32x4){y[2 * q].x * scale + hbs, y[2 * q].y * scale, y[2 * q + 1].x * scale + hbs, y[2 * q + 1].y * scale};
            fft_fwd2(O, tau, y);
#pragma unroll
            for (int q = 0; q < 8; ++q) *(f32x4*)(kf + 4096 + KFQ * q) = (f32x4){y[2 * q].x * scale + hbs, y[2 * q].y * scale, y[2 * q + 1].x * scale + hbs, y[2 * q + 1].y * scale};
            __syncthreads();
        }
    }
#undef FILT_TAPS
    {
        const int pr = tid >> 4, i = tid & 15; constexpr int KFQ = 32;
        LAS f32x2* E = (LAS f32x2*)(lds + pr * 4352); LAS f32x2* O = E + 272;
        for (int it = blockIdx.x; it < 256; it += gridDim.x) {
            const int pb = it * 32 + pr; const int d = pb & 2047, n = (pb >> 11) & 1, j = pb >> 12;
            const float* tf = (const float*)(p.ws + WS_TAPSC) + ((size_t)j * 8192 + (size_t)(n * 2 + 0) * D + d) * 256;
            const float* tb = tf + (size_t)D * 256;
            const float adel = hy_absdelta(d); const float cdec = adel * (1.0f / 255.0f);
            float dl = expf(-(float)i * cdec), dh = expf(-(float)(256 - i) * cdec); const float rl = expf(-16.0f * cdec), rh = expf(16.0f * cdec);
            f32x2 xe[16], xo[16]; float ss = 0.f;
#pragma unroll
            for (int jj = 0; jj < 16; ++jj) { const int nn = i + 16 * jj;
                const float klo = tf[nn] * dl;
                const int m = 256 - nn;
                const float khi = (m < 256) ? tb[m & 255] * dh : 0.f;
                dl *= rl; dh *= rh;
                ss += klo * klo + khi * khi; xe[jj] = (f32x2){klo + khi, 0.f}; xo[jj] = (f32x2){klo - khi, 0.f}; }
            ss += shx(ss, 8); ss += shx(ss, 4); ss += shx(ss, 2); ss += shx(ss, 1);
            const float scale = (1.0f / sqrtf(ss + EPS)) * (1.0f / 512.0f);
            const float hbs = p.hy_bias[((size_t)j * 2 + n) * D + d] * (1.0f / 512.0f);
            fft_fwd0<16>(xe, xo, E, O, i, tw);
            __syncthreads();
            f32x2* kf = (f32x2*)(p.ws + WS_KFC) + (size_t)pb * 512 + (size_t)i * 2;
            f32x2 y[16];
            fft_fwd2(E, i, y);
#pragma unroll
            for (int q = 0; q < 8; ++q) *(f32x4*)(kf + KFQ * q) = (f32x4){y[2 * q].x * scale + hbs, y[2 * q].y * scale, y[2 * q + 1].x * scale + hbs, y[2 * q + 1].y * scale};
            fft_fwd2(O, i, y);
#pragma unroll
            for (int q = 0; q < 8; ++q) *(f32x4*)(kf + 256 + KFQ * q) = (f32x4){y[2 * q].x * scale + hbs, y[2 * q].y * scale, y[2 * q + 1].x * scale + hbs, y[2 * q + 1].y * scale};
            __syncthreads();
        }
    }
}

__device__ __forceinline__ float conv3_lds(const LAS h16* row, int n, float w0, float w1, float w2, float b) { return (float)row[n - 1] * w0 + (float)row[n] * w1 + (float)row[n + 1] * w2 + b; }
constexpr int ST_P = 4112, STS_P = 272;

#ifndef PROBE_CVAR
#define PROBE_CVAR 0
#endif
__device__ __forceinline__ void conv_phase(const Params& p, int jl, LAS unsigned char* lds, int pvar = 0, int cvt_layer = -1, int cvt_n = 0) {
    const int tid = tid_fresh(); const bool cv_outer = !(pvar && (PROBE_CVAR & 1)), cv_inner = !(pvar && (PROBE_CVAR & 2));
    LAS f32x2* tw = (LAS f32x2*)(lds + LDS_MISC + 1024);
    tw[tid] = ((const f32x2*)(p.ws + WS_TW))[tid];
    __syncthreads();
    const h16* ut = (const h16*)(p.ws + WS_UT); h16* zt = (h16*)(p.ws + WS_ZT);
    const float* cw = p.hy_conv_w + (size_t)jl * 3 * D3; const float* cb = p.hy_conv_b + (size_t)jl * D3;
    {
        const int grp = tid >> 8, tau = tid & 255;
        LAS f32x2* E = (LAS f32x2*)(lds + grp * 69632); LAS f32x2* O = E + 4352; LAS h16* ST = (LAS h16*)E;
        int uit = 0; const int utrig = 4 * (((int)blockIdx.x >> 3) & 3);
        for (int unit = blockIdx.x; unit < 4096; unit += gridDim.x, ++uit) {
            if (cvt_layer >= 0 && uit == utrig) { __syncthreads(); cvt_moe_share(p, cvt_layer, blockIdx.x, cvt_n, gridDim.x, (LAS float*)lds); }
            const int ux = unit & 7, uj = unit >> 3; const int hq = uj & 1, d = (uj >> 1) * 8 + ux; const size_t col0 = (size_t)(4 * hq + 2 * grp) * 4096;
            const f32x2* kfb = (const f32x2*)(p.ws + WS_KF) + ((size_t)(jl * 2) * 2048 + d) * 8192 + (size_t)tau * 2;
            f16x8 raw[2][2][2], raw2[2][2];
#pragma unroll
            for (int sq = 0; sq < 2; ++sq)
#pragma unroll
                for (int bb = 0; bb < 2; ++bb)
#pragma unroll
                    for (int k = 0; k < 2; ++k) raw[sq][bb][k] = *(const f16x8*)(ut + (size_t)(sq * D + d) * TT + col0 + (size_t)bb * 4096 + (size_t)(tau + 256 * k) * 8);
            __syncthreads();
#pragma unroll
            for (int sq = 0; sq < 2; ++sq)
#pragma unroll
                for (int bb = 0; bb < 2; ++bb)
#pragma unroll
                    for (int k = 0; k < 2; ++k) *(LAS f16x8*)(ST + (sq * 2 + bb) * ST_P + 8 + (tau + 256 * k) * 8) = raw[sq][bb][k];
            if (tau < 4) { ST[tau * ST_P + 7] = (h16)0.f; ST[tau * ST_P + 8 + 4096] = (h16)0.f; }
            __syncthreads();
            f32x2 xin[16], gk[16], y[16];
            { const float w0 = cw[d], w1 = cw[D3 + d], w2 = cw[2 * D3 + d], bv = cb[d]; const float g0 = cw[D + d], g1 = cw[D3 + D + d], g2 = cw[2 * D3 + D + d], gb = cb[D + d];
#pragma unroll
                for (int jj = 0; jj < 16; ++jj) { const int nn = tau + 256 * jj;
                    xin[jj] = (f32x2){conv3_lds(ST + 8, nn, w0, w1, w2, bv), conv3_lds(ST + ST_P + 8, nn, w0, w1, w2, bv)};
                    gk[jj] = (f32x2){conv3_lds(ST + 2 * ST_P + 8, nn, g0, g1, g2, gb), conv3_lds(ST + 3 * ST_P + 8, nn, g0, g1, g2, gb)}; } }
            __syncthreads();
#pragma unroll 1
            for (int ord = 0; ord < 2; ++ord) {
                if (cv_outer) fft_fwd0<256>(xin, xin, E, O, tau, tw);
                const f32x2* kf = kfb + (size_t)ord * 2048 * 8192; f32x4 kfe[8], kfo[8];
                kf_load<256>(kf, kfe);
                __syncthreads();
                if (cv_inner) fft_pass1_pair<false>(E, O, tau, tw);
                kf_load<256>(kf + 4096, kfo);
                __syncthreads();
                if (cv_inner) { fft_mid(E, tau, kfe); fft_mid(O, tau, kfo); }
                if (ord == 0) {
#pragma unroll
                    for (int bb = 0; bb < 2; ++bb)
#pragma unroll
                        for (int k = 0; k < 2; ++k) raw2[bb][k] = *(const f16x8*)(ut + (size_t)(2 * D + d) * TT + col0 + (size_t)bb * 4096 + (size_t)(tau + 256 * k) * 8); }
                __syncthreads();
                if (cv_inner) fft_pass1_pair<true>(E, O, tau, tw);
                __syncthreads();
                if (cv_outer) fft_inv0<256>(E, O, tau, tw, y); else {
#pragma unroll
                    for (int jj = 0; jj < 16; ++jj) y[jj] = xin[jj]; }
#pragma unroll
                for (int jj = 0; jj < 16; ++jj) xin[jj] = gk[jj] * y[jj];
                if (ord == 0) {
                    __syncthreads();
#pragma unroll
                    for (int bb = 0; bb < 2; ++bb)
#pragma unroll
                        for (int k = 0; k < 2; ++k) *(LAS f16x8*)(ST + bb * ST_P + 8 + (tau + 256 * k) * 8) = raw2[bb][k];
                    if (tau < 2) { ST[tau * ST_P + 7] = (h16)0.f; ST[tau * ST_P + 8 + 4096] = (h16)0.f; }
                    __syncthreads();
                    const float g0 = cw[2 * D + d], g1 = cw[D3 + 2 * D + d], g2 = cw[2 * D3 + 2 * D + d], gb = cb[2 * D + d];
#pragma unroll
                    for (int jj = 0; jj < 16; ++jj) { const int nn = tau + 256 * jj; gk[jj] = (f32x2){conv3_lds(ST + 8, nn, g0, g1, g2, gb), conv3_lds(ST + ST_P + 8, nn, g0, g1, g2, gb)}; }
                    __syncthreads();
                }
            }
            h16* o0 = zt + (size_t)d * TT + col0; h16* o1 = o0 + 4096;
#pragma unroll
            for (int jj = 0; jj < 16; ++jj) { const int nn = tau + 256 * jj; o0[nn] = (h16)xin[jj].x; o1[nn] = (h16)xin[jj].y; }
        }
    }
    {
        const int pr = tid >> 4, i = tid & 15, c8 = pr >> 2, bp = pr & 3;
        LAS f32x2* E = (LAS f32x2*)(lds + pr * 4352); LAS f32x2* O = E + 272; LAS h16* ST = (LAS h16*)lds;
        for (int unit = blockIdx.x; unit < 256; unit += gridDim.x) {
            const int d0 = unit * 8, d = d0 + c8;
            const f32x2* kfb = (const f32x2*)(p.ws + WS_KFC) + ((size_t)(jl * 2) * 2048 + d) * 512 + (size_t)i * 2;
            f16x8 raw[3][4];
#pragma unroll
            for (int sq = 0; sq < 3; ++sq)
#pragma unroll
                for (int k = 0; k < 4; ++k) { const int q = tid + 512 * k, row = q >> 5, ch = q & 31;
                    raw[sq][k] = *(const f16x8*)(ut + (size_t)(sq * D + d0 + (row >> 3)) * TT + TL + (row & 7) * 256 + ch * 8); }
            __syncthreads();
#pragma unroll
            for (int sq = 0; sq < 2; ++sq)
#pragma unroll
                for (int k = 0; k < 4; ++k) { const int q = tid + 512 * k, row = q >> 5, ch = q & 31; *(LAS f16x8*)(ST + (sq * 64 + row) * STS_P + 8 + ch * 8) = raw[sq][k]; }
            if (tid < 128) { ST[tid * STS_P + 7] = (h16)0.f; ST[tid * STS_P + 8 + 256] = (h16)0.f; }
            __syncthreads();
            f32x2 xin[16], gk[16], y[16];
            { const float w0 = cw[d], w1 = cw[D3 + d], w2 = cw[2 * D3 + d], bv = cb[d]; const float g0 = cw[D + d], g1 = cw[D3 + D + d], g2 = cw[2 * D3 + D + d], gb = cb[D + d];
                const LAS h16* r0 = ST + (c8 * 8 + 2 * bp) * STS_P + 8; const LAS h16* r1 = r0 + 64 * STS_P;
#pragma unroll
                for (int jj = 0; jj < 16; ++jj) { const int nn = i + 16 * jj;
                    xin[jj] = (f32x2){conv3_lds(r0, nn, w0, w1, w2, bv), conv3_lds(r0 + STS_P, nn, w0, w1, w2, bv)};
                    gk[jj] = (f32x2){conv3_lds(r1, nn, g0, g1, g2, gb), conv3_lds(r1 + STS_P, nn, g0, g1, g2, gb)}; } }
            __syncthreads();
#pragma unroll 1
            for (int ord = 0; ord < 2; ++ord) {
                const f32x2* kf = kfb + (size_t)ord * 2048 * 512; f32x4 kfe[8], kfo[8];
                fft_fwd0<16>(xin, xin, E, O, i, tw);
                __syncthreads();
                kf_load<16>(kf, kfe); fft_mid(E, i, kfe); kf_load<16>(kf + 256, kfo); fft_mid(O, i, kfo);
                __syncthreads();
                fft_inv0<16>(E, O, i, tw, y);
#pragma unroll
                for (int jj = 0; jj < 16; ++jj) xin[jj] = gk[jj] * y[jj];
                if (ord == 0) {
                    __syncthreads();
#pragma unroll
                    for (int k = 0; k < 4; ++k) { const int q = tid + 512 * k, row = q >> 5, ch = q & 31; *(LAS f16x8*)(ST + row * STS_P + 8 + ch * 8) = raw[2][k]; }
                    if (tid < 64) { ST[tid * STS_P + 7] = (h16)0.f; ST[tid * STS_P + 8 + 256] = (h16)0.f; }
                    __syncthreads();
                    const float g0 = cw[2 * D + d], g1 = cw[D3 + 2 * D + d], g2 = cw[2 * D3 + 2 * D + d], gb = cb[2 * D + d];
                    const LAS h16* r0 = ST + (c8 * 8 + 2 * bp) * STS_P + 8;
#pragma unroll
                    for (int jj = 0; jj < 16; ++jj) { const int nn = i + 16 * jj; gk[jj] = (f32x2){conv3_lds(r0, nn, g0, g1, g2, gb), conv3_lds(r0 + STS_P, nn, g0, g1, g2, gb)}; }
                    __syncthreads();
                }
            }
            h16* o0 = zt + (size_t)d * TT + TL + (2 * bp) * 256; h16* o1 = o0 + 256;
#pragma unroll
            for (int jj = 0; jj < 16; ++jj) { const int nn = i + 16 * jj; o0[nn] = (h16)xin[jj].x; o1[nn] = (h16)xin[jj].y; }
        }
    }
}

constexpr int AT_KP = 72, AT_VP = 68;
__device__ __forceinline__ void attn_phase(const Params& p, int jl, bool with_ctx_out, LAS unsigned char* lds, int cvt_layer = -1, int cvt_n = 0) {
    const int tid = tid_fresh(), wv = tid >> 6, lane = tid & 63, r32 = lane & 31, hh = lane >> 5;
    LAS h16* Ks = (LAS h16*)lds; LAS h16* Vs = (LAS h16*)(lds + 64 * AT_KP * 2);
    const h16* qk = (const h16*)(p.ws + WS_QK); const h16* vt = (const h16*)(p.ws + WS_VT); h16* ob = (h16*)(p.ws + WS_HBUF);
    LAS float* rcos = (LAS float*)(lds + 65536); LAS float* rsin = rcos + 1024;
    { const float* rg = (const float*)(p.ws + WS_ROPE); for (int i = tid; i < 2048; i += 512) rcos[i] = rg[i]; }
    __syncthreads();
    const int nunit = 2048 + (with_ctx_out ? 128 : 0);
    int uit = 0; const int utrig = 2 * (((int)blockIdx.x >> 3) & 3);
    for (int unit = blockIdx.x; unit < nunit; unit += gridDim.x, ++uit) {
        if (cvt_layer >= 0 && uit == utrig) { __syncthreads(); cvt_moe_share(p, cvt_layer, blockIdx.x, cvt_n, gridDim.x, (LAS float*)lds); }
        int kind, b, g, qb;
        if (unit < 2048) { kind = 0; qb = unit & 63; g = (unit >> 6) & 3; b = unit >> 8; } else { const int u2 = unit - 2048; kind = 1; qb = u2 & 3; g = (u2 >> 2) & 3; b = u2 >> 4; }
        const int head = g * 8 + wv;
        const int qrow0 = kind ? (TL + b * 256 + qb * 64) : (b * 4096 + qb * 64);
        const int ctxrow0 = TL + b * 256;
        const int t_lo = kind ? 0 : (qb < 2 ? 2 - qb : 0), t_hi = kind ? -1 : (65 - qb < 4 ? 65 - qb : 4); const int nwin = t_hi - t_lo + 1, nv = nwin + 4;
        const bool krole = tid < 256; const int kkey = tid >> 2, kcp = tid & 3, kdA = (kcp & 1) * 8 + (kcp >> 1) * 32; const int vdim = (tid - 256) >> 2, vkc = tid & 3;
        f16x8 ld0, ld1;
#define AT_TILE(sidx, KROW0, MASK, ROPE) do { if ((sidx) < nwin) { const int _ti = t_lo + (sidx); KROW0 = b * 4096 + qb * 64 - 128 + 64 * _ti; ROPE = true; MASK = (_ti == 0) ? 1 : (_ti == 4) ? 2 : 0; } \
            else { KROW0 = ctxrow0 + 64 * ((sidx) - nwin); ROPE = false; MASK = 0; } } while (0)
#define AT_LOAD(KROW0) do { if (krole) { const h16* kp = qk + (size_t)((KROW0) + kkey) * DQK + D + g * 64 + kdA; ld0 = *(const f16x8*)kp; ld1 = *(const f16x8*)(kp + 16); } \
            else { const h16* vp = vt + (size_t)(g * 64 + vdim) * TT + (KROW0) + 16 * vkc; ld0 = *(const f16x8*)vp; ld1 = *(const f16x8*)(vp + 8); } } while (0)
        { int kr0, mk; bool rp; AT_TILE(0, kr0, mk, rp); (void)mk; (void)rp; AT_LOAD(kr0); }
        f16x8 qf[2][4];
#pragma unroll
        for (int qt = 0; qt < 2; ++qt) {
            f32x4 qv[4][2];
            const h16* qp = qk + (size_t)(qrow0 + 32 * qt + r32) * DQK + head * 64 + 8 * hh;
#pragma unroll
            for (int ks = 0; ks < 4; ++ks) { const f16x8 t = *(const f16x8*)(qp + 16 * ks);
#pragma unroll
                for (int i = 0; i < 4; ++i) { qv[ks][0][i] = (float)t[i]; qv[ks][1][i] = (float)t[4 + i]; } }
            if (kind == 0) {
                const int colpos = 32 * qt + r32;
#pragma unroll
                for (int a = 0; a < 2; ++a) { const int pos = a ? colpos : qb; const LAS float* cp = rcos + pos * 16 + 8 * hh; const LAS float* sp = rsin + pos * 16 + 8 * hh;
#pragma unroll
                    for (int e = 0; e < 2; ++e) { const f32x4 c = *(const LAS f32x4*)(cp + 4 * e), s = *(const LAS f32x4*)(sp + 4 * e);
                        const f32x4 x1 = qv[2 * a][e], x2 = qv[2 * a + 1][e]; qv[2 * a][e] = x1 * c - x2 * s; qv[2 * a + 1][e] = x2 * c + x1 * s; } }
            }
#pragma unroll
            for (int ks = 0; ks < 4; ++ks)
#pragma unroll
                for (int i = 0; i < 4; ++i) { qf[qt][ks][i] = (h16)(qv[ks][0][i] * (0.125f * 1.4426950408889634f)); qf[qt][ks][4 + i] = (h16)(qv[ks][1][i] * (0.125f * 1.4426950408889634f)); }
        }
        const float sink = p.at_sink[jl * 32 + head] * 1.4426950408889634f;
        float mrun[2] = {sink, sink}, lrun[2] = {hh == 0 ? 1.f : 0.f, hh == 0 ? 1.f : 0.f};
        f32x16 oacc[2][2];
#pragma unroll
        for (int a = 0; a < 2; ++a)
#pragma unroll
            for (int c = 0; c < 2; ++c)
#pragma unroll
                for (int i = 0; i < 16; ++i) oacc[a][c][i] = 0.f;
#pragma unroll 1
        for (int sx = 0; sx < nv; ++sx) {
            int krow0, mask; bool rope; AT_TILE(sx, krow0, mask, rope);
            __syncthreads();
            if (krole) {
                f16x8 o1 = ld0, o2 = ld1;
                if (rope) { const int kpos = (krow0 - b * 4096) + kkey; const int pos = (kcp >> 1) ? (kpos & 63) : (kpos >> 6);
                    const LAS float* cpp = rcos + pos * 16 + (kcp & 1) * 8; const LAS float* spp = rsin + pos * 16 + (kcp & 1) * 8;
#pragma unroll
                    for (int i = 0; i < 8; ++i) { const float c = cpp[i], s = spp[i], x1 = (float)ld0[i], x2 = (float)ld1[i]; o1[i] = (h16)(x1 * c - x2 * s); o2[i] = (h16)(x2 * c + x1 * s); } }
                *(LAS f16x8*)(Ks + kkey * AT_KP + kdA) = o1; *(LAS f16x8*)(Ks + kkey * AT_KP + kdA + 16) = o2;
            } else {
                LAS h16* dst = Vs + vdim * AT_VP + 16 * vkc;
                *(LAS f16x4*)(dst) = (f16x4){ld0[0], ld0[1], ld0[2], ld0[3]}; *(LAS f16x4*)(dst + 4) = (f16x4){ld0[4], ld0[5], ld0[6], ld0[7]};
                *(LAS f16x4*)(dst + 8) = (f16x4){ld1[0], ld1[1], ld1[2], ld1[3]}; *(LAS f16x4*)(dst + 12) = (f16x4){ld1[4], ld1[5], ld1[6], ld1[7]};
            }
            if (sx + 1 < nv) { int kr1, mk1; bool rp1; AT_TILE(sx + 1, kr1, mk1, rp1); (void)mk1; (void)rp1; AT_LOAD(kr1); }
            __syncthreads();
#pragma unroll
            for (int qt = 0; qt < 2; ++qt) {
                f32x16 sacc[2];
#pragma unroll
                for (int kt = 0; kt < 2; ++kt)
#pragma unroll
                    for (int i = 0; i < 16; ++i) sacc[kt][i] = 0.f;
#pragma unroll
                for (int ks = 0; ks < 4; ++ks)
#pragma unroll
                    for (int kt = 0; kt < 2; ++kt) { const f16x8 kf = *(const LAS f16x8*)(Ks + (32 * kt + r32) * AT_KP + 16 * ks + 8 * hh);
                        sacc[kt] = __builtin_amdgcn_mfma_f32_32x32x16_f16(kf, qf[qt][ks], sacc[kt], 0, 0, 0); }
                float tmax = -3.0e38f;
                if (mask != 0) {
                    int lim = r32 - 4 * hh; asm volatile("" : "+v"(lim));
                    if (mask == 1) {
#pragma unroll
                        for (int kt = 0; kt < 2; ++kt) {
                            if (kt < qt) {
#pragma unroll
                                for (int i = 0; i < 16; ++i) sacc[kt][i] = -1.0e30f; }
                            else if (kt == qt) {
#pragma unroll
                                for (int i = 0; i < 16; ++i) { const int kc = (i & 3) + 8 * (i >> 2); if (kc < lim) sacc[kt][i] = -1.0e30f; } } }
                    } else {
#pragma unroll
                        for (int kt = 0; kt < 2; ++kt) {
                            if (kt > qt) {
#pragma unroll
                                for (int i = 0; i < 16; ++i) sacc[kt][i] = -1.0e30f; }
                            else if (kt == qt) {
#pragma unroll
                                for (int i = 0; i < 16; ++i) { const int kc = (i & 3) + 8 * (i >> 2); if (kc > lim) sacc[kt][i] = -1.0e30f; } } }
                    } }
#pragma unroll
                for (int kt = 0; kt < 2; ++kt)
#pragma unroll
                    for (int i = 0; i < 16; ++i) tmax = fmaxf(tmax, sacc[kt][i]);
                tmax = fmaxf(tmax, shx(tmax, 32));
                const float mnew = fmaxf(mrun[qt], tmax); const float alpha = __builtin_amdgcn_exp2f(mrun[qt] - mnew); mrun[qt] = mnew;
                float psum = 0.f; f16x8 pf[2][2];
#pragma unroll
                for (int kt = 0; kt < 2; ++kt)
#pragma unroll
                    for (int s2 = 0; s2 < 2; ++s2)
#pragma unroll
                        for (int jj = 0; jj < 8; jj += 2) { const float p0 = __builtin_amdgcn_exp2f(sacc[kt][8 * s2 + jj] - mnew), p1 = __builtin_amdgcn_exp2f(sacc[kt][8 * s2 + jj + 1] - mnew);
                            const f16x2 pk = {(h16)p0, (h16)p1}; pf[kt][s2][jj] = pk[0]; pf[kt][s2][jj + 1] = pk[1];
                            psum = __builtin_amdgcn_fdot2(pk, (f16x2){(h16)1.0f, (h16)1.0f}, psum, false); }
                lrun[qt] = lrun[qt] * alpha + psum;
                if (__builtin_amdgcn_ballot_w64(alpha != 1.0f) != 0ull) {
#pragma unroll
                for (int dt = 0; dt < 2; ++dt)
#pragma unroll
                    for (int i = 0; i < 16; ++i) oacc[dt][qt][i] *= alpha; }
#pragma unroll
                for (int kt = 0; kt < 2; ++kt)
#pragma unroll
                    for (int s2 = 0; s2 < 2; ++s2)
#pragma unroll
                        for (int dt = 0; dt < 2; ++dt) { const LAS h16* vr = Vs + (32 * dt + r32) * AT_VP + 32 * kt + 16 * s2 + 4 * hh;
                            const f16x4 v0 = *(const LAS f16x4*)vr, v1 = *(const LAS f16x4*)(vr + 8);
                            const f16x8 vf = (f16x8){v0[0], v0[1], v0[2], v0[3], v1[0], v1[1], v1[2], v1[3]};
                            oacc[dt][qt] = __builtin_amdgcn_mfma_f32_32x32x16_f16(vf, pf[kt][s2], oacc[dt][qt], 0, 0, 0); }
            }
        }
        {   LAS h16* Ow = (LAS h16*)(lds + (wv < 4 ? 18432 + wv * 9216 : 73728 + (wv - 4) * 9216));
#pragma unroll
            for (int qt = 0; qt < 2; ++qt) {
                const float ltot = lrun[qt] + shx(lrun[qt], 32); const float inv = 1.0f / ltot;
                LAS h16* orow = Ow + (32 * qt + r32) * 72 + 4 * hh;
#pragma unroll
                for (int dt = 0; dt < 2; ++dt)
#pragma unroll
                    for (int q4 = 0; q4 < 4; ++q4) { f16x4 w;
#pragma unroll
                        for (int i = 0; i < 4; ++i) w[i] = (h16)(oacc[dt][qt][4 * q4 + i] * inv);
                        *(LAS f16x4*)(orow + 32 * dt + 8 * q4) = w; }
            }
            asm volatile("s_waitcnt lgkmcnt(0)" ::: "memory");
            const int orw = lane >> 3, och = lane & 7;
#pragma unroll
            for (int ps = 0; ps < 8; ++ps) { const int q = 8 * ps + orw; const f16x8 w = *(const LAS f16x8*)(Ow + q * 72 + 8 * och);
                *(f16x8*)(ob + (size_t)(qrow0 + q) * D + head * 64 + 8 * och) = w; }
        }
    }
}
#undef AT_TILE
#undef AT_LOAD

constexpr int NPHASE = 35;
#ifndef MK_MULTI
#define MK_MULTI 0
#endif

template <int KIND>
__attribute__((target("no-packed-fp32-ops"))) __global__ void __launch_bounds__(512, 2) hy_fwd(Params p_) {
    extern __shared__ __attribute__((aligned(16))) unsigned char shm[];
    LAS unsigned char* lds = (LAS unsigned char*)shm;
    constexpr bool ALL = KIND < 0;
    const int ph0 = p_.ph0;
    if (threadIdx.x == 0) { *(LAS u32x4*)(lds + LDS_XB) = (u32x4){0u, 0u, 0u, 0u}; }
    __syncthreads();
    XcdBarrier bar;
    if constexpr (ALL) bar = xcd_barrier_post((unsigned*)(p_.ws + WS_CTL), (volatile LAS unsigned*)(lds + LDS_XB));
#ifndef PROBE_SITE
#define PROBE_SITE -1
#endif
#define SITE(k) if constexpr (ALL || KIND == (k)) for (int rep_ = 0; rep_ < ((k) == PROBE_SITE ? 2 : 1); ++rep_) if (const Params& p = *params_fresh(); true)
#ifndef PROBE_XBAR
#define PROBE_XBAR 1
#endif
#define SEAM() do { if constexpr (ALL) { xcd_barrier(bar); if (PROBE_XBAR > 1) xcd_barrier(bar); if (PROBE_XBAR > 2) xcd_barrier(bar); } } while (0)
    const int G = gridDim.x, bid = blockIdx.x;
    SITE(0) {
        for (int u = bid; u < 4993; u += G) {
            if (u < 384) modp_unit(p, u, (LAS float*)lds);
            else if (u == 384) tables_unit(p);
            else if (u < 1473) h2_task(p, (u - 385) * 8 + (tid_fresh() >> 6));
            else if (u < 1537) w3p_unit(p, u - 1473);
            else if (u < 1793) rtab_unit(p, u - 1537);
            else cvt_dense_unit(p, u - 1793, (LAS float*)lds);
        }
        SEAM();
    }
    SITE(1) {
        for (int u = bid; u < 216; u += G) modr_unit(p, u);
        SchedFilt S{p.ws + WS_W3P, p.ws + WS_H2P}; EpiTaps E{(float*)(p.ws + WS_TAPS), (float*)(p.ws + WS_TAPSC)};
        pg8::gemm_phase<EpiTaps, SchedFilt, 0>(lds, 256, S, E);
        SEAM();
    }
#define TAIL_IDLE(nunits) (((nunits) % G) ? G - ((nunits) % G) : 0)
#define CVT_PER_GEMM 20
#pragma unroll 1
    for (int layer = ALL ? 0 : ph0; layer < (ALL ? NLAYER : ph0 + 1); ++layer) {
        const bool hyena = (layer & 1) == 0; const int jl = layer >> 1;
        const int nu1 = hyena ? 24 * 136 : 136 * 10, nu4 = (layer == NLAYER - 1 ? 128 : 136) * 8;
        const int idle1 = TAIL_IDLE(nu1), idle4 = TAIL_IDLE(nu4);
        int cv4 = idle4 * CVT_PER_GEMM, cv1 = idle1 * CVT_PER_GEMM; if (cv4 > CVT_MOE_UNITS / 2) cv4 = CVT_MOE_UNITS / 2; if (cv1 > CVT_MOE_UNITS / 2 - 1) cv1 = CVT_MOE_UNITS / 2 - 1;
        const int cvN0 = CVT_MOE_UNITS - cv1 - cv4, cvN1 = cvN0 + cv1;
        SITE(2) {
            n1_phase(p, layer, (h16*)(p.ws + ((!ALL && p.ph1) ? WS_UT : WS_XRES)));
            for (int rep2_ = 0; rep2_ < ((PROBE_SITE == 20 && layer > 0) ? 2 : 1); ++rep2_) {
            if (layer == 0) filt_fft_phase(p, lds);
            else { (void)0; } }
            SEAM();
        }
        SITE(3) {
#ifdef PROBE_CLK
            unsigned long long pc0_ = __builtin_readcyclecounter(), pr0_ = wall_clock64();
#endif
            if (hyena) { SchedPlain S{24, 136, D, p.ws + WS_WIN + (size_t)jl * D3 * D * 2, p.ws + WS_HBUF}; EpiH16 E{(h16*)(p.ws + WS_UT), TT, nullptr, 0};
                pg8::gemm_phase<EpiH16, SchedPlain, 0>(lds, D, S, E); }
            else { SchedQkv S{p.ws + WS_HBUF, p.ws + WS_WQKV + (size_t)jl * DQKV * D * 2}; EpiH16 E{(h16*)(p.ws + WS_QK), DQK, (h16*)(p.ws + WS_VT), TT};
                pg8::gemm_phase<EpiH16, SchedQkv, 0>(lds, D, S, E); }
#ifdef PROBE_CLK
            if (bid == 0 && threadIdx.x == 0) { const unsigned long long dc = __builtin_readcyclecounter() - pc0_, dr = wall_clock64() - pr0_; const unsigned long long spin = dc * 2500ull / (dr ? dr : 1ull);
                const unsigned long long t0 = wall_clock64(); while (wall_clock64() - t0 < spin) __builtin_amdgcn_s_sleep(8); }
#endif
            if (idle1 > 0 && bid >= G - idle1) { cvt_moe_share(p, layer, cvN0 + (bid - (G - idle1)), cvN1, idle1, (LAS float*)lds); }
            SEAM();
        }
        SITE(4) {
#ifdef PROBE_PAR
            for (int rep3_ = 0; rep3_ < (((layer & 1) == PROBE_PAR) ? 2 : 1); ++rep3_)
#endif
            { if (hyena) conv_phase(p, jl, lds, ALL ? 0 : p.ph1, layer, cvN0);
            else attn_phase(p, jl, layer != NLAYER - 1, lds, layer, cvN0); }
            SEAM();
        }
        SITE(5) {
            (void)0;
        }
        SITE(6) {
            EpiResid E{(h16*)(p.ws + WS_XRES), (const float*)(p.ws + WS_MODS), layer, (float*)(p.ws + WS_SSQ), (!ALL && p.ph1) ? (h16*)(p.ws + WS_YC) : (h16*)(p.ws + WS_XRES)};
            if (hyena) {
                SchedPlainAT S{layer == NLAYER - 1 ? 128 : 136, 8, D, p.ws + WS_ZT, p.ws + WS_WOUT + (size_t)jl * D * D * 2};
                pg8::gemm_phase<EpiResid, SchedPlainAT, 2>(lds, D, S, E, TT);
            } else {
                SchedPlain S{layer == NLAYER - 1 ? 128 : 136, 8, D, p.ws + WS_HBUF, p.ws + WS_WO + (size_t)jl * D * D * 2};
                pg8::gemm_phase<EpiResid, SchedPlain, 0>(lds, D, S, E);
            }
            if (idle4 > 0 && bid >= G - idle4) { cvt_moe_share(p, layer, cvN1 + (bid - (G - idle4)), CVT_MOE_UNITS, idle4, (LAS float*)lds); }
            SEAM();
        }
        SITE(7) { n2_phase(p, layer, lds, ALL ? 0 : p.ph1); SEAM(); }
        LAS int* tstart = (LAS int*)(lds + LDS_MISC); LAS int* texp = tstart + 80; LAS int* tcnt = texp + 352;
        SITE(8) {
            moe_table(tstart, texp, tcnt, (const int*)(p.ws + WS_CTL) + CTL_CNT + layer * NE);
            SchedMoe1 S{{tstart, texp, tcnt}, p.ws + WS_HBUF, p.ws + WS_W13, (const int*)(p.ws + WS_LIST)}; EpiMoe1 E{(h16*)(p.ws + WS_H1)};
            pg8::gemm_phase<EpiMoe1, SchedMoe1, 1>(lds, D, S, E);
            SEAM();
        }
        SITE(9) {
            moe_table(tstart, texp, tcnt, (const int*)(p.ws + WS_CTL) + CTL_CNT + layer * NE);
            SchedMoe2 S{{tstart, texp, tcnt}, p.ws + WS_H1, p.ws + WS_W2, (const int*)(p.ws + WS_LIST)}; EpiMoe2 E{(h16*)(p.ws + WS_YC), (const float*)(p.ws + WS_GATE), (const int*)(p.ws + WS_LIST)};
            pg8::gemm_phase<EpiMoe2, SchedMoe2, 0>(lds, DE, S, E);
            SEAM();
        }
    }
    SITE(10) final_phase(p);
#undef SITE
#undef SEAM
}

template <int KIND> static void launch_kind(const Params& p, int grid, hipStream_t stream) {
    static bool attr = false;
    if (!attr) { attr = true; if (hipFuncSetAttribute((const void*)hy_fwd<KIND>, hipFuncAttributeMaxDynamicSharedMemorySize, LDS_BYTES) != hipSuccess) fprintf(stderr, "kernel_launch: hipFuncSetAttribute failed (kind %d)\n", KIND); }
    hipLaunchKernelGGL(hy_fwd<KIND>, dim3(grid), dim3(512), LDS_BYTES, stream, p);
}

extern "C" void kernel_launch(void* const* d_in, const int* in_sizes, int n_in, void* d_out, int out_size, void* d_ws, size_t ws_size, hipStream_t stream) {
    static int grid = 0;
    if (!grid) {
        if (n_in != 29 || out_size != TL * D || ws_size < WS_END) { fprintf(stderr, "kernel_launch: unexpected problem (n_in %d, out %d, ws %zu < %zu)\n", n_in, out_size, ws_size, (size_t)WS_END); grid = -1; return; }
        int dev = 0, cus = 0;
        if (hipGetDevice(&dev) != hipSuccess || hipDeviceGetAttribute(&cus, hipDeviceAttributeMultiprocessorCount, dev) != hipSuccess) { grid = -1; return; }
        grid = cus;
    }
    if (grid <= 0) return;
    (void)hipMemsetAsync((char*)d_ws + WS_CTL, 0, CTL_BYTES, stream);
    Params p{};
    const float** pp = (const float**)&p;
    for (int i = 0; i < 29; ++i) pp[i] = (const float*)d_in[i];
    p.out = (float*)d_out; p.ws = (char*)d_ws;
#if MK_MULTI
    p.ph0 = 0; p.ph1 = 0;
    launch_kind<0>(p, grid, stream); launch_kind<1>(p, grid, stream);
#ifndef PROBE_KINDS
#define PROBE_KINDS 0
#endif
#ifndef PROBE_VAR
#define PROBE_VAR 0
#endif
#ifndef PROBE_LAYERS
#define PROBE_LAYERS 15
#endif
#define PKIND(k) ((PROBE_KINDS >> (k)) & 1)
#define PREP(k) ((PKIND(k) && ((PROBE_LAYERS >> layer) & 1)) ? 2 : 1)
    if (PKIND(0)) launch_kind<0>(p, grid, stream);
    if (PKIND(1)) launch_kind<1>(p, grid, stream);
    for (int layer = 0; layer < NLAYER; ++layer) { p.ph0 = layer;
        for (int r = 0; r < PREP(2); ++r) { p.ph1 = (PREP(2) == 2 && r == 0) ? 1 : 0; launch_kind<2>(p, grid, stream); p.ph1 = 0; }
        for (int r = 0; r < PREP(3); ++r) { p.ph1 = (PREP(3) == 2 && r == 0) ? PROBE_VAR : 0; launch_kind<3>(p, grid, stream); p.ph1 = 0; }
        for (int r = 0; r < PREP(4); ++r) { p.ph1 = (PREP(4) == 2 && r == 0) ? 1 : 0; launch_kind<4>(p, grid, stream); p.ph1 = 0; }
        if (PREP(6) == 2) { p.ph1 = 1; launch_kind<6>(p, grid, stream); p.ph1 = 0; }
        launch_kind<6>(p, grid, stream); launch_kind<7>(p, grid, stream);
        if (PREP(7) == 2) { p.ph1 = 1; launch_kind<7>(p, grid, stream); p.ph1 = 0; }
        for (int r = 0; r < PREP(8); ++r) launch_kind<8>(p, grid, stream);
        for (int r = 0; r < PREP(9); ++r) launch_kind<9>(p, grid, stream); }
    p.ph0 = 0; launch_kind<10>(p, grid, stream);
    if (PKIND(10)) launch_kind<10>(p, grid, stream);
#else
    p.ph0 = 0; p.ph1 = NPHASE;
    launch_kind<-1>(p, grid, stream);
#endif
}
```

```cpp
#include <hip/hip_runtime.h>
#include <cstdio>
#include <cstdint>

#define LAS __attribute__((address_space(3)))
typedef _Float16 h16;
typedef _Float16 f16x8 __attribute__((ext_vector_type(8)));
typedef _Float16 f16x4 __attribute__((ext_vector_type(4)));
typedef _Float16 f16x2 __attribute__((ext_vector_type(2)));
typedef float f32x2 __attribute__((ext_vector_type(2)));
typedef float f32x4 __attribute__((ext_vector_type(4)));
typedef float f32x16 __attribute__((ext_vector_type(16)));
typedef unsigned u32x2 __attribute__((ext_vector_type(2)));
typedef unsigned u32x4 __attribute__((ext_vector_type(4)));

constexpr int D = 2048, NB = 8, SEQ = 4096, CTXL = 256, TL = NB * SEQ, TC = NB * CTXL, TT = TL + TC;
constexpr int D3 = 3 * D, D6 = 6 * D, DQK = 2304, DQKV = 2560, NE = 64, DE = 384, DE2 = 768, NLAYER = 4;
constexpr int LCAP = TT;
constexpr int MOE_ROWS = 86016;
constexpr float EPS = 1e-6f;

constexpr size_t WS_CTL = 0;
constexpr size_t CTL_BYTES = 65536;
constexpr size_t WS_TW = WS_CTL + CTL_BYTES;
constexpr size_t WS_ROPE = WS_TW + 65536;
constexpr size_t WS_MODP = WS_ROPE + 8192;
constexpr size_t WS_MODS = WS_MODP + 16ull * 4 * 9 * 12288 * 4;
constexpr size_t WS_RTAB = WS_MODS + 4ull * 9 * 12288 * 4;
constexpr size_t RTAB_L = 64ull * 5 * 2 * 64 * 8 * 2;
constexpr size_t WS_RCST = WS_RTAB + 4 * RTAB_L;
constexpr size_t WS_H2P = WS_RCST + 16384;
constexpr size_t WS_W3P = WS_H2P + 2ull * 4352 * 256 * 2;
constexpr size_t WS_XRES = WS_W3P + 2ull * 8192 * 256 * 2;
constexpr size_t WS_HBUF = WS_XRES + (size_t)TT * D * 4;
constexpr size_t WS_UT = WS_HBUF + (size_t)TT * D * 2;
constexpr size_t UT_BYTES = (size_t)D3 * TT * 2;
constexpr size_t WS_TAPS = WS_UT;
constexpr size_t WS_TAPSC = WS_TAPS + 2ull * 8192 * 4096 * 4;
constexpr size_t WS_QK = WS_UT;
constexpr size_t WS_VT = WS_QK + (size_t)TT * DQK * 2;
constexpr size_t WS_ZT = WS_UT + UT_BYTES;
constexpr size_t WS_H1 = WS_ZT + (size_t)D * TT * 2;
constexpr size_t WS_YC = WS_H1 + (size_t)MOE_ROWS * DE * 2;
constexpr size_t WS_WIN = WS_YC + 2ull * TT * D * 2;
constexpr size_t WS_WOUT = WS_WIN + 2ull * D3 * D * 2;
constexpr size_t WS_WQKV = WS_WOUT + 2ull * D * D * 2;
constexpr size_t WS_WO = WS_WQKV + 2ull * DQKV * D * 2;
constexpr size_t WS_W13 = WS_WO + 2ull * D * D * 2;
constexpr size_t WS_W2 = WS_W13 + (size_t)NE * DE2 * D * 2;
constexpr size_t WS_KF = WS_W2 + (size_t)NE * D * DE * 2;
constexpr size_t WS_KFC = WS_KF + 2ull * 2 * 2048 * 65536;
constexpr size_t WS_LIST = WS_KFC + 2ull * 2 * 2048 * 4096;
constexpr size_t WS_GATE = WS_LIST + (size_t)NE * LCAP * 4;
constexpr size_t WS_SSQ = WS_GATE + (size_t)NE * LCAP * 4;
constexpr size_t WS_END = WS_SSQ + (size_t)TT * 32 * 4;
static_assert(WS_TAPSC + 2ull * 8192 * 256 * 4 <= WS_UT + UT_BYTES, "taps alias");
static_assert(WS_VT + 256ull * TT * 2 <= WS_UT + UT_BYTES, "qkv alias");

constexpr int CTL_CNT = 4096;

constexpr int LDS_BYTES = 147456;
constexpr int LDS_MISC = 139264;
constexpr int LDS_XB = LDS_BYTES - 16;

struct Params {
    const float *x, *c, *ctx, *c_ctx, *mod_w, *mod_b, *hy_w_in, *hy_conv_w, *hy_conv_b, *hy_f_w1, *hy_f_b1, *hy_f_freq1, *hy_f_w2, *hy_f_b2, *hy_f_freq2, *hy_f_w3,
        *hy_bias, *hy_w_out, *at_w_qkv, *at_sink, *at_w_o, *moe_wg, *moe_bg, *moe_we, *moe_be, *moe_w1, *moe_w3, *moe_w2, *final_gain;
    float* out; char* ws; int ph0, ph1;
};

__device__ __forceinline__ int tid_fresh() { int t = threadIdx.x; asm volatile("" : "+v"(t)); return t; }
__device__ __forceinline__ float bperm_f(float v, int srclane) { return __int_as_float(__builtin_amdgcn_ds_bpermute(srclane << 2, __float_as_int(v))); }
__device__ __forceinline__ float shx(float v, int mask) { return bperm_f(v, (tid_fresh() & 63) ^ mask); }
__device__ __forceinline__ const Params* params_fresh() { auto q = __builtin_amdgcn_kernarg_segment_ptr(); asm volatile("" : "+s"(q)); return (const Params*)q; }

#define XB_TMO      128
#define XB_XCNT(j)  (256  + 64 * (j))
#define XB_XSUB(j)  (1280 + 64 * (j))
#define XB_XGEN(j)  (2304 + 64 * (j))
#define XB_TOP      3328
#define XB_TOPGEN   3392
#define XCD_BAR_WORDS 3456
#define XB_SPIN_CAP (1u << 18)

__device__ __forceinline__ unsigned xb_ld(unsigned* p)              { return __hip_atomic_load(p, __ATOMIC_RELAXED, __HIP_MEMORY_SCOPE_AGENT); }
__device__ __forceinline__ unsigned xb_add(unsigned* p, unsigned v) { return __hip_atomic_fetch_add(p, v, __ATOMIC_RELAXED, __HIP_MEMORY_SCOPE_AGENT); }
__device__ __forceinline__ unsigned xb_xcc_id() { return (unsigned)__builtin_amdgcn_s_getreg((3 << 11) | 20) & 0xFu; }
#define XB_SPIN(cond, bar) do { unsigned _sp = 0; while (cond) { __builtin_amdgcn_s_sleep(1); \
    if ((++_sp & 255u) == 0u) { if (xb_ld(&(bar)[XB_TMO])) break; if (_sp > XB_SPIN_CAP) { atomicAdd(&(bar)[XB_TMO], 1u); break; } } } } while (0)

struct XcdBarrier { unsigned* bar; volatile LAS unsigned* st; };

__device__ __forceinline__ XcdBarrier xcd_barrier_post(unsigned* bar, volatile LAS unsigned* st) {
    XcdBarrier b; b.bar = bar; b.st = st;
    if (threadIdx.x == 0) (void)xb_add(&bar[XB_XCNT(xb_xcc_id())], 1u);
    return b;
}
__device__ __forceinline__ void xcd_barrier_complete(unsigned* bar, unsigned x, unsigned& nloc, unsigned& nx) {
    const unsigned G = gridDim.x * gridDim.y * gridDim.z;
    unsigned sum, cnt, mine, sp = 0u;
    for (;;) {
        sum = 0u; cnt = 0u; mine = 0u;
#pragma unroll
        for (unsigned j = 0; j < 16; ++j) { const unsigned c = xb_ld(&bar[XB_XCNT(j)]); sum += c; cnt += (c > 0u) ? 1u : 0u; mine = (j == x) ? c : mine; }
        if (sum == G) break;
        __builtin_amdgcn_s_sleep(1);
        if ((++sp & 255u) == 0u) { if (xb_ld(&bar[XB_TMO])) break; if (sp > XB_SPIN_CAP) { atomicAdd(&bar[XB_TMO], 1u); break; } }
    }
    nloc = mine > 0u ? mine : 1u; nx = cnt > 0u ? cnt : 1u;
}
__device__ __forceinline__ void xcd_barrier(const XcdBarrier& b) {
    asm volatile("s_waitcnt vmcnt(0)" ::: "memory");
    __syncthreads();
    if (threadIdx.x == 0) {
        unsigned* bar = b.bar; const unsigned bx = xb_xcc_id();
        __builtin_amdgcn_s_waitcnt(0);
        unsigned nloc = b.st[0], nx = b.st[1];
        if (nloc == 0u) { xcd_barrier_complete(bar, bx, nloc, nx); b.st[0] = nloc; b.st[1] = nx; }
        const unsigned old = xb_add(&bar[XB_XSUB(bx)], 1u);
        const unsigned gen = old / nloc;
        if (old + 1u == (gen + 1u) * nloc) {
            __builtin_amdgcn_fence(__ATOMIC_RELEASE, "agent");
            asm volatile("s_waitcnt vmcnt(0)" ::: "memory");
            const unsigned og = xb_add(&bar[XB_TOP], 1u);
            const unsigned tg = og / nx;
            if (og + 1u == (tg + 1u) * nx) xb_add(&bar[XB_TOPGEN], 1u);
            else XB_SPIN(xb_ld(&bar[XB_TOPGEN]) == tg, bar);
            __builtin_amdgcn_fence(__ATOMIC_ACQUIRE, "agent");
            xb_add(&bar[XB_XGEN(bx)], 1u);
            asm volatile("s_waitcnt vmcnt(0)" ::: "memory");
        } else {
            XB_SPIN(xb_ld(&bar[XB_XGEN(bx)]) == gen, bar);
            __builtin_amdgcn_fence(__ATOMIC_ACQUIRE, "agent");
            asm volatile("s_waitcnt vmcnt(0)" ::: "memory");
        }
    }
    __syncthreads();
}

namespace pg8 {
constexpr int BM = 256, BK = 64, HALF = 128, HTB = HALF * BK * 2, STAGE_BYTES = 8 * HTB;
__device__ __forceinline__ int lds_byte(int r, int c) { const int st = (r >> 4) * 2 + (c >> 5), rr = r & 15, cc = c & 31, ob = rr * 64 + cc * 2; return st * 1024 + (ob ^ (((ob >> 9) & 1) << 5)); }
__device__ __forceinline__ void stage_rc(int b, int& R, int& C) { const int st = b / 1024, sb = b % 1024, swz = sb ^ (((sb >> 9) & 1) << 5); R = (st >> 1) * 16 + swz / 64; C = (st & 1) * 32 + (swz % 64) / 2; }
__device__ __forceinline__ int perm32(int rho) { const int n = rho >> 4, i = rho & 15; return 8 * (i >> 2) + 4 * n + (i & 3); }

struct Unit {
    int pm, pn;
    int e, pos0, cnt;
    int kind;
    int half;
    const char* A; const char* B;
    const int* rows;
};

typedef short s16x4 __attribute__((ext_vector_type(4)));
template <class Epi, class Sched, int AMODE>
__device__ __forceinline__ void gemm_phase(LAS unsigned char* lds, const int K, const Sched& S, const Epi& E, const int ldat = 0) {
    constexpr bool GATHER = AMODE == 1, ATR = AMODE == 2;
    const int tid = tid_fresh(), wid = __builtin_amdgcn_readfirstlane(tid >> 6), lane = tid & 63, wr = wid >> 2, wc = wid & 3, fr = lane & 15, fq = lane >> 4;
    const int nt = K / BK;
    unsigned voffA[2], voffB[2]; int RA[2], CA[2];
#pragma unroll
    for (int i = 0; i < 2; ++i) { int R, C; stage_rc(tid * 16 + i * 8192, R, C); const int Rb = Epi::PERM ? ((R & ~31) + perm32(R & 31)) : R;
        voffA[i] = (unsigned)(R * K + C) * 2u; voffB[i] = (unsigned)(Rb * K + C) * 2u; RA[i] = R; CA[i] = C;
        if constexpr (ATR) { const int bb = tid * 16 + i * 8192, row = bb >> 8, pc = (bb >> 4) & 15, ch = pc ^ (((row & 3) << 2) | ((row >> 2) & 3)); voffA[i] = (unsigned)(row * ldat + 8 * ch) * 2u; } }
    const size_t kstep = (size_t)(BK * 2);
    const size_t hstep = (size_t)HALF * K * 2;
    const size_t kstepA = ATR ? (size_t)BK * ldat * 2 : kstep, hstepA = ATR ? (size_t)HALF * 2 : hstep;
    const unsigned ldsw = (unsigned)wid * 1024u;
    const int aoff = lds_byte(wr * 64 + fr, fq * 8), boff = lds_byte(wc * 32 + fr, fq * 8);
    int atr[4][2];
#pragma unroll
    for (int m = 0; m < 4; ++m)
#pragma unroll
        for (int bl = 0; bl < 2; ++bl) { const int xr = ((fr >> 2) << 2) | ((2 * fq + bl) & 3); atr[m][bl] = (int)(unsigned)(uintptr_t)lds + 256 * (8 * fq + (fr >> 2) + 4 * bl) + 16 * ((wr * 8 + 2 * m + ((fr & 3) >> 1)) ^ xr) + 8 * (fr & 1); }
    unsigned vgC[2][2], vgN[2][2];
#define PG8_ROWS(u, vg) do { if constexpr (GATHER) { _Pragma("unroll") for (int _h = 0; _h < 2; ++_h) _Pragma("unroll") for (int _i = 0; _i < 2; ++_i) { \
        const int _p = (u).pos0 + _h * HALF + RA[_i]; const int _tok = (_p < (u).cnt) ? ((u).rows[_h * HALF + RA[_i]] >> 1) : 0; \
        vg[_h][_i] = ((unsigned)_tok * (unsigned)K + (unsigned)CA[_i]) * 2u; } } } while (0)
#define PG8_SA(b, h) (((b) * 2 + (h)) * HTB)
#define PG8_SB(b, h) ((4 + (b) * 2 + (h)) * HTB)
#define PG8_STAGE_B(bufoff, gbase) do { _Pragma("unroll") for (int _i = 0; _i < 2; ++_i) \
        __builtin_amdgcn_global_load_lds((const unsigned*)((const char*)(gbase) + voffB[_i]), (LAS unsigned*)(lds + (bufoff) + ldsw + _i * 8192), 16, 0, 0); } while (0)
#define PG8_STAGE_A(bufoff, gbase, h, NEXT) do { _Pragma("unroll") for (int _i = 0; _i < 2; ++_i) { \
        const unsigned _vo = GATHER ? ((NEXT) ? vgN[h][_i] : vgC[h][_i]) : voffA[_i]; \
        __builtin_amdgcn_global_load_lds((const unsigned*)((const char*)(gbase) + (GATHER ? (size_t)0 : (size_t)(h) * hstepA) + _vo), (LAS unsigned*)(lds + (bufoff) + ldsw + _i * 8192), 16, 0, 0); } } while (0)
#define PG8_LDA(dst, b, h) do { if constexpr (!ATR) { _Pragma("unroll") for (int m = 0; m < 4; ++m) _Pragma("unroll") for (int k = 0; k < 2; ++k) dst[m][k] = *(const LAS f16x8*)(lds + PG8_SA(b, h) + aoff + m * 2048 + k * 1024); } \
        else { _Pragma("unroll") for (int m = 0; m < 4; ++m) _Pragma("unroll") for (int k = 0; k < 2; ++k) { s16x4 _lo, _hi; \
            asm volatile("ds_read_b64_tr_b16 %0, %1 offset:%2" : "=v"(_lo) : "v"(atr[m][0]), "i"(PG8_SA(b, h) + k * 8192) : "memory"); \
            asm volatile("ds_read_b64_tr_b16 %0, %1 offset:%2" : "=v"(_hi) : "v"(atr[m][1]), "i"(PG8_SA(b, h) + k * 8192) : "memory"); \
            const short __attribute__((ext_vector_type(8))) _v = {_lo[0], _lo[1], _lo[2], _lo[3], _hi[0], _hi[1], _hi[2], _hi[3]}; dst[m][k] = __builtin_bit_cast(f16x8, _v); } } } while (0)
#define PG8_PIN(At) do { if constexpr (ATR) asm volatile("" : "+v"(At[0][0]), "+v"(At[0][1]), "+v"(At[1][0]), "+v"(At[1][1]), "+v"(At[2][0]), "+v"(At[2][1]), "+v"(At[3][0]), "+v"(At[3][1])); } while (0)
#define PG8_LDB(dst, b, h) do { _Pragma("unroll") for (int n = 0; n < 2; ++n) _Pragma("unroll") for (int k = 0; k < 2; ++k) dst[n][k] = *(const LAS f16x8*)(lds + PG8_SB(b, h) + boff + n * 2048 + k * 1024); } while (0)
#define PG8_MMA(ai, bj, At, Bt) do { __builtin_amdgcn_s_setprio(1); _Pragma("unroll") for (int m = 0; m < 4; ++m) _Pragma("unroll") for (int n = 0; n < 2; ++n) _Pragma("unroll") for (int k = 0; k < 2; ++k) \
        acc[ai][bj][m][n] = __builtin_amdgcn_mfma_f32_16x16x32_f16(Bt[n][k], At[m][k], acc[ai][bj][m][n], 0, 0, 0); __builtin_amdgcn_s_setprio(0); } while (0)
#define PG8_WAIT_V(n) asm volatile("s_waitcnt vmcnt(" #n ")" ::: "memory")
#define PG8_WAIT_L(n) asm volatile("s_waitcnt lgkmcnt(" #n ")" ::: "memory")
#define PG8_BAR __builtin_amdgcn_s_barrier()
#define PG8_SCHED __builtin_amdgcn_sched_barrier(0)
    Unit cur, nxt; int ui = 0;
    if (!S.next(0, cur)) return;
    f32x4 acc[2][2][4][2];
#pragma unroll
    for (int a = 0; a < 2; ++a)
#pragma unroll
        for (int b = 0; b < 2; ++b)
#pragma unroll
            for (int m = 0; m < 4; ++m)
#pragma unroll
                for (int n = 0; n < 2; ++n) acc[a][b][m][n] = (f32x4){0.f, 0.f, 0.f, 0.f};
    f16x8 At[4][2], B0[2][2], B1[2][2];
    const char* cA = cur.A; const char* cB = cur.B;
    PG8_ROWS(cur, vgC);
#pragma unroll
    for (int _h = 0; _h < 2; ++_h)
#pragma unroll
        for (int _i = 0; _i < 2; ++_i) vgN[_h][_i] = GATHER ? vgC[_h][_i] : 0u;
    PG8_STAGE_B(PG8_SB(0, 0), cB); PG8_STAGE_B(PG8_SB(0, 1), cB + hstep); PG8_STAGE_A(PG8_SA(0, 0), cA, 0, false); PG8_STAGE_A(PG8_SA(0, 1), cA, 1, false);
    if (wr == 1) PG8_BAR;
    PG8_WAIT_V(2); PG8_BAR;
    PG8_STAGE_B(PG8_SB(1, 0), cB + kstep); PG8_STAGE_A(PG8_SA(1, 0), cA + kstepA, 0, false); PG8_STAGE_B(PG8_SB(1, 1), cB + hstep + kstep);
    PG8_WAIT_V(6); PG8_BAR;
    for (;;) {
        const bool has_next = S.next(ui + 1, nxt);
        const bool full = cur.half == 0;
        const char* nA = has_next ? nxt.A : cA; const char* nB = has_next ? nxt.B : cB;
        if (has_next) { PG8_ROWS(nxt, vgN); }
        typename Epi::Pre pre; E.prefetch(cur, wr, fr, pre);
#pragma unroll 1
        for (int t = 0; t < nt; t += 2) {
            const bool last = (t == nt - 2);
            const char* a1 = cA + (size_t)(t + 1) * kstepA;
            const char* a2 = last ? nA : cA + (size_t)(t + 2) * kstepA; const char* b2 = last ? nB : cB + (size_t)(t + 2) * kstep;
            const char* a3 = a2 + kstepA; const char* b3 = b2 + kstep;
            PG8_LDB(B0, 0, 0); PG8_LDB(B1, 0, 1); PG8_SCHED; PG8_LDA(At, 0, 0); PG8_STAGE_A(PG8_SA(1, 1), a1, 1, false);
            PG8_WAIT_V(8); PG8_WAIT_L(0); PG8_PIN(At); PG8_BAR; PG8_MMA(0, 0, At, B0); PG8_MMA(0, 1, At, B1); PG8_BAR; PG8_SCHED;
            PG8_LDA(At, 0, 1); PG8_STAGE_B(PG8_SB(0, 0), b2); PG8_STAGE_B(PG8_SB(0, 1), b2 + hstep); PG8_STAGE_A(PG8_SA(0, 0), a2, 0, last);
            PG8_WAIT_V(8); PG8_WAIT_L(0); PG8_PIN(At); PG8_BAR; if (full) { PG8_MMA(1, 0, At, B0); PG8_MMA(1, 1, At, B1); } PG8_BAR; PG8_SCHED;
            PG8_LDB(B0, 1, 0); PG8_LDB(B1, 1, 1); PG8_SCHED; PG8_LDA(At, 1, 0); PG8_STAGE_A(PG8_SA(0, 1), a2, 1, last);
            PG8_WAIT_V(8); PG8_WAIT_L(0); PG8_PIN(At); PG8_BAR; PG8_MMA(0, 0, At, B0); PG8_MMA(0, 1, At, B1); PG8_BAR; PG8_SCHED;
            PG8_LDA(At, 1, 1); PG8_STAGE_B(PG8_SB(1, 0), b3); PG8_STAGE_B(PG8_SB(1, 1), b3 + hstep); PG8_STAGE_A(PG8_SA(1, 0), a3, 0, last);
            PG8_WAIT_V(8); PG8_WAIT_L(0); PG8_PIN(At); PG8_BAR; if (full) { PG8_MMA(1, 0, At, B0); PG8_MMA(1, 1, At, B1); } PG8_BAR; PG8_SCHED;
        }
        if (wr == 0) PG8_BAR;
        E(acc, cur, wr, wc, fr, fq, pre);
        if (!has_next) break;
#pragma unroll
        for (int a = 0; a < 2; ++a)
#pragma unroll
            for (int b = 0; b < 2; ++b)
#pragma unroll
                for (int m = 0; m < 4; ++m)
#pragma unroll
                    for (int n = 0; n < 2; ++n) acc[a][b][m][n] = (f32x4){0.f, 0.f, 0.f, 0.f};
        cur = nxt; cA = nA; cB = nB; ++ui;
#pragma unroll
        for (int _h = 0; _h < 2; ++_h)
#pragma unroll
            for (int _i = 0; _i < 2; ++_i) vgC[_h][_i] = vgN[_h][_i];
        if (wr == 1) PG8_BAR;
    }
    PG8_WAIT_V(0);
    PG8_BAR;
#undef PG8_ROWS
#undef PG8_SA
#undef PG8_SB
#undef PG8_STAGE_A
#undef PG8_STAGE_B
#undef PG8_LDA
#undef PG8_LDB
#undef PG8_PIN
#undef PG8_MMA
#undef PG8_WAIT_V
#undef PG8_WAIT_L
#undef PG8_BAR
#undef PG8_SCHED
}
}

using pg8::Unit;
__device__ __forceinline__ f16x8 pack8(const f32x4 a, const f32x4 b) {
    f16x8 w; w[0] = (h16)a[0]; w[1] = (h16)a[1]; w[2] = (h16)a[2]; w[3] = (h16)a[3]; w[4] = (h16)b[0]; w[5] = (h16)b[1]; w[6] = (h16)b[2]; w[7] = (h16)b[3]; return w;
}
struct EpiH16 {
    static constexpr bool PERM = true;
    h16* O0; int ld0; h16* O1; int ld1;
    struct Pre {}; __device__ __forceinline__ void prefetch(const Unit&, int, int, Pre&) const {}
    __device__ __forceinline__ void operator()(const f32x4 (&acc)[2][2][4][2], const Unit& u, int wr, int wc, int fr, int fq, const Pre&) const {
        h16* base = u.kind ? O1 : O0; const int ld = u.kind ? ld1 : ld0;
        const int row0 = u.pm * 256 + wr * 64 + fr, col0 = u.pn * 256 + wc * 32 + 8 * fq;
#pragma unroll
        for (int ai = 0; ai < 2; ++ai)
#pragma unroll
            for (int m = 0; m < 4; ++m) { h16* rowp = base + (size_t)(row0 + ai * 128 + m * 16) * ld + col0;
#pragma unroll
                for (int bj = 0; bj < 2; ++bj) __builtin_nontemporal_store(pack8(acc[ai][bj][m][0], acc[ai][bj][m][1]), (f16x8*)(rowp + bj * 128)); }
    }
};
struct EpiTaps {
    static constexpr bool PERM = false;
    float* T0; float* T1;
    struct Pre {}; __device__ __forceinline__ void prefetch(const Unit&, int, int, Pre&) const {}
    __device__ __forceinline__ void operator()(const f32x4 (&acc)[2][2][4][2], const Unit& u, int wr, int wc, int fr, int fq, const Pre&) const {
        const int j = u.kind >> 1, v = u.kind & 1; const int ld = v ? 256 : 4096;
        float* base = v ? (T1 + (size_t)j * 8192 * 256) : (T0 + (size_t)j * 8192 * 4096);
        const int row0 = u.pm * 256 + wr * 64 + fr, col0 = u.pn * 256 + wc * 32 + 4 * fq;
#pragma unroll
        for (int ai = 0; ai < 2; ++ai)
#pragma unroll
            for (int m = 0; m < 4; ++m) { float* rowp = base + (size_t)(row0 + ai * 128 + m * 16) * ld + col0;
#pragma unroll
                for (int bj = 0; bj < 2; ++bj)
#pragma unroll
                    for (int n = 0; n < 2; ++n) *(f32x4*)(rowp + bj * 128 + n * 16) = acc[ai][bj][m][n]; }
    }
};
struct EpiResid {
    static constexpr bool PERM = true;
    h16* X; const float* mods; int layer; float* SSQ; h16* XO;
    struct Pre {}; __device__ __forceinline__ void prefetch(const Unit&, int, int, Pre&) const {}
    __device__ __forceinline__ void operator()(const f32x4 (&acc)[2][2][4][2], const Unit& u, int wr, int wc, int fr, int fq, const Pre&) const {
        const int r0 = u.pm * 256; const int b = r0 < TL ? (r0 >> 12) : 8;
        const float* g = mods + ((size_t)(layer * 9 + b) * 6 + 2) * D;
        const int row0 = r0 + wr * 64 + fr, col0 = u.pn * 256 + wc * 32 + 8 * fq;
        f32x4 gv[2][2];
#pragma unroll
        for (int bj = 0; bj < 2; ++bj)
#pragma unroll
            for (int n = 0; n < 2; ++n) gv[bj][n] = *(const f32x4*)(g + col0 + bj * 128 + n * 4);
#pragma unroll
        for (int ai = 0; ai < 2; ++ai)
#pragma unroll
            for (int m = 0; m < 4; ++m) { const int row = row0 + ai * 128 + m * 16; const h16* rowp = X + (size_t)row * D + col0; h16* rowo = XO + (size_t)row * D + col0; float sq = 0.f;
#pragma unroll
                for (int bj = 0; bj < 2; ++bj) { const f16x8 xv = __builtin_nontemporal_load((const f16x8*)(rowp + bj * 128)); f32x4 v0, v1;
#pragma unroll
                    for (int i = 0; i < 4; ++i) { v0[i] = (float)xv[i] + gv[bj][0][i] * acc[ai][bj][m][0][i]; v1[i] = (float)xv[4 + i] + gv[bj][1][i] * acc[ai][bj][m][1][i]; }
                    const f16x8 w = pack8(v0, v1); *(f16x8*)(rowo + bj * 128) = w;
#pragma unroll
                    for (int i = 0; i < 8; ++i) { const float t = (float)w[i]; sq += t * t; } }
                sq += shx(sq, 16); sq += shx(sq, 32);
                if (fq == 0) SSQ[(size_t)row * 32 + u.pn * 4 + wc] = sq; }
    }
};
struct EpiMoe1 {
    static constexpr bool PERM = true;
    h16* H1;
    struct Pre {}; __device__ __forceinline__ void prefetch(const Unit&, int, int, Pre&) const {}
    __device__ __forceinline__ void operator()(const f32x4 (&acc)[2][2][4][2], const Unit& u, int wr, int wc, int fr, int fq, const Pre&) const {
        const int row0 = u.pm * 256 + wr * 64 + fr, col0 = u.pn * 128 + wc * 16 + 4 * fq;
#pragma unroll
        for (int ai = 0; ai < 2; ++ai)
#pragma unroll
            for (int m = 0; m < 4; ++m) { if (ai == 1 && u.half) continue; h16* rowp = H1 + (size_t)(row0 + ai * 128 + m * 16) * DE + col0;
#pragma unroll
                for (int bj = 0; bj < 2; ++bj) { const f32x4 a = acc[ai][bj][m][0], b = acc[ai][bj][m][1]; f16x4 w;
#pragma unroll
                    for (int i = 0; i < 4; ++i) { const float s = a[i] * __builtin_amdgcn_rcpf(1.0f + __expf(-a[i])); w[i] = (h16)(s * b[i]); }
                    *(f16x4*)(rowp + bj * 64) = w; } }
    }
};
struct EpiMoe2 {
    static constexpr bool PERM = true;
    h16* YC; const float* gslot;
    struct Pre { int av[2][4]; float gv[2][4]; };
    __device__ __forceinline__ void prefetch(const Unit& u, int wr, int fr, Pre& q) const {
        const float* grow = gslot + ((const char*)u.rows - (const char*)listbase) / 4;
#pragma unroll
        for (int ai = 0; ai < 2; ++ai)
#pragma unroll
            for (int m = 0; m < 4; ++m) { const int r = ai * 128 + wr * 64 + m * 16 + fr; const bool ok = u.pos0 + r < u.cnt; q.av[ai][m] = ok ? u.rows[r] : -1; q.gv[ai][m] = ok ? grow[r] : 0.f; }
    }
    __device__ __forceinline__ void operator()(const f32x4 (&acc)[2][2][4][2], const Unit& u, int wr, int wc, int fr, int fq, const Pre& q) const {
        const int col0 = u.pn * 256 + wc * 32 + 8 * fq;
#pragma unroll
        for (int ai = 0; ai < 2; ++ai)
#pragma unroll
            for (int m = 0; m < 4; ++m) { if (q.av[ai][m] >= 0) { const float g = q.gv[ai][m]; h16* rowp = YC + (size_t)q.av[ai][m] * D + col0;
#pragma unroll
                    for (int bj = 0; bj < 2; ++bj) *(f16x8*)(rowp + bj * 128) = pack8(acc[ai][bj][m][0] * g, acc[ai][bj][m][1] * g); } }
    }
    const int* listbase;
};

__device__ __forceinline__ void order_tile(int wgid, int nM, int nN, int& pm, int& pn) {
    const int nwg = nM * nN; { const int q = nwg / 8, r = nwg % 8, xcd = wgid % 8, off = wgid / 8; wgid = (xcd < r ? xcd * (q + 1) : r * (q + 1) + (xcd - r) * q) + off; }
    const int nig = 8 * nN, gid = wgid / nig, fm = gid * 8, gsz = (nM - fm) < 8 ? (nM - fm) : 8;
    pm = fm + ((wgid % nig) % gsz); pn = (wgid % nig) / gsz;
}
struct SchedPlain {
    int nM, nN, K; const char* A; const char* B;
    __device__ __forceinline__ bool next(int i, Unit& u) const {
        const long L = (long)i * gridDim.x + blockIdx.x; if (L >= (long)nM * nN) return false;
        order_tile((int)L, nM, nN, u.pm, u.pn); u.kind = 0; u.half = 0; u.e = 0; u.pos0 = 0; u.cnt = 0; u.rows = nullptr;
        u.A = A + (size_t)u.pm * 256 * K * 2; u.B = B + (size_t)u.pn * 256 * K * 2; return true;
    }
};
struct SchedPlainAT {
    int nM, nN, K; const char* At; const char* B;
    __device__ __forceinline__ bool next(int i, Unit& u) const {
        const long L = (long)i * gridDim.x + blockIdx.x; if (L >= (long)nM * nN) return false;
        order_tile((int)L, nM, nN, u.pm, u.pn); u.kind = 0; u.half = 0; u.e = 0; u.pos0 = 0; u.cnt = 0; u.rows = nullptr;
        u.A = At + (size_t)u.pm * 256 * 2; u.B = B + (size_t)u.pn * 256 * K * 2; return true;
    }
};
struct SchedQkv {
    const char* H; const char* W;
    __device__ __forceinline__ bool next(int i, Unit& u) const {
        const long L = (long)i * gridDim.x + blockIdx.x; const int nA = 136 * 9; if (L >= nA + 136) return false;
        u.e = 0; u.half = 0; u.pos0 = 0; u.cnt = 0; u.rows = nullptr;
        if (L < nA) { order_tile((int)L, 136, 9, u.pm, u.pn); u.kind = 0; u.A = H + (size_t)u.pm * 256 * D * 2; u.B = W + (size_t)u.pn * 256 * D * 2; }
        else { u.pm = 0; u.pn = (int)L - nA; u.kind = 1; u.A = W + (size_t)DQK * D * 2; u.B = H + (size_t)u.pn * 256 * D * 2; }
        return true;
    }
};
struct SchedFilt {
    const char* W3P; const char* H2P;
    __device__ __forceinline__ bool next(int i, Unit& u) const {
        const long L = (long)i * gridDim.x + blockIdx.x; if (L >= 2 * 544) return false;
        const int j = (int)L / 544, r = (int)L % 544; u.e = 0; u.half = 0; u.pos0 = 0; u.cnt = 0; u.rows = nullptr;
        int v; if (r < 512) { v = 0; u.pm = r >> 4; u.pn = r & 15; } else { v = 1; u.pm = r - 512; u.pn = 0; }
        u.kind = 2 * j + v;
        u.A = W3P + ((size_t)j * 8192 + (size_t)u.pm * 256) * 256 * 2;
        u.B = H2P + ((size_t)j * 4352 + (v ? 4096 : 0) + (size_t)u.pn * 256) * 256 * 2;
        return true;
    }
};
struct MoeTab { const LAS int* tstart; const LAS int* texp; const LAS int* cnt; };
struct SchedMoe1 {
    MoeTab tb; const char* H; const char* W13; const int* list;
    __device__ __forceinline__ bool next(int i, Unit& u) const {
        const long L = (long)i * gridDim.x + blockIdx.x; const int ntile = __builtin_amdgcn_readfirstlane(tb.tstart[NE]); if (L >= (long)ntile * 3) return false;
        int rt; order_tile((int)L, ntile, 3, rt, u.pn); u.pm = rt; u.kind = 0;
        const int e = __builtin_amdgcn_readfirstlane(tb.texp[rt]); u.e = e; u.pos0 = (rt - __builtin_amdgcn_readfirstlane(tb.tstart[e])) * 256; u.cnt = __builtin_amdgcn_readfirstlane(tb.cnt[e]); u.half = (u.cnt - u.pos0 <= 128) ? 1 : 0;
        u.rows = list + (size_t)e * LCAP + u.pos0; u.A = H; u.B = W13 + ((size_t)e * DE2 + (size_t)u.pn * 256) * D * 2; return true;
    }
};
struct SchedMoe2 {
    MoeTab tb; const char* H1; const char* W2; const int* list;
    __device__ __forceinline__ bool next(int i, Unit& u) const {
        const long L = (long)i * gridDim.x + blockIdx.x; const int ntile = __builtin_amdgcn_readfirstlane(tb.tstart[NE]); if (L >= (long)ntile * 8) return false;
        int rt; order_tile((int)L, ntile, 8, rt, u.pn); u.pm = rt; u.kind = 0;
        const int e = __builtin_amdgcn_readfirstlane(tb.texp[rt]); u.e = e; u.pos0 = (rt - __builtin_amdgcn_readfirstlane(tb.tstart[e])) * 256; u.cnt = __builtin_amdgcn_readfirstlane(tb.cnt[e]); u.half = (u.cnt - u.pos0 <= 128) ? 1 : 0;
        u.rows = list + (size_t)e * LCAP + u.pos0; u.A = H1 + (size_t)rt * 256 * DE * 2; u.B = W2 + ((size_t)e * D + (size_t)u.pn * 256) * DE * 2; return true;
    }
};
__device__ __forceinline__ void moe_table(LAS int* tstart, LAS int* texp, LAS int* cnt, const int* counters) {
    const int t = tid_fresh();
    if (t < NE) cnt[t] = counters[t];
    __syncthreads();
    if (t <= NE) { int s = 0; for (int e = 0; e < t; ++e) s += (cnt[e] + 255) >> 8; tstart[t] = s; }
    __syncthreads();
    if (t < NE) { const int s0 = tstart[t], s1 = tstart[t + 1]; for (int q = s0; q < s1; ++q) texp[q] = t; }
    __syncthreads();
}

__device__ __forceinline__ float wave_sum(float v) {
#pragma unroll
    for (int o = 32; o >= 1; o >>= 1) v += shx(v, o);
    return v;
}
__device__ __forceinline__ float silu_f(float x) { return x / (1.0f + expf(-x)); }
__device__ __forceinline__ int batch_of_row(int r) { return r < TL ? (r >> 12) : 8; }

__device__ __forceinline__ void modp_unit(const Params& p, int unit, LAS float* sl) {
    const int layer = unit / 96, rem = unit % 96, ks = rem / 6, cc = rem % 6, tid = tid_fresh();
    for (int i = tid; i < 9 * 128; i += 512) { const int cnd = i >> 7, k = ks * 128 + (i & 127); const float v = cnd < 8 ? p.c[cnd * D + k] : p.c_ctx[k]; sl[i] = silu_f(v); }
    __syncthreads();
    f32x4 acc[9];
#pragma unroll
    for (int q = 0; q < 9; ++q) acc[q] = (f32x4){0.f, 0.f, 0.f, 0.f};
    const float* w = p.mod_w + ((size_t)layer * D + (size_t)ks * 128) * D6 + cc * 2048 + tid * 4;
#pragma unroll 4
    for (int k = 0; k < 128; ++k) { const f32x4 wv = __builtin_nontemporal_load((const f32x4*)(w + (size_t)k * D6));
#pragma unroll
        for (int q = 0; q < 9; ++q) acc[q] += wv * sl[q * 128 + k]; }
    float* outp = (float*)(p.ws + WS_MODP) + ((size_t)(ks * 4 + layer) * 9) * D6 + cc * 2048 + tid * 4;
#pragma unroll
    for (int q = 0; q < 9; ++q) *(f32x4*)(outp + (size_t)q * D6) = acc[q];
    __syncthreads();
}
__device__ __forceinline__ void modr_unit(const Params& p, int unit) {
    const size_t idx = (size_t)unit * 2048 + tid_fresh() * 4; const int layer = (int)(idx / (9 * D6)), col = (int)(idx % D6);
    f32x4 s = *(const f32x4*)(p.mod_b + (size_t)layer * D6 + col);
    const float* pp = (const float*)(p.ws + WS_MODP) + idx;
#pragma unroll
    for (int ks = 0; ks < 16; ++ks) s += *(const f32x4*)(pp + (size_t)ks * 4 * 9 * D6);
    *(f32x4*)((float*)(p.ws + WS_MODS) + idx) = s;
}
__device__ __forceinline__ void tables_unit(const Params& p) {
    f32x2* tw = (f32x2*)(p.ws + WS_TW);
    for (int m = tid_fresh(); m < 8192; m += 512) { double s, c; sincospi(-(double)m / 4096.0, &s, &c); tw[m] = (f32x2){(float)c, (float)s}; }
    float* rc = (float*)(p.ws + WS_ROPE);
    for (int i = tid_fresh(); i < 1024; i += 512) { const int pos = i >> 4, q = i & 15; const float inv = powf(10000.0f, -(float)q / 16.0f); const float ang = (float)pos * inv;
        rc[i] = cosf(ang); rc[1024 + i] = sinf(ang); }
}
__device__ __forceinline__ void h2_task(const Params& p, int task) {
    const int lane = tid_fresh() & 63; const int j = task / 4352, r = task % 4352; const int v = r >= 4096, t = v ? r - 4096 : r; const int Lv = v ? 256 : 4096;
    const float tl = (float)t / (float)(Lv - 1);
    const float omega = (float)(2.0 * 3.14159265358979323846 / (double)Lv) * (float)t;
    float feat = 0.f;
    if (lane == 0) feat = tl;
    else if (lane <= 32) { const int bi = (lane - 1) & 15; const float band = 1e-4f + (float)bi * ((15.0f - 1e-4f) / 15.0f); const float a = band * omega; feat = lane <= 16 ? cosf(a) : -sinf(a); }
    const float* w1 = p.hy_f_w1 + (size_t)j * 33 * 64; const float* w2 = p.hy_f_w2 + (size_t)j * 64 * 64;
    float s = p.hy_f_b1[j * 64 + lane];
    for (int f = 0; f < 33; ++f) s += bperm_f(feat, f) * w1[f * 64 + lane];
    const float h1 = sinf(p.hy_f_freq1[j * 64 + lane] * s);
    float s2 = p.hy_f_b2[j * 64 + lane];
    for (int m = 0; m < 64; ++m) s2 += bperm_f(h1, m) * w2[m * 64 + lane];
    const float h2 = sinf(p.hy_f_freq2[j * 64 + lane] * s2);
    const h16 hi = (h16)h2; const h16 lo = (h16)(h2 - (float)hi);
    h16* row = (h16*)(p.ws + WS_H2P) + ((size_t)j * 4352 + r) * 256;
    row[lane] = hi; row[64 + lane] = hi; row[128 + lane] = lo; row[192 + lane] = lo;
}
__device__ __forceinline__ void w3p_unit(const Params& p, int unit) {
    const int j = unit >> 5, c0 = (unit & 31) * 256; const float* w3 = p.hy_f_w3 + (size_t)j * 64 * 8192; h16* dst = (h16*)(p.ws + WS_W3P) + (size_t)j * 8192 * 256;
    for (int i = tid_fresh(); i < 64 * 256; i += 512) { const int m = i >> 8, col = c0 + (i & 255); const float w = w3[(size_t)m * 8192 + col];
        const h16 hi = (h16)w; const h16 lo = (h16)(w - (float)hi); h16* row = dst + (size_t)col * 256; row[m] = hi; row[64 + m] = lo; row[128 + m] = hi; row[192 + m] = lo; }
}
__device__ __forceinline__ void rtab_unit(const Params& p, int unit) {
    const int layer = unit >> 6, c = unit & 63; h16* dst = (h16*)(p.ws + WS_RTAB + (size_t)layer * RTAB_L) + (size_t)c * 5 * 2 * 64 * 8;
    for (int i = tid_fresh(); i < 5 * 2 * 64 * 8; i += 512) { const int jj = i & 7, lane = (i >> 3) & 63, hl = (i >> 9) & 1, ct = i >> 10;
        const int k = 32 * c + 8 * (lane >> 4) + jj, col = 16 * ct + (lane & 15);
        float w = 0.f; if (col < 8) w = p.moe_wg[((size_t)layer * D + k) * 8 + col]; else if (col < 72) w = p.moe_we[((size_t)layer * D + k) * 64 + (col - 8)];
        w *= 256.0f; const h16 hi = (h16)w; const h16 lo = (h16)(w - (float)hi); dst[i] = hl ? lo : hi; }
}
template <int NW>
__device__ __forceinline__ void cvt_tile(const float* src, int ldn, int k0, int n0, h16* dst, int ldk, int mode, LAS float* T) {
    constexpr int P = NW + 1; const int tid = tid_fresh();
#pragma unroll
    for (int ps = 0; ps < 64 * NW / 4 / 512; ++ps) { const int idx = ps * 512 + tid, k = idx / (NW / 4), n4 = idx % (NW / 4);
        const f32x4 v = __builtin_nontemporal_load((const f32x4*)(src + (size_t)(k0 + k) * ldn + n0 + 4 * n4)); LAS float* q = T + k * P + 4 * n4; q[0] = v[0]; q[1] = v[1]; q[2] = v[2]; q[3] = v[3]; }
    __syncthreads();
#pragma unroll
    for (int ps = 0; ps < NW * 8 / 512; ++ps) { const int item = ps * 512 + tid, kc = item & 7, n = item >> 3; f16x8 w;
#pragma unroll
        for (int i = 0; i < 8; ++i) w[i] = (h16)T[(8 * kc + i) * P + n];
        const int ng = n0 + n; const int row = mode == 0 ? ng : (8 * (ng >> 2) + (ng & 3) + (mode == 2 ? 4 : 0));
        *(f16x8*)(dst + (size_t)row * ldk + k0 + 8 * kc) = w; }
    __syncthreads();
}
__device__ __forceinline__ void cvt_dense_unit(const Params& p, int unit, LAS float* T) {
    const float* src; h16* dst; int nt, N;
    if (unit < 1536) { src = p.hy_w_in; dst = (h16*)(p.ws + WS_WIN); nt = 24; N = D3; }
    else if (unit < 2048) { unit -= 1536; src = p.hy_w_out; dst = (h16*)(p.ws + WS_WOUT); nt = 8; N = D; }
    else if (unit < 2688) { unit -= 2048; src = p.at_w_qkv; dst = (h16*)(p.ws + WS_WQKV); nt = 10; N = DQKV; }
    else { unit -= 2688; src = p.at_w_o; dst = (h16*)(p.ws + WS_WO); nt = 8; N = D; }
    const int j = unit / (32 * nt), r = unit % (32 * nt), kt = r / nt, ntile = r % nt;
    cvt_tile<256>(src + (size_t)j * D * N, N, kt * 64, ntile * 256, dst + (size_t)j * N * D, D, 0, T);
}
constexpr int CVT_DENSE_UNITS = 3200;
__device__ __forceinline__ void cvt_moe_unit(const Params& p, int layer, int unit, LAS float* T) {
    if (unit < 12288) { const int which = unit >= 6144; if (which) unit -= 6144; const int e = unit / 96, r = unit % 96, kt = r / 3, ntile = r % 3;
        const float* src = (which ? p.moe_w3 : p.moe_w1) + ((size_t)layer * NE + e) * D * DE;
        cvt_tile<128>(src, DE, kt * 64, ntile * 128, (h16*)(p.ws + WS_W13) + (size_t)e * DE2 * D, D, which ? 2 : 1, T); }
    else { unit -= 12288; const int e = unit / 48, r = unit % 48, kt = r / 8, ntile = r % 8;
        const float* src = p.moe_w2 + ((size_t)layer * NE + e) * DE * D;
        cvt_tile<256>(src, D, kt * 64, ntile * 256, (h16*)(p.ws + WS_W2) + (size_t)e * D * DE, DE, 0, T); }
}
constexpr int CVT_MOE_UNITS = 15360;
struct CvtD { const float* src; h16* dst; int mode; };
__device__ __forceinline__ CvtD cvt13_desc(const Params& p, int layer, int unit) {
    const int which = unit >= 6144; if (which) unit -= 6144; const int e = unit / 96, r = unit % 96, kt = r / 3, ntile = r % 3;
    CvtD d; d.src = (which ? p.moe_w3 : p.moe_w1) + ((size_t)layer * NE + e) * D * DE + (size_t)(kt * 64) * DE + ntile * 128;
    d.dst = (h16*)(p.ws + WS_W13) + (size_t)e * DE2 * D + kt * 64; d.mode = (which ? 4 : 0) + 8 * (256 * ntile); return d;
}
__device__ __forceinline__ void cvt13_load(const CvtD& d, f32x4 (&v)[4], int tid) {
#pragma unroll
    for (int ps = 0; ps < 4; ++ps) { const int idx = ps * 512 + tid, k = idx >> 5, n4 = idx & 31; v[ps] = __builtin_nontemporal_load((const f32x4*)(d.src + (size_t)k * DE + 4 * n4)); }
}
__device__ __forceinline__ void cvt13_store(const CvtD& d, const f32x4 (&v)[4], LAS float* T, int tid) {
    constexpr int P = 129;
#pragma unroll
    for (int ps = 0; ps < 4; ++ps) { const int idx = ps * 512 + tid, k = idx >> 5, n4 = idx & 31; LAS float* q = T + k * P + 4 * n4; q[0] = v[ps][0]; q[1] = v[ps][1]; q[2] = v[ps][2]; q[3] = v[ps][3]; }
    __syncthreads();
    const int w3off = d.mode & 7, rg0 = d.mode >> 3;
#pragma unroll
    for (int ps = 0; ps < 2; ++ps) { const int item = ps * 512 + tid, kc = item & 7, n = item >> 3; f16x8 w;
#pragma unroll
        for (int i = 0; i < 8; ++i) w[i] = (h16)T[(8 * kc + i) * P + n];
        const int row = rg0 + 8 * (n >> 2) + (n & 3) + w3off;
        *(f16x8*)(d.dst + (size_t)row * D + 8 * kc) = w; }
    __syncthreads();
}
__device__ __forceinline__ void cvt_moe_share(const Params& p, int layer, int u0, int n, int stride, LAS float* T) {
    const int tid = tid_fresh(); const int n13 = n < 12288 ? n : 12288;
    int u = u0;
    if (u < n13) {
        CvtD dA = cvt13_desc(p, layer, u), dB = dA, dC = dA; f32x4 vA[4], vB[4], vC[4];
        cvt13_load(dA, vA, tid);
        if (u + stride < n13) { dB = cvt13_desc(p, layer, u + stride); cvt13_load(dB, vB, tid); }
        for (;;) {
            if (u + 2 * stride < n13) { dC = cvt13_desc(p, layer, u + 2 * stride); cvt13_load(dC, vC, tid); }
            cvt13_store(dA, vA, T, tid); u += stride; if (u >= n13) break;
            if (u + 2 * stride < n13) { dA = cvt13_desc(p, layer, u + 2 * stride); cvt13_load(dA, vA, tid); }
            cvt13_store(dB, vB, T, tid); u += stride; if (u >= n13) break;
            if (u + 2 * stride < n13) { dB = cvt13_desc(p, layer, u + 2 * stride); cvt13_load(dB, vB, tid); }
            cvt13_store(dC, vC, T, tid); u += stride; if (u >= n13) break;
        }
    }
    for (; u < n; u += stride) cvt_moe_unit(p, layer, u, T);
}

template <int NR, bool FINAL>
__device__ __forceinline__ void n1_rows(const Params& p, int layer, int r0, int rstride, int lane, h16* xout) {
    const h16* xres = (const h16*)(p.ws + WS_XRES); h16* hb = (h16*)(p.ws + WS_HBUF); const h16* yc = (const h16*)(p.ws + WS_YC); const float* mods = (const float*)(p.ws + WS_MODS);
    f32x4 v[NR][8]; f16x4 xh[NR][8], ya[NR][8], yb[NR][8];
    const bool comb = FINAL || layer > 0; const int lprev = FINAL ? 3 : layer - 1;
#pragma unroll
    for (int q = 0; q < NR; ++q) { const int r = r0 + q * rstride;
        if (!comb) { const float* src = r < TL ? p.x + (size_t)r * D : p.ctx + (size_t)(r - TL) * D;
#pragma unroll
            for (int c = 0; c < 8; ++c) v[q][c] = __builtin_nontemporal_load((const f32x4*)(src + c * 256 + lane * 4)); }
        else { const h16* src = xres + (size_t)r * D; const h16* y0 = yc + (size_t)(2 * r) * D; const h16* y1 = y0 + D;
#pragma unroll
            for (int c = 0; c < 8; ++c) { xh[q][c] = __builtin_nontemporal_load((const f16x4*)(src + c * 256 + lane * 4)); ya[q][c] = __builtin_nontemporal_load((const f16x4*)(y0 + c * 256 + lane * 4)); yb[q][c] = __builtin_nontemporal_load((const f16x4*)(y1 + c * 256 + lane * 4)); } } }
#pragma unroll
    for (int q = 0; q < NR; ++q) { const int r = r0 + q * rstride; const int b = batch_of_row(r);
        if (comb) { const float* g2 = mods + ((size_t)(lprev * 9 + b) * 6 + 5) * D;
#pragma unroll
            for (int c = 0; c < 8; ++c) { const f32x4 g = *(const f32x4*)(g2 + c * 256 + lane * 4);
#pragma unroll
                for (int i = 0; i < 4; ++i) v[q][c][i] = (float)xh[q][c][i] + g[i] * ((float)ya[q][c][i] + (float)yb[q][c][i]); } }
        float ss = 0.f;
#pragma unroll
        for (int c = 0; c < 8; ++c) { if (!FINAL) { f16x4 w; w[0] = (h16)v[q][c][0]; w[1] = (h16)v[q][c][1]; w[2] = (h16)v[q][c][2]; w[3] = (h16)v[q][c][3]; __builtin_nontemporal_store(w, (f16x4*)(xout + (size_t)r * D + c * 256 + lane * 4));   } ss += v[q][c][0] * v[q][c][0] + v[q][c][1] * v[q][c][1] + v[q][c][2] * v[q][c][2] + v[q][c][3] * v[q][c][3]; }
        ss = wave_sum(ss); const float rs = 1.0f / sqrtf(ss * (1.0f / D) + EPS);
        if (FINAL) {
#pragma unroll
            for (int c = 0; c < 8; ++c) { const int col = c * 256 + lane * 4; const f32x4 g = *(const f32x4*)(p.final_gain + col); *(f32x4*)(p.out + (size_t)r * D + col) = v[q][c] * rs * g; }
        } else {
            const float* sh = mods + ((size_t)(layer * 9 + b) * 6 + 0) * D; const float* sc = sh + D;
#pragma unroll
            for (int c = 0; c < 8; ++c) { const int col = c * 256 + lane * 4; const f32x4 s0 = *(const f32x4*)(sh + col), s1 = *(const f32x4*)(sc + col); f16x4 w;
#pragma unroll
                for (int i = 0; i < 4; ++i) w[i] = (h16)(v[q][c][i] * rs * (1.0f + s1[i]) + s0[i]);
                *(f16x4*)(hb + (size_t)r * D + col) = w; }
        } }
}
template <bool FINAL>
__device__ __forceinline__ void n1_any(const Params& p, int layer, h16* xout) {
    const int tid = tid_fresh(), lane = tid & 63, gw = blockIdx.x * 8 + __builtin_amdgcn_readfirstlane(tid >> 6), nw = gridDim.x * 8; const int nrow = FINAL ? TL : TT;
    int r = gw;
    for (; r + nw < nrow; r += 2 * nw) n1_rows<2, FINAL>(p, layer, r, nw, lane, xout);
    if (r < nrow) n1_rows<1, FINAL>(p, layer, r, nw, lane, xout);
}
__device__ __forceinline__ void n1_phase(const Params& p, int layer, h16* xout) { n1_any<false>(p, layer, xout); }
__device__ __forceinline__ void final_phase(const Params& p) { n1_any<true>(p, 0, nullptr); }
constexpr int N2_CH = 4;
constexpr int N2_SLOT = N2_CH * 10 * 1024;
constexpr int N2_XT = 2 * N2_SLOT;
constexpr int N2_SC = N2_XT + 8 * 4096;
#ifndef PROBE_N2VAR
#define PROBE_N2VAR 0
#endif
__device__ __forceinline__ void n2_phase(const Params& p, int layer, LAS unsigned char* lds, int ctr_shadow) {
    const bool pv_tail = !(ctr_shadow && (PROBE_N2VAR & 1)), pv_store = !(ctr_shadow && (PROBE_N2VAR & 2)), pv_mma = !(ctr_shadow && (PROBE_N2VAR & 4));
    const int tid = tid_fresh(), lane = tid & 63, wv = __builtin_amdgcn_readfirstlane(tid >> 6), r16 = lane & 15, kg = lane >> 4;
    const int lrow = lane >> 3, lchk = lane & 7;
    const h16* xres = (const h16*)(p.ws + WS_XRES); h16* hb = (h16*)(p.ws + WS_HBUF); const float* mods = (const float*)(p.ws + WS_MODS);
    const char* rtb = p.ws + WS_RTAB + (size_t)layer * RTAB_L; const float* ssq = (const float*)(p.ws + WS_SSQ);
    int* counters = (int*)(p.ws + WS_CTL) + CTL_CNT + (layer + (ctr_shadow ? 4 : 0)) * NE; int* list = (int*)(p.ws + WS_LIST); float* gate = (float*)(p.ws + WS_GATE);
    LAS float* scr = (LAS float*)lds + wv * (16 * 80);
    LAS float* scl = (LAS float*)(lds + N2_SC); LAS float* shl = scl + D;
    LAS int* hist = (LAS int*)(lds + LDS_MISC); LAS int* hbase = hist + NE;
    LAS unsigned char* xt = lds + N2_XT + wv * 4096;
    const int hw_off0 = r16 * 128 + 16 * (kg ^ (r16 & 7)), hw_off1 = r16 * 128 + 16 * ((4 + kg) ^ (r16 & 7));
    const int hr_off = lrow * 128 + 16 * (lchk ^ (lrow & 7));
    const int ntask = (layer == NLAYER - 1 ? TL : TT) / 16, nfull = (int)gridDim.x * 8;
#pragma unroll 1
    for (int round = 0; round < 2; ++round) {
        const int nrem = ntask - nfull;
        if (round == 1 && (int)blockIdx.x >= nrem) break;
        const int task = round == 0 ? (int)blockIdx.x * 8 + wv : nfull + (int)blockIdx.x;
        const bool active = round == 0 ? (task < ntask) : true;
        const int trow = active ? task * 16 : 0;
        const int b = batch_of_row(trow);
        const h16* xg = xres + (size_t)(trow + r16) * D + 8 * kg;
        h16* hg0 = hb + (size_t)(trow + lrow) * D + lchk * 8; h16* hg1 = hg0 + (size_t)8 * D;
        float rs;
        { const float* sp = ssq + (size_t)(trow + r16) * 32; float t = 0.f;
#pragma unroll
            for (int q = 0; q < 8; ++q) { const f32x4 v = *(const f32x4*)(sp + 4 * q); t += (v[0] + v[1]) + (v[2] + v[3]); }
            rs = 1.0f / sqrtf(t * (1.0f / D) + EPS); }
        f32x4 acc[5];
#pragma unroll
        for (int ct = 0; ct < 5; ++ct) acc[ct] = (f32x4){0.f, 0.f, 0.f, 0.f};
        __syncthreads();
        if (tid < NE) hist[tid] = 0;
        { const float* scb = mods + ((size_t)(layer * 9 + b) * 6 + 4) * D; *(LAS f32x4*)(scl + tid * 4) = *(const f32x4*)(scb + tid * 4); *(LAS f32x4*)(shl + tid * 4) = *(const f32x4*)(scb - D + tid * 4); }
        if (round == 0) {
        f16x8 bq[5];
#pragma unroll
        for (int q = 0; q < 5; ++q) bq[q] = *(const f16x8*)(rtb + (size_t)(5 * wv + q) * 1024 + lane * 16);
#pragma unroll
        for (int q = 0; q < 5; ++q) *(LAS f16x8*)(lds + (5 * wv + q) * 1024 + lane * 16) = bq[q];
#pragma unroll
        for (int q = 0; q < 5; ++q) bq[q] = *(const f16x8*)(rtb + (size_t)N2_SLOT + (size_t)(5 * wv + q) * 1024 + lane * 16);
        f16x8 x0[N2_CH], x1[N2_CH], x2[N2_CH];
#pragma unroll
        for (int s2 = 0; s2 < N2_CH; ++s2) { x0[s2] = __builtin_nontemporal_load((const f16x8*)(xg + 32 * s2)); x1[s2] = __builtin_nontemporal_load((const f16x8*)(xg + 32 * (N2_CH + s2))); }
#define N2_CHUNK(XC, XL, CH) do { const int ch = (CH); \
            __syncthreads(); \
            const int nx2 = (ch + 2 < 64 / N2_CH) ? ch + 2 : ch; \
            {   LAS unsigned char* dst = lds + ((ch + 1) & 1) * N2_SLOT; \
 _Pragma("unroll") \
                for (int q = 0; q < 5; ++q) *(LAS f16x8*)(dst + (5 * wv + q) * 1024 + lane * 16) = bq[q]; } \
            {   const char* src = rtb + (size_t)nx2 * N2_SLOT; \
 _Pragma("unroll") \
                for (int q = 0; q < 5; ++q) bq[q] = *(const f16x8*)(src + (size_t)(5 * wv + q) * 1024 + lane * 16); } \
 _Pragma("unroll") \
            for (int s2 = 0; s2 < N2_CH; ++s2) { const int ko = 32 * (nx2 * N2_CH + s2); XL[s2] = __builtin_nontemporal_load((const f16x8*)(xg + ko)); } \
            const LAS unsigned char* bs = lds + (ch & 1) * N2_SLOT + lane * 16; \
 _Pragma("unroll") \
            for (int pp = 0; pp < N2_CH / 2; ++pp) { \
                f16x8 hk[2]; \
 _Pragma("unroll") \
                for (int sp = 0; sp < 2; ++sp) { \
                    const int s2 = 2 * pp + sp; const int ko = 32 * (ch * N2_CH + s2) + 8 * kg; \
                    const f32x4 c0 = *(const LAS f32x4*)(scl + ko), c1 = *(const LAS f32x4*)(scl + ko + 4), h0 = *(const LAS f32x4*)(shl + ko), h1 = *(const LAS f32x4*)(shl + ko + 4); \
                    f16x8 hi, lo; \
 _Pragma("unroll") \
                    for (int i = 0; i < 4; ++i) { const float a0 = (float)XC[s2][i] * rs * (1.0f + c0[i]) + h0[i], a1 = (float)XC[s2][4 + i] * rs * (1.0f + c1[i]) + h1[i]; \
                        hi[i] = (h16)a0; lo[i] = (h16)(a0 - (float)hi[i]); hi[4 + i] = (h16)a1; lo[4 + i] = (h16)(a1 - (float)hi[4 + i]); } \
                    hk[sp] = hi; \
                    if (pv_mma) \
 _Pragma("unroll") \
                    for (int ct = 0; ct < 5; ++ct) { const f16x8 whi = *(const LAS f16x8*)(bs + (s2 * 10 + ct * 2 + 0) * 1024), wlo = *(const LAS f16x8*)(bs + (s2 * 10 + ct * 2 + 1) * 1024); \
                        acc[ct] = __builtin_amdgcn_mfma_f32_16x16x32_f16(hi, whi, acc[ct], 0, 0, 0); \
                        acc[ct] = __builtin_amdgcn_mfma_f32_16x16x32_f16(hi, wlo, acc[ct], 0, 0, 0); \
                        acc[ct] = __builtin_amdgcn_mfma_f32_16x16x32_f16(lo, whi, acc[ct], 0, 0, 0); } \
                } \
                *(LAS f16x8*)(xt + hw_off0) = hk[0]; *(LAS f16x8*)(xt + hw_off1) = hk[1]; \
                const f16x8 o0 = *(const LAS f16x8*)(xt + hr_off), o1 = *(const LAS f16x8*)(xt + 1024 + hr_off); \
                if (active && pv_store) { const int ho = 32 * (ch * N2_CH + 2 * pp); *(f16x8*)(hg0 + ho) = o0; *(f16x8*)(hg1 + ho) = o1; } \
            } \
        } while (0)
#pragma unroll 1
        for (int c3 = 0; c3 < 15; c3 += 3) { N2_CHUNK(x0, x2, c3); N2_CHUNK(x1, x0, c3 + 1); N2_CHUNK(x2, x1, c3 + 2); }
        N2_CHUNK(x0, x2, 15);
#undef N2_CHUNK
        } else {
            const char* rtw = rtb + (size_t)(8 * wv) * 10240; const int kb = 256 * wv;
            unsigned loff = (unsigned)lane * 16u; asm volatile("" : "+v"(loff));
            f16x8 bb[10];
            f16x8 xa[2][2];
#pragma unroll
            for (int sp = 0; sp < 2; ++sp) xa[0][sp] = __builtin_nontemporal_load((const f16x8*)(xg + kb + 32 * sp));
#pragma unroll
            for (int pp = 0; pp < 4; ++pp) {
                if (pp < 3) {
#pragma unroll
                    for (int sp = 0; sp < 2; ++sp) xa[(pp + 1) & 1][sp] = __builtin_nontemporal_load((const f16x8*)(xg + kb + 32 * (2 * pp + 2 + sp))); }
                f16x8 hk[2];
#pragma unroll
                for (int sp = 0; sp < 2; ++sp) {
                    const int st = 2 * pp + sp; const int ko = kb + 32 * st + 8 * kg;
#pragma unroll
                    for (int q = 0; q < 10; ++q) bb[q] = *(const f16x8*)(rtw + (size_t)(st * 10 + q) * 1024 + loff);
                    asm volatile("" ::: "memory");
                    const f32x4 c0 = *(const LAS f32x4*)(scl + ko), c1 = *(const LAS f32x4*)(scl + ko + 4), h0 = *(const LAS f32x4*)(shl + ko), h1 = *(const LAS f32x4*)(shl + ko + 4);
                    f16x8 hi, lo;
#pragma unroll
                    for (int i = 0; i < 4; ++i) { const float a0 = (float)xa[pp & 1][sp][i] * rs * (1.0f + c0[i]) + h0[i], a1 = (float)xa[pp & 1][sp][4 + i] * rs * (1.0f + c1[i]) + h1[i];
                        hi[i] = (h16)a0; lo[i] = (h16)(a0 - (float)hi[i]); hi[4 + i] = (h16)a1; lo[4 + i] = (h16)(a1 - (float)hi[4 + i]); }
                    hk[sp] = hi;
#pragma unroll
                    for (int ct = 0; ct < 5; ++ct) {
                        acc[ct] = __builtin_amdgcn_mfma_f32_16x16x32_f16(hi, bb[2 * ct], acc[ct], 0, 0, 0);
                        acc[ct] = __builtin_amdgcn_mfma_f32_16x16x32_f16(hi, bb[2 * ct + 1], acc[ct], 0, 0, 0);
                        acc[ct] = __builtin_amdgcn_mfma_f32_16x16x32_f16(lo, bb[2 * ct], acc[ct], 0, 0, 0); }
                }
                *(LAS f16x8*)(xt + hw_off0) = hk[0]; *(LAS f16x8*)(xt + hw_off1) = hk[1];
                const f16x8 o0 = *(const LAS f16x8*)(xt + hr_off), o1 = *(const LAS f16x8*)(xt + 1024 + hr_off);
                if (pv_store) { const int ho = kb + 64 * pp; *(f16x8*)(hg0 + ho) = o0; *(f16x8*)(hg1 + ho) = o1; }
            }
        }
        __syncthreads();
#pragma unroll
        for (int ct = 0; ct < 5; ++ct)
#pragma unroll
            for (int i = 0; i < 4; ++i) scr[(4 * kg + i) * 80 + 16 * ct + r16] = acc[ct][i] * (1.0f / 256.0f);
        asm volatile("s_waitcnt lgkmcnt(0)" ::: "memory");
        int ea = 0, eb = 0, ra = 0, rb = 0; float g1v = 0.f, g2v = 0.f; const bool tok_lane = (round == 0 ? active : wv == 0) && lane < 16 && pv_tail;
        const int nparts = round == 0 ? 1 : 8;
        if (tok_lane) {
            const LAS float* lgr = scr + lane * 80;
#define N2_LG(c) ({ float _t = lgr[(c)]; for (int _w = 1; _w < nparts; ++_w) _t += lgr[_w * 1280 + (c)]; _t; })
            float gmax = -3.0e38f; int gsel = 0; float gl[8];
#pragma unroll
            for (int g = 0; g < 8; ++g) { gl[g] = N2_LG(g) + p.moe_bg[layer * 8 + g]; if (gl[g] > gmax) { gmax = gl[g]; gsel = g; } }
            float gz = 0.f;
#pragma unroll
            for (int g = 0; g < 8; ++g) gz += expf(gl[g] - gmax);
            const float pg = 1.0f / gz;
            float f1 = -3.0e38f, f2 = -3.0e38f; int i1 = 0, i2 = 0;
            for (int q = 0; q < 8; ++q) { const float f = N2_LG(8 + gsel * 8 + q) + p.moe_be[layer * 64 + gsel * 8 + q];
                if (f > f1) { f2 = f1; i2 = i1; f1 = f; i1 = q; } else if (f > f2) { f2 = f; i2 = q; } }
            const float e2 = expf(f2 - f1); g1v = pg / (1.0f + e2); g2v = pg * e2 / (1.0f + e2);
            ea = gsel * 8 + i1; eb = gsel * 8 + i2;
#undef N2_LG
            ra = __hip_atomic_fetch_add(hist + ea, 1, __ATOMIC_RELAXED, __HIP_MEMORY_SCOPE_WORKGROUP); rb = __hip_atomic_fetch_add(hist + eb, 1, __ATOMIC_RELAXED, __HIP_MEMORY_SCOPE_WORKGROUP);
        }
        __syncthreads();
        { const int t2 = tid_fresh(); if (t2 < NE && pv_tail) { const int n = hist[t2]; hbase[t2] = n ? atomicAdd(&counters[t2], n) : 0; } }
        __syncthreads();
        if (tok_lane) { const int tok = task * 16 + lane; const size_t sa = (size_t)ea * LCAP + hbase[ea] + ra, sb = (size_t)eb * LCAP + hbase[eb] + rb;
            list[sa] = 2 * tok; gate[sa] = g1v; list[sb] = 2 * tok + 1; gate[sb] = g2v; }
    }
}
__device__ __forceinline__ void transpose_phase(const Params& p, LAS h16* T) {
    const h16* zt = (const h16*)(p.ws + WS_ZT); h16* z = (h16*)(p.ws + WS_HBUF); const int tid = tid_fresh();
    const int ntile = (D / 64) * (TT / 64);
    for (int tile = blockIdx.x; tile < ntile; tile += gridDim.x) {
        const int td = tile % (D / 64), tt = tile / (D / 64); const int d0 = td * 64, t0 = tt * 64;
        { const int dr = tid >> 3, tc = (tid & 7) * 8; const f16x8 v = *(const f16x8*)(zt + (size_t)(d0 + dr) * TT + t0 + tc);
#pragma unroll
            for (int i = 0; i < 8; ++i) T[(tc + i) * 66 + dr] = v[i]; }
        __syncthreads();
        { const int tr = tid >> 3, dc = (tid & 7) * 8; f16x8 v;
#pragma unroll
            for (int i = 0; i < 8; ++i) v[i] = T[tr * 66 + dc + i];
            *(f16x8*)(z + (size_t)(t0 + tr) * D + d0 + dc) = v; }
        __syncthreads();
    }
}

__device__ __forceinline__ f32x2 cmul(const f32x2 a, const f32x2 b) { return (f32x2){a.x * b.x - a.y * b.y, a.x * b.y + a.y * b.x}; }
__device__ __forceinline__ f32x2 cmulc(const f32x2 a, const f32x2 b) { return (f32x2){a.x * b.x + a.y * b.y, a.y * b.x - a.x * b.y}; }
__device__ __forceinline__ f32x2 cconj(const f32x2 a) { return (f32x2){a.x, -a.y}; }
template <bool INV> __device__ __forceinline__ f32x2 mul_mi(const f32x2 a) { return INV ? (f32x2){-a.y, a.x} : (f32x2){a.y, -a.x}; }
template <bool INV> __device__ __forceinline__ void dft4(f32x2& a, f32x2& b, f32x2& c, f32x2& d) {
    const f32x2 s0 = a + c, s1 = a - c, s2 = b + d, s3 = mul_mi<INV>(b - d);
    a = s0 + s2; b = s1 + s3; c = s0 - s2; d = s1 - s3;
}
template <bool INV, int M> __device__ __forceinline__ f32x2 w16mul(const f32x2 a) {
    constexpr float C1 = 0.92387953251128674f, S1 = 0.38268343236508977f, R = 0.70710678118654752f;
    constexpr float cr = (M == 0) ? 1.f : (M == 1) ? C1 : (M == 2) ? R : (M == 3) ? S1 : (M == 4) ? 0.f : (M == 6) ? -R :   -C1;
    constexpr float ci0 = (M == 0) ? 0.f : (M == 1) ? -S1 : (M == 2) ? -R : (M == 3) ? -C1 : (M == 4) ? -1.f : (M == 6) ? -R :   S1;
    constexpr float ci = INV ? -ci0 : ci0;
    return (f32x2){a.x * cr - a.y * ci, a.x * ci + a.y * cr};
}
template <bool INV> __device__ __forceinline__ void dft16(f32x2 (&v)[16]) {
#pragma unroll
    for (int n2 = 0; n2 < 4; ++n2) dft4<INV>(v[n2], v[4 + n2], v[8 + n2], v[12 + n2]);
    v[5] = w16mul<INV, 1>(v[5]); v[6] = w16mul<INV, 2>(v[6]); v[7] = w16mul<INV, 3>(v[7]);
    v[9] = w16mul<INV, 2>(v[9]); v[10] = w16mul<INV, 4>(v[10]); v[11] = w16mul<INV, 6>(v[11]);
    v[13] = w16mul<INV, 3>(v[13]); v[14] = w16mul<INV, 6>(v[14]); v[15] = w16mul<INV, 9>(v[15]);
#pragma unroll
    for (int k1 = 0; k1 < 4; ++k1) dft4<INV>(v[4 * k1], v[4 * k1 + 1], v[4 * k1 + 2], v[4 * k1 + 3]);
    f32x2 t;
    t = v[1]; v[1] = v[4]; v[4] = t; t = v[2]; v[2] = v[8]; v[8] = t; t = v[3]; v[3] = v[12]; v[12] = t;
    t = v[6]; v[6] = v[9]; v[9] = t; t = v[7]; v[7] = v[13]; v[13] = t; t = v[11]; v[11] = v[14]; v[14] = t;
}
__device__ __forceinline__ int fphys(int i) { return i + (i >> 4); }
__device__ __forceinline__ f32x2 w32c(int j) {
    constexpr float c[16] = {1.f, 0.98078528040323043f, 0.92387953251128674f, 0.83146961230254524f, 0.70710678118654752f, 0.55557023301960218f, 0.38268343236508977f, 0.19509032201612825f,
                             0.f, -0.19509032201612825f, -0.38268343236508977f, -0.55557023301960218f, -0.70710678118654752f, -0.83146961230254524f, -0.92387953251128674f, -0.98078528040323043f};
    constexpr float s[16] = {0.f, 0.19509032201612825f, 0.38268343236508977f, 0.55557023301960218f, 0.70710678118654752f, 0.83146961230254524f, 0.92387953251128674f, 0.98078528040323043f,
                             1.f, 0.98078528040323043f, 0.92387953251128674f, 0.83146961230254524f, 0.70710678118654752f, 0.55557023301960218f, 0.38268343236508977f, 0.19509032201612825f};
    return (f32x2){c[j], -s[j]};
}
template <int S>
__device__ __forceinline__ void fft_fwd0(const f32x2 (&xe)[16], const f32x2 (&xo)[16], LAS f32x2* E, LAS f32x2* O, int t, const LAS f32x2* tw) {
    const f32x2 u = tw[t * (256 / S)]; const f32x2 u2 = cmul(u, u);
    f32x2 y[16];
#pragma unroll
    for (int j = 0; j < 16; ++j) y[j] = xe[j];
    dft16<false>(y);
    constexpr int QS = S + S / 16;
    LAS f32x2* Eb = E + fphys(t); LAS f32x2* Ob = O + fphys(t);
    f32x2 pw = u2; Eb[0] = y[0];
#pragma unroll
    for (int q = 1; q < 16; ++q) { Eb[QS * q] = cmul(y[q], pw); pw = cmul(pw, u2); }
#pragma unroll
    for (int j = 0; j < 16; ++j) y[j] = cmul(xo[j], w32c(j));
    dft16<false>(y);
    pw = u;
#pragma unroll
    for (int q = 0; q < 16; ++q) { Ob[QS * q] = cmul(y[q], pw); pw = cmul(pw, u2); }
}
template <bool INV> __device__ __forceinline__ void fft_pass1(LAS f32x2* A, int tau, const LAS f32x2* tw) {
    const int i = tau & 15, base = (tau >> 4) << 8; const f32x2 u0 = tw[32 * i]; const f32x2 u = INV ? cconj(u0) : u0;
    f32x2 y[16]; LAS f32x2* Ab = A + fphys(base + i);
#pragma unroll
    for (int j = 0; j < 16; ++j) y[j] = Ab[17 * j];
    if (INV) { f32x2 pw = u;
#pragma unroll
        for (int q = 1; q < 16; ++q) { y[q] = cmul(y[q], pw); pw = cmul(pw, u); } }
    dft16<INV>(y);
    if (!INV) { f32x2 pw = u;
#pragma unroll
        for (int q = 1; q < 16; ++q) { y[q] = cmul(y[q], pw); pw = cmul(pw, u); } }
#pragma unroll
    for (int j = 0; j < 16; ++j) Ab[17 * j] = y[j];
}
template <bool INV> __device__ __forceinline__ void fft_pass1_pair(LAS f32x2* A, LAS f32x2* B, int tau, const LAS f32x2* tw) {
    const int i = tau & 15, base = (tau >> 4) << 8; const f32x2 u0 = tw[32 * i]; const f32x2 u = INV ? cconj(u0) : u0;
    f32x2 y[16], z[16]; LAS f32x2* Ab = A + fphys(base + i); LAS f32x2* Bb = B + fphys(base + i);
#pragma unroll
    for (int j = 0; j < 16; ++j) y[j] = Ab[17 * j];
#pragma unroll
    for (int j = 0; j < 16; ++j) z[j] = Bb[17 * j];
    f32x2 pwr[16]; pwr[1] = u;
#pragma unroll
    for (int q = 2; q < 16; ++q) pwr[q] = cmul(pwr[q - 1], u);
    if (INV) {
#pragma unroll
        for (int q = 1; q < 16; ++q) y[q] = cmul(y[q], pwr[q]); }
    dft16<INV>(y);
    if (!INV) {
#pragma unroll
        for (int q = 1; q < 16; ++q) y[q] = cmul(y[q], pwr[q]); }
#pragma unroll
    for (int j = 0; j < 16; ++j) Ab[17 * j] = y[j];
    if (INV) {
#pragma unroll
        for (int q = 1; q < 16; ++q) z[q] = cmul(z[q], pwr[q]); }
    dft16<INV>(z);
    if (!INV) {
#pragma unroll
        for (int q = 1; q < 16; ++q) z[q] = cmul(z[q], pwr[q]); }
#pragma unroll
    for (int j = 0; j < 16; ++j) Bb[17 * j] = z[j];
}
__device__ __forceinline__ void fft_fwd2(const LAS f32x2* A, int t, f32x2 (&y)[16]) {
#pragma unroll
    for (int j = 0; j < 16; ++j) y[j] = A[17 * t + j];
    dft16<false>(y);
}
template <int NT> __device__ __forceinline__ void kf_load(const f32x2* kf, f32x4 (&k)[8]) {
#pragma unroll
    for (int j = 0; j < 8; ++j) k[j] = *(const f32x4*)(kf + j * (2 * NT));
}
__device__ __forceinline__ void fft_mid(LAS f32x2* A, int t, const f32x4 (&k)[8]) {
    f32x2 y[16];
    fft_fwd2(A, t, y);
#pragma unroll
    for (int j = 0; j < 8; ++j) { y[2 * j] = cmul(y[2 * j], (f32x2){k[j][0], k[j][1]}); y[2 * j + 1] = cmul(y[2 * j + 1], (f32x2){k[j][2], k[j][3]}); }
    dft16<true>(y);
#pragma unroll
    for (int j = 0; j < 16; ++j) A[17 * t + j] = y[j];
}
template <int S>
__device__ __forceinline__ void fft_inv0(const LAS f32x2* E, const LAS f32x2* O, int t, const LAS f32x2* tw, f32x2 (&out)[16]) {
    const f32x2 u = tw[t * (256 / S)]; const f32x2 u2 = cmul(u, u);
    f32x2 y[16];
    constexpr int QS = S + S / 16;
    const LAS f32x2* Eb = E + fphys(t); const LAS f32x2* Ob = O + fphys(t);
    f32x2 pw = u2; y[0] = Eb[0];
#pragma unroll
    for (int q = 1; q < 16; ++q) { y[q] = cmulc(Eb[QS * q], pw); pw = cmul(pw, u2); }
    dft16<true>(y);
#pragma unroll
    for (int j = 0; j < 16; ++j) out[j] = y[j];
    pw = u;
#pragma unroll
    for (int q = 0; q < 16; ++q) { y[q] = cmulc(Ob[QS * q], pw); pw = cmul(pw, u2); }
    dft16<true>(y);
#pragma unroll
    for (int j = 0; j < 16; ++j) out[j] += cmulc(y[j], w32c(j));
}
__device__ __forceinline__ float hy_absdelta(int d) { return fabsf(-3.0701134573253943f + (-15.350567286626973f + 3.0701134573253943f) * ((float)d / 2047.0f)); }

__device__ __forceinline__ void filt_fft_phase(const Params& p, LAS unsigned char* lds) {
    const int tid = tid_fresh();
    LAS f32x2* tw = (LAS f32x2*)(lds + LDS_MISC + 1024);
    tw[tid] = ((const f32x2*)(p.ws + WS_TW))[tid];
    __syncthreads();
    {
        const int grp = tid >> 8, tau = tid & 255; constexpr int KFQ = 512;
        LAS f32x2* E = (LAS f32x2*)(lds + grp * 69632); LAS f32x2* O = E + 4352; LAS float* red = (LAS float*)(lds + LDS_MISC) + grp * 8;
        float tlo[16], thi[16];
#define FILT_TAPS(pbx) do { const int d_ = (pbx) & 2047, n_ = ((pbx) >> 11) & 1, j_ = (pbx) >> 12; const float* tf_ = (const float*)(p.ws + WS_TAPS) + ((size_t)j_ * 8192 + (size_t)(n_ * 2 + 0) * D + d_) * 4096; \
            const float* tb_ = tf_ + (size_t)D * 4096; _Pragma("unroll") for (int jj = 0; jj < 16; ++jj) { const int nn = tau + 256 * jj; tlo[jj] = __builtin_nontemporal_load(tf_ + nn); thi[jj] = __builtin_nontemporal_load(tb_ + ((4096 - nn) & 4095)); } } while (0)
        if (blockIdx.x * 2 + grp < 2 * 2 * 2048) FILT_TAPS(blockIdx.x * 2 + grp);
        for (int pb = blockIdx.x * 2 + grp; pb < 2 * 2 * 2048; pb += gridDim.x * 2) {
            const int d = pb & 2047, n = (pb >> 11) & 1, j = pb >> 12;
            const float adel = hy_absdelta(d); const float cdec = adel * (1.0f / 4095.0f);
            float dl = expf(-(float)tau * cdec), dh = expf(-(float)(4096 - tau) * cdec); const float rl = expf(-256.0f * cdec), rh = expf(256.0f * cdec);
            f32x2 xe[16], xo[16]; float ss = 0.f;
#pragma unroll
            for (int jj = 0; jj < 16; ++jj) { const int nn = tau + 256 * jj;
                const float klo = tlo[jj] * dl;
                const float khi = (nn != 0) ? thi[jj] * dh : 0.f;
                dl *= rl; dh *= rh;
                ss += klo * klo + khi * khi; xe[jj] = (f32x2){klo + khi, 0.f}; xo[jj] = (f32x2){klo - khi, 0.f}; }
            if (pb + (int)gridDim.x * 2 < 2 * 2 * 2048) FILT_TAPS(pb + (int)gridDim.x * 2);
            ss = wave_sum(ss);
            if ((tid & 63) == 0) red[(tid >> 6) & 3] = ss;
            fft_fwd0<256>(xe, xo, E, O, tau, tw);
            __syncthreads();
            const float tot = red[0] + red[1] + red[2] + red[3];
            const float scale = (1.0f / sqrtf(tot + EPS)) * (1.0f / 8192.0f);
            const float hbs = p.hy_bias[((size_t)j * 2 + n) * D + d] * (1.0f / 8192.0f);
            fft_pass1<false>(E, tau, tw); fft_pass1<false>(O, tau, tw);
            __syncthreads();
            f32x2* kf = (f32x2*)(p.ws + WS_KF) + (size_t)pb * 8192 + (size_t)tau * 2;
            f32x2 y[16];
            fft_fwd2(E, tau, y);
#pragma unroll
            for (int q = 0; q < 8; ++q) *(f32x4*)(kf + KFQ * q) = (f32x4){y[2 * q].x * scale + hbs, y[2 * q].y * scale, y[2 * q + 1].x * scale + hbs, y[2 * q + 1].y * scale};
            fft_fwd2(O, tau, y);
#pragma unroll
            for (int q = 0; q < 8; ++q) *(f32x4*)(kf + 4096 + KFQ * q) = (f32x4){y[2 * q].x * scale + hbs, y[2 * q].y * scale, y[2 * q + 1].x * scale + hbs, y[2 * q + 1].y * scale};
            __syncthreads();
        }
    }
#undef FILT_TAPS
    {
        const int pr = tid >> 4, i = tid & 15; constexpr int KFQ = 32;
        LAS f32x2* E = (LAS f32x2*)(lds + pr * 4352); LAS f32x2* O = E + 272;
        for (int it = blockIdx.x; it < 256; it += gridDim.x) {
            const int pb = it * 32 + pr; const int d = pb & 2047, n = (pb >> 11) & 1, j = pb >> 12;
            const float* tf = (const float*)(p.ws + WS_TAPSC) + ((size_t)j * 8192 + (size_t)(n * 2 + 0) * D + d) * 256;
            const float* tb = tf + (size_t)D * 256;
            const float adel = hy_absdelta(d); const float cdec = adel * (1.0f / 255.0f);
            float dl = expf(-(float)i * cdec), dh = expf(-(float)(256 - i) * cdec); const float rl = expf(-16.0f * cdec), rh = expf(16.0f * cdec);
            f32x2 xe[16], xo[16]; float ss = 0.f;
#pragma unroll
            for (int jj = 0; jj < 16; ++jj) { const int nn = i + 16 * jj;
                const float klo = tf[nn] * dl;
                const int m = 256 - nn;
                const float khi = (m < 256) ? tb[m & 255] * dh : 0.f;
                dl *= rl; dh *= rh;
                ss += klo * klo + khi * khi; xe[jj] = (f32x2){klo + khi, 0.f}; xo[jj] = (f32x2){klo - khi, 0.f}; }
            ss += shx(ss, 8); ss += shx(ss, 4); ss += shx(ss, 2); ss += shx(ss, 1);
            const float scale = (1.0f / sqrtf(ss + EPS)) * (1.0f / 512.0f);
            const float hbs = p.hy_bias[((size_t)j * 2 + n) * D + d] * (1.0f / 512.0f);
            fft_fwd0<16>(xe, xo, E, O, i, tw);
            __syncthreads();
            f32x2* kf = (f32x2*)(p.ws + WS_KFC) + (size_t)pb * 512 + (size_t)i * 2;
            f32x2 y[16];
            fft_fwd2(E, i, y);
#pragma unroll
            for (int q = 0; q < 8; ++q) *(f32x4*)(kf + KFQ * q) = (f32x4){y[2 * q].x * scale + hbs, y[2 * q].y * scale, y[2 * q + 1].x * scale + hbs, y[2 * q + 1].y * scale};
            fft_fwd2(O, i, y);
#pragma unroll
            for (int q = 0; q < 8; ++q) *(f32x4*)(kf + 256 + KFQ * q) = (f32x4){y[2 * q].x * scale + hbs, y[2 * q].y * scale, y[2 * q + 1].x * scale + hbs, y[2 * q + 1].y * scale};
            __syncthreads();
        }
    }
}

__device__ __forceinline__ float conv3_lds(const LAS h16* row, int n, float w0, float w1, float w2, float b) { return (float)row[n - 1] * w0 + (float)row[n] * w1 + (float)row[n + 1] * w2 + b; }
constexpr int ST_P = 4112, STS_P = 272;

#ifndef PROBE_CVAR
#define PROBE_CVAR 0
#endif
__device__ __forceinline__ void conv_phase(const Params& p, int jl, LAS unsigned char* lds, int pvar = 0, int cvt_layer = -1, int cvt_n = 0) {
    const int tid = tid_fresh(); const bool cv_outer = !(pvar && (PROBE_CVAR & 1)), cv_inner = !(pvar && (PROBE_CVAR & 2));
    LAS f32x2* tw = (LAS f32x2*)(lds + LDS_MISC + 1024);
    tw[tid] = ((const f32x2*)(p.ws + WS_TW))[tid];
    __syncthreads();
    const h16* ut = (const h16*)(p.ws + WS_UT); h16* zt = (h16*)(p.ws + WS_ZT);
    const float* cw = p.hy_conv_w + (size_t)jl * 3 * D3; const float* cb = p.hy_conv_b + (size_t)jl * D3;
    {
        const int grp = tid >> 8, tau = tid & 255;
        LAS f32x2* E = (LAS f32x2*)(lds + grp * 69632); LAS f32x2* O = E + 4352; LAS h16* ST = (LAS h16*)E;
        int uit = 0; const int utrig = 4 * (((int)blockIdx.x >> 3) & 3);
        for (int unit = blockIdx.x; unit < 4096; unit += gridDim.x, ++uit) {
            if (cvt_layer >= 0 && uit == utrig) { __syncthreads(); cvt_moe_share(p, cvt_layer, blockIdx.x, cvt_n, gridDim.x, (LAS float*)lds); }
            const int ux = unit & 7, uj = unit >> 3; const int hq = uj & 1, d = (uj >> 1) * 8 + ux; const size_t col0 = (size_t)(4 * hq + 2 * grp) * 4096;
            const f32x2* kfb = (const f32x2*)(p.ws + WS_KF) + ((size_t)(jl * 2) * 2048 + d) * 8192 + (size_t)tau * 2;
            f16x8 raw[2][2][2], raw2[2][2];
#pragma unroll
            for (int sq = 0; sq < 2; ++sq)
#pragma unroll
                for (int bb = 0; bb < 2; ++bb)
#pragma unroll
                    for (int k = 0; k < 2; ++k) raw[sq][bb][k] = __builtin_nontemporal_load((const f16x8*)(ut + (size_t)(sq * D + d) * TT + col0 + (size_t)bb * 4096 + (size_t)(tau + 256 * k) * 8));
            __syncthreads();
#pragma unroll
            for (int sq = 0; sq < 2; ++sq)
#pragma unroll
                for (int bb = 0; bb < 2; ++bb)
#pragma unroll
                    for (int k = 0; k < 2; ++k) *(LAS f16x8*)(ST + (sq * 2 + bb) * ST_P + 8 + (tau + 256 * k) * 8) = raw[sq][bb][k];
            if (tau < 4) { ST[tau * ST_P + 7] = (h16)0.f; ST[tau * ST_P + 8 + 4096] = (h16)0.f; }
            __syncthreads();
            f32x2 xin[16], gk[16], y[16];
            { const float w0 = cw[d], w1 = cw[D3 + d], w2 = cw[2 * D3 + d], bv = cb[d]; const float g0 = cw[D + d], g1 = cw[D3 + D + d], g2 = cw[2 * D3 + D + d], gb = cb[D + d];
#pragma unroll
                for (int jj = 0; jj < 16; ++jj) { const int nn = tau + 256 * jj;
                    xin[jj] = (f32x2){conv3_lds(ST + 8, nn, w0, w1, w2, bv), conv3_lds(ST + ST_P + 8, nn, w0, w1, w2, bv)};
                    gk[jj] = (f32x2){conv3_lds(ST + 2 * ST_P + 8, nn, g0, g1, g2, gb), conv3_lds(ST + 3 * ST_P + 8, nn, g0, g1, g2, gb)}; } }
            __syncthreads();
#pragma unroll 1
            for (int ord = 0; ord < 2; ++ord) {
                if (cv_outer) fft_fwd0<256>(xin, xin, E, O, tau, tw);
                const f32x2* kf = kfb + (size_t)ord * 2048 * 8192; f32x4 kfe[8], kfo[8];
                kf_load<256>(kf, kfe);
                __syncthreads();
                if (cv_inner) fft_pass1_pair<false>(E, O, tau, tw);
                kf_load<256>(kf + 4096, kfo);
                __syncthreads();
                if (cv_inner) { fft_mid(E, tau, kfe); fft_mid(O, tau, kfo); }
                if (ord == 0) {
#pragma unroll
                    for (int bb = 0; bb < 2; ++bb)
#pragma unroll
                        for (int k = 0; k < 2; ++k) raw2[bb][k] = __builtin_nontemporal_load((const f16x8*)(ut + (size_t)(2 * D + d) * TT + col0 + (size_t)bb * 4096 + (size_t)(tau + 256 * k) * 8)); }
                __syncthreads();
                if (cv_inner) fft_pass1_pair<true>(E, O, tau, tw);
                __syncthreads();
                if (cv_outer) fft_inv0<256>(E, O, tau, tw, y); else {
#pragma unroll
                    for (int jj = 0; jj < 16; ++jj) y[jj] = xin[jj]; }
#pragma unroll
                for (int jj = 0; jj < 16; ++jj) xin[jj] = gk[jj] * y[jj];
                if (ord == 0) {
                    __syncthreads();
#pragma unroll
                    for (int bb = 0; bb < 2; ++bb)
#pragma unroll
                        for (int k = 0; k < 2; ++k) *(LAS f16x8*)(ST + bb * ST_P + 8 + (tau + 256 * k) * 8) = raw2[bb][k];
                    if (tau < 2) { ST[tau * ST_P + 7] = (h16)0.f; ST[tau * ST_P + 8 + 4096] = (h16)0.f; }
                    __syncthreads();
                    const float g0 = cw[2 * D + d], g1 = cw[D3 + 2 * D + d], g2 = cw[2 * D3 + 2 * D + d], gb = cb[2 * D + d];
#pragma unroll
                    for (int jj = 0; jj < 16; ++jj) { const int nn = tau + 256 * jj; gk[jj] = (f32x2){conv3_lds(ST + 8, nn, g0, g1, g2, gb), conv3_lds(ST + ST_P + 8, nn, g0, g1, g2, gb)}; }
                    __syncthreads();
                }
            }
            h16* o0 = zt + (size_t)d * TT + col0; h16* o1 = o0 + 4096;
#pragma unroll
            for (int jj = 0; jj < 16; ++jj) { const int nn = tau + 256 * jj; o0[nn] = (h16)xin[jj].x; o1[nn] = (h16)xin[jj].y; }
        }
    }
    {
        const int pr = tid >> 4, i = tid & 15, c8 = pr >> 2, bp = pr & 3;
        LAS f32x2* E = (LAS f32x2*)(lds + pr * 4352); LAS f32x2* O = E + 272; LAS h16* ST = (LAS h16*)lds;
        for (int unit = blockIdx.x; unit < 256; unit += gridDim.x) {
            const int d0 = unit * 8, d = d0 + c8;
            const f32x2* kfb = (const f32x2*)(p.ws + WS_KFC) + ((size_t)(jl * 2) * 2048 + d) * 512 + (size_t)i * 2;
            f16x8 raw[3][4];
#pragma unroll
            for (int sq = 0; sq < 3; ++sq)
#pragma unroll
                for (int k = 0; k < 4; ++k) { const int q = tid + 512 * k, row = q >> 5, ch = q & 31;
                    raw[sq][k] = *(const f16x8*)(ut + (size_t)(sq * D + d0 + (row >> 3)) * TT + TL + (row & 7) * 256 + ch * 8); }
            __syncthreads();
#pragma unroll
            for (int sq = 0; sq < 2; ++sq)
#pragma unroll
                for (int k = 0; k < 4; ++k) { const int q = tid + 512 * k, row = q >> 5, ch = q & 31; *(LAS f16x8*)(ST + (sq * 64 + row) * STS_P + 8 + ch * 8) = raw[sq][k]; }
            if (tid < 128) { ST[tid * STS_P + 7] = (h16)0.f; ST[tid * STS_P + 8 + 256] = (h16)0.f; }
            __syncthreads();
            f32x2 xin[16], gk[16], y[16];
            { const float w0 = cw[d], w1 = cw[D3 + d], w2 = cw[2 * D3 + d], bv = cb[d]; const float g0 = cw[D + d], g1 = cw[D3 + D + d], g2 = cw[2 * D3 + D + d], gb = cb[D + d];
                const LAS h16* r0 = ST + (c8 * 8 + 2 * bp) * STS_P + 8; const LAS h16* r1 = r0 + 64 * STS_P;
#pragma unroll
                for (int jj = 0; jj < 16; ++jj) { const int nn = i + 16 * jj;
                    xin[jj] = (f32x2){conv3_lds(r0, nn, w0, w1, w2, bv), conv3_lds(r0 + STS_P, nn, w0, w1, w2, bv)};
                    gk[jj] = (f32x2){conv3_lds(r1, nn, g0, g1, g2, gb), conv3_lds(r1 + STS_P, nn, g0, g1, g2, gb)}; } }
            __syncthreads();
#pragma unroll 1
            for (int ord = 0; ord < 2; ++ord) {
                const f32x2* kf = kfb + (size_t)ord * 2048 * 512; f32x4 kfe[8], kfo[8];
                fft_fwd0<16>(xin, xin, E, O, i, tw);
                __syncthreads();
                kf_load<16>(kf, kfe); fft_mid(E, i, kfe); kf_load<16>(kf + 256, kfo); fft_mid(O, i, kfo);
                __syncthreads();
                fft_inv0<16>(E, O, i, tw, y);
#pragma unroll
                for (int jj = 0; jj < 16; ++jj) xin[jj] = gk[jj] * y[jj];
                if (ord == 0) {
                    __syncthreads();
#pragma unroll
                    for (int k = 0; k < 4; ++k) { const int q = tid + 512 * k, row = q >> 5, ch = q & 31; *(LAS f16x8*)(ST + row * STS_P + 8 + ch * 8) = raw[2][k]; }
                    if (tid < 64) { ST[tid * STS_P + 7] = (h16)0.f; ST[tid * STS_P + 8 + 256] = (h16)0.f; }
                    __syncthreads();
                    const float g0 = cw[2 * D + d], g1 = cw[D3 + 2 * D + d], g2 = cw[2 * D3 + 2 * D + d], gb = cb[2 * D + d];
                    const LAS h16* r0 = ST + (c8 * 8 + 2 * bp) * STS_P + 8;
#pragma unroll
                    for (int jj = 0; jj < 16; ++jj) { const int nn = i + 16 * jj; gk[jj] = (f32x2){conv3_lds(r0, nn, g0, g1, g2, gb), conv3_lds(r0 + STS_P, nn, g0, g1, g2, gb)}; }
                    __syncthreads();
                }
            }
            h16* o0 = zt + (size_t)d * TT + TL + (2 * bp) * 256; h16* o1 = o0 + 256;
#pragma unroll
            for (int jj = 0; jj < 16; ++jj) { const int nn = i + 16 * jj; o0[nn] = (h16)xin[jj].x; o1[nn] = (h16)xin[jj].y; }
        }
    }
}

constexpr int AT_KP = 72, AT_VP = 68;
__device__ __forceinline__ void attn_phase(const Params& p, int jl, bool with_ctx_out, LAS unsigned char* lds, int cvt_layer = -1, int cvt_n = 0) {
    const int tid = tid_fresh(), wv = tid >> 6, lane = tid & 63, r32 = lane & 31, hh = lane >> 5;
    LAS h16* Ks = (LAS h16*)lds; LAS h16* Vs = (LAS h16*)(lds + 64 * AT_KP * 2);
    const h16* qk = (const h16*)(p.ws + WS_QK); const h16* vt = (const h16*)(p.ws + WS_VT); h16* ob = (h16*)(p.ws + WS_HBUF);
    LAS float* rcos = (LAS float*)(lds + 65536); LAS float* rsin = rcos + 1024;
    { const float* rg = (const float*)(p.ws + WS_ROPE); for (int i = tid; i < 2048; i += 512) rcos[i] = rg[i]; }
    __syncthreads();
    const int nunit = 2048 + (with_ctx_out ? 128 : 0);
    int uit = 0; const int utrig = 2 * (((int)blockIdx.x >> 3) & 3);
    for (int unit = blockIdx.x; unit < nunit; unit += gridDim.x, ++uit) {
        if (cvt_layer >= 0 && uit == utrig) { __syncthreads(); cvt_moe_share(p, cvt_layer, blockIdx.x, cvt_n, gridDim.x, (LAS float*)lds); }
        int kind, b, g, qb;
        if (unit < 2048) { kind = 0; qb = unit & 63; g = (unit >> 6) & 3; b = unit >> 8; } else { const int u2 = unit - 2048; kind = 1; qb = u2 & 3; g = (u2 >> 2) & 3; b = u2 >> 4; }
        const int head = g * 8 + wv;
        const int qrow0 = kind ? (TL + b * 256 + qb * 64) : (b * 4096 + qb * 64);
        const int ctxrow0 = TL + b * 256;
        const int t_lo = kind ? 0 : (qb < 2 ? 2 - qb : 0), t_hi = kind ? -1 : (65 - qb < 4 ? 65 - qb : 4); const int nwin = t_hi - t_lo + 1, nv = nwin + 4;
        const bool krole = tid < 256; const int kkey = tid >> 2, kcp = tid & 3, kdA = (kcp & 1) * 8 + (kcp >> 1) * 32; const int vdim = (tid - 256) >> 2, vkc = tid & 3;
        f16x8 ld0, ld1;
#define AT_TILE(sidx, KROW0, MASK, ROPE) do { if ((sidx) < nwin) { const int _ti = t_lo + (sidx); KROW0 = b * 4096 + qb * 64 - 128 + 64 * _ti; ROPE = true; MASK = (_ti == 0) ? 1 : (_ti == 4) ? 2 : 0; } \
            else { KROW0 = ctxrow0 + 64 * ((sidx) - nwin); ROPE = false; MASK = 0; } } while (0)
#define AT_LOAD(KROW0) do { if (krole) { const h16* kp = qk + (size_t)((KROW0) + kkey) * DQK + D + g * 64 + kdA; ld0 = *(const f16x8*)kp; ld1 = *(const f16x8*)(kp + 16); } \
            else { const h16* vp = vt + (size_t)(g * 64 + vdim) * TT + (KROW0) + 16 * vkc; ld0 = *(const f16x8*)vp; ld1 = *(const f16x8*)(vp + 8); } } while (0)
        { int kr0, mk; bool rp; AT_TILE(0, kr0, mk, rp); (void)mk; (void)rp; AT_LOAD(kr0); }
        f16x8 qf[2][4];
#pragma unroll
        for (int qt = 0; qt < 2; ++qt) {
            f32x4 qv[4][2];
            const h16* qp = qk + (size_t)(qrow0 + 32 * qt + r32) * DQK + head * 64 + 8 * hh;
#pragma unroll
            for (int ks = 0; ks < 4; ++ks) { const f16x8 t = __builtin_nontemporal_load((const f16x8*)(qp + 16 * ks));
#pragma unroll
                for (int i = 0; i < 4; ++i) { qv[ks][0][i] = (float)t[i]; qv[ks][1][i] = (float)t[4 + i]; } }
            if (kind == 0) {
                const int colpos = 32 * qt + r32;
#pragma unroll
                for (int a = 0; a < 2; ++a) { const int pos = a ? colpos : qb; const LAS float* cp = rcos + pos * 16 + 8 * hh; const LAS float* sp = rsin + pos * 16 + 8 * hh;
#pragma unroll
                    for (int e = 0; e < 2; ++e) { const f32x4 c = *(const LAS f32x4*)(cp + 4 * e), s = *(const LAS f32x4*)(sp + 4 * e);
                        const f32x4 x1 = qv[2 * a][e], x2 = qv[2 * a + 1][e]; qv[2 * a][e] = x1 * c - x2 * s; qv[2 * a + 1][e] = x2 * c + x1 * s; } }
            }
#pragma unroll
            for (int ks = 0; ks < 4; ++ks)
#pragma unroll
                for (int i = 0; i < 4; ++i) { qf[qt][ks][i] = (h16)(qv[ks][0][i] * (0.125f * 1.4426950408889634f)); qf[qt][ks][4 + i] = (h16)(qv[ks][1][i] * (0.125f * 1.4426950408889634f)); }
        }
        const float sink = p.at_sink[jl * 32 + head] * 1.4426950408889634f;
        float mrun[2] = {sink, sink}, lrun[2] = {hh == 0 ? 1.f : 0.f, hh == 0 ? 1.f : 0.f};
        f32x16 oacc[2][2];
#pragma unroll
        for (int a = 0; a < 2; ++a)
#pragma unroll
            for (int c = 0; c < 2; ++c)
#pragma unroll
                for (int i = 0; i < 16; ++i) oacc[a][c][i] = 0.f;
#pragma unroll 1
        for (int sx = 0; sx < nv; ++sx) {
            int krow0, mask; bool rope; AT_TILE(sx, krow0, mask, rope);
            __syncthreads();
            if (krole) {
                f16x8 o1 = ld0, o2 = ld1;
                if (rope) { const int kpos = (krow0 - b * 4096) + kkey; const int pos = (kcp >> 1) ? (kpos & 63) : (kpos >> 6);
                    const LAS float* cpp = rcos + pos * 16 + (kcp & 1) * 8; const LAS float* spp = rsin + pos * 16 + (kcp & 1) * 8;
#pragma unroll
                    for (int i = 0; i < 8; ++i) { const float c = cpp[i], s = spp[i], x1 = (float)ld0[i], x2 = (float)ld1[i]; o1[i] = (h16)(x1 * c - x2 * s); o2[i] = (h16)(x2 * c + x1 * s); } }
                *(LAS f16x8*)(Ks + kkey * AT_KP + kdA) = o1; *(LAS f16x8*)(Ks + kkey * AT_KP + kdA + 16) = o2;
            } else {
                LAS h16* dst = Vs + vdim * AT_VP + 16 * vkc;
                *(LAS f16x4*)(dst) = (f16x4){ld0[0], ld0[1], ld0[2], ld0[3]}; *(LAS f16x4*)(dst + 4) = (f16x4){ld0[4], ld0[5], ld0[6], ld0[7]};
                *(LAS f16x4*)(dst + 8) = (f16x4){ld1[0], ld1[1], ld1[2], ld1[3]}; *(LAS f16x4*)(dst + 12) = (f16x4){ld1[4], ld1[5], ld1[6], ld1[7]};
            }
            if (sx + 1 < nv) { int kr1, mk1; bool rp1; AT_TILE(sx + 1, kr1, mk1, rp1); (void)mk1; (void)rp1; AT_LOAD(kr1); }
            __syncthreads();
#pragma unroll
            for (int qt = 0; qt < 2; ++qt) {
                f32x16 sacc[2];
#pragma unroll
                for (int kt = 0; kt < 2; ++kt)
#pragma unroll
                    for (int i = 0; i < 16; ++i) sacc[kt][i] = 0.f;
#pragma unroll
                for (int ks = 0; ks < 4; ++ks)
#pragma unroll
                    for (int kt = 0; kt < 2; ++kt) { const f16x8 kf = *(const LAS f16x8*)(Ks + (32 * kt + r32) * AT_KP + 16 * ks + 8 * hh);
                        sacc[kt] = __builtin_amdgcn_mfma_f32_32x32x16_f16(kf, qf[qt][ks], sacc[kt], 0, 0, 0); }
                float tmax = -3.0e38f;
                if (mask != 0) {
                    int lim = r32 - 4 * hh; asm volatile("" : "+v"(lim));
                    if (mask == 1) {
#pragma unroll
                        for (int kt = 0; kt < 2; ++kt) {
                            if (kt < qt) {
#pragma unroll
                                for (int i = 0; i < 16; ++i) sacc[kt][i] = -1.0e30f; }
                            else if (kt == qt) {
#pragma unroll
                                for (int i = 0; i < 16; ++i) { const int kc = (i & 3) + 8 * (i >> 2); if (kc < lim) sacc[kt][i] = -1.0e30f; } } }
                    } else {
#pragma unroll
                        for (int kt = 0; kt < 2; ++kt) {
                            if (kt > qt) {
#pragma unroll
                                for (int i = 0; i < 16; ++i) sacc[kt][i] = -1.0e30f; }
                            else if (kt == qt) {
#pragma unroll
                                for (int i = 0; i < 16; ++i) { const int kc = (i & 3) + 8 * (i >> 2); if (kc > lim) sacc[kt][i] = -1.0e30f; } } }
                    } }
#pragma unroll
                for (int kt = 0; kt < 2; ++kt)
#pragma unroll
                    for (int i = 0; i < 16; ++i) tmax = fmaxf(tmax, sacc[kt][i]);
                tmax = fmaxf(tmax, shx(tmax, 32));
                const float mnew = fmaxf(mrun[qt], tmax); const float alpha = __builtin_amdgcn_exp2f(mrun[qt] - mnew); mrun[qt] = mnew;
                float psum = 0.f; f16x8 pf[2][2];
#pragma unroll
                for (int kt = 0; kt < 2; ++kt)
#pragma unroll
                    for (int s2 = 0; s2 < 2; ++s2)
#pragma unroll
                        for (int jj = 0; jj < 8; jj += 2) { const float p0 = __builtin_amdgcn_exp2f(sacc[kt][8 * s2 + jj] - mnew), p1 = __builtin_amdgcn_exp2f(sacc[kt][8 * s2 + jj + 1] - mnew);
                            const f16x2 pk = {(h16)p0, (h16)p1}; pf[kt][s2][jj] = pk[0]; pf[kt][s2][jj + 1] = pk[1];
                            psum = __builtin_amdgcn_fdot2(pk, (f16x2){(h16)1.0f, (h16)1.0f}, psum, false); }
                lrun[qt] = lrun[qt] * alpha + psum;
                if (__builtin_amdgcn_ballot_w64(alpha != 1.0f) != 0ull) {
#pragma unroll
                for (int dt = 0; dt < 2; ++dt)
#pragma unroll
                    for (int i = 0; i < 16; ++i) oacc[dt][qt][i] *= alpha; }
#pragma unroll
                for (int kt = 0; kt < 2; ++kt)
#pragma unroll
                    for (int s2 = 0; s2 < 2; ++s2)
#pragma unroll
                        for (int dt = 0; dt < 2; ++dt) { const LAS h16* vr = Vs + (32 * dt + r32) * AT_VP + 32 * kt + 16 * s2 + 4 * hh;
                            const f16x4 v0 = *(const LAS f16x4*)vr, v1 = *(const LAS f16x4*)(vr + 8);
                            const f16x8 vf = (f16x8){v0[0], v0[1], v0[2], v0[3], v1[0], v1[1], v1[2], v1[3]};
                            oacc[dt][qt] = __builtin_amdgcn_mfma_f32_32x32x16_f16(vf, pf[kt][s2], oacc[dt][qt], 0, 0, 0); }
            }
        }
        {   LAS h16* Ow = (LAS h16*)(lds + (wv < 4 ? 18432 + wv * 9216 : 73728 + (wv - 4) * 9216));
#pragma unroll
            for (int qt = 0; qt < 2; ++qt) {
                const float ltot = lrun[qt] + shx(lrun[qt], 32); const float inv = 1.0f / ltot;
                LAS h16* orow = Ow + (32 * qt + r32) * 72 + 4 * hh;
#pragma unroll
                for (int dt = 0; dt < 2; ++dt)
#pragma unroll
                    for (int q4 = 0; q4 < 4; ++q4) { f16x4 w;
#pragma unroll
                        for (int i = 0; i < 4; ++i) w[i] = (h16)(oacc[dt][qt][4 * q4 + i] * inv);
                        *(LAS f16x4*)(orow + 32 * dt + 8 * q4) = w; }
            }
            asm volatile("s_waitcnt lgkmcnt(0)" ::: "memory");
            const int orw = lane >> 3, och = lane & 7;
#pragma unroll
            for (int ps = 0; ps < 8; ++ps) { const int q = 8 * ps + orw; const f16x8 w = *(const LAS f16x8*)(Ow + q * 72 + 8 * och);
                *(f16x8*)(ob + (size_t)(qrow0 + q) * D + head * 64 + 8 * och) = w; }
        }
    }
}
#undef AT_TILE
#undef AT_LOAD

constexpr int NPHASE = 35;
#ifndef MK_MULTI
#define MK_MULTI 0
#endif

template <int KIND>
__attribute__((target("no-packed-fp32-ops"))) __global__ void __launch_bounds__(512, 2) hy_fwd(Params p_) {
    extern __shared__ __attribute__((aligned(16))) unsigned char shm[];
    LAS unsigned char* lds = (LAS unsigned char*)shm;
    constexpr bool ALL = KIND < 0;
    const int ph0 = p_.ph0;
    if (threadIdx.x == 0) { *(LAS u32x4*)(lds + LDS_XB) = (u32x4){0u, 0u, 0u, 0u}; }
    __syncthreads();
    XcdBarrier bar;
    if constexpr (ALL) bar = xcd_barrier_post((unsigned*)(p_.ws + WS_CTL), (volatile LAS unsigned*)(lds + LDS_XB));
#ifndef PROBE_SITE
#define PROBE_SITE -1
#endif
#define SITE(k) if constexpr (ALL || KIND == (k)) for (int rep_ = 0; rep_ < ((k) == PROBE_SITE ? 2 : 1); ++rep_) if (const Params& p = *params_fresh(); true)
#ifndef PROBE_XBAR
#define PROBE_XBAR 1
#endif
#define SEAM() do { if constexpr (ALL) { xcd_barrier(bar); if (PROBE_XBAR > 1) xcd_barrier(bar); if (PROBE_XBAR > 2) xcd_barrier(bar); } } while (0)
    const int G = gridDim.x, bid = blockIdx.x;
    SITE(0) {
        for (int u = bid; u < 4993; u += G) {
            if (u < 384) modp_unit(p, u, (LAS float*)lds);
            else if (u == 384) tables_unit(p);
            else if (u < 1473) h2_task(p, (u - 385) * 8 + (tid_fresh() >> 6));
            else if (u < 1537) w3p_unit(p, u - 1473);
            else if (u < 1793) rtab_unit(p, u - 1537);
            else cvt_dense_unit(p, u - 1793, (LAS float*)lds);
        }
        SEAM();
    }
    SITE(1) {
        for (int u = bid; u < 216; u += G) modr_unit(p, u);
        SchedFilt S{p.ws + WS_W3P, p.ws + WS_H2P}; EpiTaps E{(float*)(p.ws + WS_TAPS), (float*)(p.ws + WS_TAPSC)};
        pg8::gemm_phase<EpiTaps, SchedFilt, 0>(lds, 256, S, E);
        SEAM();
    }
#define TAIL_IDLE(nunits) (((nunits) % G) ? G - ((nunits) % G) : 0)
#define CVT_PER_GEMM 20
#pragma unroll 1
    for (int layer = ALL ? 0 : ph0; layer < (ALL ? NLAYER : ph0 + 1); ++layer) {
        const bool hyena = (layer & 1) == 0; const int jl = layer >> 1;
        const int nu1 = hyena ? 24 * 136 : 136 * 10, nu4 = (layer == NLAYER - 1 ? 128 : 136) * 8;
        const int idle1 = TAIL_IDLE(nu1), idle4 = TAIL_IDLE(nu4);
        int cv4 = idle4 * CVT_PER_GEMM, cv1 = idle1 * CVT_PER_GEMM; if (cv4 > CVT_MOE_UNITS / 2) cv4 = CVT_MOE_UNITS / 2; if (cv1 > CVT_MOE_UNITS / 2 - 1) cv1 = CVT_MOE_UNITS / 2 - 1;
        const int cvN0 = CVT_MOE_UNITS - cv1 - cv4, cvN1 = cvN0 + cv1;
        SITE(2) {
            n1_phase(p, layer, (h16*)(p.ws + ((!ALL && p.ph1) ? WS_UT : WS_XRES)));
            for (int rep2_ = 0; rep2_ < ((PROBE_SITE == 20 && layer > 0) ? 2 : 1); ++rep2_) {
            if (layer == 0) filt_fft_phase(p, lds);
            else { (void)0; } }
            SEAM();
        }
        SITE(3) {
#ifdef PROBE_CLK
            unsigned long long pc0_ = __builtin_readcyclecounter(), pr0_ = wall_clock64();
#endif
            if (hyena) { SchedPlain S{24, 136, D, p.ws + WS_WIN + (size_t)jl * D3 * D * 2, p.ws + WS_HBUF}; EpiH16 E{(h16*)(p.ws + WS_UT), TT, nullptr, 0};
                pg8::gemm_phase<EpiH16, SchedPlain, 0>(lds, D, S, E); }
            else { SchedQkv S{p.ws + WS_HBUF, p.ws + WS_WQKV + (size_t)jl * DQKV * D * 2}; EpiH16 E{(h16*)(p.ws + WS_QK), DQK, (h16*)(p.ws + WS_VT), TT};
                pg8::gemm_phase<EpiH16, SchedQkv, 0>(lds, D, S, E); }
#ifdef PROBE_CLK
            if (bid == 0 && threadIdx.x == 0) { const unsigned long long dc = __builtin_readcyclecounter() - pc0_, dr = wall_clock64() - pr0_; const unsigned long long spin = dc * 2500ull / (dr ? dr : 1ull);
                const unsigned long long t0 = wall_clock64(); while (wall_clock64() - t0 < spin) __builtin_amdgcn_s_sleep(8); }
#endif
            if (idle1 > 0 && bid >= G - idle1) { cvt_moe_share(p, layer, cvN0 + (bid - (G - idle1)), cvN1, idle1, (LAS float*)lds); }
            SEAM();
        }
        SITE(4) {
#ifdef PROBE_PAR
            for (int rep3_ = 0; rep3_ < (((layer & 1) == PROBE_PAR) ? 2 : 1); ++rep3_)
#endif
            { if (hyena) conv_phase(p, jl, lds, ALL ? 0 : p.ph1, layer, cvN0);
            else attn_phase(p, jl, layer != NLAYER - 1, lds, layer, cvN0); }
            SEAM();
        }
        SITE(5) {
            (void)0;
        }
        SITE(6) {
            EpiResid E{(h16*)(p.ws + WS_XRES), (const float*)(p.ws + WS_MODS), layer, (float*)(p.ws + WS_SSQ), (!ALL && p.ph1) ? (h16*)(p.ws + WS_YC) : (h16*)(p.ws + WS_XRES)};
            if (hyena) {
                SchedPlainAT S{layer == NLAYER - 1 ? 128 : 136, 8, D, p.ws + WS_ZT, p.ws + WS_WOUT + (size_t)jl * D * D * 2};
                pg8::gemm_phase<EpiResid, SchedPlainAT, 2>(lds, D, S, E, TT);
            } else {
                SchedPlain S{layer == NLAYER - 1 ? 128 : 136, 8, D, p.ws + WS_HBUF, p.ws + WS_WO + (size_t)jl * D * D * 2};
                pg8::gemm_phase<EpiResid, SchedPlain, 0>(lds, D, S, E);
            }
            if (idle4 > 0 && bid >= G - idle4) { cvt_moe_share(p, layer, cvN1 + (bid - (G - idle4)), CVT_MOE_UNITS, idle4, (LAS float*)lds); }
            SEAM();
        }
        SITE(7) { n2_phase(p, layer, lds, ALL ? 0 : p.ph1); SEAM(); }
        LAS int* tstart = (LAS int*)(lds + LDS_MISC); LAS int* texp = tstart + 80; LAS int* tcnt = texp + 352;
        SITE(8) {
            moe_table(tstart, texp, tcnt, (const int*)(p.ws + WS_CTL) + CTL_CNT + layer * NE);
            SchedMoe1 S{{tstart, texp, tcnt}, p.ws + WS_HBUF, p.ws + WS_W13, (const int*)(p.ws + WS_LIST)}; EpiMoe1 E{(h16*)(p.ws + WS_H1)};
            pg8::gemm_phase<EpiMoe1, SchedMoe1, 1>(lds, D, S, E);
            SEAM();
        }
        SITE(9) {
            moe_table(tstart, texp, tcnt, (const int*)(p.ws + WS_CTL) + CTL_CNT + layer * NE);
            SchedMoe2 S{{tstart, texp, tcnt}, p.ws + WS_H1, p.ws + WS_W2, (const int*)(p.ws + WS_LIST)}; EpiMoe2 E{(h16*)(p.ws + WS_YC), (const float*)(p.ws + WS_GATE), (const int*)(p.ws + WS_LIST)};
            pg8::gemm_phase<EpiMoe2, SchedMoe2, 0>(lds, DE, S, E);
            SEAM();
        }
    }
    SITE(10) final_phase(p);
#undef SITE
#undef SEAM
}

template <int KIND> static void launch_kind(const Params& p, int grid, hipStream_t stream) {
    static bool attr = false;
    if (!attr) { attr = true; if (hipFuncSetAttribute((const void*)hy_fwd<KIND>, hipFuncAttributeMaxDynamicSharedMemorySize, LDS_BYTES) != hipSuccess) fprintf(stderr, "kernel_launch: hipFuncSetAttribute failed (kind %d)\n", KIND); }
    hipLaunchKernelGGL(hy_fwd<KIND>, dim3(grid), dim3(512), LDS_BYTES, stream, p);
}

extern "C" void kernel_launch(void* const* d_in, const int* in_sizes, int n_in, void* d_out, int out_size, void* d_ws, size_t ws_size, hipStream_t stream) {
    static int grid = 0;
    if (!grid) {
        if (n_in != 29 || out_size != TL * D || ws_size < WS_END) { fprintf(stderr, "kernel_launch: unexpected problem (n_in %d, out %d, ws %zu < %zu)\n", n_in, out_size, ws_size, (size_t)WS_END); grid = -1; return; }
        int dev = 0, cus = 0;
        if (hipGetDevice(&dev) != hipSuccess || hipDeviceGetAttribute(&cus, hipDeviceAttributeMultiprocessorCount, dev) != hipSuccess) { grid = -1; return; }
        grid = cus;
    }
    if (grid <= 0) return;
    (void)hipMemsetAsync((char*)d_ws + WS_CTL, 0, CTL_BYTES, stream);
    Params p{};
    const float** pp = (const float**)&p;
    for (int i = 0; i < 29; ++i) pp[i] = (const float*)d_in[i];
    p.out = (float*)d_out; p.ws = (char*)d_ws;
#if MK_MULTI
    p.ph0 = 0; p.ph1 = 0;
    launch_kind<0>(p, grid, stream); launch_kind<1>(p, grid, stream);
#ifndef PROBE_KINDS
#define PROBE_KINDS 0
#endif
#ifndef PROBE_VAR
#define PROBE_VAR 0
#endif
#ifndef PROBE_LAYERS
#define PROBE_LAYERS 15
#endif
#define PKIND(k) ((PROBE_KINDS >> (k)) & 1)
#define PREP(k) ((PKIND(k) && ((PROBE_LAYERS >> layer) & 1)) ? 2 : 1)
    if (PKIND(0)) launch_kind<0>(p, grid, stream);
    if (PKIND(1)) launch_kind<1>(p, grid, stream);
    for (int layer = 0; layer < NLAYER; ++layer) { p.ph0 = layer;
        for (int r = 0; r < PREP(2); ++r) { p.ph1 = (PREP(2) == 2 && r == 0) ? 1 : 0; launch_kind<2>(p, grid, stream); p.ph1 = 0; }
        for (int r = 0; r < PREP(3); ++r) { p.ph1 = (PREP(3) == 2 && r == 0) ? PROBE_VAR : 0; launch_kind<3>(p, grid, stream); p.ph1 = 0; }
        for (int r = 0; r < PREP(4); ++r) { p.ph1 = (PREP(4) == 2 && r == 0) ? 1 : 0; launch_kind<4>(p, grid, stream); p.ph1 = 0; }
        if (PREP(6) == 2) { p.ph1 = 1; launch_kind<6>(p, grid, stream); p.ph1 = 0; }
        launch_kind<6>(p, grid, stream); launch_kind<7>(p, grid, stream);
        if (PREP(7) == 2) { p.ph1 = 1; launch_kind<7>(p, grid, stream); p.ph1 = 0; }
        for (int r = 0; r < PREP(8); ++r) launch_kind<8>(p, grid, stream);
        for (int r = 0; r < PREP(9); ++r) launch_kind<9>(p, grid, stream); }
    p.ph0 = 0; launch_kind<10>(p, grid, stream);
    if (PKIND(10)) launch_kind<10>(p, grid, stream);
#else
    p.ph0 = 0; p.ph1 = NPHASE;
    launch_kind<-1>(p, grid, stream);
#endif
}
```
